# Optimizing an MI355X kernel written in HIP

```python
import math
import jax
import jax.numpy as jnp
from jax import lax
import numpy as np

D_MODEL = 1024
BATCH = 4
SEQ = 4096
DEPTH = 4

GRID_W = 64
CTX_LEN = 256
F32 = jnp.float32
EPS = 1e-6
NEG = -1e30
N_MOD = 9
FFN_RESIDUAL = 0.5
D_FF = 256 * math.ceil(8 * D_MODEL / 3 / 256)
HEAD_DIM = 64
A_Q_HEADS = D_MODEL // (2 * HEAD_DIM)
A_KV_HEADS = max(1, A_Q_HEADS // 4)
WINDOW = 128
BLOCK = 128
ROPE_BASE = 10000.0
R_DIM = 64
R_HEADS = D_MODEL // (2 * R_DIM)
R_CHUNK = 128
R_MIN_EXP = 5.0
A_Q_W = A_Q_HEADS * HEAD_DIM
A_KV_W = A_KV_HEADS * HEAD_DIM
R_W = R_HEADS * R_DIM
Q_WIDTHS = (A_Q_W, R_W, R_W)
KV_WIDTHS = (A_KV_W, A_KV_W, R_W, R_W)
Q_SIDE = sum(Q_WIDTHS)
IN_W = Q_SIDE + sum(KV_WIDTHS)
MIX_W = A_Q_W + R_W
HY_EMB = 33
HY_ORDER = 64
HY_SHORT = 3
HY_MAX_DECAY = math.log(1e-2) / 0.3
HY_MIN_DECAY = math.log(1e-2) / 1.5
N_EVEN = (DEPTH + 1) // 2
N_ODD = DEPTH // 2

kernel_name = 'hybrid_swa_retention_hyena_prefix_dit'


def rmsnorm(x, g):
    xf = x.astype(F32)
    y = xf * lax.rsqrt(jnp.mean(xf * xf, -1, keepdims=True) + EPS)
    return (y * g.astype(F32)).astype(x.dtype)


def adaln_in(x, g, m, i):
    return rmsnorm(x, g) * (1.0 + m[:, :, 3 * i + 1]) + m[:, :, 3 * i]


def adaln_out(x, y, g, m, i, w):
    return x + w * m[:, :, 3 * i + 2] * rmsnorm(y, g)


def swiglu(h, w_gate, w_up, w_down):
    return (jax.nn.silu(h @ w_gate) * (h @ w_up)) @ w_down


def macaron_half(s, m, i, g_pre, g_post, w_gate, w_up, w_down):
    h = adaln_in(s, g_pre, m, i)
    return adaln_out(s, swiglu(h, w_gate, w_up, w_down), g_post, m, i, FFN_RESIDUAL)


def split_cols(z, widths):
    idx = np.cumsum(widths)[:-1].tolist()
    return jnp.split(z, idx, axis=-1)


def heads(a, d):
    return a.reshape(a.shape[0], a.shape[1], -1, d)


def axial_rope(L):
    n_rows = L // GRID_W
    row = jnp.repeat(jnp.arange(n_rows, dtype=F32), GRID_W)
    col = jnp.tile(jnp.arange(GRID_W, dtype=F32), n_rows)
    nf = HEAD_DIM // 4
    inv = ROPE_BASE ** (-jnp.arange(nf, dtype=F32) / nf)
    ang = jnp.concatenate([row[:, None] * inv, col[:, None] * inv], -1)
    return jnp.cos(ang), jnp.sin(ang)


def line_rope(L, d):
    inv = ROPE_BASE ** (-jnp.linspace(0.0, 1.0, d // 2, dtype=F32))
    ang = jnp.arange(L, dtype=F32)[:, None] * inv
    return jnp.cos(ang), jnp.sin(ang)


def apply_rope(x, cos, sin):
    half = x.shape[-1] // 2
    x1, x2 = x[..., :half], x[..., half:]
    c, s = cos[None, :, None], sin[None, :, None]
    return jnp.concatenate([x1 * c - x2 * s, x1 * s + x2 * c], -1).astype(x.dtype)


def window_attention(q, k, v, kc, vc, sink):
    Bn, L, Hq, dh = q.shape
    G = k.shape[2]
    R = Hq // G
    nb = L // BLOCK
    T = BLOCK
    qb = q.reshape(Bn, nb, T, G, R, dh)
    pad = ((0, 0), (T, T), (0, 0), (0, 0))
    kp = jnp.pad(k, pad).reshape(Bn, nb + 2, T, G, dh)
    vp = jnp.pad(v, pad).reshape(Bn, nb + 2, T, G, dh)
    kb = jnp.concatenate([kp[:, :-2], kp[:, 1:-1], kp[:, 2:]], axis=2)
    vb = jnp.concatenate([vp[:, :-2], vp[:, 1:-1], vp[:, 2:]], axis=2)
    qi = jnp.arange(T)[:, None]
    kj = jnp.arange(3 * T)[None, :]
    kpos = jnp.arange(nb)[:, None, None] * T - T + kj
    valid = (jnp.abs(kj - T - qi) <= WINDOW)[None] & (kpos >= 0) & (kpos < L)
    scale = HEAD_DIM ** -0.5
    s_loc = jnp.einsum('bnqgrd,bnkgd->bngrqk', qb, kb).astype(F32) * scale
    s_loc = jnp.where(valid[None, :, None, None], s_loc, NEG)
    s_ctx = jnp.einsum('bnqgrd,bcgd->bngrqc', qb, kc).astype(F32) * scale
    s_sink = jnp.broadcast_to(sink.astype(F32).reshape(G, R)[None, None, :, :, None, None],
                              s_loc.shape[:-1] + (1,))
    p = jax.nn.softmax(jnp.concatenate([s_loc, s_ctx, s_sink], -1), axis=-1).astype(v.dtype)
    o = (jnp.einsum('bngrqk,bnkgd->bnqgrd', p[..., :3 * T], vb)
         + jnp.einsum('bngrqc,bcgd->bnqgrd', p[..., 3 * T:-1], vc))
    return o.reshape(Bn, L, Hq * dh)


def context_attention(qc, kc, vc, sink):
    Bn, C, Hq, dh = qc.shape
    G = kc.shape[2]
    R = Hq // G
    qg = qc.reshape(Bn, C, G, R, dh)
    s = jnp.einsum('bqgrd,bkgd->bgrqk', qg, kc).astype(F32) * HEAD_DIM ** -0.5
    s_sink = jnp.broadcast_to(sink.astype(F32).reshape(G, R)[None, :, :, None, None], s.shape[:-1] + (1,))
    p = jax.nn.softmax(jnp.concatenate([s, s_sink], -1), axis=-1)[..., :-1].astype(vc.dtype)
    return jnp.einsum('bgrqk,bkgd->bqgrd', p, vc).reshape(Bn, C, Hq * dh)


def retention_chunks(q, k, v, log_g, s0):
    Bn, L, H, _ = q.shape
    dv = v.shape[-1]
    n = L // R_CHUNK
    T = R_CHUNK
    idx = jnp.arange(T, dtype=F32)
    diff = idx[:, None] - idx[None, :]
    d_in = jnp.where(diff[None] >= 0, jnp.exp(jnp.maximum(diff, 0.0)[None] * log_g[:, None, None]), 0.0)
    d_q = jnp.exp((idx + 1.0)[None, :] * log_g[:, None])
    d_k = jnp.exp((T - 1.0 - idx)[None, :] * log_g[:, None])
    d_c = jnp.exp(T * log_g)

    def to_chunks(a):
        return a.astype(F32).reshape(Bn, n, T, H, -1).transpose(1, 0, 3, 2, 4)

    def step(S, inp):
        qi, ki, vi = inp
        att = jnp.einsum('bhtd,bhsd->bhts', qi, ki) * d_in
        o = (jnp.einsum('bhts,bhse->bhte', att, vi)
             + jnp.einsum('bhtd,bhde->bhte', qi, S) * d_q[None, :, :, None])
        S = S * d_c[None, :, None, None] + jnp.einsum('bhsd,bhse->bhde', ki * d_k[None, :, :, None], vi)
        return S, o

    S, o = lax.scan(step, s0, (to_chunks(q), to_chunks(k), to_chunks(v)))
    return o.transpose(1, 0, 3, 2, 4).reshape(Bn, L, H, dv), S


def retention_final_state(k, v, log_g):
    L = k.shape[1]
    w = jnp.exp((L - 1.0 - jnp.arange(L, dtype=F32))[:, None] * log_g[None, :])
    return jnp.einsum('bthd,bthe,th->bhde', k.astype(F32), v.astype(F32), w)


def retention_out(o, g):
    o = o * lax.rsqrt(jnp.mean(o * o, -1, keepdims=True) + EPS)
    return o.reshape(o.shape[0], o.shape[1], -1).astype(g.dtype) * jax.nn.silu(g)


def even_mixer(h, hc, w_in, sink, decay_logit, w_out, rope_a, rope_r, ctx_full):
    lg_f = jax.nn.log_sigmoid(decay_logit[0].astype(F32))
    lg_b = jax.nn.log_sigmoid(decay_logit[1].astype(F32))
    z = h @ w_in
    aq, rq, rg = split_cols(z[..., :Q_SIDE], Q_WIDTHS)
    ak, av, rk, rv = split_cols(z[..., Q_SIDE:], KV_WIDTHS)
    aq = apply_rope(heads(aq, HEAD_DIM), *rope_a)
    ak = apply_rope(heads(ak, HEAD_DIM), *rope_a)
    av = heads(av, HEAD_DIM)
    rq = apply_rope(heads(rq, R_DIM), *rope_r)
    rk = apply_rope(heads(rk, R_DIM), *rope_r) * R_DIM ** -0.5
    rv = heads(rv, R_DIM)
    if ctx_full:
        zc = hc @ w_in
        aqc, rqc, rgc = split_cols(zc[..., :Q_SIDE], Q_WIDTHS)
        akc, avc, rkc, rvc = split_cols(zc[..., Q_SIDE:], KV_WIDTHS)
    else:
        akc, avc, rkc, rvc = split_cols(hc @ w_in[:, Q_SIDE:], KV_WIDTHS)
    akc, avc = heads(akc, HEAD_DIM), heads(avc, HEAD_DIM)
    rkc, rvc = heads(rkc, R_DIM) * R_DIM ** -0.5, heads(rvc, R_DIM)
    if ctx_full:
        aqc, rqc = heads(aqc, HEAD_DIM), heads(rqc, R_DIM)
        zero = jnp.zeros((hc.shape[0], R_HEADS, R_DIM, R_DIM), F32)
        oc_f, s_f = retention_chunks(rqc, rkc, rvc, lg_f, zero)
        oc_b, s_b = retention_chunks(rqc[:, ::-1], rkc[:, ::-1], rvc[:, ::-1], lg_b, zero)
        yc = jnp.concatenate([context_attention(aqc, akc, avc, sink),
                              retention_out(oc_f + oc_b[:, ::-1], rgc)], -1) @ w_out
    else:
        s_f = retention_final_state(rkc, rvc, lg_f)
        s_b = retention_final_state(rkc[:, ::-1], rvc[:, ::-1], lg_b)
        yc = None
    o_f, _ = retention_chunks(rq, rk, rv, lg_f, s_f)
    o_b, _ = retention_chunks(rq[:, ::-1], rk[:, ::-1], rv[:, ::-1], lg_b, s_b)
    a = window_attention(aq, ak, av, akc, avc, sink)
    y = jnp.concatenate([a, retention_out(o_f + o_b[:, ::-1], rg)], -1) @ w_out
    return y, yc


def hyena_filter(L, f0, fb0, f1, fb1, f2, fb2, f3, freq):
    t = jnp.linspace(0.0, 1.0, L, dtype=F32)[:, None]
    bands = (HY_EMB - 1) // 2
    w = 2.0 * math.pi * jnp.arange(L, dtype=F32)[:, None] / L
    f = jnp.linspace(1e-4, bands - 1, bands, dtype=F32)[None]
    z = jnp.concatenate([t, jnp.cos(f * w), -jnp.sin(f * w)], -1)
    fr = freq.astype(F32)
    a = jnp.sin(fr * (z @ f0.astype(F32) + fb0.astype(F32)))
    a = jnp.sin(fr * (a @ f1.astype(F32) + fb1.astype(F32)))
    a = jnp.sin(fr * (a @ f2.astype(F32) + fb2.astype(F32)))
    k = (a @ f3.astype(F32)).reshape(L, 2, D_MODEL)
    deltas = jnp.abs(jnp.linspace(HY_MIN_DECAY, HY_MAX_DECAY, D_MODEL, dtype=F32))
    k = k * jnp.exp(-t * deltas)[:, None, :]
    return k[:, 0], k[:, 1]


def bidir_fftconv(u, k_f, k_b, bias):
    L = u.shape[1]
    k = jnp.concatenate([k_f, jnp.zeros_like(k_f[:1]), k_b[:0:-1]], 0)
    uf = jnp.fft.rfft(u.astype(F32), n=2 * L, axis=1)
    kf = jnp.fft.rfft(k, n=2 * L, axis=0)
    y = jnp.fft.irfft(uf * kf[None], n=2 * L, axis=1)[:, :L]
    return (y + u.astype(F32) * bias.astype(F32)).astype(u.dtype)


def short_conv(z, w, b):
    L = z.shape[1]
    half = HY_SHORT // 2
    zp = jnp.pad(z, ((0, 0), (half, half), (0, 0)))
    return sum(zp[:, i:i + L] * w[i] for i in range(HY_SHORT)) + b


def hyena_mixer(h, w_in, b_in, w_sh, b_sh, f0, fb0, f1, fb1, f2, fb2, f3, freq, bias, w_out):
    L = h.shape[1]
    z = short_conv(h @ w_in + b_in, w_sh, b_sh)
    x0, x1, v = jnp.split(z, 3, axis=-1)
    k_f, k_b = hyena_filter(L, f0, fb0, f1, fb1, f2, fb2, f3, freq)
    y = x0 * bidir_fftconv(v * x1, k_f, k_b, bias)
    return y @ w_out


def setup_inputs(seed: int = 0) -> dict:
    key = jax.random.key(seed)
    ks = iter(jax.random.split(key, 32))
    D = D_MODEL

    def nrm(shape, s):
        return jax.random.normal(next(ks), shape, F32) * s

    expo = jnp.arange(R_HEADS, dtype=F32) + R_MIN_EXP
    decay0 = jnp.log(2.0 ** expo - 1.0)
    return {
        'x': nrm((BATCH, SEQ, D), 1.0),
        'c': nrm((BATCH, D), 1.0),
        'ctx': nrm((BATCH, CTX_LEN, D), 1.0),
        'c_ctx': nrm((D,), 1.0),
        'w_mod': nrm((DEPTH, D, N_MOD * D), 0.5 * D ** -0.5),
        'b_mod': nrm((DEPTH, N_MOD * D), 0.02),
        'norm_pre': 1.0 + nrm((DEPTH, 3, D), 0.02),
        'norm_post': 1.0 + nrm((DEPTH, 3, D), 0.02),
        'ffn_gate': nrm((DEPTH, 2, D, D_FF), D ** -0.5),
        'ffn_up': nrm((DEPTH, 2, D, D_FF), D ** -0.5),
        'ffn_down': nrm((DEPTH, 2, D_FF, D), D_FF ** -0.5),
        'mix_w_in': nrm((N_EVEN, D, IN_W), D ** -0.5),
        'attn_sink': nrm((N_EVEN, A_Q_HEADS), 0.5),
        'ret_decay': decay0 + nrm((N_EVEN, 2, R_HEADS), 0.1),
        'mix_w_out': nrm((N_EVEN, MIX_W, D), MIX_W ** -0.5),
        'hy_w_in': nrm((N_ODD, D, 3 * D), D ** -0.5),
        'hy_b_in': nrm((N_ODD, 3 * D), 0.02),
        'hy_short_w': nrm((N_ODD, HY_SHORT, 3 * D), HY_SHORT ** -0.5),
        'hy_short_b': nrm((N_ODD, 3 * D), 0.02),
        'hy_f0': nrm((N_ODD, HY_EMB, HY_ORDER), HY_EMB ** -0.5),
        'hy_fb0': nrm((N_ODD, HY_ORDER), 0.1),
        'hy_f1': nrm((N_ODD, HY_ORDER, HY_ORDER), HY_ORDER ** -0.5),
        'hy_fb1': nrm((N_ODD, HY_ORDER), 0.1),
        'hy_f2': nrm((N_ODD, HY_ORDER, HY_ORDER), HY_ORDER ** -0.5),
        'hy_fb2': nrm((N_ODD, HY_ORDER), 0.1),
        'hy_f3': nrm((N_ODD, HY_ORDER, 2 * D), 0.05 * HY_ORDER ** -0.5),
        'hy_freq': 1.0 + nrm((N_ODD, HY_ORDER), 0.02),
        'hy_bias': nrm((N_ODD, D), 1.0),
        'hy_w_out': nrm((N_ODD, D, D), D ** -0.5),
    }


def reference(x, c, ctx, c_ctx, w_mod, b_mod, norm_pre, norm_post, ffn_gate, ffn_up, ffn_down,
              mix_w_in, attn_sink, ret_decay, mix_w_out, hy_w_in, hy_b_in, hy_short_w, hy_short_b,
              hy_f0, hy_fb0, hy_f1, hy_fb1, hy_f2, hy_fb2, hy_f3, hy_freq, hy_bias, hy_w_out):
    Bn, L, D = x.shape
    rope_a = axial_rope(L)
    rope_r = line_rope(L, R_DIM)
    sc = jax.nn.silu(c)
    scc = jax.nn.silu(c_ctx)[None]
    last_reader = DEPTH - 1 if (DEPTH - 1) % 2 == 0 else DEPTH - 2
    for l in range(DEPTH):
        ctx_live = l <= last_reader
        ctx_full = l < last_reader
        m = (sc @ w_mod[l] + b_mod[l]).reshape(Bn, 1, N_MOD, D)
        mc = (scc @ w_mod[l] + b_mod[l]).reshape(1, 1, N_MOD, D)
        x = macaron_half(x, m, 0, norm_pre[l, 0], norm_post[l, 0], ffn_gate[l, 0], ffn_up[l, 0], ffn_down[l, 0])
        if ctx_live:
            ctx = macaron_half(ctx, mc, 0, norm_pre[l, 0], norm_post[l, 0],
                               ffn_gate[l, 0], ffn_up[l, 0], ffn_down[l, 0])
        h = adaln_in(x, norm_pre[l, 1], m, 1)
        hc = adaln_in(ctx, norm_pre[l, 1], mc, 1) if ctx_live else None
        if l % 2 == 0:
            e = l // 2
            y, yc = even_mixer(h, hc, mix_w_in[e], attn_sink[e], ret_decay[e], mix_w_out[e],
                               rope_a, rope_r, ctx_full)
        else:
            o = l // 2
            hp = (hy_w_in[o], hy_b_in[o], hy_short_w[o], hy_short_b[o], hy_f0[o], hy_fb0[o], hy_f1[o],
                  hy_fb1[o], hy_f2[o], hy_fb2[o], hy_f3[o], hy_freq[o], hy_bias[o], hy_w_out[o])
            y = hyena_mixer(h, *hp)
            yc = hyena_mixer(hc, *hp) if ctx_full else None
        x = adaln_out(x, y, norm_post[l, 1], m, 1, 1.0)
        x = macaron_half(x, m, 2, norm_pre[l, 2], norm_post[l, 2], ffn_gate[l, 1], ffn_up[l, 1], ffn_down[l, 1])
        if ctx_full:
            ctx = adaln_out(ctx, yc, norm_post[l, 1], mc, 1, 1.0)
            ctx = macaron_half(ctx, mc, 2, norm_pre[l, 2], norm_post[l, 2],
                               ffn_gate[l, 1], ffn_up[l, 1], ffn_down[l, 1])
    return x
```

```cpp
#include <hip/hip_runtime.h>
#include <hip/hip_cooperative_groups.h>
#include <cstdio>
namespace cg = cooperative_groups;

#define LAS __attribute__((address_space(3)))
typedef unsigned short bf16_t;
typedef short bf16x8 __attribute__((ext_vector_type(8)));
typedef float f32x4 __attribute__((ext_vector_type(4)));
typedef unsigned u32x4 __attribute__((ext_vector_type(4)));

constexpr int D = 1024, NB = 4, SEQ = 4096, CL = 256, TL = NB * SEQ, TC = NB * CL, T = TL + TC, DFF = 2816, INW = 2816, HYW = 3072;
constexpr int NMOD = 9;
constexpr float EPS = 1e-6f;
constexpr int NCH = 34;
constexpr int LDS_BYTES = 144 * 1024;

constexpr size_t SZ_WGU = (size_t)2 * DFF * D * 2, SZ_WD = (size_t)D * DFF * 2, SZ_WIN = (size_t)INW * D * 2, SZ_WOUT = (size_t)D * D * 2, SZ_HWIN = (size_t)HYW * D * 2;
constexpr size_t WS_WGU = 0;
constexpr size_t WS_WD = WS_WGU + 8 * SZ_WGU;
constexpr size_t WS_WIN = WS_WD + 8 * SZ_WD;
constexpr size_t WS_WOUT = WS_WIN + 2 * SZ_WIN;
constexpr size_t WS_HWIN = WS_WOUT + 2 * SZ_WOUT;
constexpr size_t WS_HWOUT = WS_HWIN + 2 * SZ_HWIN;
constexpr size_t WS_MOD = WS_HWOUT + 2 * SZ_WOUT;
constexpr size_t WS_ROPE = WS_MOD + (size_t)4 * 5 * NMOD * D * 4;
constexpr size_t WS_XC = WS_ROPE + (size_t)4 * SEQ * 32 * 4;
constexpr size_t WS_H = WS_XC + (size_t)TC * D * 4;
constexpr size_t WS_BIG = WS_H + (size_t)T * D * 2;
constexpr size_t WS_Y = WS_BIG + (size_t)T * HYW * 2;
constexpr size_t WS_MIX = WS_Y + (size_t)T * D * 4;
constexpr size_t SZ_ST = (size_t)NB * NCH * 8 * 4096 * 4;
constexpr size_t WS_ST = WS_MIX + (size_t)T * D * 2;
constexpr size_t SZ_KF = (size_t)(SEQ + CL) * 2 * D * 4;
constexpr size_t WS_KF = WS_ST + 4 * SZ_ST;
constexpr size_t WS_END = WS_KF + 2 * SZ_KF;

struct KP { const float* in[29]; float* out; unsigned char* ws; };

__device__ __forceinline__ bf16_t f2bf(float f) { unsigned u = __float_as_uint(f); u += 0x7FFFu + ((u >> 16) & 1u); return (bf16_t)(u >> 16); }
__device__ __forceinline__ float bf2f(bf16_t b) { return __uint_as_float(((unsigned)b) << 16); }
__device__ __forceinline__ float silu_f(float x) { return x / (1.0f + __expf(-x)); }
__device__ __forceinline__ int ltid() { int t = threadIdx.x; asm volatile("" : "+v"(t)); return t; }
__device__ __forceinline__ float wave_sum(float v) {
#pragma unroll
    for (int o = 32; o > 0; o >>= 1) v += __shfl_xor(v, o, 64);
    return v;
}

namespace pg8 {
constexpr int BM = 256, BK = 64, HALF = 128, HTB = HALF * BK * 2, STAGE_BYTES = 8 * HTB, NXCD = 8, WGM = 8;
__host__ __device__ __forceinline__ int lds_byte(int r, int c) { const int st = (r >> 4) * 2 + (c >> 5), rr = r & 15, cc = c & 31, ob = rr * 64 + cc * 2; return st * 1024 + (ob ^ (((ob >> 9) & 1) << 5)); }
__host__ __device__ __forceinline__ void stage_rc(int b, int& R, int& C) { const int st = b / 1024, sb = b % 1024, swz = sb ^ (((sb >> 9) & 1) << 5); R = (st >> 1) * 16 + swz / 64; C = (st & 1) * 32 + (swz % 64) / 2; }
__host__ __device__ __forceinline__ int perm32(int rho) { const int n = rho >> 4, i = rho & 15; return 8 * (i >> 2) + 4 * n + (i & 3); }
struct Unit { int pm, pn; };
struct Gemm { const bf16_t* A; const bf16_t* Bt; int M, N, K; };
struct StaticOrder {
    int nM, nN, nwg, G, c;
    __device__ void init(int M, int N, int G_, int c_) { nM = M / BM; nN = N / BM; nwg = nM * nN; G = G_; c = c_; }
    __device__ bool next(int i, Unit& u) const {
        const long Lx = (long)i * G + c; if (Lx >= nwg) return false;
        int wgid = (int)Lx; { const int q = nwg / NXCD, r = nwg % NXCD, xcd = wgid % NXCD, off = wgid / NXCD; wgid = (xcd < r ? xcd * (q + 1) : r * (q + 1) + (xcd - r) * q) + off; }
        const int nig = WGM * nN, gid = wgid / nig, fm = gid * WGM, gsz = (nM - fm) < WGM ? (nM - fm) : WGM;
        u.pm = fm + ((wgid % nig) % gsz); u.pn = (wgid % nig) / gsz; return true;
    }
};
__device__ __forceinline__ unsigned cvt_pk_bf16(float lo, float hi) { unsigned r; asm volatile("v_cvt_pk_bf16_f32 %0, %1, %2" : "=v"(r) : "v"(lo), "v"(hi)); return r; }

struct EpiF32 {
    static constexpr bool PERM = false;
    float* C; int ldc;
    __device__ __forceinline__ void operator()(const f32x4 (&acc)[2][2][4][2], const Unit& u, int wr, int wc, int fr, int fq) const {
        const int row0 = u.pm * BM + wr * 64 + fr, col0 = u.pn * BM + wc * 32 + 4 * fq;
#pragma unroll
        for (int ai = 0; ai < 2; ++ai)
#pragma unroll
            for (int m = 0; m < 4; ++m) { float* rowp = C + (size_t)(row0 + ai * HALF + m * 16) * ldc + col0;
#pragma unroll
                for (int bj = 0; bj < 2; ++bj)
#pragma unroll
                    for (int n = 0; n < 2; ++n) *(f32x4*)(rowp + bj * HALF + n * 16) = acc[ai][bj][m][n]; }
    }
};
struct EpiBf16 {
    static constexpr bool PERM = true;
    bf16_t* O; int ldc; const float* bias;
    __device__ __forceinline__ void operator()(const f32x4 (&acc)[2][2][4][2], const Unit& u, int wr, int wc, int fr, int fq) const {
        const int row0 = u.pm * BM + wr * 64 + fr; const int col0 = u.pn * BM + wc * 32 + 8 * fq;
        f32x4 bv[2][2];
#pragma unroll
        for (int bj = 0; bj < 2; ++bj)
#pragma unroll
            for (int n = 0; n < 2; ++n) bv[bj][n] = bias ? *(const f32x4*)(bias + col0 + bj * HALF + 4 * n) : (f32x4){0.f, 0.f, 0.f, 0.f};
#pragma unroll
        for (int ai = 0; ai < 2; ++ai)
#pragma unroll
            for (int m = 0; m < 4; ++m) { bf16_t* rowp = O + (size_t)(row0 + ai * HALF + m * 16) * ldc + col0;
#pragma unroll
                for (int bj = 0; bj < 2; ++bj) { f32x4 v0 = acc[ai][bj][m][0] + bv[bj][0], v1 = acc[ai][bj][m][1] + bv[bj][1];
                    u32x4 w; w.x = cvt_pk_bf16(v0[0], v0[1]); w.y = cvt_pk_bf16(v0[2], v0[3]); w.z = cvt_pk_bf16(v1[0], v1[1]); w.w = cvt_pk_bf16(v1[2], v1[3]);
                    *(u32x4*)(rowp + bj * HALF) = w; } }
    }
};
struct EpiSwiGLU {
    static constexpr bool PERM = true;
    bf16_t* O; int ldc;
    __device__ __forceinline__ void operator()(const f32x4 (&acc)[2][2][4][2], const Unit& u, int wr, int wc, int fr, int fq) const {
        const int row0 = u.pm * BM + wr * 64 + fr; const int col0 = u.pn * HALF + wc * 32 + 8 * fq;
#pragma unroll
        for (int ai = 0; ai < 2; ++ai)
#pragma unroll
            for (int m = 0; m < 4; ++m) { bf16_t* rowp = O + (size_t)(row0 + ai * HALF + m * 16) * ldc + col0;
                float v[8];
#pragma unroll
                for (int n = 0; n < 2; ++n)
#pragma unroll
                    for (int j = 0; j < 4; ++j) { const float g = acc[ai][0][m][n][j], up = acc[ai][1][m][n][j]; v[n * 4 + j] = silu_f(g) * up; }
                u32x4 w; w.x = cvt_pk_bf16(v[0], v[1]); w.y = cvt_pk_bf16(v[2], v[3]); w.z = cvt_pk_bf16(v[4], v[5]); w.w = cvt_pk_bf16(v[6], v[7]);
                *(u32x4*)rowp = w; }
    }
};

template <class Epi, class Sched>
__device__ __forceinline__ void gemm_phase(LAS unsigned char* lds, const Gemm g, const Sched& S, const Epi& E) {
    const int tid = ltid(), wid = __builtin_amdgcn_readfirstlane(tid >> 6), lane = tid & 63, wr = wid >> 2, wc = wid & 3, fr = lane & 15, fq = lane >> 4;
    const int K = g.K, nt = K / BK;
    unsigned voffA[2], voffB[2];
#pragma unroll
    for (int i = 0; i < 2; ++i) { int R, C; stage_rc(tid * 16 + i * 8192, R, C); const int Rb = Epi::PERM ? ((R & ~31) + perm32(R & 31)) : R;
        voffA[i] = (unsigned)(R * K + C) * 2u; voffB[i] = (unsigned)(Rb * K + C) * 2u; }
    const size_t kstep = (size_t)(BK * 2);
    const size_t hstep = (size_t)HALF * K * 2;
    const size_t tstep = 2 * hstep;
    const unsigned ldsw = (unsigned)wid * 1024u;
    const int aoff = lds_byte(wr * 64 + fr, fq * 8), boff = lds_byte(wc * 32 + fr, fq * 8);
#define PG8_SA(b, h) (((b) * 2 + (h)) * HTB)
#define PG8_SB(b, h) ((4 + (b) * 2 + (h)) * HTB)
#define PG8_STAGE(bufoff, gbase, voff) do { _Pragma("unroll") for (int _i = 0; _i < 2; ++_i) \
        __builtin_amdgcn_global_load_lds((const unsigned*)((const char*)(gbase) + (voff)[_i]), (LAS unsigned*)(lds + (bufoff) + ldsw + _i * 8192), 16, 0, 0); } while (0)
#define PG8_LDA(dst, b, h) do { _Pragma("unroll") for (int m = 0; m < 4; ++m) _Pragma("unroll") for (int k = 0; k < 2; ++k) dst[m][k] = *(const LAS bf16x8*)(lds + PG8_SA(b, h) + aoff + m * 2048 + k * 1024); } while (0)
#define PG8_LDB(dst, b, h) do { _Pragma("unroll") for (int n = 0; n < 2; ++n) _Pragma("unroll") for (int k = 0; k < 2; ++k) dst[n][k] = *(const LAS bf16x8*)(lds + PG8_SB(b, h) + boff + n * 2048 + k * 1024); } while (0)
#define PG8_MMA(ai, bj, At, Bt) do { __builtin_amdgcn_s_setprio(1); _Pragma("unroll") for (int m = 0; m < 4; ++m) _Pragma("unroll") for (int n = 0; n < 2; ++n) _Pragma("unroll") for (int k = 0; k < 2; ++k) \
        acc[ai][bj][m][n] = __builtin_amdgcn_mfma_f32_16x16x32_bf16(Bt[n][k], At[m][k], acc[ai][bj][m][n], 0, 0, 0); __builtin_amdgcn_s_setprio(0); } while (0)
#define PG8_WAIT_V(n) asm volatile("s_waitcnt vmcnt(" #n ")" ::: "memory")
#define PG8_WAIT_L(n) asm volatile("s_waitcnt lgkmcnt(" #n ")" ::: "memory")
#define PG8_BAR __builtin_amdgcn_s_barrier()
#define PG8_SCHED __builtin_amdgcn_sched_barrier(0)
    Unit cur, nxt; int ui = 0;
    if (!S.next(0, cur)) return;
    f32x4 acc[2][2][4][2];
#pragma unroll
    for (int a = 0; a < 2; ++a)
#pragma unroll
        for (int b = 0; b < 2; ++b)
#pragma unroll
            for (int m = 0; m < 4; ++m)
#pragma unroll
                for (int n = 0; n < 2; ++n) acc[a][b][m][n] = (f32x4){0.f, 0.f, 0.f, 0.f};
    bf16x8 At[4][2], B0[2][2], B1[2][2];
    const char* cA = (const char*)g.A + (size_t)cur.pm * tstep; const char* cB = (const char*)g.Bt + (size_t)cur.pn * tstep;
    PG8_STAGE(PG8_SB(0, 0), cB, voffB); PG8_STAGE(PG8_SA(0, 0), cA, voffA); PG8_STAGE(PG8_SB(0, 1), cB + hstep, voffB); PG8_STAGE(PG8_SA(0, 1), cA + hstep, voffA);
    if (wr == 1) PG8_BAR;
    PG8_WAIT_V(4); PG8_BAR;
    PG8_STAGE(PG8_SB(1, 0), cB + kstep, voffB); PG8_STAGE(PG8_SA(1, 0), cA + kstep, voffA); PG8_STAGE(PG8_SB(1, 1), cB + hstep + kstep, voffB);
    PG8_WAIT_V(6); PG8_BAR;
    for (;;) {
        const bool has_next = S.next(ui + 1, nxt);
        const char* nA = has_next ? (const char*)g.A + (size_t)nxt.pm * tstep : cA; const char* nB = has_next ? (const char*)g.Bt + (size_t)nxt.pn * tstep : cB;
        for (int t = 0; t < nt; t += 2) {
            const bool last = (t == nt - 2);
            const char* a1 = cA + (size_t)(t + 1) * kstep;
            const char* a2 = last ? nA : cA + (size_t)(t + 2) * kstep; const char* b2 = last ? nB : cB + (size_t)(t + 2) * kstep;
            const char* a3 = a2 + kstep; const char* b3 = b2 + kstep;
            PG8_LDB(B0, 0, 0); PG8_SCHED; PG8_LDA(At, 0, 0); PG8_STAGE(PG8_SA(1, 1), a1 + hstep, voffA);
            PG8_WAIT_L(8); PG8_BAR; PG8_WAIT_L(0); PG8_MMA(0, 0, At, B0); PG8_BAR; PG8_SCHED;
            PG8_LDB(B1, 0, 1); PG8_STAGE(PG8_SB(0, 0), b2, voffB);
            PG8_BAR; PG8_WAIT_L(0); PG8_MMA(0, 1, At, B1); PG8_BAR;
            PG8_LDA(At, 0, 1); PG8_STAGE(PG8_SA(0, 0), a2, voffA);
            PG8_BAR; PG8_WAIT_L(0); PG8_MMA(1, 0, At, B0); PG8_BAR; PG8_SCHED;
            PG8_STAGE(PG8_SB(0, 1), b2 + hstep, voffB);
            PG8_WAIT_V(6); PG8_BAR; PG8_MMA(1, 1, At, B1); PG8_BAR;
            PG8_LDB(B0, 1, 0); PG8_SCHED; PG8_LDA(At, 1, 0); PG8_STAGE(PG8_SA(0, 1), a2 + hstep, voffA);
            PG8_WAIT_L(8); PG8_BAR; PG8_WAIT_L(0); PG8_MMA(0, 0, At, B0); PG8_BAR; PG8_SCHED;
            PG8_LDB(B1, 1, 1); PG8_STAGE(PG8_SB(1, 0), b3, voffB);
            PG8_BAR; PG8_WAIT_L(0); PG8_MMA(0, 1, At, B1); PG8_BAR;
            PG8_LDA(At, 1, 1); PG8_STAGE(PG8_SA(1, 0), a3, voffA);
            PG8_BAR; PG8_WAIT_L(0); PG8_MMA(1, 0, At, B0); PG8_BAR; PG8_SCHED;
            PG8_STAGE(PG8_SB(1, 1), b3 + hstep, voffB);
            PG8_WAIT_V(6); PG8_BAR; PG8_MMA(1, 1, At, B1); PG8_BAR;
        }
        E(acc, cur, wr, wc, fr, fq);
        if (!has_next) break;
#pragma unroll
        for (int a = 0; a < 2; ++a)
#pragma unroll
            for (int b = 0; b < 2; ++b)
#pragma unroll
                for (int m = 0; m < 4; ++m)
#pragma unroll
                    for (int n = 0; n < 2; ++n) acc[a][b][m][n] = (f32x4){0.f, 0.f, 0.f, 0.f};
        cur = nxt; cA = nA; cB = nB; ++ui;
    }
    PG8_WAIT_V(0);
    if (wr == 0) PG8_BAR;
    PG8_BAR;
#undef PG8_SA
#undef PG8_SB
#undef PG8_STAGE
#undef PG8_LDA
#undef PG8_LDB
#undef PG8_MMA
#undef PG8_WAIT_V
#undef PG8_WAIT_L
#undef PG8_BAR
#undef PG8_SCHED
}
}

template <class Epi>
__device__ __forceinline__ void run_gemm(unsigned char* smem, const bf16_t* A, const bf16_t* Bt, int M, int N, int K, const Epi& E) {
    pg8::Gemm g{A, Bt, M, N, K}; pg8::StaticOrder S; S.init(M, N, (int)gridDim.x, (int)blockIdx.x);
    pg8::gemm_phase<Epi, pg8::StaticOrder>((LAS unsigned char*)smem, g, S, E);
}

__device__ __forceinline__ float* xrow(const KP& p, int t) { return t < TL ? p.out + (size_t)t * D : (float*)(p.ws + WS_XC) + (size_t)(t - TL) * D; }
__device__ __forceinline__ int modrow(int t) { return t < TL ? (t >> 12) : 4; }
__device__ __forceinline__ const float* modp(const KP& p, int l, int mr, int idx) { return (const float*)(p.ws + WS_MOD) + ((size_t)(l * 5 + mr) * NMOD + idx) * D; }

__device__ void p0_setup(const KP& p, float* sm) {
    const int tid = ltid(), bid = blockIdx.x, nb = gridDim.x;
    const int gtid = bid * 512 + tid, gthreads = nb * 512;
    {
        const float4* xs = (const float4*)p.in[0]; float4* xd = (float4*)p.out;
        for (int i = gtid; i < TL * D / 4; i += gthreads) xd[i] = xs[i];
        const float4* cs = (const float4*)p.in[2]; float4* cd = (float4*)(p.ws + WS_XC);
        for (int i = gtid; i < TC * D / 4; i += gthreads) cd[i] = cs[i];
    }
    {
        float* rope = (float*)(p.ws + WS_ROPE);
        for (int idx = gtid; idx < SEQ * 32; idx += gthreads) {
            const int t = idx >> 5, i = idx & 31;
            const int ii = i & 15; const float pos = (i < 16) ? (float)(t >> 6) : (float)(t & 63);
            const float invA = powf(10000.0f, -(float)ii / 16.0f);
            const float angA = pos * invA;
            rope[idx] = cosf(angA); rope[SEQ * 32 + idx] = sinf(angA);
            const float ex = (float)i * (1.0f / 31.0f);
            const float invR = powf(10000.0f, -ex);
            const float angR = (float)t * invR;
            rope[2 * SEQ * 32 + idx] = cosf(angR); rope[3 * SEQ * 32 + idx] = sinf(angR);
        }
    }
    {
        float* tile = sm;
        for (int g = bid; g < 20864; g += nb) {
            int j, tl;
            if (g < 16896) { j = g / 704; tl = g % 704; }
            else if (g < 18304) { j = 24 + (g - 16896) / 704; tl = (g - 16896) % 704; }
            else if (g < 18816) { j = 26 + (g - 18304) / 256; tl = (g - 18304) % 256; }
            else if (g < 20352) { j = 28 + (g - 18816) / 768; tl = (g - 18816) % 768; }
            else { j = 30 + (g - 20352) / 256; tl = (g - 20352) % 256; }
            const float* src; bf16_t* dst; int K, N, mode = 0;
            if (j < 8) { src = p.in[8] + (size_t)j * D * DFF; dst = (bf16_t*)(p.ws + WS_WGU + (size_t)j * SZ_WGU); K = D; N = DFF; mode = 1; }
            else if (j < 16) { src = p.in[9] + (size_t)(j - 8) * D * DFF; dst = (bf16_t*)(p.ws + WS_WGU + (size_t)(j - 8) * SZ_WGU); K = D; N = DFF; mode = 2; }
            else if (j < 24) { src = p.in[10] + (size_t)(j - 16) * DFF * D; dst = (bf16_t*)(p.ws + WS_WD + (size_t)(j - 16) * SZ_WD); K = DFF; N = D; }
            else if (j < 26) { src = p.in[11] + (size_t)(j - 24) * D * INW; dst = (bf16_t*)(p.ws + WS_WIN + (size_t)(j - 24) * SZ_WIN); K = D; N = INW; mode = 3; }
            else if (j < 28) { src = p.in[14] + (size_t)(j - 26) * D * D; dst = (bf16_t*)(p.ws + WS_WOUT + (size_t)(j - 26) * SZ_WOUT); K = D; N = D; }
            else if (j < 30) { src = p.in[15] + (size_t)(j - 28) * D * HYW; dst = (bf16_t*)(p.ws + WS_HWIN + (size_t)(j - 28) * SZ_HWIN); K = D; N = HYW; }
            else { src = p.in[28] + (size_t)(j - 30) * D * D; dst = (bf16_t*)(p.ws + WS_HWOUT + (size_t)(j - 30) * SZ_WOUT); K = D; N = D; }
            const int ntn = N / 64; const int k0 = (tl / ntn) * 64, n0 = (tl % ntn) * 64;
            __syncthreads();
#pragma unroll
            for (int i = 0; i < 8; ++i) { const int k = i * 8 + (tid >> 6), n = tid & 63; tile[k * 65 + n] = src[(size_t)(k0 + k) * N + n0 + n]; }
            __syncthreads();
#pragma unroll
            for (int i = 0; i < 8; ++i) {
                const int n = i * 8 + (tid >> 6), k = tid & 63; const int gn = n0 + n;
                float v = tile[k * 65 + n];
                int row = gn;
                if (mode == 1) row = 256 * (gn >> 7) + (gn & 127);
                else if (mode == 2) row = 256 * (gn >> 7) + 128 + (gn & 127);
                else if (mode == 3) { if (gn < 512 || (gn >= 1792 && gn < 2304)) v *= 0.125f; }
                dst[(size_t)row * K + k0 + k] = f2bf(v);
            }
        }
        __syncthreads();
    }
    {
        float* sc = sm;
        float* red = sm + 5 * 1024;
        for (int i = tid; i < 5 * 1024; i += 512) { const int r = i >> 10, k = i & 1023; const float v = (r < 4) ? p.in[1][r * D + k] : p.in[3][k]; sc[i] = silu_f(v); }
        __syncthreads();
        const int w = tid >> 6, lane = tid & 63;
        for (int it = bid; it < 288; it += nb) {
            const int l = it / 72, c0 = (it % 72) * 128;
            const float* wm = p.in[4] + (size_t)l * D * (NMOD * D) + c0 + 2 * lane;
            float a[5][2];
#pragma unroll
            for (int r = 0; r < 5; ++r) { a[r][0] = 0.f; a[r][1] = 0.f; }
            for (int k = w * 128; k < w * 128 + 128; ++k) {
                const float2 wv = *(const float2*)(wm + (size_t)k * (NMOD * D));
#pragma unroll
                for (int r = 0; r < 5; ++r) { const float s = sc[r * 1024 + k]; a[r][0] += s * wv.x; a[r][1] += s * wv.y; }
            }
#pragma unroll
            for (int r = 0; r < 5; ++r) { red[(w * 5 + r) * 128 + 2 * lane] = a[r][0]; red[(w * 5 + r) * 128 + 2 * lane + 1] = a[r][1]; }
            __syncthreads();
            for (int i = tid; i < 5 * 128; i += 512) {
                const int r = i >> 7, c = i & 127; float s = 0.f;
#pragma unroll
                for (int ww = 0; ww < 8; ++ww) s += red[(ww * 5 + r) * 128 + c];
                s += p.in[5][(size_t)l * (NMOD * D) + c0 + c];
                ((float*)(p.ws + WS_MOD))[(size_t)(l * 5 + r) * (NMOD * D) + c0 + c] = s;
            }
            __syncthreads();
        }
    }
    {
        float* z = sm;
        float* a1 = sm + 16 * 36;
        float* a2 = a1 + 16 * 64;
        float* a3 = a2 + 16 * 64;
        float* tl = a3 + 16 * 64;
        const float HMAX = -4.605170185988091f / 0.3f, HMIN = -4.605170185988091f / 1.5f;
        for (int it = bid; it < 544; it += nb) {
            const int o = it / 272, r = it % 272;
            const int Lf = (r < 256) ? SEQ : CL; const int p0 = (r < 256) ? r * 16 : (r - 256) * 16;
            float* kf = (float*)(p.ws + WS_KF + (size_t)o * SZ_KF) + ((r < 256) ? (size_t)0 : (size_t)2 * SEQ * D);
            const float* f0 = p.in[19] + (size_t)o * 33 * 64; const float* fb0 = p.in[20] + o * 64;
            const float* f1 = p.in[21] + (size_t)o * 64 * 64; const float* fb1 = p.in[22] + o * 64;
            const float* f2 = p.in[23] + (size_t)o * 64 * 64; const float* fb2 = p.in[24] + o * 64;
            const float* f3 = p.in[25] + (size_t)o * 64 * 2048; const float* fq = p.in[26] + o * 64;
            __syncthreads();
            for (int idx = tid; idx < 16 * 33; idx += 512) {
                const int ps = idx / 33, f = idx % 33; const int i = p0 + ps;
                const float tlin = (float)i * (1.0f / (float)(Lf - 1));
                const float w = (6.283185307179586f * (float)i) / (float)Lf;
                float v;
                if (f == 0) { v = tlin; tl[ps] = tlin; }
                else { const int jj = (f - 1) & 15; const float fj = 1e-4f + (float)jj * ((15.0f - 1e-4f) / 15.0f); v = (f <= 16) ? cosf(fj * w) : -sinf(fj * w); }
                z[ps * 36 + f] = v;
            }
            __syncthreads();
            for (int idx = tid; idx < 16 * 64; idx += 512) { const int ps = idx >> 6, oc = idx & 63; float s = fb0[oc];
                for (int f = 0; f < 33; ++f) s += z[ps * 36 + f] * f0[f * 64 + oc];
                a1[idx] = sinf(fq[oc] * s); }
            __syncthreads();
            for (int idx = tid; idx < 16 * 64; idx += 512) { const int ps = idx >> 6, oc = idx & 63; float s = fb1[oc];
                for (int f = 0; f < 64; ++f) s += a1[ps * 64 + f] * f1[f * 64 + oc];
                a2[idx] = sinf(fq[oc] * s); }
            __syncthreads();
            for (int idx = tid; idx < 16 * 64; idx += 512) { const int ps = idx >> 6, oc = idx & 63; float s = fb2[oc];
                for (int f = 0; f < 64; ++f) s += a2[ps * 64 + f] * f2[f * 64 + oc];
                a3[idx] = sinf(fq[oc] * s); }
            __syncthreads();
            for (int q = 0; q < 4; ++q) {
                const int c = tid + 512 * q; const int dir = c >> 10, d = c & 1023;
                float acc[16];
#pragma unroll
                for (int ps = 0; ps < 16; ++ps) acc[ps] = 0.f;
                for (int f = 0; f < 64; ++f) { const float wv = f3[f * 2048 + c];
#pragma unroll
                    for (int ps = 0; ps < 16; ++ps) acc[ps] += a3[ps * 64 + f] * wv; }
                const float delta = fabsf(HMIN + (float)d * ((HMAX - HMIN) / 1023.0f));
#pragma unroll
                for (int ps = 0; ps < 16; ++ps) kf[((size_t)dir * Lf + p0 + ps) * D + d] = acc[ps] * expf(-tl[ps] * delta);
            }
        }
        __syncthreads();
    }
}

__device__ void rowphase(const KP& p, int Mupd, const float* Y, int lu, int gidx, float wgt, const float* gpost,
                         int Mnext, int ln, const float* gpre, int shidx, int scidx, bf16_t* Hout) {
    const int tid = ltid(), w = tid >> 6, lane = tid & 63;
    const int Mmax = Mupd > Mnext ? Mupd : Mnext;
    for (int t = blockIdx.x * 8 + w; t < Mmax; t += gridDim.x * 8) {
        float* xr = xrow(p, t); const int mr = modrow(t);
        float4 xv[4];
#pragma unroll
        for (int q = 0; q < 4; ++q) xv[q] = *(const float4*)(xr + q * 256 + lane * 4);
        if (Y != nullptr && t < Mupd) {
            float4 yv[4]; float ss = 0.f;
#pragma unroll
            for (int q = 0; q < 4; ++q) { yv[q] = *(const float4*)(Y + (size_t)t * D + q * 256 + lane * 4); ss += yv[q].x * yv[q].x + yv[q].y * yv[q].y + yv[q].z * yv[q].z + yv[q].w * yv[q].w; }
            ss = wave_sum(ss);
            const float r = rsqrtf(ss * (1.0f / D) + EPS) * wgt;
            const float* gm = modp(p, lu, mr, gidx);
#pragma unroll
            for (int q = 0; q < 4; ++q) {
                const float4 g4 = *(const float4*)(gm + q * 256 + lane * 4); const float4 p4 = *(const float4*)(gpost + q * 256 + lane * 4);
                xv[q].x += r * g4.x * yv[q].x * p4.x; xv[q].y += r * g4.y * yv[q].y * p4.y; xv[q].z += r * g4.z * yv[q].z * p4.z; xv[q].w += r * g4.w * yv[q].w * p4.w;
                *(float4*)(xr + q * 256 + lane * 4) = xv[q];
            }
        }
        if (Hout != nullptr && t < Mnext) {
            float ss = 0.f;
#pragma unroll
            for (int q = 0; q < 4; ++q) ss += xv[q].x * xv[q].x + xv[q].y * xv[q].y + xv[q].z * xv[q].z + xv[q].w * xv[q].w;
            ss = wave_sum(ss);
            const float r = rsqrtf(ss * (1.0f / D) + EPS);
            const float* sh = modp(p, ln, mr, shidx); const float* sc = modp(p, ln, mr, scidx);
#pragma unroll
            for (int q = 0; q < 4; ++q) {
                const float4 g4 = *(const float4*)(gpre + q * 256 + lane * 4); const float4 s4 = *(const float4*)(sc + q * 256 + lane * 4); const float4 h4 = *(const float4*)(sh + q * 256 + lane * 4);
                const float h0 = xv[q].x * r * g4.x * (1.0f + s4.x) + h4.x, h1 = xv[q].y * r * g4.y * (1.0f + s4.y) + h4.y;
                const float h2 = xv[q].z * r * g4.z * (1.0f + s4.z) + h4.z, h3 = xv[q].w * r * g4.w * (1.0f + s4.w) + h4.w;
                uint2 pk; pk.x = (unsigned)f2bf(h0) | ((unsigned)f2bf(h1) << 16); pk.y = (unsigned)f2bf(h2) | ((unsigned)f2bf(h3) << 16);
                *(uint2*)(Hout + (size_t)t * D + q * 256 + lane * 4) = pk;
            }
        }
    }
}

__device__ __forceinline__ float log_sigmoid(float x) { return -log1pf(expf(-x)); }
__device__ __forceinline__ int chunk_t0(int b, int cidx) { return cidx < 32 ? b * SEQ + cidx * 128 : TL + b * CL + (cidx - 32) * 128; }

__device__ void m1_rope_states(const KP& p, int e, float* sm) {
    const int tid = ltid(), bid = blockIdx.x, nb = gridDim.x;
    bf16_t* Z = (bf16_t*)(p.ws + WS_BIG);
    const float* rope = (const float*)(p.ws + WS_ROPE);
    for (int idx = bid * 512 + tid; idx < TL * 576; idx += nb * 512) {
        const int t = idx / 576, r = idx % 576; const int hd = r >> 5, i = r & 31;
        const int cb = hd < 16 ? hd * 64 : 1536 + (hd - 16) * 64;
        const int tb = (hd >= 8 && hd < 16) ? 2 : 0; const int pos = t & (SEQ - 1);
        const float c = rope[(size_t)tb * SEQ * 32 + pos * 32 + i], s = rope[(size_t)(tb + 1) * SEQ * 32 + pos * 32 + i];
        bf16_t* zp = Z + (size_t)t * INW + cb + i;
        const float x1 = bf2f(zp[0]), x2 = bf2f(zp[32]);
        zp[0] = f2bf(x1 * c - x2 * s); zp[32] = f2bf(x1 * s + x2 * c);
    }
    float* Ks = sm;
    float* Vs = sm + 128 * 64;
    float* wf = Vs + 128 * 64;
    float* wb = wf + 128;
    float* AF = (float*)(p.ws + WS_ST); float* AB = AF + SZ_ST / 4;
    const float* dec = p.in[13] + e * 16;
    for (int it = bid; it < NB * NCH * 8; it += nb) {
        const int h = it & 7, cidx = (it >> 3) % NCH, b = it / (8 * NCH);
        const int t0 = chunk_t0(b, cidx); const bool lat = cidx < 32;
        const float lgf = log_sigmoid(dec[h]), lgb = log_sigmoid(dec[8 + h]);
        __syncthreads();
        if (tid < 128) { wf[tid] = expf(lgf * (float)(127 - tid)); wb[tid] = expf(lgb * (float)tid); }
        const int kc = 1792 + h * 64, vc = 2304 + h * 64;
#pragma unroll
        for (int q = 0; q < 8; ++q) {
            const int idx = tid + 512 * q; const int r = idx >> 5, i = idx & 31;
            bf16_t* zp = Z + (size_t)(t0 + r) * INW + kc + i;
            float x1 = bf2f(zp[0]), x2 = bf2f(zp[32]);
            if (lat) {
                const int pos = (t0 + r) & (SEQ - 1);
                const float c = rope[(size_t)2 * SEQ * 32 + pos * 32 + i], s = rope[(size_t)3 * SEQ * 32 + pos * 32 + i];
                const bf16_t o1 = f2bf(x1 * c - x2 * s), o2 = f2bf(x1 * s + x2 * c);
                zp[0] = o1; zp[32] = o2; x1 = bf2f(o1); x2 = bf2f(o2);
            }
            Ks[r * 64 + i] = x1; Ks[r * 64 + 32 + i] = x2;
        }
#pragma unroll
        for (int q = 0; q < 16; ++q) { const int idx = tid + 512 * q; const int r = idx >> 6, c = idx & 63; Vs[idx] = bf2f(Z[(size_t)(t0 + r) * INW + vc + c]); }
        __syncthreads();
        const int d = tid >> 3, e0 = (tid & 7) * 8;
        float af[8], ab[8];
#pragma unroll
        for (int j = 0; j < 8; ++j) { af[j] = 0.f; ab[j] = 0.f; }
        for (int s = 0; s < 128; ++s) {
            const float kv = Ks[s * 64 + d]; const float kfw = kv * wf[s], kbw = kv * wb[s];
            const float4 v0 = *(const float4*)(Vs + s * 64 + e0), v1 = *(const float4*)(Vs + s * 64 + e0 + 4);
            af[0] += kfw * v0.x; af[1] += kfw * v0.y; af[2] += kfw * v0.z; af[3] += kfw * v0.w; af[4] += kfw * v1.x; af[5] += kfw * v1.y; af[6] += kfw * v1.z; af[7] += kfw * v1.w;
            ab[0] += kbw * v0.x; ab[1] += kbw * v0.y; ab[2] += kbw * v0.z; ab[3] += kbw * v0.w; ab[4] += kbw * v1.x; ab[5] += kbw * v1.y; ab[6] += kbw * v1.z; ab[7] += kbw * v1.w;
        }
        const size_t so = ((size_t)(b * NCH + cidx) * 8 + h) * 4096 + d * 64 + e0;
        *(float4*)(AF + so) = make_float4(af[0], af[1], af[2], af[3]); *(float4*)(AF + so + 4) = make_float4(af[4], af[5], af[6], af[7]);
        *(float4*)(AB + so) = make_float4(ab[0], ab[1], ab[2], ab[3]); *(float4*)(AB + so + 4) = make_float4(ab[4], ab[5], ab[6], ab[7]);
    }
    __syncthreads();
}

__device__ void m2_scan(const KP& p, int e) {
    float* AF = (float*)(p.ws + WS_ST); float* AB = AF + SZ_ST / 4; float* TF = AB + SZ_ST / 4; float* TB = TF + SZ_ST / 4;
    const float* dec = p.in[13] + e * 16;
    for (int idx = blockIdx.x * 512 + ltid(); idx < NB * 8 * 4096; idx += gridDim.x * 512) {
        const int el = idx & 4095, h = (idx >> 12) & 7, b = idx >> 15;
        const float gf = expf(log_sigmoid(dec[h]) * 128.0f), gb = expf(log_sigmoid(dec[8 + h]) * 128.0f);
#define SIDX(c) (((size_t)(b * NCH + (c)) * 8 + h) * 4096 + el)
        const float afc0 = AF[SIDX(32)], afc1 = AF[SIDX(33)], abc0 = AB[SIDX(32)], abc1 = AB[SIDX(33)];
        TF[SIDX(32)] = 0.f; TF[SIDX(33)] = afc0; TB[SIDX(33)] = 0.f; TB[SIDX(32)] = abc1;
        float sf = gf * afc0 + afc1, sb = abc0 + gb * abc1;
        for (int c = 0; c < 32; ++c) { TF[SIDX(c)] = sf; sf = gf * sf + AF[SIDX(c)]; }
        for (int c = 31; c >= 0; --c) { TB[SIDX(c)] = sb; sb = AB[SIDX(c)] + gb * sb; }
#undef SIDX
    }
}

__device__ void m3_outputs(const KP& p, int e, bool ctx_full, float* sm) {
    const int tid = ltid(), bid = blockIdx.x, nb = gridDim.x;
    const bf16_t* Z = (const bf16_t*)(p.ws + WS_BIG);
    bf16_t* MIX = (bf16_t*)(p.ws + WS_MIX);
    const float* dec = p.in[13] + e * 16;
    const float* sink = p.in[12] + e * 8;
    const float* TF = (const float*)(p.ws + WS_ST) + 2 * (SZ_ST / 4); const float* TB = TF + SZ_ST / 4;
    const int nchunk = ctx_full ? NCH : 32;
    const int nitems = NB * nchunk * 8;
    for (int it = bid; it < 2 * nitems; it += nb) {
        const bool is_attn = it >= nitems; const int ii = is_attn ? it - nitems : it;
        const int h = ii & 7, cidx = (ii >> 3) % nchunk, b = ii / (8 * nchunk);
        const int t0 = chunk_t0(b, cidx); const bool lat = cidx < 32;
        const int i = tid >> 2, sub = tid & 3;
        __syncthreads();
        if (!is_attn) {
            float* Qs = sm; float* Ks = Qs + 8192; float* Vs = Ks + 8192; float* Tf = Vs + 8192; float* Tb = Tf + 4096; float* pf = Tb + 4096; float* pb = pf + 132;
            const float lgf = log_sigmoid(dec[h]), lgb = log_sigmoid(dec[8 + h]);
            if (tid < 129) { pf[tid] = expf(lgf * (float)tid); pb[tid] = expf(lgb * (float)tid); }
#pragma unroll
            for (int q = 0; q < 16; ++q) { const int idx = tid + 512 * q; const int r = idx >> 6, c = idx & 63; const bf16_t* zr = Z + (size_t)(t0 + r) * INW + h * 64 + c;
                Qs[idx] = bf2f(zr[512]); Ks[idx] = bf2f(zr[1792]); Vs[idx] = bf2f(zr[2304]); }
            const size_t so = ((size_t)(b * NCH + cidx) * 8 + h) * 4096;
#pragma unroll
            for (int q = 0; q < 8; ++q) { const int idx = tid + 512 * q; Tf[idx] = TF[so + idx]; Tb[idx] = TB[so + idx]; }
            __syncthreads();
            float qv[16], o[16];
#pragma unroll
            for (int j = 0; j < 16; ++j) { qv[j] = Qs[i * 64 + sub * 16 + j]; o[j] = 0.f; }
            for (int s = 0; s < 128; ++s) {
                float part = 0.f;
#pragma unroll
                for (int j4 = 0; j4 < 4; ++j4) { const float4 kk = *(const float4*)(Ks + s * 64 + sub * 16 + j4 * 4);
                    part += qv[j4 * 4] * kk.x + qv[j4 * 4 + 1] * kk.y + qv[j4 * 4 + 2] * kk.z + qv[j4 * 4 + 3] * kk.w; }
                part += __shfl_xor(part, 1, 64); part += __shfl_xor(part, 2, 64);
                const float wgt = (s < i) ? pf[i - s] : ((s > i) ? pb[s - i] : 2.0f);
                const float a = part * wgt;
#pragma unroll
                for (int j4 = 0; j4 < 4; ++j4) { const float4 vv = *(const float4*)(Vs + s * 64 + sub * 16 + j4 * 4);
                    o[j4 * 4] += a * vv.x; o[j4 * 4 + 1] += a * vv.y; o[j4 * 4 + 2] += a * vv.z; o[j4 * 4 + 3] += a * vv.w; }
            }
            const float cf = pf[i + 1], cb = pb[128 - i];
            for (int d = 0; d < 64; ++d) {
                const float qd = Qs[i * 64 + d]; const float qf = qd * cf, qb = qd * cb;
#pragma unroll
                for (int j4 = 0; j4 < 4; ++j4) { const float4 tf = *(const float4*)(Tf + d * 64 + sub * 16 + j4 * 4); const float4 tb = *(const float4*)(Tb + d * 64 + sub * 16 + j4 * 4);
                    o[j4 * 4] += qf * tf.x + qb * tb.x; o[j4 * 4 + 1] += qf * tf.y + qb * tb.y; o[j4 * 4 + 2] += qf * tf.z + qb * tb.z; o[j4 * 4 + 3] += qf * tf.w + qb * tb.w; }
            }
            float ss = 0.f;
#pragma unroll
            for (int j = 0; j < 16; ++j) ss += o[j] * o[j];
            ss += __shfl_xor(ss, 1, 64); ss += __shfl_xor(ss, 2, 64);
            const float r = rsqrtf(ss * (1.0f / 64.0f) + EPS);
            const bf16_t* gr = Z + (size_t)(t0 + i) * INW + 1024 + h * 64 + sub * 16;
            bf16_t* mo = MIX + (size_t)(t0 + i) * D + 512 + h * 64 + sub * 16;
#pragma unroll
            for (int j = 0; j < 16; ++j) mo[j] = f2bf(o[j] * r * silu_f(bf2f(gr[j])));
        } else {
            float* Kt = sm; float* Vt = sm + 128 * 68;
            const int g = h >> 2;
            float qv[16], acc[16];
            {
                const bf16_t* qr = Z + (size_t)(t0 + i) * INW + h * 64 + sub * 16;
#pragma unroll
                for (int d = 0; d < 16; ++d) { qv[d] = bf2f(qr[d]); acc[d] = 0.f; }
            }
            float mx = sink[h], l = 1.0f;
            const int qpos = lat ? (cidx * 128 + i) : 0;
            for (int tl = 0; tl < 5; ++tl) {
                int kt0; int kp0 = 0; const bool isc = tl >= 3;
                if (!isc) { if (!lat) continue; const int kc = cidx - 1 + tl; if (kc < 0 || kc >= 32) continue; kt0 = b * SEQ + kc * 128; kp0 = kc * 128; }
                else kt0 = TL + b * CL + (tl - 3) * 128;
                __syncthreads();
#pragma unroll
                for (int q = 0; q < 16; ++q) { const int idx = tid + 512 * q; const int r = idx >> 6, c = idx & 63; const bf16_t* zr = Z + (size_t)(kt0 + r) * INW + g * 64 + c;
                    Kt[r * 68 + c] = bf2f(zr[1536]); Vt[r * 68 + c] = bf2f(zr[1664]); }
                __syncthreads();
                for (int j = 0; j < 128; ++j) {
                    float s = 0.f;
#pragma unroll
                    for (int d4 = 0; d4 < 4; ++d4) { const float4 kk = *(const float4*)(Kt + j * 68 + sub * 16 + d4 * 4);
                        s += qv[d4 * 4] * kk.x + qv[d4 * 4 + 1] * kk.y + qv[d4 * 4 + 2] * kk.z + qv[d4 * 4 + 3] * kk.w; }
                    s += __shfl_xor(s, 1, 64); s += __shfl_xor(s, 2, 64);
                    bool valid = true;
                    if (!isc) { const int dd = qpos - (kp0 + j); valid = (dd <= 128) && (dd >= -128); }
                    if (valid) {
                        if (s > mx) { const float sc = __expf(mx - s); l *= sc;
#pragma unroll
                            for (int d = 0; d < 16; ++d) acc[d] *= sc;
                            mx = s; }
                        const float pw = __expf(s - mx); l += pw;
#pragma unroll
                        for (int d4 = 0; d4 < 4; ++d4) { const float4 vv = *(const float4*)(Vt + j * 68 + sub * 16 + d4 * 4);
                            acc[d4 * 4] += pw * vv.x; acc[d4 * 4 + 1] += pw * vv.y; acc[d4 * 4 + 2] += pw * vv.z; acc[d4 * 4 + 3] += pw * vv.w; }
                    }
                }
            }
            const float inv = 1.0f / l;
            bf16_t* mo = MIX + (size_t)(t0 + i) * D + h * 64 + sub * 16;
#pragma unroll
            for (int d = 0; d < 16; ++d) mo[d] = f2bf(acc[d] * inv);
        }
    }
    __syncthreads();
}

__device__ void h2_shortconv(const KP& p, int o, int M) {
    const bf16_t* ZH = (const bf16_t*)(p.ws + WS_BIG);
    float* VX = (float*)(p.ws + WS_Y); bf16_t* X0 = (bf16_t*)(p.ws + WS_H);
    const float* w = p.in[17] + (size_t)o * 3 * HYW; const float* bs = p.in[18] + (size_t)o * HYW;
    for (int idx = blockIdx.x * 512 + ltid(); idx < M * D; idx += gridDim.x * 512) {
        const int t = idx >> 10, d = idx & 1023;
        bool first, last;
        if (t < TL) { const int pos = t & (SEQ - 1); first = pos == 0; last = pos == SEQ - 1; }
        else { const int pos = (t - TL) & (CL - 1); first = pos == 0; last = pos == CL - 1; }
        float zz[3];
#pragma unroll
        for (int k = 0; k < 3; ++k) {
            const int c = k * 1024 + d;
            float s = bs[c] + bf2f(ZH[(size_t)t * HYW + c]) * w[HYW + c];
            if (!first) s += bf2f(ZH[(size_t)(t - 1) * HYW + c]) * w[c];
            if (!last) s += bf2f(ZH[(size_t)(t + 1) * HYW + c]) * w[2 * HYW + c];
            zz[k] = s;
        }
        VX[idx] = zz[2] * zz[1]; X0[idx] = f2bf(zz[0]);
    }
}

__device__ void h3_longconv(const KP& p, int o, bool ctx_full) {
    const int tid = ltid(), w = tid >> 6, lane = tid & 63;
    const float* VX = (const float*)(p.ws + WS_Y); const bf16_t* X0 = (const bf16_t*)(p.ws + WS_H);
    bf16_t* MIX = (bf16_t*)(p.ws + WS_MIX);
    const float* bias = p.in[27] + (size_t)o * D;
    const int nlat = NB * 32 * 16, nctx = ctx_full ? NB * 2 * 16 : 0;
    for (int it = blockIdx.x; it < nlat + nctx; it += gridDim.x) {
        int b, nbk, dbk, Lf, tb; const float* kf;
        if (it < nlat) { dbk = it & 15; nbk = (it >> 4) & 31; b = it >> 9; Lf = SEQ; tb = b * SEQ; kf = (const float*)(p.ws + WS_KF + (size_t)o * SZ_KF); }
        else { const int r = it - nlat; dbk = r & 15; nbk = (r >> 4) & 1; b = r >> 5; Lf = CL; tb = TL + b * CL; kf = (const float*)(p.ws + WS_KF + (size_t)o * SZ_KF) + (size_t)2 * SEQ * D; }
        const int d = dbk * 64 + lane; const int n0 = nbk * 128 + w * 16;
        const float* kfd = kf + d; const float* kbd = kf + (size_t)Lf * D + d;
        float acc[16];
#pragma unroll
        for (int j = 0; j < 16; ++j) acc[j] = 0.f;
        for (int mb = 0; mb < Lf; mb += 16) {
            const int lag0 = n0 - mb;
            float kk[31], uu[16];
#pragma unroll
            for (int q = 0; q < 31; ++q) { const int lag = lag0 - 15 + q; float v = 0.f;
                if (lag >= 0) { if (lag < Lf) v = kfd[(size_t)lag * D]; } else { if (-lag < Lf) v = kbd[(size_t)(-lag) * D]; }
                kk[q] = v; }
#pragma unroll
            for (int u = 0; u < 16; ++u) uu[u] = VX[(size_t)(tb + mb + u) * D + d];
#pragma unroll
            for (int u = 0; u < 16; ++u)
#pragma unroll
                for (int j = 0; j < 16; ++j) acc[j] += uu[u] * kk[15 - u + j];
        }
        const float bd = bias[d];
#pragma unroll
        for (int j = 0; j < 16; ++j) { const size_t ti = (size_t)(tb + n0 + j) * D + d; MIX[ti] = f2bf(bf2f(X0[ti]) * (acc[j] + bd * VX[ti])); }
    }
}

__global__ void __launch_bounds__(512, 2) mega_fwd(KP p) {
    extern __shared__ __attribute__((aligned(16))) unsigned char smem[];
    cg::grid_group grid = cg::this_grid();
    float* smf = (float*)smem;
    bf16_t* Hb = (bf16_t*)(p.ws + WS_H); bf16_t* BIG = (bf16_t*)(p.ws + WS_BIG); float* Y = (float*)(p.ws + WS_Y); bf16_t* MIX = (bf16_t*)(p.ws + WS_MIX);
    const float* npre = p.in[6]; const float* npost = p.in[7];

#ifndef NO_P0
    p0_setup(p, smf);
#endif
    grid.sync();
    rowphase(p, 0, nullptr, 0, 0, 0.f, nullptr, T, 0, npre, 0, 1, Hb);
    grid.sync();
    for (int l = 0; l < 4; ++l) {
        const bool ctx_live = l <= 2, ctx_full = l < 2;
        const int Mff = ctx_live ? T : TL, Mpost = ctx_full ? T : TL;
        for (int sub = 0; sub < 3; ++sub) {
            if (sub != 1) {
                const int fi = sub >> 1; const int M = (sub == 0) ? Mff : Mpost;
                { pg8::EpiSwiGLU E{BIG, DFF}; run_gemm(smem, Hb, (const bf16_t*)(p.ws + WS_WGU + (size_t)(l * 2 + fi) * SZ_WGU), M, 2 * DFF, D, E); }
                grid.sync();
                { pg8::EpiF32 E{Y, D}; run_gemm(smem, BIG, (const bf16_t*)(p.ws + WS_WD + (size_t)(l * 2 + fi) * SZ_WD), M, D, DFF, E); }
                grid.sync();
                if (sub == 0) rowphase(p, M, Y, l, 2, 0.5f, npost + (size_t)(l * 3 + 0) * D, Mff, l, npre + (size_t)(l * 3 + 1) * D, 3, 4, Hb);
                else {
                    const int ln = l + 1; const int Mn = (ln < 4) ? ((ln <= 2) ? T : TL) : 0;
                    rowphase(p, M, Y, l, 8, 0.5f, npost + (size_t)(l * 3 + 2) * D, Mn, ln < 4 ? ln : l, npre + (size_t)((ln < 4 ? ln : l) * 3 + 0) * D, 0, 1, ln < 4 ? Hb : nullptr);
                }
                grid.sync();
            } else {
                if ((l & 1) == 0) {
                    const int e = l >> 1;
                    { pg8::EpiBf16 E{BIG, INW, nullptr}; run_gemm(smem, Hb, (const bf16_t*)(p.ws + WS_WIN + (size_t)e * SZ_WIN), Mff, INW, D, E); }
                    grid.sync();
#ifndef NO_M1
                    m1_rope_states(p, e, smf);
#endif
                    grid.sync();
#ifndef NO_M2
                    m2_scan(p, e);
#endif
                    grid.sync();
#ifndef NO_M3
                    m3_outputs(p, e, ctx_full, smf);
#endif
                    grid.sync();
                    { pg8::EpiF32 E{Y, D}; run_gemm(smem, MIX, (const bf16_t*)(p.ws + WS_WOUT + (size_t)e * SZ_WOUT), Mpost, D, D, E); }
                    grid.sync();
                } else {
                    const int o = l >> 1;
                    { pg8::EpiBf16 E{BIG, HYW, p.in[16] + (size_t)o * HYW}; run_gemm(smem, Hb, (const bf16_t*)(p.ws + WS_HWIN + (size_t)o * SZ_HWIN), Mpost, HYW, D, E); }
                    grid.sync();
#ifndef NO_H2
                    h2_shortconv(p, o, Mpost);
#endif
                    grid.sync();
#ifndef NO_H3
                    h3_longconv(p, o, ctx_full);
#endif
                    grid.sync();
                    { pg8::EpiF32 E{Y, D}; run_gemm(smem, MIX, (const bf16_t*)(p.ws + WS_HWOUT + (size_t)o * SZ_WOUT), Mpost, D, D, E); }
                    grid.sync();
                }
                rowphase(p, Mpost, Y, l, 5, 1.0f, npost + (size_t)(l * 3 + 1) * D, Mpost, l, npre + (size_t)(l * 3 + 2) * D, 6, 7, Hb);
                grid.sync();
            }
        }
    }
}

extern "C" void kernel_launch(void* const* d_in, const int* in_sizes, int n_in, void* d_out, int out_size, void* d_ws, size_t ws_size, hipStream_t stream) {
    static int grid = 0;
    if (grid == 0) {
        if (n_in != 29 || out_size != TL * D || ws_size < WS_END) { fprintf(stderr, "kernel_launch: unexpected shapes: n_in %d out %d ws %zu (need %zu)\n", n_in, out_size, ws_size, (size_t)WS_END); grid = -1; return; }
        int dev = 0, cus = 0, per_cu = 0;
        (void)hipGetDevice(&dev);
        (void)hipDeviceGetAttribute(&cus, hipDeviceAttributeMultiprocessorCount, dev);
        if (hipFuncSetAttribute((const void*)mega_fwd, hipFuncAttributeMaxDynamicSharedMemorySize, LDS_BYTES) != hipSuccess) { fprintf(stderr, "kernel_launch: hipFuncSetAttribute failed\n"); grid = -1; return; }
        if (hipOccupancyMaxActiveBlocksPerMultiprocessor(&per_cu, (const void*)mega_fwd, 512, LDS_BYTES) != hipSuccess || per_cu < 1) { fprintf(stderr, "kernel_launch: occupancy query says %d\n", per_cu); per_cu = 1; }
        (void)hipGetLastError();
        grid = cus;
    }
    if (grid < 0) return;
    KP kp{};
    for (int i = 0; i < 29; ++i) kp.in[i] = (const float*)d_in[i];
    kp.out = (float*)d_out; kp.ws = (unsigned char*)d_ws;
    void* args[] = {&kp};
    hipError_t e = hipLaunchCooperativeKernel((const void*)mega_fwd, dim3(grid), dim3(512), args, LDS_BYTES, stream);
    if (e != hipSuccess) fprintf(stderr, "cooperative launch failed: %s (grid %d)\n", hipGetErrorString(e), grid);
}
```

```cpp
#include <hip/hip_runtime.h>
#include <hip/hip_cooperative_groups.h>
#include <cstdio>
namespace cg = cooperative_groups;

#define LAS __attribute__((address_space(3)))
typedef unsigned short bf16_t;
typedef short bf16x8 __attribute__((ext_vector_type(8)));
typedef float f32x4 __attribute__((ext_vector_type(4)));
typedef unsigned u32x4 __attribute__((ext_vector_type(4)));

constexpr int D = 1024, NB = 4, SEQ = 4096, CL = 256, TL = NB * SEQ, TC = NB * CL, T = TL + TC, DFF = 2816, INW = 2816, HYW = 3072;
constexpr int NMOD = 9;
constexpr float EPS = 1e-6f;
constexpr int NCH = 34;
constexpr int LDS_BYTES = 144 * 1024;

constexpr size_t SZ_WGU = (size_t)2 * DFF * D * 2, SZ_WD = (size_t)D * DFF * 2, SZ_WIN = (size_t)INW * D * 2, SZ_WOUT = (size_t)D * D * 2, SZ_HWIN = (size_t)HYW * D * 2;
constexpr size_t WS_WGU = 0;
constexpr size_t WS_WD = WS_WGU + 8 * SZ_WGU;
constexpr size_t WS_WIN = WS_WD + 8 * SZ_WD;
constexpr size_t WS_WOUT = WS_WIN + 2 * SZ_WIN;
constexpr size_t WS_HWIN = WS_WOUT + 2 * SZ_WOUT;
constexpr size_t WS_HWOUT = WS_HWIN + 2 * SZ_HWIN;
constexpr size_t WS_MOD = WS_HWOUT + 2 * SZ_WOUT;
constexpr size_t WS_ROPE = WS_MOD + (size_t)4 * 5 * NMOD * D * 4;
constexpr size_t WS_XC = WS_ROPE + (size_t)4 * SEQ * 32 * 4;
constexpr size_t WS_H = WS_XC + (size_t)TC * D * 4;
constexpr size_t WS_BIG = WS_H + (size_t)T * D * 2;
constexpr size_t WS_Y = WS_BIG + (size_t)T * HYW * 2;
constexpr size_t WS_MIX = WS_Y + (size_t)T * D * 4;
constexpr size_t SZ_ST = (size_t)NB * NCH * 8 * 4096 * 4;
constexpr size_t WS_ST = WS_MIX + (size_t)T * D * 2;
constexpr size_t SZ_KF = (size_t)(SEQ + CL) * 2 * D * 4;
constexpr size_t WS_KF = WS_ST + 4 * SZ_ST;
constexpr size_t WS_END = WS_KF + 2 * SZ_KF;

struct KP { const float* in[29]; float* out; unsigned char* ws; };

__device__ __forceinline__ bf16_t f2bf(float f) { unsigned u = __float_as_uint(f); u += 0x7FFFu + ((u >> 16) & 1u); return (bf16_t)(u >> 16); }
__device__ __forceinline__ float bf2f(bf16_t b) { return __uint_as_float(((unsigned)b) << 16); }
__device__ __forceinline__ float silu_f(float x) { return x / (1.0f + __expf(-x)); }
__device__ __forceinline__ int ltid() { int t = threadIdx.x; asm volatile("" : "+v"(t)); return t; }
__device__ __forceinline__ float wave_sum(float v) {
#pragma unroll
    for (int o = 32; o > 0; o >>= 1) v += __shfl_xor(v, o, 64);
    return v;
}

namespace pg8 {
constexpr int BM = 256, BK = 64, HALF = 128, HTB = HALF * BK * 2, STAGE_BYTES = 8 * HTB, NXCD = 8, WGM = 8;
__host__ __device__ __forceinline__ int lds_byte(int r, int c) { const int st = (r >> 4) * 2 + (c >> 5), rr = r & 15, cc = c & 31, ob = rr * 64 + cc * 2; return st * 1024 + (ob ^ (((ob >> 9) & 1) << 5)); }
__host__ __device__ __forceinline__ void stage_rc(int b, int& R, int& C) { const int st = b / 1024, sb = b % 1024, swz = sb ^ (((sb >> 9) & 1) << 5); R = (st >> 1) * 16 + swz / 64; C = (st & 1) * 32 + (swz % 64) / 2; }
__host__ __device__ __forceinline__ int perm32(int rho) { const int n = rho >> 4, i = rho & 15; return 8 * (i >> 2) + 4 * n + (i & 3); }
struct Unit { int pm, pn; };
struct Gemm { const bf16_t* A; const bf16_t* Bt; int M, N, K; };
struct StaticOrder {
    int nM, nN, nwg, G, c;
    __device__ void init(int M, int N, int G_, int c_) { nM = M / BM; nN = N / BM; nwg = nM * nN; G = G_; c = c_; }
    __device__ bool next(int i, Unit& u) const {
        const long Lx = (long)i * G + c; if (Lx >= nwg) return false;
        int wgid = (int)Lx; { const int q = nwg / NXCD, r = nwg % NXCD, xcd = wgid % NXCD, off = wgid / NXCD; wgid = (xcd < r ? xcd * (q + 1) : r * (q + 1) + (xcd - r) * q) + off; }
        const int nig = WGM * nN, gid = wgid / nig, fm = gid * WGM, gsz = (nM - fm) < WGM ? (nM - fm) : WGM;
        u.pm = fm + ((wgid % nig) % gsz); u.pn = (wgid % nig) / gsz; return true;
    }
};
__device__ __forceinline__ unsigned cvt_pk_bf16(float lo, float hi) { unsigned r; asm volatile("v_cvt_pk_bf16_f32 %0, %1, %2" : "=v"(r) : "v"(lo), "v"(hi)); return r; }

struct EpiF32 {
    static constexpr bool PERM = false;
    float* C; int ldc;
    __device__ __forceinline__ void operator()(const f32x4 (&acc)[2][2][4][2], const Unit& u, int wr, int wc, int fr, int fq) const {
        const int row0 = u.pm * BM + wr * 64 + fr, col0 = u.pn * BM + wc * 32 + 4 * fq;
#pragma unroll
        for (int ai = 0; ai < 2; ++ai)
#pragma unroll
            for (int m = 0; m < 4; ++m) { float* rowp = C + (size_t)(row0 + ai * HALF + m * 16) * ldc + col0;
#pragma unroll
                for (int bj = 0; bj < 2; ++bj)
#pragma unroll
                    for (int n = 0; n < 2; ++n) *(f32x4*)(rowp + bj * HALF + n * 16) = acc[ai][bj][m][n]; }
    }
};
struct EpiBf16 {
    static constexpr bool PERM = true;
    bf16_t* O; int ldc; const float* bias;
    __device__ __forceinline__ void operator()(const f32x4 (&acc)[2][2][4][2], const Unit& u, int wr, int wc, int fr, int fq) const {
        const int row0 = u.pm * BM + wr * 64 + fr; const int col0 = u.pn * BM + wc * 32 + 8 * fq;
        f32x4 bv[2][2];
#pragma unroll
        for (int bj = 0; bj < 2; ++bj)
#pragma unroll
            for (int n = 0; n < 2; ++n) bv[bj][n] = bias ? *(const f32x4*)(bias + col0 + bj * HALF + 4 * n) : (f32x4){0.f, 0.f, 0.f, 0.f};
#pragma unroll
        for (int ai = 0; ai < 2; ++ai)
#pragma unroll
            for (int m = 0; m < 4; ++m) { bf16_t* rowp = O + (size_t)(row0 + ai * HALF + m * 16) * ldc + col0;
#pragma unroll
                for (int bj = 0; bj < 2; ++bj) { f32x4 v0 = acc[ai][bj][m][0] + bv[bj][0], v1 = acc[ai][bj][m][1] + bv[bj][1];
                    u32x4 w; w.x = cvt_pk_bf16(v0[0], v0[1]); w.y = cvt_pk_bf16(v0[2], v0[3]); w.z = cvt_pk_bf16(v1[0], v1[1]); w.w = cvt_pk_bf16(v1[2], v1[3]);
                    *(u32x4*)(rowp + bj * HALF) = w; } }
    }
};
struct EpiSwiGLU {
    static constexpr bool PERM = true;
    bf16_t* O; int ldc;
    __device__ __forceinline__ void operator()(const f32x4 (&acc)[2][2][4][2], const Unit& u, int wr, int wc, int fr, int fq) const {
        const int row0 = u.pm * BM + wr * 64 + fr; const int col0 = u.pn * HALF + wc * 32 + 8 * fq;
#pragma unroll
        for (int ai = 0; ai < 2; ++ai)
#pragma unroll
            for (int m = 0; m < 4; ++m) { bf16_t* rowp = O + (size_t)(row0 + ai * HALF + m * 16) * ldc + col0;
                float v[8];
#pragma unroll
                for (int n = 0; n < 2; ++n)
#pragma unroll
                    for (int j = 0; j < 4; ++j) { const float g = acc[ai][0][m][n][j], up = acc[ai][1][m][n][j]; v[n * 4 + j] = silu_f(g) * up; }
                u32x4 w; w.x = cvt_pk_bf16(v[0], v[1]); w.y = cvt_pk_bf16(v[2], v[3]); w.z = cvt_pk_bf16(v[4], v[5]); w.w = cvt_pk_bf16(v[6], v[7]);
                *(u32x4*)rowp = w; }
    }
};

template <class Epi, class Sched>
__device__ __forceinline__ void gemm_phase(LAS unsigned char* lds, const Gemm g, const Sched& S, const Epi& E) {
    const int tid = ltid(), wid = __builtin_amdgcn_readfirstlane(tid >> 6), lane = tid & 63, wr = wid >> 2, wc = wid & 3, fr = lane & 15, fq = lane >> 4;
    const int K = g.K, nt = K / BK;
    unsigned voffA[2], voffB[2];
#pragma unroll
    for (int i = 0; i < 2; ++i) { int R, C; stage_rc(tid * 16 + i * 8192, R, C); const int Rb = Epi::PERM ? ((R & ~31) + perm32(R & 31)) : R;
        voffA[i] = (unsigned)(R * K + C) * 2u; voffB[i] = (unsigned)(Rb * K + C) * 2u; }
    const size_t kstep = (size_t)(BK * 2);
    const size_t hstep = (size_t)HALF * K * 2;
    const size_t tstep = 2 * hstep;
    const unsigned ldsw = (unsigned)wid * 1024u;
    const int aoff = lds_byte(wr * 64 + fr, fq * 8), boff = lds_byte(wc * 32 + fr, fq * 8);
#define PG8_SA(b, h) (((b) * 2 + (h)) * HTB)
#define PG8_SB(b, h) ((4 + (b) * 2 + (h)) * HTB)
#define PG8_STAGE(bufoff, gbase, voff) do { _Pragma("unroll") for (int _i = 0; _i < 2; ++_i) \
        __builtin_amdgcn_global_load_lds((const unsigned*)((const char*)(gbase) + (voff)[_i]), (LAS unsigned*)(lds + (bufoff) + ldsw + _i * 8192), 16, 0, 0); } while (0)
#define PG8_LDA(dst, b, h) do { _Pragma("unroll") for (int m = 0; m < 4; ++m) _Pragma("unroll") for (int k = 0; k < 2; ++k) dst[m][k] = *(const LAS bf16x8*)(lds + PG8_SA(b, h) + aoff + m * 2048 + k * 1024); } while (0)
#define PG8_LDB(dst, b, h) do { _Pragma("unroll") for (int n = 0; n < 2; ++n) _Pragma("unroll") for (int k = 0; k < 2; ++k) dst[n][k] = *(const LAS bf16x8*)(lds + PG8_SB(b, h) + boff + n * 2048 + k * 1024); } while (0)
#define PG8_MMA(ai, bj, At, Bt) do { __builtin_amdgcn_s_setprio(1); _Pragma("unroll") for (int m = 0; m < 4; ++m) _Pragma("unroll") for (int n = 0; n < 2; ++n) _Pragma("unroll") for (int k = 0; k < 2; ++k) \
        acc[ai][bj][m][n] = __builtin_amdgcn_mfma_f32_16x16x32_bf16(Bt[n][k], At[m][k], acc[ai][bj][m][n], 0, 0, 0); __builtin_amdgcn_s_setprio(0); } while (0)
#define PG8_WAIT_V(n) asm volatile("s_waitcnt vmcnt(" #n ")" ::: "memory")
#define PG8_WAIT_L(n) asm volatile("s_waitcnt lgkmcnt(" #n ")" ::: "memory")
#define PG8_BAR __builtin_amdgcn_s_barrier()
#define PG8_SCHED __builtin_amdgcn_sched_barrier(0)
    Unit cur, nxt; int ui = 0;
    if (!S.next(0, cur)) return;
    f32x4 acc[2][2][4][2];
#pragma unroll
    for (int a = 0; a < 2; ++a)
#pragma unroll
        for (int b = 0; b < 2; ++b)
#pragma unroll
            for (int m = 0; m < 4; ++m)
#pragma unroll
                for (int n = 0; n < 2; ++n) acc[a][b][m][n] = (f32x4){0.f, 0.f, 0.f, 0.f};
    bf16x8 At[4][2], B0[2][2], B1[2][2];
    const char* cA = (const char*)g.A + (size_t)cur.pm * tstep; const char* cB = (const char*)g.Bt + (size_t)cur.pn * tstep;
    PG8_STAGE(PG8_SB(0, 0), cB, voffB); PG8_STAGE(PG8_SA(0, 0), cA, voffA); PG8_STAGE(PG8_SB(0, 1), cB + hstep, voffB); PG8_STAGE(PG8_SA(0, 1), cA + hstep, voffA);
    if (wr == 1) PG8_BAR;
    PG8_WAIT_V(4); PG8_BAR;
    PG8_STAGE(PG8_SB(1, 0), cB + kstep, voffB); PG8_STAGE(PG8_SA(1, 0), cA + kstep, voffA); PG8_STAGE(PG8_SB(1, 1), cB + hstep + kstep, voffB);
    PG8_WAIT_V(6); PG8_BAR;
    for (;;) {
        const bool has_next = S.next(ui + 1, nxt);
        const char* nA = has_next ? (const char*)g.A + (size_t)nxt.pm * tstep : cA; const char* nB = has_next ? (const char*)g.Bt + (size_t)nxt.pn * tstep : cB;
        for (int t = 0; t < nt; t += 2) {
            const bool last = (t == nt - 2);
            const char* a1 = cA + (size_t)(t + 1) * kstep;
            const char* a2 = last ? nA : cA + (size_t)(t + 2) * kstep; const char* b2 = last ? nB : cB + (size_t)(t + 2) * kstep;
            const char* a3 = a2 + kstep; const char* b3 = b2 + kstep;
            PG8_LDB(B0, 0, 0); PG8_SCHED; PG8_LDA(At, 0, 0); PG8_STAGE(PG8_SA(1, 1), a1 + hstep, voffA);
            PG8_WAIT_L(8); PG8_BAR; PG8_WAIT_L(0); PG8_MMA(0, 0, At, B0); PG8_BAR; PG8_SCHED;
            PG8_LDB(B1, 0, 1); PG8_STAGE(PG8_SB(0, 0), b2, voffB);
            PG8_BAR; PG8_WAIT_L(0); PG8_MMA(0, 1, At, B1); PG8_BAR;
            PG8_LDA(At, 0, 1); PG8_STAGE(PG8_SA(0, 0), a2, voffA);
            PG8_BAR; PG8_WAIT_L(0); PG8_MMA(1, 0, At, B0); PG8_BAR; PG8_SCHED;
            PG8_STAGE(PG8_SB(0, 1), b2 + hstep, voffB);
            PG8_WAIT_V(6); PG8_BAR; PG8_MMA(1, 1, At, B1); PG8_BAR;
            PG8_LDB(B0, 1, 0); PG8_SCHED; PG8_LDA(At, 1, 0); PG8_STAGE(PG8_SA(0, 1), a2 + hstep, voffA);
            PG8_WAIT_L(8); PG8_BAR; PG8_WAIT_L(0); PG8_MMA(0, 0, At, B0); PG8_BAR; PG8_SCHED;
            PG8_LDB(B1, 1, 1); PG8_STAGE(PG8_SB(1, 0), b3, voffB);
            PG8_BAR; PG8_WAIT_L(0); PG8_MMA(0, 1, At, B1); PG8_BAR;
            PG8_LDA(At, 1, 1); PG8_STAGE(PG8_SA(1, 0), a3, voffA);
            PG8_BAR; PG8_WAIT_L(0); PG8_MMA(1, 0, At, B0); PG8_BAR; PG8_SCHED;
            PG8_STAGE(PG8_SB(1, 1), b3 + hstep, voffB);
            PG8_WAIT_V(6); PG8_BAR; PG8_MMA(1, 1, At, B1); PG8_BAR;
        }
        E(acc, cur, wr, wc, fr, fq);
        if (!has_next) break;
#pragma unroll
        for (int a = 0; a < 2; ++a)
#pragma unroll
            for (int b = 0; b < 2; ++b)
#pragma unroll
                for (int m = 0; m < 4; ++m)
#pragma unroll
                    for (int n = 0; n < 2; ++n) acc[a][b][m][n] = (f32x4){0.f, 0.f, 0.f, 0.f};
        cur = nxt; cA = nA; cB = nB; ++ui;
    }
    PG8_WAIT_V(0);
    if (wr == 0) PG8_BAR;
    PG8_BAR;
#undef PG8_SA
#undef PG8_SB
#undef PG8_STAGE
#undef PG8_LDA
#undef PG8_LDB
#undef PG8_MMA
#undef PG8_WAIT_V
#undef PG8_WAIT_L
#undef PG8_BAR
#undef PG8_SCHED
}
}

template <class Epi>
__device__ __forceinline__ void run_gemm(unsigned char* smem, const bf16_t* A, const bf16_t* Bt, int M, int N, int K, const Epi& E) {
    pg8::Gemm g{A, Bt, M, N, K}; pg8::StaticOrder S; S.init(M, N, (int)gridDim.x, (int)blockIdx.x);
    pg8::gemm_phase<Epi, pg8::StaticOrder>((LAS unsigned char*)smem, g, S, E);
}

__device__ __forceinline__ float* xrow(const KP& p, int t) { return t < TL ? p.out + (size_t)t * D : (float*)(p.ws + WS_XC) + (size_t)(t - TL) * D; }
__device__ __forceinline__ int modrow(int t) { return t < TL ? (t >> 12) : 4; }
__device__ __forceinline__ const float* modp(const KP& p, int l, int mr, int idx) { return (const float*)(p.ws + WS_MOD) + ((size_t)(l * 5 + mr) * NMOD + idx) * D; }

__device__ void p0_setup(const KP& p, float* sm) {
    const int tid = ltid(), bid = blockIdx.x, nb = gridDim.x;
    const int gtid = bid * 512 + tid, gthreads = nb * 512;
    {
        const float4* xs = (const float4*)p.in[0]; float4* xd = (float4*)p.out;
        for (int i = gtid; i < TL * D / 4; i += gthreads) xd[i] = xs[i];
        const float4* cs = (const float4*)p.in[2]; float4* cd = (float4*)(p.ws + WS_XC);
        for (int i = gtid; i < TC * D / 4; i += gthreads) cd[i] = cs[i];
    }
    {
        float* rope = (float*)(p.ws + WS_ROPE);
        for (int idx = gtid; idx < SEQ * 32; idx += gthreads) {
            const int t = idx >> 5, i = idx & 31;
            const int ii = i & 15; const float pos = (i < 16) ? (float)(t >> 6) : (float)(t & 63);
            const float invA = powf(10000.0f, -(float)ii / 16.0f);
            const float angA = pos * invA;
            rope[idx] = cosf(angA); rope[SEQ * 32 + idx] = sinf(angA);
            const float ex = (float)i * (1.0f / 31.0f);
            const float invR = powf(10000.0f, -ex);
            const float angR = (float)t * invR;
            rope[2 * SEQ * 32 + idx] = cosf(angR); rope[3 * SEQ * 32 + idx] = sinf(angR);
        }
    }
    {
        float* tile = sm;
        for (int g = bid; g < 20864; g += nb) {
            int j, tl;
            if (g < 16896) { j = g / 704; tl = g % 704; }
            else if (g < 18304) { j = 24 + (g - 16896) / 704; tl = (g - 16896) % 704; }
            else if (g < 18816) { j = 26 + (g - 18304) / 256; tl = (g - 18304) % 256; }
            else if (g < 20352) { j = 28 + (g - 18816) / 768; tl = (g - 18816) % 768; }
            else { j = 30 + (g - 20352) / 256; tl = (g - 20352) % 256; }
            const float* src; bf16_t* dst; int K, N, mode = 0;
            if (j < 8) { src = p.in[8] + (size_t)j * D * DFF; dst = (bf16_t*)(p.ws + WS_WGU + (size_t)j * SZ_WGU); K = D; N = DFF; mode = 1; }
            else if (j < 16) { src = p.in[9] + (size_t)(j - 8) * D * DFF; dst = (bf16_t*)(p.ws + WS_WGU + (size_t)(j - 8) * SZ_WGU); K = D; N = DFF; mode = 2; }
            else if (j < 24) { src = p.in[10] + (size_t)(j - 16) * DFF * D; dst = (bf16_t*)(p.ws + WS_WD + (size_t)(j - 16) * SZ_WD); K = DFF; N = D; }
            else if (j < 26) { src = p.in[11] + (size_t)(j - 24) * D * INW; dst = (bf16_t*)(p.ws + WS_WIN + (size_t)(j - 24) * SZ_WIN); K = D; N = INW; mode = 3; }
            else if (j < 28) { src = p.in[14] + (size_t)(j - 26) * D * D; dst = (bf16_t*)(p.ws + WS_WOUT + (size_t)(j - 26) * SZ_WOUT); K = D; N = D; }
            else if (j < 30) { src = p.in[15] + (size_t)(j - 28) * D * HYW; dst = (bf16_t*)(p.ws + WS_HWIN + (size_t)(j - 28) * SZ_HWIN); K = D; N = HYW; }
            else { src = p.in[28] + (size_t)(j - 30) * D * D; dst = (bf16_t*)(p.ws + WS_HWOUT + (size_t)(j - 30) * SZ_WOUT); K = D; N = D; }
            const int ntn = N / 64; const int k0 = (tl / ntn) * 64, n0 = (tl % ntn) * 64;
            __syncthreads();
#pragma unroll
            for (int i = 0; i < 8; ++i) { const int k = i * 8 + (tid >> 6), n = tid & 63; tile[k * 65 + n] = src[(size_t)(k0 + k) * N + n0 + n]; }
            __syncthreads();
#pragma unroll
            for (int i = 0; i < 8; ++i) {
                const int n = i * 8 + (tid >> 6), k = tid & 63; const int gn = n0 + n;
                float v = tile[k * 65 + n];
                int row = gn;
                if (mode == 1) row = 256 * (gn >> 7) + (gn & 127);
                else if (mode == 2) row = 256 * (gn >> 7) + 128 + (gn & 127);
                else if (mode == 3) { if (gn < 512 || (gn >= 1792 && gn < 2304)) v *= 0.125f; }
                dst[(size_t)row * K + k0 + k] = f2bf(v);
            }
        }
        __syncthreads();
    }
    {
        float* sc = sm;
        float* red = sm + 5 * 1024;
        for (int i = tid; i < 5 * 1024; i += 512) { const int r = i >> 10, k = i & 1023; const float v = (r < 4) ? p.in[1][r * D + k] : p.in[3][k]; sc[i] = silu_f(v); }
        __syncthreads();
        const int w = tid >> 6, lane = tid & 63;
        for (int it = bid; it < 288; it += nb) {
            const int l = it / 72, c0 = (it % 72) * 128;
            const float* wm = p.in[4] + (size_t)l * D * (NMOD * D) + c0 + 2 * lane;
            float a[5][2];
#pragma unroll
            for (int r = 0; r < 5; ++r) { a[r][0] = 0.f; a[r][1] = 0.f; }
            for (int k = w * 128; k < w * 128 + 128; ++k) {
                const float2 wv = *(const float2*)(wm + (size_t)k * (NMOD * D));
#pragma unroll
                for (int r = 0; r < 5; ++r) { const float s = sc[r * 1024 + k]; a[r][0] += s * wv.x; a[r][1] += s * wv.y; }
            }
#pragma unroll
            for (int r = 0; r < 5; ++r) { red[(w * 5 + r) * 128 + 2 * lane] = a[r][0]; red[(w * 5 + r) * 128 + 2 * lane + 1] = a[r][1]; }
            __syncthreads();
            for (int i = tid; i < 5 * 128; i += 512) {
                const int r = i >> 7, c = i & 127; float s = 0.f;
#pragma unroll
                for (int ww = 0; ww < 8; ++ww) s += red[(ww * 5 + r) * 128 + c];
                s += p.in[5][(size_t)l * (NMOD * D) + c0 + c];
                ((float*)(p.ws + WS_MOD))[(size_t)(l * 5 + r) * (NMOD * D) + c0 + c] = s;
            }
            __syncthreads();
        }
    }
    {
        float* z = sm;
        float* a1 = sm + 16 * 36;
        float* a2 = a1 + 16 * 64;
        float* a3 = a2 + 16 * 64;
        float* tl = a3 + 16 * 64;
        const float HMAX = -4.605170185988091f / 0.3f, HMIN = -4.605170185988091f / 1.5f;
        for (int it = bid; it < 544; it += nb) {
            const int o = it / 272, r = it % 272;
            const int Lf = (r < 256) ? SEQ : CL; const int p0 = (r < 256) ? r * 16 : (r - 256) * 16;
            float* kf = (float*)(p.ws + WS_KF + (size_t)o * SZ_KF) + ((r < 256) ? (size_t)0 : (size_t)2 * SEQ * D);
            const float* f0 = p.in[19] + (size_t)o * 33 * 64; const float* fb0 = p.in[20] + o * 64;
            const float* f1 = p.in[21] + (size_t)o * 64 * 64; const float* fb1 = p.in[22] + o * 64;
            const float* f2 = p.in[23] + (size_t)o * 64 * 64; const float* fb2 = p.in[24] + o * 64;
            const float* f3 = p.in[25] + (size_t)o * 64 * 2048; const float* fq = p.in[26] + o * 64;
            __syncthreads();
            for (int idx = tid; idx < 16 * 33; idx += 512) {
                const int ps = idx / 33, f = idx % 33; const int i = p0 + ps;
                const float tlin = (float)i * (1.0f / (float)(Lf - 1));
                const float w = (6.283185307179586f * (float)i) / (float)Lf;
                float v;
                if (f == 0) { v = tlin; tl[ps] = tlin; }
                else { const int jj = (f - 1) & 15; const float fj = 1e-4f + (float)jj * ((15.0f - 1e-4f) / 15.0f); v = (f <= 16) ? cosf(fj * w) : -sinf(fj * w); }
                z[ps * 36 + f] = v;
            }
            __syncthreads();
            for (int idx = tid; idx < 16 * 64; idx += 512) { const int ps = idx >> 6, oc = idx & 63; float s = fb0[oc];
                for (int f = 0; f < 33; ++f) s += z[ps * 36 + f] * f0[f * 64 + oc];
                a1[idx] = sinf(fq[oc] * s); }
            __syncthreads();
            for (int idx = tid; idx < 16 * 64; idx += 512) { const int ps = idx >> 6, oc = idx & 63; float s = fb1[oc];
                for (int f = 0; f < 64; ++f) s += a1[ps * 64 + f] * f1[f * 64 + oc];
                a2[idx] = sinf(fq[oc] * s); }
            __syncthreads();
            for (int idx = tid; idx < 16 * 64; idx += 512) { const int ps = idx >> 6, oc = idx & 63; float s = fb2[oc];
                for (int f = 0; f < 64; ++f) s += a2[ps * 64 + f] * f2[f * 64 + oc];
                a3[idx] = sinf(fq[oc] * s); }
            __syncthreads();
            for (int q = 0; q < 4; ++q) {
                const int c = tid + 512 * q; const int dir = c >> 10, d = c & 1023;
                float acc[16];
#pragma unroll
                for (int ps = 0; ps < 16; ++ps) acc[ps] = 0.f;
                for (int f = 0; f < 64; ++f) { const float wv = f3[f * 2048 + c];
#pragma unroll
                    for (int ps = 0; ps < 16; ++ps) acc[ps] += a3[ps * 64 + f] * wv; }
                const float delta = fabsf(HMIN + (float)d * ((HMAX - HMIN) / 1023.0f));
#pragma unroll
                for (int ps = 0; ps < 16; ++ps) {
                    const float kvv = acc[ps] * expf(-tl[ps] * delta);
                    if (r < 256) {
                        bf16_t* rk = (bf16_t*)(p.ws + WS_KF + (size_t)o * SZ_KF) + (size_t)d * 8192;
                        const int m = p0 + ps;
                        if (dir == 0) rk[4095 - m] = f2bf(kvv); else if (m > 0) rk[4095 + m] = f2bf(kvv);
                        if (dir == 0 && m == 0) rk[8191] = 0;
                    } else kf[((size_t)dir * Lf + p0 + ps) * D + d] = kvv;
                }
            }
        }
        __syncthreads();
    }
}

__device__ void rowphase(const KP& p, int Mupd, const float* Y, int lu, int gidx, float wgt, const float* gpost,
                         int Mnext, int ln, const float* gpre, int shidx, int scidx, bf16_t* Hout) {
    const int tid = ltid(), w = tid >> 6, lane = tid & 63;
    const int Mmax = Mupd > Mnext ? Mupd : Mnext;
    for (int t = blockIdx.x * 8 + w; t < Mmax; t += gridDim.x * 8) {
        float* xr = xrow(p, t); const int mr = modrow(t);
        float4 xv[4];
#pragma unroll
        for (int q = 0; q < 4; ++q) xv[q] = *(const float4*)(xr + q * 256 + lane * 4);
        if (Y != nullptr && t < Mupd) {
            float4 yv[4]; float ss = 0.f;
#pragma unroll
            for (int q = 0; q < 4; ++q) { yv[q] = *(const float4*)(Y + (size_t)t * D + q * 256 + lane * 4); ss += yv[q].x * yv[q].x + yv[q].y * yv[q].y + yv[q].z * yv[q].z + yv[q].w * yv[q].w; }
            ss = wave_sum(ss);
            const float r = rsqrtf(ss * (1.0f / D) + EPS) * wgt;
            const float* gm = modp(p, lu, mr, gidx);
#pragma unroll
            for (int q = 0; q < 4; ++q) {
                const float4 g4 = *(const float4*)(gm + q * 256 + lane * 4); const float4 p4 = *(const float4*)(gpost + q * 256 + lane * 4);
                xv[q].x += r * g4.x * yv[q].x * p4.x; xv[q].y += r * g4.y * yv[q].y * p4.y; xv[q].z += r * g4.z * yv[q].z * p4.z; xv[q].w += r * g4.w * yv[q].w * p4.w;
                *(float4*)(xr + q * 256 + lane * 4) = xv[q];
            }
        }
        if (Hout != nullptr && t < Mnext) {
            float ss = 0.f;
#pragma unroll
            for (int q = 0; q < 4; ++q) ss += xv[q].x * xv[q].x + xv[q].y * xv[q].y + xv[q].z * xv[q].z + xv[q].w * xv[q].w;
            ss = wave_sum(ss);
            const float r = rsqrtf(ss * (1.0f / D) + EPS);
            const float* sh = modp(p, ln, mr, shidx); const float* sc = modp(p, ln, mr, scidx);
#pragma unroll
            for (int q = 0; q < 4; ++q) {
                const float4 g4 = *(const float4*)(gpre + q * 256 + lane * 4); const float4 s4 = *(const float4*)(sc + q * 256 + lane * 4); const float4 h4 = *(const float4*)(sh + q * 256 + lane * 4);
                const float h0 = xv[q].x * r * g4.x * (1.0f + s4.x) + h4.x, h1 = xv[q].y * r * g4.y * (1.0f + s4.y) + h4.y;
                const float h2 = xv[q].z * r * g4.z * (1.0f + s4.z) + h4.z, h3 = xv[q].w * r * g4.w * (1.0f + s4.w) + h4.w;
                uint2 pk; pk.x = (unsigned)f2bf(h0) | ((unsigned)f2bf(h1) << 16); pk.y = (unsigned)f2bf(h2) | ((unsigned)f2bf(h3) << 16);
                *(uint2*)(Hout + (size_t)t * D + q * 256 + lane * 4) = pk;
            }
        }
    }
}

__device__ __forceinline__ float log_sigmoid(float x) { return -log1pf(expf(-x)); }
__device__ __forceinline__ int chunk_t0(int b, int cidx) { return cidx < 32 ? b * SEQ + cidx * 128 : TL + b * CL + (cidx - 32) * 128; }

__device__ void m1_rope_states(const KP& p, int e, float* sm) {
    const int tid = ltid(), bid = blockIdx.x, nb = gridDim.x;
    bf16_t* Z = (bf16_t*)(p.ws + WS_BIG);
    const float* rope = (const float*)(p.ws + WS_ROPE);
    for (int idx = bid * 512 + tid; idx < TL * 576; idx += nb * 512) {
        const int t = idx / 576, r = idx % 576; const int hd = r >> 5, i = r & 31;
        const int cb = hd < 16 ? hd * 64 : 1536 + (hd - 16) * 64;
        const int tb = (hd >= 8 && hd < 16) ? 2 : 0; const int pos = t & (SEQ - 1);
        const float c = rope[(size_t)tb * SEQ * 32 + pos * 32 + i], s = rope[(size_t)(tb + 1) * SEQ * 32 + pos * 32 + i];
        bf16_t* zp = Z + (size_t)t * INW + cb + i;
        const float x1 = bf2f(zp[0]), x2 = bf2f(zp[32]);
        zp[0] = f2bf(x1 * c - x2 * s); zp[32] = f2bf(x1 * s + x2 * c);
    }
    float* Ks = sm;
    float* Vs = sm + 128 * 64;
    float* wf = Vs + 128 * 64;
    float* wb = wf + 128;
    float* AF = (float*)(p.ws + WS_ST); float* AB = AF + SZ_ST / 4;
    const float* dec = p.in[13] + e * 16;
    for (int it = bid; it < NB * NCH * 8; it += nb) {
        const int h = it & 7, cidx = (it >> 3) % NCH, b = it / (8 * NCH);
        const int t0 = chunk_t0(b, cidx); const bool lat = cidx < 32;
        const float lgf = log_sigmoid(dec[h]), lgb = log_sigmoid(dec[8 + h]);
        __syncthreads();
        if (tid < 128) { wf[tid] = expf(lgf * (float)(127 - tid)); wb[tid] = expf(lgb * (float)tid); }
        const int kc = 1792 + h * 64, vc = 2304 + h * 64;
#pragma unroll
        for (int q = 0; q < 8; ++q) {
            const int idx = tid + 512 * q; const int r = idx >> 5, i = idx & 31;
            bf16_t* zp = Z + (size_t)(t0 + r) * INW + kc + i;
            float x1 = bf2f(zp[0]), x2 = bf2f(zp[32]);
            if (lat) {
                const int pos = (t0 + r) & (SEQ - 1);
                const float c = rope[(size_t)2 * SEQ * 32 + pos * 32 + i], s = rope[(size_t)3 * SEQ * 32 + pos * 32 + i];
                const bf16_t o1 = f2bf(x1 * c - x2 * s), o2 = f2bf(x1 * s + x2 * c);
                zp[0] = o1; zp[32] = o2; x1 = bf2f(o1); x2 = bf2f(o2);
            }
            Ks[r * 64 + i] = x1; Ks[r * 64 + 32 + i] = x2;
        }
#pragma unroll
        for (int q = 0; q < 16; ++q) { const int idx = tid + 512 * q; const int r = idx >> 6, c = idx & 63; Vs[idx] = bf2f(Z[(size_t)(t0 + r) * INW + vc + c]); }
        __syncthreads();
        const int d = tid >> 3, e0 = (tid & 7) * 8;
        float af[8], ab[8];
#pragma unroll
        for (int j = 0; j < 8; ++j) { af[j] = 0.f; ab[j] = 0.f; }
        for (int s = 0; s < 128; ++s) {
            const float kv = Ks[s * 64 + d]; const float kfw = kv * wf[s], kbw = kv * wb[s];
            const float4 v0 = *(const float4*)(Vs + s * 64 + e0), v1 = *(const float4*)(Vs + s * 64 + e0 + 4);
            af[0] += kfw * v0.x; af[1] += kfw * v0.y; af[2] += kfw * v0.z; af[3] += kfw * v0.w; af[4] += kfw * v1.x; af[5] += kfw * v1.y; af[6] += kfw * v1.z; af[7] += kfw * v1.w;
            ab[0] += kbw * v0.x; ab[1] += kbw * v0.y; ab[2] += kbw * v0.z; ab[3] += kbw * v0.w; ab[4] += kbw * v1.x; ab[5] += kbw * v1.y; ab[6] += kbw * v1.z; ab[7] += kbw * v1.w;
        }
        const size_t so = ((size_t)(b * NCH + cidx) * 8 + h) * 4096 + d * 64 + e0;
        *(float4*)(AF + so) = make_float4(af[0], af[1], af[2], af[3]); *(float4*)(AF + so + 4) = make_float4(af[4], af[5], af[6], af[7]);
        *(float4*)(AB + so) = make_float4(ab[0], ab[1], ab[2], ab[3]); *(float4*)(AB + so + 4) = make_float4(ab[4], ab[5], ab[6], ab[7]);
    }
    __syncthreads();
}

__device__ void m2_scan(const KP& p, int e) {
    float* AF = (float*)(p.ws + WS_ST); float* AB = AF + SZ_ST / 4; float* TF = AB + SZ_ST / 4; float* TB = TF + SZ_ST / 4;
    const float* dec = p.in[13] + e * 16;
    for (int idx = blockIdx.x * 512 + ltid(); idx < NB * 8 * 4096; idx += gridDim.x * 512) {
        const int el = idx & 4095, h = (idx >> 12) & 7, b = idx >> 15;
        const float gf = expf(log_sigmoid(dec[h]) * 128.0f), gb = expf(log_sigmoid(dec[8 + h]) * 128.0f);
#define SIDX(c) (((size_t)(b * NCH + (c)) * 8 + h) * 4096 + el)
        const float afc0 = AF[SIDX(32)], afc1 = AF[SIDX(33)], abc0 = AB[SIDX(32)], abc1 = AB[SIDX(33)];
        TF[SIDX(32)] = 0.f; TF[SIDX(33)] = afc0; TB[SIDX(33)] = 0.f; TB[SIDX(32)] = abc1;
        float sf = gf * afc0 + afc1, sb = abc0 + gb * abc1;
        for (int c = 0; c < 32; ++c) { TF[SIDX(c)] = sf; sf = gf * sf + AF[SIDX(c)]; }
        for (int c = 31; c >= 0; --c) { TB[SIDX(c)] = sb; sb = AB[SIDX(c)] + gb * sb; }
#undef SIDX
    }
}

__device__ void m3_outputs(const KP& p, int e, bool ctx_full, float* sm) {
    const int tid = ltid(), bid = blockIdx.x, nb = gridDim.x;
    const bf16_t* Z = (const bf16_t*)(p.ws + WS_BIG);
    bf16_t* MIX = (bf16_t*)(p.ws + WS_MIX);
    const float* dec = p.in[13] + e * 16;
    const float* sink = p.in[12] + e * 8;
    const float* TF = (const float*)(p.ws + WS_ST) + 2 * (SZ_ST / 4); const float* TB = TF + SZ_ST / 4;
    const int nchunk = ctx_full ? NCH : 32;
    const int nitems = NB * nchunk * 8;
    for (int it = bid; it < 2 * nitems; it += nb) {
        const bool is_attn = it >= nitems; const int ii = is_attn ? it - nitems : it;
        const int h = ii & 7, cidx = (ii >> 3) % nchunk, b = ii / (8 * nchunk);
        const int t0 = chunk_t0(b, cidx); const bool lat = cidx < 32;
        const int i = tid >> 2, sub = tid & 3;
        __syncthreads();
        if (!is_attn) {
            float* Qs = sm; float* Ks = Qs + 8192; float* Vs = Ks + 8192; float* Tf = Vs + 8192; float* Tb = Tf + 4096; float* pf = Tb + 4096; float* pb = pf + 132;
            const float lgf = log_sigmoid(dec[h]), lgb = log_sigmoid(dec[8 + h]);
            if (tid < 129) { pf[tid] = expf(lgf * (float)tid); pb[tid] = expf(lgb * (float)tid); }
#pragma unroll
            for (int q = 0; q < 16; ++q) { const int idx = tid + 512 * q; const int r = idx >> 6, c = idx & 63; const bf16_t* zr = Z + (size_t)(t0 + r) * INW + h * 64 + c;
                Qs[idx] = bf2f(zr[512]); Ks[idx] = bf2f(zr[1792]); Vs[idx] = bf2f(zr[2304]); }
            const size_t so = ((size_t)(b * NCH + cidx) * 8 + h) * 4096;
#pragma unroll
            for (int q = 0; q < 8; ++q) { const int idx = tid + 512 * q; Tf[idx] = TF[so + idx]; Tb[idx] = TB[so + idx]; }
            __syncthreads();
            float qv[16], o[16];
#pragma unroll
            for (int j = 0; j < 16; ++j) { qv[j] = Qs[i * 64 + sub * 16 + j]; o[j] = 0.f; }
            for (int s = 0; s < 128; ++s) {
                float part = 0.f;
#pragma unroll
                for (int j4 = 0; j4 < 4; ++j4) { const float4 kk = *(const float4*)(Ks + s * 64 + sub * 16 + j4 * 4);
                    part += qv[j4 * 4] * kk.x + qv[j4 * 4 + 1] * kk.y + qv[j4 * 4 + 2] * kk.z + qv[j4 * 4 + 3] * kk.w; }
                part += __shfl_xor(part, 1, 64); part += __shfl_xor(part, 2, 64);
                const float wgt = (s < i) ? pf[i - s] : ((s > i) ? pb[s - i] : 2.0f);
                const float a = part * wgt;
#pragma unroll
                for (int j4 = 0; j4 < 4; ++j4) { const float4 vv = *(const float4*)(Vs + s * 64 + sub * 16 + j4 * 4);
                    o[j4 * 4] += a * vv.x; o[j4 * 4 + 1] += a * vv.y; o[j4 * 4 + 2] += a * vv.z; o[j4 * 4 + 3] += a * vv.w; }
            }
            const float cf = pf[i + 1], cb = pb[128 - i];
            for (int d = 0; d < 64; ++d) {
                const float qd = Qs[i * 64 + d]; const float qf = qd * cf, qb = qd * cb;
#pragma unroll
                for (int j4 = 0; j4 < 4; ++j4) { const float4 tf = *(const float4*)(Tf + d * 64 + sub * 16 + j4 * 4); const float4 tb = *(const float4*)(Tb + d * 64 + sub * 16 + j4 * 4);
                    o[j4 * 4] += qf * tf.x + qb * tb.x; o[j4 * 4 + 1] += qf * tf.y + qb * tb.y; o[j4 * 4 + 2] += qf * tf.z + qb * tb.z; o[j4 * 4 + 3] += qf * tf.w + qb * tb.w; }
            }
            float ss = 0.f;
#pragma unroll
            for (int j = 0; j < 16; ++j) ss += o[j] * o[j];
            ss += __shfl_xor(ss, 1, 64); ss += __shfl_xor(ss, 2, 64);
            const float r = rsqrtf(ss * (1.0f / 64.0f) + EPS);
            const bf16_t* gr = Z + (size_t)(t0 + i) * INW + 1024 + h * 64 + sub * 16;
            bf16_t* mo = MIX + (size_t)(t0 + i) * D + 512 + h * 64 + sub * 16;
#pragma unroll
            for (int j = 0; j < 16; ++j) mo[j] = f2bf(o[j] * r * silu_f(bf2f(gr[j])));
        } else {
            float* Kt = sm; float* Vt = sm + 128 * 68;
            const int g = h >> 2;
            float qv[16], acc[16];
            {
                const bf16_t* qr = Z + (size_t)(t0 + i) * INW + h * 64 + sub * 16;
#pragma unroll
                for (int d = 0; d < 16; ++d) { qv[d] = bf2f(qr[d]); acc[d] = 0.f; }
            }
            float mx = sink[h], l = 1.0f;
            const int qpos = lat ? (cidx * 128 + i) : 0;
            for (int tl = 0; tl < 5; ++tl) {
                int kt0; int kp0 = 0; const bool isc = tl >= 3;
                if (!isc) { if (!lat) continue; const int kc = cidx - 1 + tl; if (kc < 0 || kc >= 32) continue; kt0 = b * SEQ + kc * 128; kp0 = kc * 128; }
                else kt0 = TL + b * CL + (tl - 3) * 128;
                __syncthreads();
#pragma unroll
                for (int q = 0; q < 16; ++q) { const int idx = tid + 512 * q; const int r = idx >> 6, c = idx & 63; const bf16_t* zr = Z + (size_t)(kt0 + r) * INW + g * 64 + c;
                    Kt[r * 68 + c] = bf2f(zr[1536]); Vt[r * 68 + c] = bf2f(zr[1664]); }
                __syncthreads();
                for (int j = 0; j < 128; ++j) {
                    float s = 0.f;
#pragma unroll
                    for (int d4 = 0; d4 < 4; ++d4) { const float4 kk = *(const float4*)(Kt + j * 68 + sub * 16 + d4 * 4);
                        s += qv[d4 * 4] * kk.x + qv[d4 * 4 + 1] * kk.y + qv[d4 * 4 + 2] * kk.z + qv[d4 * 4 + 3] * kk.w; }
                    s += __shfl_xor(s, 1, 64); s += __shfl_xor(s, 2, 64);
                    bool valid = true;
                    if (!isc) { const int dd = qpos - (kp0 + j); valid = (dd <= 128) && (dd >= -128); }
                    if (valid) {
                        if (s > mx) { const float sc = __expf(mx - s); l *= sc;
#pragma unroll
                            for (int d = 0; d < 16; ++d) acc[d] *= sc;
                            mx = s; }
                        const float pw = __expf(s - mx); l += pw;
#pragma unroll
                        for (int d4 = 0; d4 < 4; ++d4) { const float4 vv = *(const float4*)(Vt + j * 68 + sub * 16 + d4 * 4);
                            acc[d4 * 4] += pw * vv.x; acc[d4 * 4 + 1] += pw * vv.y; acc[d4 * 4 + 2] += pw * vv.z; acc[d4 * 4 + 3] += pw * vv.w; }
                    }
                }
            }
            const float inv = 1.0f / l;
            bf16_t* mo = MIX + (size_t)(t0 + i) * D + h * 64 + sub * 16;
#pragma unroll
            for (int d = 0; d < 16; ++d) mo[d] = f2bf(acc[d] * inv);
        }
    }
    __syncthreads();
}

__device__ void h2_shortconv(const KP& p, int o, int M, unsigned char* smem) {
    const int tid = ltid();
    const bf16_t* ZH = (const bf16_t*)(p.ws + WS_BIG);
    const float* w = p.in[17] + (size_t)o * 3 * HYW; const float* bs = p.in[18] + (size_t)o * HYW;
    bf16_t* VXT = (bf16_t*)(p.ws + WS_Y); bf16_t* X0T = VXT + (size_t)D * TL;
    bf16_t* tx = (bf16_t*)smem;
    bf16_t* tv = tx + 64 * 72;
    const int tok = tid >> 3, cg8 = (tid & 7) * 8;
    for (int it = blockIdx.x; it < (TL / 64) * 16; it += gridDim.x) {
        const int c0 = (it & 15) * 64, t0 = (it >> 4) * 64;
        const int t = t0 + tok; const int pos = t & (SEQ - 1); const bool first = pos == 0, last = pos == SEQ - 1;
        float zz[3][8];
#pragma unroll
        for (int k = 0; k < 3; ++k) {
            const int c = k * 1024 + c0 + cg8;
            const bf16x8 zc = *(const bf16x8*)(ZH + (size_t)t * HYW + c);
            bf16x8 zp = zc, zn = zc;
            if (!first) zp = *(const bf16x8*)(ZH + (size_t)(t - 1) * HYW + c);
            if (!last) zn = *(const bf16x8*)(ZH + (size_t)(t + 1) * HYW + c);
#pragma unroll
            for (int j = 0; j < 8; ++j) {
                float sacc = bs[c + j] + bf2f((bf16_t)zc[j]) * w[HYW + c + j];
                if (!first) sacc += bf2f((bf16_t)zp[j]) * w[c + j];
                if (!last) sacc += bf2f((bf16_t)zn[j]) * w[2 * HYW + c + j];
                zz[k][j] = sacc;
            }
        }
        __syncthreads();
#pragma unroll
        for (int j = 0; j < 8; ++j) { tx[(cg8 + j) * 72 + tok] = f2bf(zz[0][j]); tv[(cg8 + j) * 72 + tok] = f2bf(zz[2][j] * zz[1][j]); }
        __syncthreads();
        { const int ch = tid >> 3, tk = (tid & 7) * 8;
          *(u32x4*)(X0T + (size_t)(c0 + ch) * TL + t0 + tk) = *(const u32x4*)(tx + ch * 72 + tk);
          *(u32x4*)(VXT + (size_t)(c0 + ch) * TL + t0 + tk) = *(const u32x4*)(tv + ch * 72 + tk); }
    }
    __syncthreads();
    if (M > TL) {
        float* VX = (float*)(p.ws + WS_Y); bf16_t* X0 = (bf16_t*)(p.ws + WS_H);
        for (int idx = TL * D + blockIdx.x * 512 + tid; idx < M * D; idx += gridDim.x * 512) {
            const int t = idx >> 10, d = idx & 1023;
            const int pos = (t - TL) & (CL - 1); const bool first = pos == 0, last = pos == CL - 1;
            float zz[3];
#pragma unroll
            for (int k = 0; k < 3; ++k) {
                const int c = k * 1024 + d;
                float sacc = bs[c] + bf2f(ZH[(size_t)t * HYW + c]) * w[HYW + c];
                if (!first) sacc += bf2f(ZH[(size_t)(t - 1) * HYW + c]) * w[c];
                if (!last) sacc += bf2f(ZH[(size_t)(t + 1) * HYW + c]) * w[2 * HYW + c];
                zz[k] = sacc;
            }
            VX[idx] = zz[2] * zz[1]; X0[idx] = f2bf(zz[0]);
        }
    }
}

typedef float f32x16 __attribute__((ext_vector_type(16)));
__device__ void h3_longconv(const KP& p, int o, bool ctx_full, unsigned char* smem) {
    const int tid = ltid(), w = tid >> 6, lane = tid & 63;
    const float* bias = p.in[27] + (size_t)o * D;
    {
        const bf16_t* VXT = (const bf16_t*)(p.ws + WS_Y); const bf16_t* X0T = VXT + (size_t)D * TL;
        bf16_t* HMT = (bf16_t*)(p.ws + WS_H);
        const bf16_t* RKT = (const bf16_t*)(p.ws + WS_KF + (size_t)o * SZ_KF);
        constexpr int RK2_OFF = 16384 + 64, U_OFF = 2 * 16384 + 128, CH_BYTES = U_OFF + 142 * 256;
        const int cw = w >> 2, w4 = w & 3;
        const int ct = tid & 255;
        unsigned char* cb = smem + cw * CH_BYTES;
        const int r = lane & 31, hh = lane >> 5;
        for (int pr = blockIdx.x; pr < D / 2; pr += gridDim.x) {
            const int d = pr * 2 + cw;
            __syncthreads();
            { const bf16_t* src = RKT + (size_t)d * 8192;
              for (int i = ct; i < 1024; i += 256) *(u32x4*)(cb + i * 16) = *(const u32x4*)(src + i * 8);
              bf16_t* rk2 = (bf16_t*)(cb + RK2_OFF);
              for (int i = ct; i < 4096; i += 256) { const unsigned lo = src[2 * i + 1]; const unsigned hi = (2 * i + 2 < 8192) ? src[2 * i + 2] : 0u; *(unsigned*)(rk2 + 2 * i) = lo | (hi << 16); }
              unsigned char* ub = cb + U_OFF;
              for (int i = ct; i < 2 * 7 * 4 * 4; i += 256) { const int side = i / 112, rem = i % 112; *(u32x4*)(ub + (side ? (135 * 4 * 64) : 0) + rem * 16) = (u32x4){0u, 0u, 0u, 0u}; }
              for (int i = ct; i < 4 * 512; i += 256) { const int b = i >> 9, pc = i & 511;
                  const u32x4 v = *(const u32x4*)(VXT + (size_t)d * TL + b * SEQ + pc * 8);
                  const int chunk = pc >> 2, m0 = (pc & 3) * 8;
                  *(u32x4*)(ub + ((chunk + 7) * 4 + b) * 64 + m0 * 2) = v; } }
            __syncthreads();
            f32x16 acc[4];
#pragma unroll
            for (int j = 0; j < 4; ++j)
#pragma unroll
                for (int q = 0; q < 16; ++q) acc[j][q] = 0.f;
            const unsigned char* ub = cb + U_OFF;
            const bf16_t* rsel = (const bf16_t*)(cb + ((r & 1) ? 0 : RK2_OFF));
            const int adj = (r & 1) ? 0 : -1;
            for (int dl = 32 * w4 - 127; dl <= 32 * w4 + 31; ++dl) {
                bf16x8 af[2];
#pragma unroll
                for (int s = 0; s < 2; ++s) {
                    const int e0 = 4095 - 32 * dl - r + 16 * s + 8 * hh + adj;
                    const unsigned* ap = (const unsigned*)(rsel + e0);
                    u32x4 t4; t4.x = ap[0]; t4.y = ap[1]; t4.z = ap[2]; t4.w = ap[3];
                    af[s] = __builtin_bit_cast(bf16x8, t4);
                }
#pragma unroll
                for (int j = 0; j < 4; ++j) {
                    const int J = 4 * w4 + j;
                    if (8 * J + 7 - dl < 0 || 8 * J - dl > 127) continue;
                    const int n1 = 8 * J + (r >> 2), b = r & 3;
                    const unsigned char* bp = ub + ((n1 - dl + 7) * 4 + b) * 64 + hh * 16;
                    const bf16x8 b0 = *(const bf16x8*)(bp), b1 = *(const bf16x8*)(bp + 32);
                    acc[j] = __builtin_amdgcn_mfma_f32_32x32x16_bf16(af[0], b0, acc[j], 0, 0, 0);
                    acc[j] = __builtin_amdgcn_mfma_f32_32x32x16_bf16(af[1], b1, acc[j], 0, 0, 0);
                }
            }
            const float bd = bias[d];
#pragma unroll
            for (int j = 0; j < 4; ++j) {
                const int n1 = 8 * (4 * w4 + j) + (r >> 2), b = r & 3;
                const bf16_t* up = (const bf16_t*)(ub + ((n1 + 7) * 4 + b) * 64);
                const size_t gb = (size_t)d * TL + b * SEQ + n1 * 32;
#pragma unroll
                for (int q = 0; q < 16; ++q) {
                    const int row = (q & 3) + 8 * (q >> 2) + 4 * hh;
                    const float y = acc[j][q] + bd * bf2f(up[row]);
                    HMT[gb + row] = f2bf(bf2f(X0T[gb + row]) * y);
                }
            }
        }
        __syncthreads();
    }
    if (ctx_full) {
        const float* VX = (const float*)(p.ws + WS_Y); const bf16_t* X0 = (const bf16_t*)(p.ws + WS_H);
        bf16_t* MIX = (bf16_t*)(p.ws + WS_MIX);
        for (int it = blockIdx.x; it < NB * 2 * 16; it += gridDim.x) {
            const int dbk = it & 15, nbk = (it >> 4) & 1, b = it >> 5; const int Lf = CL, tb = TL + b * CL;
            const float* kf = (const float*)(p.ws + WS_KF + (size_t)o * SZ_KF) + (size_t)2 * SEQ * D;
            const int d = dbk * 64 + lane; const int n0 = nbk * 128 + w * 16;
            const float* kfd = kf + d; const float* kbd = kf + (size_t)Lf * D + d;
            float acc[16];
#pragma unroll
            for (int j = 0; j < 16; ++j) acc[j] = 0.f;
            for (int mb = 0; mb < Lf; mb += 16) {
                const int lag0 = n0 - mb;
                float kk[31], uu[16];
#pragma unroll
                for (int q = 0; q < 31; ++q) { const int lag = lag0 - 15 + q; float v = 0.f;
                    if (lag >= 0) { if (lag < Lf) v = kfd[(size_t)lag * D]; } else { if (-lag < Lf) v = kbd[(size_t)(-lag) * D]; }
                    kk[q] = v; }
#pragma unroll
                for (int u = 0; u < 16; ++u) uu[u] = VX[(size_t)(tb + mb + u) * D + d];
#pragma unroll
                for (int u = 0; u < 16; ++u)
#pragma unroll
                    for (int j = 0; j < 16; ++j) acc[j] += uu[u] * kk[15 - u + j];
            }
            const float bd = bias[d];
#pragma unroll
            for (int j = 0; j < 16; ++j) { const size_t ti = (size_t)(tb + n0 + j) * D + d; MIX[ti] = f2bf(bf2f(X0[ti]) * (acc[j] + bd * VX[ti])); }
        }
    }
}

__device__ void h3b_transpose(const KP& p, unsigned char* smem) {
    const int tid = ltid();
    const bf16_t* HMT = (const bf16_t*)(p.ws + WS_H); bf16_t* MIX = (bf16_t*)(p.ws + WS_MIX);
    bf16_t* tile = (bf16_t*)smem;
    for (int it = blockIdx.x; it < (TL / 64) * 16; it += gridDim.x) {
        const int c0 = (it & 15) * 64, t0 = (it >> 4) * 64;
        __syncthreads();
        { const int ch = tid >> 3, tk = (tid & 7) * 8; *(u32x4*)(tile + ch * 72 + tk) = *(const u32x4*)(HMT + (size_t)(c0 + ch) * TL + t0 + tk); }
        __syncthreads();
        { const int tok = tid >> 3, cg8 = (tid & 7) * 8; unsigned short v[8];
#pragma unroll
          for (int j = 0; j < 8; ++j) v[j] = tile[(cg8 + j) * 72 + tok];
          u32x4 o4; o4.x = v[0] | ((unsigned)v[1] << 16); o4.y = v[2] | ((unsigned)v[3] << 16); o4.z = v[4] | ((unsigned)v[5] << 16); o4.w = v[6] | ((unsigned)v[7] << 16);
          *(u32x4*)(MIX + (size_t)(t0 + tok) * D + c0 + cg8) = o4; }
    }
    __syncthreads();
}

__global__ void __launch_bounds__(512, 2) mega_fwd(KP p) {
    extern __shared__ __attribute__((aligned(16))) unsigned char smem[];
    cg::grid_group grid = cg::this_grid();
    float* smf = (float*)smem;
    bf16_t* Hb = (bf16_t*)(p.ws + WS_H); bf16_t* BIG = (bf16_t*)(p.ws + WS_BIG); float* Y = (float*)(p.ws + WS_Y); bf16_t* MIX = (bf16_t*)(p.ws + WS_MIX);
    const float* npre = p.in[6]; const float* npost = p.in[7];

#ifndef NO_P0
    p0_setup(p, smf);
#endif
    grid.sync();
    rowphase(p, 0, nullptr, 0, 0, 0.f, nullptr, T, 0, npre, 0, 1, Hb);
    grid.sync();
    for (int l = 0; l < 4; ++l) {
        const bool ctx_live = l <= 2, ctx_full = l < 2;
        const int Mff = ctx_live ? T : TL, Mpost = ctx_full ? T : TL;
        for (int sub = 0; sub < 3; ++sub) {
            if (sub != 1) {
                const int fi = sub >> 1; const int M = (sub == 0) ? Mff : Mpost;
                { pg8::EpiSwiGLU E{BIG, DFF}; run_gemm(smem, Hb, (const bf16_t*)(p.ws + WS_WGU + (size_t)(l * 2 + fi) * SZ_WGU), M, 2 * DFF, D, E); }
                grid.sync();
                { pg8::EpiF32 E{Y, D}; run_gemm(smem, BIG, (const bf16_t*)(p.ws + WS_WD + (size_t)(l * 2 + fi) * SZ_WD), M, D, DFF, E); }
                grid.sync();
                if (sub == 0) rowphase(p, M, Y, l, 2, 0.5f, npost + (size_t)(l * 3 + 0) * D, Mff, l, npre + (size_t)(l * 3 + 1) * D, 3, 4, Hb);
                else {
                    const int ln = l + 1; const int Mn = (ln < 4) ? ((ln <= 2) ? T : TL) : 0;
                    rowphase(p, M, Y, l, 8, 0.5f, npost + (size_t)(l * 3 + 2) * D, Mn, ln < 4 ? ln : l, npre + (size_t)((ln < 4 ? ln : l) * 3 + 0) * D, 0, 1, ln < 4 ? Hb : nullptr);
                }
                grid.sync();
            } else {
                if ((l & 1) == 0) {
                    const int e = l >> 1;
                    { pg8::EpiBf16 E{BIG, INW, nullptr}; run_gemm(smem, Hb, (const bf16_t*)(p.ws + WS_WIN + (size_t)e * SZ_WIN), Mff, INW, D, E); }
                    grid.sync();
#ifndef NO_M1
                    m1_rope_states(p, e, smf);
#endif
                    grid.sync();
#ifndef NO_M2
                    m2_scan(p, e);
#endif
                    grid.sync();
#ifndef NO_M3
                    m3_outputs(p, e, ctx_full, smf);
#endif
                    grid.sync();
                    { pg8::EpiF32 E{Y, D}; run_gemm(smem, MIX, (const bf16_t*)(p.ws + WS_WOUT + (size_t)e * SZ_WOUT), Mpost, D, D, E); }
                    grid.sync();
                } else {
                    const int o = l >> 1;
                    { pg8::EpiBf16 E{BIG, HYW, p.in[16] + (size_t)o * HYW}; run_gemm(smem, Hb, (const bf16_t*)(p.ws + WS_HWIN + (size_t)o * SZ_HWIN), Mpost, HYW, D, E); }
                    grid.sync();
#ifndef NO_H2
                    h2_shortconv(p, o, Mpost, smem);
#endif
                    grid.sync();
#ifndef NO_H3
                    h3_longconv(p, o, ctx_full, smem);
#endif
                    grid.sync();
                    h3b_transpose(p, smem);
                    grid.sync();
                    { pg8::EpiF32 E{Y, D}; run_gemm(smem, MIX, (const bf16_t*)(p.ws + WS_HWOUT + (size_t)o * SZ_WOUT), Mpost, D, D, E); }
                    grid.sync();
                }
                rowphase(p, Mpost, Y, l, 5, 1.0f, npost + (size_t)(l * 3 + 1) * D, Mpost, l, npre + (size_t)(l * 3 + 2) * D, 6, 7, Hb);
                grid.sync();
            }
        }
    }
}

extern "C" void kernel_launch(void* const* d_in, const int* in_sizes, int n_in, void* d_out, int out_size, void* d_ws, size_t ws_size, hipStream_t stream) {
    static int grid = 0;
    if (grid == 0) {
        if (n_in != 29 || out_size != TL * D || ws_size < WS_END) { fprintf(stderr, "kernel_launch: unexpected shapes: n_in %d out %d ws %zu (need %zu)\n", n_in, out_size, ws_size, (size_t)WS_END); grid = -1; return; }
        int dev = 0, cus = 0, per_cu = 0;
        (void)hipGetDevice(&dev);
        (void)hipDeviceGetAttribute(&cus, hipDeviceAttributeMultiprocessorCount, dev);
        if (hipFuncSetAttribute((const void*)mega_fwd, hipFuncAttributeMaxDynamicSharedMemorySize, LDS_BYTES) != hipSuccess) { fprintf(stderr, "kernel_launch: hipFuncSetAttribute failed\n"); grid = -1; return; }
        if (hipOccupancyMaxActiveBlocksPerMultiprocessor(&per_cu, (const void*)mega_fwd, 512, LDS_BYTES) != hipSuccess || per_cu < 1) { fprintf(stderr, "kernel_launch: occupancy query says %d\n", per_cu); per_cu = 1; }
        (void)hipGetLastError();
        grid = cus;
    }
    if (grid < 0) return;
    KP kp{};
    for (int i = 0; i < 29; ++i) kp.in[i] = (const float*)d_in[i];
    kp.out = (float*)d_out; kp.ws = (unsigned char*)d_ws;
    void* args[] = {&kp};
    hipError_t e = hipLaunchCooperativeKernel((const void*)mega_fwd, dim3(grid), dim3(512), args, LDS_BYTES, stream);
    if (e != hipSuccess) fprintf(stderr, "cooperative launch failed: %s (grid %d)\n", hipGetErrorString(e), grid);
}
```

```cpp
#include <hip/hip_runtime.h>
#include <hip/hip_cooperative_groups.h>
#include <cstdio>
namespace cg = cooperative_groups;

#define LAS __attribute__((address_space(3)))
typedef unsigned short bf16_t;
typedef short bf16x8 __attribute__((ext_vector_type(8)));
typedef float f32x4 __attribute__((ext_vector_type(4)));
typedef unsigned u32x4 __attribute__((ext_vector_type(4)));

constexpr int D = 1024, NB = 4, SEQ = 4096, CL = 256, TL = NB * SEQ, TC = NB * CL, T = TL + TC, DFF = 2816, INW = 2816, HYW = 3072;
constexpr int NMOD = 9;
constexpr float EPS = 1e-6f;
constexpr int NCH = 34;
constexpr int LDS_BYTES = 144 * 1024;

constexpr size_t SZ_WGU = (size_t)2 * DFF * D * 2, SZ_WD = (size_t)D * DFF * 2, SZ_WIN = (size_t)INW * D * 2, SZ_WOUT = (size_t)D * D * 2, SZ_HWIN = (size_t)HYW * D * 2;
constexpr size_t WS_WGU = 0;
constexpr size_t WS_WD = WS_WGU + 8 * SZ_WGU;
constexpr size_t WS_WIN = WS_WD + 8 * SZ_WD;
constexpr size_t WS_WOUT = WS_WIN + 2 * SZ_WIN;
constexpr size_t WS_HWIN = WS_WOUT + 2 * SZ_WOUT;
constexpr size_t WS_HWOUT = WS_HWIN + 2 * SZ_HWIN;
constexpr size_t WS_MOD = WS_HWOUT + 2 * SZ_WOUT;
constexpr size_t WS_ROPE = WS_MOD + (size_t)4 * 5 * NMOD * D * 4;
constexpr size_t WS_XC = WS_ROPE + (size_t)4 * SEQ * 32 * 4;
constexpr size_t WS_H = WS_XC + (size_t)TC * D * 4;
constexpr size_t WS_BIG = WS_H + (size_t)T * D * 2;
constexpr size_t WS_Y = WS_BIG + (size_t)T * HYW * 2;
constexpr size_t WS_MIX = WS_Y + (size_t)T * D * 4;
constexpr size_t SZ_ST = (size_t)NB * NCH * 8 * 4096 * 4;
constexpr size_t WS_ST = WS_MIX + (size_t)T * D * 2;
constexpr size_t SZ_KF = (size_t)(SEQ + CL) * 2 * D * 4;
constexpr size_t WS_KF = WS_ST + 4 * SZ_ST;
constexpr size_t WS_BAR = WS_KF + 2 * SZ_KF;
constexpr size_t WS_END = WS_BAR + 16384;

struct KP { const float* in[29]; float* out; unsigned char* ws; };

__device__ __forceinline__ bf16_t f2bf(float f) { unsigned u = __float_as_uint(f); u += 0x7FFFu + ((u >> 16) & 1u); return (bf16_t)(u >> 16); }
__device__ __forceinline__ float bf2f(bf16_t b) { return __uint_as_float(((unsigned)b) << 16); }
__device__ __forceinline__ float silu_f(float x) { return x / (1.0f + __expf(-x)); }
__device__ __forceinline__ int ltid() { int t = threadIdx.x; asm volatile("" : "+v"(t)); return t; }
__device__ __forceinline__ float wave_sum(float v) {
#pragma unroll
    for (int o = 32; o > 0; o >>= 1) v += __shfl_xor(v, o, 64);
    return v;
}


#define XB_TMO      128
#define XB_XCNT(j)  (256  + 64 * (j))
#define XB_XSUB(j)  (1280 + 64 * (j))
#define XB_XGEN(j)  (2304 + 64 * (j))
#define XB_TOP      3328
#define XB_TOPGEN   3392
#define XCD_BAR_WORDS 3456
#define XB_SPIN_CAP (1u << 18)
__device__ __forceinline__ unsigned xb_ld(unsigned* p)              { return __hip_atomic_load(p, __ATOMIC_RELAXED, __HIP_MEMORY_SCOPE_AGENT); }
__device__ __forceinline__ unsigned xb_add(unsigned* p, unsigned v) { return __hip_atomic_fetch_add(p, v, __ATOMIC_RELAXED, __HIP_MEMORY_SCOPE_AGENT); }
__device__ __forceinline__ unsigned xb_xcc_id() { return (unsigned)__builtin_amdgcn_s_getreg((3 << 11) | 20) & 0xFu; }
#define XB_SPIN(cond, bar) do { unsigned _sp = 0; while (cond) { __builtin_amdgcn_s_sleep(1); \
    if ((++_sp & 255u) == 0u) { if (xb_ld(&(bar)[XB_TMO])) break; if (_sp > XB_SPIN_CAP) { atomicAdd(&(bar)[XB_TMO], 1u); break; } } } } while (0)
struct XcdBarrier { unsigned* bar; unsigned x; volatile LAS unsigned* st; };
__device__ __forceinline__ XcdBarrier xcd_barrier_post(unsigned* bar, volatile LAS unsigned* st) {
    XcdBarrier b; b.bar = bar; b.x = xb_xcc_id(); b.st = st;
    if (threadIdx.x == 0) (void)xb_add(&bar[XB_XCNT(b.x)], 1u);
    return b;
}
__device__ __forceinline__ void xcd_barrier_complete(unsigned* bar, unsigned x, unsigned& nloc, unsigned& nx) {
    const unsigned G = gridDim.x * gridDim.y * gridDim.z;
    unsigned sum, cnt, mine, sp = 0u;
    for (;;) {
        sum = 0u; cnt = 0u; mine = 0u;
#pragma unroll
        for (unsigned j = 0; j < 16; ++j) { const unsigned c = xb_ld(&bar[XB_XCNT(j)]); sum += c; cnt += (c > 0u) ? 1u : 0u; mine = (j == x) ? c : mine; }
        if (sum == G) break;
        __builtin_amdgcn_s_sleep(1);
        if ((++sp & 255u) == 0u) { if (xb_ld(&bar[XB_TMO])) break; if (sp > XB_SPIN_CAP) { atomicAdd(&bar[XB_TMO], 1u); break; } }
    }
    nloc = mine > 0u ? mine : 1u; nx = cnt > 0u ? cnt : 1u;
}
__device__ __forceinline__ void xcd_barrier_impl(unsigned* bar, volatile LAS unsigned* st) {
    asm volatile("s_waitcnt vmcnt(0)" ::: "memory");
    __syncthreads();
    if (ltid() == 0) {
        const unsigned x = xb_xcc_id();
        __builtin_amdgcn_s_waitcnt(0);
        unsigned nloc = st[0], nx = st[1];
        if (nloc == 0u) { xcd_barrier_complete(bar, x, nloc, nx); st[0] = nloc; st[1] = nx; }
        const unsigned old = xb_add(&bar[XB_XSUB(x)], 1u);
        const unsigned gen = old / nloc;
        if (old + 1u == (gen + 1u) * nloc) {
            __builtin_amdgcn_fence(__ATOMIC_RELEASE, "agent");
            asm volatile("s_waitcnt vmcnt(0)" ::: "memory");
            const unsigned og = xb_add(&bar[XB_TOP], 1u);
            const unsigned tg = og / nx;
            if (og + 1u == (tg + 1u) * nx) xb_add(&bar[XB_TOPGEN], 1u);
            else XB_SPIN(xb_ld(&bar[XB_TOPGEN]) == tg, bar);
            __builtin_amdgcn_fence(__ATOMIC_ACQUIRE, "agent");
            xb_add(&bar[XB_XGEN(x)], 1u);
            asm volatile("s_waitcnt vmcnt(0)" ::: "memory");
        } else {
            XB_SPIN(xb_ld(&bar[XB_XGEN(x)]) == gen, bar);
            __builtin_amdgcn_fence(__ATOMIC_ACQUIRE, "agent");
            asm volatile("s_waitcnt vmcnt(0)" ::: "memory");
        }
    }
    __syncthreads();
}
#define GRID_BAR() xcd_barrier_impl((unsigned*)(p.ws + WS_BAR), (volatile LAS unsigned*)((LAS unsigned char*)smem + LDS_BYTES - 16))

namespace pg8 {
constexpr int BM = 256, BK = 64, HALF = 128, HTB = HALF * BK * 2, STAGE_BYTES = 8 * HTB, NXCD = 8, WGM = 8;
__host__ __device__ __forceinline__ int lds_byte(int r, int c) { const int st = (r >> 4) * 2 + (c >> 5), rr = r & 15, cc = c & 31, ob = rr * 64 + cc * 2; return st * 1024 + (ob ^ (((ob >> 9) & 1) << 5)); }
__host__ __device__ __forceinline__ void stage_rc(int b, int& R, int& C) { const int st = b / 1024, sb = b % 1024, swz = sb ^ (((sb >> 9) & 1) << 5); R = (st >> 1) * 16 + swz / 64; C = (st & 1) * 32 + (swz % 64) / 2; }
__host__ __device__ __forceinline__ int perm32(int rho) { const int n = rho >> 4, i = rho & 15; return 8 * (i >> 2) + 4 * n + (i & 3); }
struct Unit { int pm, pn; };
struct Gemm { const bf16_t* A; const bf16_t* Bt; int M, N, K; };
struct StaticOrder {
    int nM, nN, nwg, G, c;
    __device__ void init(int M, int N, int G_, int c_) { nM = M / BM; nN = N / BM; nwg = nM * nN; G = G_; c = c_; }
    __device__ bool next(int i, Unit& u) const {
        const long Lx = (long)i * G + c; if (Lx >= nwg) return false;
        int wgid = (int)Lx; { const int q = nwg / NXCD, r = nwg % NXCD, xcd = wgid % NXCD, off = wgid / NXCD; wgid = (xcd < r ? xcd * (q + 1) : r * (q + 1) + (xcd - r) * q) + off; }
        const int nig = WGM * nN, gid = wgid / nig, fm = gid * WGM, gsz = (nM - fm) < WGM ? (nM - fm) : WGM;
        u.pm = fm + ((wgid % nig) % gsz); u.pn = (wgid % nig) / gsz; return true;
    }
};
__device__ __forceinline__ unsigned cvt_pk_bf16(float lo, float hi) { unsigned r; asm volatile("v_cvt_pk_bf16_f32 %0, %1, %2" : "=v"(r) : "v"(lo), "v"(hi)); return r; }

struct EpiF32 {
    static constexpr bool PERM = false;
    float* C; int ldc;
    __device__ __forceinline__ void operator()(const f32x4 (&acc)[2][2][4][2], const Unit& u, int wr, int wc, int fr, int fq) const {
        const int row0 = u.pm * BM + wr * 64 + fr, col0 = u.pn * BM + wc * 32 + 4 * fq;
#pragma unroll
        for (int ai = 0; ai < 2; ++ai)
#pragma unroll
            for (int m = 0; m < 4; ++m) { float* rowp = C + (size_t)(row0 + ai * HALF + m * 16) * ldc + col0;
#pragma unroll
                for (int bj = 0; bj < 2; ++bj)
#pragma unroll
                    for (int n = 0; n < 2; ++n) *(f32x4*)(rowp + bj * HALF + n * 16) = acc[ai][bj][m][n]; }
    }
};
struct EpiBf16 {
    static constexpr bool PERM = true;
    bf16_t* O; int ldc; const float* bias;
    __device__ __forceinline__ void operator()(const f32x4 (&acc)[2][2][4][2], const Unit& u, int wr, int wc, int fr, int fq) const {
        const int row0 = u.pm * BM + wr * 64 + fr; const int col0 = u.pn * BM + wc * 32 + 8 * fq;
        f32x4 bv[2][2];
#pragma unroll
        for (int bj = 0; bj < 2; ++bj)
#pragma unroll
            for (int n = 0; n < 2; ++n) bv[bj][n] = bias ? *(const f32x4*)(bias + col0 + bj * HALF + 4 * n) : (f32x4){0.f, 0.f, 0.f, 0.f};
#pragma unroll
        for (int ai = 0; ai < 2; ++ai)
#pragma unroll
            for (int m = 0; m < 4; ++m) { bf16_t* rowp = O + (size_t)(row0 + ai * HALF + m * 16) * ldc + col0;
#pragma unroll
                for (int bj = 0; bj < 2; ++bj) { f32x4 v0 = acc[ai][bj][m][0] + bv[bj][0], v1 = acc[ai][bj][m][1] + bv[bj][1];
                    u32x4 w; w.x = cvt_pk_bf16(v0[0], v0[1]); w.y = cvt_pk_bf16(v0[2], v0[3]); w.z = cvt_pk_bf16(v1[0], v1[1]); w.w = cvt_pk_bf16(v1[2], v1[3]);
                    *(u32x4*)(rowp + bj * HALF) = w; } }
    }
};
struct EpiSwiGLU {
    static constexpr bool PERM = true;
    bf16_t* O; int ldc;
    __device__ __forceinline__ void operator()(const f32x4 (&acc)[2][2][4][2], const Unit& u, int wr, int wc, int fr, int fq) const {
        const int row0 = u.pm * BM + wr * 64 + fr; const int col0 = u.pn * HALF + wc * 32 + 8 * fq;
#pragma unroll
        for (int ai = 0; ai < 2; ++ai)
#pragma unroll
            for (int m = 0; m < 4; ++m) { bf16_t* rowp = O + (size_t)(row0 + ai * HALF + m * 16) * ldc + col0;
                float v[8];
#pragma unroll
                for (int n = 0; n < 2; ++n)
#pragma unroll
                    for (int j = 0; j < 4; ++j) { const float g = acc[ai][0][m][n][j], up = acc[ai][1][m][n][j]; v[n * 4 + j] = silu_f(g) * up; }
                u32x4 w; w.x = cvt_pk_bf16(v[0], v[1]); w.y = cvt_pk_bf16(v[2], v[3]); w.z = cvt_pk_bf16(v[4], v[5]); w.w = cvt_pk_bf16(v[6], v[7]);
                *(u32x4*)rowp = w; }
    }
};

template <class Epi, class Sched>
__device__ __forceinline__ void gemm_phase(LAS unsigned char* lds, const Gemm g, const Sched& S, const Epi& E) {
    const int tid = ltid(), wid = __builtin_amdgcn_readfirstlane(tid >> 6), lane = tid & 63, wr = wid >> 2, wc = wid & 3, fr = lane & 15, fq = lane >> 4;
    const int K = g.K, nt = K / BK;
    unsigned voffA[2], voffB[2];
#pragma unroll
    for (int i = 0; i < 2; ++i) { int R, C; stage_rc(tid * 16 + i * 8192, R, C); const int Rb = Epi::PERM ? ((R & ~31) + perm32(R & 31)) : R;
        voffA[i] = (unsigned)(R * K + C) * 2u; voffB[i] = (unsigned)(Rb * K + C) * 2u; }
    const size_t kstep = (size_t)(BK * 2);
    const size_t hstep = (size_t)HALF * K * 2;
    const size_t tstep = 2 * hstep;
    const unsigned ldsw = (unsigned)wid * 1024u;
    const int aoff = lds_byte(wr * 64 + fr, fq * 8), boff = lds_byte(wc * 32 + fr, fq * 8);
#define PG8_SA(b, h) (((b) * 2 + (h)) * HTB)
#define PG8_SB(b, h) ((4 + (b) * 2 + (h)) * HTB)
#define PG8_STAGE(bufoff, gbase, voff) do { _Pragma("unroll") for (int _i = 0; _i < 2; ++_i) \
        __builtin_amdgcn_global_load_lds((const unsigned*)((const char*)(gbase) + (voff)[_i]), (LAS unsigned*)(lds + (bufoff) + ldsw + _i * 8192), 16, 0, 0); } while (0)
#define PG8_LDA(dst, b, h) do { _Pragma("unroll") for (int m = 0; m < 4; ++m) _Pragma("unroll") for (int k = 0; k < 2; ++k) dst[m][k] = *(const LAS bf16x8*)(lds + PG8_SA(b, h) + aoff + m * 2048 + k * 1024); } while (0)
#define PG8_LDB(dst, b, h) do { _Pragma("unroll") for (int n = 0; n < 2; ++n) _Pragma("unroll") for (int k = 0; k < 2; ++k) dst[n][k] = *(const LAS bf16x8*)(lds + PG8_SB(b, h) + boff + n * 2048 + k * 1024); } while (0)
#define PG8_MMA(ai, bj, At, Bt) do { __builtin_amdgcn_s_setprio(1); _Pragma("unroll") for (int m = 0; m < 4; ++m) _Pragma("unroll") for (int n = 0; n < 2; ++n) _Pragma("unroll") for (int k = 0; k < 2; ++k) \
        acc[ai][bj][m][n] = __builtin_amdgcn_mfma_f32_16x16x32_bf16(Bt[n][k], At[m][k], acc[ai][bj][m][n], 0, 0, 0); __builtin_amdgcn_s_setprio(0); } while (0)
#define PG8_WAIT_V(n) asm volatile("s_waitcnt vmcnt(" #n ")" ::: "memory")
#define PG8_WAIT_L(n) asm volatile("s_waitcnt lgkmcnt(" #n ")" ::: "memory")
#define PG8_BAR __builtin_amdgcn_s_barrier()
#define PG8_SCHED __builtin_amdgcn_sched_barrier(0)
    Unit cur, nxt; int ui = 0;
    if (!S.next(0, cur)) return;
    f32x4 acc[2][2][4][2];
#pragma unroll
    for (int a = 0; a < 2; ++a)
#pragma unroll
        for (int b = 0; b < 2; ++b)
#pragma unroll
            for (int m = 0; m < 4; ++m)
#pragma unroll
                for (int n = 0; n < 2; ++n) acc[a][b][m][n] = (f32x4){0.f, 0.f, 0.f, 0.f};
    bf16x8 At[4][2], B0[2][2], B1[2][2];
    const char* cA = (const char*)g.A + (size_t)cur.pm * tstep; const char* cB = (const char*)g.Bt + (size_t)cur.pn * tstep;
    PG8_STAGE(PG8_SB(0, 0), cB, voffB); PG8_STAGE(PG8_SA(0, 0), cA, voffA); PG8_STAGE(PG8_SB(0, 1), cB + hstep, voffB); PG8_STAGE(PG8_SA(0, 1), cA + hstep, voffA);
    if (wr == 1) PG8_BAR;
    PG8_WAIT_V(4); PG8_BAR;
    PG8_STAGE(PG8_SB(1, 0), cB + kstep, voffB); PG8_STAGE(PG8_SA(1, 0), cA + kstep, voffA); PG8_STAGE(PG8_SB(1, 1), cB + hstep + kstep, voffB);
    PG8_WAIT_V(6); PG8_BAR;
    for (;;) {
        const bool has_next = S.next(ui + 1, nxt);
        const char* nA = has_next ? (const char*)g.A + (size_t)nxt.pm * tstep : cA; const char* nB = has_next ? (const char*)g.Bt + (size_t)nxt.pn * tstep : cB;
        for (int t = 0; t < nt; t += 2) {
            const bool last = (t == nt - 2);
            const char* a1 = cA + (size_t)(t + 1) * kstep;
            const char* a2 = last ? nA : cA + (size_t)(t + 2) * kstep; const char* b2 = last ? nB : cB + (size_t)(t + 2) * kstep;
            const char* a3 = a2 + kstep; const char* b3 = b2 + kstep;
            PG8_LDB(B0, 0, 0); PG8_SCHED; PG8_LDA(At, 0, 0); PG8_STAGE(PG8_SA(1, 1), a1 + hstep, voffA);
            PG8_WAIT_L(8); PG8_BAR; PG8_WAIT_L(0); PG8_MMA(0, 0, At, B0); PG8_BAR; PG8_SCHED;
            PG8_LDB(B1, 0, 1); PG8_STAGE(PG8_SB(0, 0), b2, voffB);
            PG8_BAR; PG8_WAIT_L(0); PG8_MMA(0, 1, At, B1); PG8_BAR;
            PG8_LDA(At, 0, 1); PG8_STAGE(PG8_SA(0, 0), a2, voffA);
            PG8_BAR; PG8_WAIT_L(0); PG8_MMA(1, 0, At, B0); PG8_BAR; PG8_SCHED;
            PG8_STAGE(PG8_SB(0, 1), b2 + hstep, voffB);
            PG8_WAIT_V(6); PG8_BAR; PG8_MMA(1, 1, At, B1); PG8_BAR;
            PG8_LDB(B0, 1, 0); PG8_SCHED; PG8_LDA(At, 1, 0); PG8_STAGE(PG8_SA(0, 1), a2 + hstep, voffA);
            PG8_WAIT_L(8); PG8_BAR; PG8_WAIT_L(0); PG8_MMA(0, 0, At, B0); PG8_BAR; PG8_SCHED;
            PG8_LDB(B1, 1, 1); PG8_STAGE(PG8_SB(1, 0), b3, voffB);
            PG8_BAR; PG8_WAIT_L(0); PG8_MMA(0, 1, At, B1); PG8_BAR;
            PG8_LDA(At, 1, 1); PG8_STAGE(PG8_SA(1, 0), a3, voffA);
            PG8_BAR; PG8_WAIT_L(0); PG8_MMA(1, 0, At, B0); PG8_BAR; PG8_SCHED;
            PG8_STAGE(PG8_SB(1, 1), b3 + hstep, voffB);
            PG8_WAIT_V(6); PG8_BAR; PG8_MMA(1, 1, At, B1); PG8_BAR;
        }
        E(acc, cur, wr, wc, fr, fq);
        if (!has_next) break;
#pragma unroll
        for (int a = 0; a < 2; ++a)
#pragma unroll
            for (int b = 0; b < 2; ++b)
#pragma unroll
                for (int m = 0; m < 4; ++m)
#pragma unroll
                    for (int n = 0; n < 2; ++n) acc[a][b][m][n] = (f32x4){0.f, 0.f, 0.f, 0.f};
        cur = nxt; cA = nA; cB = nB; ++ui;
    }
    PG8_WAIT_V(0);
    if (wr == 0) PG8_BAR;
    PG8_BAR;
#undef PG8_SA
#undef PG8_SB
#undef PG8_STAGE
#undef PG8_LDA
#undef PG8_LDB
#undef PG8_MMA
#undef PG8_WAIT_V
#undef PG8_WAIT_L
#undef PG8_BAR
#undef PG8_SCHED
}
}

template <class Epi>
__device__ __forceinline__ void run_gemm(unsigned char* smem, const bf16_t* A, const bf16_t* Bt, int M, int N, int K, const Epi& E) {
    pg8::Gemm g{A, Bt, M, N, K}; pg8::StaticOrder S; S.init(M, N, (int)gridDim.x, (int)blockIdx.x);
    pg8::gemm_phase<Epi, pg8::StaticOrder>((LAS unsigned char*)smem, g, S, E);
}

__device__ __forceinline__ float* xrow(const KP& p, int t) { return t < TL ? p.out + (size_t)t * D : (float*)(p.ws + WS_XC) + (size_t)(t - TL) * D; }
__device__ __forceinline__ int modrow(int t) { return t < TL ? (t >> 12) : 4; }
__device__ __forceinline__ const float* modp(const KP& p, int l, int mr, int idx) { return (const float*)(p.ws + WS_MOD) + ((size_t)(l * 5 + mr) * NMOD + idx) * D; }

__device__ void p0_setup(const KP& p, float* sm) {
    const int tid = ltid(), bid = blockIdx.x, nb = gridDim.x;
    const int gtid = bid * 512 + tid, gthreads = nb * 512;
    {
        const float4* xs = (const float4*)p.in[0]; float4* xd = (float4*)p.out;
        for (int i = gtid; i < TL * D / 4; i += gthreads) xd[i] = xs[i];
        const float4* cs = (const float4*)p.in[2]; float4* cd = (float4*)(p.ws + WS_XC);
        for (int i = gtid; i < TC * D / 4; i += gthreads) cd[i] = cs[i];
    }
    {
        float* rope = (float*)(p.ws + WS_ROPE);
        for (int idx = gtid; idx < SEQ * 32; idx += gthreads) {
            const int t = idx >> 5, i = idx & 31;
            const int ii = i & 15; const float pos = (i < 16) ? (float)(t >> 6) : (float)(t & 63);
            const float invA = powf(10000.0f, -(float)ii / 16.0f);
            const float angA = pos * invA;
            rope[idx] = cosf(angA); rope[SEQ * 32 + idx] = sinf(angA);
            const float ex = (float)i * (1.0f / 31.0f);
            const float invR = powf(10000.0f, -ex);
            const float angR = (float)t * invR;
            rope[2 * SEQ * 32 + idx] = cosf(angR); rope[3 * SEQ * 32 + idx] = sinf(angR);
        }
    }
    {
        float* tile = sm;
        for (int g = bid; g < 20864; g += nb) {
            int j, tl;
            if (g < 16896) { j = g / 704; tl = g % 704; }
            else if (g < 18304) { j = 24 + (g - 16896) / 704; tl = (g - 16896) % 704; }
            else if (g < 18816) { j = 26 + (g - 18304) / 256; tl = (g - 18304) % 256; }
            else if (g < 20352) { j = 28 + (g - 18816) / 768; tl = (g - 18816) % 768; }
            else { j = 30 + (g - 20352) / 256; tl = (g - 20352) % 256; }
            const float* src; bf16_t* dst; int K, N, mode = 0;
            if (j < 8) { src = p.in[8] + (size_t)j * D * DFF; dst = (bf16_t*)(p.ws + WS_WGU + (size_t)j * SZ_WGU); K = D; N = DFF; mode = 1; }
            else if (j < 16) { src = p.in[9] + (size_t)(j - 8) * D * DFF; dst = (bf16_t*)(p.ws + WS_WGU + (size_t)(j - 8) * SZ_WGU); K = D; N = DFF; mode = 2; }
            else if (j < 24) { src = p.in[10] + (size_t)(j - 16) * DFF * D; dst = (bf16_t*)(p.ws + WS_WD + (size_t)(j - 16) * SZ_WD); K = DFF; N = D; }
            else if (j < 26) { src = p.in[11] + (size_t)(j - 24) * D * INW; dst = (bf16_t*)(p.ws + WS_WIN + (size_t)(j - 24) * SZ_WIN); K = D; N = INW; mode = 3; }
            else if (j < 28) { src = p.in[14] + (size_t)(j - 26) * D * D; dst = (bf16_t*)(p.ws + WS_WOUT + (size_t)(j - 26) * SZ_WOUT); K = D; N = D; }
            else if (j < 30) { src = p.in[15] + (size_t)(j - 28) * D * HYW; dst = (bf16_t*)(p.ws + WS_HWIN + (size_t)(j - 28) * SZ_HWIN); K = D; N = HYW; }
            else { src = p.in[28] + (size_t)(j - 30) * D * D; dst = (bf16_t*)(p.ws + WS_HWOUT + (size_t)(j - 30) * SZ_WOUT); K = D; N = D; }
            const int ntn = N / 64; const int k0 = (tl / ntn) * 64, n0 = (tl % ntn) * 64;
            __syncthreads();
#pragma unroll
            for (int i = 0; i < 8; ++i) { const int k = i * 8 + (tid >> 6), n = tid & 63; tile[k * 65 + n] = src[(size_t)(k0 + k) * N + n0 + n]; }
            __syncthreads();
#pragma unroll
            for (int i = 0; i < 8; ++i) {
                const int n = i * 8 + (tid >> 6), k = tid & 63; const int gn = n0 + n;
                float v = tile[k * 65 + n];
                int row = gn;
                if (mode == 1) row = 256 * (gn >> 7) + (gn & 127);
                else if (mode == 2) row = 256 * (gn >> 7) + 128 + (gn & 127);
                else if (mode == 3) { if (gn < 512 || (gn >= 1792 && gn < 2304)) v *= 0.125f; }
                dst[(size_t)row * K + k0 + k] = f2bf(v);
            }
        }
        __syncthreads();
    }
    {
        float* sc = sm;
        float* red = sm + 5 * 1024;
        for (int i = tid; i < 5 * 1024; i += 512) { const int r = i >> 10, k = i & 1023; const float v = (r < 4) ? p.in[1][r * D + k] : p.in[3][k]; sc[i] = silu_f(v); }
        __syncthreads();
        const int w = tid >> 6, lane = tid & 63;
        for (int it = bid; it < 288; it += nb) {
            const int l = it / 72, c0 = (it % 72) * 128;
            const float* wm = p.in[4] + (size_t)l * D * (NMOD * D) + c0 + 2 * lane;
            float a[5][2];
#pragma unroll
            for (int r = 0; r < 5; ++r) { a[r][0] = 0.f; a[r][1] = 0.f; }
            for (int k = w * 128; k < w * 128 + 128; ++k) {
                const float2 wv = *(const float2*)(wm + (size_t)k * (NMOD * D));
#pragma unroll
                for (int r = 0; r < 5; ++r) { const float s = sc[r * 1024 + k]; a[r][0] += s * wv.x; a[r][1] += s * wv.y; }
            }
#pragma unroll
            for (int r = 0; r < 5; ++r) { red[(w * 5 + r) * 128 + 2 * lane] = a[r][0]; red[(w * 5 + r) * 128 + 2 * lane + 1] = a[r][1]; }
            __syncthreads();
            for (int i = tid; i < 5 * 128; i += 512) {
                const int r = i >> 7, c = i & 127; float s = 0.f;
#pragma unroll
                for (int ww = 0; ww < 8; ++ww) s += red[(ww * 5 + r) * 128 + c];
                s += p.in[5][(size_t)l * (NMOD * D) + c0 + c];
                ((float*)(p.ws + WS_MOD))[(size_t)(l * 5 + r) * (NMOD * D) + c0 + c] = s;
            }
            __syncthreads();
        }
    }
    {
        float* z = sm;
        float* a1 = sm + 16 * 36;
        float* a2 = a1 + 16 * 64;
        float* a3 = a2 + 16 * 64;
        float* tl = a3 + 16 * 64;
        const float HMAX = -4.605170185988091f / 0.3f, HMIN = -4.605170185988091f / 1.5f;
        for (int it = bid; it < 544; it += nb) {
            const int o = it / 272, r = it % 272;
            const int Lf = (r < 256) ? SEQ : CL; const int p0 = (r < 256) ? r * 16 : (r - 256) * 16;
            float* kf = (float*)(p.ws + WS_KF + (size_t)o * SZ_KF) + ((r < 256) ? (size_t)0 : (size_t)2 * SEQ * D);
            const float* f0 = p.in[19] + (size_t)o * 33 * 64; const float* fb0 = p.in[20] + o * 64;
            const float* f1 = p.in[21] + (size_t)o * 64 * 64; const float* fb1 = p.in[22] + o * 64;
            const float* f2 = p.in[23] + (size_t)o * 64 * 64; const float* fb2 = p.in[24] + o * 64;
            const float* f3 = p.in[25] + (size_t)o * 64 * 2048; const float* fq = p.in[26] + o * 64;
            __syncthreads();
            for (int idx = tid; idx < 16 * 33; idx += 512) {
                const int ps = idx / 33, f = idx % 33; const int i = p0 + ps;
                const float tlin = (float)i * (1.0f / (float)(Lf - 1));
                const float w = (6.283185307179586f * (float)i) / (float)Lf;
                float v;
                if (f == 0) { v = tlin; tl[ps] = tlin; }
                else { const int jj = (f - 1) & 15; const float fj = 1e-4f + (float)jj * ((15.0f - 1e-4f) / 15.0f); v = (f <= 16) ? cosf(fj * w) : -sinf(fj * w); }
                z[ps * 36 + f] = v;
            }
            __syncthreads();
            for (int idx = tid; idx < 16 * 64; idx += 512) { const int ps = idx >> 6, oc = idx & 63; float s = fb0[oc];
                for (int f = 0; f < 33; ++f) s += z[ps * 36 + f] * f0[f * 64 + oc];
                a1[idx] = sinf(fq[oc] * s); }
            __syncthreads();
            for (int idx = tid; idx < 16 * 64; idx += 512) { const int ps = idx >> 6, oc = idx & 63; float s = fb1[oc];
                for (int f = 0; f < 64; ++f) s += a1[ps * 64 + f] * f1[f * 64 + oc];
                a2[idx] = sinf(fq[oc] * s); }
            __syncthreads();
            for (int idx = tid; idx < 16 * 64; idx += 512) { const int ps = idx >> 6, oc = idx & 63; float s = fb2[oc];
                for (int f = 0; f < 64; ++f) s += a2[ps * 64 + f] * f2[f * 64 + oc];
                a3[idx] = sinf(fq[oc] * s); }
            __syncthreads();
            for (int q = 0; q < 4; ++q) {
                const int c = tid + 512 * q; const int dir = c >> 10, d = c & 1023;
                float acc[16];
#pragma unroll
                for (int ps = 0; ps < 16; ++ps) acc[ps] = 0.f;
                for (int f = 0; f < 64; ++f) { const float wv = f3[f * 2048 + c];
#pragma unroll
                    for (int ps = 0; ps < 16; ++ps) acc[ps] += a3[ps * 64 + f] * wv; }
                const float delta = fabsf(HMIN + (float)d * ((HMAX - HMIN) / 1023.0f));
#pragma unroll
                for (int ps = 0; ps < 16; ++ps) {
                    const float kvv = acc[ps] * expf(-tl[ps] * delta);
                    if (r < 256) {
                        bf16_t* rk = (bf16_t*)(p.ws + WS_KF + (size_t)o * SZ_KF) + (size_t)d * 8192;
                        const int m = p0 + ps;
                        if (dir == 0) rk[4095 - m] = f2bf(kvv); else if (m > 0) rk[4095 + m] = f2bf(kvv);
                        if (dir == 0 && m == 0) rk[8191] = 0;
                    } else kf[((size_t)dir * Lf + p0 + ps) * D + d] = kvv;
                }
            }
        }
        __syncthreads();
    }
}

__device__ void rowphase(const KP& p, int Mupd, const float* Y, int lu, int gidx, float wgt, const float* gpost,
                         int Mnext, int ln, const float* gpre, int shidx, int scidx, bf16_t* Hout) {
    const int tid = ltid(), w = tid >> 6, lane = tid & 63;
    const int Mmax = Mupd > Mnext ? Mupd : Mnext;
    for (int t = blockIdx.x * 8 + w; t < Mmax; t += gridDim.x * 8) {
        float* xr = xrow(p, t); const int mr = modrow(t);
        float4 xv[4];
#pragma unroll
        for (int q = 0; q < 4; ++q) xv[q] = *(const float4*)(xr + q * 256 + lane * 4);
        if (Y != nullptr && t < Mupd) {
            float4 yv[4]; float ss = 0.f;
#pragma unroll
            for (int q = 0; q < 4; ++q) { yv[q] = *(const float4*)(Y + (size_t)t * D + q * 256 + lane * 4); ss += yv[q].x * yv[q].x + yv[q].y * yv[q].y + yv[q].z * yv[q].z + yv[q].w * yv[q].w; }
            ss = wave_sum(ss);
            const float r = rsqrtf(ss * (1.0f / D) + EPS) * wgt;
            const float* gm = modp(p, lu, mr, gidx);
#pragma unroll
            for (int q = 0; q < 4; ++q) {
                const float4 g4 = *(const float4*)(gm + q * 256 + lane * 4); const float4 p4 = *(const float4*)(gpost + q * 256 + lane * 4);
                xv[q].x += r * g4.x * yv[q].x * p4.x; xv[q].y += r * g4.y * yv[q].y * p4.y; xv[q].z += r * g4.z * yv[q].z * p4.z; xv[q].w += r * g4.w * yv[q].w * p4.w;
                *(float4*)(xr + q * 256 + lane * 4) = xv[q];
            }
        }
        if (Hout != nullptr && t < Mnext) {
            float ss = 0.f;
#pragma unroll
            for (int q = 0; q < 4; ++q) ss += xv[q].x * xv[q].x + xv[q].y * xv[q].y + xv[q].z * xv[q].z + xv[q].w * xv[q].w;
            ss = wave_sum(ss);
            const float r = rsqrtf(ss * (1.0f / D) + EPS);
            const float* sh = modp(p, ln, mr, shidx); const float* sc = modp(p, ln, mr, scidx);
#pragma unroll
            for (int q = 0; q < 4; ++q) {
                const float4 g4 = *(const float4*)(gpre + q * 256 + lane * 4); const float4 s4 = *(const float4*)(sc + q * 256 + lane * 4); const float4 h4 = *(const float4*)(sh + q * 256 + lane * 4);
                const float h0 = xv[q].x * r * g4.x * (1.0f + s4.x) + h4.x, h1 = xv[q].y * r * g4.y * (1.0f + s4.y) + h4.y;
                const float h2 = xv[q].z * r * g4.z * (1.0f + s4.z) + h4.z, h3 = xv[q].w * r * g4.w * (1.0f + s4.w) + h4.w;
                uint2 pk; pk.x = (unsigned)f2bf(h0) | ((unsigned)f2bf(h1) << 16); pk.y = (unsigned)f2bf(h2) | ((unsigned)f2bf(h3) << 16);
                *(uint2*)(Hout + (size_t)t * D + q * 256 + lane * 4) = pk;
            }
        }
    }
}

__device__ __forceinline__ float log_sigmoid(float x) { return -log1pf(expf(-x)); }
__device__ __forceinline__ int chunk_t0(int b, int cidx) { return cidx < 32 ? b * SEQ + cidx * 128 : TL + b * CL + (cidx - 32) * 128; }

__device__ void m1_rope_states(const KP& p, int e, float* sm) {
    const int tid = ltid(), bid = blockIdx.x, nb = gridDim.x;
    bf16_t* Z = (bf16_t*)(p.ws + WS_BIG);
    const float* rope = (const float*)(p.ws + WS_ROPE);
    for (int idx = bid * 512 + tid; idx < TL * 576; idx += nb * 512) {
        const int t = idx / 576, r = idx % 576; const int hd = r >> 5, i = r & 31;
        const int cb = hd < 16 ? hd * 64 : 1536 + (hd - 16) * 64;
        const int tb = (hd >= 8 && hd < 16) ? 2 : 0; const int pos = t & (SEQ - 1);
        const float c = rope[(size_t)tb * SEQ * 32 + pos * 32 + i], s = rope[(size_t)(tb + 1) * SEQ * 32 + pos * 32 + i];
        bf16_t* zp = Z + (size_t)t * INW + cb + i;
        const float x1 = bf2f(zp[0]), x2 = bf2f(zp[32]);
        zp[0] = f2bf(x1 * c - x2 * s); zp[32] = f2bf(x1 * s + x2 * c);
    }
    float* Ks = sm;
    float* Vs = sm + 128 * 64;
    float* wf = Vs + 128 * 64;
    float* wb = wf + 128;
    float* AF = (float*)(p.ws + WS_ST); float* AB = AF + SZ_ST / 4;
    const float* dec = p.in[13] + e * 16;
    for (int it = bid; it < NB * NCH * 8; it += nb) {
        const int h = it & 7, cidx = (it >> 3) % NCH, b = it / (8 * NCH);
        const int t0 = chunk_t0(b, cidx); const bool lat = cidx < 32;
        const float lgf = log_sigmoid(dec[h]), lgb = log_sigmoid(dec[8 + h]);
        __syncthreads();
        if (tid < 128) { wf[tid] = expf(lgf * (float)(127 - tid)); wb[tid] = expf(lgb * (float)tid); }
        const int kc = 1792 + h * 64, vc = 2304 + h * 64;
#pragma unroll
        for (int q = 0; q < 8; ++q) {
            const int idx = tid + 512 * q; const int r = idx >> 5, i = idx & 31;
            bf16_t* zp = Z + (size_t)(t0 + r) * INW + kc + i;
            float x1 = bf2f(zp[0]), x2 = bf2f(zp[32]);
            if (lat) {
                const int pos = (t0 + r) & (SEQ - 1);
                const float c = rope[(size_t)2 * SEQ * 32 + pos * 32 + i], s = rope[(size_t)3 * SEQ * 32 + pos * 32 + i];
                const bf16_t o1 = f2bf(x1 * c - x2 * s), o2 = f2bf(x1 * s + x2 * c);
                zp[0] = o1; zp[32] = o2; x1 = bf2f(o1); x2 = bf2f(o2);
            }
            Ks[r * 64 + i] = x1; Ks[r * 64 + 32 + i] = x2;
        }
#pragma unroll
        for (int q = 0; q < 16; ++q) { const int idx = tid + 512 * q; const int r = idx >> 6, c = idx & 63; Vs[idx] = bf2f(Z[(size_t)(t0 + r) * INW + vc + c]); }
        __syncthreads();
        const int d = tid >> 3, e0 = (tid & 7) * 8;
        float af[8], ab[8];
#pragma unroll
        for (int j = 0; j < 8; ++j) { af[j] = 0.f; ab[j] = 0.f; }
        for (int s = 0; s < 128; ++s) {
            const float kv = Ks[s * 64 + d]; const float kfw = kv * wf[s], kbw = kv * wb[s];
            const float4 v0 = *(const float4*)(Vs + s * 64 + e0), v1 = *(const float4*)(Vs + s * 64 + e0 + 4);
            af[0] += kfw * v0.x; af[1] += kfw * v0.y; af[2] += kfw * v0.z; af[3] += kfw * v0.w; af[4] += kfw * v1.x; af[5] += kfw * v1.y; af[6] += kfw * v1.z; af[7] += kfw * v1.w;
            ab[0] += kbw * v0.x; ab[1] += kbw * v0.y; ab[2] += kbw * v0.z; ab[3] += kbw * v0.w; ab[4] += kbw * v1.x; ab[5] += kbw * v1.y; ab[6] += kbw * v1.z; ab[7] += kbw * v1.w;
        }
        const size_t so = ((size_t)(b * NCH + cidx) * 8 + h) * 4096 + d * 64 + e0;
        *(float4*)(AF + so) = make_float4(af[0], af[1], af[2], af[3]); *(float4*)(AF + so + 4) = make_float4(af[4], af[5], af[6], af[7]);
        *(float4*)(AB + so) = make_float4(ab[0], ab[1], ab[2], ab[3]); *(float4*)(AB + so + 4) = make_float4(ab[4], ab[5], ab[6], ab[7]);
    }
    __syncthreads();
}

__device__ void m2_scan(const KP& p, int e) {
    float* AF = (float*)(p.ws + WS_ST); float* AB = AF + SZ_ST / 4; float* TF = AB + SZ_ST / 4; float* TB = TF + SZ_ST / 4;
    const float* dec = p.in[13] + e * 16;
    for (int idx = blockIdx.x * 512 + ltid(); idx < NB * 8 * 4096; idx += gridDim.x * 512) {
        const int el = idx & 4095, h = (idx >> 12) & 7, b = idx >> 15;
        const float gf = expf(log_sigmoid(dec[h]) * 128.0f), gb = expf(log_sigmoid(dec[8 + h]) * 128.0f);
#define SIDX(c) (((size_t)(b * NCH + (c)) * 8 + h) * 4096 + el)
        const float afc0 = AF[SIDX(32)], afc1 = AF[SIDX(33)], abc0 = AB[SIDX(32)], abc1 = AB[SIDX(33)];
        TF[SIDX(32)] = 0.f; TF[SIDX(33)] = afc0; TB[SIDX(33)] = 0.f; TB[SIDX(32)] = abc1;
        float sf = gf * afc0 + afc1, sb = abc0 + gb * abc1;
        for (int c = 0; c < 32; ++c) { TF[SIDX(c)] = sf; sf = gf * sf + AF[SIDX(c)]; }
        for (int c = 31; c >= 0; --c) { TB[SIDX(c)] = sb; sb = AB[SIDX(c)] + gb * sb; }
#undef SIDX
    }
}

__device__ void m3_outputs(const KP& p, int e, bool ctx_full, float* sm) {
    const int tid = ltid(), bid = blockIdx.x, nb = gridDim.x;
    const bf16_t* Z = (const bf16_t*)(p.ws + WS_BIG);
    bf16_t* MIX = (bf16_t*)(p.ws + WS_MIX);
    const float* dec = p.in[13] + e * 16;
    const float* sink = p.in[12] + e * 8;
    const float* TF = (const float*)(p.ws + WS_ST) + 2 * (SZ_ST / 4); const float* TB = TF + SZ_ST / 4;
    const int nchunk = ctx_full ? NCH : 32;
    const int nitems = NB * nchunk * 8;
    for (int it = bid; it < 2 * nitems; it += nb) {
        const bool is_attn = it >= nitems; const int ii = is_attn ? it - nitems : it;
        const int h = ii & 7, cidx = (ii >> 3) % nchunk, b = ii / (8 * nchunk);
        const int t0 = chunk_t0(b, cidx); const bool lat = cidx < 32;
        const int i = tid >> 2, sub = tid & 3;
        __syncthreads();
        if (!is_attn) {
            float* Qs = sm; float* Ks = Qs + 8192; float* Vs = Ks + 8192; float* Tf = Vs + 8192; float* Tb = Tf + 4096; float* pf = Tb + 4096; float* pb = pf + 132;
            const float lgf = log_sigmoid(dec[h]), lgb = log_sigmoid(dec[8 + h]);
            if (tid < 129) { pf[tid] = expf(lgf * (float)tid); pb[tid] = expf(lgb * (float)tid); }
#pragma unroll
            for (int q = 0; q < 16; ++q) { const int idx = tid + 512 * q; const int r = idx >> 6, c = idx & 63; const bf16_t* zr = Z + (size_t)(t0 + r) * INW + h * 64 + c;
                Qs[idx] = bf2f(zr[512]); Ks[idx] = bf2f(zr[1792]); Vs[idx] = bf2f(zr[2304]); }
            const size_t so = ((size_t)(b * NCH + cidx) * 8 + h) * 4096;
#pragma unroll
            for (int q = 0; q < 8; ++q) { const int idx = tid + 512 * q; Tf[idx] = TF[so + idx]; Tb[idx] = TB[so + idx]; }
            __syncthreads();
            float qv[16], o[16];
#pragma unroll
            for (int j = 0; j < 16; ++j) { qv[j] = Qs[i * 64 + sub * 16 + j]; o[j] = 0.f; }
            for (int s = 0; s < 128; ++s) {
                float part = 0.f;
#pragma unroll
                for (int j4 = 0; j4 < 4; ++j4) { const float4 kk = *(const float4*)(Ks + s * 64 + sub * 16 + j4 * 4);
                    part += qv[j4 * 4] * kk.x + qv[j4 * 4 + 1] * kk.y + qv[j4 * 4 + 2] * kk.z + qv[j4 * 4 + 3] * kk.w; }
                part += __shfl_xor(part, 1, 64); part += __shfl_xor(part, 2, 64);
                const float wgt = (s < i) ? pf[i - s] : ((s > i) ? pb[s - i] : 2.0f);
                const float a = part * wgt;
#pragma unroll
                for (int j4 = 0; j4 < 4; ++j4) { const float4 vv = *(const float4*)(Vs + s * 64 + sub * 16 + j4 * 4);
                    o[j4 * 4] += a * vv.x; o[j4 * 4 + 1] += a * vv.y; o[j4 * 4 + 2] += a * vv.z; o[j4 * 4 + 3] += a * vv.w; }
            }
            const float cf = pf[i + 1], cb = pb[128 - i];
            for (int d = 0; d < 64; ++d) {
                const float qd = Qs[i * 64 + d]; const float qf = qd * cf, qb = qd * cb;
#pragma unroll
                for (int j4 = 0; j4 < 4; ++j4) { const float4 tf = *(const float4*)(Tf + d * 64 + sub * 16 + j4 * 4); const float4 tb = *(const float4*)(Tb + d * 64 + sub * 16 + j4 * 4);
                    o[j4 * 4] += qf * tf.x + qb * tb.x; o[j4 * 4 + 1] += qf * tf.y + qb * tb.y; o[j4 * 4 + 2] += qf * tf.z + qb * tb.z; o[j4 * 4 + 3] += qf * tf.w + qb * tb.w; }
            }
            float ss = 0.f;
#pragma unroll
            for (int j = 0; j < 16; ++j) ss += o[j] * o[j];
            ss += __shfl_xor(ss, 1, 64); ss += __shfl_xor(ss, 2, 64);
            const float r = rsqrtf(ss * (1.0f / 64.0f) + EPS);
            const bf16_t* gr = Z + (size_t)(t0 + i) * INW + 1024 + h * 64 + sub * 16;
            bf16_t* mo = MIX + (size_t)(t0 + i) * D + 512 + h * 64 + sub * 16;
#pragma unroll
            for (int j = 0; j < 16; ++j) mo[j] = f2bf(o[j] * r * silu_f(bf2f(gr[j])));
        } else {
            float* Kt = sm; float* Vt = sm + 128 * 68;
            const int g = h >> 2;
            float qv[16], acc[16];
            {
                const bf16_t* qr = Z + (size_t)(t0 + i) * INW + h * 64 + sub * 16;
#pragma unroll
                for (int d = 0; d < 16; ++d) { qv[d] = bf2f(qr[d]); acc[d] = 0.f; }
            }
            float mx = sink[h], l = 1.0f;
            const int qpos = lat ? (cidx * 128 + i) : 0;
            for (int tl = 0; tl < 5; ++tl) {
                int kt0; int kp0 = 0; const bool isc = tl >= 3;
                if (!isc) { if (!lat) continue; const int kc = cidx - 1 + tl; if (kc < 0 || kc >= 32) continue; kt0 = b * SEQ + kc * 128; kp0 = kc * 128; }
                else kt0 = TL + b * CL + (tl - 3) * 128;
                __syncthreads();
#pragma unroll
                for (int q = 0; q < 16; ++q) { const int idx = tid + 512 * q; const int r = idx >> 6, c = idx & 63; const bf16_t* zr = Z + (size_t)(kt0 + r) * INW + g * 64 + c;
                    Kt[r * 68 + c] = bf2f(zr[1536]); Vt[r * 68 + c] = bf2f(zr[1664]); }
                __syncthreads();
                for (int j = 0; j < 128; ++j) {
                    float s = 0.f;
#pragma unroll
                    for (int d4 = 0; d4 < 4; ++d4) { const float4 kk = *(const float4*)(Kt + j * 68 + sub * 16 + d4 * 4);
                        s += qv[d4 * 4] * kk.x + qv[d4 * 4 + 1] * kk.y + qv[d4 * 4 + 2] * kk.z + qv[d4 * 4 + 3] * kk.w; }
                    s += __shfl_xor(s, 1, 64); s += __shfl_xor(s, 2, 64);
                    bool valid = true;
                    if (!isc) { const int dd = qpos - (kp0 + j); valid = (dd <= 128) && (dd >= -128); }
                    if (valid) {
                        if (s > mx) { const float sc = __expf(mx - s); l *= sc;
#pragma unroll
                            for (int d = 0; d < 16; ++d) acc[d] *= sc;
                            mx = s; }
                        const float pw = __expf(s - mx); l += pw;
#pragma unroll
                        for (int d4 = 0; d4 < 4; ++d4) { const float4 vv = *(const float4*)(Vt + j * 68 + sub * 16 + d4 * 4);
                            acc[d4 * 4] += pw * vv.x; acc[d4 * 4 + 1] += pw * vv.y; acc[d4 * 4 + 2] += pw * vv.z; acc[d4 * 4 + 3] += pw * vv.w; }
                    }
                }
            }
            const float inv = 1.0f / l;
            bf16_t* mo = MIX + (size_t)(t0 + i) * D + h * 64 + sub * 16;
#pragma unroll
            for (int d = 0; d < 16; ++d) mo[d] = f2bf(acc[d] * inv);
        }
    }
    __syncthreads();
}

__device__ void h2_shortconv(const KP& p, int o, int M, unsigned char* smem) {
    const int tid = ltid();
    const bf16_t* ZH = (const bf16_t*)(p.ws + WS_BIG);
    const float* w = p.in[17] + (size_t)o * 3 * HYW; const float* bs = p.in[18] + (size_t)o * HYW;
    bf16_t* VXT = (bf16_t*)(p.ws + WS_Y); bf16_t* X0T = VXT + (size_t)D * TL;
    bf16_t* tx = (bf16_t*)smem;
    bf16_t* tv = tx + 64 * 72;
    const int tok = tid >> 3, cg8 = (tid & 7) * 8;
    for (int it = blockIdx.x; it < (TL / 64) * 16; it += gridDim.x) {
        const int c0 = (it & 15) * 64, t0 = (it >> 4) * 64;
        const int t = t0 + tok; const int pos = t & (SEQ - 1); const bool first = pos == 0, last = pos == SEQ - 1;
        float zz[3][8];
#pragma unroll
        for (int k = 0; k < 3; ++k) {
            const int c = k * 1024 + c0 + cg8;
            const bf16x8 zc = *(const bf16x8*)(ZH + (size_t)t * HYW + c);
            bf16x8 zp = zc, zn = zc;
            if (!first) zp = *(const bf16x8*)(ZH + (size_t)(t - 1) * HYW + c);
            if (!last) zn = *(const bf16x8*)(ZH + (size_t)(t + 1) * HYW + c);
#pragma unroll
            for (int j = 0; j < 8; ++j) {
                float sacc = bs[c + j] + bf2f((bf16_t)zc[j]) * w[HYW + c + j];
                if (!first) sacc += bf2f((bf16_t)zp[j]) * w[c + j];
                if (!last) sacc += bf2f((bf16_t)zn[j]) * w[2 * HYW + c + j];
                zz[k][j] = sacc;
            }
        }
        __syncthreads();
#pragma unroll
        for (int j = 0; j < 8; ++j) { tx[(cg8 + j) * 72 + tok] = f2bf(zz[0][j]); tv[(cg8 + j) * 72 + tok] = f2bf(zz[2][j] * zz[1][j]); }
        __syncthreads();
        { const int ch = tid >> 3, tk = (tid & 7) * 8;
          *(u32x4*)(X0T + (size_t)(c0 + ch) * TL + t0 + tk) = *(const u32x4*)(tx + ch * 72 + tk);
          *(u32x4*)(VXT + (size_t)(c0 + ch) * TL + t0 + tk) = *(const u32x4*)(tv + ch * 72 + tk); }
    }
    __syncthreads();
    if (M > TL) {
        float* VX = (float*)(p.ws + WS_Y); bf16_t* X0 = (bf16_t*)(p.ws + WS_H);
        for (int idx = TL * D + blockIdx.x * 512 + tid; idx < M * D; idx += gridDim.x * 512) {
            const int t = idx >> 10, d = idx & 1023;
            const int pos = (t - TL) & (CL - 1); const bool first = pos == 0, last = pos == CL - 1;
            float zz[3];
#pragma unroll
            for (int k = 0; k < 3; ++k) {
                const int c = k * 1024 + d;
                float sacc = bs[c] + bf2f(ZH[(size_t)t * HYW + c]) * w[HYW + c];
                if (!first) sacc += bf2f(ZH[(size_t)(t - 1) * HYW + c]) * w[c];
                if (!last) sacc += bf2f(ZH[(size_t)(t + 1) * HYW + c]) * w[2 * HYW + c];
                zz[k] = sacc;
            }
            VX[idx] = zz[2] * zz[1]; X0[idx] = f2bf(zz[0]);
        }
    }
}

typedef float f32x16 __attribute__((ext_vector_type(16)));
__device__ void h3_longconv(const KP& p, int o, bool ctx_full, unsigned char* smem) {
    const int tid = ltid(), w = tid >> 6, lane = tid & 63;
    const float* bias = p.in[27] + (size_t)o * D;
    {
        const bf16_t* VXT = (const bf16_t*)(p.ws + WS_Y); const bf16_t* X0T = VXT + (size_t)D * TL;
        bf16_t* HMT = (bf16_t*)(p.ws + WS_H);
        const bf16_t* RKT = (const bf16_t*)(p.ws + WS_KF + (size_t)o * SZ_KF);
        constexpr int RK2_OFF = 16384 + 64, U_OFF = 2 * 16384 + 128, CH_BYTES = U_OFF + 142 * 256;
        const int cw = w >> 2, w4 = w & 3;
        const int ct = tid & 255;
        unsigned char* cb = smem + cw * CH_BYTES;
        const int r = lane & 31, hh = lane >> 5;
        for (int pr = blockIdx.x; pr < D / 2; pr += gridDim.x) {
            const int d = pr * 2 + cw;
            __syncthreads();
            { const bf16_t* src = RKT + (size_t)d * 8192;
              for (int i = ct; i < 1024; i += 256) *(u32x4*)(cb + i * 16) = *(const u32x4*)(src + i * 8);
              bf16_t* rk2 = (bf16_t*)(cb + RK2_OFF);
              for (int i = ct; i < 4096; i += 256) { const unsigned lo = src[2 * i + 1]; const unsigned hi = (2 * i + 2 < 8192) ? src[2 * i + 2] : 0u; *(unsigned*)(rk2 + 2 * i) = lo | (hi << 16); }
              unsigned char* ub = cb + U_OFF;
              for (int i = ct; i < 2 * 7 * 4 * 4; i += 256) { const int side = i / 112, rem = i % 112; *(u32x4*)(ub + (side ? (135 * 4 * 64) : 0) + rem * 16) = (u32x4){0u, 0u, 0u, 0u}; }
              for (int i = ct; i < 4 * 512; i += 256) { const int b = i >> 9, pc = i & 511;
                  const u32x4 v = *(const u32x4*)(VXT + (size_t)d * TL + b * SEQ + pc * 8);
                  const int chunk = pc >> 2, m0 = (pc & 3) * 8;
                  *(u32x4*)(ub + ((chunk + 7) * 4 + b) * 64 + m0 * 2) = v; } }
            __syncthreads();
            f32x16 acc[4];
#pragma unroll
            for (int j = 0; j < 4; ++j)
#pragma unroll
                for (int q = 0; q < 16; ++q) acc[j][q] = 0.f;
            const unsigned char* ub = cb + U_OFF;
            const bf16_t* rsel = (const bf16_t*)(cb + ((r & 1) ? 0 : RK2_OFF));
            const int adj = (r & 1) ? 0 : -1;
            for (int dl = 32 * w4 - 127; dl <= 32 * w4 + 31; ++dl) {
                bf16x8 af[2];
#pragma unroll
                for (int s = 0; s < 2; ++s) {
                    const int e0 = 4095 - 32 * dl - r + 16 * s + 8 * hh + adj;
                    const unsigned* ap = (const unsigned*)(rsel + e0);
                    u32x4 t4; t4.x = ap[0]; t4.y = ap[1]; t4.z = ap[2]; t4.w = ap[3];
                    af[s] = __builtin_bit_cast(bf16x8, t4);
                }
#pragma unroll
                for (int j = 0; j < 4; ++j) {
                    const int J = 4 * w4 + j;
                    if (8 * J + 7 - dl < 0 || 8 * J - dl > 127) continue;
                    const int n1 = 8 * J + (r >> 2), b = r & 3;
                    const unsigned char* bp = ub + ((n1 - dl + 7) * 4 + b) * 64 + hh * 16;
                    const bf16x8 b0 = *(const bf16x8*)(bp), b1 = *(const bf16x8*)(bp + 32);
                    acc[j] = __builtin_amdgcn_mfma_f32_32x32x16_bf16(af[0], b0, acc[j], 0, 0, 0);
                    acc[j] = __builtin_amdgcn_mfma_f32_32x32x16_bf16(af[1], b1, acc[j], 0, 0, 0);
                }
            }
            const float bd = bias[d];
#pragma unroll
            for (int j = 0; j < 4; ++j) {
                const int n1 = 8 * (4 * w4 + j) + (r >> 2), b = r & 3;
                const bf16_t* up = (const bf16_t*)(ub + ((n1 + 7) * 4 + b) * 64);
                const size_t gb = (size_t)d * TL + b * SEQ + n1 * 32;
#pragma unroll
                for (int q = 0; q < 16; ++q) {
                    const int row = (q & 3) + 8 * (q >> 2) + 4 * hh;
                    const float y = acc[j][q] + bd * bf2f(up[row]);
                    HMT[gb + row] = f2bf(bf2f(X0T[gb + row]) * y);
                }
            }
        }
        __syncthreads();
    }
    if (ctx_full) {
        const float* VX = (const float*)(p.ws + WS_Y); const bf16_t* X0 = (const bf16_t*)(p.ws + WS_H);
        bf16_t* MIX = (bf16_t*)(p.ws + WS_MIX);
        const float* kf = (const float*)(p.ws + WS_KF + (size_t)o * SZ_KF) + (size_t)2 * SEQ * D;
        for (int idx = blockIdx.x * 512 + tid; idx < TC * D; idx += gridDim.x * 512) {
            const int tc = idx >> 10, d = idx & 1023; const int n = tc & (CL - 1), tb = TL + (tc - n);
            const float* up = VX + (size_t)tb * D + d;
            float acc = 0.f;
#pragma unroll 4
            for (int m = 0; m < CL; ++m) {
                const int lag = n - m;
                const float kv = (lag >= 0) ? kf[(size_t)lag * D + d] : kf[(size_t)(CL - lag) * D + d];
                acc += up[(size_t)m * D] * kv;
            }
            const size_t ti = (size_t)(TL + tc) * D + d;
            MIX[ti] = f2bf(bf2f(X0[ti]) * (acc + bias[d] * VX[ti]));
        }
    }
}

__device__ void h3b_transpose(const KP& p, unsigned char* smem) {
    const int tid = ltid();
    const bf16_t* HMT = (const bf16_t*)(p.ws + WS_H); bf16_t* MIX = (bf16_t*)(p.ws + WS_MIX);
    bf16_t* tile = (bf16_t*)smem;
    for (int it = blockIdx.x; it < (TL / 64) * 16; it += gridDim.x) {
        const int c0 = (it & 15) * 64, t0 = (it >> 4) * 64;
        __syncthreads();
        { const int ch = tid >> 3, tk = (tid & 7) * 8; *(u32x4*)(tile + ch * 72 + tk) = *(const u32x4*)(HMT + (size_t)(c0 + ch) * TL + t0 + tk); }
        __syncthreads();
        { const int tok = tid >> 3, cg8 = (tid & 7) * 8; unsigned short v[8];
#pragma unroll
          for (int j = 0; j < 8; ++j) v[j] = tile[(cg8 + j) * 72 + tok];
          u32x4 o4; o4.x = v[0] | ((unsigned)v[1] << 16); o4.y = v[2] | ((unsigned)v[3] << 16); o4.z = v[4] | ((unsigned)v[5] << 16); o4.w = v[6] | ((unsigned)v[7] << 16);
          *(u32x4*)(MIX + (size_t)(t0 + tok) * D + c0 + cg8) = o4; }
    }
    __syncthreads();
}

__global__ void __launch_bounds__(512, 2) mega_fwd(KP p) {
    extern __shared__ __attribute__((aligned(16))) unsigned char smem[];
    cg::grid_group grid = cg::this_grid();
    if (threadIdx.x < 4) ((volatile LAS unsigned*)(LAS unsigned char*)smem)[(LDS_BYTES - 16) / 4 + threadIdx.x] = 0u;
    __syncthreads();
    if (threadIdx.x == 0) (void)xb_add(&((unsigned*)(p.ws + WS_BAR))[XB_XCNT(xb_xcc_id())], 1u);
    grid.sync();
    float* smf = (float*)smem;
    bf16_t* Hb = (bf16_t*)(p.ws + WS_H); bf16_t* BIG = (bf16_t*)(p.ws + WS_BIG); float* Y = (float*)(p.ws + WS_Y); bf16_t* MIX = (bf16_t*)(p.ws + WS_MIX);
    const float* npre = p.in[6]; const float* npost = p.in[7];

#ifndef NO_P0
    p0_setup(p, smf);
#endif
    GRID_BAR();
    rowphase(p, 0, nullptr, 0, 0, 0.f, nullptr, T, 0, npre, 0, 1, Hb);
    GRID_BAR();
    for (int l = 0; l < 4; ++l) {
        const bool ctx_live = l <= 2, ctx_full = l < 2;
        const int Mff = ctx_live ? T : TL, Mpost = ctx_full ? T : TL;
        for (int sub = 0; sub < 3; ++sub) {
            if (sub != 1) {
                const int fi = sub >> 1; const int M = (sub == 0) ? Mff : Mpost;
                { pg8::EpiSwiGLU E{BIG, DFF}; run_gemm(smem, Hb, (const bf16_t*)(p.ws + WS_WGU + (size_t)(l * 2 + fi) * SZ_WGU), M, 2 * DFF, D, E); }
                GRID_BAR();
                { pg8::EpiF32 E{Y, D}; run_gemm(smem, BIG, (const bf16_t*)(p.ws + WS_WD + (size_t)(l * 2 + fi) * SZ_WD), M, D, DFF, E); }
                GRID_BAR();
                if (sub == 0) rowphase(p, M, Y, l, 2, 0.5f, npost + (size_t)(l * 3 + 0) * D, Mff, l, npre + (size_t)(l * 3 + 1) * D, 3, 4, Hb);
                else {
                    const int ln = l + 1; const int Mn = (ln < 4) ? ((ln <= 2) ? T : TL) : 0;
                    rowphase(p, M, Y, l, 8, 0.5f, npost + (size_t)(l * 3 + 2) * D, Mn, ln < 4 ? ln : l, npre + (size_t)((ln < 4 ? ln : l) * 3 + 0) * D, 0, 1, ln < 4 ? Hb : nullptr);
                }
                GRID_BAR();
            } else {
                if ((l & 1) == 0) {
                    const int e = l >> 1;
                    { pg8::EpiBf16 E{BIG, INW, nullptr}; run_gemm(smem, Hb, (const bf16_t*)(p.ws + WS_WIN + (size_t)e * SZ_WIN), Mff, INW, D, E); }
                    GRID_BAR();
#ifndef NO_M1
                    m1_rope_states(p, e, smf);
#endif
                    GRID_BAR();
#ifndef NO_M2
                    m2_scan(p, e);
#endif
                    GRID_BAR();
#ifndef NO_M3
                    m3_outputs(p, e, ctx_full, smf);
#endif
                    GRID_BAR();
                    { pg8::EpiF32 E{Y, D}; run_gemm(smem, MIX, (const bf16_t*)(p.ws + WS_WOUT + (size_t)e * SZ_WOUT), Mpost, D, D, E); }
                    GRID_BAR();
                } else {
                    const int o = l >> 1;
                    { pg8::EpiBf16 E{BIG, HYW, p.in[16] + (size_t)o * HYW}; run_gemm(smem, Hb, (const bf16_t*)(p.ws + WS_HWIN + (size_t)o * SZ_HWIN), Mpost, HYW, D, E); }
                    GRID_BAR();
#ifndef NO_H2
                    h2_shortconv(p, o, Mpost, smem);
#endif
                    GRID_BAR();
#ifndef NO_H3
                    h3_longconv(p, o, ctx_full, smem);
#endif
                    GRID_BAR();
                    h3b_transpose(p, smem);
                    GRID_BAR();
                    { pg8::EpiF32 E{Y, D}; run_gemm(smem, MIX, (const bf16_t*)(p.ws + WS_HWOUT + (size_t)o * SZ_WOUT), Mpost, D, D, E); }
                    GRID_BAR();
                }
                rowphase(p, Mpost, Y, l, 5, 1.0f, npost + (size_t)(l * 3 + 1) * D, Mpost, l, npre + (size_t)(l * 3 + 2) * D, 6, 7, Hb);
                GRID_BAR();
            }
        }
    }
}

extern "C" void kernel_launch(void* const* d_in, const int* in_sizes, int n_in, void* d_out, int out_size, void* d_ws, size_t ws_size, hipStream_t stream) {
    static int grid = 0;
    if (grid == 0) {
        if (n_in != 29 || out_size != TL * D || ws_size < WS_END) { fprintf(stderr, "kernel_launch: unexpected shapes: n_in %d out %d ws %zu (need %zu)\n", n_in, out_size, ws_size, (size_t)WS_END); grid = -1; return; }
        int dev = 0, cus = 0, per_cu = 0;
        (void)hipGetDevice(&dev);
        (void)hipDeviceGetAttribute(&cus, hipDeviceAttributeMultiprocessorCount, dev);
        if (hipFuncSetAttribute((const void*)mega_fwd, hipFuncAttributeMaxDynamicSharedMemorySize, LDS_BYTES) != hipSuccess) { fprintf(stderr, "kernel_launch: hipFuncSetAttribute failed\n"); grid = -1; return; }
        if (hipOccupancyMaxActiveBlocksPerMultiprocessor(&per_cu, (const void*)mega_fwd, 512, LDS_BYTES) != hipSuccess || per_cu < 1) { fprintf(stderr, "kernel_launch: occupancy query says %d\n", per_cu); per_cu = 1; }
        (void)hipGetLastError();
        grid = cus;
    }
    if (grid < 0) return;
    (void)hipMemsetAsync((unsigned char*)d_ws + WS_BAR, 0, 16384, stream);
    KP kp{};
    for (int i = 0; i < 29; ++i) kp.in[i] = (const float*)d_in[i];
    kp.out = (float*)d_out; kp.ws = (unsigned char*)d_ws;
    void* args[] = {&kp};
    hipError_t e = hipLaunchCooperativeKernel((const void*)mega_fwd, dim3(grid), dim3(512), args, LDS_BYTES, stream);
    if (e != hipSuccess) fprintf(stderr, "cooperative launch failed: %s (grid %d)\n", hipGetErrorString(e), grid);
}
```

```cpp
#include <hip/hip_runtime.h>
#include <hip/hip_cooperative_groups.h>
#include <cstdio>
namespace cg = cooperative_groups;

#define LAS __attribute__((address_space(3)))
typedef unsigned short bf16_t;
typedef short bf16x8 __attribute__((ext_vector_type(8)));
typedef float f32x4 __attribute__((ext_vector_type(4)));
typedef unsigned u32x4 __attribute__((ext_vector_type(4)));

constexpr int D = 1024, NB = 4, SEQ = 4096, CL = 256, TL = NB * SEQ, TC = NB * CL, T = TL + TC, DFF = 2816, INW = 2816, HYW = 3072;
constexpr int NMOD = 9;
constexpr float EPS = 1e-6f;
constexpr int NCH = 34;
constexpr int LDS_BYTES = 144 * 1024;

constexpr size_t SZ_WGU = (size_t)2 * DFF * D * 2, SZ_WD = (size_t)D * DFF * 2, SZ_WIN = (size_t)INW * D * 2, SZ_WOUT = (size_t)D * D * 2, SZ_HWIN = (size_t)HYW * D * 2;
constexpr size_t WS_WGU = 0;
constexpr size_t WS_WD = WS_WGU + 8 * SZ_WGU;
constexpr size_t WS_WIN = WS_WD + 8 * SZ_WD;
constexpr size_t WS_WOUT = WS_WIN + 2 * SZ_WIN;
constexpr size_t WS_HWIN = WS_WOUT + 2 * SZ_WOUT;
constexpr size_t WS_HWOUT = WS_HWIN + 2 * SZ_HWIN;
constexpr size_t WS_MOD = WS_HWOUT + 2 * SZ_WOUT;
constexpr size_t WS_ROPE = WS_MOD + (size_t)4 * 5 * NMOD * D * 4;
constexpr size_t WS_XC = WS_ROPE + (size_t)4 * SEQ * 32 * 4;
constexpr size_t WS_H = WS_XC + (size_t)TC * D * 4;
constexpr size_t WS_BIG = WS_H + (size_t)T * D * 2;
constexpr size_t WS_Y = WS_BIG + (size_t)T * HYW * 2;
constexpr size_t WS_MIX = WS_Y + (size_t)T * D * 4;
constexpr size_t SZ_ST = (size_t)NB * NCH * 8 * 4096 * 4;
constexpr size_t WS_ST = WS_MIX + (size_t)T * D * 2;
constexpr size_t SZ_KF = (size_t)(SEQ + CL) * 2 * D * 4;
constexpr size_t WS_KF = WS_ST + 4 * SZ_ST;
constexpr size_t WS_BAR = WS_KF + 2 * SZ_KF;
constexpr size_t WS_END = WS_BAR + 16384;

struct KP { const float* in[29]; float* out; unsigned char* ws; };

__device__ __forceinline__ bf16_t f2bf(float f) { unsigned u = __float_as_uint(f); u += 0x7FFFu + ((u >> 16) & 1u); return (bf16_t)(u >> 16); }
__device__ __forceinline__ float bf2f(bf16_t b) { return __uint_as_float(((unsigned)b) << 16); }
__device__ __forceinline__ float silu_f(float x) { return x / (1.0f + __expf(-x)); }
__device__ __forceinline__ int ltid() { int t = threadIdx.x; asm volatile("" : "+v"(t)); return t; }
__device__ __forceinline__ float wave_sum(float v) {
#pragma unroll
    for (int o = 32; o > 0; o >>= 1) v += __shfl_xor(v, o, 64);
    return v;
}


#define XB_TMO      128
#define XB_XCNT(j)  (256  + 64 * (j))
#define XB_XSUB(j)  (1280 + 64 * (j))
#define XB_XGEN(j)  (2304 + 64 * (j))
#define XB_TOP      3328
#define XB_TOPGEN   3392
#define XCD_BAR_WORDS 3456
#define XB_SPIN_CAP (1u << 18)
__device__ __forceinline__ unsigned xb_ld(unsigned* p)              { return __hip_atomic_load(p, __ATOMIC_RELAXED, __HIP_MEMORY_SCOPE_AGENT); }
__device__ __forceinline__ unsigned xb_add(unsigned* p, unsigned v) { return __hip_atomic_fetch_add(p, v, __ATOMIC_RELAXED, __HIP_MEMORY_SCOPE_AGENT); }
__device__ __forceinline__ unsigned xb_xcc_id() { return (unsigned)__builtin_amdgcn_s_getreg((3 << 11) | 20) & 0xFu; }
#define XB_SPIN(cond, bar) do { unsigned _sp = 0; while (cond) { __builtin_amdgcn_s_sleep(1); \
    if ((++_sp & 255u) == 0u) { if (xb_ld(&(bar)[XB_TMO])) break; if (_sp > XB_SPIN_CAP) { atomicAdd(&(bar)[XB_TMO], 1u); break; } } } } while (0)
struct XcdBarrier { unsigned* bar; unsigned x; volatile LAS unsigned* st; };
__device__ __forceinline__ XcdBarrier xcd_barrier_post(unsigned* bar, volatile LAS unsigned* st) {
    XcdBarrier b; b.bar = bar; b.x = xb_xcc_id(); b.st = st;
    if (threadIdx.x == 0) (void)xb_add(&bar[XB_XCNT(b.x)], 1u);
    return b;
}
__device__ __forceinline__ void xcd_barrier_complete(unsigned* bar, unsigned x, unsigned& nloc, unsigned& nx) {
    const unsigned G = gridDim.x * gridDim.y * gridDim.z;
    unsigned sum, cnt, mine, sp = 0u;
    for (;;) {
        sum = 0u; cnt = 0u; mine = 0u;
#pragma unroll
        for (unsigned j = 0; j < 16; ++j) { const unsigned c = xb_ld(&bar[XB_XCNT(j)]); sum += c; cnt += (c > 0u) ? 1u : 0u; mine = (j == x) ? c : mine; }
        if (sum == G) break;
        __builtin_amdgcn_s_sleep(1);
        if ((++sp & 255u) == 0u) { if (xb_ld(&bar[XB_TMO])) break; if (sp > XB_SPIN_CAP) { atomicAdd(&bar[XB_TMO], 1u); break; } }
    }
    nloc = mine > 0u ? mine : 1u; nx = cnt > 0u ? cnt : 1u;
}
__device__ __forceinline__ void xcd_barrier_impl(unsigned* bar, volatile LAS unsigned* st) {
    asm volatile("s_waitcnt vmcnt(0)" ::: "memory");
    __syncthreads();
    if (ltid() == 0) {
        const unsigned x = xb_xcc_id();
        __builtin_amdgcn_s_waitcnt(0);
        unsigned nloc = st[0], nx = st[1];
        if (nloc == 0u) { xcd_barrier_complete(bar, x, nloc, nx); st[0] = nloc; st[1] = nx; }
        const unsigned old = xb_add(&bar[XB_XSUB(x)], 1u);
        const unsigned gen = old / nloc;
        if (old + 1u == (gen + 1u) * nloc) {
            __builtin_amdgcn_fence(__ATOMIC_RELEASE, "agent");
            asm volatile("s_waitcnt vmcnt(0)" ::: "memory");
            const unsigned og = xb_add(&bar[XB_TOP], 1u);
            const unsigned tg = og / nx;
            if (og + 1u == (tg + 1u) * nx) xb_add(&bar[XB_TOPGEN], 1u);
            else XB_SPIN(xb_ld(&bar[XB_TOPGEN]) == tg, bar);
            __builtin_amdgcn_fence(__ATOMIC_ACQUIRE, "agent");
            xb_add(&bar[XB_XGEN(x)], 1u);
            asm volatile("s_waitcnt vmcnt(0)" ::: "memory");
        } else {
            XB_SPIN(xb_ld(&bar[XB_XGEN(x)]) == gen, bar);
            __builtin_amdgcn_fence(__ATOMIC_ACQUIRE, "agent");
            asm volatile("s_waitcnt vmcnt(0)" ::: "memory");
        }
    }
    __syncthreads();
}
#define GRID_BAR() xcd_barrier_impl((unsigned*)(p.ws + WS_BAR), (volatile LAS unsigned*)((LAS unsigned char*)smem + LDS_BYTES - 16))

namespace pg8 {
constexpr int BM = 256, BK = 64, HALF = 128, HTB = HALF * BK * 2, STAGE_BYTES = 8 * HTB, NXCD = 8, WGM = 8;
__host__ __device__ __forceinline__ int lds_byte(int r, int c) { const int st = (r >> 4) * 2 + (c >> 5), rr = r & 15, cc = c & 31, ob = rr * 64 + cc * 2; return st * 1024 + (ob ^ (((ob >> 9) & 1) << 5)); }
__host__ __device__ __forceinline__ void stage_rc(int b, int& R, int& C) { const int st = b / 1024, sb = b % 1024, swz = sb ^ (((sb >> 9) & 1) << 5); R = (st >> 1) * 16 + swz / 64; C = (st & 1) * 32 + (swz % 64) / 2; }
__host__ __device__ __forceinline__ int perm32(int rho) { const int n = rho >> 4, i = rho & 15; return 8 * (i >> 2) + 4 * n + (i & 3); }
struct Unit { int pm, pn; };
struct Gemm { const bf16_t* A; const bf16_t* Bt; int M, N, K; };
struct StaticOrder {
    int nM, nN, nwg, G, c;
    __device__ void init(int M, int N, int G_, int c_) { nM = M / BM; nN = N / BM; nwg = nM * nN; G = G_; c = c_; }
    __device__ bool next(int i, Unit& u) const {
        const long Lx = (long)i * G + c; if (Lx >= nwg) return false;
        int wgid = (int)Lx; { const int q = nwg / NXCD, r = nwg % NXCD, xcd = wgid % NXCD, off = wgid / NXCD; wgid = (xcd < r ? xcd * (q + 1) : r * (q + 1) + (xcd - r) * q) + off; }
        const int nig = WGM * nN, gid = wgid / nig, fm = gid * WGM, gsz = (nM - fm) < WGM ? (nM - fm) : WGM;
        u.pm = fm + ((wgid % nig) % gsz); u.pn = (wgid % nig) / gsz; return true;
    }
};
__device__ __forceinline__ unsigned cvt_pk_bf16(float lo, float hi) { unsigned r; asm volatile("v_cvt_pk_bf16_f32 %0, %1, %2" : "=v"(r) : "v"(lo), "v"(hi)); return r; }

struct EpiF32 {
    static constexpr bool PERM = false;
    float* C; int ldc;
    __device__ __forceinline__ void operator()(const f32x4 (&acc)[2][2][4][2], const Unit& u, int wr, int wc, int fr, int fq) const {
        const int row0 = u.pm * BM + wr * 64 + fr, col0 = u.pn * BM + wc * 32 + 4 * fq;
#pragma unroll
        for (int ai = 0; ai < 2; ++ai)
#pragma unroll
            for (int m = 0; m < 4; ++m) { float* rowp = C + (size_t)(row0 + ai * HALF + m * 16) * ldc + col0;
#pragma unroll
                for (int bj = 0; bj < 2; ++bj)
#pragma unroll
                    for (int n = 0; n < 2; ++n) *(f32x4*)(rowp + bj * HALF + n * 16) = acc[ai][bj][m][n]; }
    }
};
struct EpiBf16 {
    static constexpr bool PERM = true;
    bf16_t* O; int ldc; const float* bias;
    __device__ __forceinline__ void operator()(const f32x4 (&acc)[2][2][4][2], const Unit& u, int wr, int wc, int fr, int fq) const {
        const int row0 = u.pm * BM + wr * 64 + fr; const int col0 = u.pn * BM + wc * 32 + 8 * fq;
        f32x4 bv[2][2];
#pragma unroll
        for (int bj = 0; bj < 2; ++bj)
#pragma unroll
            for (int n = 0; n < 2; ++n) bv[bj][n] = bias ? *(const f32x4*)(bias + col0 + bj * HALF + 4 * n) : (f32x4){0.f, 0.f, 0.f, 0.f};
#pragma unroll
        for (int ai = 0; ai < 2; ++ai)
#pragma unroll
            for (int m = 0; m < 4; ++m) { bf16_t* rowp = O + (size_t)(row0 + ai * HALF + m * 16) * ldc + col0;
#pragma unroll
                for (int bj = 0; bj < 2; ++bj) { f32x4 v0 = acc[ai][bj][m][0] + bv[bj][0], v1 = acc[ai][bj][m][1] + bv[bj][1];
                    u32x4 w; w.x = cvt_pk_bf16(v0[0], v0[1]); w.y = cvt_pk_bf16(v0[2], v0[3]); w.z = cvt_pk_bf16(v1[0], v1[1]); w.w = cvt_pk_bf16(v1[2], v1[3]);
                    *(u32x4*)(rowp + bj * HALF) = w; } }
    }
};
struct EpiSwiGLU {
    static constexpr bool PERM = true;
    bf16_t* O; int ldc;
    __device__ __forceinline__ void operator()(const f32x4 (&acc)[2][2][4][2], const Unit& u, int wr, int wc, int fr, int fq) const {
        const int row0 = u.pm * BM + wr * 64 + fr; const int col0 = u.pn * HALF + wc * 32 + 8 * fq;
#pragma unroll
        for (int ai = 0; ai < 2; ++ai)
#pragma unroll
            for (int m = 0; m < 4; ++m) { bf16_t* rowp = O + (size_t)(row0 + ai * HALF + m * 16) * ldc + col0;
                float v[8];
#pragma unroll
                for (int n = 0; n < 2; ++n)
#pragma unroll
                    for (int j = 0; j < 4; ++j) { const float g = acc[ai][0][m][n][j], up = acc[ai][1][m][n][j]; v[n * 4 + j] = silu_f(g) * up; }
                u32x4 w; w.x = cvt_pk_bf16(v[0], v[1]); w.y = cvt_pk_bf16(v[2], v[3]); w.z = cvt_pk_bf16(v[4], v[5]); w.w = cvt_pk_bf16(v[6], v[7]);
                *(u32x4*)rowp = w; }
    }
};

template <class Epi, class Sched>
__device__ __forceinline__ void gemm_phase(LAS unsigned char* lds, const Gemm g, const Sched& S, const Epi& E) {
    const int tid = ltid(), wid = __builtin_amdgcn_readfirstlane(tid >> 6), lane = tid & 63, wr = wid >> 2, wc = wid & 3, fr = lane & 15, fq = lane >> 4;
    const int K = g.K, nt = K / BK;
    unsigned voffA[2], voffB[2];
#pragma unroll
    for (int i = 0; i < 2; ++i) { int R, C; stage_rc(tid * 16 + i * 8192, R, C); const int Rb = Epi::PERM ? ((R & ~31) + perm32(R & 31)) : R;
        voffA[i] = (unsigned)(R * K + C) * 2u; voffB[i] = (unsigned)(Rb * K + C) * 2u; }
    const size_t kstep = (size_t)(BK * 2);
    const size_t hstep = (size_t)HALF * K * 2;
    const size_t tstep = 2 * hstep;
    const unsigned ldsw = (unsigned)wid * 1024u;
    const int aoff = lds_byte(wr * 64 + fr, fq * 8), boff = lds_byte(wc * 32 + fr, fq * 8);
#define PG8_SA(b, h) (((b) * 2 + (h)) * HTB)
#define PG8_SB(b, h) ((4 + (b) * 2 + (h)) * HTB)
#define PG8_STAGE(bufoff, gbase, voff) do { _Pragma("unroll") for (int _i = 0; _i < 2; ++_i) \
        __builtin_amdgcn_global_load_lds((const unsigned*)((const char*)(gbase) + (voff)[_i]), (LAS unsigned*)(lds + (bufoff) + ldsw + _i * 8192), 16, 0, 0); } while (0)
#define PG8_LDA(dst, b, h) do { _Pragma("unroll") for (int m = 0; m < 4; ++m) _Pragma("unroll") for (int k = 0; k < 2; ++k) dst[m][k] = *(const LAS bf16x8*)(lds + PG8_SA(b, h) + aoff + m * 2048 + k * 1024); } while (0)
#define PG8_LDB(dst, b, h) do { _Pragma("unroll") for (int n = 0; n < 2; ++n) _Pragma("unroll") for (int k = 0; k < 2; ++k) dst[n][k] = *(const LAS bf16x8*)(lds + PG8_SB(b, h) + boff + n * 2048 + k * 1024); } while (0)
#define PG8_MMA(ai, bj, At, Bt) do { __builtin_amdgcn_s_setprio(1); _Pragma("unroll") for (int m = 0; m < 4; ++m) _Pragma("unroll") for (int n = 0; n < 2; ++n) _Pragma("unroll") for (int k = 0; k < 2; ++k) \
        acc[ai][bj][m][n] = __builtin_amdgcn_mfma_f32_16x16x32_bf16(Bt[n][k], At[m][k], acc[ai][bj][m][n], 0, 0, 0); __builtin_amdgcn_s_setprio(0); } while (0)
#define PG8_WAIT_V(n) asm volatile("s_waitcnt vmcnt(" #n ")" ::: "memory")
#define PG8_WAIT_L(n) asm volatile("s_waitcnt lgkmcnt(" #n ")" ::: "memory")
#define PG8_BAR __builtin_amdgcn_s_barrier()
#define PG8_SCHED __builtin_amdgcn_sched_barrier(0)
    Unit cur, nxt; int ui = 0;
    if (!S.next(0, cur)) return;
    f32x4 acc[2][2][4][2];
#pragma unroll
    for (int a = 0; a < 2; ++a)
#pragma unroll
        for (int b = 0; b < 2; ++b)
#pragma unroll
            for (int m = 0; m < 4; ++m)
#pragma unroll
                for (int n = 0; n < 2; ++n) acc[a][b][m][n] = (f32x4){0.f, 0.f, 0.f, 0.f};
    bf16x8 At[4][2], B0[2][2], B1[2][2];
    const char* cA = (const char*)g.A + (size_t)cur.pm * tstep; const char* cB = (const char*)g.Bt + (size_t)cur.pn * tstep;
    PG8_STAGE(PG8_SB(0, 0), cB, voffB); PG8_STAGE(PG8_SA(0, 0), cA, voffA); PG8_STAGE(PG8_SB(0, 1), cB + hstep, voffB); PG8_STAGE(PG8_SA(0, 1), cA + hstep, voffA);
    if (wr == 1) PG8_BAR;
    PG8_WAIT_V(4); PG8_BAR;
    PG8_STAGE(PG8_SB(1, 0), cB + kstep, voffB); PG8_STAGE(PG8_SA(1, 0), cA + kstep, voffA); PG8_STAGE(PG8_SB(1, 1), cB + hstep + kstep, voffB);
    PG8_WAIT_V(6); PG8_BAR;
    for (;;) {
        const bool has_next = S.next(ui + 1, nxt);
        const char* nA = has_next ? (const char*)g.A + (size_t)nxt.pm * tstep : cA; const char* nB = has_next ? (const char*)g.Bt + (size_t)nxt.pn * tstep : cB;
        for (int t = 0; t < nt; t += 2) {
            const bool last = (t == nt - 2);
            const char* a1 = cA + (size_t)(t + 1) * kstep;
            const char* a2 = last ? nA : cA + (size_t)(t + 2) * kstep; const char* b2 = last ? nB : cB + (size_t)(t + 2) * kstep;
            const char* a3 = a2 + kstep; const char* b3 = b2 + kstep;
            PG8_LDB(B0, 0, 0); PG8_SCHED; PG8_LDA(At, 0, 0); PG8_STAGE(PG8_SA(1, 1), a1 + hstep, voffA);
            PG8_WAIT_L(8); PG8_BAR; PG8_WAIT_L(0); PG8_MMA(0, 0, At, B0); PG8_BAR; PG8_SCHED;
            PG8_LDB(B1, 0, 1); PG8_STAGE(PG8_SB(0, 0), b2, voffB);
            PG8_BAR; PG8_WAIT_L(0); PG8_MMA(0, 1, At, B1); PG8_BAR;
            PG8_LDA(At, 0, 1); PG8_STAGE(PG8_SA(0, 0), a2, voffA);
            PG8_BAR; PG8_WAIT_L(0); PG8_MMA(1, 0, At, B0); PG8_BAR; PG8_SCHED;
            PG8_STAGE(PG8_SB(0, 1), b2 + hstep, voffB);
            PG8_WAIT_V(6); PG8_BAR; PG8_MMA(1, 1, At, B1); PG8_BAR;
            PG8_LDB(B0, 1, 0); PG8_SCHED; PG8_LDA(At, 1, 0); PG8_STAGE(PG8_SA(0, 1), a2 + hstep, voffA);
            PG8_WAIT_L(8); PG8_BAR; PG8_WAIT_L(0); PG8_MMA(0, 0, At, B0); PG8_BAR; PG8_SCHED;
            PG8_LDB(B1, 1, 1); PG8_STAGE(PG8_SB(1, 0), b3, voffB);
            PG8_BAR; PG8_WAIT_L(0); PG8_MMA(0, 1, At, B1); PG8_BAR;
            PG8_LDA(At, 1, 1); PG8_STAGE(PG8_SA(1, 0), a3, voffA);
            PG8_BAR; PG8_WAIT_L(0); PG8_MMA(1, 0, At, B0); PG8_BAR; PG8_SCHED;
            PG8_STAGE(PG8_SB(1, 1), b3 + hstep, voffB);
            PG8_WAIT_V(6); PG8_BAR; PG8_MMA(1, 1, At, B1); PG8_BAR;
        }
        E(acc, cur, wr, wc, fr, fq);
        if (!has_next) break;
#pragma unroll
        for (int a = 0; a < 2; ++a)
#pragma unroll
            for (int b = 0; b < 2; ++b)
#pragma unroll
                for (int m = 0; m < 4; ++m)
#pragma unroll
                    for (int n = 0; n < 2; ++n) acc[a][b][m][n] = (f32x4){0.f, 0.f, 0.f, 0.f};
        cur = nxt; cA = nA; cB = nB; ++ui;
    }
    PG8_WAIT_V(0);
    if (wr == 0) PG8_BAR;
    PG8_BAR;
#undef PG8_SA
#undef PG8_SB
#undef PG8_STAGE
#undef PG8_LDA
#undef PG8_LDB
#undef PG8_MMA
#undef PG8_WAIT_V
#undef PG8_WAIT_L
#undef PG8_BAR
#undef PG8_SCHED
}
}

template <class Epi>
__device__ __forceinline__ void run_gemm(unsigned char* smem, const bf16_t* A, const bf16_t* Bt, int M, int N, int K, const Epi& E) {
    pg8::Gemm g{A, Bt, M, N, K}; pg8::StaticOrder S; S.init(M, N, (int)gridDim.x, (int)blockIdx.x);
    pg8::gemm_phase<Epi, pg8::StaticOrder>((LAS unsigned char*)smem, g, S, E);
}

__device__ __forceinline__ float* xrow(const KP& p, int t) { return t < TL ? p.out + (size_t)t * D : (float*)(p.ws + WS_XC) + (size_t)(t - TL) * D; }
__device__ __forceinline__ int modrow(int t) { return t < TL ? (t >> 12) : 4; }
__device__ __forceinline__ const float* modp(const KP& p, int l, int mr, int idx) { return (const float*)(p.ws + WS_MOD) + ((size_t)(l * 5 + mr) * NMOD + idx) * D; }

__device__ void p0_setup(const KP& p, float* sm) {
    const int tid = ltid(), bid = blockIdx.x, nb = gridDim.x;
    const int gtid = bid * 512 + tid, gthreads = nb * 512;
    {
        const float4* xs = (const float4*)p.in[0]; float4* xd = (float4*)p.out;
        for (int i = gtid; i < TL * D / 4; i += gthreads) xd[i] = xs[i];
        const float4* cs = (const float4*)p.in[2]; float4* cd = (float4*)(p.ws + WS_XC);
        for (int i = gtid; i < TC * D / 4; i += gthreads) cd[i] = cs[i];
    }
    {
        float* rope = (float*)(p.ws + WS_ROPE);
        for (int idx = gtid; idx < SEQ * 32; idx += gthreads) {
            const int t = idx >> 5, i = idx & 31;
            const int ii = i & 15; const float pos = (i < 16) ? (float)(t >> 6) : (float)(t & 63);
            const float invA = powf(10000.0f, -(float)ii / 16.0f);
            const float angA = pos * invA;
            rope[idx] = cosf(angA); rope[SEQ * 32 + idx] = sinf(angA);
            const float ex = (float)i * (1.0f / 31.0f);
            const float invR = powf(10000.0f, -ex);
            const float angR = (float)t * invR;
            rope[2 * SEQ * 32 + idx] = cosf(angR); rope[3 * SEQ * 32 + idx] = sinf(angR);
        }
    }
    {
        float* tile = sm;
        for (int g = bid; g < 20864; g += nb) {
            int j, tl;
            if (g < 16896) { j = g / 704; tl = g % 704; }
            else if (g < 18304) { j = 24 + (g - 16896) / 704; tl = (g - 16896) % 704; }
            else if (g < 18816) { j = 26 + (g - 18304) / 256; tl = (g - 18304) % 256; }
            else if (g < 20352) { j = 28 + (g - 18816) / 768; tl = (g - 18816) % 768; }
            else { j = 30 + (g - 20352) / 256; tl = (g - 20352) % 256; }
            const float* src; bf16_t* dst; int K, N, mode = 0;
            if (j < 8) { src = p.in[8] + (size_t)j * D * DFF; dst = (bf16_t*)(p.ws + WS_WGU + (size_t)j * SZ_WGU); K = D; N = DFF; mode = 1; }
            else if (j < 16) { src = p.in[9] + (size_t)(j - 8) * D * DFF; dst = (bf16_t*)(p.ws + WS_WGU + (size_t)(j - 8) * SZ_WGU); K = D; N = DFF; mode = 2; }
            else if (j < 24) { src = p.in[10] + (size_t)(j - 16) * DFF * D; dst = (bf16_t*)(p.ws + WS_WD + (size_t)(j - 16) * SZ_WD); K = DFF; N = D; }
            else if (j < 26) { src = p.in[11] + (size_t)(j - 24) * D * INW; dst = (bf16_t*)(p.ws + WS_WIN + (size_t)(j - 24) * SZ_WIN); K = D; N = INW; mode = 3; }
            else if (j < 28) { src = p.in[14] + (size_t)(j - 26) * D * D; dst = (bf16_t*)(p.ws + WS_WOUT + (size_t)(j - 26) * SZ_WOUT); K = D; N = D; }
            else if (j < 30) { src = p.in[15] + (size_t)(j - 28) * D * HYW; dst = (bf16_t*)(p.ws + WS_HWIN + (size_t)(j - 28) * SZ_HWIN); K = D; N = HYW; }
            else { src = p.in[28] + (size_t)(j - 30) * D * D; dst = (bf16_t*)(p.ws + WS_HWOUT + (size_t)(j - 30) * SZ_WOUT); K = D; N = D; }
            const int ntn = N / 64; const int k0 = (tl / ntn) * 64, n0 = (tl % ntn) * 64;
            __syncthreads();
#pragma unroll
            for (int i = 0; i < 8; ++i) { const int k = i * 8 + (tid >> 6), n = tid & 63; tile[k * 65 + n] = src[(size_t)(k0 + k) * N + n0 + n]; }
            __syncthreads();
#pragma unroll
            for (int i = 0; i < 8; ++i) {
                const int n = i * 8 + (tid >> 6), k = tid & 63; const int gn = n0 + n;
                float v = tile[k * 65 + n];
                int row = gn;
                if (mode == 1) row = 256 * (gn >> 7) + (gn & 127);
                else if (mode == 2) row = 256 * (gn >> 7) + 128 + (gn & 127);
                else if (mode == 3) { if (gn < 512 || (gn >= 1792 && gn < 2304)) v *= 0.125f; }
                dst[(size_t)row * K + k0 + k] = f2bf(v);
            }
        }
        __syncthreads();
    }
    {
        float* sc = sm;
        float* red = sm + 5 * 1024;
        for (int i = tid; i < 5 * 1024; i += 512) { const int r = i >> 10, k = i & 1023; const float v = (r < 4) ? p.in[1][r * D + k] : p.in[3][k]; sc[i] = silu_f(v); }
        __syncthreads();
        const int w = tid >> 6, lane = tid & 63;
        for (int it = bid; it < 288; it += nb) {
            const int l = it / 72, c0 = (it % 72) * 128;
            const float* wm = p.in[4] + (size_t)l * D * (NMOD * D) + c0 + 2 * lane;
            float a[5][2];
#pragma unroll
            for (int r = 0; r < 5; ++r) { a[r][0] = 0.f; a[r][1] = 0.f; }
            for (int k = w * 128; k < w * 128 + 128; ++k) {
                const float2 wv = *(const float2*)(wm + (size_t)k * (NMOD * D));
#pragma unroll
                for (int r = 0; r < 5; ++r) { const float s = sc[r * 1024 + k]; a[r][0] += s * wv.x; a[r][1] += s * wv.y; }
            }
#pragma unroll
            for (int r = 0; r < 5; ++r) { red[(w * 5 + r) * 128 + 2 * lane] = a[r][0]; red[(w * 5 + r) * 128 + 2 * lane + 1] = a[r][1]; }
            __syncthreads();
            for (int i = tid; i < 5 * 128; i += 512) {
                const int r = i >> 7, c = i & 127; float s = 0.f;
#pragma unroll
                for (int ww = 0; ww < 8; ++ww) s += red[(ww * 5 + r) * 128 + c];
                s += p.in[5][(size_t)l * (NMOD * D) + c0 + c];
                ((float*)(p.ws + WS_MOD))[(size_t)(l * 5 + r) * (NMOD * D) + c0 + c] = s;
            }
            __syncthreads();
        }
    }
    {
        float* z = sm;
        float* a1 = sm + 16 * 36;
        float* a2 = a1 + 16 * 64;
        float* a3 = a2 + 16 * 64;
        float* tl = a3 + 16 * 64;
        const float HMAX = -4.605170185988091f / 0.3f, HMIN = -4.605170185988091f / 1.5f;
        for (int it = bid; it < 544; it += nb) {
            const int o = it / 272, r = it % 272;
            const int Lf = (r < 256) ? SEQ : CL; const int p0 = (r < 256) ? r * 16 : (r - 256) * 16;
            float* kf = (float*)(p.ws + WS_KF + (size_t)o * SZ_KF) + ((r < 256) ? (size_t)0 : (size_t)2 * SEQ * D);
            const float* f0 = p.in[19] + (size_t)o * 33 * 64; const float* fb0 = p.in[20] + o * 64;
            const float* f1 = p.in[21] + (size_t)o * 64 * 64; const float* fb1 = p.in[22] + o * 64;
            const float* f2 = p.in[23] + (size_t)o * 64 * 64; const float* fb2 = p.in[24] + o * 64;
            const float* f3 = p.in[25] + (size_t)o * 64 * 2048; const float* fq = p.in[26] + o * 64;
            __syncthreads();
            for (int idx = tid; idx < 16 * 33; idx += 512) {
                const int ps = idx / 33, f = idx % 33; const int i = p0 + ps;
                const float tlin = (float)i * (1.0f / (float)(Lf - 1));
                const float w = (6.283185307179586f * (float)i) / (float)Lf;
                float v;
                if (f == 0) { v = tlin; tl[ps] = tlin; }
                else { const int jj = (f - 1) & 15; const float fj = 1e-4f + (float)jj * ((15.0f - 1e-4f) / 15.0f); v = (f <= 16) ? cosf(fj * w) : -sinf(fj * w); }
                z[ps * 36 + f] = v;
            }
            __syncthreads();
            for (int idx = tid; idx < 16 * 64; idx += 512) { const int ps = idx >> 6, oc = idx & 63; float s = fb0[oc];
                for (int f = 0; f < 33; ++f) s += z[ps * 36 + f] * f0[f * 64 + oc];
                a1[idx] = sinf(fq[oc] * s); }
            __syncthreads();
            for (int idx = tid; idx < 16 * 64; idx += 512) { const int ps = idx >> 6, oc = idx & 63; float s = fb1[oc];
                for (int f = 0; f < 64; ++f) s += a1[ps * 64 + f] * f1[f * 64 + oc];
                a2[idx] = sinf(fq[oc] * s); }
            __syncthreads();
            for (int idx = tid; idx < 16 * 64; idx += 512) { const int ps = idx >> 6, oc = idx & 63; float s = fb2[oc];
                for (int f = 0; f < 64; ++f) s += a2[ps * 64 + f] * f2[f * 64 + oc];
                a3[idx] = sinf(fq[oc] * s); }
            __syncthreads();
            for (int q = 0; q < 4; ++q) {
                const int c = tid + 512 * q; const int dir = c >> 10, d = c & 1023;
                float acc[16];
#pragma unroll
                for (int ps = 0; ps < 16; ++ps) acc[ps] = 0.f;
                for (int f = 0; f < 64; ++f) { const float wv = f3[f * 2048 + c];
#pragma unroll
                    for (int ps = 0; ps < 16; ++ps) acc[ps] += a3[ps * 64 + f] * wv; }
                const float delta = fabsf(HMIN + (float)d * ((HMAX - HMIN) / 1023.0f));
#pragma unroll
                for (int ps = 0; ps < 16; ++ps) {
                    const float kvv = acc[ps] * expf(-tl[ps] * delta);
                    if (r < 256) {
                        bf16_t* rk = (bf16_t*)(p.ws + WS_KF + (size_t)o * SZ_KF) + (size_t)d * 8192;
                        const int m = p0 + ps;
                        if (dir == 0) rk[4095 - m] = f2bf(kvv); else if (m > 0) rk[4095 + m] = f2bf(kvv);
                        if (dir == 0 && m == 0) rk[8191] = 0;
                    } else kf[((size_t)dir * Lf + p0 + ps) * D + d] = kvv;
                }
            }
        }
        __syncthreads();
    }
}

__device__ void rowphase(const KP& p, int Mupd, const float* Y, int lu, int gidx, float wgt, const float* gpost,
                         int Mnext, int ln, const float* gpre, int shidx, int scidx, bf16_t* Hout) {
    const int tid = ltid(), w = tid >> 6, lane = tid & 63;
    const int Mmax = Mupd > Mnext ? Mupd : Mnext;
    for (int t = blockIdx.x * 8 + w; t < Mmax; t += gridDim.x * 8) {
        float* xr = xrow(p, t); const int mr = modrow(t);
        float4 xv[4];
#pragma unroll
        for (int q = 0; q < 4; ++q) xv[q] = *(const float4*)(xr + q * 256 + lane * 4);
        if (Y != nullptr && t < Mupd) {
            float4 yv[4]; float ss = 0.f;
#pragma unroll
            for (int q = 0; q < 4; ++q) { yv[q] = *(const float4*)(Y + (size_t)t * D + q * 256 + lane * 4); ss += yv[q].x * yv[q].x + yv[q].y * yv[q].y + yv[q].z * yv[q].z + yv[q].w * yv[q].w; }
            ss = wave_sum(ss);
            const float r = rsqrtf(ss * (1.0f / D) + EPS) * wgt;
            const float* gm = modp(p, lu, mr, gidx);
#pragma unroll
            for (int q = 0; q < 4; ++q) {
                const float4 g4 = *(const float4*)(gm + q * 256 + lane * 4); const float4 p4 = *(const float4*)(gpost + q * 256 + lane * 4);
                xv[q].x += r * g4.x * yv[q].x * p4.x; xv[q].y += r * g4.y * yv[q].y * p4.y; xv[q].z += r * g4.z * yv[q].z * p4.z; xv[q].w += r * g4.w * yv[q].w * p4.w;
                *(float4*)(xr + q * 256 + lane * 4) = xv[q];
            }
        }
        if (Hout != nullptr && t < Mnext) {
            float ss = 0.f;
#pragma unroll
            for (int q = 0; q < 4; ++q) ss += xv[q].x * xv[q].x + xv[q].y * xv[q].y + xv[q].z * xv[q].z + xv[q].w * xv[q].w;
            ss = wave_sum(ss);
            const float r = rsqrtf(ss * (1.0f / D) + EPS);
            const float* sh = modp(p, ln, mr, shidx); const float* sc = modp(p, ln, mr, scidx);
#pragma unroll
            for (int q = 0; q < 4; ++q) {
                const float4 g4 = *(const float4*)(gpre + q * 256 + lane * 4); const float4 s4 = *(const float4*)(sc + q * 256 + lane * 4); const float4 h4 = *(const float4*)(sh + q * 256 + lane * 4);
                const float h0 = xv[q].x * r * g4.x * (1.0f + s4.x) + h4.x, h1 = xv[q].y * r * g4.y * (1.0f + s4.y) + h4.y;
                const float h2 = xv[q].z * r * g4.z * (1.0f + s4.z) + h4.z, h3 = xv[q].w * r * g4.w * (1.0f + s4.w) + h4.w;
                uint2 pk; pk.x = (unsigned)f2bf(h0) | ((unsigned)f2bf(h1) << 16); pk.y = (unsigned)f2bf(h2) | ((unsigned)f2bf(h3) << 16);
                *(uint2*)(Hout + (size_t)t * D + q * 256 + lane * 4) = pk;
            }
        }
    }
}

__device__ __forceinline__ float log_sigmoid(float x) { return -log1pf(expf(-x)); }
__device__ __forceinline__ int chunk_t0(int b, int cidx) { return cidx < 32 ? b * SEQ + cidx * 128 : TL + b * CL + (cidx - 32) * 128; }

__device__ void m1_rope_states(const KP& p, int e, float* sm) {
    const int tid = ltid(), bid = blockIdx.x, nb = gridDim.x;
    bf16_t* Z = (bf16_t*)(p.ws + WS_BIG);
    const float* rope = (const float*)(p.ws + WS_ROPE);
    for (int idx = bid * 512 + tid; idx < TL * 576; idx += nb * 512) {
        const int t = idx / 576, r = idx % 576; const int hd = r >> 5, i = r & 31;
        const int cb = hd < 16 ? hd * 64 : 1536 + (hd - 16) * 64;
        const int tb = (hd >= 8 && hd < 16) ? 2 : 0; const int pos = t & (SEQ - 1);
        const float c = rope[(size_t)tb * SEQ * 32 + pos * 32 + i], s = rope[(size_t)(tb + 1) * SEQ * 32 + pos * 32 + i];
        bf16_t* zp = Z + (size_t)t * INW + cb + i;
        const float x1 = bf2f(zp[0]), x2 = bf2f(zp[32]);
        zp[0] = f2bf(x1 * c - x2 * s); zp[32] = f2bf(x1 * s + x2 * c);
    }
    float* Ks = sm;
    float* Vs = sm + 128 * 64;
    float* wf = Vs + 128 * 64;
    float* wb = wf + 128;
    float* AF = (float*)(p.ws + WS_ST); float* AB = AF + SZ_ST / 4;
    const float* dec = p.in[13] + e * 16;
    for (int it = bid; it < NB * NCH * 8; it += nb) {
        const int h = it & 7, cidx = (it >> 3) % NCH, b = it / (8 * NCH);
        const int t0 = chunk_t0(b, cidx); const bool lat = cidx < 32;
        const float lgf = log_sigmoid(dec[h]), lgb = log_sigmoid(dec[8 + h]);
        __syncthreads();
        if (tid < 128) { wf[tid] = expf(lgf * (float)(127 - tid)); wb[tid] = expf(lgb * (float)tid); }
        const int kc = 1792 + h * 64, vc = 2304 + h * 64;
#pragma unroll
        for (int q = 0; q < 8; ++q) {
            const int idx = tid + 512 * q; const int r = idx >> 5, i = idx & 31;
            bf16_t* zp = Z + (size_t)(t0 + r) * INW + kc + i;
            float x1 = bf2f(zp[0]), x2 = bf2f(zp[32]);
            if (lat) {
                const int pos = (t0 + r) & (SEQ - 1);
                const float c = rope[(size_t)2 * SEQ * 32 + pos * 32 + i], s = rope[(size_t)3 * SEQ * 32 + pos * 32 + i];
                const bf16_t o1 = f2bf(x1 * c - x2 * s), o2 = f2bf(x1 * s + x2 * c);
                zp[0] = o1; zp[32] = o2; x1 = bf2f(o1); x2 = bf2f(o2);
            }
            Ks[r * 64 + i] = x1; Ks[r * 64 + 32 + i] = x2;
        }
#pragma unroll
        for (int q = 0; q < 16; ++q) { const int idx = tid + 512 * q; const int r = idx >> 6, c = idx & 63; Vs[idx] = bf2f(Z[(size_t)(t0 + r) * INW + vc + c]); }
        __syncthreads();
        const int d = tid >> 3, e0 = (tid & 7) * 8;
        float af[8], ab[8];
#pragma unroll
        for (int j = 0; j < 8; ++j) { af[j] = 0.f; ab[j] = 0.f; }
        for (int s = 0; s < 128; ++s) {
            const float kv = Ks[s * 64 + d]; const float kfw = kv * wf[s], kbw = kv * wb[s];
            const float4 v0 = *(const float4*)(Vs + s * 64 + e0), v1 = *(const float4*)(Vs + s * 64 + e0 + 4);
            af[0] += kfw * v0.x; af[1] += kfw * v0.y; af[2] += kfw * v0.z; af[3] += kfw * v0.w; af[4] += kfw * v1.x; af[5] += kfw * v1.y; af[6] += kfw * v1.z; af[7] += kfw * v1.w;
            ab[0] += kbw * v0.x; ab[1] += kbw * v0.y; ab[2] += kbw * v0.z; ab[3] += kbw * v0.w; ab[4] += kbw * v1.x; ab[5] += kbw * v1.y; ab[6] += kbw * v1.z; ab[7] += kbw * v1.w;
        }
        const size_t so = ((size_t)(b * NCH + cidx) * 8 + h) * 4096 + d * 64 + e0;
        *(float4*)(AF + so) = make_float4(af[0], af[1], af[2], af[3]); *(float4*)(AF + so + 4) = make_float4(af[4], af[5], af[6], af[7]);
        *(float4*)(AB + so) = make_float4(ab[0], ab[1], ab[2], ab[3]); *(float4*)(AB + so + 4) = make_float4(ab[4], ab[5], ab[6], ab[7]);
    }
    __syncthreads();
}

__device__ void m2_scan(const KP& p, int e) {
    float* AF = (float*)(p.ws + WS_ST); float* AB = AF + SZ_ST / 4; float* TF = AB + SZ_ST / 4; float* TB = TF + SZ_ST / 4;
    const float* dec = p.in[13] + e * 16;
    for (int idx = blockIdx.x * 512 + ltid(); idx < NB * 8 * 4096; idx += gridDim.x * 512) {
        const int el = idx & 4095, h = (idx >> 12) & 7, b = idx >> 15;
        const float gf = expf(log_sigmoid(dec[h]) * 128.0f), gb = expf(log_sigmoid(dec[8 + h]) * 128.0f);
#define SIDX(c) (((size_t)(b * NCH + (c)) * 8 + h) * 4096 + el)
        const float afc0 = AF[SIDX(32)], afc1 = AF[SIDX(33)], abc0 = AB[SIDX(32)], abc1 = AB[SIDX(33)];
        TF[SIDX(32)] = 0.f; TF[SIDX(33)] = afc0; TB[SIDX(33)] = 0.f; TB[SIDX(32)] = abc1;
        float sf = gf * afc0 + afc1, sb = abc0 + gb * abc1;
        for (int c = 0; c < 32; ++c) { TF[SIDX(c)] = sf; sf = gf * sf + AF[SIDX(c)]; }
        for (int c = 31; c >= 0; --c) { TB[SIDX(c)] = sb; sb = AB[SIDX(c)] + gb * sb; }
#undef SIDX
    }
}

typedef short bf16x4 __attribute__((ext_vector_type(4)));
__device__ __forceinline__ bf16x8 pack8(const f32x4& a, const f32x4& b) {
    u32x4 w; w.x = pg8::cvt_pk_bf16(a[0], a[1]); w.y = pg8::cvt_pk_bf16(a[2], a[3]); w.z = pg8::cvt_pk_bf16(b[0], b[1]); w.w = pg8::cvt_pk_bf16(b[2], b[3]);
    return __builtin_bit_cast(bf16x8, w);
}
__device__ void m3_outputs(const KP& p, int e, bool ctx_full, unsigned char* smem) {
    const int tid = ltid(), bid = blockIdx.x, nb = gridDim.x;
    const int w = tid >> 6, lane = tid & 63, ln = lane & 15, g4 = lane >> 4;
    const bf16_t* Z = (const bf16_t*)(p.ws + WS_BIG);
    bf16_t* MIX = (bf16_t*)(p.ws + WS_MIX);
    const float* dec = p.in[13] + e * 16;
    const float* sink = p.in[12] + e * 8;
    const float* TF = (const float*)(p.ws + WS_ST) + 2 * (SZ_ST / 4); const float* TB = TF + SZ_ST / 4;
    const int nchunk = ctx_full ? NCH : 32;
    const int nitems = NB * nchunk * 8;
    bf16_t* Kt = (bf16_t*)smem;
    bf16_t* Vt = Kt + 128 * 72;
    bf16_t* TfT = Vt + 64 * 136;
    bf16_t* TbT = TfT + 64 * 72;
    const int i = 16 * w + ln;
    for (int it = bid; it < 2 * nitems; it += nb) {
        const bool is_attn = it >= nitems; const int ii = is_attn ? it - nitems : it;
        const int h = ii & 7, cidx = (ii >> 3) % nchunk, b = ii / (8 * nchunk);
        const int t0 = chunk_t0(b, cidx); const bool lat = cidx < 32;
        f32x4 O[4];
#pragma unroll
        for (int m = 0; m < 4; ++m) O[m] = (f32x4){0.f, 0.f, 0.f, 0.f};
        if (!is_attn) {
            const float lgf = log_sigmoid(dec[h]), lgb = log_sigmoid(dec[8 + h]);
            __syncthreads();
#pragma unroll
            for (int q = 0; q < 2; ++q) { const int idx = tid + 512 * q; const int r = idx >> 3, pc = idx & 7; const bf16_t* zr = Z + (size_t)(t0 + r) * INW + h * 64 + pc * 8;
                *(u32x4*)(Kt + r * 72 + pc * 8) = *(const u32x4*)(zr + 1792);
                const bf16x8 vv = *(const bf16x8*)(zr + 2304);
#pragma unroll
                for (int j = 0; j < 8; ++j) Vt[(pc * 8 + j) * 136 + r] = (bf16_t)vv[j]; }
            const size_t so = ((size_t)(b * NCH + cidx) * 8 + h) * 4096;
#pragma unroll
            for (int q = 0; q < 8; ++q) { const int idx = tid + 512 * q; const int d = idx >> 6, ee = idx & 63; TfT[ee * 72 + d] = f2bf(TF[so + idx]); TbT[ee * 72 + d] = f2bf(TB[so + idx]); }
            __builtin_amdgcn_sched_barrier(0);
            bf16x8 qf[2], qff[2], qfb[2];
            { const bf16_t* qr = Z + (size_t)(t0 + i) * INW + 512 + h * 64 + 8 * g4;
              const float cf = __expf(lgf * (float)(i + 1)), cb = __expf(lgb * (float)(128 - i));
#pragma unroll
              for (int k2 = 0; k2 < 2; ++k2) { qf[k2] = *(const bf16x8*)(qr + 32 * k2);
                  f32x4 a0, a1, b0, b1;
#pragma unroll
                  for (int j = 0; j < 4; ++j) { const float x0 = bf2f((bf16_t)qf[k2][j]), x1 = bf2f((bf16_t)qf[k2][4 + j]); a0[j] = x0 * cf; a1[j] = x1 * cf; b0[j] = x0 * cb; b1[j] = x1 * cb; }
                  qff[k2] = pack8(a0, a1); qfb[k2] = pack8(b0, b1); } }
            __builtin_amdgcn_sched_barrier(0);
            __syncthreads();
#pragma unroll
            for (int m = 0; m < 4; ++m)
#pragma unroll
                for (int k2 = 0; k2 < 2; ++k2) {
                    const bf16x8 af = *(const bf16x8*)(TfT + (16 * m + ln) * 72 + 32 * k2 + 8 * g4);
                    const bf16x8 ab = *(const bf16x8*)(TbT + (16 * m + ln) * 72 + 32 * k2 + 8 * g4);
                    O[m] = __builtin_amdgcn_mfma_f32_16x16x32_bf16(af, qff[k2], O[m], 0, 0, 0);
                    O[m] = __builtin_amdgcn_mfma_f32_16x16x32_bf16(ab, qfb[k2], O[m], 0, 0, 0);
                    __builtin_amdgcn_sched_barrier(0);
                }
            const float lf2 = lgf * 1.44269504f, lb2 = lgb * 1.44269504f; const int di = i - 4 * g4;
            const float bfw = lf2 * (float)di, bbw = -lb2 * (float)di;
            f32x4 st[8];
#pragma unroll
            for (int mt = 0; mt < 8; ++mt) {
                f32x4 a = (f32x4){0.f, 0.f, 0.f, 0.f};
#pragma unroll
                for (int k2 = 0; k2 < 2; ++k2) { const bf16x8 kf = *(const bf16x8*)(Kt + (16 * mt + ln) * 72 + 32 * k2 + 8 * g4); a = __builtin_amdgcn_mfma_f32_16x16x32_bf16(kf, qf[k2], a, 0, 0, 0); }
#pragma unroll
                for (int rg = 0; rg < 4; ++rg) { const int cc = 16 * mt + rg; const int df = di - cc;
                    const float arg = (df > 0) ? fmaf(-lf2, (float)cc, bfw) : fmaf(lb2, (float)cc, bbw);
                    float wgt = __builtin_amdgcn_exp2f(arg); wgt = (df == 0) ? 2.0f : wgt;
                    a[rg] *= wgt; }
                st[mt] = a;
                __builtin_amdgcn_sched_barrier(0);
            }
#pragma unroll
            for (int ks = 0; ks < 4; ++ks) {
                const bf16x8 pfr = pack8(st[2 * ks], st[2 * ks + 1]);
#pragma unroll
                for (int m = 0; m < 4; ++m) {
                    const bf16_t* vr = Vt + (16 * m + ln) * 136 + 32 * ks + 4 * g4;
                    const bf16x4 v0 = *(const bf16x4*)vr, v1 = *(const bf16x4*)(vr + 16);
                    const bf16x8 vf = __builtin_shufflevector(v0, v1, 0, 1, 2, 3, 4, 5, 6, 7);
                    O[m] = __builtin_amdgcn_mfma_f32_16x16x32_bf16(vf, pfr, O[m], 0, 0, 0);
                }
                __builtin_amdgcn_sched_barrier(0);
            }
            float ss = 0.f;
#pragma unroll
            for (int m = 0; m < 4; ++m)
#pragma unroll
                for (int rg = 0; rg < 4; ++rg) ss += O[m][rg] * O[m][rg];
            ss += __shfl_xor(ss, 16, 64); ss += __shfl_xor(ss, 32, 64);
            const float rn = rsqrtf(ss * (1.0f / 64.0f) + EPS);
#pragma unroll
            for (int m = 0; m < 4; ++m) {
                const int ee = 16 * m + 4 * g4;
                const bf16x4 gv = *(const bf16x4*)(Z + (size_t)(t0 + i) * INW + 1024 + h * 64 + ee);
                uint2 o2; o2.x = pg8::cvt_pk_bf16(O[m][0] * rn * silu_f(bf2f((bf16_t)gv[0])), O[m][1] * rn * silu_f(bf2f((bf16_t)gv[1])));
                o2.y = pg8::cvt_pk_bf16(O[m][2] * rn * silu_f(bf2f((bf16_t)gv[2])), O[m][3] * rn * silu_f(bf2f((bf16_t)gv[3])));
                *(uint2*)(MIX + (size_t)(t0 + i) * D + 512 + h * 64 + ee) = o2;
            }
        } else {
            const int gk = h >> 2;
            bf16x8 qf[2];
            { const bf16_t* qr = Z + (size_t)(t0 + i) * INW + h * 64 + 8 * g4; qf[0] = *(const bf16x8*)qr; qf[1] = *(const bf16x8*)(qr + 32); }
            float mx = sink[h], l = (g4 == 0) ? 1.0f : 0.0f;
            const int qpos = lat ? (cidx * 128 + i) : 0;
            for (int tl = 0; tl < 5; ++tl) {
                int kt0; int kp0 = 0; const bool isc = tl >= 3;
                if (!isc) { if (!lat) continue; const int kc = cidx - 1 + tl; if (kc < 0 || kc >= 32) continue; kt0 = b * SEQ + kc * 128; kp0 = kc * 128; }
                else kt0 = TL + b * CL + (tl - 3) * 128;
                __syncthreads();
#pragma unroll
                for (int q = 0; q < 2; ++q) { const int idx = tid + 512 * q; const int r = idx >> 3, pc = idx & 7; const bf16_t* zr = Z + (size_t)(kt0 + r) * INW + gk * 64 + pc * 8;
                    *(u32x4*)(Kt + r * 72 + pc * 8) = *(const u32x4*)(zr + 1536);
                    const bf16x8 vv = *(const bf16x8*)(zr + 1664);
#pragma unroll
                    for (int j = 0; j < 8; ++j) Vt[(pc * 8 + j) * 136 + r] = (bf16_t)vv[j]; }
                __syncthreads();
                f32x4 st[8];
                float mloc = -1e30f;
#pragma unroll
                for (int mt = 0; mt < 8; ++mt) {
                    f32x4 a = (f32x4){0.f, 0.f, 0.f, 0.f};
#pragma unroll
                    for (int k2 = 0; k2 < 2; ++k2) { const bf16x8 kf = *(const bf16x8*)(Kt + (16 * mt + ln) * 72 + 32 * k2 + 8 * g4); a = __builtin_amdgcn_mfma_f32_16x16x32_bf16(kf, qf[k2], a, 0, 0, 0); }
                    if (!isc) {
#pragma unroll
                        for (int rg = 0; rg < 4; ++rg) { const int dd = qpos - (kp0 + 16 * mt + 4 * g4 + rg); if (dd > 128 || dd < -128) a[rg] = -1e30f; }
                    }
#pragma unroll
                    for (int rg = 0; rg < 4; ++rg) mloc = fmaxf(mloc, a[rg]);
                    st[mt] = a;
                    __builtin_amdgcn_sched_barrier(0);
                }
                mloc = fmaxf(mloc, __shfl_xor(mloc, 16, 64)); mloc = fmaxf(mloc, __shfl_xor(mloc, 32, 64));
                const float mnew = fmaxf(mx, mloc);
                const float sc = __expf(mx - mnew); mx = mnew; l *= sc;
#pragma unroll
                for (int m = 0; m < 4; ++m) O[m] *= sc;
#pragma unroll
                for (int mt = 0; mt < 8; ++mt)
#pragma unroll
                    for (int rg = 0; rg < 4; ++rg) { const float pv = __expf(st[mt][rg] - mnew); st[mt][rg] = pv; l += pv; }
#pragma unroll
                for (int ks = 0; ks < 4; ++ks) {
                    const bf16x8 pfr = pack8(st[2 * ks], st[2 * ks + 1]);
#pragma unroll
                    for (int m = 0; m < 4; ++m) {
                        const bf16_t* vr = Vt + (16 * m + ln) * 136 + 32 * ks + 4 * g4;
                        const bf16x4 v0 = *(const bf16x4*)vr, v1 = *(const bf16x4*)(vr + 16);
                        const bf16x8 vf = __builtin_shufflevector(v0, v1, 0, 1, 2, 3, 4, 5, 6, 7);
                        O[m] = __builtin_amdgcn_mfma_f32_16x16x32_bf16(vf, pfr, O[m], 0, 0, 0);
                    }
                    __builtin_amdgcn_sched_barrier(0);
                }
            }
            l += __shfl_xor(l, 16, 64); l += __shfl_xor(l, 32, 64);
            const float inv = 1.0f / l;
#pragma unroll
            for (int m = 0; m < 4; ++m) {
                uint2 o2; o2.x = pg8::cvt_pk_bf16(O[m][0] * inv, O[m][1] * inv); o2.y = pg8::cvt_pk_bf16(O[m][2] * inv, O[m][3] * inv);
                *(uint2*)(MIX + (size_t)(t0 + i) * D + h * 64 + 16 * m + 4 * g4) = o2;
            }
        }
    }
    __syncthreads();
}

__device__ void h2_shortconv(const KP& p, int o, int M, unsigned char* smem) {
    const int tid = ltid();
    const bf16_t* ZH = (const bf16_t*)(p.ws + WS_BIG);
    const float* w = p.in[17] + (size_t)o * 3 * HYW; const float* bs = p.in[18] + (size_t)o * HYW;
    bf16_t* VXT = (bf16_t*)(p.ws + WS_Y); bf16_t* X0T = VXT + (size_t)D * TL;
    bf16_t* tx = (bf16_t*)smem;
    bf16_t* tv = tx + 64 * 72;
    const int tok = tid >> 3, cg8 = (tid & 7) * 8;
    for (int it = blockIdx.x; it < (TL / 64) * 16; it += gridDim.x) {
        const int c0 = (it & 15) * 64, t0 = (it >> 4) * 64;
        const int t = t0 + tok; const int pos = t & (SEQ - 1); const bool first = pos == 0, last = pos == SEQ - 1;
        float zz[3][8];
#pragma unroll
        for (int k = 0; k < 3; ++k) {
            const int c = k * 1024 + c0 + cg8;
            const bf16x8 zc = *(const bf16x8*)(ZH + (size_t)t * HYW + c);
            bf16x8 zp = zc, zn = zc;
            if (!first) zp = *(const bf16x8*)(ZH + (size_t)(t - 1) * HYW + c);
            if (!last) zn = *(const bf16x8*)(ZH + (size_t)(t + 1) * HYW + c);
#pragma unroll
            for (int j = 0; j < 8; ++j) {
                float sacc = bs[c + j] + bf2f((bf16_t)zc[j]) * w[HYW + c + j];
                if (!first) sacc += bf2f((bf16_t)zp[j]) * w[c + j];
                if (!last) sacc += bf2f((bf16_t)zn[j]) * w[2 * HYW + c + j];
                zz[k][j] = sacc;
            }
        }
        __syncthreads();
#pragma unroll
        for (int j = 0; j < 8; ++j) { tx[(cg8 + j) * 72 + tok] = f2bf(zz[0][j]); tv[(cg8 + j) * 72 + tok] = f2bf(zz[2][j] * zz[1][j]); }
        __syncthreads();
        { const int ch = tid >> 3, tk = (tid & 7) * 8;
          *(u32x4*)(X0T + (size_t)(c0 + ch) * TL + t0 + tk) = *(const u32x4*)(tx + ch * 72 + tk);
          *(u32x4*)(VXT + (size_t)(c0 + ch) * TL + t0 + tk) = *(const u32x4*)(tv + ch * 72 + tk); }
    }
    __syncthreads();
    if (M > TL) {
        float* VX = (float*)(p.ws + WS_Y); bf16_t* X0 = (bf16_t*)(p.ws + WS_H);
        for (int idx = TL * D + blockIdx.x * 512 + tid; idx < M * D; idx += gridDim.x * 512) {
            const int t = idx >> 10, d = idx & 1023;
            const int pos = (t - TL) & (CL - 1); const bool first = pos == 0, last = pos == CL - 1;
            float zz[3];
#pragma unroll
            for (int k = 0; k < 3; ++k) {
                const int c = k * 1024 + d;
                float sacc = bs[c] + bf2f(ZH[(size_t)t * HYW + c]) * w[HYW + c];
                if (!first) sacc += bf2f(ZH[(size_t)(t - 1) * HYW + c]) * w[c];
                if (!last) sacc += bf2f(ZH[(size_t)(t + 1) * HYW + c]) * w[2 * HYW + c];
                zz[k] = sacc;
            }
            VX[idx] = zz[2] * zz[1]; X0[idx] = f2bf(zz[0]);
        }
    }
}

typedef float f32x16 __attribute__((ext_vector_type(16)));
__device__ void h3_longconv(const KP& p, int o, bool ctx_full, unsigned char* smem) {
    const int tid = ltid(), w = tid >> 6, lane = tid & 63;
    const float* bias = p.in[27] + (size_t)o * D;
    {
        const bf16_t* VXT = (const bf16_t*)(p.ws + WS_Y); const bf16_t* X0T = VXT + (size_t)D * TL;
        bf16_t* HMT = (bf16_t*)(p.ws + WS_H);
        const bf16_t* RKT = (const bf16_t*)(p.ws + WS_KF + (size_t)o * SZ_KF);
        constexpr int RK2_OFF = 16384 + 64, U_OFF = 2 * 16384 + 128, CH_BYTES = U_OFF + 142 * 256;
        const int cw = w >> 2, w4 = w & 3;
        const int ct = tid & 255;
        unsigned char* cb = smem + cw * CH_BYTES;
        const int r = lane & 31, hh = lane >> 5;
        for (int pr = blockIdx.x; pr < D / 2; pr += gridDim.x) {
            const int d = pr * 2 + cw;
            __syncthreads();
            { const bf16_t* src = RKT + (size_t)d * 8192;
              for (int i = ct; i < 1024; i += 256) *(u32x4*)(cb + i * 16) = *(const u32x4*)(src + i * 8);
              bf16_t* rk2 = (bf16_t*)(cb + RK2_OFF);
              for (int i = ct; i < 4096; i += 256) { const unsigned lo = src[2 * i + 1]; const unsigned hi = (2 * i + 2 < 8192) ? src[2 * i + 2] : 0u; *(unsigned*)(rk2 + 2 * i) = lo | (hi << 16); }
              unsigned char* ub = cb + U_OFF;
              for (int i = ct; i < 2 * 7 * 4 * 4; i += 256) { const int side = i / 112, rem = i % 112; *(u32x4*)(ub + (side ? (135 * 4 * 64) : 0) + rem * 16) = (u32x4){0u, 0u, 0u, 0u}; }
              for (int i = ct; i < 4 * 512; i += 256) { const int b = i >> 9, pc = i & 511;
                  const u32x4 v = *(const u32x4*)(VXT + (size_t)d * TL + b * SEQ + pc * 8);
                  const int chunk = pc >> 2, m0 = (pc & 3) * 8;
                  *(u32x4*)(ub + ((chunk + 7) * 4 + b) * 64 + m0 * 2) = v; } }
            __syncthreads();
            f32x16 acc[4];
#pragma unroll
            for (int j = 0; j < 4; ++j)
#pragma unroll
                for (int q = 0; q < 16; ++q) acc[j][q] = 0.f;
            const unsigned char* ub = cb + U_OFF;
            const bf16_t* rsel = (const bf16_t*)(cb + ((r & 1) ? 0 : RK2_OFF));
            const int adj = (r & 1) ? 0 : -1;
            for (int dl = 32 * w4 - 127; dl <= 32 * w4 + 31; ++dl) {
                bf16x8 af[2];
#pragma unroll
                for (int s = 0; s < 2; ++s) {
                    const int e0 = 4095 - 32 * dl - r + 16 * s + 8 * hh + adj;
                    const unsigned* ap = (const unsigned*)(rsel + e0);
                    u32x4 t4; t4.x = ap[0]; t4.y = ap[1]; t4.z = ap[2]; t4.w = ap[3];
                    af[s] = __builtin_bit_cast(bf16x8, t4);
                }
#pragma unroll
                for (int j = 0; j < 4; ++j) {
                    const int J = 4 * w4 + j;
                    if (8 * J + 7 - dl < 0 || 8 * J - dl > 127) continue;
                    const int n1 = 8 * J + (r >> 2), b = r & 3;
                    const unsigned char* bp = ub + ((n1 - dl + 7) * 4 + b) * 64 + hh * 16;
                    const bf16x8 b0 = *(const bf16x8*)(bp), b1 = *(const bf16x8*)(bp + 32);
                    acc[j] = __builtin_amdgcn_mfma_f32_32x32x16_bf16(af[0], b0, acc[j], 0, 0, 0);
                    acc[j] = __builtin_amdgcn_mfma_f32_32x32x16_bf16(af[1], b1, acc[j], 0, 0, 0);
                }
            }
            const float bd = bias[d];
#pragma unroll
            for (int j = 0; j < 4; ++j) {
                const int n1 = 8 * (4 * w4 + j) + (r >> 2), b = r & 3;
                const bf16_t* up = (const bf16_t*)(ub + ((n1 + 7) * 4 + b) * 64);
                const size_t gb = (size_t)d * TL + b * SEQ + n1 * 32;
#pragma unroll
                for (int q = 0; q < 16; ++q) {
                    const int row = (q & 3) + 8 * (q >> 2) + 4 * hh;
                    const float y = acc[j][q] + bd * bf2f(up[row]);
                    HMT[gb + row] = f2bf(bf2f(X0T[gb + row]) * y);
                }
            }
        }
        __syncthreads();
    }
    if (ctx_full) {
        const float* VX = (const float*)(p.ws + WS_Y); const bf16_t* X0 = (const bf16_t*)(p.ws + WS_H);
        bf16_t* MIX = (bf16_t*)(p.ws + WS_MIX);
        const float* kf = (const float*)(p.ws + WS_KF + (size_t)o * SZ_KF) + (size_t)2 * SEQ * D;
        for (int idx = blockIdx.x * 512 + tid; idx < TC * D; idx += gridDim.x * 512) {
            const int tc = idx >> 10, d = idx & 1023; const int n = tc & (CL - 1), tb = TL + (tc - n);
            const float* up = VX + (size_t)tb * D + d;
            float acc = 0.f;
#pragma unroll 4
            for (int m = 0; m < CL; ++m) {
                const int lag = n - m;
                const float kv = (lag >= 0) ? kf[(size_t)lag * D + d] : kf[(size_t)(CL - lag) * D + d];
                acc += up[(size_t)m * D] * kv;
            }
            const size_t ti = (size_t)(TL + tc) * D + d;
            MIX[ti] = f2bf(bf2f(X0[ti]) * (acc + bias[d] * VX[ti]));
        }
    }
}

__device__ void h3b_transpose(const KP& p, unsigned char* smem) {
    const int tid = ltid();
    const bf16_t* HMT = (const bf16_t*)(p.ws + WS_H); bf16_t* MIX = (bf16_t*)(p.ws + WS_MIX);
    bf16_t* tile = (bf16_t*)smem;
    for (int it = blockIdx.x; it < (TL / 64) * 16; it += gridDim.x) {
        const int c0 = (it & 15) * 64, t0 = (it >> 4) * 64;
        __syncthreads();
        { const int ch = tid >> 3, tk = (tid & 7) * 8; *(u32x4*)(tile + ch * 72 + tk) = *(const u32x4*)(HMT + (size_t)(c0 + ch) * TL + t0 + tk); }
        __syncthreads();
        { const int tok = tid >> 3, cg8 = (tid & 7) * 8; unsigned short v[8];
#pragma unroll
          for (int j = 0; j < 8; ++j) v[j] = tile[(cg8 + j) * 72 + tok];
          u32x4 o4; o4.x = v[0] | ((unsigned)v[1] << 16); o4.y = v[2] | ((unsigned)v[3] << 16); o4.z = v[4] | ((unsigned)v[5] << 16); o4.w = v[6] | ((unsigned)v[7] << 16);
          *(u32x4*)(MIX + (size_t)(t0 + tok) * D + c0 + cg8) = o4; }
    }
    __syncthreads();
}

__global__ void __launch_bounds__(512, 2) mega_fwd(KP p) {
    extern __shared__ __attribute__((aligned(16))) unsigned char smem[];
    cg::grid_group grid = cg::this_grid();
    if (threadIdx.x < 4) ((volatile LAS unsigned*)(LAS unsigned char*)smem)[(LDS_BYTES - 16) / 4 + threadIdx.x] = 0u;
    __syncthreads();
    if (threadIdx.x == 0) (void)xb_add(&((unsigned*)(p.ws + WS_BAR))[XB_XCNT(xb_xcc_id())], 1u);
    grid.sync();
    float* smf = (float*)smem;
    bf16_t* Hb = (bf16_t*)(p.ws + WS_H); bf16_t* BIG = (bf16_t*)(p.ws + WS_BIG); float* Y = (float*)(p.ws + WS_Y); bf16_t* MIX = (bf16_t*)(p.ws + WS_MIX);
    const float* npre = p.in[6]; const float* npost = p.in[7];

#ifndef NO_P0
    p0_setup(p, smf);
#endif
    GRID_BAR();
    rowphase(p, 0, nullptr, 0, 0, 0.f, nullptr, T, 0, npre, 0, 1, Hb);
    GRID_BAR();
    for (int l = 0; l < 4; ++l) {
        const bool ctx_live = l <= 2, ctx_full = l < 2;
        const int Mff = ctx_live ? T : TL, Mpost = ctx_full ? T : TL;
        for (int sub = 0; sub < 3; ++sub) {
            if (sub != 1) {
                const int fi = sub >> 1; const int M = (sub == 0) ? Mff : Mpost;
                { pg8::EpiSwiGLU E{BIG, DFF}; run_gemm(smem, Hb, (const bf16_t*)(p.ws + WS_WGU + (size_t)(l * 2 + fi) * SZ_WGU), M, 2 * DFF, D, E); }
                GRID_BAR();
                { pg8::EpiF32 E{Y, D}; run_gemm(smem, BIG, (const bf16_t*)(p.ws + WS_WD + (size_t)(l * 2 + fi) * SZ_WD), M, D, DFF, E); }
                GRID_BAR();
                if (sub == 0) rowphase(p, M, Y, l, 2, 0.5f, npost + (size_t)(l * 3 + 0) * D, Mff, l, npre + (size_t)(l * 3 + 1) * D, 3, 4, Hb);
                else {
                    const int ln = l + 1; const int Mn = (ln < 4) ? ((ln <= 2) ? T : TL) : 0;
                    rowphase(p, M, Y, l, 8, 0.5f, npost + (size_t)(l * 3 + 2) * D, Mn, ln < 4 ? ln : l, npre + (size_t)((ln < 4 ? ln : l) * 3 + 0) * D, 0, 1, ln < 4 ? Hb : nullptr);
                }
                GRID_BAR();
            } else {
                if ((l & 1) == 0) {
                    const int e = l >> 1;
                    { pg8::EpiBf16 E{BIG, INW, nullptr}; run_gemm(smem, Hb, (const bf16_t*)(p.ws + WS_WIN + (size_t)e * SZ_WIN), Mff, INW, D, E); }
                    GRID_BAR();
#ifndef NO_M1
                    m1_rope_states(p, e, smf);
#endif
                    GRID_BAR();
#ifndef NO_M2
                    m2_scan(p, e);
#endif
                    GRID_BAR();
#ifndef NO_M3
                    m3_outputs(p, e, ctx_full, smem);
#endif
                    GRID_BAR();
                    { pg8::EpiF32 E{Y, D}; run_gemm(smem, MIX, (const bf16_t*)(p.ws + WS_WOUT + (size_t)e * SZ_WOUT), Mpost, D, D, E); }
                    GRID_BAR();
                } else {
                    const int o = l >> 1;
                    { pg8::EpiBf16 E{BIG, HYW, p.in[16] + (size_t)o * HYW}; run_gemm(smem, Hb, (const bf16_t*)(p.ws + WS_HWIN + (size_t)o * SZ_HWIN), Mpost, HYW, D, E); }
                    GRID_BAR();
#ifndef NO_H2
                    h2_shortconv(p, o, Mpost, smem);
#endif
                    GRID_BAR();
#ifndef NO_H3
                    h3_longconv(p, o, ctx_full, smem);
#endif
                    GRID_BAR();
                    h3b_transpose(p, smem);
                    GRID_BAR();
                    { pg8::EpiF32 E{Y, D}; run_gemm(smem, MIX, (const bf16_t*)(p.ws + WS_HWOUT + (size_t)o * SZ_WOUT), Mpost, D, D, E); }
                    GRID_BAR();
                }
                rowphase(p, Mpost, Y, l, 5, 1.0f, npost + (size_t)(l * 3 + 1) * D, Mpost, l, npre + (size_t)(l * 3 + 2) * D, 6, 7, Hb);
                GRID_BAR();
            }
        }
    }
}

extern "C" void kernel_launch(void* const* d_in, const int* in_sizes, int n_in, void* d_out, int out_size, void* d_ws, size_t ws_size, hipStream_t stream) {
    static int grid = 0;
    if (grid == 0) {
        if (n_in != 29 || out_size != TL * D || ws_size < WS_END) { fprintf(stderr, "kernel_launch: unexpected shapes: n_in %d out %d ws %zu (need %zu)\n", n_in, out_size, ws_size, (size_t)WS_END); grid = -1; return; }
        int dev = 0, cus = 0, per_cu = 0;
        (void)hipGetDevice(&dev);
        (void)hipDeviceGetAttribute(&cus, hipDeviceAttributeMultiprocessorCount, dev);
        if (hipFuncSetAttribute((const void*)mega_fwd, hipFuncAttributeMaxDynamicSharedMemorySize, LDS_BYTES) != hipSuccess) { fprintf(stderr, "kernel_launch: hipFuncSetAttribute failed\n"); grid = -1; return; }
        if (hipOccupancyMaxActiveBlocksPerMultiprocessor(&per_cu, (const void*)mega_fwd, 512, LDS_BYTES) != hipSuccess || per_cu < 1) { fprintf(stderr, "kernel_launch: occupancy query says %d\n", per_cu); per_cu = 1; }
        (void)hipGetLastError();
        grid = cus;
    }
    if (grid < 0) return;
    (void)hipMemsetAsync((unsigned char*)d_ws + WS_BAR, 0, 16384, stream);
    KP kp{};
    for (int i = 0; i < 29; ++i) kp.in[i] = (const float*)d_in[i];
    kp.out = (float*)d_out; kp.ws = (unsigned char*)d_ws;
    void* args[] = {&kp};
    hipError_t e = hipLaunchCooperativeKernel((const void*)mega_fwd, dim3(grid), dim3(512), args, LDS_BYTES, stream);
    if (e != hipSuccess) fprintf(stderr, "cooperative launch failed: %s (grid %d)\n", hipGetErrorString(e), grid);
}
```

```cpp
#include <hip/hip_runtime.h>
#include <hip/hip_cooperative_groups.h>
#include <cstdio>
namespace cg = cooperative_groups;

#define LAS __attribute__((address_space(3)))
typedef unsigned short bf16_t;
typedef short bf16x8 __attribute__((ext_vector_type(8)));
typedef float f32x4 __attribute__((ext_vector_type(4)));
typedef unsigned u32x4 __attribute__((ext_vector_type(4)));

constexpr int D = 1024, NB = 4, SEQ = 4096, CL = 256, TL = NB * SEQ, TC = NB * CL, T = TL + TC, DFF = 2816, INW = 2816, HYW = 3072;
constexpr int NMOD = 9;
constexpr float EPS = 1e-6f;
constexpr int NCH = 34;
constexpr int LDS_BYTES = 144 * 1024;

constexpr size_t SZ_WGU = (size_t)2 * DFF * D * 2, SZ_WD = (size_t)D * DFF * 2, SZ_WIN = (size_t)INW * D * 2, SZ_WOUT = (size_t)D * D * 2, SZ_HWIN = (size_t)HYW * D * 2;
constexpr size_t WS_WGU = 0;
constexpr size_t WS_WD = WS_WGU + 8 * SZ_WGU;
constexpr size_t WS_WIN = WS_WD + 8 * SZ_WD;
constexpr size_t WS_WOUT = WS_WIN + 2 * SZ_WIN;
constexpr size_t WS_HWIN = WS_WOUT + 2 * SZ_WOUT;
constexpr size_t WS_HWOUT = WS_HWIN + 2 * SZ_HWIN;
constexpr size_t WS_MOD = WS_HWOUT + 2 * SZ_WOUT;
constexpr size_t WS_ROPE = WS_MOD + (size_t)4 * 5 * NMOD * D * 4;
constexpr size_t WS_XC = WS_ROPE + (size_t)4 * SEQ * 32 * 4;
constexpr size_t WS_H = WS_XC + (size_t)TC * D * 4;
constexpr size_t WS_BIG = WS_H + (size_t)T * D * 2;
constexpr size_t WS_Y = WS_BIG + (size_t)T * HYW * 2;
constexpr size_t WS_MIX = WS_Y + (size_t)T * D * 4;
constexpr size_t SZ_ST = (size_t)NB * NCH * 8 * 4096 * 4;
constexpr size_t WS_ST = WS_MIX + (size_t)T * D * 2;
constexpr size_t SZ_KF = (size_t)(SEQ + CL) * 2 * D * 4;
constexpr size_t WS_KF = WS_ST + 4 * SZ_ST;
constexpr size_t WS_BAR = WS_KF + 2 * SZ_KF;
constexpr size_t WS_END = WS_BAR + 16384;

struct KP { const float* in[29]; float* out; unsigned char* ws; };
extern __shared__ __attribute__((aligned(16))) unsigned char g_smem[];
constexpr int PTAB_OFF = LDS_BYTES - 512;
__device__ __forceinline__ const float* pin_ld(int k) {
    const unsigned long long v = *(volatile LAS unsigned long long*)((LAS unsigned char*)g_smem + PTAB_OFF + 8 * k);
    const unsigned lo = __builtin_amdgcn_readfirstlane((unsigned)v), hi = __builtin_amdgcn_readfirstlane((unsigned)(v >> 32));
    return (const float*)(((unsigned long long)hi << 32) | lo);
}
struct KQ { float* out; unsigned char* ws; };

__device__ __forceinline__ bf16_t f2bf(float f) { unsigned u = __float_as_uint(f); u += 0x7FFFu + ((u >> 16) & 1u); return (bf16_t)(u >> 16); }
__device__ __forceinline__ float bf2f(bf16_t b) { return __uint_as_float(((unsigned)b) << 16); }
__device__ __forceinline__ float silu_f(float x) { return x / (1.0f + __expf(-x)); }
__device__ __forceinline__ int ltid() { int t = threadIdx.x; asm volatile("" : "+v"(t)); return t; }
__device__ __forceinline__ float wave_sum(float v) {
#pragma unroll
    for (int o = 32; o > 0; o >>= 1) v += __shfl_xor(v, o, 64);
    return v;
}


#define XB_TMO      128
#define XB_XCNT(j)  (256  + 64 * (j))
#define XB_XSUB(j)  (1280 + 64 * (j))
#define XB_XGEN(j)  (2304 + 64 * (j))
#define XB_TOP      3328
#define XB_TOPGEN   3392
#define XCD_BAR_WORDS 3456
#define XB_SPIN_CAP (1u << 18)
__device__ __forceinline__ unsigned xb_ld(unsigned* p)              { return __hip_atomic_load(p, __ATOMIC_RELAXED, __HIP_MEMORY_SCOPE_AGENT); }
__device__ __forceinline__ unsigned xb_add(unsigned* p, unsigned v) { return __hip_atomic_fetch_add(p, v, __ATOMIC_RELAXED, __HIP_MEMORY_SCOPE_AGENT); }
__device__ __forceinline__ unsigned xb_xcc_id() { return (unsigned)__builtin_amdgcn_s_getreg((3 << 11) | 20) & 0xFu; }
#define XB_SPIN(cond, bar) do { unsigned _sp = 0; while (cond) { __builtin_amdgcn_s_sleep(1); \
    if ((++_sp & 255u) == 0u) { if (xb_ld(&(bar)[XB_TMO])) break; if (_sp > XB_SPIN_CAP) { atomicAdd(&(bar)[XB_TMO], 1u); break; } } } } while (0)
struct XcdBarrier { unsigned* bar; unsigned x; volatile LAS unsigned* st; };
__device__ __forceinline__ XcdBarrier xcd_barrier_post(unsigned* bar, volatile LAS unsigned* st) {
    XcdBarrier b; b.bar = bar; b.x = xb_xcc_id(); b.st = st;
    if (threadIdx.x == 0) (void)xb_add(&bar[XB_XCNT(b.x)], 1u);
    return b;
}
__device__ __forceinline__ void xcd_barrier_complete(unsigned* bar, unsigned x, unsigned& nloc, unsigned& nx) {
    const unsigned G = gridDim.x * gridDim.y * gridDim.z;
    unsigned sum, cnt, mine, sp = 0u;
    for (;;) {
        sum = 0u; cnt = 0u; mine = 0u;
#pragma unroll
        for (unsigned j = 0; j < 16; ++j) { const unsigned c = xb_ld(&bar[XB_XCNT(j)]); sum += c; cnt += (c > 0u) ? 1u : 0u; mine = (j == x) ? c : mine; }
        if (sum == G) break;
        __builtin_amdgcn_s_sleep(1);
        if ((++sp & 255u) == 0u) { if (xb_ld(&bar[XB_TMO])) break; if (sp > XB_SPIN_CAP) { atomicAdd(&bar[XB_TMO], 1u); break; } }
    }
    nloc = mine > 0u ? mine : 1u; nx = cnt > 0u ? cnt : 1u;
}
__device__ __forceinline__ void xcd_barrier_impl(unsigned* bar, volatile LAS unsigned* st) {
    asm volatile("s_waitcnt vmcnt(0)" ::: "memory");
    __syncthreads();
    if (ltid() == 0) {
        const unsigned x = xb_xcc_id();
        __builtin_amdgcn_s_waitcnt(0);
        unsigned nloc = st[0], nx = st[1];
        if (nloc == 0u) { xcd_barrier_complete(bar, x, nloc, nx); st[0] = nloc; st[1] = nx; }
        const unsigned old = xb_add(&bar[XB_XSUB(x)], 1u);
        const unsigned gen = old / nloc;
        if (old + 1u == (gen + 1u) * nloc) {
            __builtin_amdgcn_fence(__ATOMIC_RELEASE, "agent");
            asm volatile("s_waitcnt vmcnt(0)" ::: "memory");
            const unsigned og = xb_add(&bar[XB_TOP], 1u);
            const unsigned tg = og / nx;
            if (og + 1u == (tg + 1u) * nx) xb_add(&bar[XB_TOPGEN], 1u);
            else XB_SPIN(xb_ld(&bar[XB_TOPGEN]) == tg, bar);
            __builtin_amdgcn_fence(__ATOMIC_ACQUIRE, "agent");
            xb_add(&bar[XB_XGEN(x)], 1u);
            asm volatile("s_waitcnt vmcnt(0)" ::: "memory");
        } else {
            XB_SPIN(xb_ld(&bar[XB_XGEN(x)]) == gen, bar);
            __builtin_amdgcn_fence(__ATOMIC_ACQUIRE, "agent");
            asm volatile("s_waitcnt vmcnt(0)" ::: "memory");
        }
    }
    __syncthreads();
}
#define GRID_BAR() xcd_barrier_impl((unsigned*)(p.ws + WS_BAR), (volatile LAS unsigned*)((LAS unsigned char*)smem + LDS_BYTES - 16))

namespace pg8 {
constexpr int BM = 256, BK = 64, HALF = 128, HTB = HALF * BK * 2, STAGE_BYTES = 8 * HTB, NXCD = 8, WGM = 8;
__host__ __device__ __forceinline__ int lds_byte(int r, int c) { const int st = (r >> 4) * 2 + (c >> 5), rr = r & 15, cc = c & 31, ob = rr * 64 + cc * 2; return st * 1024 + (ob ^ (((ob >> 9) & 1) << 5)); }
__host__ __device__ __forceinline__ void stage_rc(int b, int& R, int& C) { const int st = b / 1024, sb = b % 1024, swz = sb ^ (((sb >> 9) & 1) << 5); R = (st >> 1) * 16 + swz / 64; C = (st & 1) * 32 + (swz % 64) / 2; }
__host__ __device__ __forceinline__ int perm32(int rho) { const int n = rho >> 4, i = rho & 15; return 8 * (i >> 2) + 4 * n + (i & 3); }
struct Unit { int pm, pn; };
struct Gemm { const bf16_t* A; const bf16_t* Bt; int M, N, K; };
struct StaticOrder {
    int nM, nN, nwg, G, c;
    __device__ void init(int M, int N, int G_, int c_) { nM = M / BM; nN = N / BM; nwg = nM * nN; G = G_; c = c_; }
    __device__ bool next(int i, Unit& u) const {
        const long Lx = (long)i * G + c; if (Lx >= nwg) return false;
        int wgid = (int)Lx; { const int q = nwg / NXCD, r = nwg % NXCD, xcd = wgid % NXCD, off = wgid / NXCD; wgid = (xcd < r ? xcd * (q + 1) : r * (q + 1) + (xcd - r) * q) + off; }
        const int nig = WGM * nN, gid = wgid / nig, fm = gid * WGM, gsz = (nM - fm) < WGM ? (nM - fm) : WGM;
        u.pm = fm + ((wgid % nig) % gsz); u.pn = (wgid % nig) / gsz; return true;
    }
};
__device__ __forceinline__ unsigned cvt_pk_bf16(float lo, float hi) { unsigned r; asm volatile("v_cvt_pk_bf16_f32 %0, %1, %2" : "=v"(r) : "v"(lo), "v"(hi)); return r; }

struct EpiF32 {
    static constexpr bool PERM = false;
    float* C; int ldc;
    __device__ __forceinline__ void operator()(const f32x4 (&acc)[2][2][4][2], const Unit& u, int wr, int wc, int fr, int fq) const {
        const int row0 = u.pm * BM + wr * 64 + fr, col0 = u.pn * BM + wc * 32 + 4 * fq;
#pragma unroll
        for (int ai = 0; ai < 2; ++ai)
#pragma unroll
            for (int m = 0; m < 4; ++m) { float* rowp = C + (size_t)(row0 + ai * HALF + m * 16) * ldc + col0;
#pragma unroll
                for (int bj = 0; bj < 2; ++bj)
#pragma unroll
                    for (int n = 0; n < 2; ++n) *(f32x4*)(rowp + bj * HALF + n * 16) = acc[ai][bj][m][n]; }
    }
};
struct EpiBf16 {
    static constexpr bool PERM = true;
    bf16_t* O; int ldc; const float* bias;
    __device__ __forceinline__ void operator()(const f32x4 (&acc)[2][2][4][2], const Unit& u, int wr, int wc, int fr, int fq) const {
        const int row0 = u.pm * BM + wr * 64 + fr; const int col0 = u.pn * BM + wc * 32 + 8 * fq;
        f32x4 bv[2][2];
#pragma unroll
        for (int bj = 0; bj < 2; ++bj)
#pragma unroll
            for (int n = 0; n < 2; ++n) bv[bj][n] = bias ? *(const f32x4*)(bias + col0 + bj * HALF + 4 * n) : (f32x4){0.f, 0.f, 0.f, 0.f};
#pragma unroll
        for (int ai = 0; ai < 2; ++ai)
#pragma unroll
            for (int m = 0; m < 4; ++m) { bf16_t* rowp = O + (size_t)(row0 + ai * HALF + m * 16) * ldc + col0;
#pragma unroll
                for (int bj = 0; bj < 2; ++bj) { f32x4 v0 = acc[ai][bj][m][0] + bv[bj][0], v1 = acc[ai][bj][m][1] + bv[bj][1];
                    u32x4 w; w.x = cvt_pk_bf16(v0[0], v0[1]); w.y = cvt_pk_bf16(v0[2], v0[3]); w.z = cvt_pk_bf16(v1[0], v1[1]); w.w = cvt_pk_bf16(v1[2], v1[3]);
                    *(u32x4*)(rowp + bj * HALF) = w; } }
    }
};
struct EpiSwiGLU {
    static constexpr bool PERM = true;
    bf16_t* O; int ldc;
    __device__ __forceinline__ void operator()(const f32x4 (&acc)[2][2][4][2], const Unit& u, int wr, int wc, int fr, int fq) const {
        const int row0 = u.pm * BM + wr * 64 + fr; const int col0 = u.pn * HALF + wc * 32 + 8 * fq;
#pragma unroll
        for (int ai = 0; ai < 2; ++ai)
#pragma unroll
            for (int m = 0; m < 4; ++m) { bf16_t* rowp = O + (size_t)(row0 + ai * HALF + m * 16) * ldc + col0;
                float v[8];
#pragma unroll
                for (int n = 0; n < 2; ++n)
#pragma unroll
                    for (int j = 0; j < 4; ++j) { const float g = acc[ai][0][m][n][j], up = acc[ai][1][m][n][j]; v[n * 4 + j] = silu_f(g) * up; }
                u32x4 w; w.x = cvt_pk_bf16(v[0], v[1]); w.y = cvt_pk_bf16(v[2], v[3]); w.z = cvt_pk_bf16(v[4], v[5]); w.w = cvt_pk_bf16(v[6], v[7]);
                *(u32x4*)rowp = w; }
    }
};

template <class Epi, class Sched>
__device__ __forceinline__ void gemm_phase(LAS unsigned char* lds, const Gemm g, const Sched& S, const Epi& E) {
    const int tid = ltid(), wid = __builtin_amdgcn_readfirstlane(tid >> 6), lane = tid & 63, wr = wid >> 2, wc = wid & 3, fr = lane & 15, fq = lane >> 4;
    const int K = g.K, nt = K / BK;
    unsigned voffA[2], voffB[2];
#pragma unroll
    for (int i = 0; i < 2; ++i) { int R, C; stage_rc(tid * 16 + i * 8192, R, C); const int Rb = Epi::PERM ? ((R & ~31) + perm32(R & 31)) : R;
        voffA[i] = (unsigned)(R * K + C) * 2u; voffB[i] = (unsigned)(Rb * K + C) * 2u; }
    const size_t kstep = (size_t)(BK * 2);
    const size_t hstep = (size_t)HALF * K * 2;
    const size_t tstep = 2 * hstep;
    const unsigned ldsw = (unsigned)wid * 1024u;
    const int aoff = lds_byte(wr * 64 + fr, fq * 8), boff = lds_byte(wc * 32 + fr, fq * 8);
#define PG8_SA(b, h) (((b) * 2 + (h)) * HTB)
#define PG8_SB(b, h) ((4 + (b) * 2 + (h)) * HTB)
#define PG8_STAGE(bufoff, gbase, voff) do { _Pragma("unroll") for (int _i = 0; _i < 2; ++_i) \
        __builtin_amdgcn_global_load_lds((const unsigned*)((const char*)(gbase) + (voff)[_i]), (LAS unsigned*)(lds + (bufoff) + ldsw + _i * 8192), 16, 0, 0); } while (0)
#define PG8_LDA(dst, b, h) do { _Pragma("unroll") for (int m = 0; m < 4; ++m) _Pragma("unroll") for (int k = 0; k < 2; ++k) dst[m][k] = *(const LAS bf16x8*)(lds + PG8_SA(b, h) + aoff + m * 2048 + k * 1024); } while (0)
#define PG8_LDB(dst, b, h) do { _Pragma("unroll") for (int n = 0; n < 2; ++n) _Pragma("unroll") for (int k = 0; k < 2; ++k) dst[n][k] = *(const LAS bf16x8*)(lds + PG8_SB(b, h) + boff + n * 2048 + k * 1024); } while (0)
#define PG8_MMA(ai, bj, At, Bt) do { __builtin_amdgcn_s_setprio(1); _Pragma("unroll") for (int m = 0; m < 4; ++m) _Pragma("unroll") for (int n = 0; n < 2; ++n) _Pragma("unroll") for (int k = 0; k < 2; ++k) \
        acc[ai][bj][m][n] = __builtin_amdgcn_mfma_f32_16x16x32_bf16(Bt[n][k], At[m][k], acc[ai][bj][m][n], 0, 0, 0); __builtin_amdgcn_s_setprio(0); } while (0)
#define PG8_WAIT_V(n) asm volatile("s_waitcnt vmcnt(" #n ")" ::: "memory")
#define PG8_WAIT_L(n) asm volatile("s_waitcnt lgkmcnt(" #n ")" ::: "memory")
#define PG8_BAR __builtin_amdgcn_s_barrier()
#define PG8_SCHED __builtin_amdgcn_sched_barrier(0)
    Unit cur, nxt; int ui = 0;
    if (!S.next(0, cur)) return;
    f32x4 acc[2][2][4][2];
#pragma unroll
    for (int a = 0; a < 2; ++a)
#pragma unroll
        for (int b = 0; b < 2; ++b)
#pragma unroll
            for (int m = 0; m < 4; ++m)
#pragma unroll
                for (int n = 0; n < 2; ++n) acc[a][b][m][n] = (f32x4){0.f, 0.f, 0.f, 0.f};
    bf16x8 At[4][2], B0[2][2], B1[2][2];
    const char* cA = (const char*)g.A + (size_t)cur.pm * tstep; const char* cB = (const char*)g.Bt + (size_t)cur.pn * tstep;
    PG8_STAGE(PG8_SB(0, 0), cB, voffB); PG8_STAGE(PG8_SA(0, 0), cA, voffA); PG8_STAGE(PG8_SB(0, 1), cB + hstep, voffB); PG8_STAGE(PG8_SA(0, 1), cA + hstep, voffA);
    if (wr == 1) PG8_BAR;
    PG8_WAIT_V(4); PG8_BAR;
    PG8_STAGE(PG8_SB(1, 0), cB + kstep, voffB); PG8_STAGE(PG8_SA(1, 0), cA + kstep, voffA); PG8_STAGE(PG8_SB(1, 1), cB + hstep + kstep, voffB);
    PG8_WAIT_V(6); PG8_BAR;
    for (;;) {
        const bool has_next = S.next(ui + 1, nxt);
        const char* nA = has_next ? (const char*)g.A + (size_t)nxt.pm * tstep : cA; const char* nB = has_next ? (const char*)g.Bt + (size_t)nxt.pn * tstep : cB;
        for (int t = 0; t < nt; t += 2) {
            const bool last = (t == nt - 2);
            const char* a1 = cA + (size_t)(t + 1) * kstep;
            const char* a2 = last ? nA : cA + (size_t)(t + 2) * kstep; const char* b2 = last ? nB : cB + (size_t)(t + 2) * kstep;
            const char* a3 = a2 + kstep; const char* b3 = b2 + kstep;
            PG8_LDB(B0, 0, 0); PG8_SCHED; PG8_LDA(At, 0, 0); PG8_STAGE(PG8_SA(1, 1), a1 + hstep, voffA);
            PG8_WAIT_L(8); PG8_BAR; PG8_WAIT_L(0); PG8_MMA(0, 0, At, B0); PG8_BAR; PG8_SCHED;
            PG8_LDB(B1, 0, 1); PG8_STAGE(PG8_SB(0, 0), b2, voffB);
            PG8_BAR; PG8_WAIT_L(0); PG8_MMA(0, 1, At, B1); PG8_BAR;
            PG8_LDA(At, 0, 1); PG8_STAGE(PG8_SA(0, 0), a2, voffA);
            PG8_BAR; PG8_WAIT_L(0); PG8_MMA(1, 0, At, B0); PG8_BAR; PG8_SCHED;
            PG8_STAGE(PG8_SB(0, 1), b2 + hstep, voffB);
            PG8_WAIT_V(6); PG8_BAR; PG8_MMA(1, 1, At, B1); PG8_BAR;
            PG8_LDB(B0, 1, 0); PG8_SCHED; PG8_LDA(At, 1, 0); PG8_STAGE(PG8_SA(0, 1), a2 + hstep, voffA);
            PG8_WAIT_L(8); PG8_BAR; PG8_WAIT_L(0); PG8_MMA(0, 0, At, B0); PG8_BAR; PG8_SCHED;
            PG8_LDB(B1, 1, 1); PG8_STAGE(PG8_SB(1, 0), b3, voffB);
            PG8_BAR; PG8_WAIT_L(0); PG8_MMA(0, 1, At, B1); PG8_BAR;
            PG8_LDA(At, 1, 1); PG8_STAGE(PG8_SA(1, 0), a3, voffA);
            PG8_BAR; PG8_WAIT_L(0); PG8_MMA(1, 0, At, B0); PG8_BAR; PG8_SCHED;
            PG8_STAGE(PG8_SB(1, 1), b3 + hstep, voffB);
            PG8_WAIT_V(6); PG8_BAR; PG8_MMA(1, 1, At, B1); PG8_BAR;
        }
        E(acc, cur, wr, wc, fr, fq);
        if (!has_next) break;
#pragma unroll
        for (int a = 0; a < 2; ++a)
#pragma unroll
            for (int b = 0; b < 2; ++b)
#pragma unroll
                for (int m = 0; m < 4; ++m)
#pragma unroll
                    for (int n = 0; n < 2; ++n) acc[a][b][m][n] = (f32x4){0.f, 0.f, 0.f, 0.f};
        cur = nxt; cA = nA; cB = nB; ++ui;
    }
    PG8_WAIT_V(0);
    if (wr == 0) PG8_BAR;
    PG8_BAR;
#undef PG8_SA
#undef PG8_SB
#undef PG8_STAGE
#undef PG8_LDA
#undef PG8_LDB
#undef PG8_MMA
#undef PG8_WAIT_V
#undef PG8_WAIT_L
#undef PG8_BAR
#undef PG8_SCHED
}
}

template <class Epi>
__device__ __forceinline__ void run_gemm(unsigned char* smem, const bf16_t* A, const bf16_t* Bt, int M, int N, int K, const Epi& E) {
    pg8::Gemm g{A, Bt, M, N, K}; pg8::StaticOrder S; S.init(M, N, (int)gridDim.x, (int)blockIdx.x);
    pg8::gemm_phase<Epi, pg8::StaticOrder>((LAS unsigned char*)smem, g, S, E);
}

__device__ __forceinline__ float* xrow(const KQ p, int t) { return t < TL ? p.out + (size_t)t * D : (float*)(p.ws + WS_XC) + (size_t)(t - TL) * D; }
__device__ __forceinline__ int modrow(int t) { return t < TL ? (t >> 12) : 4; }
__device__ __forceinline__ const float* modp(const KQ p, int l, int mr, int idx) { return (const float*)(p.ws + WS_MOD) + ((size_t)(l * 5 + mr) * NMOD + idx) * D; }

__device__ __forceinline__ void p0_setup(const KQ p, float* sm) {
    const int tid = ltid(), bid = blockIdx.x, nb = gridDim.x;
    const int gtid = bid * 512 + tid, gthreads = nb * 512;
    {
        const float4* xs = (const float4*)pin_ld(0); float4* xd = (float4*)p.out;
        for (int i = gtid; i < TL * D / 4; i += gthreads) xd[i] = xs[i];
        const float4* cs = (const float4*)pin_ld(2); float4* cd = (float4*)(p.ws + WS_XC);
        for (int i = gtid; i < TC * D / 4; i += gthreads) cd[i] = cs[i];
    }
    {
        float* rope = (float*)(p.ws + WS_ROPE);
        for (int idx = gtid; idx < SEQ * 32; idx += gthreads) {
            const int t = idx >> 5, i = idx & 31;
            const int ii = i & 15; const float pos = (i < 16) ? (float)(t >> 6) : (float)(t & 63);
            const float invA = powf(10000.0f, -(float)ii / 16.0f);
            const float angA = pos * invA;
            rope[idx] = cosf(angA); rope[SEQ * 32 + idx] = sinf(angA);
            const float ex = (float)i * (1.0f / 31.0f);
            const float invR = powf(10000.0f, -ex);
            const float angR = (float)t * invR;
            rope[2 * SEQ * 32 + idx] = cosf(angR); rope[3 * SEQ * 32 + idx] = sinf(angR);
        }
    }
    {
        float* tile = sm;
        for (int g = bid; g < 20864; g += nb) {
            int j, tl;
            if (g < 16896) { j = g / 704; tl = g % 704; }
            else if (g < 18304) { j = 24 + (g - 16896) / 704; tl = (g - 16896) % 704; }
            else if (g < 18816) { j = 26 + (g - 18304) / 256; tl = (g - 18304) % 256; }
            else if (g < 20352) { j = 28 + (g - 18816) / 768; tl = (g - 18816) % 768; }
            else { j = 30 + (g - 20352) / 256; tl = (g - 20352) % 256; }
            const float* src; bf16_t* dst; int K, N, mode = 0;
            if (j < 8) { src = pin_ld(8) + (size_t)j * D * DFF; dst = (bf16_t*)(p.ws + WS_WGU + (size_t)j * SZ_WGU); K = D; N = DFF; mode = 1; }
            else if (j < 16) { src = pin_ld(9) + (size_t)(j - 8) * D * DFF; dst = (bf16_t*)(p.ws + WS_WGU + (size_t)(j - 8) * SZ_WGU); K = D; N = DFF; mode = 2; }
            else if (j < 24) { src = pin_ld(10) + (size_t)(j - 16) * DFF * D; dst = (bf16_t*)(p.ws + WS_WD + (size_t)(j - 16) * SZ_WD); K = DFF; N = D; }
            else if (j < 26) { src = pin_ld(11) + (size_t)(j - 24) * D * INW; dst = (bf16_t*)(p.ws + WS_WIN + (size_t)(j - 24) * SZ_WIN); K = D; N = INW; mode = 3; }
            else if (j < 28) { src = pin_ld(14) + (size_t)(j - 26) * D * D; dst = (bf16_t*)(p.ws + WS_WOUT + (size_t)(j - 26) * SZ_WOUT); K = D; N = D; }
            else if (j < 30) { src = pin_ld(15) + (size_t)(j - 28) * D * HYW; dst = (bf16_t*)(p.ws + WS_HWIN + (size_t)(j - 28) * SZ_HWIN); K = D; N = HYW; }
            else { src = pin_ld(28) + (size_t)(j - 30) * D * D; dst = (bf16_t*)(p.ws + WS_HWOUT + (size_t)(j - 30) * SZ_WOUT); K = D; N = D; }
            const int ntn = N / 64; const int k0 = (tl / ntn) * 64, n0 = (tl % ntn) * 64;
            __syncthreads();
#pragma unroll
            for (int i = 0; i < 8; ++i) { const int k = i * 8 + (tid >> 6), n = tid & 63; tile[k * 65 + n] = src[(size_t)(k0 + k) * N + n0 + n]; }
            __syncthreads();
#pragma unroll
            for (int i = 0; i < 8; ++i) {
                const int n = i * 8 + (tid >> 6), k = tid & 63; const int gn = n0 + n;
                float v = tile[k * 65 + n];
                int row = gn;
                if (mode == 1) row = 256 * (gn >> 7) + (gn & 127);
                else if (mode == 2) row = 256 * (gn >> 7) + 128 + (gn & 127);
                else if (mode == 3) { if (gn < 512 || (gn >= 1792 && gn < 2304)) v *= 0.125f; }
                dst[(size_t)row * K + k0 + k] = f2bf(v);
            }
        }
        __syncthreads();
    }
    {
        float* sc = sm;
        float* red = sm + 5 * 1024;
        for (int i = tid; i < 5 * 1024; i += 512) { const int r = i >> 10, k = i & 1023; const float v = (r < 4) ? pin_ld(1)[r * D + k] : pin_ld(3)[k]; sc[i] = silu_f(v); }
        __syncthreads();
        const int w = tid >> 6, lane = tid & 63;
        for (int it = bid; it < 288; it += nb) {
            const int l = it / 72, c0 = (it % 72) * 128;
            const float* wm = pin_ld(4) + (size_t)l * D * (NMOD * D) + c0 + 2 * lane;
            float a[5][2];
#pragma unroll
            for (int r = 0; r < 5; ++r) { a[r][0] = 0.f; a[r][1] = 0.f; }
            for (int k = w * 128; k < w * 128 + 128; ++k) {
                const float2 wv = *(const float2*)(wm + (size_t)k * (NMOD * D));
#pragma unroll
                for (int r = 0; r < 5; ++r) { const float s = sc[r * 1024 + k]; a[r][0] += s * wv.x; a[r][1] += s * wv.y; }
            }
#pragma unroll
            for (int r = 0; r < 5; ++r) { red[(w * 5 + r) * 128 + 2 * lane] = a[r][0]; red[(w * 5 + r) * 128 + 2 * lane + 1] = a[r][1]; }
            __syncthreads();
            for (int i = tid; i < 5 * 128; i += 512) {
                const int r = i >> 7, c = i & 127; float s = 0.f;
#pragma unroll
                for (int ww = 0; ww < 8; ++ww) s += red[(ww * 5 + r) * 128 + c];
                s += pin_ld(5)[(size_t)l * (NMOD * D) + c0 + c];
                ((float*)(p.ws + WS_MOD))[(size_t)(l * 5 + r) * (NMOD * D) + c0 + c] = s;
            }
            __syncthreads();
        }
    }
    {
        float* z = sm;
        float* a1 = sm + 16 * 36;
        float* a2 = a1 + 16 * 64;
        float* a3 = a2 + 16 * 64;
        float* tl = a3 + 16 * 64;
        const float HMAX = -4.605170185988091f / 0.3f, HMIN = -4.605170185988091f / 1.5f;
        for (int it = bid; it < 544; it += nb) {
            const int o = it / 272, r = it % 272;
            const int Lf = (r < 256) ? SEQ : CL; const int p0 = (r < 256) ? r * 16 : (r - 256) * 16;
            float* kf = (float*)(p.ws + WS_KF + (size_t)o * SZ_KF) + ((r < 256) ? (size_t)0 : (size_t)2 * SEQ * D);
            const float* f0 = pin_ld(19) + (size_t)o * 33 * 64; const float* fb0 = pin_ld(20) + o * 64;
            const float* f1 = pin_ld(21) + (size_t)o * 64 * 64; const float* fb1 = pin_ld(22) + o * 64;
            const float* f2 = pin_ld(23) + (size_t)o * 64 * 64; const float* fb2 = pin_ld(24) + o * 64;
            const float* f3 = pin_ld(25) + (size_t)o * 64 * 2048; const float* fq = pin_ld(26) + o * 64;
            __syncthreads();
            for (int idx = tid; idx < 16 * 33; idx += 512) {
                const int ps = idx / 33, f = idx % 33; const int i = p0 + ps;
                const float tlin = (float)i * (1.0f / (float)(Lf - 1));
                const float w = (6.283185307179586f * (float)i) / (float)Lf;
                float v;
                if (f == 0) { v = tlin; tl[ps] = tlin; }
                else { const int jj = (f - 1) & 15; const float fj = 1e-4f + (float)jj * ((15.0f - 1e-4f) / 15.0f); v = (f <= 16) ? cosf(fj * w) : -sinf(fj * w); }
                z[ps * 36 + f] = v;
            }
            __syncthreads();
            for (int idx = tid; idx < 16 * 64; idx += 512) { const int ps = idx >> 6, oc = idx & 63; float s = fb0[oc];
                for (int f = 0; f < 33; ++f) s += z[ps * 36 + f] * f0[f * 64 + oc];
                a1[idx] = sinf(fq[oc] * s); }
            __syncthreads();
            for (int idx = tid; idx < 16 * 64; idx += 512) { const int ps = idx >> 6, oc = idx & 63; float s = fb1[oc];
                for (int f = 0; f < 64; ++f) s += a1[ps * 64 + f] * f1[f * 64 + oc];
                a2[idx] = sinf(fq[oc] * s); }
            __syncthreads();
            for (int idx = tid; idx < 16 * 64; idx += 512) { const int ps = idx >> 6, oc = idx & 63; float s = fb2[oc];
                for (int f = 0; f < 64; ++f) s += a2[ps * 64 + f] * f2[f * 64 + oc];
                a3[idx] = sinf(fq[oc] * s); }
            __syncthreads();
            for (int q = 0; q < 4; ++q) {
                const int c = tid + 512 * q; const int dir = c >> 10, d = c & 1023;
                float acc[16];
#pragma unroll
                for (int ps = 0; ps < 16; ++ps) acc[ps] = 0.f;
                for (int f = 0; f < 64; ++f) { const float wv = f3[f * 2048 + c];
#pragma unroll
                    for (int ps = 0; ps < 16; ++ps) acc[ps] += a3[ps * 64 + f] * wv; }
                const float delta = fabsf(HMIN + (float)d * ((HMAX - HMIN) / 1023.0f));
#pragma unroll
                for (int ps = 0; ps < 16; ++ps) {
                    const float kvv = acc[ps] * expf(-tl[ps] * delta);
                    if (r < 256) {
                        bf16_t* rk = (bf16_t*)(p.ws + WS_KF + (size_t)o * SZ_KF) + (size_t)d * 8192;
                        const int m = p0 + ps;
                        if (dir == 0) rk[4095 - m] = f2bf(kvv); else if (m > 0) rk[4095 + m] = f2bf(kvv);
                        if (dir == 0 && m == 0) rk[8191] = 0;
                    } else kf[((size_t)dir * Lf + p0 + ps) * D + d] = kvv;
                }
            }
        }
        __syncthreads();
    }
}

__device__ __forceinline__ void rowphase(const KQ p, int Mupd, const float* Y, int lu, int gidx, float wgt, const float* gpost,
                         int Mnext, int ln, const float* gpre, int shidx, int scidx, bf16_t* Hout) {
    const int tid = ltid(), w = tid >> 6, lane = tid & 63;
    const int Mmax = Mupd > Mnext ? Mupd : Mnext;
    for (int t = blockIdx.x * 8 + w; t < Mmax; t += gridDim.x * 8) {
        float* xr = xrow(p, t); const int mr = modrow(t);
        float4 xv[4];
#pragma unroll
        for (int q = 0; q < 4; ++q) xv[q] = *(const float4*)(xr + q * 256 + lane * 4);
        if (Y != nullptr && t < Mupd) {
            float4 yv[4]; float ss = 0.f;
#pragma unroll
            for (int q = 0; q < 4; ++q) { yv[q] = *(const float4*)(Y + (size_t)t * D + q * 256 + lane * 4); ss += yv[q].x * yv[q].x + yv[q].y * yv[q].y + yv[q].z * yv[q].z + yv[q].w * yv[q].w; }
            ss = wave_sum(ss);
            const float r = rsqrtf(ss * (1.0f / D) + EPS) * wgt;
            const float* gm = modp(p, lu, mr, gidx);
#pragma unroll
            for (int q = 0; q < 4; ++q) {
                const float4 g4 = *(const float4*)(gm + q * 256 + lane * 4); const float4 p4 = *(const float4*)(gpost + q * 256 + lane * 4);
                xv[q].x += r * g4.x * yv[q].x * p4.x; xv[q].y += r * g4.y * yv[q].y * p4.y; xv[q].z += r * g4.z * yv[q].z * p4.z; xv[q].w += r * g4.w * yv[q].w * p4.w;
                *(float4*)(xr + q * 256 + lane * 4) = xv[q];
            }
        }
        if (Hout != nullptr && t < Mnext) {
            float ss = 0.f;
#pragma unroll
            for (int q = 0; q < 4; ++q) ss += xv[q].x * xv[q].x + xv[q].y * xv[q].y + xv[q].z * xv[q].z + xv[q].w * xv[q].w;
            ss = wave_sum(ss);
            const float r = rsqrtf(ss * (1.0f / D) + EPS);
            const float* sh = modp(p, ln, mr, shidx); const float* sc = modp(p, ln, mr, scidx);
#pragma unroll
            for (int q = 0; q < 4; ++q) {
                const float4 g4 = *(const float4*)(gpre + q * 256 + lane * 4); const float4 s4 = *(const float4*)(sc + q * 256 + lane * 4); const float4 h4 = *(const float4*)(sh + q * 256 + lane * 4);
                const float h0 = xv[q].x * r * g4.x * (1.0f + s4.x) + h4.x, h1 = xv[q].y * r * g4.y * (1.0f + s4.y) + h4.y;
                const float h2 = xv[q].z * r * g4.z * (1.0f + s4.z) + h4.z, h3 = xv[q].w * r * g4.w * (1.0f + s4.w) + h4.w;
                uint2 pk; pk.x = (unsigned)f2bf(h0) | ((unsigned)f2bf(h1) << 16); pk.y = (unsigned)f2bf(h2) | ((unsigned)f2bf(h3) << 16);
                *(uint2*)(Hout + (size_t)t * D + q * 256 + lane * 4) = pk;
            }
        }
    }
}

__device__ __forceinline__ float log_sigmoid(float x) { return -log1pf(expf(-x)); }
__device__ __forceinline__ int chunk_t0(int b, int cidx) { return cidx < 32 ? b * SEQ + cidx * 128 : TL + b * CL + (cidx - 32) * 128; }

__device__ __forceinline__ void m1_rope_states(const KQ p, int e, float* sm) {
    const int tid = ltid(), bid = blockIdx.x, nb = gridDim.x;
    bf16_t* Z = (bf16_t*)(p.ws + WS_BIG);
    const float* rope = (const float*)(p.ws + WS_ROPE);
    for (int idx = bid * 512 + tid; idx < TL * 576; idx += nb * 512) {
        const int t = idx / 576, r = idx % 576; const int hd = r >> 5, i = r & 31;
        const int cb = hd < 16 ? hd * 64 : 1536 + (hd - 16) * 64;
        const int tb = (hd >= 8 && hd < 16) ? 2 : 0; const int pos = t & (SEQ - 1);
        const float c = rope[(size_t)tb * SEQ * 32 + pos * 32 + i], s = rope[(size_t)(tb + 1) * SEQ * 32 + pos * 32 + i];
        bf16_t* zp = Z + (size_t)t * INW + cb + i;
        const float x1 = bf2f(zp[0]), x2 = bf2f(zp[32]);
        zp[0] = f2bf(x1 * c - x2 * s); zp[32] = f2bf(x1 * s + x2 * c);
    }
    float* Ks = sm;
    float* Vs = sm + 128 * 64;
    float* wf = Vs + 128 * 64;
    float* wb = wf + 128;
    float* AF = (float*)(p.ws + WS_ST); float* AB = AF + SZ_ST / 4;
    const float* dec = pin_ld(13) + e * 16;
    for (int it = bid; it < NB * NCH * 8; it += nb) {
        const int h = it & 7, cidx = (it >> 3) % NCH, b = it / (8 * NCH);
        const int t0 = chunk_t0(b, cidx); const bool lat = cidx < 32;
        const float lgf = log_sigmoid(dec[h]), lgb = log_sigmoid(dec[8 + h]);
        __syncthreads();
        if (tid < 128) { wf[tid] = expf(lgf * (float)(127 - tid)); wb[tid] = expf(lgb * (float)tid); }
        const int kc = 1792 + h * 64, vc = 2304 + h * 64;
#pragma unroll
        for (int q = 0; q < 8; ++q) {
            const int idx = tid + 512 * q; const int r = idx >> 5, i = idx & 31;
            bf16_t* zp = Z + (size_t)(t0 + r) * INW + kc + i;
            float x1 = bf2f(zp[0]), x2 = bf2f(zp[32]);
            if (lat) {
                const int pos = (t0 + r) & (SEQ - 1);
                const float c = rope[(size_t)2 * SEQ * 32 + pos * 32 + i], s = rope[(size_t)3 * SEQ * 32 + pos * 32 + i];
                const bf16_t o1 = f2bf(x1 * c - x2 * s), o2 = f2bf(x1 * s + x2 * c);
                zp[0] = o1; zp[32] = o2; x1 = bf2f(o1); x2 = bf2f(o2);
            }
            Ks[r * 64 + i] = x1; Ks[r * 64 + 32 + i] = x2;
        }
#pragma unroll
        for (int q = 0; q < 16; ++q) { const int idx = tid + 512 * q; const int r = idx >> 6, c = idx & 63; Vs[idx] = bf2f(Z[(size_t)(t0 + r) * INW + vc + c]); }
        __syncthreads();
        const int d = tid >> 3, e0 = (tid & 7) * 8;
        float af[8], ab[8];
#pragma unroll
        for (int j = 0; j < 8; ++j) { af[j] = 0.f; ab[j] = 0.f; }
        for (int s = 0; s < 128; ++s) {
            const float kv = Ks[s * 64 + d]; const float kfw = kv * wf[s], kbw = kv * wb[s];
            const float4 v0 = *(const float4*)(Vs + s * 64 + e0), v1 = *(const float4*)(Vs + s * 64 + e0 + 4);
            af[0] += kfw * v0.x; af[1] += kfw * v0.y; af[2] += kfw * v0.z; af[3] += kfw * v0.w; af[4] += kfw * v1.x; af[5] += kfw * v1.y; af[6] += kfw * v1.z; af[7] += kfw * v1.w;
            ab[0] += kbw * v0.x; ab[1] += kbw * v0.y; ab[2] += kbw * v0.z; ab[3] += kbw * v0.w; ab[4] += kbw * v1.x; ab[5] += kbw * v1.y; ab[6] += kbw * v1.z; ab[7] += kbw * v1.w;
        }
        const size_t so = ((size_t)(b * NCH + cidx) * 8 + h) * 4096 + d * 64 + e0;
        *(float4*)(AF + so) = make_float4(af[0], af[1], af[2], af[3]); *(float4*)(AF + so + 4) = make_float4(af[4], af[5], af[6], af[7]);
        *(float4*)(AB + so) = make_float4(ab[0], ab[1], ab[2], ab[3]); *(float4*)(AB + so + 4) = make_float4(ab[4], ab[5], ab[6], ab[7]);
    }
    __syncthreads();
}

__device__ __forceinline__ void m2_scan(const KQ p, int e) {
    float* AF = (float*)(p.ws + WS_ST); float* AB = AF + SZ_ST / 4; float* TF = AB + SZ_ST / 4; float* TB = TF + SZ_ST / 4;
    const float* dec = pin_ld(13) + e * 16;
    for (int idx = blockIdx.x * 512 + ltid(); idx < NB * 8 * 4096; idx += gridDim.x * 512) {
        const int el = idx & 4095, h = (idx >> 12) & 7, b = idx >> 15;
        const float gf = expf(log_sigmoid(dec[h]) * 128.0f), gb = expf(log_sigmoid(dec[8 + h]) * 128.0f);
#define SIDX(c) (((size_t)(b * NCH + (c)) * 8 + h) * 4096 + el)
        const float afc0 = AF[SIDX(32)], afc1 = AF[SIDX(33)], abc0 = AB[SIDX(32)], abc1 = AB[SIDX(33)];
        TF[SIDX(32)] = 0.f; TF[SIDX(33)] = afc0; TB[SIDX(33)] = 0.f; TB[SIDX(32)] = abc1;
        float sf = gf * afc0 + afc1, sb = abc0 + gb * abc1;
        for (int c = 0; c < 32; ++c) { TF[SIDX(c)] = sf; sf = gf * sf + AF[SIDX(c)]; }
        for (int c = 31; c >= 0; --c) { TB[SIDX(c)] = sb; sb = AB[SIDX(c)] + gb * sb; }
#undef SIDX
    }
}

typedef short bf16x4 __attribute__((ext_vector_type(4)));
__device__ __forceinline__ bf16x8 pack8(const f32x4& a, const f32x4& b) {
    u32x4 w; w.x = pg8::cvt_pk_bf16(a[0], a[1]); w.y = pg8::cvt_pk_bf16(a[2], a[3]); w.z = pg8::cvt_pk_bf16(b[0], b[1]); w.w = pg8::cvt_pk_bf16(b[2], b[3]);
    return __builtin_bit_cast(bf16x8, w);
}
__device__ __forceinline__ void m3_outputs(const KQ p, int e, bool ctx_full, unsigned char* smem) {
    const int tid = ltid(), bid = blockIdx.x, nb = gridDim.x;
    const int w = tid >> 6, lane = tid & 63, ln = lane & 15, g4 = lane >> 4;
    const bf16_t* Z = (const bf16_t*)(p.ws + WS_BIG);
    bf16_t* MIX = (bf16_t*)(p.ws + WS_MIX);
    const float* dec = pin_ld(13) + e * 16;
    const float* sink = pin_ld(12) + e * 8;
    const float* TF = (const float*)(p.ws + WS_ST) + 2 * (SZ_ST / 4); const float* TB = TF + SZ_ST / 4;
    const int nchunk = ctx_full ? NCH : 32;
    const int nitems = NB * nchunk * 8;
    bf16_t* Kt = (bf16_t*)smem;
    bf16_t* Vt = Kt + 128 * 72;
    bf16_t* TfT = Vt + 64 * 136;
    bf16_t* TbT = TfT + 64 * 72;
    const int i = 16 * w + ln;
    for (int it = bid; it < 2 * nitems; it += nb) {
        const bool is_attn = it >= nitems; const int ii = is_attn ? it - nitems : it;
        const int h = ii & 7, cidx = (ii >> 3) % nchunk, b = ii / (8 * nchunk);
        const int t0 = chunk_t0(b, cidx); const bool lat = cidx < 32;
        f32x4 O[4];
#pragma unroll
        for (int m = 0; m < 4; ++m) O[m] = (f32x4){0.f, 0.f, 0.f, 0.f};
        if (!is_attn) {
            const float lgf = log_sigmoid(dec[h]), lgb = log_sigmoid(dec[8 + h]);
            __syncthreads();
#pragma unroll
            for (int q = 0; q < 2; ++q) { const int idx = tid + 512 * q; const int r = idx >> 3, pc = idx & 7; const bf16_t* zr = Z + (size_t)(t0 + r) * INW + h * 64 + pc * 8;
                *(u32x4*)(Kt + r * 72 + pc * 8) = *(const u32x4*)(zr + 1792);
                const bf16x8 vv = *(const bf16x8*)(zr + 2304);
#pragma unroll
                for (int j = 0; j < 8; ++j) Vt[(pc * 8 + j) * 136 + r] = (bf16_t)vv[j]; }
            const size_t so = ((size_t)(b * NCH + cidx) * 8 + h) * 4096;
#pragma unroll
            for (int q = 0; q < 8; ++q) { const int idx = tid + 512 * q; const int d = idx >> 6, ee = idx & 63; TfT[ee * 72 + d] = f2bf(TF[so + idx]); TbT[ee * 72 + d] = f2bf(TB[so + idx]); }
            __builtin_amdgcn_sched_barrier(0);
            bf16x8 qf[2], qff[2], qfb[2];
            { const bf16_t* qr = Z + (size_t)(t0 + i) * INW + 512 + h * 64 + 8 * g4;
              const float cf = __expf(lgf * (float)(i + 1)), cb = __expf(lgb * (float)(128 - i));
#pragma unroll
              for (int k2 = 0; k2 < 2; ++k2) { qf[k2] = *(const bf16x8*)(qr + 32 * k2);
                  f32x4 a0, a1, b0, b1;
#pragma unroll
                  for (int j = 0; j < 4; ++j) { const float x0 = bf2f((bf16_t)qf[k2][j]), x1 = bf2f((bf16_t)qf[k2][4 + j]); a0[j] = x0 * cf; a1[j] = x1 * cf; b0[j] = x0 * cb; b1[j] = x1 * cb; }
                  qff[k2] = pack8(a0, a1); qfb[k2] = pack8(b0, b1); } }
            __builtin_amdgcn_sched_barrier(0);
            __syncthreads();
#pragma unroll
            for (int m = 0; m < 4; ++m)
#pragma unroll
                for (int k2 = 0; k2 < 2; ++k2) {
                    const bf16x8 af = *(const bf16x8*)(TfT + (16 * m + ln) * 72 + 32 * k2 + 8 * g4);
                    const bf16x8 ab = *(const bf16x8*)(TbT + (16 * m + ln) * 72 + 32 * k2 + 8 * g4);
                    O[m] = __builtin_amdgcn_mfma_f32_16x16x32_bf16(af, qff[k2], O[m], 0, 0, 0);
                    O[m] = __builtin_amdgcn_mfma_f32_16x16x32_bf16(ab, qfb[k2], O[m], 0, 0, 0);
                    __builtin_amdgcn_sched_barrier(0);
                }
            const float lf2 = lgf * 1.44269504f, lb2 = lgb * 1.44269504f; const int di = i - 4 * g4;
            const float bfw = lf2 * (float)di, bbw = -lb2 * (float)di;
            f32x4 st[8];
#pragma unroll
            for (int mt = 0; mt < 8; ++mt) {
                f32x4 a = (f32x4){0.f, 0.f, 0.f, 0.f};
#pragma unroll
                for (int k2 = 0; k2 < 2; ++k2) { const bf16x8 kf = *(const bf16x8*)(Kt + (16 * mt + ln) * 72 + 32 * k2 + 8 * g4); a = __builtin_amdgcn_mfma_f32_16x16x32_bf16(kf, qf[k2], a, 0, 0, 0); }
#pragma unroll
                for (int rg = 0; rg < 4; ++rg) { const int cc = 16 * mt + rg; const int df = di - cc;
                    const float arg = (df > 0) ? fmaf(-lf2, (float)cc, bfw) : fmaf(lb2, (float)cc, bbw);
                    float wgt = __builtin_amdgcn_exp2f(arg); wgt = (df == 0) ? 2.0f : wgt;
                    a[rg] *= wgt; }
                st[mt] = a;
                __builtin_amdgcn_sched_barrier(0);
            }
#pragma unroll
            for (int ks = 0; ks < 4; ++ks) {
                const bf16x8 pfr = pack8(st[2 * ks], st[2 * ks + 1]);
#pragma unroll
                for (int m = 0; m < 4; ++m) {
                    const bf16_t* vr = Vt + (16 * m + ln) * 136 + 32 * ks + 4 * g4;
                    const bf16x4 v0 = *(const bf16x4*)vr, v1 = *(const bf16x4*)(vr + 16);
                    const bf16x8 vf = __builtin_shufflevector(v0, v1, 0, 1, 2, 3, 4, 5, 6, 7);
                    O[m] = __builtin_amdgcn_mfma_f32_16x16x32_bf16(vf, pfr, O[m], 0, 0, 0);
                }
                __builtin_amdgcn_sched_barrier(0);
            }
            float ss = 0.f;
#pragma unroll
            for (int m = 0; m < 4; ++m)
#pragma unroll
                for (int rg = 0; rg < 4; ++rg) ss += O[m][rg] * O[m][rg];
            ss += __shfl_xor(ss, 16, 64); ss += __shfl_xor(ss, 32, 64);
            const float rn = rsqrtf(ss * (1.0f / 64.0f) + EPS);
#pragma unroll
            for (int m = 0; m < 4; ++m) {
                const int ee = 16 * m + 4 * g4;
                const bf16x4 gv = *(const bf16x4*)(Z + (size_t)(t0 + i) * INW + 1024 + h * 64 + ee);
                uint2 o2; o2.x = pg8::cvt_pk_bf16(O[m][0] * rn * silu_f(bf2f((bf16_t)gv[0])), O[m][1] * rn * silu_f(bf2f((bf16_t)gv[1])));
                o2.y = pg8::cvt_pk_bf16(O[m][2] * rn * silu_f(bf2f((bf16_t)gv[2])), O[m][3] * rn * silu_f(bf2f((bf16_t)gv[3])));
                *(uint2*)(MIX + (size_t)(t0 + i) * D + 512 + h * 64 + ee) = o2;
            }
        } else {
            const int gk = h >> 2;
            bf16x8 qf[2];
            { const bf16_t* qr = Z + (size_t)(t0 + i) * INW + h * 64 + 8 * g4; qf[0] = *(const bf16x8*)qr; qf[1] = *(const bf16x8*)(qr + 32); }
            float mx = sink[h], l = (g4 == 0) ? 1.0f : 0.0f;
            const int qpos = lat ? (cidx * 128 + i) : 0;
            for (int tl = 0; tl < 5; ++tl) {
                int kt0; int kp0 = 0; const bool isc = tl >= 3;
                if (!isc) { if (!lat) continue; const int kc = cidx - 1 + tl; if (kc < 0 || kc >= 32) continue; kt0 = b * SEQ + kc * 128; kp0 = kc * 128; }
                else kt0 = TL + b * CL + (tl - 3) * 128;
                __syncthreads();
#pragma unroll
                for (int q = 0; q < 2; ++q) { const int idx = tid + 512 * q; const int r = idx >> 3, pc = idx & 7; const bf16_t* zr = Z + (size_t)(kt0 + r) * INW + gk * 64 + pc * 8;
                    *(u32x4*)(Kt + r * 72 + pc * 8) = *(const u32x4*)(zr + 1536);
                    const bf16x8 vv = *(const bf16x8*)(zr + 1664);
#pragma unroll
                    for (int j = 0; j < 8; ++j) Vt[(pc * 8 + j) * 136 + r] = (bf16_t)vv[j]; }
                __syncthreads();
                f32x4 st[8];
                float mloc = -1e30f;
#pragma unroll
                for (int mt = 0; mt < 8; ++mt) {
                    f32x4 a = (f32x4){0.f, 0.f, 0.f, 0.f};
#pragma unroll
                    for (int k2 = 0; k2 < 2; ++k2) { const bf16x8 kf = *(const bf16x8*)(Kt + (16 * mt + ln) * 72 + 32 * k2 + 8 * g4); a = __builtin_amdgcn_mfma_f32_16x16x32_bf16(kf, qf[k2], a, 0, 0, 0); }
                    if (!isc) {
#pragma unroll
                        for (int rg = 0; rg < 4; ++rg) { const int dd = qpos - (kp0 + 16 * mt + 4 * g4 + rg); if (dd > 128 || dd < -128) a[rg] = -1e30f; }
                    }
#pragma unroll
                    for (int rg = 0; rg < 4; ++rg) mloc = fmaxf(mloc, a[rg]);
                    st[mt] = a;
                    __builtin_amdgcn_sched_barrier(0);
                }
                mloc = fmaxf(mloc, __shfl_xor(mloc, 16, 64)); mloc = fmaxf(mloc, __shfl_xor(mloc, 32, 64));
                const float mnew = fmaxf(mx, mloc);
                const float sc = __expf(mx - mnew); mx = mnew; l *= sc;
#pragma unroll
                for (int m = 0; m < 4; ++m) O[m] *= sc;
#pragma unroll
                for (int mt = 0; mt < 8; ++mt)
#pragma unroll
                    for (int rg = 0; rg < 4; ++rg) { const float pv = __expf(st[mt][rg] - mnew); st[mt][rg] = pv; l += pv; }
#pragma unroll
                for (int ks = 0; ks < 4; ++ks) {
                    const bf16x8 pfr = pack8(st[2 * ks], st[2 * ks + 1]);
#pragma unroll
                    for (int m = 0; m < 4; ++m) {
                        const bf16_t* vr = Vt + (16 * m + ln) * 136 + 32 * ks + 4 * g4;
                        const bf16x4 v0 = *(const bf16x4*)vr, v1 = *(const bf16x4*)(vr + 16);
                        const bf16x8 vf = __builtin_shufflevector(v0, v1, 0, 1, 2, 3, 4, 5, 6, 7);
                        O[m] = __builtin_amdgcn_mfma_f32_16x16x32_bf16(vf, pfr, O[m], 0, 0, 0);
                    }
                    __builtin_amdgcn_sched_barrier(0);
                }
            }
            l += __shfl_xor(l, 16, 64); l += __shfl_xor(l, 32, 64);
            const float inv = 1.0f / l;
#pragma unroll
            for (int m = 0; m < 4; ++m) {
                uint2 o2; o2.x = pg8::cvt_pk_bf16(O[m][0] * inv, O[m][1] * inv); o2.y = pg8::cvt_pk_bf16(O[m][2] * inv, O[m][3] * inv);
                *(uint2*)(MIX + (size_t)(t0 + i) * D + h * 64 + 16 * m + 4 * g4) = o2;
            }
        }
    }
    __syncthreads();
}

__device__ __forceinline__ void h2_shortconv(const KQ p, int o, int M, unsigned char* smem) {
    const int tid = ltid();
    const bf16_t* ZH = (const bf16_t*)(p.ws + WS_BIG);
    const float* w = pin_ld(17) + (size_t)o * 3 * HYW; const float* bs = pin_ld(18) + (size_t)o * HYW;
    bf16_t* VXT = (bf16_t*)(p.ws + WS_Y); bf16_t* X0T = VXT + (size_t)D * TL;
    bf16_t* tx = (bf16_t*)smem;
    bf16_t* tv = tx + 64 * 72;
    const int tok = tid >> 3, cg8 = (tid & 7) * 8;
    for (int it = blockIdx.x; it < (TL / 64) * 16; it += gridDim.x) {
        const int c0 = (it & 15) * 64, t0 = (it >> 4) * 64;
        const int t = t0 + tok; const int pos = t & (SEQ - 1); const bool first = pos == 0, last = pos == SEQ - 1;
        float zz[3][8];
#pragma unroll
        for (int k = 0; k < 3; ++k) {
            const int c = k * 1024 + c0 + cg8;
            const bf16x8 zc = *(const bf16x8*)(ZH + (size_t)t * HYW + c);
            bf16x8 zp = zc, zn = zc;
            if (!first) zp = *(const bf16x8*)(ZH + (size_t)(t - 1) * HYW + c);
            if (!last) zn = *(const bf16x8*)(ZH + (size_t)(t + 1) * HYW + c);
#pragma unroll
            for (int j = 0; j < 8; ++j) {
                float sacc = bs[c + j] + bf2f((bf16_t)zc[j]) * w[HYW + c + j];
                if (!first) sacc += bf2f((bf16_t)zp[j]) * w[c + j];
                if (!last) sacc += bf2f((bf16_t)zn[j]) * w[2 * HYW + c + j];
                zz[k][j] = sacc;
            }
        }
        __syncthreads();
#pragma unroll
        for (int j = 0; j < 8; ++j) { tx[(cg8 + j) * 72 + tok] = f2bf(zz[0][j]); tv[(cg8 + j) * 72 + tok] = f2bf(zz[2][j] * zz[1][j]); }
        __syncthreads();
        { const int ch = tid >> 3, tk = (tid & 7) * 8;
          *(u32x4*)(X0T + (size_t)(c0 + ch) * TL + t0 + tk) = *(const u32x4*)(tx + ch * 72 + tk);
          *(u32x4*)(VXT + (size_t)(c0 + ch) * TL + t0 + tk) = *(const u32x4*)(tv + ch * 72 + tk); }
    }
    __syncthreads();
    if (M > TL) {
        float* VX = (float*)(p.ws + WS_Y); bf16_t* X0 = (bf16_t*)(p.ws + WS_H);
        for (int idx = TL * D + blockIdx.x * 512 + tid; idx < M * D; idx += gridDim.x * 512) {
            const int t = idx >> 10, d = idx & 1023;
            const int pos = (t - TL) & (CL - 1); const bool first = pos == 0, last = pos == CL - 1;
            float zz[3];
#pragma unroll
            for (int k = 0; k < 3; ++k) {
                const int c = k * 1024 + d;
                float sacc = bs[c] + bf2f(ZH[(size_t)t * HYW + c]) * w[HYW + c];
                if (!first) sacc += bf2f(ZH[(size_t)(t - 1) * HYW + c]) * w[c];
                if (!last) sacc += bf2f(ZH[(size_t)(t + 1) * HYW + c]) * w[2 * HYW + c];
                zz[k] = sacc;
            }
            VX[idx] = zz[2] * zz[1]; X0[idx] = f2bf(zz[0]);
        }
    }
}

typedef float f32x16 __attribute__((ext_vector_type(16)));
__device__ __forceinline__ void h3_longconv(const KQ p, int o, bool ctx_full, unsigned char* smem) {
    const int tid = ltid(), w = tid >> 6, lane = tid & 63;
    const float* bias = pin_ld(27) + (size_t)o * D;
    {
        const bf16_t* VXT = (const bf16_t*)(p.ws + WS_Y); const bf16_t* X0T = VXT + (size_t)D * TL;
        bf16_t* HMT = (bf16_t*)(p.ws + WS_H);
        const bf16_t* RKT = (const bf16_t*)(p.ws + WS_KF + (size_t)o * SZ_KF);
        constexpr int RK2_OFF = 16384 + 64, U_OFF = 2 * 16384 + 128, CH_BYTES = U_OFF + 142 * 256;
        const int cw = w >> 2, w4 = w & 3;
        const int ct = tid & 255;
        unsigned char* cb = smem + cw * CH_BYTES;
        unsigned char* ub = cb + U_OFF;
        const int r = lane & 31, hh = lane >> 5;
        for (int pr = blockIdx.x; pr < D / 2; pr += gridDim.x) {
            const int d = pr * 2 + cw;
            __syncthreads();
            { const bf16_t* src = RKT + (size_t)d * 8192;
              for (int i = ct; i < 1024; i += 256) *(u32x4*)(cb + i * 16) = *(const u32x4*)(src + i * 8);
              for (int i = ct; i < 2 * 7 * 4 * 4; i += 256) { const int side = i / 112, rem = i % 112; *(u32x4*)(ub + (side ? (135 * 4 * 64) : 0) + rem * 16) = (u32x4){0u, 0u, 0u, 0u}; }
              for (int i = ct; i < 4 * 512; i += 256) { const int b = i >> 9, pc = i & 511;
                  const u32x4 v = *(const u32x4*)(VXT + (size_t)d * TL + b * SEQ + pc * 8);
                  const int col = ((pc >> 2) + 7) * 4 + b, q = pc & 3;
                  *(u32x4*)(ub + col * 64 + ((q ^ ((col >> 2) & 3)) * 16)) = v; } }
            __syncthreads();
            { const bf16_t* rk = (const bf16_t*)cb; bf16_t* rk2 = (bf16_t*)(cb + RK2_OFF);
              for (int i = ct; i < 4096; i += 256) { const unsigned lo = rk[2 * i + 1]; const unsigned hi = (2 * i + 2 < 8192) ? rk[2 * i + 2] : 0u; *(unsigned*)(rk2 + 2 * i) = lo | (hi << 16); } }
            __syncthreads();
            f32x16 acc[4];
#pragma unroll
            for (int j = 0; j < 4; ++j)
#pragma unroll
                for (int q = 0; q < 16; ++q) acc[j][q] = 0.f;
            const bf16_t* rsel = (const bf16_t*)(cb + ((r & 1) ? 0 : RK2_OFF));
            const int adj = (r & 1) ? 0 : -1;
            const int bq = r & 3;
#define H3_LOAD(AF, BF, DL) do { const int dl_ = (DL); \
                _Pragma("unroll") for (int s2 = 0; s2 < 2; ++s2) { \
                    const int e0 = 4095 - 32 * dl_ - r + 16 * s2 + 8 * hh + adj; \
                    const unsigned* ap = (const unsigned*)(rsel + e0); \
                    u32x4 t4; t4.x = ap[0]; t4.y = ap[1]; t4.z = ap[2]; t4.w = ap[3]; \
                    AF[s2] = __builtin_bit_cast(bf16x8, t4); } \
                _Pragma("unroll") for (int j = 0; j < 4; ++j) { \
                    int ch = 8 * (4 * w4 + j) + (r >> 2) - dl_; ch = ch < -1 ? -1 : (ch > 128 ? 128 : ch); \
                    const int col = (ch + 7) * 4 + bq; const int sw = (col >> 2) & 3; \
                    const unsigned char* bp = ub + col * 64; \
                    BF[j][0] = *(const bf16x8*)(bp + ((hh ^ sw) * 16)); BF[j][1] = *(const bf16x8*)(bp + (((2 + hh) ^ sw) * 16)); } } while (0)
#define H3_MMA(AF, BF) do { \
                _Pragma("unroll") for (int s2 = 0; s2 < 2; ++s2) \
                _Pragma("unroll") for (int j = 0; j < 4; ++j) acc[j] = __builtin_amdgcn_mfma_f32_32x32x16_bf16(AF[s2], BF[j][s2], acc[j], 0, 0, 0); } while (0)
            {
                const int dlo = 32 * w4 - 127, dhi = 32 * w4 + 31;
                bf16x8 afA[2], bfA[4][2], afB[2], bfB[4][2];
                H3_LOAD(afA, bfA, dlo);
                for (int dl = dlo; dl < dhi; dl += 2) {
                    H3_LOAD(afB, bfB, dl + 1);
                    __builtin_amdgcn_sched_barrier(0);
                    H3_MMA(afA, bfA);
                    __builtin_amdgcn_sched_barrier(0);
                    H3_LOAD(afA, bfA, dl + 2);
                    __builtin_amdgcn_sched_barrier(0);
                    H3_MMA(afB, bfB);
                    __builtin_amdgcn_sched_barrier(0);
                }
                H3_MMA(afA, bfA);
            }
#undef H3_LOAD
#undef H3_MMA
            __syncthreads();
            const float bd = bias[d];
#pragma unroll
            for (int j = 0; j < 4; ++j) {
                const int n1 = 8 * (4 * w4 + j) + (r >> 2);
                const int col = (n1 + 7) * 4 + bq; const int sw = (col >> 2) & 3;
                bf16_t* up = (bf16_t*)(ub + col * 64);
#pragma unroll
                for (int q4 = 0; q4 < 4; ++q4) {
                    bf16_t* pp = up + ((q4 ^ sw) * 8) + 4 * hh;
                    const bf16x4 uv = *(const bf16x4*)pp;
                    uint2 o2; o2.x = pg8::cvt_pk_bf16(acc[j][4 * q4] + bd * bf2f((bf16_t)uv[0]), acc[j][4 * q4 + 1] + bd * bf2f((bf16_t)uv[1]));
                    o2.y = pg8::cvt_pk_bf16(acc[j][4 * q4 + 2] + bd * bf2f((bf16_t)uv[2]), acc[j][4 * q4 + 3] + bd * bf2f((bf16_t)uv[3]));
                    *(uint2*)pp = o2;
                }
            }
            __syncthreads();
            for (int i = ct; i < 4 * 512; i += 256) { const int b = i >> 9, pc = i & 511;
                const int col = ((pc >> 2) + 7) * 4 + b, q = pc & 3;
                const bf16x8 yv = *(const bf16x8*)(ub + col * 64 + ((q ^ ((col >> 2) & 3)) * 16));
                const size_t gi = (size_t)d * TL + b * SEQ + pc * 8;
                const bf16x8 xv = *(const bf16x8*)(X0T + gi);
                u32x4 o4;
                o4.x = pg8::cvt_pk_bf16(bf2f((bf16_t)yv[0]) * bf2f((bf16_t)xv[0]), bf2f((bf16_t)yv[1]) * bf2f((bf16_t)xv[1]));
                o4.y = pg8::cvt_pk_bf16(bf2f((bf16_t)yv[2]) * bf2f((bf16_t)xv[2]), bf2f((bf16_t)yv[3]) * bf2f((bf16_t)xv[3]));
                o4.z = pg8::cvt_pk_bf16(bf2f((bf16_t)yv[4]) * bf2f((bf16_t)xv[4]), bf2f((bf16_t)yv[5]) * bf2f((bf16_t)xv[5]));
                o4.w = pg8::cvt_pk_bf16(bf2f((bf16_t)yv[6]) * bf2f((bf16_t)xv[6]), bf2f((bf16_t)yv[7]) * bf2f((bf16_t)xv[7]));
                *(u32x4*)(HMT + gi) = o4; }
        }
        __syncthreads();
    }
    if (ctx_full) {
        const float* VX = (const float*)(p.ws + WS_Y); const bf16_t* X0 = (const bf16_t*)(p.ws + WS_H);
        bf16_t* MIX = (bf16_t*)(p.ws + WS_MIX);
        const float* kf = (const float*)(p.ws + WS_KF + (size_t)o * SZ_KF) + (size_t)2 * SEQ * D;
        for (int idx = blockIdx.x * 512 + tid; idx < (TC / 8) * D; idx += gridDim.x * 512) {
            const int d = idx & 1023, og = idx >> 10;
            const int bb = og >> 5, n0 = (og & 31) * 8, tb = TL + bb * CL;
            const float* up = VX + (size_t)tb * D + d;
            float acc[8];
#pragma unroll
            for (int j = 0; j < 8; ++j) acc[j] = 0.f;
#pragma unroll 1
            for (int mb = 0; mb < CL; mb += 8) {
                float kk[15], uu[8];
#pragma unroll
                for (int q = 0; q < 15; ++q) { const int lag = n0 - mb - 7 + q;
                    kk[q] = (lag >= 0) ? ((lag < CL) ? kf[(size_t)lag * D + d] : 0.f) : ((-lag < CL) ? kf[(size_t)(CL - lag) * D + d] : 0.f); }
#pragma unroll
                for (int u = 0; u < 8; ++u) uu[u] = up[(size_t)(mb + u) * D];
#pragma unroll
                for (int u = 0; u < 8; ++u)
#pragma unroll
                    for (int j = 0; j < 8; ++j) acc[j] += uu[u] * kk[7 - u + j];
            }
            const float bd = bias[d];
#pragma unroll
            for (int j = 0; j < 8; ++j) { const size_t ti = (size_t)(tb + n0 + j) * D + d; MIX[ti] = f2bf(bf2f(X0[ti]) * (acc[j] + bd * VX[ti])); }
        }
    }
}

__device__ __forceinline__ void h3b_transpose(const KQ p, unsigned char* smem) {
    const int tid = ltid();
    const bf16_t* HMT = (const bf16_t*)(p.ws + WS_H); bf16_t* MIX = (bf16_t*)(p.ws + WS_MIX);
    bf16_t* tile = (bf16_t*)smem;
    for (int it = blockIdx.x; it < (TL / 64) * 16; it += gridDim.x) {
        const int c0 = (it & 15) * 64, t0 = (it >> 4) * 64;
        __syncthreads();
        { const int ch = tid >> 3, tk = (tid & 7) * 8; *(u32x4*)(tile + ch * 72 + tk) = *(const u32x4*)(HMT + (size_t)(c0 + ch) * TL + t0 + tk); }
        __syncthreads();
        { const int tok = tid >> 3, cg8 = (tid & 7) * 8; unsigned short v[8];
#pragma unroll
          for (int j = 0; j < 8; ++j) v[j] = tile[(cg8 + j) * 72 + tok];
          u32x4 o4; o4.x = v[0] | ((unsigned)v[1] << 16); o4.y = v[2] | ((unsigned)v[3] << 16); o4.z = v[4] | ((unsigned)v[5] << 16); o4.w = v[6] | ((unsigned)v[7] << 16);
          *(u32x4*)(MIX + (size_t)(t0 + tok) * D + c0 + cg8) = o4; }
    }
    __syncthreads();
}

__global__ void __launch_bounds__(512, 2) mega_fwd(KP kp) {
    unsigned char* const smem = g_smem;
    if (threadIdx.x < 29) *(LAS unsigned long long*)((LAS unsigned char*)g_smem + PTAB_OFF + 8 * threadIdx.x) = ((const unsigned long long*)__builtin_amdgcn_kernarg_segment_ptr())[threadIdx.x];
    KQ p; p.out = kp.out; p.ws = kp.ws;
    cg::grid_group grid = cg::this_grid();
    if (threadIdx.x < 4) ((volatile LAS unsigned*)(LAS unsigned char*)smem)[(LDS_BYTES - 16) / 4 + threadIdx.x] = 0u;
    __syncthreads();
    if (threadIdx.x == 0) (void)xb_add(&((unsigned*)(p.ws + WS_BAR))[XB_XCNT(xb_xcc_id())], 1u);
    grid.sync();
    float* smf = (float*)smem;
    bf16_t* Hb = (bf16_t*)(p.ws + WS_H); bf16_t* BIG = (bf16_t*)(p.ws + WS_BIG); float* Y = (float*)(p.ws + WS_Y); bf16_t* MIX = (bf16_t*)(p.ws + WS_MIX);

#ifndef NO_P0
    p0_setup(p, smf);
#endif
    GRID_BAR();
    rowphase(p, 0, nullptr, 0, 0, 0.f, nullptr, T, 0, pin_ld(6), 0, 1, Hb);
    GRID_BAR();
    for (int l = 0; l < 4; ++l) {
        const bool ctx_live = l <= 2, ctx_full = l < 2;
        const int Mff = ctx_live ? T : TL, Mpost = ctx_full ? T : TL;
        for (int sub = 0; sub < 3; ++sub) {
            if (sub != 1) {
                const int fi = sub >> 1; const int M = (sub == 0) ? Mff : Mpost;
                { pg8::EpiSwiGLU E{BIG, DFF}; run_gemm(smem, Hb, (const bf16_t*)(p.ws + WS_WGU + (size_t)(l * 2 + fi) * SZ_WGU), M, 2 * DFF, D, E); }
                GRID_BAR();
                { pg8::EpiF32 E{Y, D}; run_gemm(smem, BIG, (const bf16_t*)(p.ws + WS_WD + (size_t)(l * 2 + fi) * SZ_WD), M, D, DFF, E); }
                GRID_BAR();
                if (sub == 0) rowphase(p, M, Y, l, 2, 0.5f, pin_ld(7) + (size_t)(l * 3 + 0) * D, Mff, l, pin_ld(6) + (size_t)(l * 3 + 1) * D, 3, 4, Hb);
                else {
                    const int ln = l + 1; const int Mn = (ln < 4) ? ((ln <= 2) ? T : TL) : 0;
                    rowphase(p, M, Y, l, 8, 0.5f, pin_ld(7) + (size_t)(l * 3 + 2) * D, Mn, ln < 4 ? ln : l, pin_ld(6) + (size_t)((ln < 4 ? ln : l) * 3 + 0) * D, 0, 1, ln < 4 ? Hb : nullptr);
                }
                GRID_BAR();
            } else {
                if ((l & 1) == 0) {
                    const int e = l >> 1;
                    { pg8::EpiBf16 E{BIG, INW, nullptr}; run_gemm(smem, Hb, (const bf16_t*)(p.ws + WS_WIN + (size_t)e * SZ_WIN), Mff, INW, D, E); }
                    GRID_BAR();
#ifndef NO_M1
                    m1_rope_states(p, e, smf);
#endif
                    GRID_BAR();
#ifndef NO_M2
                    m2_scan(p, e);
#endif
                    GRID_BAR();
#ifndef NO_M3
                    m3_outputs(p, e, ctx_full, smem);
#endif
                    GRID_BAR();
                    { pg8::EpiF32 E{Y, D}; run_gemm(smem, MIX, (const bf16_t*)(p.ws + WS_WOUT + (size_t)e * SZ_WOUT), Mpost, D, D, E); }
                    GRID_BAR();
                } else {
                    const int o = l >> 1;
                    { pg8::EpiBf16 E{BIG, HYW, pin_ld(16) + (size_t)o * HYW}; run_gemm(smem, Hb, (const bf16_t*)(p.ws + WS_HWIN + (size_t)o * SZ_HWIN), Mpost, HYW, D, E); }
                    GRID_BAR();
#ifndef NO_H2
                    h2_shortconv(p, o, Mpost, smem);
#endif
                    GRID_BAR();
#ifndef NO_H3
                    h3_longconv(p, o, ctx_full, smem);
#endif
                    GRID_BAR();
                    h3b_transpose(p, smem);
                    GRID_BAR();
                    { pg8::EpiF32 E{Y, D}; run_gemm(smem, MIX, (const bf16_t*)(p.ws + WS_HWOUT + (size_t)o * SZ_WOUT), Mpost, D, D, E); }
                    GRID_BAR();
                }
                rowphase(p, Mpost, Y, l, 5, 1.0f, pin_ld(7) + (size_t)(l * 3 + 1) * D, Mpost, l, pin_ld(6) + (size_t)(l * 3 + 2) * D, 6, 7, Hb);
                GRID_BAR();
            }
        }
    }
}

extern "C" void kernel_launch(void* const* d_in, const int* in_sizes, int n_in, void* d_out, int out_size, void* d_ws, size_t ws_size, hipStream_t stream) {
    static int grid = 0;
    if (grid == 0) {
        if (n_in != 29 || out_size != TL * D || ws_size < WS_END) { fprintf(stderr, "kernel_launch: unexpected shapes: n_in %d out %d ws %zu (need %zu)\n", n_in, out_size, ws_size, (size_t)WS_END); grid = -1; return; }
        int dev = 0, cus = 0, per_cu = 0;
        (void)hipGetDevice(&dev);
        (void)hipDeviceGetAttribute(&cus, hipDeviceAttributeMultiprocessorCount, dev);
        if (hipFuncSetAttribute((const void*)mega_fwd, hipFuncAttributeMaxDynamicSharedMemorySize, LDS_BYTES) != hipSuccess) { fprintf(stderr, "kernel_launch: hipFuncSetAttribute failed\n"); grid = -1; return; }
        if (hipOccupancyMaxActiveBlocksPerMultiprocessor(&per_cu, (const void*)mega_fwd, 512, LDS_BYTES) != hipSuccess || per_cu < 1) { fprintf(stderr, "kernel_launch: occupancy query says %d\n", per_cu); per_cu = 1; }
        (void)hipGetLastError();
        grid = cus;
    }
    if (grid < 0) return;
    (void)hipMemsetAsync((unsigned char*)d_ws + WS_BAR, 0, 16384, stream);
    KP kp{};
    for (int i = 0; i < 29; ++i) kp.in[i] = (const float*)d_in[i];
    kp.out = (float*)d_out; kp.ws = (unsigned char*)d_ws;
    void* args[] = {&kp};
    hipError_t e = hipLaunchCooperativeKernel((const void*)mega_fwd, dim3(grid), dim3(512), args, LDS_BYTES, stream);
    if (e != hipSuccess) fprintf(stderr, "cooperative launch failed: %s (grid %d)\n", hipGetErrorString(e), grid);
}
```

```cpp
#include <hip/hip_runtime.h>
#include <hip/hip_cooperative_groups.h>
#include <cstdio>
namespace cg = cooperative_groups;

#define LAS __attribute__((address_space(3)))
typedef unsigned short bf16_t;
typedef short bf16x8 __attribute__((ext_vector_type(8)));
typedef float f32x4 __attribute__((ext_vector_type(4)));
typedef unsigned u32x4 __attribute__((ext_vector_type(4)));

constexpr int D = 1024, NB = 4, SEQ = 4096, CL = 256, TL = NB * SEQ, TC = NB * CL, T = TL + TC, DFF = 2816, INW = 2816, HYW = 3072;
constexpr int NMOD = 9;
constexpr float EPS = 1e-6f;
constexpr int NCH = 34;
constexpr int LDS_BYTES = 144 * 1024;

constexpr size_t SZ_WGU = (size_t)2 * DFF * D * 2, SZ_WD = (size_t)D * DFF * 2, SZ_WIN = (size_t)INW * D * 2, SZ_WOUT = (size_t)D * D * 2, SZ_HWIN = (size_t)HYW * D * 2;
constexpr size_t WS_WGU = 0;
constexpr size_t WS_WD = WS_WGU + 8 * SZ_WGU;
constexpr size_t WS_WIN = WS_WD + 8 * SZ_WD;
constexpr size_t WS_WOUT = WS_WIN + 2 * SZ_WIN;
constexpr size_t WS_HWIN = WS_WOUT + 2 * SZ_WOUT;
constexpr size_t WS_HWOUT = WS_HWIN + 2 * SZ_HWIN;
constexpr size_t WS_MOD = WS_HWOUT + 2 * SZ_WOUT;
constexpr size_t WS_ROPE = WS_MOD + (size_t)4 * 5 * NMOD * D * 4;
constexpr size_t WS_XC = WS_ROPE + (size_t)4 * SEQ * 32 * 4;
constexpr size_t WS_H = WS_XC + (size_t)TC * D * 4;
constexpr size_t WS_BIG = WS_H + (size_t)T * D * 2;
constexpr size_t WS_Y = WS_BIG + (size_t)T * HYW * 2;
constexpr size_t WS_MIX = WS_Y + (size_t)T * D * 4;
constexpr size_t SZ_ST = (size_t)NB * NCH * 8 * 4096 * 4;
constexpr size_t WS_ST = WS_MIX + (size_t)T * D * 2;
constexpr size_t SZ_KF = (size_t)(SEQ + CL) * 2 * D * 4;
constexpr size_t WS_KF = WS_ST + 4 * SZ_ST;
constexpr size_t WS_YP = WS_KF + 2 * SZ_KF;
constexpr size_t WS_BAR = WS_YP + (size_t)4 * TC * D * 4;
constexpr size_t WS_END = WS_BAR + 16384;

struct KP { const float* in[29]; float* out; unsigned char* ws; };
extern __shared__ __attribute__((aligned(16))) unsigned char g_smem[];
constexpr int PTAB_OFF = LDS_BYTES - 512;
__device__ __forceinline__ const float* pin_ld(int k) {
    const unsigned long long v = *(volatile LAS unsigned long long*)((LAS unsigned char*)g_smem + PTAB_OFF + 8 * k);
    const unsigned lo = __builtin_amdgcn_readfirstlane((unsigned)v), hi = __builtin_amdgcn_readfirstlane((unsigned)(v >> 32));
    return (const float*)(((unsigned long long)hi << 32) | lo);
}
struct KQ { float* out; unsigned char* ws; };

__device__ __forceinline__ bf16_t f2bf(float f) { unsigned u = __float_as_uint(f); u += 0x7FFFu + ((u >> 16) & 1u); return (bf16_t)(u >> 16); }
__device__ __forceinline__ float bf2f(bf16_t b) { return __uint_as_float(((unsigned)b) << 16); }
__device__ __forceinline__ float silu_f(float x) { return x / (1.0f + __expf(-x)); }
__device__ __forceinline__ int ltid() { int t = threadIdx.x; asm volatile("" : "+v"(t)); return t; }
__device__ __forceinline__ float wave_sum(float v) {
#pragma unroll
    for (int o = 32; o > 0; o >>= 1) v += __shfl_xor(v, o, 64);
    return v;
}


#define XB_TMO      128
#define XB_XCNT(j)  (256  + 64 * (j))
#define XB_XSUB(j)  (1280 + 64 * (j))
#define XB_XGEN(j)  (2304 + 64 * (j))
#define XB_TOP      3328
#define XB_TOPGEN   3392
#define XCD_BAR_WORDS 3456
#define XB_SPIN_CAP (1u << 18)
__device__ __forceinline__ unsigned xb_ld(unsigned* p)              { return __hip_atomic_load(p, __ATOMIC_RELAXED, __HIP_MEMORY_SCOPE_AGENT); }
__device__ __forceinline__ unsigned xb_add(unsigned* p, unsigned v) { return __hip_atomic_fetch_add(p, v, __ATOMIC_RELAXED, __HIP_MEMORY_SCOPE_AGENT); }
__device__ __forceinline__ unsigned xb_xcc_id() { return (unsigned)__builtin_amdgcn_s_getreg((3 << 11) | 20) & 0xFu; }
#define XB_SPIN(cond, bar) do { unsigned _sp = 0; while (cond) { __builtin_amdgcn_s_sleep(1); \
    if ((++_sp & 255u) == 0u) { if (xb_ld(&(bar)[XB_TMO])) break; if (_sp > XB_SPIN_CAP) { atomicAdd(&(bar)[XB_TMO], 1u); break; } } } } while (0)
struct XcdBarrier { unsigned* bar; unsigned x; volatile LAS unsigned* st; };
__device__ __forceinline__ XcdBarrier xcd_barrier_post(unsigned* bar, volatile LAS unsigned* st) {
    XcdBarrier b; b.bar = bar; b.x = xb_xcc_id(); b.st = st;
    if (threadIdx.x == 0) (void)xb_add(&bar[XB_XCNT(b.x)], 1u);
    return b;
}
__device__ __forceinline__ void xcd_barrier_complete(unsigned* bar, unsigned x, unsigned& nloc, unsigned& nx) {
    const unsigned G = gridDim.x * gridDim.y * gridDim.z;
    unsigned sum, cnt, mine, sp = 0u;
    for (;;) {
        sum = 0u; cnt = 0u; mine = 0u;
#pragma unroll
        for (unsigned j = 0; j < 16; ++j) { const unsigned c = xb_ld(&bar[XB_XCNT(j)]); sum += c; cnt += (c > 0u) ? 1u : 0u; mine = (j == x) ? c : mine; }
        if (sum == G) break;
        __builtin_amdgcn_s_sleep(1);
        if ((++sp & 255u) == 0u) { if (xb_ld(&bar[XB_TMO])) break; if (sp > XB_SPIN_CAP) { atomicAdd(&bar[XB_TMO], 1u); break; } }
    }
    nloc = mine > 0u ? mine : 1u; nx = cnt > 0u ? cnt : 1u;
}
__device__ __forceinline__ void xcd_barrier_impl(unsigned* bar, volatile LAS unsigned* st) {
    asm volatile("s_waitcnt vmcnt(0)" ::: "memory");
    __syncthreads();
    if (ltid() == 0) {
        const unsigned x = xb_xcc_id();
        __builtin_amdgcn_s_waitcnt(0);
        unsigned nloc = st[0], nx = st[1];
        if (nloc == 0u) { xcd_barrier_complete(bar, x, nloc, nx); st[0] = nloc; st[1] = nx; }
        const unsigned old = xb_add(&bar[XB_XSUB(x)], 1u);
        const unsigned gen = old / nloc;
        if (old + 1u == (gen + 1u) * nloc) {
            __builtin_amdgcn_fence(__ATOMIC_RELEASE, "agent");
            asm volatile("s_waitcnt vmcnt(0)" ::: "memory");
            const unsigned og = xb_add(&bar[XB_TOP], 1u);
            const unsigned tg = og / nx;
            if (og + 1u == (tg + 1u) * nx) xb_add(&bar[XB_TOPGEN], 1u);
            else XB_SPIN(xb_ld(&bar[XB_TOPGEN]) == tg, bar);
            __builtin_amdgcn_fence(__ATOMIC_ACQUIRE, "agent");
            xb_add(&bar[XB_XGEN(x)], 1u);
            asm volatile("s_waitcnt vmcnt(0)" ::: "memory");
        } else {
            XB_SPIN(xb_ld(&bar[XB_XGEN(x)]) == gen, bar);
            __builtin_amdgcn_fence(__ATOMIC_ACQUIRE, "agent");
            asm volatile("s_waitcnt vmcnt(0)" ::: "memory");
        }
    }
    __syncthreads();
}
#define GRID_BAR() xcd_barrier_impl((unsigned*)(p.ws + WS_BAR), (volatile LAS unsigned*)((LAS unsigned char*)smem + LDS_BYTES - 16))

namespace pg8 {
constexpr int BM = 256, BK = 64, HALF = 128, HTB = HALF * BK * 2, STAGE_BYTES = 8 * HTB, NXCD = 8, WGM = 8;
__host__ __device__ __forceinline__ int lds_byte(int r, int c) { const int st = (r >> 4) * 2 + (c >> 5), rr = r & 15, cc = c & 31, ob = rr * 64 + cc * 2; return st * 1024 + (ob ^ (((ob >> 9) & 1) << 5)); }
__host__ __device__ __forceinline__ void stage_rc(int b, int& R, int& C) { const int st = b / 1024, sb = b % 1024, swz = sb ^ (((sb >> 9) & 1) << 5); R = (st >> 1) * 16 + swz / 64; C = (st & 1) * 32 + (swz % 64) / 2; }
__host__ __device__ __forceinline__ int perm32(int rho) { const int n = rho >> 4, i = rho & 15; return 8 * (i >> 2) + 4 * n + (i & 3); }
struct Unit { int pm, pn; };
struct Gemm { const bf16_t* A; const bf16_t* Bt; int M, N, K, ld; };
struct StaticOrder {
    int nM, nN, nwg, G, c;
    __device__ void init(int M, int N, int G_, int c_) { nM = M / BM; nN = N / BM; nwg = nM * nN; G = G_; c = c_; }
    __device__ bool next(int i, Unit& u) const {
        const long Lx = (long)i * G + c; if (Lx >= nwg) return false;
        int wgid = (int)Lx; { const int q = nwg / NXCD, r = nwg % NXCD, xcd = wgid % NXCD, off = wgid / NXCD; wgid = (xcd < r ? xcd * (q + 1) : r * (q + 1) + (xcd - r) * q) + off; }
        const int nig = WGM * nN, gid = wgid / nig, fm = gid * WGM, gsz = (nM - fm) < WGM ? (nM - fm) : WGM;
        u.pm = fm + ((wgid % nig) % gsz); u.pn = (wgid % nig) / gsz; return true;
    }
};
__device__ __forceinline__ unsigned cvt_pk_bf16(float lo, float hi) { unsigned r; asm volatile("v_cvt_pk_bf16_f32 %0, %1, %2" : "=v"(r) : "v"(lo), "v"(hi)); return r; }

struct EpiF32 {
    static constexpr bool PERM = false;
    float* C; int ldc;
    __device__ __forceinline__ void operator()(const f32x4 (&acc)[2][2][4][2], const Unit& u, int wr, int wc, int fr, int fq) const {
        const int row0 = u.pm * BM + wr * 64 + fr, col0 = u.pn * BM + wc * 32 + 4 * fq;
#pragma unroll
        for (int ai = 0; ai < 2; ++ai)
#pragma unroll
            for (int m = 0; m < 4; ++m) { float* rowp = C + (size_t)(row0 + ai * HALF + m * 16) * ldc + col0;
#pragma unroll
                for (int bj = 0; bj < 2; ++bj)
#pragma unroll
                    for (int n = 0; n < 2; ++n) *(f32x4*)(rowp + bj * HALF + n * 16) = acc[ai][bj][m][n]; }
    }
};
struct EpiBf16 {
    static constexpr bool PERM = true;
    bf16_t* O; int ldc; const float* bias;
    __device__ __forceinline__ void operator()(const f32x4 (&acc)[2][2][4][2], const Unit& u, int wr, int wc, int fr, int fq) const {
        const int row0 = u.pm * BM + wr * 64 + fr; const int col0 = u.pn * BM + wc * 32 + 8 * fq;
        f32x4 bv[2][2];
#pragma unroll
        for (int bj = 0; bj < 2; ++bj)
#pragma unroll
            for (int n = 0; n < 2; ++n) bv[bj][n] = bias ? *(const f32x4*)(bias + col0 + bj * HALF + 4 * n) : (f32x4){0.f, 0.f, 0.f, 0.f};
#pragma unroll
        for (int ai = 0; ai < 2; ++ai)
#pragma unroll
            for (int m = 0; m < 4; ++m) { bf16_t* rowp = O + (size_t)(row0 + ai * HALF + m * 16) * ldc + col0;
#pragma unroll
                for (int bj = 0; bj < 2; ++bj) { f32x4 v0 = acc[ai][bj][m][0] + bv[bj][0], v1 = acc[ai][bj][m][1] + bv[bj][1];
                    u32x4 w; w.x = cvt_pk_bf16(v0[0], v0[1]); w.y = cvt_pk_bf16(v0[2], v0[3]); w.z = cvt_pk_bf16(v1[0], v1[1]); w.w = cvt_pk_bf16(v1[2], v1[3]);
                    *(u32x4*)(rowp + bj * HALF) = w; } }
    }
};
struct EpiSwiGLU {
    static constexpr bool PERM = true;
    bf16_t* O; int ldc;
    __device__ __forceinline__ void operator()(const f32x4 (&acc)[2][2][4][2], const Unit& u, int wr, int wc, int fr, int fq) const {
        const int row0 = u.pm * BM + wr * 64 + fr; const int col0 = u.pn * HALF + wc * 32 + 8 * fq;
#pragma unroll
        for (int ai = 0; ai < 2; ++ai)
#pragma unroll
            for (int m = 0; m < 4; ++m) { bf16_t* rowp = O + (size_t)(row0 + ai * HALF + m * 16) * ldc + col0;
                float v[8];
#pragma unroll
                for (int n = 0; n < 2; ++n)
#pragma unroll
                    for (int j = 0; j < 4; ++j) { const float g = acc[ai][0][m][n][j], up = acc[ai][1][m][n][j]; v[n * 4 + j] = silu_f(g) * up; }
                u32x4 w; w.x = cvt_pk_bf16(v[0], v[1]); w.y = cvt_pk_bf16(v[2], v[3]); w.z = cvt_pk_bf16(v[4], v[5]); w.w = cvt_pk_bf16(v[6], v[7]);
                *(u32x4*)rowp = w; }
    }
};

template <class Epi, class Sched>
__device__ __forceinline__ void gemm_phase(LAS unsigned char* lds, const Gemm g, const Sched& S, const Epi& E) {
    const int tid = ltid(), wid = __builtin_amdgcn_readfirstlane(tid >> 6), lane = tid & 63, wr = wid >> 2, wc = wid & 3, fr = lane & 15, fq = lane >> 4;
    const int K = g.ld, nt = g.K / BK;
    unsigned voffA[2], voffB[2];
#pragma unroll
    for (int i = 0; i < 2; ++i) { int R, C; stage_rc(tid * 16 + i * 8192, R, C); const int Rb = Epi::PERM ? ((R & ~31) + perm32(R & 31)) : R;
        voffA[i] = (unsigned)(R * K + C) * 2u; voffB[i] = (unsigned)(Rb * K + C) * 2u; }
    const size_t kstep = (size_t)(BK * 2);
    const size_t hstep = (size_t)HALF * K * 2;
    const size_t tstep = 2 * hstep;
    const unsigned ldsw = (unsigned)wid * 1024u;
    const int aoff = lds_byte(wr * 64 + fr, fq * 8), boff = lds_byte(wc * 32 + fr, fq * 8);
#define PG8_SA(b, h) (((b) * 2 + (h)) * HTB)
#define PG8_SB(b, h) ((4 + (b) * 2 + (h)) * HTB)
#define PG8_STAGE(bufoff, gbase, voff) do { _Pragma("unroll") for (int _i = 0; _i < 2; ++_i) \
        __builtin_amdgcn_global_load_lds((const unsigned*)((const char*)(gbase) + (voff)[_i]), (LAS unsigned*)(lds + (bufoff) + ldsw + _i * 8192), 16, 0, 0); } while (0)
#define PG8_LDA(dst, b, h) do { _Pragma("unroll") for (int m = 0; m < 4; ++m) _Pragma("unroll") for (int k = 0; k < 2; ++k) dst[m][k] = *(const LAS bf16x8*)(lds + PG8_SA(b, h) + aoff + m * 2048 + k * 1024); } while (0)
#define PG8_LDB(dst, b, h) do { _Pragma("unroll") for (int n = 0; n < 2; ++n) _Pragma("unroll") for (int k = 0; k < 2; ++k) dst[n][k] = *(const LAS bf16x8*)(lds + PG8_SB(b, h) + boff + n * 2048 + k * 1024); } while (0)
#define PG8_MMA(ai, bj, At, Bt) do { __builtin_amdgcn_s_setprio(1); _Pragma("unroll") for (int m = 0; m < 4; ++m) _Pragma("unroll") for (int n = 0; n < 2; ++n) _Pragma("unroll") for (int k = 0; k < 2; ++k) \
        acc[ai][bj][m][n] = __builtin_amdgcn_mfma_f32_16x16x32_bf16(Bt[n][k], At[m][k], acc[ai][bj][m][n], 0, 0, 0); __builtin_amdgcn_s_setprio(0); } while (0)
#define PG8_WAIT_V(n) asm volatile("s_waitcnt vmcnt(" #n ")" ::: "memory")
#define PG8_WAIT_L(n) asm volatile("s_waitcnt lgkmcnt(" #n ")" ::: "memory")
#define PG8_BAR __builtin_amdgcn_s_barrier()
#define PG8_SCHED __builtin_amdgcn_sched_barrier(0)
    Unit cur, nxt; int ui = 0;
    if (!S.next(0, cur)) return;
    f32x4 acc[2][2][4][2];
#pragma unroll
    for (int a = 0; a < 2; ++a)
#pragma unroll
        for (int b = 0; b < 2; ++b)
#pragma unroll
            for (int m = 0; m < 4; ++m)
#pragma unroll
                for (int n = 0; n < 2; ++n) acc[a][b][m][n] = (f32x4){0.f, 0.f, 0.f, 0.f};
    bf16x8 At[4][2], B0[2][2], B1[2][2];
    const char* cA = (const char*)g.A + (size_t)cur.pm * tstep; const char* cB = (const char*)g.Bt + (size_t)cur.pn * tstep;
    PG8_STAGE(PG8_SB(0, 0), cB, voffB); PG8_STAGE(PG8_SA(0, 0), cA, voffA); PG8_STAGE(PG8_SB(0, 1), cB + hstep, voffB); PG8_STAGE(PG8_SA(0, 1), cA + hstep, voffA);
    if (wr == 1) PG8_BAR;
    PG8_WAIT_V(4); PG8_BAR;
    PG8_STAGE(PG8_SB(1, 0), cB + kstep, voffB); PG8_STAGE(PG8_SA(1, 0), cA + kstep, voffA); PG8_STAGE(PG8_SB(1, 1), cB + hstep + kstep, voffB);
    PG8_WAIT_V(6); PG8_BAR;
    for (;;) {
        const bool has_next = S.next(ui + 1, nxt);
        const char* nA = has_next ? (const char*)g.A + (size_t)nxt.pm * tstep : cA; const char* nB = has_next ? (const char*)g.Bt + (size_t)nxt.pn * tstep : cB;
        for (int t = 0; t < nt; t += 2) {
            const bool last = (t == nt - 2);
            const char* a1 = cA + (size_t)(t + 1) * kstep;
            const char* a2 = last ? nA : cA + (size_t)(t + 2) * kstep; const char* b2 = last ? nB : cB + (size_t)(t + 2) * kstep;
            const char* a3 = a2 + kstep; const char* b3 = b2 + kstep;
            PG8_LDB(B0, 0, 0); PG8_SCHED; PG8_LDA(At, 0, 0); PG8_STAGE(PG8_SA(1, 1), a1 + hstep, voffA);
            PG8_WAIT_L(8); PG8_BAR; PG8_WAIT_L(0); PG8_MMA(0, 0, At, B0); PG8_BAR; PG8_SCHED;
            PG8_LDB(B1, 0, 1); PG8_STAGE(PG8_SB(0, 0), b2, voffB);
            PG8_BAR; PG8_WAIT_L(0); PG8_MMA(0, 1, At, B1); PG8_BAR;
            PG8_LDA(At, 0, 1); PG8_STAGE(PG8_SA(0, 0), a2, voffA);
            PG8_BAR; PG8_WAIT_L(0); PG8_MMA(1, 0, At, B0); PG8_BAR; PG8_SCHED;
            PG8_STAGE(PG8_SB(0, 1), b2 + hstep, voffB);
            PG8_WAIT_V(6); PG8_BAR; PG8_MMA(1, 1, At, B1); PG8_BAR;
            PG8_LDB(B0, 1, 0); PG8_SCHED; PG8_LDA(At, 1, 0); PG8_STAGE(PG8_SA(0, 1), a2 + hstep, voffA);
            PG8_WAIT_L(8); PG8_BAR; PG8_WAIT_L(0); PG8_MMA(0, 0, At, B0); PG8_BAR; PG8_SCHED;
            PG8_LDB(B1, 1, 1); PG8_STAGE(PG8_SB(1, 0), b3, voffB);
            PG8_BAR; PG8_WAIT_L(0); PG8_MMA(0, 1, At, B1); PG8_BAR;
            PG8_LDA(At, 1, 1); PG8_STAGE(PG8_SA(1, 0), a3, voffA);
            PG8_BAR; PG8_WAIT_L(0); PG8_MMA(1, 0, At, B0); PG8_BAR; PG8_SCHED;
            PG8_STAGE(PG8_SB(1, 1), b3 + hstep, voffB);
            PG8_WAIT_V(6); PG8_BAR; PG8_MMA(1, 1, At, B1); PG8_BAR;
        }
        E(acc, cur, wr, wc, fr, fq);
        if (!has_next) break;
#pragma unroll
        for (int a = 0; a < 2; ++a)
#pragma unroll
            for (int b = 0; b < 2; ++b)
#pragma unroll
                for (int m = 0; m < 4; ++m)
#pragma unroll
                    for (int n = 0; n < 2; ++n) acc[a][b][m][n] = (f32x4){0.f, 0.f, 0.f, 0.f};
        cur = nxt; cA = nA; cB = nB; ++ui;
    }
    PG8_WAIT_V(0);
    if (wr == 0) PG8_BAR;
    PG8_BAR;
#undef PG8_SA
#undef PG8_SB
#undef PG8_STAGE
#undef PG8_LDA
#undef PG8_LDB
#undef PG8_MMA
#undef PG8_WAIT_V
#undef PG8_WAIT_L
#undef PG8_BAR
#undef PG8_SCHED
}
}

template <class Epi>
__device__ __forceinline__ void run_gemm(unsigned char* smem, const bf16_t* A, const bf16_t* Bt, int M, int N, int K, const Epi& E) {
    pg8::Gemm g{A, Bt, M, N, K, K}; pg8::StaticOrder S; S.init(M, N, (int)gridDim.x, (int)blockIdx.x);
    pg8::gemm_phase<Epi, pg8::StaticOrder>((LAS unsigned char*)smem, g, S, E);
}
__device__ __forceinline__ void run_gemm_f32_split(unsigned char* smem, const bf16_t* A, const bf16_t* Bt, int M, int K, float* Yo, float* YP) {
    for (int part = 0; part < 2; ++part) {
        pg8::Gemm g; pg8::StaticOrder S; pg8::EpiF32 E;
        if (part == 0) { g = pg8::Gemm{A, Bt, TL, D, K, K}; S.init(TL, D, (int)gridDim.x, (int)blockIdx.x); E = pg8::EpiF32{Yo, D}; }
        else {
            if (M <= TL || blockIdx.x >= 64) break;
            const int ks = blockIdx.x >> 4;
            int koff, klen;
            if (K == DFF) { koff = (ks < 2) ? ks * 768 : 1536 + (ks - 2) * 640; klen = (ks < 2) ? 768 : 640; }
            else { klen = K / 4; koff = ks * klen; }
            g = pg8::Gemm{A + (size_t)TL * K + koff, Bt + koff, TC, D, klen, K}; S.init(TC, D, 16, (int)(blockIdx.x & 15)); E = pg8::EpiF32{YP + (size_t)ks * TC * D, D};
        }
        pg8::gemm_phase<pg8::EpiF32, pg8::StaticOrder>((LAS unsigned char*)smem, g, S, E);
        __syncthreads();
    }
}

__device__ __forceinline__ float* xrow(const KQ p, int t) { return t < TL ? p.out + (size_t)t * D : (float*)(p.ws + WS_XC) + (size_t)(t - TL) * D; }
__device__ __forceinline__ int modrow(int t) { return t < TL ? (t >> 12) : 4; }
__device__ __forceinline__ const float* modp(const KQ p, int l, int mr, int idx) { return (const float*)(p.ws + WS_MOD) + ((size_t)(l * 5 + mr) * NMOD + idx) * D; }

__device__ __forceinline__ void p0_setup(const KQ p, float* sm) {
    const int tid = ltid(), bid = blockIdx.x, nb = gridDim.x;
    const int gtid = bid * 512 + tid, gthreads = nb * 512;
    {
        const float4* xs = (const float4*)pin_ld(0); float4* xd = (float4*)p.out;
        for (int i = gtid; i < TL * D / 4; i += gthreads) xd[i] = xs[i];
        const float4* cs = (const float4*)pin_ld(2); float4* cd = (float4*)(p.ws + WS_XC);
        for (int i = gtid; i < TC * D / 4; i += gthreads) cd[i] = cs[i];
    }
    {
        float* rope = (float*)(p.ws + WS_ROPE);
        for (int idx = gtid; idx < SEQ * 32; idx += gthreads) {
            const int t = idx >> 5, i = idx & 31;
            const int ii = i & 15; const float pos = (i < 16) ? (float)(t >> 6) : (float)(t & 63);
            const float invA = powf(10000.0f, -(float)ii / 16.0f);
            const float angA = pos * invA;
            rope[idx] = cosf(angA); rope[SEQ * 32 + idx] = sinf(angA);
            const float ex = (float)i * (1.0f / 31.0f);
            const float invR = powf(10000.0f, -ex);
            const float angR = (float)t * invR;
            rope[2 * SEQ * 32 + idx] = cosf(angR); rope[3 * SEQ * 32 + idx] = sinf(angR);
        }
    }
    {
        float* tile = sm;
        for (int g = bid; g < 20864; g += nb) {
            int j, tl;
            if (g < 16896) { j = g / 704; tl = g % 704; }
            else if (g < 18304) { j = 24 + (g - 16896) / 704; tl = (g - 16896) % 704; }
            else if (g < 18816) { j = 26 + (g - 18304) / 256; tl = (g - 18304) % 256; }
            else if (g < 20352) { j = 28 + (g - 18816) / 768; tl = (g - 18816) % 768; }
            else { j = 30 + (g - 20352) / 256; tl = (g - 20352) % 256; }
            const float* src; bf16_t* dst; int K, N, mode = 0;
            if (j < 8) { src = pin_ld(8) + (size_t)j * D * DFF; dst = (bf16_t*)(p.ws + WS_WGU + (size_t)j * SZ_WGU); K = D; N = DFF; mode = 1; }
            else if (j < 16) { src = pin_ld(9) + (size_t)(j - 8) * D * DFF; dst = (bf16_t*)(p.ws + WS_WGU + (size_t)(j - 8) * SZ_WGU); K = D; N = DFF; mode = 2; }
            else if (j < 24) { src = pin_ld(10) + (size_t)(j - 16) * DFF * D; dst = (bf16_t*)(p.ws + WS_WD + (size_t)(j - 16) * SZ_WD); K = DFF; N = D; }
            else if (j < 26) { src = pin_ld(11) + (size_t)(j - 24) * D * INW; dst = (bf16_t*)(p.ws + WS_WIN + (size_t)(j - 24) * SZ_WIN); K = D; N = INW; mode = 3; }
            else if (j < 28) { src = pin_ld(14) + (size_t)(j - 26) * D * D; dst = (bf16_t*)(p.ws + WS_WOUT + (size_t)(j - 26) * SZ_WOUT); K = D; N = D; }
            else if (j < 30) { src = pin_ld(15) + (size_t)(j - 28) * D * HYW; dst = (bf16_t*)(p.ws + WS_HWIN + (size_t)(j - 28) * SZ_HWIN); K = D; N = HYW; }
            else { src = pin_ld(28) + (size_t)(j - 30) * D * D; dst = (bf16_t*)(p.ws + WS_HWOUT + (size_t)(j - 30) * SZ_WOUT); K = D; N = D; }
            const int ntn = N / 64; const int k0 = (tl / ntn) * 64, n0 = (tl % ntn) * 64;
            __syncthreads();
#pragma unroll
            for (int i = 0; i < 2; ++i) { const int k = i * 32 + (tid >> 4), n4 = (tid & 15) * 4; const float4 v = *(const float4*)(src + (size_t)(k0 + k) * N + n0 + n4);
                tile[k * 65 + n4] = v.x; tile[k * 65 + n4 + 1] = v.y; tile[k * 65 + n4 + 2] = v.z; tile[k * 65 + n4 + 3] = v.w; }
            __syncthreads();
            {
                const int n = tid >> 3, k8 = (tid & 7) * 8; const int gn = n0 + n;
                float sc_ = 1.0f; int row = gn;
                if (mode == 1) row = 256 * (gn >> 7) + (gn & 127);
                else if (mode == 2) row = 256 * (gn >> 7) + 128 + (gn & 127);
                else if (mode == 3) { if (gn < 512 || (gn >= 1792 && gn < 2304)) sc_ = 0.125f; }
                float v[8];
#pragma unroll
                for (int j = 0; j < 8; ++j) v[j] = tile[(k8 + j) * 65 + n] * sc_;
                u32x4 o4; o4.x = pg8::cvt_pk_bf16(v[0], v[1]); o4.y = pg8::cvt_pk_bf16(v[2], v[3]); o4.z = pg8::cvt_pk_bf16(v[4], v[5]); o4.w = pg8::cvt_pk_bf16(v[6], v[7]);
                *(u32x4*)(dst + (size_t)row * K + k0 + k8) = o4;
            }
        }
        __syncthreads();
    }
    {
        float* sc = sm;
        float* red = sm + 5 * 1024;
        for (int i = tid; i < 5 * 1024; i += 512) { const int r = i >> 10, k = i & 1023; const float v = (r < 4) ? pin_ld(1)[r * D + k] : pin_ld(3)[k]; sc[i] = silu_f(v); }
        __syncthreads();
        const int w = tid >> 6, lane = tid & 63;
        for (int it = bid; it < 288; it += nb) {
            const int l = it / 72, c0 = (it % 72) * 128;
            const float* wm = pin_ld(4) + (size_t)l * D * (NMOD * D) + c0 + 2 * lane;
            float a[5][2];
#pragma unroll
            for (int r = 0; r < 5; ++r) { a[r][0] = 0.f; a[r][1] = 0.f; }
            for (int k = w * 128; k < w * 128 + 128; ++k) {
                const float2 wv = *(const float2*)(wm + (size_t)k * (NMOD * D));
#pragma unroll
                for (int r = 0; r < 5; ++r) { const float s = sc[r * 1024 + k]; a[r][0] += s * wv.x; a[r][1] += s * wv.y; }
            }
#pragma unroll
            for (int r = 0; r < 5; ++r) { red[(w * 5 + r) * 128 + 2 * lane] = a[r][0]; red[(w * 5 + r) * 128 + 2 * lane + 1] = a[r][1]; }
            __syncthreads();
            for (int i = tid; i < 5 * 128; i += 512) {
                const int r = i >> 7, c = i & 127; float s = 0.f;
#pragma unroll
                for (int ww = 0; ww < 8; ++ww) s += red[(ww * 5 + r) * 128 + c];
                s += pin_ld(5)[(size_t)l * (NMOD * D) + c0 + c];
                ((float*)(p.ws + WS_MOD))[(size_t)(l * 5 + r) * (NMOD * D) + c0 + c] = s;
            }
            __syncthreads();
        }
    }
    {
        float* z = sm;
        float* a1 = sm + 16 * 36;
        float* a2 = a1 + 16 * 64;
        float* a3 = a2 + 16 * 64;
        float* tl = a3 + 16 * 64;
        const float HMAX = -4.605170185988091f / 0.3f, HMIN = -4.605170185988091f / 1.5f;
        for (int it = bid; it < 544; it += nb) {
            const int o = it / 272, r = it % 272;
            const int Lf = (r < 256) ? SEQ : CL; const int p0 = (r < 256) ? r * 16 : (r - 256) * 16;
            float* kf = (float*)(p.ws + WS_KF + (size_t)o * SZ_KF) + ((r < 256) ? (size_t)0 : (size_t)2 * SEQ * D);
            const float* f0 = pin_ld(19) + (size_t)o * 33 * 64; const float* fb0 = pin_ld(20) + o * 64;
            const float* f1 = pin_ld(21) + (size_t)o * 64 * 64; const float* fb1 = pin_ld(22) + o * 64;
            const float* f2 = pin_ld(23) + (size_t)o * 64 * 64; const float* fb2 = pin_ld(24) + o * 64;
            const float* f3 = pin_ld(25) + (size_t)o * 64 * 2048; const float* fq = pin_ld(26) + o * 64;
            __syncthreads();
            for (int idx = tid; idx < 16 * 33; idx += 512) {
                const int ps = idx / 33, f = idx % 33; const int i = p0 + ps;
                const float tlin = (float)i * (1.0f / (float)(Lf - 1));
                const float w = (6.283185307179586f * (float)i) / (float)Lf;
                float v;
                if (f == 0) { v = tlin; tl[ps] = tlin; }
                else { const int jj = (f - 1) & 15; const float fj = 1e-4f + (float)jj * ((15.0f - 1e-4f) / 15.0f); v = (f <= 16) ? cosf(fj * w) : -sinf(fj * w); }
                z[ps * 36 + f] = v;
            }
            __syncthreads();
            for (int idx = tid; idx < 16 * 64; idx += 512) { const int ps = idx >> 6, oc = idx & 63; float s = fb0[oc];
                for (int f = 0; f < 33; ++f) s += z[ps * 36 + f] * f0[f * 64 + oc];
                a1[idx] = sinf(fq[oc] * s); }
            __syncthreads();
            for (int idx = tid; idx < 16 * 64; idx += 512) { const int ps = idx >> 6, oc = idx & 63; float s = fb1[oc];
                for (int f = 0; f < 64; ++f) s += a1[ps * 64 + f] * f1[f * 64 + oc];
                a2[idx] = sinf(fq[oc] * s); }
            __syncthreads();
            for (int idx = tid; idx < 16 * 64; idx += 512) { const int ps = idx >> 6, oc = idx & 63; float s = fb2[oc];
                for (int f = 0; f < 64; ++f) s += a2[ps * 64 + f] * f2[f * 64 + oc];
                a3[idx] = sinf(fq[oc] * s); }
            __syncthreads();
            for (int q = 0; q < 4; ++q) {
                const int c = tid + 512 * q; const int dir = c >> 10, d = c & 1023;
                float acc[16];
#pragma unroll
                for (int ps = 0; ps < 16; ++ps) acc[ps] = 0.f;
                for (int f = 0; f < 64; ++f) { const float wv = f3[f * 2048 + c];
#pragma unroll
                    for (int ps = 0; ps < 16; ++ps) acc[ps] += a3[ps * 64 + f] * wv; }
                const float delta = fabsf(HMIN + (float)d * ((HMAX - HMIN) / 1023.0f));
#pragma unroll
                for (int ps = 0; ps < 16; ++ps) {
                    const float kvv = acc[ps] * expf(-tl[ps] * delta);
                    if (r < 256) {
                        bf16_t* rk = (bf16_t*)(p.ws + WS_KF + (size_t)o * SZ_KF) + (size_t)d * 8192;
                        const int m = p0 + ps;
                        if (dir == 0) rk[4095 - m] = f2bf(kvv); else if (m > 0) rk[4095 + m] = f2bf(kvv);
                        if (dir == 0 && m == 0) rk[8191] = 0;
                    } else kf[((size_t)dir * Lf + p0 + ps) * D + d] = kvv;
                }
            }
        }
        __syncthreads();
    }
}

__device__ __forceinline__ void rowphase(const KQ p, int Mupd, const float* Y, int lu, int gidx, float wgt, const float* gpost,
                         int Mnext, int ln, const float* gpre, int shidx, int scidx, bf16_t* Hout) {
    const int tid = ltid(), w = tid >> 6, lane = tid & 63;
    const int Mmax = Mupd > Mnext ? Mupd : Mnext;
    for (int t = (blockIdx.x * 8 + w) * 2; t < Mmax; t += gridDim.x * 16) {
        float* xr = xrow(p, t); const int mr = modrow(t);
        float4 xv[2][4];
#pragma unroll
        for (int rr = 0; rr < 2; ++rr)
#pragma unroll
            for (int q = 0; q < 4; ++q) xv[rr][q] = *(const float4*)(xr + rr * D + q * 256 + lane * 4);
        if (Y != nullptr && t < Mupd) {
            float4 yv[2][4]; float ss[2] = {0.f, 0.f};
#pragma unroll
            for (int rr = 0; rr < 2; ++rr)
#pragma unroll
                for (int q = 0; q < 4; ++q) {
                    if (t < TL) yv[rr][q] = *(const float4*)(Y + (size_t)(t + rr) * D + q * 256 + lane * 4);
                    else { const float* yp = (const float*)(p.ws + WS_YP) + (size_t)(t + rr - TL) * D + q * 256 + lane * 4;
                        const float4 a0 = *(const float4*)yp, a1 = *(const float4*)(yp + (size_t)TC * D), a2 = *(const float4*)(yp + (size_t)2 * TC * D), a3 = *(const float4*)(yp + (size_t)3 * TC * D);
                        yv[rr][q] = make_float4(a0.x + a1.x + a2.x + a3.x, a0.y + a1.y + a2.y + a3.y, a0.z + a1.z + a2.z + a3.z, a0.w + a1.w + a2.w + a3.w); }
                    ss[rr] += yv[rr][q].x * yv[rr][q].x + yv[rr][q].y * yv[rr][q].y + yv[rr][q].z * yv[rr][q].z + yv[rr][q].w * yv[rr][q].w; }
            ss[0] = wave_sum(ss[0]); ss[1] = wave_sum(ss[1]);
            const float r0 = rsqrtf(ss[0] * (1.0f / D) + EPS) * wgt, r1 = rsqrtf(ss[1] * (1.0f / D) + EPS) * wgt;
            const float* gm = modp(p, lu, mr, gidx);
#pragma unroll
            for (int q = 0; q < 4; ++q) {
                const float4 g4 = *(const float4*)(gm + q * 256 + lane * 4); const float4 p4 = *(const float4*)(gpost + q * 256 + lane * 4);
                const float cx = g4.x * p4.x, cy = g4.y * p4.y, cz = g4.z * p4.z, cw = g4.w * p4.w;
                xv[0][q].x += r0 * cx * yv[0][q].x; xv[0][q].y += r0 * cy * yv[0][q].y; xv[0][q].z += r0 * cz * yv[0][q].z; xv[0][q].w += r0 * cw * yv[0][q].w;
                xv[1][q].x += r1 * cx * yv[1][q].x; xv[1][q].y += r1 * cy * yv[1][q].y; xv[1][q].z += r1 * cz * yv[1][q].z; xv[1][q].w += r1 * cw * yv[1][q].w;
                *(float4*)(xr + q * 256 + lane * 4) = xv[0][q]; *(float4*)(xr + D + q * 256 + lane * 4) = xv[1][q];
            }
        }
        if (Hout != nullptr && t < Mnext) {
            float ss[2] = {0.f, 0.f};
#pragma unroll
            for (int rr = 0; rr < 2; ++rr)
#pragma unroll
                for (int q = 0; q < 4; ++q) ss[rr] += xv[rr][q].x * xv[rr][q].x + xv[rr][q].y * xv[rr][q].y + xv[rr][q].z * xv[rr][q].z + xv[rr][q].w * xv[rr][q].w;
            ss[0] = wave_sum(ss[0]); ss[1] = wave_sum(ss[1]);
            const float rn[2] = {rsqrtf(ss[0] * (1.0f / D) + EPS), rsqrtf(ss[1] * (1.0f / D) + EPS)};
            const float* sh = modp(p, ln, mr, shidx); const float* sc = modp(p, ln, mr, scidx);
#pragma unroll
            for (int q = 0; q < 4; ++q) {
                const float4 g4 = *(const float4*)(gpre + q * 256 + lane * 4); const float4 s4 = *(const float4*)(sc + q * 256 + lane * 4); const float4 h4 = *(const float4*)(sh + q * 256 + lane * 4);
                const float mx_ = g4.x * (1.0f + s4.x), my_ = g4.y * (1.0f + s4.y), mz_ = g4.z * (1.0f + s4.z), mw_ = g4.w * (1.0f + s4.w);
#pragma unroll
                for (int rr = 0; rr < 2; ++rr) {
                    const float h0 = xv[rr][q].x * rn[rr] * mx_ + h4.x, h1 = xv[rr][q].y * rn[rr] * my_ + h4.y;
                    const float h2 = xv[rr][q].z * rn[rr] * mz_ + h4.z, h3 = xv[rr][q].w * rn[rr] * mw_ + h4.w;
                    uint2 pk; pk.x = pg8::cvt_pk_bf16(h0, h1); pk.y = pg8::cvt_pk_bf16(h2, h3);
                    *(uint2*)(Hout + (size_t)(t + rr) * D + q * 256 + lane * 4) = pk;
                }
            }
        }
    }
}

__device__ __forceinline__ float log_sigmoid(float x) { return -log1pf(expf(-x)); }
__device__ __forceinline__ int chunk_t0(int b, int cidx) { return cidx < 32 ? b * SEQ + cidx * 128 : TL + b * CL + (cidx - 32) * 128; }

__device__ __forceinline__ void m1_rope_states(const KQ p, int e, float* sm) {
    const int tid = ltid(), bid = blockIdx.x, nb = gridDim.x;
    bf16_t* Z = (bf16_t*)(p.ws + WS_BIG);
    const float* rope = (const float*)(p.ws + WS_ROPE);
    for (int idx = bid * 512 + tid; idx < TL * 576; idx += nb * 512) {
        const int t = idx / 576, r = idx % 576; const int hd = r >> 5, i = r & 31;
        const int cb = hd < 16 ? hd * 64 : 1536 + (hd - 16) * 64;
        const int tb = (hd >= 8 && hd < 16) ? 2 : 0; const int pos = t & (SEQ - 1);
        const float c = rope[(size_t)tb * SEQ * 32 + pos * 32 + i], s = rope[(size_t)(tb + 1) * SEQ * 32 + pos * 32 + i];
        bf16_t* zp = Z + (size_t)t * INW + cb + i;
        const float x1 = bf2f(zp[0]), x2 = bf2f(zp[32]);
        zp[0] = f2bf(x1 * c - x2 * s); zp[32] = f2bf(x1 * s + x2 * c);
    }
    float* Ks = sm;
    float* Vs = sm + 128 * 64;
    float* wf = Vs + 128 * 64;
    float* wb = wf + 128;
    float* AF = (float*)(p.ws + WS_ST); float* AB = AF + SZ_ST / 4;
    const float* dec = pin_ld(13) + e * 16;
    for (int it = bid; it < NB * NCH * 8; it += nb) {
        const int h = it & 7, cidx = (it >> 3) % NCH, b = it / (8 * NCH);
        const int t0 = chunk_t0(b, cidx); const bool lat = cidx < 32;
        const float lgf = log_sigmoid(dec[h]), lgb = log_sigmoid(dec[8 + h]);
        __syncthreads();
        if (tid < 128) { wf[tid] = expf(lgf * (float)(127 - tid)); wb[tid] = expf(lgb * (float)tid); }
        const int kc = 1792 + h * 64, vc = 2304 + h * 64;
#pragma unroll
        for (int q = 0; q < 8; ++q) {
            const int idx = tid + 512 * q; const int r = idx >> 5, i = idx & 31;
            bf16_t* zp = Z + (size_t)(t0 + r) * INW + kc + i;
            float x1 = bf2f(zp[0]), x2 = bf2f(zp[32]);
            if (lat) {
                const int pos = (t0 + r) & (SEQ - 1);
                const float c = rope[(size_t)2 * SEQ * 32 + pos * 32 + i], s = rope[(size_t)3 * SEQ * 32 + pos * 32 + i];
                const bf16_t o1 = f2bf(x1 * c - x2 * s), o2 = f2bf(x1 * s + x2 * c);
                zp[0] = o1; zp[32] = o2; x1 = bf2f(o1); x2 = bf2f(o2);
            }
            Ks[r * 64 + i] = x1; Ks[r * 64 + 32 + i] = x2;
        }
#pragma unroll
        for (int q = 0; q < 16; ++q) { const int idx = tid + 512 * q; const int r = idx >> 6, c = idx & 63; Vs[idx] = bf2f(Z[(size_t)(t0 + r) * INW + vc + c]); }
        __syncthreads();
        const int d = tid >> 3, e0 = (tid & 7) * 8;
        float af[8], ab[8];
#pragma unroll
        for (int j = 0; j < 8; ++j) { af[j] = 0.f; ab[j] = 0.f; }
        for (int s = 0; s < 128; ++s) {
            const float kv = Ks[s * 64 + d]; const float kfw = kv * wf[s], kbw = kv * wb[s];
            const float4 v0 = *(const float4*)(Vs + s * 64 + e0), v1 = *(const float4*)(Vs + s * 64 + e0 + 4);
            af[0] += kfw * v0.x; af[1] += kfw * v0.y; af[2] += kfw * v0.z; af[3] += kfw * v0.w; af[4] += kfw * v1.x; af[5] += kfw * v1.y; af[6] += kfw * v1.z; af[7] += kfw * v1.w;
            ab[0] += kbw * v0.x; ab[1] += kbw * v0.y; ab[2] += kbw * v0.z; ab[3] += kbw * v0.w; ab[4] += kbw * v1.x; ab[5] += kbw * v1.y; ab[6] += kbw * v1.z; ab[7] += kbw * v1.w;
        }
        const size_t so = ((size_t)(b * NCH + cidx) * 8 + h) * 4096 + d * 64 + e0;
        *(float4*)(AF + so) = make_float4(af[0], af[1], af[2], af[3]); *(float4*)(AF + so + 4) = make_float4(af[4], af[5], af[6], af[7]);
        *(float4*)(AB + so) = make_float4(ab[0], ab[1], ab[2], ab[3]); *(float4*)(AB + so + 4) = make_float4(ab[4], ab[5], ab[6], ab[7]);
    }
    __syncthreads();
}

__device__ __forceinline__ void m2_scan(const KQ p, int e) {
    float* AF = (float*)(p.ws + WS_ST); float* AB = AF + SZ_ST / 4; float* TF = AB + SZ_ST / 4; float* TB = TF + SZ_ST / 4;
    const float* dec = pin_ld(13) + e * 16;
    for (int idx = blockIdx.x * 512 + ltid(); idx < NB * 8 * 4096; idx += gridDim.x * 512) {
        const int el = idx & 4095, h = (idx >> 12) & 7, b = idx >> 15;
        const float gf = expf(log_sigmoid(dec[h]) * 128.0f), gb = expf(log_sigmoid(dec[8 + h]) * 128.0f);
#define SIDX(c) (((size_t)(b * NCH + (c)) * 8 + h) * 4096 + el)
        const float afc0 = AF[SIDX(32)], afc1 = AF[SIDX(33)], abc0 = AB[SIDX(32)], abc1 = AB[SIDX(33)];
        TF[SIDX(32)] = 0.f; TF[SIDX(33)] = afc0; TB[SIDX(33)] = 0.f; TB[SIDX(32)] = abc1;
        float sf = gf * afc0 + afc1, sb = abc0 + gb * abc1;
        for (int c = 0; c < 32; ++c) { TF[SIDX(c)] = sf; sf = gf * sf + AF[SIDX(c)]; }
        for (int c = 31; c >= 0; --c) { TB[SIDX(c)] = sb; sb = AB[SIDX(c)] + gb * sb; }
#undef SIDX
    }
}

typedef short bf16x4 __attribute__((ext_vector_type(4)));
__device__ __forceinline__ bf16x8 pack8(const f32x4& a, const f32x4& b) {
    u32x4 w; w.x = pg8::cvt_pk_bf16(a[0], a[1]); w.y = pg8::cvt_pk_bf16(a[2], a[3]); w.z = pg8::cvt_pk_bf16(b[0], b[1]); w.w = pg8::cvt_pk_bf16(b[2], b[3]);
    return __builtin_bit_cast(bf16x8, w);
}
__device__ __forceinline__ void m3_outputs(const KQ p, int e, bool ctx_full, unsigned char* smem) {
    const int tid = ltid(), bid = blockIdx.x, nb = gridDim.x;
    const int w = tid >> 6, lane = tid & 63, ln = lane & 15, g4 = lane >> 4;
    const bf16_t* Z = (const bf16_t*)(p.ws + WS_BIG);
    bf16_t* MIX = (bf16_t*)(p.ws + WS_MIX);
    const float* dec = pin_ld(13) + e * 16;
    const float* sink = pin_ld(12) + e * 8;
    const float* TF = (const float*)(p.ws + WS_ST) + 2 * (SZ_ST / 4); const float* TB = TF + SZ_ST / 4;
    const int nchunk = ctx_full ? NCH : 32;
    const int nitems = NB * nchunk * 8;
    bf16_t* Kt = (bf16_t*)smem;
    bf16_t* Vt = Kt + 128 * 72;
    bf16_t* TfT = Vt + 64 * 136;
    bf16_t* TbT = TfT + 64 * 72;
    const int i = 16 * w + ln;
    for (int it = bid; it < 2 * nitems; it += nb) {
        const bool is_attn = it >= nitems; const int ii = is_attn ? it - nitems : it;
        const int h = ii & 7, cidx = (ii >> 3) % nchunk, b = ii / (8 * nchunk);
        const int t0 = chunk_t0(b, cidx); const bool lat = cidx < 32;
        f32x4 O[4];
#pragma unroll
        for (int m = 0; m < 4; ++m) O[m] = (f32x4){0.f, 0.f, 0.f, 0.f};
        if (!is_attn) {
            const float lgf = log_sigmoid(dec[h]), lgb = log_sigmoid(dec[8 + h]);
            __syncthreads();
#pragma unroll
            for (int q = 0; q < 2; ++q) { const int idx = tid + 512 * q; const int r = idx >> 3, pc = idx & 7; const bf16_t* zr = Z + (size_t)(t0 + r) * INW + h * 64 + pc * 8;
                *(u32x4*)(Kt + r * 72 + pc * 8) = *(const u32x4*)(zr + 1792);
                const bf16x8 vv = *(const bf16x8*)(zr + 2304);
#pragma unroll
                for (int j = 0; j < 8; ++j) Vt[(pc * 8 + j) * 136 + r] = (bf16_t)vv[j]; }
            const size_t so = ((size_t)(b * NCH + cidx) * 8 + h) * 4096;
#pragma unroll
            for (int q = 0; q < 8; ++q) { const int idx = tid + 512 * q; const int d = idx >> 6, ee = idx & 63; TfT[ee * 72 + d] = f2bf(TF[so + idx]); TbT[ee * 72 + d] = f2bf(TB[so + idx]); }
            __builtin_amdgcn_sched_barrier(0);
            bf16x8 qf[2], qff[2], qfb[2];
            { const bf16_t* qr = Z + (size_t)(t0 + i) * INW + 512 + h * 64 + 8 * g4;
              const float cf = __expf(lgf * (float)(i + 1)), cb = __expf(lgb * (float)(128 - i));
#pragma unroll
              for (int k2 = 0; k2 < 2; ++k2) { qf[k2] = *(const bf16x8*)(qr + 32 * k2);
                  f32x4 a0, a1, b0, b1;
#pragma unroll
                  for (int j = 0; j < 4; ++j) { const float x0 = bf2f((bf16_t)qf[k2][j]), x1 = bf2f((bf16_t)qf[k2][4 + j]); a0[j] = x0 * cf; a1[j] = x1 * cf; b0[j] = x0 * cb; b1[j] = x1 * cb; }
                  qff[k2] = pack8(a0, a1); qfb[k2] = pack8(b0, b1); } }
            __builtin_amdgcn_sched_barrier(0);
            __syncthreads();
#pragma unroll
            for (int m = 0; m < 4; ++m)
#pragma unroll
                for (int k2 = 0; k2 < 2; ++k2) {
                    const bf16x8 af = *(const bf16x8*)(TfT + (16 * m + ln) * 72 + 32 * k2 + 8 * g4);
                    const bf16x8 ab = *(const bf16x8*)(TbT + (16 * m + ln) * 72 + 32 * k2 + 8 * g4);
                    O[m] = __builtin_amdgcn_mfma_f32_16x16x32_bf16(af, qff[k2], O[m], 0, 0, 0);
                    O[m] = __builtin_amdgcn_mfma_f32_16x16x32_bf16(ab, qfb[k2], O[m], 0, 0, 0);
                    __builtin_amdgcn_sched_barrier(0);
                }
            const float lf2 = lgf * 1.44269504f, lb2 = lgb * 1.44269504f; const int di = i - 4 * g4;
            const float bfw = lf2 * (float)di, bbw = -lb2 * (float)di;
            f32x4 st[8];
#pragma unroll
            for (int mt = 0; mt < 8; ++mt) {
                f32x4 a = (f32x4){0.f, 0.f, 0.f, 0.f};
#pragma unroll
                for (int k2 = 0; k2 < 2; ++k2) { const bf16x8 kf = *(const bf16x8*)(Kt + (16 * mt + ln) * 72 + 32 * k2 + 8 * g4); a = __builtin_amdgcn_mfma_f32_16x16x32_bf16(kf, qf[k2], a, 0, 0, 0); }
#pragma unroll
                for (int rg = 0; rg < 4; ++rg) { const int cc = 16 * mt + rg; const int df = di - cc;
                    const float arg = (df > 0) ? fmaf(-lf2, (float)cc, bfw) : fmaf(lb2, (float)cc, bbw);
                    float wgt = __builtin_amdgcn_exp2f(arg); wgt = (df == 0) ? 2.0f : wgt;
                    a[rg] *= wgt; }
                st[mt] = a;
                __builtin_amdgcn_sched_barrier(0);
            }
#pragma unroll
            for (int ks = 0; ks < 4; ++ks) {
                const bf16x8 pfr = pack8(st[2 * ks], st[2 * ks + 1]);
#pragma unroll
                for (int m = 0; m < 4; ++m) {
                    const bf16_t* vr = Vt + (16 * m + ln) * 136 + 32 * ks + 4 * g4;
                    const bf16x4 v0 = *(const bf16x4*)vr, v1 = *(const bf16x4*)(vr + 16);
                    const bf16x8 vf = __builtin_shufflevector(v0, v1, 0, 1, 2, 3, 4, 5, 6, 7);
                    O[m] = __builtin_amdgcn_mfma_f32_16x16x32_bf16(vf, pfr, O[m], 0, 0, 0);
                }
                __builtin_amdgcn_sched_barrier(0);
            }
            float ss = 0.f;
#pragma unroll
            for (int m = 0; m < 4; ++m)
#pragma unroll
                for (int rg = 0; rg < 4; ++rg) ss += O[m][rg] * O[m][rg];
            ss += __shfl_xor(ss, 16, 64); ss += __shfl_xor(ss, 32, 64);
            const float rn = rsqrtf(ss * (1.0f / 64.0f) + EPS);
#pragma unroll
            for (int m = 0; m < 4; ++m) {
                const int ee = 16 * m + 4 * g4;
                const bf16x4 gv = *(const bf16x4*)(Z + (size_t)(t0 + i) * INW + 1024 + h * 64 + ee);
                uint2 o2; o2.x = pg8::cvt_pk_bf16(O[m][0] * rn * silu_f(bf2f((bf16_t)gv[0])), O[m][1] * rn * silu_f(bf2f((bf16_t)gv[1])));
                o2.y = pg8::cvt_pk_bf16(O[m][2] * rn * silu_f(bf2f((bf16_t)gv[2])), O[m][3] * rn * silu_f(bf2f((bf16_t)gv[3])));
                *(uint2*)(MIX + (size_t)(t0 + i) * D + 512 + h * 64 + ee) = o2;
            }
        } else {
            const int gk = h >> 2;
            bf16x8 qf[2];
            { const bf16_t* qr = Z + (size_t)(t0 + i) * INW + h * 64 + 8 * g4; qf[0] = *(const bf16x8*)qr; qf[1] = *(const bf16x8*)(qr + 32); }
            float mx = sink[h], l = (g4 == 0) ? 1.0f : 0.0f;
            const int qpos = lat ? (cidx * 128 + i) : 0;
            for (int tl = 0; tl < 5; ++tl) {
                int kt0; int kp0 = 0; const bool isc = tl >= 3;
                if (!isc) { if (!lat) continue; const int kc = cidx - 1 + tl; if (kc < 0 || kc >= 32) continue; kt0 = b * SEQ + kc * 128; kp0 = kc * 128; }
                else kt0 = TL + b * CL + (tl - 3) * 128;
                __syncthreads();
#pragma unroll
                for (int q = 0; q < 2; ++q) { const int idx = tid + 512 * q; const int r = idx >> 3, pc = idx & 7; const bf16_t* zr = Z + (size_t)(kt0 + r) * INW + gk * 64 + pc * 8;
                    *(u32x4*)(Kt + r * 72 + pc * 8) = *(const u32x4*)(zr + 1536);
                    const bf16x8 vv = *(const bf16x8*)(zr + 1664);
#pragma unroll
                    for (int j = 0; j < 8; ++j) Vt[(pc * 8 + j) * 136 + r] = (bf16_t)vv[j]; }
                __syncthreads();
                f32x4 st[8];
                float mloc = -1e30f;
#pragma unroll
                for (int mt = 0; mt < 8; ++mt) {
                    f32x4 a = (f32x4){0.f, 0.f, 0.f, 0.f};
#pragma unroll
                    for (int k2 = 0; k2 < 2; ++k2) { const bf16x8 kf = *(const bf16x8*)(Kt + (16 * mt + ln) * 72 + 32 * k2 + 8 * g4); a = __builtin_amdgcn_mfma_f32_16x16x32_bf16(kf, qf[k2], a, 0, 0, 0); }
                    if (!isc) {
#pragma unroll
                        for (int rg = 0; rg < 4; ++rg) { const int dd = qpos - (kp0 + 16 * mt + 4 * g4 + rg); if (dd > 128 || dd < -128) a[rg] = -1e30f; }
                    }
#pragma unroll
                    for (int rg = 0; rg < 4; ++rg) mloc = fmaxf(mloc, a[rg]);
                    st[mt] = a;
                    __builtin_amdgcn_sched_barrier(0);
                }
                mloc = fmaxf(mloc, __shfl_xor(mloc, 16, 64)); mloc = fmaxf(mloc, __shfl_xor(mloc, 32, 64));
                const float mnew = fmaxf(mx, mloc);
                const float sc = __expf(mx - mnew); mx = mnew; l *= sc;
#pragma unroll
                for (int m = 0; m < 4; ++m) O[m] *= sc;
#pragma unroll
                for (int mt = 0; mt < 8; ++mt)
#pragma unroll
                    for (int rg = 0; rg < 4; ++rg) { const float pv = __expf(st[mt][rg] - mnew); st[mt][rg] = pv; l += pv; }
#pragma unroll
                for (int ks = 0; ks < 4; ++ks) {
                    const bf16x8 pfr = pack8(st[2 * ks], st[2 * ks + 1]);
#pragma unroll
                    for (int m = 0; m < 4; ++m) {
                        const bf16_t* vr = Vt + (16 * m + ln) * 136 + 32 * ks + 4 * g4;
                        const bf16x4 v0 = *(const bf16x4*)vr, v1 = *(const bf16x4*)(vr + 16);
                        const bf16x8 vf = __builtin_shufflevector(v0, v1, 0, 1, 2, 3, 4, 5, 6, 7);
                        O[m] = __builtin_amdgcn_mfma_f32_16x16x32_bf16(vf, pfr, O[m], 0, 0, 0);
                    }
                    __builtin_amdgcn_sched_barrier(0);
                }
            }
            l += __shfl_xor(l, 16, 64); l += __shfl_xor(l, 32, 64);
            const float inv = 1.0f / l;
#pragma unroll
            for (int m = 0; m < 4; ++m) {
                uint2 o2; o2.x = pg8::cvt_pk_bf16(O[m][0] * inv, O[m][1] * inv); o2.y = pg8::cvt_pk_bf16(O[m][2] * inv, O[m][3] * inv);
                *(uint2*)(MIX + (size_t)(t0 + i) * D + h * 64 + 16 * m + 4 * g4) = o2;
            }
        }
    }
    __syncthreads();
}

__device__ __forceinline__ void h2_shortconv(const KQ p, int o, int M, unsigned char* smem) {
    const int tid = ltid();
    const bf16_t* ZH = (const bf16_t*)(p.ws + WS_BIG);
    const float* w = pin_ld(17) + (size_t)o * 3 * HYW; const float* bs = pin_ld(18) + (size_t)o * HYW;
    bf16_t* VXT = (bf16_t*)(p.ws + WS_Y); bf16_t* X0T = VXT + (size_t)D * TL;
    bf16_t* tx = (bf16_t*)smem;
    bf16_t* tv = tx + 64 * 72;
    const int tok = tid >> 3, cg8 = (tid & 7) * 8;
    for (int it = blockIdx.x; it < (TL / 64) * 16; it += gridDim.x) {
        const int c0 = (it & 15) * 64, t0 = (it >> 4) * 64;
        const int t = t0 + tok; const int pos = t & (SEQ - 1); const bool first = pos == 0, last = pos == SEQ - 1;
        float zz[3][8];
#pragma unroll
        for (int k = 0; k < 3; ++k) {
            const int c = k * 1024 + c0 + cg8;
            const bf16x8 zc = *(const bf16x8*)(ZH + (size_t)t * HYW + c);
            bf16x8 zp = zc, zn = zc;
            if (!first) zp = *(const bf16x8*)(ZH + (size_t)(t - 1) * HYW + c);
            if (!last) zn = *(const bf16x8*)(ZH + (size_t)(t + 1) * HYW + c);
#pragma unroll
            for (int j = 0; j < 8; ++j) {
                float sacc = bs[c + j] + bf2f((bf16_t)zc[j]) * w[HYW + c + j];
                if (!first) sacc += bf2f((bf16_t)zp[j]) * w[c + j];
                if (!last) sacc += bf2f((bf16_t)zn[j]) * w[2 * HYW + c + j];
                zz[k][j] = sacc;
            }
        }
        __syncthreads();
#pragma unroll
        for (int j = 0; j < 8; ++j) { tx[(cg8 + j) * 72 + tok] = f2bf(zz[0][j]); tv[(cg8 + j) * 72 + tok] = f2bf(zz[2][j] * zz[1][j]); }
        __syncthreads();
        { const int ch = tid >> 3, tk = (tid & 7) * 8;
          *(u32x4*)(X0T + (size_t)(c0 + ch) * TL + t0 + tk) = *(const u32x4*)(tx + ch * 72 + tk);
          *(u32x4*)(VXT + (size_t)(c0 + ch) * TL + t0 + tk) = *(const u32x4*)(tv + ch * 72 + tk); }
    }
    __syncthreads();
    if (M > TL) {
        float* VX = (float*)(p.ws + WS_Y); bf16_t* X0 = (bf16_t*)(p.ws + WS_H);
        for (int idx = TL * D + blockIdx.x * 512 + tid; idx < M * D; idx += gridDim.x * 512) {
            const int t = idx >> 10, d = idx & 1023;
            const int pos = (t - TL) & (CL - 1); const bool first = pos == 0, last = pos == CL - 1;
            float zz[3];
#pragma unroll
            for (int k = 0; k < 3; ++k) {
                const int c = k * 1024 + d;
                float sacc = bs[c] + bf2f(ZH[(size_t)t * HYW + c]) * w[HYW + c];
                if (!first) sacc += bf2f(ZH[(size_t)(t - 1) * HYW + c]) * w[c];
                if (!last) sacc += bf2f(ZH[(size_t)(t + 1) * HYW + c]) * w[2 * HYW + c];
                zz[k] = sacc;
            }
            VX[idx] = zz[2] * zz[1]; X0[idx] = f2bf(zz[0]);
        }
    }
}

typedef float f32x16 __attribute__((ext_vector_type(16)));
__device__ __forceinline__ void h3_longconv(const KQ p, int o, bool ctx_full, unsigned char* smem) {
    const int tid = ltid(), w = tid >> 6, lane = tid & 63;
    const float* bias = pin_ld(27) + (size_t)o * D;
    {
        const bf16_t* VXT = (const bf16_t*)(p.ws + WS_Y); const bf16_t* X0T = VXT + (size_t)D * TL;
        bf16_t* HMT = (bf16_t*)(p.ws + WS_H);
        const bf16_t* RKT = (const bf16_t*)(p.ws + WS_KF + (size_t)o * SZ_KF);
        constexpr int RK2_OFF = 16384 + 64, U_OFF = 2 * 16384 + 128, CH_BYTES = U_OFF + 142 * 256;
        const int cw = w >> 2, w4 = w & 3;
        const int ct = tid & 255;
        unsigned char* cb = smem + cw * CH_BYTES;
        unsigned char* ub = cb + U_OFF;
        const int r = lane & 31, hh = lane >> 5;
        for (int pr = blockIdx.x; pr < D / 2; pr += gridDim.x) {
            const int d = pr * 2 + cw;
            __syncthreads();
            { const bf16_t* src = RKT + (size_t)d * 8192;
              for (int i = ct; i < 1024; i += 256) *(u32x4*)(cb + i * 16) = *(const u32x4*)(src + i * 8);
              for (int i = ct; i < 2 * 7 * 4 * 4; i += 256) { const int side = i / 112, rem = i % 112; *(u32x4*)(ub + (side ? (135 * 4 * 64) : 0) + rem * 16) = (u32x4){0u, 0u, 0u, 0u}; }
              for (int i = ct; i < 4 * 512; i += 256) { const int b = i >> 9, pc = i & 511;
                  const u32x4 v = *(const u32x4*)(VXT + (size_t)d * TL + b * SEQ + pc * 8);
                  const int col = ((pc >> 2) + 7) * 4 + b, q = pc & 3;
                  *(u32x4*)(ub + col * 64 + ((q ^ ((col >> 2) & 3)) * 16)) = v; } }
            __syncthreads();
            { const bf16_t* rk = (const bf16_t*)cb; bf16_t* rk2 = (bf16_t*)(cb + RK2_OFF);
              for (int i = ct; i < 4096; i += 256) { const unsigned lo = rk[2 * i + 1]; const unsigned hi = (2 * i + 2 < 8192) ? rk[2 * i + 2] : 0u; *(unsigned*)(rk2 + 2 * i) = lo | (hi << 16); } }
            __syncthreads();
            f32x16 acc[4];
#pragma unroll
            for (int j = 0; j < 4; ++j)
#pragma unroll
                for (int q = 0; q < 16; ++q) acc[j][q] = 0.f;
            const bf16_t* rsel = (const bf16_t*)(cb + ((r & 1) ? 0 : RK2_OFF));
            const int adj = (r & 1) ? 0 : -1;
            const int bq = r & 3;
#define H3_LOAD(AF, BF, DL) do { const int dl_ = (DL); \
                _Pragma("unroll") for (int s2 = 0; s2 < 2; ++s2) { \
                    const int e0 = 4095 - 32 * dl_ - r + 16 * s2 + 8 * hh + adj; \
                    const unsigned* ap = (const unsigned*)(rsel + e0); \
                    u32x4 t4; t4.x = ap[0]; t4.y = ap[1]; t4.z = ap[2]; t4.w = ap[3]; \
                    AF[s2] = __builtin_bit_cast(bf16x8, t4); } \
                _Pragma("unroll") for (int j = 0; j < 4; ++j) { \
                    int ch = 8 * (4 * w4 + j) + (r >> 2) - dl_; ch = ch < -1 ? -1 : (ch > 128 ? 128 : ch); \
                    const int col = (ch + 7) * 4 + bq; const int sw = (col >> 2) & 3; \
                    const unsigned char* bp = ub + col * 64; \
                    BF[j][0] = *(const bf16x8*)(bp + ((hh ^ sw) * 16)); BF[j][1] = *(const bf16x8*)(bp + (((2 + hh) ^ sw) * 16)); } } while (0)
#define H3_MMA(AF, BF) do { \
                _Pragma("unroll") for (int s2 = 0; s2 < 2; ++s2) \
                _Pragma("unroll") for (int j = 0; j < 4; ++j) acc[j] = __builtin_amdgcn_mfma_f32_32x32x16_bf16(AF[s2], BF[j][s2], acc[j], 0, 0, 0); } while (0)
            {
                const int dlo = 32 * w4 - 127, dhi = 32 * w4 + 31;
                bf16x8 afA[2], bfA[4][2], afB[2], bfB[4][2];
                H3_LOAD(afA, bfA, dlo);
                for (int dl = dlo; dl < dhi; dl += 2) {
                    H3_LOAD(afB, bfB, dl + 1);
                    __builtin_amdgcn_sched_barrier(0);
                    H3_MMA(afA, bfA);
                    __builtin_amdgcn_sched_barrier(0);
                    H3_LOAD(afA, bfA, dl + 2);
                    __builtin_amdgcn_sched_barrier(0);
                    H3_MMA(afB, bfB);
                    __builtin_amdgcn_sched_barrier(0);
                }
                H3_MMA(afA, bfA);
            }
#undef H3_LOAD
#undef H3_MMA
            __syncthreads();
            const float bd = bias[d];
#pragma unroll
            for (int j = 0; j < 4; ++j) {
                const int n1 = 8 * (4 * w4 + j) + (r >> 2);
                const int col = (n1 + 7) * 4 + bq; const int sw = (col >> 2) & 3;
                bf16_t* up = (bf16_t*)(ub + col * 64);
#pragma unroll
                for (int q4 = 0; q4 < 4; ++q4) {
                    bf16_t* pp = up + ((q4 ^ sw) * 8) + 4 * hh;
                    const bf16x4 uv = *(const bf16x4*)pp;
                    uint2 o2; o2.x = pg8::cvt_pk_bf16(acc[j][4 * q4] + bd * bf2f((bf16_t)uv[0]), acc[j][4 * q4 + 1] + bd * bf2f((bf16_t)uv[1]));
                    o2.y = pg8::cvt_pk_bf16(acc[j][4 * q4 + 2] + bd * bf2f((bf16_t)uv[2]), acc[j][4 * q4 + 3] + bd * bf2f((bf16_t)uv[3]));
                    *(uint2*)pp = o2;
                }
            }
            __syncthreads();
            for (int i = ct; i < 4 * 512; i += 256) { const int b = i >> 9, pc = i & 511;
                const int col = ((pc >> 2) + 7) * 4 + b, q = pc & 3;
                const bf16x8 yv = *(const bf16x8*)(ub + col * 64 + ((q ^ ((col >> 2) & 3)) * 16));
                const size_t gi = (size_t)d * TL + b * SEQ + pc * 8;
                const bf16x8 xv = *(const bf16x8*)(X0T + gi);
                u32x4 o4;
                o4.x = pg8::cvt_pk_bf16(bf2f((bf16_t)yv[0]) * bf2f((bf16_t)xv[0]), bf2f((bf16_t)yv[1]) * bf2f((bf16_t)xv[1]));
                o4.y = pg8::cvt_pk_bf16(bf2f((bf16_t)yv[2]) * bf2f((bf16_t)xv[2]), bf2f((bf16_t)yv[3]) * bf2f((bf16_t)xv[3]));
                o4.z = pg8::cvt_pk_bf16(bf2f((bf16_t)yv[4]) * bf2f((bf16_t)xv[4]), bf2f((bf16_t)yv[5]) * bf2f((bf16_t)xv[5]));
                o4.w = pg8::cvt_pk_bf16(bf2f((bf16_t)yv[6]) * bf2f((bf16_t)xv[6]), bf2f((bf16_t)yv[7]) * bf2f((bf16_t)xv[7]));
                *(u32x4*)(HMT + gi) = o4; }
        }
        __syncthreads();
    }
    if (ctx_full) {
        const float* VX = (const float*)(p.ws + WS_Y); const bf16_t* X0 = (const bf16_t*)(p.ws + WS_H);
        bf16_t* MIX = (bf16_t*)(p.ws + WS_MIX);
        const float* kf = (const float*)(p.ws + WS_KF + (size_t)o * SZ_KF) + (size_t)2 * SEQ * D;
        for (int idx = blockIdx.x * 512 + tid; idx < (TC / 8) * D; idx += gridDim.x * 512) {
            const int d = idx & 1023, og = idx >> 10;
            const int bb = og >> 5, n0 = (og & 31) * 8, tb = TL + bb * CL;
            const float* up = VX + (size_t)tb * D + d;
            float acc[8];
#pragma unroll
            for (int j = 0; j < 8; ++j) acc[j] = 0.f;
#pragma unroll 1
            for (int mb = 0; mb < CL; mb += 8) {
                float kk[15], uu[8];
#pragma unroll
                for (int q = 0; q < 15; ++q) { const int lag = n0 - mb - 7 + q;
                    kk[q] = (lag >= 0) ? ((lag < CL) ? kf[(size_t)lag * D + d] : 0.f) : ((-lag < CL) ? kf[(size_t)(CL - lag) * D + d] : 0.f); }
#pragma unroll
                for (int u = 0; u < 8; ++u) uu[u] = up[(size_t)(mb + u) * D];
#pragma unroll
                for (int u = 0; u < 8; ++u)
#pragma unroll
                    for (int j = 0; j < 8; ++j) acc[j] += uu[u] * kk[7 - u + j];
            }
            const float bd = bias[d];
#pragma unroll
            for (int j = 0; j < 8; ++j) { const size_t ti = (size_t)(tb + n0 + j) * D + d; MIX[ti] = f2bf(bf2f(X0[ti]) * (acc[j] + bd * VX[ti])); }
        }
    }
}

__device__ __forceinline__ void h3b_transpose(const KQ p, unsigned char* smem) {
    const int tid = ltid();
    const bf16_t* HMT = (const bf16_t*)(p.ws + WS_H); bf16_t* MIX = (bf16_t*)(p.ws + WS_MIX);
    bf16_t* tile = (bf16_t*)smem;
    for (int it = blockIdx.x; it < (TL / 64) * 16; it += gridDim.x) {
        const int c0 = (it & 15) * 64, t0 = (it >> 4) * 64;
        __syncthreads();
        { const int ch = tid >> 3, tk = (tid & 7) * 8; *(u32x4*)(tile + ch * 72 + tk) = *(const u32x4*)(HMT + (size_t)(c0 + ch) * TL + t0 + tk); }
        __syncthreads();
        { const int tok = tid >> 3, cg8 = (tid & 7) * 8; unsigned short v[8];
#pragma unroll
          for (int j = 0; j < 8; ++j) v[j] = tile[(cg8 + j) * 72 + tok];
          u32x4 o4; o4.x = v[0] | ((unsigned)v[1] << 16); o4.y = v[2] | ((unsigned)v[3] << 16); o4.z = v[4] | ((unsigned)v[5] << 16); o4.w = v[6] | ((unsigned)v[7] << 16);
          *(u32x4*)(MIX + (size_t)(t0 + tok) * D + c0 + cg8) = o4; }
    }
    __syncthreads();
}

__global__ void __launch_bounds__(512, 2) mega_fwd(KP kp) {
    unsigned char* const smem = g_smem;
    if (threadIdx.x < 29) *(LAS unsigned long long*)((LAS unsigned char*)g_smem + PTAB_OFF + 8 * threadIdx.x) = ((const unsigned long long*)__builtin_amdgcn_kernarg_segment_ptr())[threadIdx.x];
    KQ p; p.out = kp.out; p.ws = kp.ws;
    cg::grid_group grid = cg::this_grid();
    if (threadIdx.x < 4) ((volatile LAS unsigned*)(LAS unsigned char*)smem)[(LDS_BYTES - 16) / 4 + threadIdx.x] = 0u;
    __syncthreads();
    if (threadIdx.x == 0) (void)xb_add(&((unsigned*)(p.ws + WS_BAR))[XB_XCNT(xb_xcc_id())], 1u);
    grid.sync();
    float* smf = (float*)smem;
    bf16_t* Hb = (bf16_t*)(p.ws + WS_H); bf16_t* BIG = (bf16_t*)(p.ws + WS_BIG); float* Y = (float*)(p.ws + WS_Y); bf16_t* MIX = (bf16_t*)(p.ws + WS_MIX);

#ifndef NO_P0
    p0_setup(p, smf);
#endif
    GRID_BAR();
    rowphase(p, 0, nullptr, 0, 0, 0.f, nullptr, T, 0, pin_ld(6), 0, 1, Hb);
    GRID_BAR();
    for (int l = 0; l < 4; ++l) {
        const bool ctx_live = l <= 2, ctx_full = l < 2;
        const int Mff = ctx_live ? T : TL, Mpost = ctx_full ? T : TL;
        for (int sub = 0; sub < 3; ++sub) {
            if (sub != 1) {
                const int fi = sub >> 1; const int M = (sub == 0) ? Mff : Mpost;
                { pg8::EpiSwiGLU E{BIG, DFF}; run_gemm(smem, Hb, (const bf16_t*)(p.ws + WS_WGU + (size_t)(l * 2 + fi) * SZ_WGU), M, 2 * DFF, D, E); }
                GRID_BAR();
                run_gemm_f32_split(smem, BIG, (const bf16_t*)(p.ws + WS_WD + (size_t)(l * 2 + fi) * SZ_WD), M, DFF, Y, (float*)(p.ws + WS_YP));
                GRID_BAR();
                if (sub == 0) rowphase(p, M, Y, l, 2, 0.5f, pin_ld(7) + (size_t)(l * 3 + 0) * D, Mff, l, pin_ld(6) + (size_t)(l * 3 + 1) * D, 3, 4, Hb);
                else {
                    const int ln = l + 1; const int Mn = (ln < 4) ? ((ln <= 2) ? T : TL) : 0;
                    rowphase(p, M, Y, l, 8, 0.5f, pin_ld(7) + (size_t)(l * 3 + 2) * D, Mn, ln < 4 ? ln : l, pin_ld(6) + (size_t)((ln < 4 ? ln : l) * 3 + 0) * D, 0, 1, ln < 4 ? Hb : nullptr);
                }
                GRID_BAR();
            } else {
                if ((l & 1) == 0) {
                    const int e = l >> 1;
                    { pg8::EpiBf16 E{BIG, INW, nullptr}; run_gemm(smem, Hb, (const bf16_t*)(p.ws + WS_WIN + (size_t)e * SZ_WIN), Mff, INW, D, E); }
                    GRID_BAR();
#ifndef NO_M1
                    m1_rope_states(p, e, smf);
#endif
                    GRID_BAR();
#ifndef NO_M2
                    m2_scan(p, e);
#endif
                    GRID_BAR();
#ifndef NO_M3
                    m3_outputs(p, e, ctx_full, smem);
#endif
                    GRID_BAR();
                    run_gemm_f32_split(smem, MIX, (const bf16_t*)(p.ws + WS_WOUT + (size_t)e * SZ_WOUT), Mpost, D, Y, (float*)(p.ws + WS_YP));
                    GRID_BAR();
                } else {
                    const int o = l >> 1;
                    { pg8::EpiBf16 E{BIG, HYW, pin_ld(16) + (size_t)o * HYW}; run_gemm(smem, Hb, (const bf16_t*)(p.ws + WS_HWIN + (size_t)o * SZ_HWIN), Mpost, HYW, D, E); }
                    GRID_BAR();
#ifndef NO_H2
                    h2_shortconv(p, o, Mpost, smem);
#endif
                    GRID_BAR();
#ifndef NO_H3
                    h3_longconv(p, o, ctx_full, smem);
#endif
                    GRID_BAR();
                    h3b_transpose(p, smem);
                    GRID_BAR();
                    run_gemm_f32_split(smem, MIX, (const bf16_t*)(p.ws + WS_HWOUT + (size_t)o * SZ_WOUT), Mpost, D, Y, (float*)(p.ws + WS_YP));
                    GRID_BAR();
                }
                rowphase(p, Mpost, Y, l, 5, 1.0f, pin_ld(7) + (size_t)(l * 3 + 1) * D, Mpost, l, pin_ld(6) + (size_t)(l * 3 + 2) * D, 6, 7, Hb);
                GRID_BAR();
            }
        }
    }
}

extern "C" void kernel_launch(void* const* d_in, const int* in_sizes, int n_in, void* d_out, int out_size, void* d_ws, size_t ws_size, hipStream_t stream) {
    static int grid = 0;
    if (grid == 0) {
        if (n_in != 29 || out_size != TL * D || ws_size < WS_END) { fprintf(stderr, "kernel_launch: unexpected shapes: n_in %d out %d ws %zu (need %zu)\n", n_in, out_size, ws_size, (size_t)WS_END); grid = -1; return; }
        int dev = 0, cus = 0, per_cu = 0;
        (void)hipGetDevice(&dev);
        (void)hipDeviceGetAttribute(&cus, hipDeviceAttributeMultiprocessorCount, dev);
        if (hipFuncSetAttribute((const void*)mega_fwd, hipFuncAttributeMaxDynamicSharedMemorySize, LDS_BYTES) != hipSuccess) { fprintf(stderr, "kernel_launch: hipFuncSetAttribute failed\n"); grid = -1; return; }
        if (hipOccupancyMaxActiveBlocksPerMultiprocessor(&per_cu, (const void*)mega_fwd, 512, LDS_BYTES) != hipSuccess || per_cu < 1) { fprintf(stderr, "kernel_launch: occupancy query says %d\n", per_cu); per_cu = 1; }
        (void)hipGetLastError();
        grid = cus;
    }
    if (grid < 0) return;
    (void)hipMemsetAsync((unsigned char*)d_ws + WS_BAR, 0, 16384, stream);
    KP kp{};
    for (int i = 0; i < 29; ++i) kp.in[i] = (const float*)d_in[i];
    kp.out = (float*)d_out; kp.ws = (unsigned char*)d_ws;
    void* args[] = {&kp};
    hipError_t e = hipLaunchCooperativeKernel((const void*)mega_fwd, dim3(grid), dim3(512), args, LDS_BYTES, stream);
    if (e != hipSuccess) fprintf(stderr, "cooperative launch failed: %s (grid %d)\n", hipGetErrorString(e), grid);
}
```

```cpp
#include <hip/hip_runtime.h>
#include <hip/hip_cooperative_groups.h>
#include <cstdio>
namespace cg = cooperative_groups;

#define LAS __attribute__((address_space(3)))
typedef unsigned short bf16_t;
typedef short bf16x8 __attribute__((ext_vector_type(8)));
typedef short bf16x4 __attribute__((ext_vector_type(4)));
typedef float f32x4 __attribute__((ext_vector_type(4)));
typedef unsigned u32x4 __attribute__((ext_vector_type(4)));

constexpr int D = 1024, NB = 4, SEQ = 4096, CL = 256, TL = NB * SEQ, TC = NB * CL, T = TL + TC, DFF = 2816, INW = 2816, HYW = 3072;
constexpr int NMOD = 9;
constexpr float EPS = 1e-6f;
constexpr int NCH = 34;
constexpr int LDS_BYTES = 144 * 1024;

constexpr size_t SZ_WGU = (size_t)2 * DFF * D * 2, SZ_WD = (size_t)D * DFF * 2, SZ_WIN = (size_t)INW * D * 2, SZ_WOUT = (size_t)D * D * 2, SZ_HWIN = (size_t)HYW * D * 2;
constexpr size_t WS_WGU = 0;
constexpr size_t WS_WD = WS_WGU + 8 * SZ_WGU;
constexpr size_t WS_WIN = WS_WD + 8 * SZ_WD;
constexpr size_t WS_WOUT = WS_WIN + 2 * SZ_WIN;
constexpr size_t WS_HWIN = WS_WOUT + 2 * SZ_WOUT;
constexpr size_t WS_HWOUT = WS_HWIN + 2 * SZ_HWIN;
constexpr size_t WS_MOD = WS_HWOUT + 2 * SZ_WOUT;
constexpr size_t WS_ROPE = WS_MOD + (size_t)4 * 5 * NMOD * D * 4;
constexpr size_t WS_XC = WS_ROPE + (size_t)4 * SEQ * 32 * 4;
constexpr size_t WS_H = WS_XC + (size_t)TC * D * 4;
constexpr size_t WS_BIG = WS_H + (size_t)T * D * 2;
constexpr size_t WS_Y = WS_BIG + (size_t)T * HYW * 2;
constexpr size_t WS_MIX = WS_Y + (size_t)T * D * 4;
constexpr size_t SZ_ST = (size_t)NB * NCH * 8 * 4096 * 4;
constexpr size_t WS_ST = WS_MIX + (size_t)T * D * 2;
constexpr size_t SZ_KF = (size_t)(SEQ + CL) * 2 * D * 4;
constexpr size_t WS_KF = WS_ST + 4 * SZ_ST;
constexpr size_t WS_YP = WS_KF + 2 * SZ_KF;
constexpr size_t WS_BAR = WS_YP + (size_t)4 * TC * D * 4;
constexpr size_t WS_END = WS_BAR + 16384;

struct KP { const float* in[29]; float* out; unsigned char* ws; };
extern __shared__ __attribute__((aligned(16))) unsigned char g_smem[];
constexpr int PTAB_OFF = LDS_BYTES - 512;
__device__ __forceinline__ const float* pin_ld(int k) {
    const unsigned long long v = *(volatile LAS unsigned long long*)((LAS unsigned char*)g_smem + PTAB_OFF + 8 * k);
    const unsigned lo = __builtin_amdgcn_readfirstlane((unsigned)v), hi = __builtin_amdgcn_readfirstlane((unsigned)(v >> 32));
    return (const float*)(((unsigned long long)hi << 32) | lo);
}
struct KQ { float* out; unsigned char* ws; };
__device__ __forceinline__ KQ lq(KQ q) { asm volatile("" : "+s"(q.out), "+s"(q.ws)); return q; }

__device__ __forceinline__ bf16_t f2bf(float f) { unsigned u = __float_as_uint(f); u += 0x7FFFu + ((u >> 16) & 1u); return (bf16_t)(u >> 16); }
__device__ __forceinline__ float bf2f(bf16_t b) { return __uint_as_float(((unsigned)b) << 16); }
__device__ __forceinline__ float silu_f(float x) { return x * __builtin_amdgcn_rcpf(1.0f + __expf(-x)); }
__device__ __forceinline__ int ltid() { int t = threadIdx.x; asm volatile("" : "+v"(t)); return t; }
__device__ __forceinline__ float wave_sum(float v) {
#pragma unroll
    for (int o = 32; o > 0; o >>= 1) v += __shfl_xor(v, o, 64);
    return v;
}


#define XB_TMO      128
#define XB_XCNT(j)  (256  + 64 * (j))
#define XB_XSUB(j)  (1280 + 64 * (j))
#define XB_XGEN(j)  (2304 + 64 * (j))
#define XB_TOP      3328
#define XB_TOPGEN   3392
#define XCD_BAR_WORDS 3456
#define XB_SPIN_CAP (1u << 18)
__device__ __forceinline__ unsigned xb_ld(unsigned* p)              { return __hip_atomic_load(p, __ATOMIC_RELAXED, __HIP_MEMORY_SCOPE_AGENT); }
__device__ __forceinline__ unsigned xb_add(unsigned* p, unsigned v) { return __hip_atomic_fetch_add(p, v, __ATOMIC_RELAXED, __HIP_MEMORY_SCOPE_AGENT); }
__device__ __forceinline__ unsigned xb_xcc_id() { return (unsigned)__builtin_amdgcn_s_getreg((3 << 11) | 20) & 0xFu; }
#define XB_SPIN(cond, bar) do { unsigned _sp = 0; while (cond) { __builtin_amdgcn_s_sleep(1); \
    if ((++_sp & 255u) == 0u) { if (xb_ld(&(bar)[XB_TMO])) break; if (_sp > XB_SPIN_CAP) { atomicAdd(&(bar)[XB_TMO], 1u); break; } } } } while (0)
struct XcdBarrier { unsigned* bar; unsigned x; volatile LAS unsigned* st; };
__device__ __forceinline__ XcdBarrier xcd_barrier_post(unsigned* bar, volatile LAS unsigned* st) {
    XcdBarrier b; b.bar = bar; b.x = xb_xcc_id(); b.st = st;
    if (threadIdx.x == 0) (void)xb_add(&bar[XB_XCNT(b.x)], 1u);
    return b;
}
__device__ __forceinline__ void xcd_barrier_complete(unsigned* bar, unsigned x, unsigned& nloc, unsigned& nx) {
    const unsigned G = gridDim.x * gridDim.y * gridDim.z;
    unsigned sum, cnt, mine, sp = 0u;
    for (;;) {
        sum = 0u; cnt = 0u; mine = 0u;
#pragma unroll
        for (unsigned j = 0; j < 16; ++j) { const unsigned c = xb_ld(&bar[XB_XCNT(j)]); sum += c; cnt += (c > 0u) ? 1u : 0u; mine = (j == x) ? c : mine; }
        if (sum == G) break;
        __builtin_amdgcn_s_sleep(1);
        if ((++sp & 255u) == 0u) { if (xb_ld(&bar[XB_TMO])) break; if (sp > XB_SPIN_CAP) { atomicAdd(&bar[XB_TMO], 1u); break; } }
    }
    nloc = mine > 0u ? mine : 1u; nx = cnt > 0u ? cnt : 1u;
}
__device__ __forceinline__ void xcd_barrier_impl(unsigned* bar, volatile LAS unsigned* st) {
    asm volatile("s_waitcnt vmcnt(0)" ::: "memory");
    __syncthreads();
    if (ltid() == 0) {
        const unsigned x = xb_xcc_id();
        __builtin_amdgcn_s_waitcnt(0);
        unsigned nloc = st[0], nx = st[1];
        if (nloc == 0u) { xcd_barrier_complete(bar, x, nloc, nx); st[0] = nloc; st[1] = nx; }
        const unsigned old = xb_add(&bar[XB_XSUB(x)], 1u);
        const unsigned gen = old / nloc;
        if (old + 1u == (gen + 1u) * nloc) {
            __builtin_amdgcn_fence(__ATOMIC_RELEASE, "agent");
            asm volatile("s_waitcnt vmcnt(0)" ::: "memory");
            const unsigned og = xb_add(&bar[XB_TOP], 1u);
            const unsigned tg = og / nx;
            if (og + 1u == (tg + 1u) * nx) xb_add(&bar[XB_TOPGEN], 1u);
            else XB_SPIN(xb_ld(&bar[XB_TOPGEN]) == tg, bar);
            __builtin_amdgcn_fence(__ATOMIC_ACQUIRE, "agent");
            xb_add(&bar[XB_XGEN(x)], 1u);
            asm volatile("s_waitcnt vmcnt(0)" ::: "memory");
        } else {
            XB_SPIN(xb_ld(&bar[XB_XGEN(x)]) == gen, bar);
            __builtin_amdgcn_fence(__ATOMIC_ACQUIRE, "agent");
            asm volatile("s_waitcnt vmcnt(0)" ::: "memory");
        }
    }
    __syncthreads();
}
#define GRID_BAR() xcd_barrier_impl((unsigned*)(p.ws + WS_BAR), (volatile LAS unsigned*)((LAS unsigned char*)smem + LDS_BYTES - 16))

namespace pg8 {
constexpr int BM = 256, BK = 64, HALF = 128, HTB = HALF * BK * 2, STAGE_BYTES = 8 * HTB, NXCD = 8, WGM = 8;
__host__ __device__ __forceinline__ int lds_byte(int r, int c) { const int st = (r >> 4) * 2 + (c >> 5), rr = r & 15, cc = c & 31, ob = rr * 64 + cc * 2; return st * 1024 + (ob ^ (((ob >> 9) & 1) << 5)); }
__host__ __device__ __forceinline__ void stage_rc(int b, int& R, int& C) { const int st = b / 1024, sb = b % 1024, swz = sb ^ (((sb >> 9) & 1) << 5); R = (st >> 1) * 16 + swz / 64; C = (st & 1) * 32 + (swz % 64) / 2; }
__host__ __device__ __forceinline__ int perm32(int rho) { const int n = rho >> 4, i = rho & 15; return 8 * (i >> 2) + 4 * n + (i & 3); }
struct Unit { int pm, pn; };
struct Gemm { const bf16_t* A; const bf16_t* Bt; int M, N, K, ld; };
struct StaticOrder {
    int nM, nN, nwg, G, c;
    __device__ void init(int M, int N, int G_, int c_) { nM = M / BM; nN = N / BM; nwg = nM * nN; G = G_; c = c_; }
    __device__ bool next(int i, Unit& u) const {
        const long Lx = (long)i * G + c; if (Lx >= nwg) return false;
        int wgid = (int)Lx; { const int q = nwg / NXCD, r = nwg % NXCD, xcd = wgid % NXCD, off = wgid / NXCD; wgid = (xcd < r ? xcd * (q + 1) : r * (q + 1) + (xcd - r) * q) + off; }
        const int nig = WGM * nN, gid = wgid / nig, fm = gid * WGM, gsz = (nM - fm) < WGM ? (nM - fm) : WGM;
        u.pm = fm + ((wgid % nig) % gsz); u.pn = (wgid % nig) / gsz; return true;
    }
};
__device__ __forceinline__ unsigned cvt_pk_bf16(float lo, float hi) { unsigned r; asm volatile("v_cvt_pk_bf16_f32 %0, %1, %2" : "=v"(r) : "v"(lo), "v"(hi)); return r; }

struct EpiF32 {
    static constexpr bool PERM = false;
    float* C; int ldc;
    __device__ __forceinline__ void operator()(const f32x4 (&acc)[2][2][4][2], const Unit& u, int wr, int wc, int fr, int fq) const {
        const int row0 = u.pm * BM + wr * 64 + fr, col0 = u.pn * BM + wc * 32 + 4 * fq;
#pragma unroll
        for (int ai = 0; ai < 2; ++ai)
#pragma unroll
            for (int m = 0; m < 4; ++m) { float* rowp = C + (size_t)(row0 + ai * HALF + m * 16) * ldc + col0;
#pragma unroll
                for (int bj = 0; bj < 2; ++bj)
#pragma unroll
                    for (int n = 0; n < 2; ++n) *(f32x4*)(rowp + bj * HALF + n * 16) = acc[ai][bj][m][n]; }
    }
};
struct EpiBf16 {
    static constexpr bool PERM = true;
    bf16_t* O; int ldc; const float* bias;
    __device__ __forceinline__ void operator()(const f32x4 (&acc)[2][2][4][2], const Unit& u, int wr, int wc, int fr, int fq) const {
        const int row0 = u.pm * BM + wr * 64 + fr; const int col0 = u.pn * BM + wc * 32 + 8 * fq;
        f32x4 bv[2][2];
#pragma unroll
        for (int bj = 0; bj < 2; ++bj)
#pragma unroll
            for (int n = 0; n < 2; ++n) bv[bj][n] = bias ? *(const f32x4*)(bias + col0 + bj * HALF + 4 * n) : (f32x4){0.f, 0.f, 0.f, 0.f};
#pragma unroll
        for (int ai = 0; ai < 2; ++ai)
#pragma unroll
            for (int m = 0; m < 4; ++m) { bf16_t* rowp = O + (size_t)(row0 + ai * HALF + m * 16) * ldc + col0;
#pragma unroll
                for (int bj = 0; bj < 2; ++bj) { f32x4 v0 = acc[ai][bj][m][0] + bv[bj][0], v1 = acc[ai][bj][m][1] + bv[bj][1];
                    u32x4 w; w.x = cvt_pk_bf16(v0[0], v0[1]); w.y = cvt_pk_bf16(v0[2], v0[3]); w.z = cvt_pk_bf16(v1[0], v1[1]); w.w = cvt_pk_bf16(v1[2], v1[3]);
                    *(u32x4*)(rowp + bj * HALF) = w; } }
    }
};
struct EpiSwiGLU {
    static constexpr bool PERM = true;
    bf16_t* O; int ldc;
    __device__ __forceinline__ void operator()(const f32x4 (&acc)[2][2][4][2], const Unit& u, int wr, int wc, int fr, int fq) const {
        const int row0 = u.pm * BM + wr * 64 + fr; const int col0 = u.pn * HALF + wc * 32 + 8 * fq;
#pragma unroll
        for (int ai = 0; ai < 2; ++ai)
#pragma unroll
            for (int m = 0; m < 4; ++m) { bf16_t* rowp = O + (size_t)(row0 + ai * HALF + m * 16) * ldc + col0;
                float v[8];
#pragma unroll
                for (int n = 0; n < 2; ++n)
#pragma unroll
                    for (int j = 0; j < 4; ++j) { const float g = acc[ai][0][m][n][j], up = acc[ai][1][m][n][j]; v[n * 4 + j] = silu_f(g) * up; }
                u32x4 w; w.x = cvt_pk_bf16(v[0], v[1]); w.y = cvt_pk_bf16(v[2], v[3]); w.z = cvt_pk_bf16(v[4], v[5]); w.w = cvt_pk_bf16(v[6], v[7]);
                *(u32x4*)rowp = w; }
    }
};

template <class Epi, class Sched>
__device__ __forceinline__ void gemm_phase(LAS unsigned char* lds, const Gemm g, const Sched& S, const Epi& E) {
    const int tid = ltid(), wid = __builtin_amdgcn_readfirstlane(tid >> 6), lane = tid & 63, wr = wid >> 2, wc = wid & 3, fr = lane & 15, fq = lane >> 4;
    const int K = g.ld, nt = g.K / BK;
    unsigned voffA[2], voffB[2];
#pragma unroll
    for (int i = 0; i < 2; ++i) { int R, C; stage_rc(tid * 16 + i * 8192, R, C); const int Rb = Epi::PERM ? ((R & ~31) + perm32(R & 31)) : R;
        voffA[i] = (unsigned)(R * K + C) * 2u; voffB[i] = (unsigned)(Rb * K + C) * 2u; }
    const size_t kstep = (size_t)(BK * 2);
    const size_t hstep = (size_t)HALF * K * 2;
    const size_t tstep = 2 * hstep;
    const unsigned ldsw = (unsigned)wid * 1024u;
    const int aoff = lds_byte(wr * 64 + fr, fq * 8), boff = lds_byte(wc * 32 + fr, fq * 8);
#define PG8_SA(b, h) (((b) * 2 + (h)) * HTB)
#define PG8_SB(b, h) ((4 + (b) * 2 + (h)) * HTB)
#define PG8_STAGE(bufoff, gbase, voff) do { _Pragma("unroll") for (int _i = 0; _i < 2; ++_i) \
        __builtin_amdgcn_global_load_lds((const unsigned*)((const char*)(gbase) + (voff)[_i]), (LAS unsigned*)(lds + (bufoff) + ldsw + _i * 8192), 16, 0, 0); } while (0)
#define PG8_LDA(dst, b, h) do { _Pragma("unroll") for (int m = 0; m < 4; ++m) _Pragma("unroll") for (int k = 0; k < 2; ++k) dst[m][k] = *(const LAS bf16x8*)(lds + PG8_SA(b, h) + aoff + m * 2048 + k * 1024); } while (0)
#define PG8_LDB(dst, b, h) do { _Pragma("unroll") for (int n = 0; n < 2; ++n) _Pragma("unroll") for (int k = 0; k < 2; ++k) dst[n][k] = *(const LAS bf16x8*)(lds + PG8_SB(b, h) + boff + n * 2048 + k * 1024); } while (0)
#define PG8_MMA(ai, bj, At, Bt) do { __builtin_amdgcn_s_setprio(1); _Pragma("unroll") for (int m = 0; m < 4; ++m) _Pragma("unroll") for (int n = 0; n < 2; ++n) _Pragma("unroll") for (int k = 0; k < 2; ++k) \
        acc[ai][bj][m][n] = __builtin_amdgcn_mfma_f32_16x16x32_bf16(Bt[n][k], At[m][k], acc[ai][bj][m][n], 0, 0, 0); __builtin_amdgcn_s_setprio(0); } while (0)
#define PG8_WAIT_V(n) asm volatile("s_waitcnt vmcnt(" #n ")" ::: "memory")
#define PG8_WAIT_L(n) asm volatile("s_waitcnt lgkmcnt(" #n ")" ::: "memory")
#define PG8_BAR __builtin_amdgcn_s_barrier()
#define PG8_SCHED __builtin_amdgcn_sched_barrier(0)
    Unit cur, nxt; int ui = 0;
    if (!S.next(0, cur)) return;
    f32x4 acc[2][2][4][2];
#pragma unroll
    for (int a = 0; a < 2; ++a)
#pragma unroll
        for (int b = 0; b < 2; ++b)
#pragma unroll
            for (int m = 0; m < 4; ++m)
#pragma unroll
                for (int n = 0; n < 2; ++n) acc[a][b][m][n] = (f32x4){0.f, 0.f, 0.f, 0.f};
    bf16x8 At[4][2], B0[2][2], B1[2][2];
    const char* cA = (const char*)g.A + (size_t)cur.pm * tstep; const char* cB = (const char*)g.Bt + (size_t)cur.pn * tstep;
    PG8_STAGE(PG8_SB(0, 0), cB, voffB); PG8_STAGE(PG8_SA(0, 0), cA, voffA); PG8_STAGE(PG8_SB(0, 1), cB + hstep, voffB); PG8_STAGE(PG8_SA(0, 1), cA + hstep, voffA);
    if (wr == 1) PG8_BAR;
    PG8_WAIT_V(4); PG8_BAR;
    PG8_STAGE(PG8_SB(1, 0), cB + kstep, voffB); PG8_STAGE(PG8_SA(1, 0), cA + kstep, voffA); PG8_STAGE(PG8_SB(1, 1), cB + hstep + kstep, voffB);
    PG8_WAIT_V(6); PG8_BAR;
    for (;;) {
        const bool has_next = S.next(ui + 1, nxt);
        const char* nA = has_next ? (const char*)g.A + (size_t)nxt.pm * tstep : cA; const char* nB = has_next ? (const char*)g.Bt + (size_t)nxt.pn * tstep : cB;
        for (int t = 0; t < nt; t += 2) {
            const bool last = (t == nt - 2);
            const char* a1 = cA + (size_t)(t + 1) * kstep;
            const char* a2 = last ? nA : cA + (size_t)(t + 2) * kstep; const char* b2 = last ? nB : cB + (size_t)(t + 2) * kstep;
            const char* a3 = a2 + kstep; const char* b3 = b2 + kstep;
            PG8_LDB(B0, 0, 0); PG8_SCHED; PG8_LDA(At, 0, 0); PG8_STAGE(PG8_SA(1, 1), a1 + hstep, voffA);
            PG8_WAIT_L(8); PG8_BAR; PG8_WAIT_L(0); PG8_MMA(0, 0, At, B0); PG8_BAR; PG8_SCHED;
            PG8_LDB(B1, 0, 1); PG8_STAGE(PG8_SB(0, 0), b2, voffB);
            PG8_BAR; PG8_WAIT_L(0); PG8_MMA(0, 1, At, B1); PG8_BAR;
            PG8_LDA(At, 0, 1); PG8_STAGE(PG8_SA(0, 0), a2, voffA);
            PG8_BAR; PG8_WAIT_L(0); PG8_MMA(1, 0, At, B0); PG8_BAR; PG8_SCHED;
            PG8_STAGE(PG8_SB(0, 1), b2 + hstep, voffB);
            PG8_WAIT_V(6); PG8_BAR; PG8_MMA(1, 1, At, B1); PG8_BAR;
            PG8_LDB(B0, 1, 0); PG8_SCHED; PG8_LDA(At, 1, 0); PG8_STAGE(PG8_SA(0, 1), a2 + hstep, voffA);
            PG8_WAIT_L(8); PG8_BAR; PG8_WAIT_L(0); PG8_MMA(0, 0, At, B0); PG8_BAR; PG8_SCHED;
            PG8_LDB(B1, 1, 1); PG8_STAGE(PG8_SB(1, 0), b3, voffB);
            PG8_BAR; PG8_WAIT_L(0); PG8_MMA(0, 1, At, B1); PG8_BAR;
            PG8_LDA(At, 1, 1); PG8_STAGE(PG8_SA(1, 0), a3, voffA);
            PG8_BAR; PG8_WAIT_L(0); PG8_MMA(1, 0, At, B0); PG8_BAR; PG8_SCHED;
            PG8_STAGE(PG8_SB(1, 1), b3 + hstep, voffB);
            PG8_WAIT_V(6); PG8_BAR; PG8_MMA(1, 1, At, B1); PG8_BAR;
        }
        E(acc, cur, wr, wc, fr, fq);
        if (!has_next) break;
#pragma unroll
        for (int a = 0; a < 2; ++a)
#pragma unroll
            for (int b = 0; b < 2; ++b)
#pragma unroll
                for (int m = 0; m < 4; ++m)
#pragma unroll
                    for (int n = 0; n < 2; ++n) acc[a][b][m][n] = (f32x4){0.f, 0.f, 0.f, 0.f};
        cur = nxt; cA = nA; cB = nB; ++ui;
    }
    PG8_WAIT_V(0);
    if (wr == 0) PG8_BAR;
    PG8_BAR;
#undef PG8_SA
#undef PG8_SB
#undef PG8_STAGE
#undef PG8_LDA
#undef PG8_LDB
#undef PG8_MMA
#undef PG8_WAIT_V
#undef PG8_WAIT_L
#undef PG8_BAR
#undef PG8_SCHED
}
}

template <class Epi>
__device__ __forceinline__ void run_gemm(unsigned char* smem, const bf16_t* A, const bf16_t* Bt, int M, int N, int K, const Epi& E) {
    pg8::Gemm g{A, Bt, M, N, K, K}; pg8::StaticOrder S; S.init(M, N, (int)gridDim.x, (int)blockIdx.x);
    pg8::gemm_phase<Epi, pg8::StaticOrder>((LAS unsigned char*)smem, g, S, E);
}
__device__ __forceinline__ void run_gemm_f32_split(unsigned char* smem, const bf16_t* A, const bf16_t* Bt, int M, int K, bf16_t* Yo, float* YP) {
    { pg8::Gemm g{A, Bt, TL, D, K, K}; pg8::StaticOrder S; S.init(TL, D, (int)gridDim.x, (int)blockIdx.x); pg8::EpiBf16 E{Yo, D, nullptr};
      pg8::gemm_phase<pg8::EpiBf16, pg8::StaticOrder>((LAS unsigned char*)smem, g, S, E); }
    __syncthreads();
    if (M > TL && blockIdx.x < 64) {
        const int ks = blockIdx.x >> 4;
        int koff, klen;
        if (K == DFF) { koff = (ks < 2) ? ks * 768 : 1536 + (ks - 2) * 640; klen = (ks < 2) ? 768 : 640; }
        else { klen = K / 4; koff = ks * klen; }
        pg8::Gemm g{A + (size_t)TL * K + koff, Bt + koff, TC, D, klen, K}; pg8::StaticOrder S; S.init(TC, D, 16, (int)(blockIdx.x & 15)); pg8::EpiF32 E{YP + (size_t)ks * TC * D, D};
        pg8::gemm_phase<pg8::EpiF32, pg8::StaticOrder>((LAS unsigned char*)smem, g, S, E);
        __syncthreads();
    }
}

__device__ __forceinline__ float* xrow(const KQ p, int t) { return t < TL ? p.out + (size_t)t * D : (float*)(p.ws + WS_XC) + (size_t)(t - TL) * D; }
__device__ __forceinline__ int modrow(int t) { return t < TL ? (t >> 12) : 4; }
__device__ __forceinline__ const float* modp(const KQ p, int l, int mr, int idx) { return (const float*)(p.ws + WS_MOD) + ((size_t)(l * 5 + mr) * NMOD + idx) * D; }

__device__ __forceinline__ void p0_setup(const KQ p_in, float* sm) {
    const KQ p = lq(p_in);
    const int tid = ltid(), bid = blockIdx.x, nb = gridDim.x;
    const int gtid = bid * 512 + tid, gthreads = nb * 512;
    {
        float* rope = (float*)(p.ws + WS_ROPE);
        for (int idx = gtid; idx < SEQ * 32; idx += gthreads) {
            const int t = idx >> 5, i = idx & 31;
            const int ii = i & 15; const float pos = (i < 16) ? (float)(t >> 6) : (float)(t & 63);
            const float invA = powf(10000.0f, -(float)ii / 16.0f);
            const float angA = pos * invA;
            rope[idx] = cosf(angA); rope[SEQ * 32 + idx] = sinf(angA);
            const float ex = (float)i * (1.0f / 31.0f);
            const float invR = powf(10000.0f, -ex);
            const float angR = (float)t * invR;
            rope[2 * SEQ * 32 + idx] = cosf(angR); rope[3 * SEQ * 32 + idx] = sinf(angR);
        }
    }
    {
        float* tile = sm;
        for (int g = bid; g < 20864; g += nb) {
            int j, tl;
            if (g < 16896) { j = g / 704; tl = g % 704; }
            else if (g < 18304) { j = 24 + (g - 16896) / 704; tl = (g - 16896) % 704; }
            else if (g < 18816) { j = 26 + (g - 18304) / 256; tl = (g - 18304) % 256; }
            else if (g < 20352) { j = 28 + (g - 18816) / 768; tl = (g - 18816) % 768; }
            else { j = 30 + (g - 20352) / 256; tl = (g - 20352) % 256; }
            const float* src; bf16_t* dst; int K, N, mode = 0;
            if (j < 8) { src = pin_ld(8) + (size_t)j * D * DFF; dst = (bf16_t*)(p.ws + WS_WGU + (size_t)j * SZ_WGU); K = D; N = DFF; mode = 1; }
            else if (j < 16) { src = pin_ld(9) + (size_t)(j - 8) * D * DFF; dst = (bf16_t*)(p.ws + WS_WGU + (size_t)(j - 8) * SZ_WGU); K = D; N = DFF; mode = 2; }
            else if (j < 24) { src = pin_ld(10) + (size_t)(j - 16) * DFF * D; dst = (bf16_t*)(p.ws + WS_WD + (size_t)(j - 16) * SZ_WD); K = DFF; N = D; }
            else if (j < 26) { src = pin_ld(11) + (size_t)(j - 24) * D * INW; dst = (bf16_t*)(p.ws + WS_WIN + (size_t)(j - 24) * SZ_WIN); K = D; N = INW; mode = 3; }
            else if (j < 28) { src = pin_ld(14) + (size_t)(j - 26) * D * D; dst = (bf16_t*)(p.ws + WS_WOUT + (size_t)(j - 26) * SZ_WOUT); K = D; N = D; }
            else if (j < 30) { src = pin_ld(15) + (size_t)(j - 28) * D * HYW; dst = (bf16_t*)(p.ws + WS_HWIN + (size_t)(j - 28) * SZ_HWIN); K = D; N = HYW; }
            else { src = pin_ld(28) + (size_t)(j - 30) * D * D; dst = (bf16_t*)(p.ws + WS_HWOUT + (size_t)(j - 30) * SZ_WOUT); K = D; N = D; }
            const int ntn = N / 64; const int k0 = (tl / ntn) * 64, n0 = (tl % ntn) * 64;
            __syncthreads();
#pragma unroll
            for (int i = 0; i < 2; ++i) { const int k = i * 32 + (tid >> 4), n4 = (tid & 15) * 4; const float4 v = *(const float4*)(src + (size_t)(k0 + k) * N + n0 + n4);
                tile[k * 65 + n4] = v.x; tile[k * 65 + n4 + 1] = v.y; tile[k * 65 + n4 + 2] = v.z; tile[k * 65 + n4 + 3] = v.w; }
            __syncthreads();
            {
                const int n = tid >> 3, k8 = (tid & 7) * 8; const int gn = n0 + n;
                float sc_ = 1.0f; int row = gn;
                if (mode == 1) row = 256 * (gn >> 7) + (gn & 127);
                else if (mode == 2) row = 256 * (gn >> 7) + 128 + (gn & 127);
                else if (mode == 3) { if (gn < 512 || (gn >= 1792 && gn < 2304)) sc_ = 0.125f; }
                float v[8];
#pragma unroll
                for (int j = 0; j < 8; ++j) v[j] = tile[(k8 + j) * 65 + n] * sc_;
                u32x4 o4; o4.x = pg8::cvt_pk_bf16(v[0], v[1]); o4.y = pg8::cvt_pk_bf16(v[2], v[3]); o4.z = pg8::cvt_pk_bf16(v[4], v[5]); o4.w = pg8::cvt_pk_bf16(v[6], v[7]);
                *(u32x4*)(dst + (size_t)row * K + k0 + k8) = o4;
            }
        }
        __syncthreads();
    }
    {
        float* sc = sm;
        float* red = sm + 5 * 1024;
        for (int i = tid; i < 5 * 1024; i += 512) { const int r = i >> 10, k = i & 1023; const float v = (r < 4) ? pin_ld(1)[r * D + k] : pin_ld(3)[k]; sc[i] = silu_f(v); }
        __syncthreads();
        const int w = tid >> 6, lane = tid & 63;
        for (int it = bid; it < 288; it += nb) {
            const int l = it / 72, c0 = (it % 72) * 128;
            const float* wm = pin_ld(4) + (size_t)l * D * (NMOD * D) + c0 + 2 * lane;
            float a[5][2];
#pragma unroll
            for (int r = 0; r < 5; ++r) { a[r][0] = 0.f; a[r][1] = 0.f; }
            for (int k = w * 128; k < w * 128 + 128; ++k) {
                const float2 wv = *(const float2*)(wm + (size_t)k * (NMOD * D));
#pragma unroll
                for (int r = 0; r < 5; ++r) { const float s = sc[r * 1024 + k]; a[r][0] += s * wv.x; a[r][1] += s * wv.y; }
            }
#pragma unroll
            for (int r = 0; r < 5; ++r) { red[(w * 5 + r) * 128 + 2 * lane] = a[r][0]; red[(w * 5 + r) * 128 + 2 * lane + 1] = a[r][1]; }
            __syncthreads();
            for (int i = tid; i < 5 * 128; i += 512) {
                const int r = i >> 7, c = i & 127; float s = 0.f;
#pragma unroll
                for (int ww = 0; ww < 8; ++ww) s += red[(ww * 5 + r) * 128 + c];
                s += pin_ld(5)[(size_t)l * (NMOD * D) + c0 + c];
                ((float*)(p.ws + WS_MOD))[(size_t)(l * 5 + r) * (NMOD * D) + c0 + c] = s;
            }
            __syncthreads();
        }
    }
    {
        float* z = sm;
        float* a1 = sm + 16 * 36;
        float* a2 = a1 + 16 * 64;
        float* a3 = a2 + 16 * 64;
        float* tl = a3 + 16 * 64;
        const float HMAX = -4.605170185988091f / 0.3f, HMIN = -4.605170185988091f / 1.5f;
        for (int it = nb - 1 - bid; it < 544; it += nb) {
            const int o = it / 272, r = it % 272;
            const int Lf = (r < 256) ? SEQ : CL; const int p0 = (r < 256) ? r * 16 : (r - 256) * 16;
            float* kf = (float*)(p.ws + WS_KF + (size_t)o * SZ_KF) + ((r < 256) ? (size_t)0 : (size_t)2 * SEQ * D);
            const float* f0 = pin_ld(19) + (size_t)o * 33 * 64; const float* fb0 = pin_ld(20) + o * 64;
            const float* f1 = pin_ld(21) + (size_t)o * 64 * 64; const float* fb1 = pin_ld(22) + o * 64;
            const float* f2 = pin_ld(23) + (size_t)o * 64 * 64; const float* fb2 = pin_ld(24) + o * 64;
            const float* f3 = pin_ld(25) + (size_t)o * 64 * 2048; const float* fq = pin_ld(26) + o * 64;
            __syncthreads();
            for (int idx = tid; idx < 16 * 33; idx += 512) {
                const int ps = idx / 33, f = idx % 33; const int i = p0 + ps;
                const float tlin = (float)i * (1.0f / (float)(Lf - 1));
                const float w = (6.283185307179586f * (float)i) / (float)Lf;
                float v;
                if (f == 0) { v = tlin; tl[ps] = tlin; }
                else { const int jj = (f - 1) & 15; const float fj = 1e-4f + (float)jj * ((15.0f - 1e-4f) / 15.0f); v = (f <= 16) ? cosf(fj * w) : -sinf(fj * w); }
                z[ps * 36 + f] = v;
            }
            __syncthreads();
            for (int idx = tid; idx < 16 * 64; idx += 512) { const int ps = idx >> 6, oc = idx & 63; float s = fb0[oc];
                for (int f = 0; f < 33; ++f) s += z[ps * 36 + f] * f0[f * 64 + oc];
                a1[idx] = sinf(fq[oc] * s); }
            __syncthreads();
            for (int idx = tid; idx < 16 * 64; idx += 512) { const int ps = idx >> 6, oc = idx & 63; float s = fb1[oc];
                for (int f = 0; f < 64; ++f) s += a1[ps * 64 + f] * f1[f * 64 + oc];
                a2[idx] = sinf(fq[oc] * s); }
            __syncthreads();
            for (int idx = tid; idx < 16 * 64; idx += 512) { const int ps = idx >> 6, oc = idx & 63; float s = fb2[oc];
                for (int f = 0; f < 64; ++f) s += a2[ps * 64 + f] * f2[f * 64 + oc];
                a3[idx] = sinf(fq[oc] * s); }
            __syncthreads();
            for (int q = 0; q < 4; ++q) {
                const int c = tid + 512 * q; const int dir = c >> 10, d = c & 1023;
                float acc[16];
#pragma unroll
                for (int ps = 0; ps < 16; ++ps) acc[ps] = 0.f;
                for (int f = 0; f < 64; ++f) { const float wv = f3[f * 2048 + c];
#pragma unroll
                    for (int ps = 0; ps < 16; ++ps) acc[ps] += a3[ps * 64 + f] * wv; }
                const float delta = fabsf(HMIN + (float)d * ((HMAX - HMIN) / 1023.0f));
#pragma unroll
                for (int ps = 0; ps < 16; ++ps) {
                    const float kvv = acc[ps] * expf(-tl[ps] * delta);
                    if (r < 256) {
                        bf16_t* rk = (bf16_t*)(p.ws + WS_KF + (size_t)o * SZ_KF) + (size_t)d * 8192;
                        const int m = p0 + ps;
                        if (dir == 0) rk[4095 - m] = f2bf(kvv); else if (m > 0) rk[4095 + m] = f2bf(kvv);
                        if (dir == 0 && m == 0) rk[8191] = 0;
                    } else kf[((size_t)dir * Lf + p0 + ps) * D + d] = kvv;
                }
            }
        }
        __syncthreads();
    }
}

__device__ __forceinline__ void rowphase(const KQ p_in, int Mupd, const bf16_t* Y, int lu, int gidx, float wgt, const float* gpost,
                         int Mnext, int ln, const float* gpre, int shidx, int scidx, bf16_t* Hout, bool from_input) {
    const KQ p = lq(p_in);
    const int tid = ltid(), w = tid >> 6, lane = tid & 63;
    const int Mmax = Mupd > Mnext ? Mupd : Mnext;
    for (int t = (blockIdx.x * 8 + w) * 2; t < Mmax; t += gridDim.x * 16) {
        float* xr = xrow(p, t); const int mr = modrow(t);
        const float* xs = xr;
        if (from_input) xs = (t < TL) ? pin_ld(0) + (size_t)t * D : pin_ld(2) + (size_t)(t - TL) * D;
        float4 xv[2][4];
#pragma unroll
        for (int rr = 0; rr < 2; ++rr)
#pragma unroll
            for (int q = 0; q < 4; ++q) xv[rr][q] = *(const float4*)(xs + rr * D + q * 256 + lane * 4);
        if (Y != nullptr && t < Mupd) {
            float4 yv[2][4]; float ss[2] = {0.f, 0.f};
#pragma unroll
            for (int rr = 0; rr < 2; ++rr)
#pragma unroll
                for (int q = 0; q < 4; ++q) {
                    if (t < TL) { const bf16x4 yb = *(const bf16x4*)(Y + (size_t)(t + rr) * D + q * 256 + lane * 4);
                        yv[rr][q] = make_float4(bf2f((bf16_t)yb[0]), bf2f((bf16_t)yb[1]), bf2f((bf16_t)yb[2]), bf2f((bf16_t)yb[3])); }
                    else { const float* yp = (const float*)(p.ws + WS_YP) + (size_t)(t + rr - TL) * D + q * 256 + lane * 4;
                        const float4 a0 = *(const float4*)yp, a1 = *(const float4*)(yp + (size_t)TC * D), a2 = *(const float4*)(yp + (size_t)2 * TC * D), a3 = *(const float4*)(yp + (size_t)3 * TC * D);
                        yv[rr][q] = make_float4(a0.x + a1.x + a2.x + a3.x, a0.y + a1.y + a2.y + a3.y, a0.z + a1.z + a2.z + a3.z, a0.w + a1.w + a2.w + a3.w); }
                    ss[rr] += yv[rr][q].x * yv[rr][q].x + yv[rr][q].y * yv[rr][q].y + yv[rr][q].z * yv[rr][q].z + yv[rr][q].w * yv[rr][q].w; }
            ss[0] = wave_sum(ss[0]); ss[1] = wave_sum(ss[1]);
            float wgl = wgt; asm volatile("" : "+v"(wgl));
            const float r0 = rsqrtf(ss[0] * (1.0f / D) + EPS) * wgl, r1 = rsqrtf(ss[1] * (1.0f / D) + EPS) * wgl;
            const float* gm = modp(p, lu, mr, gidx);
#pragma unroll
            for (int q = 0; q < 4; ++q) {
                const float4 g4 = *(const float4*)(gm + q * 256 + lane * 4); const float4 p4 = *(const float4*)(gpost + q * 256 + lane * 4);
                const float cx = g4.x * p4.x, cy = g4.y * p4.y, cz = g4.z * p4.z, cw = g4.w * p4.w;
                xv[0][q].x += r0 * cx * yv[0][q].x; xv[0][q].y += r0 * cy * yv[0][q].y; xv[0][q].z += r0 * cz * yv[0][q].z; xv[0][q].w += r0 * cw * yv[0][q].w;
                xv[1][q].x += r1 * cx * yv[1][q].x; xv[1][q].y += r1 * cy * yv[1][q].y; xv[1][q].z += r1 * cz * yv[1][q].z; xv[1][q].w += r1 * cw * yv[1][q].w;
                *(float4*)(xr + q * 256 + lane * 4) = xv[0][q]; *(float4*)(xr + D + q * 256 + lane * 4) = xv[1][q];
            }
        }
        if (Hout != nullptr && t < Mnext) {
            float ss[2] = {0.f, 0.f};
#pragma unroll
            for (int rr = 0; rr < 2; ++rr)
#pragma unroll
                for (int q = 0; q < 4; ++q) ss[rr] += xv[rr][q].x * xv[rr][q].x + xv[rr][q].y * xv[rr][q].y + xv[rr][q].z * xv[rr][q].z + xv[rr][q].w * xv[rr][q].w;
            ss[0] = wave_sum(ss[0]); ss[1] = wave_sum(ss[1]);
            const float rn[2] = {rsqrtf(ss[0] * (1.0f / D) + EPS), rsqrtf(ss[1] * (1.0f / D) + EPS)};
            const float* sh = modp(p, ln, mr, shidx); const float* sc = modp(p, ln, mr, scidx);
#pragma unroll
            for (int q = 0; q < 4; ++q) {
                const float4 g4 = *(const float4*)(gpre + q * 256 + lane * 4); const float4 s4 = *(const float4*)(sc + q * 256 + lane * 4); const float4 h4 = *(const float4*)(sh + q * 256 + lane * 4);
                const float mx_ = g4.x * (1.0f + s4.x), my_ = g4.y * (1.0f + s4.y), mz_ = g4.z * (1.0f + s4.z), mw_ = g4.w * (1.0f + s4.w);
#pragma unroll
                for (int rr = 0; rr < 2; ++rr) {
                    const float h0 = xv[rr][q].x * rn[rr] * mx_ + h4.x, h1 = xv[rr][q].y * rn[rr] * my_ + h4.y;
                    const float h2 = xv[rr][q].z * rn[rr] * mz_ + h4.z, h3 = xv[rr][q].w * rn[rr] * mw_ + h4.w;
                    uint2 pk; pk.x = pg8::cvt_pk_bf16(h0, h1); pk.y = pg8::cvt_pk_bf16(h2, h3);
                    *(uint2*)(Hout + (size_t)(t + rr) * D + q * 256 + lane * 4) = pk;
                }
            }
        }
    }
}

__device__ __forceinline__ float log_sigmoid(float x) { return -log1pf(expf(-x)); }
__device__ __forceinline__ int chunk_t0(int b, int cidx) { return cidx < 32 ? b * SEQ + cidx * 128 : TL + b * CL + (cidx - 32) * 128; }

__device__ __forceinline__ void m1_rope_states(const KQ p_in, int e, float* sm) {
    const KQ p = lq(p_in);
    const int tid = ltid(), bid = blockIdx.x, nb = gridDim.x;
    bf16_t* Z = (bf16_t*)(p.ws + WS_BIG);
    const float* rope = (const float*)(p.ws + WS_ROPE);
    for (int idx = bid * 512 + tid; idx < TL * 72; idx += nb * 512) {
        const int t = idx / 72, r = idx % 72; const int hd = r >> 2, i0 = (r & 3) * 8;
        const int cb = hd < 16 ? hd * 64 : 1536 + (hd - 16) * 64;
        const int tb = (hd >= 8 && hd < 16) ? 2 : 0; const int pos = t & (SEQ - 1);
        const float* cp = rope + (size_t)tb * SEQ * 32 + pos * 32 + i0; const float* sp = cp + (size_t)SEQ * 32;
        bf16_t* zp = Z + (size_t)t * INW + cb + i0;
        const bf16x8 a1 = *(const bf16x8*)zp, a2 = *(const bf16x8*)(zp + 32);
        const float4 c0 = *(const float4*)cp, c1 = *(const float4*)(cp + 4), s0 = *(const float4*)sp, s1 = *(const float4*)(sp + 4);
        const float cc[8] = {c0.x, c0.y, c0.z, c0.w, c1.x, c1.y, c1.z, c1.w}, sn[8] = {s0.x, s0.y, s0.z, s0.w, s1.x, s1.y, s1.z, s1.w};
        float o1[8], o2[8];
#pragma unroll
        for (int j = 0; j < 8; ++j) { const float x1 = bf2f((bf16_t)a1[j]), x2 = bf2f((bf16_t)a2[j]); o1[j] = x1 * cc[j] - x2 * sn[j]; o2[j] = x1 * sn[j] + x2 * cc[j]; }
        u32x4 w1, w2;
        w1.x = pg8::cvt_pk_bf16(o1[0], o1[1]); w1.y = pg8::cvt_pk_bf16(o1[2], o1[3]); w1.z = pg8::cvt_pk_bf16(o1[4], o1[5]); w1.w = pg8::cvt_pk_bf16(o1[6], o1[7]);
        w2.x = pg8::cvt_pk_bf16(o2[0], o2[1]); w2.y = pg8::cvt_pk_bf16(o2[2], o2[3]); w2.z = pg8::cvt_pk_bf16(o2[4], o2[5]); w2.w = pg8::cvt_pk_bf16(o2[6], o2[7]);
        *(u32x4*)zp = w1; *(u32x4*)(zp + 32) = w2;
    }
    float* Ks = sm;
    float* Vs = sm + 128 * 64;
    float* wf = Vs + 128 * 64;
    float* wb = wf + 128;
    float* AF = (float*)(p.ws + WS_ST); float* AB = AF + SZ_ST / 4;
    const float* dec = pin_ld(13) + e * 16;
    for (int it = bid; it < NB * NCH * 8; it += nb) {
        const int h = it & 7, cidx = (it >> 3) % NCH, b = it / (8 * NCH);
        const int t0 = chunk_t0(b, cidx); const bool lat = cidx < 32;
        const float lgf = log_sigmoid(dec[h]), lgb = log_sigmoid(dec[8 + h]);
        __syncthreads();
        if (tid < 128) { wf[tid] = expf(lgf * (float)(127 - tid)); wb[tid] = expf(lgb * (float)tid); }
        const int kc = 1792 + h * 64, vc = 2304 + h * 64;
#pragma unroll
        for (int q = 0; q < 8; ++q) {
            const int idx = tid + 512 * q; const int r = idx >> 5, i = idx & 31;
            bf16_t* zp = Z + (size_t)(t0 + r) * INW + kc + i;
            float x1 = bf2f(zp[0]), x2 = bf2f(zp[32]);
            if (lat) {
                const int pos = (t0 + r) & (SEQ - 1);
                const float c = rope[(size_t)2 * SEQ * 32 + pos * 32 + i], s = rope[(size_t)3 * SEQ * 32 + pos * 32 + i];
                const bf16_t o1 = f2bf(x1 * c - x2 * s), o2 = f2bf(x1 * s + x2 * c);
                zp[0] = o1; zp[32] = o2; x1 = bf2f(o1); x2 = bf2f(o2);
            }
            Ks[r * 64 + i] = x1; Ks[r * 64 + 32 + i] = x2;
        }
#pragma unroll
        for (int q = 0; q < 16; ++q) { const int idx = tid + 512 * q; const int r = idx >> 6, c = idx & 63; Vs[idx] = bf2f(Z[(size_t)(t0 + r) * INW + vc + c]); }
        __syncthreads();
        const int d = tid >> 3, e0 = (tid & 7) * 8;
        float af[8], ab[8];
#pragma unroll
        for (int j = 0; j < 8; ++j) { af[j] = 0.f; ab[j] = 0.f; }
        for (int s = 0; s < 128; ++s) {
            const float kv = Ks[s * 64 + d]; const float kfw = kv * wf[s], kbw = kv * wb[s];
            const float4 v0 = *(const float4*)(Vs + s * 64 + e0), v1 = *(const float4*)(Vs + s * 64 + e0 + 4);
            af[0] += kfw * v0.x; af[1] += kfw * v0.y; af[2] += kfw * v0.z; af[3] += kfw * v0.w; af[4] += kfw * v1.x; af[5] += kfw * v1.y; af[6] += kfw * v1.z; af[7] += kfw * v1.w;
            ab[0] += kbw * v0.x; ab[1] += kbw * v0.y; ab[2] += kbw * v0.z; ab[3] += kbw * v0.w; ab[4] += kbw * v1.x; ab[5] += kbw * v1.y; ab[6] += kbw * v1.z; ab[7] += kbw * v1.w;
        }
        const size_t so = ((size_t)(b * NCH + cidx) * 8 + h) * 4096 + d * 64 + e0;
        *(float4*)(AF + so) = make_float4(af[0], af[1], af[2], af[3]); *(float4*)(AF + so + 4) = make_float4(af[4], af[5], af[6], af[7]);
        *(float4*)(AB + so) = make_float4(ab[0], ab[1], ab[2], ab[3]); *(float4*)(AB + so + 4) = make_float4(ab[4], ab[5], ab[6], ab[7]);
    }
    __syncthreads();
}

__device__ __forceinline__ void m2_scan(const KQ p_in, int e) {
    const KQ p = lq(p_in);
    const float* __restrict__ AF = (const float*)(p.ws + WS_ST); const float* __restrict__ AB = AF + SZ_ST / 4;
    float* __restrict__ TF = (float*)(p.ws + WS_ST) + 2 * (SZ_ST / 4); float* __restrict__ TB = TF + SZ_ST / 4;
    const float* dec = pin_ld(13) + e * 16;
    for (int idx = blockIdx.x * 512 + ltid(); idx < NB * 8 * 4096; idx += gridDim.x * 512) {
        const int el = idx & 4095, h = (idx >> 12) & 7, b = idx >> 15;
        const float gf = expf(log_sigmoid(dec[h]) * 128.0f), gb = expf(log_sigmoid(dec[8 + h]) * 128.0f);
        const size_t base = ((size_t)(b * NCH) * 8 + h) * 4096 + el; constexpr size_t CS = (size_t)8 * 4096;
        float af[NCH], ab[NCH];
#pragma unroll
        for (int c = 0; c < NCH; ++c) { af[c] = AF[base + c * CS]; ab[c] = AB[base + c * CS]; }
        TF[base + 32 * CS] = 0.f; TF[base + 33 * CS] = af[32]; TB[base + 33 * CS] = 0.f; TB[base + 32 * CS] = ab[33];
        float sf = gf * af[32] + af[33], sb = ab[32] + gb * ab[33];
#pragma unroll
        for (int c = 0; c < 32; ++c) { TF[base + c * CS] = sf; sf = gf * sf + af[c]; }
#pragma unroll
        for (int c = 31; c >= 0; --c) { TB[base + c * CS] = sb; sb = ab[c] + gb * sb; }
    }
}

__device__ __forceinline__ bf16x8 pack8(const f32x4& a, const f32x4& b) {
    u32x4 w; w.x = pg8::cvt_pk_bf16(a[0], a[1]); w.y = pg8::cvt_pk_bf16(a[2], a[3]); w.z = pg8::cvt_pk_bf16(b[0], b[1]); w.w = pg8::cvt_pk_bf16(b[2], b[3]);
    return __builtin_bit_cast(bf16x8, w);
}
__device__ __forceinline__ void m3_outputs(const KQ p_in, int e, bool ctx_full, unsigned char* smem) {
    const KQ p = lq(p_in);
    const int tid = ltid(), bid = blockIdx.x, nb = gridDim.x;
    const int w = tid >> 6, lane = tid & 63, ln = lane & 15, g4 = lane >> 4;
    const bf16_t* Z = (const bf16_t*)(p.ws + WS_BIG);
    bf16_t* MIX = (bf16_t*)(p.ws + WS_MIX);
    const float* dec = pin_ld(13) + e * 16;
    const float* sink = pin_ld(12) + e * 8;
    const float* TF = (const float*)(p.ws + WS_ST) + 2 * (SZ_ST / 4); const float* TB = TF + SZ_ST / 4;
    const int nchunk = ctx_full ? NCH : 32;
    const int nitems = NB * nchunk * 8;
    bf16_t* Kt = (bf16_t*)smem;
    bf16_t* Vt = Kt + 128 * 72;
    bf16_t* TfT = Vt + 64 * 136;
    bf16_t* TbT = TfT + 64 * 72;
    const int i = 16 * w + ln;
    for (int it = bid; it < 2 * nitems; it += nb) {
        const bool is_attn = it < nitems; const int ii = is_attn ? it : it - nitems;
        const int h = ii & 7, cidx = (ii >> 3) % nchunk, b = ii / (8 * nchunk);
        const int t0 = chunk_t0(b, cidx); const bool lat = cidx < 32;
        f32x4 O[4];
#pragma unroll
        for (int m = 0; m < 4; ++m) O[m] = (f32x4){0.f, 0.f, 0.f, 0.f};
        if (!is_attn) {
            const float lgf = log_sigmoid(dec[h]), lgb = log_sigmoid(dec[8 + h]);
            __syncthreads();
#pragma unroll
            for (int q = 0; q < 2; ++q) { const int idx = tid + 512 * q; const int r = idx >> 3, pc = idx & 7; const bf16_t* zr = Z + (size_t)(t0 + r) * INW + h * 64 + pc * 8;
                *(u32x4*)(Kt + r * 72 + pc * 8) = *(const u32x4*)(zr + 1792);
                const bf16x8 vv = *(const bf16x8*)(zr + 2304);
#pragma unroll
                for (int j = 0; j < 8; ++j) Vt[(pc * 8 + j) * 136 + r] = (bf16_t)vv[j]; }
            const size_t so = ((size_t)(b * NCH + cidx) * 8 + h) * 4096;
#pragma unroll
            for (int q = 0; q < 8; ++q) { const int idx = tid + 512 * q; const int d = idx >> 6, ee = idx & 63; TfT[ee * 72 + d] = f2bf(TF[so + idx]); TbT[ee * 72 + d] = f2bf(TB[so + idx]); }
            __builtin_amdgcn_sched_barrier(0);
            bf16x8 qf[2], qff[2], qfb[2];
            { const bf16_t* qr = Z + (size_t)(t0 + i) * INW + 512 + h * 64 + 8 * g4;
              const float cf = __expf(lgf * (float)(i + 1)), cb = __expf(lgb * (float)(128 - i));
#pragma unroll
              for (int k2 = 0; k2 < 2; ++k2) { qf[k2] = *(const bf16x8*)(qr + 32 * k2);
                  f32x4 a0, a1, b0, b1;
#pragma unroll
                  for (int j = 0; j < 4; ++j) { const float x0 = bf2f((bf16_t)qf[k2][j]), x1 = bf2f((bf16_t)qf[k2][4 + j]); a0[j] = x0 * cf; a1[j] = x1 * cf; b0[j] = x0 * cb; b1[j] = x1 * cb; }
                  qff[k2] = pack8(a0, a1); qfb[k2] = pack8(b0, b1); } }
            __builtin_amdgcn_sched_barrier(0);
            __syncthreads();
#pragma unroll
            for (int m = 0; m < 4; ++m)
#pragma unroll
                for (int k2 = 0; k2 < 2; ++k2) {
                    const bf16x8 af = *(const bf16x8*)(TfT + (16 * m + ln) * 72 + 32 * k2 + 8 * g4);
                    const bf16x8 ab = *(const bf16x8*)(TbT + (16 * m + ln) * 72 + 32 * k2 + 8 * g4);
                    O[m] = __builtin_amdgcn_mfma_f32_16x16x32_bf16(af, qff[k2], O[m], 0, 0, 0);
                    O[m] = __builtin_amdgcn_mfma_f32_16x16x32_bf16(ab, qfb[k2], O[m], 0, 0, 0);
                    __builtin_amdgcn_sched_barrier(0);
                }
            const float lf2 = lgf * 1.44269504f, lb2 = lgb * 1.44269504f; const int di = i - 4 * g4;
            const float bfw = lf2 * (float)di, bbw = -lb2 * (float)di;
            f32x4 st[8];
#pragma unroll
            for (int mt = 0; mt < 8; ++mt) {
                f32x4 a = (f32x4){0.f, 0.f, 0.f, 0.f};
#pragma unroll
                for (int k2 = 0; k2 < 2; ++k2) { const bf16x8 kf = *(const bf16x8*)(Kt + (16 * mt + ln) * 72 + 32 * k2 + 8 * g4); a = __builtin_amdgcn_mfma_f32_16x16x32_bf16(kf, qf[k2], a, 0, 0, 0); }
#pragma unroll
                for (int rg = 0; rg < 4; ++rg) { const int cc = 16 * mt + rg; const int df = di - cc;
                    const float arg = (df > 0) ? fmaf(-lf2, (float)cc, bfw) : fmaf(lb2, (float)cc, bbw);
                    float wgt = __builtin_amdgcn_exp2f(arg); wgt = (df == 0) ? 2.0f : wgt;
                    a[rg] *= wgt; }
                st[mt] = a;
                __builtin_amdgcn_sched_barrier(0);
            }
#pragma unroll
            for (int ks = 0; ks < 4; ++ks) {
                const bf16x8 pfr = pack8(st[2 * ks], st[2 * ks + 1]);
#pragma unroll
                for (int m = 0; m < 4; ++m) {
                    const bf16_t* vr = Vt + (16 * m + ln) * 136 + 32 * ks + 4 * g4;
                    const bf16x4 v0 = *(const bf16x4*)vr, v1 = *(const bf16x4*)(vr + 16);
                    const bf16x8 vf = __builtin_shufflevector(v0, v1, 0, 1, 2, 3, 4, 5, 6, 7);
                    O[m] = __builtin_amdgcn_mfma_f32_16x16x32_bf16(vf, pfr, O[m], 0, 0, 0);
                }
                __builtin_amdgcn_sched_barrier(0);
            }
            float ss = 0.f;
#pragma unroll
            for (int m = 0; m < 4; ++m)
#pragma unroll
                for (int rg = 0; rg < 4; ++rg) ss += O[m][rg] * O[m][rg];
            ss += __shfl_xor(ss, 16, 64); ss += __shfl_xor(ss, 32, 64);
            const float rn = rsqrtf(ss * (1.0f / 64.0f) + EPS);
#pragma unroll
            for (int m = 0; m < 4; ++m) {
                const int ee = 16 * m + 4 * g4;
                const bf16x4 gv = *(const bf16x4*)(Z + (size_t)(t0 + i) * INW + 1024 + h * 64 + ee);
                uint2 o2; o2.x = pg8::cvt_pk_bf16(O[m][0] * rn * silu_f(bf2f((bf16_t)gv[0])), O[m][1] * rn * silu_f(bf2f((bf16_t)gv[1])));
                o2.y = pg8::cvt_pk_bf16(O[m][2] * rn * silu_f(bf2f((bf16_t)gv[2])), O[m][3] * rn * silu_f(bf2f((bf16_t)gv[3])));
                *(uint2*)(MIX + (size_t)(t0 + i) * D + 512 + h * 64 + ee) = o2;
            }
        } else {
            const int gk = h >> 2;
            bf16x8 qf[2];
            { const bf16_t* qr = Z + (size_t)(t0 + i) * INW + h * 64 + 8 * g4; qf[0] = *(const bf16x8*)qr; qf[1] = *(const bf16x8*)(qr + 32); }
            float mx = sink[h], l = (g4 == 0) ? 1.0f : 0.0f;
            const int qpos = lat ? (cidx * 128 + i) : 0;
#define ATT_VALID(tl_) ((tl_) >= 3 || (lat && (cidx - 1 + (tl_)) >= 0 && (cidx - 1 + (tl_)) < 32))
#define ATT_KT0(tl_) ((tl_) >= 3 ? TL + b * CL + ((tl_) - 3) * 128 : b * SEQ + (cidx - 1 + (tl_)) * 128)
            int tl = 0; while (!ATT_VALID(tl)) ++tl;
            u32x4 kreg[2]; bf16x8 vreg[2];
            { const int kt0 = ATT_KT0(tl);
#pragma unroll
              for (int q = 0; q < 2; ++q) { const int idx = tid + 512 * q; const int r = idx >> 3, pc = idx & 7; const bf16_t* zr = Z + (size_t)(kt0 + r) * INW + gk * 64 + pc * 8;
                  kreg[q] = *(const u32x4*)(zr + 1536); vreg[q] = *(const bf16x8*)(zr + 1664); } }
            while (tl < 5) {
                const bool isc = tl >= 3; const int kp0 = isc ? 0 : (cidx - 1 + tl) * 128;
                __syncthreads();
#pragma unroll
                for (int q = 0; q < 2; ++q) { const int idx = tid + 512 * q; const int r = idx >> 3, pc = idx & 7;
                    *(u32x4*)(Kt + r * 72 + pc * 8) = kreg[q];
#pragma unroll
                    for (int j = 0; j < 8; ++j) Vt[(pc * 8 + j) * 136 + r] = (bf16_t)vreg[q][j]; }
                __syncthreads();
                int tn = tl + 1; while (tn < 5 && !ATT_VALID(tn)) ++tn;
                if (tn < 5) { const int kt0 = ATT_KT0(tn);
#pragma unroll
                    for (int q = 0; q < 2; ++q) { const int idx = tid + 512 * q; const int r = idx >> 3, pc = idx & 7; const bf16_t* zr = Z + (size_t)(kt0 + r) * INW + gk * 64 + pc * 8;
                        kreg[q] = *(const u32x4*)(zr + 1536); vreg[q] = *(const bf16x8*)(zr + 1664); } }
                f32x4 st[8];
                float mloc = -1e30f;
#pragma unroll
                for (int mt = 0; mt < 8; ++mt) {
                    f32x4 a = (f32x4){0.f, 0.f, 0.f, 0.f};
#pragma unroll
                    for (int k2 = 0; k2 < 2; ++k2) { const bf16x8 kf = *(const bf16x8*)(Kt + (16 * mt + ln) * 72 + 32 * k2 + 8 * g4); a = __builtin_amdgcn_mfma_f32_16x16x32_bf16(kf, qf[k2], a, 0, 0, 0); }
                    if (!isc) {
#pragma unroll
                        for (int rg = 0; rg < 4; ++rg) { const int dd = qpos - (kp0 + 16 * mt + 4 * g4 + rg); if (dd > 128 || dd < -128) a[rg] = -1e30f; }
                    }
#pragma unroll
                    for (int rg = 0; rg < 4; ++rg) mloc = fmaxf(mloc, a[rg]);
                    st[mt] = a;
                    __builtin_amdgcn_sched_barrier(0);
                }
                mloc = fmaxf(mloc, __shfl_xor(mloc, 16, 64)); mloc = fmaxf(mloc, __shfl_xor(mloc, 32, 64));
                const float mnew = fmaxf(mx, mloc);
                const float sc = __expf(mx - mnew); mx = mnew; l *= sc;
#pragma unroll
                for (int m = 0; m < 4; ++m) O[m] *= sc;
#pragma unroll
                for (int mt = 0; mt < 8; ++mt)
#pragma unroll
                    for (int rg = 0; rg < 4; ++rg) { const float pv = __expf(st[mt][rg] - mnew); st[mt][rg] = pv; l += pv; }
#pragma unroll
                for (int ks = 0; ks < 4; ++ks) {
                    const bf16x8 pfr = pack8(st[2 * ks], st[2 * ks + 1]);
#pragma unroll
                    for (int m = 0; m < 4; ++m) {
                        const bf16_t* vr = Vt + (16 * m + ln) * 136 + 32 * ks + 4 * g4;
                        const bf16x4 v0 = *(const bf16x4*)vr, v1 = *(const bf16x4*)(vr + 16);
                        const bf16x8 vf = __builtin_shufflevector(v0, v1, 0, 1, 2, 3, 4, 5, 6, 7);
                        O[m] = __builtin_amdgcn_mfma_f32_16x16x32_bf16(vf, pfr, O[m], 0, 0, 0);
                    }
                    __builtin_amdgcn_sched_barrier(0);
                }
                tl = tn;
            }
#undef ATT_VALID
#undef ATT_KT0
            l += __shfl_xor(l, 16, 64); l += __shfl_xor(l, 32, 64);
            const float inv = 1.0f / l;
#pragma unroll
            for (int m = 0; m < 4; ++m) {
                uint2 o2; o2.x = pg8::cvt_pk_bf16(O[m][0] * inv, O[m][1] * inv); o2.y = pg8::cvt_pk_bf16(O[m][2] * inv, O[m][3] * inv);
                *(uint2*)(MIX + (size_t)(t0 + i) * D + h * 64 + 16 * m + 4 * g4) = o2;
            }
        }
    }
    __syncthreads();
}

__device__ __forceinline__ void h2_shortconv(const KQ p_in, int o, int M, unsigned char* smem) {
    const KQ p = lq(p_in);
    const int tid = ltid();
    const bf16_t* ZH = (const bf16_t*)(p.ws + WS_BIG);
    const float* w = pin_ld(17) + (size_t)o * 3 * HYW; const float* bs = pin_ld(18) + (size_t)o * HYW;
    bf16_t* VXT = (bf16_t*)(p.ws + WS_Y); bf16_t* X0T = VXT + (size_t)D * TL;
    bf16_t* tx = (bf16_t*)smem;
    bf16_t* tv = tx + 64 * 72;
    const int tok = tid >> 3, cg8 = (tid & 7) * 8;
    float* wl = (float*)(smem + 32768);
    { const int c0b = (blockIdx.x & 15) * 64;
      for (int i = tid; i < 768; i += 512) { const int k = i >> 8, q = (i >> 6) & 3, c = i & 63; const int col = k * 1024 + c0b + c; wl[i] = (q < 3) ? w[q * HYW + col] : bs[col]; } }
    __syncthreads();
    for (int it = blockIdx.x; it < (TL / 64) * 16; it += gridDim.x) {
        const int c0 = (it & 15) * 64, t0 = (it >> 4) * 64;
        const int t = t0 + tok; const int pos = t & (SEQ - 1); const bool first = pos == 0, last = pos == SEQ - 1;
        float zz[3][8];
#pragma unroll
        for (int k = 0; k < 3; ++k) {
            const int c = k * 1024 + c0 + cg8;
            const bf16x8 zc = *(const bf16x8*)(ZH + (size_t)t * HYW + c);
            bf16x8 zp = zc, zn = zc;
            if (!first) zp = *(const bf16x8*)(ZH + (size_t)(t - 1) * HYW + c);
            if (!last) zn = *(const bf16x8*)(ZH + (size_t)(t + 1) * HYW + c);
            const float* wk = wl + k * 256 + cg8;
#pragma unroll
            for (int j = 0; j < 8; ++j) {
                float sacc = wk[192 + j] + bf2f((bf16_t)zc[j]) * wk[64 + j];
                if (!first) sacc += bf2f((bf16_t)zp[j]) * wk[j];
                if (!last) sacc += bf2f((bf16_t)zn[j]) * wk[128 + j];
                zz[k][j] = sacc;
            }
        }
        __syncthreads();
#pragma unroll
        for (int j = 0; j < 8; ++j) { tx[(cg8 + j) * 72 + tok] = f2bf(zz[0][j]); tv[(cg8 + j) * 72 + tok] = f2bf(zz[2][j] * zz[1][j]); }
        __syncthreads();
        { const int ch = tid >> 3, tk = (tid & 7) * 8;
          *(u32x4*)(X0T + (size_t)(c0 + ch) * TL + t0 + tk) = *(const u32x4*)(tx + ch * 72 + tk);
          *(u32x4*)(VXT + (size_t)(c0 + ch) * TL + t0 + tk) = *(const u32x4*)(tv + ch * 72 + tk); }
    }
    __syncthreads();
    if (M > TL) {
        float* VX = (float*)(p.ws + WS_Y); bf16_t* X0 = (bf16_t*)(p.ws + WS_H);
        for (int idx = TL * D + blockIdx.x * 512 + tid; idx < M * D; idx += gridDim.x * 512) {
            const int t = idx >> 10, d = idx & 1023;
            const int pos = (t - TL) & (CL - 1); const bool first = pos == 0, last = pos == CL - 1;
            float zz[3];
#pragma unroll
            for (int k = 0; k < 3; ++k) {
                const int c = k * 1024 + d;
                float sacc = bs[c] + bf2f(ZH[(size_t)t * HYW + c]) * w[HYW + c];
                if (!first) sacc += bf2f(ZH[(size_t)(t - 1) * HYW + c]) * w[c];
                if (!last) sacc += bf2f(ZH[(size_t)(t + 1) * HYW + c]) * w[2 * HYW + c];
                zz[k] = sacc;
            }
            VX[idx] = zz[2] * zz[1]; X0[idx] = f2bf(zz[0]);
        }
    }
}

typedef float f32x16 __attribute__((ext_vector_type(16)));
__device__ __forceinline__ void h3_longconv(const KQ p_in, int o, bool ctx_full, unsigned char* smem) {
    const KQ p = lq(p_in);
    const int tid = ltid(), w = tid >> 6, lane = tid & 63;
    const float* bias = pin_ld(27) + (size_t)o * D;
    {
        const bf16_t* VXT = (const bf16_t*)(p.ws + WS_Y); const bf16_t* X0T = VXT + (size_t)D * TL;
        bf16_t* HMT = (bf16_t*)(p.ws + WS_H);
        const bf16_t* RKT = (const bf16_t*)(p.ws + WS_KF + (size_t)o * SZ_KF);
        constexpr int RK2_OFF = 16384 + 64, U_OFF = 2 * 16384 + 128, CH_BYTES = U_OFF + 142 * 256;
        const int cw = w >> 2, w4 = w & 3;
        const int ct = tid & 255;
        unsigned char* cb = smem + cw * CH_BYTES;
        unsigned char* ub = cb + U_OFF;
        const int r = lane & 31, hh = lane >> 5;
        for (int pr = blockIdx.x; pr < D / 2; pr += gridDim.x) {
            const int d = pr * 2 + cw;
            __syncthreads();
            { const bf16_t* src = RKT + (size_t)d * 8192;
              for (int i = ct; i < 1024; i += 256) *(u32x4*)(cb + i * 16) = *(const u32x4*)(src + i * 8);
              for (int i = ct; i < 2 * 7 * 4 * 4; i += 256) { const int side = i / 112, rem = i % 112; unsigned z0 = 0u; asm volatile("" : "+v"(z0)); *(u32x4*)(ub + (side ? (135 * 4 * 64) : 0) + rem * 16) = (u32x4){z0, z0, z0, z0}; }
#pragma unroll 4
              for (int i = ct; i < 4 * 512; i += 256) { const int b = i >> 9, pc = i & 511;
                  const u32x4 v = *(const u32x4*)(VXT + (size_t)d * TL + b * SEQ + pc * 8);
                  const int col = ((pc >> 2) + 7) * 4 + b, q = pc & 3;
                  *(u32x4*)(ub + col * 64 + ((q ^ ((col >> 2) & 3)) * 16)) = v; } }
            __syncthreads();
            { const bf16_t* rk = (const bf16_t*)cb; bf16_t* rk2 = (bf16_t*)(cb + RK2_OFF);
#pragma unroll 4
              for (int i = ct; i < 4096; i += 256) { const unsigned lo = rk[2 * i + 1]; const unsigned hi = (2 * i + 2 < 8192) ? rk[2 * i + 2] : 0u; *(unsigned*)(rk2 + 2 * i) = lo | (hi << 16); } }
            __syncthreads();
            f32x16 acc[4];
#pragma unroll
            for (int j = 0; j < 4; ++j)
#pragma unroll
                for (int q = 0; q < 16; ++q) acc[j][q] = 0.f;
            const bf16_t* rsel = (const bf16_t*)(cb + ((r & 1) ? 0 : RK2_OFF));
            const int adj = (r & 1) ? 0 : -1;
            const int bq = r & 3;
#define H3_LOAD(AF, BF, DL) do { const int dl_ = (DL); \
                _Pragma("unroll") for (int s2 = 0; s2 < 2; ++s2) { \
                    const int e0 = 4095 - 32 * dl_ - r + 16 * s2 + 8 * hh + adj; \
                    const unsigned* ap = (const unsigned*)(rsel + e0); \
                    u32x4 t4; t4.x = ap[0]; t4.y = ap[1]; t4.z = ap[2]; t4.w = ap[3]; \
                    AF[s2] = __builtin_bit_cast(bf16x8, t4); } \
                _Pragma("unroll") for (int j = 0; j < 4; ++j) { \
                    int ch = 8 * (4 * w4 + j) + (r >> 2) - dl_; ch = ch < -1 ? -1 : (ch > 128 ? 128 : ch); \
                    const int col = (ch + 7) * 4 + bq; const int sw = (col >> 2) & 3; \
                    const unsigned char* bp = ub + col * 64; \
                    BF[j][0] = *(const bf16x8*)(bp + ((hh ^ sw) * 16)); BF[j][1] = *(const bf16x8*)(bp + (((2 + hh) ^ sw) * 16)); } } while (0)
#define H3_MMA(AF, BF) do { \
                _Pragma("unroll") for (int s2 = 0; s2 < 2; ++s2) \
                _Pragma("unroll") for (int j = 0; j < 4; ++j) acc[j] = __builtin_amdgcn_mfma_f32_32x32x16_bf16(AF[s2], BF[j][s2], acc[j], 0, 0, 0); } while (0)
            {
                const int dlo = 32 * w4 - 127, dhi = 32 * w4 + 31;
                bf16x8 afA[2], bfA[4][2], afB[2], bfB[4][2];
                H3_LOAD(afA, bfA, dlo);
                for (int dl = dlo; dl < dhi; dl += 2) {
                    H3_LOAD(afB, bfB, dl + 1);
                    __builtin_amdgcn_sched_barrier(0);
                    H3_MMA(afA, bfA);
                    __builtin_amdgcn_sched_barrier(0);
                    H3_LOAD(afA, bfA, dl + 2);
                    __builtin_amdgcn_sched_barrier(0);
                    H3_MMA(afB, bfB);
                    __builtin_amdgcn_sched_barrier(0);
                }
                H3_MMA(afA, bfA);
            }
#undef H3_LOAD
#undef H3_MMA
            __syncthreads();
            const float bd = bias[d];
#pragma unroll
            for (int j = 0; j < 4; ++j) {
                const int n1 = 8 * (4 * w4 + j) + (r >> 2);
                const int col = (n1 + 7) * 4 + bq; const int sw = (col >> 2) & 3;
                bf16_t* up = (bf16_t*)(ub + col * 64);
#pragma unroll
                for (int q4 = 0; q4 < 4; ++q4) {
                    bf16_t* pp = up + ((q4 ^ sw) * 8) + 4 * hh;
                    const bf16x4 uv = *(const bf16x4*)pp;
                    uint2 o2; o2.x = pg8::cvt_pk_bf16(acc[j][4 * q4] + bd * bf2f((bf16_t)uv[0]), acc[j][4 * q4 + 1] + bd * bf2f((bf16_t)uv[1]));
                    o2.y = pg8::cvt_pk_bf16(acc[j][4 * q4 + 2] + bd * bf2f((bf16_t)uv[2]), acc[j][4 * q4 + 3] + bd * bf2f((bf16_t)uv[3]));
                    *(uint2*)pp = o2;
                }
            }
            __syncthreads();
#pragma unroll 2
            for (int i = ct; i < 4 * 512; i += 256) { const int b = i >> 9, pc = i & 511;
                const int col = ((pc >> 2) + 7) * 4 + b, q = pc & 3;
                const bf16x8 yv = *(const bf16x8*)(ub + col * 64 + ((q ^ ((col >> 2) & 3)) * 16));
                const size_t gi = (size_t)d * TL + b * SEQ + pc * 8;
                const bf16x8 xv = *(const bf16x8*)(X0T + gi);
                u32x4 o4;
                o4.x = pg8::cvt_pk_bf16(bf2f((bf16_t)yv[0]) * bf2f((bf16_t)xv[0]), bf2f((bf16_t)yv[1]) * bf2f((bf16_t)xv[1]));
                o4.y = pg8::cvt_pk_bf16(bf2f((bf16_t)yv[2]) * bf2f((bf16_t)xv[2]), bf2f((bf16_t)yv[3]) * bf2f((bf16_t)xv[3]));
                o4.z = pg8::cvt_pk_bf16(bf2f((bf16_t)yv[4]) * bf2f((bf16_t)xv[4]), bf2f((bf16_t)yv[5]) * bf2f((bf16_t)xv[5]));
                o4.w = pg8::cvt_pk_bf16(bf2f((bf16_t)yv[6]) * bf2f((bf16_t)xv[6]), bf2f((bf16_t)yv[7]) * bf2f((bf16_t)xv[7]));
                *(u32x4*)(HMT + gi) = o4; }
        }
        __syncthreads();
    }
    if (ctx_full) {
        const float* VX = (const float*)(p.ws + WS_Y); const bf16_t* X0 = (const bf16_t*)(p.ws + WS_H);
        bf16_t* MIX = (bf16_t*)(p.ws + WS_MIX);
        const float* kf = (const float*)(p.ws + WS_KF + (size_t)o * SZ_KF) + (size_t)2 * SEQ * D;
        for (int idx = blockIdx.x * 512 + tid; idx < (TC / 8) * D; idx += gridDim.x * 512) {
            const int d = idx & 1023, og = idx >> 10;
            const int bb = og >> 5, n0 = (og & 31) * 8, tb = TL + bb * CL;
            const float* up = VX + (size_t)tb * D + d;
            float acc[8];
#pragma unroll
            for (int j = 0; j < 8; ++j) acc[j] = 0.f;
#pragma unroll 1
            for (int mb = 0; mb < CL; mb += 8) {
                float kk[15], uu[8];
#pragma unroll
                for (int q = 0; q < 15; ++q) { const int lag = n0 - mb - 7 + q;
                    kk[q] = (lag >= 0) ? ((lag < CL) ? kf[(size_t)lag * D + d] : 0.f) : ((-lag < CL) ? kf[(size_t)(CL - lag) * D + d] : 0.f); }
#pragma unroll
                for (int u = 0; u < 8; ++u) uu[u] = up[(size_t)(mb + u) * D];
#pragma unroll
                for (int u = 0; u < 8; ++u)
#pragma unroll
                    for (int j = 0; j < 8; ++j) acc[j] += uu[u] * kk[7 - u + j];
            }
            const float bd = bias[d];
#pragma unroll
            for (int j = 0; j < 8; ++j) { const size_t ti = (size_t)(tb + n0 + j) * D + d; MIX[ti] = f2bf(bf2f(X0[ti]) * (acc[j] + bd * VX[ti])); }
        }
    }
}

__device__ __forceinline__ void h3b_transpose(const KQ p_in, unsigned char* smem) {
    const KQ p = lq(p_in);
    const int tid = ltid();
    const bf16_t* HMT = (const bf16_t*)(p.ws + WS_H); bf16_t* MIX = (bf16_t*)(p.ws + WS_MIX);
    bf16_t* tile = (bf16_t*)smem;
    for (int it = blockIdx.x; it < (TL / 64) * 16; it += gridDim.x) {
        const int c0 = (it & 15) * 64, t0 = (it >> 4) * 64;
        __syncthreads();
        { const int ch = tid >> 3, tk = (tid & 7) * 8; *(u32x4*)(tile + ch * 72 + tk) = *(const u32x4*)(HMT + (size_t)(c0 + ch) * TL + t0 + tk); }
        __syncthreads();
        { const int tok = tid >> 3, cg8 = (tid & 7) * 8; unsigned short v[8];
#pragma unroll
          for (int j = 0; j < 8; ++j) v[j] = tile[(cg8 + j) * 72 + tok];
          u32x4 o4; o4.x = v[0] | ((unsigned)v[1] << 16); o4.y = v[2] | ((unsigned)v[3] << 16); o4.z = v[4] | ((unsigned)v[5] << 16); o4.w = v[6] | ((unsigned)v[7] << 16);
          *(u32x4*)(MIX + (size_t)(t0 + tok) * D + c0 + cg8) = o4; }
    }
    __syncthreads();
}

__global__ void __launch_bounds__(512, 2) mega_fwd(KP kp) {
    unsigned char* const smem = g_smem;
    if (threadIdx.x < 29) *(LAS unsigned long long*)((LAS unsigned char*)g_smem + PTAB_OFF + 8 * threadIdx.x) = ((const unsigned long long*)__builtin_amdgcn_kernarg_segment_ptr())[threadIdx.x];
    KQ p; p.out = kp.out; p.ws = kp.ws;
    cg::grid_group grid = cg::this_grid();
    if (threadIdx.x < 4) ((volatile LAS unsigned*)(LAS unsigned char*)smem)[(LDS_BYTES - 16) / 4 + threadIdx.x] = 0u;
    __syncthreads();
    if (threadIdx.x == 0) (void)xb_add(&((unsigned*)(lq(p).ws + WS_BAR))[XB_XCNT(xb_xcc_id())], 1u);
    grid.sync();
    float* smf = (float*)smem;
#define Hb ((bf16_t*)(lq(p).ws + WS_H))
#define BIG ((bf16_t*)(lq(p).ws + WS_BIG))
#define Y ((bf16_t*)(lq(p).ws + WS_Y))
#define MIX ((bf16_t*)(lq(p).ws + WS_MIX))

#ifndef NO_P0
    p0_setup(p, smf);
#endif
    GRID_BAR();
    rowphase(p, 0, nullptr, 0, 0, 0.f, nullptr, T, 0, pin_ld(6), 0, 1, Hb, true);
    GRID_BAR();
    for (int l = 0; l < 4; ++l) {
        const bool ctx_live = l <= 2, ctx_full = l < 2;
        const int Mff = ctx_live ? T : TL, Mpost = ctx_full ? T : TL;
        for (int sub = 0; sub < 3; ++sub) {
            if (sub != 1) {
                const int fi = sub >> 1; const int M = (sub == 0) ? Mff : Mpost;
                { pg8::EpiSwiGLU E{BIG, DFF}; run_gemm(smem, Hb, (const bf16_t*)(lq(p).ws + WS_WGU + (size_t)(l * 2 + fi) * SZ_WGU), M, 2 * DFF, D, E); }
                GRID_BAR();
                run_gemm_f32_split(smem, BIG, (const bf16_t*)(lq(p).ws + WS_WD + (size_t)(l * 2 + fi) * SZ_WD), M, DFF, Y, (float*)(lq(p).ws + WS_YP));
                GRID_BAR();
                if (sub == 0) rowphase(p, M, Y, l, 2, 0.5f, pin_ld(7) + (size_t)(l * 3 + 0) * D, Mff, l, pin_ld(6) + (size_t)(l * 3 + 1) * D, 3, 4, Hb, l == 0);
                else {
                    const int ln = l + 1; const int Mn = (ln < 4) ? ((ln <= 2) ? T : TL) : 0;
                    rowphase(p, M, Y, l, 8, 0.5f, pin_ld(7) + (size_t)(l * 3 + 2) * D, Mn, ln < 4 ? ln : l, pin_ld(6) + (size_t)((ln < 4 ? ln : l) * 3 + 0) * D, 0, 1, ln < 4 ? Hb : nullptr, false);
                }
                GRID_BAR();
            } else {
                if ((l & 1) == 0) {
                    const int e = l >> 1;
                    { pg8::EpiBf16 E{BIG, INW, nullptr}; run_gemm(smem, Hb, (const bf16_t*)(lq(p).ws + WS_WIN + (size_t)e * SZ_WIN), Mff, INW, D, E); }
                    GRID_BAR();
#ifndef NO_M1
                    m1_rope_states(p, e, smf);
#endif
                    GRID_BAR();
#ifndef NO_M2
                    m2_scan(p, e);
#endif
                    GRID_BAR();
#ifndef NO_M3
                    m3_outputs(p, e, ctx_full, smem);
#endif
                    GRID_BAR();
                    run_gemm_f32_split(smem, MIX, (const bf16_t*)(lq(p).ws + WS_WOUT + (size_t)e * SZ_WOUT), Mpost, D, Y, (float*)(lq(p).ws + WS_YP));
                    GRID_BAR();
                } else {
                    const int o = l >> 1;
                    { pg8::EpiBf16 E{BIG, HYW, pin_ld(16) + (size_t)o * HYW}; run_gemm(smem, Hb, (const bf16_t*)(lq(p).ws + WS_HWIN + (size_t)o * SZ_HWIN), Mpost, HYW, D, E); }
                    GRID_BAR();
#ifndef NO_H2
                    h2_shortconv(p, o, Mpost, smem);
#endif
                    GRID_BAR();
#ifndef NO_H3
                    h3_longconv(p, o, ctx_full, smem);
#endif
                    GRID_BAR();
                    h3b_transpose(p, smem);
                    GRID_BAR();
                    run_gemm_f32_split(smem, MIX, (const bf16_t*)(lq(p).ws + WS_HWOUT + (size_t)o * SZ_WOUT), Mpost, D, Y, (float*)(lq(p).ws + WS_YP));
                    GRID_BAR();
                }
                rowphase(p, Mpost, Y, l, 5, 1.0f, pin_ld(7) + (size_t)(l * 3 + 1) * D, Mpost, l, pin_ld(6) + (size_t)(l * 3 + 2) * D, 6, 7, Hb, false);
                GRID_BAR();
            }
        }
    }
}

extern "C" void kernel_launch(void* const* d_in, const int* in_sizes, int n_in, void* d_out, int out_size, void* d_ws, size_t ws_size, hipStream_t stream) {
    static int grid = 0;
    if (grid == 0) {
        if (n_in != 29 || out_size != TL * D || ws_size < WS_END) { fprintf(stderr, "kernel_launch: unexpected shapes: n_in %d out %d ws %zu (need %zu)\n", n_in, out_size, ws_size, (size_t)WS_END); grid = -1; return; }
        int dev = 0, cus = 0, per_cu = 0;
        (void)hipGetDevice(&dev);
        (void)hipDeviceGetAttribute(&cus, hipDeviceAttributeMultiprocessorCount, dev);
        if (hipFuncSetAttribute((const void*)mega_fwd, hipFuncAttributeMaxDynamicSharedMemorySize, LDS_BYTES) != hipSuccess) { fprintf(stderr, "kernel_launch: hipFuncSetAttribute failed\n"); grid = -1; return; }
        if (hipOccupancyMaxActiveBlocksPerMultiprocessor(&per_cu, (const void*)mega_fwd, 512, LDS_BYTES) != hipSuccess || per_cu < 1) { fprintf(stderr, "kernel_launch: occupancy query says %d\n", per_cu); per_cu = 1; }
        (void)hipGetLastError();
        grid = cus;
    }
    if (grid < 0) return;
    (void)hipMemsetAsync((unsigned char*)d_ws + WS_BAR, 0, 16384, stream);
    KP kp{};
    for (int i = 0; i < 29; ++i) kp.in[i] = (const float*)d_in[i];
    kp.out = (float*)d_out; kp.ws = (unsigned char*)d_ws;
    void* args[] = {&kp};
    hipError_t e = hipLaunchCooperativeKernel((const void*)mega_fwd, dim3(grid), dim3(512), args, LDS_BYTES, stream);
    if (e != hipSuccess) fprintf(stderr, "cooperative launch failed: %s (grid %d)\n", hipGetErrorString(e), grid);
}
```

```cpp
#include <hip/hip_runtime.h>
#include <hip/hip_cooperative_groups.h>
#include <cstdio>
namespace cg = cooperative_groups;

#define LAS __attribute__((address_space(3)))
typedef unsigned short bf16_t;
typedef short bf16x8 __attribute__((ext_vector_type(8)));
typedef short bf16x4 __attribute__((ext_vector_type(4)));
typedef float f32x4 __attribute__((ext_vector_type(4)));
typedef unsigned u32x4 __attribute__((ext_vector_type(4)));

constexpr int D = 1024, NB = 4, SEQ = 4096, CL = 256, TL = NB * SEQ, TC = NB * CL, T = TL + TC, DFF = 2816, INW = 2816, HYW = 3072;
constexpr int NMOD = 9;
constexpr float EPS = 1e-6f;
constexpr int NCH = 34;
constexpr int LDS_BYTES = 144 * 1024;

constexpr size_t SZ_WGU = (size_t)2 * DFF * D * 2, SZ_WD = (size_t)D * DFF * 2, SZ_WIN = (size_t)INW * D * 2, SZ_WOUT = (size_t)D * D * 2, SZ_HWIN = (size_t)HYW * D * 2;
constexpr size_t WS_WGU = 0;
constexpr size_t WS_WD = WS_WGU + 8 * SZ_WGU;
constexpr size_t WS_WIN = WS_WD + 8 * SZ_WD;
constexpr size_t WS_WOUT = WS_WIN + 2 * SZ_WIN;
constexpr size_t WS_HWIN = WS_WOUT + 2 * SZ_WOUT;
constexpr size_t WS_HWOUT = WS_HWIN + 2 * SZ_HWIN;
constexpr size_t WS_MOD = WS_HWOUT + 2 * SZ_WOUT;
constexpr size_t WS_ROPE = WS_MOD + (size_t)4 * 5 * NMOD * D * 4;
constexpr size_t WS_XC = WS_ROPE + (size_t)4 * SEQ * 32 * 4;
constexpr size_t WS_H = WS_XC + (size_t)TC * D * 4;
constexpr size_t WS_BIG = WS_H + (size_t)T * D * 2;
constexpr size_t WS_Y = WS_BIG + (size_t)T * HYW * 2;
constexpr size_t WS_MIX = WS_Y + (size_t)T * D * 4;
constexpr size_t SZ_ST = (size_t)NB * NCH * 8 * 4096 * 4;
constexpr size_t WS_ST = WS_MIX + (size_t)T * D * 2;
constexpr size_t SZ_KF = (size_t)(SEQ + CL) * 2 * D * 4;
constexpr size_t WS_KF = WS_ST + 4 * SZ_ST;
constexpr size_t WS_YP = WS_KF + 2 * SZ_KF;
constexpr size_t WS_BAR = WS_YP + (size_t)4 * TC * D * 4;
constexpr size_t WS_END = WS_BAR + 16384;

struct KP { const float* in[29]; float* out; unsigned char* ws; };
extern __shared__ __attribute__((aligned(16))) unsigned char g_smem[];
constexpr int PTAB_OFF = LDS_BYTES - 512;
__device__ __forceinline__ const float* pin_ld(int k) {
    const unsigned long long v = *(volatile LAS unsigned long long*)((LAS unsigned char*)g_smem + PTAB_OFF + 8 * k);
    const unsigned lo = __builtin_amdgcn_readfirstlane((unsigned)v), hi = __builtin_amdgcn_readfirstlane((unsigned)(v >> 32));
    return (const float*)(((unsigned long long)hi << 32) | lo);
}
struct KQ { float* out; unsigned char* ws; };
__device__ __forceinline__ KQ lq(KQ q) { asm volatile("" : "+s"(q.out), "+s"(q.ws)); return q; }

__device__ __forceinline__ bf16_t f2bf(float f) { unsigned u = __float_as_uint(f); u += 0x7FFFu + ((u >> 16) & 1u); return (bf16_t)(u >> 16); }
__device__ __forceinline__ float bf2f(bf16_t b) { return __uint_as_float(((unsigned)b) << 16); }
__device__ __forceinline__ float silu_f(float x) { return x * __builtin_amdgcn_rcpf(1.0f + __expf(-x)); }
__device__ __forceinline__ int ltid() { int t = threadIdx.x; asm volatile("" : "+v"(t)); return t; }
__device__ __forceinline__ float wave_sum(float v) {
#pragma unroll
    for (int o = 32; o > 0; o >>= 1) v += __shfl_xor(v, o, 64);
    return v;
}


#define XB_TMO      128
#define XB_XCNT(j)  (256  + 64 * (j))
#define XB_XSUB(j)  (1280 + 64 * (j))
#define XB_XGEN(j)  (2304 + 64 * (j))
#define XB_TOP      3328
#define XB_TOPGEN   3392
#define XCD_BAR_WORDS 3456
#define XB_SPIN_CAP (1u << 18)
__device__ __forceinline__ unsigned xb_ld(unsigned* p)              { return __hip_atomic_load(p, __ATOMIC_RELAXED, __HIP_MEMORY_SCOPE_AGENT); }
__device__ __forceinline__ unsigned xb_add(unsigned* p, unsigned v) { return __hip_atomic_fetch_add(p, v, __ATOMIC_RELAXED, __HIP_MEMORY_SCOPE_AGENT); }
__device__ __forceinline__ unsigned xb_xcc_id() { return (unsigned)__builtin_amdgcn_s_getreg((3 << 11) | 20) & 0xFu; }
#define XB_SPIN(cond, bar) do { unsigned _sp = 0; while (cond) { __builtin_amdgcn_s_sleep(1); \
    if ((++_sp & 255u) == 0u) { if (xb_ld(&(bar)[XB_TMO])) break; if (_sp > XB_SPIN_CAP) { atomicAdd(&(bar)[XB_TMO], 1u); break; } } } } while (0)
struct XcdBarrier { unsigned* bar; unsigned x; volatile LAS unsigned* st; };
__device__ __forceinline__ XcdBarrier xcd_barrier_post(unsigned* bar, volatile LAS unsigned* st) {
    XcdBarrier b; b.bar = bar; b.x = xb_xcc_id(); b.st = st;
    if (threadIdx.x == 0) (void)xb_add(&bar[XB_XCNT(b.x)], 1u);
    return b;
}
__device__ __forceinline__ void xcd_barrier_complete(unsigned* bar, unsigned x, unsigned& nloc, unsigned& nx) {
    const unsigned G = gridDim.x * gridDim.y * gridDim.z;
    unsigned sum, cnt, mine, sp = 0u;
    for (;;) {
        sum = 0u; cnt = 0u; mine = 0u;
#pragma unroll
        for (unsigned j = 0; j < 16; ++j) { const unsigned c = xb_ld(&bar[XB_XCNT(j)]); sum += c; cnt += (c > 0u) ? 1u : 0u; mine = (j == x) ? c : mine; }
        if (sum == G) break;
        __builtin_amdgcn_s_sleep(1);
        if ((++sp & 255u) == 0u) { if (xb_ld(&bar[XB_TMO])) break; if (sp > XB_SPIN_CAP) { atomicAdd(&bar[XB_TMO], 1u); break; } }
    }
    nloc = mine > 0u ? mine : 1u; nx = cnt > 0u ? cnt : 1u;
}
__device__ __forceinline__ void xcd_barrier_impl(unsigned* bar, volatile LAS unsigned* st) {
    asm volatile("s_waitcnt vmcnt(0)" ::: "memory");
    __syncthreads();
    if (ltid() == 0) {
        const unsigned x = xb_xcc_id();
        __builtin_amdgcn_s_waitcnt(0);
        unsigned nloc = st[0], nx = st[1];
        if (nloc == 0u) { xcd_barrier_complete(bar, x, nloc, nx); st[0] = nloc; st[1] = nx; }
        const unsigned old = xb_add(&bar[XB_XSUB(x)], 1u);
        const unsigned gen = old / nloc;
        if (old + 1u == (gen + 1u) * nloc) {
            __builtin_amdgcn_fence(__ATOMIC_RELEASE, "agent");
            asm volatile("s_waitcnt vmcnt(0)" ::: "memory");
            const unsigned og = xb_add(&bar[XB_TOP], 1u);
            const unsigned tg = og / nx;
            if (og + 1u == (tg + 1u) * nx) xb_add(&bar[XB_TOPGEN], 1u);
            else XB_SPIN(xb_ld(&bar[XB_TOPGEN]) == tg, bar);
            __builtin_amdgcn_fence(__ATOMIC_ACQUIRE, "agent");
            xb_add(&bar[XB_XGEN(x)], 1u);
            asm volatile("s_waitcnt vmcnt(0)" ::: "memory");
        } else {
            XB_SPIN(xb_ld(&bar[XB_XGEN(x)]) == gen, bar);
            __builtin_amdgcn_fence(__ATOMIC_ACQUIRE, "agent");
            asm volatile("s_waitcnt vmcnt(0)" ::: "memory");
        }
    }
    __syncthreads();
}
#define GRID_BAR() xcd_barrier_impl((unsigned*)(p.ws + WS_BAR), (volatile LAS unsigned*)((LAS unsigned char*)smem + LDS_BYTES - 16))

namespace pg8 {
constexpr int BM = 256, BK = 64, HALF = 128, HTB = HALF * BK * 2, STAGE_BYTES = 8 * HTB, NXCD = 8, WGM = 8;
__host__ __device__ __forceinline__ int lds_byte(int r, int c) { const int st = (r >> 4) * 2 + (c >> 5), rr = r & 15, cc = c & 31, ob = rr * 64 + cc * 2; return st * 1024 + (ob ^ (((ob >> 9) & 1) << 5)); }
__host__ __device__ __forceinline__ void stage_rc(int b, int& R, int& C) { const int st = b / 1024, sb = b % 1024, swz = sb ^ (((sb >> 9) & 1) << 5); R = (st >> 1) * 16 + swz / 64; C = (st & 1) * 32 + (swz % 64) / 2; }
__host__ __device__ __forceinline__ int perm32(int rho) { const int n = rho >> 4, i = rho & 15; return 8 * (i >> 2) + 4 * n + (i & 3); }
struct Unit { int pm, pn; };
struct Gemm { const bf16_t* A; const bf16_t* Bt; int M, N, K, ld; };
struct StaticOrder {
    int nM, nN, nwg, G, c;
    __device__ void init(int M, int N, int G_, int c_) { nM = M / BM; nN = N / BM; nwg = nM * nN; G = G_; c = c_; }
    __device__ bool next(int i, Unit& u) const {
        const long Lx = (long)i * G + c; if (Lx >= nwg) return false;
        int wgid = (int)Lx; { const int q = nwg / NXCD, r = nwg % NXCD, xcd = wgid % NXCD, off = wgid / NXCD; wgid = (xcd < r ? xcd * (q + 1) : r * (q + 1) + (xcd - r) * q) + off; }
        const int nig = WGM * nN, gid = wgid / nig, fm = gid * WGM, gsz = (nM - fm) < WGM ? (nM - fm) : WGM;
        u.pm = fm + ((wgid % nig) % gsz); u.pn = (wgid % nig) / gsz; return true;
    }
};
__device__ __forceinline__ unsigned cvt_pk_bf16(float lo, float hi) { unsigned r; asm volatile("v_cvt_pk_bf16_f32 %0, %1, %2" : "=v"(r) : "v"(lo), "v"(hi)); return r; }

struct EpiF32 {
    static constexpr bool PERM = false;
    float* C; int ldc;
    __device__ __forceinline__ void operator()(const f32x4 (&acc)[2][2][4][2], const Unit& u, int wr, int wc, int fr, int fq) const {
        const int row0 = u.pm * BM + wr * 64 + fr, col0 = u.pn * BM + wc * 32 + 4 * fq;
#pragma unroll
        for (int ai = 0; ai < 2; ++ai)
#pragma unroll
            for (int m = 0; m < 4; ++m) { float* rowp = C + (size_t)(row0 + ai * HALF + m * 16) * ldc + col0;
#pragma unroll
                for (int bj = 0; bj < 2; ++bj)
#pragma unroll
                    for (int n = 0; n < 2; ++n) *(f32x4*)(rowp + bj * HALF + n * 16) = acc[ai][bj][m][n]; }
    }
};
struct EpiBf16 {
    static constexpr bool PERM = true;
    bf16_t* O; int ldc; const float* bias;
    __device__ __forceinline__ void operator()(const f32x4 (&acc)[2][2][4][2], const Unit& u, int wr, int wc, int fr, int fq) const {
        const int row0 = u.pm * BM + wr * 64 + fr; const int col0 = u.pn * BM + wc * 32 + 8 * fq;
        f32x4 bv[2][2];
#pragma unroll
        for (int bj = 0; bj < 2; ++bj)
#pragma unroll
            for (int n = 0; n < 2; ++n) bv[bj][n] = bias ? *(const f32x4*)(bias + col0 + bj * HALF + 4 * n) : (f32x4){0.f, 0.f, 0.f, 0.f};
#pragma unroll
        for (int ai = 0; ai < 2; ++ai)
#pragma unroll
            for (int m = 0; m < 4; ++m) { bf16_t* rowp = O + (size_t)(row0 + ai * HALF + m * 16) * ldc + col0;
#pragma unroll
                for (int bj = 0; bj < 2; ++bj) { f32x4 v0 = acc[ai][bj][m][0] + bv[bj][0], v1 = acc[ai][bj][m][1] + bv[bj][1];
                    u32x4 w; w.x = cvt_pk_bf16(v0[0], v0[1]); w.y = cvt_pk_bf16(v0[2], v0[3]); w.z = cvt_pk_bf16(v1[0], v1[1]); w.w = cvt_pk_bf16(v1[2], v1[3]);
                    *(u32x4*)(rowp + bj * HALF) = w; } }
    }
};
struct EpiSwiGLU {
    static constexpr bool PERM = true;
    bf16_t* O; int ldc;
    __device__ __forceinline__ void operator()(const f32x4 (&acc)[2][2][4][2], const Unit& u, int wr, int wc, int fr, int fq) const {
        const int row0 = u.pm * BM + wr * 64 + fr; const int col0 = u.pn * HALF + wc * 32 + 8 * fq;
#pragma unroll
        for (int ai = 0; ai < 2; ++ai)
#pragma unroll
            for (int m = 0; m < 4; ++m) { bf16_t* rowp = O + (size_t)(row0 + ai * HALF + m * 16) * ldc + col0;
                float v[8];
#pragma unroll
                for (int n = 0; n < 2; ++n)
#pragma unroll
                    for (int j = 0; j < 4; ++j) { const float g = acc[ai][0][m][n][j], up = acc[ai][1][m][n][j]; v[n * 4 + j] = silu_f(g) * up; }
                u32x4 w; w.x = cvt_pk_bf16(v[0], v[1]); w.y = cvt_pk_bf16(v[2], v[3]); w.z = cvt_pk_bf16(v[4], v[5]); w.w = cvt_pk_bf16(v[6], v[7]);
                *(u32x4*)rowp = w; }
    }
};

template <class Epi, class Sched>
__device__ __forceinline__ void gemm_phase(LAS unsigned char* lds, const Gemm g, const Sched& S, const Epi& E) {
    const int tid = ltid(), wid = __builtin_amdgcn_readfirstlane(tid >> 6), lane = tid & 63, wr = wid >> 2, wc = wid & 3, fr = lane & 15, fq = lane >> 4;
    const int K = g.ld, nt = g.K / BK;
    unsigned voffA[2], voffB[2];
#pragma unroll
    for (int i = 0; i < 2; ++i) { int R, C; stage_rc(tid * 16 + i * 8192, R, C); const int Rb = Epi::PERM ? ((R & ~31) + perm32(R & 31)) : R;
        voffA[i] = (unsigned)(R * K + C) * 2u; voffB[i] = (unsigned)(Rb * K + C) * 2u; }
    const size_t kstep = (size_t)(BK * 2);
    const size_t hstep = (size_t)HALF * K * 2;
    const size_t tstep = 2 * hstep;
    const unsigned ldsw = (unsigned)wid * 1024u;
    const int aoff = lds_byte(wr * 64 + fr, fq * 8), boff = lds_byte(wc * 32 + fr, fq * 8);
#define PG8_SA(b, h) (((b) * 2 + (h)) * HTB)
#define PG8_SB(b, h) ((4 + (b) * 2 + (h)) * HTB)
#define PG8_STAGE(bufoff, gbase, voff) do { _Pragma("unroll") for (int _i = 0; _i < 2; ++_i) \
        __builtin_amdgcn_global_load_lds((const unsigned*)((const char*)(gbase) + (voff)[_i]), (LAS unsigned*)(lds + (bufoff) + ldsw + _i * 8192), 16, 0, 0); } while (0)
#define PG8_LDA(dst, b, h) do { _Pragma("unroll") for (int m = 0; m < 4; ++m) _Pragma("unroll") for (int k = 0; k < 2; ++k) dst[m][k] = *(const LAS bf16x8*)(lds + PG8_SA(b, h) + aoff + m * 2048 + k * 1024); } while (0)
#define PG8_LDB(dst, b, h) do { _Pragma("unroll") for (int n = 0; n < 2; ++n) _Pragma("unroll") for (int k = 0; k < 2; ++k) dst[n][k] = *(const LAS bf16x8*)(lds + PG8_SB(b, h) + boff + n * 2048 + k * 1024); } while (0)
#define PG8_MMA(ai, bj, At, Bt) do { __builtin_amdgcn_s_setprio(1); _Pragma("unroll") for (int m = 0; m < 4; ++m) _Pragma("unroll") for (int n = 0; n < 2; ++n) _Pragma("unroll") for (int k = 0; k < 2; ++k) \
        acc[ai][bj][m][n] = __builtin_amdgcn_mfma_f32_16x16x32_bf16(Bt[n][k], At[m][k], acc[ai][bj][m][n], 0, 0, 0); __builtin_amdgcn_s_setprio(0); } while (0)
#define PG8_WAIT_V(n) asm volatile("s_waitcnt vmcnt(" #n ")" ::: "memory")
#define PG8_WAIT_L(n) asm volatile("s_waitcnt lgkmcnt(" #n ")" ::: "memory")
#define PG8_BAR __builtin_amdgcn_s_barrier()
#define PG8_SCHED __builtin_amdgcn_sched_barrier(0)
    Unit cur, nxt; int ui = 0;
    if (!S.next(0, cur)) return;
    f32x4 acc[2][2][4][2];
#pragma unroll
    for (int a = 0; a < 2; ++a)
#pragma unroll
        for (int b = 0; b < 2; ++b)
#pragma unroll
            for (int m = 0; m < 4; ++m)
#pragma unroll
                for (int n = 0; n < 2; ++n) acc[a][b][m][n] = (f32x4){0.f, 0.f, 0.f, 0.f};
    bf16x8 At[4][2], B0[2][2], B1[2][2];
    const char* cA = (const char*)g.A + (size_t)cur.pm * tstep; const char* cB = (const char*)g.Bt + (size_t)cur.pn * tstep;
    PG8_STAGE(PG8_SB(0, 0), cB, voffB); PG8_STAGE(PG8_SA(0, 0), cA, voffA); PG8_STAGE(PG8_SB(0, 1), cB + hstep, voffB); PG8_STAGE(PG8_SA(0, 1), cA + hstep, voffA);
    if (wr == 1) PG8_BAR;
    PG8_WAIT_V(4); PG8_BAR;
    PG8_STAGE(PG8_SB(1, 0), cB + kstep, voffB); PG8_STAGE(PG8_SA(1, 0), cA + kstep, voffA); PG8_STAGE(PG8_SB(1, 1), cB + hstep + kstep, voffB);
    PG8_WAIT_V(6); PG8_BAR;
    for (;;) {
        const bool has_next = S.next(ui + 1, nxt);
        const char* nA = has_next ? (const char*)g.A + (size_t)nxt.pm * tstep : cA; const char* nB = has_next ? (const char*)g.Bt + (size_t)nxt.pn * tstep : cB;
        for (int t = 0; t < nt; t += 2) {
            const bool last = (t == nt - 2);
            const char* a1 = cA + (size_t)(t + 1) * kstep;
            const char* a2 = last ? nA : cA + (size_t)(t + 2) * kstep; const char* b2 = last ? nB : cB + (size_t)(t + 2) * kstep;
            const char* a3 = a2 + kstep; const char* b3 = b2 + kstep;
            PG8_LDB(B0, 0, 0); PG8_SCHED; PG8_LDA(At, 0, 0); PG8_STAGE(PG8_SA(1, 1), a1 + hstep, voffA);
            PG8_WAIT_L(8); PG8_BAR; PG8_WAIT_L(0); PG8_MMA(0, 0, At, B0); PG8_BAR; PG8_SCHED;
            PG8_LDB(B1, 0, 1); PG8_STAGE(PG8_SB(0, 0), b2, voffB);
            PG8_BAR; PG8_WAIT_L(0); PG8_MMA(0, 1, At, B1); PG8_BAR;
            PG8_LDA(At, 0, 1); PG8_STAGE(PG8_SA(0, 0), a2, voffA);
            PG8_BAR; PG8_WAIT_L(0); PG8_MMA(1, 0, At, B0); PG8_BAR; PG8_SCHED;
            PG8_STAGE(PG8_SB(0, 1), b2 + hstep, voffB);
            PG8_WAIT_V(6); PG8_BAR; PG8_MMA(1, 1, At, B1); PG8_BAR;
            PG8_LDB(B0, 1, 0); PG8_SCHED; PG8_LDA(At, 1, 0); PG8_STAGE(PG8_SA(0, 1), a2 + hstep, voffA);
            PG8_WAIT_L(8); PG8_BAR; PG8_WAIT_L(0); PG8_MMA(0, 0, At, B0); PG8_BAR; PG8_SCHED;
            PG8_LDB(B1, 1, 1); PG8_STAGE(PG8_SB(1, 0), b3, voffB);
            PG8_BAR; PG8_WAIT_L(0); PG8_MMA(0, 1, At, B1); PG8_BAR;
            PG8_LDA(At, 1, 1); PG8_STAGE(PG8_SA(1, 0), a3, voffA);
            PG8_BAR; PG8_WAIT_L(0); PG8_MMA(1, 0, At, B0); PG8_BAR; PG8_SCHED;
            PG8_STAGE(PG8_SB(1, 1), b3 + hstep, voffB);
            PG8_WAIT_V(6); PG8_BAR; PG8_MMA(1, 1, At, B1); PG8_BAR;
        }
        E(acc, cur, wr, wc, fr, fq);
        if (!has_next) break;
#pragma unroll
        for (int a = 0; a < 2; ++a)
#pragma unroll
            for (int b = 0; b < 2; ++b)
#pragma unroll
                for (int m = 0; m < 4; ++m)
#pragma unroll
                    for (int n = 0; n < 2; ++n) acc[a][b][m][n] = (f32x4){0.f, 0.f, 0.f, 0.f};
        cur = nxt; cA = nA; cB = nB; ++ui;
    }
    PG8_WAIT_V(0);
    if (wr == 0) PG8_BAR;
    PG8_BAR;
#undef PG8_SA
#undef PG8_SB
#undef PG8_STAGE
#undef PG8_LDA
#undef PG8_LDB
#undef PG8_MMA
#undef PG8_WAIT_V
#undef PG8_WAIT_L
#undef PG8_BAR
#undef PG8_SCHED
}
}

template <class Epi>
__device__ __forceinline__ void run_gemm(unsigned char* smem, const bf16_t* A, const bf16_t* Bt, int M, int N, int K, const Epi& E) {
    pg8::Gemm g{A, Bt, M, N, K, K}; pg8::StaticOrder S; S.init(M, N, (int)gridDim.x, (int)blockIdx.x);
    pg8::gemm_phase<Epi, pg8::StaticOrder>((LAS unsigned char*)smem, g, S, E);
}
__device__ __forceinline__ void run_gemm_f32_split(unsigned char* smem, const bf16_t* A, const bf16_t* Bt, int M, int K, bf16_t* Yo, float* YP) {
    { pg8::Gemm g{A, Bt, TL, D, K, K}; pg8::StaticOrder S; S.init(TL, D, (int)gridDim.x, (int)blockIdx.x); pg8::EpiBf16 E{Yo, D, nullptr};
      pg8::gemm_phase<pg8::EpiBf16, pg8::StaticOrder>((LAS unsigned char*)smem, g, S, E); }
    __syncthreads();
    if (M > TL && blockIdx.x < 64) {
        const int ks = blockIdx.x >> 4;
        int koff, klen;
        if (K == DFF) { koff = (ks < 2) ? ks * 768 : 1536 + (ks - 2) * 640; klen = (ks < 2) ? 768 : 640; }
        else { klen = K / 4; koff = ks * klen; }
        pg8::Gemm g{A + (size_t)TL * K + koff, Bt + koff, TC, D, klen, K}; pg8::StaticOrder S; S.init(TC, D, 16, (int)(blockIdx.x & 15)); pg8::EpiF32 E{YP + (size_t)ks * TC * D, D};
        pg8::gemm_phase<pg8::EpiF32, pg8::StaticOrder>((LAS unsigned char*)smem, g, S, E);
        __syncthreads();
    }
}

__device__ __forceinline__ float* xrow(const KQ p, int t) { return t < TL ? p.out + (size_t)t * D : (float*)(p.ws + WS_XC) + (size_t)(t - TL) * D; }
__device__ __forceinline__ int modrow(int t) { return t < TL ? (t >> 12) : 4; }
__device__ __forceinline__ const float* modp(const KQ p, int l, int mr, int idx) { return (const float*)(p.ws + WS_MOD) + ((size_t)(l * 5 + mr) * NMOD + idx) * D; }

__device__ __forceinline__ void p0_setup(const KQ p_in, float* sm) {
    const KQ p = lq(p_in);
    const int tid = ltid(), bid = blockIdx.x, nb = gridDim.x;
    const int gtid = bid * 512 + tid, gthreads = nb * 512;
    {
        float* rope = (float*)(p.ws + WS_ROPE);
        for (int idx = gtid; idx < SEQ * 32; idx += gthreads) {
            const int t = idx >> 5, i = idx & 31;
            const int ii = i & 15; const float pos = (i < 16) ? (float)(t >> 6) : (float)(t & 63);
            const float invA = powf(10000.0f, -(float)ii / 16.0f);
            const float angA = pos * invA;
            rope[idx] = cosf(angA); rope[SEQ * 32 + idx] = sinf(angA);
            const float ex = (float)i * (1.0f / 31.0f);
            const float invR = powf(10000.0f, -ex);
            const float angR = (float)t * invR;
            rope[2 * SEQ * 32 + idx] = cosf(angR); rope[3 * SEQ * 32 + idx] = sinf(angR);
        }
    }
    {
        float* tile = sm;
        for (int g = bid; g < 20864; g += nb) {
            int j, tl;
            if (g < 16896) { j = g / 704; tl = g % 704; }
            else if (g < 18304) { j = 24 + (g - 16896) / 704; tl = (g - 16896) % 704; }
            else if (g < 18816) { j = 26 + (g - 18304) / 256; tl = (g - 18304) % 256; }
            else if (g < 20352) { j = 28 + (g - 18816) / 768; tl = (g - 18816) % 768; }
            else { j = 30 + (g - 20352) / 256; tl = (g - 20352) % 256; }
            const float* src; bf16_t* dst; int K, N, mode = 0;
            if (j < 8) { src = pin_ld(8) + (size_t)j * D * DFF; dst = (bf16_t*)(p.ws + WS_WGU + (size_t)j * SZ_WGU); K = D; N = DFF; mode = 1; }
            else if (j < 16) { src = pin_ld(9) + (size_t)(j - 8) * D * DFF; dst = (bf16_t*)(p.ws + WS_WGU + (size_t)(j - 8) * SZ_WGU); K = D; N = DFF; mode = 2; }
            else if (j < 24) { src = pin_ld(10) + (size_t)(j - 16) * DFF * D; dst = (bf16_t*)(p.ws + WS_WD + (size_t)(j - 16) * SZ_WD); K = DFF; N = D; }
            else if (j < 26) { src = pin_ld(11) + (size_t)(j - 24) * D * INW; dst = (bf16_t*)(p.ws + WS_WIN + (size_t)(j - 24) * SZ_WIN); K = D; N = INW; mode = 3; }
            else if (j < 28) { src = pin_ld(14) + (size_t)(j - 26) * D * D; dst = (bf16_t*)(p.ws + WS_WOUT + (size_t)(j - 26) * SZ_WOUT); K = D; N = D; }
            else if (j < 30) { src = pin_ld(15) + (size_t)(j - 28) * D * HYW; dst = (bf16_t*)(p.ws + WS_HWIN + (size_t)(j - 28) * SZ_HWIN); K = D; N = HYW; }
            else { src = pin_ld(28) + (size_t)(j - 30) * D * D; dst = (bf16_t*)(p.ws + WS_HWOUT + (size_t)(j - 30) * SZ_WOUT); K = D; N = D; }
            const int ntn = N / 64; const int k0 = (tl / ntn) * 64, n0 = (tl % ntn) * 64;
            __syncthreads();
#pragma unroll
            for (int i = 0; i < 2; ++i) { const int k = i * 32 + (tid >> 4), n4 = (tid & 15) * 4; const float4 v = *(const float4*)(src + (size_t)(k0 + k) * N + n0 + n4);
                tile[k * 65 + n4] = v.x; tile[k * 65 + n4 + 1] = v.y; tile[k * 65 + n4 + 2] = v.z; tile[k * 65 + n4 + 3] = v.w; }
            __syncthreads();
            {
                const int n = tid >> 3, k8 = (tid & 7) * 8; const int gn = n0 + n;
                float sc_ = 1.0f; int row = gn;
                if (mode == 1) row = 256 * (gn >> 7) + (gn & 127);
                else if (mode == 2) row = 256 * (gn >> 7) + 128 + (gn & 127);
                else if (mode == 3) { if (gn < 512 || (gn >= 1792 && gn < 2304)) sc_ = 0.125f; }
                float v[8];
#pragma unroll
                for (int j = 0; j < 8; ++j) v[j] = tile[(k8 + j) * 65 + n] * sc_;
                u32x4 o4; o4.x = pg8::cvt_pk_bf16(v[0], v[1]); o4.y = pg8::cvt_pk_bf16(v[2], v[3]); o4.z = pg8::cvt_pk_bf16(v[4], v[5]); o4.w = pg8::cvt_pk_bf16(v[6], v[7]);
                *(u32x4*)(dst + (size_t)row * K + k0 + k8) = o4;
            }
        }
        __syncthreads();
    }
    {
        float* sc = sm;
        float* red = sm + 5 * 1024;
        for (int i = tid; i < 5 * 1024; i += 512) { const int r = i >> 10, k = i & 1023; const float v = (r < 4) ? pin_ld(1)[r * D + k] : pin_ld(3)[k]; sc[i] = silu_f(v); }
        __syncthreads();
        const int w = tid >> 6, lane = tid & 63;
        for (int it = bid; it < 288; it += nb) {
            const int l = it / 72, c0 = (it % 72) * 128;
            const float* wm = pin_ld(4) + (size_t)l * D * (NMOD * D) + c0 + 2 * lane;
            float a[5][2];
#pragma unroll
            for (int r = 0; r < 5; ++r) { a[r][0] = 0.f; a[r][1] = 0.f; }
            for (int kb = w * 128; kb < w * 128 + 128; kb += 16) {
                float2 wv[16];
#pragma unroll
                for (int q = 0; q < 16; ++q) wv[q] = *(const float2*)(wm + (size_t)(kb + q) * (NMOD * D));
#pragma unroll
                for (int q = 0; q < 16; ++q)
#pragma unroll
                    for (int r = 0; r < 5; ++r) { const float s = sc[r * 1024 + kb + q]; a[r][0] += s * wv[q].x; a[r][1] += s * wv[q].y; }
            }
#pragma unroll
            for (int r = 0; r < 5; ++r) { red[(w * 5 + r) * 128 + 2 * lane] = a[r][0]; red[(w * 5 + r) * 128 + 2 * lane + 1] = a[r][1]; }
            __syncthreads();
            for (int i = tid; i < 5 * 128; i += 512) {
                const int r = i >> 7, c = i & 127; float s = 0.f;
#pragma unroll
                for (int ww = 0; ww < 8; ++ww) s += red[(ww * 5 + r) * 128 + c];
                s += pin_ld(5)[(size_t)l * (NMOD * D) + c0 + c];
                ((float*)(p.ws + WS_MOD))[(size_t)(l * 5 + r) * (NMOD * D) + c0 + c] = s;
            }
            __syncthreads();
        }
    }
    {
        float* z = sm;
        float* a1 = sm + 16 * 36;
        float* a2 = a1 + 16 * 64;
        float* a3 = a2 + 16 * 64;
        float* tl = a3 + 16 * 64;
        float* wl = tl + 16;
        const float HMAX = -4.605170185988091f / 0.3f, HMIN = -4.605170185988091f / 1.5f;
        int o_loaded = -1;
        for (int it = nb - 1 - bid; it < 544; it += nb) {
            const int o = it / 272, r = it % 272;
            const int Lf = (r < 256) ? SEQ : CL; const int p0 = (r < 256) ? r * 16 : (r - 256) * 16;
            float* kf = (float*)(p.ws + WS_KF + (size_t)o * SZ_KF) + ((r < 256) ? (size_t)0 : (size_t)2 * SEQ * D);
            const float* f3 = pin_ld(25) + (size_t)o * 64 * 2048;
            __syncthreads();
            if (o != o_loaded) {
                const float* f0 = pin_ld(19) + (size_t)o * 33 * 64; const float* f1 = pin_ld(21) + (size_t)o * 64 * 64; const float* f2 = pin_ld(23) + (size_t)o * 64 * 64;
                for (int i = tid; i < 33 * 64; i += 512) wl[i] = f0[i];
                for (int i = tid; i < 64 * 64; i += 512) { wl[2112 + i] = f1[i]; wl[2112 + 4096 + i] = f2[i]; }
                if (tid < 64) { wl[10304 + tid] = pin_ld(20)[o * 64 + tid]; wl[10304 + 64 + tid] = pin_ld(22)[o * 64 + tid]; wl[10304 + 128 + tid] = pin_ld(24)[o * 64 + tid]; wl[10304 + 192 + tid] = pin_ld(26)[o * 64 + tid]; }
                o_loaded = o;
            }
            const float* f0 = wl; const float* f1 = wl + 2112; const float* f2 = wl + 2112 + 4096;
            const float* fb0 = wl + 10304; const float* fb1 = fb0 + 64; const float* fb2 = fb0 + 128; const float* fq = fb0 + 192;
            for (int idx = tid; idx < 16 * 33; idx += 512) {
                const int ps = idx / 33, f = idx % 33; const int i = p0 + ps;
                const float tlin = (float)i * (1.0f / (float)(Lf - 1));
                const float w = (6.283185307179586f * (float)i) / (float)Lf;
                float v;
                if (f == 0) { v = tlin; tl[ps] = tlin; }
                else { const int jj = (f - 1) & 15; const float fj = 1e-4f + (float)jj * ((15.0f - 1e-4f) / 15.0f); v = (f <= 16) ? cosf(fj * w) : -sinf(fj * w); }
                z[ps * 36 + f] = v;
            }
            __syncthreads();
            for (int idx = tid; idx < 16 * 64; idx += 512) { const int ps = idx >> 6, oc = idx & 63; float s = fb0[oc];
                for (int f = 0; f < 33; ++f) s += z[ps * 36 + f] * f0[f * 64 + oc];
                a1[idx] = sinf(fq[oc] * s); }
            __syncthreads();
            for (int idx = tid; idx < 16 * 64; idx += 512) { const int ps = idx >> 6, oc = idx & 63; float s = fb1[oc];
                for (int f = 0; f < 64; ++f) s += a1[ps * 64 + f] * f1[f * 64 + oc];
                a2[idx] = sinf(fq[oc] * s); }
            __syncthreads();
            for (int idx = tid; idx < 16 * 64; idx += 512) { const int ps = idx >> 6, oc = idx & 63; float s = fb2[oc];
                for (int f = 0; f < 64; ++f) s += a2[ps * 64 + f] * f2[f * 64 + oc];
                a3[idx] = sinf(fq[oc] * s); }
            __syncthreads();
            for (int q = 0; q < 4; ++q) {
                const int c = tid + 512 * q; const int dir = c >> 10, d = c & 1023;
                float acc[16];
#pragma unroll
                for (int ps = 0; ps < 16; ++ps) acc[ps] = 0.f;
                for (int fb = 0; fb < 64; fb += 16) {
                    float wv[16];
#pragma unroll
                    for (int f = 0; f < 16; ++f) wv[f] = f3[(fb + f) * 2048 + c];
#pragma unroll
                    for (int f = 0; f < 16; ++f)
#pragma unroll
                        for (int ps = 0; ps < 16; ++ps) acc[ps] += a3[ps * 64 + fb + f] * wv[f];
                }
                const float delta = fabsf(HMIN + (float)d * ((HMAX - HMIN) / 1023.0f));
#pragma unroll
                for (int ps = 0; ps < 16; ++ps) {
                    const float kvv = acc[ps] * expf(-tl[ps] * delta);
                    if (r < 256) {
                        bf16_t* rk = (bf16_t*)(p.ws + WS_KF + (size_t)o * SZ_KF) + (size_t)d * 8192;
                        const int m = p0 + ps;
                        if (dir == 0) rk[4095 - m] = f2bf(kvv); else if (m > 0) rk[4095 + m] = f2bf(kvv);
                        if (dir == 0 && m == 0) rk[8191] = 0;
                    } else kf[((size_t)dir * Lf + p0 + ps) * D + d] = kvv;
                }
            }
        }
        __syncthreads();
    }
}

__device__ __forceinline__ void rowphase(const KQ p_in, int Mupd, const bf16_t* Y, int lu, int gidx, float wgt, const float* gpost,
                         int Mnext, int ln, const float* gpre, int shidx, int scidx, bf16_t* Hout, bool from_input) {
    const KQ p = lq(p_in);
    const int tid = ltid(), w = tid >> 6, lane = tid & 63;
    const int Mmax = Mupd > Mnext ? Mupd : Mnext;
    for (int t = (blockIdx.x * 8 + w) * 2; t < Mmax; t += gridDim.x * 16) {
        float* xr = xrow(p, t); const int mr = modrow(t);
        const float* xs = xr;
        if (from_input) xs = (t < TL) ? pin_ld(0) + (size_t)t * D : pin_ld(2) + (size_t)(t - TL) * D;
        float4 xv[2][4];
#pragma unroll
        for (int rr = 0; rr < 2; ++rr)
#pragma unroll
            for (int q = 0; q < 4; ++q) xv[rr][q] = *(const float4*)(xs + rr * D + q * 256 + lane * 4);
        if (Y != nullptr && t < Mupd) {
            float4 yv[2][4]; float ss[2] = {0.f, 0.f};
#pragma unroll
            for (int rr = 0; rr < 2; ++rr)
#pragma unroll
                for (int q = 0; q < 4; ++q) {
                    if (t < TL) { const bf16x4 yb = *(const bf16x4*)(Y + (size_t)(t + rr) * D + q * 256 + lane * 4);
                        yv[rr][q] = make_float4(bf2f((bf16_t)yb[0]), bf2f((bf16_t)yb[1]), bf2f((bf16_t)yb[2]), bf2f((bf16_t)yb[3])); }
                    else { const float* yp = (const float*)(p.ws + WS_YP) + (size_t)(t + rr - TL) * D + q * 256 + lane * 4;
                        const float4 a0 = *(const float4*)yp, a1 = *(const float4*)(yp + (size_t)TC * D), a2 = *(const float4*)(yp + (size_t)2 * TC * D), a3 = *(const float4*)(yp + (size_t)3 * TC * D);
                        yv[rr][q] = make_float4(a0.x + a1.x + a2.x + a3.x, a0.y + a1.y + a2.y + a3.y, a0.z + a1.z + a2.z + a3.z, a0.w + a1.w + a2.w + a3.w); }
                    ss[rr] += yv[rr][q].x * yv[rr][q].x + yv[rr][q].y * yv[rr][q].y + yv[rr][q].z * yv[rr][q].z + yv[rr][q].w * yv[rr][q].w; }
            ss[0] = wave_sum(ss[0]); ss[1] = wave_sum(ss[1]);
            float wgl = wgt; asm volatile("" : "+v"(wgl));
            const float r0 = rsqrtf(ss[0] * (1.0f / D) + EPS) * wgl, r1 = rsqrtf(ss[1] * (1.0f / D) + EPS) * wgl;
            const float* gm = modp(p, lu, mr, gidx);
#pragma unroll
            for (int q = 0; q < 4; ++q) {
                const float4 g4 = *(const float4*)(gm + q * 256 + lane * 4); const float4 p4 = *(const float4*)(gpost + q * 256 + lane * 4);
                const float cx = g4.x * p4.x, cy = g4.y * p4.y, cz = g4.z * p4.z, cw = g4.w * p4.w;
                xv[0][q].x += r0 * cx * yv[0][q].x; xv[0][q].y += r0 * cy * yv[0][q].y; xv[0][q].z += r0 * cz * yv[0][q].z; xv[0][q].w += r0 * cw * yv[0][q].w;
                xv[1][q].x += r1 * cx * yv[1][q].x; xv[1][q].y += r1 * cy * yv[1][q].y; xv[1][q].z += r1 * cz * yv[1][q].z; xv[1][q].w += r1 * cw * yv[1][q].w;
                *(float4*)(xr + q * 256 + lane * 4) = xv[0][q]; *(float4*)(xr + D + q * 256 + lane * 4) = xv[1][q];
            }
        }
        if (Hout != nullptr && t < Mnext) {
            float ss[2] = {0.f, 0.f};
#pragma unroll
            for (int rr = 0; rr < 2; ++rr)
#pragma unroll
                for (int q = 0; q < 4; ++q) ss[rr] += xv[rr][q].x * xv[rr][q].x + xv[rr][q].y * xv[rr][q].y + xv[rr][q].z * xv[rr][q].z + xv[rr][q].w * xv[rr][q].w;
            ss[0] = wave_sum(ss[0]); ss[1] = wave_sum(ss[1]);
            const float rn[2] = {rsqrtf(ss[0] * (1.0f / D) + EPS), rsqrtf(ss[1] * (1.0f / D) + EPS)};
            const float* sh = modp(p, ln, mr, shidx); const float* sc = modp(p, ln, mr, scidx);
#pragma unroll
            for (int q = 0; q < 4; ++q) {
                const float4 g4 = *(const float4*)(gpre + q * 256 + lane * 4); const float4 s4 = *(const float4*)(sc + q * 256 + lane * 4); const float4 h4 = *(const float4*)(sh + q * 256 + lane * 4);
                const float mx_ = g4.x * (1.0f + s4.x), my_ = g4.y * (1.0f + s4.y), mz_ = g4.z * (1.0f + s4.z), mw_ = g4.w * (1.0f + s4.w);
#pragma unroll
                for (int rr = 0; rr < 2; ++rr) {
                    const float h0 = xv[rr][q].x * rn[rr] * mx_ + h4.x, h1 = xv[rr][q].y * rn[rr] * my_ + h4.y;
                    const float h2 = xv[rr][q].z * rn[rr] * mz_ + h4.z, h3 = xv[rr][q].w * rn[rr] * mw_ + h4.w;
                    uint2 pk; pk.x = pg8::cvt_pk_bf16(h0, h1); pk.y = pg8::cvt_pk_bf16(h2, h3);
                    *(uint2*)(Hout + (size_t)(t + rr) * D + q * 256 + lane * 4) = pk;
                }
            }
        }
    }
}

__device__ __forceinline__ float log_sigmoid(float x) { return -log1pf(expf(-x)); }
__device__ __forceinline__ int chunk_t0(int b, int cidx) { return cidx < 32 ? b * SEQ + cidx * 128 : TL + b * CL + (cidx - 32) * 128; }

__device__ __forceinline__ void m1_rope_states(const KQ p_in, int e, float* sm) {
    const KQ p = lq(p_in);
    const int tid = ltid(), bid = blockIdx.x, nb = gridDim.x;
    bf16_t* Z = (bf16_t*)(p.ws + WS_BIG);
    const float* rope = (const float*)(p.ws + WS_ROPE);
    for (int idx = bid * 512 + tid; idx < TL * 72; idx += nb * 512) {
        const int t = idx / 72, r = idx % 72; const int hd = r >> 2, i0 = (r & 3) * 8;
        const int cb = hd < 16 ? hd * 64 : 1536 + (hd - 16) * 64;
        const int tb = (hd >= 8 && hd < 16) ? 2 : 0; const int pos = t & (SEQ - 1);
        const float* cp = rope + (size_t)tb * SEQ * 32 + pos * 32 + i0; const float* sp = cp + (size_t)SEQ * 32;
        bf16_t* zp = Z + (size_t)t * INW + cb + i0;
        const bf16x8 a1 = *(const bf16x8*)zp, a2 = *(const bf16x8*)(zp + 32);
        const float4 c0 = *(const float4*)cp, c1 = *(const float4*)(cp + 4), s0 = *(const float4*)sp, s1 = *(const float4*)(sp + 4);
        const float cc[8] = {c0.x, c0.y, c0.z, c0.w, c1.x, c1.y, c1.z, c1.w}, sn[8] = {s0.x, s0.y, s0.z, s0.w, s1.x, s1.y, s1.z, s1.w};
        float o1[8], o2[8];
#pragma unroll
        for (int j = 0; j < 8; ++j) { const float x1 = bf2f((bf16_t)a1[j]), x2 = bf2f((bf16_t)a2[j]); o1[j] = x1 * cc[j] - x2 * sn[j]; o2[j] = x1 * sn[j] + x2 * cc[j]; }
        u32x4 w1, w2;
        w1.x = pg8::cvt_pk_bf16(o1[0], o1[1]); w1.y = pg8::cvt_pk_bf16(o1[2], o1[3]); w1.z = pg8::cvt_pk_bf16(o1[4], o1[5]); w1.w = pg8::cvt_pk_bf16(o1[6], o1[7]);
        w2.x = pg8::cvt_pk_bf16(o2[0], o2[1]); w2.y = pg8::cvt_pk_bf16(o2[2], o2[3]); w2.z = pg8::cvt_pk_bf16(o2[4], o2[5]); w2.w = pg8::cvt_pk_bf16(o2[6], o2[7]);
        *(u32x4*)zp = w1; *(u32x4*)(zp + 32) = w2;
    }
    float* Ks = sm;
    float* Vs = sm + 128 * 64;
    float* wf = Vs + 128 * 64;
    float* wb = wf + 128;
    float* AF = (float*)(p.ws + WS_ST); float* AB = AF + SZ_ST / 4;
    const float* dec = pin_ld(13) + e * 16;
    for (int it = bid; it < NB * NCH * 8; it += nb) {
        const int h = it & 7, cidx = (it >> 3) % NCH, b = it / (8 * NCH);
        const int t0 = chunk_t0(b, cidx); const bool lat = cidx < 32;
        const float lgf = log_sigmoid(dec[h]), lgb = log_sigmoid(dec[8 + h]);
        __syncthreads();
        if (tid < 128) { wf[tid] = expf(lgf * (float)(127 - tid)); wb[tid] = expf(lgb * (float)tid); }
        const int kc = 1792 + h * 64, vc = 2304 + h * 64;
#pragma unroll
        for (int q = 0; q < 8; ++q) {
            const int idx = tid + 512 * q; const int r = idx >> 5, i = idx & 31;
            bf16_t* zp = Z + (size_t)(t0 + r) * INW + kc + i;
            float x1 = bf2f(zp[0]), x2 = bf2f(zp[32]);
            if (lat) {
                const int pos = (t0 + r) & (SEQ - 1);
                const float c = rope[(size_t)2 * SEQ * 32 + pos * 32 + i], s = rope[(size_t)3 * SEQ * 32 + pos * 32 + i];
                const bf16_t o1 = f2bf(x1 * c - x2 * s), o2 = f2bf(x1 * s + x2 * c);
                zp[0] = o1; zp[32] = o2; x1 = bf2f(o1); x2 = bf2f(o2);
            }
            Ks[r * 64 + i] = x1; Ks[r * 64 + 32 + i] = x2;
        }
#pragma unroll
        for (int q = 0; q < 16; ++q) { const int idx = tid + 512 * q; const int r = idx >> 6, c = idx & 63; Vs[idx] = bf2f(Z[(size_t)(t0 + r) * INW + vc + c]); }
        __syncthreads();
        const int d = tid >> 3, e0 = (tid & 7) * 8;
        float af[8], ab[8];
#pragma unroll
        for (int j = 0; j < 8; ++j) { af[j] = 0.f; ab[j] = 0.f; }
        for (int s = 0; s < 128; ++s) {
            const float kv = Ks[s * 64 + d]; const float kfw = kv * wf[s], kbw = kv * wb[s];
            const float4 v0 = *(const float4*)(Vs + s * 64 + e0), v1 = *(const float4*)(Vs + s * 64 + e0 + 4);
            af[0] += kfw * v0.x; af[1] += kfw * v0.y; af[2] += kfw * v0.z; af[3] += kfw * v0.w; af[4] += kfw * v1.x; af[5] += kfw * v1.y; af[6] += kfw * v1.z; af[7] += kfw * v1.w;
            ab[0] += kbw * v0.x; ab[1] += kbw * v0.y; ab[2] += kbw * v0.z; ab[3] += kbw * v0.w; ab[4] += kbw * v1.x; ab[5] += kbw * v1.y; ab[6] += kbw * v1.z; ab[7] += kbw * v1.w;
        }
        const size_t so = ((size_t)(b * NCH + cidx) * 8 + h) * 4096 + d * 64 + e0;
        *(float4*)(AF + so) = make_float4(af[0], af[1], af[2], af[3]); *(float4*)(AF + so + 4) = make_float4(af[4], af[5], af[6], af[7]);
        *(float4*)(AB + so) = make_float4(ab[0], ab[1], ab[2], ab[3]); *(float4*)(AB + so + 4) = make_float4(ab[4], ab[5], ab[6], ab[7]);
    }
    __syncthreads();
}

__device__ __forceinline__ void m2_scan(const KQ p_in, int e) {
    const KQ p = lq(p_in);
    const float* __restrict__ AF = (const float*)(p.ws + WS_ST); const float* __restrict__ AB = AF + SZ_ST / 4;
    float* __restrict__ TF = (float*)(p.ws + WS_ST) + 2 * (SZ_ST / 4); float* __restrict__ TB = TF + SZ_ST / 4;
    const float* dec = pin_ld(13) + e * 16;
    for (int idx = blockIdx.x * 512 + ltid(); idx < NB * 8 * 4096; idx += gridDim.x * 512) {
        const int el = idx & 4095, h = (idx >> 12) & 7, b = idx >> 15;
        const float gf = expf(log_sigmoid(dec[h]) * 128.0f), gb = expf(log_sigmoid(dec[8 + h]) * 128.0f);
        const size_t base = ((size_t)(b * NCH) * 8 + h) * 4096 + el; constexpr size_t CS = (size_t)8 * 4096;
        float af[NCH], ab[NCH];
#pragma unroll
        for (int c = 0; c < NCH; ++c) { af[c] = AF[base + c * CS]; ab[c] = AB[base + c * CS]; }
        TF[base + 32 * CS] = 0.f; TF[base + 33 * CS] = af[32]; TB[base + 33 * CS] = 0.f; TB[base + 32 * CS] = ab[33];
        float sf = gf * af[32] + af[33], sb = ab[32] + gb * ab[33];
#pragma unroll
        for (int c = 0; c < 32; ++c) { TF[base + c * CS] = sf; sf = gf * sf + af[c]; }
#pragma unroll
        for (int c = 31; c >= 0; --c) { TB[base + c * CS] = sb; sb = ab[c] + gb * sb; }
    }
}

__device__ __forceinline__ bf16x8 pack8(const f32x4& a, const f32x4& b) {
    u32x4 w; w.x = pg8::cvt_pk_bf16(a[0], a[1]); w.y = pg8::cvt_pk_bf16(a[2], a[3]); w.z = pg8::cvt_pk_bf16(b[0], b[1]); w.w = pg8::cvt_pk_bf16(b[2], b[3]);
    return __builtin_bit_cast(bf16x8, w);
}
__device__ __forceinline__ void m3_outputs(const KQ p_in, int e, bool ctx_full, unsigned char* smem) {
    const KQ p = lq(p_in);
    const int tid = ltid(), bid = blockIdx.x, nb = gridDim.x;
    const int w = tid >> 6, lane = tid & 63, ln = lane & 15, g4 = lane >> 4;
    const bf16_t* Z = (const bf16_t*)(p.ws + WS_BIG);
    bf16_t* MIX = (bf16_t*)(p.ws + WS_MIX);
    const float* dec = pin_ld(13) + e * 16;
    const float* sink = pin_ld(12) + e * 8;
    const float* TF = (const float*)(p.ws + WS_ST) + 2 * (SZ_ST / 4); const float* TB = TF + SZ_ST / 4;
    const int nchunk = ctx_full ? NCH : 32;
    const int nitems = NB * nchunk * 8;
    bf16_t* Kt = (bf16_t*)smem;
    bf16_t* Vt = Kt + 128 * 72;
    bf16_t* TfT = Vt + 64 * 136;
    bf16_t* TbT = TfT + 64 * 72;
    const int i = 16 * w + ln;
    for (int it = bid; it < 2 * nitems; it += nb) {
        const bool is_attn = it < nitems; const int ii = is_attn ? it : it - nitems;
        const int h = ii & 7, cidx = (ii >> 3) % nchunk, b = ii / (8 * nchunk);
        const int t0 = chunk_t0(b, cidx); const bool lat = cidx < 32;
        f32x4 O[4];
#pragma unroll
        for (int m = 0; m < 4; ++m) O[m] = (f32x4){0.f, 0.f, 0.f, 0.f};
        if (!is_attn) {
            const float lgf = log_sigmoid(dec[h]), lgb = log_sigmoid(dec[8 + h]);
            __syncthreads();
#pragma unroll
            for (int q = 0; q < 2; ++q) { const int idx = tid + 512 * q; const int r = idx >> 3, pc = idx & 7; const bf16_t* zr = Z + (size_t)(t0 + r) * INW + h * 64 + pc * 8;
                *(u32x4*)(Kt + r * 72 + pc * 8) = *(const u32x4*)(zr + 1792);
                const bf16x8 vv = *(const bf16x8*)(zr + 2304);
#pragma unroll
                for (int j = 0; j < 8; ++j) Vt[(pc * 8 + j) * 136 + r] = (bf16_t)vv[j]; }
            const size_t so = ((size_t)(b * NCH + cidx) * 8 + h) * 4096;
#pragma unroll
            for (int q = 0; q < 8; ++q) { const int idx = tid + 512 * q; const int d = idx >> 6, ee = idx & 63; TfT[ee * 72 + d] = f2bf(TF[so + idx]); TbT[ee * 72 + d] = f2bf(TB[so + idx]); }
            __builtin_amdgcn_sched_barrier(0);
            bf16x8 qf[2], qff[2], qfb[2];
            { const bf16_t* qr = Z + (size_t)(t0 + i) * INW + 512 + h * 64 + 8 * g4;
              const float cf = __expf(lgf * (float)(i + 1)), cb = __expf(lgb * (float)(128 - i));
#pragma unroll
              for (int k2 = 0; k2 < 2; ++k2) { qf[k2] = *(const bf16x8*)(qr + 32 * k2);
                  f32x4 a0, a1, b0, b1;
#pragma unroll
                  for (int j = 0; j < 4; ++j) { const float x0 = bf2f((bf16_t)qf[k2][j]), x1 = bf2f((bf16_t)qf[k2][4 + j]); a0[j] = x0 * cf; a1[j] = x1 * cf; b0[j] = x0 * cb; b1[j] = x1 * cb; }
                  qff[k2] = pack8(a0, a1); qfb[k2] = pack8(b0, b1); } }
            __builtin_amdgcn_sched_barrier(0);
            __syncthreads();
#pragma unroll
            for (int m = 0; m < 4; ++m)
#pragma unroll
                for (int k2 = 0; k2 < 2; ++k2) {
                    const bf16x8 af = *(const bf16x8*)(TfT + (16 * m + ln) * 72 + 32 * k2 + 8 * g4);
                    const bf16x8 ab = *(const bf16x8*)(TbT + (16 * m + ln) * 72 + 32 * k2 + 8 * g4);
                    O[m] = __builtin_amdgcn_mfma_f32_16x16x32_bf16(af, qff[k2], O[m], 0, 0, 0);
                    O[m] = __builtin_amdgcn_mfma_f32_16x16x32_bf16(ab, qfb[k2], O[m], 0, 0, 0);
                    __builtin_amdgcn_sched_barrier(0);
                }
            const float lf2 = lgf * 1.44269504f, lb2 = lgb * 1.44269504f; const int di = i - 4 * g4;
            const float bfw = lf2 * (float)di, bbw = -lb2 * (float)di;
            f32x4 st[8];
#pragma unroll
            for (int mt = 0; mt < 8; ++mt) {
                f32x4 a = (f32x4){0.f, 0.f, 0.f, 0.f};
#pragma unroll
                for (int k2 = 0; k2 < 2; ++k2) { const bf16x8 kf = *(const bf16x8*)(Kt + (16 * mt + ln) * 72 + 32 * k2 + 8 * g4); a = __builtin_amdgcn_mfma_f32_16x16x32_bf16(kf, qf[k2], a, 0, 0, 0); }
#pragma unroll
                for (int rg = 0; rg < 4; ++rg) { const int cc = 16 * mt + rg; const int df = di - cc;
                    const float arg = (df > 0) ? fmaf(-lf2, (float)cc, bfw) : fmaf(lb2, (float)cc, bbw);
                    float wgt = __builtin_amdgcn_exp2f(arg); wgt = (df == 0) ? 2.0f : wgt;
                    a[rg] *= wgt; }
                st[mt] = a;
                __builtin_amdgcn_sched_barrier(0);
            }
#pragma unroll
            for (int ks = 0; ks < 4; ++ks) {
                const bf16x8 pfr = pack8(st[2 * ks], st[2 * ks + 1]);
#pragma unroll
                for (int m = 0; m < 4; ++m) {
                    const bf16_t* vr = Vt + (16 * m + ln) * 136 + 32 * ks + 4 * g4;
                    const bf16x4 v0 = *(const bf16x4*)vr, v1 = *(const bf16x4*)(vr + 16);
                    const bf16x8 vf = __builtin_shufflevector(v0, v1, 0, 1, 2, 3, 4, 5, 6, 7);
                    O[m] = __builtin_amdgcn_mfma_f32_16x16x32_bf16(vf, pfr, O[m], 0, 0, 0);
                }
                __builtin_amdgcn_sched_barrier(0);
            }
            float ss = 0.f;
#pragma unroll
            for (int m = 0; m < 4; ++m)
#pragma unroll
                for (int rg = 0; rg < 4; ++rg) ss += O[m][rg] * O[m][rg];
            ss += __shfl_xor(ss, 16, 64); ss += __shfl_xor(ss, 32, 64);
            const float rn = rsqrtf(ss * (1.0f / 64.0f) + EPS);
#pragma unroll
            for (int m = 0; m < 4; ++m) {
                const int ee = 16 * m + 4 * g4;
                const bf16x4 gv = *(const bf16x4*)(Z + (size_t)(t0 + i) * INW + 1024 + h * 64 + ee);
                uint2 o2; o2.x = pg8::cvt_pk_bf16(O[m][0] * rn * silu_f(bf2f((bf16_t)gv[0])), O[m][1] * rn * silu_f(bf2f((bf16_t)gv[1])));
                o2.y = pg8::cvt_pk_bf16(O[m][2] * rn * silu_f(bf2f((bf16_t)gv[2])), O[m][3] * rn * silu_f(bf2f((bf16_t)gv[3])));
                *(uint2*)(MIX + (size_t)(t0 + i) * D + 512 + h * 64 + ee) = o2;
            }
        } else {
            const int gk = h >> 2;
            bf16x8 qf[2];
            { const bf16_t* qr = Z + (size_t)(t0 + i) * INW + h * 64 + 8 * g4; qf[0] = *(const bf16x8*)qr; qf[1] = *(const bf16x8*)(qr + 32); }
            float mx = sink[h], l = (g4 == 0) ? 1.0f : 0.0f;
            const int qpos = lat ? (cidx * 128 + i) : 0;
#define ATT_VALID(tl_) ((tl_) >= 3 || (lat && (cidx - 1 + (tl_)) >= 0 && (cidx - 1 + (tl_)) < 32))
#define ATT_KT0(tl_) ((tl_) >= 3 ? TL + b * CL + ((tl_) - 3) * 128 : b * SEQ + (cidx - 1 + (tl_)) * 128)
            int tl = 0; while (!ATT_VALID(tl)) ++tl;
            u32x4 kreg[2]; bf16x8 vreg[2];
            { const int kt0 = ATT_KT0(tl);
#pragma unroll
              for (int q = 0; q < 2; ++q) { const int idx = tid + 512 * q; const int r = idx >> 3, pc = idx & 7; const bf16_t* zr = Z + (size_t)(kt0 + r) * INW + gk * 64 + pc * 8;
                  kreg[q] = *(const u32x4*)(zr + 1536); vreg[q] = *(const bf16x8*)(zr + 1664); } }
            while (tl < 5) {
                const bool isc = tl >= 3; const int kp0 = isc ? 0 : (cidx - 1 + tl) * 128;
                __syncthreads();
#pragma unroll
                for (int q = 0; q < 2; ++q) { const int idx = tid + 512 * q; const int r = idx >> 3, pc = idx & 7;
                    *(u32x4*)(Kt + r * 72 + pc * 8) = kreg[q];
#pragma unroll
                    for (int j = 0; j < 8; ++j) Vt[(pc * 8 + j) * 136 + r] = (bf16_t)vreg[q][j]; }
                __syncthreads();
                int tn = tl + 1; while (tn < 5 && !ATT_VALID(tn)) ++tn;
                if (tn < 5) { const int kt0 = ATT_KT0(tn);
#pragma unroll
                    for (int q = 0; q < 2; ++q) { const int idx = tid + 512 * q; const int r = idx >> 3, pc = idx & 7; const bf16_t* zr = Z + (size_t)(kt0 + r) * INW + gk * 64 + pc * 8;
                        kreg[q] = *(const u32x4*)(zr + 1536); vreg[q] = *(const bf16x8*)(zr + 1664); } }
                f32x4 st[8];
                float mloc = -1e30f;
#pragma unroll
                for (int mt = 0; mt < 8; ++mt) {
                    f32x4 a = (f32x4){0.f, 0.f, 0.f, 0.f};
#pragma unroll
                    for (int k2 = 0; k2 < 2; ++k2) { const bf16x8 kf = *(const bf16x8*)(Kt + (16 * mt + ln) * 72 + 32 * k2 + 8 * g4); a = __builtin_amdgcn_mfma_f32_16x16x32_bf16(kf, qf[k2], a, 0, 0, 0); }
                    if (!isc) {
#pragma unroll
                        for (int rg = 0; rg < 4; ++rg) { const int dd = qpos - (kp0 + 16 * mt + 4 * g4 + rg); if (dd > 128 || dd < -128) a[rg] = -1e30f; }
                    }
#pragma unroll
                    for (int rg = 0; rg < 4; ++rg) mloc = fmaxf(mloc, a[rg]);
                    st[mt] = a;
                    __builtin_amdgcn_sched_barrier(0);
                }
                mloc = fmaxf(mloc, __shfl_xor(mloc, 16, 64)); mloc = fmaxf(mloc, __shfl_xor(mloc, 32, 64));
                const float mnew = fmaxf(mx, mloc);
                const float sc = __expf(mx - mnew); mx = mnew; l *= sc;
#pragma unroll
                for (int m = 0; m < 4; ++m) O[m] *= sc;
#pragma unroll
                for (int mt = 0; mt < 8; ++mt)
#pragma unroll
                    for (int rg = 0; rg < 4; ++rg) { const float pv = __expf(st[mt][rg] - mnew); st[mt][rg] = pv; l += pv; }
#pragma unroll
                for (int ks = 0; ks < 4; ++ks) {
                    const bf16x8 pfr = pack8(st[2 * ks], st[2 * ks + 1]);
#pragma unroll
                    for (int m = 0; m < 4; ++m) {
                        const bf16_t* vr = Vt + (16 * m + ln) * 136 + 32 * ks + 4 * g4;
                        const bf16x4 v0 = *(const bf16x4*)vr, v1 = *(const bf16x4*)(vr + 16);
                        const bf16x8 vf = __builtin_shufflevector(v0, v1, 0, 1, 2, 3, 4, 5, 6, 7);
                        O[m] = __builtin_amdgcn_mfma_f32_16x16x32_bf16(vf, pfr, O[m], 0, 0, 0);
                    }
                    __builtin_amdgcn_sched_barrier(0);
                }
                tl = tn;
            }
#undef ATT_VALID
#undef ATT_KT0
            l += __shfl_xor(l, 16, 64); l += __shfl_xor(l, 32, 64);
            const float inv = 1.0f / l;
#pragma unroll
            for (int m = 0; m < 4; ++m) {
                uint2 o2; o2.x = pg8::cvt_pk_bf16(O[m][0] * inv, O[m][1] * inv); o2.y = pg8::cvt_pk_bf16(O[m][2] * inv, O[m][3] * inv);
                *(uint2*)(MIX + (size_t)(t0 + i) * D + h * 64 + 16 * m + 4 * g4) = o2;
            }
        }
    }
    __syncthreads();
}

__device__ __forceinline__ void h2_shortconv(const KQ p_in, int o, int M, unsigned char* smem) {
    const KQ p = lq(p_in);
    const int tid = ltid();
    const bf16_t* ZH = (const bf16_t*)(p.ws + WS_BIG);
    const float* w = pin_ld(17) + (size_t)o * 3 * HYW; const float* bs = pin_ld(18) + (size_t)o * HYW;
    bf16_t* VXT = (bf16_t*)(p.ws + WS_Y); bf16_t* X0T = VXT + (size_t)D * TL;
    bf16_t* tx = (bf16_t*)smem;
    bf16_t* tv = tx + 64 * 72;
    const int tok = tid >> 3, cg8 = (tid & 7) * 8;
    float* wl = (float*)(smem + 32768);
    { const int c0b = (blockIdx.x & 15) * 64;
      for (int i = tid; i < 768; i += 512) { const int k = i >> 8, q = (i >> 6) & 3, c = i & 63; const int col = k * 1024 + c0b + c; wl[i] = (q < 3) ? w[q * HYW + col] : bs[col]; } }
    __syncthreads();
    for (int it = blockIdx.x; it < (TL / 64) * 16; it += gridDim.x) {
        const int c0 = (it & 15) * 64, t0 = (it >> 4) * 64;
        const int t = t0 + tok; const int pos = t & (SEQ - 1); const bool first = pos == 0, last = pos == SEQ - 1;
        float zz[3][8];
#pragma unroll
        for (int k = 0; k < 3; ++k) {
            const int c = k * 1024 + c0 + cg8;
            const bf16x8 zc = *(const bf16x8*)(ZH + (size_t)t * HYW + c);
            bf16x8 zp = zc, zn = zc;
            if (!first) zp = *(const bf16x8*)(ZH + (size_t)(t - 1) * HYW + c);
            if (!last) zn = *(const bf16x8*)(ZH + (size_t)(t + 1) * HYW + c);
            const float* wk = wl + k * 256 + cg8;
#pragma unroll
            for (int j = 0; j < 8; ++j) {
                float sacc = wk[192 + j] + bf2f((bf16_t)zc[j]) * wk[64 + j];
                if (!first) sacc += bf2f((bf16_t)zp[j]) * wk[j];
                if (!last) sacc += bf2f((bf16_t)zn[j]) * wk[128 + j];
                zz[k][j] = sacc;
            }
        }
        __syncthreads();
#pragma unroll
        for (int j = 0; j < 8; ++j) { tx[(cg8 + j) * 72 + tok] = f2bf(zz[0][j]); tv[(cg8 + j) * 72 + tok] = f2bf(zz[2][j] * zz[1][j]); }
        __syncthreads();
        { const int ch = tid >> 3, tk = (tid & 7) * 8;
          *(u32x4*)(X0T + (size_t)(c0 + ch) * TL + t0 + tk) = *(const u32x4*)(tx + ch * 72 + tk);
          *(u32x4*)(VXT + (size_t)(c0 + ch) * TL + t0 + tk) = *(const u32x4*)(tv + ch * 72 + tk); }
    }
    __syncthreads();
    if (M > TL) {
        float* VX = (float*)(p.ws + WS_Y); bf16_t* X0 = (bf16_t*)(p.ws + WS_H);
        for (int idx = TL * D + blockIdx.x * 512 + tid; idx < M * D; idx += gridDim.x * 512) {
            const int t = idx >> 10, d = idx & 1023;
            const int pos = (t - TL) & (CL - 1); const bool first = pos == 0, last = pos == CL - 1;
            float zz[3];
#pragma unroll
            for (int k = 0; k < 3; ++k) {
                const int c = k * 1024 + d;
                float sacc = bs[c] + bf2f(ZH[(size_t)t * HYW + c]) * w[HYW + c];
                if (!first) sacc += bf2f(ZH[(size_t)(t - 1) * HYW + c]) * w[c];
                if (!last) sacc += bf2f(ZH[(size_t)(t + 1) * HYW + c]) * w[2 * HYW + c];
                zz[k] = sacc;
            }
            VX[idx] = zz[2] * zz[1]; X0[idx] = f2bf(zz[0]);
        }
    }
}

typedef float f32x16 __attribute__((ext_vector_type(16)));
__device__ __forceinline__ void h3_longconv(const KQ p_in, int o, bool ctx_full, unsigned char* smem) {
    const KQ p = lq(p_in);
    const int tid = ltid(), w = tid >> 6, lane = tid & 63;
    const float* bias = pin_ld(27) + (size_t)o * D;
    {
        const bf16_t* VXT = (const bf16_t*)(p.ws + WS_Y); const bf16_t* X0T = VXT + (size_t)D * TL;
        bf16_t* HMT = (bf16_t*)(p.ws + WS_H);
        const bf16_t* RKT = (const bf16_t*)(p.ws + WS_KF + (size_t)o * SZ_KF);
        constexpr int RK2_OFF = 16384 + 64, U_OFF = 2 * 16384 + 128, CH_BYTES = U_OFF + 142 * 256;
        const int cw = w >> 2, w4 = w & 3;
        const int ct = tid & 255;
        unsigned char* cb = smem + cw * CH_BYTES;
        unsigned char* ub = cb + U_OFF;
        const int r = lane & 31, hh = lane >> 5;
        for (int pr = blockIdx.x; pr < D / 2; pr += gridDim.x) {
            const int d = pr * 2 + cw;
            __syncthreads();
            { const bf16_t* src = RKT + (size_t)d * 8192;
              for (int i = ct; i < 1024; i += 256) *(u32x4*)(cb + i * 16) = *(const u32x4*)(src + i * 8);
              for (int i = ct; i < 2 * 7 * 4 * 4; i += 256) { const int side = i / 112, rem = i % 112; unsigned z0 = 0u; asm volatile("" : "+v"(z0)); *(u32x4*)(ub + (side ? (135 * 4 * 64) : 0) + rem * 16) = (u32x4){z0, z0, z0, z0}; }
#pragma unroll 4
              for (int i = ct; i < 4 * 512; i += 256) { const int b = i >> 9, pc = i & 511;
                  const u32x4 v = *(const u32x4*)(VXT + (size_t)d * TL + b * SEQ + pc * 8);
                  const int col = ((pc >> 2) + 7) * 4 + b, q = pc & 3;
                  *(u32x4*)(ub + col * 64 + ((q ^ ((col >> 2) & 3)) * 16)) = v; } }
            __syncthreads();
            { const bf16_t* rk = (const bf16_t*)cb; bf16_t* rk2 = (bf16_t*)(cb + RK2_OFF);
#pragma unroll 4
              for (int i = ct; i < 4096; i += 256) { const unsigned lo = rk[2 * i + 1]; const unsigned hi = (2 * i + 2 < 8192) ? rk[2 * i + 2] : 0u; *(unsigned*)(rk2 + 2 * i) = lo | (hi << 16); } }
            __syncthreads();
            f32x16 acc[4];
#pragma unroll
            for (int j = 0; j < 4; ++j)
#pragma unroll
                for (int q = 0; q < 16; ++q) acc[j][q] = 0.f;
            const bf16_t* rsel = (const bf16_t*)(cb + ((r & 1) ? 0 : RK2_OFF));
            const int adj = (r & 1) ? 0 : -1;
            const int bq = r & 3;
#define H3_LOAD(AF, BF, U) do { \
                _Pragma("unroll") for (int s2 = 0; s2 < 2; ++s2) { \
                    const unsigned* ap = (const unsigned*)(Ab + 64 * (3 - (U)) + 32 * s2); \
                    u32x4 t4; t4.x = ap[0]; t4.y = ap[1]; t4.z = ap[2]; t4.w = ap[3]; \
                    AF[s2] = __builtin_bit_cast(bf16x8, t4); } \
                _Pragma("unroll") for (int j = 0; j < 4; ++j) { \
                    int c_ = Lb - 256 * (U) + 2048 * j; c_ = c_ < LO ? LO : (c_ > HI ? HI : c_); \
                    BF[j][0] = *(const bf16x8*)(ub + c_ + off[U][0]); BF[j][1] = *(const bf16x8*)(ub + c_ + off[U][1]); } } while (0)
#define H3_MMA(AF, BF) do { \
                _Pragma("unroll") for (int s2 = 0; s2 < 2; ++s2) \
                _Pragma("unroll") for (int j = 0; j < 4; ++j) acc[j] = __builtin_amdgcn_mfma_f32_32x32x16_bf16(AF[s2], BF[j][s2], acc[j], 0, 0, 0); } while (0)
            {
                const int dlo = 32 * w4 - 127;
                const int LO = (24 + bq) * 64, HI = (540 + bq) * 64;
                int off[4][2];
#pragma unroll
                for (int u = 0; u < 4; ++u) { const int sw = ((r >> 2) + 2 - u) & 3; off[u][0] = (hh ^ sw) * 16; off[u][1] = ((2 + hh) ^ sw) * 16; }
                int Lb = (((r >> 2) + 134) * 4 + bq) * 64;
                const unsigned char* Ab = (const unsigned char*)(rsel + (4095 - 32 * dlo - r + 8 * hh + adj)) - 192;
                bf16x8 afA[2], bfA[4][2], afB[2], bfB[4][2];
                H3_LOAD(afA, bfA, 0);
                for (int g = 0; g < 39; ++g) {
                    H3_LOAD(afB, bfB, 1);
                    __builtin_amdgcn_sched_barrier(0);
                    H3_MMA(afA, bfA);
                    __builtin_amdgcn_sched_barrier(0);
                    H3_LOAD(afA, bfA, 2);
                    __builtin_amdgcn_sched_barrier(0);
                    H3_MMA(afB, bfB);
                    __builtin_amdgcn_sched_barrier(0);
                    H3_LOAD(afB, bfB, 3);
                    __builtin_amdgcn_sched_barrier(0);
                    H3_MMA(afA, bfA);
                    __builtin_amdgcn_sched_barrier(0);
                    Ab -= 256; Lb -= 1024;
                    H3_LOAD(afA, bfA, 0);
                    __builtin_amdgcn_sched_barrier(0);
                    H3_MMA(afB, bfB);
                    __builtin_amdgcn_sched_barrier(0);
                }
                H3_LOAD(afB, bfB, 1);
                __builtin_amdgcn_sched_barrier(0);
                H3_MMA(afA, bfA);
                __builtin_amdgcn_sched_barrier(0);
                H3_LOAD(afA, bfA, 2);
                __builtin_amdgcn_sched_barrier(0);
                H3_MMA(afB, bfB);
                H3_MMA(afA, bfA);
            }
#undef H3_LOAD
#undef H3_MMA
            __syncthreads();
            const float bd = bias[d];
#pragma unroll
            for (int j = 0; j < 4; ++j) {
                const int n1 = 8 * (4 * w4 + j) + (r >> 2);
                const int col = (n1 + 7) * 4 + bq; const int sw = (col >> 2) & 3;
                bf16_t* up = (bf16_t*)(ub + col * 64);
#pragma unroll
                for (int q4 = 0; q4 < 4; ++q4) {
                    bf16_t* pp = up + ((q4 ^ sw) * 8) + 4 * hh;
                    const bf16x4 uv = *(const bf16x4*)pp;
                    uint2 o2; o2.x = pg8::cvt_pk_bf16(acc[j][4 * q4] + bd * bf2f((bf16_t)uv[0]), acc[j][4 * q4 + 1] + bd * bf2f((bf16_t)uv[1]));
                    o2.y = pg8::cvt_pk_bf16(acc[j][4 * q4 + 2] + bd * bf2f((bf16_t)uv[2]), acc[j][4 * q4 + 3] + bd * bf2f((bf16_t)uv[3]));
                    *(uint2*)pp = o2;
                }
            }
            __syncthreads();
#pragma unroll 2
            for (int i = ct; i < 4 * 512; i += 256) { const int b = i >> 9, pc = i & 511;
                const int col = ((pc >> 2) + 7) * 4 + b, q = pc & 3;
                const bf16x8 yv = *(const bf16x8*)(ub + col * 64 + ((q ^ ((col >> 2) & 3)) * 16));
                const size_t gi = (size_t)d * TL + b * SEQ + pc * 8;
                const bf16x8 xv = *(const bf16x8*)(X0T + gi);
                u32x4 o4;
                o4.x = pg8::cvt_pk_bf16(bf2f((bf16_t)yv[0]) * bf2f((bf16_t)xv[0]), bf2f((bf16_t)yv[1]) * bf2f((bf16_t)xv[1]));
                o4.y = pg8::cvt_pk_bf16(bf2f((bf16_t)yv[2]) * bf2f((bf16_t)xv[2]), bf2f((bf16_t)yv[3]) * bf2f((bf16_t)xv[3]));
                o4.z = pg8::cvt_pk_bf16(bf2f((bf16_t)yv[4]) * bf2f((bf16_t)xv[4]), bf2f((bf16_t)yv[5]) * bf2f((bf16_t)xv[5]));
                o4.w = pg8::cvt_pk_bf16(bf2f((bf16_t)yv[6]) * bf2f((bf16_t)xv[6]), bf2f((bf16_t)yv[7]) * bf2f((bf16_t)xv[7]));
                *(u32x4*)(HMT + gi) = o4; }
        }
        __syncthreads();
    }
    if (ctx_full) {
        const float* VX = (const float*)(p.ws + WS_Y); const bf16_t* X0 = (const bf16_t*)(p.ws + WS_H);
        bf16_t* MIX = (bf16_t*)(p.ws + WS_MIX);
        const float* kf = (const float*)(p.ws + WS_KF + (size_t)o * SZ_KF) + (size_t)2 * SEQ * D;
        for (int idx = blockIdx.x * 512 + tid; idx < (TC / 8) * D; idx += gridDim.x * 512) {
            const int d = idx & 1023, og = idx >> 10;
            const int bb = og >> 5, n0 = (og & 31) * 8, tb = TL + bb * CL;
            const float* up = VX + (size_t)tb * D + d;
            float acc[8];
#pragma unroll
            for (int j = 0; j < 8; ++j) acc[j] = 0.f;
#pragma unroll 1
            for (int mb = 0; mb < CL; mb += 8) {
                float kk[15], uu[8];
#pragma unroll
                for (int q = 0; q < 15; ++q) { const int lag = n0 - mb - 7 + q;
                    kk[q] = (lag >= 0) ? ((lag < CL) ? kf[(size_t)lag * D + d] : 0.f) : ((-lag < CL) ? kf[(size_t)(CL - lag) * D + d] : 0.f); }
#pragma unroll
                for (int u = 0; u < 8; ++u) uu[u] = up[(size_t)(mb + u) * D];
#pragma unroll
                for (int u = 0; u < 8; ++u)
#pragma unroll
                    for (int j = 0; j < 8; ++j) acc[j] += uu[u] * kk[7 - u + j];
            }
            const float bd = bias[d];
#pragma unroll
            for (int j = 0; j < 8; ++j) { const size_t ti = (size_t)(tb + n0 + j) * D + d; MIX[ti] = f2bf(bf2f(X0[ti]) * (acc[j] + bd * VX[ti])); }
        }
    }
}

__device__ __forceinline__ void h3b_transpose(const KQ p_in, unsigned char* smem) {
    const KQ p = lq(p_in);
    const int tid = ltid();
    const bf16_t* HMT = (const bf16_t*)(p.ws + WS_H); bf16_t* MIX = (bf16_t*)(p.ws + WS_MIX);
    bf16_t* tile = (bf16_t*)smem;
    for (int it = blockIdx.x; it < (TL / 64) * 16; it += gridDim.x) {
        const int c0 = (it & 15) * 64, t0 = (it >> 4) * 64;
        __syncthreads();
        { const int ch = tid >> 3, tk = (tid & 7) * 8; *(u32x4*)(tile + ch * 72 + tk) = *(const u32x4*)(HMT + (size_t)(c0 + ch) * TL + t0 + tk); }
        __syncthreads();
        { const int tok = tid >> 3, cg8 = (tid & 7) * 8; unsigned short v[8];
#pragma unroll
          for (int j = 0; j < 8; ++j) v[j] = tile[(cg8 + j) * 72 + tok];
          u32x4 o4; o4.x = v[0] | ((unsigned)v[1] << 16); o4.y = v[2] | ((unsigned)v[3] << 16); o4.z = v[4] | ((unsigned)v[5] << 16); o4.w = v[6] | ((unsigned)v[7] << 16);
          *(u32x4*)(MIX + (size_t)(t0 + tok) * D + c0 + cg8) = o4; }
    }
    __syncthreads();
}

__global__ void __launch_bounds__(512, 2) mega_fwd(KP kp) {
    unsigned char* const smem = g_smem;
    if (threadIdx.x < 29) *(LAS unsigned long long*)((LAS unsigned char*)g_smem + PTAB_OFF + 8 * threadIdx.x) = ((const unsigned long long*)__builtin_amdgcn_kernarg_segment_ptr())[threadIdx.x];
    KQ p; p.out = kp.out; p.ws = kp.ws;
    cg::grid_group grid = cg::this_grid();
    if (threadIdx.x < 4) ((volatile LAS unsigned*)(LAS unsigned char*)smem)[(LDS_BYTES - 16) / 4 + threadIdx.x] = 0u;
    __syncthreads();
    if (threadIdx.x == 0) (void)xb_add(&((unsigned*)(lq(p).ws + WS_BAR))[XB_XCNT(xb_xcc_id())], 1u);
    grid.sync();
    float* smf = (float*)smem;
#define Hb ((bf16_t*)(lq(p).ws + WS_H))
#define BIG ((bf16_t*)(lq(p).ws + WS_BIG))
#define Y ((bf16_t*)(lq(p).ws + WS_Y))
#define MIX ((bf16_t*)(lq(p).ws + WS_MIX))

#ifndef NO_P0
    p0_setup(p, smf);
#endif
    GRID_BAR();
    rowphase(p, 0, nullptr, 0, 0, 0.f, nullptr, T, 0, pin_ld(6), 0, 1, Hb, true);
    GRID_BAR();
    for (int l = 0; l < 4; ++l) {
        const bool ctx_live = l <= 2, ctx_full = l < 2;
        const int Mff = ctx_live ? T : TL, Mpost = ctx_full ? T : TL;
        for (int sub = 0; sub < 3; ++sub) {
            if (sub != 1) {
                const int fi = sub >> 1; const int M = (sub == 0) ? Mff : Mpost;
                { pg8::EpiSwiGLU E{BIG, DFF}; run_gemm(smem, Hb, (const bf16_t*)(lq(p).ws + WS_WGU + (size_t)(l * 2 + fi) * SZ_WGU), M, 2 * DFF, D, E); }
                GRID_BAR();
                run_gemm_f32_split(smem, BIG, (const bf16_t*)(lq(p).ws + WS_WD + (size_t)(l * 2 + fi) * SZ_WD), M, DFF, Y, (float*)(lq(p).ws + WS_YP));
                GRID_BAR();
                if (sub == 0) rowphase(p, M, Y, l, 2, 0.5f, pin_ld(7) + (size_t)(l * 3 + 0) * D, Mff, l, pin_ld(6) + (size_t)(l * 3 + 1) * D, 3, 4, Hb, l == 0);
                else {
                    const int ln = l + 1; const int Mn = (ln < 4) ? ((ln <= 2) ? T : TL) : 0;
                    rowphase(p, M, Y, l, 8, 0.5f, pin_ld(7) + (size_t)(l * 3 + 2) * D, Mn, ln < 4 ? ln : l, pin_ld(6) + (size_t)((ln < 4 ? ln : l) * 3 + 0) * D, 0, 1, ln < 4 ? Hb : nullptr, false);
                }
                GRID_BAR();
            } else {
                if ((l & 1) == 0) {
                    const int e = l >> 1;
                    { pg8::EpiBf16 E{BIG, INW, nullptr}; run_gemm(smem, Hb, (const bf16_t*)(lq(p).ws + WS_WIN + (size_t)e * SZ_WIN), Mff, INW, D, E); }
                    GRID_BAR();
#ifndef NO_M1
                    m1_rope_states(p, e, smf);
#endif
                    GRID_BAR();
#ifndef NO_M2
                    m2_scan(p, e);
#endif
                    GRID_BAR();
#ifndef NO_M3
                    m3_outputs(p, e, ctx_full, smem);
#endif
                    GRID_BAR();
                    run_gemm_f32_split(smem, MIX, (const bf16_t*)(lq(p).ws + WS_WOUT + (size_t)e * SZ_WOUT), Mpost, D, Y, (float*)(lq(p).ws + WS_YP));
                    GRID_BAR();
                } else {
                    const int o = l >> 1;
                    { pg8::EpiBf16 E{BIG, HYW, pin_ld(16) + (size_t)o * HYW}; run_gemm(smem, Hb, (const bf16_t*)(lq(p).ws + WS_HWIN + (size_t)o * SZ_HWIN), Mpost, HYW, D, E); }
                    GRID_BAR();
#ifndef NO_H2
                    h2_shortconv(p, o, Mpost, smem);
#endif
                    GRID_BAR();
#ifndef NO_H3
                    h3_longconv(p, o, ctx_full, smem);
#endif
                    GRID_BAR();
                    h3b_transpose(p, smem);
                    GRID_BAR();
                    run_gemm_f32_split(smem, MIX, (const bf16_t*)(lq(p).ws + WS_HWOUT + (size_t)o * SZ_WOUT), Mpost, D, Y, (float*)(lq(p).ws + WS_YP));
                    GRID_BAR();
                }
                rowphase(p, Mpost, Y, l, 5, 1.0f, pin_ld(7) + (size_t)(l * 3 + 1) * D, Mpost, l, pin_ld(6) + (size_t)(l * 3 + 2) * D, 6, 7, Hb, false);
                GRID_BAR();
            }
        }
    }
}

extern "C" void kernel_launch(void* const* d_in, const int* in_sizes, int n_in, void* d_out, int out_size, void* d_ws, size_t ws_size, hipStream_t stream) {
    static int grid = 0;
    if (grid == 0) {
        if (n_in != 29 || out_size != TL * D || ws_size < WS_END) { fprintf(stderr, "kernel_launch: unexpected shapes: n_in %d out %d ws %zu (need %zu)\n", n_in, out_size, ws_size, (size_t)WS_END); grid = -1; return; }
        int dev = 0, cus = 0, per_cu = 0;
        (void)hipGetDevice(&dev);
        (void)hipDeviceGetAttribute(&cus, hipDeviceAttributeMultiprocessorCount, dev);
        if (hipFuncSetAttribute((const void*)mega_fwd, hipFuncAttributeMaxDynamicSharedMemorySize, LDS_BYTES) != hipSuccess) { fprintf(stderr, "kernel_launch: hipFuncSetAttribute failed\n"); grid = -1; return; }
        if (hipOccupancyMaxActiveBlocksPerMultiprocessor(&per_cu, (const void*)mega_fwd, 512, LDS_BYTES) != hipSuccess || per_cu < 1) { fprintf(stderr, "kernel_launch: occupancy query says %d\n", per_cu); per_cu = 1; }
        (void)hipGetLastError();
        grid = cus;
    }
    if (grid < 0) return;
    (void)hipMemsetAsync((unsigned char*)d_ws + WS_BAR, 0, 16384, stream);
    KP kp{};
    for (int i = 0; i < 29; ++i) kp.in[i] = (const float*)d_in[i];
    kp.out = (float*)d_out; kp.ws = (unsigned char*)d_ws;
    void* args[] = {&kp};
    hipError_t e = hipLaunchCooperativeKernel((const void*)mega_fwd, dim3(grid), dim3(512), args, LDS_BYTES, stream);
    if (e != hipSuccess) fprintf(stderr, "cooperative launch failed: %s (grid %d)\n", hipGetErrorString(e), grid);
}
```

```cpp
#include <hip/hip_runtime.h>
#include <hip/hip_cooperative_groups.h>
#include <cstdio>
namespace cg = cooperative_groups;

#define LAS __attribute__((address_space(3)))
typedef unsigned short bf16_t;
typedef short bf16x8 __attribute__((ext_vector_type(8)));
typedef short bf16x4 __attribute__((ext_vector_type(4)));
typedef float f32x4 __attribute__((ext_vector_type(4)));
typedef unsigned u32x4 __attribute__((ext_vector_type(4)));

constexpr int D = 1024, NB = 4, SEQ = 4096, CL = 256, TL = NB * SEQ, TC = NB * CL, T = TL + TC, DFF = 2816, INW = 2816, HYW = 3072;
constexpr int NMOD = 9;
constexpr float EPS = 1e-6f;
constexpr int NCH = 34;
constexpr int LDS_BYTES = 144 * 1024;

constexpr size_t SZ_WGU = (size_t)2 * DFF * D * 2, SZ_WD = (size_t)D * DFF * 2, SZ_WIN = (size_t)INW * D * 2, SZ_WOUT = (size_t)D * D * 2, SZ_HWIN = (size_t)HYW * D * 2;
constexpr size_t WS_WGU = 0;
constexpr size_t WS_WD = WS_WGU + 8 * SZ_WGU;
constexpr size_t WS_WIN = WS_WD + 8 * SZ_WD;
constexpr size_t WS_WOUT = WS_WIN + 2 * SZ_WIN;
constexpr size_t WS_HWIN = WS_WOUT + 2 * SZ_WOUT;
constexpr size_t WS_HWOUT = WS_HWIN + 2 * SZ_HWIN;
constexpr size_t WS_MOD = WS_HWOUT + 2 * SZ_WOUT;
constexpr size_t WS_ROPE = WS_MOD + (size_t)4 * 5 * NMOD * D * 4;
constexpr size_t WS_XC = WS_ROPE + (size_t)4 * SEQ * 32 * 4;
constexpr size_t WS_H = WS_XC + (size_t)TC * D * 4;
constexpr size_t WS_BIG = WS_H + (size_t)T * D * 2;
constexpr size_t WS_Y = WS_BIG + (size_t)T * HYW * 2;
constexpr size_t WS_MIX = WS_Y + (size_t)T * D * 4;
constexpr size_t SZ_ST = (size_t)NB * NCH * 8 * 4096 * 4;
constexpr size_t WS_ST = WS_MIX + (size_t)T * D * 2;
constexpr size_t SZ_KF = (size_t)(SEQ + CL) * 2 * D * 4;
constexpr size_t WS_KF = WS_ST + 4 * SZ_ST;
constexpr size_t WS_YP = WS_KF + 2 * SZ_KF;
constexpr size_t WS_BAR = WS_YP + (size_t)4 * TC * D * 4;
constexpr size_t WS_END = WS_BAR + 16384;

struct KP { const float* in[29]; float* out; unsigned char* ws; };
extern __shared__ __attribute__((aligned(16))) unsigned char g_smem[];
constexpr int PTAB_OFF = LDS_BYTES - 512;
__device__ __forceinline__ const float* pin_ld(int k) {
    const unsigned long long v = *(volatile LAS unsigned long long*)((LAS unsigned char*)g_smem + PTAB_OFF + 8 * k);
    const unsigned lo = __builtin_amdgcn_readfirstlane((unsigned)v), hi = __builtin_amdgcn_readfirstlane((unsigned)(v >> 32));
    return (const float*)(((unsigned long long)hi << 32) | lo);
}
struct KQ { float* out; unsigned char* ws; };
__device__ __forceinline__ KQ lq(KQ q) { asm volatile("" : "+s"(q.out), "+s"(q.ws)); return q; }

__device__ __forceinline__ bf16_t f2bf(float f) { unsigned u = __float_as_uint(f); u += 0x7FFFu + ((u >> 16) & 1u); return (bf16_t)(u >> 16); }
__device__ __forceinline__ float bf2f(bf16_t b) { return __uint_as_float(((unsigned)b) << 16); }
__device__ __forceinline__ float silu_f(float x) { return x * __builtin_amdgcn_rcpf(1.0f + __expf(-x)); }
__device__ __forceinline__ int ltid() { int t = threadIdx.x; asm volatile("" : "+v"(t)); return t; }
__device__ __forceinline__ float wave_sum(float v) {
#pragma unroll
    for (int o = 32; o > 0; o >>= 1) v += __shfl_xor(v, o, 64);
    return v;
}


#define XB_TMO      128
#define XB_XCNT(j)  (256  + 64 * (j))
#define XB_XSUB(j)  (1280 + 64 * (j))
#define XB_XGEN(j)  (2304 + 64 * (j))
#define XB_TOP      3328
#define XB_TOPGEN   3392
#define XCD_BAR_WORDS 3456
#define XB_SPIN_CAP (1u << 18)
__device__ __forceinline__ unsigned xb_ld(unsigned* p)              { return __hip_atomic_load(p, __ATOMIC_RELAXED, __HIP_MEMORY_SCOPE_AGENT); }
__device__ __forceinline__ unsigned xb_add(unsigned* p, unsigned v) { return __hip_atomic_fetch_add(p, v, __ATOMIC_RELAXED, __HIP_MEMORY_SCOPE_AGENT); }
__device__ __forceinline__ unsigned xb_xcc_id() { return (unsigned)__builtin_amdgcn_s_getreg((3 << 11) | 20) & 0xFu; }
#define XB_SPIN(cond, bar) do { unsigned _sp = 0; while (cond) { __builtin_amdgcn_s_sleep(1); \
    if ((++_sp & 255u) == 0u) { if (xb_ld(&(bar)[XB_TMO])) break; if (_sp > XB_SPIN_CAP) { atomicAdd(&(bar)[XB_TMO], 1u); break; } } } } while (0)
struct XcdBarrier { unsigned* bar; unsigned x; volatile LAS unsigned* st; };
__device__ __forceinline__ XcdBarrier xcd_barrier_post(unsigned* bar, volatile LAS unsigned* st) {
    XcdBarrier b; b.bar = bar; b.x = xb_xcc_id(); b.st = st;
    if (threadIdx.x == 0) (void)xb_add(&bar[XB_XCNT(b.x)], 1u);
    return b;
}
__device__ __forceinline__ void xcd_barrier_complete(unsigned* bar, unsigned x, unsigned& nloc, unsigned& nx) {
    const unsigned G = gridDim.x * gridDim.y * gridDim.z;
    unsigned sum, cnt, mine, sp = 0u;
    for (;;) {
        sum = 0u; cnt = 0u; mine = 0u;
#pragma unroll
        for (unsigned j = 0; j < 16; ++j) { const unsigned c = xb_ld(&bar[XB_XCNT(j)]); sum += c; cnt += (c > 0u) ? 1u : 0u; mine = (j == x) ? c : mine; }
        if (sum == G) break;
        __builtin_amdgcn_s_sleep(1);
        if ((++sp & 255u) == 0u) { if (xb_ld(&bar[XB_TMO])) break; if (sp > XB_SPIN_CAP) { atomicAdd(&bar[XB_TMO], 1u); break; } }
    }
    nloc = mine > 0u ? mine : 1u; nx = cnt > 0u ? cnt : 1u;
}
__device__ __forceinline__ void xcd_barrier_impl(unsigned* bar, volatile LAS unsigned* st) {
    asm volatile("s_waitcnt vmcnt(0)" ::: "memory");
    __syncthreads();
    if (ltid() == 0) {
        const unsigned x = xb_xcc_id();
        __builtin_amdgcn_s_waitcnt(0);
        unsigned nloc = st[0], nx = st[1];
        if (nloc == 0u) { xcd_barrier_complete(bar, x, nloc, nx); st[0] = nloc; st[1] = nx; }
        const unsigned old = xb_add(&bar[XB_XSUB(x)], 1u);
        const unsigned gen = old / nloc;
        if (old + 1u == (gen + 1u) * nloc) {
            __builtin_amdgcn_fence(__ATOMIC_RELEASE, "agent");
            asm volatile("s_waitcnt vmcnt(0)" ::: "memory");
            const unsigned og = xb_add(&bar[XB_TOP], 1u);
            const unsigned tg = og / nx;
            if (og + 1u == (tg + 1u) * nx) xb_add(&bar[XB_TOPGEN], 1u);
            else XB_SPIN(xb_ld(&bar[XB_TOPGEN]) == tg, bar);
            __builtin_amdgcn_fence(__ATOMIC_ACQUIRE, "agent");
            xb_add(&bar[XB_XGEN(x)], 1u);
            asm volatile("s_waitcnt vmcnt(0)" ::: "memory");
        } else {
            XB_SPIN(xb_ld(&bar[XB_XGEN(x)]) == gen, bar);
            __builtin_amdgcn_fence(__ATOMIC_ACQUIRE, "agent");
            asm volatile("s_waitcnt vmcnt(0)" ::: "memory");
        }
    }
    __syncthreads();
}
#define GRID_BAR() xcd_barrier_impl((unsigned*)(p.ws + WS_BAR), (volatile LAS unsigned*)((LAS unsigned char*)smem + LDS_BYTES - 16))

namespace pg8 {
constexpr int BM = 256, BK = 64, HALF = 128, HTB = HALF * BK * 2, STAGE_BYTES = 8 * HTB, NXCD = 8, WGM = 8;
__host__ __device__ __forceinline__ int lds_byte(int r, int c) { const int st = (r >> 4) * 2 + (c >> 5), rr = r & 15, cc = c & 31, ob = rr * 64 + cc * 2; return st * 1024 + (ob ^ (((ob >> 9) & 1) << 5)); }
__host__ __device__ __forceinline__ void stage_rc(int b, int& R, int& C) { const int st = b / 1024, sb = b % 1024, swz = sb ^ (((sb >> 9) & 1) << 5); R = (st >> 1) * 16 + swz / 64; C = (st & 1) * 32 + (swz % 64) / 2; }
__host__ __device__ __forceinline__ int perm32(int rho) { const int n = rho >> 4, i = rho & 15; return 8 * (i >> 2) + 4 * n + (i & 3); }
struct Unit { int pm, pn; };
struct Gemm { const bf16_t* A; const bf16_t* Bt; int M, N, K, ld; };
struct StaticOrder {
    int nM, nN, nwg, G, c;
    __device__ void init(int M, int N, int G_, int c_) { nM = M / BM; nN = N / BM; nwg = nM * nN; G = G_; c = c_; }
    __device__ bool next(int i, Unit& u) const {
        const long Lx = (long)i * G + c; if (Lx >= nwg) return false;
        int wgid = (int)Lx; { const int q = nwg / NXCD, r = nwg % NXCD, xcd = wgid % NXCD, off = wgid / NXCD; wgid = (xcd < r ? xcd * (q + 1) : r * (q + 1) + (xcd - r) * q) + off; }
        const int nig = WGM * nN, gid = wgid / nig, fm = gid * WGM, gsz = (nM - fm) < WGM ? (nM - fm) : WGM;
        u.pm = fm + ((wgid % nig) % gsz); u.pn = (wgid % nig) / gsz; return true;
    }
};
__device__ __forceinline__ unsigned cvt_pk_bf16(float lo, float hi) { unsigned r; asm volatile("v_cvt_pk_bf16_f32 %0, %1, %2" : "=v"(r) : "v"(lo), "v"(hi)); return r; }

struct EpiF32 {
    static constexpr bool PERM = false;
    float* C; int ldc;
    __device__ __forceinline__ void operator()(const f32x4 (&acc)[2][2][4][2], const Unit& u, int wr, int wc, int fr, int fq) const {
        const int row0 = u.pm * BM + wr * 64 + fr, col0 = u.pn * BM + wc * 32 + 4 * fq;
#pragma unroll
        for (int ai = 0; ai < 2; ++ai)
#pragma unroll
            for (int m = 0; m < 4; ++m) { float* rowp = C + (size_t)(row0 + ai * HALF + m * 16) * ldc + col0;
#pragma unroll
                for (int bj = 0; bj < 2; ++bj)
#pragma unroll
                    for (int n = 0; n < 2; ++n) *(f32x4*)(rowp + bj * HALF + n * 16) = acc[ai][bj][m][n]; }
    }
};
struct EpiBf16 {
    static constexpr bool PERM = true;
    bf16_t* O; int ldc; const float* bias;
    __device__ __forceinline__ void operator()(const f32x4 (&acc)[2][2][4][2], const Unit& u, int wr, int wc, int fr, int fq) const {
        const int row0 = u.pm * BM + wr * 64 + fr; const int col0 = u.pn * BM + wc * 32 + 8 * fq;
        f32x4 bv[2][2];
#pragma unroll
        for (int bj = 0; bj < 2; ++bj)
#pragma unroll
            for (int n = 0; n < 2; ++n) bv[bj][n] = bias ? *(const f32x4*)(bias + col0 + bj * HALF + 4 * n) : (f32x4){0.f, 0.f, 0.f, 0.f};
#pragma unroll
        for (int ai = 0; ai < 2; ++ai)
#pragma unroll
            for (int m = 0; m < 4; ++m) { bf16_t* rowp = O + (size_t)(row0 + ai * HALF + m * 16) * ldc + col0;
#pragma unroll
                for (int bj = 0; bj < 2; ++bj) { f32x4 v0 = acc[ai][bj][m][0] + bv[bj][0], v1 = acc[ai][bj][m][1] + bv[bj][1];
                    u32x4 w; w.x = cvt_pk_bf16(v0[0], v0[1]); w.y = cvt_pk_bf16(v0[2], v0[3]); w.z = cvt_pk_bf16(v1[0], v1[1]); w.w = cvt_pk_bf16(v1[2], v1[3]);
                    *(u32x4*)(rowp + bj * HALF) = w; } }
    }
};
struct EpiSwiGLU {
    static constexpr bool PERM = true;
    bf16_t* O; int ldc;
    __device__ __forceinline__ void operator()(const f32x4 (&acc)[2][2][4][2], const Unit& u, int wr, int wc, int fr, int fq) const {
        const int row0 = u.pm * BM + wr * 64 + fr; const int col0 = u.pn * HALF + wc * 32 + 8 * fq;
#pragma unroll
        for (int ai = 0; ai < 2; ++ai)
#pragma unroll
            for (int m = 0; m < 4; ++m) { bf16_t* rowp = O + (size_t)(row0 + ai * HALF + m * 16) * ldc + col0;
                float v[8];
#pragma unroll
                for (int n = 0; n < 2; ++n)
#pragma unroll
                    for (int j = 0; j < 4; ++j) { const float g = acc[ai][0][m][n][j], up = acc[ai][1][m][n][j]; v[n * 4 + j] = silu_f(g) * up; }
                u32x4 w; w.x = cvt_pk_bf16(v[0], v[1]); w.y = cvt_pk_bf16(v[2], v[3]); w.z = cvt_pk_bf16(v[4], v[5]); w.w = cvt_pk_bf16(v[6], v[7]);
                *(u32x4*)rowp = w; }
    }
};

template <class Epi, class Sched>
__device__ __forceinline__ void gemm_phase(LAS unsigned char* lds, const Gemm g, const Sched& S, const Epi& E) {
    const int tid = ltid(), wid = __builtin_amdgcn_readfirstlane(tid >> 6), lane = tid & 63, wr = wid >> 2, wc = wid & 3, fr = lane & 15, fq = lane >> 4;
    const int K = g.ld, nt = g.K / BK;
    unsigned voffA[2], voffB[2];
#pragma unroll
    for (int i = 0; i < 2; ++i) { int R, C; stage_rc(tid * 16 + i * 8192, R, C); const int Rb = Epi::PERM ? ((R & ~31) + perm32(R & 31)) : R;
        voffA[i] = (unsigned)(R * K + C) * 2u; voffB[i] = (unsigned)(Rb * K + C) * 2u; }
    const size_t kstep = (size_t)(BK * 2);
    const size_t hstep = (size_t)HALF * K * 2;
    const size_t tstep = 2 * hstep;
    const unsigned ldsw = (unsigned)wid * 1024u;
    const int aoff = lds_byte(wr * 64 + fr, fq * 8), boff = lds_byte(wc * 32 + fr, fq * 8);
#define PG8_SA(b, h) (((b) * 2 + (h)) * HTB)
#define PG8_SB(b, h) ((4 + (b) * 2 + (h)) * HTB)
#define PG8_STAGE(bufoff, gbase, voff) do { _Pragma("unroll") for (int _i = 0; _i < 2; ++_i) \
        __builtin_amdgcn_global_load_lds((const unsigned*)((const char*)(gbase) + (voff)[_i]), (LAS unsigned*)(lds + (bufoff) + ldsw + _i * 8192), 16, 0, 0); } while (0)
#define PG8_LDA(dst, b, h) do { _Pragma("unroll") for (int m = 0; m < 4; ++m) _Pragma("unroll") for (int k = 0; k < 2; ++k) dst[m][k] = *(const LAS bf16x8*)(lds + PG8_SA(b, h) + aoff + m * 2048 + k * 1024); } while (0)
#define PG8_LDB(dst, b, h) do { _Pragma("unroll") for (int n = 0; n < 2; ++n) _Pragma("unroll") for (int k = 0; k < 2; ++k) dst[n][k] = *(const LAS bf16x8*)(lds + PG8_SB(b, h) + boff + n * 2048 + k * 1024); } while (0)
#define PG8_MMA(ai, bj, At, Bt) do { __builtin_amdgcn_s_setprio(1); _Pragma("unroll") for (int m = 0; m < 4; ++m) _Pragma("unroll") for (int n = 0; n < 2; ++n) _Pragma("unroll") for (int k = 0; k < 2; ++k) \
        acc[ai][bj][m][n] = __builtin_amdgcn_mfma_f32_16x16x32_bf16(Bt[n][k], At[m][k], acc[ai][bj][m][n], 0, 0, 0); __builtin_amdgcn_s_setprio(0); } while (0)
#define PG8_WAIT_V(n) asm volatile("s_waitcnt vmcnt(" #n ")" ::: "memory")
#define PG8_WAIT_L(n) asm volatile("s_waitcnt lgkmcnt(" #n ")" ::: "memory")
#define PG8_BAR __builtin_amdgcn_s_barrier()
#define PG8_SCHED __builtin_amdgcn_sched_barrier(0)
    Unit cur, nxt; int ui = 0;
    if (!S.next(0, cur)) return;
    f32x4 acc[2][2][4][2];
#pragma unroll
    for (int a = 0; a < 2; ++a)
#pragma unroll
        for (int b = 0; b < 2; ++b)
#pragma unroll
            for (int m = 0; m < 4; ++m)
#pragma unroll
                for (int n = 0; n < 2; ++n) acc[a][b][m][n] = (f32x4){0.f, 0.f, 0.f, 0.f};
    bf16x8 At[4][2], B0[2][2], B1[2][2];
    const char* cA = (const char*)g.A + (size_t)cur.pm * tstep; const char* cB = (const char*)g.Bt + (size_t)cur.pn * tstep;
    PG8_STAGE(PG8_SB(0, 0), cB, voffB); PG8_STAGE(PG8_SA(0, 0), cA, voffA); PG8_STAGE(PG8_SB(0, 1), cB + hstep, voffB); PG8_STAGE(PG8_SA(0, 1), cA + hstep, voffA);
    if (wr == 1) PG8_BAR;
    PG8_WAIT_V(4); PG8_BAR;
    PG8_STAGE(PG8_SB(1, 0), cB + kstep, voffB); PG8_STAGE(PG8_SA(1, 0), cA + kstep, voffA); PG8_STAGE(PG8_SB(1, 1), cB + hstep + kstep, voffB);
    PG8_WAIT_V(6); PG8_BAR;
    for (;;) {
        const bool has_next = S.next(ui + 1, nxt);
        const char* nA = has_next ? (const char*)g.A + (size_t)nxt.pm * tstep : cA; const char* nB = has_next ? (const char*)g.Bt + (size_t)nxt.pn * tstep : cB;
        for (int t = 0; t < nt; t += 2) {
            const bool last = (t == nt - 2);
            const char* a1 = cA + (size_t)(t + 1) * kstep;
            const char* a2 = last ? nA : cA + (size_t)(t + 2) * kstep; const char* b2 = last ? nB : cB + (size_t)(t + 2) * kstep;
            const char* a3 = a2 + kstep; const char* b3 = b2 + kstep;
            PG8_LDB(B0, 0, 0); PG8_SCHED; PG8_LDA(At, 0, 0); PG8_STAGE(PG8_SA(1, 1), a1 + hstep, voffA);
            PG8_WAIT_L(8); PG8_BAR; PG8_WAIT_L(0); PG8_MMA(0, 0, At, B0); PG8_BAR; PG8_SCHED;
            PG8_LDB(B1, 0, 1); PG8_STAGE(PG8_SB(0, 0), b2, voffB);
            PG8_BAR; PG8_WAIT_L(0); PG8_MMA(0, 1, At, B1); PG8_BAR;
            PG8_LDA(At, 0, 1); PG8_STAGE(PG8_SA(0, 0), a2, voffA);
            PG8_BAR; PG8_WAIT_L(0); PG8_MMA(1, 0, At, B0); PG8_BAR; PG8_SCHED;
            PG8_STAGE(PG8_SB(0, 1), b2 + hstep, voffB);
            PG8_WAIT_V(6); PG8_BAR; PG8_MMA(1, 1, At, B1); PG8_BAR;
            PG8_LDB(B0, 1, 0); PG8_SCHED; PG8_LDA(At, 1, 0); PG8_STAGE(PG8_SA(0, 1), a2 + hstep, voffA);
            PG8_WAIT_L(8); PG8_BAR; PG8_WAIT_L(0); PG8_MMA(0, 0, At, B0); PG8_BAR; PG8_SCHED;
            PG8_LDB(B1, 1, 1); PG8_STAGE(PG8_SB(1, 0), b3, voffB);
            PG8_BAR; PG8_WAIT_L(0); PG8_MMA(0, 1, At, B1); PG8_BAR;
            PG8_LDA(At, 1, 1); PG8_STAGE(PG8_SA(1, 0), a3, voffA);
            PG8_BAR; PG8_WAIT_L(0); PG8_MMA(1, 0, At, B0); PG8_BAR; PG8_SCHED;
            PG8_STAGE(PG8_SB(1, 1), b3 + hstep, voffB);
            PG8_WAIT_V(6); PG8_BAR; PG8_MMA(1, 1, At, B1); PG8_BAR;
        }
        E(acc, cur, wr, wc, fr, fq);
        if (!has_next) break;
#pragma unroll
        for (int a = 0; a < 2; ++a)
#pragma unroll
            for (int b = 0; b < 2; ++b)
#pragma unroll
                for (int m = 0; m < 4; ++m)
#pragma unroll
                    for (int n = 0; n < 2; ++n) acc[a][b][m][n] = (f32x4){0.f, 0.f, 0.f, 0.f};
        cur = nxt; cA = nA; cB = nB; ++ui;
    }
    PG8_WAIT_V(0);
    if (wr == 0) PG8_BAR;
    PG8_BAR;
#undef PG8_SA
#undef PG8_SB
#undef PG8_STAGE
#undef PG8_LDA
#undef PG8_LDB
#undef PG8_MMA
#undef PG8_WAIT_V
#undef PG8_WAIT_L
#undef PG8_BAR
#undef PG8_SCHED
}
}

template <class Epi>
__device__ __forceinline__ void run_gemm(unsigned char* smem, const bf16_t* A, const bf16_t* Bt, int M, int N, int K, const Epi& E) {
    pg8::Gemm g{A, Bt, M, N, K, K}; pg8::StaticOrder S; S.init(M, N, (int)gridDim.x, (int)blockIdx.x);
    pg8::gemm_phase<Epi, pg8::StaticOrder>((LAS unsigned char*)smem, g, S, E);
}
__device__ __forceinline__ void run_gemm_f32_split(unsigned char* smem, const bf16_t* A, const bf16_t* Bt, int M, int K, bf16_t* Yo, float* YP) {
    { pg8::Gemm g{A, Bt, TL, D, K, K}; pg8::StaticOrder S; S.init(TL, D, (int)gridDim.x, (int)blockIdx.x); pg8::EpiBf16 E{Yo, D, nullptr};
      pg8::gemm_phase<pg8::EpiBf16, pg8::StaticOrder>((LAS unsigned char*)smem, g, S, E); }
    __syncthreads();
    if (M > TL && blockIdx.x < 64) {
        const int ks = blockIdx.x >> 4;
        int koff, klen;
        if (K == DFF) { koff = (ks < 2) ? ks * 768 : 1536 + (ks - 2) * 640; klen = (ks < 2) ? 768 : 640; }
        else { klen = K / 4; koff = ks * klen; }
        pg8::Gemm g{A + (size_t)TL * K + koff, Bt + koff, TC, D, klen, K}; pg8::StaticOrder S; S.init(TC, D, 16, (int)(blockIdx.x & 15)); pg8::EpiF32 E{YP + (size_t)ks * TC * D, D};
        pg8::gemm_phase<pg8::EpiF32, pg8::StaticOrder>((LAS unsigned char*)smem, g, S, E);
        __syncthreads();
    }
}

__device__ __forceinline__ float* xrow(const KQ p, int t) { return t < TL ? p.out + (size_t)t * D : (float*)(p.ws + WS_XC) + (size_t)(t - TL) * D; }
__device__ __forceinline__ int modrow(int t) { return t < TL ? (t >> 12) : 4; }
__device__ __forceinline__ const float* modp(const KQ p, int l, int mr, int idx) { return (const float*)(p.ws + WS_MOD) + ((size_t)(l * 5 + mr) * NMOD + idx) * D; }

__device__ __forceinline__ void p0_setup(const KQ p_in, float* sm) {
    const KQ p = lq(p_in);
    const int tid = ltid(), bid = blockIdx.x, nb = gridDim.x;
    const int gtid = bid * 512 + tid, gthreads = nb * 512;
    {
        float* rope = (float*)(p.ws + WS_ROPE);
        for (int idx = gtid; idx < SEQ * 32; idx += gthreads) {
            const int t = idx >> 5, i = idx & 31;
            const int ii = i & 15; const float pos = (i < 16) ? (float)(t >> 6) : (float)(t & 63);
            const float invA = powf(10000.0f, -(float)ii / 16.0f);
            const float angA = pos * invA;
            rope[idx] = cosf(angA); rope[SEQ * 32 + idx] = sinf(angA);
            const float ex = (float)i * (1.0f / 31.0f);
            const float invR = powf(10000.0f, -ex);
            const float angR = (float)t * invR;
            rope[2 * SEQ * 32 + idx] = cosf(angR); rope[3 * SEQ * 32 + idx] = sinf(angR);
        }
    }
    {
        float* tile = sm;
        for (int gs = bid; gs < 20864 / 4; gs += nb) {
            const int g = gs * 4;
            int j, tl;
            if (g < 16896) { j = g / 704; tl = g % 704; }
            else if (g < 18304) { j = 24 + (g - 16896) / 704; tl = (g - 16896) % 704; }
            else if (g < 18816) { j = 26 + (g - 18304) / 256; tl = (g - 18304) % 256; }
            else if (g < 20352) { j = 28 + (g - 18816) / 768; tl = (g - 18816) % 768; }
            else { j = 30 + (g - 20352) / 256; tl = (g - 20352) % 256; }
            const float* src; bf16_t* dst; int K, N, mode = 0;
            if (j < 8) { src = pin_ld(8) + (size_t)j * D * DFF; dst = (bf16_t*)(p.ws + WS_WGU + (size_t)j * SZ_WGU); K = D; N = DFF; mode = 1; }
            else if (j < 16) { src = pin_ld(9) + (size_t)(j - 8) * D * DFF; dst = (bf16_t*)(p.ws + WS_WGU + (size_t)(j - 8) * SZ_WGU); K = D; N = DFF; mode = 2; }
            else if (j < 24) { src = pin_ld(10) + (size_t)(j - 16) * DFF * D; dst = (bf16_t*)(p.ws + WS_WD + (size_t)(j - 16) * SZ_WD); K = DFF; N = D; }
            else if (j < 26) { src = pin_ld(11) + (size_t)(j - 24) * D * INW; dst = (bf16_t*)(p.ws + WS_WIN + (size_t)(j - 24) * SZ_WIN); K = D; N = INW; mode = 3; }
            else if (j < 28) { src = pin_ld(14) + (size_t)(j - 26) * D * D; dst = (bf16_t*)(p.ws + WS_WOUT + (size_t)(j - 26) * SZ_WOUT); K = D; N = D; }
            else if (j < 30) { src = pin_ld(15) + (size_t)(j - 28) * D * HYW; dst = (bf16_t*)(p.ws + WS_HWIN + (size_t)(j - 28) * SZ_HWIN); K = D; N = HYW; }
            else { src = pin_ld(28) + (size_t)(j - 30) * D * D; dst = (bf16_t*)(p.ws + WS_HWOUT + (size_t)(j - 30) * SZ_WOUT); K = D; N = D; }
            const int ntn = N / 64; const int k0 = (tl / ntn) * 64, n0 = (tl % ntn) * 64;
            f32x4 ld[8];
#pragma unroll
            for (int i = 0; i < 8; ++i) ld[i] = *(const f32x4*)(src + (size_t)(k0 + i * 8 + (tid >> 6)) * N + n0 + (tid & 63) * 4);
            __syncthreads();
#pragma unroll
            for (int i = 0; i < 8; ++i) *(f32x4*)(tile + (i * 8 + (tid >> 6)) * 260 + (tid & 63) * 4) = ld[i];
            __syncthreads();
            {
                const int n = tid >> 1, kh = (tid & 1) * 32; const int gn = n0 + n;
                float sc_ = 1.0f; int row = gn;
                if (mode == 1) row = 256 * (gn >> 7) + (gn & 127);
                else if (mode == 2) row = 256 * (gn >> 7) + 128 + (gn & 127);
                else if (mode == 3) { if (gn < 512 || (gn >= 1792 && gn < 2304)) sc_ = 0.125f; }
#pragma unroll
                for (int q = 0; q < 4; ++q) {
                    float v[8];
#pragma unroll
                    for (int jj = 0; jj < 8; ++jj) v[jj] = tile[(kh + q * 8 + jj) * 260 + n] * sc_;
                    u32x4 o4; o4.x = pg8::cvt_pk_bf16(v[0], v[1]); o4.y = pg8::cvt_pk_bf16(v[2], v[3]); o4.z = pg8::cvt_pk_bf16(v[4], v[5]); o4.w = pg8::cvt_pk_bf16(v[6], v[7]);
                    *(u32x4*)(dst + (size_t)row * K + k0 + kh + q * 8) = o4;
                }
            }
        }
        __syncthreads();
    }
    {
        float* sc = sm;
        float* red = sm + 5 * 1024;
        for (int i = tid; i < 5 * 1024; i += 512) { const int r = i >> 10, k = i & 1023; const float v = (r < 4) ? pin_ld(1)[r * D + k] : pin_ld(3)[k]; sc[i] = silu_f(v); }
        __syncthreads();
        const int w = tid >> 6, lane = tid & 63;
        for (int it = bid; it < 288; it += nb) {
            const int l = it / 72, c0 = (it % 72) * 128;
            const float* wm = pin_ld(4) + (size_t)l * D * (NMOD * D) + c0 + 2 * lane;
            float a[5][2];
#pragma unroll
            for (int r = 0; r < 5; ++r) { a[r][0] = 0.f; a[r][1] = 0.f; }
            for (int kb = w * 128; kb < w * 128 + 128; kb += 16) {
                float2 wv[16];
#pragma unroll
                for (int q = 0; q < 16; ++q) wv[q] = *(const float2*)(wm + (size_t)(kb + q) * (NMOD * D));
#pragma unroll
                for (int q = 0; q < 16; ++q)
#pragma unroll
                    for (int r = 0; r < 5; ++r) { const float s = sc[r * 1024 + kb + q]; a[r][0] += s * wv[q].x; a[r][1] += s * wv[q].y; }
            }
#pragma unroll
            for (int r = 0; r < 5; ++r) { red[(w * 5 + r) * 128 + 2 * lane] = a[r][0]; red[(w * 5 + r) * 128 + 2 * lane + 1] = a[r][1]; }
            __syncthreads();
            for (int i = tid; i < 5 * 128; i += 512) {
                const int r = i >> 7, c = i & 127; float s = 0.f;
#pragma unroll
                for (int ww = 0; ww < 8; ++ww) s += red[(ww * 5 + r) * 128 + c];
                s += pin_ld(5)[(size_t)l * (NMOD * D) + c0 + c];
                ((float*)(p.ws + WS_MOD))[(size_t)(l * 5 + r) * (NMOD * D) + c0 + c] = s;
            }
            __syncthreads();
        }
    }
    {
        float* z = sm;
        float* a1 = sm + 16 * 36;
        float* a2 = a1 + 16 * 64;
        float* a3 = a2 + 16 * 64;
        float* tl = a3 + 16 * 64;
        float* wl = tl + 16;
        const float HMAX = -4.605170185988091f / 0.3f, HMIN = -4.605170185988091f / 1.5f;
        int o_loaded = -1;
        for (int it = nb - 1 - bid; it < 544; it += nb) {
            const int o = it / 272, r = it % 272;
            const int Lf = (r < 256) ? SEQ : CL; const int p0 = (r < 256) ? r * 16 : (r - 256) * 16;
            float* kf = (float*)(p.ws + WS_KF + (size_t)o * SZ_KF) + ((r < 256) ? (size_t)0 : (size_t)2 * SEQ * D);
            const float* f3 = pin_ld(25) + (size_t)o * 64 * 2048;
            __syncthreads();
            if (o != o_loaded) {
                const float* f0 = pin_ld(19) + (size_t)o * 33 * 64; const float* f1 = pin_ld(21) + (size_t)o * 64 * 64; const float* f2 = pin_ld(23) + (size_t)o * 64 * 64;
                for (int i = tid; i < 33 * 64; i += 512) wl[i] = f0[i];
                for (int i = tid; i < 64 * 64; i += 512) { wl[2112 + i] = f1[i]; wl[2112 + 4096 + i] = f2[i]; }
                if (tid < 64) { wl[10304 + tid] = pin_ld(20)[o * 64 + tid]; wl[10304 + 64 + tid] = pin_ld(22)[o * 64 + tid]; wl[10304 + 128 + tid] = pin_ld(24)[o * 64 + tid]; wl[10304 + 192 + tid] = pin_ld(26)[o * 64 + tid]; }
                o_loaded = o;
            }
            const float* f0 = wl; const float* f1 = wl + 2112; const float* f2 = wl + 2112 + 4096;
            const float* fb0 = wl + 10304; const float* fb1 = fb0 + 64; const float* fb2 = fb0 + 128; const float* fq = fb0 + 192;
            for (int idx = tid; idx < 16 * 33; idx += 512) {
                const int ps = idx / 33, f = idx % 33; const int i = p0 + ps;
                const float tlin = (float)i * (1.0f / (float)(Lf - 1));
                const float w = (6.283185307179586f * (float)i) / (float)Lf;
                float v;
                if (f == 0) { v = tlin; tl[ps] = tlin; }
                else { const int jj = (f - 1) & 15; const float fj = 1e-4f + (float)jj * ((15.0f - 1e-4f) / 15.0f); v = (f <= 16) ? cosf(fj * w) : -sinf(fj * w); }
                z[ps * 36 + f] = v;
            }
            __syncthreads();
            for (int idx = tid; idx < 16 * 64; idx += 512) { const int ps = idx >> 6, oc = idx & 63; float s = fb0[oc];
                for (int f = 0; f < 33; ++f) s += z[ps * 36 + f] * f0[f * 64 + oc];
                a1[idx] = sinf(fq[oc] * s); }
            __syncthreads();
            for (int idx = tid; idx < 16 * 64; idx += 512) { const int ps = idx >> 6, oc = idx & 63; float s = fb1[oc];
                for (int f = 0; f < 64; ++f) s += a1[ps * 64 + f] * f1[f * 64 + oc];
                a2[idx] = sinf(fq[oc] * s); }
            __syncthreads();
            for (int idx = tid; idx < 16 * 64; idx += 512) { const int ps = idx >> 6, oc = idx & 63; float s = fb2[oc];
                for (int f = 0; f < 64; ++f) s += a2[ps * 64 + f] * f2[f * 64 + oc];
                a3[oc * 16 + ps] = sinf(fq[oc] * s); }
            __syncthreads();
            {
                float acc[4][16];
#pragma unroll
                for (int q = 0; q < 4; ++q)
#pragma unroll
                    for (int ps = 0; ps < 16; ++ps) acc[q][ps] = 0.f;
                for (int fb = 0; fb < 64; fb += 4) {
                    float wv[4][4];
#pragma unroll
                    for (int f = 0; f < 4; ++f)
#pragma unroll
                        for (int q = 0; q < 4; ++q) wv[f][q] = f3[(fb + f) * 2048 + tid + 512 * q];
#pragma unroll
                    for (int f = 0; f < 4; ++f) {
                        const f32x4 av0 = *(const f32x4*)(a3 + (fb + f) * 16), av1 = *(const f32x4*)(a3 + (fb + f) * 16 + 4), av2 = *(const f32x4*)(a3 + (fb + f) * 16 + 8), av3 = *(const f32x4*)(a3 + (fb + f) * 16 + 12);
#pragma unroll
                        for (int q = 0; q < 4; ++q)
#pragma unroll
                            for (int e = 0; e < 4; ++e) { acc[q][e] += av0[e] * wv[f][q]; acc[q][4 + e] += av1[e] * wv[f][q]; acc[q][8 + e] += av2[e] * wv[f][q]; acc[q][12 + e] += av3[e] * wv[f][q]; }
                    }
                }
#pragma unroll
                for (int q = 0; q < 4; ++q) {
                    const int c = tid + 512 * q; const int dir = c >> 10, d = c & 1023;
                    const float delta = fabsf(HMIN + (float)d * ((HMAX - HMIN) / 1023.0f));
#pragma unroll
                    for (int ps = 0; ps < 16; ++ps) {
                        const float kvv = acc[q][ps] * expf(-tl[ps] * delta);
                        if (r < 256) {
                            bf16_t* rk = (bf16_t*)(p.ws + WS_KF + (size_t)o * SZ_KF) + (size_t)d * 8192;
                            const int m = p0 + ps;
                            if (dir == 0) rk[4095 - m] = f2bf(kvv); else if (m > 0) rk[4095 + m] = f2bf(kvv);
                            if (dir == 0 && m == 0) rk[8191] = 0;
                        } else kf[((size_t)dir * Lf + p0 + ps) * D + d] = kvv;
                    }
                }
            }
        }
        __syncthreads();
    }
}

__device__ __forceinline__ void rowphase(const KQ p_in, int Mupd, const bf16_t* Y, int lu, int gidx, float wgt, const float* gpost,
                         int Mnext, int ln, const float* gpre, int shidx, int scidx, bf16_t* Hout, bool from_input) {
    const KQ p = lq(p_in);
    const int tid = ltid(), w = tid >> 6, lane = tid & 63;
    const int Mmax = Mupd > Mnext ? Mupd : Mnext;
    for (int t = (blockIdx.x * 8 + w) * 2; t < Mmax; t += gridDim.x * 16) {
        float* xr = xrow(p, t); const int mr = modrow(t);
        const float* xs = xr;
        if (from_input) xs = (t < TL) ? pin_ld(0) + (size_t)t * D : pin_ld(2) + (size_t)(t - TL) * D;
        float4 xv[2][4];
#pragma unroll
        for (int rr = 0; rr < 2; ++rr)
#pragma unroll
            for (int q = 0; q < 4; ++q) xv[rr][q] = *(const float4*)(xs + rr * D + q * 256 + lane * 4);
        if (Y != nullptr && t < Mupd) {
            float4 yv[2][4]; float ss[2] = {0.f, 0.f};
#pragma unroll
            for (int rr = 0; rr < 2; ++rr)
#pragma unroll
                for (int q = 0; q < 4; ++q) {
                    if (t < TL) { const bf16x4 yb = *(const bf16x4*)(Y + (size_t)(t + rr) * D + q * 256 + lane * 4);
                        yv[rr][q] = make_float4(bf2f((bf16_t)yb[0]), bf2f((bf16_t)yb[1]), bf2f((bf16_t)yb[2]), bf2f((bf16_t)yb[3])); }
                    else { const float* yp = (const float*)(p.ws + WS_YP) + (size_t)(t + rr - TL) * D + q * 256 + lane * 4;
                        const float4 a0 = *(const float4*)yp, a1 = *(const float4*)(yp + (size_t)TC * D), a2 = *(const float4*)(yp + (size_t)2 * TC * D), a3 = *(const float4*)(yp + (size_t)3 * TC * D);
                        yv[rr][q] = make_float4(a0.x + a1.x + a2.x + a3.x, a0.y + a1.y + a2.y + a3.y, a0.z + a1.z + a2.z + a3.z, a0.w + a1.w + a2.w + a3.w); }
                    ss[rr] += yv[rr][q].x * yv[rr][q].x + yv[rr][q].y * yv[rr][q].y + yv[rr][q].z * yv[rr][q].z + yv[rr][q].w * yv[rr][q].w; }
            ss[0] = wave_sum(ss[0]); ss[1] = wave_sum(ss[1]);
            float wgl = wgt; asm volatile("" : "+v"(wgl));
            const float r0 = rsqrtf(ss[0] * (1.0f / D) + EPS) * wgl, r1 = rsqrtf(ss[1] * (1.0f / D) + EPS) * wgl;
            const float* gm = modp(p, lu, mr, gidx);
#pragma unroll
            for (int q = 0; q < 4; ++q) {
                const float4 g4 = *(const float4*)(gm + q * 256 + lane * 4); const float4 p4 = *(const float4*)(gpost + q * 256 + lane * 4);
                const float cx = g4.x * p4.x, cy = g4.y * p4.y, cz = g4.z * p4.z, cw = g4.w * p4.w;
                xv[0][q].x += r0 * cx * yv[0][q].x; xv[0][q].y += r0 * cy * yv[0][q].y; xv[0][q].z += r0 * cz * yv[0][q].z; xv[0][q].w += r0 * cw * yv[0][q].w;
                xv[1][q].x += r1 * cx * yv[1][q].x; xv[1][q].y += r1 * cy * yv[1][q].y; xv[1][q].z += r1 * cz * yv[1][q].z; xv[1][q].w += r1 * cw * yv[1][q].w;
                *(float4*)(xr + q * 256 + lane * 4) = xv[0][q]; *(float4*)(xr + D + q * 256 + lane * 4) = xv[1][q];
            }
        }
        if (Hout != nullptr && t < Mnext) {
            float ss[2] = {0.f, 0.f};
#pragma unroll
            for (int rr = 0; rr < 2; ++rr)
#pragma unroll
                for (int q = 0; q < 4; ++q) ss[rr] += xv[rr][q].x * xv[rr][q].x + xv[rr][q].y * xv[rr][q].y + xv[rr][q].z * xv[rr][q].z + xv[rr][q].w * xv[rr][q].w;
            ss[0] = wave_sum(ss[0]); ss[1] = wave_sum(ss[1]);
            const float rn[2] = {rsqrtf(ss[0] * (1.0f / D) + EPS), rsqrtf(ss[1] * (1.0f / D) + EPS)};
            const float* sh = modp(p, ln, mr, shidx); const float* sc = modp(p, ln, mr, scidx);
#pragma unroll
            for (int q = 0; q < 4; ++q) {
                const float4 g4 = *(const float4*)(gpre + q * 256 + lane * 4); const float4 s4 = *(const float4*)(sc + q * 256 + lane * 4); const float4 h4 = *(const float4*)(sh + q * 256 + lane * 4);
                const float mx_ = g4.x * (1.0f + s4.x), my_ = g4.y * (1.0f + s4.y), mz_ = g4.z * (1.0f + s4.z), mw_ = g4.w * (1.0f + s4.w);
#pragma unroll
                for (int rr = 0; rr < 2; ++rr) {
                    const float h0 = xv[rr][q].x * rn[rr] * mx_ + h4.x, h1 = xv[rr][q].y * rn[rr] * my_ + h4.y;
                    const float h2 = xv[rr][q].z * rn[rr] * mz_ + h4.z, h3 = xv[rr][q].w * rn[rr] * mw_ + h4.w;
                    uint2 pk; pk.x = pg8::cvt_pk_bf16(h0, h1); pk.y = pg8::cvt_pk_bf16(h2, h3);
                    *(uint2*)(Hout + (size_t)(t + rr) * D + q * 256 + lane * 4) = pk;
                }
            }
        }
    }
}

__device__ __forceinline__ float log_sigmoid(float x) { return -log1pf(expf(-x)); }
__device__ __forceinline__ int chunk_t0(int b, int cidx) { return cidx < 32 ? b * SEQ + cidx * 128 : TL + b * CL + (cidx - 32) * 128; }

__device__ __forceinline__ void m1_rope_states(const KQ p_in, int e, float* sm) {
    const KQ p = lq(p_in);
    const int tid = ltid(), bid = blockIdx.x, nb = gridDim.x;
    bf16_t* Z = (bf16_t*)(p.ws + WS_BIG);
    const float* rope = (const float*)(p.ws + WS_ROPE);
    for (int idx = bid * 512 + tid; idx < TL * 72; idx += nb * 512) {
        const int t = idx / 72, r = idx % 72; const int hd = r >> 2, i0 = (r & 3) * 8;
        const int cb = hd < 16 ? hd * 64 : 1536 + (hd - 16) * 64;
        const int tb = (hd >= 8 && hd < 16) ? 2 : 0; const int pos = t & (SEQ - 1);
        const float* cp = rope + (size_t)tb * SEQ * 32 + pos * 32 + i0; const float* sp = cp + (size_t)SEQ * 32;
        bf16_t* zp = Z + (size_t)t * INW + cb + i0;
        const bf16x8 a1 = *(const bf16x8*)zp, a2 = *(const bf16x8*)(zp + 32);
        const float4 c0 = *(const float4*)cp, c1 = *(const float4*)(cp + 4), s0 = *(const float4*)sp, s1 = *(const float4*)(sp + 4);
        const float cc[8] = {c0.x, c0.y, c0.z, c0.w, c1.x, c1.y, c1.z, c1.w}, sn[8] = {s0.x, s0.y, s0.z, s0.w, s1.x, s1.y, s1.z, s1.w};
        float o1[8], o2[8];
#pragma unroll
        for (int j = 0; j < 8; ++j) { const float x1 = bf2f((bf16_t)a1[j]), x2 = bf2f((bf16_t)a2[j]); o1[j] = x1 * cc[j] - x2 * sn[j]; o2[j] = x1 * sn[j] + x2 * cc[j]; }
        u32x4 w1, w2;
        w1.x = pg8::cvt_pk_bf16(o1[0], o1[1]); w1.y = pg8::cvt_pk_bf16(o1[2], o1[3]); w1.z = pg8::cvt_pk_bf16(o1[4], o1[5]); w1.w = pg8::cvt_pk_bf16(o1[6], o1[7]);
        w2.x = pg8::cvt_pk_bf16(o2[0], o2[1]); w2.y = pg8::cvt_pk_bf16(o2[2], o2[3]); w2.z = pg8::cvt_pk_bf16(o2[4], o2[5]); w2.w = pg8::cvt_pk_bf16(o2[6], o2[7]);
        *(u32x4*)zp = w1; *(u32x4*)(zp + 32) = w2;
    }
    float* Ks = sm;
    float* Vs = sm + 128 * 64;
    float* wf = Vs + 128 * 64;
    float* wb = wf + 128;
    float* AF = (float*)(p.ws + WS_ST); float* AB = AF + SZ_ST / 4;
    const float* dec = pin_ld(13) + e * 16;
    for (int it = bid; it < NB * NCH * 8; it += nb) {
        const int h = it & 7, cidx = (it >> 3) % NCH, b = it / (8 * NCH);
        const int t0 = chunk_t0(b, cidx); const bool lat = cidx < 32;
        const float lgf = log_sigmoid(dec[h]), lgb = log_sigmoid(dec[8 + h]);
        __syncthreads();
        if (tid < 128) { wf[tid] = expf(lgf * (float)(127 - tid)); wb[tid] = expf(lgb * (float)tid); }
        const int kc = 1792 + h * 64, vc = 2304 + h * 64;
#pragma unroll
        for (int q = 0; q < 8; ++q) {
            const int idx = tid + 512 * q; const int r = idx >> 5, i = idx & 31;
            bf16_t* zp = Z + (size_t)(t0 + r) * INW + kc + i;
            float x1 = bf2f(zp[0]), x2 = bf2f(zp[32]);
            if (lat) {
                const int pos = (t0 + r) & (SEQ - 1);
                const float c = rope[(size_t)2 * SEQ * 32 + pos * 32 + i], s = rope[(size_t)3 * SEQ * 32 + pos * 32 + i];
                const bf16_t o1 = f2bf(x1 * c - x2 * s), o2 = f2bf(x1 * s + x2 * c);
                zp[0] = o1; zp[32] = o2; x1 = bf2f(o1); x2 = bf2f(o2);
            }
            Ks[r * 64 + i] = x1; Ks[r * 64 + 32 + i] = x2;
        }
#pragma unroll
        for (int q = 0; q < 16; ++q) { const int idx = tid + 512 * q; const int r = idx >> 6, c = idx & 63; Vs[idx] = bf2f(Z[(size_t)(t0 + r) * INW + vc + c]); }
        __syncthreads();
        const int d = tid >> 3, e0 = (tid & 7) * 8;
        float af[8], ab[8];
#pragma unroll
        for (int j = 0; j < 8; ++j) { af[j] = 0.f; ab[j] = 0.f; }
        for (int s = 0; s < 128; ++s) {
            const float kv = Ks[s * 64 + d]; const float kfw = kv * wf[s], kbw = kv * wb[s];
            const float4 v0 = *(const float4*)(Vs + s * 64 + e0), v1 = *(const float4*)(Vs + s * 64 + e0 + 4);
            af[0] += kfw * v0.x; af[1] += kfw * v0.y; af[2] += kfw * v0.z; af[3] += kfw * v0.w; af[4] += kfw * v1.x; af[5] += kfw * v1.y; af[6] += kfw * v1.z; af[7] += kfw * v1.w;
            ab[0] += kbw * v0.x; ab[1] += kbw * v0.y; ab[2] += kbw * v0.z; ab[3] += kbw * v0.w; ab[4] += kbw * v1.x; ab[5] += kbw * v1.y; ab[6] += kbw * v1.z; ab[7] += kbw * v1.w;
        }
        const size_t so = ((size_t)(b * NCH + cidx) * 8 + h) * 4096 + d * 64 + e0;
        *(float4*)(AF + so) = make_float4(af[0], af[1], af[2], af[3]); *(float4*)(AF + so + 4) = make_float4(af[4], af[5], af[6], af[7]);
        *(float4*)(AB + so) = make_float4(ab[0], ab[1], ab[2], ab[3]); *(float4*)(AB + so + 4) = make_float4(ab[4], ab[5], ab[6], ab[7]);
    }
    __syncthreads();
}

__device__ __forceinline__ void m2_scan(const KQ p_in, int e) {
    const KQ p = lq(p_in);
    const float* __restrict__ AF = (const float*)(p.ws + WS_ST); const float* __restrict__ AB = AF + SZ_ST / 4;
    float* __restrict__ TF = (float*)(p.ws + WS_ST) + 2 * (SZ_ST / 4); float* __restrict__ TB = TF + SZ_ST / 4;
    const float* dec = pin_ld(13) + e * 16;
    for (int idx = blockIdx.x * 512 + ltid(); idx < NB * 8 * 4096; idx += gridDim.x * 512) {
        const int el = idx & 4095, h = (idx >> 12) & 7, b = idx >> 15;
        const float gf = expf(log_sigmoid(dec[h]) * 128.0f), gb = expf(log_sigmoid(dec[8 + h]) * 128.0f);
        const size_t base = ((size_t)(b * NCH) * 8 + h) * 4096 + el; constexpr size_t CS = (size_t)8 * 4096;
        float af[NCH], ab[NCH];
#pragma unroll
        for (int c = 0; c < NCH; ++c) { af[c] = AF[base + c * CS]; ab[c] = AB[base + c * CS]; }
        TF[base + 32 * CS] = 0.f; TF[base + 33 * CS] = af[32]; TB[base + 33 * CS] = 0.f; TB[base + 32 * CS] = ab[33];
        float sf = gf * af[32] + af[33], sb = ab[32] + gb * ab[33];
#pragma unroll
        for (int c = 0; c < 32; ++c) { TF[base + c * CS] = sf; sf = gf * sf + af[c]; }
#pragma unroll
        for (int c = 31; c >= 0; --c) { TB[base + c * CS] = sb; sb = ab[c] + gb * sb; }
    }
}

__device__ __forceinline__ bf16x8 pack8(const f32x4& a, const f32x4& b) {
    u32x4 w; w.x = pg8::cvt_pk_bf16(a[0], a[1]); w.y = pg8::cvt_pk_bf16(a[2], a[3]); w.z = pg8::cvt_pk_bf16(b[0], b[1]); w.w = pg8::cvt_pk_bf16(b[2], b[3]);
    return __builtin_bit_cast(bf16x8, w);
}
__device__ __forceinline__ void m3_outputs(const KQ p_in, int e, bool ctx_full, unsigned char* smem) {
    const KQ p = lq(p_in);
    const int tid = ltid(), bid = blockIdx.x, nb = gridDim.x;
    const int w = tid >> 6, lane = tid & 63, ln = lane & 15, g4 = lane >> 4;
    const bf16_t* Z = (const bf16_t*)(p.ws + WS_BIG);
    bf16_t* MIX = (bf16_t*)(p.ws + WS_MIX);
    const float* dec = pin_ld(13) + e * 16;
    const float* sink = pin_ld(12) + e * 8;
    const float* TF = (const float*)(p.ws + WS_ST) + 2 * (SZ_ST / 4); const float* TB = TF + SZ_ST / 4;
    const int nchunk = ctx_full ? NCH : 32;
    const int nitems = NB * nchunk * 8;
    bf16_t* Kt = (bf16_t*)smem;
    bf16_t* Vt = Kt + 128 * 72;
    bf16_t* TfT = Vt + 64 * 136;
    bf16_t* TbT = TfT + 64 * 72;
    const int i = 16 * w + ln;
    for (int it = bid; it < 2 * nitems; it += nb) {
        const bool is_attn = it < nitems; const int ii = is_attn ? it : it - nitems;
        const int h = ii & 7, cidx = (ii >> 3) % nchunk, b = ii / (8 * nchunk);
        const int t0 = chunk_t0(b, cidx); const bool lat = cidx < 32;
        f32x4 O[4];
#pragma unroll
        for (int m = 0; m < 4; ++m) O[m] = (f32x4){0.f, 0.f, 0.f, 0.f};
        if (!is_attn) {
            const float lgf = log_sigmoid(dec[h]), lgb = log_sigmoid(dec[8 + h]);
            __syncthreads();
#pragma unroll
            for (int q = 0; q < 2; ++q) { const int idx = tid + 512 * q; const int r = idx >> 3, pc = idx & 7; const bf16_t* zr = Z + (size_t)(t0 + r) * INW + h * 64 + pc * 8;
                *(u32x4*)(Kt + r * 72 + pc * 8) = *(const u32x4*)(zr + 1792);
                const bf16x8 vv = *(const bf16x8*)(zr + 2304);
#pragma unroll
                for (int j = 0; j < 8; ++j) Vt[(pc * 8 + j) * 136 + r] = (bf16_t)vv[j]; }
            const size_t so = ((size_t)(b * NCH + cidx) * 8 + h) * 4096;
#pragma unroll
            for (int q = 0; q < 8; ++q) { const int idx = tid + 512 * q; const int d = idx >> 6, ee = idx & 63; TfT[ee * 72 + d] = f2bf(TF[so + idx]); TbT[ee * 72 + d] = f2bf(TB[so + idx]); }
            __builtin_amdgcn_sched_barrier(0);
            bf16x8 qf[2], qff[2], qfb[2];
            { const bf16_t* qr = Z + (size_t)(t0 + i) * INW + 512 + h * 64 + 8 * g4;
              const float cf = __expf(lgf * (float)(i + 1)), cb = __expf(lgb * (float)(128 - i));
#pragma unroll
              for (int k2 = 0; k2 < 2; ++k2) { qf[k2] = *(const bf16x8*)(qr + 32 * k2);
                  f32x4 a0, a1, b0, b1;
#pragma unroll
                  for (int j = 0; j < 4; ++j) { const float x0 = bf2f((bf16_t)qf[k2][j]), x1 = bf2f((bf16_t)qf[k2][4 + j]); a0[j] = x0 * cf; a1[j] = x1 * cf; b0[j] = x0 * cb; b1[j] = x1 * cb; }
                  qff[k2] = pack8(a0, a1); qfb[k2] = pack8(b0, b1); } }
            __builtin_amdgcn_sched_barrier(0);
            __syncthreads();
#pragma unroll
            for (int m = 0; m < 4; ++m)
#pragma unroll
                for (int k2 = 0; k2 < 2; ++k2) {
                    const bf16x8 af = *(const bf16x8*)(TfT + (16 * m + ln) * 72 + 32 * k2 + 8 * g4);
                    const bf16x8 ab = *(const bf16x8*)(TbT + (16 * m + ln) * 72 + 32 * k2 + 8 * g4);
                    O[m] = __builtin_amdgcn_mfma_f32_16x16x32_bf16(af, qff[k2], O[m], 0, 0, 0);
                    O[m] = __builtin_amdgcn_mfma_f32_16x16x32_bf16(ab, qfb[k2], O[m], 0, 0, 0);
                    __builtin_amdgcn_sched_barrier(0);
                }
            const float lf2 = lgf * 1.44269504f, lb2 = lgb * 1.44269504f; const int di = i - 4 * g4;
            const float bfw = lf2 * (float)di, bbw = -lb2 * (float)di;
            f32x4 st[8];
#pragma unroll
            for (int mt = 0; mt < 8; ++mt) {
                f32x4 a = (f32x4){0.f, 0.f, 0.f, 0.f};
#pragma unroll
                for (int k2 = 0; k2 < 2; ++k2) { const bf16x8 kf = *(const bf16x8*)(Kt + (16 * mt + ln) * 72 + 32 * k2 + 8 * g4); a = __builtin_amdgcn_mfma_f32_16x16x32_bf16(kf, qf[k2], a, 0, 0, 0); }
#pragma unroll
                for (int rg = 0; rg < 4; ++rg) { const int cc = 16 * mt + rg; const int df = di - cc;
                    const float arg = (df > 0) ? fmaf(-lf2, (float)cc, bfw) : fmaf(lb2, (float)cc, bbw);
                    float wgt = __builtin_amdgcn_exp2f(arg); wgt = (df == 0) ? 2.0f : wgt;
                    a[rg] *= wgt; }
                st[mt] = a;
                __builtin_amdgcn_sched_barrier(0);
            }
#pragma unroll
            for (int ks = 0; ks < 4; ++ks) {
                const bf16x8 pfr = pack8(st[2 * ks], st[2 * ks + 1]);
#pragma unroll
                for (int m = 0; m < 4; ++m) {
                    const bf16_t* vr = Vt + (16 * m + ln) * 136 + 32 * ks + 4 * g4;
                    const bf16x4 v0 = *(const bf16x4*)vr, v1 = *(const bf16x4*)(vr + 16);
                    const bf16x8 vf = __builtin_shufflevector(v0, v1, 0, 1, 2, 3, 4, 5, 6, 7);
                    O[m] = __builtin_amdgcn_mfma_f32_16x16x32_bf16(vf, pfr, O[m], 0, 0, 0);
                }
                __builtin_amdgcn_sched_barrier(0);
            }
            float ss = 0.f;
#pragma unroll
            for (int m = 0; m < 4; ++m)
#pragma unroll
                for (int rg = 0; rg < 4; ++rg) ss += O[m][rg] * O[m][rg];
            ss += __shfl_xor(ss, 16, 64); ss += __shfl_xor(ss, 32, 64);
            const float rn = rsqrtf(ss * (1.0f / 64.0f) + EPS);
#pragma unroll
            for (int m = 0; m < 4; ++m) {
                const int ee = 16 * m + 4 * g4;
                const bf16x4 gv = *(const bf16x4*)(Z + (size_t)(t0 + i) * INW + 1024 + h * 64 + ee);
                uint2 o2; o2.x = pg8::cvt_pk_bf16(O[m][0] * rn * silu_f(bf2f((bf16_t)gv[0])), O[m][1] * rn * silu_f(bf2f((bf16_t)gv[1])));
                o2.y = pg8::cvt_pk_bf16(O[m][2] * rn * silu_f(bf2f((bf16_t)gv[2])), O[m][3] * rn * silu_f(bf2f((bf16_t)gv[3])));
                *(uint2*)(MIX + (size_t)(t0 + i) * D + 512 + h * 64 + ee) = o2;
            }
        } else {
            const int gk = h >> 2;
            bf16x8 qf[2];
            { const bf16_t* qr = Z + (size_t)(t0 + i) * INW + h * 64 + 8 * g4; qf[0] = *(const bf16x8*)qr; qf[1] = *(const bf16x8*)(qr + 32); }
            float mx = sink[h], l = (g4 == 0) ? 1.0f : 0.0f;
            const int qpos = lat ? (cidx * 128 + i) : 0;
#define ATT_VALID(tl_) ((tl_) >= 3 || (lat && (cidx - 1 + (tl_)) >= 0 && (cidx - 1 + (tl_)) < 32))
#define ATT_KT0(tl_) ((tl_) >= 3 ? TL + b * CL + ((tl_) - 3) * 128 : b * SEQ + (cidx - 1 + (tl_)) * 128)
            int tl = 0; while (!ATT_VALID(tl)) ++tl;
            u32x4 kreg[2]; bf16x8 vreg[2];
            { const int kt0 = ATT_KT0(tl);
#pragma unroll
              for (int q = 0; q < 2; ++q) { const int idx = tid + 512 * q; const int r = idx >> 3, pc = idx & 7; const bf16_t* zr = Z + (size_t)(kt0 + r) * INW + gk * 64 + pc * 8;
                  kreg[q] = *(const u32x4*)(zr + 1536); vreg[q] = *(const bf16x8*)(zr + 1664); } }
            while (tl < 5) {
                const bool isc = tl >= 3; const int kp0 = isc ? 0 : (cidx - 1 + tl) * 128;
                __syncthreads();
#pragma unroll
                for (int q = 0; q < 2; ++q) { const int idx = tid + 512 * q; const int r = idx >> 3, pc = idx & 7;
                    *(u32x4*)(Kt + r * 72 + pc * 8) = kreg[q];
#pragma unroll
                    for (int j = 0; j < 8; ++j) Vt[(pc * 8 + j) * 136 + r] = (bf16_t)vreg[q][j]; }
                __syncthreads();
                int tn = tl + 1; while (tn < 5 && !ATT_VALID(tn)) ++tn;
                if (tn < 5) { const int kt0 = ATT_KT0(tn);
#pragma unroll
                    for (int q = 0; q < 2; ++q) { const int idx = tid + 512 * q; const int r = idx >> 3, pc = idx & 7; const bf16_t* zr = Z + (size_t)(kt0 + r) * INW + gk * 64 + pc * 8;
                        kreg[q] = *(const u32x4*)(zr + 1536); vreg[q] = *(const bf16x8*)(zr + 1664); } }
                f32x4 st[8];
                float mloc = -1e30f;
#pragma unroll
                for (int mt = 0; mt < 8; ++mt) {
                    f32x4 a = (f32x4){0.f, 0.f, 0.f, 0.f};
#pragma unroll
                    for (int k2 = 0; k2 < 2; ++k2) { const bf16x8 kf = *(const bf16x8*)(Kt + (16 * mt + ln) * 72 + 32 * k2 + 8 * g4); a = __builtin_amdgcn_mfma_f32_16x16x32_bf16(kf, qf[k2], a, 0, 0, 0); }
                    if (!isc) {
#pragma unroll
                        for (int rg = 0; rg < 4; ++rg) { const int dd = qpos - (kp0 + 16 * mt + 4 * g4 + rg); if (dd > 128 || dd < -128) a[rg] = -1e30f; }
                    }
#pragma unroll
                    for (int rg = 0; rg < 4; ++rg) mloc = fmaxf(mloc, a[rg]);
                    st[mt] = a;
                    __builtin_amdgcn_sched_barrier(0);
                }
                mloc = fmaxf(mloc, __shfl_xor(mloc, 16, 64)); mloc = fmaxf(mloc, __shfl_xor(mloc, 32, 64));
                const float mnew = fmaxf(mx, mloc);
                const float sc = __expf(mx - mnew); mx = mnew; l *= sc;
#pragma unroll
                for (int m = 0; m < 4; ++m) O[m] *= sc;
#pragma unroll
                for (int mt = 0; mt < 8; ++mt)
#pragma unroll
                    for (int rg = 0; rg < 4; ++rg) { const float pv = __expf(st[mt][rg] - mnew); st[mt][rg] = pv; l += pv; }
#pragma unroll
                for (int ks = 0; ks < 4; ++ks) {
                    const bf16x8 pfr = pack8(st[2 * ks], st[2 * ks + 1]);
#pragma unroll
                    for (int m = 0; m < 4; ++m) {
                        const bf16_t* vr = Vt + (16 * m + ln) * 136 + 32 * ks + 4 * g4;
                        const bf16x4 v0 = *(const bf16x4*)vr, v1 = *(const bf16x4*)(vr + 16);
                        const bf16x8 vf = __builtin_shufflevector(v0, v1, 0, 1, 2, 3, 4, 5, 6, 7);
                        O[m] = __builtin_amdgcn_mfma_f32_16x16x32_bf16(vf, pfr, O[m], 0, 0, 0);
                    }
                    __builtin_amdgcn_sched_barrier(0);
                }
                tl = tn;
            }
#undef ATT_VALID
#undef ATT_KT0
            l += __shfl_xor(l, 16, 64); l += __shfl_xor(l, 32, 64);
            const float inv = 1.0f / l;
#pragma unroll
            for (int m = 0; m < 4; ++m) {
                uint2 o2; o2.x = pg8::cvt_pk_bf16(O[m][0] * inv, O[m][1] * inv); o2.y = pg8::cvt_pk_bf16(O[m][2] * inv, O[m][3] * inv);
                *(uint2*)(MIX + (size_t)(t0 + i) * D + h * 64 + 16 * m + 4 * g4) = o2;
            }
        }
    }
    __syncthreads();
}

__device__ __forceinline__ void h2_shortconv(const KQ p_in, int o, int M, unsigned char* smem) {
    const KQ p = lq(p_in);
    const int tid = ltid();
    const bf16_t* ZH = (const bf16_t*)(p.ws + WS_BIG);
    const float* w = pin_ld(17) + (size_t)o * 3 * HYW; const float* bs = pin_ld(18) + (size_t)o * HYW;
    bf16_t* VXT = (bf16_t*)(p.ws + WS_Y); bf16_t* X0T = VXT + (size_t)D * TL;
    bf16_t* tx = (bf16_t*)smem;
    bf16_t* tv = tx + 64 * 72;
    const int tok = tid >> 3, cg8 = (tid & 7) * 8;
    float* wl = (float*)(smem + 32768);
    { const int c0b = (blockIdx.x & 15) * 64;
      for (int i = tid; i < 768; i += 512) { const int k = i >> 8, q = (i >> 6) & 3, c = i & 63; const int col = k * 1024 + c0b + c; wl[i] = (q < 3) ? w[q * HYW + col] : bs[col]; } }
    __syncthreads();
    for (int it = blockIdx.x; it < (TL / 64) * 16; it += gridDim.x) {
        const int c0 = (it & 15) * 64, t0 = (it >> 4) * 64;
        const int t = t0 + tok; const int pos = t & (SEQ - 1); const bool first = pos == 0, last = pos == SEQ - 1;
        float zz[3][8];
#pragma unroll
        for (int k = 0; k < 3; ++k) {
            const int c = k * 1024 + c0 + cg8;
            const bf16x8 zc = *(const bf16x8*)(ZH + (size_t)t * HYW + c);
            bf16x8 zp = zc, zn = zc;
            if (!first) zp = *(const bf16x8*)(ZH + (size_t)(t - 1) * HYW + c);
            if (!last) zn = *(const bf16x8*)(ZH + (size_t)(t + 1) * HYW + c);
            const float* wk = wl + k * 256 + cg8;
#pragma unroll
            for (int j = 0; j < 8; ++j) {
                float sacc = wk[192 + j] + bf2f((bf16_t)zc[j]) * wk[64 + j];
                if (!first) sacc += bf2f((bf16_t)zp[j]) * wk[j];
                if (!last) sacc += bf2f((bf16_t)zn[j]) * wk[128 + j];
                zz[k][j] = sacc;
            }
        }
        __syncthreads();
#pragma unroll
        for (int j = 0; j < 8; ++j) { tx[(cg8 + j) * 72 + tok] = f2bf(zz[0][j]); tv[(cg8 + j) * 72 + tok] = f2bf(zz[2][j] * zz[1][j]); }
        __syncthreads();
        { const int ch = tid >> 3, tk = (tid & 7) * 8;
          *(u32x4*)(X0T + (size_t)(c0 + ch) * TL + t0 + tk) = *(const u32x4*)(tx + ch * 72 + tk);
          *(u32x4*)(VXT + (size_t)(c0 + ch) * TL + t0 + tk) = *(const u32x4*)(tv + ch * 72 + tk); }
    }
    __syncthreads();
    if (M > TL) {
        float* VX = (float*)(p.ws + WS_Y); bf16_t* X0 = (bf16_t*)(p.ws + WS_H);
        for (int idx = TL * D + blockIdx.x * 512 + tid; idx < M * D; idx += gridDim.x * 512) {
            const int t = idx >> 10, d = idx & 1023;
            const int pos = (t - TL) & (CL - 1); const bool first = pos == 0, last = pos == CL - 1;
            float zz[3];
#pragma unroll
            for (int k = 0; k < 3; ++k) {
                const int c = k * 1024 + d;
                float sacc = bs[c] + bf2f(ZH[(size_t)t * HYW + c]) * w[HYW + c];
                if (!first) sacc += bf2f(ZH[(size_t)(t - 1) * HYW + c]) * w[c];
                if (!last) sacc += bf2f(ZH[(size_t)(t + 1) * HYW + c]) * w[2 * HYW + c];
                zz[k] = sacc;
            }
            VX[idx] = zz[2] * zz[1]; X0[idx] = f2bf(zz[0]);
        }
    }
}

typedef float f32x16 __attribute__((ext_vector_type(16)));
__device__ __forceinline__ void h3_longconv(const KQ p_in, int o, bool ctx_full, unsigned char* smem) {
    const KQ p = lq(p_in);
    const int tid = ltid(), w = tid >> 6, lane = tid & 63;
    const float* bias = pin_ld(27) + (size_t)o * D;
    {
        const bf16_t* VXT = (const bf16_t*)(p.ws + WS_Y); const bf16_t* X0T = VXT + (size_t)D * TL;
        bf16_t* HMT = (bf16_t*)(p.ws + WS_H);
        const bf16_t* RKT = (const bf16_t*)(p.ws + WS_KF + (size_t)o * SZ_KF);
        constexpr int RK2_OFF = 16384 + 64, U_OFF = 2 * 16384 + 128, CH_BYTES = U_OFF + 142 * 256;
        const int cw = w >> 2, w4 = w & 3;
        const int ct = tid & 255;
        unsigned char* cb = smem + cw * CH_BYTES;
        unsigned char* ub = cb + U_OFF;
        const int r = lane & 31, hh = lane >> 5;
        for (int pr = blockIdx.x; pr < D / 2; pr += gridDim.x) {
            const int d = pr * 2 + cw;
            __syncthreads();
            { const bf16_t* src = RKT + (size_t)d * 8192;
              for (int i = ct; i < 1024; i += 256) *(u32x4*)(cb + i * 16) = *(const u32x4*)(src + i * 8);
              for (int i = ct; i < 2 * 7 * 4 * 4; i += 256) { const int side = i / 112, rem = i % 112; unsigned z0 = 0u; asm volatile("" : "+v"(z0)); *(u32x4*)(ub + (side ? (135 * 4 * 64) : 0) + rem * 16) = (u32x4){z0, z0, z0, z0}; }
#pragma unroll 4
              for (int i = ct; i < 4 * 512; i += 256) { const int b = i >> 9, pc = i & 511;
                  const u32x4 v = *(const u32x4*)(VXT + (size_t)d * TL + b * SEQ + pc * 8);
                  const int col = ((pc >> 2) + 7) * 4 + b, q = pc & 3;
                  *(u32x4*)(ub + col * 64 + ((q ^ ((col >> 2) & 3)) * 16)) = v; } }
            __syncthreads();
            { const bf16_t* rk = (const bf16_t*)cb; bf16_t* rk2 = (bf16_t*)(cb + RK2_OFF);
#pragma unroll 4
              for (int i = ct; i < 4096; i += 256) { const unsigned lo = rk[2 * i + 1]; const unsigned hi = (2 * i + 2 < 8192) ? rk[2 * i + 2] : 0u; *(unsigned*)(rk2 + 2 * i) = lo | (hi << 16); } }
            __syncthreads();
            f32x16 acc[4];
#pragma unroll
            for (int j = 0; j < 4; ++j)
#pragma unroll
                for (int q = 0; q < 16; ++q) acc[j][q] = 0.f;
            const bf16_t* rsel = (const bf16_t*)(cb + ((r & 1) ? 0 : RK2_OFF));
            const int adj = (r & 1) ? 0 : -1;
            const int bq = r & 3;
#define H3_LOAD(AF, BF, U) do { \
                _Pragma("unroll") for (int s2 = 0; s2 < 2; ++s2) { \
                    const unsigned* ap = (const unsigned*)(Ab + 64 * (3 - (U)) + 32 * s2); \
                    u32x4 t4; t4.x = ap[0]; t4.y = ap[1]; t4.z = ap[2]; t4.w = ap[3]; \
                    AF[s2] = __builtin_bit_cast(bf16x8, t4); } \
                _Pragma("unroll") for (int j = 0; j < 4; ++j) { \
                    int c_ = Lb - 256 * (U) + 2048 * j; c_ = c_ < LO ? LO : (c_ > HI ? HI : c_); \
                    BF[j][0] = *(const bf16x8*)(ub + c_ + off[U][0]); BF[j][1] = *(const bf16x8*)(ub + c_ + off[U][1]); } } while (0)
#define H3_MMA(AF, BF) do { \
                _Pragma("unroll") for (int s2 = 0; s2 < 2; ++s2) \
                _Pragma("unroll") for (int j = 0; j < 4; ++j) acc[j] = __builtin_amdgcn_mfma_f32_32x32x16_bf16(AF[s2], BF[j][s2], acc[j], 0, 0, 0); } while (0)
            {
                const int dlo = 32 * w4 - 127;
                const int LO = (24 + bq) * 64, HI = (540 + bq) * 64;
                int off[4][2];
#pragma unroll
                for (int u = 0; u < 4; ++u) { const int sw = ((r >> 2) + 2 - u) & 3; off[u][0] = (hh ^ sw) * 16; off[u][1] = ((2 + hh) ^ sw) * 16; }
                int Lb = (((r >> 2) + 134) * 4 + bq) * 64;
                const unsigned char* Ab = (const unsigned char*)(rsel + (4095 - 32 * dlo - r + 8 * hh + adj)) - 192;
                bf16x8 afA[2], bfA[4][2], afB[2], bfB[4][2];
                H3_LOAD(afA, bfA, 0);
                for (int g = 0; g < 39; ++g) {
                    H3_LOAD(afB, bfB, 1);
                    __builtin_amdgcn_sched_barrier(0);
                    H3_MMA(afA, bfA);
                    __builtin_amdgcn_sched_barrier(0);
                    H3_LOAD(afA, bfA, 2);
                    __builtin_amdgcn_sched_barrier(0);
                    H3_MMA(afB, bfB);
                    __builtin_amdgcn_sched_barrier(0);
                    H3_LOAD(afB, bfB, 3);
                    __builtin_amdgcn_sched_barrier(0);
                    H3_MMA(afA, bfA);
                    __builtin_amdgcn_sched_barrier(0);
                    Ab -= 256; Lb -= 1024;
                    H3_LOAD(afA, bfA, 0);
                    __builtin_amdgcn_sched_barrier(0);
                    H3_MMA(afB, bfB);
                    __builtin_amdgcn_sched_barrier(0);
                }
                H3_LOAD(afB, bfB, 1);
                __builtin_amdgcn_sched_barrier(0);
                H3_MMA(afA, bfA);
                __builtin_amdgcn_sched_barrier(0);
                H3_LOAD(afA, bfA, 2);
                __builtin_amdgcn_sched_barrier(0);
                H3_MMA(afB, bfB);
                H3_MMA(afA, bfA);
            }
#undef H3_LOAD
#undef H3_MMA
            __syncthreads();
            const float bd = bias[d];
#pragma unroll
            for (int j = 0; j < 4; ++j) {
                const int n1 = 8 * (4 * w4 + j) + (r >> 2);
                const int col = (n1 + 7) * 4 + bq; const int sw = (col >> 2) & 3;
                bf16_t* up = (bf16_t*)(ub + col * 64);
#pragma unroll
                for (int q4 = 0; q4 < 4; ++q4) {
                    bf16_t* pp = up + ((q4 ^ sw) * 8) + 4 * hh;
                    const bf16x4 uv = *(const bf16x4*)pp;
                    uint2 o2; o2.x = pg8::cvt_pk_bf16(acc[j][4 * q4] + bd * bf2f((bf16_t)uv[0]), acc[j][4 * q4 + 1] + bd * bf2f((bf16_t)uv[1]));
                    o2.y = pg8::cvt_pk_bf16(acc[j][4 * q4 + 2] + bd * bf2f((bf16_t)uv[2]), acc[j][4 * q4 + 3] + bd * bf2f((bf16_t)uv[3]));
                    *(uint2*)pp = o2;
                }
            }
            __syncthreads();
#pragma unroll 2
            for (int i = ct; i < 4 * 512; i += 256) { const int b = i >> 9, pc = i & 511;
                const int col = ((pc >> 2) + 7) * 4 + b, q = pc & 3;
                const bf16x8 yv = *(const bf16x8*)(ub + col * 64 + ((q ^ ((col >> 2) & 3)) * 16));
                const size_t gi = (size_t)d * TL + b * SEQ + pc * 8;
                const bf16x8 xv = *(const bf16x8*)(X0T + gi);
                u32x4 o4;
                o4.x = pg8::cvt_pk_bf16(bf2f((bf16_t)yv[0]) * bf2f((bf16_t)xv[0]), bf2f((bf16_t)yv[1]) * bf2f((bf16_t)xv[1]));
                o4.y = pg8::cvt_pk_bf16(bf2f((bf16_t)yv[2]) * bf2f((bf16_t)xv[2]), bf2f((bf16_t)yv[3]) * bf2f((bf16_t)xv[3]));
                o4.z = pg8::cvt_pk_bf16(bf2f((bf16_t)yv[4]) * bf2f((bf16_t)xv[4]), bf2f((bf16_t)yv[5]) * bf2f((bf16_t)xv[5]));
                o4.w = pg8::cvt_pk_bf16(bf2f((bf16_t)yv[6]) * bf2f((bf16_t)xv[6]), bf2f((bf16_t)yv[7]) * bf2f((bf16_t)xv[7]));
                *(u32x4*)(HMT + gi) = o4; }
        }
        __syncthreads();
    }
    if (ctx_full) {
        const float* VX = (const float*)(p.ws + WS_Y); const bf16_t* X0 = (const bf16_t*)(p.ws + WS_H);
        bf16_t* MIX = (bf16_t*)(p.ws + WS_MIX);
        const float* kf = (const float*)(p.ws + WS_KF + (size_t)o * SZ_KF) + (size_t)2 * SEQ * D;
        for (int idx = blockIdx.x * 512 + tid; idx < (TC / 8) * D; idx += gridDim.x * 512) {
            const int d = idx & 1023, og = idx >> 10;
            const int bb = og >> 5, n0 = (og & 31) * 8, tb = TL + bb * CL;
            const float* up = VX + (size_t)tb * D + d;
            float acc[8];
#pragma unroll
            for (int j = 0; j < 8; ++j) acc[j] = 0.f;
#pragma unroll 1
            for (int mb = 0; mb < CL; mb += 8) {
                float kk[15], uu[8];
#pragma unroll
                for (int q = 0; q < 15; ++q) { const int lag = n0 - mb - 7 + q;
                    kk[q] = (lag >= 0) ? ((lag < CL) ? kf[(size_t)lag * D + d] : 0.f) : ((-lag < CL) ? kf[(size_t)(CL - lag) * D + d] : 0.f); }
#pragma unroll
                for (int u = 0; u < 8; ++u) uu[u] = up[(size_t)(mb + u) * D];
#pragma unroll
                for (int u = 0; u < 8; ++u)
#pragma unroll
                    for (int j = 0; j < 8; ++j) acc[j] += uu[u] * kk[7 - u + j];
            }
            const float bd = bias[d];
#pragma unroll
            for (int j = 0; j < 8; ++j) { const size_t ti = (size_t)(tb + n0 + j) * D + d; MIX[ti] = f2bf(bf2f(X0[ti]) * (acc[j] + bd * VX[ti])); }
        }
    }
}

__device__ __forceinline__ void h3b_transpose(const KQ p_in, unsigned char* smem) {
    const KQ p = lq(p_in);
    const int tid = ltid();
    const bf16_t* HMT = (const bf16_t*)(p.ws + WS_H); bf16_t* MIX = (bf16_t*)(p.ws + WS_MIX);
    bf16_t* tile = (bf16_t*)smem;
    for (int it = blockIdx.x; it < (TL / 64) * 16; it += gridDim.x) {
        const int c0 = (it & 15) * 64, t0 = (it >> 4) * 64;
        __syncthreads();
        { const int ch = tid >> 3, tk = (tid & 7) * 8; *(u32x4*)(tile + ch * 72 + tk) = *(const u32x4*)(HMT + (size_t)(c0 + ch) * TL + t0 + tk); }
        __syncthreads();
        { const int tok = tid >> 3, cg8 = (tid & 7) * 8; unsigned short v[8];
#pragma unroll
          for (int j = 0; j < 8; ++j) v[j] = tile[(cg8 + j) * 72 + tok];
          u32x4 o4; o4.x = v[0] | ((unsigned)v[1] << 16); o4.y = v[2] | ((unsigned)v[3] << 16); o4.z = v[4] | ((unsigned)v[5] << 16); o4.w = v[6] | ((unsigned)v[7] << 16);
          *(u32x4*)(MIX + (size_t)(t0 + tok) * D + c0 + cg8) = o4; }
    }
    __syncthreads();
}

__global__ void __launch_bounds__(512, 2) mega_fwd(KP kp) {
    unsigned char* const smem = g_smem;
    if (threadIdx.x < 29) *(LAS unsigned long long*)((LAS unsigned char*)g_smem + PTAB_OFF + 8 * threadIdx.x) = ((const unsigned long long*)__builtin_amdgcn_kernarg_segment_ptr())[threadIdx.x];
    KQ p; p.out = kp.out; p.ws = kp.ws;
    cg::grid_group grid = cg::this_grid();
    if (threadIdx.x < 4) ((volatile LAS unsigned*)(LAS unsigned char*)smem)[(LDS_BYTES - 16) / 4 + threadIdx.x] = 0u;
    __syncthreads();
    if (threadIdx.x == 0) (void)xb_add(&((unsigned*)(lq(p).ws + WS_BAR))[XB_XCNT(xb_xcc_id())], 1u);
    grid.sync();
    float* smf = (float*)smem;
#define Hb ((bf16_t*)(lq(p).ws + WS_H))
#define BIG ((bf16_t*)(lq(p).ws + WS_BIG))
#define Y ((bf16_t*)(lq(p).ws + WS_Y))
#define MIX ((bf16_t*)(lq(p).ws + WS_MIX))

#ifndef NO_P0
    p0_setup(p, smf);
#endif
    GRID_BAR();
    rowphase(p, 0, nullptr, 0, 0, 0.f, nullptr, T, 0, pin_ld(6), 0, 1, Hb, true);
    GRID_BAR();
    for (int l = 0; l < 4; ++l) {
        const bool ctx_live = l <= 2, ctx_full = l < 2;
        const int Mff = ctx_live ? T : TL, Mpost = ctx_full ? T : TL;
        for (int sub = 0; sub < 3; ++sub) {
            if (sub != 1) {
                const int fi = sub >> 1; const int M = (sub == 0) ? Mff : Mpost;
                { pg8::EpiSwiGLU E{BIG, DFF}; run_gemm(smem, Hb, (const bf16_t*)(lq(p).ws + WS_WGU + (size_t)(l * 2 + fi) * SZ_WGU), M, 2 * DFF, D, E); }
                GRID_BAR();
                run_gemm_f32_split(smem, BIG, (const bf16_t*)(lq(p).ws + WS_WD + (size_t)(l * 2 + fi) * SZ_WD), M, DFF, Y, (float*)(lq(p).ws + WS_YP));
                GRID_BAR();
                if (sub == 0) rowphase(p, M, Y, l, 2, 0.5f, pin_ld(7) + (size_t)(l * 3 + 0) * D, Mff, l, pin_ld(6) + (size_t)(l * 3 + 1) * D, 3, 4, Hb, l == 0);
                else {
                    const int ln = l + 1; const int Mn = (ln < 4) ? ((ln <= 2) ? T : TL) : 0;
                    rowphase(p, M, Y, l, 8, 0.5f, pin_ld(7) + (size_t)(l * 3 + 2) * D, Mn, ln < 4 ? ln : l, pin_ld(6) + (size_t)((ln < 4 ? ln : l) * 3 + 0) * D, 0, 1, ln < 4 ? Hb : nullptr, false);
                }
                GRID_BAR();
            } else {
                if ((l & 1) == 0) {
                    const int e = l >> 1;
                    { pg8::EpiBf16 E{BIG, INW, nullptr}; run_gemm(smem, Hb, (const bf16_t*)(lq(p).ws + WS_WIN + (size_t)e * SZ_WIN), Mff, INW, D, E); }
                    GRID_BAR();
#ifndef NO_M1
                    m1_rope_states(p, e, smf);
#endif
                    GRID_BAR();
#ifndef NO_M2
                    m2_scan(p, e);
#endif
                    GRID_BAR();
#ifndef NO_M3
                    m3_outputs(p, e, ctx_full, smem);
#endif
                    GRID_BAR();
                    run_gemm_f32_split(smem, MIX, (const bf16_t*)(lq(p).ws + WS_WOUT + (size_t)e * SZ_WOUT), Mpost, D, Y, (float*)(lq(p).ws + WS_YP));
                    GRID_BAR();
                } else {
                    const int o = l >> 1;
                    { pg8::EpiBf16 E{BIG, HYW, pin_ld(16) + (size_t)o * HYW}; run_gemm(smem, Hb, (const bf16_t*)(lq(p).ws + WS_HWIN + (size_t)o * SZ_HWIN), Mpost, HYW, D, E); }
                    GRID_BAR();
#ifndef NO_H2
                    h2_shortconv(p, o, Mpost, smem);
#endif
                    GRID_BAR();
#ifndef NO_H3
                    h3_longconv(p, o, ctx_full, smem);
#endif
                    GRID_BAR();
                    h3b_transpose(p, smem);
                    GRID_BAR();
                    run_gemm_f32_split(smem, MIX, (const bf16_t*)(lq(p).ws + WS_HWOUT + (size_t)o * SZ_WOUT), Mpost, D, Y, (float*)(lq(p).ws + WS_YP));
                    GRID_BAR();
                }
                rowphase(p, Mpost, Y, l, 5, 1.0f, pin_ld(7) + (size_t)(l * 3 + 1) * D, Mpost, l, pin_ld(6) + (size_t)(l * 3 + 2) * D, 6, 7, Hb, false);
                GRID_BAR();
            }
        }
    }
}

extern "C" void kernel_launch(void* const* d_in, const int* in_sizes, int n_in, void* d_out, int out_size, void* d_ws, size_t ws_size, hipStream_t stream) {
    static int grid = 0;
    if (grid == 0) {
        if (n_in != 29 || out_size != TL * D || ws_size < WS_END) { fprintf(stderr, "kernel_launch: unexpected shapes: n_in %d out %d ws %zu (need %zu)\n", n_in, out_size, ws_size, (size_t)WS_END); grid = -1; return; }
        int dev = 0, cus = 0, per_cu = 0;
        (void)hipGetDevice(&dev);
        (void)hipDeviceGetAttribute(&cus, hipDeviceAttributeMultiprocessorCount, dev);
        if (hipFuncSetAttribute((const void*)mega_fwd, hipFuncAttributeMaxDynamicSharedMemorySize, LDS_BYTES) != hipSuccess) { fprintf(stderr, "kernel_launch: hipFuncSetAttribute failed\n"); grid = -1; return; }
        if (hipOccupancyMaxActiveBlocksPerMultiprocessor(&per_cu, (const void*)mega_fwd, 512, LDS_BYTES) != hipSuccess || per_cu < 1) { fprintf(stderr, "kernel_launch: occupancy query says %d\n", per_cu); per_cu = 1; }
        (void)hipGetLastError();
        grid = cus;
    }
    if (grid < 0) return;
    (void)hipMemsetAsync((unsigned char*)d_ws + WS_BAR, 0, 16384, stream);
    KP kp{};
    for (int i = 0; i < 29; ++i) kp.in[i] = (const float*)d_in[i];
    kp.out = (float*)d_out; kp.ws = (unsigned char*)d_ws;
    void* args[] = {&kp};
    hipError_t e = hipLaunchCooperativeKernel((const void*)mega_fwd, dim3(grid), dim3(512), args, LDS_BYTES, stream);
    if (e != hipSuccess) fprintf(stderr, "cooperative launch failed: %s (grid %d)\n", hipGetErrorString(e), grid);
}
```

```cpp
#include <hip/hip_runtime.h>
#include <hip/hip_cooperative_groups.h>
#include <cstdio>
namespace cg = cooperative_groups;

#define LAS __attribute__((address_space(3)))
typedef unsigned short bf16_t;
typedef short bf16x8 __attribute__((ext_vector_type(8)));
typedef short bf16x4 __attribute__((ext_vector_type(4)));
typedef float f32x4 __attribute__((ext_vector_type(4)));
typedef unsigned u32x4 __attribute__((ext_vector_type(4)));

constexpr int D = 1024, NB = 4, SEQ = 4096, CL = 256, TL = NB * SEQ, TC = NB * CL, T = TL + TC, DFF = 2816, INW = 2816, HYW = 3072;
constexpr int NMOD = 9;
constexpr float EPS = 1e-6f;
constexpr int NCH = 34;
constexpr int LDS_BYTES = 144 * 1024;

constexpr size_t SZ_WGU = (size_t)2 * DFF * D * 2, SZ_WD = (size_t)D * DFF * 2, SZ_WIN = (size_t)INW * D * 2, SZ_WOUT = (size_t)D * D * 2, SZ_HWIN = (size_t)HYW * D * 2;
constexpr size_t WS_WGU = 0;
constexpr size_t WS_WD = WS_WGU + 8 * SZ_WGU;
constexpr size_t WS_WIN = WS_WD + 8 * SZ_WD;
constexpr size_t WS_WOUT = WS_WIN + 2 * SZ_WIN;
constexpr size_t WS_HWIN = WS_WOUT + 2 * SZ_WOUT;
constexpr size_t WS_HWOUT = WS_HWIN + 2 * SZ_HWIN;
constexpr size_t WS_MOD = WS_HWOUT + 2 * SZ_WOUT;
constexpr size_t WS_ROPE = WS_MOD + (size_t)4 * 5 * NMOD * D * 4;
constexpr size_t WS_XC = WS_ROPE + (size_t)4 * SEQ * 32 * 4;
constexpr size_t WS_H = WS_XC + (size_t)TC * D * 4;
constexpr size_t WS_BIG = WS_H + (size_t)T * D * 2;
constexpr size_t WS_Y = WS_BIG + (size_t)T * HYW * 2;
constexpr size_t WS_MIX = WS_Y + (size_t)T * D * 4;
constexpr size_t SZ_ST = (size_t)NB * NCH * 8 * 4096 * 4;
constexpr size_t WS_ST = WS_MIX + (size_t)T * D * 2;
constexpr size_t SZ_KF = (size_t)(SEQ + CL) * 2 * D * 4;
constexpr size_t WS_KF = WS_ST + 4 * SZ_ST;
constexpr size_t WS_YP = WS_KF + 2 * SZ_KF;
constexpr size_t WS_BAR = WS_YP + (size_t)4 * TC * D * 4;
constexpr size_t WS_CNT = WS_BAR + 16384;
constexpr size_t SZ_CNT = (size_t)12 * 2 * 64 * 256;
constexpr size_t WS_SLOT = WS_CNT + SZ_CNT;
constexpr size_t WS_END = WS_SLOT + (size_t)2 * TL * 4 * 4;

struct KP { const float* in[29]; float* out; unsigned char* ws; };
extern __shared__ __attribute__((aligned(16))) unsigned char g_smem[];
constexpr int PTAB_OFF = LDS_BYTES - 512;
__device__ __forceinline__ const float* pin_ld(int k) {
    const unsigned long long v = *(volatile LAS unsigned long long*)((LAS unsigned char*)g_smem + PTAB_OFF + 8 * k);
    const unsigned lo = __builtin_amdgcn_readfirstlane((unsigned)v), hi = __builtin_amdgcn_readfirstlane((unsigned)(v >> 32));
    return (const float*)(((unsigned long long)hi << 32) | lo);
}
struct KQ { float* out; unsigned char* ws; };
__device__ __forceinline__ KQ lq(KQ q) { asm volatile("" : "+s"(q.out), "+s"(q.ws)); return q; }

__device__ __forceinline__ bf16_t f2bf(float f) { unsigned u = __float_as_uint(f); u += 0x7FFFu + ((u >> 16) & 1u); return (bf16_t)(u >> 16); }
__device__ __forceinline__ float bf2f(bf16_t b) { return __uint_as_float(((unsigned)b) << 16); }
__device__ __forceinline__ float silu_f(float x) { return x * __builtin_amdgcn_rcpf(1.0f + __expf(-x)); }
__device__ __forceinline__ int ltid() { int t = threadIdx.x; asm volatile("" : "+v"(t)); return t; }
__device__ __forceinline__ float wave_sum(float v) {
#pragma unroll
    for (int o = 32; o > 0; o >>= 1) v += __shfl_xor(v, o, 64);
    return v;
}


#define XB_TMO      128
#define XB_XCNT(j)  (256  + 64 * (j))
#define XB_XSUB(j)  (1280 + 64 * (j))
#define XB_XGEN(j)  (2304 + 64 * (j))
#define XB_TOP      3328
#define XB_TOPGEN   3392
#define XCD_BAR_WORDS 3456
#define XB_SPIN_CAP (1u << 18)
__device__ __forceinline__ unsigned xb_ld(unsigned* p)              { return __hip_atomic_load(p, __ATOMIC_RELAXED, __HIP_MEMORY_SCOPE_AGENT); }
__device__ __forceinline__ unsigned xb_add(unsigned* p, unsigned v) { return __hip_atomic_fetch_add(p, v, __ATOMIC_RELAXED, __HIP_MEMORY_SCOPE_AGENT); }
__device__ __forceinline__ unsigned xb_xcc_id() { return (unsigned)__builtin_amdgcn_s_getreg((3 << 11) | 20) & 0xFu; }
#define XB_SPIN(cond, bar) do { unsigned _sp = 0; while (cond) { __builtin_amdgcn_s_sleep(1); \
    if ((++_sp & 255u) == 0u) { if (xb_ld(&(bar)[XB_TMO])) break; if (_sp > XB_SPIN_CAP) { atomicAdd(&(bar)[XB_TMO], 1u); break; } } } } while (0)
struct XcdBarrier { unsigned* bar; unsigned x; volatile LAS unsigned* st; };
__device__ __forceinline__ XcdBarrier xcd_barrier_post(unsigned* bar, volatile LAS unsigned* st) {
    XcdBarrier b; b.bar = bar; b.x = xb_xcc_id(); b.st = st;
    if (threadIdx.x == 0) (void)xb_add(&bar[XB_XCNT(b.x)], 1u);
    return b;
}
__device__ __forceinline__ void xcd_barrier_complete(unsigned* bar, unsigned x, unsigned& nloc, unsigned& nx) {
    const unsigned G = gridDim.x * gridDim.y * gridDim.z;
    unsigned sum, cnt, mine, sp = 0u;
    for (;;) {
        sum = 0u; cnt = 0u; mine = 0u;
#pragma unroll
        for (unsigned j = 0; j < 16; ++j) { const unsigned c = xb_ld(&bar[XB_XCNT(j)]); sum += c; cnt += (c > 0u) ? 1u : 0u; mine = (j == x) ? c : mine; }
        if (sum == G) break;
        __builtin_amdgcn_s_sleep(1);
        if ((++sp & 255u) == 0u) { if (xb_ld(&bar[XB_TMO])) break; if (sp > XB_SPIN_CAP) { atomicAdd(&bar[XB_TMO], 1u); break; } }
    }
    nloc = mine > 0u ? mine : 1u; nx = cnt > 0u ? cnt : 1u;
}
__device__ __forceinline__ void xcd_barrier_impl(unsigned* bar, volatile LAS unsigned* st) {
    asm volatile("s_waitcnt vmcnt(0)" ::: "memory");
    __syncthreads();
    if (ltid() == 0) {
        const unsigned x = xb_xcc_id();
        __builtin_amdgcn_s_waitcnt(0);
        unsigned nloc = st[0], nx = st[1];
        if (nloc == 0u) { xcd_barrier_complete(bar, x, nloc, nx); st[0] = nloc; st[1] = nx; }
        const unsigned old = xb_add(&bar[XB_XSUB(x)], 1u);
        const unsigned gen = old / nloc;
        if (old + 1u == (gen + 1u) * nloc) {
            __builtin_amdgcn_fence(__ATOMIC_RELEASE, "agent");
            asm volatile("s_waitcnt vmcnt(0)" ::: "memory");
            const unsigned og = xb_add(&bar[XB_TOP], 1u);
            const unsigned tg = og / nx;
            if (og + 1u == (tg + 1u) * nx) xb_add(&bar[XB_TOPGEN], 1u);
            else XB_SPIN(xb_ld(&bar[XB_TOPGEN]) == tg, bar);
            __builtin_amdgcn_fence(__ATOMIC_ACQUIRE, "agent");
            xb_add(&bar[XB_XGEN(x)], 1u);
            asm volatile("s_waitcnt vmcnt(0)" ::: "memory");
        } else {
            XB_SPIN(xb_ld(&bar[XB_XGEN(x)]) == gen, bar);
            __builtin_amdgcn_fence(__ATOMIC_ACQUIRE, "agent");
            asm volatile("s_waitcnt vmcnt(0)" ::: "memory");
        }
    }
    __syncthreads();
}
#define GRID_BAR() xcd_barrier_impl((unsigned*)(p.ws + WS_BAR), (volatile LAS unsigned*)((LAS unsigned char*)smem + LDS_BYTES - 16))

namespace pg8 {
constexpr int BM = 256, BK = 64, HALF = 128, HTB = HALF * BK * 2, STAGE_BYTES = 8 * HTB, NXCD = 8, WGM = 8;
__host__ __device__ __forceinline__ int lds_byte(int r, int c) { const int st = (r >> 4) * 2 + (c >> 5), rr = r & 15, cc = c & 31, ob = rr * 64 + cc * 2; return st * 1024 + (ob ^ (((ob >> 9) & 1) << 5)); }
__host__ __device__ __forceinline__ void stage_rc(int b, int& R, int& C) { const int st = b / 1024, sb = b % 1024, swz = sb ^ (((sb >> 9) & 1) << 5); R = (st >> 1) * 16 + swz / 64; C = (st & 1) * 32 + (swz % 64) / 2; }
__host__ __device__ __forceinline__ int perm32(int rho) { const int n = rho >> 4, i = rho & 15; return 8 * (i >> 2) + 4 * n + (i & 3); }
struct Unit { int pm, pn; };
struct Gemm { const bf16_t* A; const bf16_t* Bt; int M, N, K, ld; };
struct StaticOrder {
    int nM, nN, nwg, G, c;
    __device__ void init(int M, int N, int G_, int c_) { nM = M / BM; nN = N / BM; nwg = nM * nN; G = G_; c = c_; }
    __device__ bool next(int i, Unit& u) const {
        const long Lx = (long)i * G + c; if (Lx >= nwg) return false;
        int wgid = (int)Lx; { const int q = nwg / NXCD, r = nwg % NXCD, xcd = wgid % NXCD, off = wgid / NXCD; wgid = (xcd < r ? xcd * (q + 1) : r * (q + 1) + (xcd - r) * q) + off; }
        const int nig = WGM * nN, gid = wgid / nig, fm = gid * WGM, gsz = (nM - fm) < WGM ? (nM - fm) : WGM;
        u.pm = fm + ((wgid % nig) % gsz); u.pn = (wgid % nig) / gsz; return true;
    }
};
__device__ __forceinline__ unsigned cvt_pk_bf16(float lo, float hi) { unsigned r; asm volatile("v_cvt_pk_bf16_f32 %0, %1, %2" : "=v"(r) : "v"(lo), "v"(hi)); return r; }

struct EpiF32 {
    static constexpr bool PERM = false, AFTER_DRAIN = false;
    float* C; int ldc;
    __device__ __forceinline__ void operator()(const f32x4 (&acc)[2][2][4][2], const Unit& u, int wr, int wc, int fr, int fq) const {
        const int row0 = u.pm * BM + wr * 64 + fr, col0 = u.pn * BM + wc * 32 + 4 * fq;
#pragma unroll
        for (int ai = 0; ai < 2; ++ai)
#pragma unroll
            for (int m = 0; m < 4; ++m) { float* rowp = C + (size_t)(row0 + ai * HALF + m * 16) * ldc + col0;
#pragma unroll
                for (int bj = 0; bj < 2; ++bj)
#pragma unroll
                    for (int n = 0; n < 2; ++n) *(f32x4*)(rowp + bj * HALF + n * 16) = acc[ai][bj][m][n]; }
    }
};
struct EpiBf16 {
    static constexpr bool PERM = true, AFTER_DRAIN = false;
    bf16_t* O; int ldc; const float* bias;
    __device__ __forceinline__ void operator()(const f32x4 (&acc)[2][2][4][2], const Unit& u, int wr, int wc, int fr, int fq) const {
        const int row0 = u.pm * BM + wr * 64 + fr; const int col0 = u.pn * BM + wc * 32 + 8 * fq;
        f32x4 bv[2][2];
#pragma unroll
        for (int bj = 0; bj < 2; ++bj)
#pragma unroll
            for (int n = 0; n < 2; ++n) bv[bj][n] = bias ? *(const f32x4*)(bias + col0 + bj * HALF + 4 * n) : (f32x4){0.f, 0.f, 0.f, 0.f};
#pragma unroll
        for (int ai = 0; ai < 2; ++ai)
#pragma unroll
            for (int m = 0; m < 4; ++m) { bf16_t* rowp = O + (size_t)(row0 + ai * HALF + m * 16) * ldc + col0;
#pragma unroll
                for (int bj = 0; bj < 2; ++bj) { f32x4 v0 = acc[ai][bj][m][0] + bv[bj][0], v1 = acc[ai][bj][m][1] + bv[bj][1];
                    u32x4 w; w.x = cvt_pk_bf16(v0[0], v0[1]); w.y = cvt_pk_bf16(v0[2], v0[3]); w.z = cvt_pk_bf16(v1[0], v1[1]); w.w = cvt_pk_bf16(v1[2], v1[3]);
                    *(u32x4*)(rowp + bj * HALF) = w; } }
    }
};
struct EpiSwiGLU {
    static constexpr bool PERM = true, AFTER_DRAIN = false;
    bf16_t* O; int ldc;
    __device__ __forceinline__ void operator()(const f32x4 (&acc)[2][2][4][2], const Unit& u, int wr, int wc, int fr, int fq) const {
        const int row0 = u.pm * BM + wr * 64 + fr; const int col0 = u.pn * HALF + wc * 32 + 8 * fq;
#pragma unroll
        for (int ai = 0; ai < 2; ++ai)
#pragma unroll
            for (int m = 0; m < 4; ++m) { bf16_t* rowp = O + (size_t)(row0 + ai * HALF + m * 16) * ldc + col0;
                float v[8];
#pragma unroll
                for (int n = 0; n < 2; ++n)
#pragma unroll
                    for (int j = 0; j < 4; ++j) { const float g = acc[ai][0][m][n][j], up = acc[ai][1][m][n][j]; v[n * 4 + j] = silu_f(g) * up; }
                u32x4 w; w.x = cvt_pk_bf16(v[0], v[1]); w.y = cvt_pk_bf16(v[2], v[3]); w.z = cvt_pk_bf16(v[4], v[5]); w.w = cvt_pk_bf16(v[6], v[7]);
                *(u32x4*)rowp = w; }
    }
};


__device__ __forceinline__ void row_exchange(const f32x4 (&v)[2][2][4][2], const Unit& u, int wr, int wc, int fr, int fq, LAS unsigned char* lds, int wid, int lane, float* slots, unsigned* cnt) {
    LAS float* P = (LAS float*)lds;
    LAS float* S = (LAS float*)(lds + 4096);
#pragma unroll
    for (int ai = 0; ai < 2; ++ai)
#pragma unroll
        for (int m = 0; m < 4; ++m) {
            float sq = 0.f;
#pragma unroll
            for (int bj = 0; bj < 2; ++bj)
#pragma unroll
                for (int n = 0; n < 2; ++n) { const f32x4 x = v[ai][bj][m][n]; sq += (x[0] * x[0] + x[1] * x[1]) + (x[2] * x[2] + x[3] * x[3]); }
            sq += __shfl_xor(sq, 16); sq += __shfl_xor(sq, 32);
            if (fq == 0) P[(ai * HALF + wr * 64 + m * 16 + fr) * 4 + wc] = sq;
        }
    asm volatile("s_waitcnt lgkmcnt(0)" ::: "memory"); __builtin_amdgcn_s_barrier(); asm volatile("" ::: "memory");
    const int row = wid * 32 + (lane & 31);
    if (lane < 32) {
        const float tot = (P[row * 4 + 0] + P[row * 4 + 1]) + (P[row * 4 + 2] + P[row * 4 + 3]);
        __hip_atomic_store((unsigned*)slots + ((size_t)(u.pm * BM + row) * 4 + u.pn), __float_as_uint(tot), __ATOMIC_RELAXED, __HIP_MEMORY_SCOPE_AGENT);
    }
    asm volatile("s_waitcnt vmcnt(0)" ::: "memory");
    if (lane == 0) __hip_atomic_fetch_add(cnt + 64 * u.pm, 1u, __ATOMIC_RELAXED, __HIP_MEMORY_SCOPE_AGENT);
    if (wid == 0) {
        for (unsigned sp = 0; sp < (1u << 21); ++sp) {
            if ((unsigned)__builtin_amdgcn_readfirstlane(__hip_atomic_load(cnt + 64 * u.pm, __ATOMIC_RELAXED, __HIP_MEMORY_SCOPE_AGENT)) >= 32u) break;
            __builtin_amdgcn_s_sleep(2);
        }
        __builtin_amdgcn_fence(__ATOMIC_ACQUIRE, "agent");
    }
    asm volatile("s_waitcnt vmcnt(0) lgkmcnt(0)" ::: "memory"); __builtin_amdgcn_s_barrier(); asm volatile("" ::: "memory");
    if (lane < 32) {
        const unsigned* sl = (const unsigned*)slots + (size_t)(u.pm * BM + row) * 4;
        float tot = 0.f;
#pragma unroll
        for (int t = 0; t < 4; ++t) tot += __uint_as_float(__hip_atomic_load(sl + t, __ATOMIC_RELAXED, __HIP_MEMORY_SCOPE_AGENT));
        S[row] = tot;
    }
    asm volatile("s_waitcnt vmcnt(0) lgkmcnt(0)" ::: "memory"); __builtin_amdgcn_s_barrier(); asm volatile("" ::: "memory");
}
struct EpiFusedRow {
    static constexpr bool PERM = false, AFTER_DRAIN = true;
    const float* xin; float* xout; bf16_t* H;
    const float* gate; const float* gpost; float wgt;
    const float* gpre; const float* shift; const float* scale;
    float* slots; unsigned* cnt;
    __device__ __forceinline__ void operator()(const f32x4 (&)[2][2][4][2], const Unit&, int, int, int, int) const {}
    __device__ __forceinline__ void fused(f32x4 (&acc)[2][2][4][2], const Unit& u, int wr, int wc, int fr, int fq, LAS unsigned char* lds, int wid, int lane) const {
        const LAS float* S = (const LAS float*)(lds + 4096);
        const int col0 = u.pn * BM + wc * 32 + 4 * fq; const size_t mb = (size_t)(u.pm >> 4) * (NMOD * D);
        row_exchange(acc, u, wr, wc, fr, fq, lds, wid, lane, slots, cnt);
        {
            f32x4 cw[2][2];
#pragma unroll
            for (int bj = 0; bj < 2; ++bj)
#pragma unroll
                for (int n = 0; n < 2; ++n) cw[bj][n] = *(const f32x4*)(gate + mb + col0 + bj * HALF + n * 16) * *(const f32x4*)(gpost + col0 + bj * HALF + n * 16);
#pragma unroll
            for (int ai = 0; ai < 2; ++ai)
#pragma unroll
                for (int m = 0; m < 4; ++m) { const int r = ai * HALF + wr * 64 + m * 16 + fr; const float r1 = rsqrtf(S[r] * (1.0f / D) + EPS) * wgt; const size_t off = (size_t)(u.pm * BM + r) * D + col0;
#pragma unroll
                    for (int bj = 0; bj < 2; ++bj)
#pragma unroll
                        for (int n = 0; n < 2; ++n) { const f32x4 xv = *(const f32x4*)(xin + off + bj * HALF + n * 16); const f32x4 xn = xv + (cw[bj][n] * r1) * acc[ai][bj][m][n];
                            acc[ai][bj][m][n] = xn; *(f32x4*)(xout + off + bj * HALF + n * 16) = xn; }
                    asm volatile("" : "+v"(acc[ai][0][m][0]), "+v"(acc[ai][0][m][1]), "+v"(acc[ai][1][m][0]), "+v"(acc[ai][1][m][1]));
                    asm volatile("" ::: "memory"); }
        }
        if (H == nullptr) return;
        row_exchange(acc, u, wr, wc, fr, fq, lds, wid, lane, slots + (size_t)TL * 4, cnt + 64 * 64);
        {
            f32x4 gm[2][2], sh[2][2];
#pragma unroll
            for (int bj = 0; bj < 2; ++bj)
#pragma unroll
                for (int n = 0; n < 2; ++n) { const int c = col0 + bj * HALF + n * 16; gm[bj][n] = *(const f32x4*)(gpre + c) * (*(const f32x4*)(scale + mb + c) + 1.0f); sh[bj][n] = *(const f32x4*)(shift + mb + c); }
#pragma unroll
            for (int ai = 0; ai < 2; ++ai)
#pragma unroll
                for (int m = 0; m < 4; ++m) { const int r = ai * HALF + wr * 64 + m * 16 + fr; const float r2 = rsqrtf(S[r] * (1.0f / D) + EPS); const size_t off = (size_t)(u.pm * BM + r) * D + col0;
#pragma unroll
                    for (int bj = 0; bj < 2; ++bj)
#pragma unroll
                        for (int n = 0; n < 2; ++n) { const f32x4 hv = (acc[ai][bj][m][n] * r2) * gm[bj][n] + sh[bj][n];
                            uint2 w2; w2.x = cvt_pk_bf16(hv[0], hv[1]); w2.y = cvt_pk_bf16(hv[2], hv[3]); *(uint2*)(H + off + bj * HALF + n * 16) = w2; }
                    asm volatile("" ::: "memory"); }
        }
    }
};

template <class Epi, class Sched>
__device__ __forceinline__ void gemm_phase(LAS unsigned char* lds, const Gemm g, const Sched& S, const Epi& E) {
    const int tid = ltid(), wid = __builtin_amdgcn_readfirstlane(tid >> 6), lane = tid & 63, wr = wid >> 2, wc = wid & 3, fr = lane & 15, fq = lane >> 4;
    const int K = g.ld, nt = g.K / BK;
    unsigned voffA[2], voffB[2];
#pragma unroll
    for (int i = 0; i < 2; ++i) { int R, C; stage_rc(tid * 16 + i * 8192, R, C); const int Rb = Epi::PERM ? ((R & ~31) + perm32(R & 31)) : R;
        voffA[i] = (unsigned)(R * K + C) * 2u; voffB[i] = (unsigned)(Rb * K + C) * 2u; }
    const size_t kstep = (size_t)(BK * 2);
    const size_t hstep = (size_t)HALF * K * 2;
    const size_t tstep = 2 * hstep;
    const unsigned ldsw = (unsigned)wid * 1024u;
    const int aoff = lds_byte(wr * 64 + fr, fq * 8), boff = lds_byte(wc * 32 + fr, fq * 8);
#define PG8_SA(b, h) (((b) * 2 + (h)) * HTB)
#define PG8_SB(b, h) ((4 + (b) * 2 + (h)) * HTB)
#define PG8_STAGE(bufoff, gbase, voff) do { _Pragma("unroll") for (int _i = 0; _i < 2; ++_i) \
        __builtin_amdgcn_global_load_lds((const unsigned*)((const char*)(gbase) + (voff)[_i]), (LAS unsigned*)(lds + (bufoff) + ldsw + _i * 8192), 16, 0, 0); } while (0)
#define PG8_LDA(dst, b, h) do { _Pragma("unroll") for (int m = 0; m < 4; ++m) _Pragma("unroll") for (int k = 0; k < 2; ++k) dst[m][k] = *(const LAS bf16x8*)(lds + PG8_SA(b, h) + aoff + m * 2048 + k * 1024); } while (0)
#define PG8_LDB(dst, b, h) do { _Pragma("unroll") for (int n = 0; n < 2; ++n) _Pragma("unroll") for (int k = 0; k < 2; ++k) dst[n][k] = *(const LAS bf16x8*)(lds + PG8_SB(b, h) + boff + n * 2048 + k * 1024); } while (0)
#define PG8_MMA(ai, bj, At, Bt) do { __builtin_amdgcn_s_setprio(1); _Pragma("unroll") for (int m = 0; m < 4; ++m) _Pragma("unroll") for (int n = 0; n < 2; ++n) _Pragma("unroll") for (int k = 0; k < 2; ++k) \
        acc[ai][bj][m][n] = __builtin_amdgcn_mfma_f32_16x16x32_bf16(Bt[n][k], At[m][k], acc[ai][bj][m][n], 0, 0, 0); __builtin_amdgcn_s_setprio(0); } while (0)
#define PG8_WAIT_V(n) asm volatile("s_waitcnt vmcnt(" #n ")" ::: "memory")
#define PG8_WAIT_L(n) asm volatile("s_waitcnt lgkmcnt(" #n ")" ::: "memory")
#define PG8_BAR __builtin_amdgcn_s_barrier()
#define PG8_SCHED __builtin_amdgcn_sched_barrier(0)
    Unit cur, nxt; int ui = 0;
    if (!S.next(0, cur)) return;
    f32x4 acc[2][2][4][2];
#pragma unroll
    for (int a = 0; a < 2; ++a)
#pragma unroll
        for (int b = 0; b < 2; ++b)
#pragma unroll
            for (int m = 0; m < 4; ++m)
#pragma unroll
                for (int n = 0; n < 2; ++n) acc[a][b][m][n] = (f32x4){0.f, 0.f, 0.f, 0.f};
    bf16x8 At[4][2], B0[2][2], B1[2][2];
    const char* cA = (const char*)g.A + (size_t)cur.pm * tstep; const char* cB = (const char*)g.Bt + (size_t)cur.pn * tstep;
    PG8_STAGE(PG8_SB(0, 0), cB, voffB); PG8_STAGE(PG8_SA(0, 0), cA, voffA); PG8_STAGE(PG8_SB(0, 1), cB + hstep, voffB); PG8_STAGE(PG8_SA(0, 1), cA + hstep, voffA);
    if (wr == 1) PG8_BAR;
    PG8_WAIT_V(4); PG8_BAR;
    PG8_STAGE(PG8_SB(1, 0), cB + kstep, voffB); PG8_STAGE(PG8_SA(1, 0), cA + kstep, voffA); PG8_STAGE(PG8_SB(1, 1), cB + hstep + kstep, voffB);
    PG8_WAIT_V(6); PG8_BAR;
    for (;;) {
        const bool has_next = S.next(ui + 1, nxt);
        const char* nA = has_next ? (const char*)g.A + (size_t)nxt.pm * tstep : cA; const char* nB = has_next ? (const char*)g.Bt + (size_t)nxt.pn * tstep : cB;
        for (int t = 0; t < nt; t += 2) {
            const bool last = (t == nt - 2);
            const char* a1 = cA + (size_t)(t + 1) * kstep;
            const char* a2 = last ? nA : cA + (size_t)(t + 2) * kstep; const char* b2 = last ? nB : cB + (size_t)(t + 2) * kstep;
            const char* a3 = a2 + kstep; const char* b3 = b2 + kstep;
            PG8_LDB(B0, 0, 0); PG8_SCHED; PG8_LDA(At, 0, 0); PG8_STAGE(PG8_SA(1, 1), a1 + hstep, voffA);
            PG8_WAIT_L(8); PG8_BAR; PG8_WAIT_L(0); PG8_MMA(0, 0, At, B0); PG8_BAR; PG8_SCHED;
            PG8_LDB(B1, 0, 1); PG8_STAGE(PG8_SB(0, 0), b2, voffB);
            PG8_BAR; PG8_WAIT_L(0); PG8_MMA(0, 1, At, B1); PG8_BAR;
            PG8_LDA(At, 0, 1); PG8_STAGE(PG8_SA(0, 0), a2, voffA);
            PG8_BAR; PG8_WAIT_L(0); PG8_MMA(1, 0, At, B0); PG8_BAR; PG8_SCHED;
            PG8_STAGE(PG8_SB(0, 1), b2 + hstep, voffB);
            PG8_WAIT_V(6); PG8_BAR; PG8_MMA(1, 1, At, B1); PG8_BAR;
            PG8_LDB(B0, 1, 0); PG8_SCHED; PG8_LDA(At, 1, 0); PG8_STAGE(PG8_SA(0, 1), a2 + hstep, voffA);
            PG8_WAIT_L(8); PG8_BAR; PG8_WAIT_L(0); PG8_MMA(0, 0, At, B0); PG8_BAR; PG8_SCHED;
            PG8_LDB(B1, 1, 1); PG8_STAGE(PG8_SB(1, 0), b3, voffB);
            PG8_BAR; PG8_WAIT_L(0); PG8_MMA(0, 1, At, B1); PG8_BAR;
            PG8_LDA(At, 1, 1); PG8_STAGE(PG8_SA(1, 0), a3, voffA);
            PG8_BAR; PG8_WAIT_L(0); PG8_MMA(1, 0, At, B0); PG8_BAR; PG8_SCHED;
            PG8_STAGE(PG8_SB(1, 1), b3 + hstep, voffB);
            PG8_WAIT_V(6); PG8_BAR; PG8_MMA(1, 1, At, B1); PG8_BAR;
        }
        if constexpr (!Epi::AFTER_DRAIN) E(acc, cur, wr, wc, fr, fq);
        if (!has_next) break;
#pragma unroll
        for (int a = 0; a < 2; ++a)
#pragma unroll
            for (int b = 0; b < 2; ++b)
#pragma unroll
                for (int m = 0; m < 4; ++m)
#pragma unroll
                    for (int n = 0; n < 2; ++n) acc[a][b][m][n] = (f32x4){0.f, 0.f, 0.f, 0.f};
        cur = nxt; cA = nA; cB = nB; ++ui;
    }
    PG8_WAIT_V(0);
    if (wr == 0) PG8_BAR;
    PG8_BAR;
    if constexpr (Epi::AFTER_DRAIN) E.fused(acc, cur, wr, wc, fr, fq, lds, wid, lane);
#undef PG8_SA
#undef PG8_SB
#undef PG8_STAGE
#undef PG8_LDA
#undef PG8_LDB
#undef PG8_MMA
#undef PG8_WAIT_V
#undef PG8_WAIT_L
#undef PG8_BAR
#undef PG8_SCHED
}
}

template <class Epi>
__device__ __forceinline__ void run_gemm(unsigned char* smem, const bf16_t* A, const bf16_t* Bt, int M, int N, int K, const Epi& E) {
    pg8::Gemm g{A, Bt, M, N, K, K}; pg8::StaticOrder S; S.init(M, N, (int)gridDim.x, (int)blockIdx.x);
    pg8::gemm_phase<Epi, pg8::StaticOrder>((LAS unsigned char*)smem, g, S, E);
}
__device__ __forceinline__ void run_gemm_f32_split(unsigned char* smem, const bf16_t* A, const bf16_t* Bt, int M, int K, const pg8::EpiFusedRow& EF, float* YP) {
    { pg8::Gemm g{A, Bt, TL, D, K, K}; pg8::StaticOrder S; S.init(TL, D, (int)gridDim.x, (int)blockIdx.x);
      pg8::gemm_phase<pg8::EpiFusedRow, pg8::StaticOrder>((LAS unsigned char*)smem, g, S, EF); }
    __syncthreads();
    if (M > TL && blockIdx.x < 64) {
        const int ks = blockIdx.x >> 4;
        int koff, klen;
        if (K == DFF) { koff = (ks < 2) ? ks * 768 : 1536 + (ks - 2) * 640; klen = (ks < 2) ? 768 : 640; }
        else { klen = K / 4; koff = ks * klen; }
        pg8::Gemm g{A + (size_t)TL * K + koff, Bt + koff, TC, D, klen, K}; pg8::StaticOrder S; S.init(TC, D, 16, (int)(blockIdx.x & 15)); pg8::EpiF32 E{YP + (size_t)ks * TC * D, D};
        pg8::gemm_phase<pg8::EpiF32, pg8::StaticOrder>((LAS unsigned char*)smem, g, S, E);
        __syncthreads();
    }
}

__device__ __forceinline__ float* xrow(const KQ p, int t) { return t < TL ? p.out + (size_t)t * D : (float*)(p.ws + WS_XC) + (size_t)(t - TL) * D; }
__device__ __forceinline__ int modrow(int t) { return t < TL ? (t >> 12) : 4; }
__device__ __forceinline__ const float* modp(const KQ p, int l, int mr, int idx) { return (const float*)(p.ws + WS_MOD) + ((size_t)(l * 5 + mr) * NMOD + idx) * D; }

__device__ __forceinline__ void p0_setup(const KQ p_in, float* sm) {
    const KQ p = lq(p_in);
    const int tid = ltid(), bid = blockIdx.x, nb = gridDim.x;
    const int gtid = bid * 512 + tid, gthreads = nb * 512;
    {
        float* rope = (float*)(p.ws + WS_ROPE);
        for (int idx = gtid; idx < SEQ * 32; idx += gthreads) {
            const int t = idx >> 5, i = idx & 31;
            const int ii = i & 15; const float pos = (i < 16) ? (float)(t >> 6) : (float)(t & 63);
            const float invA = powf(10000.0f, -(float)ii / 16.0f);
            const float angA = pos * invA;
            rope[idx] = cosf(angA); rope[SEQ * 32 + idx] = sinf(angA);
            const float ex = (float)i * (1.0f / 31.0f);
            const float invR = powf(10000.0f, -ex);
            const float angR = (float)t * invR;
            rope[2 * SEQ * 32 + idx] = cosf(angR); rope[3 * SEQ * 32 + idx] = sinf(angR);
        }
    }
    {
        float* tile = sm;
        for (int gs = bid; gs < 20864 / 4; gs += nb) {
            const int g = gs * 4;
            int j, tl;
            if (g < 16896) { j = g / 704; tl = g % 704; }
            else if (g < 18304) { j = 24 + (g - 16896) / 704; tl = (g - 16896) % 704; }
            else if (g < 18816) { j = 26 + (g - 18304) / 256; tl = (g - 18304) % 256; }
            else if (g < 20352) { j = 28 + (g - 18816) / 768; tl = (g - 18816) % 768; }
            else { j = 30 + (g - 20352) / 256; tl = (g - 20352) % 256; }
            const float* src; bf16_t* dst; int K, N, mode = 0;
            if (j < 8) { src = pin_ld(8) + (size_t)j * D * DFF; dst = (bf16_t*)(p.ws + WS_WGU + (size_t)j * SZ_WGU); K = D; N = DFF; mode = 1; }
            else if (j < 16) { src = pin_ld(9) + (size_t)(j - 8) * D * DFF; dst = (bf16_t*)(p.ws + WS_WGU + (size_t)(j - 8) * SZ_WGU); K = D; N = DFF; mode = 2; }
            else if (j < 24) { src = pin_ld(10) + (size_t)(j - 16) * DFF * D; dst = (bf16_t*)(p.ws + WS_WD + (size_t)(j - 16) * SZ_WD); K = DFF; N = D; }
            else if (j < 26) { src = pin_ld(11) + (size_t)(j - 24) * D * INW; dst = (bf16_t*)(p.ws + WS_WIN + (size_t)(j - 24) * SZ_WIN); K = D; N = INW; mode = 3; }
            else if (j < 28) { src = pin_ld(14) + (size_t)(j - 26) * D * D; dst = (bf16_t*)(p.ws + WS_WOUT + (size_t)(j - 26) * SZ_WOUT); K = D; N = D; }
            else if (j < 30) { src = pin_ld(15) + (size_t)(j - 28) * D * HYW; dst = (bf16_t*)(p.ws + WS_HWIN + (size_t)(j - 28) * SZ_HWIN); K = D; N = HYW; }
            else { src = pin_ld(28) + (size_t)(j - 30) * D * D; dst = (bf16_t*)(p.ws + WS_HWOUT + (size_t)(j - 30) * SZ_WOUT); K = D; N = D; }
            const int ntn = N / 64; const int k0 = (tl / ntn) * 64, n0 = (tl % ntn) * 64;
            f32x4 ld[8];
#pragma unroll
            for (int i = 0; i < 8; ++i) ld[i] = *(const f32x4*)(src + (size_t)(k0 + i * 8 + (tid >> 6)) * N + n0 + (tid & 63) * 4);
            __syncthreads();
#pragma unroll
            for (int i = 0; i < 8; ++i) *(f32x4*)(tile + (i * 8 + (tid >> 6)) * 260 + (tid & 63) * 4) = ld[i];
            __syncthreads();
            {
                const int n = tid >> 1, kh = (tid & 1) * 32; const int gn = n0 + n;
                float sc_ = 1.0f; int row = gn;
                if (mode == 1) row = 256 * (gn >> 7) + (gn & 127);
                else if (mode == 2) row = 256 * (gn >> 7) + 128 + (gn & 127);
                else if (mode == 3) { if (gn < 512 || (gn >= 1792 && gn < 2304)) sc_ = 0.125f; }
#pragma unroll
                for (int q = 0; q < 4; ++q) {
                    float v[8];
#pragma unroll
                    for (int jj = 0; jj < 8; ++jj) v[jj] = tile[(kh + q * 8 + jj) * 260 + n] * sc_;
                    u32x4 o4; o4.x = pg8::cvt_pk_bf16(v[0], v[1]); o4.y = pg8::cvt_pk_bf16(v[2], v[3]); o4.z = pg8::cvt_pk_bf16(v[4], v[5]); o4.w = pg8::cvt_pk_bf16(v[6], v[7]);
                    *(u32x4*)(dst + (size_t)row * K + k0 + kh + q * 8) = o4;
                }
            }
        }
        __syncthreads();
    }
    {
        float* sc = sm;
        float* red = sm + 5 * 1024;
        for (int i = tid; i < 5 * 1024; i += 512) { const int r = i >> 10, k = i & 1023; const float v = (r < 4) ? pin_ld(1)[r * D + k] : pin_ld(3)[k]; sc[i] = silu_f(v); }
        __syncthreads();
        const int w = tid >> 6, lane = tid & 63;
        for (int it = bid; it < 288; it += nb) {
            const int l = it / 72, c0 = (it % 72) * 128;
            const float* wm = pin_ld(4) + (size_t)l * D * (NMOD * D) + c0 + 2 * lane;
            float a[5][2];
#pragma unroll
            for (int r = 0; r < 5; ++r) { a[r][0] = 0.f; a[r][1] = 0.f; }
            for (int kb = w * 128; kb < w * 128 + 128; kb += 16) {
                float2 wv[16];
#pragma unroll
                for (int q = 0; q < 16; ++q) wv[q] = *(const float2*)(wm + (size_t)(kb + q) * (NMOD * D));
#pragma unroll
                for (int q = 0; q < 16; ++q)
#pragma unroll
                    for (int r = 0; r < 5; ++r) { const float s = sc[r * 1024 + kb + q]; a[r][0] += s * wv[q].x; a[r][1] += s * wv[q].y; }
            }
#pragma unroll
            for (int r = 0; r < 5; ++r) { red[(w * 5 + r) * 128 + 2 * lane] = a[r][0]; red[(w * 5 + r) * 128 + 2 * lane + 1] = a[r][1]; }
            __syncthreads();
            for (int i = tid; i < 5 * 128; i += 512) {
                const int r = i >> 7, c = i & 127; float s = 0.f;
#pragma unroll
                for (int ww = 0; ww < 8; ++ww) s += red[(ww * 5 + r) * 128 + c];
                s += pin_ld(5)[(size_t)l * (NMOD * D) + c0 + c];
                ((float*)(p.ws + WS_MOD))[(size_t)(l * 5 + r) * (NMOD * D) + c0 + c] = s;
            }
            __syncthreads();
        }
    }
    {
        float* z = sm;
        float* a1 = sm + 16 * 36;
        float* a2 = a1 + 16 * 64;
        float* a3 = a2 + 16 * 64;
        float* tl = a3 + 16 * 64;
        float* wl = tl + 16;
        const float HMAX = -4.605170185988091f / 0.3f, HMIN = -4.605170185988091f / 1.5f;
        int o_loaded = -1;
        for (int it = nb - 1 - bid; it < 544; it += nb) {
            const int o = it / 272, r = it % 272;
            const int Lf = (r < 256) ? SEQ : CL; const int p0 = (r < 256) ? r * 16 : (r - 256) * 16;
            float* kf = (float*)(p.ws + WS_KF + (size_t)o * SZ_KF) + ((r < 256) ? (size_t)0 : (size_t)2 * SEQ * D);
            const float* f3 = pin_ld(25) + (size_t)o * 64 * 2048;
            __syncthreads();
            if (o != o_loaded) {
                const float* f0 = pin_ld(19) + (size_t)o * 33 * 64; const float* f1 = pin_ld(21) + (size_t)o * 64 * 64; const float* f2 = pin_ld(23) + (size_t)o * 64 * 64;
                for (int i = tid; i < 33 * 64; i += 512) wl[i] = f0[i];
                for (int i = tid; i < 64 * 64; i += 512) { wl[2112 + i] = f1[i]; wl[2112 + 4096 + i] = f2[i]; }
                if (tid < 64) { wl[10304 + tid] = pin_ld(20)[o * 64 + tid]; wl[10304 + 64 + tid] = pin_ld(22)[o * 64 + tid]; wl[10304 + 128 + tid] = pin_ld(24)[o * 64 + tid]; wl[10304 + 192 + tid] = pin_ld(26)[o * 64 + tid]; }
                o_loaded = o;
            }
            const float* f0 = wl; const float* f1 = wl + 2112; const float* f2 = wl + 2112 + 4096;
            const float* fb0 = wl + 10304; const float* fb1 = fb0 + 64; const float* fb2 = fb0 + 128; const float* fq = fb0 + 192;
            for (int idx = tid; idx < 16 * 33; idx += 512) {
                const int ps = idx / 33, f = idx % 33; const int i = p0 + ps;
                const float tlin = (float)i * (1.0f / (float)(Lf - 1));
                const float w = (6.283185307179586f * (float)i) / (float)Lf;
                float v;
                if (f == 0) { v = tlin; tl[ps] = tlin; }
                else { const int jj = (f - 1) & 15; const float fj = 1e-4f + (float)jj * ((15.0f - 1e-4f) / 15.0f); v = (f <= 16) ? cosf(fj * w) : -sinf(fj * w); }
                z[ps * 36 + f] = v;
            }
            __syncthreads();
            for (int idx = tid; idx < 16 * 64; idx += 512) { const int ps = idx >> 6, oc = idx & 63; float s = fb0[oc];
                for (int f = 0; f < 33; ++f) s += z[ps * 36 + f] * f0[f * 64 + oc];
                a1[idx] = sinf(fq[oc] * s); }
            __syncthreads();
            for (int idx = tid; idx < 16 * 64; idx += 512) { const int ps = idx >> 6, oc = idx & 63; float s = fb1[oc];
                for (int f = 0; f < 64; ++f) s += a1[ps * 64 + f] * f1[f * 64 + oc];
                a2[idx] = sinf(fq[oc] * s); }
            __syncthreads();
            for (int idx = tid; idx < 16 * 64; idx += 512) { const int ps = idx >> 6, oc = idx & 63; float s = fb2[oc];
                for (int f = 0; f < 64; ++f) s += a2[ps * 64 + f] * f2[f * 64 + oc];
                a3[oc * 16 + ps] = sinf(fq[oc] * s); }
            __syncthreads();
            {
                float acc[4][16];
#pragma unroll
                for (int q = 0; q < 4; ++q)
#pragma unroll
                    for (int ps = 0; ps < 16; ++ps) acc[q][ps] = 0.f;
                for (int fb = 0; fb < 64; fb += 4) {
                    float wv[4][4];
#pragma unroll
                    for (int f = 0; f < 4; ++f)
#pragma unroll
                        for (int q = 0; q < 4; ++q) wv[f][q] = f3[(fb + f) * 2048 + tid + 512 * q];
#pragma unroll
                    for (int f = 0; f < 4; ++f) {
                        const f32x4 av0 = *(const f32x4*)(a3 + (fb + f) * 16), av1 = *(const f32x4*)(a3 + (fb + f) * 16 + 4), av2 = *(const f32x4*)(a3 + (fb + f) * 16 + 8), av3 = *(const f32x4*)(a3 + (fb + f) * 16 + 12);
#pragma unroll
                        for (int q = 0; q < 4; ++q)
#pragma unroll
                            for (int e = 0; e < 4; ++e) { acc[q][e] += av0[e] * wv[f][q]; acc[q][4 + e] += av1[e] * wv[f][q]; acc[q][8 + e] += av2[e] * wv[f][q]; acc[q][12 + e] += av3[e] * wv[f][q]; }
                    }
                }
#pragma unroll
                for (int q = 0; q < 4; ++q) {
                    const int c = tid + 512 * q; const int dir = c >> 10, d = c & 1023;
                    const float delta = fabsf(HMIN + (float)d * ((HMAX - HMIN) / 1023.0f));
#pragma unroll
                    for (int ps = 0; ps < 16; ++ps) {
                        const float kvv = acc[q][ps] * expf(-tl[ps] * delta);
                        if (r < 256) {
                            bf16_t* rk = (bf16_t*)(p.ws + WS_KF + (size_t)o * SZ_KF) + (size_t)d * 8192;
                            const int m = p0 + ps;
                            if (dir == 0) rk[4095 - m] = f2bf(kvv); else if (m > 0) rk[4095 + m] = f2bf(kvv);
                            if (dir == 0 && m == 0) rk[8191] = 0;
                        } else kf[((size_t)dir * Lf + p0 + ps) * D + d] = kvv;
                    }
                }
            }
        }
        __syncthreads();
    }
}

__device__ __forceinline__ void rowphase(const KQ p_in, int Mupd, const bf16_t* Y, int lu, int gidx, float wgt, const float* gpost,
                         int Mnext, int ln, const float* gpre, int shidx, int scidx, bf16_t* Hout, bool from_input, int tbeg) {
    const KQ p = lq(p_in);
    const int tid = ltid(), w = tid >> 6, lane = tid & 63;
    const int Mmax = Mupd > Mnext ? Mupd : Mnext;
    for (int t = tbeg + (blockIdx.x * 8 + w) * 2; t < Mmax; t += gridDim.x * 16) {
        float* xr = xrow(p, t); const int mr = modrow(t);
        const float* xs = xr;
        if (from_input) xs = (t < TL) ? pin_ld(0) + (size_t)t * D : pin_ld(2) + (size_t)(t - TL) * D;
        float4 xv[2][4];
#pragma unroll
        for (int rr = 0; rr < 2; ++rr)
#pragma unroll
            for (int q = 0; q < 4; ++q) xv[rr][q] = *(const float4*)(xs + rr * D + q * 256 + lane * 4);
        if (Y != nullptr && t < Mupd) {
            float4 yv[2][4]; float ss[2] = {0.f, 0.f};
#pragma unroll
            for (int rr = 0; rr < 2; ++rr)
#pragma unroll
                for (int q = 0; q < 4; ++q) {
                    if (t < TL) { const bf16x4 yb = *(const bf16x4*)(Y + (size_t)(t + rr) * D + q * 256 + lane * 4);
                        yv[rr][q] = make_float4(bf2f((bf16_t)yb[0]), bf2f((bf16_t)yb[1]), bf2f((bf16_t)yb[2]), bf2f((bf16_t)yb[3])); }
                    else { const float* yp = (const float*)(p.ws + WS_YP) + (size_t)(t + rr - TL) * D + q * 256 + lane * 4;
                        const float4 a0 = *(const float4*)yp, a1 = *(const float4*)(yp + (size_t)TC * D), a2 = *(const float4*)(yp + (size_t)2 * TC * D), a3 = *(const float4*)(yp + (size_t)3 * TC * D);
                        yv[rr][q] = make_float4(a0.x + a1.x + a2.x + a3.x, a0.y + a1.y + a2.y + a3.y, a0.z + a1.z + a2.z + a3.z, a0.w + a1.w + a2.w + a3.w); }
                    ss[rr] += yv[rr][q].x * yv[rr][q].x + yv[rr][q].y * yv[rr][q].y + yv[rr][q].z * yv[rr][q].z + yv[rr][q].w * yv[rr][q].w; }
            ss[0] = wave_sum(ss[0]); ss[1] = wave_sum(ss[1]);
            float wgl = wgt; asm volatile("" : "+v"(wgl));
            const float r0 = rsqrtf(ss[0] * (1.0f / D) + EPS) * wgl, r1 = rsqrtf(ss[1] * (1.0f / D) + EPS) * wgl;
            const float* gm = modp(p, lu, mr, gidx);
#pragma unroll
            for (int q = 0; q < 4; ++q) {
                const float4 g4 = *(const float4*)(gm + q * 256 + lane * 4); const float4 p4 = *(const float4*)(gpost + q * 256 + lane * 4);
                const float cx = g4.x * p4.x, cy = g4.y * p4.y, cz = g4.z * p4.z, cw = g4.w * p4.w;
                xv[0][q].x += r0 * cx * yv[0][q].x; xv[0][q].y += r0 * cy * yv[0][q].y; xv[0][q].z += r0 * cz * yv[0][q].z; xv[0][q].w += r0 * cw * yv[0][q].w;
                xv[1][q].x += r1 * cx * yv[1][q].x; xv[1][q].y += r1 * cy * yv[1][q].y; xv[1][q].z += r1 * cz * yv[1][q].z; xv[1][q].w += r1 * cw * yv[1][q].w;
                *(float4*)(xr + q * 256 + lane * 4) = xv[0][q]; *(float4*)(xr + D + q * 256 + lane * 4) = xv[1][q];
            }
        }
        if (Hout != nullptr && t < Mnext) {
            float ss[2] = {0.f, 0.f};
#pragma unroll
            for (int rr = 0; rr < 2; ++rr)
#pragma unroll
                for (int q = 0; q < 4; ++q) ss[rr] += xv[rr][q].x * xv[rr][q].x + xv[rr][q].y * xv[rr][q].y + xv[rr][q].z * xv[rr][q].z + xv[rr][q].w * xv[rr][q].w;
            ss[0] = wave_sum(ss[0]); ss[1] = wave_sum(ss[1]);
            const float rn[2] = {rsqrtf(ss[0] * (1.0f / D) + EPS), rsqrtf(ss[1] * (1.0f / D) + EPS)};
            const float* sh = modp(p, ln, mr, shidx); const float* sc = modp(p, ln, mr, scidx);
#pragma unroll
            for (int q = 0; q < 4; ++q) {
                const float4 g4 = *(const float4*)(gpre + q * 256 + lane * 4); const float4 s4 = *(const float4*)(sc + q * 256 + lane * 4); const float4 h4 = *(const float4*)(sh + q * 256 + lane * 4);
                const float mx_ = g4.x * (1.0f + s4.x), my_ = g4.y * (1.0f + s4.y), mz_ = g4.z * (1.0f + s4.z), mw_ = g4.w * (1.0f + s4.w);
#pragma unroll
                for (int rr = 0; rr < 2; ++rr) {
                    const float h0 = xv[rr][q].x * rn[rr] * mx_ + h4.x, h1 = xv[rr][q].y * rn[rr] * my_ + h4.y;
                    const float h2 = xv[rr][q].z * rn[rr] * mz_ + h4.z, h3 = xv[rr][q].w * rn[rr] * mw_ + h4.w;
                    uint2 pk; pk.x = pg8::cvt_pk_bf16(h0, h1); pk.y = pg8::cvt_pk_bf16(h2, h3);
                    *(uint2*)(Hout + (size_t)(t + rr) * D + q * 256 + lane * 4) = pk;
                }
            }
        }
    }
}

__device__ __forceinline__ float log_sigmoid(float x) { return -log1pf(expf(-x)); }
__device__ __forceinline__ int chunk_t0(int b, int cidx) { return cidx < 32 ? b * SEQ + cidx * 128 : TL + b * CL + (cidx - 32) * 128; }

__device__ __forceinline__ void m1_rope_states(const KQ p_in, int e, float* sm) {
    const KQ p = lq(p_in);
    const int tid = ltid(), bid = blockIdx.x, nb = gridDim.x;
    bf16_t* Z = (bf16_t*)(p.ws + WS_BIG);
    const float* rope = (const float*)(p.ws + WS_ROPE);
    for (int idx = bid * 512 + tid; idx < TL * 72; idx += nb * 512) {
        const int t = idx / 72, r = idx % 72; const int hd = r >> 2, i0 = (r & 3) * 8;
        const int cb = hd < 16 ? hd * 64 : 1536 + (hd - 16) * 64;
        const int tb = (hd >= 8 && hd < 16) ? 2 : 0; const int pos = t & (SEQ - 1);
        const float* cp = rope + (size_t)tb * SEQ * 32 + pos * 32 + i0; const float* sp = cp + (size_t)SEQ * 32;
        bf16_t* zp = Z + (size_t)t * INW + cb + i0;
        const bf16x8 a1 = *(const bf16x8*)zp, a2 = *(const bf16x8*)(zp + 32);
        const float4 c0 = *(const float4*)cp, c1 = *(const float4*)(cp + 4), s0 = *(const float4*)sp, s1 = *(const float4*)(sp + 4);
        const float cc[8] = {c0.x, c0.y, c0.z, c0.w, c1.x, c1.y, c1.z, c1.w}, sn[8] = {s0.x, s0.y, s0.z, s0.w, s1.x, s1.y, s1.z, s1.w};
        float o1[8], o2[8];
#pragma unroll
        for (int j = 0; j < 8; ++j) { const float x1 = bf2f((bf16_t)a1[j]), x2 = bf2f((bf16_t)a2[j]); o1[j] = x1 * cc[j] - x2 * sn[j]; o2[j] = x1 * sn[j] + x2 * cc[j]; }
        u32x4 w1, w2;
        w1.x = pg8::cvt_pk_bf16(o1[0], o1[1]); w1.y = pg8::cvt_pk_bf16(o1[2], o1[3]); w1.z = pg8::cvt_pk_bf16(o1[4], o1[5]); w1.w = pg8::cvt_pk_bf16(o1[6], o1[7]);
        w2.x = pg8::cvt_pk_bf16(o2[0], o2[1]); w2.y = pg8::cvt_pk_bf16(o2[2], o2[3]); w2.z = pg8::cvt_pk_bf16(o2[4], o2[5]); w2.w = pg8::cvt_pk_bf16(o2[6], o2[7]);
        *(u32x4*)zp = w1; *(u32x4*)(zp + 32) = w2;
    }
    float* Ks = sm;
    float* Vs = sm + 128 * 64;
    float* wf = Vs + 128 * 64;
    float* wb = wf + 128;
    float* AF = (float*)(p.ws + WS_ST); float* AB = AF + SZ_ST / 4;
    const float* dec = pin_ld(13) + e * 16;
    for (int it = bid; it < NB * NCH * 8; it += nb) {
        const int h = it & 7, cidx = (it >> 3) % NCH, b = it / (8 * NCH);
        const int t0 = chunk_t0(b, cidx); const bool lat = cidx < 32;
        const float lgf = log_sigmoid(dec[h]), lgb = log_sigmoid(dec[8 + h]);
        __syncthreads();
        if (tid < 128) { wf[tid] = expf(lgf * (float)(127 - tid)); wb[tid] = expf(lgb * (float)tid); }
        const int kc = 1792 + h * 64, vc = 2304 + h * 64;
#pragma unroll
        for (int q = 0; q < 8; ++q) {
            const int idx = tid + 512 * q; const int r = idx >> 5, i = idx & 31;
            bf16_t* zp = Z + (size_t)(t0 + r) * INW + kc + i;
            float x1 = bf2f(zp[0]), x2 = bf2f(zp[32]);
            if (lat) {
                const int pos = (t0 + r) & (SEQ - 1);
                const float c = rope[(size_t)2 * SEQ * 32 + pos * 32 + i], s = rope[(size_t)3 * SEQ * 32 + pos * 32 + i];
                const bf16_t o1 = f2bf(x1 * c - x2 * s), o2 = f2bf(x1 * s + x2 * c);
                zp[0] = o1; zp[32] = o2; x1 = bf2f(o1); x2 = bf2f(o2);
            }
            Ks[r * 64 + i] = x1; Ks[r * 64 + 32 + i] = x2;
        }
#pragma unroll
        for (int q = 0; q < 16; ++q) { const int idx = tid + 512 * q; const int r = idx >> 6, c = idx & 63; Vs[idx] = bf2f(Z[(size_t)(t0 + r) * INW + vc + c]); }
        __syncthreads();
        const int d = tid >> 3, e0 = (tid & 7) * 8;
        float af[8], ab[8];
#pragma unroll
        for (int j = 0; j < 8; ++j) { af[j] = 0.f; ab[j] = 0.f; }
        for (int s = 0; s < 128; ++s) {
            const float kv = Ks[s * 64 + d]; const float kfw = kv * wf[s], kbw = kv * wb[s];
            const float4 v0 = *(const float4*)(Vs + s * 64 + e0), v1 = *(const float4*)(Vs + s * 64 + e0 + 4);
            af[0] += kfw * v0.x; af[1] += kfw * v0.y; af[2] += kfw * v0.z; af[3] += kfw * v0.w; af[4] += kfw * v1.x; af[5] += kfw * v1.y; af[6] += kfw * v1.z; af[7] += kfw * v1.w;
            ab[0] += kbw * v0.x; ab[1] += kbw * v0.y; ab[2] += kbw * v0.z; ab[3] += kbw * v0.w; ab[4] += kbw * v1.x; ab[5] += kbw * v1.y; ab[6] += kbw * v1.z; ab[7] += kbw * v1.w;
        }
        const size_t so = ((size_t)(b * NCH + cidx) * 8 + h) * 4096 + d * 64 + e0;
        *(float4*)(AF + so) = make_float4(af[0], af[1], af[2], af[3]); *(float4*)(AF + so + 4) = make_float4(af[4], af[5], af[6], af[7]);
        *(float4*)(AB + so) = make_float4(ab[0], ab[1], ab[2], ab[3]); *(float4*)(AB + so + 4) = make_float4(ab[4], ab[5], ab[6], ab[7]);
    }
    __syncthreads();
}

__device__ __forceinline__ void m2_scan(const KQ p_in, int e) {
    const KQ p = lq(p_in);
    const float* __restrict__ AF = (const float*)(p.ws + WS_ST); const float* __restrict__ AB = AF + SZ_ST / 4;
    float* __restrict__ TF = (float*)(p.ws + WS_ST) + 2 * (SZ_ST / 4); float* __restrict__ TB = TF + SZ_ST / 4;
    const float* dec = pin_ld(13) + e * 16;
    for (int idx = blockIdx.x * 512 + ltid(); idx < NB * 8 * 4096; idx += gridDim.x * 512) {
        const int el = idx & 4095, h = (idx >> 12) & 7, b = idx >> 15;
        const float gf = expf(log_sigmoid(dec[h]) * 128.0f), gb = expf(log_sigmoid(dec[8 + h]) * 128.0f);
        const size_t base = ((size_t)(b * NCH) * 8 + h) * 4096 + el; constexpr size_t CS = (size_t)8 * 4096;
        float af[NCH], ab[NCH];
#pragma unroll
        for (int c = 0; c < NCH; ++c) { af[c] = AF[base + c * CS]; ab[c] = AB[base + c * CS]; }
        TF[base + 32 * CS] = 0.f; TF[base + 33 * CS] = af[32]; TB[base + 33 * CS] = 0.f; TB[base + 32 * CS] = ab[33];
        float sf = gf * af[32] + af[33], sb = ab[32] + gb * ab[33];
#pragma unroll
        for (int c = 0; c < 32; ++c) { TF[base + c * CS] = sf; sf = gf * sf + af[c]; }
#pragma unroll
        for (int c = 31; c >= 0; --c) { TB[base + c * CS] = sb; sb = ab[c] + gb * sb; }
    }
}

__device__ __forceinline__ bf16x8 pack8(const f32x4& a, const f32x4& b) {
    u32x4 w; w.x = pg8::cvt_pk_bf16(a[0], a[1]); w.y = pg8::cvt_pk_bf16(a[2], a[3]); w.z = pg8::cvt_pk_bf16(b[0], b[1]); w.w = pg8::cvt_pk_bf16(b[2], b[3]);
    return __builtin_bit_cast(bf16x8, w);
}
__device__ __forceinline__ void m3_outputs(const KQ p_in, int e, bool ctx_full, unsigned char* smem) {
    const KQ p = lq(p_in);
    const int tid = ltid(), bid = blockIdx.x, nb = gridDim.x;
    const int w = tid >> 6, lane = tid & 63, ln = lane & 15, g4 = lane >> 4;
    const bf16_t* Z = (const bf16_t*)(p.ws + WS_BIG);
    bf16_t* MIX = (bf16_t*)(p.ws + WS_MIX);
    const float* dec = pin_ld(13) + e * 16;
    const float* sink = pin_ld(12) + e * 8;
    const float* TF = (const float*)(p.ws + WS_ST) + 2 * (SZ_ST / 4); const float* TB = TF + SZ_ST / 4;
    const int nchunk = ctx_full ? NCH : 32;
    const int nitems = NB * nchunk * 8;
    bf16_t* Kt = (bf16_t*)smem;
    bf16_t* Vt = Kt + 128 * 72;
    bf16_t* TfT = Vt + 64 * 136;
    bf16_t* TbT = TfT + 64 * 72;
    const int i = 16 * w + ln;
    for (int it = bid; it < 2 * nitems; it += nb) {
        const bool is_attn = it < nitems; const int ii = is_attn ? it : it - nitems;
        const int h = ii & 7, cidx = (ii >> 3) % nchunk, b = ii / (8 * nchunk);
        const int t0 = chunk_t0(b, cidx); const bool lat = cidx < 32;
        f32x4 O[4];
#pragma unroll
        for (int m = 0; m < 4; ++m) O[m] = (f32x4){0.f, 0.f, 0.f, 0.f};
        if (!is_attn) {
            const float lgf = log_sigmoid(dec[h]), lgb = log_sigmoid(dec[8 + h]);
            __syncthreads();
#pragma unroll
            for (int q = 0; q < 2; ++q) { const int idx = tid + 512 * q; const int r = idx >> 3, pc = idx & 7; const bf16_t* zr = Z + (size_t)(t0 + r) * INW + h * 64 + pc * 8;
                *(u32x4*)(Kt + r * 72 + pc * 8) = *(const u32x4*)(zr + 1792);
                const bf16x8 vv = *(const bf16x8*)(zr + 2304);
#pragma unroll
                for (int j = 0; j < 8; ++j) Vt[(pc * 8 + j) * 136 + r] = (bf16_t)vv[j]; }
            const size_t so = ((size_t)(b * NCH + cidx) * 8 + h) * 4096;
#pragma unroll
            for (int q = 0; q < 8; ++q) { const int idx = tid + 512 * q; const int d = idx >> 6, ee = idx & 63; TfT[ee * 72 + d] = f2bf(TF[so + idx]); TbT[ee * 72 + d] = f2bf(TB[so + idx]); }
            __builtin_amdgcn_sched_barrier(0);
            bf16x8 qf[2], qff[2], qfb[2];
            { const bf16_t* qr = Z + (size_t)(t0 + i) * INW + 512 + h * 64 + 8 * g4;
              const float cf = __expf(lgf * (float)(i + 1)), cb = __expf(lgb * (float)(128 - i));
#pragma unroll
              for (int k2 = 0; k2 < 2; ++k2) { qf[k2] = *(const bf16x8*)(qr + 32 * k2);
                  f32x4 a0, a1, b0, b1;
#pragma unroll
                  for (int j = 0; j < 4; ++j) { const float x0 = bf2f((bf16_t)qf[k2][j]), x1 = bf2f((bf16_t)qf[k2][4 + j]); a0[j] = x0 * cf; a1[j] = x1 * cf; b0[j] = x0 * cb; b1[j] = x1 * cb; }
                  qff[k2] = pack8(a0, a1); qfb[k2] = pack8(b0, b1); } }
            __builtin_amdgcn_sched_barrier(0);
            __syncthreads();
#pragma unroll
            for (int m = 0; m < 4; ++m)
#pragma unroll
                for (int k2 = 0; k2 < 2; ++k2) {
                    const bf16x8 af = *(const bf16x8*)(TfT + (16 * m + ln) * 72 + 32 * k2 + 8 * g4);
                    const bf16x8 ab = *(const bf16x8*)(TbT + (16 * m + ln) * 72 + 32 * k2 + 8 * g4);
                    O[m] = __builtin_amdgcn_mfma_f32_16x16x32_bf16(af, qff[k2], O[m], 0, 0, 0);
                    O[m] = __builtin_amdgcn_mfma_f32_16x16x32_bf16(ab, qfb[k2], O[m], 0, 0, 0);
                    __builtin_amdgcn_sched_barrier(0);
                }
            const float lf2 = lgf * 1.44269504f, lb2 = lgb * 1.44269504f; const int di = i - 4 * g4;
            const float bfw = lf2 * (float)di, bbw = -lb2 * (float)di;
            f32x4 st[8];
#pragma unroll
            for (int mt = 0; mt < 8; ++mt) {
                f32x4 a = (f32x4){0.f, 0.f, 0.f, 0.f};
#pragma unroll
                for (int k2 = 0; k2 < 2; ++k2) { const bf16x8 kf = *(const bf16x8*)(Kt + (16 * mt + ln) * 72 + 32 * k2 + 8 * g4); a = __builtin_amdgcn_mfma_f32_16x16x32_bf16(kf, qf[k2], a, 0, 0, 0); }
#pragma unroll
                for (int rg = 0; rg < 4; ++rg) { const int cc = 16 * mt + rg; const int df = di - cc;
                    const float arg = (df > 0) ? fmaf(-lf2, (float)cc, bfw) : fmaf(lb2, (float)cc, bbw);
                    float wgt = __builtin_amdgcn_exp2f(arg); wgt = (df == 0) ? 2.0f : wgt;
                    a[rg] *= wgt; }
                st[mt] = a;
                __builtin_amdgcn_sched_barrier(0);
            }
#pragma unroll
            for (int ks = 0; ks < 4; ++ks) {
                const bf16x8 pfr = pack8(st[2 * ks], st[2 * ks + 1]);
#pragma unroll
                for (int m = 0; m < 4; ++m) {
                    const bf16_t* vr = Vt + (16 * m + ln) * 136 + 32 * ks + 4 * g4;
                    const bf16x4 v0 = *(const bf16x4*)vr, v1 = *(const bf16x4*)(vr + 16);
                    const bf16x8 vf = __builtin_shufflevector(v0, v1, 0, 1, 2, 3, 4, 5, 6, 7);
                    O[m] = __builtin_amdgcn_mfma_f32_16x16x32_bf16(vf, pfr, O[m], 0, 0, 0);
                }
                __builtin_amdgcn_sched_barrier(0);
            }
            float ss = 0.f;
#pragma unroll
            for (int m = 0; m < 4; ++m)
#pragma unroll
                for (int rg = 0; rg < 4; ++rg) ss += O[m][rg] * O[m][rg];
            ss += __shfl_xor(ss, 16, 64); ss += __shfl_xor(ss, 32, 64);
            const float rn = rsqrtf(ss * (1.0f / 64.0f) + EPS);
#pragma unroll
            for (int m = 0; m < 4; ++m) {
                const int ee = 16 * m + 4 * g4;
                const bf16x4 gv = *(const bf16x4*)(Z + (size_t)(t0 + i) * INW + 1024 + h * 64 + ee);
                uint2 o2; o2.x = pg8::cvt_pk_bf16(O[m][0] * rn * silu_f(bf2f((bf16_t)gv[0])), O[m][1] * rn * silu_f(bf2f((bf16_t)gv[1])));
                o2.y = pg8::cvt_pk_bf16(O[m][2] * rn * silu_f(bf2f((bf16_t)gv[2])), O[m][3] * rn * silu_f(bf2f((bf16_t)gv[3])));
                *(uint2*)(MIX + (size_t)(t0 + i) * D + 512 + h * 64 + ee) = o2;
            }
        } else {
            const int gk = h >> 2;
            bf16x8 qf[2];
            { const bf16_t* qr = Z + (size_t)(t0 + i) * INW + h * 64 + 8 * g4; qf[0] = *(const bf16x8*)qr; qf[1] = *(const bf16x8*)(qr + 32); }
            float mx = sink[h], l = (g4 == 0) ? 1.0f : 0.0f;
            const int qpos = lat ? (cidx * 128 + i) : 0;
#define ATT_VALID(tl_) ((tl_) >= 3 || (lat && (cidx - 1 + (tl_)) >= 0 && (cidx - 1 + (tl_)) < 32))
#define ATT_KT0(tl_) ((tl_) >= 3 ? TL + b * CL + ((tl_) - 3) * 128 : b * SEQ + (cidx - 1 + (tl_)) * 128)
            int tl = 0; while (!ATT_VALID(tl)) ++tl;
            u32x4 kreg[2]; bf16x8 vreg[2];
            { const int kt0 = ATT_KT0(tl);
#pragma unroll
              for (int q = 0; q < 2; ++q) { const int idx = tid + 512 * q; const int r = idx >> 3, pc = idx & 7; const bf16_t* zr = Z + (size_t)(kt0 + r) * INW + gk * 64 + pc * 8;
                  kreg[q] = *(const u32x4*)(zr + 1536); vreg[q] = *(const bf16x8*)(zr + 1664); } }
            while (tl < 5) {
                const bool isc = tl >= 3; const int kp0 = isc ? 0 : (cidx - 1 + tl) * 128;
                __syncthreads();
#pragma unroll
                for (int q = 0; q < 2; ++q) { const int idx = tid + 512 * q; const int r = idx >> 3, pc = idx & 7;
                    *(u32x4*)(Kt + r * 72 + pc * 8) = kreg[q];
#pragma unroll
                    for (int j = 0; j < 8; ++j) Vt[(pc * 8 + j) * 136 + r] = (bf16_t)vreg[q][j]; }
                __syncthreads();
                int tn = tl + 1; while (tn < 5 && !ATT_VALID(tn)) ++tn;
                if (tn < 5) { const int kt0 = ATT_KT0(tn);
#pragma unroll
                    for (int q = 0; q < 2; ++q) { const int idx = tid + 512 * q; const int r = idx >> 3, pc = idx & 7; const bf16_t* zr = Z + (size_t)(kt0 + r) * INW + gk * 64 + pc * 8;
                        kreg[q] = *(const u32x4*)(zr + 1536); vreg[q] = *(const bf16x8*)(zr + 1664); } }
                f32x4 st[8];
                float mloc = -1e30f;
#pragma unroll
                for (int mt = 0; mt < 8; ++mt) {
                    f32x4 a = (f32x4){0.f, 0.f, 0.f, 0.f};
#pragma unroll
                    for (int k2 = 0; k2 < 2; ++k2) { const bf16x8 kf = *(const bf16x8*)(Kt + (16 * mt + ln) * 72 + 32 * k2 + 8 * g4); a = __builtin_amdgcn_mfma_f32_16x16x32_bf16(kf, qf[k2], a, 0, 0, 0); }
                    if (!isc) {
#pragma unroll
                        for (int rg = 0; rg < 4; ++rg) { const int dd = qpos - (kp0 + 16 * mt + 4 * g4 + rg); if (dd > 128 || dd < -128) a[rg] = -1e30f; }
                    }
#pragma unroll
                    for (int rg = 0; rg < 4; ++rg) mloc = fmaxf(mloc, a[rg]);
                    st[mt] = a;
                    __builtin_amdgcn_sched_barrier(0);
                }
                mloc = fmaxf(mloc, __shfl_xor(mloc, 16, 64)); mloc = fmaxf(mloc, __shfl_xor(mloc, 32, 64));
                const float mnew = fmaxf(mx, mloc);
                const float sc = __expf(mx - mnew); mx = mnew; l *= sc;
#pragma unroll
                for (int m = 0; m < 4; ++m) O[m] *= sc;
#pragma unroll
                for (int mt = 0; mt < 8; ++mt)
#pragma unroll
                    for (int rg = 0; rg < 4; ++rg) { const float pv = __expf(st[mt][rg] - mnew); st[mt][rg] = pv; l += pv; }
#pragma unroll
                for (int ks = 0; ks < 4; ++ks) {
                    const bf16x8 pfr = pack8(st[2 * ks], st[2 * ks + 1]);
#pragma unroll
                    for (int m = 0; m < 4; ++m) {
                        const bf16_t* vr = Vt + (16 * m + ln) * 136 + 32 * ks + 4 * g4;
                        const bf16x4 v0 = *(const bf16x4*)vr, v1 = *(const bf16x4*)(vr + 16);
                        const bf16x8 vf = __builtin_shufflevector(v0, v1, 0, 1, 2, 3, 4, 5, 6, 7);
                        O[m] = __builtin_amdgcn_mfma_f32_16x16x32_bf16(vf, pfr, O[m], 0, 0, 0);
                    }
                    __builtin_amdgcn_sched_barrier(0);
                }
                tl = tn;
            }
#undef ATT_VALID
#undef ATT_KT0
            l += __shfl_xor(l, 16, 64); l += __shfl_xor(l, 32, 64);
            const float inv = 1.0f / l;
#pragma unroll
            for (int m = 0; m < 4; ++m) {
                uint2 o2; o2.x = pg8::cvt_pk_bf16(O[m][0] * inv, O[m][1] * inv); o2.y = pg8::cvt_pk_bf16(O[m][2] * inv, O[m][3] * inv);
                *(uint2*)(MIX + (size_t)(t0 + i) * D + h * 64 + 16 * m + 4 * g4) = o2;
            }
        }
    }
    __syncthreads();
}

__device__ __forceinline__ void h2_shortconv(const KQ p_in, int o, int M, unsigned char* smem) {
    const KQ p = lq(p_in);
    const int tid = ltid();
    const bf16_t* ZH = (const bf16_t*)(p.ws + WS_BIG);
    const float* w = pin_ld(17) + (size_t)o * 3 * HYW; const float* bs = pin_ld(18) + (size_t)o * HYW;
    bf16_t* VXT = (bf16_t*)(p.ws + WS_Y); bf16_t* X0T = VXT + (size_t)D * TL;
    bf16_t* tx = (bf16_t*)smem;
    bf16_t* tv = tx + 64 * 72;
    const int tok = tid >> 3, cg8 = (tid & 7) * 8;
    float* wl = (float*)(smem + 32768);
    { const int c0b = (blockIdx.x & 15) * 64;
      for (int i = tid; i < 768; i += 512) { const int k = i >> 8, q = (i >> 6) & 3, c = i & 63; const int col = k * 1024 + c0b + c; wl[i] = (q < 3) ? w[q * HYW + col] : bs[col]; } }
    __syncthreads();
    for (int it = blockIdx.x; it < (TL / 64) * 16; it += gridDim.x) {
        const int c0 = (it & 15) * 64, t0 = (it >> 4) * 64;
        const int t = t0 + tok; const int pos = t & (SEQ - 1); const bool first = pos == 0, last = pos == SEQ - 1;
        float zz[3][8];
#pragma unroll
        for (int k = 0; k < 3; ++k) {
            const int c = k * 1024 + c0 + cg8;
            const bf16x8 zc = *(const bf16x8*)(ZH + (size_t)t * HYW + c);
            bf16x8 zp = zc, zn = zc;
            if (!first) zp = *(const bf16x8*)(ZH + (size_t)(t - 1) * HYW + c);
            if (!last) zn = *(const bf16x8*)(ZH + (size_t)(t + 1) * HYW + c);
            const float* wk = wl + k * 256 + cg8;
#pragma unroll
            for (int j = 0; j < 8; ++j) {
                float sacc = wk[192 + j] + bf2f((bf16_t)zc[j]) * wk[64 + j];
                if (!first) sacc += bf2f((bf16_t)zp[j]) * wk[j];
                if (!last) sacc += bf2f((bf16_t)zn[j]) * wk[128 + j];
                zz[k][j] = sacc;
            }
        }
        __syncthreads();
#pragma unroll
        for (int j = 0; j < 8; ++j) { tx[(cg8 + j) * 72 + tok] = f2bf(zz[0][j]); tv[(cg8 + j) * 72 + tok] = f2bf(zz[2][j] * zz[1][j]); }
        __syncthreads();
        { const int ch = tid >> 3, tk = (tid & 7) * 8;
          *(u32x4*)(X0T + (size_t)(c0 + ch) * TL + t0 + tk) = *(const u32x4*)(tx + ch * 72 + tk);
          *(u32x4*)(VXT + (size_t)(c0 + ch) * TL + t0 + tk) = *(const u32x4*)(tv + ch * 72 + tk); }
    }
    __syncthreads();
    if (M > TL) {
        float* VX = (float*)(p.ws + WS_Y); bf16_t* X0 = (bf16_t*)(p.ws + WS_H);
        for (int idx = TL * D + blockIdx.x * 512 + tid; idx < M * D; idx += gridDim.x * 512) {
            const int t = idx >> 10, d = idx & 1023;
            const int pos = (t - TL) & (CL - 1); const bool first = pos == 0, last = pos == CL - 1;
            float zz[3];
#pragma unroll
            for (int k = 0; k < 3; ++k) {
                const int c = k * 1024 + d;
                float sacc = bs[c] + bf2f(ZH[(size_t)t * HYW + c]) * w[HYW + c];
                if (!first) sacc += bf2f(ZH[(size_t)(t - 1) * HYW + c]) * w[c];
                if (!last) sacc += bf2f(ZH[(size_t)(t + 1) * HYW + c]) * w[2 * HYW + c];
                zz[k] = sacc;
            }
            VX[idx] = zz[2] * zz[1]; X0[idx] = f2bf(zz[0]);
        }
    }
}

typedef float f32x16 __attribute__((ext_vector_type(16)));
__device__ __forceinline__ void h3_longconv(const KQ p_in, int o, bool ctx_full, unsigned char* smem) {
    const KQ p = lq(p_in);
    const int tid = ltid(), w = tid >> 6, lane = tid & 63;
    const float* bias = pin_ld(27) + (size_t)o * D;
    {
        const bf16_t* VXT = (const bf16_t*)(p.ws + WS_Y); const bf16_t* X0T = VXT + (size_t)D * TL;
        bf16_t* HMT = (bf16_t*)(p.ws + WS_H);
        const bf16_t* RKT = (const bf16_t*)(p.ws + WS_KF + (size_t)o * SZ_KF);
        constexpr int RK2_OFF = 16384 + 64, U_OFF = 2 * 16384 + 128, CH_BYTES = U_OFF + 142 * 256;
        const int cw = w >> 2, w4 = w & 3;
        const int ct = tid & 255;
        unsigned char* cb = smem + cw * CH_BYTES;
        unsigned char* ub = cb + U_OFF;
        const int r = lane & 31, hh = lane >> 5;
        for (int pr = blockIdx.x; pr < D / 2; pr += gridDim.x) {
            const int d = pr * 2 + cw;
            __syncthreads();
            { const bf16_t* src = RKT + (size_t)d * 8192;
              for (int i = ct; i < 1024; i += 256) *(u32x4*)(cb + i * 16) = *(const u32x4*)(src + i * 8);
              for (int i = ct; i < 2 * 7 * 4 * 4; i += 256) { const int side = i / 112, rem = i % 112; unsigned z0 = 0u; asm volatile("" : "+v"(z0)); *(u32x4*)(ub + (side ? (135 * 4 * 64) : 0) + rem * 16) = (u32x4){z0, z0, z0, z0}; }
#pragma unroll 4
              for (int i = ct; i < 4 * 512; i += 256) { const int b = i >> 9, pc = i & 511;
                  const u32x4 v = *(const u32x4*)(VXT + (size_t)d * TL + b * SEQ + pc * 8);
                  const int col = ((pc >> 2) + 7) * 4 + b, q = pc & 3;
                  *(u32x4*)(ub + col * 64 + ((q ^ ((col >> 2) & 3)) * 16)) = v; } }
            __syncthreads();
            { const bf16_t* rk = (const bf16_t*)cb; bf16_t* rk2 = (bf16_t*)(cb + RK2_OFF);
#pragma unroll 4
              for (int i = ct; i < 4096; i += 256) { const unsigned lo = rk[2 * i + 1]; const unsigned hi = (2 * i + 2 < 8192) ? rk[2 * i + 2] : 0u; *(unsigned*)(rk2 + 2 * i) = lo | (hi << 16); } }
            __syncthreads();
            f32x16 acc[4];
#pragma unroll
            for (int j = 0; j < 4; ++j)
#pragma unroll
                for (int q = 0; q < 16; ++q) acc[j][q] = 0.f;
            const bf16_t* rsel = (const bf16_t*)(cb + ((r & 1) ? 0 : RK2_OFF));
            const int adj = (r & 1) ? 0 : -1;
            const int bq = r & 3;
#define H3_LOAD(AF, BF, U) do { \
                _Pragma("unroll") for (int s2 = 0; s2 < 2; ++s2) { \
                    const unsigned* ap = (const unsigned*)(Ab + 64 * (3 - (U)) + 32 * s2); \
                    u32x4 t4; t4.x = ap[0]; t4.y = ap[1]; t4.z = ap[2]; t4.w = ap[3]; \
                    AF[s2] = __builtin_bit_cast(bf16x8, t4); } \
                _Pragma("unroll") for (int j = 0; j < 4; ++j) { \
                    int c_ = Lb - 256 * (U) + 2048 * j; c_ = c_ < LO ? LO : (c_ > HI ? HI : c_); \
                    BF[j][0] = *(const bf16x8*)(ub + c_ + off[U][0]); BF[j][1] = *(const bf16x8*)(ub + c_ + off[U][1]); } } while (0)
#define H3_MMA(AF, BF) do { \
                _Pragma("unroll") for (int s2 = 0; s2 < 2; ++s2) \
                _Pragma("unroll") for (int j = 0; j < 4; ++j) acc[j] = __builtin_amdgcn_mfma_f32_32x32x16_bf16(AF[s2], BF[j][s2], acc[j], 0, 0, 0); } while (0)
            {
                const int dlo = 32 * w4 - 127;
                const int LO = (24 + bq) * 64, HI = (540 + bq) * 64;
                int off[4][2];
#pragma unroll
                for (int u = 0; u < 4; ++u) { const int sw = ((r >> 2) + 2 - u) & 3; off[u][0] = (hh ^ sw) * 16; off[u][1] = ((2 + hh) ^ sw) * 16; }
                int Lb = (((r >> 2) + 134) * 4 + bq) * 64;
                const unsigned char* Ab = (const unsigned char*)(rsel + (4095 - 32 * dlo - r + 8 * hh + adj)) - 192;
                bf16x8 afA[2], bfA[4][2], afB[2], bfB[4][2];
                H3_LOAD(afA, bfA, 0);
                for (int g = 0; g < 39; ++g) {
                    H3_LOAD(afB, bfB, 1);
                    __builtin_amdgcn_sched_barrier(0);
                    H3_MMA(afA, bfA);
                    __builtin_amdgcn_sched_barrier(0);
                    H3_LOAD(afA, bfA, 2);
                    __builtin_amdgcn_sched_barrier(0);
                    H3_MMA(afB, bfB);
                    __builtin_amdgcn_sched_barrier(0);
                    H3_LOAD(afB, bfB, 3);
                    __builtin_amdgcn_sched_barrier(0);
                    H3_MMA(afA, bfA);
                    __builtin_amdgcn_sched_barrier(0);
                    Ab -= 256; Lb -= 1024;
                    H3_LOAD(afA, bfA, 0);
                    __builtin_amdgcn_sched_barrier(0);
                    H3_MMA(afB, bfB);
                    __builtin_amdgcn_sched_barrier(0);
                }
                H3_LOAD(afB, bfB, 1);
                __builtin_amdgcn_sched_barrier(0);
                H3_MMA(afA, bfA);
                __builtin_amdgcn_sched_barrier(0);
                H3_LOAD(afA, bfA, 2);
                __builtin_amdgcn_sched_barrier(0);
                H3_MMA(afB, bfB);
                H3_MMA(afA, bfA);
            }
#undef H3_LOAD
#undef H3_MMA
            __syncthreads();
            const float bd = bias[d];
#pragma unroll
            for (int j = 0; j < 4; ++j) {
                const int n1 = 8 * (4 * w4 + j) + (r >> 2);
                const int col = (n1 + 7) * 4 + bq; const int sw = (col >> 2) & 3;
                bf16_t* up = (bf16_t*)(ub + col * 64);
#pragma unroll
                for (int q4 = 0; q4 < 4; ++q4) {
                    bf16_t* pp = up + ((q4 ^ sw) * 8) + 4 * hh;
                    const bf16x4 uv = *(const bf16x4*)pp;
                    uint2 o2; o2.x = pg8::cvt_pk_bf16(acc[j][4 * q4] + bd * bf2f((bf16_t)uv[0]), acc[j][4 * q4 + 1] + bd * bf2f((bf16_t)uv[1]));
                    o2.y = pg8::cvt_pk_bf16(acc[j][4 * q4 + 2] + bd * bf2f((bf16_t)uv[2]), acc[j][4 * q4 + 3] + bd * bf2f((bf16_t)uv[3]));
                    *(uint2*)pp = o2;
                }
            }
            __syncthreads();
#pragma unroll 2
            for (int i = ct; i < 4 * 512; i += 256) { const int b = i >> 9, pc = i & 511;
                const int col = ((pc >> 2) + 7) * 4 + b, q = pc & 3;
                const bf16x8 yv = *(const bf16x8*)(ub + col * 64 + ((q ^ ((col >> 2) & 3)) * 16));
                const size_t gi = (size_t)d * TL + b * SEQ + pc * 8;
                const bf16x8 xv = *(const bf16x8*)(X0T + gi);
                u32x4 o4;
                o4.x = pg8::cvt_pk_bf16(bf2f((bf16_t)yv[0]) * bf2f((bf16_t)xv[0]), bf2f((bf16_t)yv[1]) * bf2f((bf16_t)xv[1]));
                o4.y = pg8::cvt_pk_bf16(bf2f((bf16_t)yv[2]) * bf2f((bf16_t)xv[2]), bf2f((bf16_t)yv[3]) * bf2f((bf16_t)xv[3]));
                o4.z = pg8::cvt_pk_bf16(bf2f((bf16_t)yv[4]) * bf2f((bf16_t)xv[4]), bf2f((bf16_t)yv[5]) * bf2f((bf16_t)xv[5]));
                o4.w = pg8::cvt_pk_bf16(bf2f((bf16_t)yv[6]) * bf2f((bf16_t)xv[6]), bf2f((bf16_t)yv[7]) * bf2f((bf16_t)xv[7]));
                *(u32x4*)(HMT + gi) = o4; }
        }
        __syncthreads();
    }
    if (ctx_full) {
        const float* VX = (const float*)(p.ws + WS_Y); const bf16_t* X0 = (const bf16_t*)(p.ws + WS_H);
        bf16_t* MIX = (bf16_t*)(p.ws + WS_MIX);
        const float* kf = (const float*)(p.ws + WS_KF + (size_t)o * SZ_KF) + (size_t)2 * SEQ * D;
        for (int idx = blockIdx.x * 512 + tid; idx < (TC / 8) * D; idx += gridDim.x * 512) {
            const int d = idx & 1023, og = idx >> 10;
            const int bb = og >> 5, n0 = (og & 31) * 8, tb = TL + bb * CL;
            const float* up = VX + (size_t)tb * D + d;
            float acc[8];
#pragma unroll
            for (int j = 0; j < 8; ++j) acc[j] = 0.f;
#pragma unroll 1
            for (int mb = 0; mb < CL; mb += 8) {
                float kk[15], uu[8];
#pragma unroll
                for (int q = 0; q < 15; ++q) { const int lag = n0 - mb - 7 + q;
                    kk[q] = (lag >= 0) ? ((lag < CL) ? kf[(size_t)lag * D + d] : 0.f) : ((-lag < CL) ? kf[(size_t)(CL - lag) * D + d] : 0.f); }
#pragma unroll
                for (int u = 0; u < 8; ++u) uu[u] = up[(size_t)(mb + u) * D];
#pragma unroll
                for (int u = 0; u < 8; ++u)
#pragma unroll
                    for (int j = 0; j < 8; ++j) acc[j] += uu[u] * kk[7 - u + j];
            }
            const float bd = bias[d];
#pragma unroll
            for (int j = 0; j < 8; ++j) { const size_t ti = (size_t)(tb + n0 + j) * D + d; MIX[ti] = f2bf(bf2f(X0[ti]) * (acc[j] + bd * VX[ti])); }
        }
    }
}

__device__ __forceinline__ void h3b_transpose(const KQ p_in, unsigned char* smem) {
    const KQ p = lq(p_in);
    const int tid = ltid();
    const bf16_t* HMT = (const bf16_t*)(p.ws + WS_H); bf16_t* MIX = (bf16_t*)(p.ws + WS_MIX);
    bf16_t* tile = (bf16_t*)smem;
    for (int it = blockIdx.x; it < (TL / 64) * 16; it += gridDim.x) {
        const int c0 = (it & 15) * 64, t0 = (it >> 4) * 64;
        __syncthreads();
        { const int ch = tid >> 3, tk = (tid & 7) * 8; *(u32x4*)(tile + ch * 72 + tk) = *(const u32x4*)(HMT + (size_t)(c0 + ch) * TL + t0 + tk); }
        __syncthreads();
        { const int tok = tid >> 3, cg8 = (tid & 7) * 8; unsigned short v[8];
#pragma unroll
          for (int j = 0; j < 8; ++j) v[j] = tile[(cg8 + j) * 72 + tok];
          u32x4 o4; o4.x = v[0] | ((unsigned)v[1] << 16); o4.y = v[2] | ((unsigned)v[3] << 16); o4.z = v[4] | ((unsigned)v[5] << 16); o4.w = v[6] | ((unsigned)v[7] << 16);
          *(u32x4*)(MIX + (size_t)(t0 + tok) * D + c0 + cg8) = o4; }
    }
    __syncthreads();
}

__global__ void __launch_bounds__(512, 2) mega_fwd(KP kp) {
    unsigned char* const smem = g_smem;
    if (threadIdx.x < 29) *(LAS unsigned long long*)((LAS unsigned char*)g_smem + PTAB_OFF + 8 * threadIdx.x) = ((const unsigned long long*)__builtin_amdgcn_kernarg_segment_ptr())[threadIdx.x];
    KQ p; p.out = kp.out; p.ws = kp.ws;
    cg::grid_group grid = cg::this_grid();
    if (threadIdx.x < 4) ((volatile LAS unsigned*)(LAS unsigned char*)smem)[(LDS_BYTES - 16) / 4 + threadIdx.x] = 0u;
    __syncthreads();
    if (threadIdx.x == 0) (void)xb_add(&((unsigned*)(lq(p).ws + WS_BAR))[XB_XCNT(xb_xcc_id())], 1u);
    grid.sync();
    float* smf = (float*)smem;
#define Hb ((bf16_t*)(lq(p).ws + WS_H))
#define BIG ((bf16_t*)(lq(p).ws + WS_BIG))
#define Y ((bf16_t*)(lq(p).ws + WS_Y))
#define MIX ((bf16_t*)(lq(p).ws + WS_MIX))

#ifndef NO_P0
    p0_setup(p, smf);
#endif
    GRID_BAR();
    rowphase(p, 0, nullptr, 0, 0, 0.f, nullptr, T, 0, pin_ld(6), 0, 1, Hb, true, 0);
    GRID_BAR();
    for (int l = 0; l < 4; ++l) {
        const bool ctx_live = l <= 2, ctx_full = l < 2;
        const int Mff = ctx_live ? T : TL, Mpost = ctx_full ? T : TL;
        for (int sub = 0; sub < 3; ++sub) {
            const bf16_t* Ao; const bf16_t* Bo; int Ko; int Mo;
            if (sub != 1) {
                const int fi = sub >> 1; const int M = (sub == 0) ? Mff : Mpost;
                { pg8::EpiSwiGLU E{BIG, DFF}; run_gemm(smem, Hb, (const bf16_t*)(lq(p).ws + WS_WGU + (size_t)(l * 2 + fi) * SZ_WGU), M, 2 * DFF, D, E); }
                GRID_BAR();
                Ao = BIG; Bo = (const bf16_t*)(lq(p).ws + WS_WD + (size_t)(l * 2 + fi) * SZ_WD); Ko = DFF; Mo = M;
            } else {
                if ((l & 1) == 0) {
                    const int e = l >> 1;
                    { pg8::EpiBf16 E{BIG, INW, nullptr}; run_gemm(smem, Hb, (const bf16_t*)(lq(p).ws + WS_WIN + (size_t)e * SZ_WIN), Mff, INW, D, E); }
                    GRID_BAR();
#ifndef NO_M1
                    m1_rope_states(p, e, smf);
#endif
                    GRID_BAR();
#ifndef NO_M2
                    m2_scan(p, e);
#endif
                    GRID_BAR();
#ifndef NO_M3
                    m3_outputs(p, e, ctx_full, smem);
#endif
                    GRID_BAR();
                    Bo = (const bf16_t*)(lq(p).ws + WS_WOUT + (size_t)e * SZ_WOUT);
                } else {
                    const int o = l >> 1;
                    { pg8::EpiBf16 E{BIG, HYW, pin_ld(16) + (size_t)o * HYW}; run_gemm(smem, Hb, (const bf16_t*)(lq(p).ws + WS_HWIN + (size_t)o * SZ_HWIN), Mpost, HYW, D, E); }
                    GRID_BAR();
#ifndef NO_H2
                    h2_shortconv(p, o, Mpost, smem);
#endif
                    GRID_BAR();
#ifndef NO_H3
                    h3_longconv(p, o, ctx_full, smem);
#endif
                    GRID_BAR();
                    h3b_transpose(p, smem);
                    GRID_BAR();
                    Bo = (const bf16_t*)(lq(p).ws + WS_HWOUT + (size_t)o * SZ_WOUT);
                }
                Ao = MIX; Ko = D; Mo = Mpost;
            }
            const int gidx = 2 + 3 * sub;
            const int ln = (sub == 2) ? l + 1 : l; const bool has_next = ln < 4; const int lnn = has_next ? ln : l;
            const int pre_i = (sub == 2) ? 0 : sub + 1;
            const int Mn = has_next ? ((sub == 2) ? ((ln <= 2) ? T : TL) : ((sub == 0) ? Mff : Mpost)) : 0;
            const float* gpost = pin_ld(7) + (size_t)(l * 3 + sub) * D; const float* gpre = pin_ld(6) + (size_t)(lnn * 3 + pre_i) * D;
            const float wg = (sub == 1) ? 1.0f : 0.5f;
            {
                pg8::EpiFusedRow EF;
                EF.xin = (l == 0 && sub == 0) ? pin_ld(0) : (const float*)lq(p).out; EF.xout = lq(p).out; EF.H = has_next ? Hb : nullptr;
                EF.gate = modp(lq(p), l, 0, gidx); EF.gpost = gpost; EF.wgt = wg;
                EF.gpre = gpre; EF.shift = modp(lq(p), lnn, 0, 3 * pre_i); EF.scale = modp(lq(p), lnn, 0, 3 * pre_i + 1);
                EF.slots = (float*)(lq(p).ws + WS_SLOT); EF.cnt = (unsigned*)(lq(p).ws + WS_CNT) + (size_t)(l * 3 + sub) * 2 * 64 * 64;
                run_gemm_f32_split(smem, Ao, Bo, Mo, Ko, EF, (float*)(lq(p).ws + WS_YP));
            }
            GRID_BAR();
            if (Mo > TL) {
                rowphase(p, Mo, Y, l, gidx, wg, gpost, Mn, lnn, gpre, 3 * pre_i, 3 * pre_i + 1, has_next ? Hb : nullptr, l == 0 && sub == 0, TL);
                GRID_BAR();
            }
        }
    }
}

extern "C" void kernel_launch(void* const* d_in, const int* in_sizes, int n_in, void* d_out, int out_size, void* d_ws, size_t ws_size, hipStream_t stream) {
    static int grid = 0;
    if (grid == 0) {
        if (n_in != 29 || out_size != TL * D || ws_size < WS_END) { fprintf(stderr, "kernel_launch: unexpected shapes: n_in %d out %d ws %zu (need %zu)\n", n_in, out_size, ws_size, (size_t)WS_END); grid = -1; return; }
        int dev = 0, cus = 0, per_cu = 0;
        (void)hipGetDevice(&dev);
        (void)hipDeviceGetAttribute(&cus, hipDeviceAttributeMultiprocessorCount, dev);
        if (hipFuncSetAttribute((const void*)mega_fwd, hipFuncAttributeMaxDynamicSharedMemorySize, LDS_BYTES) != hipSuccess) { fprintf(stderr, "kernel_launch: hipFuncSetAttribute failed\n"); grid = -1; return; }
        if (hipOccupancyMaxActiveBlocksPerMultiprocessor(&per_cu, (const void*)mega_fwd, 512, LDS_BYTES) != hipSuccess || per_cu < 1) { fprintf(stderr, "kernel_launch: occupancy query says %d\n", per_cu); per_cu = 1; }
        (void)hipGetLastError();
        grid = cus >= 256 ? 256 : cus;
    }
    if (grid < 0) return;
    (void)hipMemsetAsync((unsigned char*)d_ws + WS_BAR, 0, 16384 + SZ_CNT, stream);
    KP kp{};
    for (int i = 0; i < 29; ++i) kp.in[i] = (const float*)d_in[i];
    kp.out = (float*)d_out; kp.ws = (unsigned char*)d_ws;
    void* args[] = {&kp};
    hipError_t e = hipLaunchCooperativeKernel((const void*)mega_fwd, dim3(grid), dim3(512), args, LDS_BYTES, stream);
    if (e != hipSuccess) fprintf(stderr, "cooperative launch failed: %s (grid %d)\n", hipGetErrorString(e), grid);
}
```

```cpp
#include <hip/hip_runtime.h>
#include <hip/hip_cooperative_groups.h>
#include <cstdio>
namespace cg = cooperative_groups;

#define LAS __attribute__((address_space(3)))
typedef unsigned short bf16_t;
typedef short bf16x8 __attribute__((ext_vector_type(8)));
typedef short bf16x4 __attribute__((ext_vector_type(4)));
typedef float f32x4 __attribute__((ext_vector_type(4)));
typedef unsigned u32x4 __attribute__((ext_vector_type(4)));

constexpr int D = 1024, NB = 4, SEQ = 4096, CL = 256, TL = NB * SEQ, TC = NB * CL, T = TL + TC, DFF = 2816, INW = 2816, HYW = 3072;
constexpr int NMOD = 9;
constexpr float EPS = 1e-6f;
constexpr int NCH = 34;
constexpr int LDS_BYTES = 144 * 1024;

constexpr size_t SZ_WGU = (size_t)2 * DFF * D * 2, SZ_WD = (size_t)D * DFF * 2, SZ_WIN = (size_t)INW * D * 2, SZ_WOUT = (size_t)D * D * 2, SZ_HWIN = (size_t)HYW * D * 2;
constexpr size_t WS_WGU = 0;
constexpr size_t WS_WD = WS_WGU + 8 * SZ_WGU;
constexpr size_t WS_WIN = WS_WD + 8 * SZ_WD;
constexpr size_t WS_WOUT = WS_WIN + 2 * SZ_WIN;
constexpr size_t WS_HWIN = WS_WOUT + 2 * SZ_WOUT;
constexpr size_t WS_HWOUT = WS_HWIN + 2 * SZ_HWIN;
constexpr size_t WS_MOD = WS_HWOUT + 2 * SZ_WOUT;
constexpr size_t WS_ROPE = WS_MOD + (size_t)4 * 5 * NMOD * D * 4;
constexpr size_t WS_XC = WS_ROPE + (size_t)4 * SEQ * 32 * 4;
constexpr size_t WS_H = WS_XC + (size_t)TC * D * 4;
constexpr size_t WS_BIG = WS_H + (size_t)T * D * 2;
constexpr size_t WS_Y = WS_BIG + (size_t)T * HYW * 2;
constexpr size_t WS_MIX = WS_Y + (size_t)T * D * 4;
constexpr size_t SZ_ST = (size_t)NB * NCH * 8 * 4096 * 4;
constexpr size_t WS_ST = WS_MIX + (size_t)T * D * 2;
constexpr size_t SZ_KF = (size_t)(SEQ + CL) * 2 * D * 4;
constexpr size_t WS_KF = WS_ST + 4 * SZ_ST;
constexpr size_t WS_YP = WS_KF + 2 * SZ_KF;
constexpr size_t WS_BAR = WS_YP + (size_t)4 * TC * D * 4;
constexpr size_t WS_CNT = WS_BAR + 16384;
constexpr size_t SZ_CNT = (size_t)12 * 2 * 64 * 256 + 12 * 256;
constexpr size_t WS_SLOT = WS_CNT + SZ_CNT;
constexpr size_t WS_END = WS_SLOT + (size_t)2 * TL * 4 * 4;

struct KP { const float* in[29]; float* out; unsigned char* ws; };
extern __shared__ __attribute__((aligned(16))) unsigned char g_smem[];
constexpr int PTAB_OFF = LDS_BYTES - 512;
__device__ __forceinline__ const float* pin_ld(int k) {
    const unsigned long long v = *(volatile LAS unsigned long long*)((LAS unsigned char*)g_smem + PTAB_OFF + 8 * k);
    const unsigned lo = __builtin_amdgcn_readfirstlane((unsigned)v), hi = __builtin_amdgcn_readfirstlane((unsigned)(v >> 32));
    return (const float*)(((unsigned long long)hi << 32) | lo);
}
struct KQ { float* out; unsigned char* ws; };
__device__ __forceinline__ KQ lq(KQ q) { asm volatile("" : "+s"(q.out), "+s"(q.ws)); return q; }

__device__ __forceinline__ bf16_t f2bf(float f) { unsigned u = __float_as_uint(f); u += 0x7FFFu + ((u >> 16) & 1u); return (bf16_t)(u >> 16); }
__device__ __forceinline__ float bf2f(bf16_t b) { return __uint_as_float(((unsigned)b) << 16); }
__device__ __forceinline__ float silu_f(float x) { return x * __builtin_amdgcn_rcpf(1.0f + __expf(-x)); }
__device__ __forceinline__ int ltid() { int t = threadIdx.x; asm volatile("" : "+v"(t)); return t; }
__device__ __forceinline__ float wave_sum(float v) {
#pragma unroll
    for (int o = 32; o > 0; o >>= 1) v += __shfl_xor(v, o, 64);
    return v;
}


#define XB_TMO      128
#define XB_XCNT(j)  (256  + 64 * (j))
#define XB_XSUB(j)  (1280 + 64 * (j))
#define XB_XGEN(j)  (2304 + 64 * (j))
#define XB_TOP      3328
#define XB_TOPGEN   3392
#define XCD_BAR_WORDS 3456
#define XB_SPIN_CAP (1u << 18)
__device__ __forceinline__ unsigned xb_ld(unsigned* p)              { return __hip_atomic_load(p, __ATOMIC_RELAXED, __HIP_MEMORY_SCOPE_AGENT); }
__device__ __forceinline__ unsigned xb_add(unsigned* p, unsigned v) { return __hip_atomic_fetch_add(p, v, __ATOMIC_RELAXED, __HIP_MEMORY_SCOPE_AGENT); }
__device__ __forceinline__ unsigned xb_xcc_id() { return (unsigned)__builtin_amdgcn_s_getreg((3 << 11) | 20) & 0xFu; }
#define XB_SPIN(cond, bar) do { unsigned _sp = 0; while (cond) { __builtin_amdgcn_s_sleep(1); \
    if ((++_sp & 255u) == 0u) { if (xb_ld(&(bar)[XB_TMO])) break; if (_sp > XB_SPIN_CAP) { atomicAdd(&(bar)[XB_TMO], 1u); break; } } } } while (0)
struct XcdBarrier { unsigned* bar; unsigned x; volatile LAS unsigned* st; };
__device__ __forceinline__ XcdBarrier xcd_barrier_post(unsigned* bar, volatile LAS unsigned* st) {
    XcdBarrier b; b.bar = bar; b.x = xb_xcc_id(); b.st = st;
    if (threadIdx.x == 0) (void)xb_add(&bar[XB_XCNT(b.x)], 1u);
    return b;
}
__device__ __forceinline__ void xcd_barrier_complete(unsigned* bar, unsigned x, unsigned& nloc, unsigned& nx) {
    const unsigned G = gridDim.x * gridDim.y * gridDim.z;
    unsigned sum, cnt, mine, sp = 0u;
    for (;;) {
        sum = 0u; cnt = 0u; mine = 0u;
#pragma unroll
        for (unsigned j = 0; j < 16; ++j) { const unsigned c = xb_ld(&bar[XB_XCNT(j)]); sum += c; cnt += (c > 0u) ? 1u : 0u; mine = (j == x) ? c : mine; }
        if (sum == G) break;
        __builtin_amdgcn_s_sleep(1);
        if ((++sp & 255u) == 0u) { if (xb_ld(&bar[XB_TMO])) break; if (sp > XB_SPIN_CAP) { atomicAdd(&bar[XB_TMO], 1u); break; } }
    }
    nloc = mine > 0u ? mine : 1u; nx = cnt > 0u ? cnt : 1u;
}
__device__ __forceinline__ void xcd_barrier_impl(unsigned* bar, volatile LAS unsigned* st) {
    asm volatile("s_waitcnt vmcnt(0)" ::: "memory");
    __syncthreads();
    if (ltid() == 0) {
        const unsigned x = xb_xcc_id();
        __builtin_amdgcn_s_waitcnt(0);
        unsigned nloc = st[0], nx = st[1];
        if (nloc == 0u) { xcd_barrier_complete(bar, x, nloc, nx); st[0] = nloc; st[1] = nx; }
        const unsigned old = xb_add(&bar[XB_XSUB(x)], 1u);
        const unsigned gen = old / nloc;
        if (old + 1u == (gen + 1u) * nloc) {
            __builtin_amdgcn_fence(__ATOMIC_RELEASE, "agent");
            asm volatile("s_waitcnt vmcnt(0)" ::: "memory");
            const unsigned og = xb_add(&bar[XB_TOP], 1u);
            const unsigned tg = og / nx;
            if (og + 1u == (tg + 1u) * nx) xb_add(&bar[XB_TOPGEN], 1u);
            else XB_SPIN(xb_ld(&bar[XB_TOPGEN]) == tg, bar);
            __builtin_amdgcn_fence(__ATOMIC_ACQUIRE, "agent");
            xb_add(&bar[XB_XGEN(x)], 1u);
            asm volatile("s_waitcnt vmcnt(0)" ::: "memory");
        } else {
            XB_SPIN(xb_ld(&bar[XB_XGEN(x)]) == gen, bar);
            __builtin_amdgcn_fence(__ATOMIC_ACQUIRE, "agent");
            asm volatile("s_waitcnt vmcnt(0)" ::: "memory");
        }
    }
    __syncthreads();
}
__device__ __forceinline__ void sub_barrier(unsigned* word, unsigned n) {
    asm volatile("s_waitcnt vmcnt(0)" ::: "memory");
    __syncthreads();
    if (ltid() == 0) {
        __builtin_amdgcn_fence(__ATOMIC_RELEASE, "agent");
        asm volatile("s_waitcnt vmcnt(0)" ::: "memory");
        (void)xb_add(word, 1u);
        for (unsigned sp = 0; sp < (1u << 21); ++sp) { if (xb_ld(word) >= n) break; __builtin_amdgcn_s_sleep(2); }
        __builtin_amdgcn_fence(__ATOMIC_ACQUIRE, "agent");
        asm volatile("s_waitcnt vmcnt(0)" ::: "memory");
    }
    __syncthreads();
}
#define GRID_BAR() xcd_barrier_impl((unsigned*)(p.ws + WS_BAR), (volatile LAS unsigned*)((LAS unsigned char*)smem + LDS_BYTES - 16))

namespace pg8 {
constexpr int BM = 256, BK = 64, HALF = 128, HTB = HALF * BK * 2, STAGE_BYTES = 8 * HTB, NXCD = 8, WGM = 8;
__host__ __device__ __forceinline__ int lds_byte(int r, int c) { const int st = (r >> 4) * 2 + (c >> 5), rr = r & 15, cc = c & 31, ob = rr * 64 + cc * 2; return st * 1024 + (ob ^ (((ob >> 9) & 1) << 5)); }
__host__ __device__ __forceinline__ void stage_rc(int b, int& R, int& C) { const int st = b / 1024, sb = b % 1024, swz = sb ^ (((sb >> 9) & 1) << 5); R = (st >> 1) * 16 + swz / 64; C = (st & 1) * 32 + (swz % 64) / 2; }
__host__ __device__ __forceinline__ int perm32(int rho) { const int n = rho >> 4, i = rho & 15; return 8 * (i >> 2) + 4 * n + (i & 3); }
struct Unit { int pm, pn; };
struct Gemm { const bf16_t* A; const bf16_t* Bt; int M, N, K, ld; };
struct StaticOrder {
    int nM, nN, nwg, G, c;
    __device__ void init(int M, int N, int G_, int c_) { nM = M / BM; nN = N / BM; nwg = nM * nN; G = G_; c = c_; }
    __device__ bool next(int i, Unit& u) const {
        const long Lx = (long)i * G + c; if (Lx >= nwg) return false;
        int wgid = (int)Lx; { const int q = nwg / NXCD, r = nwg % NXCD, xcd = wgid % NXCD, off = wgid / NXCD; wgid = (xcd < r ? xcd * (q + 1) : r * (q + 1) + (xcd - r) * q) + off; }
        const int nig = WGM * nN, gid = wgid / nig, fm = gid * WGM, gsz = (nM - fm) < WGM ? (nM - fm) : WGM;
        u.pm = fm + ((wgid % nig) % gsz); u.pn = (wgid % nig) / gsz; return true;
    }
};
__device__ __forceinline__ unsigned cvt_pk_bf16(float lo, float hi) { unsigned r; asm volatile("v_cvt_pk_bf16_f32 %0, %1, %2" : "=v"(r) : "v"(lo), "v"(hi)); return r; }

struct EpiF32 {
    static constexpr bool PERM = false, AFTER_DRAIN = false;
    float* C; int ldc;
    __device__ __forceinline__ void operator()(const f32x4 (&acc)[2][2][4][2], const Unit& u, int wr, int wc, int fr, int fq) const {
        const int row0 = u.pm * BM + wr * 64 + fr, col0 = u.pn * BM + wc * 32 + 4 * fq;
#pragma unroll
        for (int ai = 0; ai < 2; ++ai)
#pragma unroll
            for (int m = 0; m < 4; ++m) { float* rowp = C + (size_t)(row0 + ai * HALF + m * 16) * ldc + col0;
#pragma unroll
                for (int bj = 0; bj < 2; ++bj)
#pragma unroll
                    for (int n = 0; n < 2; ++n) *(f32x4*)(rowp + bj * HALF + n * 16) = acc[ai][bj][m][n]; }
    }
};
struct EpiBf16 {
    static constexpr bool PERM = true, AFTER_DRAIN = false;
    bf16_t* O; int ldc; const float* bias;
    __device__ __forceinline__ void operator()(const f32x4 (&acc)[2][2][4][2], const Unit& u, int wr, int wc, int fr, int fq) const {
        const int row0 = u.pm * BM + wr * 64 + fr; const int col0 = u.pn * BM + wc * 32 + 8 * fq;
        f32x4 bv[2][2];
#pragma unroll
        for (int bj = 0; bj < 2; ++bj)
#pragma unroll
            for (int n = 0; n < 2; ++n) bv[bj][n] = bias ? *(const f32x4*)(bias + col0 + bj * HALF + 4 * n) : (f32x4){0.f, 0.f, 0.f, 0.f};
#pragma unroll
        for (int ai = 0; ai < 2; ++ai)
#pragma unroll
            for (int m = 0; m < 4; ++m) { bf16_t* rowp = O + (size_t)(row0 + ai * HALF + m * 16) * ldc + col0;
#pragma unroll
                for (int bj = 0; bj < 2; ++bj) { f32x4 v0 = acc[ai][bj][m][0] + bv[bj][0], v1 = acc[ai][bj][m][1] + bv[bj][1];
                    u32x4 w; w.x = cvt_pk_bf16(v0[0], v0[1]); w.y = cvt_pk_bf16(v0[2], v0[3]); w.z = cvt_pk_bf16(v1[0], v1[1]); w.w = cvt_pk_bf16(v1[2], v1[3]);
                    *(u32x4*)(rowp + bj * HALF) = w; } }
    }
};
struct EpiSwiGLU {
    static constexpr bool PERM = true, AFTER_DRAIN = false;
    bf16_t* O; int ldc;
    __device__ __forceinline__ void operator()(const f32x4 (&acc)[2][2][4][2], const Unit& u, int wr, int wc, int fr, int fq) const {
        const int row0 = u.pm * BM + wr * 64 + fr; const int col0 = u.pn * HALF + wc * 32 + 8 * fq;
#pragma unroll
        for (int ai = 0; ai < 2; ++ai)
#pragma unroll
            for (int m = 0; m < 4; ++m) { bf16_t* rowp = O + (size_t)(row0 + ai * HALF + m * 16) * ldc + col0;
                float v[8];
#pragma unroll
                for (int n = 0; n < 2; ++n)
#pragma unroll
                    for (int j = 0; j < 4; ++j) { const float g = acc[ai][0][m][n][j], up = acc[ai][1][m][n][j]; v[n * 4 + j] = silu_f(g) * up; }
                u32x4 w; w.x = cvt_pk_bf16(v[0], v[1]); w.y = cvt_pk_bf16(v[2], v[3]); w.z = cvt_pk_bf16(v[4], v[5]); w.w = cvt_pk_bf16(v[6], v[7]);
                *(u32x4*)rowp = w; }
    }
};


__device__ __forceinline__ void row_exchange(const f32x4 (&v)[2][2][4][2], const Unit& u, int wr, int wc, int fr, int fq, LAS unsigned char* lds, int wid, int lane, float* slots, unsigned* cnt) {
    LAS float* P = (LAS float*)lds;
    LAS float* S = (LAS float*)(lds + 4096);
#pragma unroll
    for (int ai = 0; ai < 2; ++ai)
#pragma unroll
        for (int m = 0; m < 4; ++m) {
            float sq = 0.f;
#pragma unroll
            for (int bj = 0; bj < 2; ++bj)
#pragma unroll
                for (int n = 0; n < 2; ++n) { const f32x4 x = v[ai][bj][m][n]; sq += (x[0] * x[0] + x[1] * x[1]) + (x[2] * x[2] + x[3] * x[3]); }
            sq += __shfl_xor(sq, 16); sq += __shfl_xor(sq, 32);
            if (fq == 0) P[(ai * HALF + wr * 64 + m * 16 + fr) * 4 + wc] = sq;
        }
    asm volatile("s_waitcnt lgkmcnt(0)" ::: "memory"); __builtin_amdgcn_s_barrier(); asm volatile("" ::: "memory");
    const int row = wid * 32 + (lane & 31);
    if (lane < 32) {
        const float tot = (P[row * 4 + 0] + P[row * 4 + 1]) + (P[row * 4 + 2] + P[row * 4 + 3]);
        __hip_atomic_store((unsigned*)slots + ((size_t)(u.pm * BM + row) * 4 + u.pn), __float_as_uint(tot), __ATOMIC_RELAXED, __HIP_MEMORY_SCOPE_AGENT);
    }
    asm volatile("s_waitcnt vmcnt(0)" ::: "memory");
    if (lane == 0) __hip_atomic_fetch_add(cnt + 64 * u.pm, 1u, __ATOMIC_RELAXED, __HIP_MEMORY_SCOPE_AGENT);
    if (wid == 0) {
        for (unsigned sp = 0; sp < (1u << 21); ++sp) {
            if ((unsigned)__builtin_amdgcn_readfirstlane(__hip_atomic_load(cnt + 64 * u.pm, __ATOMIC_RELAXED, __HIP_MEMORY_SCOPE_AGENT)) >= 32u) break;
            __builtin_amdgcn_s_sleep(2);
        }
        __builtin_amdgcn_fence(__ATOMIC_ACQUIRE, "agent");
    }
    asm volatile("s_waitcnt vmcnt(0) lgkmcnt(0)" ::: "memory"); __builtin_amdgcn_s_barrier(); asm volatile("" ::: "memory");
    if (lane < 32) {
        const unsigned* sl = (const unsigned*)slots + (size_t)(u.pm * BM + row) * 4;
        float tot = 0.f;
#pragma unroll
        for (int t = 0; t < 4; ++t) tot += __uint_as_float(__hip_atomic_load(sl + t, __ATOMIC_RELAXED, __HIP_MEMORY_SCOPE_AGENT));
        S[row] = tot;
    }
    asm volatile("s_waitcnt vmcnt(0) lgkmcnt(0)" ::: "memory"); __builtin_amdgcn_s_barrier(); asm volatile("" ::: "memory");
}
struct EpiFusedRow {
    static constexpr bool PERM = false, AFTER_DRAIN = true;
    const float* xin; float* xout; bf16_t* H;
    const float* gate; const float* gpost; float wgt;
    const float* gpre; const float* shift; const float* scale;
    float* slots; unsigned* cnt;
    __device__ __forceinline__ void operator()(const f32x4 (&)[2][2][4][2], const Unit&, int, int, int, int) const {}
    __device__ __forceinline__ void fused(f32x4 (&acc)[2][2][4][2], const Unit& u, int wr, int wc, int fr, int fq, LAS unsigned char* lds, int wid, int lane) const {
        const LAS float* S = (const LAS float*)(lds + 4096);
        const int col0 = u.pn * BM + wc * 32 + 4 * fq; const size_t mb = (size_t)(u.pm >> 4) * (NMOD * D);
        row_exchange(acc, u, wr, wc, fr, fq, lds, wid, lane, slots, cnt);
        {
            f32x4 cw[2][2];
#pragma unroll
            for (int bj = 0; bj < 2; ++bj)
#pragma unroll
                for (int n = 0; n < 2; ++n) cw[bj][n] = *(const f32x4*)(gate + mb + col0 + bj * HALF + n * 16) * *(const f32x4*)(gpost + col0 + bj * HALF + n * 16);
#pragma unroll
            for (int ai = 0; ai < 2; ++ai)
#pragma unroll
                for (int m = 0; m < 4; ++m) { const int r = ai * HALF + wr * 64 + m * 16 + fr; const float r1 = rsqrtf(S[r] * (1.0f / D) + EPS) * wgt; const size_t off = (size_t)(u.pm * BM + r) * D + col0;
#pragma unroll
                    for (int bj = 0; bj < 2; ++bj)
#pragma unroll
                        for (int n = 0; n < 2; ++n) { const f32x4 xv = *(const f32x4*)(xin + off + bj * HALF + n * 16); const f32x4 xn = xv + (cw[bj][n] * r1) * acc[ai][bj][m][n];
                            acc[ai][bj][m][n] = xn; *(f32x4*)(xout + off + bj * HALF + n * 16) = xn; }
                    asm volatile("" : "+v"(acc[ai][0][m][0]), "+v"(acc[ai][0][m][1]), "+v"(acc[ai][1][m][0]), "+v"(acc[ai][1][m][1]));
                    asm volatile("" ::: "memory"); }
        }
        if (H == nullptr) return;
        row_exchange(acc, u, wr, wc, fr, fq, lds, wid, lane, slots + (size_t)TL * 4, cnt + 64 * 64);
        {
            f32x4 gm[2][2], sh[2][2];
#pragma unroll
            for (int bj = 0; bj < 2; ++bj)
#pragma unroll
                for (int n = 0; n < 2; ++n) { const int c = col0 + bj * HALF + n * 16; gm[bj][n] = *(const f32x4*)(gpre + c) * (*(const f32x4*)(scale + mb + c) + 1.0f); sh[bj][n] = *(const f32x4*)(shift + mb + c); }
#pragma unroll
            for (int ai = 0; ai < 2; ++ai)
#pragma unroll
                for (int m = 0; m < 4; ++m) { const int r = ai * HALF + wr * 64 + m * 16 + fr; const float r2 = rsqrtf(S[r] * (1.0f / D) + EPS); const size_t off = (size_t)(u.pm * BM + r) * D + col0;
#pragma unroll
                    for (int bj = 0; bj < 2; ++bj)
#pragma unroll
                        for (int n = 0; n < 2; ++n) { const f32x4 hv = (acc[ai][bj][m][n] * r2) * gm[bj][n] + sh[bj][n];
                            uint2 w2; w2.x = cvt_pk_bf16(hv[0], hv[1]); w2.y = cvt_pk_bf16(hv[2], hv[3]); *(uint2*)(H + off + bj * HALF + n * 16) = w2; }
                    asm volatile("" ::: "memory"); }
        }
    }
};

template <class Epi, class Sched>
__device__ __forceinline__ void gemm_phase(LAS unsigned char* lds, const Gemm g, const Sched& S, const Epi& E) {
    const int tid = ltid(), wid = __builtin_amdgcn_readfirstlane(tid >> 6), lane = tid & 63, wr = wid >> 2, wc = wid & 3, fr = lane & 15, fq = lane >> 4;
    const int K = g.ld, nt = g.K / BK;
    unsigned voffA[2], voffB[2];
#pragma unroll
    for (int i = 0; i < 2; ++i) { int R, C; stage_rc(tid * 16 + i * 8192, R, C); const int Rb = Epi::PERM ? ((R & ~31) + perm32(R & 31)) : R;
        voffA[i] = (unsigned)(R * K + C) * 2u; voffB[i] = (unsigned)(Rb * K + C) * 2u; }
    const size_t kstep = (size_t)(BK * 2);
    const size_t hstep = (size_t)HALF * K * 2;
    const size_t tstep = 2 * hstep;
    const unsigned ldsw = (unsigned)wid * 1024u;
    const int aoff = lds_byte(wr * 64 + fr, fq * 8), boff = lds_byte(wc * 32 + fr, fq * 8);
#define PG8_SA(b, h) (((b) * 2 + (h)) * HTB)
#define PG8_SB(b, h) ((4 + (b) * 2 + (h)) * HTB)
#define PG8_STAGE(bufoff, gbase, voff) do { _Pragma("unroll") for (int _i = 0; _i < 2; ++_i) \
        __builtin_amdgcn_global_load_lds((const unsigned*)((const char*)(gbase) + (voff)[_i]), (LAS unsigned*)(lds + (bufoff) + ldsw + _i * 8192), 16, 0, 0); } while (0)
#define PG8_LDA(dst, b, h) do { _Pragma("unroll") for (int m = 0; m < 4; ++m) _Pragma("unroll") for (int k = 0; k < 2; ++k) dst[m][k] = *(const LAS bf16x8*)(lds + PG8_SA(b, h) + aoff + m * 2048 + k * 1024); } while (0)
#define PG8_LDB(dst, b, h) do { _Pragma("unroll") for (int n = 0; n < 2; ++n) _Pragma("unroll") for (int k = 0; k < 2; ++k) dst[n][k] = *(const LAS bf16x8*)(lds + PG8_SB(b, h) + boff + n * 2048 + k * 1024); } while (0)
#define PG8_MMA(ai, bj, At, Bt) do { __builtin_amdgcn_s_setprio(1); _Pragma("unroll") for (int m = 0; m < 4; ++m) _Pragma("unroll") for (int n = 0; n < 2; ++n) _Pragma("unroll") for (int k = 0; k < 2; ++k) \
        acc[ai][bj][m][n] = __builtin_amdgcn_mfma_f32_16x16x32_bf16(Bt[n][k], At[m][k], acc[ai][bj][m][n], 0, 0, 0); __builtin_amdgcn_s_setprio(0); } while (0)
#define PG8_WAIT_V(n) asm volatile("s_waitcnt vmcnt(" #n ")" ::: "memory")
#define PG8_WAIT_L(n) asm volatile("s_waitcnt lgkmcnt(" #n ")" ::: "memory")
#define PG8_BAR __builtin_amdgcn_s_barrier()
#define PG8_SCHED __builtin_amdgcn_sched_barrier(0)
    Unit cur, nxt; int ui = 0;
    if (!S.next(0, cur)) return;
    f32x4 acc[2][2][4][2];
#pragma unroll
    for (int a = 0; a < 2; ++a)
#pragma unroll
        for (int b = 0; b < 2; ++b)
#pragma unroll
            for (int m = 0; m < 4; ++m)
#pragma unroll
                for (int n = 0; n < 2; ++n) acc[a][b][m][n] = (f32x4){0.f, 0.f, 0.f, 0.f};
    bf16x8 At[4][2], B0[2][2], B1[2][2];
    const char* cA = (const char*)g.A + (size_t)cur.pm * tstep; const char* cB = (const char*)g.Bt + (size_t)cur.pn * tstep;
    PG8_STAGE(PG8_SB(0, 0), cB, voffB); PG8_STAGE(PG8_SA(0, 0), cA, voffA); PG8_STAGE(PG8_SB(0, 1), cB + hstep, voffB); PG8_STAGE(PG8_SA(0, 1), cA + hstep, voffA);
    if (wr == 1) PG8_BAR;
    PG8_WAIT_V(4); PG8_BAR;
    PG8_STAGE(PG8_SB(1, 0), cB + kstep, voffB); PG8_STAGE(PG8_SA(1, 0), cA + kstep, voffA); PG8_STAGE(PG8_SB(1, 1), cB + hstep + kstep, voffB);
    PG8_WAIT_V(6); PG8_BAR;
    for (;;) {
        const bool has_next = S.next(ui + 1, nxt);
        const char* nA = has_next ? (const char*)g.A + (size_t)nxt.pm * tstep : cA; const char* nB = has_next ? (const char*)g.Bt + (size_t)nxt.pn * tstep : cB;
        for (int t = 0; t < nt; t += 2) {
            const bool last = (t == nt - 2);
            const char* a1 = cA + (size_t)(t + 1) * kstep;
            const char* a2 = last ? nA : cA + (size_t)(t + 2) * kstep; const char* b2 = last ? nB : cB + (size_t)(t + 2) * kstep;
            const char* a3 = a2 + kstep; const char* b3 = b2 + kstep;
            PG8_LDB(B0, 0, 0); PG8_SCHED; PG8_LDA(At, 0, 0); PG8_STAGE(PG8_SA(1, 1), a1 + hstep, voffA);
            PG8_WAIT_L(8); PG8_BAR; PG8_WAIT_L(0); PG8_MMA(0, 0, At, B0); PG8_BAR; PG8_SCHED;
            PG8_LDB(B1, 0, 1); PG8_STAGE(PG8_SB(0, 0), b2, voffB);
            PG8_BAR; PG8_WAIT_L(0); PG8_MMA(0, 1, At, B1); PG8_BAR;
            PG8_LDA(At, 0, 1); PG8_STAGE(PG8_SA(0, 0), a2, voffA);
            PG8_BAR; PG8_WAIT_L(0); PG8_MMA(1, 0, At, B0); PG8_BAR; PG8_SCHED;
            PG8_STAGE(PG8_SB(0, 1), b2 + hstep, voffB);
            PG8_WAIT_V(6); PG8_BAR; PG8_MMA(1, 1, At, B1); PG8_BAR;
            PG8_LDB(B0, 1, 0); PG8_SCHED; PG8_LDA(At, 1, 0); PG8_STAGE(PG8_SA(0, 1), a2 + hstep, voffA);
            PG8_WAIT_L(8); PG8_BAR; PG8_WAIT_L(0); PG8_MMA(0, 0, At, B0); PG8_BAR; PG8_SCHED;
            PG8_LDB(B1, 1, 1); PG8_STAGE(PG8_SB(1, 0), b3, voffB);
            PG8_BAR; PG8_WAIT_L(0); PG8_MMA(0, 1, At, B1); PG8_BAR;
            PG8_LDA(At, 1, 1); PG8_STAGE(PG8_SA(1, 0), a3, voffA);
            PG8_BAR; PG8_WAIT_L(0); PG8_MMA(1, 0, At, B0); PG8_BAR; PG8_SCHED;
            PG8_STAGE(PG8_SB(1, 1), b3 + hstep, voffB);
            PG8_WAIT_V(6); PG8_BAR; PG8_MMA(1, 1, At, B1); PG8_BAR;
        }
        if constexpr (!Epi::AFTER_DRAIN) E(acc, cur, wr, wc, fr, fq);
        if (!has_next) break;
#pragma unroll
        for (int a = 0; a < 2; ++a)
#pragma unroll
            for (int b = 0; b < 2; ++b)
#pragma unroll
                for (int m = 0; m < 4; ++m)
#pragma unroll
                    for (int n = 0; n < 2; ++n) acc[a][b][m][n] = (f32x4){0.f, 0.f, 0.f, 0.f};
        cur = nxt; cA = nA; cB = nB; ++ui;
    }
    PG8_WAIT_V(0);
    if (wr == 0) PG8_BAR;
    PG8_BAR;
    if constexpr (Epi::AFTER_DRAIN) E.fused(acc, cur, wr, wc, fr, fq, lds, wid, lane);
#undef PG8_SA
#undef PG8_SB
#undef PG8_STAGE
#undef PG8_LDA
#undef PG8_LDB
#undef PG8_MMA
#undef PG8_WAIT_V
#undef PG8_WAIT_L
#undef PG8_BAR
#undef PG8_SCHED
}
}

template <class Epi>
__device__ __forceinline__ void run_gemm(unsigned char* smem, const bf16_t* A, const bf16_t* Bt, int M, int N, int K, const Epi& E) {
    pg8::Gemm g{A, Bt, M, N, K, K}; pg8::StaticOrder S; S.init(M, N, (int)gridDim.x, (int)blockIdx.x);
    pg8::gemm_phase<Epi, pg8::StaticOrder>((LAS unsigned char*)smem, g, S, E);
}
__device__ __forceinline__ void run_gemm_f32_split(unsigned char* smem, const bf16_t* A, const bf16_t* Bt, int M, int K, const pg8::EpiFusedRow& EF, float* YP) {
    { pg8::Gemm g{A, Bt, TL, D, K, K}; pg8::StaticOrder S; S.init(TL, D, (int)gridDim.x, (int)blockIdx.x);
      pg8::gemm_phase<pg8::EpiFusedRow, pg8::StaticOrder>((LAS unsigned char*)smem, g, S, EF); }
    __syncthreads();
    if (M > TL && blockIdx.x < 64) {
        const int ks = blockIdx.x >> 4;
        int koff, klen;
        if (K == DFF) { koff = (ks < 2) ? ks * 768 : 1536 + (ks - 2) * 640; klen = (ks < 2) ? 768 : 640; }
        else { klen = K / 4; koff = ks * klen; }
        pg8::Gemm g{A + (size_t)TL * K + koff, Bt + koff, TC, D, klen, K}; pg8::StaticOrder S; S.init(TC, D, 16, (int)(blockIdx.x & 15)); pg8::EpiF32 E{YP + (size_t)ks * TC * D, D};
        pg8::gemm_phase<pg8::EpiF32, pg8::StaticOrder>((LAS unsigned char*)smem, g, S, E);
        __syncthreads();
    }
}

__device__ __forceinline__ float* xrow(const KQ p, int t) { return t < TL ? p.out + (size_t)t * D : (float*)(p.ws + WS_XC) + (size_t)(t - TL) * D; }
__device__ __forceinline__ int modrow(int t) { return t < TL ? (t >> 12) : 4; }
__device__ __forceinline__ const float* modp(const KQ p, int l, int mr, int idx) { return (const float*)(p.ws + WS_MOD) + ((size_t)(l * 5 + mr) * NMOD + idx) * D; }

__device__ __forceinline__ void p0_setup(const KQ p_in, float* sm) {
    const KQ p = lq(p_in);
    const int tid = ltid(), bid = blockIdx.x, nb = gridDim.x;
    const int gtid = bid * 512 + tid, gthreads = nb * 512;
    {
        float* rope = (float*)(p.ws + WS_ROPE);
        for (int idx = gtid; idx < SEQ * 32; idx += gthreads) {
            const int t = idx >> 5, i = idx & 31;
            const int ii = i & 15; const float pos = (i < 16) ? (float)(t >> 6) : (float)(t & 63);
            const float invA = powf(10000.0f, -(float)ii / 16.0f);
            const float angA = pos * invA;
            rope[idx] = cosf(angA); rope[SEQ * 32 + idx] = sinf(angA);
            const float ex = (float)i * (1.0f / 31.0f);
            const float invR = powf(10000.0f, -ex);
            const float angR = (float)t * invR;
            rope[2 * SEQ * 32 + idx] = cosf(angR); rope[3 * SEQ * 32 + idx] = sinf(angR);
        }
    }
    {
        float* tile = sm;
        for (int gs = bid; gs < 20864 / 4; gs += nb) {
            const int g = gs * 4;
            int j, tl;
            if (g < 16896) { j = g / 704; tl = g % 704; }
            else if (g < 18304) { j = 24 + (g - 16896) / 704; tl = (g - 16896) % 704; }
            else if (g < 18816) { j = 26 + (g - 18304) / 256; tl = (g - 18304) % 256; }
            else if (g < 20352) { j = 28 + (g - 18816) / 768; tl = (g - 18816) % 768; }
            else { j = 30 + (g - 20352) / 256; tl = (g - 20352) % 256; }
            const float* src; bf16_t* dst; int K, N, mode = 0;
            if (j < 8) { src = pin_ld(8) + (size_t)j * D * DFF; dst = (bf16_t*)(p.ws + WS_WGU + (size_t)j * SZ_WGU); K = D; N = DFF; mode = 1; }
            else if (j < 16) { src = pin_ld(9) + (size_t)(j - 8) * D * DFF; dst = (bf16_t*)(p.ws + WS_WGU + (size_t)(j - 8) * SZ_WGU); K = D; N = DFF; mode = 2; }
            else if (j < 24) { src = pin_ld(10) + (size_t)(j - 16) * DFF * D; dst = (bf16_t*)(p.ws + WS_WD + (size_t)(j - 16) * SZ_WD); K = DFF; N = D; }
            else if (j < 26) { src = pin_ld(11) + (size_t)(j - 24) * D * INW; dst = (bf16_t*)(p.ws + WS_WIN + (size_t)(j - 24) * SZ_WIN); K = D; N = INW; mode = 3; }
            else if (j < 28) { src = pin_ld(14) + (size_t)(j - 26) * D * D; dst = (bf16_t*)(p.ws + WS_WOUT + (size_t)(j - 26) * SZ_WOUT); K = D; N = D; }
            else if (j < 30) { src = pin_ld(15) + (size_t)(j - 28) * D * HYW; dst = (bf16_t*)(p.ws + WS_HWIN + (size_t)(j - 28) * SZ_HWIN); K = D; N = HYW; }
            else { src = pin_ld(28) + (size_t)(j - 30) * D * D; dst = (bf16_t*)(p.ws + WS_HWOUT + (size_t)(j - 30) * SZ_WOUT); K = D; N = D; }
            const int ntn = N / 64; const int k0 = (tl / ntn) * 64, n0 = (tl % ntn) * 64;
            f32x4 ld[8];
#pragma unroll
            for (int i = 0; i < 8; ++i) ld[i] = *(const f32x4*)(src + (size_t)(k0 + i * 8 + (tid >> 6)) * N + n0 + (tid & 63) * 4);
            __syncthreads();
#pragma unroll
            for (int i = 0; i < 8; ++i) *(f32x4*)(tile + (i * 8 + (tid >> 6)) * 260 + (tid & 63) * 4) = ld[i];
            __syncthreads();
            {
                const int n = tid >> 1, kh = (tid & 1) * 32; const int gn = n0 + n;
                float sc_ = 1.0f; int row = gn;
                if (mode == 1) row = 256 * (gn >> 7) + (gn & 127);
                else if (mode == 2) row = 256 * (gn >> 7) + 128 + (gn & 127);
                else if (mode == 3) { if (gn < 512 || (gn >= 1792 && gn < 2304)) sc_ = 0.125f; }
#pragma unroll
                for (int q = 0; q < 4; ++q) {
                    float v[8];
#pragma unroll
                    for (int jj = 0; jj < 8; ++jj) v[jj] = tile[(kh + q * 8 + jj) * 260 + n] * sc_;
                    u32x4 o4; o4.x = pg8::cvt_pk_bf16(v[0], v[1]); o4.y = pg8::cvt_pk_bf16(v[2], v[3]); o4.z = pg8::cvt_pk_bf16(v[4], v[5]); o4.w = pg8::cvt_pk_bf16(v[6], v[7]);
                    *(u32x4*)(dst + (size_t)row * K + k0 + kh + q * 8) = o4;
                }
            }
        }
        __syncthreads();
    }
    {
        float* sc = sm;
        float* red = sm + 5 * 1024;
        for (int i = tid; i < 5 * 1024; i += 512) { const int r = i >> 10, k = i & 1023; const float v = (r < 4) ? pin_ld(1)[r * D + k] : pin_ld(3)[k]; sc[i] = silu_f(v); }
        __syncthreads();
        const int w = tid >> 6, lane = tid & 63;
        for (int it = bid; it < 288; it += nb) {
            const int l = it / 72, c0 = (it % 72) * 128;
            const float* wm = pin_ld(4) + (size_t)l * D * (NMOD * D) + c0 + 2 * lane;
            float a[5][2];
#pragma unroll
            for (int r = 0; r < 5; ++r) { a[r][0] = 0.f; a[r][1] = 0.f; }
            for (int kb = w * 128; kb < w * 128 + 128; kb += 16) {
                float2 wv[16];
#pragma unroll
                for (int q = 0; q < 16; ++q) wv[q] = *(const float2*)(wm + (size_t)(kb + q) * (NMOD * D));
#pragma unroll
                for (int q = 0; q < 16; ++q)
#pragma unroll
                    for (int r = 0; r < 5; ++r) { const float s = sc[r * 1024 + kb + q]; a[r][0] += s * wv[q].x; a[r][1] += s * wv[q].y; }
            }
#pragma unroll
            for (int r = 0; r < 5; ++r) { red[(w * 5 + r) * 128 + 2 * lane] = a[r][0]; red[(w * 5 + r) * 128 + 2 * lane + 1] = a[r][1]; }
            __syncthreads();
            for (int i = tid; i < 5 * 128; i += 512) {
                const int r = i >> 7, c = i & 127; float s = 0.f;
#pragma unroll
                for (int ww = 0; ww < 8; ++ww) s += red[(ww * 5 + r) * 128 + c];
                s += pin_ld(5)[(size_t)l * (NMOD * D) + c0 + c];
                ((float*)(p.ws + WS_MOD))[(size_t)(l * 5 + r) * (NMOD * D) + c0 + c] = s;
            }
            __syncthreads();
        }
    }
    {
        float* z = sm;
        float* a1 = sm + 16 * 36;
        float* a2 = a1 + 16 * 64;
        float* a3 = a2 + 16 * 64;
        float* tl = a3 + 16 * 64;
        float* wl = tl + 16;
        const float HMAX = -4.605170185988091f / 0.3f, HMIN = -4.605170185988091f / 1.5f;
        int o_loaded = -1;
        for (int it = nb - 1 - bid; it < 544; it += nb) {
            const int o = it / 272, r = it % 272;
            const int Lf = (r < 256) ? SEQ : CL; const int p0 = (r < 256) ? r * 16 : (r - 256) * 16;
            float* kf = (float*)(p.ws + WS_KF + (size_t)o * SZ_KF) + ((r < 256) ? (size_t)0 : (size_t)2 * SEQ * D);
            const float* f3 = pin_ld(25) + (size_t)o * 64 * 2048;
            __syncthreads();
            if (o != o_loaded) {
                const float* f0 = pin_ld(19) + (size_t)o * 33 * 64; const float* f1 = pin_ld(21) + (size_t)o * 64 * 64; const float* f2 = pin_ld(23) + (size_t)o * 64 * 64;
                for (int i = tid; i < 33 * 64; i += 512) wl[i] = f0[i];
                for (int i = tid; i < 64 * 64; i += 512) { wl[2112 + i] = f1[i]; wl[2112 + 4096 + i] = f2[i]; }
                if (tid < 64) { wl[10304 + tid] = pin_ld(20)[o * 64 + tid]; wl[10304 + 64 + tid] = pin_ld(22)[o * 64 + tid]; wl[10304 + 128 + tid] = pin_ld(24)[o * 64 + tid]; wl[10304 + 192 + tid] = pin_ld(26)[o * 64 + tid]; }
                o_loaded = o;
            }
            const float* f0 = wl; const float* f1 = wl + 2112; const float* f2 = wl + 2112 + 4096;
            const float* fb0 = wl + 10304; const float* fb1 = fb0 + 64; const float* fb2 = fb0 + 128; const float* fq = fb0 + 192;
            for (int idx = tid; idx < 16 * 33; idx += 512) {
                const int ps = idx / 33, f = idx % 33; const int i = p0 + ps;
                const float tlin = (float)i * (1.0f / (float)(Lf - 1));
                const float w = (6.283185307179586f * (float)i) / (float)Lf;
                float v;
                if (f == 0) { v = tlin; tl[ps] = tlin; }
                else { const int jj = (f - 1) & 15; const float fj = 1e-4f + (float)jj * ((15.0f - 1e-4f) / 15.0f); v = (f <= 16) ? cosf(fj * w) : -sinf(fj * w); }
                z[ps * 36 + f] = v;
            }
            __syncthreads();
            for (int idx = tid; idx < 16 * 64; idx += 512) { const int ps = idx >> 6, oc = idx & 63; float s = fb0[oc];
                for (int f = 0; f < 33; ++f) s += z[ps * 36 + f] * f0[f * 64 + oc];
                a1[idx] = sinf(fq[oc] * s); }
            __syncthreads();
            for (int idx = tid; idx < 16 * 64; idx += 512) { const int ps = idx >> 6, oc = idx & 63; float s = fb1[oc];
                for (int f = 0; f < 64; ++f) s += a1[ps * 64 + f] * f1[f * 64 + oc];
                a2[idx] = sinf(fq[oc] * s); }
            __syncthreads();
            for (int idx = tid; idx < 16 * 64; idx += 512) { const int ps = idx >> 6, oc = idx & 63; float s = fb2[oc];
                for (int f = 0; f < 64; ++f) s += a2[ps * 64 + f] * f2[f * 64 + oc];
                a3[oc * 16 + ps] = sinf(fq[oc] * s); }
            __syncthreads();
            {
                float acc[4][16];
#pragma unroll
                for (int q = 0; q < 4; ++q)
#pragma unroll
                    for (int ps = 0; ps < 16; ++ps) acc[q][ps] = 0.f;
                for (int fb = 0; fb < 64; fb += 4) {
                    float wv[4][4];
#pragma unroll
                    for (int f = 0; f < 4; ++f)
#pragma unroll
                        for (int q = 0; q < 4; ++q) wv[f][q] = f3[(fb + f) * 2048 + tid + 512 * q];
#pragma unroll
                    for (int f = 0; f < 4; ++f) {
                        const f32x4 av0 = *(const f32x4*)(a3 + (fb + f) * 16), av1 = *(const f32x4*)(a3 + (fb + f) * 16 + 4), av2 = *(const f32x4*)(a3 + (fb + f) * 16 + 8), av3 = *(const f32x4*)(a3 + (fb + f) * 16 + 12);
#pragma unroll
                        for (int q = 0; q < 4; ++q)
#pragma unroll
                            for (int e = 0; e < 4; ++e) { acc[q][e] += av0[e] * wv[f][q]; acc[q][4 + e] += av1[e] * wv[f][q]; acc[q][8 + e] += av2[e] * wv[f][q]; acc[q][12 + e] += av3[e] * wv[f][q]; }
                    }
                }
#pragma unroll
                for (int q = 0; q < 4; ++q) {
                    const int c = tid + 512 * q; const int dir = c >> 10, d = c & 1023;
                    const float delta = fabsf(HMIN + (float)d * ((HMAX - HMIN) / 1023.0f));
#pragma unroll
                    for (int ps = 0; ps < 16; ++ps) {
                        const float kvv = acc[q][ps] * expf(-tl[ps] * delta);
                        if (r < 256) {
                            bf16_t* rk = (bf16_t*)(p.ws + WS_KF + (size_t)o * SZ_KF) + (size_t)d * 8192;
                            const int m = p0 + ps;
                            if (dir == 0) rk[4095 - m] = f2bf(kvv); else if (m > 0) rk[4095 + m] = f2bf(kvv);
                            if (dir == 0 && m == 0) rk[8191] = 0;
                        } else kf[((size_t)dir * Lf + p0 + ps) * D + d] = kvv;
                    }
                }
            }
        }
        __syncthreads();
    }
}

__device__ __forceinline__ void rowphase(const KQ p_in, int Mupd, const bf16_t* Y, int lu, int gidx, float wgt, const float* gpost,
                         int Mnext, int ln, const float* gpre, int shidx, int scidx, bf16_t* Hout, bool from_input, int tbeg) {
    const KQ p = lq(p_in);
    const int tid = ltid(), w = tid >> 6, lane = tid & 63;
    const int Mmax = Mupd > Mnext ? Mupd : Mnext;
    for (int t = tbeg + (blockIdx.x * 8 + w) * 2; t < Mmax; t += gridDim.x * 16) {
        float* xr = xrow(p, t); const int mr = modrow(t);
        const float* xs = xr;
        if (from_input) xs = (t < TL) ? pin_ld(0) + (size_t)t * D : pin_ld(2) + (size_t)(t - TL) * D;
        float4 xv[2][4];
#pragma unroll
        for (int rr = 0; rr < 2; ++rr)
#pragma unroll
            for (int q = 0; q < 4; ++q) xv[rr][q] = *(const float4*)(xs + rr * D + q * 256 + lane * 4);
        if (Y != nullptr && t < Mupd) {
            float4 yv[2][4]; float ss[2] = {0.f, 0.f};
#pragma unroll
            for (int rr = 0; rr < 2; ++rr)
#pragma unroll
                for (int q = 0; q < 4; ++q) {
                    if (t < TL) { const bf16x4 yb = *(const bf16x4*)(Y + (size_t)(t + rr) * D + q * 256 + lane * 4);
                        yv[rr][q] = make_float4(bf2f((bf16_t)yb[0]), bf2f((bf16_t)yb[1]), bf2f((bf16_t)yb[2]), bf2f((bf16_t)yb[3])); }
                    else { const float* yp = (const float*)(p.ws + WS_YP) + (size_t)(t + rr - TL) * D + q * 256 + lane * 4;
                        const float4 a0 = *(const float4*)yp, a1 = *(const float4*)(yp + (size_t)TC * D), a2 = *(const float4*)(yp + (size_t)2 * TC * D), a3 = *(const float4*)(yp + (size_t)3 * TC * D);
                        yv[rr][q] = make_float4(a0.x + a1.x + a2.x + a3.x, a0.y + a1.y + a2.y + a3.y, a0.z + a1.z + a2.z + a3.z, a0.w + a1.w + a2.w + a3.w); }
                    ss[rr] += yv[rr][q].x * yv[rr][q].x + yv[rr][q].y * yv[rr][q].y + yv[rr][q].z * yv[rr][q].z + yv[rr][q].w * yv[rr][q].w; }
            ss[0] = wave_sum(ss[0]); ss[1] = wave_sum(ss[1]);
            float wgl = wgt; asm volatile("" : "+v"(wgl));
            const float r0 = rsqrtf(ss[0] * (1.0f / D) + EPS) * wgl, r1 = rsqrtf(ss[1] * (1.0f / D) + EPS) * wgl;
            const float* gm = modp(p, lu, mr, gidx);
#pragma unroll
            for (int q = 0; q < 4; ++q) {
                const float4 g4 = *(const float4*)(gm + q * 256 + lane * 4); const float4 p4 = *(const float4*)(gpost + q * 256 + lane * 4);
                const float cx = g4.x * p4.x, cy = g4.y * p4.y, cz = g4.z * p4.z, cw = g4.w * p4.w;
                xv[0][q].x += r0 * cx * yv[0][q].x; xv[0][q].y += r0 * cy * yv[0][q].y; xv[0][q].z += r0 * cz * yv[0][q].z; xv[0][q].w += r0 * cw * yv[0][q].w;
                xv[1][q].x += r1 * cx * yv[1][q].x; xv[1][q].y += r1 * cy * yv[1][q].y; xv[1][q].z += r1 * cz * yv[1][q].z; xv[1][q].w += r1 * cw * yv[1][q].w;
                *(float4*)(xr + q * 256 + lane * 4) = xv[0][q]; *(float4*)(xr + D + q * 256 + lane * 4) = xv[1][q];
            }
        }
        if (Hout != nullptr && t < Mnext) {
            float ss[2] = {0.f, 0.f};
#pragma unroll
            for (int rr = 0; rr < 2; ++rr)
#pragma unroll
                for (int q = 0; q < 4; ++q) ss[rr] += xv[rr][q].x * xv[rr][q].x + xv[rr][q].y * xv[rr][q].y + xv[rr][q].z * xv[rr][q].z + xv[rr][q].w * xv[rr][q].w;
            ss[0] = wave_sum(ss[0]); ss[1] = wave_sum(ss[1]);
            const float rn[2] = {rsqrtf(ss[0] * (1.0f / D) + EPS), rsqrtf(ss[1] * (1.0f / D) + EPS)};
            const float* sh = modp(p, ln, mr, shidx); const float* sc = modp(p, ln, mr, scidx);
#pragma unroll
            for (int q = 0; q < 4; ++q) {
                const float4 g4 = *(const float4*)(gpre + q * 256 + lane * 4); const float4 s4 = *(const float4*)(sc + q * 256 + lane * 4); const float4 h4 = *(const float4*)(sh + q * 256 + lane * 4);
                const float mx_ = g4.x * (1.0f + s4.x), my_ = g4.y * (1.0f + s4.y), mz_ = g4.z * (1.0f + s4.z), mw_ = g4.w * (1.0f + s4.w);
#pragma unroll
                for (int rr = 0; rr < 2; ++rr) {
                    const float h0 = xv[rr][q].x * rn[rr] * mx_ + h4.x, h1 = xv[rr][q].y * rn[rr] * my_ + h4.y;
                    const float h2 = xv[rr][q].z * rn[rr] * mz_ + h4.z, h3 = xv[rr][q].w * rn[rr] * mw_ + h4.w;
                    uint2 pk; pk.x = pg8::cvt_pk_bf16(h0, h1); pk.y = pg8::cvt_pk_bf16(h2, h3);
                    *(uint2*)(Hout + (size_t)(t + rr) * D + q * 256 + lane * 4) = pk;
                }
            }
        }
    }
}

__device__ __forceinline__ float log_sigmoid(float x) { return -log1pf(expf(-x)); }
__device__ __forceinline__ int chunk_t0(int b, int cidx) { return cidx < 32 ? b * SEQ + cidx * 128 : TL + b * CL + (cidx - 32) * 128; }

__device__ __forceinline__ void m1_rope_states(const KQ p_in, int e, float* sm) {
    const KQ p = lq(p_in);
    const int tid = ltid(), bid = blockIdx.x, nb = gridDim.x;
    bf16_t* Z = (bf16_t*)(p.ws + WS_BIG);
    const float* rope = (const float*)(p.ws + WS_ROPE);
    for (int idx = bid * 512 + tid; idx < TL * 72; idx += nb * 512) {
        const int t = idx / 72, r = idx % 72; const int hd = r >> 2, i0 = (r & 3) * 8;
        const int cb = hd < 16 ? hd * 64 : 1536 + (hd - 16) * 64;
        const int tb = (hd >= 8 && hd < 16) ? 2 : 0; const int pos = t & (SEQ - 1);
        const float* cp = rope + (size_t)tb * SEQ * 32 + pos * 32 + i0; const float* sp = cp + (size_t)SEQ * 32;
        bf16_t* zp = Z + (size_t)t * INW + cb + i0;
        const bf16x8 a1 = *(const bf16x8*)zp, a2 = *(const bf16x8*)(zp + 32);
        const float4 c0 = *(const float4*)cp, c1 = *(const float4*)(cp + 4), s0 = *(const float4*)sp, s1 = *(const float4*)(sp + 4);
        const float cc[8] = {c0.x, c0.y, c0.z, c0.w, c1.x, c1.y, c1.z, c1.w}, sn[8] = {s0.x, s0.y, s0.z, s0.w, s1.x, s1.y, s1.z, s1.w};
        float o1[8], o2[8];
#pragma unroll
        for (int j = 0; j < 8; ++j) { const float x1 = bf2f((bf16_t)a1[j]), x2 = bf2f((bf16_t)a2[j]); o1[j] = x1 * cc[j] - x2 * sn[j]; o2[j] = x1 * sn[j] + x2 * cc[j]; }
        u32x4 w1, w2;
        w1.x = pg8::cvt_pk_bf16(o1[0], o1[1]); w1.y = pg8::cvt_pk_bf16(o1[2], o1[3]); w1.z = pg8::cvt_pk_bf16(o1[4], o1[5]); w1.w = pg8::cvt_pk_bf16(o1[6], o1[7]);
        w2.x = pg8::cvt_pk_bf16(o2[0], o2[1]); w2.y = pg8::cvt_pk_bf16(o2[2], o2[3]); w2.z = pg8::cvt_pk_bf16(o2[4], o2[5]); w2.w = pg8::cvt_pk_bf16(o2[6], o2[7]);
        *(u32x4*)zp = w1; *(u32x4*)(zp + 32) = w2;
    }
    float* Ks = sm;
    float* Vs = sm + 128 * 64;
    float* wf = Vs + 128 * 64;
    float* wb = wf + 128;
    float* AF = (float*)(p.ws + WS_ST); float* AB = AF + SZ_ST / 4;
    const float* dec = pin_ld(13) + e * 16;
    for (int it = bid; it < NB * NCH * 8; it += nb) {
        const int h = it & 7, cidx = (it >> 3) % NCH, b = it / (8 * NCH);
        const int t0 = chunk_t0(b, cidx); const bool lat = cidx < 32;
        const float lgf = log_sigmoid(dec[h]), lgb = log_sigmoid(dec[8 + h]);
        __syncthreads();
        if (tid < 128) { wf[tid] = expf(lgf * (float)(127 - tid)); wb[tid] = expf(lgb * (float)tid); }
        const int kc = 1792 + h * 64, vc = 2304 + h * 64;
#pragma unroll
        for (int q = 0; q < 8; ++q) {
            const int idx = tid + 512 * q; const int r = idx >> 5, i = idx & 31;
            bf16_t* zp = Z + (size_t)(t0 + r) * INW + kc + i;
            float x1 = bf2f(zp[0]), x2 = bf2f(zp[32]);
            if (lat) {
                const int pos = (t0 + r) & (SEQ - 1);
                const float c = rope[(size_t)2 * SEQ * 32 + pos * 32 + i], s = rope[(size_t)3 * SEQ * 32 + pos * 32 + i];
                const bf16_t o1 = f2bf(x1 * c - x2 * s), o2 = f2bf(x1 * s + x2 * c);
                zp[0] = o1; zp[32] = o2; x1 = bf2f(o1); x2 = bf2f(o2);
            }
            Ks[r * 64 + i] = x1; Ks[r * 64 + 32 + i] = x2;
        }
#pragma unroll
        for (int q = 0; q < 16; ++q) { const int idx = tid + 512 * q; const int r = idx >> 6, c = idx & 63; Vs[idx] = bf2f(Z[(size_t)(t0 + r) * INW + vc + c]); }
        __syncthreads();
        const int d = tid >> 3, e0 = (tid & 7) * 8;
        float af[8], ab[8];
#pragma unroll
        for (int j = 0; j < 8; ++j) { af[j] = 0.f; ab[j] = 0.f; }
        for (int s = 0; s < 128; ++s) {
            const float kv = Ks[s * 64 + d]; const float kfw = kv * wf[s], kbw = kv * wb[s];
            const float4 v0 = *(const float4*)(Vs + s * 64 + e0), v1 = *(const float4*)(Vs + s * 64 + e0 + 4);
            af[0] += kfw * v0.x; af[1] += kfw * v0.y; af[2] += kfw * v0.z; af[3] += kfw * v0.w; af[4] += kfw * v1.x; af[5] += kfw * v1.y; af[6] += kfw * v1.z; af[7] += kfw * v1.w;
            ab[0] += kbw * v0.x; ab[1] += kbw * v0.y; ab[2] += kbw * v0.z; ab[3] += kbw * v0.w; ab[4] += kbw * v1.x; ab[5] += kbw * v1.y; ab[6] += kbw * v1.z; ab[7] += kbw * v1.w;
        }
        const size_t so = ((size_t)(b * NCH + cidx) * 8 + h) * 4096 + d * 64 + e0;
        *(float4*)(AF + so) = make_float4(af[0], af[1], af[2], af[3]); *(float4*)(AF + so + 4) = make_float4(af[4], af[5], af[6], af[7]);
        *(float4*)(AB + so) = make_float4(ab[0], ab[1], ab[2], ab[3]); *(float4*)(AB + so + 4) = make_float4(ab[4], ab[5], ab[6], ab[7]);
    }
    __syncthreads();
}

__device__ __forceinline__ void m2_scan(const KQ p_in, int e) {
    const KQ p = lq(p_in);
    const float* __restrict__ AF = (const float*)(p.ws + WS_ST); const float* __restrict__ AB = AF + SZ_ST / 4;
    float* __restrict__ TF = (float*)(p.ws + WS_ST) + 2 * (SZ_ST / 4); float* __restrict__ TB = TF + SZ_ST / 4;
    const float* dec = pin_ld(13) + e * 16;
    for (int idx = blockIdx.x * 512 + ltid(); idx < NB * 8 * 4096; idx += gridDim.x * 512) {
        const int el = idx & 4095, h = (idx >> 12) & 7, b = idx >> 15;
        const float gf = expf(log_sigmoid(dec[h]) * 128.0f), gb = expf(log_sigmoid(dec[8 + h]) * 128.0f);
        const size_t base = ((size_t)(b * NCH) * 8 + h) * 4096 + el; constexpr size_t CS = (size_t)8 * 4096;
        float af[NCH], ab[NCH];
#pragma unroll
        for (int c = 0; c < NCH; ++c) { af[c] = AF[base + c * CS]; ab[c] = AB[base + c * CS]; }
        TF[base + 32 * CS] = 0.f; TF[base + 33 * CS] = af[32]; TB[base + 33 * CS] = 0.f; TB[base + 32 * CS] = ab[33];
        float sf = gf * af[32] + af[33], sb = ab[32] + gb * ab[33];
#pragma unroll
        for (int c = 0; c < 32; ++c) { TF[base + c * CS] = sf; sf = gf * sf + af[c]; }
#pragma unroll
        for (int c = 31; c >= 0; --c) { TB[base + c * CS] = sb; sb = ab[c] + gb * sb; }
    }
}

__device__ __forceinline__ bf16x8 pack8(const f32x4& a, const f32x4& b) {
    u32x4 w; w.x = pg8::cvt_pk_bf16(a[0], a[1]); w.y = pg8::cvt_pk_bf16(a[2], a[3]); w.z = pg8::cvt_pk_bf16(b[0], b[1]); w.w = pg8::cvt_pk_bf16(b[2], b[3]);
    return __builtin_bit_cast(bf16x8, w);
}
__device__ __forceinline__ void m3_outputs(const KQ p_in, int e, bool ctx_full, unsigned char* smem) {
    const KQ p = lq(p_in);
    const int tid = ltid(), bid = blockIdx.x, nb = gridDim.x;
    const int w = tid >> 6, lane = tid & 63, ln = lane & 15, g4 = lane >> 4;
    const bf16_t* Z = (const bf16_t*)(p.ws + WS_BIG);
    bf16_t* MIX = (bf16_t*)(p.ws + WS_MIX);
    const float* dec = pin_ld(13) + e * 16;
    const float* sink = pin_ld(12) + e * 8;
    const float* TF = (const float*)(p.ws + WS_ST) + 2 * (SZ_ST / 4); const float* TB = TF + SZ_ST / 4;
    const int nchunk = ctx_full ? NCH : 32;
    const int nitems = NB * nchunk * 8;
    bf16_t* Kt = (bf16_t*)smem;
    bf16_t* Vt = Kt + 128 * 72;
    bf16_t* TfT = Vt + 64 * 136;
    bf16_t* TbT = TfT + 64 * 72;
    const int i = 16 * w + ln;
    for (int it = bid; it < 2 * nitems; it += nb) {
        const bool is_attn = it < nitems; const int ii = is_attn ? it : it - nitems;
        const int h = ii & 7, cidx = (ii >> 3) % nchunk, b = ii / (8 * nchunk);
        const int t0 = chunk_t0(b, cidx); const bool lat = cidx < 32;
        f32x4 O[4];
#pragma unroll
        for (int m = 0; m < 4; ++m) O[m] = (f32x4){0.f, 0.f, 0.f, 0.f};
        if (!is_attn) {
            const float lgf = log_sigmoid(dec[h]), lgb = log_sigmoid(dec[8 + h]);
            __syncthreads();
#pragma unroll
            for (int q = 0; q < 2; ++q) { const int idx = tid + 512 * q; const int r = idx >> 3, pc = idx & 7; const bf16_t* zr = Z + (size_t)(t0 + r) * INW + h * 64 + pc * 8;
                *(u32x4*)(Kt + r * 72 + pc * 8) = *(const u32x4*)(zr + 1792);
                const bf16x8 vv = *(const bf16x8*)(zr + 2304);
#pragma unroll
                for (int j = 0; j < 8; ++j) Vt[(pc * 8 + j) * 136 + r] = (bf16_t)vv[j]; }
            const size_t so = ((size_t)(b * NCH + cidx) * 8 + h) * 4096;
#pragma unroll
            for (int q = 0; q < 8; ++q) { const int idx = tid + 512 * q; const int d = idx >> 6, ee = idx & 63; TfT[ee * 72 + d] = f2bf(TF[so + idx]); TbT[ee * 72 + d] = f2bf(TB[so + idx]); }
            __builtin_amdgcn_sched_barrier(0);
            bf16x8 qf[2], qff[2], qfb[2];
            { const bf16_t* qr = Z + (size_t)(t0 + i) * INW + 512 + h * 64 + 8 * g4;
              const float cf = __expf(lgf * (float)(i + 1)), cb = __expf(lgb * (float)(128 - i));
#pragma unroll
              for (int k2 = 0; k2 < 2; ++k2) { qf[k2] = *(const bf16x8*)(qr + 32 * k2);
                  f32x4 a0, a1, b0, b1;
#pragma unroll
                  for (int j = 0; j < 4; ++j) { const float x0 = bf2f((bf16_t)qf[k2][j]), x1 = bf2f((bf16_t)qf[k2][4 + j]); a0[j] = x0 * cf; a1[j] = x1 * cf; b0[j] = x0 * cb; b1[j] = x1 * cb; }
                  qff[k2] = pack8(a0, a1); qfb[k2] = pack8(b0, b1); } }
            __builtin_amdgcn_sched_barrier(0);
            __syncthreads();
#pragma unroll
            for (int m = 0; m < 4; ++m)
#pragma unroll
                for (int k2 = 0; k2 < 2; ++k2) {
                    const bf16x8 af = *(const bf16x8*)(TfT + (16 * m + ln) * 72 + 32 * k2 + 8 * g4);
                    const bf16x8 ab = *(const bf16x8*)(TbT + (16 * m + ln) * 72 + 32 * k2 + 8 * g4);
                    O[m] = __builtin_amdgcn_mfma_f32_16x16x32_bf16(af, qff[k2], O[m], 0, 0, 0);
                    O[m] = __builtin_amdgcn_mfma_f32_16x16x32_bf16(ab, qfb[k2], O[m], 0, 0, 0);
                    __builtin_amdgcn_sched_barrier(0);
                }
            const float lf2 = lgf * 1.44269504f, lb2 = lgb * 1.44269504f; const int di = i - 4 * g4;
            const float bfw = lf2 * (float)di, bbw = -lb2 * (float)di;
            f32x4 st[8];
#pragma unroll
            for (int mt = 0; mt < 8; ++mt) {
                f32x4 a = (f32x4){0.f, 0.f, 0.f, 0.f};
#pragma unroll
                for (int k2 = 0; k2 < 2; ++k2) { const bf16x8 kf = *(const bf16x8*)(Kt + (16 * mt + ln) * 72 + 32 * k2 + 8 * g4); a = __builtin_amdgcn_mfma_f32_16x16x32_bf16(kf, qf[k2], a, 0, 0, 0); }
#pragma unroll
                for (int rg = 0; rg < 4; ++rg) { const int cc = 16 * mt + rg; const int df = di - cc;
                    const float arg = (df > 0) ? fmaf(-lf2, (float)cc, bfw) : fmaf(lb2, (float)cc, bbw);
                    float wgt = __builtin_amdgcn_exp2f(arg); wgt = (df == 0) ? 2.0f : wgt;
                    a[rg] *= wgt; }
                st[mt] = a;
                __builtin_amdgcn_sched_barrier(0);
            }
#pragma unroll
            for (int ks = 0; ks < 4; ++ks) {
                const bf16x8 pfr = pack8(st[2 * ks], st[2 * ks + 1]);
#pragma unroll
                for (int m = 0; m < 4; ++m) {
                    const bf16_t* vr = Vt + (16 * m + ln) * 136 + 32 * ks + 4 * g4;
                    const bf16x4 v0 = *(const bf16x4*)vr, v1 = *(const bf16x4*)(vr + 16);
                    const bf16x8 vf = __builtin_shufflevector(v0, v1, 0, 1, 2, 3, 4, 5, 6, 7);
                    O[m] = __builtin_amdgcn_mfma_f32_16x16x32_bf16(vf, pfr, O[m], 0, 0, 0);
                }
                __builtin_amdgcn_sched_barrier(0);
            }
            float ss = 0.f;
#pragma unroll
            for (int m = 0; m < 4; ++m)
#pragma unroll
                for (int rg = 0; rg < 4; ++rg) ss += O[m][rg] * O[m][rg];
            ss += __shfl_xor(ss, 16, 64); ss += __shfl_xor(ss, 32, 64);
            const float rn = rsqrtf(ss * (1.0f / 64.0f) + EPS);
#pragma unroll
            for (int m = 0; m < 4; ++m) {
                const int ee = 16 * m + 4 * g4;
                const bf16x4 gv = *(const bf16x4*)(Z + (size_t)(t0 + i) * INW + 1024 + h * 64 + ee);
                uint2 o2; o2.x = pg8::cvt_pk_bf16(O[m][0] * rn * silu_f(bf2f((bf16_t)gv[0])), O[m][1] * rn * silu_f(bf2f((bf16_t)gv[1])));
                o2.y = pg8::cvt_pk_bf16(O[m][2] * rn * silu_f(bf2f((bf16_t)gv[2])), O[m][3] * rn * silu_f(bf2f((bf16_t)gv[3])));
                *(uint2*)(MIX + (size_t)(t0 + i) * D + 512 + h * 64 + ee) = o2;
            }
        } else {
            const int gk = h >> 2;
            bf16x8 qf[2];
            { const bf16_t* qr = Z + (size_t)(t0 + i) * INW + h * 64 + 8 * g4; qf[0] = *(const bf16x8*)qr; qf[1] = *(const bf16x8*)(qr + 32); }
            float mx = sink[h], l = (g4 == 0) ? 1.0f : 0.0f;
            const int qpos = lat ? (cidx * 128 + i) : 0;
#define ATT_VALID(tl_) ((tl_) >= 3 || (lat && (cidx - 1 + (tl_)) >= 0 && (cidx - 1 + (tl_)) < 32))
#define ATT_KT0(tl_) ((tl_) >= 3 ? TL + b * CL + ((tl_) - 3) * 128 : b * SEQ + (cidx - 1 + (tl_)) * 128)
            int tl = 0; while (!ATT_VALID(tl)) ++tl;
            u32x4 kreg[2]; bf16x8 vreg[2];
            { const int kt0 = ATT_KT0(tl);
#pragma unroll
              for (int q = 0; q < 2; ++q) { const int idx = tid + 512 * q; const int r = idx >> 3, pc = idx & 7; const bf16_t* zr = Z + (size_t)(kt0 + r) * INW + gk * 64 + pc * 8;
                  kreg[q] = *(const u32x4*)(zr + 1536); vreg[q] = *(const bf16x8*)(zr + 1664); } }
            while (tl < 5) {
                const bool isc = tl >= 3; const int kp0 = isc ? 0 : (cidx - 1 + tl) * 128;
                __syncthreads();
#pragma unroll
                for (int q = 0; q < 2; ++q) { const int idx = tid + 512 * q; const int r = idx >> 3, pc = idx & 7;
                    *(u32x4*)(Kt + r * 72 + pc * 8) = kreg[q];
#pragma unroll
                    for (int j = 0; j < 8; ++j) Vt[(pc * 8 + j) * 136 + r] = (bf16_t)vreg[q][j]; }
                __syncthreads();
                int tn = tl + 1; while (tn < 5 && !ATT_VALID(tn)) ++tn;
                if (tn < 5) { const int kt0 = ATT_KT0(tn);
#pragma unroll
                    for (int q = 0; q < 2; ++q) { const int idx = tid + 512 * q; const int r = idx >> 3, pc = idx & 7; const bf16_t* zr = Z + (size_t)(kt0 + r) * INW + gk * 64 + pc * 8;
                        kreg[q] = *(const u32x4*)(zr + 1536); vreg[q] = *(const bf16x8*)(zr + 1664); } }
                f32x4 st[8];
                float mloc = -1e30f;
#pragma unroll
                for (int mt = 0; mt < 8; ++mt) {
                    f32x4 a = (f32x4){0.f, 0.f, 0.f, 0.f};
#pragma unroll
                    for (int k2 = 0; k2 < 2; ++k2) { const bf16x8 kf = *(const bf16x8*)(Kt + (16 * mt + ln) * 72 + 32 * k2 + 8 * g4); a = __builtin_amdgcn_mfma_f32_16x16x32_bf16(kf, qf[k2], a, 0, 0, 0); }
                    if (!isc) {
#pragma unroll
                        for (int rg = 0; rg < 4; ++rg) { const int dd = qpos - (kp0 + 16 * mt + 4 * g4 + rg); if (dd > 128 || dd < -128) a[rg] = -1e30f; }
                    }
#pragma unroll
                    for (int rg = 0; rg < 4; ++rg) mloc = fmaxf(mloc, a[rg]);
                    st[mt] = a;
                    __builtin_amdgcn_sched_barrier(0);
                }
                mloc = fmaxf(mloc, __shfl_xor(mloc, 16, 64)); mloc = fmaxf(mloc, __shfl_xor(mloc, 32, 64));
                const float mnew = fmaxf(mx, mloc);
                const float sc = __expf(mx - mnew); mx = mnew; l *= sc;
#pragma unroll
                for (int m = 0; m < 4; ++m) O[m] *= sc;
#pragma unroll
                for (int mt = 0; mt < 8; ++mt)
#pragma unroll
                    for (int rg = 0; rg < 4; ++rg) { const float pv = __expf(st[mt][rg] - mnew); st[mt][rg] = pv; l += pv; }
#pragma unroll
                for (int ks = 0; ks < 4; ++ks) {
                    const bf16x8 pfr = pack8(st[2 * ks], st[2 * ks + 1]);
#pragma unroll
                    for (int m = 0; m < 4; ++m) {
                        const bf16_t* vr = Vt + (16 * m + ln) * 136 + 32 * ks + 4 * g4;
                        const bf16x4 v0 = *(const bf16x4*)vr, v1 = *(const bf16x4*)(vr + 16);
                        const bf16x8 vf = __builtin_shufflevector(v0, v1, 0, 1, 2, 3, 4, 5, 6, 7);
                        O[m] = __builtin_amdgcn_mfma_f32_16x16x32_bf16(vf, pfr, O[m], 0, 0, 0);
                    }
                    __builtin_amdgcn_sched_barrier(0);
                }
                tl = tn;
            }
#undef ATT_VALID
#undef ATT_KT0
            l += __shfl_xor(l, 16, 64); l += __shfl_xor(l, 32, 64);
            const float inv = 1.0f / l;
#pragma unroll
            for (int m = 0; m < 4; ++m) {
                uint2 o2; o2.x = pg8::cvt_pk_bf16(O[m][0] * inv, O[m][1] * inv); o2.y = pg8::cvt_pk_bf16(O[m][2] * inv, O[m][3] * inv);
                *(uint2*)(MIX + (size_t)(t0 + i) * D + h * 64 + 16 * m + 4 * g4) = o2;
            }
        }
    }
    __syncthreads();
}

__device__ __forceinline__ void h2_shortconv(const KQ p_in, int o, int M, unsigned char* smem) {
    const KQ p = lq(p_in);
    const int tid = ltid();
    const bf16_t* ZH = (const bf16_t*)(p.ws + WS_BIG);
    const float* w = pin_ld(17) + (size_t)o * 3 * HYW; const float* bs = pin_ld(18) + (size_t)o * HYW;
    bf16_t* VXT = (bf16_t*)(p.ws + WS_Y); bf16_t* X0T = VXT + (size_t)D * TL;
    bf16_t* tx = (bf16_t*)smem;
    bf16_t* tv = tx + 64 * 136;
    const int tok = tid >> 3, cg8 = (tid & 7) * 8;
    float* wl = (float*)(smem + 40960);
    { const int c0b = (blockIdx.x & 15) * 64;
      for (int i = tid; i < 768; i += 512) { const int k = i >> 8, q = (i >> 6) & 3, c = i & 63; const int col = k * 1024 + c0b + c; wl[i] = (q < 3) ? w[q * HYW + col] : bs[col]; } }
    __syncthreads();
    for (int it = blockIdx.x; it < (TL / 128) * 16; it += gridDim.x) {
        const int c0 = (it & 15) * 64, t0 = (it >> 4) * 128;
        bf16x8 zc[2][3], zp[2][3], zn[2][3];
#pragma unroll
        for (int g = 0; g < 2; ++g) {
            const int t = t0 + tok + 64 * g; const int pos = t & (SEQ - 1); const bool first = pos == 0, last = pos == SEQ - 1;
#pragma unroll
            for (int k = 0; k < 3; ++k) {
                const int c = k * 1024 + c0 + cg8;
                zc[g][k] = *(const bf16x8*)(ZH + (size_t)t * HYW + c);
                zp[g][k] = *(const bf16x8*)(ZH + (size_t)(first ? t : t - 1) * HYW + c);
                zn[g][k] = *(const bf16x8*)(ZH + (size_t)(last ? t : t + 1) * HYW + c);
            }
        }
        __syncthreads();
#pragma unroll
        for (int g = 0; g < 2; ++g) {
            const int t = t0 + tok + 64 * g; const int pos = t & (SEQ - 1); const float mf = (pos == 0) ? 0.f : 1.f, ml = (pos == SEQ - 1) ? 0.f : 1.f;
            float zz[3][8];
#pragma unroll
            for (int k = 0; k < 3; ++k) {
                const float* wk = wl + k * 256 + cg8;
#pragma unroll
                for (int j = 0; j < 8; ++j)
                    zz[k][j] = wk[192 + j] + bf2f((bf16_t)zc[g][k][j]) * wk[64 + j] + mf * bf2f((bf16_t)zp[g][k][j]) * wk[j] + ml * bf2f((bf16_t)zn[g][k][j]) * wk[128 + j];
            }
#pragma unroll
            for (int j = 0; j < 8; ++j) { tx[(cg8 + j) * 136 + tok + 64 * g] = f2bf(zz[0][j]); tv[(cg8 + j) * 136 + tok + 64 * g] = f2bf(zz[2][j] * zz[1][j]); }
        }
        __syncthreads();
        { const int ch = tid >> 3, tk = (tid & 7) * 8;
#pragma unroll
          for (int q = 0; q < 2; ++q) {
            *(u32x4*)(X0T + (size_t)(c0 + ch) * TL + t0 + tk + 64 * q) = *(const u32x4*)(tx + ch * 136 + tk + 64 * q);
            *(u32x4*)(VXT + (size_t)(c0 + ch) * TL + t0 + tk + 64 * q) = *(const u32x4*)(tv + ch * 136 + tk + 64 * q); } }
    }
    __syncthreads();
    if (M > TL) {
        float* VX = (float*)(p.ws + WS_Y); bf16_t* X0 = (bf16_t*)(p.ws + WS_H);
        for (int idx = TL * D + blockIdx.x * 512 + tid; idx < M * D; idx += gridDim.x * 512) {
            const int t = idx >> 10, d = idx & 1023;
            const int pos = (t - TL) & (CL - 1); const bool first = pos == 0, last = pos == CL - 1;
            float zz[3];
#pragma unroll
            for (int k = 0; k < 3; ++k) {
                const int c = k * 1024 + d;
                float sacc = bs[c] + bf2f(ZH[(size_t)t * HYW + c]) * w[HYW + c];
                if (!first) sacc += bf2f(ZH[(size_t)(t - 1) * HYW + c]) * w[c];
                if (!last) sacc += bf2f(ZH[(size_t)(t + 1) * HYW + c]) * w[2 * HYW + c];
                zz[k] = sacc;
            }
            VX[idx] = zz[2] * zz[1]; X0[idx] = f2bf(zz[0]);
        }
    }
}

typedef float f32x16 __attribute__((ext_vector_type(16)));
__device__ __forceinline__ void h3_longconv(const KQ p_in, int o, bool ctx_full, unsigned char* smem) {
    const KQ p = lq(p_in);
    const int tid = ltid(), w = tid >> 6, lane = tid & 63;
    const float* bias = pin_ld(27) + (size_t)o * D;
    {
        const bf16_t* VXT = (const bf16_t*)(p.ws + WS_Y); const bf16_t* X0T = VXT + (size_t)D * TL;
        bf16_t* HMT = (bf16_t*)(p.ws + WS_H);
        const bf16_t* RKT = (const bf16_t*)(p.ws + WS_KF + (size_t)o * SZ_KF);
        constexpr int RK2_OFF = 16384 + 64, U_OFF = 2 * 16384 + 128, CH_BYTES = U_OFF + 142 * 256;
        const int cw = w >> 2, w4 = w & 3;
        const int ct = tid & 255;
        unsigned char* cb = smem + cw * CH_BYTES;
        unsigned char* ub = cb + U_OFF;
        const int r = lane & 31, hh = lane >> 5;
        for (int pr = blockIdx.x; pr < D / 2; pr += gridDim.x) {
            const int d = pr * 2 + cw;
            __syncthreads();
            { const bf16_t* src = RKT + (size_t)d * 8192;
              for (int i = ct; i < 1024; i += 256) *(u32x4*)(cb + i * 16) = *(const u32x4*)(src + i * 8);
              for (int i = ct; i < 2 * 7 * 4 * 4; i += 256) { const int side = i / 112, rem = i % 112; unsigned z0 = 0u; asm volatile("" : "+v"(z0)); *(u32x4*)(ub + (side ? (135 * 4 * 64) : 0) + rem * 16) = (u32x4){z0, z0, z0, z0}; }
#pragma unroll 4
              for (int i = ct; i < 4 * 512; i += 256) { const int b = i >> 9, pc = i & 511;
                  const u32x4 v = *(const u32x4*)(VXT + (size_t)d * TL + b * SEQ + pc * 8);
                  const int col = ((pc >> 2) + 7) * 4 + b, q = pc & 3;
                  *(u32x4*)(ub + col * 64 + ((q ^ ((col >> 2) & 3)) * 16)) = v; } }
            __syncthreads();
            { const bf16_t* rk = (const bf16_t*)cb; bf16_t* rk2 = (bf16_t*)(cb + RK2_OFF);
#pragma unroll 4
              for (int i = ct; i < 4096; i += 256) { const unsigned lo = rk[2 * i + 1]; const unsigned hi = (2 * i + 2 < 8192) ? rk[2 * i + 2] : 0u; *(unsigned*)(rk2 + 2 * i) = lo | (hi << 16); } }
            __syncthreads();
            f32x16 acc[4];
#pragma unroll
            for (int j = 0; j < 4; ++j)
#pragma unroll
                for (int q = 0; q < 16; ++q) acc[j][q] = 0.f;
            const bf16_t* rsel = (const bf16_t*)(cb + ((r & 1) ? 0 : RK2_OFF));
            const int adj = (r & 1) ? 0 : -1;
            const int bq = r & 3;
#define H3_LOAD(AF, BF, U) do { \
                _Pragma("unroll") for (int s2 = 0; s2 < 2; ++s2) { \
                    const unsigned* ap = (const unsigned*)(Ab + 64 * (3 - (U)) + 32 * s2); \
                    u32x4 t4; t4.x = ap[0]; t4.y = ap[1]; t4.z = ap[2]; t4.w = ap[3]; \
                    AF[s2] = __builtin_bit_cast(bf16x8, t4); } \
                _Pragma("unroll") for (int j = 0; j < 4; ++j) { \
                    int c_ = Lb - 256 * (U) + 2048 * j; c_ = c_ < LO ? LO : (c_ > HI ? HI : c_); \
                    BF[j][0] = *(const bf16x8*)(ub + c_ + off[U][0]); BF[j][1] = *(const bf16x8*)(ub + c_ + off[U][1]); } } while (0)
#define H3_MMA(AF, BF) do { \
                _Pragma("unroll") for (int s2 = 0; s2 < 2; ++s2) \
                _Pragma("unroll") for (int j = 0; j < 4; ++j) acc[j] = __builtin_amdgcn_mfma_f32_32x32x16_bf16(AF[s2], BF[j][s2], acc[j], 0, 0, 0); } while (0)
            {
                const int dlo = 32 * w4 - 127;
                const int LO = (24 + bq) * 64, HI = (540 + bq) * 64;
                int off[4][2];
#pragma unroll
                for (int u = 0; u < 4; ++u) { const int sw = ((r >> 2) + 2 - u) & 3; off[u][0] = (hh ^ sw) * 16; off[u][1] = ((2 + hh) ^ sw) * 16; }
                int Lb = (((r >> 2) + 134) * 4 + bq) * 64;
                const unsigned char* Ab = (const unsigned char*)(rsel + (4095 - 32 * dlo - r + 8 * hh + adj)) - 192;
                bf16x8 afA[2], bfA[4][2], afB[2], bfB[4][2];
                H3_LOAD(afA, bfA, 0);
                for (int g = 0; g < 39; ++g) {
                    H3_LOAD(afB, bfB, 1);
                    __builtin_amdgcn_sched_barrier(0);
                    H3_MMA(afA, bfA);
                    __builtin_amdgcn_sched_barrier(0);
                    H3_LOAD(afA, bfA, 2);
                    __builtin_amdgcn_sched_barrier(0);
                    H3_MMA(afB, bfB);
                    __builtin_amdgcn_sched_barrier(0);
                    H3_LOAD(afB, bfB, 3);
                    __builtin_amdgcn_sched_barrier(0);
                    H3_MMA(afA, bfA);
                    __builtin_amdgcn_sched_barrier(0);
                    Ab -= 256; Lb -= 1024;
                    H3_LOAD(afA, bfA, 0);
                    __builtin_amdgcn_sched_barrier(0);
                    H3_MMA(afB, bfB);
                    __builtin_amdgcn_sched_barrier(0);
                }
                H3_LOAD(afB, bfB, 1);
                __builtin_amdgcn_sched_barrier(0);
                H3_MMA(afA, bfA);
                __builtin_amdgcn_sched_barrier(0);
                H3_LOAD(afA, bfA, 2);
                __builtin_amdgcn_sched_barrier(0);
                H3_MMA(afB, bfB);
                H3_MMA(afA, bfA);
            }
#undef H3_LOAD
#undef H3_MMA
            __syncthreads();
            const float bd = bias[d];
#pragma unroll
            for (int j = 0; j < 4; ++j) {
                const int n1 = 8 * (4 * w4 + j) + (r >> 2);
                const int col = (n1 + 7) * 4 + bq; const int sw = (col >> 2) & 3;
                bf16_t* up = (bf16_t*)(ub + col * 64);
#pragma unroll
                for (int q4 = 0; q4 < 4; ++q4) {
                    bf16_t* pp = up + ((q4 ^ sw) * 8) + 4 * hh;
                    const bf16x4 uv = *(const bf16x4*)pp;
                    uint2 o2; o2.x = pg8::cvt_pk_bf16(acc[j][4 * q4] + bd * bf2f((bf16_t)uv[0]), acc[j][4 * q4 + 1] + bd * bf2f((bf16_t)uv[1]));
                    o2.y = pg8::cvt_pk_bf16(acc[j][4 * q4 + 2] + bd * bf2f((bf16_t)uv[2]), acc[j][4 * q4 + 3] + bd * bf2f((bf16_t)uv[3]));
                    *(uint2*)pp = o2;
                }
            }
            __syncthreads();
#pragma unroll 2
            for (int i = ct; i < 4 * 512; i += 256) { const int b = i >> 9, pc = i & 511;
                const int col = ((pc >> 2) + 7) * 4 + b, q = pc & 3;
                const bf16x8 yv = *(const bf16x8*)(ub + col * 64 + ((q ^ ((col >> 2) & 3)) * 16));
                const size_t gi = (size_t)d * TL + b * SEQ + pc * 8;
                const bf16x8 xv = *(const bf16x8*)(X0T + gi);
                u32x4 o4;
                o4.x = pg8::cvt_pk_bf16(bf2f((bf16_t)yv[0]) * bf2f((bf16_t)xv[0]), bf2f((bf16_t)yv[1]) * bf2f((bf16_t)xv[1]));
                o4.y = pg8::cvt_pk_bf16(bf2f((bf16_t)yv[2]) * bf2f((bf16_t)xv[2]), bf2f((bf16_t)yv[3]) * bf2f((bf16_t)xv[3]));
                o4.z = pg8::cvt_pk_bf16(bf2f((bf16_t)yv[4]) * bf2f((bf16_t)xv[4]), bf2f((bf16_t)yv[5]) * bf2f((bf16_t)xv[5]));
                o4.w = pg8::cvt_pk_bf16(bf2f((bf16_t)yv[6]) * bf2f((bf16_t)xv[6]), bf2f((bf16_t)yv[7]) * bf2f((bf16_t)xv[7]));
                *(u32x4*)(HMT + gi) = o4; }
        }
        __syncthreads();
    }
    if (ctx_full) {
        const float* VX = (const float*)(p.ws + WS_Y); const bf16_t* X0 = (const bf16_t*)(p.ws + WS_H);
        bf16_t* MIX = (bf16_t*)(p.ws + WS_MIX);
        const float* kf = (const float*)(p.ws + WS_KF + (size_t)o * SZ_KF) + (size_t)2 * SEQ * D;
        for (int idx = blockIdx.x * 512 + tid; idx < (TC / 8) * D; idx += gridDim.x * 512) {
            const int d = idx & 1023, og = idx >> 10;
            const int bb = og >> 5, n0 = (og & 31) * 8, tb = TL + bb * CL;
            const float* up = VX + (size_t)tb * D + d;
            float acc[8];
#pragma unroll
            for (int j = 0; j < 8; ++j) acc[j] = 0.f;
#pragma unroll 1
            for (int mb = 0; mb < CL; mb += 8) {
                float kk[15], uu[8];
#pragma unroll
                for (int q = 0; q < 15; ++q) { const int lag = n0 - mb - 7 + q;
                    kk[q] = (lag >= 0) ? ((lag < CL) ? kf[(size_t)lag * D + d] : 0.f) : ((-lag < CL) ? kf[(size_t)(CL - lag) * D + d] : 0.f); }
#pragma unroll
                for (int u = 0; u < 8; ++u) uu[u] = up[(size_t)(mb + u) * D];
#pragma unroll
                for (int u = 0; u < 8; ++u)
#pragma unroll
                    for (int j = 0; j < 8; ++j) acc[j] += uu[u] * kk[7 - u + j];
            }
            const float bd = bias[d];
#pragma unroll
            for (int j = 0; j < 8; ++j) { const size_t ti = (size_t)(tb + n0 + j) * D + d; MIX[ti] = f2bf(bf2f(X0[ti]) * (acc[j] + bd * VX[ti])); }
        }
    }
}

__device__ __forceinline__ void h3b_transpose(const KQ p_in, unsigned char* smem) {
    const KQ p = lq(p_in);
    const int tid = ltid();
    const bf16_t* HMT = (const bf16_t*)(p.ws + WS_H); bf16_t* MIX = (bf16_t*)(p.ws + WS_MIX);
    bf16_t* tile = (bf16_t*)smem;
    for (int it = blockIdx.x; it < (TL / 256) * 16; it += gridDim.x) {
        const int c0 = (it & 15) * 64, t0 = (it >> 4) * 256;
        u32x4 ld[4];
        { const int ch = tid >> 3, tk = (tid & 7) * 8;
#pragma unroll
          for (int q = 0; q < 4; ++q) ld[q] = *(const u32x4*)(HMT + (size_t)(c0 + ch) * TL + t0 + tk + 64 * q);
          __syncthreads();
#pragma unroll
          for (int q = 0; q < 4; ++q) *(u32x4*)(tile + ch * 264 + tk + 64 * q) = ld[q]; }
        __syncthreads();
        { const int cg8 = (tid & 7) * 8;
#pragma unroll
          for (int q = 0; q < 4; ++q) { const int tok = (tid >> 3) + 64 * q; unsigned short v[8];
#pragma unroll
              for (int j = 0; j < 8; ++j) v[j] = tile[(cg8 + j) * 264 + tok];
              u32x4 o4; o4.x = v[0] | ((unsigned)v[1] << 16); o4.y = v[2] | ((unsigned)v[3] << 16); o4.z = v[4] | ((unsigned)v[5] << 16); o4.w = v[6] | ((unsigned)v[7] << 16);
              *(u32x4*)(MIX + (size_t)(t0 + tok) * D + c0 + cg8) = o4; } }
    }
    __syncthreads();
}

__global__ void __launch_bounds__(512, 2) mega_fwd(KP kp) {
    unsigned char* const smem = g_smem;
    if (threadIdx.x < 29) *(LAS unsigned long long*)((LAS unsigned char*)g_smem + PTAB_OFF + 8 * threadIdx.x) = ((const unsigned long long*)__builtin_amdgcn_kernarg_segment_ptr())[threadIdx.x];
    KQ p; p.out = kp.out; p.ws = kp.ws;
    cg::grid_group grid = cg::this_grid();
    if (threadIdx.x < 4) ((volatile LAS unsigned*)(LAS unsigned char*)smem)[(LDS_BYTES - 16) / 4 + threadIdx.x] = 0u;
    __syncthreads();
    if (threadIdx.x == 0) (void)xb_add(&((unsigned*)(lq(p).ws + WS_BAR))[XB_XCNT(xb_xcc_id())], 1u);
    grid.sync();
    float* smf = (float*)smem;
#define Hb ((bf16_t*)(lq(p).ws + WS_H))
#define BIG ((bf16_t*)(lq(p).ws + WS_BIG))
#define Y ((bf16_t*)(lq(p).ws + WS_Y))
#define MIX ((bf16_t*)(lq(p).ws + WS_MIX))

#ifndef NO_P0
    p0_setup(p, smf);
#endif
    GRID_BAR();
    rowphase(p, 0, nullptr, 0, 0, 0.f, nullptr, T, 0, pin_ld(6), 0, 1, Hb, true, 0);
    GRID_BAR();
    for (int l = 0; l < 4; ++l) {
        const bool ctx_live = l <= 2, ctx_full = l < 2;
        const int Mff = ctx_live ? T : TL, Mpost = ctx_full ? T : TL;
        for (int sub = 0; sub < 3; ++sub) {
            const bf16_t* Ao; const bf16_t* Bo; int Ko; int Mo;
            if (sub != 1) {
                const int fi = sub >> 1; const int M = (sub == 0) ? Mff : Mpost;
                { pg8::EpiSwiGLU E{BIG, DFF}; run_gemm(smem, Hb, (const bf16_t*)(lq(p).ws + WS_WGU + (size_t)(l * 2 + fi) * SZ_WGU), M, 2 * DFF, D, E); }
                GRID_BAR();
                Ao = BIG; Bo = (const bf16_t*)(lq(p).ws + WS_WD + (size_t)(l * 2 + fi) * SZ_WD); Ko = DFF; Mo = M;
            } else {
                if ((l & 1) == 0) {
                    const int e = l >> 1;
                    { pg8::EpiBf16 E{BIG, INW, nullptr}; run_gemm(smem, Hb, (const bf16_t*)(lq(p).ws + WS_WIN + (size_t)e * SZ_WIN), Mff, INW, D, E); }
                    GRID_BAR();
#ifndef NO_M1
                    m1_rope_states(p, e, smf);
#endif
                    GRID_BAR();
#ifndef NO_M2
                    m2_scan(p, e);
#endif
                    GRID_BAR();
#ifndef NO_M3
                    m3_outputs(p, e, ctx_full, smem);
#endif
                    GRID_BAR();
                    Bo = (const bf16_t*)(lq(p).ws + WS_WOUT + (size_t)e * SZ_WOUT);
                } else {
                    const int o = l >> 1;
                    { pg8::EpiBf16 E{BIG, HYW, pin_ld(16) + (size_t)o * HYW}; run_gemm(smem, Hb, (const bf16_t*)(lq(p).ws + WS_HWIN + (size_t)o * SZ_HWIN), Mpost, HYW, D, E); }
                    GRID_BAR();
#ifndef NO_H2
                    h2_shortconv(p, o, Mpost, smem);
#endif
                    GRID_BAR();
#ifndef NO_H3
                    h3_longconv(p, o, ctx_full, smem);
#endif
                    GRID_BAR();
                    h3b_transpose(p, smem);
                    GRID_BAR();
                    Bo = (const bf16_t*)(lq(p).ws + WS_HWOUT + (size_t)o * SZ_WOUT);
                }
                Ao = MIX; Ko = D; Mo = Mpost;
            }
            const int gidx = 2 + 3 * sub;
            const int ln = (sub == 2) ? l + 1 : l; const bool has_next = ln < 4; const int lnn = has_next ? ln : l;
            const int pre_i = (sub == 2) ? 0 : sub + 1;
            const int Mn = has_next ? ((sub == 2) ? ((ln <= 2) ? T : TL) : ((sub == 0) ? Mff : Mpost)) : 0;
            const float* gpost = pin_ld(7) + (size_t)(l * 3 + sub) * D; const float* gpre = pin_ld(6) + (size_t)(lnn * 3 + pre_i) * D;
            const float wg = (sub == 1) ? 1.0f : 0.5f;
            {
                pg8::EpiFusedRow EF;
                EF.xin = (l == 0 && sub == 0) ? pin_ld(0) : (const float*)lq(p).out; EF.xout = lq(p).out; EF.H = has_next ? Hb : nullptr;
                EF.gate = modp(lq(p), l, 0, gidx); EF.gpost = gpost; EF.wgt = wg;
                EF.gpre = gpre; EF.shift = modp(lq(p), lnn, 0, 3 * pre_i); EF.scale = modp(lq(p), lnn, 0, 3 * pre_i + 1);
                EF.slots = (float*)(lq(p).ws + WS_SLOT); EF.cnt = (unsigned*)(lq(p).ws + WS_CNT) + (size_t)(l * 3 + sub) * 2 * 64 * 64;
                run_gemm_f32_split(smem, Ao, Bo, Mo, Ko, EF, (float*)(lq(p).ws + WS_YP));
            }
            if (Mo > TL && blockIdx.x < 64) {
                sub_barrier((unsigned*)(lq(p).ws + WS_CNT) + (size_t)12 * 2 * 64 * 64 + (l * 3 + sub) * 64, 64u);
                rowphase(p, Mo, Y, l, gidx, wg, gpost, Mn, lnn, gpre, 3 * pre_i, 3 * pre_i + 1, has_next ? Hb : nullptr, l == 0 && sub == 0, TL);
            }
            GRID_BAR();
        }
    }
}

extern "C" void kernel_launch(void* const* d_in, const int* in_sizes, int n_in, void* d_out, int out_size, void* d_ws, size_t ws_size, hipStream_t stream) {
    static int grid = 0;
    if (grid == 0) {
        if (n_in != 29 || out_size != TL * D || ws_size < WS_END) { fprintf(stderr, "kernel_launch: unexpected shapes: n_in %d out %d ws %zu (need %zu)\n", n_in, out_size, ws_size, (size_t)WS_END); grid = -1; return; }
        int dev = 0, cus = 0, per_cu = 0;
        (void)hipGetDevice(&dev);
        (void)hipDeviceGetAttribute(&cus, hipDeviceAttributeMultiprocessorCount, dev);
        if (hipFuncSetAttribute((const void*)mega_fwd, hipFuncAttributeMaxDynamicSharedMemorySize, LDS_BYTES) != hipSuccess) { fprintf(stderr, "kernel_launch: hipFuncSetAttribute failed\n"); grid = -1; return; }
        if (hipOccupancyMaxActiveBlocksPerMultiprocessor(&per_cu, (const void*)mega_fwd, 512, LDS_BYTES) != hipSuccess || per_cu < 1) { fprintf(stderr, "kernel_launch: occupancy query says %d\n", per_cu); per_cu = 1; }
        (void)hipGetLastError();
        grid = cus >= 256 ? 256 : cus;
    }
    if (grid < 0) return;
    (void)hipMemsetAsync((unsigned char*)d_ws + WS_BAR, 0, 16384 + SZ_CNT, stream);
    KP kp{};
    for (int i = 0; i < 29; ++i) kp.in[i] = (const float*)d_in[i];
    kp.out = (float*)d_out; kp.ws = (unsigned char*)d_ws;
    void* args[] = {&kp};
    hipError_t e = hipLaunchCooperativeKernel((const void*)mega_fwd, dim3(grid), dim3(512), args, LDS_BYTES, stream);
    if (e != hipSuccess) fprintf(stderr, "cooperative launch failed: %s (grid %d)\n", hipGetErrorString(e), grid);
}
```

```cpp
#include <hip/hip_runtime.h>
#include <hip/hip_cooperative_groups.h>
#include <cstdio>
namespace cg = cooperative_groups;

#define LAS __attribute__((address_space(3)))
typedef unsigned short bf16_t;
typedef short bf16x8 __attribute__((ext_vector_type(8)));
typedef short bf16x4 __attribute__((ext_vector_type(4)));
typedef float f32x4 __attribute__((ext_vector_type(4)));
typedef unsigned u32x4 __attribute__((ext_vector_type(4)));

constexpr int D = 1024, NB = 4, SEQ = 4096, CL = 256, TL = NB * SEQ, TC = NB * CL, T = TL + TC, DFF = 2816, INW = 2816, HYW = 3072;
constexpr int NMOD = 9;
constexpr float EPS = 1e-6f;
constexpr int NCH = 34;
constexpr int LDS_BYTES = 144 * 1024;

constexpr size_t SZ_WGU = (size_t)2 * DFF * D * 2, SZ_WD = (size_t)D * DFF * 2, SZ_WIN = (size_t)INW * D * 2, SZ_WOUT = (size_t)D * D * 2, SZ_HWIN = (size_t)HYW * D * 2;
constexpr size_t WS_WGU = 0;
constexpr size_t WS_WD = WS_WGU + 8 * SZ_WGU;
constexpr size_t WS_WIN = WS_WD + 8 * SZ_WD;
constexpr size_t WS_WOUT = WS_WIN + 2 * SZ_WIN;
constexpr size_t WS_HWIN = WS_WOUT + 2 * SZ_WOUT;
constexpr size_t WS_HWOUT = WS_HWIN + 2 * SZ_HWIN;
constexpr size_t WS_MOD = WS_HWOUT + 2 * SZ_WOUT;
constexpr size_t WS_ROPE = WS_MOD + (size_t)4 * 5 * NMOD * D * 4;
constexpr size_t WS_XC = WS_ROPE + (size_t)4 * SEQ * 32 * 4;
constexpr size_t WS_H = WS_XC + (size_t)TC * D * 4;
constexpr size_t WS_BIG = WS_H + (size_t)T * D * 2;
constexpr size_t WS_Y = WS_BIG + (size_t)T * HYW * 2;
constexpr size_t WS_MIX = WS_Y + (size_t)T * D * 4;
constexpr size_t SZ_ST = (size_t)NB * NCH * 8 * 4096 * 4;
constexpr size_t WS_ST = WS_MIX + (size_t)T * D * 2;
constexpr size_t SZ_KF = (size_t)(SEQ + CL) * 2 * D * 4;
constexpr size_t WS_KF = WS_ST + 4 * SZ_ST;
constexpr size_t WS_YP = WS_KF + 2 * SZ_KF;
constexpr size_t WS_BAR = WS_YP + (size_t)4 * TC * D * 4;
constexpr size_t WS_CNT = WS_BAR + 16384;
constexpr size_t SZ_CNT = (size_t)12 * 2 * 64 * 256 + 12 * 256;
constexpr size_t WS_SLOT = WS_CNT + SZ_CNT;
constexpr size_t WS_END = WS_SLOT + (size_t)2 * TL * 4 * 4;

struct KP { const float* in[29]; float* out; unsigned char* ws; };
extern __shared__ __attribute__((aligned(16))) unsigned char g_smem[];
constexpr int PTAB_OFF = LDS_BYTES - 512;
__device__ __forceinline__ const float* pin_ld(int k) {
    const unsigned long long v = *(volatile LAS unsigned long long*)((LAS unsigned char*)g_smem + PTAB_OFF + 8 * k);
    const unsigned lo = __builtin_amdgcn_readfirstlane((unsigned)v), hi = __builtin_amdgcn_readfirstlane((unsigned)(v >> 32));
    return (const float*)(((unsigned long long)hi << 32) | lo);
}
struct KQ { float* out; unsigned char* ws; };
__device__ __forceinline__ KQ lq(KQ q) { asm volatile("" : "+s"(q.out), "+s"(q.ws)); return q; }

__device__ __forceinline__ bf16_t f2bf(float f) { unsigned u = __float_as_uint(f); u += 0x7FFFu + ((u >> 16) & 1u); return (bf16_t)(u >> 16); }
__device__ __forceinline__ float bf2f(bf16_t b) { return __uint_as_float(((unsigned)b) << 16); }
__device__ __forceinline__ float silu_f(float x) { return x * __builtin_amdgcn_rcpf(1.0f + __expf(-x)); }
__device__ __forceinline__ int ltid() { int t = threadIdx.x; asm volatile("" : "+v"(t)); return t; }
__device__ __forceinline__ float wave_sum(float v) {
#pragma unroll
    for (int o = 32; o > 0; o >>= 1) v += __shfl_xor(v, o, 64);
    return v;
}


#define XB_TMO      128
#define XB_XCNT(j)  (256  + 64 * (j))
#define XB_XSUB(j)  (1280 + 64 * (j))
#define XB_XGEN(j)  (2304 + 64 * (j))
#define XB_TOP      3328
#define XB_TOPGEN   3392
#define XCD_BAR_WORDS 3456
#define XB_SPIN_CAP (1u << 18)
__device__ __forceinline__ unsigned xb_ld(unsigned* p)              { return __hip_atomic_load(p, __ATOMIC_RELAXED, __HIP_MEMORY_SCOPE_AGENT); }
__device__ __forceinline__ unsigned xb_add(unsigned* p, unsigned v) { return __hip_atomic_fetch_add(p, v, __ATOMIC_RELAXED, __HIP_MEMORY_SCOPE_AGENT); }
__device__ __forceinline__ unsigned xb_xcc_id() { return (unsigned)__builtin_amdgcn_s_getreg((3 << 11) | 20) & 0xFu; }
#define XB_SPIN(cond, bar) do { unsigned _sp = 0; while (cond) { __builtin_amdgcn_s_sleep(1); \
    if ((++_sp & 255u) == 0u) { if (xb_ld(&(bar)[XB_TMO])) break; if (_sp > XB_SPIN_CAP) { atomicAdd(&(bar)[XB_TMO], 1u); break; } } } } while (0)
struct XcdBarrier { unsigned* bar; unsigned x; volatile LAS unsigned* st; };
__device__ __forceinline__ XcdBarrier xcd_barrier_post(unsigned* bar, volatile LAS unsigned* st) {
    XcdBarrier b; b.bar = bar; b.x = xb_xcc_id(); b.st = st;
    if (threadIdx.x == 0) (void)xb_add(&bar[XB_XCNT(b.x)], 1u);
    return b;
}
__device__ __forceinline__ void xcd_barrier_complete(unsigned* bar, unsigned x, unsigned& nloc, unsigned& nx) {
    const unsigned G = gridDim.x * gridDim.y * gridDim.z;
    unsigned sum, cnt, mine, sp = 0u;
    for (;;) {
        sum = 0u; cnt = 0u; mine = 0u;
#pragma unroll
        for (unsigned j = 0; j < 16; ++j) { const unsigned c = xb_ld(&bar[XB_XCNT(j)]); sum += c; cnt += (c > 0u) ? 1u : 0u; mine = (j == x) ? c : mine; }
        if (sum == G) break;
        __builtin_amdgcn_s_sleep(1);
        if ((++sp & 255u) == 0u) { if (xb_ld(&bar[XB_TMO])) break; if (sp > XB_SPIN_CAP) { atomicAdd(&bar[XB_TMO], 1u); break; } }
    }
    nloc = mine > 0u ? mine : 1u; nx = cnt > 0u ? cnt : 1u;
}
__device__ __forceinline__ void xcd_barrier_impl(unsigned* bar, volatile LAS unsigned* st) {
    asm volatile("s_waitcnt vmcnt(0)" ::: "memory");
    __syncthreads();
    if (ltid() == 0) {
        const unsigned x = xb_xcc_id();
        __builtin_amdgcn_s_waitcnt(0);
        unsigned nloc = st[0], nx = st[1];
        if (nloc == 0u) { xcd_barrier_complete(bar, x, nloc, nx); st[0] = nloc; st[1] = nx; }
        const unsigned old = xb_add(&bar[XB_XSUB(x)], 1u);
        const unsigned gen = old / nloc;
        if (old + 1u == (gen + 1u) * nloc) {
            __builtin_amdgcn_fence(__ATOMIC_RELEASE, "agent");
            asm volatile("s_waitcnt vmcnt(0)" ::: "memory");
            const unsigned og = xb_add(&bar[XB_TOP], 1u);
            const unsigned tg = og / nx;
            if (og + 1u == (tg + 1u) * nx) xb_add(&bar[XB_TOPGEN], 1u);
            else XB_SPIN(xb_ld(&bar[XB_TOPGEN]) == tg, bar);
            __builtin_amdgcn_fence(__ATOMIC_ACQUIRE, "agent");
            xb_add(&bar[XB_XGEN(x)], 1u);
            asm volatile("s_waitcnt vmcnt(0)" ::: "memory");
        } else {
            XB_SPIN(xb_ld(&bar[XB_XGEN(x)]) == gen, bar);
            __builtin_amdgcn_fence(__ATOMIC_ACQUIRE, "agent");
            asm volatile("s_waitcnt vmcnt(0)" ::: "memory");
        }
    }
    __syncthreads();
}
__device__ __forceinline__ void sub_barrier(unsigned* word, unsigned n) {
    asm volatile("s_waitcnt vmcnt(0)" ::: "memory");
    __syncthreads();
    if (ltid() == 0) {
        __builtin_amdgcn_fence(__ATOMIC_RELEASE, "agent");
        asm volatile("s_waitcnt vmcnt(0)" ::: "memory");
        (void)xb_add(word, 1u);
        for (unsigned sp = 0; sp < (1u << 21); ++sp) { if (xb_ld(word) >= n) break; __builtin_amdgcn_s_sleep(2); }
        __builtin_amdgcn_fence(__ATOMIC_ACQUIRE, "agent");
        asm volatile("s_waitcnt vmcnt(0)" ::: "memory");
    }
    __syncthreads();
}
#define GRID_BAR() xcd_barrier_impl((unsigned*)(p.ws + WS_BAR), (volatile LAS unsigned*)((LAS unsigned char*)smem + LDS_BYTES - 16))

namespace pg8 {
constexpr int BM = 256, BK = 64, HALF = 128, HTB = HALF * BK * 2, STAGE_BYTES = 8 * HTB, NXCD = 8, WGM = 8;
__host__ __device__ __forceinline__ int lds_byte(int r, int c) { const int st = (r >> 4) * 2 + (c >> 5), rr = r & 15, cc = c & 31, ob = rr * 64 + cc * 2; return st * 1024 + (ob ^ (((ob >> 9) & 1) << 5)); }
__host__ __device__ __forceinline__ void stage_rc(int b, int& R, int& C) { const int st = b / 1024, sb = b % 1024, swz = sb ^ (((sb >> 9) & 1) << 5); R = (st >> 1) * 16 + swz / 64; C = (st & 1) * 32 + (swz % 64) / 2; }
__host__ __device__ __forceinline__ int perm32(int rho) { const int n = rho >> 4, i = rho & 15; return 8 * (i >> 2) + 4 * n + (i & 3); }
struct Unit { int pm, pn; };
struct Gemm { const bf16_t* A; const bf16_t* Bt; int M, N, K, ld; };
struct StaticOrder {
    int nM, nN, nwg, G, c;
    __device__ void init(int M, int N, int G_, int c_) { nM = M / BM; nN = N / BM; nwg = nM * nN; G = G_; c = c_; }
    __device__ bool next(int i, Unit& u) const {
        const long Lx = (long)i * G + c; if (Lx >= nwg) return false;
        int wgid = (int)Lx; { const int q = nwg / NXCD, r = nwg % NXCD, xcd = wgid % NXCD, off = wgid / NXCD; wgid = (xcd < r ? xcd * (q + 1) : r * (q + 1) + (xcd - r) * q) + off; }
        const int nig = WGM * nN, gid = wgid / nig, fm = gid * WGM, gsz = (nM - fm) < WGM ? (nM - fm) : WGM;
        u.pm = fm + ((wgid % nig) % gsz); u.pn = (wgid % nig) / gsz; return true;
    }
};
__device__ __forceinline__ unsigned cvt_pk_bf16(float lo, float hi) { unsigned r; asm volatile("v_cvt_pk_bf16_f32 %0, %1, %2" : "=v"(r) : "v"(lo), "v"(hi)); return r; }

struct EpiF32 {
    static constexpr bool PERM = false, AFTER_DRAIN = false;
    float* C; int ldc;
    __device__ __forceinline__ void operator()(const f32x4 (&acc)[2][2][4][2], const Unit& u, int wr, int wc, int fr, int fq) const {
        const int row0 = u.pm * BM + wr * 64 + fr, col0 = u.pn * BM + wc * 32 + 4 * fq;
#pragma unroll
        for (int ai = 0; ai < 2; ++ai)
#pragma unroll
            for (int m = 0; m < 4; ++m) { float* rowp = C + (size_t)(row0 + ai * HALF + m * 16) * ldc + col0;
#pragma unroll
                for (int bj = 0; bj < 2; ++bj)
#pragma unroll
                    for (int n = 0; n < 2; ++n) *(f32x4*)(rowp + bj * HALF + n * 16) = acc[ai][bj][m][n]; }
    }
};
struct EpiBf16 {
    static constexpr bool PERM = true, AFTER_DRAIN = false;
    bf16_t* O; int ldc; const float* bias;
    __device__ __forceinline__ void operator()(const f32x4 (&acc)[2][2][4][2], const Unit& u, int wr, int wc, int fr, int fq) const {
        const int row0 = u.pm * BM + wr * 64 + fr; const int col0 = u.pn * BM + wc * 32 + 8 * fq;
        f32x4 bv[2][2];
#pragma unroll
        for (int bj = 0; bj < 2; ++bj)
#pragma unroll
            for (int n = 0; n < 2; ++n) bv[bj][n] = bias ? *(const f32x4*)(bias + col0 + bj * HALF + 4 * n) : (f32x4){0.f, 0.f, 0.f, 0.f};
#pragma unroll
        for (int ai = 0; ai < 2; ++ai)
#pragma unroll
            for (int m = 0; m < 4; ++m) { bf16_t* rowp = O + (size_t)(row0 + ai * HALF + m * 16) * ldc + col0;
#pragma unroll
                for (int bj = 0; bj < 2; ++bj) { f32x4 v0 = acc[ai][bj][m][0] + bv[bj][0], v1 = acc[ai][bj][m][1] + bv[bj][1];
                    u32x4 w; w.x = cvt_pk_bf16(v0[0], v0[1]); w.y = cvt_pk_bf16(v0[2], v0[3]); w.z = cvt_pk_bf16(v1[0], v1[1]); w.w = cvt_pk_bf16(v1[2], v1[3]);
                    *(u32x4*)(rowp + bj * HALF) = w; } }
    }
};
struct EpiSwiGLU {
    static constexpr bool PERM = true, AFTER_DRAIN = false;
    bf16_t* O; int ldc;
    __device__ __forceinline__ void operator()(const f32x4 (&acc)[2][2][4][2], const Unit& u, int wr, int wc, int fr, int fq) const {
        const int row0 = u.pm * BM + wr * 64 + fr; const int col0 = u.pn * HALF + wc * 32 + 8 * fq;
#pragma unroll
        for (int ai = 0; ai < 2; ++ai)
#pragma unroll
            for (int m = 0; m < 4; ++m) { bf16_t* rowp = O + (size_t)(row0 + ai * HALF + m * 16) * ldc + col0;
                float v[8];
#pragma unroll
                for (int n = 0; n < 2; ++n)
#pragma unroll
                    for (int j = 0; j < 4; ++j) { const float g = acc[ai][0][m][n][j], up = acc[ai][1][m][n][j]; v[n * 4 + j] = silu_f(g) * up; }
                u32x4 w; w.x = cvt_pk_bf16(v[0], v[1]); w.y = cvt_pk_bf16(v[2], v[3]); w.z = cvt_pk_bf16(v[4], v[5]); w.w = cvt_pk_bf16(v[6], v[7]);
                *(u32x4*)rowp = w; }
    }
};


__device__ __forceinline__ void row_exchange(const f32x4 (&v)[2][2][4][2], const Unit& u, int wr, int wc, int fr, int fq, LAS unsigned char* lds, int wid, int lane, float* slots, unsigned* cnt) {
    LAS float* P = (LAS float*)lds;
    LAS float* S = (LAS float*)(lds + 4096);
#pragma unroll
    for (int ai = 0; ai < 2; ++ai)
#pragma unroll
        for (int m = 0; m < 4; ++m) {
            float sq = 0.f;
#pragma unroll
            for (int bj = 0; bj < 2; ++bj)
#pragma unroll
                for (int n = 0; n < 2; ++n) { const f32x4 x = v[ai][bj][m][n]; sq += (x[0] * x[0] + x[1] * x[1]) + (x[2] * x[2] + x[3] * x[3]); }
            sq += __shfl_xor(sq, 16); sq += __shfl_xor(sq, 32);
            if (fq == 0) P[(ai * HALF + wr * 64 + m * 16 + fr) * 4 + wc] = sq;
        }
    asm volatile("s_waitcnt lgkmcnt(0)" ::: "memory"); __builtin_amdgcn_s_barrier(); asm volatile("" ::: "memory");
    const int row = wid * 32 + (lane & 31);
    if (lane < 32) {
        const float tot = (P[row * 4 + 0] + P[row * 4 + 1]) + (P[row * 4 + 2] + P[row * 4 + 3]);
        __hip_atomic_store((unsigned*)slots + ((size_t)(u.pm * BM + row) * 4 + u.pn), __float_as_uint(tot), __ATOMIC_RELAXED, __HIP_MEMORY_SCOPE_AGENT);
    }
    asm volatile("s_waitcnt vmcnt(0)" ::: "memory");
    if (lane == 0) __hip_atomic_fetch_add(cnt + 64 * u.pm, 1u, __ATOMIC_RELAXED, __HIP_MEMORY_SCOPE_AGENT);
    if (wid == 0) {
        for (unsigned sp = 0; sp < (1u << 21); ++sp) {
            if ((unsigned)__builtin_amdgcn_readfirstlane(__hip_atomic_load(cnt + 64 * u.pm, __ATOMIC_RELAXED, __HIP_MEMORY_SCOPE_AGENT)) >= 32u) break;
            __builtin_amdgcn_s_sleep(2);
        }
        __builtin_amdgcn_fence(__ATOMIC_ACQUIRE, "agent");
    }
    asm volatile("s_waitcnt vmcnt(0) lgkmcnt(0)" ::: "memory"); __builtin_amdgcn_s_barrier(); asm volatile("" ::: "memory");
    if (lane < 32) {
        const unsigned* sl = (const unsigned*)slots + (size_t)(u.pm * BM + row) * 4;
        float tot = 0.f;
#pragma unroll
        for (int t = 0; t < 4; ++t) tot += __uint_as_float(__hip_atomic_load(sl + t, __ATOMIC_RELAXED, __HIP_MEMORY_SCOPE_AGENT));
        S[row] = tot;
    }
    asm volatile("s_waitcnt vmcnt(0) lgkmcnt(0)" ::: "memory"); __builtin_amdgcn_s_barrier(); asm volatile("" ::: "memory");
}
struct EpiFusedRow {
    static constexpr bool PERM = false, AFTER_DRAIN = true;
    const float* xin; float* xout; bf16_t* H;
    const float* gate; const float* gpost; float wgt;
    const float* gpre; const float* shift; const float* scale;
    float* slots; unsigned* cnt;
    __device__ __forceinline__ void operator()(const f32x4 (&)[2][2][4][2], const Unit&, int, int, int, int) const {}
    __device__ __forceinline__ void fused(f32x4 (&acc)[2][2][4][2], const Unit& u, int wr, int wc, int fr, int fq, LAS unsigned char* lds, int wid, int lane) const {
        const LAS float* S = (const LAS float*)(lds + 4096);
        const int col0 = u.pn * BM + wc * 32 + 4 * fq; const size_t mb = (size_t)(u.pm >> 4) * (NMOD * D);
        row_exchange(acc, u, wr, wc, fr, fq, lds, wid, lane, slots, cnt);
        {
            f32x4 cw[2][2];
#pragma unroll
            for (int bj = 0; bj < 2; ++bj)
#pragma unroll
                for (int n = 0; n < 2; ++n) cw[bj][n] = *(const f32x4*)(gate + mb + col0 + bj * HALF + n * 16) * *(const f32x4*)(gpost + col0 + bj * HALF + n * 16);
#pragma unroll
            for (int ai = 0; ai < 2; ++ai)
#pragma unroll
                for (int m = 0; m < 4; ++m) { const int r = ai * HALF + wr * 64 + m * 16 + fr; const float r1 = rsqrtf(S[r] * (1.0f / D) + EPS) * wgt; const size_t off = (size_t)(u.pm * BM + r) * D + col0;
#pragma unroll
                    for (int bj = 0; bj < 2; ++bj)
#pragma unroll
                        for (int n = 0; n < 2; ++n) { const f32x4 xv = *(const f32x4*)(xin + off + bj * HALF + n * 16); const f32x4 xn = xv + (cw[bj][n] * r1) * acc[ai][bj][m][n];
                            acc[ai][bj][m][n] = xn; *(f32x4*)(xout + off + bj * HALF + n * 16) = xn; }
                    asm volatile("" : "+v"(acc[ai][0][m][0]), "+v"(acc[ai][0][m][1]), "+v"(acc[ai][1][m][0]), "+v"(acc[ai][1][m][1]));
                    asm volatile("" ::: "memory"); }
        }
        if (H == nullptr) return;
        row_exchange(acc, u, wr, wc, fr, fq, lds, wid, lane, slots + (size_t)TL * 4, cnt + 64 * 64);
        {
            f32x4 gm[2][2], sh[2][2];
#pragma unroll
            for (int bj = 0; bj < 2; ++bj)
#pragma unroll
                for (int n = 0; n < 2; ++n) { const int c = col0 + bj * HALF + n * 16; gm[bj][n] = *(const f32x4*)(gpre + c) * (*(const f32x4*)(scale + mb + c) + 1.0f); sh[bj][n] = *(const f32x4*)(shift + mb + c); }
#pragma unroll
            for (int ai = 0; ai < 2; ++ai)
#pragma unroll
                for (int m = 0; m < 4; ++m) { const int r = ai * HALF + wr * 64 + m * 16 + fr; const float r2 = rsqrtf(S[r] * (1.0f / D) + EPS); const size_t off = (size_t)(u.pm * BM + r) * D + col0;
#pragma unroll
                    for (int bj = 0; bj < 2; ++bj)
#pragma unroll
                        for (int n = 0; n < 2; ++n) { const f32x4 hv = (acc[ai][bj][m][n] * r2) * gm[bj][n] + sh[bj][n];
                            uint2 w2; w2.x = cvt_pk_bf16(hv[0], hv[1]); w2.y = cvt_pk_bf16(hv[2], hv[3]); *(uint2*)(H + off + bj * HALF + n * 16) = w2; }
                    asm volatile("" ::: "memory"); }
        }
    }
};

template <class Epi, class Sched>
__device__ __forceinline__ void gemm_phase(LAS unsigned char* lds, const Gemm g, const Sched& S, const Epi& E) {
    const int tid = ltid(), wid = __builtin_amdgcn_readfirstlane(tid >> 6), lane = tid & 63, wr = wid >> 2, wc = wid & 3, fr = lane & 15, fq = lane >> 4;
    const int K = g.ld, nt = g.K / BK;
    unsigned voffA[2], voffB[2];
#pragma unroll
    for (int i = 0; i < 2; ++i) { int R, C; stage_rc(tid * 16 + i * 8192, R, C); const int Rb = Epi::PERM ? ((R & ~31) + perm32(R & 31)) : R;
        voffA[i] = (unsigned)(R * K + C) * 2u; voffB[i] = (unsigned)(Rb * K + C) * 2u; }
    const size_t kstep = (size_t)(BK * 2);
    const size_t hstep = (size_t)HALF * K * 2;
    const size_t tstep = 2 * hstep;
    const unsigned ldsw = (unsigned)wid * 1024u;
    const int aoff = lds_byte(wr * 64 + fr, fq * 8), boff = lds_byte(wc * 32 + fr, fq * 8);
#define PG8_SA(b, h) (((b) * 2 + (h)) * HTB)
#define PG8_SB(b, h) ((4 + (b) * 2 + (h)) * HTB)
#define PG8_STAGE(bufoff, gbase, voff) do { _Pragma("unroll") for (int _i = 0; _i < 2; ++_i) \
        __builtin_amdgcn_global_load_lds((const unsigned*)((const char*)(gbase) + (voff)[_i]), (LAS unsigned*)(lds + (bufoff) + ldsw + _i * 8192), 16, 0, 0); } while (0)
#define PG8_LDA(dst, b, h) do { _Pragma("unroll") for (int m = 0; m < 4; ++m) _Pragma("unroll") for (int k = 0; k < 2; ++k) dst[m][k] = *(const LAS bf16x8*)(lds + PG8_SA(b, h) + aoff + m * 2048 + k * 1024); } while (0)
#define PG8_LDB(dst, b, h) do { _Pragma("unroll") for (int n = 0; n < 2; ++n) _Pragma("unroll") for (int k = 0; k < 2; ++k) dst[n][k] = *(const LAS bf16x8*)(lds + PG8_SB(b, h) + boff + n * 2048 + k * 1024); } while (0)
#define PG8_MMA(ai, bj, At, Bt) do { __builtin_amdgcn_s_setprio(1); _Pragma("unroll") for (int m = 0; m < 4; ++m) _Pragma("unroll") for (int n = 0; n < 2; ++n) _Pragma("unroll") for (int k = 0; k < 2; ++k) \
        acc[ai][bj][m][n] = __builtin_amdgcn_mfma_f32_16x16x32_bf16(Bt[n][k], At[m][k], acc[ai][bj][m][n], 0, 0, 0); __builtin_amdgcn_s_setprio(0); } while (0)
#define PG8_WAIT_V(n) asm volatile("s_waitcnt vmcnt(" #n ")" ::: "memory")
#define PG8_WAIT_L(n) asm volatile("s_waitcnt lgkmcnt(" #n ")" ::: "memory")
#define PG8_BAR __builtin_amdgcn_s_barrier()
#define PG8_SCHED __builtin_amdgcn_sched_barrier(0)
    Unit cur, nxt; int ui = 0;
    if (!S.next(0, cur)) return;
    f32x4 acc[2][2][4][2];
#pragma unroll
    for (int a = 0; a < 2; ++a)
#pragma unroll
        for (int b = 0; b < 2; ++b)
#pragma unroll
            for (int m = 0; m < 4; ++m)
#pragma unroll
                for (int n = 0; n < 2; ++n) acc[a][b][m][n] = (f32x4){0.f, 0.f, 0.f, 0.f};
    bf16x8 At[4][2], B0[2][2], B1[2][2];
    const char* cA = (const char*)g.A + (size_t)cur.pm * tstep; const char* cB = (const char*)g.Bt + (size_t)cur.pn * tstep;
    PG8_STAGE(PG8_SB(0, 0), cB, voffB); PG8_STAGE(PG8_SA(0, 0), cA, voffA); PG8_STAGE(PG8_SB(0, 1), cB + hstep, voffB); PG8_STAGE(PG8_SA(0, 1), cA + hstep, voffA);
    if (wr == 1) PG8_BAR;
    PG8_WAIT_V(4); PG8_BAR;
    PG8_STAGE(PG8_SB(1, 0), cB + kstep, voffB); PG8_STAGE(PG8_SA(1, 0), cA + kstep, voffA); PG8_STAGE(PG8_SB(1, 1), cB + hstep + kstep, voffB);
    PG8_WAIT_V(6); PG8_BAR;
    for (;;) {
        const bool has_next = S.next(ui + 1, nxt);
        const char* nA = has_next ? (const char*)g.A + (size_t)nxt.pm * tstep : cA; const char* nB = has_next ? (const char*)g.Bt + (size_t)nxt.pn * tstep : cB;
        for (int t = 0; t < nt; t += 2) {
            const bool last = (t == nt - 2);
            const char* a1 = cA + (size_t)(t + 1) * kstep;
            const char* a2 = last ? nA : cA + (size_t)(t + 2) * kstep; const char* b2 = last ? nB : cB + (size_t)(t + 2) * kstep;
            const char* a3 = a2 + kstep; const char* b3 = b2 + kstep;
            PG8_LDB(B0, 0, 0); PG8_SCHED; PG8_LDA(At, 0, 0); PG8_STAGE(PG8_SA(1, 1), a1 + hstep, voffA);
            PG8_WAIT_L(8); PG8_BAR; PG8_WAIT_L(0); PG8_MMA(0, 0, At, B0); PG8_BAR; PG8_SCHED;
            PG8_LDB(B1, 0, 1); PG8_STAGE(PG8_SB(0, 0), b2, voffB);
            PG8_BAR; PG8_WAIT_L(0); PG8_MMA(0, 1, At, B1); PG8_BAR;
            PG8_LDA(At, 0, 1); PG8_STAGE(PG8_SA(0, 0), a2, voffA);
            PG8_BAR; PG8_WAIT_L(0); PG8_MMA(1, 0, At, B0); PG8_BAR; PG8_SCHED;
            PG8_STAGE(PG8_SB(0, 1), b2 + hstep, voffB);
            PG8_WAIT_V(6); PG8_BAR; PG8_MMA(1, 1, At, B1); PG8_BAR;
            PG8_LDB(B0, 1, 0); PG8_SCHED; PG8_LDA(At, 1, 0); PG8_STAGE(PG8_SA(0, 1), a2 + hstep, voffA);
            PG8_WAIT_L(8); PG8_BAR; PG8_WAIT_L(0); PG8_MMA(0, 0, At, B0); PG8_BAR; PG8_SCHED;
            PG8_LDB(B1, 1, 1); PG8_STAGE(PG8_SB(1, 0), b3, voffB);
            PG8_BAR; PG8_WAIT_L(0); PG8_MMA(0, 1, At, B1); PG8_BAR;
            PG8_LDA(At, 1, 1); PG8_STAGE(PG8_SA(1, 0), a3, voffA);
            PG8_BAR; PG8_WAIT_L(0); PG8_MMA(1, 0, At, B0); PG8_BAR; PG8_SCHED;
            PG8_STAGE(PG8_SB(1, 1), b3 + hstep, voffB);
            PG8_WAIT_V(6); PG8_BAR; PG8_MMA(1, 1, At, B1); PG8_BAR;
        }
        if constexpr (!Epi::AFTER_DRAIN) E(acc, cur, wr, wc, fr, fq);
        if (!has_next) break;
#pragma unroll
        for (int a = 0; a < 2; ++a)
#pragma unroll
            for (int b = 0; b < 2; ++b)
#pragma unroll
                for (int m = 0; m < 4; ++m)
#pragma unroll
                    for (int n = 0; n < 2; ++n) acc[a][b][m][n] = (f32x4){0.f, 0.f, 0.f, 0.f};
        cur = nxt; cA = nA; cB = nB; ++ui;
    }
    PG8_WAIT_V(0);
    if (wr == 0) PG8_BAR;
    PG8_BAR;
    if constexpr (Epi::AFTER_DRAIN) E.fused(acc, cur, wr, wc, fr, fq, lds, wid, lane);
#undef PG8_SA
#undef PG8_SB
#undef PG8_STAGE
#undef PG8_LDA
#undef PG8_LDB
#undef PG8_MMA
#undef PG8_WAIT_V
#undef PG8_WAIT_L
#undef PG8_BAR
#undef PG8_SCHED
}
}

template <class Epi>
__device__ __forceinline__ void run_gemm(unsigned char* smem, const bf16_t* A, const bf16_t* Bt, int M, int N, int K, const Epi& E) {
    pg8::Gemm g{A, Bt, M, N, K, K}; pg8::StaticOrder S; S.init(M, N, (int)gridDim.x, (int)blockIdx.x);
    pg8::gemm_phase<Epi, pg8::StaticOrder>((LAS unsigned char*)smem, g, S, E);
}
__device__ __forceinline__ void run_gemm_f32_split(unsigned char* smem, const bf16_t* A, const bf16_t* Bt, int M, int K, const pg8::EpiFusedRow& EF, float* YP) {
    { pg8::Gemm g{A, Bt, TL, D, K, K}; pg8::StaticOrder S; S.init(TL, D, (int)gridDim.x, (int)blockIdx.x);
      pg8::gemm_phase<pg8::EpiFusedRow, pg8::StaticOrder>((LAS unsigned char*)smem, g, S, EF); }
    __syncthreads();
    if (M > TL && blockIdx.x < 64) {
        const int ks = blockIdx.x >> 4;
        int koff, klen;
        if (K == DFF) { koff = (ks < 2) ? ks * 768 : 1536 + (ks - 2) * 640; klen = (ks < 2) ? 768 : 640; }
        else { klen = K / 4; koff = ks * klen; }
        pg8::Gemm g{A + (size_t)TL * K + koff, Bt + koff, TC, D, klen, K}; pg8::StaticOrder S; S.init(TC, D, 16, (int)(blockIdx.x & 15)); pg8::EpiF32 E{YP + (size_t)ks * TC * D, D};
        pg8::gemm_phase<pg8::EpiF32, pg8::StaticOrder>((LAS unsigned char*)smem, g, S, E);
        __syncthreads();
    }
}

__device__ __forceinline__ float* xrow(const KQ p, int t) { return t < TL ? p.out + (size_t)t * D : (float*)(p.ws + WS_XC) + (size_t)(t - TL) * D; }
__device__ __forceinline__ int modrow(int t) { return t < TL ? (t >> 12) : 4; }
__device__ __forceinline__ const float* modp(const KQ p, int l, int mr, int idx) { return (const float*)(p.ws + WS_MOD) + ((size_t)(l * 5 + mr) * NMOD + idx) * D; }

__device__ __forceinline__ void p0_setup(const KQ p_in, float* sm) {
    const KQ p = lq(p_in);
    const int tid = ltid(), bid = blockIdx.x, nb = gridDim.x;
    const int gtid = bid * 512 + tid, gthreads = nb * 512;
    {
        float* rope = (float*)(p.ws + WS_ROPE);
        for (int idx = gtid; idx < SEQ * 32; idx += gthreads) {
            const int t = idx >> 5, i = idx & 31;
            const int ii = i & 15; const float pos = (i < 16) ? (float)(t >> 6) : (float)(t & 63);
            const float invA = powf(10000.0f, -(float)ii / 16.0f);
            const float angA = pos * invA;
            rope[idx] = cosf(angA); rope[SEQ * 32 + idx] = sinf(angA);
            const float ex = (float)i * (1.0f / 31.0f);
            const float invR = powf(10000.0f, -ex);
            const float angR = (float)t * invR;
            rope[2 * SEQ * 32 + idx] = cosf(angR); rope[3 * SEQ * 32 + idx] = sinf(angR);
        }
    }
    {
        float* tile = sm;
        for (int gs = bid; gs < 20864 / 4; gs += nb) {
            const int g = gs * 4;
            int j, tl;
            if (g < 16896) { j = g / 704; tl = g % 704; }
            else if (g < 18304) { j = 24 + (g - 16896) / 704; tl = (g - 16896) % 704; }
            else if (g < 18816) { j = 26 + (g - 18304) / 256; tl = (g - 18304) % 256; }
            else if (g < 20352) { j = 28 + (g - 18816) / 768; tl = (g - 18816) % 768; }
            else { j = 30 + (g - 20352) / 256; tl = (g - 20352) % 256; }
            const float* src; bf16_t* dst; int K, N, mode = 0;
            if (j < 8) { src = pin_ld(8) + (size_t)j * D * DFF; dst = (bf16_t*)(p.ws + WS_WGU + (size_t)j * SZ_WGU); K = D; N = DFF; mode = 1; }
            else if (j < 16) { src = pin_ld(9) + (size_t)(j - 8) * D * DFF; dst = (bf16_t*)(p.ws + WS_WGU + (size_t)(j - 8) * SZ_WGU); K = D; N = DFF; mode = 2; }
            else if (j < 24) { src = pin_ld(10) + (size_t)(j - 16) * DFF * D; dst = (bf16_t*)(p.ws + WS_WD + (size_t)(j - 16) * SZ_WD); K = DFF; N = D; }
            else if (j < 26) { src = pin_ld(11) + (size_t)(j - 24) * D * INW; dst = (bf16_t*)(p.ws + WS_WIN + (size_t)(j - 24) * SZ_WIN); K = D; N = INW; mode = 3; }
            else if (j < 28) { src = pin_ld(14) + (size_t)(j - 26) * D * D; dst = (bf16_t*)(p.ws + WS_WOUT + (size_t)(j - 26) * SZ_WOUT); K = D; N = D; }
            else if (j < 30) { src = pin_ld(15) + (size_t)(j - 28) * D * HYW; dst = (bf16_t*)(p.ws + WS_HWIN + (size_t)(j - 28) * SZ_HWIN); K = D; N = HYW; }
            else { src = pin_ld(28) + (size_t)(j - 30) * D * D; dst = (bf16_t*)(p.ws + WS_HWOUT + (size_t)(j - 30) * SZ_WOUT); K = D; N = D; }
            const int ntn = N / 64; const int k0 = (tl / ntn) * 64, n0 = (tl % ntn) * 64;
            f32x4 ld[8];
#pragma unroll
            for (int i = 0; i < 8; ++i) ld[i] = *(const f32x4*)(src + (size_t)(k0 + i * 8 + (tid >> 6)) * N + n0 + (tid & 63) * 4);
            __syncthreads();
#pragma unroll
            for (int i = 0; i < 8; ++i) *(f32x4*)(tile + (i * 8 + (tid >> 6)) * 260 + (tid & 63) * 4) = ld[i];
            __syncthreads();
            {
                const int n = tid >> 1, kh = (tid & 1) * 32; const int gn = n0 + n;
                float sc_ = 1.0f; int row = gn;
                if (mode == 1) row = 256 * (gn >> 7) + (gn & 127);
                else if (mode == 2) row = 256 * (gn >> 7) + 128 + (gn & 127);
                else if (mode == 3) { if (gn < 512 || (gn >= 1792 && gn < 2304)) sc_ = 0.125f; }
#pragma unroll
                for (int q = 0; q < 4; ++q) {
                    float v[8];
#pragma unroll
                    for (int jj = 0; jj < 8; ++jj) v[jj] = tile[(kh + q * 8 + jj) * 260 + n] * sc_;
                    u32x4 o4; o4.x = pg8::cvt_pk_bf16(v[0], v[1]); o4.y = pg8::cvt_pk_bf16(v[2], v[3]); o4.z = pg8::cvt_pk_bf16(v[4], v[5]); o4.w = pg8::cvt_pk_bf16(v[6], v[7]);
                    *(u32x4*)(dst + (size_t)row * K + k0 + kh + q * 8) = o4;
                }
            }
        }
        __syncthreads();
    }
    {
        float* sc = sm;
        float* red = sm + 5 * 1024;
        for (int i = tid; i < 5 * 1024; i += 512) { const int r = i >> 10, k = i & 1023; const float v = (r < 4) ? pin_ld(1)[r * D + k] : pin_ld(3)[k]; sc[i] = silu_f(v); }
        __syncthreads();
        const int w = tid >> 6, lane = tid & 63;
        for (int it = bid; it < 288; it += nb) {
            const int l = it / 72, c0 = (it % 72) * 128;
            const float* wm = pin_ld(4) + (size_t)l * D * (NMOD * D) + c0 + 2 * lane;
            float a[5][2];
#pragma unroll
            for (int r = 0; r < 5; ++r) { a[r][0] = 0.f; a[r][1] = 0.f; }
            for (int kb = w * 128; kb < w * 128 + 128; kb += 16) {
                float2 wv[16];
#pragma unroll
                for (int q = 0; q < 16; ++q) wv[q] = *(const float2*)(wm + (size_t)(kb + q) * (NMOD * D));
#pragma unroll
                for (int q = 0; q < 16; ++q)
#pragma unroll
                    for (int r = 0; r < 5; ++r) { const float s = sc[r * 1024 + kb + q]; a[r][0] += s * wv[q].x; a[r][1] += s * wv[q].y; }
            }
#pragma unroll
            for (int r = 0; r < 5; ++r) { red[(w * 5 + r) * 128 + 2 * lane] = a[r][0]; red[(w * 5 + r) * 128 + 2 * lane + 1] = a[r][1]; }
            __syncthreads();
            for (int i = tid; i < 5 * 128; i += 512) {
                const int r = i >> 7, c = i & 127; float s = 0.f;
#pragma unroll
                for (int ww = 0; ww < 8; ++ww) s += red[(ww * 5 + r) * 128 + c];
                s += pin_ld(5)[(size_t)l * (NMOD * D) + c0 + c];
                ((float*)(p.ws + WS_MOD))[(size_t)(l * 5 + r) * (NMOD * D) + c0 + c] = s;
            }
            __syncthreads();
        }
    }
    {
        float* z = sm;
        float* a1 = sm + 16 * 36;
        float* a2 = a1 + 16 * 64;
        float* a3 = a2 + 16 * 64;
        float* tl = a3 + 16 * 64;
        float* wl = tl + 16;
        const float HMAX = -4.605170185988091f / 0.3f, HMIN = -4.605170185988091f / 1.5f;
        int o_loaded = -1;
        for (int it = nb - 1 - bid; it < 544; it += nb) {
            const int o = it / 272, r = it % 272;
            const int Lf = (r < 256) ? SEQ : CL; const int p0 = (r < 256) ? r * 16 : (r - 256) * 16;
            float* kf = (float*)(p.ws + WS_KF + (size_t)o * SZ_KF) + ((r < 256) ? (size_t)0 : (size_t)2 * SEQ * D);
            const float* f3 = pin_ld(25) + (size_t)o * 64 * 2048;
            __syncthreads();
            if (o != o_loaded) {
                const float* f0 = pin_ld(19) + (size_t)o * 33 * 64; const float* f1 = pin_ld(21) + (size_t)o * 64 * 64; const float* f2 = pin_ld(23) + (size_t)o * 64 * 64;
                for (int i = tid; i < 33 * 64; i += 512) wl[i] = f0[i];
                for (int i = tid; i < 64 * 64; i += 512) { wl[2112 + i] = f1[i]; wl[2112 + 4096 + i] = f2[i]; }
                if (tid < 64) { wl[10304 + tid] = pin_ld(20)[o * 64 + tid]; wl[10304 + 64 + tid] = pin_ld(22)[o * 64 + tid]; wl[10304 + 128 + tid] = pin_ld(24)[o * 64 + tid]; wl[10304 + 192 + tid] = pin_ld(26)[o * 64 + tid]; }
                o_loaded = o;
            }
            const float* f0 = wl; const float* f1 = wl + 2112; const float* f2 = wl + 2112 + 4096;
            const float* fb0 = wl + 10304; const float* fb1 = fb0 + 64; const float* fb2 = fb0 + 128; const float* fq = fb0 + 192;
            for (int idx = tid; idx < 16 * 33; idx += 512) {
                const int ps = idx / 33, f = idx % 33; const int i = p0 + ps;
                const float tlin = (float)i * (1.0f / (float)(Lf - 1));
                const float w = (6.283185307179586f * (float)i) / (float)Lf;
                float v;
                if (f == 0) { v = tlin; tl[ps] = tlin; }
                else { const int jj = (f - 1) & 15; const float fj = 1e-4f + (float)jj * ((15.0f - 1e-4f) / 15.0f); v = (f <= 16) ? cosf(fj * w) : -sinf(fj * w); }
                z[ps * 36 + f] = v;
            }
            __syncthreads();
            for (int idx = tid; idx < 16 * 64; idx += 512) { const int ps = idx >> 6, oc = idx & 63; float s = fb0[oc];
                for (int f = 0; f < 33; ++f) s += z[ps * 36 + f] * f0[f * 64 + oc];
                a1[idx] = sinf(fq[oc] * s); }
            __syncthreads();
            for (int idx = tid; idx < 16 * 64; idx += 512) { const int ps = idx >> 6, oc = idx & 63; float s = fb1[oc];
                for (int f = 0; f < 64; ++f) s += a1[ps * 64 + f] * f1[f * 64 + oc];
                a2[idx] = sinf(fq[oc] * s); }
            __syncthreads();
            for (int idx = tid; idx < 16 * 64; idx += 512) { const int ps = idx >> 6, oc = idx & 63; float s = fb2[oc];
                for (int f = 0; f < 64; ++f) s += a2[ps * 64 + f] * f2[f * 64 + oc];
                a3[oc * 16 + ps] = sinf(fq[oc] * s); }
            __syncthreads();
            {
                float acc[4][16];
#pragma unroll
                for (int q = 0; q < 4; ++q)
#pragma unroll
                    for (int ps = 0; ps < 16; ++ps) acc[q][ps] = 0.f;
                for (int fb = 0; fb < 64; fb += 4) {
                    float wv[4][4];
#pragma unroll
                    for (int f = 0; f < 4; ++f)
#pragma unroll
                        for (int q = 0; q < 4; ++q) wv[f][q] = f3[(fb + f) * 2048 + tid + 512 * q];
#pragma unroll
                    for (int f = 0; f < 4; ++f) {
                        const f32x4 av0 = *(const f32x4*)(a3 + (fb + f) * 16), av1 = *(const f32x4*)(a3 + (fb + f) * 16 + 4), av2 = *(const f32x4*)(a3 + (fb + f) * 16 + 8), av3 = *(const f32x4*)(a3 + (fb + f) * 16 + 12);
#pragma unroll
                        for (int q = 0; q < 4; ++q)
#pragma unroll
                            for (int e = 0; e < 4; ++e) { acc[q][e] += av0[e] * wv[f][q]; acc[q][4 + e] += av1[e] * wv[f][q]; acc[q][8 + e] += av2[e] * wv[f][q]; acc[q][12 + e] += av3[e] * wv[f][q]; }
                    }
                }
#pragma unroll
                for (int q = 0; q < 4; ++q) {
                    const int c = tid + 512 * q; const int dir = c >> 10, d = c & 1023;
                    const float delta = fabsf(HMIN + (float)d * ((HMAX - HMIN) / 1023.0f));
#pragma unroll
                    for (int ps = 0; ps < 16; ++ps) {
                        const float kvv = acc[q][ps] * expf(-tl[ps] * delta);
                        if (r < 256) {
                            bf16_t* rk = (bf16_t*)(p.ws + WS_KF + (size_t)o * SZ_KF) + (size_t)d * 8192;
                            const int m = p0 + ps;
                            if (dir == 0) rk[4095 - m] = f2bf(kvv); else if (m > 0) rk[4095 + m] = f2bf(kvv);
                            if (dir == 0 && m == 0) rk[8191] = 0;
                        } else kf[((size_t)dir * Lf + p0 + ps) * D + d] = kvv;
                    }
                }
            }
        }
        __syncthreads();
    }
}

__device__ __forceinline__ void rowphase(const KQ p_in, int Mupd, const bf16_t* Y, int lu, int gidx, float wgt, const float* gpost,
                         int Mnext, int ln, const float* gpre, int shidx, int scidx, bf16_t* Hout, bool from_input, int tbeg) {
    const KQ p = lq(p_in);
    const int tid = ltid(), w = tid >> 6, lane = tid & 63;
    const int Mmax = Mupd > Mnext ? Mupd : Mnext;
    for (int t = tbeg + (blockIdx.x * 8 + w) * 2; t < Mmax; t += gridDim.x * 16) {
        float* xr = xrow(p, t); const int mr = modrow(t);
        const float* xs = xr;
        if (from_input) xs = (t < TL) ? pin_ld(0) + (size_t)t * D : pin_ld(2) + (size_t)(t - TL) * D;
        float4 xv[2][4];
#pragma unroll
        for (int rr = 0; rr < 2; ++rr)
#pragma unroll
            for (int q = 0; q < 4; ++q) xv[rr][q] = *(const float4*)(xs + rr * D + q * 256 + lane * 4);
        if (Y != nullptr && t < Mupd) {
            float4 yv[2][4]; float ss[2] = {0.f, 0.f};
#pragma unroll
            for (int rr = 0; rr < 2; ++rr)
#pragma unroll
                for (int q = 0; q < 4; ++q) {
                    if (t < TL) { const bf16x4 yb = *(const bf16x4*)(Y + (size_t)(t + rr) * D + q * 256 + lane * 4);
                        yv[rr][q] = make_float4(bf2f((bf16_t)yb[0]), bf2f((bf16_t)yb[1]), bf2f((bf16_t)yb[2]), bf2f((bf16_t)yb[3])); }
                    else { const float* yp = (const float*)(p.ws + WS_YP) + (size_t)(t + rr - TL) * D + q * 256 + lane * 4;
                        const float4 a0 = *(const float4*)yp, a1 = *(const float4*)(yp + (size_t)TC * D), a2 = *(const float4*)(yp + (size_t)2 * TC * D), a3 = *(const float4*)(yp + (size_t)3 * TC * D);
                        yv[rr][q] = make_float4(a0.x + a1.x + a2.x + a3.x, a0.y + a1.y + a2.y + a3.y, a0.z + a1.z + a2.z + a3.z, a0.w + a1.w + a2.w + a3.w); }
                    ss[rr] += yv[rr][q].x * yv[rr][q].x + yv[rr][q].y * yv[rr][q].y + yv[rr][q].z * yv[rr][q].z + yv[rr][q].w * yv[rr][q].w; }
            ss[0] = wave_sum(ss[0]); ss[1] = wave_sum(ss[1]);
            float wgl = wgt; asm volatile("" : "+v"(wgl));
            const float r0 = rsqrtf(ss[0] * (1.0f / D) + EPS) * wgl, r1 = rsqrtf(ss[1] * (1.0f / D) + EPS) * wgl;
            const float* gm = modp(p, lu, mr, gidx);
#pragma unroll
            for (int q = 0; q < 4; ++q) {
                const float4 g4 = *(const float4*)(gm + q * 256 + lane * 4); const float4 p4 = *(const float4*)(gpost + q * 256 + lane * 4);
                const float cx = g4.x * p4.x, cy = g4.y * p4.y, cz = g4.z * p4.z, cw = g4.w * p4.w;
                xv[0][q].x += r0 * cx * yv[0][q].x; xv[0][q].y += r0 * cy * yv[0][q].y; xv[0][q].z += r0 * cz * yv[0][q].z; xv[0][q].w += r0 * cw * yv[0][q].w;
                xv[1][q].x += r1 * cx * yv[1][q].x; xv[1][q].y += r1 * cy * yv[1][q].y; xv[1][q].z += r1 * cz * yv[1][q].z; xv[1][q].w += r1 * cw * yv[1][q].w;
                *(float4*)(xr + q * 256 + lane * 4) = xv[0][q]; *(float4*)(xr + D + q * 256 + lane * 4) = xv[1][q];
            }
        }
        if (Hout != nullptr && t < Mnext) {
            float ss[2] = {0.f, 0.f};
#pragma unroll
            for (int rr = 0; rr < 2; ++rr)
#pragma unroll
                for (int q = 0; q < 4; ++q) ss[rr] += xv[rr][q].x * xv[rr][q].x + xv[rr][q].y * xv[rr][q].y + xv[rr][q].z * xv[rr][q].z + xv[rr][q].w * xv[rr][q].w;
            ss[0] = wave_sum(ss[0]); ss[1] = wave_sum(ss[1]);
            const float rn[2] = {rsqrtf(ss[0] * (1.0f / D) + EPS), rsqrtf(ss[1] * (1.0f / D) + EPS)};
            const float* sh = modp(p, ln, mr, shidx); const float* sc = modp(p, ln, mr, scidx);
#pragma unroll
            for (int q = 0; q < 4; ++q) {
                const float4 g4 = *(const float4*)(gpre + q * 256 + lane * 4); const float4 s4 = *(const float4*)(sc + q * 256 + lane * 4); const float4 h4 = *(const float4*)(sh + q * 256 + lane * 4);
                const float mx_ = g4.x * (1.0f + s4.x), my_ = g4.y * (1.0f + s4.y), mz_ = g4.z * (1.0f + s4.z), mw_ = g4.w * (1.0f + s4.w);
#pragma unroll
                for (int rr = 0; rr < 2; ++rr) {
                    const float h0 = xv[rr][q].x * rn[rr] * mx_ + h4.x, h1 = xv[rr][q].y * rn[rr] * my_ + h4.y;
                    const float h2 = xv[rr][q].z * rn[rr] * mz_ + h4.z, h3 = xv[rr][q].w * rn[rr] * mw_ + h4.w;
                    uint2 pk; pk.x = pg8::cvt_pk_bf16(h0, h1); pk.y = pg8::cvt_pk_bf16(h2, h3);
                    *(uint2*)(Hout + (size_t)(t + rr) * D + q * 256 + lane * 4) = pk;
                }
            }
        }
    }
}

__device__ __forceinline__ float log_sigmoid(float x) { return -log1pf(expf(-x)); }
__device__ __forceinline__ int chunk_t0(int b, int cidx) { return cidx < 32 ? b * SEQ + cidx * 128 : TL + b * CL + (cidx - 32) * 128; }

__device__ __forceinline__ void m1_rope_states(const KQ p_in, int e, float* sm) {
    const KQ p = lq(p_in);
    const int tid = ltid(), bid = blockIdx.x, nb = gridDim.x;
    bf16_t* Z = (bf16_t*)(p.ws + WS_BIG);
    const float* rope = (const float*)(p.ws + WS_ROPE);
    for (int idx = bid * 512 + tid; idx < TL * 72; idx += nb * 512) {
        const int t = idx / 72, r = idx % 72; const int hd = r >> 2, i0 = (r & 3) * 8;
        const int cb = hd < 16 ? hd * 64 : 1536 + (hd - 16) * 64;
        const int tb = (hd >= 8 && hd < 16) ? 2 : 0; const int pos = t & (SEQ - 1);
        const float* cp = rope + (size_t)tb * SEQ * 32 + pos * 32 + i0; const float* sp = cp + (size_t)SEQ * 32;
        bf16_t* zp = Z + (size_t)t * INW + cb + i0;
        const bf16x8 a1 = *(const bf16x8*)zp, a2 = *(const bf16x8*)(zp + 32);
        const float4 c0 = *(const float4*)cp, c1 = *(const float4*)(cp + 4), s0 = *(const float4*)sp, s1 = *(const float4*)(sp + 4);
        const float cc[8] = {c0.x, c0.y, c0.z, c0.w, c1.x, c1.y, c1.z, c1.w}, sn[8] = {s0.x, s0.y, s0.z, s0.w, s1.x, s1.y, s1.z, s1.w};
        float o1[8], o2[8];
#pragma unroll
        for (int j = 0; j < 8; ++j) { const float x1 = bf2f((bf16_t)a1[j]), x2 = bf2f((bf16_t)a2[j]); o1[j] = x1 * cc[j] - x2 * sn[j]; o2[j] = x1 * sn[j] + x2 * cc[j]; }
        u32x4 w1, w2;
        w1.x = pg8::cvt_pk_bf16(o1[0], o1[1]); w1.y = pg8::cvt_pk_bf16(o1[2], o1[3]); w1.z = pg8::cvt_pk_bf16(o1[4], o1[5]); w1.w = pg8::cvt_pk_bf16(o1[6], o1[7]);
        w2.x = pg8::cvt_pk_bf16(o2[0], o2[1]); w2.y = pg8::cvt_pk_bf16(o2[2], o2[3]); w2.z = pg8::cvt_pk_bf16(o2[4], o2[5]); w2.w = pg8::cvt_pk_bf16(o2[6], o2[7]);
        *(u32x4*)zp = w1; *(u32x4*)(zp + 32) = w2;
    }
    float* Ks = sm;
    float* Vs = sm + 128 * 64;
    float* wf = Vs + 128 * 64;
    float* wb = wf + 128;
    float* AF = (float*)(p.ws + WS_ST); float* AB = AF + SZ_ST / 4;
    const float* dec = pin_ld(13) + e * 16;
    for (int it = bid; it < NB * NCH * 8; it += nb) {
        const int h = it & 7, cidx = (it >> 3) % NCH, b = it / (8 * NCH);
        const int t0 = chunk_t0(b, cidx); const bool lat = cidx < 32;
        const float lgf = log_sigmoid(dec[h]), lgb = log_sigmoid(dec[8 + h]);
        __syncthreads();
        if (tid < 128) { wf[tid] = expf(lgf * (float)(127 - tid)); wb[tid] = expf(lgb * (float)tid); }
        const int kc = 1792 + h * 64, vc = 2304 + h * 64;
#pragma unroll
        for (int q = 0; q < 8; ++q) {
            const int idx = tid + 512 * q; const int r = idx >> 5, i = idx & 31;
            bf16_t* zp = Z + (size_t)(t0 + r) * INW + kc + i;
            float x1 = bf2f(zp[0]), x2 = bf2f(zp[32]);
            if (lat) {
                const int pos = (t0 + r) & (SEQ - 1);
                const float c = rope[(size_t)2 * SEQ * 32 + pos * 32 + i], s = rope[(size_t)3 * SEQ * 32 + pos * 32 + i];
                const bf16_t o1 = f2bf(x1 * c - x2 * s), o2 = f2bf(x1 * s + x2 * c);
                zp[0] = o1; zp[32] = o2; x1 = bf2f(o1); x2 = bf2f(o2);
            }
            Ks[r * 64 + i] = x1; Ks[r * 64 + 32 + i] = x2;
        }
#pragma unroll
        for (int q = 0; q < 16; ++q) { const int idx = tid + 512 * q; const int r = idx >> 6, c = idx & 63; Vs[idx] = bf2f(Z[(size_t)(t0 + r) * INW + vc + c]); }
        __syncthreads();
        const int d = tid >> 3, e0 = (tid & 7) * 8;
        float af[8], ab[8];
#pragma unroll
        for (int j = 0; j < 8; ++j) { af[j] = 0.f; ab[j] = 0.f; }
        for (int s = 0; s < 128; ++s) {
            const float kv = Ks[s * 64 + d]; const float kfw = kv * wf[s], kbw = kv * wb[s];
            const float4 v0 = *(const float4*)(Vs + s * 64 + e0), v1 = *(const float4*)(Vs + s * 64 + e0 + 4);
            af[0] += kfw * v0.x; af[1] += kfw * v0.y; af[2] += kfw * v0.z; af[3] += kfw * v0.w; af[4] += kfw * v1.x; af[5] += kfw * v1.y; af[6] += kfw * v1.z; af[7] += kfw * v1.w;
            ab[0] += kbw * v0.x; ab[1] += kbw * v0.y; ab[2] += kbw * v0.z; ab[3] += kbw * v0.w; ab[4] += kbw * v1.x; ab[5] += kbw * v1.y; ab[6] += kbw * v1.z; ab[7] += kbw * v1.w;
        }
        const size_t so = ((size_t)(b * NCH + cidx) * 8 + h) * 4096 + d * 64 + e0;
        *(float4*)(AF + so) = make_float4(af[0], af[1], af[2], af[3]); *(float4*)(AF + so + 4) = make_float4(af[4], af[5], af[6], af[7]);
        *(float4*)(AB + so) = make_float4(ab[0], ab[1], ab[2], ab[3]); *(float4*)(AB + so + 4) = make_float4(ab[4], ab[5], ab[6], ab[7]);
    }
    __syncthreads();
}

__device__ __forceinline__ void m2_scan(const KQ p_in, int e) {
    const KQ p = lq(p_in);
    const float* __restrict__ AF = (const float*)(p.ws + WS_ST); const float* __restrict__ AB = AF + SZ_ST / 4;
    float* __restrict__ TF = (float*)(p.ws + WS_ST) + 2 * (SZ_ST / 4); float* __restrict__ TB = TF + SZ_ST / 4;
    const float* dec = pin_ld(13) + e * 16;
    for (int idx = blockIdx.x * 512 + ltid(); idx < NB * 8 * 4096; idx += gridDim.x * 512) {
        const int el = idx & 4095, h = (idx >> 12) & 7, b = idx >> 15;
        const float gf = expf(log_sigmoid(dec[h]) * 128.0f), gb = expf(log_sigmoid(dec[8 + h]) * 128.0f);
        const size_t base = ((size_t)(b * NCH) * 8 + h) * 4096 + el; constexpr size_t CS = (size_t)8 * 4096;
        float af[NCH], ab[NCH];
#pragma unroll
        for (int c = 0; c < NCH; ++c) { af[c] = AF[base + c * CS]; ab[c] = AB[base + c * CS]; }
        TF[base + 32 * CS] = 0.f; TF[base + 33 * CS] = af[32]; TB[base + 33 * CS] = 0.f; TB[base + 32 * CS] = ab[33];
        float sf = gf * af[32] + af[33], sb = ab[32] + gb * ab[33];
#pragma unroll
        for (int c = 0; c < 32; ++c) { TF[base + c * CS] = sf; sf = gf * sf + af[c]; }
#pragma unroll
        for (int c = 31; c >= 0; --c) { TB[base + c * CS] = sb; sb = ab[c] + gb * sb; }
    }
}

__device__ __forceinline__ bf16x8 pack8(const f32x4& a, const f32x4& b) {
    u32x4 w; w.x = pg8::cvt_pk_bf16(a[0], a[1]); w.y = pg8::cvt_pk_bf16(a[2], a[3]); w.z = pg8::cvt_pk_bf16(b[0], b[1]); w.w = pg8::cvt_pk_bf16(b[2], b[3]);
    return __builtin_bit_cast(bf16x8, w);
}
__device__ __forceinline__ void m3_outputs(const KQ p_in, int e, bool ctx_full, unsigned char* smem) {
    const KQ p = lq(p_in);
    const int tid = ltid(), bid = blockIdx.x, nb = gridDim.x;
    const int w = tid >> 6, lane = tid & 63, ln = lane & 15, g4 = lane >> 4;
    const bf16_t* Z = (const bf16_t*)(p.ws + WS_BIG);
    bf16_t* MIX = (bf16_t*)(p.ws + WS_MIX);
    const float* dec = pin_ld(13) + e * 16;
    const float* sink = pin_ld(12) + e * 8;
    const float* TF = (const float*)(p.ws + WS_ST) + 2 * (SZ_ST / 4); const float* TB = TF + SZ_ST / 4;
    const int nchunk = ctx_full ? NCH : 32;
    const int nitems = NB * nchunk * 8;
    bf16_t* Kt = (bf16_t*)smem;
    bf16_t* Vt = Kt + 128 * 72;
    bf16_t* TfT = Vt + 64 * 136;
    bf16_t* TbT = TfT + 64 * 72;
    const int i = 16 * w + ln;
    for (int it = bid; it < 2 * nitems; it += nb) {
        const bool is_attn = it < nitems; const int ii = is_attn ? it : it - nitems;
        const int h = ii & 7, cidx = (ii >> 3) % nchunk, b = ii / (8 * nchunk);
        const int t0 = chunk_t0(b, cidx); const bool lat = cidx < 32;
        f32x4 O[4];
#pragma unroll
        for (int m = 0; m < 4; ++m) O[m] = (f32x4){0.f, 0.f, 0.f, 0.f};
        if (!is_attn) {
            const float lgf = log_sigmoid(dec[h]), lgb = log_sigmoid(dec[8 + h]);
            __syncthreads();
#pragma unroll
            for (int q = 0; q < 2; ++q) { const int idx = tid + 512 * q; const int r = idx >> 3, pc = idx & 7; const bf16_t* zr = Z + (size_t)(t0 + r) * INW + h * 64 + pc * 8;
                *(u32x4*)(Kt + r * 72 + pc * 8) = *(const u32x4*)(zr + 1792);
                const bf16x8 vv = *(const bf16x8*)(zr + 2304);
#pragma unroll
                for (int j = 0; j < 8; ++j) Vt[(pc * 8 + j) * 136 + (r ^ (pc << 2))] = (bf16_t)vv[j]; }
            const size_t so = ((size_t)(b * NCH + cidx) * 8 + h) * 4096;
#pragma unroll
            for (int q = 0; q < 8; ++q) { const int idx = tid + 512 * q; const int d = idx >> 6, ee = idx & 63; TfT[ee * 72 + d] = f2bf(TF[so + idx]); TbT[ee * 72 + d] = f2bf(TB[so + idx]); }
            __builtin_amdgcn_sched_barrier(0);
            bf16x8 qf[2], qff[2], qfb[2];
            { const bf16_t* qr = Z + (size_t)(t0 + i) * INW + 512 + h * 64 + 8 * g4;
              const float cf = __expf(lgf * (float)(i + 1)), cb = __expf(lgb * (float)(128 - i));
#pragma unroll
              for (int k2 = 0; k2 < 2; ++k2) { qf[k2] = *(const bf16x8*)(qr + 32 * k2);
                  f32x4 a0, a1, b0, b1;
#pragma unroll
                  for (int j = 0; j < 4; ++j) { const float x0 = bf2f((bf16_t)qf[k2][j]), x1 = bf2f((bf16_t)qf[k2][4 + j]); a0[j] = x0 * cf; a1[j] = x1 * cf; b0[j] = x0 * cb; b1[j] = x1 * cb; }
                  qff[k2] = pack8(a0, a1); qfb[k2] = pack8(b0, b1); } }
            __builtin_amdgcn_sched_barrier(0);
            __syncthreads();
#pragma unroll
            for (int m = 0; m < 4; ++m)
#pragma unroll
                for (int k2 = 0; k2 < 2; ++k2) {
                    const bf16x8 af = *(const bf16x8*)(TfT + (16 * m + ln) * 72 + 32 * k2 + 8 * g4);
                    const bf16x8 ab = *(const bf16x8*)(TbT + (16 * m + ln) * 72 + 32 * k2 + 8 * g4);
                    O[m] = __builtin_amdgcn_mfma_f32_16x16x32_bf16(af, qff[k2], O[m], 0, 0, 0);
                    O[m] = __builtin_amdgcn_mfma_f32_16x16x32_bf16(ab, qfb[k2], O[m], 0, 0, 0);
                    __builtin_amdgcn_sched_barrier(0);
                }
            const float lf2 = lgf * 1.44269504f, lb2 = lgb * 1.44269504f; const int di = i - 4 * g4;
            const float bfw = lf2 * (float)di, bbw = -lb2 * (float)di;
            f32x4 st[8];
#pragma unroll
            for (int mt = 0; mt < 8; ++mt) {
                f32x4 a = (f32x4){0.f, 0.f, 0.f, 0.f};
#pragma unroll
                for (int k2 = 0; k2 < 2; ++k2) { const bf16x8 kf = *(const bf16x8*)(Kt + (16 * mt + ln) * 72 + 32 * k2 + 8 * g4); a = __builtin_amdgcn_mfma_f32_16x16x32_bf16(kf, qf[k2], a, 0, 0, 0); }
#pragma unroll
                for (int rg = 0; rg < 4; ++rg) { const int cc = 16 * mt + rg; const int df = di - cc;
                    const float arg = (df > 0) ? fmaf(-lf2, (float)cc, bfw) : fmaf(lb2, (float)cc, bbw);
                    float wgt = __builtin_amdgcn_exp2f(arg); wgt = (df == 0) ? 2.0f : wgt;
                    a[rg] *= wgt; }
                st[mt] = a;
                __builtin_amdgcn_sched_barrier(0);
            }
#pragma unroll
            for (int ks = 0; ks < 4; ++ks) {
                const bf16x8 pfr = pack8(st[2 * ks], st[2 * ks + 1]);
#pragma unroll
                for (int m = 0; m < 4; ++m) {
                    const int vrow = 16 * m + ln; const int kx = (32 * ks + 4 * g4) ^ (((vrow >> 3) & 7) << 2);
                    const bf16_t* vr = Vt + vrow * 136;
                    const bf16x4 v0 = *(const bf16x4*)(vr + kx), v1 = *(const bf16x4*)(vr + (kx ^ 16));
                    const bf16x8 vf = __builtin_shufflevector(v0, v1, 0, 1, 2, 3, 4, 5, 6, 7);
                    O[m] = __builtin_amdgcn_mfma_f32_16x16x32_bf16(vf, pfr, O[m], 0, 0, 0);
                }
                __builtin_amdgcn_sched_barrier(0);
            }
            float ss = 0.f;
#pragma unroll
            for (int m = 0; m < 4; ++m)
#pragma unroll
                for (int rg = 0; rg < 4; ++rg) ss += O[m][rg] * O[m][rg];
            ss += __shfl_xor(ss, 16, 64); ss += __shfl_xor(ss, 32, 64);
            const float rn = rsqrtf(ss * (1.0f / 64.0f) + EPS);
#pragma unroll
            for (int m = 0; m < 4; ++m) {
                const int ee = 16 * m + 4 * g4;
                const bf16x4 gv = *(const bf16x4*)(Z + (size_t)(t0 + i) * INW + 1024 + h * 64 + ee);
                uint2 o2; o2.x = pg8::cvt_pk_bf16(O[m][0] * rn * silu_f(bf2f((bf16_t)gv[0])), O[m][1] * rn * silu_f(bf2f((bf16_t)gv[1])));
                o2.y = pg8::cvt_pk_bf16(O[m][2] * rn * silu_f(bf2f((bf16_t)gv[2])), O[m][3] * rn * silu_f(bf2f((bf16_t)gv[3])));
                *(uint2*)(MIX + (size_t)(t0 + i) * D + 512 + h * 64 + ee) = o2;
            }
        } else {
            const int gk = h >> 2;
            bf16x8 qf[2];
            { const bf16_t* qr = Z + (size_t)(t0 + i) * INW + h * 64 + 8 * g4; qf[0] = *(const bf16x8*)qr; qf[1] = *(const bf16x8*)(qr + 32); }
            float mx = sink[h], l = (g4 == 0) ? 1.0f : 0.0f;
            const int qpos = lat ? (cidx * 128 + i) : 0;
#define ATT_VALID(tl_) ((tl_) >= 3 || (lat && (cidx - 1 + (tl_)) >= 0 && (cidx - 1 + (tl_)) < 32))
#define ATT_KT0(tl_) ((tl_) >= 3 ? TL + b * CL + ((tl_) - 3) * 128 : b * SEQ + (cidx - 1 + (tl_)) * 128)
            int tl = 0; while (!ATT_VALID(tl)) ++tl;
            u32x4 kreg[2]; bf16x8 vreg[2];
            { const int kt0 = ATT_KT0(tl);
#pragma unroll
              for (int q = 0; q < 2; ++q) { const int idx = tid + 512 * q; const int r = idx >> 3, pc = idx & 7; const bf16_t* zr = Z + (size_t)(kt0 + r) * INW + gk * 64 + pc * 8;
                  kreg[q] = *(const u32x4*)(zr + 1536); vreg[q] = *(const bf16x8*)(zr + 1664); } }
            while (tl < 5) {
                const bool isc = tl >= 3; const int kp0 = isc ? 0 : (cidx - 1 + tl) * 128;
                __syncthreads();
#pragma unroll
                for (int q = 0; q < 2; ++q) { const int idx = tid + 512 * q; const int r = idx >> 3, pc = idx & 7;
                    *(u32x4*)(Kt + r * 72 + pc * 8) = kreg[q];
#pragma unroll
                    for (int j = 0; j < 8; ++j) Vt[(pc * 8 + j) * 136 + (r ^ (pc << 2))] = (bf16_t)vreg[q][j]; }
                __syncthreads();
                int tn = tl + 1; while (tn < 5 && !ATT_VALID(tn)) ++tn;
                if (tn < 5) { const int kt0 = ATT_KT0(tn);
#pragma unroll
                    for (int q = 0; q < 2; ++q) { const int idx = tid + 512 * q; const int r = idx >> 3, pc = idx & 7; const bf16_t* zr = Z + (size_t)(kt0 + r) * INW + gk * 64 + pc * 8;
                        kreg[q] = *(const u32x4*)(zr + 1536); vreg[q] = *(const bf16x8*)(zr + 1664); } }
                f32x4 st[8];
                float mloc = -1e30f;
#pragma unroll
                for (int mt = 0; mt < 8; ++mt) {
                    f32x4 a = (f32x4){0.f, 0.f, 0.f, 0.f};
#pragma unroll
                    for (int k2 = 0; k2 < 2; ++k2) { const bf16x8 kf = *(const bf16x8*)(Kt + (16 * mt + ln) * 72 + 32 * k2 + 8 * g4); a = __builtin_amdgcn_mfma_f32_16x16x32_bf16(kf, qf[k2], a, 0, 0, 0); }
                    if (!isc) {
#pragma unroll
                        for (int rg = 0; rg < 4; ++rg) { const int dd = qpos - (kp0 + 16 * mt + 4 * g4 + rg); if (dd > 128 || dd < -128) a[rg] = -1e30f; }
                    }
#pragma unroll
                    for (int rg = 0; rg < 4; ++rg) mloc = fmaxf(mloc, a[rg]);
                    st[mt] = a;
                    __builtin_amdgcn_sched_barrier(0);
                }
                mloc = fmaxf(mloc, __shfl_xor(mloc, 16, 64)); mloc = fmaxf(mloc, __shfl_xor(mloc, 32, 64));
                const float mnew = fmaxf(mx, mloc);
                const float sc = __expf(mx - mnew); mx = mnew; l *= sc;
#pragma unroll
                for (int m = 0; m < 4; ++m) O[m] *= sc;
#pragma unroll
                for (int mt = 0; mt < 8; ++mt)
#pragma unroll
                    for (int rg = 0; rg < 4; ++rg) { const float pv = __expf(st[mt][rg] - mnew); st[mt][rg] = pv; l += pv; }
#pragma unroll
                for (int ks = 0; ks < 4; ++ks) {
                    const bf16x8 pfr = pack8(st[2 * ks], st[2 * ks + 1]);
#pragma unroll
                    for (int m = 0; m < 4; ++m) {
                        const int vrow = 16 * m + ln; const int kx = (32 * ks + 4 * g4) ^ (((vrow >> 3) & 7) << 2);
                        const bf16_t* vr = Vt + vrow * 136;
                        const bf16x4 v0 = *(const bf16x4*)(vr + kx), v1 = *(const bf16x4*)(vr + (kx ^ 16));
                        const bf16x8 vf = __builtin_shufflevector(v0, v1, 0, 1, 2, 3, 4, 5, 6, 7);
                        O[m] = __builtin_amdgcn_mfma_f32_16x16x32_bf16(vf, pfr, O[m], 0, 0, 0);
                    }
                    __builtin_amdgcn_sched_barrier(0);
                }
                tl = tn;
            }
#undef ATT_VALID
#undef ATT_KT0
            l += __shfl_xor(l, 16, 64); l += __shfl_xor(l, 32, 64);
            const float inv = 1.0f / l;
#pragma unroll
            for (int m = 0; m < 4; ++m) {
                uint2 o2; o2.x = pg8::cvt_pk_bf16(O[m][0] * inv, O[m][1] * inv); o2.y = pg8::cvt_pk_bf16(O[m][2] * inv, O[m][3] * inv);
                *(uint2*)(MIX + (size_t)(t0 + i) * D + h * 64 + 16 * m + 4 * g4) = o2;
            }
        }
    }
    __syncthreads();
}

__device__ __forceinline__ void h2_shortconv(const KQ p_in, int o, int M, unsigned char* smem) {
    const KQ p = lq(p_in);
    const int tid = ltid();
    const bf16_t* ZH = (const bf16_t*)(p.ws + WS_BIG);
    const float* w = pin_ld(17) + (size_t)o * 3 * HYW; const float* bs = pin_ld(18) + (size_t)o * HYW;
    bf16_t* VXT = (bf16_t*)(p.ws + WS_Y); bf16_t* X0T = VXT + (size_t)D * TL;
    bf16_t* tx = (bf16_t*)smem;
    bf16_t* tv = tx + 64 * 136;
    const int tok = tid >> 3, cg8 = (tid & 7) * 8;
    float* wl = (float*)(smem + 40960);
    { const int c0b = (blockIdx.x & 15) * 64;
      for (int i = tid; i < 768; i += 512) { const int k = i >> 8, q = (i >> 6) & 3, c = i & 63; const int col = k * 1024 + c0b + c; wl[i] = (q < 3) ? w[q * HYW + col] : bs[col]; } }
    __syncthreads();
    for (int it = blockIdx.x; it < (TL / 128) * 16; it += gridDim.x) {
        const int c0 = (it & 15) * 64, t0 = (it >> 4) * 128;
        bf16x8 zc[2][3], zp[2][3], zn[2][3];
#pragma unroll
        for (int g = 0; g < 2; ++g) {
            const int t = t0 + tok + 64 * g; const int pos = t & (SEQ - 1); const bool first = pos == 0, last = pos == SEQ - 1;
#pragma unroll
            for (int k = 0; k < 3; ++k) {
                const int c = k * 1024 + c0 + cg8;
                zc[g][k] = *(const bf16x8*)(ZH + (size_t)t * HYW + c);
                zp[g][k] = *(const bf16x8*)(ZH + (size_t)(first ? t : t - 1) * HYW + c);
                zn[g][k] = *(const bf16x8*)(ZH + (size_t)(last ? t : t + 1) * HYW + c);
            }
        }
        __syncthreads();
#pragma unroll
        for (int g = 0; g < 2; ++g) {
            const int t = t0 + tok + 64 * g; const int pos = t & (SEQ - 1); const float mf = (pos == 0) ? 0.f : 1.f, ml = (pos == SEQ - 1) ? 0.f : 1.f;
            float zz[3][8];
#pragma unroll
            for (int k = 0; k < 3; ++k) {
                const float* wk = wl + k * 256 + cg8;
#pragma unroll
                for (int j = 0; j < 8; ++j)
                    zz[k][j] = wk[192 + j] + bf2f((bf16_t)zc[g][k][j]) * wk[64 + j] + mf * bf2f((bf16_t)zp[g][k][j]) * wk[j] + ml * bf2f((bf16_t)zn[g][k][j]) * wk[128 + j];
            }
#pragma unroll
            for (int j = 0; j < 8; ++j) { const int cs = (tok + 64 * g) ^ ((tid & 7) << 3);
                tx[(cg8 + j) * 136 + cs] = f2bf(zz[0][j]); tv[(cg8 + j) * 136 + cs] = f2bf(zz[2][j] * zz[1][j]); }
        }
        __syncthreads();
        { const int ch = tid >> 3, tk = (tid & 7) * 8;
#pragma unroll
          for (int q = 0; q < 2; ++q) {
            const int cs = (tk + 64 * q) ^ (((ch >> 3) & 7) << 3);
            *(u32x4*)(X0T + (size_t)(c0 + ch) * TL + t0 + tk + 64 * q) = *(const u32x4*)(tx + ch * 136 + cs);
            *(u32x4*)(VXT + (size_t)(c0 + ch) * TL + t0 + tk + 64 * q) = *(const u32x4*)(tv + ch * 136 + cs); } }
    }
    __syncthreads();
    if (M > TL) {
        float* VX = (float*)(p.ws + WS_Y); bf16_t* X0 = (bf16_t*)(p.ws + WS_H);
        for (int idx = TL * D + blockIdx.x * 512 + tid; idx < M * D; idx += gridDim.x * 512) {
            const int t = idx >> 10, d = idx & 1023;
            const int pos = (t - TL) & (CL - 1); const bool first = pos == 0, last = pos == CL - 1;
            float zz[3];
#pragma unroll
            for (int k = 0; k < 3; ++k) {
                const int c = k * 1024 + d;
                float sacc = bs[c] + bf2f(ZH[(size_t)t * HYW + c]) * w[HYW + c];
                if (!first) sacc += bf2f(ZH[(size_t)(t - 1) * HYW + c]) * w[c];
                if (!last) sacc += bf2f(ZH[(size_t)(t + 1) * HYW + c]) * w[2 * HYW + c];
                zz[k] = sacc;
            }
            VX[idx] = zz[2] * zz[1]; X0[idx] = f2bf(zz[0]);
        }
    }
}

typedef float f32x16 __attribute__((ext_vector_type(16)));
__device__ __forceinline__ void h3_longconv(const KQ p_in, int o, bool ctx_full, unsigned char* smem) {
    const KQ p = lq(p_in);
    const int tid = ltid(), w = tid >> 6, lane = tid & 63;
    const float* bias = pin_ld(27) + (size_t)o * D;
    {
        const bf16_t* VXT = (const bf16_t*)(p.ws + WS_Y); const bf16_t* X0T = VXT + (size_t)D * TL;
        bf16_t* HMT = (bf16_t*)(p.ws + WS_H);
        const bf16_t* RKT = (const bf16_t*)(p.ws + WS_KF + (size_t)o * SZ_KF);
        constexpr int RK2_OFF = 16384 + 64, U_OFF = 2 * 16384 + 128, CH_BYTES = U_OFF + 142 * 256;
        const int cw = w >> 2, w4 = w & 3;
        const int ct = tid & 255;
        unsigned char* cb = smem + cw * CH_BYTES;
        unsigned char* ub = cb + U_OFF;
        const int r = lane & 31, hh = lane >> 5;
        for (int pr = blockIdx.x; pr < D / 2; pr += gridDim.x) {
            const int d = pr * 2 + cw;
            __syncthreads();
            { const bf16_t* src = RKT + (size_t)d * 8192;
              for (int i = ct; i < 1024; i += 256) *(u32x4*)(cb + i * 16) = *(const u32x4*)(src + i * 8);
              for (int i = ct; i < 2 * 7 * 4 * 4; i += 256) { const int side = i / 112, rem = i % 112; unsigned z0 = 0u; asm volatile("" : "+v"(z0)); *(u32x4*)(ub + (side ? (135 * 4 * 64) : 0) + rem * 16) = (u32x4){z0, z0, z0, z0}; }
#pragma unroll 8
              for (int i = ct; i < 4 * 512; i += 256) { const int b = i >> 9, pc = i & 511;
                  const u32x4 v = *(const u32x4*)(VXT + (size_t)d * TL + b * SEQ + pc * 8);
                  const int col = ((pc >> 2) + 7) * 4 + b, q = pc & 3;
                  *(u32x4*)(ub + col * 64 + ((q ^ ((col >> 2) & 3)) * 16)) = v; } }
            __syncthreads();
            { const bf16_t* rk = (const bf16_t*)cb; bf16_t* rk2 = (bf16_t*)(cb + RK2_OFF);
#pragma unroll 4
              for (int i = ct; i < 4096; i += 256) { const unsigned lo = rk[2 * i + 1]; const unsigned hi = (2 * i + 2 < 8192) ? rk[2 * i + 2] : 0u; *(unsigned*)(rk2 + 2 * i) = lo | (hi << 16); } }
            __syncthreads();
            f32x16 acc[4];
#pragma unroll
            for (int j = 0; j < 4; ++j)
#pragma unroll
                for (int q = 0; q < 16; ++q) acc[j][q] = 0.f;
            const bf16_t* rsel = (const bf16_t*)(cb + ((r & 1) ? 0 : RK2_OFF));
            const int adj = (r & 1) ? 0 : -1;
            const int bq = r & 3;
#define H3_LOAD(AF, BF, U) do { \
                _Pragma("unroll") for (int s2 = 0; s2 < 2; ++s2) { \
                    const unsigned* ap = (const unsigned*)(Ab + 64 * (3 - (U)) + 32 * s2); \
                    u32x4 t4; t4.x = ap[0]; t4.y = ap[1]; t4.z = ap[2]; t4.w = ap[3]; \
                    AF[s2] = __builtin_bit_cast(bf16x8, t4); } \
                _Pragma("unroll") for (int j = 0; j < 4; ++j) { \
                    int c_ = Lb - 256 * (U) + 2048 * j; c_ = c_ < LO ? LO : (c_ > HI ? HI : c_); \
                    BF[j][0] = *(const bf16x8*)(ub + c_ + off[U][0]); BF[j][1] = *(const bf16x8*)(ub + c_ + off[U][1]); } } while (0)
#define H3_MMA(AF, BF) do { \
                _Pragma("unroll") for (int s2 = 0; s2 < 2; ++s2) \
                _Pragma("unroll") for (int j = 0; j < 4; ++j) acc[j] = __builtin_amdgcn_mfma_f32_32x32x16_bf16(AF[s2], BF[j][s2], acc[j], 0, 0, 0); } while (0)
            {
                const int dlo = 32 * w4 - 127;
                const int LO = (24 + bq) * 64, HI = (540 + bq) * 64;
                int off[4][2];
#pragma unroll
                for (int u = 0; u < 4; ++u) { const int sw = ((r >> 2) + 2 - u) & 3; off[u][0] = (hh ^ sw) * 16; off[u][1] = ((2 + hh) ^ sw) * 16; }
                int Lb = (((r >> 2) + 134) * 4 + bq) * 64;
                const unsigned char* Ab = (const unsigned char*)(rsel + (4095 - 32 * dlo - r + 8 * hh + adj)) - 192;
                bf16x8 afA[2], bfA[4][2], afB[2], bfB[4][2];
                H3_LOAD(afA, bfA, 0);
                for (int g = 0; g < 39; ++g) {
                    H3_LOAD(afB, bfB, 1);
                    __builtin_amdgcn_sched_barrier(0);
                    H3_MMA(afA, bfA);
                    __builtin_amdgcn_sched_barrier(0);
                    H3_LOAD(afA, bfA, 2);
                    __builtin_amdgcn_sched_barrier(0);
                    H3_MMA(afB, bfB);
                    __builtin_amdgcn_sched_barrier(0);
                    H3_LOAD(afB, bfB, 3);
                    __builtin_amdgcn_sched_barrier(0);
                    H3_MMA(afA, bfA);
                    __builtin_amdgcn_sched_barrier(0);
                    Ab -= 256; Lb -= 1024;
                    H3_LOAD(afA, bfA, 0);
                    __builtin_amdgcn_sched_barrier(0);
                    H3_MMA(afB, bfB);
                    __builtin_amdgcn_sched_barrier(0);
                }
                H3_LOAD(afB, bfB, 1);
                __builtin_amdgcn_sched_barrier(0);
                H3_MMA(afA, bfA);
                __builtin_amdgcn_sched_barrier(0);
                H3_LOAD(afA, bfA, 2);
                __builtin_amdgcn_sched_barrier(0);
                H3_MMA(afB, bfB);
                H3_MMA(afA, bfA);
            }
#undef H3_LOAD
#undef H3_MMA
            __syncthreads();
            const float bd = bias[d];
#pragma unroll
            for (int j = 0; j < 4; ++j) {
                const int n1 = 8 * (4 * w4 + j) + (r >> 2);
                const int col = (n1 + 7) * 4 + bq; const int sw = (col >> 2) & 3;
                bf16_t* up = (bf16_t*)(ub + col * 64);
#pragma unroll
                for (int q4 = 0; q4 < 4; ++q4) {
                    bf16_t* pp = up + ((q4 ^ sw) * 8) + 4 * hh;
                    const bf16x4 uv = *(const bf16x4*)pp;
                    uint2 o2; o2.x = pg8::cvt_pk_bf16(acc[j][4 * q4] + bd * bf2f((bf16_t)uv[0]), acc[j][4 * q4 + 1] + bd * bf2f((bf16_t)uv[1]));
                    o2.y = pg8::cvt_pk_bf16(acc[j][4 * q4 + 2] + bd * bf2f((bf16_t)uv[2]), acc[j][4 * q4 + 3] + bd * bf2f((bf16_t)uv[3]));
                    *(uint2*)pp = o2;
                }
            }
            __syncthreads();
#pragma unroll 4
            for (int i = ct; i < 4 * 512; i += 256) { const int b = i >> 9, pc = i & 511;
                const int col = ((pc >> 2) + 7) * 4 + b, q = pc & 3;
                const bf16x8 yv = *(const bf16x8*)(ub + col * 64 + ((q ^ ((col >> 2) & 3)) * 16));
                const size_t gi = (size_t)d * TL + b * SEQ + pc * 8;
                const bf16x8 xv = *(const bf16x8*)(X0T + gi);
                u32x4 o4;
                o4.x = pg8::cvt_pk_bf16(bf2f((bf16_t)yv[0]) * bf2f((bf16_t)xv[0]), bf2f((bf16_t)yv[1]) * bf2f((bf16_t)xv[1]));
                o4.y = pg8::cvt_pk_bf16(bf2f((bf16_t)yv[2]) * bf2f((bf16_t)xv[2]), bf2f((bf16_t)yv[3]) * bf2f((bf16_t)xv[3]));
                o4.z = pg8::cvt_pk_bf16(bf2f((bf16_t)yv[4]) * bf2f((bf16_t)xv[4]), bf2f((bf16_t)yv[5]) * bf2f((bf16_t)xv[5]));
                o4.w = pg8::cvt_pk_bf16(bf2f((bf16_t)yv[6]) * bf2f((bf16_t)xv[6]), bf2f((bf16_t)yv[7]) * bf2f((bf16_t)xv[7]));
                *(u32x4*)(HMT + gi) = o4; }
        }
        __syncthreads();
    }
    if (ctx_full) {
        const float* VX = (const float*)(p.ws + WS_Y); const bf16_t* X0 = (const bf16_t*)(p.ws + WS_H);
        bf16_t* MIX = (bf16_t*)(p.ws + WS_MIX);
        const float* kf = (const float*)(p.ws + WS_KF + (size_t)o * SZ_KF) + (size_t)2 * SEQ * D;
        for (int idx = blockIdx.x * 512 + tid; idx < (TC / 8) * D; idx += gridDim.x * 512) {
            const int d = idx & 1023, og = idx >> 10;
            const int bb = og >> 5, n0 = (og & 31) * 8, tb = TL + bb * CL;
            const float* up = VX + (size_t)tb * D + d;
            float acc[8];
#pragma unroll
            for (int j = 0; j < 8; ++j) acc[j] = 0.f;
#pragma unroll 1
            for (int mb = 0; mb < CL; mb += 8) {
                float kk[15], uu[8];
#pragma unroll
                for (int q = 0; q < 15; ++q) { const int lag = n0 - mb - 7 + q;
                    kk[q] = (lag >= 0) ? ((lag < CL) ? kf[(size_t)lag * D + d] : 0.f) : ((-lag < CL) ? kf[(size_t)(CL - lag) * D + d] : 0.f); }
#pragma unroll
                for (int u = 0; u < 8; ++u) uu[u] = up[(size_t)(mb + u) * D];
#pragma unroll
                for (int u = 0; u < 8; ++u)
#pragma unroll
                    for (int j = 0; j < 8; ++j) acc[j] += uu[u] * kk[7 - u + j];
            }
            const float bd = bias[d];
#pragma unroll
            for (int j = 0; j < 8; ++j) { const size_t ti = (size_t)(tb + n0 + j) * D + d; MIX[ti] = f2bf(bf2f(X0[ti]) * (acc[j] + bd * VX[ti])); }
        }
    }
}

__device__ __forceinline__ void h3b_transpose(const KQ p_in, unsigned char* smem) {
    const KQ p = lq(p_in);
    const int tid = ltid();
    const bf16_t* HMT = (const bf16_t*)(p.ws + WS_H); bf16_t* MIX = (bf16_t*)(p.ws + WS_MIX);
    bf16_t* tile = (bf16_t*)smem;
    for (int it = blockIdx.x; it < (TL / 256) * 16; it += gridDim.x) {
        const int c0 = (it & 15) * 64, t0 = (it >> 4) * 256;
        u32x4 ld[4];
        { const int ch = tid >> 3, tk = (tid & 7) * 8;
#pragma unroll
          for (int q = 0; q < 4; ++q) ld[q] = *(const u32x4*)(HMT + (size_t)(c0 + ch) * TL + t0 + tk + 64 * q);
          __syncthreads();
#pragma unroll
          for (int q = 0; q < 4; ++q) *(u32x4*)(tile + ch * 264 + ((tk + 64 * q) ^ (((ch >> 3) & 7) << 3))) = ld[q]; }
        __syncthreads();
        { const int cg8 = (tid & 7) * 8;
#pragma unroll
          for (int q = 0; q < 4; ++q) { const int tok = (tid >> 3) + 64 * q; unsigned short v[8];
#pragma unroll
              for (int j = 0; j < 8; ++j) v[j] = tile[(cg8 + j) * 264 + (tok ^ ((tid & 7) << 3))];
              u32x4 o4; o4.x = v[0] | ((unsigned)v[1] << 16); o4.y = v[2] | ((unsigned)v[3] << 16); o4.z = v[4] | ((unsigned)v[5] << 16); o4.w = v[6] | ((unsigned)v[7] << 16);
              *(u32x4*)(MIX + (size_t)(t0 + tok) * D + c0 + cg8) = o4; } }
    }
    __syncthreads();
}

__global__ void __launch_bounds__(512, 2) mega_fwd(KP kp) {
    unsigned char* const smem = g_smem;
    if (threadIdx.x < 29) *(LAS unsigned long long*)((LAS unsigned char*)g_smem + PTAB_OFF + 8 * threadIdx.x) = ((const unsigned long long*)__builtin_amdgcn_kernarg_segment_ptr())[threadIdx.x];
    KQ p; p.out = kp.out; p.ws = kp.ws;
    cg::grid_group grid = cg::this_grid();
    if (threadIdx.x < 4) ((volatile LAS unsigned*)(LAS unsigned char*)smem)[(LDS_BYTES - 16) / 4 + threadIdx.x] = 0u;
    __syncthreads();
    if (threadIdx.x == 0) (void)xb_add(&((unsigned*)(lq(p).ws + WS_BAR))[XB_XCNT(xb_xcc_id())], 1u);
    grid.sync();
    float* smf = (float*)smem;
#define Hb ((bf16_t*)(lq(p).ws + WS_H))
#define BIG ((bf16_t*)(lq(p).ws + WS_BIG))
#define Y ((bf16_t*)(lq(p).ws + WS_Y))
#define MIX ((bf16_t*)(lq(p).ws + WS_MIX))

#ifndef NO_P0
    p0_setup(p, smf);
#endif
    GRID_BAR();
    rowphase(p, 0, nullptr, 0, 0, 0.f, nullptr, T, 0, pin_ld(6), 0, 1, Hb, true, 0);
    GRID_BAR();
    for (int l = 0; l < 4; ++l) {
        const bool ctx_live = l <= 2, ctx_full = l < 2;
        const int Mff = ctx_live ? T : TL, Mpost = ctx_full ? T : TL;
        for (int sub = 0; sub < 3; ++sub) {
            const bf16_t* Ao; const bf16_t* Bo; int Ko; int Mo;
            if (sub != 1) {
                const int fi = sub >> 1; const int M = (sub == 0) ? Mff : Mpost;
                { pg8::EpiSwiGLU E{BIG, DFF}; run_gemm(smem, Hb, (const bf16_t*)(lq(p).ws + WS_WGU + (size_t)(l * 2 + fi) * SZ_WGU), M, 2 * DFF, D, E); }
                GRID_BAR();
                Ao = BIG; Bo = (const bf16_t*)(lq(p).ws + WS_WD + (size_t)(l * 2 + fi) * SZ_WD); Ko = DFF; Mo = M;
            } else {
                if ((l & 1) == 0) {
                    const int e = l >> 1;
                    { pg8::EpiBf16 E{BIG, INW, nullptr}; run_gemm(smem, Hb, (const bf16_t*)(lq(p).ws + WS_WIN + (size_t)e * SZ_WIN), Mff, INW, D, E); }
                    GRID_BAR();
#ifndef NO_M1
                    m1_rope_states(p, e, smf);
#endif
                    GRID_BAR();
#ifndef NO_M2
                    m2_scan(p, e);
#endif
                    GRID_BAR();
#ifndef NO_M3
                    m3_outputs(p, e, ctx_full, smem);
#endif
                    GRID_BAR();
                    Bo = (const bf16_t*)(lq(p).ws + WS_WOUT + (size_t)e * SZ_WOUT);
                } else {
                    const int o = l >> 1;
                    { pg8::EpiBf16 E{BIG, HYW, pin_ld(16) + (size_t)o * HYW}; run_gemm(smem, Hb, (const bf16_t*)(lq(p).ws + WS_HWIN + (size_t)o * SZ_HWIN), Mpost, HYW, D, E); }
                    GRID_BAR();
#ifndef NO_H2
                    h2_shortconv(p, o, Mpost, smem);
#endif
                    GRID_BAR();
#ifndef NO_H3
                    h3_longconv(p, o, ctx_full, smem);
#endif
                    GRID_BAR();
                    h3b_transpose(p, smem);
                    GRID_BAR();
                    Bo = (const bf16_t*)(lq(p).ws + WS_HWOUT + (size_t)o * SZ_WOUT);
                }
                Ao = MIX; Ko = D; Mo = Mpost;
            }
            const int gidx = 2 + 3 * sub;
            const int ln = (sub == 2) ? l + 1 : l; const bool has_next = ln < 4; const int lnn = has_next ? ln : l;
            const int pre_i = (sub == 2) ? 0 : sub + 1;
            const int Mn = has_next ? ((sub == 2) ? ((ln <= 2) ? T : TL) : ((sub == 0) ? Mff : Mpost)) : 0;
            const float* gpost = pin_ld(7) + (size_t)(l * 3 + sub) * D; const float* gpre = pin_ld(6) + (size_t)(lnn * 3 + pre_i) * D;
            const float wg = (sub == 1) ? 1.0f : 0.5f;
            {
                pg8::EpiFusedRow EF;
                EF.xin = (l == 0 && sub == 0) ? pin_ld(0) : (const float*)lq(p).out; EF.xout = lq(p).out; EF.H = has_next ? Hb : nullptr;
                EF.gate = modp(lq(p), l, 0, gidx); EF.gpost = gpost; EF.wgt = wg;
                EF.gpre = gpre; EF.shift = modp(lq(p), lnn, 0, 3 * pre_i); EF.scale = modp(lq(p), lnn, 0, 3 * pre_i + 1);
                EF.slots = (float*)(lq(p).ws + WS_SLOT); EF.cnt = (unsigned*)(lq(p).ws + WS_CNT) + (size_t)(l * 3 + sub) * 2 * 64 * 64;
                run_gemm_f32_split(smem, Ao, Bo, Mo, Ko, EF, (float*)(lq(p).ws + WS_YP));
            }
            if (Mo > TL && blockIdx.x < 64) {
                sub_barrier((unsigned*)(lq(p).ws + WS_CNT) + (size_t)12 * 2 * 64 * 64 + (l * 3 + sub) * 64, 64u);
                rowphase(p, Mo, Y, l, gidx, wg, gpost, Mn, lnn, gpre, 3 * pre_i, 3 * pre_i + 1, has_next ? Hb : nullptr, l == 0 && sub == 0, TL);
            }
            GRID_BAR();
        }
    }
}

extern "C" void kernel_launch(void* const* d_in, const int* in_sizes, int n_in, void* d_out, int out_size, void* d_ws, size_t ws_size, hipStream_t stream) {
    static int grid = 0;
    if (grid == 0) {
        if (n_in != 29 || out_size != TL * D || ws_size < WS_END) { fprintf(stderr, "kernel_launch: unexpected shapes: n_in %d out %d ws %zu (need %zu)\n", n_in, out_size, ws_size, (size_t)WS_END); grid = -1; return; }
        int dev = 0, cus = 0, per_cu = 0;
        (void)hipGetDevice(&dev);
        (void)hipDeviceGetAttribute(&cus, hipDeviceAttributeMultiprocessorCount, dev);
        if (hipFuncSetAttribute((const void*)mega_fwd, hipFuncAttributeMaxDynamicSharedMemorySize, LDS_BYTES) != hipSuccess) { fprintf(stderr, "kernel_launch: hipFuncSetAttribute failed\n"); grid = -1; return; }
        if (hipOccupancyMaxActiveBlocksPerMultiprocessor(&per_cu, (const void*)mega_fwd, 512, LDS_BYTES) != hipSuccess || per_cu < 1) { fprintf(stderr, "kernel_launch: occupancy query says %d\n", per_cu); per_cu = 1; }
        (void)hipGetLastError();
        grid = cus >= 256 ? 256 : cus;
    }
    if (grid < 0) return;
    (void)hipMemsetAsync((unsigned char*)d_ws + WS_BAR, 0, 16384 + SZ_CNT, stream);
    KP kp{};
    for (int i = 0; i < 29; ++i) kp.in[i] = (const float*)d_in[i];
    kp.out = (float*)d_out; kp.ws = (unsigned char*)d_ws;
    void* args[] = {&kp};
    hipError_t e = hipLaunchCooperativeKernel((const void*)mega_fwd, dim3(grid), dim3(512), args, LDS_BYTES, stream);
    if (e != hipSuccess) fprintf(stderr, "cooperative launch failed: %s (grid %d)\n", hipGetErrorString(e), grid);
}
```

```cpp
#include <hip/hip_runtime.h>
#include <hip/hip_cooperative_groups.h>
#include <cstdio>
namespace cg = cooperative_groups;

#define LAS __attribute__((address_space(3)))
typedef unsigned short bf16_t;
typedef short bf16x8 __attribute__((ext_vector_type(8)));
typedef short bf16x4 __attribute__((ext_vector_type(4)));
typedef float f32x4 __attribute__((ext_vector_type(4)));
typedef unsigned u32x4 __attribute__((ext_vector_type(4)));

constexpr int D = 1024, NB = 4, SEQ = 4096, CL = 256, TL = NB * SEQ, TC = NB * CL, T = TL + TC, DFF = 2816, INW = 2816, HYW = 3072;
constexpr int NMOD = 9;
constexpr float EPS = 1e-6f;
constexpr int NCH = 34;
constexpr int LDS_BYTES = 144 * 1024;

constexpr size_t SZ_WGU = (size_t)2 * DFF * D * 2, SZ_WD = (size_t)D * DFF * 2, SZ_WIN = (size_t)INW * D * 2, SZ_WOUT = (size_t)D * D * 2, SZ_HWIN = (size_t)HYW * D * 2;
constexpr size_t WS_WGU = 0;
constexpr size_t WS_WD = WS_WGU + 8 * SZ_WGU;
constexpr size_t WS_WIN = WS_WD + 8 * SZ_WD;
constexpr size_t WS_WOUT = WS_WIN + 2 * SZ_WIN;
constexpr size_t WS_HWIN = WS_WOUT + 2 * SZ_WOUT;
constexpr size_t WS_HWOUT = WS_HWIN + 2 * SZ_HWIN;
constexpr size_t WS_MOD = WS_HWOUT + 2 * SZ_WOUT;
constexpr size_t WS_ROPE = WS_MOD + (size_t)4 * 5 * NMOD * D * 4;
constexpr size_t WS_XC = WS_ROPE + (size_t)4 * SEQ * 32 * 4;
constexpr size_t WS_H = WS_XC + (size_t)TC * D * 4;
constexpr size_t WS_BIG = WS_H + (size_t)T * D * 2;
constexpr size_t WS_Y = WS_BIG + (size_t)T * HYW * 2;
constexpr size_t WS_MIX = WS_Y + (size_t)T * D * 4;
constexpr size_t SZ_ST = (size_t)NB * NCH * 8 * 4096 * 4;
constexpr size_t WS_ST = WS_MIX + (size_t)T * D * 2;
constexpr size_t SZ_KF = (size_t)(SEQ + CL) * 2 * D * 4;
constexpr size_t WS_KF = WS_ST + 4 * SZ_ST;
constexpr size_t WS_YP = WS_KF + 2 * SZ_KF;
constexpr size_t WS_BAR = WS_YP + (size_t)4 * TC * D * 4;
constexpr size_t WS_CNT = WS_BAR + 16384;
constexpr size_t SZ_CNT = (size_t)12 * 2 * 64 * 256 + 12 * 256;
constexpr size_t WS_SLOT = WS_CNT + SZ_CNT;
constexpr size_t WS_END = WS_SLOT + (size_t)2 * TL * 4 * 4;

struct KP { const float* in[29]; float* out; unsigned char* ws; };
extern __shared__ __attribute__((aligned(16))) unsigned char g_smem[];
constexpr int PTAB_OFF = LDS_BYTES - 512;
__device__ __forceinline__ const float* pin_ld(int k) {
    const unsigned long long v = *(volatile LAS unsigned long long*)((LAS unsigned char*)g_smem + PTAB_OFF + 8 * k);
    const unsigned lo = __builtin_amdgcn_readfirstlane((unsigned)v), hi = __builtin_amdgcn_readfirstlane((unsigned)(v >> 32));
    return (const float*)(((unsigned long long)hi << 32) | lo);
}
struct KQ { float* out; unsigned char* ws; };
__device__ __forceinline__ KQ lq(KQ q) { asm volatile("" : "+s"(q.out), "+s"(q.ws)); return q; }

__device__ __forceinline__ bf16_t f2bf(float f) { unsigned u = __float_as_uint(f); u += 0x7FFFu + ((u >> 16) & 1u); return (bf16_t)(u >> 16); }
__device__ __forceinline__ float bf2f(bf16_t b) { return __uint_as_float(((unsigned)b) << 16); }
__device__ __forceinline__ float silu_f(float x) { return x * __builtin_amdgcn_rcpf(1.0f + __expf(-x)); }
__device__ __forceinline__ int ltid() { int t = threadIdx.x; asm volatile("" : "+v"(t)); return t; }
__device__ __forceinline__ float wave_sum(float v) {
#pragma unroll
    for (int o = 32; o > 0; o >>= 1) v += __shfl_xor(v, o, 64);
    return v;
}


#define XB_TMO      128
#define XB_XCNT(j)  (256  + 64 * (j))
#define XB_XSUB(j)  (1280 + 64 * (j))
#define XB_XGEN(j)  (2304 + 64 * (j))
#define XB_TOP      3328
#define XB_TOPGEN   3392
#define XCD_BAR_WORDS 3456
#define XB_SPIN_CAP (1u << 18)
__device__ __forceinline__ unsigned xb_ld(unsigned* p)              { return __hip_atomic_load(p, __ATOMIC_RELAXED, __HIP_MEMORY_SCOPE_AGENT); }
__device__ __forceinline__ unsigned xb_add(unsigned* p, unsigned v) { return __hip_atomic_fetch_add(p, v, __ATOMIC_RELAXED, __HIP_MEMORY_SCOPE_AGENT); }
__device__ __forceinline__ unsigned xb_xcc_id() { return (unsigned)__builtin_amdgcn_s_getreg((3 << 11) | 20) & 0xFu; }
#define XB_SPIN(cond, bar) do { unsigned _sp = 0; while (cond) { __builtin_amdgcn_s_sleep(1); \
    if ((++_sp & 255u) == 0u) { if (xb_ld(&(bar)[XB_TMO])) break; if (_sp > XB_SPIN_CAP) { atomicAdd(&(bar)[XB_TMO], 1u); break; } } } } while (0)
struct XcdBarrier { unsigned* bar; unsigned x; volatile LAS unsigned* st; };
__device__ __forceinline__ XcdBarrier xcd_barrier_post(unsigned* bar, volatile LAS unsigned* st) {
    XcdBarrier b; b.bar = bar; b.x = xb_xcc_id(); b.st = st;
    if (threadIdx.x == 0) (void)xb_add(&bar[XB_XCNT(b.x)], 1u);
    return b;
}
__device__ __forceinline__ void xcd_barrier_complete(unsigned* bar, unsigned x, unsigned& nloc, unsigned& nx) {
    const unsigned G = gridDim.x * gridDim.y * gridDim.z;
    unsigned sum, cnt, mine, sp = 0u;
    for (;;) {
        sum = 0u; cnt = 0u; mine = 0u;
#pragma unroll
        for (unsigned j = 0; j < 16; ++j) { const unsigned c = xb_ld(&bar[XB_XCNT(j)]); sum += c; cnt += (c > 0u) ? 1u : 0u; mine = (j == x) ? c : mine; }
        if (sum == G) break;
        __builtin_amdgcn_s_sleep(1);
        if ((++sp & 255u) == 0u) { if (xb_ld(&bar[XB_TMO])) break; if (sp > XB_SPIN_CAP) { atomicAdd(&bar[XB_TMO], 1u); break; } }
    }
    nloc = mine > 0u ? mine : 1u; nx = cnt > 0u ? cnt : 1u;
}
__device__ __forceinline__ void xcd_barrier_impl(unsigned* bar, volatile LAS unsigned* st) {
    asm volatile("s_waitcnt vmcnt(0)" ::: "memory");
    __syncthreads();
    if (ltid() == 0) {
        const unsigned x = xb_xcc_id();
        __builtin_amdgcn_s_waitcnt(0);
        unsigned nloc = st[0], nx = st[1];
        if (nloc == 0u) { xcd_barrier_complete(bar, x, nloc, nx); st[0] = nloc; st[1] = nx; }
        const unsigned old = xb_add(&bar[XB_XSUB(x)], 1u);
        const unsigned gen = old / nloc;
        if (old + 1u == (gen + 1u) * nloc) {
            __builtin_amdgcn_fence(__ATOMIC_RELEASE, "agent");
            asm volatile("s_waitcnt vmcnt(0)" ::: "memory");
            const unsigned og = xb_add(&bar[XB_TOP], 1u);
            const unsigned tg = og / nx;
            if (og + 1u == (tg + 1u) * nx) xb_add(&bar[XB_TOPGEN], 1u);
            else XB_SPIN(xb_ld(&bar[XB_TOPGEN]) == tg, bar);
            __builtin_amdgcn_fence(__ATOMIC_ACQUIRE, "agent");
            xb_add(&bar[XB_XGEN(x)], 1u);
            asm volatile("s_waitcnt vmcnt(0)" ::: "memory");
        } else {
            XB_SPIN(xb_ld(&bar[XB_XGEN(x)]) == gen, bar);
            __builtin_amdgcn_fence(__ATOMIC_ACQUIRE, "agent");
            asm volatile("s_waitcnt vmcnt(0)" ::: "memory");
        }
    }
    __syncthreads();
}
__device__ __forceinline__ void sub_barrier(unsigned* word, unsigned n) {
    asm volatile("s_waitcnt vmcnt(0)" ::: "memory");
    __syncthreads();
    if (ltid() == 0) {
        __builtin_amdgcn_fence(__ATOMIC_RELEASE, "agent");
        asm volatile("s_waitcnt vmcnt(0)" ::: "memory");
        (void)xb_add(word, 1u);
        for (unsigned sp = 0; sp < (1u << 21); ++sp) { if (xb_ld(word) >= n) break; __builtin_amdgcn_s_sleep(2); }
        __builtin_amdgcn_fence(__ATOMIC_ACQUIRE, "agent");
        asm volatile("s_waitcnt vmcnt(0)" ::: "memory");
    }
    __syncthreads();
}
#define GRID_BAR() xcd_barrier_impl((unsigned*)(p.ws + WS_BAR), (volatile LAS unsigned*)((LAS unsigned char*)smem + LDS_BYTES - 16))

namespace pg8 {
constexpr int BM = 256, BK = 64, HALF = 128, HTB = HALF * BK * 2, STAGE_BYTES = 8 * HTB, NXCD = 8, WGM = 8;
__host__ __device__ __forceinline__ int lds_byte(int r, int c) { const int st = (r >> 4) * 2 + (c >> 5), rr = r & 15, cc = c & 31, ob = rr * 64 + cc * 2; return st * 1024 + (ob ^ (((ob >> 9) & 1) << 5)); }
__host__ __device__ __forceinline__ void stage_rc(int b, int& R, int& C) { const int st = b / 1024, sb = b % 1024, swz = sb ^ (((sb >> 9) & 1) << 5); R = (st >> 1) * 16 + swz / 64; C = (st & 1) * 32 + (swz % 64) / 2; }
__host__ __device__ __forceinline__ int perm32(int rho) { const int n = rho >> 4, i = rho & 15; return 8 * (i >> 2) + 4 * n + (i & 3); }
struct Unit { int pm, pn; };
struct Gemm { const bf16_t* A; const bf16_t* Bt; int M, N, K, ld; };
struct StaticOrder {
    int nM, nN, nwg, G, c;
    __device__ void init(int M, int N, int G_, int c_) { nM = M / BM; nN = N / BM; nwg = nM * nN; G = G_; c = c_; }
    __device__ bool next(int i, Unit& u) const {
        const long Lx = (long)i * G + c; if (Lx >= nwg) return false;
        int wgid = (int)Lx; { const int q = nwg / NXCD, r = nwg % NXCD, xcd = wgid % NXCD, off = wgid / NXCD; wgid = (xcd < r ? xcd * (q + 1) : r * (q + 1) + (xcd - r) * q) + off; }
        const int nig = WGM * nN, gid = wgid / nig, fm = gid * WGM, gsz = (nM - fm) < WGM ? (nM - fm) : WGM;
        u.pm = fm + ((wgid % nig) % gsz); u.pn = (wgid % nig) / gsz; return true;
    }
};
__device__ __forceinline__ unsigned cvt_pk_bf16(float lo, float hi) { unsigned r; asm volatile("v_cvt_pk_bf16_f32 %0, %1, %2" : "=v"(r) : "v"(lo), "v"(hi)); return r; }

struct EpiF32 {
    static constexpr bool PERM = false, AFTER_DRAIN = false;
    float* C; int ldc;
    __device__ __forceinline__ void operator()(const f32x4 (&acc)[2][2][4][2], const Unit& u, int wr, int wc, int fr, int fq) const {
        const int row0 = u.pm * BM + wr * 64 + fr, col0 = u.pn * BM + wc * 32 + 4 * fq;
#pragma unroll
        for (int ai = 0; ai < 2; ++ai)
#pragma unroll
            for (int m = 0; m < 4; ++m) { float* rowp = C + (size_t)(row0 + ai * HALF + m * 16) * ldc + col0;
#pragma unroll
                for (int bj = 0; bj < 2; ++bj)
#pragma unroll
                    for (int n = 0; n < 2; ++n) *(f32x4*)(rowp + bj * HALF + n * 16) = acc[ai][bj][m][n]; }
    }
};
struct EpiBf16 {
    static constexpr bool PERM = true, AFTER_DRAIN = false;
    bf16_t* O; int ldc; const float* bias;
    __device__ __forceinline__ void operator()(const f32x4 (&acc)[2][2][4][2], const Unit& u, int wr, int wc, int fr, int fq) const {
        const int row0 = u.pm * BM + wr * 64 + fr; const int col0 = u.pn * BM + wc * 32 + 8 * fq;
        f32x4 bv[2][2];
#pragma unroll
        for (int bj = 0; bj < 2; ++bj)
#pragma unroll
            for (int n = 0; n < 2; ++n) bv[bj][n] = bias ? *(const f32x4*)(bias + col0 + bj * HALF + 4 * n) : (f32x4){0.f, 0.f, 0.f, 0.f};
#pragma unroll
        for (int ai = 0; ai < 2; ++ai)
#pragma unroll
            for (int m = 0; m < 4; ++m) { bf16_t* rowp = O + (size_t)(row0 + ai * HALF + m * 16) * ldc + col0;
#pragma unroll
                for (int bj = 0; bj < 2; ++bj) { f32x4 v0 = acc[ai][bj][m][0] + bv[bj][0], v1 = acc[ai][bj][m][1] + bv[bj][1];
                    u32x4 w; w.x = cvt_pk_bf16(v0[0], v0[1]); w.y = cvt_pk_bf16(v0[2], v0[3]); w.z = cvt_pk_bf16(v1[0], v1[1]); w.w = cvt_pk_bf16(v1[2], v1[3]);
                    *(u32x4*)(rowp + bj * HALF) = w; } }
    }
};
struct EpiSwiGLU {
    static constexpr bool PERM = true, AFTER_DRAIN = false;
    bf16_t* O; int ldc;
    __device__ __forceinline__ void operator()(const f32x4 (&acc)[2][2][4][2], const Unit& u, int wr, int wc, int fr, int fq) const {
        const int row0 = u.pm * BM + wr * 64 + fr; const int col0 = u.pn * HALF + wc * 32 + 8 * fq;
#pragma unroll
        for (int ai = 0; ai < 2; ++ai)
#pragma unroll
            for (int m = 0; m < 4; ++m) { bf16_t* rowp = O + (size_t)(row0 + ai * HALF + m * 16) * ldc + col0;
                float v[8];
#pragma unroll
                for (int n = 0; n < 2; ++n)
#pragma unroll
                    for (int j = 0; j < 4; ++j) { const float g = acc[ai][0][m][n][j], up = acc[ai][1][m][n][j]; v[n * 4 + j] = silu_f(g) * up; }
                u32x4 w; w.x = cvt_pk_bf16(v[0], v[1]); w.y = cvt_pk_bf16(v[2], v[3]); w.z = cvt_pk_bf16(v[4], v[5]); w.w = cvt_pk_bf16(v[6], v[7]);
                *(u32x4*)rowp = w; }
    }
};


__device__ __forceinline__ void row_exchange(const f32x4 (&v)[2][2][4][2], const Unit& u, int wr, int wc, int fr, int fq, LAS unsigned char* lds, int wid, int lane, float* slots, unsigned* cnt) {
    LAS float* P = (LAS float*)lds;
    LAS float* S = (LAS float*)(lds + 4096);
#pragma unroll
    for (int ai = 0; ai < 2; ++ai)
#pragma unroll
        for (int m = 0; m < 4; ++m) {
            float sq = 0.f;
#pragma unroll
            for (int bj = 0; bj < 2; ++bj)
#pragma unroll
                for (int n = 0; n < 2; ++n) { const f32x4 x = v[ai][bj][m][n]; sq += (x[0] * x[0] + x[1] * x[1]) + (x[2] * x[2] + x[3] * x[3]); }
            sq += __shfl_xor(sq, 16); sq += __shfl_xor(sq, 32);
            if (fq == 0) P[(ai * HALF + wr * 64 + m * 16 + fr) * 4 + wc] = sq;
        }
    asm volatile("s_waitcnt lgkmcnt(0)" ::: "memory"); __builtin_amdgcn_s_barrier(); asm volatile("" ::: "memory");
    const int row = wid * 32 + (lane & 31);
    if (lane < 32) {
        const float tot = (P[row * 4 + 0] + P[row * 4 + 1]) + (P[row * 4 + 2] + P[row * 4 + 3]);
        __hip_atomic_store((unsigned*)slots + ((size_t)(u.pm * BM + row) * 4 + u.pn), __float_as_uint(tot), __ATOMIC_RELAXED, __HIP_MEMORY_SCOPE_AGENT);
    }
    asm volatile("s_waitcnt vmcnt(0)" ::: "memory");
    if (lane == 0) __hip_atomic_fetch_add(cnt + 64 * u.pm, 1u, __ATOMIC_RELAXED, __HIP_MEMORY_SCOPE_AGENT);
    if (wid == 0) {
        for (unsigned sp = 0; sp < (1u << 21); ++sp) {
            if ((unsigned)__builtin_amdgcn_readfirstlane(__hip_atomic_load(cnt + 64 * u.pm, __ATOMIC_RELAXED, __HIP_MEMORY_SCOPE_AGENT)) >= 32u) break;
            __builtin_amdgcn_s_sleep(2);
        }
        __builtin_amdgcn_fence(__ATOMIC_ACQUIRE, "agent");
    }
    asm volatile("s_waitcnt vmcnt(0) lgkmcnt(0)" ::: "memory"); __builtin_amdgcn_s_barrier(); asm volatile("" ::: "memory");
    if (lane < 32) {
        const unsigned* sl = (const unsigned*)slots + (size_t)(u.pm * BM + row) * 4;
        float tot = 0.f;
#pragma unroll
        for (int t = 0; t < 4; ++t) tot += __uint_as_float(__hip_atomic_load(sl + t, __ATOMIC_RELAXED, __HIP_MEMORY_SCOPE_AGENT));
        S[row] = tot;
    }
    asm volatile("s_waitcnt vmcnt(0) lgkmcnt(0)" ::: "memory"); __builtin_amdgcn_s_barrier(); asm volatile("" ::: "memory");
}
struct EpiFusedRow {
    static constexpr bool PERM = false, AFTER_DRAIN = true;
    const float* xin; float* xout; bf16_t* H;
    const float* gate; const float* gpost; float wgt;
    const float* gpre; const float* shift; const float* scale;
    float* slots; unsigned* cnt;
    __device__ __forceinline__ void operator()(const f32x4 (&)[2][2][4][2], const Unit&, int, int, int, int) const {}
    __device__ __forceinline__ void fused(f32x4 (&acc)[2][2][4][2], const Unit& u, int wr, int wc, int fr, int fq, LAS unsigned char* lds, int wid, int lane) const {
        const LAS float* S = (const LAS float*)(lds + 4096);
        const int col0 = u.pn * BM + wc * 32 + 4 * fq; const size_t mb = (size_t)(u.pm >> 4) * (NMOD * D);
        row_exchange(acc, u, wr, wc, fr, fq, lds, wid, lane, slots, cnt);
        {
            f32x4 cw[2][2];
#pragma unroll
            for (int bj = 0; bj < 2; ++bj)
#pragma unroll
                for (int n = 0; n < 2; ++n) cw[bj][n] = *(const f32x4*)(gate + mb + col0 + bj * HALF + n * 16) * *(const f32x4*)(gpost + col0 + bj * HALF + n * 16);
#pragma unroll
            for (int ai = 0; ai < 2; ++ai)
#pragma unroll
                for (int m = 0; m < 4; ++m) { const int r = ai * HALF + wr * 64 + m * 16 + fr; const float r1 = rsqrtf(S[r] * (1.0f / D) + EPS) * wgt; const size_t off = (size_t)(u.pm * BM + r) * D + col0;
#pragma unroll
                    for (int bj = 0; bj < 2; ++bj)
#pragma unroll
                        for (int n = 0; n < 2; ++n) { const f32x4 xv = *(const f32x4*)(xin + off + bj * HALF + n * 16); const f32x4 xn = xv + (cw[bj][n] * r1) * acc[ai][bj][m][n];
                            acc[ai][bj][m][n] = xn; *(f32x4*)(xout + off + bj * HALF + n * 16) = xn; }
                    asm volatile("" : "+v"(acc[ai][0][m][0]), "+v"(acc[ai][0][m][1]), "+v"(acc[ai][1][m][0]), "+v"(acc[ai][1][m][1]));
                    asm volatile("" ::: "memory"); }
        }
        if (H == nullptr) return;
        row_exchange(acc, u, wr, wc, fr, fq, lds, wid, lane, slots + (size_t)TL * 4, cnt + 64 * 64);
        {
            f32x4 gm[2][2], sh[2][2];
#pragma unroll
            for (int bj = 0; bj < 2; ++bj)
#pragma unroll
                for (int n = 0; n < 2; ++n) { const int c = col0 + bj * HALF + n * 16; gm[bj][n] = *(const f32x4*)(gpre + c) * (*(const f32x4*)(scale + mb + c) + 1.0f); sh[bj][n] = *(const f32x4*)(shift + mb + c); }
#pragma unroll
            for (int ai = 0; ai < 2; ++ai)
#pragma unroll
                for (int m = 0; m < 4; ++m) { const int r = ai * HALF + wr * 64 + m * 16 + fr; const float r2 = rsqrtf(S[r] * (1.0f / D) + EPS); const size_t off = (size_t)(u.pm * BM + r) * D + col0;
#pragma unroll
                    for (int bj = 0; bj < 2; ++bj)
#pragma unroll
                        for (int n = 0; n < 2; ++n) { const f32x4 hv = (acc[ai][bj][m][n] * r2) * gm[bj][n] + sh[bj][n];
                            uint2 w2; w2.x = cvt_pk_bf16(hv[0], hv[1]); w2.y = cvt_pk_bf16(hv[2], hv[3]); *(uint2*)(H + off + bj * HALF + n * 16) = w2; }
                    asm volatile("" ::: "memory"); }
        }
    }
};

template <class Epi, class Sched>
__device__ __forceinline__ void gemm_phase(LAS unsigned char* lds, const Gemm g, const Sched& S, const Epi& E) {
    const int tid = ltid(), wid = __builtin_amdgcn_readfirstlane(tid >> 6), lane = tid & 63, wr = wid >> 2, wc = wid & 3, fr = lane & 15, fq = lane >> 4;
    const int K = g.ld, nt = g.K / BK;
    unsigned voffA[2], voffB[2];
#pragma unroll
    for (int i = 0; i < 2; ++i) { int R, C; stage_rc(tid * 16 + i * 8192, R, C); const int Rb = Epi::PERM ? ((R & ~31) + perm32(R & 31)) : R;
        voffA[i] = (unsigned)(R * K + C) * 2u; voffB[i] = (unsigned)(Rb * K + C) * 2u; }
    const size_t kstep = (size_t)(BK * 2);
    const size_t hstep = (size_t)HALF * K * 2;
    const size_t tstep = 2 * hstep;
    const unsigned ldsw = (unsigned)wid * 1024u;
    const int aoff = lds_byte(wr * 64 + fr, fq * 8), boff = lds_byte(wc * 32 + fr, fq * 8);
#define PG8_SA(b, h) (((b) * 2 + (h)) * HTB)
#define PG8_SB(b, h) ((4 + (b) * 2 + (h)) * HTB)
#define PG8_STAGE(bufoff, gbase, voff) do { _Pragma("unroll") for (int _i = 0; _i < 2; ++_i) \
        __builtin_amdgcn_global_load_lds((const unsigned*)((const char*)(gbase) + (voff)[_i]), (LAS unsigned*)(lds + (bufoff) + ldsw + _i * 8192), 16, 0, 0); } while (0)
#define PG8_LDA(dst, b, h) do { _Pragma("unroll") for (int m = 0; m < 4; ++m) _Pragma("unroll") for (int k = 0; k < 2; ++k) dst[m][k] = *(const LAS bf16x8*)(lds + PG8_SA(b, h) + aoff + m * 2048 + k * 1024); } while (0)
#define PG8_LDB(dst, b, h) do { _Pragma("unroll") for (int n = 0; n < 2; ++n) _Pragma("unroll") for (int k = 0; k < 2; ++k) dst[n][k] = *(const LAS bf16x8*)(lds + PG8_SB(b, h) + boff + n * 2048 + k * 1024); } while (0)
#define PG8_MMA(ai, bj, At, Bt) do { __builtin_amdgcn_s_setprio(1); _Pragma("unroll") for (int m = 0; m < 4; ++m) _Pragma("unroll") for (int n = 0; n < 2; ++n) _Pragma("unroll") for (int k = 0; k < 2; ++k) \
        acc[ai][bj][m][n] = __builtin_amdgcn_mfma_f32_16x16x32_bf16(Bt[n][k], At[m][k], acc[ai][bj][m][n], 0, 0, 0); __builtin_amdgcn_s_setprio(0); } while (0)
#define PG8_WAIT_V(n) asm volatile("s_waitcnt vmcnt(" #n ")" ::: "memory")
#define PG8_WAIT_L(n) asm volatile("s_waitcnt lgkmcnt(" #n ")" ::: "memory")
#define PG8_BAR __builtin_amdgcn_s_barrier()
#define PG8_SCHED __builtin_amdgcn_sched_barrier(0)
    Unit cur, nxt; int ui = 0;
    if (!S.next(0, cur)) return;
    f32x4 acc[2][2][4][2];
#pragma unroll
    for (int a = 0; a < 2; ++a)
#pragma unroll
        for (int b = 0; b < 2; ++b)
#pragma unroll
            for (int m = 0; m < 4; ++m)
#pragma unroll
                for (int n = 0; n < 2; ++n) acc[a][b][m][n] = (f32x4){0.f, 0.f, 0.f, 0.f};
    bf16x8 At[4][2], B0[2][2], B1[2][2];
    const char* cA = (const char*)g.A + (size_t)cur.pm * tstep; const char* cB = (const char*)g.Bt + (size_t)cur.pn * tstep;
    PG8_STAGE(PG8_SB(0, 0), cB, voffB); PG8_STAGE(PG8_SA(0, 0), cA, voffA); PG8_STAGE(PG8_SB(0, 1), cB + hstep, voffB); PG8_STAGE(PG8_SA(0, 1), cA + hstep, voffA);
    if (wr == 1) PG8_BAR;
    PG8_WAIT_V(4); PG8_BAR;
    PG8_STAGE(PG8_SB(1, 0), cB + kstep, voffB); PG8_STAGE(PG8_SA(1, 0), cA + kstep, voffA); PG8_STAGE(PG8_SB(1, 1), cB + hstep + kstep, voffB);
    PG8_WAIT_V(6); PG8_BAR;
    for (;;) {
        const bool has_next = S.next(ui + 1, nxt);
        const char* nA = has_next ? (const char*)g.A + (size_t)nxt.pm * tstep : cA; const char* nB = has_next ? (const char*)g.Bt + (size_t)nxt.pn * tstep : cB;
        for (int t = 0; t < nt; t += 2) {
            const bool last = (t == nt - 2);
            const char* a1 = cA + (size_t)(t + 1) * kstep;
            const char* a2 = last ? nA : cA + (size_t)(t + 2) * kstep; const char* b2 = last ? nB : cB + (size_t)(t + 2) * kstep;
            const char* a3 = a2 + kstep; const char* b3 = b2 + kstep;
            PG8_LDB(B0, 0, 0); PG8_SCHED; PG8_LDA(At, 0, 0); PG8_STAGE(PG8_SA(1, 1), a1 + hstep, voffA);
            PG8_WAIT_L(8); PG8_BAR; PG8_WAIT_L(0); PG8_MMA(0, 0, At, B0); PG8_BAR; PG8_SCHED;
            PG8_LDB(B1, 0, 1); PG8_STAGE(PG8_SB(0, 0), b2, voffB);
            PG8_BAR; PG8_WAIT_L(0); PG8_MMA(0, 1, At, B1); PG8_BAR;
            PG8_LDA(At, 0, 1); PG8_STAGE(PG8_SA(0, 0), a2, voffA);
            PG8_BAR; PG8_WAIT_L(0); PG8_MMA(1, 0, At, B0); PG8_BAR; PG8_SCHED;
            PG8_STAGE(PG8_SB(0, 1), b2 + hstep, voffB);
            PG8_WAIT_V(6); PG8_BAR; PG8_MMA(1, 1, At, B1); PG8_BAR;
            PG8_LDB(B0, 1, 0); PG8_SCHED; PG8_LDA(At, 1, 0); PG8_STAGE(PG8_SA(0, 1), a2 + hstep, voffA);
            PG8_WAIT_L(8); PG8_BAR; PG8_WAIT_L(0); PG8_MMA(0, 0, At, B0); PG8_BAR; PG8_SCHED;
            PG8_LDB(B1, 1, 1); PG8_STAGE(PG8_SB(1, 0), b3, voffB);
            PG8_BAR; PG8_WAIT_L(0); PG8_MMA(0, 1, At, B1); PG8_BAR;
            PG8_LDA(At, 1, 1); PG8_STAGE(PG8_SA(1, 0), a3, voffA);
            PG8_BAR; PG8_WAIT_L(0); PG8_MMA(1, 0, At, B0); PG8_BAR; PG8_SCHED;
            PG8_STAGE(PG8_SB(1, 1), b3 + hstep, voffB);
            PG8_WAIT_V(6); PG8_BAR; PG8_MMA(1, 1, At, B1); PG8_BAR;
        }
        if constexpr (!Epi::AFTER_DRAIN) E(acc, cur, wr, wc, fr, fq);
        if (!has_next) break;
#pragma unroll
        for (int a = 0; a < 2; ++a)
#pragma unroll
            for (int b = 0; b < 2; ++b)
#pragma unroll
                for (int m = 0; m < 4; ++m)
#pragma unroll
                    for (int n = 0; n < 2; ++n) acc[a][b][m][n] = (f32x4){0.f, 0.f, 0.f, 0.f};
        cur = nxt; cA = nA; cB = nB; ++ui;
    }
    PG8_WAIT_V(0);
    if (wr == 0) PG8_BAR;
    PG8_BAR;
    if constexpr (Epi::AFTER_DRAIN) E.fused(acc, cur, wr, wc, fr, fq, lds, wid, lane);
#undef PG8_SA
#undef PG8_SB
#undef PG8_STAGE
#undef PG8_LDA
#undef PG8_LDB
#undef PG8_MMA
#undef PG8_WAIT_V
#undef PG8_WAIT_L
#undef PG8_BAR
#undef PG8_SCHED
}
}

template <class Epi>
__device__ __forceinline__ void run_gemm(unsigned char* smem, const bf16_t* A, const bf16_t* Bt, int M, int N, int K, const Epi& E) {
    pg8::Gemm g{A, Bt, M, N, K, K}; pg8::StaticOrder S; S.init(M, N, (int)gridDim.x, (int)blockIdx.x);
    pg8::gemm_phase<Epi, pg8::StaticOrder>((LAS unsigned char*)smem, g, S, E);
}
__device__ __forceinline__ void run_gemm_f32_split(unsigned char* smem, const bf16_t* A, const bf16_t* Bt, int M, int K, const pg8::EpiFusedRow& EF, float* YP) {
    { pg8::Gemm g{A, Bt, TL, D, K, K}; pg8::StaticOrder S; S.init(TL, D, (int)gridDim.x, (int)blockIdx.x);
      pg8::gemm_phase<pg8::EpiFusedRow, pg8::StaticOrder>((LAS unsigned char*)smem, g, S, EF); }
    __syncthreads();
    if (M > TL && blockIdx.x < 64) {
        const int ks = blockIdx.x >> 4;
        int koff, klen;
        if (K == DFF) { koff = (ks < 2) ? ks * 768 : 1536 + (ks - 2) * 640; klen = (ks < 2) ? 768 : 640; }
        else { klen = K / 4; koff = ks * klen; }
        pg8::Gemm g{A + (size_t)TL * K + koff, Bt + koff, TC, D, klen, K}; pg8::StaticOrder S; S.init(TC, D, 16, (int)(blockIdx.x & 15)); pg8::EpiF32 E{YP + (size_t)ks * TC * D, D};
        pg8::gemm_phase<pg8::EpiF32, pg8::StaticOrder>((LAS unsigned char*)smem, g, S, E);
        __syncthreads();
    }
}

__device__ __forceinline__ float* xrow(const KQ p, int t) { return t < TL ? p.out + (size_t)t * D : (float*)(p.ws + WS_XC) + (size_t)(t - TL) * D; }
__device__ __forceinline__ int modrow(int t) { return t < TL ? (t >> 12) : 4; }
__device__ __forceinline__ const float* modp(const KQ p, int l, int mr, int idx) { return (const float*)(p.ws + WS_MOD) + ((size_t)(l * 5 + mr) * NMOD + idx) * D; }

__device__ __forceinline__ void p0_setup(const KQ p_in, float* sm) {
    const KQ p = lq(p_in);
    const int tid = ltid(), bid = blockIdx.x, nb = gridDim.x;
    const int gtid = bid * 512 + tid, gthreads = nb * 512;
    {
        float* rope = (float*)(p.ws + WS_ROPE);
        for (int idx = gtid; idx < SEQ * 32; idx += gthreads) {
            const int t = idx >> 5, i = idx & 31;
            const int ii = i & 15; const float pos = (i < 16) ? (float)(t >> 6) : (float)(t & 63);
            const float invA = powf(10000.0f, -(float)ii / 16.0f);
            const float angA = pos * invA;
            rope[idx] = cosf(angA); rope[SEQ * 32 + idx] = sinf(angA);
            const float ex = (float)i * (1.0f / 31.0f);
            const float invR = powf(10000.0f, -ex);
            const float angR = (float)t * invR;
            rope[2 * SEQ * 32 + idx] = cosf(angR); rope[3 * SEQ * 32 + idx] = sinf(angR);
        }
    }
    {
        float* tile = sm;
        for (int gs = bid; gs < 20864 / 4; gs += nb) {
            const int g = gs * 4;
            int j, tl;
            if (g < 16896) { j = g / 704; tl = g % 704; }
            else if (g < 18304) { j = 24 + (g - 16896) / 704; tl = (g - 16896) % 704; }
            else if (g < 18816) { j = 26 + (g - 18304) / 256; tl = (g - 18304) % 256; }
            else if (g < 20352) { j = 28 + (g - 18816) / 768; tl = (g - 18816) % 768; }
            else { j = 30 + (g - 20352) / 256; tl = (g - 20352) % 256; }
            const float* src; bf16_t* dst; int K, N, mode = 0;
            if (j < 8) { src = pin_ld(8) + (size_t)j * D * DFF; dst = (bf16_t*)(p.ws + WS_WGU + (size_t)j * SZ_WGU); K = D; N = DFF; mode = 1; }
            else if (j < 16) { src = pin_ld(9) + (size_t)(j - 8) * D * DFF; dst = (bf16_t*)(p.ws + WS_WGU + (size_t)(j - 8) * SZ_WGU); K = D; N = DFF; mode = 2; }
            else if (j < 24) { src = pin_ld(10) + (size_t)(j - 16) * DFF * D; dst = (bf16_t*)(p.ws + WS_WD + (size_t)(j - 16) * SZ_WD); K = DFF; N = D; }
            else if (j < 26) { src = pin_ld(11) + (size_t)(j - 24) * D * INW; dst = (bf16_t*)(p.ws + WS_WIN + (size_t)(j - 24) * SZ_WIN); K = D; N = INW; mode = 3; }
            else if (j < 28) { src = pin_ld(14) + (size_t)(j - 26) * D * D; dst = (bf16_t*)(p.ws + WS_WOUT + (size_t)(j - 26) * SZ_WOUT); K = D; N = D; }
            else if (j < 30) { src = pin_ld(15) + (size_t)(j - 28) * D * HYW; dst = (bf16_t*)(p.ws + WS_HWIN + (size_t)(j - 28) * SZ_HWIN); K = D; N = HYW; }
            else { src = pin_ld(28) + (size_t)(j - 30) * D * D; dst = (bf16_t*)(p.ws + WS_HWOUT + (size_t)(j - 30) * SZ_WOUT); K = D; N = D; }
            const int ntn = N / 64; const int k0 = (tl / ntn) * 64, n0 = (tl % ntn) * 64;
            f32x4 ld[8];
#pragma unroll
            for (int i = 0; i < 8; ++i) ld[i] = *(const f32x4*)(src + (size_t)(k0 + i * 8 + (tid >> 6)) * N + n0 + (tid & 63) * 4);
            __syncthreads();
#pragma unroll
            for (int i = 0; i < 8; ++i) *(f32x4*)(tile + (i * 8 + (tid >> 6)) * 260 + (tid & 63) * 4) = ld[i];
            __syncthreads();
            {
                const int n = tid >> 1, kh = (tid & 1) * 32; const int gn = n0 + n;
                float sc_ = 1.0f; int row = gn;
                if (mode == 1) row = 256 * (gn >> 7) + (gn & 127);
                else if (mode == 2) row = 256 * (gn >> 7) + 128 + (gn & 127);
                else if (mode == 3) { if (gn < 512 || (gn >= 1792 && gn < 2304)) sc_ = 0.125f; }
#pragma unroll
                for (int q = 0; q < 4; ++q) {
                    float v[8];
#pragma unroll
                    for (int jj = 0; jj < 8; ++jj) v[jj] = tile[(kh + q * 8 + jj) * 260 + n] * sc_;
                    u32x4 o4; o4.x = pg8::cvt_pk_bf16(v[0], v[1]); o4.y = pg8::cvt_pk_bf16(v[2], v[3]); o4.z = pg8::cvt_pk_bf16(v[4], v[5]); o4.w = pg8::cvt_pk_bf16(v[6], v[7]);
                    *(u32x4*)(dst + (size_t)row * K + k0 + kh + q * 8) = o4;
                }
            }
        }
        __syncthreads();
    }
    {
        float* sc = sm;
        float* red = sm + 5 * 1024;
        for (int i = tid; i < 5 * 1024; i += 512) { const int r = i >> 10, k = i & 1023; const float v = (r < 4) ? pin_ld(1)[r * D + k] : pin_ld(3)[k]; sc[i] = silu_f(v); }
        __syncthreads();
        const int w = tid >> 6, lane = tid & 63;
        for (int it = bid; it < 288; it += nb) {
            const int l = it / 72, c0 = (it % 72) * 128;
            const float* wm = pin_ld(4) + (size_t)l * D * (NMOD * D) + c0 + 2 * lane;
            float a[5][2];
#pragma unroll
            for (int r = 0; r < 5; ++r) { a[r][0] = 0.f; a[r][1] = 0.f; }
            for (int kb = w * 128; kb < w * 128 + 128; kb += 16) {
                float2 wv[16];
#pragma unroll
                for (int q = 0; q < 16; ++q) wv[q] = *(const float2*)(wm + (size_t)(kb + q) * (NMOD * D));
#pragma unroll
                for (int q = 0; q < 16; ++q)
#pragma unroll
                    for (int r = 0; r < 5; ++r) { const float s = sc[r * 1024 + kb + q]; a[r][0] += s * wv[q].x; a[r][1] += s * wv[q].y; }
            }
#pragma unroll
            for (int r = 0; r < 5; ++r) { red[(w * 5 + r) * 128 + 2 * lane] = a[r][0]; red[(w * 5 + r) * 128 + 2 * lane + 1] = a[r][1]; }
            __syncthreads();
            for (int i = tid; i < 5 * 128; i += 512) {
                const int r = i >> 7, c = i & 127; float s = 0.f;
#pragma unroll
                for (int ww = 0; ww < 8; ++ww) s += red[(ww * 5 + r) * 128 + c];
                s += pin_ld(5)[(size_t)l * (NMOD * D) + c0 + c];
                ((float*)(p.ws + WS_MOD))[(size_t)(l * 5 + r) * (NMOD * D) + c0 + c] = s;
            }
            __syncthreads();
        }
    }
    {
        float* z = sm;
        float* a1 = sm + 16 * 36;
        float* a2 = a1 + 16 * 64;
        float* a3 = a2 + 16 * 64;
        float* tl = a3 + 16 * 64;
        float* wl = tl + 16;
        const float HMAX = -4.605170185988091f / 0.3f, HMIN = -4.605170185988091f / 1.5f;
        int o_loaded = -1;
        for (int it = nb - 1 - bid; it < 544; it += nb) {
            const int o = it / 272, r = it % 272;
            const int Lf = (r < 256) ? SEQ : CL; const int p0 = (r < 256) ? r * 16 : (r - 256) * 16;
            float* kf = (float*)(p.ws + WS_KF + (size_t)o * SZ_KF) + ((r < 256) ? (size_t)0 : (size_t)2 * SEQ * D);
            const float* f3 = pin_ld(25) + (size_t)o * 64 * 2048;
            __syncthreads();
            if (o != o_loaded) {
                const float* f0 = pin_ld(19) + (size_t)o * 33 * 64; const float* f1 = pin_ld(21) + (size_t)o * 64 * 64; const float* f2 = pin_ld(23) + (size_t)o * 64 * 64;
                for (int i = tid; i < 33 * 64; i += 512) wl[i] = f0[i];
                for (int i = tid; i < 64 * 64; i += 512) { wl[2112 + i] = f1[i]; wl[2112 + 4096 + i] = f2[i]; }
                if (tid < 64) { wl[10304 + tid] = pin_ld(20)[o * 64 + tid]; wl[10304 + 64 + tid] = pin_ld(22)[o * 64 + tid]; wl[10304 + 128 + tid] = pin_ld(24)[o * 64 + tid]; wl[10304 + 192 + tid] = pin_ld(26)[o * 64 + tid]; }
                o_loaded = o;
            }
            const float* f0 = wl; const float* f1 = wl + 2112; const float* f2 = wl + 2112 + 4096;
            const float* fb0 = wl + 10304; const float* fb1 = fb0 + 64; const float* fb2 = fb0 + 128; const float* fq = fb0 + 192;
            for (int idx = tid; idx < 16 * 33; idx += 512) {
                const int ps = idx / 33, f = idx % 33; const int i = p0 + ps;
                const float tlin = (float)i * (1.0f / (float)(Lf - 1));
                const float w = (6.283185307179586f * (float)i) / (float)Lf;
                float v;
                if (f == 0) { v = tlin; tl[ps] = tlin; }
                else { const int jj = (f - 1) & 15; const float fj = 1e-4f + (float)jj * ((15.0f - 1e-4f) / 15.0f); v = (f <= 16) ? cosf(fj * w) : -sinf(fj * w); }
                z[ps * 36 + f] = v;
            }
            __syncthreads();
            for (int idx = tid; idx < 16 * 64; idx += 512) { const int ps = idx >> 6, oc = idx & 63; float s = fb0[oc];
                for (int f = 0; f < 33; ++f) s += z[ps * 36 + f] * f0[f * 64 + oc];
                a1[idx] = sinf(fq[oc] * s); }
            __syncthreads();
            for (int idx = tid; idx < 16 * 64; idx += 512) { const int ps = idx >> 6, oc = idx & 63; float s = fb1[oc];
                for (int f = 0; f < 64; ++f) s += a1[ps * 64 + f] * f1[f * 64 + oc];
                a2[idx] = sinf(fq[oc] * s); }
            __syncthreads();
            for (int idx = tid; idx < 16 * 64; idx += 512) { const int ps = idx >> 6, oc = idx & 63; float s = fb2[oc];
                for (int f = 0; f < 64; ++f) s += a2[ps * 64 + f] * f2[f * 64 + oc];
                a3[oc * 16 + ps] = sinf(fq[oc] * s); }
            __syncthreads();
            {
                float acc[4][16];
#pragma unroll
                for (int q = 0; q < 4; ++q)
#pragma unroll
                    for (int ps = 0; ps < 16; ++ps) acc[q][ps] = 0.f;
                for (int fb = 0; fb < 64; fb += 4) {
                    float wv[4][4];
#pragma unroll
                    for (int f = 0; f < 4; ++f)
#pragma unroll
                        for (int q = 0; q < 4; ++q) wv[f][q] = f3[(fb + f) * 2048 + tid + 512 * q];
#pragma unroll
                    for (int f = 0; f < 4; ++f) {
                        const f32x4 av0 = *(const f32x4*)(a3 + (fb + f) * 16), av1 = *(const f32x4*)(a3 + (fb + f) * 16 + 4), av2 = *(const f32x4*)(a3 + (fb + f) * 16 + 8), av3 = *(const f32x4*)(a3 + (fb + f) * 16 + 12);
#pragma unroll
                        for (int q = 0; q < 4; ++q)
#pragma unroll
                            for (int e = 0; e < 4; ++e) { acc[q][e] += av0[e] * wv[f][q]; acc[q][4 + e] += av1[e] * wv[f][q]; acc[q][8 + e] += av2[e] * wv[f][q]; acc[q][12 + e] += av3[e] * wv[f][q]; }
                    }
                }
#pragma unroll
                for (int q = 0; q < 4; ++q) {
                    const int c = tid + 512 * q; const int dir = c >> 10, d = c & 1023;
                    const float delta = fabsf(HMIN + (float)d * ((HMAX - HMIN) / 1023.0f));
#pragma unroll
                    for (int ps = 0; ps < 16; ++ps) {
                        const float kvv = acc[q][ps] * expf(-tl[ps] * delta);
                        if (r < 256) {
                            bf16_t* rk = (bf16_t*)(p.ws + WS_KF + (size_t)o * SZ_KF) + (size_t)d * 8192;
                            const int m = p0 + ps;
                            if (dir == 0) rk[4095 - m] = f2bf(kvv); else if (m > 0) rk[4095 + m] = f2bf(kvv);
                            if (dir == 0 && m == 0) rk[8191] = 0;
                        } else kf[((size_t)dir * Lf + p0 + ps) * D + d] = kvv;
                    }
                }
            }
        }
        __syncthreads();
    }
}

__device__ __forceinline__ void rowphase(const KQ p_in, int Mupd, const bf16_t* Y, int lu, int gidx, float wgt, const float* gpost,
                         int Mnext, int ln, const float* gpre, int shidx, int scidx, bf16_t* Hout, bool from_input, int tbeg) {
    const KQ p = lq(p_in);
    const int tid = ltid(), w = tid >> 6, lane = tid & 63;
    const int Mmax = Mupd > Mnext ? Mupd : Mnext;
    for (int t = tbeg + (blockIdx.x * 8 + w) * 2; t < Mmax; t += gridDim.x * 16) {
        float* xr = xrow(p, t); const int mr = modrow(t);
        const float* xs = xr;
        if (from_input) xs = (t < TL) ? pin_ld(0) + (size_t)t * D : pin_ld(2) + (size_t)(t - TL) * D;
        float4 xv[2][4];
#pragma unroll
        for (int rr = 0; rr < 2; ++rr)
#pragma unroll
            for (int q = 0; q < 4; ++q) xv[rr][q] = *(const float4*)(xs + rr * D + q * 256 + lane * 4);
        if (Y != nullptr && t < Mupd) {
            float4 yv[2][4]; float ss[2] = {0.f, 0.f};
#pragma unroll
            for (int rr = 0; rr < 2; ++rr)
#pragma unroll
                for (int q = 0; q < 4; ++q) {
                    if (t < TL) { const bf16x4 yb = *(const bf16x4*)(Y + (size_t)(t + rr) * D + q * 256 + lane * 4);
                        yv[rr][q] = make_float4(bf2f((bf16_t)yb[0]), bf2f((bf16_t)yb[1]), bf2f((bf16_t)yb[2]), bf2f((bf16_t)yb[3])); }
                    else { const float* yp = (const float*)(p.ws + WS_YP) + (size_t)(t + rr - TL) * D + q * 256 + lane * 4;
                        const float4 a0 = *(const float4*)yp, a1 = *(const float4*)(yp + (size_t)TC * D), a2 = *(const float4*)(yp + (size_t)2 * TC * D), a3 = *(const float4*)(yp + (size_t)3 * TC * D);
                        yv[rr][q] = make_float4(a0.x + a1.x + a2.x + a3.x, a0.y + a1.y + a2.y + a3.y, a0.z + a1.z + a2.z + a3.z, a0.w + a1.w + a2.w + a3.w); }
                    ss[rr] += yv[rr][q].x * yv[rr][q].x + yv[rr][q].y * yv[rr][q].y + yv[rr][q].z * yv[rr][q].z + yv[rr][q].w * yv[rr][q].w; }
            ss[0] = wave_sum(ss[0]); ss[1] = wave_sum(ss[1]);
            float wgl = wgt; asm volatile("" : "+v"(wgl));
            const float r0 = rsqrtf(ss[0] * (1.0f / D) + EPS) * wgl, r1 = rsqrtf(ss[1] * (1.0f / D) + EPS) * wgl;
            const float* gm = modp(p, lu, mr, gidx);
#pragma unroll
            for (int q = 0; q < 4; ++q) {
                const float4 g4 = *(const float4*)(gm + q * 256 + lane * 4); const float4 p4 = *(const float4*)(gpost + q * 256 + lane * 4);
                const float cx = g4.x * p4.x, cy = g4.y * p4.y, cz = g4.z * p4.z, cw = g4.w * p4.w;
                xv[0][q].x += r0 * cx * yv[0][q].x; xv[0][q].y += r0 * cy * yv[0][q].y; xv[0][q].z += r0 * cz * yv[0][q].z; xv[0][q].w += r0 * cw * yv[0][q].w;
                xv[1][q].x += r1 * cx * yv[1][q].x; xv[1][q].y += r1 * cy * yv[1][q].y; xv[1][q].z += r1 * cz * yv[1][q].z; xv[1][q].w += r1 * cw * yv[1][q].w;
                *(float4*)(xr + q * 256 + lane * 4) = xv[0][q]; *(float4*)(xr + D + q * 256 + lane * 4) = xv[1][q];
            }
        }
        if (Hout != nullptr && t < Mnext) {
            float ss[2] = {0.f, 0.f};
#pragma unroll
            for (int rr = 0; rr < 2; ++rr)
#pragma unroll
                for (int q = 0; q < 4; ++q) ss[rr] += xv[rr][q].x * xv[rr][q].x + xv[rr][q].y * xv[rr][q].y + xv[rr][q].z * xv[rr][q].z + xv[rr][q].w * xv[rr][q].w;
            ss[0] = wave_sum(ss[0]); ss[1] = wave_sum(ss[1]);
            const float rn[2] = {rsqrtf(ss[0] * (1.0f / D) + EPS), rsqrtf(ss[1] * (1.0f / D) + EPS)};
            const float* sh = modp(p, ln, mr, shidx); const float* sc = modp(p, ln, mr, scidx);
#pragma unroll
            for (int q = 0; q < 4; ++q) {
                const float4 g4 = *(const float4*)(gpre + q * 256 + lane * 4); const float4 s4 = *(const float4*)(sc + q * 256 + lane * 4); const float4 h4 = *(const float4*)(sh + q * 256 + lane * 4);
                const float mx_ = g4.x * (1.0f + s4.x), my_ = g4.y * (1.0f + s4.y), mz_ = g4.z * (1.0f + s4.z), mw_ = g4.w * (1.0f + s4.w);
#pragma unroll
                for (int rr = 0; rr < 2; ++rr) {
                    const float h0 = xv[rr][q].x * rn[rr] * mx_ + h4.x, h1 = xv[rr][q].y * rn[rr] * my_ + h4.y;
                    const float h2 = xv[rr][q].z * rn[rr] * mz_ + h4.z, h3 = xv[rr][q].w * rn[rr] * mw_ + h4.w;
                    uint2 pk; pk.x = pg8::cvt_pk_bf16(h0, h1); pk.y = pg8::cvt_pk_bf16(h2, h3);
                    *(uint2*)(Hout + (size_t)(t + rr) * D + q * 256 + lane * 4) = pk;
                }
            }
        }
    }
}

__device__ __forceinline__ float log_sigmoid(float x) { return -log1pf(expf(-x)); }
__device__ __forceinline__ int chunk_t0(int b, int cidx) { return cidx < 32 ? b * SEQ + cidx * 128 : TL + b * CL + (cidx - 32) * 128; }

__device__ __forceinline__ void m1_rope_states(const KQ p_in, int e, float* sm) {
    const KQ p = lq(p_in);
    const int tid = ltid(), bid = blockIdx.x, nb = gridDim.x;
    bf16_t* Z = (bf16_t*)(p.ws + WS_BIG);
    const float* rope = (const float*)(p.ws + WS_ROPE);
    for (int base = bid * 512 + tid; base < TL * 72; base += 2 * nb * 512) {
        bf16_t* zp[2]; bf16x8 a1[2], a2[2]; f32x4 c0[2], c1[2], s0[2], s1[2]; bool ok[2];
#pragma unroll
        for (int u = 0; u < 2; ++u) {
            const int idx = base + u * nb * 512; ok[u] = idx < TL * 72; const int ix = ok[u] ? idx : base;
            const int t = ix / 72, r = ix % 72; const int hd = r >> 2, i0 = (r & 3) * 8;
            const int cb = hd < 16 ? hd * 64 : 1536 + (hd - 16) * 64;
            const int tb = (hd >= 8 && hd < 16) ? 2 : 0; const int pos = t & (SEQ - 1);
            const float* cp = rope + (size_t)tb * SEQ * 32 + pos * 32 + i0; const float* sp = cp + (size_t)SEQ * 32;
            zp[u] = Z + (size_t)t * INW + cb + i0;
            a1[u] = *(const bf16x8*)zp[u]; a2[u] = *(const bf16x8*)(zp[u] + 32);
            c0[u] = *(const f32x4*)cp; c1[u] = *(const f32x4*)(cp + 4); s0[u] = *(const f32x4*)sp; s1[u] = *(const f32x4*)(sp + 4);
        }
#pragma unroll
        for (int u = 0; u < 2; ++u) {
            if (!ok[u]) continue;
            float o1[8], o2[8];
#pragma unroll
            for (int j = 0; j < 8; ++j) { const float x1 = bf2f((bf16_t)a1[u][j]), x2 = bf2f((bf16_t)a2[u][j]); const float cc = j < 4 ? c0[u][j & 3] : c1[u][j & 3], sn = j < 4 ? s0[u][j & 3] : s1[u][j & 3];
                o1[j] = x1 * cc - x2 * sn; o2[j] = x1 * sn + x2 * cc; }
            u32x4 w1, w2;
            w1.x = pg8::cvt_pk_bf16(o1[0], o1[1]); w1.y = pg8::cvt_pk_bf16(o1[2], o1[3]); w1.z = pg8::cvt_pk_bf16(o1[4], o1[5]); w1.w = pg8::cvt_pk_bf16(o1[6], o1[7]);
            w2.x = pg8::cvt_pk_bf16(o2[0], o2[1]); w2.y = pg8::cvt_pk_bf16(o2[2], o2[3]); w2.z = pg8::cvt_pk_bf16(o2[4], o2[5]); w2.w = pg8::cvt_pk_bf16(o2[6], o2[7]);
            *(u32x4*)zp[u] = w1; *(u32x4*)(zp[u] + 32) = w2;
        }
    }
    float* Ks = sm;
    float* Vs = sm + 128 * 64;
    float* wf = Vs + 128 * 64;
    float* wb = wf + 128;
    float* AF = (float*)(p.ws + WS_ST); float* AB = AF + SZ_ST / 4;
    const float* dec = pin_ld(13) + e * 16;
    for (int it = bid; it < NB * NCH * 8; it += nb) {
        const int h = it & 7, cidx = (it >> 3) % NCH, b = it / (8 * NCH);
        const int t0 = chunk_t0(b, cidx); const bool lat = cidx < 32;
        const float lgf = log_sigmoid(dec[h]), lgb = log_sigmoid(dec[8 + h]);
        __syncthreads();
        if (tid < 128) { wf[tid] = expf(lgf * (float)(127 - tid)); wb[tid] = expf(lgb * (float)tid); }
        const int kc = 1792 + h * 64, vc = 2304 + h * 64;
        {
            const int r = tid >> 2, pq = tid & 3;
            bf16_t* zp = Z + (size_t)(t0 + r) * INW + kc + 8 * pq;
            const bf16x8 a1 = *(const bf16x8*)zp, a2 = *(const bf16x8*)(zp + 32);
            float o1[8], o2[8];
            if (lat) {
                const int pos = (t0 + r) & (SEQ - 1);
                const float* cp = rope + (size_t)2 * SEQ * 32 + pos * 32 + 8 * pq; const float* sp = cp + (size_t)SEQ * 32;
                const f32x4 c0 = *(const f32x4*)cp, c1 = *(const f32x4*)(cp + 4), s0 = *(const f32x4*)sp, s1 = *(const f32x4*)(sp + 4);
#pragma unroll
                for (int j = 0; j < 8; ++j) { const float x1 = bf2f((bf16_t)a1[j]), x2 = bf2f((bf16_t)a2[j]); const float cc = j < 4 ? c0[j & 3] : c1[j & 3], sn = j < 4 ? s0[j & 3] : s1[j & 3];
                    o1[j] = bf2f(f2bf(x1 * cc - x2 * sn)); o2[j] = bf2f(f2bf(x1 * sn + x2 * cc)); }
                u32x4 w1, w2;
                w1.x = pg8::cvt_pk_bf16(o1[0], o1[1]); w1.y = pg8::cvt_pk_bf16(o1[2], o1[3]); w1.z = pg8::cvt_pk_bf16(o1[4], o1[5]); w1.w = pg8::cvt_pk_bf16(o1[6], o1[7]);
                w2.x = pg8::cvt_pk_bf16(o2[0], o2[1]); w2.y = pg8::cvt_pk_bf16(o2[2], o2[3]); w2.z = pg8::cvt_pk_bf16(o2[4], o2[5]); w2.w = pg8::cvt_pk_bf16(o2[6], o2[7]);
                *(u32x4*)zp = w1; *(u32x4*)(zp + 32) = w2;
            } else {
#pragma unroll
                for (int j = 0; j < 8; ++j) { o1[j] = bf2f((bf16_t)a1[j]); o2[j] = bf2f((bf16_t)a2[j]); }
            }
            *(f32x4*)(Ks + r * 64 + 8 * pq) = (f32x4){o1[0], o1[1], o1[2], o1[3]}; *(f32x4*)(Ks + r * 64 + 8 * pq + 4) = (f32x4){o1[4], o1[5], o1[6], o1[7]};
            *(f32x4*)(Ks + r * 64 + 32 + 8 * pq) = (f32x4){o2[0], o2[1], o2[2], o2[3]}; *(f32x4*)(Ks + r * 64 + 32 + 8 * pq + 4) = (f32x4){o2[4], o2[5], o2[6], o2[7]};
        }
#pragma unroll
        for (int q = 0; q < 2; ++q) { const int idx = tid + 512 * q; const int r = idx >> 3, pc = idx & 7;
            const bf16x8 vv = *(const bf16x8*)(Z + (size_t)(t0 + r) * INW + vc + 8 * pc);
            *(f32x4*)(Vs + r * 64 + 8 * pc) = (f32x4){bf2f((bf16_t)vv[0]), bf2f((bf16_t)vv[1]), bf2f((bf16_t)vv[2]), bf2f((bf16_t)vv[3])};
            *(f32x4*)(Vs + r * 64 + 8 * pc + 4) = (f32x4){bf2f((bf16_t)vv[4]), bf2f((bf16_t)vv[5]), bf2f((bf16_t)vv[6]), bf2f((bf16_t)vv[7])}; }
        __syncthreads();
        const int d = tid >> 3, e0 = (tid & 7) * 8;
        float af[8], ab[8];
#pragma unroll
        for (int j = 0; j < 8; ++j) { af[j] = 0.f; ab[j] = 0.f; }
        for (int s = 0; s < 128; ++s) {
            const float kv = Ks[s * 64 + d]; const float kfw = kv * wf[s], kbw = kv * wb[s];
            const float4 v0 = *(const float4*)(Vs + s * 64 + e0), v1 = *(const float4*)(Vs + s * 64 + e0 + 4);
            af[0] += kfw * v0.x; af[1] += kfw * v0.y; af[2] += kfw * v0.z; af[3] += kfw * v0.w; af[4] += kfw * v1.x; af[5] += kfw * v1.y; af[6] += kfw * v1.z; af[7] += kfw * v1.w;
            ab[0] += kbw * v0.x; ab[1] += kbw * v0.y; ab[2] += kbw * v0.z; ab[3] += kbw * v0.w; ab[4] += kbw * v1.x; ab[5] += kbw * v1.y; ab[6] += kbw * v1.z; ab[7] += kbw * v1.w;
        }
        const size_t so = ((size_t)(b * NCH + cidx) * 8 + h) * 4096 + d * 64 + e0;
        *(float4*)(AF + so) = make_float4(af[0], af[1], af[2], af[3]); *(float4*)(AF + so + 4) = make_float4(af[4], af[5], af[6], af[7]);
        *(float4*)(AB + so) = make_float4(ab[0], ab[1], ab[2], ab[3]); *(float4*)(AB + so + 4) = make_float4(ab[4], ab[5], ab[6], ab[7]);
    }
    __syncthreads();
}

__device__ __forceinline__ void m2_scan(const KQ p_in, int e) {
    const KQ p = lq(p_in);
    const float* __restrict__ AF = (const float*)(p.ws + WS_ST); const float* __restrict__ AB = AF + SZ_ST / 4;
    float* __restrict__ TF = (float*)(p.ws + WS_ST) + 2 * (SZ_ST / 4); float* __restrict__ TB = TF + SZ_ST / 4;
    const float* dec = pin_ld(13) + e * 16;
    for (int idx = blockIdx.x * 512 + ltid(); idx < NB * 8 * 4096; idx += gridDim.x * 512) {
        const int el = idx & 4095, h = (idx >> 12) & 7, b = idx >> 15;
        const float gf = expf(log_sigmoid(dec[h]) * 128.0f), gb = expf(log_sigmoid(dec[8 + h]) * 128.0f);
        const size_t base = ((size_t)(b * NCH) * 8 + h) * 4096 + el; constexpr size_t CS = (size_t)8 * 4096;
        float af[NCH], ab[NCH];
#pragma unroll
        for (int c = 0; c < NCH; ++c) { af[c] = AF[base + c * CS]; ab[c] = AB[base + c * CS]; }
        TF[base + 32 * CS] = 0.f; TF[base + 33 * CS] = af[32]; TB[base + 33 * CS] = 0.f; TB[base + 32 * CS] = ab[33];
        float sf = gf * af[32] + af[33], sb = ab[32] + gb * ab[33];
#pragma unroll
        for (int c = 0; c < 32; ++c) { TF[base + c * CS] = sf; sf = gf * sf + af[c]; }
#pragma unroll
        for (int c = 31; c >= 0; --c) { TB[base + c * CS] = sb; sb = ab[c] + gb * sb; }
    }
}

__device__ __forceinline__ bf16x8 pack8(const f32x4& a, const f32x4& b) {
    u32x4 w; w.x = pg8::cvt_pk_bf16(a[0], a[1]); w.y = pg8::cvt_pk_bf16(a[2], a[3]); w.z = pg8::cvt_pk_bf16(b[0], b[1]); w.w = pg8::cvt_pk_bf16(b[2], b[3]);
    return __builtin_bit_cast(bf16x8, w);
}
__device__ __forceinline__ void m3_outputs(const KQ p_in, int e, bool ctx_full, unsigned char* smem) {
    const KQ p = lq(p_in);
    const int tid = ltid(), bid = blockIdx.x, nb = gridDim.x;
    const int w = tid >> 6, lane = tid & 63, ln = lane & 15, g4 = lane >> 4;
    const bf16_t* Z = (const bf16_t*)(p.ws + WS_BIG);
    bf16_t* MIX = (bf16_t*)(p.ws + WS_MIX);
    const float* dec = pin_ld(13) + e * 16;
    const float* sink = pin_ld(12) + e * 8;
    const float* TF = (const float*)(p.ws + WS_ST) + 2 * (SZ_ST / 4); const float* TB = TF + SZ_ST / 4;
    const int nchunk = ctx_full ? NCH : 32;
    const int nitems = NB * nchunk * 8;
    bf16_t* Kt = (bf16_t*)smem;
    bf16_t* Vt = Kt + 128 * 72;
    bf16_t* TfT = Vt + 64 * 136;
    bf16_t* TbT = TfT + 64 * 72;
    const int i = 16 * w + ln;
    for (int it = bid; it < 2 * nitems; it += nb) {
        const bool is_attn = it < nitems; const int ii = is_attn ? it : it - nitems;
        const int h = ii & 7, cidx = (ii >> 3) % nchunk, b = ii / (8 * nchunk);
        const int t0 = chunk_t0(b, cidx); const bool lat = cidx < 32;
        f32x4 O[4];
#pragma unroll
        for (int m = 0; m < 4; ++m) O[m] = (f32x4){0.f, 0.f, 0.f, 0.f};
        if (!is_attn) {
            const float lgf = log_sigmoid(dec[h]), lgb = log_sigmoid(dec[8 + h]);
            __syncthreads();
#pragma unroll
            for (int q = 0; q < 2; ++q) { const int idx = tid + 512 * q; const int r = idx >> 3, pc = idx & 7; const bf16_t* zr = Z + (size_t)(t0 + r) * INW + h * 64 + pc * 8;
                *(u32x4*)(Kt + r * 72 + pc * 8) = *(const u32x4*)(zr + 1792);
                const bf16x8 vv = *(const bf16x8*)(zr + 2304);
#pragma unroll
                for (int j = 0; j < 8; ++j) Vt[(pc * 8 + j) * 136 + (r ^ (pc << 2))] = (bf16_t)vv[j]; }
            const size_t so = ((size_t)(b * NCH + cidx) * 8 + h) * 4096;
#pragma unroll
            for (int q = 0; q < 8; ++q) { const int idx = tid + 512 * q; const int d = idx >> 6, ee = idx & 63; TfT[ee * 72 + d] = f2bf(TF[so + idx]); TbT[ee * 72 + d] = f2bf(TB[so + idx]); }
            __builtin_amdgcn_sched_barrier(0);
            bf16x8 qf[2], qff[2], qfb[2];
            { const bf16_t* qr = Z + (size_t)(t0 + i) * INW + 512 + h * 64 + 8 * g4;
              const float cf = __expf(lgf * (float)(i + 1)), cb = __expf(lgb * (float)(128 - i));
#pragma unroll
              for (int k2 = 0; k2 < 2; ++k2) { qf[k2] = *(const bf16x8*)(qr + 32 * k2);
                  f32x4 a0, a1, b0, b1;
#pragma unroll
                  for (int j = 0; j < 4; ++j) { const float x0 = bf2f((bf16_t)qf[k2][j]), x1 = bf2f((bf16_t)qf[k2][4 + j]); a0[j] = x0 * cf; a1[j] = x1 * cf; b0[j] = x0 * cb; b1[j] = x1 * cb; }
                  qff[k2] = pack8(a0, a1); qfb[k2] = pack8(b0, b1); } }
            __builtin_amdgcn_sched_barrier(0);
            __syncthreads();
#pragma unroll
            for (int m = 0; m < 4; ++m)
#pragma unroll
                for (int k2 = 0; k2 < 2; ++k2) {
                    const bf16x8 af = *(const bf16x8*)(TfT + (16 * m + ln) * 72 + 32 * k2 + 8 * g4);
                    const bf16x8 ab = *(const bf16x8*)(TbT + (16 * m + ln) * 72 + 32 * k2 + 8 * g4);
                    O[m] = __builtin_amdgcn_mfma_f32_16x16x32_bf16(af, qff[k2], O[m], 0, 0, 0);
                    O[m] = __builtin_amdgcn_mfma_f32_16x16x32_bf16(ab, qfb[k2], O[m], 0, 0, 0);
                    __builtin_amdgcn_sched_barrier(0);
                }
            const float lf2 = lgf * 1.44269504f, lb2 = lgb * 1.44269504f; const int di = i - 4 * g4;
            const float bfw = lf2 * (float)di, bbw = -lb2 * (float)di;
            f32x4 st[8];
#pragma unroll
            for (int mt = 0; mt < 8; ++mt) {
                f32x4 a = (f32x4){0.f, 0.f, 0.f, 0.f};
#pragma unroll
                for (int k2 = 0; k2 < 2; ++k2) { const bf16x8 kf = *(const bf16x8*)(Kt + (16 * mt + ln) * 72 + 32 * k2 + 8 * g4); a = __builtin_amdgcn_mfma_f32_16x16x32_bf16(kf, qf[k2], a, 0, 0, 0); }
#pragma unroll
                for (int rg = 0; rg < 4; ++rg) { const int cc = 16 * mt + rg; const int df = di - cc;
                    const float arg = (df > 0) ? fmaf(-lf2, (float)cc, bfw) : fmaf(lb2, (float)cc, bbw);
                    float wgt = __builtin_amdgcn_exp2f(arg); wgt = (df == 0) ? 2.0f : wgt;
                    a[rg] *= wgt; }
                st[mt] = a;
                __builtin_amdgcn_sched_barrier(0);
            }
#pragma unroll
            for (int ks = 0; ks < 4; ++ks) {
                const bf16x8 pfr = pack8(st[2 * ks], st[2 * ks + 1]);
#pragma unroll
                for (int m = 0; m < 4; ++m) {
                    const int vrow = 16 * m + ln; const int kx = (32 * ks + 4 * g4) ^ (((vrow >> 3) & 7) << 2);
                    const bf16_t* vr = Vt + vrow * 136;
                    const bf16x4 v0 = *(const bf16x4*)(vr + kx), v1 = *(const bf16x4*)(vr + (kx ^ 16));
                    const bf16x8 vf = __builtin_shufflevector(v0, v1, 0, 1, 2, 3, 4, 5, 6, 7);
                    O[m] = __builtin_amdgcn_mfma_f32_16x16x32_bf16(vf, pfr, O[m], 0, 0, 0);
                }
                __builtin_amdgcn_sched_barrier(0);
            }
            float ss = 0.f;
#pragma unroll
            for (int m = 0; m < 4; ++m)
#pragma unroll
                for (int rg = 0; rg < 4; ++rg) ss += O[m][rg] * O[m][rg];
            ss += __shfl_xor(ss, 16, 64); ss += __shfl_xor(ss, 32, 64);
            const float rn = rsqrtf(ss * (1.0f / 64.0f) + EPS);
#pragma unroll
            for (int m = 0; m < 4; ++m) {
                const int ee = 16 * m + 4 * g4;
                const bf16x4 gv = *(const bf16x4*)(Z + (size_t)(t0 + i) * INW + 1024 + h * 64 + ee);
                uint2 o2; o2.x = pg8::cvt_pk_bf16(O[m][0] * rn * silu_f(bf2f((bf16_t)gv[0])), O[m][1] * rn * silu_f(bf2f((bf16_t)gv[1])));
                o2.y = pg8::cvt_pk_bf16(O[m][2] * rn * silu_f(bf2f((bf16_t)gv[2])), O[m][3] * rn * silu_f(bf2f((bf16_t)gv[3])));
                *(uint2*)(MIX + (size_t)(t0 + i) * D + 512 + h * 64 + ee) = o2;
            }
        } else {
            const int gk = h >> 2;
            bf16x8 qf[2];
            { const bf16_t* qr = Z + (size_t)(t0 + i) * INW + h * 64 + 8 * g4; qf[0] = *(const bf16x8*)qr; qf[1] = *(const bf16x8*)(qr + 32); }
            float mx = sink[h], l = (g4 == 0) ? 1.0f : 0.0f;
            const int qpos = lat ? (cidx * 128 + i) : 0;
#define ATT_VALID(tl_) ((tl_) >= 3 || (lat && (cidx - 1 + (tl_)) >= 0 && (cidx - 1 + (tl_)) < 32))
#define ATT_KT0(tl_) ((tl_) >= 3 ? TL + b * CL + ((tl_) - 3) * 128 : b * SEQ + (cidx - 1 + (tl_)) * 128)
            int tl = 0; while (!ATT_VALID(tl)) ++tl;
            u32x4 kreg[2]; bf16x8 vreg[2];
            { const int kt0 = ATT_KT0(tl);
#pragma unroll
              for (int q = 0; q < 2; ++q) { const int idx = tid + 512 * q; const int r = idx >> 3, pc = idx & 7; const bf16_t* zr = Z + (size_t)(kt0 + r) * INW + gk * 64 + pc * 8;
                  kreg[q] = *(const u32x4*)(zr + 1536); vreg[q] = *(const bf16x8*)(zr + 1664); } }
            while (tl < 5) {
                const bool isc = tl >= 3; const int kp0 = isc ? 0 : (cidx - 1 + tl) * 128;
                __syncthreads();
#pragma unroll
                for (int q = 0; q < 2; ++q) { const int idx = tid + 512 * q; const int r = idx >> 3, pc = idx & 7;
                    *(u32x4*)(Kt + r * 72 + pc * 8) = kreg[q];
#pragma unroll
                    for (int j = 0; j < 8; ++j) Vt[(pc * 8 + j) * 136 + (r ^ (pc << 2))] = (bf16_t)vreg[q][j]; }
                __syncthreads();
                int tn = tl + 1; while (tn < 5 && !ATT_VALID(tn)) ++tn;
                if (tn < 5) { const int kt0 = ATT_KT0(tn);
#pragma unroll
                    for (int q = 0; q < 2; ++q) { const int idx = tid + 512 * q; const int r = idx >> 3, pc = idx & 7; const bf16_t* zr = Z + (size_t)(kt0 + r) * INW + gk * 64 + pc * 8;
                        kreg[q] = *(const u32x4*)(zr + 1536); vreg[q] = *(const bf16x8*)(zr + 1664); } }
                f32x4 st[8];
                float mloc = -1e30f;
#pragma unroll
                for (int mt = 0; mt < 8; ++mt) {
                    f32x4 a = (f32x4){0.f, 0.f, 0.f, 0.f};
#pragma unroll
                    for (int k2 = 0; k2 < 2; ++k2) { const bf16x8 kf = *(const bf16x8*)(Kt + (16 * mt + ln) * 72 + 32 * k2 + 8 * g4); a = __builtin_amdgcn_mfma_f32_16x16x32_bf16(kf, qf[k2], a, 0, 0, 0); }
                    if (!isc) {
#pragma unroll
                        for (int rg = 0; rg < 4; ++rg) { const int dd = qpos - (kp0 + 16 * mt + 4 * g4 + rg); if (dd > 128 || dd < -128) a[rg] = -1e30f; }
                    }
#pragma unroll
                    for (int rg = 0; rg < 4; ++rg) mloc = fmaxf(mloc, a[rg]);
                    st[mt] = a;
                    __builtin_amdgcn_sched_barrier(0);
                }
                mloc = fmaxf(mloc, __shfl_xor(mloc, 16, 64)); mloc = fmaxf(mloc, __shfl_xor(mloc, 32, 64));
                const float mnew = fmaxf(mx, mloc);
                const float sc = __expf(mx - mnew); mx = mnew; l *= sc;
#pragma unroll
                for (int m = 0; m < 4; ++m) O[m] *= sc;
#pragma unroll
                for (int mt = 0; mt < 8; ++mt)
#pragma unroll
                    for (int rg = 0; rg < 4; ++rg) { const float pv = __expf(st[mt][rg] - mnew); st[mt][rg] = pv; l += pv; }
#pragma unroll
                for (int ks = 0; ks < 4; ++ks) {
                    const bf16x8 pfr = pack8(st[2 * ks], st[2 * ks + 1]);
#pragma unroll
                    for (int m = 0; m < 4; ++m) {
                        const int vrow = 16 * m + ln; const int kx = (32 * ks + 4 * g4) ^ (((vrow >> 3) & 7) << 2);
                        const bf16_t* vr = Vt + vrow * 136;
                        const bf16x4 v0 = *(const bf16x4*)(vr + kx), v1 = *(const bf16x4*)(vr + (kx ^ 16));
                        const bf16x8 vf = __builtin_shufflevector(v0, v1, 0, 1, 2, 3, 4, 5, 6, 7);
                        O[m] = __builtin_amdgcn_mfma_f32_16x16x32_bf16(vf, pfr, O[m], 0, 0, 0);
                    }
                    __builtin_amdgcn_sched_barrier(0);
                }
                tl = tn;
            }
#undef ATT_VALID
#undef ATT_KT0
            l += __shfl_xor(l, 16, 64); l += __shfl_xor(l, 32, 64);
            const float inv = 1.0f / l;
#pragma unroll
            for (int m = 0; m < 4; ++m) {
                uint2 o2; o2.x = pg8::cvt_pk_bf16(O[m][0] * inv, O[m][1] * inv); o2.y = pg8::cvt_pk_bf16(O[m][2] * inv, O[m][3] * inv);
                *(uint2*)(MIX + (size_t)(t0 + i) * D + h * 64 + 16 * m + 4 * g4) = o2;
            }
        }
    }
    __syncthreads();
}

__device__ __forceinline__ void h2_shortconv(const KQ p_in, int o, int M, unsigned char* smem) {
    const KQ p = lq(p_in);
    const int tid = ltid();
    const bf16_t* ZH = (const bf16_t*)(p.ws + WS_BIG);
    const float* w = pin_ld(17) + (size_t)o * 3 * HYW; const float* bs = pin_ld(18) + (size_t)o * HYW;
    bf16_t* VXT = (bf16_t*)(p.ws + WS_Y); bf16_t* X0T = VXT + (size_t)D * TL;
    bf16_t* tx = (bf16_t*)smem;
    bf16_t* tv = tx + 64 * 136;
    const int tok = tid >> 3, cg8 = (tid & 7) * 8;
    float* wl = (float*)(smem + 40960);
    { const int c0b = (blockIdx.x & 15) * 64;
      for (int i = tid; i < 768; i += 512) { const int k = i >> 8, q = (i >> 6) & 3, c = i & 63; const int col = k * 1024 + c0b + c; wl[i] = (q < 3) ? w[q * HYW + col] : bs[col]; } }
    __syncthreads();
    for (int it = blockIdx.x; it < (TL / 128) * 16; it += gridDim.x) {
        const int c0 = (it & 15) * 64, t0 = (it >> 4) * 128;
        bf16x8 zc[2][3], zp[2][3], zn[2][3];
#pragma unroll
        for (int g = 0; g < 2; ++g) {
            const int t = t0 + tok + 64 * g; const int pos = t & (SEQ - 1); const bool first = pos == 0, last = pos == SEQ - 1;
#pragma unroll
            for (int k = 0; k < 3; ++k) {
                const int c = k * 1024 + c0 + cg8;
                zc[g][k] = *(const bf16x8*)(ZH + (size_t)t * HYW + c);
                zp[g][k] = *(const bf16x8*)(ZH + (size_t)(first ? t : t - 1) * HYW + c);
                zn[g][k] = *(const bf16x8*)(ZH + (size_t)(last ? t : t + 1) * HYW + c);
            }
        }
        __syncthreads();
#pragma unroll
        for (int g = 0; g < 2; ++g) {
            const int t = t0 + tok + 64 * g; const int pos = t & (SEQ - 1); const float mf = (pos == 0) ? 0.f : 1.f, ml = (pos == SEQ - 1) ? 0.f : 1.f;
            float zz[3][8];
#pragma unroll
            for (int k = 0; k < 3; ++k) {
                const float* wk = wl + k * 256 + cg8;
#pragma unroll
                for (int j = 0; j < 8; ++j)
                    zz[k][j] = wk[192 + j] + bf2f((bf16_t)zc[g][k][j]) * wk[64 + j] + mf * bf2f((bf16_t)zp[g][k][j]) * wk[j] + ml * bf2f((bf16_t)zn[g][k][j]) * wk[128 + j];
            }
#pragma unroll
            for (int j = 0; j < 8; ++j) { const int cs = (tok + 64 * g) ^ ((tid & 7) << 3);
                tx[(cg8 + j) * 136 + cs] = f2bf(zz[0][j]); tv[(cg8 + j) * 136 + cs] = f2bf(zz[2][j] * zz[1][j]); }
        }
        __syncthreads();
        { const int ch = tid >> 3, tk = (tid & 7) * 8;
#pragma unroll
          for (int q = 0; q < 2; ++q) {
            const int cs = (tk + 64 * q) ^ (((ch >> 3) & 7) << 3);
            *(u32x4*)(X0T + (size_t)(c0 + ch) * TL + t0 + tk + 64 * q) = *(const u32x4*)(tx + ch * 136 + cs);
            *(u32x4*)(VXT + (size_t)(c0 + ch) * TL + t0 + tk + 64 * q) = *(const u32x4*)(tv + ch * 136 + cs); } }
    }
    __syncthreads();
    if (M > TL) {
        float* VX = (float*)(p.ws + WS_Y); bf16_t* X0 = (bf16_t*)(p.ws + WS_H);
        for (int idx = TL * D + blockIdx.x * 512 + tid; idx < M * D; idx += gridDim.x * 512) {
            const int t = idx >> 10, d = idx & 1023;
            const int pos = (t - TL) & (CL - 1); const bool first = pos == 0, last = pos == CL - 1;
            float zz[3];
#pragma unroll
            for (int k = 0; k < 3; ++k) {
                const int c = k * 1024 + d;
                float sacc = bs[c] + bf2f(ZH[(size_t)t * HYW + c]) * w[HYW + c];
                if (!first) sacc += bf2f(ZH[(size_t)(t - 1) * HYW + c]) * w[c];
                if (!last) sacc += bf2f(ZH[(size_t)(t + 1) * HYW + c]) * w[2 * HYW + c];
                zz[k] = sacc;
            }
            VX[idx] = zz[2] * zz[1]; X0[idx] = f2bf(zz[0]);
        }
    }
}

typedef float f32x16 __attribute__((ext_vector_type(16)));
__device__ __forceinline__ void h3_longconv(const KQ p_in, int o, bool ctx_full, unsigned char* smem) {
    const KQ p = lq(p_in);
    const int tid = ltid(), w = tid >> 6, lane = tid & 63;
    const float* bias = pin_ld(27) + (size_t)o * D;
    {
        const bf16_t* VXT = (const bf16_t*)(p.ws + WS_Y); const bf16_t* X0T = VXT + (size_t)D * TL;
        bf16_t* HMT = (bf16_t*)(p.ws + WS_H);
        const bf16_t* RKT = (const bf16_t*)(p.ws + WS_KF + (size_t)o * SZ_KF);
        constexpr int RK2_OFF = 16384 + 64, U_OFF = 2 * 16384 + 128, CH_BYTES = U_OFF + 142 * 256;
        const int cw = w >> 2, w4 = w & 3;
        const int ct = tid & 255;
        unsigned char* cb = smem + cw * CH_BYTES;
        unsigned char* ub = cb + U_OFF;
        const int r = lane & 31, hh = lane >> 5;
        for (int pr = blockIdx.x; pr < D / 2; pr += gridDim.x) {
            const int d = pr * 2 + cw;
            __syncthreads();
            { const bf16_t* src = RKT + (size_t)d * 8192;
              for (int i = ct; i < 1024; i += 256) *(u32x4*)(cb + i * 16) = *(const u32x4*)(src + i * 8);
              for (int i = ct; i < 2 * 7 * 4 * 4; i += 256) { const int side = i / 112, rem = i % 112; unsigned z0 = 0u; asm volatile("" : "+v"(z0)); *(u32x4*)(ub + (side ? (135 * 4 * 64) : 0) + rem * 16) = (u32x4){z0, z0, z0, z0}; }
#pragma unroll 8
              for (int i = ct; i < 4 * 512; i += 256) { const int b = i >> 9, pc = i & 511;
                  const u32x4 v = *(const u32x4*)(VXT + (size_t)d * TL + b * SEQ + pc * 8);
                  const int col = ((pc >> 2) + 7) * 4 + b, q = pc & 3;
                  *(u32x4*)(ub + col * 64 + ((q ^ ((col >> 2) & 3)) * 16)) = v; } }
            __syncthreads();
            { const bf16_t* rk = (const bf16_t*)cb; bf16_t* rk2 = (bf16_t*)(cb + RK2_OFF);
#pragma unroll 4
              for (int i = ct; i < 4096; i += 256) { const unsigned lo = rk[2 * i + 1]; const unsigned hi = (2 * i + 2 < 8192) ? rk[2 * i + 2] : 0u; *(unsigned*)(rk2 + 2 * i) = lo | (hi << 16); } }
            __syncthreads();
            f32x16 acc[4];
#pragma unroll
            for (int j = 0; j < 4; ++j)
#pragma unroll
                for (int q = 0; q < 16; ++q) acc[j][q] = 0.f;
            const bf16_t* rsel = (const bf16_t*)(cb + ((r & 1) ? 0 : RK2_OFF));
            const int adj = (r & 1) ? 0 : -1;
            const int bq = r & 3;
#define H3_LOAD(AF, BF, U) do { \
                _Pragma("unroll") for (int s2 = 0; s2 < 2; ++s2) { \
                    const unsigned* ap = (const unsigned*)(Ab + 64 * (3 - (U)) + 32 * s2); \
                    u32x4 t4; t4.x = ap[0]; t4.y = ap[1]; t4.z = ap[2]; t4.w = ap[3]; \
                    AF[s2] = __builtin_bit_cast(bf16x8, t4); } \
                _Pragma("unroll") for (int j = 0; j < 4; ++j) { \
                    int c_ = Lb - 256 * (U) + 2048 * j; c_ = c_ < LO ? LO : (c_ > HI ? HI : c_); \
                    BF[j][0] = *(const bf16x8*)(ub + c_ + off[U][0]); BF[j][1] = *(const bf16x8*)(ub + c_ + off[U][1]); } } while (0)
#define H3_MMA(AF, BF) do { \
                _Pragma("unroll") for (int s2 = 0; s2 < 2; ++s2) \
                _Pragma("unroll") for (int j = 0; j < 4; ++j) acc[j] = __builtin_amdgcn_mfma_f32_32x32x16_bf16(AF[s2], BF[j][s2], acc[j], 0, 0, 0); } while (0)
            {
                const int dlo = 32 * w4 - 127;
                const int LO = (24 + bq) * 64, HI = (540 + bq) * 64;
                int off[4][2];
#pragma unroll
                for (int u = 0; u < 4; ++u) { const int sw = ((r >> 2) + 2 - u) & 3; off[u][0] = (hh ^ sw) * 16; off[u][1] = ((2 + hh) ^ sw) * 16; }
                int Lb = (((r >> 2) + 134) * 4 + bq) * 64;
                const unsigned char* Ab = (const unsigned char*)(rsel + (4095 - 32 * dlo - r + 8 * hh + adj)) - 192;
                bf16x8 afA[2], bfA[4][2], afB[2], bfB[4][2];
                H3_LOAD(afA, bfA, 0);
                for (int g = 0; g < 39; ++g) {
                    H3_LOAD(afB, bfB, 1);
                    __builtin_amdgcn_sched_barrier(0);
                    H3_MMA(afA, bfA);
                    __builtin_amdgcn_sched_barrier(0);
                    H3_LOAD(afA, bfA, 2);
                    __builtin_amdgcn_sched_barrier(0);
                    H3_MMA(afB, bfB);
                    __builtin_amdgcn_sched_barrier(0);
                    H3_LOAD(afB, bfB, 3);
                    __builtin_amdgcn_sched_barrier(0);
                    H3_MMA(afA, bfA);
                    __builtin_amdgcn_sched_barrier(0);
                    Ab -= 256; Lb -= 1024;
                    H3_LOAD(afA, bfA, 0);
                    __builtin_amdgcn_sched_barrier(0);
                    H3_MMA(afB, bfB);
                    __builtin_amdgcn_sched_barrier(0);
                }
                H3_LOAD(afB, bfB, 1);
                __builtin_amdgcn_sched_barrier(0);
                H3_MMA(afA, bfA);
                __builtin_amdgcn_sched_barrier(0);
                H3_LOAD(afA, bfA, 2);
                __builtin_amdgcn_sched_barrier(0);
                H3_MMA(afB, bfB);
                H3_MMA(afA, bfA);
            }
#undef H3_LOAD
#undef H3_MMA
            __syncthreads();
            const float bd = bias[d];
#pragma unroll
            for (int j = 0; j < 4; ++j) {
                const int n1 = 8 * (4 * w4 + j) + (r >> 2);
                const int col = (n1 + 7) * 4 + bq; const int sw = (col >> 2) & 3;
                bf16_t* up = (bf16_t*)(ub + col * 64);
#pragma unroll
                for (int q4 = 0; q4 < 4; ++q4) {
                    bf16_t* pp = up + ((q4 ^ sw) * 8) + 4 * hh;
                    const bf16x4 uv = *(const bf16x4*)pp;
                    uint2 o2; o2.x = pg8::cvt_pk_bf16(acc[j][4 * q4] + bd * bf2f((bf16_t)uv[0]), acc[j][4 * q4 + 1] + bd * bf2f((bf16_t)uv[1]));
                    o2.y = pg8::cvt_pk_bf16(acc[j][4 * q4 + 2] + bd * bf2f((bf16_t)uv[2]), acc[j][4 * q4 + 3] + bd * bf2f((bf16_t)uv[3]));
                    *(uint2*)pp = o2;
                }
            }
            __syncthreads();
#pragma unroll 4
            for (int i = ct; i < 4 * 512; i += 256) { const int b = i >> 9, pc = i & 511;
                const int col = ((pc >> 2) + 7) * 4 + b, q = pc & 3;
                const bf16x8 yv = *(const bf16x8*)(ub + col * 64 + ((q ^ ((col >> 2) & 3)) * 16));
                const size_t gi = (size_t)d * TL + b * SEQ + pc * 8;
                const bf16x8 xv = *(const bf16x8*)(X0T + gi);
                u32x4 o4;
                o4.x = pg8::cvt_pk_bf16(bf2f((bf16_t)yv[0]) * bf2f((bf16_t)xv[0]), bf2f((bf16_t)yv[1]) * bf2f((bf16_t)xv[1]));
                o4.y = pg8::cvt_pk_bf16(bf2f((bf16_t)yv[2]) * bf2f((bf16_t)xv[2]), bf2f((bf16_t)yv[3]) * bf2f((bf16_t)xv[3]));
                o4.z = pg8::cvt_pk_bf16(bf2f((bf16_t)yv[4]) * bf2f((bf16_t)xv[4]), bf2f((bf16_t)yv[5]) * bf2f((bf16_t)xv[5]));
                o4.w = pg8::cvt_pk_bf16(bf2f((bf16_t)yv[6]) * bf2f((bf16_t)xv[6]), bf2f((bf16_t)yv[7]) * bf2f((bf16_t)xv[7]));
                *(u32x4*)(HMT + gi) = o4; }
        }
        __syncthreads();
    }
    if (ctx_full) {
        const float* VX = (const float*)(p.ws + WS_Y); const bf16_t* X0 = (const bf16_t*)(p.ws + WS_H);
        bf16_t* MIX = (bf16_t*)(p.ws + WS_MIX);
        const float* kf = (const float*)(p.ws + WS_KF + (size_t)o * SZ_KF) + (size_t)2 * SEQ * D;
        for (int idx = blockIdx.x * 512 + tid; idx < (TC / 8) * D; idx += gridDim.x * 512) {
            const int d = idx & 1023, og = idx >> 10;
            const int bb = og >> 5, n0 = (og & 31) * 8, tb = TL + bb * CL;
            const float* up = VX + (size_t)tb * D + d;
            float acc[8];
#pragma unroll
            for (int j = 0; j < 8; ++j) acc[j] = 0.f;
#pragma unroll 1
            for (int mb = 0; mb < CL; mb += 8) {
                float kk[15], uu[8];
#pragma unroll
                for (int q = 0; q < 15; ++q) { const int lag = n0 - mb - 7 + q;
                    kk[q] = (lag >= 0) ? ((lag < CL) ? kf[(size_t)lag * D + d] : 0.f) : ((-lag < CL) ? kf[(size_t)(CL - lag) * D + d] : 0.f); }
#pragma unroll
                for (int u = 0; u < 8; ++u) uu[u] = up[(size_t)(mb + u) * D];
#pragma unroll
                for (int u = 0; u < 8; ++u)
#pragma unroll
                    for (int j = 0; j < 8; ++j) acc[j] += uu[u] * kk[7 - u + j];
            }
            const float bd = bias[d];
#pragma unroll
            for (int j = 0; j < 8; ++j) { const size_t ti = (size_t)(tb + n0 + j) * D + d; MIX[ti] = f2bf(bf2f(X0[ti]) * (acc[j] + bd * VX[ti])); }
        }
    }
}

__device__ __forceinline__ void h3b_transpose(const KQ p_in, unsigned char* smem) {
    const KQ p = lq(p_in);
    const int tid = ltid();
    const bf16_t* HMT = (const bf16_t*)(p.ws + WS_H); bf16_t* MIX = (bf16_t*)(p.ws + WS_MIX);
    bf16_t* tile = (bf16_t*)smem;
    for (int it = blockIdx.x; it < (TL / 256) * 16; it += gridDim.x) {
        const int c0 = (it & 15) * 64, t0 = (it >> 4) * 256;
        u32x4 ld[4];
        { const int ch = tid >> 3, tk = (tid & 7) * 8;
#pragma unroll
          for (int q = 0; q < 4; ++q) ld[q] = *(const u32x4*)(HMT + (size_t)(c0 + ch) * TL + t0 + tk + 64 * q);
          __syncthreads();
#pragma unroll
          for (int q = 0; q < 4; ++q) *(u32x4*)(tile + ch * 264 + ((tk + 64 * q) ^ (((ch >> 3) & 7) << 3))) = ld[q]; }
        __syncthreads();
        { const int cg8 = (tid & 7) * 8;
#pragma unroll
          for (int q = 0; q < 4; ++q) { const int tok = (tid >> 3) + 64 * q; unsigned short v[8];
#pragma unroll
              for (int j = 0; j < 8; ++j) v[j] = tile[(cg8 + j) * 264 + (tok ^ ((tid & 7) << 3))];
              u32x4 o4; o4.x = v[0] | ((unsigned)v[1] << 16); o4.y = v[2] | ((unsigned)v[3] << 16); o4.z = v[4] | ((unsigned)v[5] << 16); o4.w = v[6] | ((unsigned)v[7] << 16);
              *(u32x4*)(MIX + (size_t)(t0 + tok) * D + c0 + cg8) = o4; } }
    }
    __syncthreads();
}

__global__ void __launch_bounds__(512, 2) mega_fwd(KP kp) {
    unsigned char* const smem = g_smem;
    if (threadIdx.x < 29) *(LAS unsigned long long*)((LAS unsigned char*)g_smem + PTAB_OFF + 8 * threadIdx.x) = ((const unsigned long long*)__builtin_amdgcn_kernarg_segment_ptr())[threadIdx.x];
    KQ p; p.out = kp.out; p.ws = kp.ws;
    cg::grid_group grid = cg::this_grid();
    if (threadIdx.x < 4) ((volatile LAS unsigned*)(LAS unsigned char*)smem)[(LDS_BYTES - 16) / 4 + threadIdx.x] = 0u;
    __syncthreads();
    if (threadIdx.x == 0) (void)xb_add(&((unsigned*)(lq(p).ws + WS_BAR))[XB_XCNT(xb_xcc_id())], 1u);
    grid.sync();
    float* smf = (float*)smem;
#define Hb ((bf16_t*)(lq(p).ws + WS_H))
#define BIG ((bf16_t*)(lq(p).ws + WS_BIG))
#define Y ((bf16_t*)(lq(p).ws + WS_Y))
#define MIX ((bf16_t*)(lq(p).ws + WS_MIX))

#ifndef NO_P0
    p0_setup(p, smf);
#endif
    GRID_BAR();
    rowphase(p, 0, nullptr, 0, 0, 0.f, nullptr, T, 0, pin_ld(6), 0, 1, Hb, true, 0);
    GRID_BAR();
    for (int l = 0; l < 4; ++l) {
        const bool ctx_live = l <= 2, ctx_full = l < 2;
        const int Mff = ctx_live ? T : TL, Mpost = ctx_full ? T : TL;
        for (int sub = 0; sub < 3; ++sub) {
            const bf16_t* Ao; const bf16_t* Bo; int Ko; int Mo;
            if (sub != 1) {
                const int fi = sub >> 1; const int M = (sub == 0) ? Mff : Mpost;
                { pg8::EpiSwiGLU E{BIG, DFF}; run_gemm(smem, Hb, (const bf16_t*)(lq(p).ws + WS_WGU + (size_t)(l * 2 + fi) * SZ_WGU), M, 2 * DFF, D, E); }
                GRID_BAR();
                Ao = BIG; Bo = (const bf16_t*)(lq(p).ws + WS_WD + (size_t)(l * 2 + fi) * SZ_WD); Ko = DFF; Mo = M;
            } else {
                if ((l & 1) == 0) {
                    const int e = l >> 1;
                    { pg8::EpiBf16 E{BIG, INW, nullptr}; run_gemm(smem, Hb, (const bf16_t*)(lq(p).ws + WS_WIN + (size_t)e * SZ_WIN), Mff, INW, D, E); }
                    GRID_BAR();
#ifndef NO_M1
                    m1_rope_states(p, e, smf);
#endif
                    GRID_BAR();
#ifndef NO_M2
                    m2_scan(p, e);
#endif
                    GRID_BAR();
#ifndef NO_M3
                    m3_outputs(p, e, ctx_full, smem);
#endif
                    GRID_BAR();
                    Bo = (const bf16_t*)(lq(p).ws + WS_WOUT + (size_t)e * SZ_WOUT);
                } else {
                    const int o = l >> 1;
                    { pg8::EpiBf16 E{BIG, HYW, pin_ld(16) + (size_t)o * HYW}; run_gemm(smem, Hb, (const bf16_t*)(lq(p).ws + WS_HWIN + (size_t)o * SZ_HWIN), Mpost, HYW, D, E); }
                    GRID_BAR();
#ifndef NO_H2
                    h2_shortconv(p, o, Mpost, smem);
#endif
                    GRID_BAR();
#ifndef NO_H3
                    h3_longconv(p, o, ctx_full, smem);
#endif
                    GRID_BAR();
                    h3b_transpose(p, smem);
                    GRID_BAR();
                    Bo = (const bf16_t*)(lq(p).ws + WS_HWOUT + (size_t)o * SZ_WOUT);
                }
                Ao = MIX; Ko = D; Mo = Mpost;
            }
            const int gidx = 2 + 3 * sub;
            const int ln = (sub == 2) ? l + 1 : l; const bool has_next = ln < 4; const int lnn = has_next ? ln : l;
            const int pre_i = (sub == 2) ? 0 : sub + 1;
            const int Mn = has_next ? ((sub == 2) ? ((ln <= 2) ? T : TL) : ((sub == 0) ? Mff : Mpost)) : 0;
            const float* gpost = pin_ld(7) + (size_t)(l * 3 + sub) * D; const float* gpre = pin_ld(6) + (size_t)(lnn * 3 + pre_i) * D;
            const float wg = (sub == 1) ? 1.0f : 0.5f;
            {
                pg8::EpiFusedRow EF;
                EF.xin = (l == 0 && sub == 0) ? pin_ld(0) : (const float*)lq(p).out; EF.xout = lq(p).out; EF.H = has_next ? Hb : nullptr;
                EF.gate = modp(lq(p), l, 0, gidx); EF.gpost = gpost; EF.wgt = wg;
                EF.gpre = gpre; EF.shift = modp(lq(p), lnn, 0, 3 * pre_i); EF.scale = modp(lq(p), lnn, 0, 3 * pre_i + 1);
                EF.slots = (float*)(lq(p).ws + WS_SLOT); EF.cnt = (unsigned*)(lq(p).ws + WS_CNT) + (size_t)(l * 3 + sub) * 2 * 64 * 64;
                run_gemm_f32_split(smem, Ao, Bo, Mo, Ko, EF, (float*)(lq(p).ws + WS_YP));
            }
            if (Mo > TL && blockIdx.x < 64) {
                sub_barrier((unsigned*)(lq(p).ws + WS_CNT) + (size_t)12 * 2 * 64 * 64 + (l * 3 + sub) * 64, 64u);
                rowphase(p, Mo, Y, l, gidx, wg, gpost, Mn, lnn, gpre, 3 * pre_i, 3 * pre_i + 1, has_next ? Hb : nullptr, l == 0 && sub == 0, TL);
            }
            GRID_BAR();
        }
    }
}

extern "C" void kernel_launch(void* const* d_in, const int* in_sizes, int n_in, void* d_out, int out_size, void* d_ws, size_t ws_size, hipStream_t stream) {
    static int grid = 0;
    if (grid == 0) {
        if (n_in != 29 || out_size != TL * D || ws_size < WS_END) { fprintf(stderr, "kernel_launch: unexpected shapes: n_in %d out %d ws %zu (need %zu)\n", n_in, out_size, ws_size, (size_t)WS_END); grid = -1; return; }
        int dev = 0, cus = 0, per_cu = 0;
        (void)hipGetDevice(&dev);
        (void)hipDeviceGetAttribute(&cus, hipDeviceAttributeMultiprocessorCount, dev);
        if (hipFuncSetAttribute((const void*)mega_fwd, hipFuncAttributeMaxDynamicSharedMemorySize, LDS_BYTES) != hipSuccess) { fprintf(stderr, "kernel_launch: hipFuncSetAttribute failed\n"); grid = -1; return; }
        if (hipOccupancyMaxActiveBlocksPerMultiprocessor(&per_cu, (const void*)mega_fwd, 512, LDS_BYTES) != hipSuccess || per_cu < 1) { fprintf(stderr, "kernel_launch: occupancy query says %d\n", per_cu); per_cu = 1; }
        (void)hipGetLastError();
        grid = cus >= 256 ? 256 : cus;
    }
    if (grid < 0) return;
    (void)hipMemsetAsync((unsigned char*)d_ws + WS_BAR, 0, 16384 + SZ_CNT, stream);
    KP kp{};
    for (int i = 0; i < 29; ++i) kp.in[i] = (const float*)d_in[i];
    kp.out = (float*)d_out; kp.ws = (unsigned char*)d_ws;
    void* args[] = {&kp};
    hipError_t e = hipLaunchCooperativeKernel((const void*)mega_fwd, dim3(grid), dim3(512), args, LDS_BYTES, stream);
    if (e != hipSuccess) fprintf(stderr, "cooperative launch failed: %s (grid %d)\n", hipGetErrorString(e), grid);
}
```

```cpp
#include <hip/hip_runtime.h>
#include <hip/hip_cooperative_groups.h>
#include <cstdio>
namespace cg = cooperative_groups;

#define LAS __attribute__((address_space(3)))
typedef unsigned short bf16_t;
typedef short bf16x8 __attribute__((ext_vector_type(8)));
typedef short bf16x4 __attribute__((ext_vector_type(4)));
typedef float f32x4 __attribute__((ext_vector_type(4)));
typedef unsigned u32x4 __attribute__((ext_vector_type(4)));

constexpr int D = 1024, NB = 4, SEQ = 4096, CL = 256, TL = NB * SEQ, TC = NB * CL, T = TL + TC, DFF = 2816, INW = 2816, HYW = 3072;
constexpr int NMOD = 9;
constexpr float EPS = 1e-6f;
constexpr int NCH = 34;
constexpr int LDS_BYTES = 144 * 1024;

constexpr size_t SZ_WGU = (size_t)2 * DFF * D * 2, SZ_WD = (size_t)D * DFF * 2, SZ_WIN = (size_t)INW * D * 2, SZ_WOUT = (size_t)D * D * 2, SZ_HWIN = (size_t)HYW * D * 2;
constexpr size_t WS_WGU = 0;
constexpr size_t WS_WD = WS_WGU + 8 * SZ_WGU;
constexpr size_t WS_WIN = WS_WD + 8 * SZ_WD;
constexpr size_t WS_WOUT = WS_WIN + 2 * SZ_WIN;
constexpr size_t WS_HWIN = WS_WOUT + 2 * SZ_WOUT;
constexpr size_t WS_HWOUT = WS_HWIN + 2 * SZ_HWIN;
constexpr size_t WS_MOD = WS_HWOUT + 2 * SZ_WOUT;
constexpr size_t WS_ROPE = WS_MOD + (size_t)4 * 5 * NMOD * D * 4;
constexpr size_t WS_XC = WS_ROPE + (size_t)4 * SEQ * 32 * 4;
constexpr size_t WS_H = WS_XC + (size_t)TC * D * 4;
constexpr size_t WS_BIG = WS_H + (size_t)T * D * 2;
constexpr size_t WS_Y = WS_BIG + (size_t)T * HYW * 2;
constexpr size_t WS_MIX = WS_Y + (size_t)T * D * 4;
constexpr size_t SZ_ST = (size_t)NB * NCH * 8 * 4096 * 4;
constexpr size_t WS_ST = WS_MIX + (size_t)T * D * 2;
constexpr size_t SZ_KF = (size_t)(SEQ + CL) * 2 * D * 4;
constexpr size_t WS_KF = WS_ST + 4 * SZ_ST;
constexpr size_t WS_YP = WS_KF + 2 * SZ_KF;
constexpr size_t WS_BAR = WS_YP + (size_t)4 * TC * D * 4;
constexpr size_t WS_CNT = WS_BAR + 16384;
constexpr size_t SZ_CNT = (size_t)12 * 2 * 64 * 256 + 12 * 256;
constexpr size_t WS_SLOT = WS_CNT + SZ_CNT;
constexpr size_t WS_END = WS_SLOT + (size_t)2 * TL * 4 * 4;

struct KP { const float* in[29]; float* out; unsigned char* ws; };
extern __shared__ __attribute__((aligned(16))) unsigned char g_smem[];
constexpr int PTAB_OFF = LDS_BYTES - 512;
__device__ __forceinline__ const float* pin_ld(int k) {
    const unsigned long long v = *(volatile LAS unsigned long long*)((LAS unsigned char*)g_smem + PTAB_OFF + 8 * k);
    const unsigned lo = __builtin_amdgcn_readfirstlane((unsigned)v), hi = __builtin_amdgcn_readfirstlane((unsigned)(v >> 32));
    return (const float*)(((unsigned long long)hi << 32) | lo);
}
struct KQ { float* out; unsigned char* ws; };
__device__ __forceinline__ KQ lq(KQ q) { asm volatile("" : "+s"(q.out), "+s"(q.ws)); return q; }

__device__ __forceinline__ bf16_t f2bf(float f) { unsigned u = __float_as_uint(f); u += 0x7FFFu + ((u >> 16) & 1u); return (bf16_t)(u >> 16); }
__device__ __forceinline__ float bf2f(bf16_t b) { return __uint_as_float(((unsigned)b) << 16); }
__device__ __forceinline__ float silu_f(float x) { return x * __builtin_amdgcn_rcpf(1.0f + __expf(-x)); }
__device__ __forceinline__ int ltid() { int t = threadIdx.x; asm volatile("" : "+v"(t)); return t; }
__device__ __forceinline__ float wave_sum(float v) {
#pragma unroll
    for (int o = 32; o > 0; o >>= 1) v += __shfl_xor(v, o, 64);
    return v;
}


#define XB_TMO      128
#define XB_XCNT(j)  (256  + 64 * (j))
#define XB_XSUB(j)  (1280 + 64 * (j))
#define XB_XGEN(j)  (2304 + 64 * (j))
#define XB_TOP      3328
#define XB_TOPGEN   3392
#define XCD_BAR_WORDS 3456
#define XB_SPIN_CAP (1u << 18)
__device__ __forceinline__ unsigned xb_ld(unsigned* p)              { return __hip_atomic_load(p, __ATOMIC_RELAXED, __HIP_MEMORY_SCOPE_AGENT); }
__device__ __forceinline__ unsigned xb_add(unsigned* p, unsigned v) { return __hip_atomic_fetch_add(p, v, __ATOMIC_RELAXED, __HIP_MEMORY_SCOPE_AGENT); }
__device__ __forceinline__ unsigned xb_xcc_id() { return (unsigned)__builtin_amdgcn_s_getreg((3 << 11) | 20) & 0xFu; }
#define XB_SPIN(cond, bar) do { unsigned _sp = 0; while (cond) { __builtin_amdgcn_s_sleep(1); \
    if ((++_sp & 255u) == 0u) { if (xb_ld(&(bar)[XB_TMO])) break; if (_sp > XB_SPIN_CAP) { atomicAdd(&(bar)[XB_TMO], 1u); break; } } } } while (0)
struct XcdBarrier { unsigned* bar; unsigned x; volatile LAS unsigned* st; };
__device__ __forceinline__ XcdBarrier xcd_barrier_post(unsigned* bar, volatile LAS unsigned* st) {
    XcdBarrier b; b.bar = bar; b.x = xb_xcc_id(); b.st = st;
    if (threadIdx.x == 0) (void)xb_add(&bar[XB_XCNT(b.x)], 1u);
    return b;
}
__device__ __forceinline__ void xcd_barrier_complete(unsigned* bar, unsigned x, unsigned& nloc, unsigned& nx) {
    const unsigned G = gridDim.x * gridDim.y * gridDim.z;
    unsigned sum, cnt, mine, sp = 0u;
    for (;;) {
        sum = 0u; cnt = 0u; mine = 0u;
#pragma unroll
        for (unsigned j = 0; j < 16; ++j) { const unsigned c = xb_ld(&bar[XB_XCNT(j)]); sum += c; cnt += (c > 0u) ? 1u : 0u; mine = (j == x) ? c : mine; }
        if (sum == G) break;
        __builtin_amdgcn_s_sleep(1);
        if ((++sp & 255u) == 0u) { if (xb_ld(&bar[XB_TMO])) break; if (sp > XB_SPIN_CAP) { atomicAdd(&bar[XB_TMO], 1u); break; } }
    }
    nloc = mine > 0u ? mine : 1u; nx = cnt > 0u ? cnt : 1u;
}
__device__ __forceinline__ void xcd_barrier_impl(unsigned* bar, volatile LAS unsigned* st) {
    asm volatile("s_waitcnt vmcnt(0)" ::: "memory");
    __syncthreads();
    if (ltid() == 0) {
        const unsigned x = xb_xcc_id();
        __builtin_amdgcn_s_waitcnt(0);
        unsigned nloc = st[0], nx = st[1];
        if (nloc == 0u) { xcd_barrier_complete(bar, x, nloc, nx); st[0] = nloc; st[1] = nx; }
        const unsigned old = xb_add(&bar[XB_XSUB(x)], 1u);
        const unsigned gen = old / nloc;
        if (old + 1u == (gen + 1u) * nloc) {
            __builtin_amdgcn_fence(__ATOMIC_RELEASE, "agent");
            asm volatile("s_waitcnt vmcnt(0)" ::: "memory");
            const unsigned og = xb_add(&bar[XB_TOP], 1u);
            const unsigned tg = og / nx;
            if (og + 1u == (tg + 1u) * nx) xb_add(&bar[XB_TOPGEN], 1u);
            else XB_SPIN(xb_ld(&bar[XB_TOPGEN]) == tg, bar);
            __builtin_amdgcn_fence(__ATOMIC_ACQUIRE, "agent");
            xb_add(&bar[XB_XGEN(x)], 1u);
            asm volatile("s_waitcnt vmcnt(0)" ::: "memory");
        } else {
            XB_SPIN(xb_ld(&bar[XB_XGEN(x)]) == gen, bar);
            __builtin_amdgcn_fence(__ATOMIC_ACQUIRE, "agent");
            asm volatile("s_waitcnt vmcnt(0)" ::: "memory");
        }
    }
    __syncthreads();
}
__device__ __forceinline__ void sub_barrier(unsigned* word, unsigned n) {
    asm volatile("s_waitcnt vmcnt(0)" ::: "memory");
    __syncthreads();
    if (ltid() == 0) {
        __builtin_amdgcn_fence(__ATOMIC_RELEASE, "agent");
        asm volatile("s_waitcnt vmcnt(0)" ::: "memory");
        (void)xb_add(word, 1u);
        for (unsigned sp = 0; sp < (1u << 21); ++sp) { if (xb_ld(word) >= n) break; __builtin_amdgcn_s_sleep(2); }
        __builtin_amdgcn_fence(__ATOMIC_ACQUIRE, "agent");
        asm volatile("s_waitcnt vmcnt(0)" ::: "memory");
    }
    __syncthreads();
}
#define GRID_BAR() xcd_barrier_impl((unsigned*)(p.ws + WS_BAR), (volatile LAS unsigned*)((LAS unsigned char*)smem + LDS_BYTES - 16))

namespace pg8 {
constexpr int BM = 256, BK = 64, HALF = 128, HTB = HALF * BK * 2, STAGE_BYTES = 8 * HTB, NXCD = 8, WGM = 8;
__host__ __device__ __forceinline__ int lds_byte(int r, int c) { const int st = (r >> 4) * 2 + (c >> 5), rr = r & 15, cc = c & 31, ob = rr * 64 + cc * 2; return st * 1024 + (ob ^ (((ob >> 9) & 1) << 5)); }
__host__ __device__ __forceinline__ void stage_rc(int b, int& R, int& C) { const int st = b / 1024, sb = b % 1024, swz = sb ^ (((sb >> 9) & 1) << 5); R = (st >> 1) * 16 + swz / 64; C = (st & 1) * 32 + (swz % 64) / 2; }
__host__ __device__ __forceinline__ int perm32(int rho) { const int n = rho >> 4, i = rho & 15; return 8 * (i >> 2) + 4 * n + (i & 3); }
struct Unit { int pm, pn; };
struct Gemm { const bf16_t* A; const bf16_t* Bt; int M, N, K, ld; };
struct StaticOrder {
    int nM, nN, nwg, G, c;
    __device__ void init(int M, int N, int G_, int c_) { nM = M / BM; nN = N / BM; nwg = nM * nN; G = G_; c = c_; }
    __device__ bool next(int i, Unit& u) const {
        const long Lx = (long)i * G + c; if (Lx >= nwg) return false;
        int wgid = (int)Lx; { const int q = nwg / NXCD, r = nwg % NXCD, xcd = wgid % NXCD, off = wgid / NXCD; wgid = (xcd < r ? xcd * (q + 1) : r * (q + 1) + (xcd - r) * q) + off; }
        const int nig = WGM * nN, gid = wgid / nig, fm = gid * WGM, gsz = (nM - fm) < WGM ? (nM - fm) : WGM;
        u.pm = fm + ((wgid % nig) % gsz); u.pn = (wgid % nig) / gsz; return true;
    }
};
__device__ __forceinline__ unsigned cvt_pk_bf16(float lo, float hi) { unsigned r; asm volatile("v_cvt_pk_bf16_f32 %0, %1, %2" : "=v"(r) : "v"(lo), "v"(hi)); return r; }

struct EpiF32 {
    static constexpr bool PERM = false, AFTER_DRAIN = false;
    float* C; int ldc;
    __device__ __forceinline__ void operator()(const f32x4 (&acc)[2][2][4][2], const Unit& u, int wr, int wc, int fr, int fq) const {
        const int row0 = u.pm * BM + wr * 64 + fr, col0 = u.pn * BM + wc * 32 + 4 * fq;
#pragma unroll
        for (int ai = 0; ai < 2; ++ai)
#pragma unroll
            for (int m = 0; m < 4; ++m) { float* rowp = C + (size_t)(row0 + ai * HALF + m * 16) * ldc + col0;
#pragma unroll
                for (int bj = 0; bj < 2; ++bj)
#pragma unroll
                    for (int n = 0; n < 2; ++n) *(f32x4*)(rowp + bj * HALF + n * 16) = acc[ai][bj][m][n]; }
    }
};
struct EpiBf16 {
    static constexpr bool PERM = true, AFTER_DRAIN = false;
    bf16_t* O; int ldc; const float* bias;
    __device__ __forceinline__ void operator()(const f32x4 (&acc)[2][2][4][2], const Unit& u, int wr, int wc, int fr, int fq) const {
        const int row0 = u.pm * BM + wr * 64 + fr; const int col0 = u.pn * BM + wc * 32 + 8 * fq;
        f32x4 bv[2][2];
#pragma unroll
        for (int bj = 0; bj < 2; ++bj)
#pragma unroll
            for (int n = 0; n < 2; ++n) bv[bj][n] = bias ? *(const f32x4*)(bias + col0 + bj * HALF + 4 * n) : (f32x4){0.f, 0.f, 0.f, 0.f};
#pragma unroll
        for (int ai = 0; ai < 2; ++ai)
#pragma unroll
            for (int m = 0; m < 4; ++m) { bf16_t* rowp = O + (size_t)(row0 + ai * HALF + m * 16) * ldc + col0;
#pragma unroll
                for (int bj = 0; bj < 2; ++bj) { f32x4 v0 = acc[ai][bj][m][0] + bv[bj][0], v1 = acc[ai][bj][m][1] + bv[bj][1];
                    u32x4 w; w.x = cvt_pk_bf16(v0[0], v0[1]); w.y = cvt_pk_bf16(v0[2], v0[3]); w.z = cvt_pk_bf16(v1[0], v1[1]); w.w = cvt_pk_bf16(v1[2], v1[3]);
                    *(u32x4*)(rowp + bj * HALF) = w; } }
    }
};
struct EpiSwiGLU {
    static constexpr bool PERM = true, AFTER_DRAIN = false;
    bf16_t* O; int ldc;
    __device__ __forceinline__ void operator()(const f32x4 (&acc)[2][2][4][2], const Unit& u, int wr, int wc, int fr, int fq) const {
        const int row0 = u.pm * BM + wr * 64 + fr; const int col0 = u.pn * HALF + wc * 32 + 8 * fq;
#pragma unroll
        for (int ai = 0; ai < 2; ++ai)
#pragma unroll
            for (int m = 0; m < 4; ++m) { bf16_t* rowp = O + (size_t)(row0 + ai * HALF + m * 16) * ldc + col0;
                float v[8];
#pragma unroll
                for (int n = 0; n < 2; ++n)
#pragma unroll
                    for (int j = 0; j < 4; ++j) { const float g = acc[ai][0][m][n][j], up = acc[ai][1][m][n][j]; v[n * 4 + j] = silu_f(g) * up; }
                u32x4 w; w.x = cvt_pk_bf16(v[0], v[1]); w.y = cvt_pk_bf16(v[2], v[3]); w.z = cvt_pk_bf16(v[4], v[5]); w.w = cvt_pk_bf16(v[6], v[7]);
                *(u32x4*)rowp = w; }
    }
};


__device__ __forceinline__ void row_exchange(const f32x4 (&v)[2][2][4][2], const Unit& u, int wr, int wc, int fr, int fq, LAS unsigned char* lds, int wid, int lane, float* slots, unsigned* cnt) {
    LAS float* P = (LAS float*)lds;
    LAS float* S = (LAS float*)(lds + 4096);
#pragma unroll
    for (int ai = 0; ai < 2; ++ai)
#pragma unroll
        for (int m = 0; m < 4; ++m) {
            float sq = 0.f;
#pragma unroll
            for (int bj = 0; bj < 2; ++bj)
#pragma unroll
                for (int n = 0; n < 2; ++n) { const f32x4 x = v[ai][bj][m][n]; sq += (x[0] * x[0] + x[1] * x[1]) + (x[2] * x[2] + x[3] * x[3]); }
            sq += __shfl_xor(sq, 16); sq += __shfl_xor(sq, 32);
            if (fq == 0) P[(ai * HALF + wr * 64 + m * 16 + fr) * 4 + wc] = sq;
        }
    asm volatile("s_waitcnt lgkmcnt(0)" ::: "memory"); __builtin_amdgcn_s_barrier(); asm volatile("" ::: "memory");
    const int row = wid * 32 + (lane & 31);
    if (lane < 32) {
        const float tot = (P[row * 4 + 0] + P[row * 4 + 1]) + (P[row * 4 + 2] + P[row * 4 + 3]);
        __hip_atomic_store((unsigned*)slots + ((size_t)(u.pm * BM + row) * 4 + u.pn), __float_as_uint(tot), __ATOMIC_RELAXED, __HIP_MEMORY_SCOPE_AGENT);
    }
    asm volatile("s_waitcnt vmcnt(0)" ::: "memory");
    if (lane == 0) __hip_atomic_fetch_add(cnt + 64 * u.pm, 1u, __ATOMIC_RELAXED, __HIP_MEMORY_SCOPE_AGENT);
    if (wid == 0) {
        for (unsigned sp = 0; sp < (1u << 21); ++sp) {
            if ((unsigned)__builtin_amdgcn_readfirstlane(__hip_atomic_load(cnt + 64 * u.pm, __ATOMIC_RELAXED, __HIP_MEMORY_SCOPE_AGENT)) >= 32u) break;
            __builtin_amdgcn_s_sleep(2);
        }
        __builtin_amdgcn_fence(__ATOMIC_ACQUIRE, "agent");
    }
    asm volatile("s_waitcnt vmcnt(0) lgkmcnt(0)" ::: "memory"); __builtin_amdgcn_s_barrier(); asm volatile("" ::: "memory");
    if (lane < 32) {
        const unsigned* sl = (const unsigned*)slots + (size_t)(u.pm * BM + row) * 4;
        float tot = 0.f;
#pragma unroll
        for (int t = 0; t < 4; ++t) tot += __uint_as_float(__hip_atomic_load(sl + t, __ATOMIC_RELAXED, __HIP_MEMORY_SCOPE_AGENT));
        S[row] = tot;
    }
    asm volatile("s_waitcnt vmcnt(0) lgkmcnt(0)" ::: "memory"); __builtin_amdgcn_s_barrier(); asm volatile("" ::: "memory");
}
struct EpiFusedRow {
    static constexpr bool PERM = false, AFTER_DRAIN = true;
    const float* xin; float* xout; bf16_t* H;
    const float* gate; const float* gpost; float wgt;
    const float* gpre; const float* shift; const float* scale;
    float* slots; unsigned* cnt;
    __device__ __forceinline__ void operator()(const f32x4 (&)[2][2][4][2], const Unit&, int, int, int, int) const {}
    __device__ __forceinline__ void fused(f32x4 (&acc)[2][2][4][2], const Unit& u, int wr, int wc, int fr, int fq, LAS unsigned char* lds, int wid, int lane) const {
        const LAS float* S = (const LAS float*)(lds + 4096);
        const int col0 = u.pn * BM + wc * 32 + 4 * fq; const size_t mb = (size_t)(u.pm >> 4) * (NMOD * D);
        row_exchange(acc, u, wr, wc, fr, fq, lds, wid, lane, slots, cnt);
        {
            f32x4 cw[2][2];
#pragma unroll
            for (int bj = 0; bj < 2; ++bj)
#pragma unroll
                for (int n = 0; n < 2; ++n) cw[bj][n] = *(const f32x4*)(gate + mb + col0 + bj * HALF + n * 16) * *(const f32x4*)(gpost + col0 + bj * HALF + n * 16);
#pragma unroll
            for (int ai = 0; ai < 2; ++ai)
#pragma unroll
                for (int m = 0; m < 4; ++m) { const int r = ai * HALF + wr * 64 + m * 16 + fr; const float r1 = rsqrtf(S[r] * (1.0f / D) + EPS) * wgt; const size_t off = (size_t)(u.pm * BM + r) * D + col0;
#pragma unroll
                    for (int bj = 0; bj < 2; ++bj)
#pragma unroll
                        for (int n = 0; n < 2; ++n) { const f32x4 xv = *(const f32x4*)(xin + off + bj * HALF + n * 16); const f32x4 xn = xv + (cw[bj][n] * r1) * acc[ai][bj][m][n];
                            acc[ai][bj][m][n] = xn; *(f32x4*)(xout + off + bj * HALF + n * 16) = xn; }
                    asm volatile("" : "+v"(acc[ai][0][m][0]), "+v"(acc[ai][0][m][1]), "+v"(acc[ai][1][m][0]), "+v"(acc[ai][1][m][1]));
                    asm volatile("" ::: "memory"); }
        }
        if (H == nullptr) return;
        row_exchange(acc, u, wr, wc, fr, fq, lds, wid, lane, slots + (size_t)TL * 4, cnt + 64 * 64);
        {
            f32x4 gm[2][2], sh[2][2];
#pragma unroll
            for (int bj = 0; bj < 2; ++bj)
#pragma unroll
                for (int n = 0; n < 2; ++n) { const int c = col0 + bj * HALF + n * 16; gm[bj][n] = *(const f32x4*)(gpre + c) * (*(const f32x4*)(scale + mb + c) + 1.0f); sh[bj][n] = *(const f32x4*)(shift + mb + c); }
#pragma unroll
            for (int ai = 0; ai < 2; ++ai)
#pragma unroll
                for (int m = 0; m < 4; ++m) { const int r = ai * HALF + wr * 64 + m * 16 + fr; const float r2 = rsqrtf(S[r] * (1.0f / D) + EPS); const size_t off = (size_t)(u.pm * BM + r) * D + col0;
#pragma unroll
                    for (int bj = 0; bj < 2; ++bj)
#pragma unroll
                        for (int n = 0; n < 2; ++n) { const f32x4 hv = (acc[ai][bj][m][n] * r2) * gm[bj][n] + sh[bj][n];
                            uint2 w2; w2.x = cvt_pk_bf16(hv[0], hv[1]); w2.y = cvt_pk_bf16(hv[2], hv[3]); *(uint2*)(H + off + bj * HALF + n * 16) = w2; }
                    asm volatile("" ::: "memory"); }
        }
    }
};

template <class Epi, class Sched>
__device__ __forceinline__ void gemm_phase(LAS unsigned char* lds, const Gemm g, const Sched& S, const Epi& E) {
    const int tid = ltid(), wid = __builtin_amdgcn_readfirstlane(tid >> 6), lane = tid & 63, wr = wid >> 2, wc = wid & 3, fr = lane & 15, fq = lane >> 4;
    const int K = g.ld, nt = g.K / BK;
    unsigned voffA[2], voffB[2];
#pragma unroll
    for (int i = 0; i < 2; ++i) { int R, C; stage_rc(tid * 16 + i * 8192, R, C); const int Rb = Epi::PERM ? ((R & ~31) + perm32(R & 31)) : R;
        voffA[i] = (unsigned)(R * K + C) * 2u; voffB[i] = (unsigned)(Rb * K + C) * 2u; }
    const size_t kstep = (size_t)(BK * 2);
    const size_t hstep = (size_t)HALF * K * 2;
    const size_t tstep = 2 * hstep;
    const unsigned ldsw = (unsigned)wid * 1024u;
    const int aoff = lds_byte(wr * 64 + fr, fq * 8), boff = lds_byte(wc * 32 + fr, fq * 8);
#define PG8_SA(b, h) (((b) * 2 + (h)) * HTB)
#define PG8_SB(b, h) ((4 + (b) * 2 + (h)) * HTB)
#define PG8_STAGE(bufoff, gbase, voff) do { _Pragma("unroll") for (int _i = 0; _i < 2; ++_i) \
        __builtin_amdgcn_global_load_lds((const unsigned*)((const char*)(gbase) + (voff)[_i]), (LAS unsigned*)(lds + (bufoff) + ldsw + _i * 8192), 16, 0, 0); } while (0)
#define PG8_LDA(dst, b, h) do { _Pragma("unroll") for (int m = 0; m < 4; ++m) _Pragma("unroll") for (int k = 0; k < 2; ++k) dst[m][k] = *(const LAS bf16x8*)(lds + PG8_SA(b, h) + aoff + m * 2048 + k * 1024); } while (0)
#define PG8_LDB(dst, b, h) do { _Pragma("unroll") for (int n = 0; n < 2; ++n) _Pragma("unroll") for (int k = 0; k < 2; ++k) dst[n][k] = *(const LAS bf16x8*)(lds + PG8_SB(b, h) + boff + n * 2048 + k * 1024); } while (0)
#define PG8_MMA(ai, bj, At, Bt) do { __builtin_amdgcn_s_setprio(1); _Pragma("unroll") for (int m = 0; m < 4; ++m) _Pragma("unroll") for (int n = 0; n < 2; ++n) _Pragma("unroll") for (int k = 0; k < 2; ++k) \
        acc[ai][bj][m][n] = __builtin_amdgcn_mfma_f32_16x16x32_bf16(Bt[n][k], At[m][k], acc[ai][bj][m][n], 0, 0, 0); __builtin_amdgcn_s_setprio(0); } while (0)
#define PG8_WAIT_V(n) asm volatile("s_waitcnt vmcnt(" #n ")" ::: "memory")
#define PG8_WAIT_L(n) asm volatile("s_waitcnt lgkmcnt(" #n ")" ::: "memory")
#define PG8_BAR __builtin_amdgcn_s_barrier()
#define PG8_SCHED __builtin_amdgcn_sched_barrier(0)
    Unit cur, nxt; int ui = 0;
    if (!S.next(0, cur)) return;
    f32x4 acc[2][2][4][2];
#pragma unroll
    for (int a = 0; a < 2; ++a)
#pragma unroll
        for (int b = 0; b < 2; ++b)
#pragma unroll
            for (int m = 0; m < 4; ++m)
#pragma unroll
                for (int n = 0; n < 2; ++n) acc[a][b][m][n] = (f32x4){0.f, 0.f, 0.f, 0.f};
    bf16x8 At[4][2], B0[2][2], B1[2][2];
    const char* cA = (const char*)g.A + (size_t)cur.pm * tstep; const char* cB = (const char*)g.Bt + (size_t)cur.pn * tstep;
    PG8_STAGE(PG8_SB(0, 0), cB, voffB); PG8_STAGE(PG8_SA(0, 0), cA, voffA); PG8_STAGE(PG8_SB(0, 1), cB + hstep, voffB); PG8_STAGE(PG8_SA(0, 1), cA + hstep, voffA);
    if (wr == 1) PG8_BAR;
    PG8_WAIT_V(4); PG8_BAR;
    PG8_STAGE(PG8_SB(1, 0), cB + kstep, voffB); PG8_STAGE(PG8_SA(1, 0), cA + kstep, voffA); PG8_STAGE(PG8_SB(1, 1), cB + hstep + kstep, voffB);
    PG8_WAIT_V(6); PG8_BAR;
    for (;;) {
        const bool has_next = S.next(ui + 1, nxt);
        const char* nA = has_next ? (const char*)g.A + (size_t)nxt.pm * tstep : cA; const char* nB = has_next ? (const char*)g.Bt + (size_t)nxt.pn * tstep : cB;
        for (int t = 0; t < nt; t += 2) {
            const bool last = (t == nt - 2);
            const char* a1 = cA + (size_t)(t + 1) * kstep;
            const char* a2 = last ? nA : cA + (size_t)(t + 2) * kstep; const char* b2 = last ? nB : cB + (size_t)(t + 2) * kstep;
            const char* a3 = a2 + kstep; const char* b3 = b2 + kstep;
            PG8_LDB(B0, 0, 0); PG8_SCHED; PG8_LDA(At, 0, 0); PG8_STAGE(PG8_SA(1, 1), a1 + hstep, voffA);
            PG8_WAIT_L(8); PG8_BAR; PG8_WAIT_L(0); PG8_MMA(0, 0, At, B0); PG8_BAR; PG8_SCHED;
            PG8_LDB(B1, 0, 1); PG8_STAGE(PG8_SB(0, 0), b2, voffB);
            PG8_BAR; PG8_WAIT_L(0); PG8_MMA(0, 1, At, B1); PG8_BAR;
            PG8_LDA(At, 0, 1); PG8_STAGE(PG8_SA(0, 0), a2, voffA);
            PG8_BAR; PG8_WAIT_L(0); PG8_MMA(1, 0, At, B0); PG8_BAR; PG8_SCHED;
            PG8_STAGE(PG8_SB(0, 1), b2 + hstep, voffB);
            PG8_WAIT_V(6); PG8_BAR; PG8_MMA(1, 1, At, B1); PG8_BAR;
            PG8_LDB(B0, 1, 0); PG8_SCHED; PG8_LDA(At, 1, 0); PG8_STAGE(PG8_SA(0, 1), a2 + hstep, voffA);
            PG8_WAIT_L(8); PG8_BAR; PG8_WAIT_L(0); PG8_MMA(0, 0, At, B0); PG8_BAR; PG8_SCHED;
            PG8_LDB(B1, 1, 1); PG8_STAGE(PG8_SB(1, 0), b3, voffB);
            PG8_BAR; PG8_WAIT_L(0); PG8_MMA(0, 1, At, B1); PG8_BAR;
            PG8_LDA(At, 1, 1); PG8_STAGE(PG8_SA(1, 0), a3, voffA);
            PG8_BAR; PG8_WAIT_L(0); PG8_MMA(1, 0, At, B0); PG8_BAR; PG8_SCHED;
            PG8_STAGE(PG8_SB(1, 1), b3 + hstep, voffB);
            PG8_WAIT_V(6); PG8_BAR; PG8_MMA(1, 1, At, B1); PG8_BAR;
        }
        if constexpr (!Epi::AFTER_DRAIN) E(acc, cur, wr, wc, fr, fq);
        if (!has_next) break;
#pragma unroll
        for (int a = 0; a < 2; ++a)
#pragma unroll
            for (int b = 0; b < 2; ++b)
#pragma unroll
                for (int m = 0; m < 4; ++m)
#pragma unroll
                    for (int n = 0; n < 2; ++n) acc[a][b][m][n] = (f32x4){0.f, 0.f, 0.f, 0.f};
        cur = nxt; cA = nA; cB = nB; ++ui;
    }
    PG8_WAIT_V(0);
    if (wr == 0) PG8_BAR;
    PG8_BAR;
    if constexpr (Epi::AFTER_DRAIN) E.fused(acc, cur, wr, wc, fr, fq, lds, wid, lane);
#undef PG8_SA
#undef PG8_SB
#undef PG8_STAGE
#undef PG8_LDA
#undef PG8_LDB
#undef PG8_MMA
#undef PG8_WAIT_V
#undef PG8_WAIT_L
#undef PG8_BAR
#undef PG8_SCHED
}
}

template <class Epi>
__device__ __forceinline__ void run_gemm(unsigned char* smem, const bf16_t* A, const bf16_t* Bt, int M, int N, int K, const Epi& E) {
    pg8::Gemm g{A, Bt, M, N, K, K}; pg8::StaticOrder S; S.init(M, N, (int)gridDim.x, (int)blockIdx.x);
    pg8::gemm_phase<Epi, pg8::StaticOrder>((LAS unsigned char*)smem, g, S, E);
}
__device__ __forceinline__ void run_gemm_f32_split(unsigned char* smem, const bf16_t* A, const bf16_t* Bt, int M, int K, const pg8::EpiFusedRow& EF, float* YP) {
    { pg8::Gemm g{A, Bt, TL, D, K, K}; pg8::StaticOrder S; S.init(TL, D, (int)gridDim.x, (int)blockIdx.x);
      pg8::gemm_phase<pg8::EpiFusedRow, pg8::StaticOrder>((LAS unsigned char*)smem, g, S, EF); }
    __syncthreads();
    if (M > TL && blockIdx.x < 64) {
        const int ks = blockIdx.x >> 4;
        int koff, klen;
        if (K == DFF) { koff = (ks < 2) ? ks * 768 : 1536 + (ks - 2) * 640; klen = (ks < 2) ? 768 : 640; }
        else { klen = K / 4; koff = ks * klen; }
        pg8::Gemm g{A + (size_t)TL * K + koff, Bt + koff, TC, D, klen, K}; pg8::StaticOrder S; S.init(TC, D, 16, (int)(blockIdx.x & 15)); pg8::EpiF32 E{YP + (size_t)ks * TC * D, D};
        pg8::gemm_phase<pg8::EpiF32, pg8::StaticOrder>((LAS unsigned char*)smem, g, S, E);
        __syncthreads();
    }
}

__device__ __forceinline__ float* xrow(const KQ p, int t) { return t < TL ? p.out + (size_t)t * D : (float*)(p.ws + WS_XC) + (size_t)(t - TL) * D; }
__device__ __forceinline__ int modrow(int t) { return t < TL ? (t >> 12) : 4; }
__device__ __forceinline__ const float* modp(const KQ p, int l, int mr, int idx) { return (const float*)(p.ws + WS_MOD) + ((size_t)(l * 5 + mr) * NMOD + idx) * D; }

__device__ __forceinline__ void p0_setup(const KQ p_in, float* sm) {
    const KQ p = lq(p_in);
    const int tid = ltid(), bid = blockIdx.x, nb = gridDim.x;
    const int gtid = bid * 512 + tid, gthreads = nb * 512;
    {
        float* rope = (float*)(p.ws + WS_ROPE);
        for (int idx = gtid; idx < SEQ * 32; idx += gthreads) {
            const int t = idx >> 5, i = idx & 31;
            const int ii = i & 15; const float pos = (i < 16) ? (float)(t >> 6) : (float)(t & 63);
            const float invA = powf(10000.0f, -(float)ii / 16.0f);
            const float angA = pos * invA;
            rope[idx] = cosf(angA); rope[SEQ * 32 + idx] = sinf(angA);
            const float ex = (float)i * (1.0f / 31.0f);
            const float invR = powf(10000.0f, -ex);
            const float angR = (float)t * invR;
            rope[2 * SEQ * 32 + idx] = cosf(angR); rope[3 * SEQ * 32 + idx] = sinf(angR);
        }
    }
    {
        float* tile = sm;
        for (int gs = bid; gs < 20864 / 4; gs += nb) {
            const int g = gs * 4;
            int j, tl;
            if (g < 16896) { j = g / 704; tl = g % 704; }
            else if (g < 18304) { j = 24 + (g - 16896) / 704; tl = (g - 16896) % 704; }
            else if (g < 18816) { j = 26 + (g - 18304) / 256; tl = (g - 18304) % 256; }
            else if (g < 20352) { j = 28 + (g - 18816) / 768; tl = (g - 18816) % 768; }
            else { j = 30 + (g - 20352) / 256; tl = (g - 20352) % 256; }
            const float* src; bf16_t* dst; int K, N, mode = 0;
            if (j < 8) { src = pin_ld(8) + (size_t)j * D * DFF; dst = (bf16_t*)(p.ws + WS_WGU + (size_t)j * SZ_WGU); K = D; N = DFF; mode = 1; }
            else if (j < 16) { src = pin_ld(9) + (size_t)(j - 8) * D * DFF; dst = (bf16_t*)(p.ws + WS_WGU + (size_t)(j - 8) * SZ_WGU); K = D; N = DFF; mode = 2; }
            else if (j < 24) { src = pin_ld(10) + (size_t)(j - 16) * DFF * D; dst = (bf16_t*)(p.ws + WS_WD + (size_t)(j - 16) * SZ_WD); K = DFF; N = D; }
            else if (j < 26) { src = pin_ld(11) + (size_t)(j - 24) * D * INW; dst = (bf16_t*)(p.ws + WS_WIN + (size_t)(j - 24) * SZ_WIN); K = D; N = INW; mode = 3; }
            else if (j < 28) { src = pin_ld(14) + (size_t)(j - 26) * D * D; dst = (bf16_t*)(p.ws + WS_WOUT + (size_t)(j - 26) * SZ_WOUT); K = D; N = D; }
            else if (j < 30) { src = pin_ld(15) + (size_t)(j - 28) * D * HYW; dst = (bf16_t*)(p.ws + WS_HWIN + (size_t)(j - 28) * SZ_HWIN); K = D; N = HYW; }
            else { src = pin_ld(28) + (size_t)(j - 30) * D * D; dst = (bf16_t*)(p.ws + WS_HWOUT + (size_t)(j - 30) * SZ_WOUT); K = D; N = D; }
            const int ntn = N / 64; const int k0 = (tl / ntn) * 64, n0 = (tl % ntn) * 64;
            f32x4 ld[8];
#pragma unroll
            for (int i = 0; i < 8; ++i) ld[i] = *(const f32x4*)(src + (size_t)(k0 + i * 8 + (tid >> 6)) * N + n0 + (tid & 63) * 4);
            __syncthreads();
#pragma unroll
            for (int i = 0; i < 8; ++i) *(f32x4*)(tile + (i * 8 + (tid >> 6)) * 260 + (tid & 63) * 4) = ld[i];
            __syncthreads();
            {
                const int n = tid >> 1, kh = (tid & 1) * 32; const int gn = n0 + n;
                float sc_ = 1.0f; int row = gn;
                if (mode == 1) row = 256 * (gn >> 7) + (gn & 127);
                else if (mode == 2) row = 256 * (gn >> 7) + 128 + (gn & 127);
                else if (mode == 3) { if (gn < 512 || (gn >= 1792 && gn < 2304)) sc_ = 0.125f; }
#pragma unroll
                for (int q = 0; q < 4; ++q) {
                    float v[8];
#pragma unroll
                    for (int jj = 0; jj < 8; ++jj) v[jj] = tile[(kh + q * 8 + jj) * 260 + n] * sc_;
                    u32x4 o4; o4.x = pg8::cvt_pk_bf16(v[0], v[1]); o4.y = pg8::cvt_pk_bf16(v[2], v[3]); o4.z = pg8::cvt_pk_bf16(v[4], v[5]); o4.w = pg8::cvt_pk_bf16(v[6], v[7]);
                    *(u32x4*)(dst + (size_t)row * K + k0 + kh + q * 8) = o4;
                }
            }
        }
        __syncthreads();
    }
    {
        float* sc = sm;
        float* red = sm + 5 * 1024;
        for (int i = tid; i < 5 * 1024; i += 512) { const int r = i >> 10, k = i & 1023; const float v = (r < 4) ? pin_ld(1)[r * D + k] : pin_ld(3)[k]; sc[i] = silu_f(v); }
        __syncthreads();
        const int w = tid >> 6, lane = tid & 63;
        for (int it = bid; it < 288; it += nb) {
            const int l = it / 72, c0 = (it % 72) * 128;
            const float* wm = pin_ld(4) + (size_t)l * D * (NMOD * D) + c0 + 2 * lane;
            float a[5][2];
#pragma unroll
            for (int r = 0; r < 5; ++r) { a[r][0] = 0.f; a[r][1] = 0.f; }
            for (int kb = w * 128; kb < w * 128 + 128; kb += 16) {
                float2 wv[16];
#pragma unroll
                for (int q = 0; q < 16; ++q) wv[q] = *(const float2*)(wm + (size_t)(kb + q) * (NMOD * D));
#pragma unroll
                for (int q = 0; q < 16; ++q)
#pragma unroll
                    for (int r = 0; r < 5; ++r) { const float s = sc[r * 1024 + kb + q]; a[r][0] += s * wv[q].x; a[r][1] += s * wv[q].y; }
            }
#pragma unroll
            for (int r = 0; r < 5; ++r) { red[(w * 5 + r) * 128 + 2 * lane] = a[r][0]; red[(w * 5 + r) * 128 + 2 * lane + 1] = a[r][1]; }
            __syncthreads();
            for (int i = tid; i < 5 * 128; i += 512) {
                const int r = i >> 7, c = i & 127; float s = 0.f;
#pragma unroll
                for (int ww = 0; ww < 8; ++ww) s += red[(ww * 5 + r) * 128 + c];
                s += pin_ld(5)[(size_t)l * (NMOD * D) + c0 + c];
                ((float*)(p.ws + WS_MOD))[(size_t)(l * 5 + r) * (NMOD * D) + c0 + c] = s;
            }
            __syncthreads();
        }
    }
    {
        float* z = sm;
        float* a1 = sm + 16 * 36;
        float* a2 = a1 + 16 * 64;
        float* a3 = a2 + 16 * 64;
        float* tl = a3 + 16 * 64;
        float* wl = tl + 16;
        const float HMAX = -4.605170185988091f / 0.3f, HMIN = -4.605170185988091f / 1.5f;
        int o_loaded = -1;
        for (int it = nb - 1 - bid; it < 544; it += nb) {
            const int o = it / 272, r = it % 272;
            const int Lf = (r < 256) ? SEQ : CL; const int p0 = (r < 256) ? r * 16 : (r - 256) * 16;
            float* kf = (float*)(p.ws + WS_KF + (size_t)o * SZ_KF) + ((r < 256) ? (size_t)0 : (size_t)2 * SEQ * D);
            const float* f3 = pin_ld(25) + (size_t)o * 64 * 2048;
            __syncthreads();
            if (o != o_loaded) {
                const float* f0 = pin_ld(19) + (size_t)o * 33 * 64; const float* f1 = pin_ld(21) + (size_t)o * 64 * 64; const float* f2 = pin_ld(23) + (size_t)o * 64 * 64;
                for (int i = tid; i < 33 * 64; i += 512) wl[i] = f0[i];
                for (int i = tid; i < 64 * 64; i += 512) { wl[2112 + i] = f1[i]; wl[2112 + 4096 + i] = f2[i]; }
                if (tid < 64) { wl[10304 + tid] = pin_ld(20)[o * 64 + tid]; wl[10304 + 64 + tid] = pin_ld(22)[o * 64 + tid]; wl[10304 + 128 + tid] = pin_ld(24)[o * 64 + tid]; wl[10304 + 192 + tid] = pin_ld(26)[o * 64 + tid]; }
                o_loaded = o;
            }
            const float* f0 = wl; const float* f1 = wl + 2112; const float* f2 = wl + 2112 + 4096;
            const float* fb0 = wl + 10304; const float* fb1 = fb0 + 64; const float* fb2 = fb0 + 128; const float* fq = fb0 + 192;
            for (int idx = tid; idx < 16 * 33; idx += 512) {
                const int ps = idx / 33, f = idx % 33; const int i = p0 + ps;
                const float tlin = (float)i * (1.0f / (float)(Lf - 1));
                const float w = (6.283185307179586f * (float)i) / (float)Lf;
                float v;
                if (f == 0) { v = tlin; tl[ps] = tlin; }
                else { const int jj = (f - 1) & 15; const float fj = 1e-4f + (float)jj * ((15.0f - 1e-4f) / 15.0f); v = (f <= 16) ? cosf(fj * w) : -sinf(fj * w); }
                z[ps * 36 + f] = v;
            }
            __syncthreads();
            for (int idx = tid; idx < 16 * 64; idx += 512) { const int ps = idx >> 6, oc = idx & 63; float s = fb0[oc];
                for (int f = 0; f < 33; ++f) s += z[ps * 36 + f] * f0[f * 64 + oc];
                a1[idx] = sinf(fq[oc] * s); }
            __syncthreads();
            for (int idx = tid; idx < 16 * 64; idx += 512) { const int ps = idx >> 6, oc = idx & 63; float s = fb1[oc];
                for (int f = 0; f < 64; ++f) s += a1[ps * 64 + f] * f1[f * 64 + oc];
                a2[idx] = sinf(fq[oc] * s); }
            __syncthreads();
            for (int idx = tid; idx < 16 * 64; idx += 512) { const int ps = idx >> 6, oc = idx & 63; float s = fb2[oc];
                for (int f = 0; f < 64; ++f) s += a2[ps * 64 + f] * f2[f * 64 + oc];
                a3[oc * 16 + ps] = sinf(fq[oc] * s); }
            __syncthreads();
            {
                float acc[4][16];
#pragma unroll
                for (int q = 0; q < 4; ++q)
#pragma unroll
                    for (int ps = 0; ps < 16; ++ps) acc[q][ps] = 0.f;
                for (int fb = 0; fb < 64; fb += 4) {
                    float wv[4][4];
#pragma unroll
                    for (int f = 0; f < 4; ++f)
#pragma unroll
                        for (int q = 0; q < 4; ++q) wv[f][q] = f3[(fb + f) * 2048 + tid + 512 * q];
#pragma unroll
                    for (int f = 0; f < 4; ++f) {
                        const f32x4 av0 = *(const f32x4*)(a3 + (fb + f) * 16), av1 = *(const f32x4*)(a3 + (fb + f) * 16 + 4), av2 = *(const f32x4*)(a3 + (fb + f) * 16 + 8), av3 = *(const f32x4*)(a3 + (fb + f) * 16 + 12);
#pragma unroll
                        for (int q = 0; q < 4; ++q)
#pragma unroll
                            for (int e = 0; e < 4; ++e) { acc[q][e] += av0[e] * wv[f][q]; acc[q][4 + e] += av1[e] * wv[f][q]; acc[q][8 + e] += av2[e] * wv[f][q]; acc[q][12 + e] += av3[e] * wv[f][q]; }
                    }
                }
#pragma unroll
                for (int q = 0; q < 4; ++q) {
                    const int c = tid + 512 * q; const int dir = c >> 10, d = c & 1023;
                    const float delta = fabsf(HMIN + (float)d * ((HMAX - HMIN) / 1023.0f));
                    float kv[16];
#pragma unroll
                    for (int ps = 0; ps < 16; ++ps) kv[ps] = acc[q][ps] * expf(-tl[ps] * delta);
                    if (r < 256) {
                        bf16_t* rk = (bf16_t*)(p.ws + WS_KF + (size_t)o * SZ_KF) + (size_t)d * 8192;
                        if (dir == 0) {
                            u32x4 w0, w1;
                            w0.x = pg8::cvt_pk_bf16(kv[15], kv[14]); w0.y = pg8::cvt_pk_bf16(kv[13], kv[12]); w0.z = pg8::cvt_pk_bf16(kv[11], kv[10]); w0.w = pg8::cvt_pk_bf16(kv[9], kv[8]);
                            w1.x = pg8::cvt_pk_bf16(kv[7], kv[6]); w1.y = pg8::cvt_pk_bf16(kv[5], kv[4]); w1.z = pg8::cvt_pk_bf16(kv[3], kv[2]); w1.w = pg8::cvt_pk_bf16(kv[1], kv[0]);
                            *(u32x4*)(rk + 4080 - p0) = w0; *(u32x4*)(rk + 4088 - p0) = w1;
                            if (p0 == 0) rk[8191] = 0;
                        } else {
                            if (p0 > 0) rk[4095 + p0] = f2bf(kv[0]);
                            u32x4 w0; w0.x = pg8::cvt_pk_bf16(kv[1], kv[2]); w0.y = pg8::cvt_pk_bf16(kv[3], kv[4]); w0.z = pg8::cvt_pk_bf16(kv[5], kv[6]); w0.w = pg8::cvt_pk_bf16(kv[7], kv[8]);
                            *(u32x4*)(rk + 4096 + p0) = w0;
                            uint2 w1; w1.x = pg8::cvt_pk_bf16(kv[9], kv[10]); w1.y = pg8::cvt_pk_bf16(kv[11], kv[12]);
                            *(uint2*)(rk + 4104 + p0) = w1;
                            *(unsigned*)(rk + 4108 + p0) = pg8::cvt_pk_bf16(kv[13], kv[14]);
                            rk[4110 + p0] = f2bf(kv[15]);
                        }
                    } else {
#pragma unroll
                        for (int ps = 0; ps < 16; ++ps) kf[((size_t)dir * Lf + p0 + ps) * D + d] = kv[ps];
                    }
                }
            }
        }
        __syncthreads();
    }
}

__device__ __forceinline__ void rowphase(const KQ p_in, int Mupd, const bf16_t* Y, int lu, int gidx, float wgt, const float* gpost,
                         int Mnext, int ln, const float* gpre, int shidx, int scidx, bf16_t* Hout, bool from_input, int tbeg) {
    const KQ p = lq(p_in);
    const int tid = ltid(), w = tid >> 6, lane = tid & 63;
    const int Mmax = Mupd > Mnext ? Mupd : Mnext;
    for (int t = tbeg + (blockIdx.x * 8 + w) * 2; t < Mmax; t += gridDim.x * 16) {
        float* xr = xrow(p, t); const int mr = modrow(t);
        const float* xs = xr;
        if (from_input) xs = (t < TL) ? pin_ld(0) + (size_t)t * D : pin_ld(2) + (size_t)(t - TL) * D;
        float4 xv[2][4];
#pragma unroll
        for (int rr = 0; rr < 2; ++rr)
#pragma unroll
            for (int q = 0; q < 4; ++q) xv[rr][q] = *(const float4*)(xs + rr * D + q * 256 + lane * 4);
        if (Y != nullptr && t < Mupd) {
            float4 yv[2][4]; float ss[2] = {0.f, 0.f};
#pragma unroll
            for (int rr = 0; rr < 2; ++rr)
#pragma unroll
                for (int q = 0; q < 4; ++q) {
                    if (t < TL) { const bf16x4 yb = *(const bf16x4*)(Y + (size_t)(t + rr) * D + q * 256 + lane * 4);
                        yv[rr][q] = make_float4(bf2f((bf16_t)yb[0]), bf2f((bf16_t)yb[1]), bf2f((bf16_t)yb[2]), bf2f((bf16_t)yb[3])); }
                    else { const float* yp = (const float*)(p.ws + WS_YP) + (size_t)(t + rr - TL) * D + q * 256 + lane * 4;
                        const float4 a0 = *(const float4*)yp, a1 = *(const float4*)(yp + (size_t)TC * D), a2 = *(const float4*)(yp + (size_t)2 * TC * D), a3 = *(const float4*)(yp + (size_t)3 * TC * D);
                        yv[rr][q] = make_float4(a0.x + a1.x + a2.x + a3.x, a0.y + a1.y + a2.y + a3.y, a0.z + a1.z + a2.z + a3.z, a0.w + a1.w + a2.w + a3.w); }
                    ss[rr] += yv[rr][q].x * yv[rr][q].x + yv[rr][q].y * yv[rr][q].y + yv[rr][q].z * yv[rr][q].z + yv[rr][q].w * yv[rr][q].w; }
            ss[0] = wave_sum(ss[0]); ss[1] = wave_sum(ss[1]);
            float wgl = wgt; asm volatile("" : "+v"(wgl));
            const float r0 = rsqrtf(ss[0] * (1.0f / D) + EPS) * wgl, r1 = rsqrtf(ss[1] * (1.0f / D) + EPS) * wgl;
            const float* gm = modp(p, lu, mr, gidx);
#pragma unroll
            for (int q = 0; q < 4; ++q) {
                const float4 g4 = *(const float4*)(gm + q * 256 + lane * 4); const float4 p4 = *(const float4*)(gpost + q * 256 + lane * 4);
                const float cx = g4.x * p4.x, cy = g4.y * p4.y, cz = g4.z * p4.z, cw = g4.w * p4.w;
                xv[0][q].x += r0 * cx * yv[0][q].x; xv[0][q].y += r0 * cy * yv[0][q].y; xv[0][q].z += r0 * cz * yv[0][q].z; xv[0][q].w += r0 * cw * yv[0][q].w;
                xv[1][q].x += r1 * cx * yv[1][q].x; xv[1][q].y += r1 * cy * yv[1][q].y; xv[1][q].z += r1 * cz * yv[1][q].z; xv[1][q].w += r1 * cw * yv[1][q].w;
                *(float4*)(xr + q * 256 + lane * 4) = xv[0][q]; *(float4*)(xr + D + q * 256 + lane * 4) = xv[1][q];
            }
        }
        if (Hout != nullptr && t < Mnext) {
            float ss[2] = {0.f, 0.f};
#pragma unroll
            for (int rr = 0; rr < 2; ++rr)
#pragma unroll
                for (int q = 0; q < 4; ++q) ss[rr] += xv[rr][q].x * xv[rr][q].x + xv[rr][q].y * xv[rr][q].y + xv[rr][q].z * xv[rr][q].z + xv[rr][q].w * xv[rr][q].w;
            ss[0] = wave_sum(ss[0]); ss[1] = wave_sum(ss[1]);
            const float rn[2] = {rsqrtf(ss[0] * (1.0f / D) + EPS), rsqrtf(ss[1] * (1.0f / D) + EPS)};
            const float* sh = modp(p, ln, mr, shidx); const float* sc = modp(p, ln, mr, scidx);
#pragma unroll
            for (int q = 0; q < 4; ++q) {
                const float4 g4 = *(const float4*)(gpre + q * 256 + lane * 4); const float4 s4 = *(const float4*)(sc + q * 256 + lane * 4); const float4 h4 = *(const float4*)(sh + q * 256 + lane * 4);
                const float mx_ = g4.x * (1.0f + s4.x), my_ = g4.y * (1.0f + s4.y), mz_ = g4.z * (1.0f + s4.z), mw_ = g4.w * (1.0f + s4.w);
#pragma unroll
                for (int rr = 0; rr < 2; ++rr) {
                    const float h0 = xv[rr][q].x * rn[rr] * mx_ + h4.x, h1 = xv[rr][q].y * rn[rr] * my_ + h4.y;
                    const float h2 = xv[rr][q].z * rn[rr] * mz_ + h4.z, h3 = xv[rr][q].w * rn[rr] * mw_ + h4.w;
                    uint2 pk; pk.x = pg8::cvt_pk_bf16(h0, h1); pk.y = pg8::cvt_pk_bf16(h2, h3);
                    *(uint2*)(Hout + (size_t)(t + rr) * D + q * 256 + lane * 4) = pk;
                }
            }
        }
    }
}

__device__ __forceinline__ float log_sigmoid(float x) { return -log1pf(expf(-x)); }
__device__ __forceinline__ int chunk_t0(int b, int cidx) { return cidx < 32 ? b * SEQ + cidx * 128 : TL + b * CL + (cidx - 32) * 128; }

__device__ __forceinline__ void m1_rope_states(const KQ p_in, int e, float* sm) {
    const KQ p = lq(p_in);
    const int tid = ltid(), bid = blockIdx.x, nb = gridDim.x;
    bf16_t* Z = (bf16_t*)(p.ws + WS_BIG);
    const float* rope = (const float*)(p.ws + WS_ROPE);
    for (int base = bid * 512 + tid; base < TL * 72; base += 2 * nb * 512) {
        bf16_t* zp[2]; bf16x8 a1[2], a2[2]; f32x4 c0[2], c1[2], s0[2], s1[2]; bool ok[2];
#pragma unroll
        for (int u = 0; u < 2; ++u) {
            const int idx = base + u * nb * 512; ok[u] = idx < TL * 72; const int ix = ok[u] ? idx : base;
            const int t = ix / 72, r = ix % 72; const int hd = r >> 2, i0 = (r & 3) * 8;
            const int cb = hd < 16 ? hd * 64 : 1536 + (hd - 16) * 64;
            const int tb = (hd >= 8 && hd < 16) ? 2 : 0; const int pos = t & (SEQ - 1);
            const float* cp = rope + (size_t)tb * SEQ * 32 + pos * 32 + i0; const float* sp = cp + (size_t)SEQ * 32;
            zp[u] = Z + (size_t)t * INW + cb + i0;
            a1[u] = *(const bf16x8*)zp[u]; a2[u] = *(const bf16x8*)(zp[u] + 32);
            c0[u] = *(const f32x4*)cp; c1[u] = *(const f32x4*)(cp + 4); s0[u] = *(const f32x4*)sp; s1[u] = *(const f32x4*)(sp + 4);
        }
#pragma unroll
        for (int u = 0; u < 2; ++u) {
            if (!ok[u]) continue;
            float o1[8], o2[8];
#pragma unroll
            for (int j = 0; j < 8; ++j) { const float x1 = bf2f((bf16_t)a1[u][j]), x2 = bf2f((bf16_t)a2[u][j]); const float cc = j < 4 ? c0[u][j & 3] : c1[u][j & 3], sn = j < 4 ? s0[u][j & 3] : s1[u][j & 3];
                o1[j] = x1 * cc - x2 * sn; o2[j] = x1 * sn + x2 * cc; }
            u32x4 w1, w2;
            w1.x = pg8::cvt_pk_bf16(o1[0], o1[1]); w1.y = pg8::cvt_pk_bf16(o1[2], o1[3]); w1.z = pg8::cvt_pk_bf16(o1[4], o1[5]); w1.w = pg8::cvt_pk_bf16(o1[6], o1[7]);
            w2.x = pg8::cvt_pk_bf16(o2[0], o2[1]); w2.y = pg8::cvt_pk_bf16(o2[2], o2[3]); w2.z = pg8::cvt_pk_bf16(o2[4], o2[5]); w2.w = pg8::cvt_pk_bf16(o2[6], o2[7]);
            *(u32x4*)zp[u] = w1; *(u32x4*)(zp[u] + 32) = w2;
        }
    }
    float* Ks = sm;
    float* Vs = sm + 128 * 64;
    float* wf = Vs + 128 * 64;
    float* wb = wf + 128;
    float* AF = (float*)(p.ws + WS_ST); float* AB = AF + SZ_ST / 4;
    const float* dec = pin_ld(13) + e * 16;
    for (int it = bid; it < NB * NCH * 8; it += nb) {
        const int h = it & 7, cidx = (it >> 3) % NCH, b = it / (8 * NCH);
        const int t0 = chunk_t0(b, cidx); const bool lat = cidx < 32;
        const float lgf = log_sigmoid(dec[h]), lgb = log_sigmoid(dec[8 + h]);
        __syncthreads();
        if (tid < 128) { wf[tid] = expf(lgf * (float)(127 - tid)); wb[tid] = expf(lgb * (float)tid); }
        const int kc = 1792 + h * 64, vc = 2304 + h * 64;
        {
            const int r = tid >> 2, pq = tid & 3;
            bf16_t* zp = Z + (size_t)(t0 + r) * INW + kc + 8 * pq;
            const bf16x8 a1 = *(const bf16x8*)zp, a2 = *(const bf16x8*)(zp + 32);
            float o1[8], o2[8];
            if (lat) {
                const int pos = (t0 + r) & (SEQ - 1);
                const float* cp = rope + (size_t)2 * SEQ * 32 + pos * 32 + 8 * pq; const float* sp = cp + (size_t)SEQ * 32;
                const f32x4 c0 = *(const f32x4*)cp, c1 = *(const f32x4*)(cp + 4), s0 = *(const f32x4*)sp, s1 = *(const f32x4*)(sp + 4);
#pragma unroll
                for (int j = 0; j < 8; ++j) { const float x1 = bf2f((bf16_t)a1[j]), x2 = bf2f((bf16_t)a2[j]); const float cc = j < 4 ? c0[j & 3] : c1[j & 3], sn = j < 4 ? s0[j & 3] : s1[j & 3];
                    o1[j] = bf2f(f2bf(x1 * cc - x2 * sn)); o2[j] = bf2f(f2bf(x1 * sn + x2 * cc)); }
                u32x4 w1, w2;
                w1.x = pg8::cvt_pk_bf16(o1[0], o1[1]); w1.y = pg8::cvt_pk_bf16(o1[2], o1[3]); w1.z = pg8::cvt_pk_bf16(o1[4], o1[5]); w1.w = pg8::cvt_pk_bf16(o1[6], o1[7]);
                w2.x = pg8::cvt_pk_bf16(o2[0], o2[1]); w2.y = pg8::cvt_pk_bf16(o2[2], o2[3]); w2.z = pg8::cvt_pk_bf16(o2[4], o2[5]); w2.w = pg8::cvt_pk_bf16(o2[6], o2[7]);
                *(u32x4*)zp = w1; *(u32x4*)(zp + 32) = w2;
            } else {
#pragma unroll
                for (int j = 0; j < 8; ++j) { o1[j] = bf2f((bf16_t)a1[j]); o2[j] = bf2f((bf16_t)a2[j]); }
            }
            *(f32x4*)(Ks + r * 64 + 8 * pq) = (f32x4){o1[0], o1[1], o1[2], o1[3]}; *(f32x4*)(Ks + r * 64 + 8 * pq + 4) = (f32x4){o1[4], o1[5], o1[6], o1[7]};
            *(f32x4*)(Ks + r * 64 + 32 + 8 * pq) = (f32x4){o2[0], o2[1], o2[2], o2[3]}; *(f32x4*)(Ks + r * 64 + 32 + 8 * pq + 4) = (f32x4){o2[4], o2[5], o2[6], o2[7]};
        }
#pragma unroll
        for (int q = 0; q < 2; ++q) { const int idx = tid + 512 * q; const int r = idx >> 3, pc = idx & 7;
            const bf16x8 vv = *(const bf16x8*)(Z + (size_t)(t0 + r) * INW + vc + 8 * pc);
            *(f32x4*)(Vs + r * 64 + 8 * pc) = (f32x4){bf2f((bf16_t)vv[0]), bf2f((bf16_t)vv[1]), bf2f((bf16_t)vv[2]), bf2f((bf16_t)vv[3])};
            *(f32x4*)(Vs + r * 64 + 8 * pc + 4) = (f32x4){bf2f((bf16_t)vv[4]), bf2f((bf16_t)vv[5]), bf2f((bf16_t)vv[6]), bf2f((bf16_t)vv[7])}; }
        __syncthreads();
        const int d = tid >> 3, e0 = (tid & 7) * 8;
        float af[8], ab[8];
#pragma unroll
        for (int j = 0; j < 8; ++j) { af[j] = 0.f; ab[j] = 0.f; }
        for (int s = 0; s < 128; ++s) {
            const float kv = Ks[s * 64 + d]; const float kfw = kv * wf[s], kbw = kv * wb[s];
            const float4 v0 = *(const float4*)(Vs + s * 64 + e0), v1 = *(const float4*)(Vs + s * 64 + e0 + 4);
            af[0] += kfw * v0.x; af[1] += kfw * v0.y; af[2] += kfw * v0.z; af[3] += kfw * v0.w; af[4] += kfw * v1.x; af[5] += kfw * v1.y; af[6] += kfw * v1.z; af[7] += kfw * v1.w;
            ab[0] += kbw * v0.x; ab[1] += kbw * v0.y; ab[2] += kbw * v0.z; ab[3] += kbw * v0.w; ab[4] += kbw * v1.x; ab[5] += kbw * v1.y; ab[6] += kbw * v1.z; ab[7] += kbw * v1.w;
        }
        const size_t so = ((size_t)(b * NCH + cidx) * 8 + h) * 4096 + d * 64 + e0;
        *(float4*)(AF + so) = make_float4(af[0], af[1], af[2], af[3]); *(float4*)(AF + so + 4) = make_float4(af[4], af[5], af[6], af[7]);
        *(float4*)(AB + so) = make_float4(ab[0], ab[1], ab[2], ab[3]); *(float4*)(AB + so + 4) = make_float4(ab[4], ab[5], ab[6], ab[7]);
    }
    __syncthreads();
}

__device__ __forceinline__ void m2_scan(const KQ p_in, int e) {
    const KQ p = lq(p_in);
    const float* __restrict__ AF = (const float*)(p.ws + WS_ST); const float* __restrict__ AB = AF + SZ_ST / 4;
    float* __restrict__ TF = (float*)(p.ws + WS_ST) + 2 * (SZ_ST / 4); float* __restrict__ TB = TF + SZ_ST / 4;
    const float* dec = pin_ld(13) + e * 16;
    for (int idx = blockIdx.x * 512 + ltid(); idx < NB * 8 * 4096; idx += gridDim.x * 512) {
        const int el = idx & 4095, h = (idx >> 12) & 7, b = idx >> 15;
        const float gf = expf(log_sigmoid(dec[h]) * 128.0f), gb = expf(log_sigmoid(dec[8 + h]) * 128.0f);
        const size_t base = ((size_t)(b * NCH) * 8 + h) * 4096 + el; constexpr size_t CS = (size_t)8 * 4096;
        float af[NCH], ab[NCH];
#pragma unroll
        for (int c = 0; c < NCH; ++c) { af[c] = AF[base + c * CS]; ab[c] = AB[base + c * CS]; }
        TF[base + 32 * CS] = 0.f; TF[base + 33 * CS] = af[32]; TB[base + 33 * CS] = 0.f; TB[base + 32 * CS] = ab[33];
        float sf = gf * af[32] + af[33], sb = ab[32] + gb * ab[33];
#pragma unroll
        for (int c = 0; c < 32; ++c) { TF[base + c * CS] = sf; sf = gf * sf + af[c]; }
#pragma unroll
        for (int c = 31; c >= 0; --c) { TB[base + c * CS] = sb; sb = ab[c] + gb * sb; }
    }
}

__device__ __forceinline__ bf16x8 pack8(const f32x4& a, const f32x4& b) {
    u32x4 w; w.x = pg8::cvt_pk_bf16(a[0], a[1]); w.y = pg8::cvt_pk_bf16(a[2], a[3]); w.z = pg8::cvt_pk_bf16(b[0], b[1]); w.w = pg8::cvt_pk_bf16(b[2], b[3]);
    return __builtin_bit_cast(bf16x8, w);
}
__device__ __forceinline__ void m3_outputs(const KQ p_in, int e, bool ctx_full, unsigned char* smem) {
    const KQ p = lq(p_in);
    const int tid = ltid(), bid = blockIdx.x, nb = gridDim.x;
    const int w = tid >> 6, lane = tid & 63, ln = lane & 15, g4 = lane >> 4;
    const bf16_t* Z = (const bf16_t*)(p.ws + WS_BIG);
    bf16_t* MIX = (bf16_t*)(p.ws + WS_MIX);
    const float* dec = pin_ld(13) + e * 16;
    const float* sink = pin_ld(12) + e * 8;
    const float* TF = (const float*)(p.ws + WS_ST) + 2 * (SZ_ST / 4); const float* TB = TF + SZ_ST / 4;
    const int nchunk = ctx_full ? NCH : 32;
    const int nitems = NB * nchunk * 8;
    bf16_t* Kt = (bf16_t*)smem;
    bf16_t* Vt = Kt + 128 * 72;
    bf16_t* TfT = Vt + 64 * 136;
    bf16_t* TbT = TfT + 64 * 72;
    const int i = 16 * w + ln;
    for (int it = bid; it < 2 * nitems; it += nb) {
        const bool is_attn = it < nitems; const int ii = is_attn ? it : it - nitems;
        const int h = ii & 7, cidx = (ii >> 3) % nchunk, b = ii / (8 * nchunk);
        const int t0 = chunk_t0(b, cidx); const bool lat = cidx < 32;
        f32x4 O[4];
#pragma unroll
        for (int m = 0; m < 4; ++m) O[m] = (f32x4){0.f, 0.f, 0.f, 0.f};
        if (!is_attn) {
            const float lgf = log_sigmoid(dec[h]), lgb = log_sigmoid(dec[8 + h]);
            __syncthreads();
#pragma unroll
            for (int q = 0; q < 2; ++q) { const int idx = tid + 512 * q; const int r = idx >> 3, pc = idx & 7; const bf16_t* zr = Z + (size_t)(t0 + r) * INW + h * 64 + pc * 8;
                *(u32x4*)(Kt + r * 72 + pc * 8) = *(const u32x4*)(zr + 1792);
                const bf16x8 vv = *(const bf16x8*)(zr + 2304);
#pragma unroll
                for (int j = 0; j < 8; ++j) Vt[(pc * 8 + j) * 136 + (r ^ (pc << 2))] = (bf16_t)vv[j]; }
            const size_t so = ((size_t)(b * NCH + cidx) * 8 + h) * 4096;
#pragma unroll
            for (int q = 0; q < 8; ++q) { const int idx = tid + 512 * q; const int d = idx >> 6, ee = idx & 63; TfT[ee * 72 + d] = f2bf(TF[so + idx]); TbT[ee * 72 + d] = f2bf(TB[so + idx]); }
            __builtin_amdgcn_sched_barrier(0);
            bf16x8 qf[2], qff[2], qfb[2];
            { const bf16_t* qr = Z + (size_t)(t0 + i) * INW + 512 + h * 64 + 8 * g4;
              const float cf = __expf(lgf * (float)(i + 1)), cb = __expf(lgb * (float)(128 - i));
#pragma unroll
              for (int k2 = 0; k2 < 2; ++k2) { qf[k2] = *(const bf16x8*)(qr + 32 * k2);
                  f32x4 a0, a1, b0, b1;
#pragma unroll
                  for (int j = 0; j < 4; ++j) { const float x0 = bf2f((bf16_t)qf[k2][j]), x1 = bf2f((bf16_t)qf[k2][4 + j]); a0[j] = x0 * cf; a1[j] = x1 * cf; b0[j] = x0 * cb; b1[j] = x1 * cb; }
                  qff[k2] = pack8(a0, a1); qfb[k2] = pack8(b0, b1); } }
            __builtin_amdgcn_sched_barrier(0);
            __syncthreads();
#pragma unroll
            for (int m = 0; m < 4; ++m)
#pragma unroll
                for (int k2 = 0; k2 < 2; ++k2) {
                    const bf16x8 af = *(const bf16x8*)(TfT + (16 * m + ln) * 72 + 32 * k2 + 8 * g4);
                    const bf16x8 ab = *(const bf16x8*)(TbT + (16 * m + ln) * 72 + 32 * k2 + 8 * g4);
                    O[m] = __builtin_amdgcn_mfma_f32_16x16x32_bf16(af, qff[k2], O[m], 0, 0, 0);
                    O[m] = __builtin_amdgcn_mfma_f32_16x16x32_bf16(ab, qfb[k2], O[m], 0, 0, 0);
                    __builtin_amdgcn_sched_barrier(0);
                }
            const float lf2 = lgf * 1.44269504f, lb2 = lgb * 1.44269504f; const int di = i - 4 * g4;
            const float bfw = lf2 * (float)di, bbw = -lb2 * (float)di;
            f32x4 st[8];
#pragma unroll
            for (int mt = 0; mt < 8; ++mt) {
                f32x4 a = (f32x4){0.f, 0.f, 0.f, 0.f};
#pragma unroll
                for (int k2 = 0; k2 < 2; ++k2) { const bf16x8 kf = *(const bf16x8*)(Kt + (16 * mt + ln) * 72 + 32 * k2 + 8 * g4); a = __builtin_amdgcn_mfma_f32_16x16x32_bf16(kf, qf[k2], a, 0, 0, 0); }
#pragma unroll
                for (int rg = 0; rg < 4; ++rg) { const int cc = 16 * mt + rg; const int df = di - cc;
                    const float arg = (df > 0) ? fmaf(-lf2, (float)cc, bfw) : fmaf(lb2, (float)cc, bbw);
                    float wgt = __builtin_amdgcn_exp2f(arg); wgt = (df == 0) ? 2.0f : wgt;
                    a[rg] *= wgt; }
                st[mt] = a;
                __builtin_amdgcn_sched_barrier(0);
            }
#pragma unroll
            for (int ks = 0; ks < 4; ++ks) {
                const bf16x8 pfr = pack8(st[2 * ks], st[2 * ks + 1]);
#pragma unroll
                for (int m = 0; m < 4; ++m) {
                    const int vrow = 16 * m + ln; const int kx = (32 * ks + 4 * g4) ^ (((vrow >> 3) & 7) << 2);
                    const bf16_t* vr = Vt + vrow * 136;
                    const bf16x4 v0 = *(const bf16x4*)(vr + kx), v1 = *(const bf16x4*)(vr + (kx ^ 16));
                    const bf16x8 vf = __builtin_shufflevector(v0, v1, 0, 1, 2, 3, 4, 5, 6, 7);
                    O[m] = __builtin_amdgcn_mfma_f32_16x16x32_bf16(vf, pfr, O[m], 0, 0, 0);
                }
                __builtin_amdgcn_sched_barrier(0);
            }
            float ss = 0.f;
#pragma unroll
            for (int m = 0; m < 4; ++m)
#pragma unroll
                for (int rg = 0; rg < 4; ++rg) ss += O[m][rg] * O[m][rg];
            ss += __shfl_xor(ss, 16, 64); ss += __shfl_xor(ss, 32, 64);
            const float rn = rsqrtf(ss * (1.0f / 64.0f) + EPS);
#pragma unroll
            for (int m = 0; m < 4; ++m) {
                const int ee = 16 * m + 4 * g4;
                const bf16x4 gv = *(const bf16x4*)(Z + (size_t)(t0 + i) * INW + 1024 + h * 64 + ee);
                uint2 o2; o2.x = pg8::cvt_pk_bf16(O[m][0] * rn * silu_f(bf2f((bf16_t)gv[0])), O[m][1] * rn * silu_f(bf2f((bf16_t)gv[1])));
                o2.y = pg8::cvt_pk_bf16(O[m][2] * rn * silu_f(bf2f((bf16_t)gv[2])), O[m][3] * rn * silu_f(bf2f((bf16_t)gv[3])));
                *(uint2*)(MIX + (size_t)(t0 + i) * D + 512 + h * 64 + ee) = o2;
            }
        } else {
            const int gk = h >> 2;
            bf16x8 qf[2];
            { const bf16_t* qr = Z + (size_t)(t0 + i) * INW + h * 64 + 8 * g4; qf[0] = *(const bf16x8*)qr; qf[1] = *(const bf16x8*)(qr + 32); }
            float mx = sink[h], l = (g4 == 0) ? 1.0f : 0.0f;
            const int qpos = lat ? (cidx * 128 + i) : 0;
#define ATT_VALID(tl_) ((tl_) >= 3 || (lat && (cidx - 1 + (tl_)) >= 0 && (cidx - 1 + (tl_)) < 32))
#define ATT_KT0(tl_) ((tl_) >= 3 ? TL + b * CL + ((tl_) - 3) * 128 : b * SEQ + (cidx - 1 + (tl_)) * 128)
            int tl = 0; while (!ATT_VALID(tl)) ++tl;
            u32x4 kreg[2]; bf16x8 vreg[2];
            { const int kt0 = ATT_KT0(tl);
#pragma unroll
              for (int q = 0; q < 2; ++q) { const int idx = tid + 512 * q; const int r = idx >> 3, pc = idx & 7; const bf16_t* zr = Z + (size_t)(kt0 + r) * INW + gk * 64 + pc * 8;
                  kreg[q] = *(const u32x4*)(zr + 1536); vreg[q] = *(const bf16x8*)(zr + 1664); } }
            while (tl < 5) {
                const bool isc = tl >= 3; const int kp0 = isc ? 0 : (cidx - 1 + tl) * 128;
                __syncthreads();
#pragma unroll
                for (int q = 0; q < 2; ++q) { const int idx = tid + 512 * q; const int r = idx >> 3, pc = idx & 7;
                    *(u32x4*)(Kt + r * 72 + pc * 8) = kreg[q];
#pragma unroll
                    for (int j = 0; j < 8; ++j) Vt[(pc * 8 + j) * 136 + (r ^ (pc << 2))] = (bf16_t)vreg[q][j]; }
                __syncthreads();
                int tn = tl + 1; while (tn < 5 && !ATT_VALID(tn)) ++tn;
                if (tn < 5) { const int kt0 = ATT_KT0(tn);
#pragma unroll
                    for (int q = 0; q < 2; ++q) { const int idx = tid + 512 * q; const int r = idx >> 3, pc = idx & 7; const bf16_t* zr = Z + (size_t)(kt0 + r) * INW + gk * 64 + pc * 8;
                        kreg[q] = *(const u32x4*)(zr + 1536); vreg[q] = *(const bf16x8*)(zr + 1664); } }
                f32x4 st[8];
                float mloc = -1e30f;
#pragma unroll
                for (int mt = 0; mt < 8; ++mt) {
                    f32x4 a = (f32x4){0.f, 0.f, 0.f, 0.f};
#pragma unroll
                    for (int k2 = 0; k2 < 2; ++k2) { const bf16x8 kf = *(const bf16x8*)(Kt + (16 * mt + ln) * 72 + 32 * k2 + 8 * g4); a = __builtin_amdgcn_mfma_f32_16x16x32_bf16(kf, qf[k2], a, 0, 0, 0); }
                    if (!isc) {
#pragma unroll
                        for (int rg = 0; rg < 4; ++rg) { const int dd = qpos - (kp0 + 16 * mt + 4 * g4 + rg); if (dd > 128 || dd < -128) a[rg] = -1e30f; }
                    }
#pragma unroll
                    for (int rg = 0; rg < 4; ++rg) mloc = fmaxf(mloc, a[rg]);
                    st[mt] = a;
                    __builtin_amdgcn_sched_barrier(0);
                }
                mloc = fmaxf(mloc, __shfl_xor(mloc, 16, 64)); mloc = fmaxf(mloc, __shfl_xor(mloc, 32, 64));
                const float mnew = fmaxf(mx, mloc);
                const float sc = __expf(mx - mnew); mx = mnew; l *= sc;
#pragma unroll
                for (int m = 0; m < 4; ++m) O[m] *= sc;
#pragma unroll
                for (int mt = 0; mt < 8; ++mt)
#pragma unroll
                    for (int rg = 0; rg < 4; ++rg) { const float pv = __expf(st[mt][rg] - mnew); st[mt][rg] = pv; l += pv; }
#pragma unroll
                for (int ks = 0; ks < 4; ++ks) {
                    const bf16x8 pfr = pack8(st[2 * ks], st[2 * ks + 1]);
#pragma unroll
                    for (int m = 0; m < 4; ++m) {
                        const int vrow = 16 * m + ln; const int kx = (32 * ks + 4 * g4) ^ (((vrow >> 3) & 7) << 2);
                        const bf16_t* vr = Vt + vrow * 136;
                        const bf16x4 v0 = *(const bf16x4*)(vr + kx), v1 = *(const bf16x4*)(vr + (kx ^ 16));
                        const bf16x8 vf = __builtin_shufflevector(v0, v1, 0, 1, 2, 3, 4, 5, 6, 7);
                        O[m] = __builtin_amdgcn_mfma_f32_16x16x32_bf16(vf, pfr, O[m], 0, 0, 0);
                    }
                    __builtin_amdgcn_sched_barrier(0);
                }
                tl = tn;
            }
#undef ATT_VALID
#undef ATT_KT0
            l += __shfl_xor(l, 16, 64); l += __shfl_xor(l, 32, 64);
            const float inv = 1.0f / l;
#pragma unroll
            for (int m = 0; m < 4; ++m) {
                uint2 o2; o2.x = pg8::cvt_pk_bf16(O[m][0] * inv, O[m][1] * inv); o2.y = pg8::cvt_pk_bf16(O[m][2] * inv, O[m][3] * inv);
                *(uint2*)(MIX + (size_t)(t0 + i) * D + h * 64 + 16 * m + 4 * g4) = o2;
            }
        }
    }
    __syncthreads();
}

__device__ __forceinline__ void h2_shortconv(const KQ p_in, int o, int M, unsigned char* smem) {
    const KQ p = lq(p_in);
    const int tid = ltid();
    const bf16_t* ZH = (const bf16_t*)(p.ws + WS_BIG);
    const float* w = pin_ld(17) + (size_t)o * 3 * HYW; const float* bs = pin_ld(18) + (size_t)o * HYW;
    bf16_t* VXT = (bf16_t*)(p.ws + WS_Y); bf16_t* X0T = VXT + (size_t)D * TL;
    bf16_t* tx = (bf16_t*)smem;
    bf16_t* tv = tx + 64 * 136;
    const int tok = tid >> 3, cg8 = (tid & 7) * 8;
    float* wl = (float*)(smem + 40960);
    { const int c0b = (blockIdx.x & 15) * 64;
      for (int i = tid; i < 768; i += 512) { const int k = i >> 8, q = (i >> 6) & 3, c = i & 63; const int col = k * 1024 + c0b + c; wl[i] = (q < 3) ? w[q * HYW + col] : bs[col]; } }
    __syncthreads();
    for (int it = blockIdx.x; it < (TL / 128) * 16; it += gridDim.x) {
        const int c0 = (it & 15) * 64, t0 = (it >> 4) * 128;
        bf16x8 zc[2][3], zp[2][3], zn[2][3];
#pragma unroll
        for (int g = 0; g < 2; ++g) {
            const int t = t0 + tok + 64 * g; const int pos = t & (SEQ - 1); const bool first = pos == 0, last = pos == SEQ - 1;
#pragma unroll
            for (int k = 0; k < 3; ++k) {
                const int c = k * 1024 + c0 + cg8;
                zc[g][k] = *(const bf16x8*)(ZH + (size_t)t * HYW + c);
                zp[g][k] = *(const bf16x8*)(ZH + (size_t)(first ? t : t - 1) * HYW + c);
                zn[g][k] = *(const bf16x8*)(ZH + (size_t)(last ? t : t + 1) * HYW + c);
            }
        }
        __syncthreads();
#pragma unroll
        for (int g = 0; g < 2; ++g) {
            const int t = t0 + tok + 64 * g; const int pos = t & (SEQ - 1); const float mf = (pos == 0) ? 0.f : 1.f, ml = (pos == SEQ - 1) ? 0.f : 1.f;
            float zz[3][8];
#pragma unroll
            for (int k = 0; k < 3; ++k) {
                const float* wk = wl + k * 256 + cg8;
#pragma unroll
                for (int j = 0; j < 8; ++j)
                    zz[k][j] = wk[192 + j] + bf2f((bf16_t)zc[g][k][j]) * wk[64 + j] + mf * bf2f((bf16_t)zp[g][k][j]) * wk[j] + ml * bf2f((bf16_t)zn[g][k][j]) * wk[128 + j];
            }
#pragma unroll
            for (int j = 0; j < 8; ++j) { const int cs = (tok + 64 * g) ^ ((tid & 7) << 3);
                tx[(cg8 + j) * 136 + cs] = f2bf(zz[0][j]); tv[(cg8 + j) * 136 + cs] = f2bf(zz[2][j] * zz[1][j]); }
        }
        __syncthreads();
        { const int ch = tid >> 3, tk = (tid & 7) * 8;
#pragma unroll
          for (int q = 0; q < 2; ++q) {
            const int cs = (tk + 64 * q) ^ (((ch >> 3) & 7) << 3);
            *(u32x4*)(X0T + (size_t)(c0 + ch) * TL + t0 + tk + 64 * q) = *(const u32x4*)(tx + ch * 136 + cs);
            *(u32x4*)(VXT + (size_t)(c0 + ch) * TL + t0 + tk + 64 * q) = *(const u32x4*)(tv + ch * 136 + cs); } }
    }
    __syncthreads();
    if (M > TL) {
        float* VX = (float*)(p.ws + WS_Y); bf16_t* X0 = (bf16_t*)(p.ws + WS_H);
        for (int idx = TL * D + blockIdx.x * 512 + tid; idx < M * D; idx += gridDim.x * 512) {
            const int t = idx >> 10, d = idx & 1023;
            const int pos = (t - TL) & (CL - 1); const bool first = pos == 0, last = pos == CL - 1;
            float zz[3];
#pragma unroll
            for (int k = 0; k < 3; ++k) {
                const int c = k * 1024 + d;
                float sacc = bs[c] + bf2f(ZH[(size_t)t * HYW + c]) * w[HYW + c];
                if (!first) sacc += bf2f(ZH[(size_t)(t - 1) * HYW + c]) * w[c];
                if (!last) sacc += bf2f(ZH[(size_t)(t + 1) * HYW + c]) * w[2 * HYW + c];
                zz[k] = sacc;
            }
            VX[idx] = zz[2] * zz[1]; X0[idx] = f2bf(zz[0]);
        }
    }
}

typedef float f32x16 __attribute__((ext_vector_type(16)));
__device__ __forceinline__ void h3_longconv(const KQ p_in, int o, bool ctx_full, unsigned char* smem) {
    const KQ p = lq(p_in);
    const int tid = ltid(), w = tid >> 6, lane = tid & 63;
    const float* bias = pin_ld(27) + (size_t)o * D;
    {
        const bf16_t* VXT = (const bf16_t*)(p.ws + WS_Y); const bf16_t* X0T = VXT + (size_t)D * TL;
        bf16_t* HMT = (bf16_t*)(p.ws + WS_H);
        const bf16_t* RKT = (const bf16_t*)(p.ws + WS_KF + (size_t)o * SZ_KF);
        constexpr int RK2_OFF = 16384 + 64, U_OFF = 2 * 16384 + 128, CH_BYTES = U_OFF + 142 * 256;
        const int cw = w >> 2, w4 = w & 3;
        const int ct = tid & 255;
        unsigned char* cb = smem + cw * CH_BYTES;
        unsigned char* ub = cb + U_OFF;
        const int r = lane & 31, hh = lane >> 5;
        for (int pr = blockIdx.x; pr < D / 2; pr += gridDim.x) {
            const int d = pr * 2 + cw;
            __syncthreads();
            { const bf16_t* src = RKT + (size_t)d * 8192;
              for (int i = ct; i < 1024; i += 256) *(u32x4*)(cb + i * 16) = *(const u32x4*)(src + i * 8);
              for (int i = ct; i < 2 * 7 * 4 * 4; i += 256) { const int side = i / 112, rem = i % 112; unsigned z0 = 0u; asm volatile("" : "+v"(z0)); *(u32x4*)(ub + (side ? (135 * 4 * 64) : 0) + rem * 16) = (u32x4){z0, z0, z0, z0}; }
#pragma unroll 8
              for (int i = ct; i < 4 * 512; i += 256) { const int b = i >> 9, pc = i & 511;
                  const u32x4 v = *(const u32x4*)(VXT + (size_t)d * TL + b * SEQ + pc * 8);
                  const int col = ((pc >> 2) + 7) * 4 + b, q = pc & 3;
                  *(u32x4*)(ub + col * 64 + ((q ^ ((col >> 2) & 3)) * 16)) = v; } }
            __syncthreads();
            { const bf16_t* rk = (const bf16_t*)cb; bf16_t* rk2 = (bf16_t*)(cb + RK2_OFF);
#pragma unroll 4
              for (int i = ct; i < 4096; i += 256) { const unsigned lo = rk[2 * i + 1]; const unsigned hi = (2 * i + 2 < 8192) ? rk[2 * i + 2] : 0u; *(unsigned*)(rk2 + 2 * i) = lo | (hi << 16); } }
            __syncthreads();
            f32x16 acc[4];
#pragma unroll
            for (int j = 0; j < 4; ++j)
#pragma unroll
                for (int q = 0; q < 16; ++q) acc[j][q] = 0.f;
            const bf16_t* rsel = (const bf16_t*)(cb + ((r & 1) ? 0 : RK2_OFF));
            const int adj = (r & 1) ? 0 : -1;
            const int bq = r & 3;
#define H3_LOAD(AF, BF, U) do { \
                _Pragma("unroll") for (int s2 = 0; s2 < 2; ++s2) { \
                    const unsigned* ap = (const unsigned*)(Ab + 64 * (3 - (U)) + 32 * s2); \
                    u32x4 t4; t4.x = ap[0]; t4.y = ap[1]; t4.z = ap[2]; t4.w = ap[3]; \
                    AF[s2] = __builtin_bit_cast(bf16x8, t4); } \
                _Pragma("unroll") for (int j = 0; j < 4; ++j) { \
                    int c_ = Lb - 256 * (U) + 2048 * j; c_ = c_ < LO ? LO : (c_ > HI ? HI : c_); \
                    BF[j][0] = *(const bf16x8*)(ub + c_ + off[U][0]); BF[j][1] = *(const bf16x8*)(ub + c_ + off[U][1]); } } while (0)
#define H3_MMA(AF, BF) do { \
                _Pragma("unroll") for (int s2 = 0; s2 < 2; ++s2) \
                _Pragma("unroll") for (int j = 0; j < 4; ++j) acc[j] = __builtin_amdgcn_mfma_f32_32x32x16_bf16(AF[s2], BF[j][s2], acc[j], 0, 0, 0); } while (0)
            {
                const int dlo = 32 * w4 - 127;
                const int LO = (24 + bq) * 64, HI = (540 + bq) * 64;
                int off[4][2];
#pragma unroll
                for (int u = 0; u < 4; ++u) { const int sw = ((r >> 2) + 2 - u) & 3; off[u][0] = (hh ^ sw) * 16; off[u][1] = ((2 + hh) ^ sw) * 16; }
                int Lb = (((r >> 2) + 134) * 4 + bq) * 64;
                const unsigned char* Ab = (const unsigned char*)(rsel + (4095 - 32 * dlo - r + 8 * hh + adj)) - 192;
                bf16x8 afA[2], bfA[4][2], afB[2], bfB[4][2];
                H3_LOAD(afA, bfA, 0);
                for (int g = 0; g < 39; ++g) {
                    H3_LOAD(afB, bfB, 1);
                    __builtin_amdgcn_sched_barrier(0);
                    H3_MMA(afA, bfA);
                    __builtin_amdgcn_sched_barrier(0);
                    H3_LOAD(afA, bfA, 2);
                    __builtin_amdgcn_sched_barrier(0);
                    H3_MMA(afB, bfB);
                    __builtin_amdgcn_sched_barrier(0);
                    H3_LOAD(afB, bfB, 3);
                    __builtin_amdgcn_sched_barrier(0);
                    H3_MMA(afA, bfA);
                    __builtin_amdgcn_sched_barrier(0);
                    Ab -= 256; Lb -= 1024;
                    H3_LOAD(afA, bfA, 0);
                    __builtin_amdgcn_sched_barrier(0);
                    H3_MMA(afB, bfB);
                    __builtin_amdgcn_sched_barrier(0);
                }
                H3_LOAD(afB, bfB, 1);
                __builtin_amdgcn_sched_barrier(0);
                H3_MMA(afA, bfA);
                __builtin_amdgcn_sched_barrier(0);
                H3_LOAD(afA, bfA, 2);
                __builtin_amdgcn_sched_barrier(0);
                H3_MMA(afB, bfB);
                H3_MMA(afA, bfA);
            }
#undef H3_LOAD
#undef H3_MMA
            __syncthreads();
            const float bd = bias[d];
#pragma unroll
            for (int j = 0; j < 4; ++j) {
                const int n1 = 8 * (4 * w4 + j) + (r >> 2);
                const int col = (n1 + 7) * 4 + bq; const int sw = (col >> 2) & 3;
                bf16_t* up = (bf16_t*)(ub + col * 64);
#pragma unroll
                for (int q4 = 0; q4 < 4; ++q4) {
                    bf16_t* pp = up + ((q4 ^ sw) * 8) + 4 * hh;
                    const bf16x4 uv = *(const bf16x4*)pp;
                    uint2 o2; o2.x = pg8::cvt_pk_bf16(acc[j][4 * q4] + bd * bf2f((bf16_t)uv[0]), acc[j][4 * q4 + 1] + bd * bf2f((bf16_t)uv[1]));
                    o2.y = pg8::cvt_pk_bf16(acc[j][4 * q4 + 2] + bd * bf2f((bf16_t)uv[2]), acc[j][4 * q4 + 3] + bd * bf2f((bf16_t)uv[3]));
                    *(uint2*)pp = o2;
                }
            }
            __syncthreads();
#pragma unroll 4
            for (int i = ct; i < 4 * 512; i += 256) { const int b = i >> 9, pc = i & 511;
                const int col = ((pc >> 2) + 7) * 4 + b, q = pc & 3;
                const bf16x8 yv = *(const bf16x8*)(ub + col * 64 + ((q ^ ((col >> 2) & 3)) * 16));
                const size_t gi = (size_t)d * TL + b * SEQ + pc * 8;
                const bf16x8 xv = *(const bf16x8*)(X0T + gi);
                u32x4 o4;
                o4.x = pg8::cvt_pk_bf16(bf2f((bf16_t)yv[0]) * bf2f((bf16_t)xv[0]), bf2f((bf16_t)yv[1]) * bf2f((bf16_t)xv[1]));
                o4.y = pg8::cvt_pk_bf16(bf2f((bf16_t)yv[2]) * bf2f((bf16_t)xv[2]), bf2f((bf16_t)yv[3]) * bf2f((bf16_t)xv[3]));
                o4.z = pg8::cvt_pk_bf16(bf2f((bf16_t)yv[4]) * bf2f((bf16_t)xv[4]), bf2f((bf16_t)yv[5]) * bf2f((bf16_t)xv[5]));
                o4.w = pg8::cvt_pk_bf16(bf2f((bf16_t)yv[6]) * bf2f((bf16_t)xv[6]), bf2f((bf16_t)yv[7]) * bf2f((bf16_t)xv[7]));
                *(u32x4*)(HMT + gi) = o4; }
        }
        __syncthreads();
    }
    if (ctx_full) {
        const float* VX = (const float*)(p.ws + WS_Y); const bf16_t* X0 = (const bf16_t*)(p.ws + WS_H);
        bf16_t* MIX = (bf16_t*)(p.ws + WS_MIX);
        const float* kf = (const float*)(p.ws + WS_KF + (size_t)o * SZ_KF) + (size_t)2 * SEQ * D;
        for (int idx = blockIdx.x * 512 + tid; idx < (TC / 8) * D; idx += gridDim.x * 512) {
            const int d = idx & 1023, og = idx >> 10;
            const int bb = og >> 5, n0 = (og & 31) * 8, tb = TL + bb * CL;
            const float* up = VX + (size_t)tb * D + d;
            float acc[8];
#pragma unroll
            for (int j = 0; j < 8; ++j) acc[j] = 0.f;
#pragma unroll 1
            for (int mb = 0; mb < CL; mb += 8) {
                float kk[15], uu[8];
#pragma unroll
                for (int q = 0; q < 15; ++q) { const int lag = n0 - mb - 7 + q;
                    kk[q] = (lag >= 0) ? ((lag < CL) ? kf[(size_t)lag * D + d] : 0.f) : ((-lag < CL) ? kf[(size_t)(CL - lag) * D + d] : 0.f); }
#pragma unroll
                for (int u = 0; u < 8; ++u) uu[u] = up[(size_t)(mb + u) * D];
#pragma unroll
                for (int u = 0; u < 8; ++u)
#pragma unroll
                    for (int j = 0; j < 8; ++j) acc[j] += uu[u] * kk[7 - u + j];
            }
            const float bd = bias[d];
#pragma unroll
            for (int j = 0; j < 8; ++j) { const size_t ti = (size_t)(tb + n0 + j) * D + d; MIX[ti] = f2bf(bf2f(X0[ti]) * (acc[j] + bd * VX[ti])); }
        }
    }
}

__device__ __forceinline__ void h3b_transpose(const KQ p_in, unsigned char* smem) {
    const KQ p = lq(p_in);
    const int tid = ltid();
    const bf16_t* HMT = (const bf16_t*)(p.ws + WS_H); bf16_t* MIX = (bf16_t*)(p.ws + WS_MIX);
    bf16_t* tile = (bf16_t*)smem;
    for (int it = blockIdx.x; it < (TL / 256) * 16; it += gridDim.x) {
        const int c0 = (it & 15) * 64, t0 = (it >> 4) * 256;
        u32x4 ld[4];
        { const int ch = tid >> 3, tk = (tid & 7) * 8;
#pragma unroll
          for (int q = 0; q < 4; ++q) ld[q] = *(const u32x4*)(HMT + (size_t)(c0 + ch) * TL + t0 + tk + 64 * q);
          __syncthreads();
#pragma unroll
          for (int q = 0; q < 4; ++q) *(u32x4*)(tile + ch * 264 + ((tk + 64 * q) ^ (((ch >> 3) & 7) << 3))) = ld[q]; }
        __syncthreads();
        { const int cg8 = (tid & 7) * 8;
#pragma unroll
          for (int q = 0; q < 4; ++q) { const int tok = (tid >> 3) + 64 * q; unsigned short v[8];
#pragma unroll
              for (int j = 0; j < 8; ++j) v[j] = tile[(cg8 + j) * 264 + (tok ^ ((tid & 7) << 3))];
              u32x4 o4; o4.x = v[0] | ((unsigned)v[1] << 16); o4.y = v[2] | ((unsigned)v[3] << 16); o4.z = v[4] | ((unsigned)v[5] << 16); o4.w = v[6] | ((unsigned)v[7] << 16);
              *(u32x4*)(MIX + (size_t)(t0 + tok) * D + c0 + cg8) = o4; } }
    }
    __syncthreads();
}

__global__ void __launch_bounds__(512, 2) mega_fwd(KP kp) {
    unsigned char* const smem = g_smem;
    if (threadIdx.x < 29) *(LAS unsigned long long*)((LAS unsigned char*)g_smem + PTAB_OFF + 8 * threadIdx.x) = ((const unsigned long long*)__builtin_amdgcn_kernarg_segment_ptr())[threadIdx.x];
    KQ p; p.out = kp.out; p.ws = kp.ws;
    cg::grid_group grid = cg::this_grid();
    if (threadIdx.x < 4) ((volatile LAS unsigned*)(LAS unsigned char*)smem)[(LDS_BYTES - 16) / 4 + threadIdx.x] = 0u;
    __syncthreads();
    if (threadIdx.x == 0) (void)xb_add(&((unsigned*)(lq(p).ws + WS_BAR))[XB_XCNT(xb_xcc_id())], 1u);
    grid.sync();
    float* smf = (float*)smem;
#define Hb ((bf16_t*)(lq(p).ws + WS_H))
#define BIG ((bf16_t*)(lq(p).ws + WS_BIG))
#define Y ((bf16_t*)(lq(p).ws + WS_Y))
#define MIX ((bf16_t*)(lq(p).ws + WS_MIX))

#ifndef NO_P0
    p0_setup(p, smf);
#endif
    GRID_BAR();
    rowphase(p, 0, nullptr, 0, 0, 0.f, nullptr, T, 0, pin_ld(6), 0, 1, Hb, true, 0);
    GRID_BAR();
    for (int l = 0; l < 4; ++l) {
        const bool ctx_live = l <= 2, ctx_full = l < 2;
        const int Mff = ctx_live ? T : TL, Mpost = ctx_full ? T : TL;
        for (int sub = 0; sub < 3; ++sub) {
            const bf16_t* Ao; const bf16_t* Bo; int Ko; int Mo;
            if (sub != 1) {
                const int fi = sub >> 1; const int M = (sub == 0) ? Mff : Mpost;
                { pg8::EpiSwiGLU E{BIG, DFF}; run_gemm(smem, Hb, (const bf16_t*)(lq(p).ws + WS_WGU + (size_t)(l * 2 + fi) * SZ_WGU), M, 2 * DFF, D, E); }
                GRID_BAR();
                Ao = BIG; Bo = (const bf16_t*)(lq(p).ws + WS_WD + (size_t)(l * 2 + fi) * SZ_WD); Ko = DFF; Mo = M;
            } else {
                if ((l & 1) == 0) {
                    const int e = l >> 1;
                    { pg8::EpiBf16 E{BIG, INW, nullptr}; run_gemm(smem, Hb, (const bf16_t*)(lq(p).ws + WS_WIN + (size_t)e * SZ_WIN), Mff, INW, D, E); }
                    GRID_BAR();
#ifndef NO_M1
                    m1_rope_states(p, e, smf);
#endif
                    GRID_BAR();
#ifndef NO_M2
                    m2_scan(p, e);
#endif
                    GRID_BAR();
#ifndef NO_M3
                    m3_outputs(p, e, ctx_full, smem);
#endif
                    GRID_BAR();
                    Bo = (const bf16_t*)(lq(p).ws + WS_WOUT + (size_t)e * SZ_WOUT);
                } else {
                    const int o = l >> 1;
                    { pg8::EpiBf16 E{BIG, HYW, pin_ld(16) + (size_t)o * HYW}; run_gemm(smem, Hb, (const bf16_t*)(lq(p).ws + WS_HWIN + (size_t)o * SZ_HWIN), Mpost, HYW, D, E); }
                    GRID_BAR();
#ifndef NO_H2
                    h2_shortconv(p, o, Mpost, smem);
#endif
                    GRID_BAR();
#ifndef NO_H3
                    h3_longconv(p, o, ctx_full, smem);
#endif
                    GRID_BAR();
                    h3b_transpose(p, smem);
                    GRID_BAR();
                    Bo = (const bf16_t*)(lq(p).ws + WS_HWOUT + (size_t)o * SZ_WOUT);
                }
                Ao = MIX; Ko = D; Mo = Mpost;
            }
            const int gidx = 2 + 3 * sub;
            const int ln = (sub == 2) ? l + 1 : l; const bool has_next = ln < 4; const int lnn = has_next ? ln : l;
            const int pre_i = (sub == 2) ? 0 : sub + 1;
            const int Mn = has_next ? ((sub == 2) ? ((ln <= 2) ? T : TL) : ((sub == 0) ? Mff : Mpost)) : 0;
            const float* gpost = pin_ld(7) + (size_t)(l * 3 + sub) * D; const float* gpre = pin_ld(6) + (size_t)(lnn * 3 + pre_i) * D;
            const float wg = (sub == 1) ? 1.0f : 0.5f;
            {
                pg8::EpiFusedRow EF;
                EF.xin = (l == 0 && sub == 0) ? pin_ld(0) : (const float*)lq(p).out; EF.xout = lq(p).out; EF.H = has_next ? Hb : nullptr;
                EF.gate = modp(lq(p), l, 0, gidx); EF.gpost = gpost; EF.wgt = wg;
                EF.gpre = gpre; EF.shift = modp(lq(p), lnn, 0, 3 * pre_i); EF.scale = modp(lq(p), lnn, 0, 3 * pre_i + 1);
                EF.slots = (float*)(lq(p).ws + WS_SLOT); EF.cnt = (unsigned*)(lq(p).ws + WS_CNT) + (size_t)(l * 3 + sub) * 2 * 64 * 64;
                run_gemm_f32_split(smem, Ao, Bo, Mo, Ko, EF, (float*)(lq(p).ws + WS_YP));
            }
            if (Mo > TL && blockIdx.x < 64) {
                sub_barrier((unsigned*)(lq(p).ws + WS_CNT) + (size_t)12 * 2 * 64 * 64 + (l * 3 + sub) * 64, 64u);
                rowphase(p, Mo, Y, l, gidx, wg, gpost, Mn, lnn, gpre, 3 * pre_i, 3 * pre_i + 1, has_next ? Hb : nullptr, l == 0 && sub == 0, TL);
            }
            GRID_BAR();
        }
    }
}

extern "C" void kernel_launch(void* const* d_in, const int* in_sizes, int n_in, void* d_out, int out_size, void* d_ws, size_t ws_size, hipStream_t stream) {
    static int grid = 0;
    if (grid == 0) {
        if (n_in != 29 || out_size != TL * D || ws_size < WS_END) { fprintf(stderr, "kernel_launch: unexpected shapes: n_in %d out %d ws %zu (need %zu)\n", n_in, out_size, ws_size, (size_t)WS_END); grid = -1; return; }
        int dev = 0, cus = 0, per_cu = 0;
        (void)hipGetDevice(&dev);
        (void)hipDeviceGetAttribute(&cus, hipDeviceAttributeMultiprocessorCount, dev);
        if (hipFuncSetAttribute((const void*)mega_fwd, hipFuncAttributeMaxDynamicSharedMemorySize, LDS_BYTES) != hipSuccess) { fprintf(stderr, "kernel_launch: hipFuncSetAttribute failed\n"); grid = -1; return; }
        if (hipOccupancyMaxActiveBlocksPerMultiprocessor(&per_cu, (const void*)mega_fwd, 512, LDS_BYTES) != hipSuccess || per_cu < 1) { fprintf(stderr, "kernel_launch: occupancy query says %d\n", per_cu); per_cu = 1; }
        (void)hipGetLastError();
        grid = cus >= 256 ? 256 : cus;
    }
    if (grid < 0) return;
    (void)hipMemsetAsync((unsigned char*)d_ws + WS_BAR, 0, 16384 + SZ_CNT, stream);
    KP kp{};
    for (int i = 0; i < 29; ++i) kp.in[i] = (const float*)d_in[i];
    kp.out = (float*)d_out; kp.ws = (unsigned char*)d_ws;
    void* args[] = {&kp};
    hipError_t e = hipLaunchCooperativeKernel((const void*)mega_fwd, dim3(grid), dim3(512), args, LDS_BYTES, stream);
    if (e != hipSuccess) fprintf(stderr, "cooperative launch failed: %s (grid %d)\n", hipGetErrorString(e), grid);
}
```

```cpp
#include <hip/hip_runtime.h>
#include <hip/hip_cooperative_groups.h>
#include <cstdio>
namespace cg = cooperative_groups;

#define LAS __attribute__((address_space(3)))
typedef unsigned short bf16_t;
typedef short bf16x8 __attribute__((ext_vector_type(8)));
typedef short bf16x4 __attribute__((ext_vector_type(4)));
typedef float f32x4 __attribute__((ext_vector_type(4)));
typedef unsigned u32x4 __attribute__((ext_vector_type(4)));

constexpr int D = 1024, NB = 4, SEQ = 4096, CL = 256, TL = NB * SEQ, TC = NB * CL, T = TL + TC, DFF = 2816, INW = 2816, HYW = 3072;
constexpr int NMOD = 9;
constexpr float EPS = 1e-6f;
constexpr int NCH = 34;
constexpr int LDS_BYTES = 144 * 1024;

constexpr size_t SZ_WGU = (size_t)2 * DFF * D * 2, SZ_WD = (size_t)D * DFF * 2, SZ_WIN = (size_t)INW * D * 2, SZ_WOUT = (size_t)D * D * 2, SZ_HWIN = (size_t)HYW * D * 2;
constexpr size_t WS_WGU = 0;
constexpr size_t WS_WD = WS_WGU + 8 * SZ_WGU;
constexpr size_t WS_WIN = WS_WD + 8 * SZ_WD;
constexpr size_t WS_WOUT = WS_WIN + 2 * SZ_WIN;
constexpr size_t WS_HWIN = WS_WOUT + 2 * SZ_WOUT;
constexpr size_t WS_HWOUT = WS_HWIN + 2 * SZ_HWIN;
constexpr size_t WS_MOD = WS_HWOUT + 2 * SZ_WOUT;
constexpr size_t WS_ROPE = WS_MOD + (size_t)4 * 5 * NMOD * D * 4;
constexpr size_t WS_XC = WS_ROPE + (size_t)4 * SEQ * 32 * 4;
constexpr size_t WS_H = WS_XC + (size_t)TC * D * 4;
constexpr size_t WS_BIG = WS_H + (size_t)T * D * 2;
constexpr size_t WS_Y = WS_BIG + (size_t)T * HYW * 2;
constexpr size_t WS_MIX = WS_Y + (size_t)T * D * 4;
constexpr size_t SZ_ST = (size_t)NB * NCH * 8 * 4096 * 4;
constexpr size_t WS_ST = WS_MIX + (size_t)T * D * 2;
constexpr size_t SZ_KF = (size_t)(SEQ + CL) * 2 * D * 4;
constexpr size_t WS_KF = WS_ST + 4 * SZ_ST;
constexpr size_t WS_YP = WS_KF + 2 * SZ_KF;
constexpr size_t WS_BAR = WS_YP + (size_t)4 * TC * D * 4;
constexpr size_t WS_CNT = WS_BAR + 16384;
constexpr size_t SZ_CNT = (size_t)12 * 2 * 64 * 256 + 12 * 256;
constexpr size_t WS_SLOT = WS_CNT + SZ_CNT;
constexpr size_t WS_END = WS_SLOT + (size_t)2 * TL * 4 * 4;

struct KP { const float* in[29]; float* out; unsigned char* ws; };
extern __shared__ __attribute__((aligned(16))) unsigned char g_smem[];
constexpr int PTAB_OFF = LDS_BYTES - 512;
__device__ __forceinline__ const float* pin_ld(int k) {
    const unsigned long long v = *(volatile LAS unsigned long long*)((LAS unsigned char*)g_smem + PTAB_OFF + 8 * k);
    const unsigned lo = __builtin_amdgcn_readfirstlane((unsigned)v), hi = __builtin_amdgcn_readfirstlane((unsigned)(v >> 32));
    return (const float*)(((unsigned long long)hi << 32) | lo);
}
struct KQ { float* out; unsigned char* ws; };
__device__ __forceinline__ KQ lq(KQ q) { asm volatile("" : "+s"(q.out), "+s"(q.ws)); return q; }

__device__ __forceinline__ bf16_t f2bf(float f) { unsigned u = __float_as_uint(f); u += 0x7FFFu + ((u >> 16) & 1u); return (bf16_t)(u >> 16); }
__device__ __forceinline__ float bf2f(bf16_t b) { return __uint_as_float(((unsigned)b) << 16); }
__device__ __forceinline__ float silu_f(float x) { return x * __builtin_amdgcn_rcpf(1.0f + __expf(-x)); }
__device__ __forceinline__ int ltid() { int t = threadIdx.x; asm volatile("" : "+v"(t)); return t; }
__device__ __forceinline__ float wave_sum(float v) {
#pragma unroll
    for (int o = 32; o > 0; o >>= 1) v += __shfl_xor(v, o, 64);
    return v;
}


#define XB_TMO      128
#define XB_XCNT(j)  (256  + 64 * (j))
#define XB_XSUB(j)  (1280 + 64 * (j))
#define XB_XGEN(j)  (2304 + 64 * (j))
#define XB_TOP      3328
#define XB_TOPGEN   3392
#define XCD_BAR_WORDS 3456
#define XB_SPIN_CAP (1u << 18)
__device__ __forceinline__ unsigned xb_ld(unsigned* p)              { return __hip_atomic_load(p, __ATOMIC_RELAXED, __HIP_MEMORY_SCOPE_AGENT); }
__device__ __forceinline__ unsigned xb_add(unsigned* p, unsigned v) { return __hip_atomic_fetch_add(p, v, __ATOMIC_RELAXED, __HIP_MEMORY_SCOPE_AGENT); }
__device__ __forceinline__ unsigned xb_xcc_id() { return (unsigned)__builtin_amdgcn_s_getreg((3 << 11) | 20) & 0xFu; }
#define XB_SPIN(cond, bar) do { unsigned _sp = 0; while (cond) { __builtin_amdgcn_s_sleep(1); \
    if ((++_sp & 255u) == 0u) { if (xb_ld(&(bar)[XB_TMO])) break; if (_sp > XB_SPIN_CAP) { atomicAdd(&(bar)[XB_TMO], 1u); break; } } } } while (0)
struct XcdBarrier { unsigned* bar; unsigned x; volatile LAS unsigned* st; };
__device__ __forceinline__ XcdBarrier xcd_barrier_post(unsigned* bar, volatile LAS unsigned* st) {
    XcdBarrier b; b.bar = bar; b.x = xb_xcc_id(); b.st = st;
    if (threadIdx.x == 0) (void)xb_add(&bar[XB_XCNT(b.x)], 1u);
    return b;
}
__device__ __forceinline__ void xcd_barrier_complete(unsigned* bar, unsigned x, unsigned& nloc, unsigned& nx) {
    const unsigned G = gridDim.x * gridDim.y * gridDim.z;
    unsigned sum, cnt, mine, sp = 0u;
    for (;;) {
        sum = 0u; cnt = 0u; mine = 0u;
#pragma unroll
        for (unsigned j = 0; j < 16; ++j) { const unsigned c = xb_ld(&bar[XB_XCNT(j)]); sum += c; cnt += (c > 0u) ? 1u : 0u; mine = (j == x) ? c : mine; }
        if (sum == G) break;
        __builtin_amdgcn_s_sleep(1);
        if ((++sp & 255u) == 0u) { if (xb_ld(&bar[XB_TMO])) break; if (sp > XB_SPIN_CAP) { atomicAdd(&bar[XB_TMO], 1u); break; } }
    }
    nloc = mine > 0u ? mine : 1u; nx = cnt > 0u ? cnt : 1u;
}
__device__ __forceinline__ void xcd_barrier_impl(unsigned* bar, volatile LAS unsigned* st) {
    asm volatile("s_waitcnt vmcnt(0)" ::: "memory");
    __syncthreads();
    if (ltid() == 0) {
        const unsigned x = xb_xcc_id();
        __builtin_amdgcn_s_waitcnt(0);
        unsigned nloc = st[0], nx = st[1];
        if (nloc == 0u) { xcd_barrier_complete(bar, x, nloc, nx); st[0] = nloc; st[1] = nx; }
        const unsigned old = xb_add(&bar[XB_XSUB(x)], 1u);
        const unsigned gen = old / nloc;
        if (old + 1u == (gen + 1u) * nloc) {
            __builtin_amdgcn_fence(__ATOMIC_RELEASE, "agent");
            asm volatile("s_waitcnt vmcnt(0)" ::: "memory");
            const unsigned og = xb_add(&bar[XB_TOP], 1u);
            const unsigned tg = og / nx;
            if (og + 1u == (tg + 1u) * nx) xb_add(&bar[XB_TOPGEN], 1u);
            else XB_SPIN(xb_ld(&bar[XB_TOPGEN]) == tg, bar);
            __builtin_amdgcn_fence(__ATOMIC_ACQUIRE, "agent");
            xb_add(&bar[XB_XGEN(x)], 1u);
            asm volatile("s_waitcnt vmcnt(0)" ::: "memory");
        } else {
            XB_SPIN(xb_ld(&bar[XB_XGEN(x)]) == gen, bar);
            __builtin_amdgcn_fence(__ATOMIC_ACQUIRE, "agent");
            asm volatile("s_waitcnt vmcnt(0)" ::: "memory");
        }
    }
    __syncthreads();
}
__device__ __forceinline__ void sub_barrier(unsigned* word, unsigned n) {
    asm volatile("s_waitcnt vmcnt(0)" ::: "memory");
    __syncthreads();
    if (ltid() == 0) {
        __builtin_amdgcn_fence(__ATOMIC_RELEASE, "agent");
        asm volatile("s_waitcnt vmcnt(0)" ::: "memory");
        (void)xb_add(word, 1u);
        for (unsigned sp = 0; sp < (1u << 21); ++sp) { if (xb_ld(word) >= n) break; __builtin_amdgcn_s_sleep(2); }
        __builtin_amdgcn_fence(__ATOMIC_ACQUIRE, "agent");
        asm volatile("s_waitcnt vmcnt(0)" ::: "memory");
    }
    __syncthreads();
}
#define GRID_BAR() xcd_barrier_impl((unsigned*)(p.ws + WS_BAR), (volatile LAS unsigned*)((LAS unsigned char*)smem + LDS_BYTES - 16))

namespace pg8 {
constexpr int BM = 256, BK = 64, HALF = 128, HTB = HALF * BK * 2, STAGE_BYTES = 8 * HTB, NXCD = 8, WGM = 8;
__host__ __device__ __forceinline__ int lds_byte(int r, int c) { const int st = (r >> 4) * 2 + (c >> 5), rr = r & 15, cc = c & 31, ob = rr * 64 + cc * 2; return st * 1024 + (ob ^ (((ob >> 9) & 1) << 5)); }
__host__ __device__ __forceinline__ void stage_rc(int b, int& R, int& C) { const int st = b / 1024, sb = b % 1024, swz = sb ^ (((sb >> 9) & 1) << 5); R = (st >> 1) * 16 + swz / 64; C = (st & 1) * 32 + (swz % 64) / 2; }
__host__ __device__ __forceinline__ int perm32(int rho) { const int n = rho >> 4, i = rho & 15; return 8 * (i >> 2) + 4 * n + (i & 3); }
struct Unit { int pm, pn; };
struct Gemm { const bf16_t* A; const bf16_t* Bt; int M, N, K, ld; };
struct StaticOrder {
    int nM, nN, nwg, G, c;
    __device__ void init(int M, int N, int G_, int c_) { nM = M / BM; nN = N / BM; nwg = nM * nN; G = G_; c = c_; }
    __device__ bool next(int i, Unit& u) const {
        const long Lx = (long)i * G + c; if (Lx >= nwg) return false;
        int wgid = (int)Lx; { const int q = nwg / NXCD, r = nwg % NXCD, xcd = wgid % NXCD, off = wgid / NXCD; wgid = (xcd < r ? xcd * (q + 1) : r * (q + 1) + (xcd - r) * q) + off; }
        const int nig = WGM * nN, gid = wgid / nig, fm = gid * WGM, gsz = (nM - fm) < WGM ? (nM - fm) : WGM;
        u.pm = fm + ((wgid % nig) % gsz); u.pn = (wgid % nig) / gsz; return true;
    }
};
__device__ __forceinline__ unsigned cvt_pk_bf16(float lo, float hi) { unsigned r; asm volatile("v_cvt_pk_bf16_f32 %0, %1, %2" : "=v"(r) : "v"(lo), "v"(hi)); return r; }

struct EpiF32 {
    static constexpr bool PERM = false, AFTER_DRAIN = false;
    float* C; int ldc;
    __device__ __forceinline__ void operator()(const f32x4 (&acc)[2][2][4][2], const Unit& u, int wr, int wc, int fr, int fq) const {
        const int row0 = u.pm * BM + wr * 64 + fr, col0 = u.pn * BM + wc * 32 + 4 * fq;
#pragma unroll
        for (int ai = 0; ai < 2; ++ai)
#pragma unroll
            for (int m = 0; m < 4; ++m) { float* rowp = C + (size_t)(row0 + ai * HALF + m * 16) * ldc + col0;
#pragma unroll
                for (int bj = 0; bj < 2; ++bj)
#pragma unroll
                    for (int n = 0; n < 2; ++n) *(f32x4*)(rowp + bj * HALF + n * 16) = acc[ai][bj][m][n]; }
    }
};
struct EpiBf16 {
    static constexpr bool PERM = true, AFTER_DRAIN = false;
    bf16_t* O; int ldc; const float* bias;
    __device__ __forceinline__ void operator()(const f32x4 (&acc)[2][2][4][2], const Unit& u, int wr, int wc, int fr, int fq) const {
        const int row0 = u.pm * BM + wr * 64 + fr; const int col0 = u.pn * BM + wc * 32 + 8 * fq;
        f32x4 bv[2][2];
#pragma unroll
        for (int bj = 0; bj < 2; ++bj)
#pragma unroll
            for (int n = 0; n < 2; ++n) bv[bj][n] = bias ? *(const f32x4*)(bias + col0 + bj * HALF + 4 * n) : (f32x4){0.f, 0.f, 0.f, 0.f};
#pragma unroll
        for (int ai = 0; ai < 2; ++ai)
#pragma unroll
            for (int m = 0; m < 4; ++m) { bf16_t* rowp = O + (size_t)(row0 + ai * HALF + m * 16) * ldc + col0;
#pragma unroll
                for (int bj = 0; bj < 2; ++bj) { f32x4 v0 = acc[ai][bj][m][0] + bv[bj][0], v1 = acc[ai][bj][m][1] + bv[bj][1];
                    u32x4 w; w.x = cvt_pk_bf16(v0[0], v0[1]); w.y = cvt_pk_bf16(v0[2], v0[3]); w.z = cvt_pk_bf16(v1[0], v1[1]); w.w = cvt_pk_bf16(v1[2], v1[3]);
                    *(u32x4*)(rowp + bj * HALF) = w; } }
    }
};
struct EpiSwiGLU {
    static constexpr bool PERM = true, AFTER_DRAIN = false;
    bf16_t* O; int ldc;
    __device__ __forceinline__ void operator()(const f32x4 (&acc)[2][2][4][2], const Unit& u, int wr, int wc, int fr, int fq) const {
        const int row0 = u.pm * BM + wr * 64 + fr; const int col0 = u.pn * HALF + wc * 32 + 8 * fq;
#pragma unroll
        for (int ai = 0; ai < 2; ++ai)
#pragma unroll
            for (int m = 0; m < 4; ++m) { bf16_t* rowp = O + (size_t)(row0 + ai * HALF + m * 16) * ldc + col0;
                float v[8];
#pragma unroll
                for (int n = 0; n < 2; ++n)
#pragma unroll
                    for (int j = 0; j < 4; ++j) { const float g = acc[ai][0][m][n][j], up = acc[ai][1][m][n][j]; v[n * 4 + j] = silu_f(g) * up; }
                u32x4 w; w.x = cvt_pk_bf16(v[0], v[1]); w.y = cvt_pk_bf16(v[2], v[3]); w.z = cvt_pk_bf16(v[4], v[5]); w.w = cvt_pk_bf16(v[6], v[7]);
                *(u32x4*)rowp = w; }
    }
};


__device__ __forceinline__ void row_exchange(const f32x4 (&v)[2][2][4][2], const Unit& u, int wr, int wc, int fr, int fq, LAS unsigned char* lds, int wid, int lane, float* slots, unsigned* cnt) {
    LAS float* P = (LAS float*)lds;
    LAS float* S = (LAS float*)(lds + 4096);
#pragma unroll
    for (int ai = 0; ai < 2; ++ai)
#pragma unroll
        for (int m = 0; m < 4; ++m) {
            float sq = 0.f;
#pragma unroll
            for (int bj = 0; bj < 2; ++bj)
#pragma unroll
                for (int n = 0; n < 2; ++n) { const f32x4 x = v[ai][bj][m][n]; sq += (x[0] * x[0] + x[1] * x[1]) + (x[2] * x[2] + x[3] * x[3]); }
            sq += __shfl_xor(sq, 16); sq += __shfl_xor(sq, 32);
            if (fq == 0) P[(ai * HALF + wr * 64 + m * 16 + fr) * 4 + wc] = sq;
        }
    asm volatile("s_waitcnt lgkmcnt(0)" ::: "memory"); __builtin_amdgcn_s_barrier(); asm volatile("" ::: "memory");
    const int row = wid * 32 + (lane & 31);
    if (lane < 32) {
        const float tot = (P[row * 4 + 0] + P[row * 4 + 1]) + (P[row * 4 + 2] + P[row * 4 + 3]);
        __hip_atomic_store((unsigned*)slots + ((size_t)(u.pm * BM + row) * 4 + u.pn), __float_as_uint(tot), __ATOMIC_RELAXED, __HIP_MEMORY_SCOPE_AGENT);
    }
    asm volatile("s_waitcnt vmcnt(0)" ::: "memory");
    if (lane == 0) __hip_atomic_fetch_add(cnt + 64 * u.pm, 1u, __ATOMIC_RELAXED, __HIP_MEMORY_SCOPE_AGENT);
    if (wid == 0) {
        for (unsigned sp = 0; sp < (1u << 21); ++sp) {
            if ((unsigned)__builtin_amdgcn_readfirstlane(__hip_atomic_load(cnt + 64 * u.pm, __ATOMIC_RELAXED, __HIP_MEMORY_SCOPE_AGENT)) >= 32u) break;
            __builtin_amdgcn_s_sleep(2);
        }
        __builtin_amdgcn_fence(__ATOMIC_ACQUIRE, "agent");
    }
    asm volatile("s_waitcnt vmcnt(0) lgkmcnt(0)" ::: "memory"); __builtin_amdgcn_s_barrier(); asm volatile("" ::: "memory");
    if (lane < 32) {
        const unsigned* sl = (const unsigned*)slots + (size_t)(u.pm * BM + row) * 4;
        float tot = 0.f;
#pragma unroll
        for (int t = 0; t < 4; ++t) tot += __uint_as_float(__hip_atomic_load(sl + t, __ATOMIC_RELAXED, __HIP_MEMORY_SCOPE_AGENT));
        S[row] = tot;
    }
    asm volatile("s_waitcnt vmcnt(0) lgkmcnt(0)" ::: "memory"); __builtin_amdgcn_s_barrier(); asm volatile("" ::: "memory");
}
struct EpiFusedRow {
    static constexpr bool PERM = false, AFTER_DRAIN = true;
    const float* xin; float* xout; bf16_t* H;
    const float* gate; const float* gpost; float wgt;
    const float* gpre; const float* shift; const float* scale;
    float* slots; unsigned* cnt;
    __device__ __forceinline__ void operator()(const f32x4 (&)[2][2][4][2], const Unit&, int, int, int, int) const {}
    __device__ __forceinline__ void fused(f32x4 (&acc)[2][2][4][2], const Unit& u, int wr, int wc, int fr, int fq, LAS unsigned char* lds, int wid, int lane) const {
        const LAS float* S = (const LAS float*)(lds + 4096);
        const int col0 = u.pn * BM + wc * 32 + 4 * fq; const size_t mb = (size_t)(u.pm >> 4) * (NMOD * D);
        row_exchange(acc, u, wr, wc, fr, fq, lds, wid, lane, slots, cnt);
        {
            f32x4 cw[2][2];
#pragma unroll
            for (int bj = 0; bj < 2; ++bj)
#pragma unroll
                for (int n = 0; n < 2; ++n) cw[bj][n] = *(const f32x4*)(gate + mb + col0 + bj * HALF + n * 16) * *(const f32x4*)(gpost + col0 + bj * HALF + n * 16);
#pragma unroll
            for (int ai = 0; ai < 2; ++ai)
#pragma unroll
                for (int m = 0; m < 4; ++m) { const int r = ai * HALF + wr * 64 + m * 16 + fr; const float r1 = rsqrtf(S[r] * (1.0f / D) + EPS) * wgt; const size_t off = (size_t)(u.pm * BM + r) * D + col0;
#pragma unroll
                    for (int bj = 0; bj < 2; ++bj)
#pragma unroll
                        for (int n = 0; n < 2; ++n) { const f32x4 xv = *(const f32x4*)(xin + off + bj * HALF + n * 16); const f32x4 xn = xv + (cw[bj][n] * r1) * acc[ai][bj][m][n];
                            acc[ai][bj][m][n] = xn; *(f32x4*)(xout + off + bj * HALF + n * 16) = xn; }
                    asm volatile("" : "+v"(acc[ai][0][m][0]), "+v"(acc[ai][0][m][1]), "+v"(acc[ai][1][m][0]), "+v"(acc[ai][1][m][1]));
                    asm volatile("" ::: "memory"); }
        }
        if (H == nullptr) return;
        row_exchange(acc, u, wr, wc, fr, fq, lds, wid, lane, slots + (size_t)TL * 4, cnt + 64 * 64);
        {
            f32x4 gm[2][2], sh[2][2];
#pragma unroll
            for (int bj = 0; bj < 2; ++bj)
#pragma unroll
                for (int n = 0; n < 2; ++n) { const int c = col0 + bj * HALF + n * 16; gm[bj][n] = *(const f32x4*)(gpre + c) * (*(const f32x4*)(scale + mb + c) + 1.0f); sh[bj][n] = *(const f32x4*)(shift + mb + c); }
#pragma unroll
            for (int ai = 0; ai < 2; ++ai)
#pragma unroll
                for (int m = 0; m < 4; ++m) { const int r = ai * HALF + wr * 64 + m * 16 + fr; const float r2 = rsqrtf(S[r] * (1.0f / D) + EPS); const size_t off = (size_t)(u.pm * BM + r) * D + col0;
#pragma unroll
                    for (int bj = 0; bj < 2; ++bj)
#pragma unroll
                        for (int n = 0; n < 2; ++n) { const f32x4 hv = (acc[ai][bj][m][n] * r2) * gm[bj][n] + sh[bj][n];
                            uint2 w2; w2.x = cvt_pk_bf16(hv[0], hv[1]); w2.y = cvt_pk_bf16(hv[2], hv[3]); *(uint2*)(H + off + bj * HALF + n * 16) = w2; }
                    asm volatile("" ::: "memory"); }
        }
    }
};

template <class Epi, class Sched>
__device__ __forceinline__ void gemm_phase(LAS unsigned char* lds, const Gemm g, const Sched& S, const Epi& E) {
    const int tid = ltid(), wid = __builtin_amdgcn_readfirstlane(tid >> 6), lane = tid & 63, wr = wid >> 2, wc = wid & 3, fr = lane & 15, fq = lane >> 4;
    const int K = g.ld, nt = g.K / BK;
    unsigned voffA[2], voffB[2];
#pragma unroll
    for (int i = 0; i < 2; ++i) { int R, C; stage_rc(tid * 16 + i * 8192, R, C); const int Rb = Epi::PERM ? ((R & ~31) + perm32(R & 31)) : R;
        voffA[i] = (unsigned)(R * K + C) * 2u; voffB[i] = (unsigned)(Rb * K + C) * 2u; }
    const size_t kstep = (size_t)(BK * 2);
    const size_t hstep = (size_t)HALF * K * 2;
    const size_t tstep = 2 * hstep;
    const unsigned ldsw = (unsigned)wid * 1024u;
    const int aoff = lds_byte(wr * 64 + fr, fq * 8), boff = lds_byte(wc * 32 + fr, fq * 8);
#define PG8_SA(b, h) (((b) * 2 + (h)) * HTB)
#define PG8_SB(b, h) ((4 + (b) * 2 + (h)) * HTB)
#define PG8_STAGE(bufoff, gbase, voff) do { _Pragma("unroll") for (int _i = 0; _i < 2; ++_i) \
        __builtin_amdgcn_global_load_lds((const unsigned*)((const char*)(gbase) + (voff)[_i]), (LAS unsigned*)(lds + (bufoff) + ldsw + _i * 8192), 16, 0, 0); } while (0)
#define PG8_LDA(dst, b, h) do { _Pragma("unroll") for (int m = 0; m < 4; ++m) _Pragma("unroll") for (int k = 0; k < 2; ++k) dst[m][k] = *(const LAS bf16x8*)(lds + PG8_SA(b, h) + aoff + m * 2048 + k * 1024); } while (0)
#define PG8_LDB(dst, b, h) do { _Pragma("unroll") for (int n = 0; n < 2; ++n) _Pragma("unroll") for (int k = 0; k < 2; ++k) dst[n][k] = *(const LAS bf16x8*)(lds + PG8_SB(b, h) + boff + n * 2048 + k * 1024); } while (0)
#define PG8_MMA(ai, bj, At, Bt) do { __builtin_amdgcn_s_setprio(1); _Pragma("unroll") for (int m = 0; m < 4; ++m) _Pragma("unroll") for (int n = 0; n < 2; ++n) _Pragma("unroll") for (int k = 0; k < 2; ++k) \
        acc[ai][bj][m][n] = __builtin_amdgcn_mfma_f32_16x16x32_bf16(Bt[n][k], At[m][k], acc[ai][bj][m][n], 0, 0, 0); __builtin_amdgcn_s_setprio(0); } while (0)
#define PG8_WAIT_V(n) asm volatile("s_waitcnt vmcnt(" #n ")" ::: "memory")
#define PG8_WAIT_L(n) asm volatile("s_waitcnt lgkmcnt(" #n ")" ::: "memory")
#define PG8_BAR __builtin_amdgcn_s_barrier()
#define PG8_SCHED __builtin_amdgcn_sched_barrier(0)
    Unit cur, nxt; int ui = 0;
    if (!S.next(0, cur)) return;
    f32x4 acc[2][2][4][2];
#pragma unroll
    for (int a = 0; a < 2; ++a)
#pragma unroll
        for (int b = 0; b < 2; ++b)
#pragma unroll
            for (int m = 0; m < 4; ++m)
#pragma unroll
                for (int n = 0; n < 2; ++n) acc[a][b][m][n] = (f32x4){0.f, 0.f, 0.f, 0.f};
    bf16x8 At[4][2], B0[2][2], B1[2][2];
    const char* cA = (const char*)g.A + (size_t)cur.pm * tstep; const char* cB = (const char*)g.Bt + (size_t)cur.pn * tstep;
    PG8_STAGE(PG8_SB(0, 0), cB, voffB); PG8_STAGE(PG8_SA(0, 0), cA, voffA); PG8_STAGE(PG8_SB(0, 1), cB + hstep, voffB); PG8_STAGE(PG8_SA(0, 1), cA + hstep, voffA);
    if (wr == 1) PG8_BAR;
    PG8_WAIT_V(4); PG8_BAR;
    PG8_STAGE(PG8_SB(1, 0), cB + kstep, voffB); PG8_STAGE(PG8_SA(1, 0), cA + kstep, voffA); PG8_STAGE(PG8_SB(1, 1), cB + hstep + kstep, voffB);
    PG8_WAIT_V(6); PG8_BAR;
    for (;;) {
        const bool has_next = S.next(ui + 1, nxt);
        const char* nA = has_next ? (const char*)g.A + (size_t)nxt.pm * tstep : cA; const char* nB = has_next ? (const char*)g.Bt + (size_t)nxt.pn * tstep : cB;
        for (int t = 0; t < nt; t += 2) {
            const bool last = (t == nt - 2);
            const char* a1 = cA + (size_t)(t + 1) * kstep;
            const char* a2 = last ? nA : cA + (size_t)(t + 2) * kstep; const char* b2 = last ? nB : cB + (size_t)(t + 2) * kstep;
            const char* a3 = a2 + kstep; const char* b3 = b2 + kstep;
            PG8_LDB(B0, 0, 0); PG8_SCHED; PG8_LDA(At, 0, 0); PG8_STAGE(PG8_SA(1, 1), a1 + hstep, voffA);
            PG8_WAIT_L(8); PG8_BAR; PG8_WAIT_L(0); PG8_MMA(0, 0, At, B0); PG8_BAR; PG8_SCHED;
            PG8_LDB(B1, 0, 1); PG8_STAGE(PG8_SB(0, 0), b2, voffB);
            PG8_BAR; PG8_WAIT_L(0); PG8_MMA(0, 1, At, B1); PG8_BAR;
            PG8_LDA(At, 0, 1); PG8_STAGE(PG8_SA(0, 0), a2, voffA);
            PG8_BAR; PG8_WAIT_L(0); PG8_MMA(1, 0, At, B0); PG8_BAR; PG8_SCHED;
            PG8_STAGE(PG8_SB(0, 1), b2 + hstep, voffB);
            PG8_WAIT_V(6); PG8_BAR; PG8_MMA(1, 1, At, B1); PG8_BAR;
            PG8_LDB(B0, 1, 0); PG8_SCHED; PG8_LDA(At, 1, 0); PG8_STAGE(PG8_SA(0, 1), a2 + hstep, voffA);
            PG8_WAIT_L(8); PG8_BAR; PG8_WAIT_L(0); PG8_MMA(0, 0, At, B0); PG8_BAR; PG8_SCHED;
            PG8_LDB(B1, 1, 1); PG8_STAGE(PG8_SB(1, 0), b3, voffB);
            PG8_BAR; PG8_WAIT_L(0); PG8_MMA(0, 1, At, B1); PG8_BAR;
            PG8_LDA(At, 1, 1); PG8_STAGE(PG8_SA(1, 0), a3, voffA);
            PG8_BAR; PG8_WAIT_L(0); PG8_MMA(1, 0, At, B0); PG8_BAR; PG8_SCHED;
            PG8_STAGE(PG8_SB(1, 1), b3 + hstep, voffB);
            PG8_WAIT_V(6); PG8_BAR; PG8_MMA(1, 1, At, B1); PG8_BAR;
        }
        if constexpr (!Epi::AFTER_DRAIN) E(acc, cur, wr, wc, fr, fq);
        if (!has_next) break;
#pragma unroll
        for (int a = 0; a < 2; ++a)
#pragma unroll
            for (int b = 0; b < 2; ++b)
#pragma unroll
                for (int m = 0; m < 4; ++m)
#pragma unroll
                    for (int n = 0; n < 2; ++n) acc[a][b][m][n] = (f32x4){0.f, 0.f, 0.f, 0.f};
        cur = nxt; cA = nA; cB = nB; ++ui;
    }
    PG8_WAIT_V(0);
    if (wr == 0) PG8_BAR;
    PG8_BAR;
    if constexpr (Epi::AFTER_DRAIN) E.fused(acc, cur, wr, wc, fr, fq, lds, wid, lane);
#undef PG8_SA
#undef PG8_SB
#undef PG8_STAGE
#undef PG8_LDA
#undef PG8_LDB
#undef PG8_MMA
#undef PG8_WAIT_V
#undef PG8_WAIT_L
#undef PG8_BAR
#undef PG8_SCHED
}
}

template <class Epi>
__device__ __forceinline__ void run_gemm(unsigned char* smem, const bf16_t* A, const bf16_t* Bt, int M, int N, int K, const Epi& E) {
    pg8::Gemm g{A, Bt, M, N, K, K}; pg8::StaticOrder S; S.init(M, N, (int)gridDim.x, (int)blockIdx.x);
    pg8::gemm_phase<Epi, pg8::StaticOrder>((LAS unsigned char*)smem, g, S, E);
}
__device__ __forceinline__ void run_gemm_f32_split(unsigned char* smem, const bf16_t* A, const bf16_t* Bt, int M, int K, const pg8::EpiFusedRow& EF, float* YP) {
    { pg8::Gemm g{A, Bt, TL, D, K, K}; pg8::StaticOrder S; S.init(TL, D, (int)gridDim.x, (int)blockIdx.x);
      pg8::gemm_phase<pg8::EpiFusedRow, pg8::StaticOrder>((LAS unsigned char*)smem, g, S, EF); }
    __syncthreads();
    if (M > TL && blockIdx.x < 64) {
        const int ks = blockIdx.x >> 4;
        int koff, klen;
        if (K == DFF) { koff = (ks < 2) ? ks * 768 : 1536 + (ks - 2) * 640; klen = (ks < 2) ? 768 : 640; }
        else { klen = K / 4; koff = ks * klen; }
        pg8::Gemm g{A + (size_t)TL * K + koff, Bt + koff, TC, D, klen, K}; pg8::StaticOrder S; S.init(TC, D, 16, (int)(blockIdx.x & 15)); pg8::EpiF32 E{YP + (size_t)ks * TC * D, D};
        pg8::gemm_phase<pg8::EpiF32, pg8::StaticOrder>((LAS unsigned char*)smem, g, S, E);
        __syncthreads();
    }
}

__device__ __forceinline__ float* xrow(const KQ p, int t) { return t < TL ? p.out + (size_t)t * D : (float*)(p.ws + WS_XC) + (size_t)(t - TL) * D; }
__device__ __forceinline__ int modrow(int t) { return t < TL ? (t >> 12) : 4; }
__device__ __forceinline__ const float* modp(const KQ p, int l, int mr, int idx) { return (const float*)(p.ws + WS_MOD) + ((size_t)(l * 5 + mr) * NMOD + idx) * D; }

__device__ __forceinline__ void p0_setup(const KQ p_in, float* sm) {
    const KQ p = lq(p_in);
    const int tid = ltid(), bid = blockIdx.x, nb = gridDim.x;
    const int gtid = bid * 512 + tid, gthreads = nb * 512;
    {
        float* rope = (float*)(p.ws + WS_ROPE);
        for (int idx = gtid; idx < SEQ * 32; idx += gthreads) {
            const int t = idx >> 5, i = idx & 31;
            const int ii = i & 15; const float pos = (i < 16) ? (float)(t >> 6) : (float)(t & 63);
            const float invA = powf(10000.0f, -(float)ii / 16.0f);
            const float angA = pos * invA;
            rope[idx] = cosf(angA); rope[SEQ * 32 + idx] = sinf(angA);
            const float ex = (float)i * (1.0f / 31.0f);
            const float invR = powf(10000.0f, -ex);
            const float angR = (float)t * invR;
            rope[2 * SEQ * 32 + idx] = cosf(angR); rope[3 * SEQ * 32 + idx] = sinf(angR);
        }
    }
    {
        float* tile = sm;
        for (int gs = bid; gs < 20864 / 4; gs += nb) {
            const int g = gs * 4;
            int j, tl;
            if (g < 16896) { j = g / 704; tl = g % 704; }
            else if (g < 18304) { j = 24 + (g - 16896) / 704; tl = (g - 16896) % 704; }
            else if (g < 18816) { j = 26 + (g - 18304) / 256; tl = (g - 18304) % 256; }
            else if (g < 20352) { j = 28 + (g - 18816) / 768; tl = (g - 18816) % 768; }
            else { j = 30 + (g - 20352) / 256; tl = (g - 20352) % 256; }
            const float* src; bf16_t* dst; int K, N, mode = 0;
            if (j < 8) { src = pin_ld(8) + (size_t)j * D * DFF; dst = (bf16_t*)(p.ws + WS_WGU + (size_t)j * SZ_WGU); K = D; N = DFF; mode = 1; }
            else if (j < 16) { src = pin_ld(9) + (size_t)(j - 8) * D * DFF; dst = (bf16_t*)(p.ws + WS_WGU + (size_t)(j - 8) * SZ_WGU); K = D; N = DFF; mode = 2; }
            else if (j < 24) { src = pin_ld(10) + (size_t)(j - 16) * DFF * D; dst = (bf16_t*)(p.ws + WS_WD + (size_t)(j - 16) * SZ_WD); K = DFF; N = D; }
            else if (j < 26) { src = pin_ld(11) + (size_t)(j - 24) * D * INW; dst = (bf16_t*)(p.ws + WS_WIN + (size_t)(j - 24) * SZ_WIN); K = D; N = INW; mode = 3; }
            else if (j < 28) { src = pin_ld(14) + (size_t)(j - 26) * D * D; dst = (bf16_t*)(p.ws + WS_WOUT + (size_t)(j - 26) * SZ_WOUT); K = D; N = D; }
            else if (j < 30) { src = pin_ld(15) + (size_t)(j - 28) * D * HYW; dst = (bf16_t*)(p.ws + WS_HWIN + (size_t)(j - 28) * SZ_HWIN); K = D; N = HYW; }
            else { src = pin_ld(28) + (size_t)(j - 30) * D * D; dst = (bf16_t*)(p.ws + WS_HWOUT + (size_t)(j - 30) * SZ_WOUT); K = D; N = D; }
            const int ntn = N / 64; const int k0 = (tl / ntn) * 64, n0 = (tl % ntn) * 64;
            f32x4 ld[8];
#pragma unroll
            for (int i = 0; i < 8; ++i) ld[i] = *(const f32x4*)(src + (size_t)(k0 + i * 8 + (tid >> 6)) * N + n0 + (tid & 63) * 4);
            __syncthreads();
#pragma unroll
            for (int i = 0; i < 8; ++i) *(f32x4*)(tile + (i * 8 + (tid >> 6)) * 260 + (tid & 63) * 4) = ld[i];
            __syncthreads();
            {
                const int n = tid >> 1, kh = (tid & 1) * 32; const int gn = n0 + n;
                float sc_ = 1.0f; int row = gn;
                if (mode == 1) row = 256 * (gn >> 7) + (gn & 127);
                else if (mode == 2) row = 256 * (gn >> 7) + 128 + (gn & 127);
                else if (mode == 3) { if (gn < 512 || (gn >= 1792 && gn < 2304)) sc_ = 0.125f; }
#pragma unroll
                for (int q = 0; q < 4; ++q) {
                    float v[8];
#pragma unroll
                    for (int jj = 0; jj < 8; ++jj) v[jj] = tile[(kh + q * 8 + jj) * 260 + n] * sc_;
                    u32x4 o4; o4.x = pg8::cvt_pk_bf16(v[0], v[1]); o4.y = pg8::cvt_pk_bf16(v[2], v[3]); o4.z = pg8::cvt_pk_bf16(v[4], v[5]); o4.w = pg8::cvt_pk_bf16(v[6], v[7]);
                    *(u32x4*)(dst + (size_t)row * K + k0 + kh + q * 8) = o4;
                }
            }
        }
        __syncthreads();
    }
    {
        float* sc = sm;
        float* red = sm + 5 * 1024;
        for (int i = tid; i < 5 * 1024; i += 512) { const int r = i >> 10, k = i & 1023; const float v = (r < 4) ? pin_ld(1)[r * D + k] : pin_ld(3)[k]; sc[i] = silu_f(v); }
        __syncthreads();
        const int w = tid >> 6, lane = tid & 63;
        for (int it = bid; it < 288; it += nb) {
            const int l = it / 72, c0 = (it % 72) * 128;
            const float* wm = pin_ld(4) + (size_t)l * D * (NMOD * D) + c0 + 2 * lane;
            float a[5][2];
#pragma unroll
            for (int r = 0; r < 5; ++r) { a[r][0] = 0.f; a[r][1] = 0.f; }
            for (int kb = w * 128; kb < w * 128 + 128; kb += 16) {
                float2 wv[16];
#pragma unroll
                for (int q = 0; q < 16; ++q) wv[q] = *(const float2*)(wm + (size_t)(kb + q) * (NMOD * D));
#pragma unroll
                for (int q = 0; q < 16; ++q)
#pragma unroll
                    for (int r = 0; r < 5; ++r) { const float s = sc[r * 1024 + kb + q]; a[r][0] += s * wv[q].x; a[r][1] += s * wv[q].y; }
            }
#pragma unroll
            for (int r = 0; r < 5; ++r) { red[(w * 5 + r) * 128 + 2 * lane] = a[r][0]; red[(w * 5 + r) * 128 + 2 * lane + 1] = a[r][1]; }
            __syncthreads();
            for (int i = tid; i < 5 * 128; i += 512) {
                const int r = i >> 7, c = i & 127; float s = 0.f;
#pragma unroll
                for (int ww = 0; ww < 8; ++ww) s += red[(ww * 5 + r) * 128 + c];
                s += pin_ld(5)[(size_t)l * (NMOD * D) + c0 + c];
                ((float*)(p.ws + WS_MOD))[(size_t)(l * 5 + r) * (NMOD * D) + c0 + c] = s;
            }
            __syncthreads();
        }
    }
    {
        float* z = sm;
        float* a1 = sm + 16 * 36;
        float* a2 = a1 + 16 * 64;
        float* a3 = a2 + 16 * 64;
        float* tl = a3 + 16 * 64;
        float* wl = tl + 16;
        const float HMAX = -4.605170185988091f / 0.3f, HMIN = -4.605170185988091f / 1.5f;
        int o_loaded = -1;
        for (int it = nb - 1 - bid; it < 544; it += nb) {
            const int o = it / 272, r = it % 272;
            const int Lf = (r < 256) ? SEQ : CL; const int p0 = (r < 256) ? r * 16 : (r - 256) * 16;
            float* kf = (float*)(p.ws + WS_KF + (size_t)o * SZ_KF) + ((r < 256) ? (size_t)0 : (size_t)2 * SEQ * D);
            const float* f3 = pin_ld(25) + (size_t)o * 64 * 2048;
            __syncthreads();
            if (o != o_loaded) {
                const float* f0 = pin_ld(19) + (size_t)o * 33 * 64; const float* f1 = pin_ld(21) + (size_t)o * 64 * 64; const float* f2 = pin_ld(23) + (size_t)o * 64 * 64;
                for (int i = tid; i < 33 * 64; i += 512) wl[i] = f0[i];
                for (int i = tid; i < 64 * 64; i += 512) { wl[2112 + i] = f1[i]; wl[2112 + 4096 + i] = f2[i]; }
                if (tid < 64) { wl[10304 + tid] = pin_ld(20)[o * 64 + tid]; wl[10304 + 64 + tid] = pin_ld(22)[o * 64 + tid]; wl[10304 + 128 + tid] = pin_ld(24)[o * 64 + tid]; wl[10304 + 192 + tid] = pin_ld(26)[o * 64 + tid]; }
                o_loaded = o;
            }
            const float* f0 = wl; const float* f1 = wl + 2112; const float* f2 = wl + 2112 + 4096;
            const float* fb0 = wl + 10304; const float* fb1 = fb0 + 64; const float* fb2 = fb0 + 128; const float* fq = fb0 + 192;
            for (int idx = tid; idx < 16 * 33; idx += 512) {
                const int ps = idx / 33, f = idx % 33; const int i = p0 + ps;
                const float tlin = (float)i * (1.0f / (float)(Lf - 1));
                const float w = (6.283185307179586f * (float)i) / (float)Lf;
                float v;
                if (f == 0) { v = tlin; tl[ps] = tlin; }
                else { const int jj = (f - 1) & 15; const float fj = 1e-4f + (float)jj * ((15.0f - 1e-4f) / 15.0f); v = (f <= 16) ? cosf(fj * w) : -sinf(fj * w); }
                z[ps * 36 + f] = v;
            }
            __syncthreads();
            for (int idx = tid; idx < 16 * 64; idx += 512) { const int ps = idx >> 6, oc = idx & 63; float s = fb0[oc];
                for (int f = 0; f < 33; ++f) s += z[ps * 36 + f] * f0[f * 64 + oc];
                a1[idx] = sinf(fq[oc] * s); }
            __syncthreads();
            for (int idx = tid; idx < 16 * 64; idx += 512) { const int ps = idx >> 6, oc = idx & 63; float s = fb1[oc];
                for (int f = 0; f < 64; ++f) s += a1[ps * 64 + f] * f1[f * 64 + oc];
                a2[idx] = sinf(fq[oc] * s); }
            __syncthreads();
            for (int idx = tid; idx < 16 * 64; idx += 512) { const int ps = idx >> 6, oc = idx & 63; float s = fb2[oc];
                for (int f = 0; f < 64; ++f) s += a2[ps * 64 + f] * f2[f * 64 + oc];
                a3[oc * 16 + ps] = sinf(fq[oc] * s); }
            __syncthreads();
            {
                float acc[4][16];
#pragma unroll
                for (int q = 0; q < 4; ++q)
#pragma unroll
                    for (int ps = 0; ps < 16; ++ps) acc[q][ps] = 0.f;
                for (int fb = 0; fb < 64; fb += 4) {
                    float wv[4][4];
#pragma unroll
                    for (int f = 0; f < 4; ++f)
#pragma unroll
                        for (int q = 0; q < 4; ++q) wv[f][q] = f3[(fb + f) * 2048 + tid + 512 * q];
#pragma unroll
                    for (int f = 0; f < 4; ++f) {
                        const f32x4 av0 = *(const f32x4*)(a3 + (fb + f) * 16), av1 = *(const f32x4*)(a3 + (fb + f) * 16 + 4), av2 = *(const f32x4*)(a3 + (fb + f) * 16 + 8), av3 = *(const f32x4*)(a3 + (fb + f) * 16 + 12);
#pragma unroll
                        for (int q = 0; q < 4; ++q)
#pragma unroll
                            for (int e = 0; e < 4; ++e) { acc[q][e] += av0[e] * wv[f][q]; acc[q][4 + e] += av1[e] * wv[f][q]; acc[q][8 + e] += av2[e] * wv[f][q]; acc[q][12 + e] += av3[e] * wv[f][q]; }
                    }
                }
#pragma unroll
                for (int q = 0; q < 4; ++q) {
                    const int c = tid + 512 * q; const int dir = c >> 10, d = c & 1023;
                    const float delta = fabsf(HMIN + (float)d * ((HMAX - HMIN) / 1023.0f));
                    float kv[16];
#pragma unroll
                    for (int ps = 0; ps < 16; ++ps) kv[ps] = acc[q][ps] * expf(-tl[ps] * delta);
                    if (r < 256) {
                        bf16_t* rk = (bf16_t*)(p.ws + WS_KF + (size_t)o * SZ_KF) + (size_t)d * 8192;
                        if (dir == 0) {
                            u32x4 w0, w1;
                            w0.x = pg8::cvt_pk_bf16(kv[15], kv[14]); w0.y = pg8::cvt_pk_bf16(kv[13], kv[12]); w0.z = pg8::cvt_pk_bf16(kv[11], kv[10]); w0.w = pg8::cvt_pk_bf16(kv[9], kv[8]);
                            w1.x = pg8::cvt_pk_bf16(kv[7], kv[6]); w1.y = pg8::cvt_pk_bf16(kv[5], kv[4]); w1.z = pg8::cvt_pk_bf16(kv[3], kv[2]); w1.w = pg8::cvt_pk_bf16(kv[1], kv[0]);
                            *(u32x4*)(rk + 4080 - p0) = w0; *(u32x4*)(rk + 4088 - p0) = w1;
                            if (p0 == 0) rk[8191] = 0;
                        } else {
                            if (p0 > 0) rk[4095 + p0] = f2bf(kv[0]);
                            u32x4 w0; w0.x = pg8::cvt_pk_bf16(kv[1], kv[2]); w0.y = pg8::cvt_pk_bf16(kv[3], kv[4]); w0.z = pg8::cvt_pk_bf16(kv[5], kv[6]); w0.w = pg8::cvt_pk_bf16(kv[7], kv[8]);
                            *(u32x4*)(rk + 4096 + p0) = w0;
                            uint2 w1; w1.x = pg8::cvt_pk_bf16(kv[9], kv[10]); w1.y = pg8::cvt_pk_bf16(kv[11], kv[12]);
                            *(uint2*)(rk + 4104 + p0) = w1;
                            *(unsigned*)(rk + 4108 + p0) = pg8::cvt_pk_bf16(kv[13], kv[14]);
                            rk[4110 + p0] = f2bf(kv[15]);
                        }
                    } else {
#pragma unroll
                        for (int ps = 0; ps < 16; ++ps) kf[((size_t)dir * Lf + p0 + ps) * D + d] = kv[ps];
                    }
                }
            }
        }
        __syncthreads();
    }
}

__device__ __forceinline__ void rowphase(const KQ p_in, int Mupd, const bf16_t* Y, int lu, int gidx, float wgt, const float* gpost,
                         int Mnext, int ln, const float* gpre, int shidx, int scidx, bf16_t* Hout, bool from_input, int tbeg) {
    const KQ p = lq(p_in);
    const int tid = ltid(), w = tid >> 6, lane = tid & 63;
    const int Mmax = Mupd > Mnext ? Mupd : Mnext;
    for (int t = tbeg + (blockIdx.x * 8 + w) * 2; t < Mmax; t += gridDim.x * 16) {
        float* xr = xrow(p, t); const int mr = modrow(t);
        const float* xs = xr;
        if (from_input) xs = (t < TL) ? pin_ld(0) + (size_t)t * D : pin_ld(2) + (size_t)(t - TL) * D;
        float4 xv[2][4];
#pragma unroll
        for (int rr = 0; rr < 2; ++rr)
#pragma unroll
            for (int q = 0; q < 4; ++q) xv[rr][q] = *(const float4*)(xs + rr * D + q * 256 + lane * 4);
        if (Y != nullptr && t < Mupd) {
            float4 yv[2][4]; float ss[2] = {0.f, 0.f};
#pragma unroll
            for (int rr = 0; rr < 2; ++rr)
#pragma unroll
                for (int q = 0; q < 4; ++q) {
                    if (t < TL) { const bf16x4 yb = *(const bf16x4*)(Y + (size_t)(t + rr) * D + q * 256 + lane * 4);
                        yv[rr][q] = make_float4(bf2f((bf16_t)yb[0]), bf2f((bf16_t)yb[1]), bf2f((bf16_t)yb[2]), bf2f((bf16_t)yb[3])); }
                    else { const float* yp = (const float*)(p.ws + WS_YP) + (size_t)(t + rr - TL) * D + q * 256 + lane * 4;
                        const float4 a0 = *(const float4*)yp, a1 = *(const float4*)(yp + (size_t)TC * D), a2 = *(const float4*)(yp + (size_t)2 * TC * D), a3 = *(const float4*)(yp + (size_t)3 * TC * D);
                        yv[rr][q] = make_float4(a0.x + a1.x + a2.x + a3.x, a0.y + a1.y + a2.y + a3.y, a0.z + a1.z + a2.z + a3.z, a0.w + a1.w + a2.w + a3.w); }
                    ss[rr] += yv[rr][q].x * yv[rr][q].x + yv[rr][q].y * yv[rr][q].y + yv[rr][q].z * yv[rr][q].z + yv[rr][q].w * yv[rr][q].w; }
            ss[0] = wave_sum(ss[0]); ss[1] = wave_sum(ss[1]);
            float wgl = wgt; asm volatile("" : "+v"(wgl));
            const float r0 = rsqrtf(ss[0] * (1.0f / D) + EPS) * wgl, r1 = rsqrtf(ss[1] * (1.0f / D) + EPS) * wgl;
            const float* gm = modp(p, lu, mr, gidx);
#pragma unroll
            for (int q = 0; q < 4; ++q) {
                const float4 g4 = *(const float4*)(gm + q * 256 + lane * 4); const float4 p4 = *(const float4*)(gpost + q * 256 + lane * 4);
                const float cx = g4.x * p4.x, cy = g4.y * p4.y, cz = g4.z * p4.z, cw = g4.w * p4.w;
                xv[0][q].x += r0 * cx * yv[0][q].x; xv[0][q].y += r0 * cy * yv[0][q].y; xv[0][q].z += r0 * cz * yv[0][q].z; xv[0][q].w += r0 * cw * yv[0][q].w;
                xv[1][q].x += r1 * cx * yv[1][q].x; xv[1][q].y += r1 * cy * yv[1][q].y; xv[1][q].z += r1 * cz * yv[1][q].z; xv[1][q].w += r1 * cw * yv[1][q].w;
                *(float4*)(xr + q * 256 + lane * 4) = xv[0][q]; *(float4*)(xr + D + q * 256 + lane * 4) = xv[1][q];
            }
        }
        if (Hout != nullptr && t < Mnext) {
            float ss[2] = {0.f, 0.f};
#pragma unroll
            for (int rr = 0; rr < 2; ++rr)
#pragma unroll
                for (int q = 0; q < 4; ++q) ss[rr] += xv[rr][q].x * xv[rr][q].x + xv[rr][q].y * xv[rr][q].y + xv[rr][q].z * xv[rr][q].z + xv[rr][q].w * xv[rr][q].w;
            ss[0] = wave_sum(ss[0]); ss[1] = wave_sum(ss[1]);
            const float rn[2] = {rsqrtf(ss[0] * (1.0f / D) + EPS), rsqrtf(ss[1] * (1.0f / D) + EPS)};
            const float* sh = modp(p, ln, mr, shidx); const float* sc = modp(p, ln, mr, scidx);
#pragma unroll
            for (int q = 0; q < 4; ++q) {
                const float4 g4 = *(const float4*)(gpre + q * 256 + lane * 4); const float4 s4 = *(const float4*)(sc + q * 256 + lane * 4); const float4 h4 = *(const float4*)(sh + q * 256 + lane * 4);
                const float mx_ = g4.x * (1.0f + s4.x), my_ = g4.y * (1.0f + s4.y), mz_ = g4.z * (1.0f + s4.z), mw_ = g4.w * (1.0f + s4.w);
#pragma unroll
                for (int rr = 0; rr < 2; ++rr) {
                    const float h0 = xv[rr][q].x * rn[rr] * mx_ + h4.x, h1 = xv[rr][q].y * rn[rr] * my_ + h4.y;
                    const float h2 = xv[rr][q].z * rn[rr] * mz_ + h4.z, h3 = xv[rr][q].w * rn[rr] * mw_ + h4.w;
                    uint2 pk; pk.x = pg8::cvt_pk_bf16(h0, h1); pk.y = pg8::cvt_pk_bf16(h2, h3);
                    *(uint2*)(Hout + (size_t)(t + rr) * D + q * 256 + lane * 4) = pk;
                }
            }
        }
    }
}

__device__ __forceinline__ float log_sigmoid(float x) { return -log1pf(expf(-x)); }
__device__ __forceinline__ int chunk_t0(int b, int cidx) { return cidx < 32 ? b * SEQ + cidx * 128 : TL + b * CL + (cidx - 32) * 128; }

__device__ __forceinline__ void m1_rope_states(const KQ p_in, int e, float* sm) {
    const KQ p = lq(p_in);
    const int tid = ltid(), bid = blockIdx.x, nb = gridDim.x;
    bf16_t* Z = (bf16_t*)(p.ws + WS_BIG);
    const float* rope = (const float*)(p.ws + WS_ROPE);
    for (int base = bid * 512 + tid; base < TL * 72; base += 2 * nb * 512) {
        bf16_t* zp[2]; bf16x8 a1[2], a2[2]; f32x4 c0[2], c1[2], s0[2], s1[2]; bool ok[2];
#pragma unroll
        for (int u = 0; u < 2; ++u) {
            const int idx = base + u * nb * 512; ok[u] = idx < TL * 72; const int ix = ok[u] ? idx : base;
            const int t = ix / 72, r = ix % 72; const int hd = r >> 2, i0 = (r & 3) * 8;
            const int cb = hd < 16 ? hd * 64 : 1536 + (hd - 16) * 64;
            const int tb = (hd >= 8 && hd < 16) ? 2 : 0; const int pos = t & (SEQ - 1);
            const float* cp = rope + (size_t)tb * SEQ * 32 + pos * 32 + i0; const float* sp = cp + (size_t)SEQ * 32;
            zp[u] = Z + (size_t)t * INW + cb + i0;
            a1[u] = *(const bf16x8*)zp[u]; a2[u] = *(const bf16x8*)(zp[u] + 32);
            c0[u] = *(const f32x4*)cp; c1[u] = *(const f32x4*)(cp + 4); s0[u] = *(const f32x4*)sp; s1[u] = *(const f32x4*)(sp + 4);
        }
#pragma unroll
        for (int u = 0; u < 2; ++u) {
            if (!ok[u]) continue;
            float o1[8], o2[8];
#pragma unroll
            for (int j = 0; j < 8; ++j) { const float x1 = bf2f((bf16_t)a1[u][j]), x2 = bf2f((bf16_t)a2[u][j]); const float cc = j < 4 ? c0[u][j & 3] : c1[u][j & 3], sn = j < 4 ? s0[u][j & 3] : s1[u][j & 3];
                o1[j] = x1 * cc - x2 * sn; o2[j] = x1 * sn + x2 * cc; }
            u32x4 w1, w2;
            w1.x = pg8::cvt_pk_bf16(o1[0], o1[1]); w1.y = pg8::cvt_pk_bf16(o1[2], o1[3]); w1.z = pg8::cvt_pk_bf16(o1[4], o1[5]); w1.w = pg8::cvt_pk_bf16(o1[6], o1[7]);
            w2.x = pg8::cvt_pk_bf16(o2[0], o2[1]); w2.y = pg8::cvt_pk_bf16(o2[2], o2[3]); w2.z = pg8::cvt_pk_bf16(o2[4], o2[5]); w2.w = pg8::cvt_pk_bf16(o2[6], o2[7]);
            *(u32x4*)zp[u] = w1; *(u32x4*)(zp[u] + 32) = w2;
        }
    }
    float* Ks = sm;
    float* Vs = sm + 128 * 64;
    float* wf = Vs + 128 * 64;
    float* wb = wf + 128;
    float* AF = (float*)(p.ws + WS_ST); float* AB = AF + SZ_ST / 4;
    const float* dec = pin_ld(13) + e * 16;
    for (int it = bid; it < NB * NCH * 8; it += nb) {
        const int h = it & 7, cidx = (it >> 3) % NCH, b = it / (8 * NCH);
        const int t0 = chunk_t0(b, cidx); const bool lat = cidx < 32;
        const float lgf = log_sigmoid(dec[h]), lgb = log_sigmoid(dec[8 + h]);
        __syncthreads();
        if (tid < 128) { wf[tid] = expf(lgf * (float)(127 - tid)); wb[tid] = expf(lgb * (float)tid); }
        const int kc = 1792 + h * 64, vc = 2304 + h * 64;
        {
            const int r = tid >> 2, pq = tid & 3;
            bf16_t* zp = Z + (size_t)(t0 + r) * INW + kc + 8 * pq;
            const bf16x8 a1 = *(const bf16x8*)zp, a2 = *(const bf16x8*)(zp + 32);
            float o1[8], o2[8];
            if (lat) {
                const int pos = (t0 + r) & (SEQ - 1);
                const float* cp = rope + (size_t)2 * SEQ * 32 + pos * 32 + 8 * pq; const float* sp = cp + (size_t)SEQ * 32;
                const f32x4 c0 = *(const f32x4*)cp, c1 = *(const f32x4*)(cp + 4), s0 = *(const f32x4*)sp, s1 = *(const f32x4*)(sp + 4);
#pragma unroll
                for (int j = 0; j < 8; ++j) { const float x1 = bf2f((bf16_t)a1[j]), x2 = bf2f((bf16_t)a2[j]); const float cc = j < 4 ? c0[j & 3] : c1[j & 3], sn = j < 4 ? s0[j & 3] : s1[j & 3];
                    o1[j] = bf2f(f2bf(x1 * cc - x2 * sn)); o2[j] = bf2f(f2bf(x1 * sn + x2 * cc)); }
                u32x4 w1, w2;
                w1.x = pg8::cvt_pk_bf16(o1[0], o1[1]); w1.y = pg8::cvt_pk_bf16(o1[2], o1[3]); w1.z = pg8::cvt_pk_bf16(o1[4], o1[5]); w1.w = pg8::cvt_pk_bf16(o1[6], o1[7]);
                w2.x = pg8::cvt_pk_bf16(o2[0], o2[1]); w2.y = pg8::cvt_pk_bf16(o2[2], o2[3]); w2.z = pg8::cvt_pk_bf16(o2[4], o2[5]); w2.w = pg8::cvt_pk_bf16(o2[6], o2[7]);
                *(u32x4*)zp = w1; *(u32x4*)(zp + 32) = w2;
            } else {
#pragma unroll
                for (int j = 0; j < 8; ++j) { o1[j] = bf2f((bf16_t)a1[j]); o2[j] = bf2f((bf16_t)a2[j]); }
            }
            *(f32x4*)(Ks + r * 64 + 8 * pq) = (f32x4){o1[0], o1[1], o1[2], o1[3]}; *(f32x4*)(Ks + r * 64 + 8 * pq + 4) = (f32x4){o1[4], o1[5], o1[6], o1[7]};
            *(f32x4*)(Ks + r * 64 + 32 + 8 * pq) = (f32x4){o2[0], o2[1], o2[2], o2[3]}; *(f32x4*)(Ks + r * 64 + 32 + 8 * pq + 4) = (f32x4){o2[4], o2[5], o2[6], o2[7]};
        }
#pragma unroll
        for (int q = 0; q < 2; ++q) { const int idx = tid + 512 * q; const int r = idx >> 3, pc = idx & 7;
            const bf16x8 vv = *(const bf16x8*)(Z + (size_t)(t0 + r) * INW + vc + 8 * pc);
            *(f32x4*)(Vs + r * 64 + 8 * pc) = (f32x4){bf2f((bf16_t)vv[0]), bf2f((bf16_t)vv[1]), bf2f((bf16_t)vv[2]), bf2f((bf16_t)vv[3])};
            *(f32x4*)(Vs + r * 64 + 8 * pc + 4) = (f32x4){bf2f((bf16_t)vv[4]), bf2f((bf16_t)vv[5]), bf2f((bf16_t)vv[6]), bf2f((bf16_t)vv[7])}; }
        __syncthreads();
        const int d = tid >> 3, e0 = (tid & 7) * 8;
        float af[8], ab[8];
#pragma unroll
        for (int j = 0; j < 8; ++j) { af[j] = 0.f; ab[j] = 0.f; }
        for (int s = 0; s < 128; ++s) {
            const float kv = Ks[s * 64 + d]; const float kfw = kv * wf[s], kbw = kv * wb[s];
            const float4 v0 = *(const float4*)(Vs + s * 64 + e0), v1 = *(const float4*)(Vs + s * 64 + e0 + 4);
            af[0] += kfw * v0.x; af[1] += kfw * v0.y; af[2] += kfw * v0.z; af[3] += kfw * v0.w; af[4] += kfw * v1.x; af[5] += kfw * v1.y; af[6] += kfw * v1.z; af[7] += kfw * v1.w;
            ab[0] += kbw * v0.x; ab[1] += kbw * v0.y; ab[2] += kbw * v0.z; ab[3] += kbw * v0.w; ab[4] += kbw * v1.x; ab[5] += kbw * v1.y; ab[6] += kbw * v1.z; ab[7] += kbw * v1.w;
        }
        const size_t so = ((size_t)(b * NCH + cidx) * 8 + h) * 4096 + d * 64 + e0;
        *(float4*)(AF + so) = make_float4(af[0], af[1], af[2], af[3]); *(float4*)(AF + so + 4) = make_float4(af[4], af[5], af[6], af[7]);
        *(float4*)(AB + so) = make_float4(ab[0], ab[1], ab[2], ab[3]); *(float4*)(AB + so + 4) = make_float4(ab[4], ab[5], ab[6], ab[7]);
    }
    __syncthreads();
}

__device__ __forceinline__ void m2_scan(const KQ p_in, int e) {
    const KQ p = lq(p_in);
    const float* __restrict__ AF = (const float*)(p.ws + WS_ST); const float* __restrict__ AB = AF + SZ_ST / 4;
    float* __restrict__ TF = (float*)(p.ws + WS_ST) + 2 * (SZ_ST / 4); float* __restrict__ TB = TF + SZ_ST / 4;
    const float* dec = pin_ld(13) + e * 16;
    for (int idx = blockIdx.x * 512 + ltid(); idx < NB * 8 * 4096; idx += gridDim.x * 512) {
        const int el = idx & 4095, h = (idx >> 12) & 7, b = idx >> 15;
        const float gf = expf(log_sigmoid(dec[h]) * 128.0f), gb = expf(log_sigmoid(dec[8 + h]) * 128.0f);
        const size_t base = ((size_t)(b * NCH) * 8 + h) * 4096 + el; constexpr size_t CS = (size_t)8 * 4096;
        float af[NCH], ab[NCH];
#pragma unroll
        for (int c = 0; c < NCH; ++c) { af[c] = AF[base + c * CS]; ab[c] = AB[base + c * CS]; }
        TF[base + 32 * CS] = 0.f; TF[base + 33 * CS] = af[32]; TB[base + 33 * CS] = 0.f; TB[base + 32 * CS] = ab[33];
        float sf = gf * af[32] + af[33], sb = ab[32] + gb * ab[33];
#pragma unroll
        for (int c = 0; c < 32; ++c) { TF[base + c * CS] = sf; sf = gf * sf + af[c]; }
#pragma unroll
        for (int c = 31; c >= 0; --c) { TB[base + c * CS] = sb; sb = ab[c] + gb * sb; }
    }
}

__device__ __forceinline__ bf16x8 pack8(const f32x4& a, const f32x4& b) {
    u32x4 w; w.x = pg8::cvt_pk_bf16(a[0], a[1]); w.y = pg8::cvt_pk_bf16(a[2], a[3]); w.z = pg8::cvt_pk_bf16(b[0], b[1]); w.w = pg8::cvt_pk_bf16(b[2], b[3]);
    return __builtin_bit_cast(bf16x8, w);
}
__device__ __forceinline__ void m3_outputs(const KQ p_in, int e, bool ctx_full, unsigned char* smem) {
    const KQ p = lq(p_in);
    const int tid = ltid(), bid = blockIdx.x, nb = gridDim.x;
    const int w = tid >> 6, lane = tid & 63, ln = lane & 15, g4 = lane >> 4;
    const bf16_t* Z = (const bf16_t*)(p.ws + WS_BIG);
    bf16_t* MIX = (bf16_t*)(p.ws + WS_MIX);
    const float* dec = pin_ld(13) + e * 16;
    const float* sink = pin_ld(12) + e * 8;
    const float* TF = (const float*)(p.ws + WS_ST) + 2 * (SZ_ST / 4); const float* TB = TF + SZ_ST / 4;
    const int nchunk = ctx_full ? NCH : 32;
    const int nitems = NB * nchunk * 8;
    bf16_t* Kt = (bf16_t*)smem;
    bf16_t* Vt = Kt + 128 * 72;
    bf16_t* TfT = Vt + 64 * 136;
    bf16_t* TbT = TfT + 64 * 72;
    const int i = 16 * w + ln;
    for (int it = bid; it < 2 * nitems; it += nb) {
        const bool is_attn = it < nitems; const int ii = is_attn ? it : it - nitems;
        const int h = ii & 7, cidx = (ii >> 3) % nchunk, b = ii / (8 * nchunk);
        const int t0 = chunk_t0(b, cidx); const bool lat = cidx < 32;
        f32x4 O[4];
#pragma unroll
        for (int m = 0; m < 4; ++m) O[m] = (f32x4){0.f, 0.f, 0.f, 0.f};
        if (!is_attn) {
            const float lgf = log_sigmoid(dec[h]), lgb = log_sigmoid(dec[8 + h]);
            __syncthreads();
#pragma unroll
            for (int q = 0; q < 2; ++q) { const int idx = tid + 512 * q; const int r = idx >> 3, pc = idx & 7; const bf16_t* zr = Z + (size_t)(t0 + r) * INW + h * 64 + pc * 8;
                *(u32x4*)(Kt + r * 72 + pc * 8) = *(const u32x4*)(zr + 1792);
                const bf16x8 vv = *(const bf16x8*)(zr + 2304);
#pragma unroll
                for (int j = 0; j < 8; ++j) Vt[(pc * 8 + j) * 136 + (r ^ (pc << 2))] = (bf16_t)vv[j]; }
            const size_t so = ((size_t)(b * NCH + cidx) * 8 + h) * 4096;
            {
                const int ee = tid & 63, d0 = (tid >> 6) * 8;
                float tf[8], tb[8];
#pragma unroll
                for (int j = 0; j < 8; ++j) { tf[j] = TF[so + (d0 + j) * 64 + ee]; tb[j] = TB[so + (d0 + j) * 64 + ee]; }
                u32x4 wf4, wb4;
                wf4.x = pg8::cvt_pk_bf16(tf[0], tf[1]); wf4.y = pg8::cvt_pk_bf16(tf[2], tf[3]); wf4.z = pg8::cvt_pk_bf16(tf[4], tf[5]); wf4.w = pg8::cvt_pk_bf16(tf[6], tf[7]);
                wb4.x = pg8::cvt_pk_bf16(tb[0], tb[1]); wb4.y = pg8::cvt_pk_bf16(tb[2], tb[3]); wb4.z = pg8::cvt_pk_bf16(tb[4], tb[5]); wb4.w = pg8::cvt_pk_bf16(tb[6], tb[7]);
                *(u32x4*)(TfT + ee * 72 + d0) = wf4; *(u32x4*)(TbT + ee * 72 + d0) = wb4;
            }
            __builtin_amdgcn_sched_barrier(0);
            bf16x8 qf[2], qff[2], qfb[2];
            { const bf16_t* qr = Z + (size_t)(t0 + i) * INW + 512 + h * 64 + 8 * g4;
              const float cf = __expf(lgf * (float)(i + 1)), cb = __expf(lgb * (float)(128 - i));
#pragma unroll
              for (int k2 = 0; k2 < 2; ++k2) { qf[k2] = *(const bf16x8*)(qr + 32 * k2);
                  f32x4 a0, a1, b0, b1;
#pragma unroll
                  for (int j = 0; j < 4; ++j) { const float x0 = bf2f((bf16_t)qf[k2][j]), x1 = bf2f((bf16_t)qf[k2][4 + j]); a0[j] = x0 * cf; a1[j] = x1 * cf; b0[j] = x0 * cb; b1[j] = x1 * cb; }
                  qff[k2] = pack8(a0, a1); qfb[k2] = pack8(b0, b1); } }
            __builtin_amdgcn_sched_barrier(0);
            __syncthreads();
#pragma unroll
            for (int m = 0; m < 4; ++m)
#pragma unroll
                for (int k2 = 0; k2 < 2; ++k2) {
                    const bf16x8 af = *(const bf16x8*)(TfT + (16 * m + ln) * 72 + 32 * k2 + 8 * g4);
                    const bf16x8 ab = *(const bf16x8*)(TbT + (16 * m + ln) * 72 + 32 * k2 + 8 * g4);
                    O[m] = __builtin_amdgcn_mfma_f32_16x16x32_bf16(af, qff[k2], O[m], 0, 0, 0);
                    O[m] = __builtin_amdgcn_mfma_f32_16x16x32_bf16(ab, qfb[k2], O[m], 0, 0, 0);
                    __builtin_amdgcn_sched_barrier(0);
                }
            const float lf2 = lgf * 1.44269504f, lb2 = lgb * 1.44269504f; const int di = i - 4 * g4;
            const float bfw = lf2 * (float)di, bbw = -lb2 * (float)di;
            f32x4 st[8];
#pragma unroll
            for (int mt = 0; mt < 8; ++mt) {
                f32x4 a = (f32x4){0.f, 0.f, 0.f, 0.f};
#pragma unroll
                for (int k2 = 0; k2 < 2; ++k2) { const bf16x8 kf = *(const bf16x8*)(Kt + (16 * mt + ln) * 72 + 32 * k2 + 8 * g4); a = __builtin_amdgcn_mfma_f32_16x16x32_bf16(kf, qf[k2], a, 0, 0, 0); }
#pragma unroll
                for (int rg = 0; rg < 4; ++rg) { const int cc = 16 * mt + rg; const int df = di - cc;
                    const float arg = (df > 0) ? fmaf(-lf2, (float)cc, bfw) : fmaf(lb2, (float)cc, bbw);
                    float wgt = __builtin_amdgcn_exp2f(arg); wgt = (df == 0) ? 2.0f : wgt;
                    a[rg] *= wgt; }
                st[mt] = a;
                __builtin_amdgcn_sched_barrier(0);
            }
#pragma unroll
            for (int ks = 0; ks < 4; ++ks) {
                const bf16x8 pfr = pack8(st[2 * ks], st[2 * ks + 1]);
#pragma unroll
                for (int m = 0; m < 4; ++m) {
                    const int vrow = 16 * m + ln; const int kx = (32 * ks + 4 * g4) ^ (((vrow >> 3) & 7) << 2);
                    const bf16_t* vr = Vt + vrow * 136;
                    const bf16x4 v0 = *(const bf16x4*)(vr + kx), v1 = *(const bf16x4*)(vr + (kx ^ 16));
                    const bf16x8 vf = __builtin_shufflevector(v0, v1, 0, 1, 2, 3, 4, 5, 6, 7);
                    O[m] = __builtin_amdgcn_mfma_f32_16x16x32_bf16(vf, pfr, O[m], 0, 0, 0);
                }
                __builtin_amdgcn_sched_barrier(0);
            }
            float ss = 0.f;
#pragma unroll
            for (int m = 0; m < 4; ++m)
#pragma unroll
                for (int rg = 0; rg < 4; ++rg) ss += O[m][rg] * O[m][rg];
            ss += __shfl_xor(ss, 16, 64); ss += __shfl_xor(ss, 32, 64);
            const float rn = rsqrtf(ss * (1.0f / 64.0f) + EPS);
#pragma unroll
            for (int m = 0; m < 4; ++m) {
                const int ee = 16 * m + 4 * g4;
                const bf16x4 gv = *(const bf16x4*)(Z + (size_t)(t0 + i) * INW + 1024 + h * 64 + ee);
                uint2 o2; o2.x = pg8::cvt_pk_bf16(O[m][0] * rn * silu_f(bf2f((bf16_t)gv[0])), O[m][1] * rn * silu_f(bf2f((bf16_t)gv[1])));
                o2.y = pg8::cvt_pk_bf16(O[m][2] * rn * silu_f(bf2f((bf16_t)gv[2])), O[m][3] * rn * silu_f(bf2f((bf16_t)gv[3])));
                *(uint2*)(MIX + (size_t)(t0 + i) * D + 512 + h * 64 + ee) = o2;
            }
        } else {
            const int gk = h >> 2;
            bf16x8 qf[2];
            { const bf16_t* qr = Z + (size_t)(t0 + i) * INW + h * 64 + 8 * g4; qf[0] = *(const bf16x8*)qr; qf[1] = *(const bf16x8*)(qr + 32); }
            float mx = sink[h], l = (g4 == 0) ? 1.0f : 0.0f;
            const int qpos = lat ? (cidx * 128 + i) : 0;
#define ATT_VALID(tl_) ((tl_) >= 3 || (lat && (cidx - 1 + (tl_)) >= 0 && (cidx - 1 + (tl_)) < 32))
#define ATT_KT0(tl_) ((tl_) >= 3 ? TL + b * CL + ((tl_) - 3) * 128 : b * SEQ + (cidx - 1 + (tl_)) * 128)
            int tl = 0; while (!ATT_VALID(tl)) ++tl;
            u32x4 kreg[2]; bf16x8 vreg[2];
            { const int kt0 = ATT_KT0(tl);
#pragma unroll
              for (int q = 0; q < 2; ++q) { const int idx = tid + 512 * q; const int r = idx >> 3, pc = idx & 7; const bf16_t* zr = Z + (size_t)(kt0 + r) * INW + gk * 64 + pc * 8;
                  kreg[q] = *(const u32x4*)(zr + 1536); vreg[q] = *(const bf16x8*)(zr + 1664); } }
            while (tl < 5) {
                const bool isc = tl >= 3; const int kp0 = isc ? 0 : (cidx - 1 + tl) * 128;
                __syncthreads();
#pragma unroll
                for (int q = 0; q < 2; ++q) { const int idx = tid + 512 * q; const int r = idx >> 3, pc = idx & 7;
                    *(u32x4*)(Kt + r * 72 + pc * 8) = kreg[q];
#pragma unroll
                    for (int j = 0; j < 8; ++j) Vt[(pc * 8 + j) * 136 + (r ^ (pc << 2))] = (bf16_t)vreg[q][j]; }
                __syncthreads();
                int tn = tl + 1; while (tn < 5 && !ATT_VALID(tn)) ++tn;
                if (tn < 5) { const int kt0 = ATT_KT0(tn);
#pragma unroll
                    for (int q = 0; q < 2; ++q) { const int idx = tid + 512 * q; const int r = idx >> 3, pc = idx & 7; const bf16_t* zr = Z + (size_t)(kt0 + r) * INW + gk * 64 + pc * 8;
                        kreg[q] = *(const u32x4*)(zr + 1536); vreg[q] = *(const bf16x8*)(zr + 1664); } }
                f32x4 st[8];
                float mloc = -1e30f;
#pragma unroll
                for (int mt = 0; mt < 8; ++mt) {
                    f32x4 a = (f32x4){0.f, 0.f, 0.f, 0.f};
#pragma unroll
                    for (int k2 = 0; k2 < 2; ++k2) { const bf16x8 kf = *(const bf16x8*)(Kt + (16 * mt + ln) * 72 + 32 * k2 + 8 * g4); a = __builtin_amdgcn_mfma_f32_16x16x32_bf16(kf, qf[k2], a, 0, 0, 0); }
                    if (!isc) {
#pragma unroll
                        for (int rg = 0; rg < 4; ++rg) { const int dd = qpos - (kp0 + 16 * mt + 4 * g4 + rg); if (dd > 128 || dd < -128) a[rg] = -1e30f; }
                    }
#pragma unroll
                    for (int rg = 0; rg < 4; ++rg) mloc = fmaxf(mloc, a[rg]);
                    st[mt] = a;
                    __builtin_amdgcn_sched_barrier(0);
                }
                mloc = fmaxf(mloc, __shfl_xor(mloc, 16, 64)); mloc = fmaxf(mloc, __shfl_xor(mloc, 32, 64));
                const float mnew = fmaxf(mx, mloc);
                const float sc = __expf(mx - mnew); mx = mnew; l *= sc;
#pragma unroll
                for (int m = 0; m < 4; ++m) O[m] *= sc;
#pragma unroll
                for (int mt = 0; mt < 8; ++mt)
#pragma unroll
                    for (int rg = 0; rg < 4; ++rg) { const float pv = __expf(st[mt][rg] - mnew); st[mt][rg] = pv; l += pv; }
#pragma unroll
                for (int ks = 0; ks < 4; ++ks) {
                    const bf16x8 pfr = pack8(st[2 * ks], st[2 * ks + 1]);
#pragma unroll
                    for (int m = 0; m < 4; ++m) {
                        const int vrow = 16 * m + ln; const int kx = (32 * ks + 4 * g4) ^ (((vrow >> 3) & 7) << 2);
                        const bf16_t* vr = Vt + vrow * 136;
                        const bf16x4 v0 = *(const bf16x4*)(vr + kx), v1 = *(const bf16x4*)(vr + (kx ^ 16));
                        const bf16x8 vf = __builtin_shufflevector(v0, v1, 0, 1, 2, 3, 4, 5, 6, 7);
                        O[m] = __builtin_amdgcn_mfma_f32_16x16x32_bf16(vf, pfr, O[m], 0, 0, 0);
                    }
                    __builtin_amdgcn_sched_barrier(0);
                }
                tl = tn;
            }
#undef ATT_VALID
#undef ATT_KT0
            l += __shfl_xor(l, 16, 64); l += __shfl_xor(l, 32, 64);
            const float inv = 1.0f / l;
#pragma unroll
            for (int m = 0; m < 4; ++m) {
                uint2 o2; o2.x = pg8::cvt_pk_bf16(O[m][0] * inv, O[m][1] * inv); o2.y = pg8::cvt_pk_bf16(O[m][2] * inv, O[m][3] * inv);
                *(uint2*)(MIX + (size_t)(t0 + i) * D + h * 64 + 16 * m + 4 * g4) = o2;
            }
        }
    }
    __syncthreads();
}

__device__ __forceinline__ void h2_shortconv(const KQ p_in, int o, int M, unsigned char* smem) {
    const KQ p = lq(p_in);
    const int tid = ltid();
    const bf16_t* ZH = (const bf16_t*)(p.ws + WS_BIG);
    const float* w = pin_ld(17) + (size_t)o * 3 * HYW; const float* bs = pin_ld(18) + (size_t)o * HYW;
    bf16_t* VXT = (bf16_t*)(p.ws + WS_Y); bf16_t* X0T = VXT + (size_t)D * TL;
    bf16_t* tx = (bf16_t*)smem;
    bf16_t* tv = tx + 64 * 136;
    const int tok = tid >> 3, cg8 = (tid & 7) * 8;
    float* wl = (float*)(smem + 40960);
    { const int c0b = (blockIdx.x & 15) * 64;
      for (int i = tid; i < 768; i += 512) { const int k = i >> 8, q = (i >> 6) & 3, c = i & 63; const int col = k * 1024 + c0b + c; wl[i] = (q < 3) ? w[q * HYW + col] : bs[col]; } }
    __syncthreads();
    for (int it = blockIdx.x; it < (TL / 128) * 16; it += gridDim.x) {
        const int c0 = (it & 15) * 64, t0 = (it >> 4) * 128;
        bf16x8 zc[2][3], zp[2][3], zn[2][3];
#pragma unroll
        for (int g = 0; g < 2; ++g) {
            const int t = t0 + tok + 64 * g; const int pos = t & (SEQ - 1); const bool first = pos == 0, last = pos == SEQ - 1;
#pragma unroll
            for (int k = 0; k < 3; ++k) {
                const int c = k * 1024 + c0 + cg8;
                zc[g][k] = *(const bf16x8*)(ZH + (size_t)t * HYW + c);
                zp[g][k] = *(const bf16x8*)(ZH + (size_t)(first ? t : t - 1) * HYW + c);
                zn[g][k] = *(const bf16x8*)(ZH + (size_t)(last ? t : t + 1) * HYW + c);
            }
        }
        __syncthreads();
#pragma unroll
        for (int g = 0; g < 2; ++g) {
            const int t = t0 + tok + 64 * g; const int pos = t & (SEQ - 1); const float mf = (pos == 0) ? 0.f : 1.f, ml = (pos == SEQ - 1) ? 0.f : 1.f;
            float zz[3][8];
#pragma unroll
            for (int k = 0; k < 3; ++k) {
                const float* wk = wl + k * 256 + cg8;
#pragma unroll
                for (int j = 0; j < 8; ++j)
                    zz[k][j] = wk[192 + j] + bf2f((bf16_t)zc[g][k][j]) * wk[64 + j] + mf * bf2f((bf16_t)zp[g][k][j]) * wk[j] + ml * bf2f((bf16_t)zn[g][k][j]) * wk[128 + j];
            }
#pragma unroll
            for (int j = 0; j < 8; ++j) { const int cs = (tok + 64 * g) ^ ((tid & 7) << 3);
                tx[(cg8 + j) * 136 + cs] = f2bf(zz[0][j]); tv[(cg8 + j) * 136 + cs] = f2bf(zz[2][j] * zz[1][j]); }
        }
        __syncthreads();
        { const int ch = tid >> 3, tk = (tid & 7) * 8;
#pragma unroll
          for (int q = 0; q < 2; ++q) {
            const int cs = (tk + 64 * q) ^ (((ch >> 3) & 7) << 3);
            *(u32x4*)(X0T + (size_t)(c0 + ch) * TL + t0 + tk + 64 * q) = *(const u32x4*)(tx + ch * 136 + cs);
            *(u32x4*)(VXT + (size_t)(c0 + ch) * TL + t0 + tk + 64 * q) = *(const u32x4*)(tv + ch * 136 + cs); } }
    }
    __syncthreads();
    if (M > TL) {
        float* VX = (float*)(p.ws + WS_Y); bf16_t* X0 = (bf16_t*)(p.ws + WS_H);
        for (int idx = TL * D + blockIdx.x * 512 + tid; idx < M * D; idx += gridDim.x * 512) {
            const int t = idx >> 10, d = idx & 1023;
            const int pos = (t - TL) & (CL - 1); const bool first = pos == 0, last = pos == CL - 1;
            float zz[3];
#pragma unroll
            for (int k = 0; k < 3; ++k) {
                const int c = k * 1024 + d;
                float sacc = bs[c] + bf2f(ZH[(size_t)t * HYW + c]) * w[HYW + c];
                if (!first) sacc += bf2f(ZH[(size_t)(t - 1) * HYW + c]) * w[c];
                if (!last) sacc += bf2f(ZH[(size_t)(t + 1) * HYW + c]) * w[2 * HYW + c];
                zz[k] = sacc;
            }
            VX[idx] = zz[2] * zz[1]; X0[idx] = f2bf(zz[0]);
        }
    }
}

typedef float f32x16 __attribute__((ext_vector_type(16)));
__device__ __forceinline__ void h3_longconv(const KQ p_in, int o, bool ctx_full, unsigned char* smem) {
    const KQ p = lq(p_in);
    const int tid = ltid(), w = tid >> 6, lane = tid & 63;
    const float* bias = pin_ld(27) + (size_t)o * D;
    {
        const bf16_t* VXT = (const bf16_t*)(p.ws + WS_Y); const bf16_t* X0T = VXT + (size_t)D * TL;
        bf16_t* HMT = (bf16_t*)(p.ws + WS_H);
        const bf16_t* RKT = (const bf16_t*)(p.ws + WS_KF + (size_t)o * SZ_KF);
        constexpr int RK2_OFF = 16384 + 64, U_OFF = 2 * 16384 + 128, CH_BYTES = U_OFF + 142 * 256;
        const int cw = w >> 2, w4 = w & 3;
        const int ct = tid & 255;
        unsigned char* cb = smem + cw * CH_BYTES;
        unsigned char* ub = cb + U_OFF;
        const int r = lane & 31, hh = lane >> 5;
        for (int pr = blockIdx.x; pr < D / 2; pr += gridDim.x) {
            const int d = pr * 2 + cw;
            __syncthreads();
            { const bf16_t* src = RKT + (size_t)d * 8192;
              for (int i = ct; i < 1024; i += 256) *(u32x4*)(cb + i * 16) = *(const u32x4*)(src + i * 8);
              for (int i = ct; i < 2 * 7 * 4 * 4; i += 256) { const int side = i / 112, rem = i % 112; unsigned z0 = 0u; asm volatile("" : "+v"(z0)); *(u32x4*)(ub + (side ? (135 * 4 * 64) : 0) + rem * 16) = (u32x4){z0, z0, z0, z0}; }
#pragma unroll 8
              for (int i = ct; i < 4 * 512; i += 256) { const int b = i >> 9, pc = i & 511;
                  const u32x4 v = *(const u32x4*)(VXT + (size_t)d * TL + b * SEQ + pc * 8);
                  const int col = ((pc >> 2) + 7) * 4 + b, q = pc & 3;
                  *(u32x4*)(ub + col * 64 + ((q ^ ((col >> 2) & 3)) * 16)) = v; } }
            __syncthreads();
            { const bf16_t* rk = (const bf16_t*)cb; bf16_t* rk2 = (bf16_t*)(cb + RK2_OFF);
#pragma unroll 4
              for (int i = ct; i < 4096; i += 256) { const unsigned lo = rk[2 * i + 1]; const unsigned hi = (2 * i + 2 < 8192) ? rk[2 * i + 2] : 0u; *(unsigned*)(rk2 + 2 * i) = lo | (hi << 16); } }
            __syncthreads();
            f32x16 acc[4];
#pragma unroll
            for (int j = 0; j < 4; ++j)
#pragma unroll
                for (int q = 0; q < 16; ++q) acc[j][q] = 0.f;
            const bf16_t* rsel = (const bf16_t*)(cb + ((r & 1) ? 0 : RK2_OFF));
            const int adj = (r & 1) ? 0 : -1;
            const int bq = r & 3;
#define H3_LOAD(AF, BF, U) do { \
                _Pragma("unroll") for (int s2 = 0; s2 < 2; ++s2) { \
                    const unsigned* ap = (const unsigned*)(Ab + 64 * (3 - (U)) + 32 * s2); \
                    u32x4 t4; t4.x = ap[0]; t4.y = ap[1]; t4.z = ap[2]; t4.w = ap[3]; \
                    AF[s2] = __builtin_bit_cast(bf16x8, t4); } \
                _Pragma("unroll") for (int j = 0; j < 4; ++j) { \
                    int c_ = Lb - 256 * (U) + 2048 * j; c_ = c_ < LO ? LO : (c_ > HI ? HI : c_); \
                    BF[j][0] = *(const bf16x8*)(ub + c_ + off[U][0]); BF[j][1] = *(const bf16x8*)(ub + c_ + off[U][1]); } } while (0)
#define H3_MMA(AF, BF) do { \
                _Pragma("unroll") for (int s2 = 0; s2 < 2; ++s2) \
                _Pragma("unroll") for (int j = 0; j < 4; ++j) acc[j] = __builtin_amdgcn_mfma_f32_32x32x16_bf16(AF[s2], BF[j][s2], acc[j], 0, 0, 0); } while (0)
            {
                const int dlo = 32 * w4 - 127;
                const int LO = (24 + bq) * 64, HI = (540 + bq) * 64;
                int off[4][2];
#pragma unroll
                for (int u = 0; u < 4; ++u) { const int sw = ((r >> 2) + 2 - u) & 3; off[u][0] = (hh ^ sw) * 16; off[u][1] = ((2 + hh) ^ sw) * 16; }
                int Lb = (((r >> 2) + 134) * 4 + bq) * 64;
                const unsigned char* Ab = (const unsigned char*)(rsel + (4095 - 32 * dlo - r + 8 * hh + adj)) - 192;
                bf16x8 afA[2], bfA[4][2], afB[2], bfB[4][2];
                H3_LOAD(afA, bfA, 0);
                for (int g = 0; g < 39; ++g) {
                    H3_LOAD(afB, bfB, 1);
                    __builtin_amdgcn_sched_barrier(0);
                    H3_MMA(afA, bfA);
                    __builtin_amdgcn_sched_barrier(0);
                    H3_LOAD(afA, bfA, 2);
                    __builtin_amdgcn_sched_barrier(0);
                    H3_MMA(afB, bfB);
                    __builtin_amdgcn_sched_barrier(0);
                    H3_LOAD(afB, bfB, 3);
                    __builtin_amdgcn_sched_barrier(0);
                    H3_MMA(afA, bfA);
                    __builtin_amdgcn_sched_barrier(0);
                    Ab -= 256; Lb -= 1024;
                    H3_LOAD(afA, bfA, 0);
                    __builtin_amdgcn_sched_barrier(0);
                    H3_MMA(afB, bfB);
                    __builtin_amdgcn_sched_barrier(0);
                }
                H3_LOAD(afB, bfB, 1);
                __builtin_amdgcn_sched_barrier(0);
                H3_MMA(afA, bfA);
                __builtin_amdgcn_sched_barrier(0);
                H3_LOAD(afA, bfA, 2);
                __builtin_amdgcn_sched_barrier(0);
                H3_MMA(afB, bfB);
                H3_MMA(afA, bfA);
            }
#undef H3_LOAD
#undef H3_MMA
            __syncthreads();
            const float bd = bias[d];
#pragma unroll
            for (int j = 0; j < 4; ++j) {
                const int n1 = 8 * (4 * w4 + j) + (r >> 2);
                const int col = (n1 + 7) * 4 + bq; const int sw = (col >> 2) & 3;
                bf16_t* up = (bf16_t*)(ub + col * 64);
#pragma unroll
                for (int q4 = 0; q4 < 4; ++q4) {
                    bf16_t* pp = up + ((q4 ^ sw) * 8) + 4 * hh;
                    const bf16x4 uv = *(const bf16x4*)pp;
                    uint2 o2; o2.x = pg8::cvt_pk_bf16(acc[j][4 * q4] + bd * bf2f((bf16_t)uv[0]), acc[j][4 * q4 + 1] + bd * bf2f((bf16_t)uv[1]));
                    o2.y = pg8::cvt_pk_bf16(acc[j][4 * q4 + 2] + bd * bf2f((bf16_t)uv[2]), acc[j][4 * q4 + 3] + bd * bf2f((bf16_t)uv[3]));
                    *(uint2*)pp = o2;
                }
            }
            __syncthreads();
#pragma unroll 4
            for (int i = ct; i < 4 * 512; i += 256) { const int b = i >> 9, pc = i & 511;
                const int col = ((pc >> 2) + 7) * 4 + b, q = pc & 3;
                const bf16x8 yv = *(const bf16x8*)(ub + col * 64 + ((q ^ ((col >> 2) & 3)) * 16));
                const size_t gi = (size_t)d * TL + b * SEQ + pc * 8;
                const bf16x8 xv = *(const bf16x8*)(X0T + gi);
                u32x4 o4;
                o4.x = pg8::cvt_pk_bf16(bf2f((bf16_t)yv[0]) * bf2f((bf16_t)xv[0]), bf2f((bf16_t)yv[1]) * bf2f((bf16_t)xv[1]));
                o4.y = pg8::cvt_pk_bf16(bf2f((bf16_t)yv[2]) * bf2f((bf16_t)xv[2]), bf2f((bf16_t)yv[3]) * bf2f((bf16_t)xv[3]));
                o4.z = pg8::cvt_pk_bf16(bf2f((bf16_t)yv[4]) * bf2f((bf16_t)xv[4]), bf2f((bf16_t)yv[5]) * bf2f((bf16_t)xv[5]));
                o4.w = pg8::cvt_pk_bf16(bf2f((bf16_t)yv[6]) * bf2f((bf16_t)xv[6]), bf2f((bf16_t)yv[7]) * bf2f((bf16_t)xv[7]));
                *(u32x4*)(HMT + gi) = o4; }
        }
        __syncthreads();
    }
    if (ctx_full) {
        const float* VX = (const float*)(p.ws + WS_Y); const bf16_t* X0 = (const bf16_t*)(p.ws + WS_H);
        bf16_t* MIX = (bf16_t*)(p.ws + WS_MIX);
        const float* kf = (const float*)(p.ws + WS_KF + (size_t)o * SZ_KF) + (size_t)2 * SEQ * D;
        for (int idx = blockIdx.x * 512 + tid; idx < (TC / 8) * D; idx += gridDim.x * 512) {
            const int d = idx & 1023, og = idx >> 10;
            const int bb = og >> 5, n0 = (og & 31) * 8, tb = TL + bb * CL;
            const float* up = VX + (size_t)tb * D + d;
            float acc[8];
#pragma unroll
            for (int j = 0; j < 8; ++j) acc[j] = 0.f;
#pragma unroll 1
            for (int mb = 0; mb < CL; mb += 8) {
                float kk[15], uu[8];
#pragma unroll
                for (int q = 0; q < 15; ++q) { const int lag = n0 - mb - 7 + q;
                    kk[q] = (lag >= 0) ? ((lag < CL) ? kf[(size_t)lag * D + d] : 0.f) : ((-lag < CL) ? kf[(size_t)(CL - lag) * D + d] : 0.f); }
#pragma unroll
                for (int u = 0; u < 8; ++u) uu[u] = up[(size_t)(mb + u) * D];
#pragma unroll
                for (int u = 0; u < 8; ++u)
#pragma unroll
                    for (int j = 0; j < 8; ++j) acc[j] += uu[u] * kk[7 - u + j];
            }
            const float bd = bias[d];
#pragma unroll
            for (int j = 0; j < 8; ++j) { const size_t ti = (size_t)(tb + n0 + j) * D + d; MIX[ti] = f2bf(bf2f(X0[ti]) * (acc[j] + bd * VX[ti])); }
        }
    }
}

__device__ __forceinline__ void h3b_transpose(const KQ p_in, unsigned char* smem) {
    const KQ p = lq(p_in);
    const int tid = ltid();
    const bf16_t* HMT = (const bf16_t*)(p.ws + WS_H); bf16_t* MIX = (bf16_t*)(p.ws + WS_MIX);
    bf16_t* tile = (bf16_t*)smem;
    for (int it = blockIdx.x; it < (TL / 256) * 16; it += gridDim.x) {
        const int c0 = (it & 15) * 64, t0 = (it >> 4) * 256;
        u32x4 ld[4];
        { const int ch = tid >> 3, tk = (tid & 7) * 8;
#pragma unroll
          for (int q = 0; q < 4; ++q) ld[q] = *(const u32x4*)(HMT + (size_t)(c0 + ch) * TL + t0 + tk + 64 * q);
          __syncthreads();
#pragma unroll
          for (int q = 0; q < 4; ++q) *(u32x4*)(tile + ch * 264 + ((tk + 64 * q) ^ (((ch >> 3) & 7) << 3))) = ld[q]; }
        __syncthreads();
        { const int cg8 = (tid & 7) * 8;
#pragma unroll
          for (int q = 0; q < 4; ++q) { const int tok = (tid >> 3) + 64 * q; unsigned short v[8];
#pragma unroll
              for (int j = 0; j < 8; ++j) v[j] = tile[(cg8 + j) * 264 + (tok ^ ((tid & 7) << 3))];
              u32x4 o4; o4.x = v[0] | ((unsigned)v[1] << 16); o4.y = v[2] | ((unsigned)v[3] << 16); o4.z = v[4] | ((unsigned)v[5] << 16); o4.w = v[6] | ((unsigned)v[7] << 16);
              *(u32x4*)(MIX + (size_t)(t0 + tok) * D + c0 + cg8) = o4; } }
    }
    __syncthreads();
}

__global__ void __launch_bounds__(512, 2) mega_fwd(KP kp) {
    unsigned char* const smem = g_smem;
    if (threadIdx.x < 29) *(LAS unsigned long long*)((LAS unsigned char*)g_smem + PTAB_OFF + 8 * threadIdx.x) = ((const unsigned long long*)__builtin_amdgcn_kernarg_segment_ptr())[threadIdx.x];
    KQ p; p.out = kp.out; p.ws = kp.ws;
    cg::grid_group grid = cg::this_grid();
    if (threadIdx.x < 4) ((volatile LAS unsigned*)(LAS unsigned char*)smem)[(LDS_BYTES - 16) / 4 + threadIdx.x] = 0u;
    __syncthreads();
    if (threadIdx.x == 0) (void)xb_add(&((unsigned*)(lq(p).ws + WS_BAR))[XB_XCNT(xb_xcc_id())], 1u);
    grid.sync();
    float* smf = (float*)smem;
#define Hb ((bf16_t*)(lq(p).ws + WS_H))
#define BIG ((bf16_t*)(lq(p).ws + WS_BIG))
#define Y ((bf16_t*)(lq(p).ws + WS_Y))
#define MIX ((bf16_t*)(lq(p).ws + WS_MIX))

#ifndef NO_P0
    p0_setup(p, smf);
#endif
    GRID_BAR();
    rowphase(p, 0, nullptr, 0, 0, 0.f, nullptr, T, 0, pin_ld(6), 0, 1, Hb, true, 0);
    GRID_BAR();
    for (int l = 0; l < 4; ++l) {
        const bool ctx_live = l <= 2, ctx_full = l < 2;
        const int Mff = ctx_live ? T : TL, Mpost = ctx_full ? T : TL;
        for (int sub = 0; sub < 3; ++sub) {
            const bf16_t* Ao; const bf16_t* Bo; int Ko; int Mo;
            if (sub != 1) {
                const int fi = sub >> 1; const int M = (sub == 0) ? Mff : Mpost;
                { pg8::EpiSwiGLU E{BIG, DFF}; run_gemm(smem, Hb, (const bf16_t*)(lq(p).ws + WS_WGU + (size_t)(l * 2 + fi) * SZ_WGU), M, 2 * DFF, D, E); }
                GRID_BAR();
                Ao = BIG; Bo = (const bf16_t*)(lq(p).ws + WS_WD + (size_t)(l * 2 + fi) * SZ_WD); Ko = DFF; Mo = M;
            } else {
                if ((l & 1) == 0) {
                    const int e = l >> 1;
                    { pg8::EpiBf16 E{BIG, INW, nullptr}; run_gemm(smem, Hb, (const bf16_t*)(lq(p).ws + WS_WIN + (size_t)e * SZ_WIN), Mff, INW, D, E); }
                    GRID_BAR();
#ifndef NO_M1
                    m1_rope_states(p, e, smf);
#endif
                    GRID_BAR();
#ifndef NO_M2
                    m2_scan(p, e);
#endif
                    GRID_BAR();
#ifndef NO_M3
                    m3_outputs(p, e, ctx_full, smem);
#endif
                    GRID_BAR();
                    Bo = (const bf16_t*)(lq(p).ws + WS_WOUT + (size_t)e * SZ_WOUT);
                } else {
                    const int o = l >> 1;
                    { pg8::EpiBf16 E{BIG, HYW, pin_ld(16) + (size_t)o * HYW}; run_gemm(smem, Hb, (const bf16_t*)(lq(p).ws + WS_HWIN + (size_t)o * SZ_HWIN), Mpost, HYW, D, E); }
                    GRID_BAR();
#ifndef NO_H2
                    h2_shortconv(p, o, Mpost, smem);
#endif
                    GRID_BAR();
#ifndef NO_H3
                    h3_longconv(p, o, ctx_full, smem);
#endif
                    GRID_BAR();
                    h3b_transpose(p, smem);
                    GRID_BAR();
                    Bo = (const bf16_t*)(lq(p).ws + WS_HWOUT + (size_t)o * SZ_WOUT);
                }
                Ao = MIX; Ko = D; Mo = Mpost;
            }
            const int gidx = 2 + 3 * sub;
            const int ln = (sub == 2) ? l + 1 : l; const bool has_next = ln < 4; const int lnn = has_next ? ln : l;
            const int pre_i = (sub == 2) ? 0 : sub + 1;
            const int Mn = has_next ? ((sub == 2) ? ((ln <= 2) ? T : TL) : ((sub == 0) ? Mff : Mpost)) : 0;
            const float* gpost = pin_ld(7) + (size_t)(l * 3 + sub) * D; const float* gpre = pin_ld(6) + (size_t)(lnn * 3 + pre_i) * D;
            const float wg = (sub == 1) ? 1.0f : 0.5f;
            {
                pg8::EpiFusedRow EF;
                EF.xin = (l == 0 && sub == 0) ? pin_ld(0) : (const float*)lq(p).out; EF.xout = lq(p).out; EF.H = has_next ? Hb : nullptr;
                EF.gate = modp(lq(p), l, 0, gidx); EF.gpost = gpost; EF.wgt = wg;
                EF.gpre = gpre; EF.shift = modp(lq(p), lnn, 0, 3 * pre_i); EF.scale = modp(lq(p), lnn, 0, 3 * pre_i + 1);
                EF.slots = (float*)(lq(p).ws + WS_SLOT); EF.cnt = (unsigned*)(lq(p).ws + WS_CNT) + (size_t)(l * 3 + sub) * 2 * 64 * 64;
                run_gemm_f32_split(smem, Ao, Bo, Mo, Ko, EF, (float*)(lq(p).ws + WS_YP));
            }
            if (Mo > TL && blockIdx.x < 64) {
                sub_barrier((unsigned*)(lq(p).ws + WS_CNT) + (size_t)12 * 2 * 64 * 64 + (l * 3 + sub) * 64, 64u);
                rowphase(p, Mo, Y, l, gidx, wg, gpost, Mn, lnn, gpre, 3 * pre_i, 3 * pre_i + 1, has_next ? Hb : nullptr, l == 0 && sub == 0, TL);
            }
            GRID_BAR();
        }
    }
}

extern "C" void kernel_launch(void* const* d_in, const int* in_sizes, int n_in, void* d_out, int out_size, void* d_ws, size_t ws_size, hipStream_t stream) {
    static int grid = 0;
    if (grid == 0) {
        if (n_in != 29 || out_size != TL * D || ws_size < WS_END) { fprintf(stderr, "kernel_launch: unexpected shapes: n_in %d out %d ws %zu (need %zu)\n", n_in, out_size, ws_size, (size_t)WS_END); grid = -1; return; }
        int dev = 0, cus = 0, per_cu = 0;
        (void)hipGetDevice(&dev);
        (void)hipDeviceGetAttribute(&cus, hipDeviceAttributeMultiprocessorCount, dev);
        if (hipFuncSetAttribute((const void*)mega_fwd, hipFuncAttributeMaxDynamicSharedMemorySize, LDS_BYTES) != hipSuccess) { fprintf(stderr, "kernel_launch: hipFuncSetAttribute failed\n"); grid = -1; return; }
        if (hipOccupancyMaxActiveBlocksPerMultiprocessor(&per_cu, (const void*)mega_fwd, 512, LDS_BYTES) != hipSuccess || per_cu < 1) { fprintf(stderr, "kernel_launch: occupancy query says %d\n", per_cu); per_cu = 1; }
        (void)hipGetLastError();
        grid = cus >= 256 ? 256 : cus;
    }
    if (grid < 0) return;
    (void)hipMemsetAsync((unsigned char*)d_ws + WS_BAR, 0, 16384 + SZ_CNT, stream);
    KP kp{};
    for (int i = 0; i < 29; ++i) kp.in[i] = (const float*)d_in[i];
    kp.out = (float*)d_out; kp.ws = (unsigned char*)d_ws;
    void* args[] = {&kp};
    hipError_t e = hipLaunchCooperativeKernel((const void*)mega_fwd, dim3(grid), dim3(512), args, LDS_BYTES, stream);
    if (e != hipSuccess) fprintf(stderr, "cooperative launch failed: %s (grid %d)\n", hipGetErrorString(e), grid);
}
```

```cpp
#include <hip/hip_runtime.h>
#include <hip/hip_cooperative_groups.h>
#include <cstdio>
namespace cg = cooperative_groups;

#define LAS __attribute__((address_space(3)))
typedef unsigned short bf16_t;
typedef short bf16x8 __attribute__((ext_vector_type(8)));
typedef short bf16x4 __attribute__((ext_vector_type(4)));
typedef float f32x4 __attribute__((ext_vector_type(4)));
typedef unsigned u32x4 __attribute__((ext_vector_type(4)));

constexpr int D = 1024, NB = 4, SEQ = 4096, CL = 256, TL = NB * SEQ, TC = NB * CL, T = TL + TC, DFF = 2816, INW = 2816, HYW = 3072;
constexpr int NMOD = 9;
constexpr float EPS = 1e-6f;
constexpr int NCH = 34;
constexpr int LDS_BYTES = 144 * 1024;

constexpr size_t SZ_WGU = (size_t)2 * DFF * D * 2, SZ_WD = (size_t)D * DFF * 2, SZ_WIN = (size_t)INW * D * 2, SZ_WOUT = (size_t)D * D * 2, SZ_HWIN = (size_t)HYW * D * 2;
constexpr size_t WS_WGU = 0;
constexpr size_t WS_WD = WS_WGU + 8 * SZ_WGU;
constexpr size_t WS_WIN = WS_WD + 8 * SZ_WD;
constexpr size_t WS_WOUT = WS_WIN + 2 * SZ_WIN;
constexpr size_t WS_HWIN = WS_WOUT + 2 * SZ_WOUT;
constexpr size_t WS_HWOUT = WS_HWIN + 2 * SZ_HWIN;
constexpr size_t WS_MOD = WS_HWOUT + 2 * SZ_WOUT;
constexpr size_t WS_ROPE = WS_MOD + (size_t)4 * 5 * NMOD * D * 4;
constexpr size_t WS_XC = WS_ROPE + (size_t)4 * SEQ * 32 * 4;
constexpr size_t WS_H = WS_XC + (size_t)TC * D * 4;
constexpr size_t WS_BIG = WS_H + (size_t)T * D * 2;
constexpr size_t WS_Y = WS_BIG + (size_t)T * HYW * 2;
constexpr size_t WS_MIX = WS_Y + (size_t)T * D * 4;
constexpr size_t SZ_ST = (size_t)NB * NCH * 8 * 4096 * 4;
constexpr size_t WS_ST = WS_MIX + (size_t)T * D * 2;
constexpr size_t SZ_KF = (size_t)(SEQ + CL) * 2 * D * 4;
constexpr size_t WS_KF = WS_ST + 4 * SZ_ST;
constexpr size_t WS_YP = WS_KF + 2 * SZ_KF;
constexpr size_t WS_BAR = WS_YP + (size_t)4 * TC * D * 4;
constexpr size_t WS_CNT = WS_BAR + 16384;
constexpr size_t SZ_CNT = (size_t)12 * 2 * 64 * 256 + 16 * 256;
constexpr size_t WS_SLOT = WS_CNT + SZ_CNT;
constexpr size_t WS_END = WS_SLOT + (size_t)2 * TL * 4 * 4;

struct KP { const float* in[29]; float* out; unsigned char* ws; };
extern __shared__ __attribute__((aligned(16))) unsigned char g_smem[];
constexpr int PTAB_OFF = LDS_BYTES - 512;
__device__ __forceinline__ const float* pin_ld(int k) {
    const unsigned long long v = *(volatile LAS unsigned long long*)((LAS unsigned char*)g_smem + PTAB_OFF + 8 * k);
    const unsigned lo = __builtin_amdgcn_readfirstlane((unsigned)v), hi = __builtin_amdgcn_readfirstlane((unsigned)(v >> 32));
    return (const float*)(((unsigned long long)hi << 32) | lo);
}
struct KQ { float* out; unsigned char* ws; };
__device__ __forceinline__ KQ lq(KQ q) { asm volatile("" : "+s"(q.out), "+s"(q.ws)); return q; }

__device__ __forceinline__ bf16_t f2bf(float f) { unsigned u = __float_as_uint(f); u += 0x7FFFu + ((u >> 16) & 1u); return (bf16_t)(u >> 16); }
__device__ __forceinline__ float bf2f(bf16_t b) { return __uint_as_float(((unsigned)b) << 16); }
__device__ __forceinline__ float silu_f(float x) { return x * __builtin_amdgcn_rcpf(1.0f + __expf(-x)); }
__device__ __forceinline__ int ltid() { int t = threadIdx.x; asm volatile("" : "+v"(t)); return t; }
__device__ __forceinline__ float wave_sum(float v) {
#pragma unroll
    for (int o = 32; o > 0; o >>= 1) v += __shfl_xor(v, o, 64);
    return v;
}


#define XB_TMO      128
#define XB_XCNT(j)  (256  + 64 * (j))
#define XB_XSUB(j)  (1280 + 64 * (j))
#define XB_XGEN(j)  (2304 + 64 * (j))
#define XB_TOP      3328
#define XB_TOPGEN   3392
#define XCD_BAR_WORDS 3456
#define XB_SPIN_CAP (1u << 18)
__device__ __forceinline__ unsigned xb_ld(unsigned* p)              { return __hip_atomic_load(p, __ATOMIC_RELAXED, __HIP_MEMORY_SCOPE_AGENT); }
__device__ __forceinline__ unsigned xb_add(unsigned* p, unsigned v) { return __hip_atomic_fetch_add(p, v, __ATOMIC_RELAXED, __HIP_MEMORY_SCOPE_AGENT); }
__device__ __forceinline__ unsigned xb_xcc_id() { return (unsigned)__builtin_amdgcn_s_getreg((3 << 11) | 20) & 0xFu; }
#define XB_SPIN(cond, bar) do { unsigned _sp = 0; while (cond) { __builtin_amdgcn_s_sleep(1); \
    if ((++_sp & 255u) == 0u) { if (xb_ld(&(bar)[XB_TMO])) break; if (_sp > XB_SPIN_CAP) { atomicAdd(&(bar)[XB_TMO], 1u); break; } } } } while (0)
struct XcdBarrier { unsigned* bar; unsigned x; volatile LAS unsigned* st; };
__device__ __forceinline__ XcdBarrier xcd_barrier_post(unsigned* bar, volatile LAS unsigned* st) {
    XcdBarrier b; b.bar = bar; b.x = xb_xcc_id(); b.st = st;
    if (threadIdx.x == 0) (void)xb_add(&bar[XB_XCNT(b.x)], 1u);
    return b;
}
__device__ __forceinline__ void xcd_barrier_complete(unsigned* bar, unsigned x, unsigned& nloc, unsigned& nx) {
    const unsigned G = gridDim.x * gridDim.y * gridDim.z;
    unsigned sum, cnt, mine, sp = 0u;
    for (;;) {
        sum = 0u; cnt = 0u; mine = 0u;
#pragma unroll
        for (unsigned j = 0; j < 16; ++j) { const unsigned c = xb_ld(&bar[XB_XCNT(j)]); sum += c; cnt += (c > 0u) ? 1u : 0u; mine = (j == x) ? c : mine; }
        if (sum == G) break;
        __builtin_amdgcn_s_sleep(1);
        if ((++sp & 255u) == 0u) { if (xb_ld(&bar[XB_TMO])) break; if (sp > XB_SPIN_CAP) { atomicAdd(&bar[XB_TMO], 1u); break; } }
    }
    nloc = mine > 0u ? mine : 1u; nx = cnt > 0u ? cnt : 1u;
}
__device__ __forceinline__ void xcd_barrier_impl(unsigned* bar, volatile LAS unsigned* st) {
    asm volatile("s_waitcnt vmcnt(0)" ::: "memory");
    __syncthreads();
    if (ltid() == 0) {
        const unsigned x = xb_xcc_id();
        __builtin_amdgcn_s_waitcnt(0);
        unsigned nloc = st[0], nx = st[1];
        if (nloc == 0u) { xcd_barrier_complete(bar, x, nloc, nx); st[0] = nloc; st[1] = nx; }
        const unsigned old = xb_add(&bar[XB_XSUB(x)], 1u);
        const unsigned gen = old / nloc;
        if (old + 1u == (gen + 1u) * nloc) {
            __builtin_amdgcn_fence(__ATOMIC_RELEASE, "agent");
            asm volatile("s_waitcnt vmcnt(0)" ::: "memory");
            const unsigned og = xb_add(&bar[XB_TOP], 1u);
            const unsigned tg = og / nx;
            if (og + 1u == (tg + 1u) * nx) xb_add(&bar[XB_TOPGEN], 1u);
            else XB_SPIN(xb_ld(&bar[XB_TOPGEN]) == tg, bar);
            __builtin_amdgcn_fence(__ATOMIC_ACQUIRE, "agent");
            xb_add(&bar[XB_XGEN(x)], 1u);
            asm volatile("s_waitcnt vmcnt(0)" ::: "memory");
        } else {
            XB_SPIN(xb_ld(&bar[XB_XGEN(x)]) == gen, bar);
            __builtin_amdgcn_fence(__ATOMIC_ACQUIRE, "agent");
            asm volatile("s_waitcnt vmcnt(0)" ::: "memory");
        }
    }
    __syncthreads();
}
__device__ __forceinline__ void sub_barrier(unsigned* word, unsigned n) {
    asm volatile("s_waitcnt vmcnt(0)" ::: "memory");
    __syncthreads();
    if (ltid() == 0) {
        __builtin_amdgcn_fence(__ATOMIC_RELEASE, "agent");
        asm volatile("s_waitcnt vmcnt(0)" ::: "memory");
        (void)xb_add(word, 1u);
        for (unsigned sp = 0; sp < (1u << 21); ++sp) { if (xb_ld(word) >= n) break; __builtin_amdgcn_s_sleep(2); }
        __builtin_amdgcn_fence(__ATOMIC_ACQUIRE, "agent");
        asm volatile("s_waitcnt vmcnt(0)" ::: "memory");
    }
    __syncthreads();
}
__device__ __forceinline__ void sub_arrive(unsigned* word) {
    asm volatile("s_waitcnt vmcnt(0)" ::: "memory");
    __syncthreads();
    if (ltid() == 0) { __builtin_amdgcn_fence(__ATOMIC_RELEASE, "agent"); asm volatile("s_waitcnt vmcnt(0)" ::: "memory"); (void)xb_add(word, 1u); }
}
__device__ __forceinline__ void sub_wait(unsigned* word, unsigned n) {
    if (ltid() == 0) {
        for (unsigned sp = 0; sp < (1u << 21); ++sp) { if (xb_ld(word) >= n) break; __builtin_amdgcn_s_sleep(2); }
        __builtin_amdgcn_fence(__ATOMIC_ACQUIRE, "agent");
        asm volatile("s_waitcnt vmcnt(0)" ::: "memory");
    }
    __syncthreads();
}
#define GRID_BAR() xcd_barrier_impl((unsigned*)(p.ws + WS_BAR), (volatile LAS unsigned*)((LAS unsigned char*)smem + LDS_BYTES - 16))

namespace pg8 {
constexpr int BM = 256, BK = 64, HALF = 128, HTB = HALF * BK * 2, STAGE_BYTES = 8 * HTB, NXCD = 8, WGM = 8;
__host__ __device__ __forceinline__ int lds_byte(int r, int c) { const int st = (r >> 4) * 2 + (c >> 5), rr = r & 15, cc = c & 31, ob = rr * 64 + cc * 2; return st * 1024 + (ob ^ (((ob >> 9) & 1) << 5)); }
__host__ __device__ __forceinline__ void stage_rc(int b, int& R, int& C) { const int st = b / 1024, sb = b % 1024, swz = sb ^ (((sb >> 9) & 1) << 5); R = (st >> 1) * 16 + swz / 64; C = (st & 1) * 32 + (swz % 64) / 2; }
__host__ __device__ __forceinline__ int perm32(int rho) { const int n = rho >> 4, i = rho & 15; return 8 * (i >> 2) + 4 * n + (i & 3); }
struct Unit { int pm, pn; };
struct Gemm { const bf16_t* A; const bf16_t* Bt; int M, N, K, ld; };
struct StaticOrder {
    int nM, nN, nwg, G, c;
    __device__ void init(int M, int N, int G_, int c_) { nM = M / BM; nN = N / BM; nwg = nM * nN; G = G_; c = c_; }
    __device__ bool next(int i, Unit& u) const {
        const long Lx = (long)i * G + c; if (Lx >= nwg) return false;
        int wgid = (int)Lx; { const int q = nwg / NXCD, r = nwg % NXCD, xcd = wgid % NXCD, off = wgid / NXCD; wgid = (xcd < r ? xcd * (q + 1) : r * (q + 1) + (xcd - r) * q) + off; }
        const int nig = WGM * nN, gid = wgid / nig, fm = gid * WGM, gsz = (nM - fm) < WGM ? (nM - fm) : WGM;
        u.pm = fm + ((wgid % nig) % gsz); u.pn = (wgid % nig) / gsz; return true;
    }
};
__device__ __forceinline__ unsigned cvt_pk_bf16(float lo, float hi) { unsigned r; asm volatile("v_cvt_pk_bf16_f32 %0, %1, %2" : "=v"(r) : "v"(lo), "v"(hi)); return r; }

struct EpiF32 {
    static constexpr bool PERM = false, AFTER_DRAIN = false;
    float* C; int ldc;
    __device__ __forceinline__ void operator()(const f32x4 (&acc)[2][2][4][2], const Unit& u, int wr, int wc, int fr, int fq) const {
        const int row0 = u.pm * BM + wr * 64 + fr, col0 = u.pn * BM + wc * 32 + 4 * fq;
#pragma unroll
        for (int ai = 0; ai < 2; ++ai)
#pragma unroll
            for (int m = 0; m < 4; ++m) { float* rowp = C + (size_t)(row0 + ai * HALF + m * 16) * ldc + col0;
#pragma unroll
                for (int bj = 0; bj < 2; ++bj)
#pragma unroll
                    for (int n = 0; n < 2; ++n) *(f32x4*)(rowp + bj * HALF + n * 16) = acc[ai][bj][m][n]; }
    }
};
struct EpiBf16 {
    static constexpr bool PERM = true, AFTER_DRAIN = false;
    bf16_t* O; int ldc; const float* bias;
    __device__ __forceinline__ void operator()(const f32x4 (&acc)[2][2][4][2], const Unit& u, int wr, int wc, int fr, int fq) const {
        const int row0 = u.pm * BM + wr * 64 + fr; const int col0 = u.pn * BM + wc * 32 + 8 * fq;
        f32x4 bv[2][2];
#pragma unroll
        for (int bj = 0; bj < 2; ++bj)
#pragma unroll
            for (int n = 0; n < 2; ++n) bv[bj][n] = bias ? *(const f32x4*)(bias + col0 + bj * HALF + 4 * n) : (f32x4){0.f, 0.f, 0.f, 0.f};
#pragma unroll
        for (int ai = 0; ai < 2; ++ai)
#pragma unroll
            for (int m = 0; m < 4; ++m) { bf16_t* rowp = O + (size_t)(row0 + ai * HALF + m * 16) * ldc + col0;
#pragma unroll
                for (int bj = 0; bj < 2; ++bj) { f32x4 v0 = acc[ai][bj][m][0] + bv[bj][0], v1 = acc[ai][bj][m][1] + bv[bj][1];
                    u32x4 w; w.x = cvt_pk_bf16(v0[0], v0[1]); w.y = cvt_pk_bf16(v0[2], v0[3]); w.z = cvt_pk_bf16(v1[0], v1[1]); w.w = cvt_pk_bf16(v1[2], v1[3]);
                    *(u32x4*)(rowp + bj * HALF) = w; } }
    }
};
struct EpiSwiGLU {
    static constexpr bool PERM = true, AFTER_DRAIN = false;
    bf16_t* O; int ldc;
    __device__ __forceinline__ void operator()(const f32x4 (&acc)[2][2][4][2], const Unit& u, int wr, int wc, int fr, int fq) const {
        const int row0 = u.pm * BM + wr * 64 + fr; const int col0 = u.pn * HALF + wc * 32 + 8 * fq;
#pragma unroll
        for (int ai = 0; ai < 2; ++ai)
#pragma unroll
            for (int m = 0; m < 4; ++m) { bf16_t* rowp = O + (size_t)(row0 + ai * HALF + m * 16) * ldc + col0;
                float v[8];
#pragma unroll
                for (int n = 0; n < 2; ++n)
#pragma unroll
                    for (int j = 0; j < 4; ++j) { const float g = acc[ai][0][m][n][j], up = acc[ai][1][m][n][j]; v[n * 4 + j] = silu_f(g) * up; }
                u32x4 w; w.x = cvt_pk_bf16(v[0], v[1]); w.y = cvt_pk_bf16(v[2], v[3]); w.z = cvt_pk_bf16(v[4], v[5]); w.w = cvt_pk_bf16(v[6], v[7]);
                *(u32x4*)rowp = w; }
    }
};


__device__ __forceinline__ void row_exchange(const f32x4 (&v)[2][2][4][2], const Unit& u, int wr, int wc, int fr, int fq, LAS unsigned char* lds, int wid, int lane, float* slots, unsigned* cnt) {
    LAS float* P = (LAS float*)lds;
    LAS float* S = (LAS float*)(lds + 4096);
#pragma unroll
    for (int ai = 0; ai < 2; ++ai)
#pragma unroll
        for (int m = 0; m < 4; ++m) {
            float sq = 0.f;
#pragma unroll
            for (int bj = 0; bj < 2; ++bj)
#pragma unroll
                for (int n = 0; n < 2; ++n) { const f32x4 x = v[ai][bj][m][n]; sq += (x[0] * x[0] + x[1] * x[1]) + (x[2] * x[2] + x[3] * x[3]); }
            sq += __shfl_xor(sq, 16); sq += __shfl_xor(sq, 32);
            if (fq == 0) P[(ai * HALF + wr * 64 + m * 16 + fr) * 4 + wc] = sq;
        }
    asm volatile("s_waitcnt lgkmcnt(0)" ::: "memory"); __builtin_amdgcn_s_barrier(); asm volatile("" ::: "memory");
    const int row = wid * 32 + (lane & 31);
    if (lane < 32) {
        const float tot = (P[row * 4 + 0] + P[row * 4 + 1]) + (P[row * 4 + 2] + P[row * 4 + 3]);
        __hip_atomic_store((unsigned*)slots + ((size_t)(u.pm * BM + row) * 4 + u.pn), __float_as_uint(tot), __ATOMIC_RELAXED, __HIP_MEMORY_SCOPE_AGENT);
    }
    asm volatile("s_waitcnt vmcnt(0)" ::: "memory");
    if (lane == 0) __hip_atomic_fetch_add(cnt + 64 * u.pm, 1u, __ATOMIC_RELAXED, __HIP_MEMORY_SCOPE_AGENT);
    if (wid == 0) {
        for (unsigned sp = 0; sp < (1u << 21); ++sp) {
            if ((unsigned)__builtin_amdgcn_readfirstlane(__hip_atomic_load(cnt + 64 * u.pm, __ATOMIC_RELAXED, __HIP_MEMORY_SCOPE_AGENT)) >= 32u) break;
            __builtin_amdgcn_s_sleep(2);
        }
        __builtin_amdgcn_fence(__ATOMIC_ACQUIRE, "agent");
    }
    asm volatile("s_waitcnt vmcnt(0) lgkmcnt(0)" ::: "memory"); __builtin_amdgcn_s_barrier(); asm volatile("" ::: "memory");
    if (lane < 32) {
        const unsigned* sl = (const unsigned*)slots + (size_t)(u.pm * BM + row) * 4;
        float tot = 0.f;
#pragma unroll
        for (int t = 0; t < 4; ++t) tot += __uint_as_float(__hip_atomic_load(sl + t, __ATOMIC_RELAXED, __HIP_MEMORY_SCOPE_AGENT));
        S[row] = tot;
    }
    asm volatile("s_waitcnt vmcnt(0) lgkmcnt(0)" ::: "memory"); __builtin_amdgcn_s_barrier(); asm volatile("" ::: "memory");
}
struct EpiFusedRow {
    static constexpr bool PERM = false, AFTER_DRAIN = true;
    const float* xin; float* xout; bf16_t* H;
    const float* gate; const float* gpost; float wgt;
    const float* gpre; const float* shift; const float* scale;
    float* slots; unsigned* cnt;
    __device__ __forceinline__ void operator()(const f32x4 (&)[2][2][4][2], const Unit&, int, int, int, int) const {}
    __device__ __forceinline__ void fused(f32x4 (&acc)[2][2][4][2], const Unit& u, int wr, int wc, int fr, int fq, LAS unsigned char* lds, int wid, int lane) const {
        const LAS float* S = (const LAS float*)(lds + 4096);
        const int col0 = u.pn * BM + wc * 32 + 4 * fq; const size_t mb = (size_t)(u.pm >> 4) * (NMOD * D);
        row_exchange(acc, u, wr, wc, fr, fq, lds, wid, lane, slots, cnt);
        {
            f32x4 cw[2][2];
#pragma unroll
            for (int bj = 0; bj < 2; ++bj)
#pragma unroll
                for (int n = 0; n < 2; ++n) cw[bj][n] = *(const f32x4*)(gate + mb + col0 + bj * HALF + n * 16) * *(const f32x4*)(gpost + col0 + bj * HALF + n * 16);
#pragma unroll
            for (int ai = 0; ai < 2; ++ai)
#pragma unroll
                for (int m = 0; m < 4; ++m) { const int r = ai * HALF + wr * 64 + m * 16 + fr; const float r1 = rsqrtf(S[r] * (1.0f / D) + EPS) * wgt; const size_t off = (size_t)(u.pm * BM + r) * D + col0;
#pragma unroll
                    for (int bj = 0; bj < 2; ++bj)
#pragma unroll
                        for (int n = 0; n < 2; ++n) { const f32x4 xv = *(const f32x4*)(xin + off + bj * HALF + n * 16); const f32x4 xn = xv + (cw[bj][n] * r1) * acc[ai][bj][m][n];
                            acc[ai][bj][m][n] = xn; *(f32x4*)(xout + off + bj * HALF + n * 16) = xn; }
                    asm volatile("" : "+v"(acc[ai][0][m][0]), "+v"(acc[ai][0][m][1]), "+v"(acc[ai][1][m][0]), "+v"(acc[ai][1][m][1]));
                    asm volatile("" ::: "memory"); }
        }
        if (H == nullptr) return;
        row_exchange(acc, u, wr, wc, fr, fq, lds, wid, lane, slots + (size_t)TL * 4, cnt + 64 * 64);
        {
            f32x4 gm[2][2], sh[2][2];
#pragma unroll
            for (int bj = 0; bj < 2; ++bj)
#pragma unroll
                for (int n = 0; n < 2; ++n) { const int c = col0 + bj * HALF + n * 16; gm[bj][n] = *(const f32x4*)(gpre + c) * (*(const f32x4*)(scale + mb + c) + 1.0f); sh[bj][n] = *(const f32x4*)(shift + mb + c); }
#pragma unroll
            for (int ai = 0; ai < 2; ++ai)
#pragma unroll
                for (int m = 0; m < 4; ++m) { const int r = ai * HALF + wr * 64 + m * 16 + fr; const float r2 = rsqrtf(S[r] * (1.0f / D) + EPS); const size_t off = (size_t)(u.pm * BM + r) * D + col0;
#pragma unroll
                    for (int bj = 0; bj < 2; ++bj)
#pragma unroll
                        for (int n = 0; n < 2; ++n) { const f32x4 hv = (acc[ai][bj][m][n] * r2) * gm[bj][n] + sh[bj][n];
                            uint2 w2; w2.x = cvt_pk_bf16(hv[0], hv[1]); w2.y = cvt_pk_bf16(hv[2], hv[3]); *(uint2*)(H + off + bj * HALF + n * 16) = w2; }
                    asm volatile("" ::: "memory"); }
        }
    }
};

template <class Epi, class Sched>
__device__ __forceinline__ void gemm_phase(LAS unsigned char* lds, const Gemm g, const Sched& S, const Epi& E) {
    const int tid = ltid(), wid = __builtin_amdgcn_readfirstlane(tid >> 6), lane = tid & 63, wr = wid >> 2, wc = wid & 3, fr = lane & 15, fq = lane >> 4;
    const int K = g.ld, nt = g.K / BK;
    unsigned voffA[2], voffB[2];
#pragma unroll
    for (int i = 0; i < 2; ++i) { int R, C; stage_rc(tid * 16 + i * 8192, R, C); const int Rb = Epi::PERM ? ((R & ~31) + perm32(R & 31)) : R;
        voffA[i] = (unsigned)(R * K + C) * 2u; voffB[i] = (unsigned)(Rb * K + C) * 2u; }
    const size_t kstep = (size_t)(BK * 2);
    const size_t hstep = (size_t)HALF * K * 2;
    const size_t tstep = 2 * hstep;
    const unsigned ldsw = (unsigned)wid * 1024u;
    const int aoff = lds_byte(wr * 64 + fr, fq * 8), boff = lds_byte(wc * 32 + fr, fq * 8);
#define PG8_SA(b, h) (((b) * 2 + (h)) * HTB)
#define PG8_SB(b, h) ((4 + (b) * 2 + (h)) * HTB)
#define PG8_STAGE(bufoff, gbase, voff) do { _Pragma("unroll") for (int _i = 0; _i < 2; ++_i) \
        __builtin_amdgcn_global_load_lds((const unsigned*)((const char*)(gbase) + (voff)[_i]), (LAS unsigned*)(lds + (bufoff) + ldsw + _i * 8192), 16, 0, 0); } while (0)
#define PG8_LDA(dst, b, h) do { _Pragma("unroll") for (int m = 0; m < 4; ++m) _Pragma("unroll") for (int k = 0; k < 2; ++k) dst[m][k] = *(const LAS bf16x8*)(lds + PG8_SA(b, h) + aoff + m * 2048 + k * 1024); } while (0)
#define PG8_LDB(dst, b, h) do { _Pragma("unroll") for (int n = 0; n < 2; ++n) _Pragma("unroll") for (int k = 0; k < 2; ++k) dst[n][k] = *(const LAS bf16x8*)(lds + PG8_SB(b, h) + boff + n * 2048 + k * 1024); } while (0)
#define PG8_MMA(ai, bj, At, Bt) do { __builtin_amdgcn_s_setprio(1); _Pragma("unroll") for (int m = 0; m < 4; ++m) _Pragma("unroll") for (int n = 0; n < 2; ++n) _Pragma("unroll") for (int k = 0; k < 2; ++k) \
        acc[ai][bj][m][n] = __builtin_amdgcn_mfma_f32_16x16x32_bf16(Bt[n][k], At[m][k], acc[ai][bj][m][n], 0, 0, 0); __builtin_amdgcn_s_setprio(0); } while (0)
#define PG8_WAIT_V(n) asm volatile("s_waitcnt vmcnt(" #n ")" ::: "memory")
#define PG8_WAIT_L(n) asm volatile("s_waitcnt lgkmcnt(" #n ")" ::: "memory")
#define PG8_BAR __builtin_amdgcn_s_barrier()
#define PG8_SCHED __builtin_amdgcn_sched_barrier(0)
    Unit cur, nxt; int ui = 0;
    if (!S.next(0, cur)) return;
    f32x4 acc[2][2][4][2];
#pragma unroll
    for (int a = 0; a < 2; ++a)
#pragma unroll
        for (int b = 0; b < 2; ++b)
#pragma unroll
            for (int m = 0; m < 4; ++m)
#pragma unroll
                for (int n = 0; n < 2; ++n) acc[a][b][m][n] = (f32x4){0.f, 0.f, 0.f, 0.f};
    bf16x8 At[4][2], B0[2][2], B1[2][2];
    const char* cA = (const char*)g.A + (size_t)cur.pm * tstep; const char* cB = (const char*)g.Bt + (size_t)cur.pn * tstep;
    PG8_STAGE(PG8_SB(0, 0), cB, voffB); PG8_STAGE(PG8_SA(0, 0), cA, voffA); PG8_STAGE(PG8_SB(0, 1), cB + hstep, voffB); PG8_STAGE(PG8_SA(0, 1), cA + hstep, voffA);
    if (wr == 1) PG8_BAR;
    PG8_WAIT_V(4); PG8_BAR;
    PG8_STAGE(PG8_SB(1, 0), cB + kstep, voffB); PG8_STAGE(PG8_SA(1, 0), cA + kstep, voffA); PG8_STAGE(PG8_SB(1, 1), cB + hstep + kstep, voffB);
    PG8_WAIT_V(6); PG8_BAR;
    for (;;) {
        const bool has_next = S.next(ui + 1, nxt);
        const char* nA = has_next ? (const char*)g.A + (size_t)nxt.pm * tstep : cA; const char* nB = has_next ? (const char*)g.Bt + (size_t)nxt.pn * tstep : cB;
        for (int t = 0; t < nt; t += 2) {
            const bool last = (t == nt - 2);
            const char* a1 = cA + (size_t)(t + 1) * kstep;
            const char* a2 = last ? nA : cA + (size_t)(t + 2) * kstep; const char* b2 = last ? nB : cB + (size_t)(t + 2) * kstep;
            const char* a3 = a2 + kstep; const char* b3 = b2 + kstep;
            PG8_LDB(B0, 0, 0); PG8_SCHED; PG8_LDA(At, 0, 0); PG8_STAGE(PG8_SA(1, 1), a1 + hstep, voffA);
            PG8_WAIT_L(8); PG8_BAR; PG8_WAIT_L(0); PG8_MMA(0, 0, At, B0); PG8_BAR; PG8_SCHED;
            PG8_LDB(B1, 0, 1); PG8_STAGE(PG8_SB(0, 0), b2, voffB);
            PG8_BAR; PG8_WAIT_L(0); PG8_MMA(0, 1, At, B1); PG8_BAR;
            PG8_LDA(At, 0, 1); PG8_STAGE(PG8_SA(0, 0), a2, voffA);
            PG8_BAR; PG8_WAIT_L(0); PG8_MMA(1, 0, At, B0); PG8_BAR; PG8_SCHED;
            PG8_STAGE(PG8_SB(0, 1), b2 + hstep, voffB);
            PG8_WAIT_V(6); PG8_BAR; PG8_MMA(1, 1, At, B1); PG8_BAR;
            PG8_LDB(B0, 1, 0); PG8_SCHED; PG8_LDA(At, 1, 0); PG8_STAGE(PG8_SA(0, 1), a2 + hstep, voffA);
            PG8_WAIT_L(8); PG8_BAR; PG8_WAIT_L(0); PG8_MMA(0, 0, At, B0); PG8_BAR; PG8_SCHED;
            PG8_LDB(B1, 1, 1); PG8_STAGE(PG8_SB(1, 0), b3, voffB);
            PG8_BAR; PG8_WAIT_L(0); PG8_MMA(0, 1, At, B1); PG8_BAR;
            PG8_LDA(At, 1, 1); PG8_STAGE(PG8_SA(1, 0), a3, voffA);
            PG8_BAR; PG8_WAIT_L(0); PG8_MMA(1, 0, At, B0); PG8_BAR; PG8_SCHED;
            PG8_STAGE(PG8_SB(1, 1), b3 + hstep, voffB);
            PG8_WAIT_V(6); PG8_BAR; PG8_MMA(1, 1, At, B1); PG8_BAR;
        }
        if constexpr (!Epi::AFTER_DRAIN) E(acc, cur, wr, wc, fr, fq);
        if (!has_next) break;
#pragma unroll
        for (int a = 0; a < 2; ++a)
#pragma unroll
            for (int b = 0; b < 2; ++b)
#pragma unroll
                for (int m = 0; m < 4; ++m)
#pragma unroll
                    for (int n = 0; n < 2; ++n) acc[a][b][m][n] = (f32x4){0.f, 0.f, 0.f, 0.f};
        cur = nxt; cA = nA; cB = nB; ++ui;
    }
    PG8_WAIT_V(0);
    if (wr == 0) PG8_BAR;
    PG8_BAR;
    if constexpr (Epi::AFTER_DRAIN) E.fused(acc, cur, wr, wc, fr, fq, lds, wid, lane);
#undef PG8_SA
#undef PG8_SB
#undef PG8_STAGE
#undef PG8_LDA
#undef PG8_LDB
#undef PG8_MMA
#undef PG8_WAIT_V
#undef PG8_WAIT_L
#undef PG8_BAR
#undef PG8_SCHED
}
}

template <class Epi>
__device__ __forceinline__ void run_gemm(unsigned char* smem, const bf16_t* A, const bf16_t* Bt, int M, int N, int K, const Epi& E) {
    pg8::Gemm g{A, Bt, M, N, K, K}; pg8::StaticOrder S; S.init(M, N, (int)gridDim.x, (int)blockIdx.x);
    pg8::gemm_phase<Epi, pg8::StaticOrder>((LAS unsigned char*)smem, g, S, E);
}
__device__ __forceinline__ void run_gemm_f32_split(unsigned char* smem, const bf16_t* A, const bf16_t* Bt, int M, int K, const pg8::EpiFusedRow& EF, float* YP) {
    { pg8::Gemm g{A, Bt, TL, D, K, K}; pg8::StaticOrder S; S.init(TL, D, (int)gridDim.x, (int)blockIdx.x);
      pg8::gemm_phase<pg8::EpiFusedRow, pg8::StaticOrder>((LAS unsigned char*)smem, g, S, EF); }
    __syncthreads();
    if (M > TL && blockIdx.x < 64) {
        const int ks = blockIdx.x >> 4;
        int koff, klen;
        if (K == DFF) { koff = (ks < 2) ? ks * 768 : 1536 + (ks - 2) * 640; klen = (ks < 2) ? 768 : 640; }
        else { klen = K / 4; koff = ks * klen; }
        pg8::Gemm g{A + (size_t)TL * K + koff, Bt + koff, TC, D, klen, K}; pg8::StaticOrder S; S.init(TC, D, 16, (int)(blockIdx.x & 15)); pg8::EpiF32 E{YP + (size_t)ks * TC * D, D};
        pg8::gemm_phase<pg8::EpiF32, pg8::StaticOrder>((LAS unsigned char*)smem, g, S, E);
        __syncthreads();
    }
}

__device__ __forceinline__ float* xrow(const KQ p, int t) { return t < TL ? p.out + (size_t)t * D : (float*)(p.ws + WS_XC) + (size_t)(t - TL) * D; }
__device__ __forceinline__ int modrow(int t) { return t < TL ? (t >> 12) : 4; }
__device__ __forceinline__ const float* modp(const KQ p, int l, int mr, int idx) { return (const float*)(p.ws + WS_MOD) + ((size_t)(l * 5 + mr) * NMOD + idx) * D; }

__device__ __forceinline__ void p0_setup(const KQ p_in, float* sm) {
    const KQ p = lq(p_in);
    const int tid = ltid(), bid = blockIdx.x, nb = gridDim.x;
    const int gtid = bid * 512 + tid, gthreads = nb * 512;
    {
        float* rope = (float*)(p.ws + WS_ROPE);
        for (int idx = gtid; idx < SEQ * 32; idx += gthreads) {
            const int t = idx >> 5, i = idx & 31;
            const int ii = i & 15; const float pos = (i < 16) ? (float)(t >> 6) : (float)(t & 63);
            const float invA = powf(10000.0f, -(float)ii / 16.0f);
            const float angA = pos * invA;
            rope[idx] = cosf(angA); rope[SEQ * 32 + idx] = sinf(angA);
            const float ex = (float)i * (1.0f / 31.0f);
            const float invR = powf(10000.0f, -ex);
            const float angR = (float)t * invR;
            rope[2 * SEQ * 32 + idx] = cosf(angR); rope[3 * SEQ * 32 + idx] = sinf(angR);
        }
    }
    {
        float* tile = sm;
        for (int gs = bid; gs < 20864 / 4; gs += nb) {
            const int g = gs * 4;
            int j, tl;
            if (g < 16896) { j = g / 704; tl = g % 704; }
            else if (g < 18304) { j = 24 + (g - 16896) / 704; tl = (g - 16896) % 704; }
            else if (g < 18816) { j = 26 + (g - 18304) / 256; tl = (g - 18304) % 256; }
            else if (g < 20352) { j = 28 + (g - 18816) / 768; tl = (g - 18816) % 768; }
            else { j = 30 + (g - 20352) / 256; tl = (g - 20352) % 256; }
            const float* src; bf16_t* dst; int K, N, mode = 0;
            if (j < 8) { src = pin_ld(8) + (size_t)j * D * DFF; dst = (bf16_t*)(p.ws + WS_WGU + (size_t)j * SZ_WGU); K = D; N = DFF; mode = 1; }
            else if (j < 16) { src = pin_ld(9) + (size_t)(j - 8) * D * DFF; dst = (bf16_t*)(p.ws + WS_WGU + (size_t)(j - 8) * SZ_WGU); K = D; N = DFF; mode = 2; }
            else if (j < 24) { src = pin_ld(10) + (size_t)(j - 16) * DFF * D; dst = (bf16_t*)(p.ws + WS_WD + (size_t)(j - 16) * SZ_WD); K = DFF; N = D; }
            else if (j < 26) { src = pin_ld(11) + (size_t)(j - 24) * D * INW; dst = (bf16_t*)(p.ws + WS_WIN + (size_t)(j - 24) * SZ_WIN); K = D; N = INW; mode = 3; }
            else if (j < 28) { src = pin_ld(14) + (size_t)(j - 26) * D * D; dst = (bf16_t*)(p.ws + WS_WOUT + (size_t)(j - 26) * SZ_WOUT); K = D; N = D; }
            else if (j < 30) { src = pin_ld(15) + (size_t)(j - 28) * D * HYW; dst = (bf16_t*)(p.ws + WS_HWIN + (size_t)(j - 28) * SZ_HWIN); K = D; N = HYW; }
            else { src = pin_ld(28) + (size_t)(j - 30) * D * D; dst = (bf16_t*)(p.ws + WS_HWOUT + (size_t)(j - 30) * SZ_WOUT); K = D; N = D; }
            const int ntn = N / 64; const int k0 = (tl / ntn) * 64, n0 = (tl % ntn) * 64;
            f32x4 ld[8];
#pragma unroll
            for (int i = 0; i < 8; ++i) ld[i] = *(const f32x4*)(src + (size_t)(k0 + i * 8 + (tid >> 6)) * N + n0 + (tid & 63) * 4);
            __syncthreads();
#pragma unroll
            for (int i = 0; i < 8; ++i) *(f32x4*)(tile + (i * 8 + (tid >> 6)) * 260 + (tid & 63) * 4) = ld[i];
            __syncthreads();
            {
                const int n = tid >> 1, kh = (tid & 1) * 32; const int gn = n0 + n;
                float sc_ = 1.0f; int row = gn;
                if (mode == 1) row = 256 * (gn >> 7) + (gn & 127);
                else if (mode == 2) row = 256 * (gn >> 7) + 128 + (gn & 127);
                else if (mode == 3) { if (gn < 512 || (gn >= 1792 && gn < 2304)) sc_ = 0.125f; }
#pragma unroll
                for (int q = 0; q < 4; ++q) {
                    float v[8];
#pragma unroll
                    for (int jj = 0; jj < 8; ++jj) v[jj] = tile[(kh + q * 8 + jj) * 260 + n] * sc_;
                    u32x4 o4; o4.x = pg8::cvt_pk_bf16(v[0], v[1]); o4.y = pg8::cvt_pk_bf16(v[2], v[3]); o4.z = pg8::cvt_pk_bf16(v[4], v[5]); o4.w = pg8::cvt_pk_bf16(v[6], v[7]);
                    *(u32x4*)(dst + (size_t)row * K + k0 + kh + q * 8) = o4;
                }
            }
        }
        __syncthreads();
    }
    {
        float* sc = sm;
        float* red = sm + 5 * 1024;
        for (int i = tid; i < 5 * 1024; i += 512) { const int r = i >> 10, k = i & 1023; const float v = (r < 4) ? pin_ld(1)[r * D + k] : pin_ld(3)[k]; sc[i] = silu_f(v); }
        __syncthreads();
        const int w = tid >> 6, lane = tid & 63;
        for (int it = bid; it < 288; it += nb) {
            const int l = it / 72, c0 = (it % 72) * 128;
            const float* wm = pin_ld(4) + (size_t)l * D * (NMOD * D) + c0 + 2 * lane;
            float a[5][2];
#pragma unroll
            for (int r = 0; r < 5; ++r) { a[r][0] = 0.f; a[r][1] = 0.f; }
            for (int kb = w * 128; kb < w * 128 + 128; kb += 16) {
                float2 wv[16];
#pragma unroll
                for (int q = 0; q < 16; ++q) wv[q] = *(const float2*)(wm + (size_t)(kb + q) * (NMOD * D));
#pragma unroll
                for (int q = 0; q < 16; ++q)
#pragma unroll
                    for (int r = 0; r < 5; ++r) { const float s = sc[r * 1024 + kb + q]; a[r][0] += s * wv[q].x; a[r][1] += s * wv[q].y; }
            }
#pragma unroll
            for (int r = 0; r < 5; ++r) { red[(w * 5 + r) * 128 + 2 * lane] = a[r][0]; red[(w * 5 + r) * 128 + 2 * lane + 1] = a[r][1]; }
            __syncthreads();
            for (int i = tid; i < 5 * 128; i += 512) {
                const int r = i >> 7, c = i & 127; float s = 0.f;
#pragma unroll
                for (int ww = 0; ww < 8; ++ww) s += red[(ww * 5 + r) * 128 + c];
                s += pin_ld(5)[(size_t)l * (NMOD * D) + c0 + c];
                ((float*)(p.ws + WS_MOD))[(size_t)(l * 5 + r) * (NMOD * D) + c0 + c] = s;
            }
            __syncthreads();
        }
    }
    {
        float* z = sm;
        float* a1 = sm + 16 * 36;
        float* a2 = a1 + 16 * 64;
        float* a3 = a2 + 16 * 64;
        float* tl = a3 + 16 * 64;
        float* wl = tl + 16;
        const float HMAX = -4.605170185988091f / 0.3f, HMIN = -4.605170185988091f / 1.5f;
        int o_loaded = -1;
        for (int it = nb - 1 - bid; it < 544; it += nb) {
            const int o = it / 272, r = it % 272;
            const int Lf = (r < 256) ? SEQ : CL; const int p0 = (r < 256) ? r * 16 : (r - 256) * 16;
            float* kf = (float*)(p.ws + WS_KF + (size_t)o * SZ_KF) + ((r < 256) ? (size_t)0 : (size_t)2 * SEQ * D);
            const float* f3 = pin_ld(25) + (size_t)o * 64 * 2048;
            __syncthreads();
            if (o != o_loaded) {
                const float* f0 = pin_ld(19) + (size_t)o * 33 * 64; const float* f1 = pin_ld(21) + (size_t)o * 64 * 64; const float* f2 = pin_ld(23) + (size_t)o * 64 * 64;
                for (int i = tid; i < 33 * 64; i += 512) wl[i] = f0[i];
                for (int i = tid; i < 64 * 64; i += 512) { wl[2112 + i] = f1[i]; wl[2112 + 4096 + i] = f2[i]; }
                if (tid < 64) { wl[10304 + tid] = pin_ld(20)[o * 64 + tid]; wl[10304 + 64 + tid] = pin_ld(22)[o * 64 + tid]; wl[10304 + 128 + tid] = pin_ld(24)[o * 64 + tid]; wl[10304 + 192 + tid] = pin_ld(26)[o * 64 + tid]; }
                o_loaded = o;
            }
            const float* f0 = wl; const float* f1 = wl + 2112; const float* f2 = wl + 2112 + 4096;
            const float* fb0 = wl + 10304; const float* fb1 = fb0 + 64; const float* fb2 = fb0 + 128; const float* fq = fb0 + 192;
            for (int idx = tid; idx < 16 * 33; idx += 512) {
                const int ps = idx / 33, f = idx % 33; const int i = p0 + ps;
                const float tlin = (float)i * (1.0f / (float)(Lf - 1));
                const float w = (6.283185307179586f * (float)i) / (float)Lf;
                float v;
                if (f == 0) { v = tlin; tl[ps] = tlin; }
                else { const int jj = (f - 1) & 15; const float fj = 1e-4f + (float)jj * ((15.0f - 1e-4f) / 15.0f); v = (f <= 16) ? cosf(fj * w) : -sinf(fj * w); }
                z[ps * 36 + f] = v;
            }
            __syncthreads();
            for (int idx = tid; idx < 16 * 64; idx += 512) { const int ps = idx >> 6, oc = idx & 63; float s = fb0[oc];
                for (int f = 0; f < 33; ++f) s += z[ps * 36 + f] * f0[f * 64 + oc];
                a1[idx] = sinf(fq[oc] * s); }
            __syncthreads();
            for (int idx = tid; idx < 16 * 64; idx += 512) { const int ps = idx >> 6, oc = idx & 63; float s = fb1[oc];
                for (int f = 0; f < 64; ++f) s += a1[ps * 64 + f] * f1[f * 64 + oc];
                a2[idx] = sinf(fq[oc] * s); }
            __syncthreads();
            for (int idx = tid; idx < 16 * 64; idx += 512) { const int ps = idx >> 6, oc = idx & 63; float s = fb2[oc];
                for (int f = 0; f < 64; ++f) s += a2[ps * 64 + f] * f2[f * 64 + oc];
                a3[oc * 16 + ps] = sinf(fq[oc] * s); }
            __syncthreads();
            {
                float acc[4][16];
#pragma unroll
                for (int q = 0; q < 4; ++q)
#pragma unroll
                    for (int ps = 0; ps < 16; ++ps) acc[q][ps] = 0.f;
                for (int fb = 0; fb < 64; fb += 4) {
                    float wv[4][4];
#pragma unroll
                    for (int f = 0; f < 4; ++f)
#pragma unroll
                        for (int q = 0; q < 4; ++q) wv[f][q] = f3[(fb + f) * 2048 + tid + 512 * q];
#pragma unroll
                    for (int f = 0; f < 4; ++f) {
                        const f32x4 av0 = *(const f32x4*)(a3 + (fb + f) * 16), av1 = *(const f32x4*)(a3 + (fb + f) * 16 + 4), av2 = *(const f32x4*)(a3 + (fb + f) * 16 + 8), av3 = *(const f32x4*)(a3 + (fb + f) * 16 + 12);
#pragma unroll
                        for (int q = 0; q < 4; ++q)
#pragma unroll
                            for (int e = 0; e < 4; ++e) { acc[q][e] += av0[e] * wv[f][q]; acc[q][4 + e] += av1[e] * wv[f][q]; acc[q][8 + e] += av2[e] * wv[f][q]; acc[q][12 + e] += av3[e] * wv[f][q]; }
                    }
                }
#pragma unroll
                for (int q = 0; q < 4; ++q) {
                    const int c = tid + 512 * q; const int dir = c >> 10, d = c & 1023;
                    const float delta = fabsf(HMIN + (float)d * ((HMAX - HMIN) / 1023.0f));
                    float kv[16];
#pragma unroll
                    for (int ps = 0; ps < 16; ++ps) kv[ps] = acc[q][ps] * expf(-tl[ps] * delta);
                    if (r < 256) {
                        bf16_t* rk = (bf16_t*)(p.ws + WS_KF + (size_t)o * SZ_KF) + (size_t)d * 8192;
                        if (dir == 0) {
                            u32x4 w0, w1;
                            w0.x = pg8::cvt_pk_bf16(kv[15], kv[14]); w0.y = pg8::cvt_pk_bf16(kv[13], kv[12]); w0.z = pg8::cvt_pk_bf16(kv[11], kv[10]); w0.w = pg8::cvt_pk_bf16(kv[9], kv[8]);
                            w1.x = pg8::cvt_pk_bf16(kv[7], kv[6]); w1.y = pg8::cvt_pk_bf16(kv[5], kv[4]); w1.z = pg8::cvt_pk_bf16(kv[3], kv[2]); w1.w = pg8::cvt_pk_bf16(kv[1], kv[0]);
                            *(u32x4*)(rk + 4080 - p0) = w0; *(u32x4*)(rk + 4088 - p0) = w1;
                            if (p0 == 0) rk[8191] = 0;
                        } else {
                            if (p0 > 0) rk[4095 + p0] = f2bf(kv[0]);
                            u32x4 w0; w0.x = pg8::cvt_pk_bf16(kv[1], kv[2]); w0.y = pg8::cvt_pk_bf16(kv[3], kv[4]); w0.z = pg8::cvt_pk_bf16(kv[5], kv[6]); w0.w = pg8::cvt_pk_bf16(kv[7], kv[8]);
                            *(u32x4*)(rk + 4096 + p0) = w0;
                            uint2 w1; w1.x = pg8::cvt_pk_bf16(kv[9], kv[10]); w1.y = pg8::cvt_pk_bf16(kv[11], kv[12]);
                            *(uint2*)(rk + 4104 + p0) = w1;
                            *(unsigned*)(rk + 4108 + p0) = pg8::cvt_pk_bf16(kv[13], kv[14]);
                            rk[4110 + p0] = f2bf(kv[15]);
                        }
                    } else {
#pragma unroll
                        for (int ps = 0; ps < 16; ++ps) kf[((size_t)dir * Lf + p0 + ps) * D + d] = kv[ps];
                    }
                }
            }
        }
        __syncthreads();
    }
}

__device__ __forceinline__ void rowphase(const KQ p_in, int Mupd, const bf16_t* Y, int lu, int gidx, float wgt, const float* gpost,
                         int Mnext, int ln, const float* gpre, int shidx, int scidx, bf16_t* Hout, bool from_input, int tbeg) {
    const KQ p = lq(p_in);
    const int tid = ltid(), w = tid >> 6, lane = tid & 63;
    const int Mmax = Mupd > Mnext ? Mupd : Mnext;
    for (int t = tbeg + (blockIdx.x * 8 + w) * 2; t < Mmax; t += gridDim.x * 16) {
        float* xr = xrow(p, t); const int mr = modrow(t);
        const float* xs = xr;
        if (from_input) xs = (t < TL) ? pin_ld(0) + (size_t)t * D : pin_ld(2) + (size_t)(t - TL) * D;
        float4 xv[2][4];
#pragma unroll
        for (int rr = 0; rr < 2; ++rr)
#pragma unroll
            for (int q = 0; q < 4; ++q) xv[rr][q] = *(const float4*)(xs + rr * D + q * 256 + lane * 4);
        if (Y != nullptr && t < Mupd) {
            float4 yv[2][4]; float ss[2] = {0.f, 0.f};
#pragma unroll
            for (int rr = 0; rr < 2; ++rr)
#pragma unroll
                for (int q = 0; q < 4; ++q) {
                    if (t < TL) { const bf16x4 yb = *(const bf16x4*)(Y + (size_t)(t + rr) * D + q * 256 + lane * 4);
                        yv[rr][q] = make_float4(bf2f((bf16_t)yb[0]), bf2f((bf16_t)yb[1]), bf2f((bf16_t)yb[2]), bf2f((bf16_t)yb[3])); }
                    else { const float* yp = (const float*)(p.ws + WS_YP) + (size_t)(t + rr - TL) * D + q * 256 + lane * 4;
                        const float4 a0 = *(const float4*)yp, a1 = *(const float4*)(yp + (size_t)TC * D), a2 = *(const float4*)(yp + (size_t)2 * TC * D), a3 = *(const float4*)(yp + (size_t)3 * TC * D);
                        yv[rr][q] = make_float4(a0.x + a1.x + a2.x + a3.x, a0.y + a1.y + a2.y + a3.y, a0.z + a1.z + a2.z + a3.z, a0.w + a1.w + a2.w + a3.w); }
                    ss[rr] += yv[rr][q].x * yv[rr][q].x + yv[rr][q].y * yv[rr][q].y + yv[rr][q].z * yv[rr][q].z + yv[rr][q].w * yv[rr][q].w; }
            ss[0] = wave_sum(ss[0]); ss[1] = wave_sum(ss[1]);
            float wgl = wgt; asm volatile("" : "+v"(wgl));
            const float r0 = rsqrtf(ss[0] * (1.0f / D) + EPS) * wgl, r1 = rsqrtf(ss[1] * (1.0f / D) + EPS) * wgl;
            const float* gm = modp(p, lu, mr, gidx);
#pragma unroll
            for (int q = 0; q < 4; ++q) {
                const float4 g4 = *(const float4*)(gm + q * 256 + lane * 4); const float4 p4 = *(const float4*)(gpost + q * 256 + lane * 4);
                const float cx = g4.x * p4.x, cy = g4.y * p4.y, cz = g4.z * p4.z, cw = g4.w * p4.w;
                xv[0][q].x += r0 * cx * yv[0][q].x; xv[0][q].y += r0 * cy * yv[0][q].y; xv[0][q].z += r0 * cz * yv[0][q].z; xv[0][q].w += r0 * cw * yv[0][q].w;
                xv[1][q].x += r1 * cx * yv[1][q].x; xv[1][q].y += r1 * cy * yv[1][q].y; xv[1][q].z += r1 * cz * yv[1][q].z; xv[1][q].w += r1 * cw * yv[1][q].w;
                *(float4*)(xr + q * 256 + lane * 4) = xv[0][q]; *(float4*)(xr + D + q * 256 + lane * 4) = xv[1][q];
            }
        }
        if (Hout != nullptr && t < Mnext) {
            float ss[2] = {0.f, 0.f};
#pragma unroll
            for (int rr = 0; rr < 2; ++rr)
#pragma unroll
                for (int q = 0; q < 4; ++q) ss[rr] += xv[rr][q].x * xv[rr][q].x + xv[rr][q].y * xv[rr][q].y + xv[rr][q].z * xv[rr][q].z + xv[rr][q].w * xv[rr][q].w;
            ss[0] = wave_sum(ss[0]); ss[1] = wave_sum(ss[1]);
            const float rn[2] = {rsqrtf(ss[0] * (1.0f / D) + EPS), rsqrtf(ss[1] * (1.0f / D) + EPS)};
            const float* sh = modp(p, ln, mr, shidx); const float* sc = modp(p, ln, mr, scidx);
#pragma unroll
            for (int q = 0; q < 4; ++q) {
                const float4 g4 = *(const float4*)(gpre + q * 256 + lane * 4); const float4 s4 = *(const float4*)(sc + q * 256 + lane * 4); const float4 h4 = *(const float4*)(sh + q * 256 + lane * 4);
                const float mx_ = g4.x * (1.0f + s4.x), my_ = g4.y * (1.0f + s4.y), mz_ = g4.z * (1.0f + s4.z), mw_ = g4.w * (1.0f + s4.w);
#pragma unroll
                for (int rr = 0; rr < 2; ++rr) {
                    const float h0 = xv[rr][q].x * rn[rr] * mx_ + h4.x, h1 = xv[rr][q].y * rn[rr] * my_ + h4.y;
                    const float h2 = xv[rr][q].z * rn[rr] * mz_ + h4.z, h3 = xv[rr][q].w * rn[rr] * mw_ + h4.w;
                    uint2 pk; pk.x = pg8::cvt_pk_bf16(h0, h1); pk.y = pg8::cvt_pk_bf16(h2, h3);
                    *(uint2*)(Hout + (size_t)(t + rr) * D + q * 256 + lane * 4) = pk;
                }
            }
        }
    }
}

__device__ __forceinline__ float log_sigmoid(float x) { return -log1pf(expf(-x)); }
__device__ __forceinline__ int chunk_t0(int b, int cidx) { return cidx < 32 ? b * SEQ + cidx * 128 : TL + b * CL + (cidx - 32) * 128; }

__device__ __forceinline__ void m1_rope_states(const KQ p_in, int e, float* sm) {
    const KQ p = lq(p_in);
    const int tid = ltid(), bid = blockIdx.x, nb = gridDim.x;
    bf16_t* Z = (bf16_t*)(p.ws + WS_BIG);
    const float* rope = (const float*)(p.ws + WS_ROPE);
    for (int base = bid * 512 + tid; base < TL * 72; base += 2 * nb * 512) {
        bf16_t* zp[2]; bf16x8 a1[2], a2[2]; f32x4 c0[2], c1[2], s0[2], s1[2]; bool ok[2];
#pragma unroll
        for (int u = 0; u < 2; ++u) {
            const int idx = base + u * nb * 512; ok[u] = idx < TL * 72; const int ix = ok[u] ? idx : base;
            const int t = ix / 72, r = ix % 72; const int hd = r >> 2, i0 = (r & 3) * 8;
            const int cb = hd < 16 ? hd * 64 : 1536 + (hd - 16) * 64;
            const int tb = (hd >= 8 && hd < 16) ? 2 : 0; const int pos = t & (SEQ - 1);
            const float* cp = rope + (size_t)tb * SEQ * 32 + pos * 32 + i0; const float* sp = cp + (size_t)SEQ * 32;
            zp[u] = Z + (size_t)t * INW + cb + i0;
            a1[u] = *(const bf16x8*)zp[u]; a2[u] = *(const bf16x8*)(zp[u] + 32);
            c0[u] = *(const f32x4*)cp; c1[u] = *(const f32x4*)(cp + 4); s0[u] = *(const f32x4*)sp; s1[u] = *(const f32x4*)(sp + 4);
        }
#pragma unroll
        for (int u = 0; u < 2; ++u) {
            if (!ok[u]) continue;
            float o1[8], o2[8];
#pragma unroll
            for (int j = 0; j < 8; ++j) { const float x1 = bf2f((bf16_t)a1[u][j]), x2 = bf2f((bf16_t)a2[u][j]); const float cc = j < 4 ? c0[u][j & 3] : c1[u][j & 3], sn = j < 4 ? s0[u][j & 3] : s1[u][j & 3];
                o1[j] = x1 * cc - x2 * sn; o2[j] = x1 * sn + x2 * cc; }
            u32x4 w1, w2;
            w1.x = pg8::cvt_pk_bf16(o1[0], o1[1]); w1.y = pg8::cvt_pk_bf16(o1[2], o1[3]); w1.z = pg8::cvt_pk_bf16(o1[4], o1[5]); w1.w = pg8::cvt_pk_bf16(o1[6], o1[7]);
            w2.x = pg8::cvt_pk_bf16(o2[0], o2[1]); w2.y = pg8::cvt_pk_bf16(o2[2], o2[3]); w2.z = pg8::cvt_pk_bf16(o2[4], o2[5]); w2.w = pg8::cvt_pk_bf16(o2[6], o2[7]);
            *(u32x4*)zp[u] = w1; *(u32x4*)(zp[u] + 32) = w2;
        }
    }
    float* Ks = sm;
    float* Vs = sm + 128 * 64;
    float* wf = Vs + 128 * 64;
    float* wb = wf + 128;
    float* AF = (float*)(p.ws + WS_ST); float* AB = AF + SZ_ST / 4;
    const float* dec = pin_ld(13) + e * 16;
    for (int it = bid; it < NB * NCH * 8; it += nb) {
        const int h = it & 7, cidx = (it >> 3) % NCH, b = it / (8 * NCH);
        const int t0 = chunk_t0(b, cidx); const bool lat = cidx < 32;
        const float lgf = log_sigmoid(dec[h]), lgb = log_sigmoid(dec[8 + h]);
        __syncthreads();
        if (tid < 128) { wf[tid] = expf(lgf * (float)(127 - tid)); wb[tid] = expf(lgb * (float)tid); }
        const int kc = 1792 + h * 64, vc = 2304 + h * 64;
        {
            const int r = tid >> 2, pq = tid & 3;
            bf16_t* zp = Z + (size_t)(t0 + r) * INW + kc + 8 * pq;
            const bf16x8 a1 = *(const bf16x8*)zp, a2 = *(const bf16x8*)(zp + 32);
            float o1[8], o2[8];
            if (lat) {
                const int pos = (t0 + r) & (SEQ - 1);
                const float* cp = rope + (size_t)2 * SEQ * 32 + pos * 32 + 8 * pq; const float* sp = cp + (size_t)SEQ * 32;
                const f32x4 c0 = *(const f32x4*)cp, c1 = *(const f32x4*)(cp + 4), s0 = *(const f32x4*)sp, s1 = *(const f32x4*)(sp + 4);
#pragma unroll
                for (int j = 0; j < 8; ++j) { const float x1 = bf2f((bf16_t)a1[j]), x2 = bf2f((bf16_t)a2[j]); const float cc = j < 4 ? c0[j & 3] : c1[j & 3], sn = j < 4 ? s0[j & 3] : s1[j & 3];
                    o1[j] = bf2f(f2bf(x1 * cc - x2 * sn)); o2[j] = bf2f(f2bf(x1 * sn + x2 * cc)); }
                u32x4 w1, w2;
                w1.x = pg8::cvt_pk_bf16(o1[0], o1[1]); w1.y = pg8::cvt_pk_bf16(o1[2], o1[3]); w1.z = pg8::cvt_pk_bf16(o1[4], o1[5]); w1.w = pg8::cvt_pk_bf16(o1[6], o1[7]);
                w2.x = pg8::cvt_pk_bf16(o2[0], o2[1]); w2.y = pg8::cvt_pk_bf16(o2[2], o2[3]); w2.z = pg8::cvt_pk_bf16(o2[4], o2[5]); w2.w = pg8::cvt_pk_bf16(o2[6], o2[7]);
                *(u32x4*)zp = w1; *(u32x4*)(zp + 32) = w2;
            } else {
#pragma unroll
                for (int j = 0; j < 8; ++j) { o1[j] = bf2f((bf16_t)a1[j]); o2[j] = bf2f((bf16_t)a2[j]); }
            }
            *(f32x4*)(Ks + r * 64 + 8 * pq) = (f32x4){o1[0], o1[1], o1[2], o1[3]}; *(f32x4*)(Ks + r * 64 + 8 * pq + 4) = (f32x4){o1[4], o1[5], o1[6], o1[7]};
            *(f32x4*)(Ks + r * 64 + 32 + 8 * pq) = (f32x4){o2[0], o2[1], o2[2], o2[3]}; *(f32x4*)(Ks + r * 64 + 32 + 8 * pq + 4) = (f32x4){o2[4], o2[5], o2[6], o2[7]};
        }
#pragma unroll
        for (int q = 0; q < 2; ++q) { const int idx = tid + 512 * q; const int r = idx >> 3, pc = idx & 7;
            const bf16x8 vv = *(const bf16x8*)(Z + (size_t)(t0 + r) * INW + vc + 8 * pc);
            *(f32x4*)(Vs + r * 64 + 8 * pc) = (f32x4){bf2f((bf16_t)vv[0]), bf2f((bf16_t)vv[1]), bf2f((bf16_t)vv[2]), bf2f((bf16_t)vv[3])};
            *(f32x4*)(Vs + r * 64 + 8 * pc + 4) = (f32x4){bf2f((bf16_t)vv[4]), bf2f((bf16_t)vv[5]), bf2f((bf16_t)vv[6]), bf2f((bf16_t)vv[7])}; }
        __syncthreads();
        const int d = tid >> 3, e0 = (tid & 7) * 8;
        float af[8], ab[8];
#pragma unroll
        for (int j = 0; j < 8; ++j) { af[j] = 0.f; ab[j] = 0.f; }
        for (int s = 0; s < 128; ++s) {
            const float kv = Ks[s * 64 + d]; const float kfw = kv * wf[s], kbw = kv * wb[s];
            const float4 v0 = *(const float4*)(Vs + s * 64 + e0), v1 = *(const float4*)(Vs + s * 64 + e0 + 4);
            af[0] += kfw * v0.x; af[1] += kfw * v0.y; af[2] += kfw * v0.z; af[3] += kfw * v0.w; af[4] += kfw * v1.x; af[5] += kfw * v1.y; af[6] += kfw * v1.z; af[7] += kfw * v1.w;
            ab[0] += kbw * v0.x; ab[1] += kbw * v0.y; ab[2] += kbw * v0.z; ab[3] += kbw * v0.w; ab[4] += kbw * v1.x; ab[5] += kbw * v1.y; ab[6] += kbw * v1.z; ab[7] += kbw * v1.w;
        }
        const size_t so = ((size_t)(b * NCH + cidx) * 8 + h) * 4096 + d * 64 + e0;
        *(float4*)(AF + so) = make_float4(af[0], af[1], af[2], af[3]); *(float4*)(AF + so + 4) = make_float4(af[4], af[5], af[6], af[7]);
        *(float4*)(AB + so) = make_float4(ab[0], ab[1], ab[2], ab[3]); *(float4*)(AB + so + 4) = make_float4(ab[4], ab[5], ab[6], ab[7]);
    }
    __syncthreads();
}

__device__ __forceinline__ void m2_scan(const KQ p_in, int e) {
    const KQ p = lq(p_in);
    const float* __restrict__ AF = (const float*)(p.ws + WS_ST); const float* __restrict__ AB = AF + SZ_ST / 4;
    float* __restrict__ TF = (float*)(p.ws + WS_ST) + 2 * (SZ_ST / 4); float* __restrict__ TB = TF + SZ_ST / 4;
    const float* dec = pin_ld(13) + e * 16;
    for (int idx = blockIdx.x * 512 + ltid(); idx < NB * 8 * 4096; idx += gridDim.x * 512) {
        const int el = idx & 4095, h = (idx >> 12) & 7, b = idx >> 15;
        const float gf = expf(log_sigmoid(dec[h]) * 128.0f), gb = expf(log_sigmoid(dec[8 + h]) * 128.0f);
        const size_t base = ((size_t)(b * NCH) * 8 + h) * 4096 + el; constexpr size_t CS = (size_t)8 * 4096;
        float af[NCH], ab[NCH];
#pragma unroll
        for (int c = 0; c < NCH; ++c) { af[c] = AF[base + c * CS]; ab[c] = AB[base + c * CS]; }
        TF[base + 32 * CS] = 0.f; TF[base + 33 * CS] = af[32]; TB[base + 33 * CS] = 0.f; TB[base + 32 * CS] = ab[33];
        float sf = gf * af[32] + af[33], sb = ab[32] + gb * ab[33];
#pragma unroll
        for (int c = 0; c < 32; ++c) { TF[base + c * CS] = sf; sf = gf * sf + af[c]; }
#pragma unroll
        for (int c = 31; c >= 0; --c) { TB[base + c * CS] = sb; sb = ab[c] + gb * sb; }
    }
}

__device__ __forceinline__ bf16x8 pack8(const f32x4& a, const f32x4& b) {
    u32x4 w; w.x = pg8::cvt_pk_bf16(a[0], a[1]); w.y = pg8::cvt_pk_bf16(a[2], a[3]); w.z = pg8::cvt_pk_bf16(b[0], b[1]); w.w = pg8::cvt_pk_bf16(b[2], b[3]);
    return __builtin_bit_cast(bf16x8, w);
}
__device__ __forceinline__ void m3_outputs(const KQ p_in, int e, bool ctx_full, unsigned char* smem, unsigned* scan_word) {
    const KQ p = lq(p_in);
    m2_scan(p, e);
    sub_arrive(scan_word);
    bool scan_ready = false;
    const int tid = ltid(), bid = blockIdx.x, nb = gridDim.x;
    const int w = tid >> 6, lane = tid & 63, ln = lane & 15, g4 = lane >> 4;
    const bf16_t* Z = (const bf16_t*)(p.ws + WS_BIG);
    bf16_t* MIX = (bf16_t*)(p.ws + WS_MIX);
    const float* dec = pin_ld(13) + e * 16;
    const float* sink = pin_ld(12) + e * 8;
    const float* TF = (const float*)(p.ws + WS_ST) + 2 * (SZ_ST / 4); const float* TB = TF + SZ_ST / 4;
    const int nchunk = ctx_full ? NCH : 32;
    const int nitems = NB * nchunk * 8;
    bf16_t* Kt = (bf16_t*)smem;
    bf16_t* Vt = Kt + 128 * 72;
    bf16_t* TfT = Vt + 64 * 136;
    bf16_t* TbT = TfT + 64 * 72;
    const int i = 16 * w + ln;
    for (int it = bid; it < 2 * nitems; it += nb) {
        const bool is_attn = it < nitems; const int ii = is_attn ? it : it - nitems;
        const int h = (ii >> 3) & 7, cbx = (ii >> 6) * 8 + (ii & 7), cidx = cbx % nchunk, b = cbx / nchunk;
        if (!is_attn && !scan_ready) { sub_wait(scan_word, gridDim.x); scan_ready = true; }
        const int t0 = chunk_t0(b, cidx); const bool lat = cidx < 32;
        f32x4 O[4];
#pragma unroll
        for (int m = 0; m < 4; ++m) O[m] = (f32x4){0.f, 0.f, 0.f, 0.f};
        if (!is_attn) {
            const float lgf = log_sigmoid(dec[h]), lgb = log_sigmoid(dec[8 + h]);
            __syncthreads();
#pragma unroll
            for (int q = 0; q < 2; ++q) { const int idx = tid + 512 * q; const int r = idx >> 3, pc = idx & 7; const bf16_t* zr = Z + (size_t)(t0 + r) * INW + h * 64 + pc * 8;
                *(u32x4*)(Kt + r * 72 + pc * 8) = *(const u32x4*)(zr + 1792);
                const bf16x8 vv = *(const bf16x8*)(zr + 2304);
#pragma unroll
                for (int j = 0; j < 8; ++j) Vt[(pc * 8 + j) * 136 + (r ^ (pc << 2))] = (bf16_t)vv[j]; }
            const size_t so = ((size_t)(b * NCH + cidx) * 8 + h) * 4096;
            {
                const int ee = tid & 63, d0 = (tid >> 6) * 8;
                float tf[8], tb[8];
#pragma unroll
                for (int j = 0; j < 8; ++j) { tf[j] = TF[so + (d0 + j) * 64 + ee]; tb[j] = TB[so + (d0 + j) * 64 + ee]; }
                u32x4 wf4, wb4;
                wf4.x = pg8::cvt_pk_bf16(tf[0], tf[1]); wf4.y = pg8::cvt_pk_bf16(tf[2], tf[3]); wf4.z = pg8::cvt_pk_bf16(tf[4], tf[5]); wf4.w = pg8::cvt_pk_bf16(tf[6], tf[7]);
                wb4.x = pg8::cvt_pk_bf16(tb[0], tb[1]); wb4.y = pg8::cvt_pk_bf16(tb[2], tb[3]); wb4.z = pg8::cvt_pk_bf16(tb[4], tb[5]); wb4.w = pg8::cvt_pk_bf16(tb[6], tb[7]);
                *(u32x4*)(TfT + ee * 72 + d0) = wf4; *(u32x4*)(TbT + ee * 72 + d0) = wb4;
            }
            __builtin_amdgcn_sched_barrier(0);
            bf16x8 qf[2], qff[2], qfb[2];
            { const bf16_t* qr = Z + (size_t)(t0 + i) * INW + 512 + h * 64 + 8 * g4;
              const float cf = __expf(lgf * (float)(i + 1)), cb = __expf(lgb * (float)(128 - i));
#pragma unroll
              for (int k2 = 0; k2 < 2; ++k2) { qf[k2] = *(const bf16x8*)(qr + 32 * k2);
                  f32x4 a0, a1, b0, b1;
#pragma unroll
                  for (int j = 0; j < 4; ++j) { const float x0 = bf2f((bf16_t)qf[k2][j]), x1 = bf2f((bf16_t)qf[k2][4 + j]); a0[j] = x0 * cf; a1[j] = x1 * cf; b0[j] = x0 * cb; b1[j] = x1 * cb; }
                  qff[k2] = pack8(a0, a1); qfb[k2] = pack8(b0, b1); } }
            __builtin_amdgcn_sched_barrier(0);
            __syncthreads();
#pragma unroll
            for (int m = 0; m < 4; ++m)
#pragma unroll
                for (int k2 = 0; k2 < 2; ++k2) {
                    const bf16x8 af = *(const bf16x8*)(TfT + (16 * m + ln) * 72 + 32 * k2 + 8 * g4);
                    const bf16x8 ab = *(const bf16x8*)(TbT + (16 * m + ln) * 72 + 32 * k2 + 8 * g4);
                    O[m] = __builtin_amdgcn_mfma_f32_16x16x32_bf16(af, qff[k2], O[m], 0, 0, 0);
                    O[m] = __builtin_amdgcn_mfma_f32_16x16x32_bf16(ab, qfb[k2], O[m], 0, 0, 0);
                    __builtin_amdgcn_sched_barrier(0);
                }
            const float lf2 = lgf * 1.44269504f, lb2 = lgb * 1.44269504f; const int di = i - 4 * g4;
            const float bfw = lf2 * (float)di, bbw = -lb2 * (float)di;
            f32x4 st[8];
#pragma unroll
            for (int mt = 0; mt < 8; ++mt) {
                f32x4 a = (f32x4){0.f, 0.f, 0.f, 0.f};
#pragma unroll
                for (int k2 = 0; k2 < 2; ++k2) { const bf16x8 kf = *(const bf16x8*)(Kt + (16 * mt + ln) * 72 + 32 * k2 + 8 * g4); a = __builtin_amdgcn_mfma_f32_16x16x32_bf16(kf, qf[k2], a, 0, 0, 0); }
#pragma unroll
                for (int rg = 0; rg < 4; ++rg) { const int cc = 16 * mt + rg; const int df = di - cc;
                    const float arg = (df > 0) ? fmaf(-lf2, (float)cc, bfw) : fmaf(lb2, (float)cc, bbw);
                    float wgt = __builtin_amdgcn_exp2f(arg); wgt = (df == 0) ? 2.0f : wgt;
                    a[rg] *= wgt; }
                st[mt] = a;
                __builtin_amdgcn_sched_barrier(0);
            }
#pragma unroll
            for (int ks = 0; ks < 4; ++ks) {
                const bf16x8 pfr = pack8(st[2 * ks], st[2 * ks + 1]);
#pragma unroll
                for (int m = 0; m < 4; ++m) {
                    const int vrow = 16 * m + ln; const int kx = (32 * ks + 4 * g4) ^ (((vrow >> 3) & 7) << 2);
                    const bf16_t* vr = Vt + vrow * 136;
                    const bf16x4 v0 = *(const bf16x4*)(vr + kx), v1 = *(const bf16x4*)(vr + (kx ^ 16));
                    const bf16x8 vf = __builtin_shufflevector(v0, v1, 0, 1, 2, 3, 4, 5, 6, 7);
                    O[m] = __builtin_amdgcn_mfma_f32_16x16x32_bf16(vf, pfr, O[m], 0, 0, 0);
                }
                __builtin_amdgcn_sched_barrier(0);
            }
            float ss = 0.f;
#pragma unroll
            for (int m = 0; m < 4; ++m)
#pragma unroll
                for (int rg = 0; rg < 4; ++rg) ss += O[m][rg] * O[m][rg];
            ss += __shfl_xor(ss, 16, 64); ss += __shfl_xor(ss, 32, 64);
            const float rn = rsqrtf(ss * (1.0f / 64.0f) + EPS);
#pragma unroll
            for (int m = 0; m < 4; ++m) {
                const int ee = 16 * m + 4 * g4;
                const bf16x4 gv = *(const bf16x4*)(Z + (size_t)(t0 + i) * INW + 1024 + h * 64 + ee);
                uint2 o2; o2.x = pg8::cvt_pk_bf16(O[m][0] * rn * silu_f(bf2f((bf16_t)gv[0])), O[m][1] * rn * silu_f(bf2f((bf16_t)gv[1])));
                o2.y = pg8::cvt_pk_bf16(O[m][2] * rn * silu_f(bf2f((bf16_t)gv[2])), O[m][3] * rn * silu_f(bf2f((bf16_t)gv[3])));
                *(uint2*)(MIX + (size_t)(t0 + i) * D + 512 + h * 64 + ee) = o2;
            }
        } else {
            const int gk = h >> 2;
            bf16x8 qf[2];
            { const bf16_t* qr = Z + (size_t)(t0 + i) * INW + h * 64 + 8 * g4; qf[0] = *(const bf16x8*)qr; qf[1] = *(const bf16x8*)(qr + 32); }
            float mx = sink[h], l = (g4 == 0) ? 1.0f : 0.0f;
            const int qpos = lat ? (cidx * 128 + i) : 0;
#define ATT_VALID(tl_) ((tl_) >= 3 || (lat && (cidx - 1 + (tl_)) >= 0 && (cidx - 1 + (tl_)) < 32))
#define ATT_KT0(tl_) ((tl_) >= 3 ? TL + b * CL + ((tl_) - 3) * 128 : b * SEQ + (cidx - 1 + (tl_)) * 128)
            int tl = 0; while (!ATT_VALID(tl)) ++tl;
            u32x4 kreg[2]; bf16x8 vreg[2];
            { const int kt0 = ATT_KT0(tl);
#pragma unroll
              for (int q = 0; q < 2; ++q) { const int idx = tid + 512 * q; const int r = idx >> 3, pc = idx & 7; const bf16_t* zr = Z + (size_t)(kt0 + r) * INW + gk * 64 + pc * 8;
                  kreg[q] = *(const u32x4*)(zr + 1536); vreg[q] = *(const bf16x8*)(zr + 1664); } }
            while (tl < 5) {
                const bool isc = tl >= 3; const int kp0 = isc ? 0 : (cidx - 1 + tl) * 128;
                __syncthreads();
#pragma unroll
                for (int q = 0; q < 2; ++q) { const int idx = tid + 512 * q; const int r = idx >> 3, pc = idx & 7;
                    *(u32x4*)(Kt + r * 72 + pc * 8) = kreg[q];
#pragma unroll
                    for (int j = 0; j < 8; ++j) Vt[(pc * 8 + j) * 136 + (r ^ (pc << 2))] = (bf16_t)vreg[q][j]; }
                __syncthreads();
                int tn = tl + 1; while (tn < 5 && !ATT_VALID(tn)) ++tn;
                if (tn < 5) { const int kt0 = ATT_KT0(tn);
#pragma unroll
                    for (int q = 0; q < 2; ++q) { const int idx = tid + 512 * q; const int r = idx >> 3, pc = idx & 7; const bf16_t* zr = Z + (size_t)(kt0 + r) * INW + gk * 64 + pc * 8;
                        kreg[q] = *(const u32x4*)(zr + 1536); vreg[q] = *(const bf16x8*)(zr + 1664); } }
                f32x4 st[8];
                float mloc = -1e30f;
#pragma unroll
                for (int mt = 0; mt < 8; ++mt) {
                    f32x4 a = (f32x4){0.f, 0.f, 0.f, 0.f};
#pragma unroll
                    for (int k2 = 0; k2 < 2; ++k2) { const bf16x8 kf = *(const bf16x8*)(Kt + (16 * mt + ln) * 72 + 32 * k2 + 8 * g4); a = __builtin_amdgcn_mfma_f32_16x16x32_bf16(kf, qf[k2], a, 0, 0, 0); }
                    if (!isc) {
#pragma unroll
                        for (int rg = 0; rg < 4; ++rg) { const int dd = qpos - (kp0 + 16 * mt + 4 * g4 + rg); if (dd > 128 || dd < -128) a[rg] = -1e30f; }
                    }
#pragma unroll
                    for (int rg = 0; rg < 4; ++rg) mloc = fmaxf(mloc, a[rg]);
                    st[mt] = a;
                    __builtin_amdgcn_sched_barrier(0);
                }
                mloc = fmaxf(mloc, __shfl_xor(mloc, 16, 64)); mloc = fmaxf(mloc, __shfl_xor(mloc, 32, 64));
                const float mnew = fmaxf(mx, mloc);
                const float sc = __expf(mx - mnew); mx = mnew; l *= sc;
#pragma unroll
                for (int m = 0; m < 4; ++m) O[m] *= sc;
#pragma unroll
                for (int mt = 0; mt < 8; ++mt)
#pragma unroll
                    for (int rg = 0; rg < 4; ++rg) { const float pv = __expf(st[mt][rg] - mnew); st[mt][rg] = pv; l += pv; }
#pragma unroll
                for (int ks = 0; ks < 4; ++ks) {
                    const bf16x8 pfr = pack8(st[2 * ks], st[2 * ks + 1]);
#pragma unroll
                    for (int m = 0; m < 4; ++m) {
                        const int vrow = 16 * m + ln; const int kx = (32 * ks + 4 * g4) ^ (((vrow >> 3) & 7) << 2);
                        const bf16_t* vr = Vt + vrow * 136;
                        const bf16x4 v0 = *(const bf16x4*)(vr + kx), v1 = *(const bf16x4*)(vr + (kx ^ 16));
                        const bf16x8 vf = __builtin_shufflevector(v0, v1, 0, 1, 2, 3, 4, 5, 6, 7);
                        O[m] = __builtin_amdgcn_mfma_f32_16x16x32_bf16(vf, pfr, O[m], 0, 0, 0);
                    }
                    __builtin_amdgcn_sched_barrier(0);
                }
                tl = tn;
            }
#undef ATT_VALID
#undef ATT_KT0
            l += __shfl_xor(l, 16, 64); l += __shfl_xor(l, 32, 64);
            const float inv = 1.0f / l;
#pragma unroll
            for (int m = 0; m < 4; ++m) {
                uint2 o2; o2.x = pg8::cvt_pk_bf16(O[m][0] * inv, O[m][1] * inv); o2.y = pg8::cvt_pk_bf16(O[m][2] * inv, O[m][3] * inv);
                *(uint2*)(MIX + (size_t)(t0 + i) * D + h * 64 + 16 * m + 4 * g4) = o2;
            }
        }
    }
    __syncthreads();
}

__device__ __forceinline__ void h2_shortconv(const KQ p_in, int o, int M, unsigned char* smem) {
    const KQ p = lq(p_in);
    const int tid = ltid();
    const bf16_t* ZH = (const bf16_t*)(p.ws + WS_BIG);
    const float* w = pin_ld(17) + (size_t)o * 3 * HYW; const float* bs = pin_ld(18) + (size_t)o * HYW;
    bf16_t* VXT = (bf16_t*)(p.ws + WS_Y); bf16_t* X0T = VXT + (size_t)D * TL;
    bf16_t* tx = (bf16_t*)smem;
    bf16_t* tv = tx + 64 * 136;
    const int tok = tid >> 3, cg8 = (tid & 7) * 8;
    float* wl = (float*)(smem + 40960);
    { const int c0b = (blockIdx.x & 15) * 64;
      for (int i = tid; i < 768; i += 512) { const int k = i >> 8, q = (i >> 6) & 3, c = i & 63; const int col = k * 1024 + c0b + c; wl[i] = (q < 3) ? w[q * HYW + col] : bs[col]; } }
    __syncthreads();
    for (int it = blockIdx.x; it < (TL / 128) * 16; it += gridDim.x) {
        const int c0 = (it & 15) * 64, t0 = (it >> 4) * 128;
        bf16x8 zc[2][3], zp[2][3], zn[2][3];
#pragma unroll
        for (int g = 0; g < 2; ++g) {
            const int t = t0 + tok + 64 * g; const int pos = t & (SEQ - 1); const bool first = pos == 0, last = pos == SEQ - 1;
#pragma unroll
            for (int k = 0; k < 3; ++k) {
                const int c = k * 1024 + c0 + cg8;
                zc[g][k] = *(const bf16x8*)(ZH + (size_t)t * HYW + c);
                zp[g][k] = *(const bf16x8*)(ZH + (size_t)(first ? t : t - 1) * HYW + c);
                zn[g][k] = *(const bf16x8*)(ZH + (size_t)(last ? t : t + 1) * HYW + c);
            }
        }
        __syncthreads();
#pragma unroll
        for (int g = 0; g < 2; ++g) {
            const int t = t0 + tok + 64 * g; const int pos = t & (SEQ - 1); const float mf = (pos == 0) ? 0.f : 1.f, ml = (pos == SEQ - 1) ? 0.f : 1.f;
            float zz[3][8];
#pragma unroll
            for (int k = 0; k < 3; ++k) {
                const float* wk = wl + k * 256 + cg8;
#pragma unroll
                for (int j = 0; j < 8; ++j)
                    zz[k][j] = wk[192 + j] + bf2f((bf16_t)zc[g][k][j]) * wk[64 + j] + mf * bf2f((bf16_t)zp[g][k][j]) * wk[j] + ml * bf2f((bf16_t)zn[g][k][j]) * wk[128 + j];
            }
#pragma unroll
            for (int j = 0; j < 8; ++j) { const int cs = (tok + 64 * g) ^ ((tid & 7) << 3);
                tx[(cg8 + j) * 136 + cs] = f2bf(zz[0][j]); tv[(cg8 + j) * 136 + cs] = f2bf(zz[2][j] * zz[1][j]); }
        }
        __syncthreads();
        { const int ch = tid >> 3, tk = (tid & 7) * 8;
#pragma unroll
          for (int q = 0; q < 2; ++q) {
            const int cs = (tk + 64 * q) ^ (((ch >> 3) & 7) << 3);
            *(u32x4*)(X0T + (size_t)(c0 + ch) * TL + t0 + tk + 64 * q) = *(const u32x4*)(tx + ch * 136 + cs);
            *(u32x4*)(VXT + (size_t)(c0 + ch) * TL + t0 + tk + 64 * q) = *(const u32x4*)(tv + ch * 136 + cs); } }
    }
    __syncthreads();
    if (M > TL) {
        float* VX = (float*)(p.ws + WS_Y); bf16_t* X0 = (bf16_t*)(p.ws + WS_H);
        for (int idx = TL * D + blockIdx.x * 512 + tid; idx < M * D; idx += gridDim.x * 512) {
            const int t = idx >> 10, d = idx & 1023;
            const int pos = (t - TL) & (CL - 1); const bool first = pos == 0, last = pos == CL - 1;
            float zz[3];
#pragma unroll
            for (int k = 0; k < 3; ++k) {
                const int c = k * 1024 + d;
                float sacc = bs[c] + bf2f(ZH[(size_t)t * HYW + c]) * w[HYW + c];
                if (!first) sacc += bf2f(ZH[(size_t)(t - 1) * HYW + c]) * w[c];
                if (!last) sacc += bf2f(ZH[(size_t)(t + 1) * HYW + c]) * w[2 * HYW + c];
                zz[k] = sacc;
            }
            VX[idx] = zz[2] * zz[1]; X0[idx] = f2bf(zz[0]);
        }
    }
}

typedef float f32x16 __attribute__((ext_vector_type(16)));
__device__ __forceinline__ void h3_longconv(const KQ p_in, int o, bool ctx_full, unsigned char* smem) {
    const KQ p = lq(p_in);
    const int tid = ltid(), w = tid >> 6, lane = tid & 63;
    const float* bias = pin_ld(27) + (size_t)o * D;
    {
        const bf16_t* VXT = (const bf16_t*)(p.ws + WS_Y); const bf16_t* X0T = VXT + (size_t)D * TL;
        bf16_t* HMT = (bf16_t*)(p.ws + WS_H);
        const bf16_t* RKT = (const bf16_t*)(p.ws + WS_KF + (size_t)o * SZ_KF);
        constexpr int RK2_OFF = 16384 + 64, U_OFF = 2 * 16384 + 128, CH_BYTES = U_OFF + 142 * 256;
        const int cw = w >> 2, w4 = w & 3;
        const int ct = tid & 255;
        unsigned char* cb = smem + cw * CH_BYTES;
        unsigned char* ub = cb + U_OFF;
        const int r = lane & 31, hh = lane >> 5;
        for (int pr = blockIdx.x; pr < D / 2; pr += gridDim.x) {
            const int d = pr * 2 + cw;
            __syncthreads();
            { const bf16_t* src = RKT + (size_t)d * 8192;
              for (int i = ct; i < 1024; i += 256) *(u32x4*)(cb + i * 16) = *(const u32x4*)(src + i * 8);
              for (int i = ct; i < 2 * 7 * 4 * 4; i += 256) { const int side = i / 112, rem = i % 112; unsigned z0 = 0u; asm volatile("" : "+v"(z0)); *(u32x4*)(ub + (side ? (135 * 4 * 64) : 0) + rem * 16) = (u32x4){z0, z0, z0, z0}; }
#pragma unroll 8
              for (int i = ct; i < 4 * 512; i += 256) { const int b = i >> 9, pc = i & 511;
                  const u32x4 v = *(const u32x4*)(VXT + (size_t)d * TL + b * SEQ + pc * 8);
                  const int col = ((pc >> 2) + 7) * 4 + b, q = pc & 3;
                  *(u32x4*)(ub + col * 64 + ((q ^ ((col >> 2) & 3)) * 16)) = v; } }
            __syncthreads();
            { const bf16_t* rk = (const bf16_t*)cb; bf16_t* rk2 = (bf16_t*)(cb + RK2_OFF);
#pragma unroll 4
              for (int i = ct; i < 4096; i += 256) { const unsigned lo = rk[2 * i + 1]; const unsigned hi = (2 * i + 2 < 8192) ? rk[2 * i + 2] : 0u; *(unsigned*)(rk2 + 2 * i) = lo | (hi << 16); } }
            __syncthreads();
            f32x16 acc[4];
#pragma unroll
            for (int j = 0; j < 4; ++j)
#pragma unroll
                for (int q = 0; q < 16; ++q) acc[j][q] = 0.f;
            const bf16_t* rsel = (const bf16_t*)(cb + ((r & 1) ? 0 : RK2_OFF));
            const int adj = (r & 1) ? 0 : -1;
            const int bq = r & 3;
#define H3_LOAD(AF, BF, U) do { \
                _Pragma("unroll") for (int s2 = 0; s2 < 2; ++s2) { \
                    const unsigned* ap = (const unsigned*)(Ab + 64 * (3 - (U)) + 32 * s2); \
                    u32x4 t4; t4.x = ap[0]; t4.y = ap[1]; t4.z = ap[2]; t4.w = ap[3]; \
                    AF[s2] = __builtin_bit_cast(bf16x8, t4); } \
                _Pragma("unroll") for (int j = 0; j < 4; ++j) { \
                    int c_ = Lb - 256 * (U) + 2048 * j; c_ = c_ < LO ? LO : (c_ > HI ? HI : c_); \
                    BF[j][0] = *(const bf16x8*)(ub + c_ + off[U][0]); BF[j][1] = *(const bf16x8*)(ub + c_ + off[U][1]); } } while (0)
#define H3_MMA(AF, BF) do { \
                _Pragma("unroll") for (int s2 = 0; s2 < 2; ++s2) \
                _Pragma("unroll") for (int j = 0; j < 4; ++j) acc[j] = __builtin_amdgcn_mfma_f32_32x32x16_bf16(AF[s2], BF[j][s2], acc[j], 0, 0, 0); } while (0)
            {
                const int dlo = 32 * w4 - 127;
                const int LO = (24 + bq) * 64, HI = (540 + bq) * 64;
                int off[4][2];
#pragma unroll
                for (int u = 0; u < 4; ++u) { const int sw = ((r >> 2) + 2 - u) & 3; off[u][0] = (hh ^ sw) * 16; off[u][1] = ((2 + hh) ^ sw) * 16; }
                int Lb = (((r >> 2) + 134) * 4 + bq) * 64;
                const unsigned char* Ab = (const unsigned char*)(rsel + (4095 - 32 * dlo - r + 8 * hh + adj)) - 192;
                bf16x8 afA[2], bfA[4][2], afB[2], bfB[4][2];
                H3_LOAD(afA, bfA, 0);
                for (int g = 0; g < 39; ++g) {
                    H3_LOAD(afB, bfB, 1);
                    __builtin_amdgcn_sched_barrier(0);
                    H3_MMA(afA, bfA);
                    __builtin_amdgcn_sched_barrier(0);
                    H3_LOAD(afA, bfA, 2);
                    __builtin_amdgcn_sched_barrier(0);
                    H3_MMA(afB, bfB);
                    __builtin_amdgcn_sched_barrier(0);
                    H3_LOAD(afB, bfB, 3);
                    __builtin_amdgcn_sched_barrier(0);
                    H3_MMA(afA, bfA);
                    __builtin_amdgcn_sched_barrier(0);
                    Ab -= 256; Lb -= 1024;
                    H3_LOAD(afA, bfA, 0);
                    __builtin_amdgcn_sched_barrier(0);
                    H3_MMA(afB, bfB);
                    __builtin_amdgcn_sched_barrier(0);
                }
                H3_LOAD(afB, bfB, 1);
                __builtin_amdgcn_sched_barrier(0);
                H3_MMA(afA, bfA);
                __builtin_amdgcn_sched_barrier(0);
                H3_LOAD(afA, bfA, 2);
                __builtin_amdgcn_sched_barrier(0);
                H3_MMA(afB, bfB);
                H3_MMA(afA, bfA);
            }
#undef H3_LOAD
#undef H3_MMA
            __syncthreads();
            const float bd = bias[d];
#pragma unroll
            for (int j = 0; j < 4; ++j) {
                const int n1 = 8 * (4 * w4 + j) + (r >> 2);
                const int col = (n1 + 7) * 4 + bq; const int sw = (col >> 2) & 3;
                bf16_t* up = (bf16_t*)(ub + col * 64);
#pragma unroll
                for (int q4 = 0; q4 < 4; ++q4) {
                    bf16_t* pp = up + ((q4 ^ sw) * 8) + 4 * hh;
                    const bf16x4 uv = *(const bf16x4*)pp;
                    uint2 o2; o2.x = pg8::cvt_pk_bf16(acc[j][4 * q4] + bd * bf2f((bf16_t)uv[0]), acc[j][4 * q4 + 1] + bd * bf2f((bf16_t)uv[1]));
                    o2.y = pg8::cvt_pk_bf16(acc[j][4 * q4 + 2] + bd * bf2f((bf16_t)uv[2]), acc[j][4 * q4 + 3] + bd * bf2f((bf16_t)uv[3]));
                    *(uint2*)pp = o2;
                }
            }
            __syncthreads();
#pragma unroll 4
            for (int i = ct; i < 4 * 512; i += 256) { const int b = i >> 9, pc = i & 511;
                const int col = ((pc >> 2) + 7) * 4 + b, q = pc & 3;
                const bf16x8 yv = *(const bf16x8*)(ub + col * 64 + ((q ^ ((col >> 2) & 3)) * 16));
                const size_t gi = (size_t)d * TL + b * SEQ + pc * 8;
                const bf16x8 xv = *(const bf16x8*)(X0T + gi);
                u32x4 o4;
                o4.x = pg8::cvt_pk_bf16(bf2f((bf16_t)yv[0]) * bf2f((bf16_t)xv[0]), bf2f((bf16_t)yv[1]) * bf2f((bf16_t)xv[1]));
                o4.y = pg8::cvt_pk_bf16(bf2f((bf16_t)yv[2]) * bf2f((bf16_t)xv[2]), bf2f((bf16_t)yv[3]) * bf2f((bf16_t)xv[3]));
                o4.z = pg8::cvt_pk_bf16(bf2f((bf16_t)yv[4]) * bf2f((bf16_t)xv[4]), bf2f((bf16_t)yv[5]) * bf2f((bf16_t)xv[5]));
                o4.w = pg8::cvt_pk_bf16(bf2f((bf16_t)yv[6]) * bf2f((bf16_t)xv[6]), bf2f((bf16_t)yv[7]) * bf2f((bf16_t)xv[7]));
                *(u32x4*)(HMT + gi) = o4; }
        }
        __syncthreads();
    }
    if (ctx_full) {
        const float* VX = (const float*)(p.ws + WS_Y); const bf16_t* X0 = (const bf16_t*)(p.ws + WS_H);
        bf16_t* MIX = (bf16_t*)(p.ws + WS_MIX);
        const float* kf = (const float*)(p.ws + WS_KF + (size_t)o * SZ_KF) + (size_t)2 * SEQ * D;
        for (int idx = blockIdx.x * 512 + tid; idx < (TC / 8) * D; idx += gridDim.x * 512) {
            const int d = idx & 1023, og = idx >> 10;
            const int bb = og >> 5, n0 = (og & 31) * 8, tb = TL + bb * CL;
            const float* up = VX + (size_t)tb * D + d;
            float acc[8];
#pragma unroll
            for (int j = 0; j < 8; ++j) acc[j] = 0.f;
#pragma unroll 1
            for (int mb = 0; mb < CL; mb += 8) {
                float kk[15], uu[8];
#pragma unroll
                for (int q = 0; q < 15; ++q) { const int lag = n0 - mb - 7 + q;
                    kk[q] = (lag >= 0) ? ((lag < CL) ? kf[(size_t)lag * D + d] : 0.f) : ((-lag < CL) ? kf[(size_t)(CL - lag) * D + d] : 0.f); }
#pragma unroll
                for (int u = 0; u < 8; ++u) uu[u] = up[(size_t)(mb + u) * D];
#pragma unroll
                for (int u = 0; u < 8; ++u)
#pragma unroll
                    for (int j = 0; j < 8; ++j) acc[j] += uu[u] * kk[7 - u + j];
            }
            const float bd = bias[d];
#pragma unroll
            for (int j = 0; j < 8; ++j) { const size_t ti = (size_t)(tb + n0 + j) * D + d; MIX[ti] = f2bf(bf2f(X0[ti]) * (acc[j] + bd * VX[ti])); }
        }
    }
}

__device__ __forceinline__ void h3b_transpose(const KQ p_in, unsigned char* smem) {
    const KQ p = lq(p_in);
    const int tid = ltid();
    const bf16_t* HMT = (const bf16_t*)(p.ws + WS_H); bf16_t* MIX = (bf16_t*)(p.ws + WS_MIX);
    bf16_t* tile = (bf16_t*)smem;
    for (int it = blockIdx.x; it < (TL / 256) * 16; it += gridDim.x) {
        const int c0 = (it & 15) * 64, t0 = (it >> 4) * 256;
        u32x4 ld[4];
        { const int ch = tid >> 3, tk = (tid & 7) * 8;
#pragma unroll
          for (int q = 0; q < 4; ++q) ld[q] = *(const u32x4*)(HMT + (size_t)(c0 + ch) * TL + t0 + tk + 64 * q);
          __syncthreads();
#pragma unroll
          for (int q = 0; q < 4; ++q) *(u32x4*)(tile + ch * 264 + ((tk + 64 * q) ^ (((ch >> 3) & 7) << 3))) = ld[q]; }
        __syncthreads();
        { const int cg8 = (tid & 7) * 8;
#pragma unroll
          for (int q = 0; q < 4; ++q) { const int tok = (tid >> 3) + 64 * q; unsigned short v[8];
#pragma unroll
              for (int j = 0; j < 8; ++j) v[j] = tile[(cg8 + j) * 264 + (tok ^ ((tid & 7) << 3))];
              u32x4 o4; o4.x = v[0] | ((unsigned)v[1] << 16); o4.y = v[2] | ((unsigned)v[3] << 16); o4.z = v[4] | ((unsigned)v[5] << 16); o4.w = v[6] | ((unsigned)v[7] << 16);
              *(u32x4*)(MIX + (size_t)(t0 + tok) * D + c0 + cg8) = o4; } }
    }
    __syncthreads();
}

__global__ void __launch_bounds__(512, 2) mega_fwd(KP kp) {
    unsigned char* const smem = g_smem;
    if (threadIdx.x < 29) *(LAS unsigned long long*)((LAS unsigned char*)g_smem + PTAB_OFF + 8 * threadIdx.x) = ((const unsigned long long*)__builtin_amdgcn_kernarg_segment_ptr())[threadIdx.x];
    KQ p; p.out = kp.out; p.ws = kp.ws;
    cg::grid_group grid = cg::this_grid();
    if (threadIdx.x < 4) ((volatile LAS unsigned*)(LAS unsigned char*)smem)[(LDS_BYTES - 16) / 4 + threadIdx.x] = 0u;
    __syncthreads();
    if (threadIdx.x == 0) (void)xb_add(&((unsigned*)(lq(p).ws + WS_BAR))[XB_XCNT(xb_xcc_id())], 1u);
    grid.sync();
    float* smf = (float*)smem;
#define Hb ((bf16_t*)(lq(p).ws + WS_H))
#define BIG ((bf16_t*)(lq(p).ws + WS_BIG))
#define Y ((bf16_t*)(lq(p).ws + WS_Y))
#define MIX ((bf16_t*)(lq(p).ws + WS_MIX))

#ifndef NO_P0
    p0_setup(p, smf);
#endif
    GRID_BAR();
    rowphase(p, 0, nullptr, 0, 0, 0.f, nullptr, T, 0, pin_ld(6), 0, 1, Hb, true, 0);
    GRID_BAR();
    for (int l = 0; l < 4; ++l) {
        const bool ctx_live = l <= 2, ctx_full = l < 2;
        const int Mff = ctx_live ? T : TL, Mpost = ctx_full ? T : TL;
        for (int sub = 0; sub < 3; ++sub) {
            const bf16_t* Ao; const bf16_t* Bo; int Ko; int Mo;
            if (sub != 1) {
                const int fi = sub >> 1; const int M = (sub == 0) ? Mff : Mpost;
                { pg8::EpiSwiGLU E{BIG, DFF}; run_gemm(smem, Hb, (const bf16_t*)(lq(p).ws + WS_WGU + (size_t)(l * 2 + fi) * SZ_WGU), M, 2 * DFF, D, E); }
                GRID_BAR();
                Ao = BIG; Bo = (const bf16_t*)(lq(p).ws + WS_WD + (size_t)(l * 2 + fi) * SZ_WD); Ko = DFF; Mo = M;
            } else {
                if ((l & 1) == 0) {
                    const int e = l >> 1;
                    { pg8::EpiBf16 E{BIG, INW, nullptr}; run_gemm(smem, Hb, (const bf16_t*)(lq(p).ws + WS_WIN + (size_t)e * SZ_WIN), Mff, INW, D, E); }
                    GRID_BAR();
#ifndef NO_M1
                    m1_rope_states(p, e, smf);
#endif
                    GRID_BAR();
#ifndef NO_M3
                    m3_outputs(p, e, ctx_full, smem, (unsigned*)(lq(p).ws + WS_CNT) + (size_t)12 * 2 * 64 * 64 + (12 + e) * 64);
#endif
                    GRID_BAR();
                    Bo = (const bf16_t*)(lq(p).ws + WS_WOUT + (size_t)e * SZ_WOUT);
                } else {
                    const int o = l >> 1;
                    { pg8::EpiBf16 E{BIG, HYW, pin_ld(16) + (size_t)o * HYW}; run_gemm(smem, Hb, (const bf16_t*)(lq(p).ws + WS_HWIN + (size_t)o * SZ_HWIN), Mpost, HYW, D, E); }
                    GRID_BAR();
#ifndef NO_H2
                    h2_shortconv(p, o, Mpost, smem);
#endif
                    GRID_BAR();
#ifndef NO_H3
                    h3_longconv(p, o, ctx_full, smem);
#endif
                    GRID_BAR();
                    h3b_transpose(p, smem);
                    GRID_BAR();
                    Bo = (const bf16_t*)(lq(p).ws + WS_HWOUT + (size_t)o * SZ_WOUT);
                }
                Ao = MIX; Ko = D; Mo = Mpost;
            }
            const int gidx = 2 + 3 * sub;
            const int ln = (sub == 2) ? l + 1 : l; const bool has_next = ln < 4; const int lnn = has_next ? ln : l;
            const int pre_i = (sub == 2) ? 0 : sub + 1;
            const int Mn = has_next ? ((sub == 2) ? ((ln <= 2) ? T : TL) : ((sub == 0) ? Mff : Mpost)) : 0;
            const float* gpost = pin_ld(7) + (size_t)(l * 3 + sub) * D; const float* gpre = pin_ld(6) + (size_t)(lnn * 3 + pre_i) * D;
            const float wg = (sub == 1) ? 1.0f : 0.5f;
            {
                pg8::EpiFusedRow EF;
                EF.xin = (l == 0 && sub == 0) ? pin_ld(0) : (const float*)lq(p).out; EF.xout = lq(p).out; EF.H = has_next ? Hb : nullptr;
                EF.gate = modp(lq(p), l, 0, gidx); EF.gpost = gpost; EF.wgt = wg;
                EF.gpre = gpre; EF.shift = modp(lq(p), lnn, 0, 3 * pre_i); EF.scale = modp(lq(p), lnn, 0, 3 * pre_i + 1);
                EF.slots = (float*)(lq(p).ws + WS_SLOT); EF.cnt = (unsigned*)(lq(p).ws + WS_CNT) + (size_t)(l * 3 + sub) * 2 * 64 * 64;
                run_gemm_f32_split(smem, Ao, Bo, Mo, Ko, EF, (float*)(lq(p).ws + WS_YP));
            }
            if (Mo > TL && blockIdx.x < 64) {
                sub_barrier((unsigned*)(lq(p).ws + WS_CNT) + (size_t)12 * 2 * 64 * 64 + (l * 3 + sub) * 64, 64u);
                rowphase(p, Mo, Y, l, gidx, wg, gpost, Mn, lnn, gpre, 3 * pre_i, 3 * pre_i + 1, has_next ? Hb : nullptr, l == 0 && sub == 0, TL);
            }
            GRID_BAR();
        }
    }
}

extern "C" void kernel_launch(void* const* d_in, const int* in_sizes, int n_in, void* d_out, int out_size, void* d_ws, size_t ws_size, hipStream_t stream) {
    static int grid = 0;
    if (grid == 0) {
        if (n_in != 29 || out_size != TL * D || ws_size < WS_END) { fprintf(stderr, "kernel_launch: unexpected shapes: n_in %d out %d ws %zu (need %zu)\n", n_in, out_size, ws_size, (size_t)WS_END); grid = -1; return; }
        int dev = 0, cus = 0, per_cu = 0;
        (void)hipGetDevice(&dev);
        (void)hipDeviceGetAttribute(&cus, hipDeviceAttributeMultiprocessorCount, dev);
        if (hipFuncSetAttribute((const void*)mega_fwd, hipFuncAttributeMaxDynamicSharedMemorySize, LDS_BYTES) != hipSuccess) { fprintf(stderr, "kernel_launch: hipFuncSetAttribute failed\n"); grid = -1; return; }
        if (hipOccupancyMaxActiveBlocksPerMultiprocessor(&per_cu, (const void*)mega_fwd, 512, LDS_BYTES) != hipSuccess || per_cu < 1) { fprintf(stderr, "kernel_launch: occupancy query says %d\n", per_cu); per_cu = 1; }
        (void)hipGetLastError();
        grid = cus >= 256 ? 256 : cus;
    }
    if (grid < 0) return;
    (void)hipMemsetAsync((unsigned char*)d_ws + WS_BAR, 0, 16384 + SZ_CNT, stream);
    KP kp{};
    for (int i = 0; i < 29; ++i) kp.in[i] = (const float*)d_in[i];
    kp.out = (float*)d_out; kp.ws = (unsigned char*)d_ws;
    void* args[] = {&kp};
    hipError_t e = hipLaunchCooperativeKernel((const void*)mega_fwd, dim3(grid), dim3(512), args, LDS_BYTES, stream);
    if (e != hipSuccess) fprintf(stderr, "cooperative launch failed: %s (grid %d)\n", hipGetErrorString(e), grid);
}
```

```cpp
#include <hip/hip_runtime.h>
#include <hip/hip_cooperative_groups.h>
#include <cstdio>
namespace cg = cooperative_groups;

#define LAS __attribute__((address_space(3)))
typedef unsigned short bf16_t;
typedef short bf16x8 __attribute__((ext_vector_type(8)));
typedef short bf16x4 __attribute__((ext_vector_type(4)));
typedef float f32x4 __attribute__((ext_vector_type(4)));
typedef unsigned u32x4 __attribute__((ext_vector_type(4)));

constexpr int D = 1024, NB = 4, SEQ = 4096, CL = 256, TL = NB * SEQ, TC = NB * CL, T = TL + TC, DFF = 2816, INW = 2816, HYW = 3072;
constexpr int NMOD = 9;
constexpr float EPS = 1e-6f;
constexpr int NCH = 34;
constexpr int LDS_BYTES = 144 * 1024;

constexpr size_t SZ_WGU = (size_t)2 * DFF * D * 2, SZ_WD = (size_t)D * DFF * 2, SZ_WIN = (size_t)INW * D * 2, SZ_WOUT = (size_t)D * D * 2, SZ_HWIN = (size_t)HYW * D * 2;
constexpr size_t WS_WGU = 0;
constexpr size_t WS_WD = WS_WGU + 8 * SZ_WGU;
constexpr size_t WS_WIN = WS_WD + 8 * SZ_WD;
constexpr size_t WS_WOUT = WS_WIN + 2 * SZ_WIN;
constexpr size_t WS_HWIN = WS_WOUT + 2 * SZ_WOUT;
constexpr size_t WS_HWOUT = WS_HWIN + 2 * SZ_HWIN;
constexpr size_t WS_MOD = WS_HWOUT + 2 * SZ_WOUT;
constexpr size_t WS_ROPE = WS_MOD + (size_t)4 * 5 * NMOD * D * 4;
constexpr size_t WS_XC = WS_ROPE + (size_t)4 * SEQ * 32 * 4;
constexpr size_t WS_H = WS_XC + (size_t)TC * D * 4;
constexpr size_t WS_BIG = WS_H + (size_t)T * D * 2;
constexpr size_t WS_Y = WS_BIG + (size_t)T * HYW * 2;
constexpr size_t WS_MIX = WS_Y + (size_t)T * D * 4;
constexpr size_t SZ_ST = (size_t)NB * NCH * 8 * 4096 * 4;
constexpr size_t WS_ST = WS_MIX + (size_t)T * D * 2;
constexpr size_t SZ_KF = (size_t)(SEQ + CL) * 2 * D * 4;
constexpr size_t WS_KF = WS_ST + 4 * SZ_ST;
constexpr size_t WS_YP = WS_KF + 2 * SZ_KF;
constexpr size_t WS_BAR = WS_YP + (size_t)4 * TC * D * 4;
constexpr size_t WS_CNT = WS_BAR + 16384;
constexpr size_t SZ_CNT = (size_t)12 * 2 * 64 * 256 + 16 * 256;
constexpr size_t WS_SLOT = WS_CNT + SZ_CNT;
constexpr size_t WS_END = WS_SLOT + (size_t)2 * TL * 4 * 4;

struct KP { const float* in[29]; float* out; unsigned char* ws; };
extern __shared__ __attribute__((aligned(16))) unsigned char g_smem[];
constexpr int PTAB_OFF = LDS_BYTES - 512;
__device__ __forceinline__ const float* pin_ld(int k) {
    const unsigned long long v = *(volatile LAS unsigned long long*)((LAS unsigned char*)g_smem + PTAB_OFF + 8 * k);
    const unsigned lo = __builtin_amdgcn_readfirstlane((unsigned)v), hi = __builtin_amdgcn_readfirstlane((unsigned)(v >> 32));
    return (const float*)(((unsigned long long)hi << 32) | lo);
}
struct KQ { float* out; unsigned char* ws; };
__device__ __forceinline__ KQ lq(KQ q) { asm volatile("" : "+s"(q.out), "+s"(q.ws)); return q; }

__device__ __forceinline__ bf16_t f2bf(float f) { unsigned u = __float_as_uint(f); u += 0x7FFFu + ((u >> 16) & 1u); return (bf16_t)(u >> 16); }
__device__ __forceinline__ float bf2f(bf16_t b) { return __uint_as_float(((unsigned)b) << 16); }
__device__ __forceinline__ float silu_f(float x) { return x * __builtin_amdgcn_rcpf(1.0f + __expf(-x)); }
__device__ __forceinline__ int ltid() { int t = threadIdx.x; asm volatile("" : "+v"(t)); return t; }
__device__ __forceinline__ float wave_sum(float v) {
#pragma unroll
    for (int o = 32; o > 0; o >>= 1) v += __shfl_xor(v, o, 64);
    return v;
}


#define XB_TMO      128
#define XB_XCNT(j)  (256  + 64 * (j))
#define XB_XSUB(j)  (1280 + 64 * (j))
#define XB_XGEN(j)  (2304 + 64 * (j))
#define XB_TOP      3328
#define XB_TOPGEN   3392
#define XCD_BAR_WORDS 3456
#define XB_SPIN_CAP (1u << 18)
__device__ __forceinline__ unsigned xb_ld(unsigned* p)              { return __hip_atomic_load(p, __ATOMIC_RELAXED, __HIP_MEMORY_SCOPE_AGENT); }
__device__ __forceinline__ unsigned xb_add(unsigned* p, unsigned v) { return __hip_atomic_fetch_add(p, v, __ATOMIC_RELAXED, __HIP_MEMORY_SCOPE_AGENT); }
__device__ __forceinline__ unsigned xb_xcc_id() { return (unsigned)__builtin_amdgcn_s_getreg((3 << 11) | 20) & 0xFu; }
#define XB_SPIN(cond, bar) do { unsigned _sp = 0; while (cond) { __builtin_amdgcn_s_sleep(1); \
    if ((++_sp & 255u) == 0u) { if (xb_ld(&(bar)[XB_TMO])) break; if (_sp > XB_SPIN_CAP) { atomicAdd(&(bar)[XB_TMO], 1u); break; } } } } while (0)
struct XcdBarrier { unsigned* bar; unsigned x; volatile LAS unsigned* st; };
__device__ __forceinline__ XcdBarrier xcd_barrier_post(unsigned* bar, volatile LAS unsigned* st) {
    XcdBarrier b; b.bar = bar; b.x = xb_xcc_id(); b.st = st;
    if (threadIdx.x == 0) (void)xb_add(&bar[XB_XCNT(b.x)], 1u);
    return b;
}
__device__ __forceinline__ void xcd_barrier_complete(unsigned* bar, unsigned x, unsigned& nloc, unsigned& nx) {
    const unsigned G = gridDim.x * gridDim.y * gridDim.z;
    unsigned sum, cnt, mine, sp = 0u;
    for (;;) {
        sum = 0u; cnt = 0u; mine = 0u;
#pragma unroll
        for (unsigned j = 0; j < 16; ++j) { const unsigned c = xb_ld(&bar[XB_XCNT(j)]); sum += c; cnt += (c > 0u) ? 1u : 0u; mine = (j == x) ? c : mine; }
        if (sum == G) break;
        __builtin_amdgcn_s_sleep(1);
        if ((++sp & 255u) == 0u) { if (xb_ld(&bar[XB_TMO])) break; if (sp > XB_SPIN_CAP) { atomicAdd(&bar[XB_TMO], 1u); break; } }
    }
    nloc = mine > 0u ? mine : 1u; nx = cnt > 0u ? cnt : 1u;
}
__device__ __forceinline__ void xcd_barrier_impl(unsigned* bar, volatile LAS unsigned* st) {
    asm volatile("s_waitcnt vmcnt(0)" ::: "memory");
    __syncthreads();
    if (ltid() == 0) {
        const unsigned x = xb_xcc_id();
        __builtin_amdgcn_s_waitcnt(0);
        unsigned nloc = st[0], nx = st[1];
        if (nloc == 0u) { xcd_barrier_complete(bar, x, nloc, nx); st[0] = nloc; st[1] = nx; }
        const unsigned old = xb_add(&bar[XB_XSUB(x)], 1u);
        const unsigned gen = old / nloc;
        if (old + 1u == (gen + 1u) * nloc) {
            __builtin_amdgcn_fence(__ATOMIC_RELEASE, "agent");
            asm volatile("s_waitcnt vmcnt(0)" ::: "memory");
            const unsigned og = xb_add(&bar[XB_TOP], 1u);
            const unsigned tg = og / nx;
            if (og + 1u == (tg + 1u) * nx) xb_add(&bar[XB_TOPGEN], 1u);
            else XB_SPIN(xb_ld(&bar[XB_TOPGEN]) == tg, bar);
            __builtin_amdgcn_fence(__ATOMIC_ACQUIRE, "agent");
            xb_add(&bar[XB_XGEN(x)], 1u);
            asm volatile("s_waitcnt vmcnt(0)" ::: "memory");
        } else {
            XB_SPIN(xb_ld(&bar[XB_XGEN(x)]) == gen, bar);
            __builtin_amdgcn_fence(__ATOMIC_ACQUIRE, "agent");
            asm volatile("s_waitcnt vmcnt(0)" ::: "memory");
        }
    }
    __syncthreads();
}
__device__ __forceinline__ void sub_barrier(unsigned* word, unsigned n) {
    asm volatile("s_waitcnt vmcnt(0)" ::: "memory");
    __syncthreads();
    if (ltid() == 0) {
        __builtin_amdgcn_fence(__ATOMIC_RELEASE, "agent");
        asm volatile("s_waitcnt vmcnt(0)" ::: "memory");
        (void)xb_add(word, 1u);
        for (unsigned sp = 0; sp < (1u << 21); ++sp) { if (xb_ld(word) >= n) break; __builtin_amdgcn_s_sleep(2); }
        __builtin_amdgcn_fence(__ATOMIC_ACQUIRE, "agent");
        asm volatile("s_waitcnt vmcnt(0)" ::: "memory");
    }
    __syncthreads();
}
__device__ __forceinline__ void sub_arrive(unsigned* word) {
    asm volatile("s_waitcnt vmcnt(0)" ::: "memory");
    __syncthreads();
    if (ltid() == 0) { __builtin_amdgcn_fence(__ATOMIC_RELEASE, "agent"); asm volatile("s_waitcnt vmcnt(0)" ::: "memory"); (void)xb_add(word, 1u); }
}
__device__ __forceinline__ void sub_wait(unsigned* word, unsigned n) {
    if (ltid() == 0) {
        for (unsigned sp = 0; sp < (1u << 21); ++sp) { if (xb_ld(word) >= n) break; __builtin_amdgcn_s_sleep(2); }
        __builtin_amdgcn_fence(__ATOMIC_ACQUIRE, "agent");
        asm volatile("s_waitcnt vmcnt(0)" ::: "memory");
    }
    __syncthreads();
}
#define GRID_BAR() xcd_barrier_impl((unsigned*)(p.ws + WS_BAR), (volatile LAS unsigned*)((LAS unsigned char*)smem + LDS_BYTES - 16))

namespace pg8 {
constexpr int BM = 256, BK = 64, HALF = 128, HTB = HALF * BK * 2, STAGE_BYTES = 8 * HTB, NXCD = 8, WGM = 16;
__host__ __device__ __forceinline__ int lds_byte(int r, int c) { const int st = (r >> 4) * 2 + (c >> 5), rr = r & 15, cc = c & 31, ob = rr * 64 + cc * 2; return st * 1024 + (ob ^ (((ob >> 9) & 1) << 5)); }
__host__ __device__ __forceinline__ void stage_rc(int b, int& R, int& C) { const int st = b / 1024, sb = b % 1024, swz = sb ^ (((sb >> 9) & 1) << 5); R = (st >> 1) * 16 + swz / 64; C = (st & 1) * 32 + (swz % 64) / 2; }
__host__ __device__ __forceinline__ int perm32(int rho) { const int n = rho >> 4, i = rho & 15; return 8 * (i >> 2) + 4 * n + (i & 3); }
struct Unit { int pm, pn; };
struct Gemm { const bf16_t* A; const bf16_t* Bt; int M, N, K, ld; };
struct StaticOrder {
    int nM, nN, nwg, G, c;
    __device__ void init(int M, int N, int G_, int c_) { nM = M / BM; nN = N / BM; nwg = nM * nN; G = G_; c = c_; }
    __device__ bool next(int i, Unit& u) const {
        const long Lx = (long)i * G + c; if (Lx >= nwg) return false;
        int wgid = (int)Lx; { const int q = nwg / NXCD, r = nwg % NXCD, xcd = wgid % NXCD, off = wgid / NXCD; wgid = (xcd < r ? xcd * (q + 1) : r * (q + 1) + (xcd - r) * q) + off; }
        const int nig = WGM * nN, gid = wgid / nig, fm = gid * WGM, gsz = (nM - fm) < WGM ? (nM - fm) : WGM;
        u.pm = fm + ((wgid % nig) % gsz); u.pn = (wgid % nig) / gsz; return true;
    }
};
__device__ __forceinline__ unsigned cvt_pk_bf16(float lo, float hi) { unsigned r; asm volatile("v_cvt_pk_bf16_f32 %0, %1, %2" : "=v"(r) : "v"(lo), "v"(hi)); return r; }

struct EpiF32 {
    static constexpr bool PERM = false, AFTER_DRAIN = false;
    float* C; int ldc;
    __device__ __forceinline__ void operator()(const f32x4 (&acc)[2][2][4][2], const Unit& u, int wr, int wc, int fr, int fq) const {
        const int row0 = u.pm * BM + wr * 64 + fr, col0 = u.pn * BM + wc * 32 + 4 * fq;
#pragma unroll
        for (int ai = 0; ai < 2; ++ai)
#pragma unroll
            for (int m = 0; m < 4; ++m) { float* rowp = C + (size_t)(row0 + ai * HALF + m * 16) * ldc + col0;
#pragma unroll
                for (int bj = 0; bj < 2; ++bj)
#pragma unroll
                    for (int n = 0; n < 2; ++n) *(f32x4*)(rowp + bj * HALF + n * 16) = acc[ai][bj][m][n]; }
    }
};
struct EpiBf16 {
    static constexpr bool PERM = true, AFTER_DRAIN = false;
    bf16_t* O; int ldc; const float* bias;
    __device__ __forceinline__ void operator()(const f32x4 (&acc)[2][2][4][2], const Unit& u, int wr, int wc, int fr, int fq) const {
        const int row0 = u.pm * BM + wr * 64 + fr; const int col0 = u.pn * BM + wc * 32 + 8 * fq;
        f32x4 bv[2][2];
#pragma unroll
        for (int bj = 0; bj < 2; ++bj)
#pragma unroll
            for (int n = 0; n < 2; ++n) bv[bj][n] = bias ? *(const f32x4*)(bias + col0 + bj * HALF + 4 * n) : (f32x4){0.f, 0.f, 0.f, 0.f};
#pragma unroll
        for (int ai = 0; ai < 2; ++ai)
#pragma unroll
            for (int m = 0; m < 4; ++m) { bf16_t* rowp = O + (size_t)(row0 + ai * HALF + m * 16) * ldc + col0;
#pragma unroll
                for (int bj = 0; bj < 2; ++bj) { f32x4 v0 = acc[ai][bj][m][0] + bv[bj][0], v1 = acc[ai][bj][m][1] + bv[bj][1];
                    u32x4 w; w.x = cvt_pk_bf16(v0[0], v0[1]); w.y = cvt_pk_bf16(v0[2], v0[3]); w.z = cvt_pk_bf16(v1[0], v1[1]); w.w = cvt_pk_bf16(v1[2], v1[3]);
                    *(u32x4*)(rowp + bj * HALF) = w; } }
    }
};
struct EpiSwiGLU {
    static constexpr bool PERM = true, AFTER_DRAIN = false;
    bf16_t* O; int ldc;
    __device__ __forceinline__ void operator()(const f32x4 (&acc)[2][2][4][2], const Unit& u, int wr, int wc, int fr, int fq) const {
        const int row0 = u.pm * BM + wr * 64 + fr; const int col0 = u.pn * HALF + wc * 32 + 8 * fq;
#pragma unroll
        for (int ai = 0; ai < 2; ++ai)
#pragma unroll
            for (int m = 0; m < 4; ++m) { bf16_t* rowp = O + (size_t)(row0 + ai * HALF + m * 16) * ldc + col0;
                float v[8];
#pragma unroll
                for (int n = 0; n < 2; ++n)
#pragma unroll
                    for (int j = 0; j < 4; ++j) { const float g = acc[ai][0][m][n][j], up = acc[ai][1][m][n][j]; v[n * 4 + j] = silu_f(g) * up; }
                u32x4 w; w.x = cvt_pk_bf16(v[0], v[1]); w.y = cvt_pk_bf16(v[2], v[3]); w.z = cvt_pk_bf16(v[4], v[5]); w.w = cvt_pk_bf16(v[6], v[7]);
                *(u32x4*)rowp = w; }
    }
};


__device__ __forceinline__ void row_exchange(const f32x4 (&v)[2][2][4][2], const Unit& u, int wr, int wc, int fr, int fq, LAS unsigned char* lds, int wid, int lane, float* slots, unsigned* cnt) {
    LAS float* P = (LAS float*)lds;
    LAS float* S = (LAS float*)(lds + 4096);
#pragma unroll
    for (int ai = 0; ai < 2; ++ai)
#pragma unroll
        for (int m = 0; m < 4; ++m) {
            float sq = 0.f;
#pragma unroll
            for (int bj = 0; bj < 2; ++bj)
#pragma unroll
                for (int n = 0; n < 2; ++n) { const f32x4 x = v[ai][bj][m][n]; sq += (x[0] * x[0] + x[1] * x[1]) + (x[2] * x[2] + x[3] * x[3]); }
            sq += __shfl_xor(sq, 16); sq += __shfl_xor(sq, 32);
            if (fq == 0) P[(ai * HALF + wr * 64 + m * 16 + fr) * 4 + wc] = sq;
        }
    asm volatile("s_waitcnt lgkmcnt(0)" ::: "memory"); __builtin_amdgcn_s_barrier(); asm volatile("" ::: "memory");
    const int row = wid * 32 + (lane & 31);
    if (lane < 32) {
        const float tot = (P[row * 4 + 0] + P[row * 4 + 1]) + (P[row * 4 + 2] + P[row * 4 + 3]);
        __hip_atomic_store((unsigned*)slots + ((size_t)(u.pm * BM + row) * 4 + u.pn), __float_as_uint(tot), __ATOMIC_RELAXED, __HIP_MEMORY_SCOPE_AGENT);
    }
    asm volatile("s_waitcnt vmcnt(0)" ::: "memory");
    if (lane == 0) __hip_atomic_fetch_add(cnt + 64 * u.pm, 1u, __ATOMIC_RELAXED, __HIP_MEMORY_SCOPE_AGENT);
    if (wid == 0) {
        for (unsigned sp = 0; sp < (1u << 21); ++sp) {
            if ((unsigned)__builtin_amdgcn_readfirstlane(__hip_atomic_load(cnt + 64 * u.pm, __ATOMIC_RELAXED, __HIP_MEMORY_SCOPE_AGENT)) >= 32u) break;
            __builtin_amdgcn_s_sleep(2);
        }
        __builtin_amdgcn_fence(__ATOMIC_ACQUIRE, "agent");
    }
    asm volatile("s_waitcnt vmcnt(0) lgkmcnt(0)" ::: "memory"); __builtin_amdgcn_s_barrier(); asm volatile("" ::: "memory");
    if (lane < 32) {
        const unsigned* sl = (const unsigned*)slots + (size_t)(u.pm * BM + row) * 4;
        float tot = 0.f;
#pragma unroll
        for (int t = 0; t < 4; ++t) tot += __uint_as_float(__hip_atomic_load(sl + t, __ATOMIC_RELAXED, __HIP_MEMORY_SCOPE_AGENT));
        S[row] = tot;
    }
    asm volatile("s_waitcnt vmcnt(0) lgkmcnt(0)" ::: "memory"); __builtin_amdgcn_s_barrier(); asm volatile("" ::: "memory");
}
struct EpiFusedRow {
    static constexpr bool PERM = false, AFTER_DRAIN = true;
    const float* xin; float* xout; bf16_t* H;
    const float* gate; const float* gpost; float wgt;
    const float* gpre; const float* shift; const float* scale;
    float* slots; unsigned* cnt;
    __device__ __forceinline__ void operator()(const f32x4 (&)[2][2][4][2], const Unit&, int, int, int, int) const {}
    __device__ __forceinline__ void fused(f32x4 (&acc)[2][2][4][2], const Unit& u, int wr, int wc, int fr, int fq, LAS unsigned char* lds, int wid, int lane) const {
        const LAS float* S = (const LAS float*)(lds + 4096);
        const int col0 = u.pn * BM + wc * 32 + 4 * fq; const size_t mb = (size_t)(u.pm >> 4) * (NMOD * D);
        row_exchange(acc, u, wr, wc, fr, fq, lds, wid, lane, slots, cnt);
        {
            f32x4 cw[2][2];
#pragma unroll
            for (int bj = 0; bj < 2; ++bj)
#pragma unroll
                for (int n = 0; n < 2; ++n) cw[bj][n] = *(const f32x4*)(gate + mb + col0 + bj * HALF + n * 16) * *(const f32x4*)(gpost + col0 + bj * HALF + n * 16);
#pragma unroll
            for (int ai = 0; ai < 2; ++ai)
#pragma unroll
                for (int m = 0; m < 4; ++m) { const int r = ai * HALF + wr * 64 + m * 16 + fr; const float r1 = rsqrtf(S[r] * (1.0f / D) + EPS) * wgt; const size_t off = (size_t)(u.pm * BM + r) * D + col0;
#pragma unroll
                    for (int bj = 0; bj < 2; ++bj)
#pragma unroll
                        for (int n = 0; n < 2; ++n) { const f32x4 xv = *(const f32x4*)(xin + off + bj * HALF + n * 16); const f32x4 xn = xv + (cw[bj][n] * r1) * acc[ai][bj][m][n];
                            acc[ai][bj][m][n] = xn; *(f32x4*)(xout + off + bj * HALF + n * 16) = xn; }
                    asm volatile("" : "+v"(acc[ai][0][m][0]), "+v"(acc[ai][0][m][1]), "+v"(acc[ai][1][m][0]), "+v"(acc[ai][1][m][1]));
                    asm volatile("" ::: "memory"); }
        }
        if (H == nullptr) return;
        row_exchange(acc, u, wr, wc, fr, fq, lds, wid, lane, slots + (size_t)TL * 4, cnt + 64 * 64);
        {
            f32x4 gm[2][2], sh[2][2];
#pragma unroll
            for (int bj = 0; bj < 2; ++bj)
#pragma unroll
                for (int n = 0; n < 2; ++n) { const int c = col0 + bj * HALF + n * 16; gm[bj][n] = *(const f32x4*)(gpre + c) * (*(const f32x4*)(scale + mb + c) + 1.0f); sh[bj][n] = *(const f32x4*)(shift + mb + c); }
#pragma unroll
            for (int ai = 0; ai < 2; ++ai)
#pragma unroll
                for (int m = 0; m < 4; ++m) { const int r = ai * HALF + wr * 64 + m * 16 + fr; const float r2 = rsqrtf(S[r] * (1.0f / D) + EPS); const size_t off = (size_t)(u.pm * BM + r) * D + col0;
#pragma unroll
                    for (int bj = 0; bj < 2; ++bj)
#pragma unroll
                        for (int n = 0; n < 2; ++n) { const f32x4 hv = (acc[ai][bj][m][n] * r2) * gm[bj][n] + sh[bj][n];
                            uint2 w2; w2.x = cvt_pk_bf16(hv[0], hv[1]); w2.y = cvt_pk_bf16(hv[2], hv[3]); *(uint2*)(H + off + bj * HALF + n * 16) = w2; }
                    asm volatile("" ::: "memory"); }
        }
    }
};

template <class Epi, class Sched>
__device__ __forceinline__ void gemm_phase(LAS unsigned char* lds, const Gemm g, const Sched& S, const Epi& E) {
    const int tid = ltid(), wid = __builtin_amdgcn_readfirstlane(tid >> 6), lane = tid & 63, wr = wid >> 2, wc = wid & 3, fr = lane & 15, fq = lane >> 4;
    const int K = g.ld, nt = g.K / BK;
    unsigned voffA[2], voffB[2];
#pragma unroll
    for (int i = 0; i < 2; ++i) { int R, C; stage_rc(tid * 16 + i * 8192, R, C); const int Rb = Epi::PERM ? ((R & ~31) + perm32(R & 31)) : R;
        voffA[i] = (unsigned)(R * K + C) * 2u; voffB[i] = (unsigned)(Rb * K + C) * 2u; }
    const size_t kstep = (size_t)(BK * 2);
    const size_t hstep = (size_t)HALF * K * 2;
    const size_t tstep = 2 * hstep;
    const unsigned ldsw = (unsigned)wid * 1024u;
    const int aoff = lds_byte(wr * 64 + fr, fq * 8), boff = lds_byte(wc * 32 + fr, fq * 8);
#define PG8_SA(b, h) (((b) * 2 + (h)) * HTB)
#define PG8_SB(b, h) ((4 + (b) * 2 + (h)) * HTB)
#define PG8_STAGE(bufoff, gbase, voff) do { _Pragma("unroll") for (int _i = 0; _i < 2; ++_i) \
        __builtin_amdgcn_global_load_lds((const unsigned*)((const char*)(gbase) + (voff)[_i]), (LAS unsigned*)(lds + (bufoff) + ldsw + _i * 8192), 16, 0, 0); } while (0)
#define PG8_LDA(dst, b, h) do { _Pragma("unroll") for (int m = 0; m < 4; ++m) _Pragma("unroll") for (int k = 0; k < 2; ++k) dst[m][k] = *(const LAS bf16x8*)(lds + PG8_SA(b, h) + aoff + m * 2048 + k * 1024); } while (0)
#define PG8_LDB(dst, b, h) do { _Pragma("unroll") for (int n = 0; n < 2; ++n) _Pragma("unroll") for (int k = 0; k < 2; ++k) dst[n][k] = *(const LAS bf16x8*)(lds + PG8_SB(b, h) + boff + n * 2048 + k * 1024); } while (0)
#define PG8_MMA(ai, bj, At, Bt) do { __builtin_amdgcn_s_setprio(1); _Pragma("unroll") for (int m = 0; m < 4; ++m) _Pragma("unroll") for (int n = 0; n < 2; ++n) _Pragma("unroll") for (int k = 0; k < 2; ++k) \
        acc[ai][bj][m][n] = __builtin_amdgcn_mfma_f32_16x16x32_bf16(Bt[n][k], At[m][k], acc[ai][bj][m][n], 0, 0, 0); __builtin_amdgcn_s_setprio(0); } while (0)
#define PG8_WAIT_V(n) asm volatile("s_waitcnt vmcnt(" #n ")" ::: "memory")
#define PG8_WAIT_L(n) asm volatile("s_waitcnt lgkmcnt(" #n ")" ::: "memory")
#define PG8_BAR __builtin_amdgcn_s_barrier()
#define PG8_SCHED __builtin_amdgcn_sched_barrier(0)
    Unit cur, nxt; int ui = 0;
    if (!S.next(0, cur)) return;
    f32x4 acc[2][2][4][2];
#pragma unroll
    for (int a = 0; a < 2; ++a)
#pragma unroll
        for (int b = 0; b < 2; ++b)
#pragma unroll
            for (int m = 0; m < 4; ++m)
#pragma unroll
                for (int n = 0; n < 2; ++n) acc[a][b][m][n] = (f32x4){0.f, 0.f, 0.f, 0.f};
    bf16x8 At[4][2], B0[2][2], B1[2][2];
    const char* cA = (const char*)g.A + (size_t)cur.pm * tstep; const char* cB = (const char*)g.Bt + (size_t)cur.pn * tstep;
    PG8_STAGE(PG8_SB(0, 0), cB, voffB); PG8_STAGE(PG8_SA(0, 0), cA, voffA); PG8_STAGE(PG8_SB(0, 1), cB + hstep, voffB); PG8_STAGE(PG8_SA(0, 1), cA + hstep, voffA);
    if (wr == 1) PG8_BAR;
    PG8_WAIT_V(4); PG8_BAR;
    PG8_STAGE(PG8_SB(1, 0), cB + kstep, voffB); PG8_STAGE(PG8_SA(1, 0), cA + kstep, voffA); PG8_STAGE(PG8_SB(1, 1), cB + hstep + kstep, voffB);
    PG8_WAIT_V(6); PG8_BAR;
    for (;;) {
        const bool has_next = S.next(ui + 1, nxt);
        const char* nA = has_next ? (const char*)g.A + (size_t)nxt.pm * tstep : cA; const char* nB = has_next ? (const char*)g.Bt + (size_t)nxt.pn * tstep : cB;
        for (int t = 0; t < nt; t += 2) {
            const bool last = (t == nt - 2);
            const char* a1 = cA + (size_t)(t + 1) * kstep;
            const char* a2 = last ? nA : cA + (size_t)(t + 2) * kstep; const char* b2 = last ? nB : cB + (size_t)(t + 2) * kstep;
            const char* a3 = a2 + kstep; const char* b3 = b2 + kstep;
            PG8_LDB(B0, 0, 0); PG8_SCHED; PG8_LDA(At, 0, 0); PG8_STAGE(PG8_SA(1, 1), a1 + hstep, voffA);
            PG8_WAIT_L(8); PG8_BAR; PG8_WAIT_L(0); PG8_MMA(0, 0, At, B0); PG8_BAR; PG8_SCHED;
            PG8_LDB(B1, 0, 1); PG8_STAGE(PG8_SB(0, 0), b2, voffB);
            PG8_BAR; PG8_WAIT_L(0); PG8_MMA(0, 1, At, B1); PG8_BAR;
            PG8_LDA(At, 0, 1); PG8_STAGE(PG8_SA(0, 0), a2, voffA);
            PG8_BAR; PG8_WAIT_L(0); PG8_MMA(1, 0, At, B0); PG8_BAR; PG8_SCHED;
            PG8_STAGE(PG8_SB(0, 1), b2 + hstep, voffB);
            PG8_WAIT_V(6); PG8_BAR; PG8_MMA(1, 1, At, B1); PG8_BAR;
            PG8_LDB(B0, 1, 0); PG8_SCHED; PG8_LDA(At, 1, 0); PG8_STAGE(PG8_SA(0, 1), a2 + hstep, voffA);
            PG8_WAIT_L(8); PG8_BAR; PG8_WAIT_L(0); PG8_MMA(0, 0, At, B0); PG8_BAR; PG8_SCHED;
            PG8_LDB(B1, 1, 1); PG8_STAGE(PG8_SB(1, 0), b3, voffB);
            PG8_BAR; PG8_WAIT_L(0); PG8_MMA(0, 1, At, B1); PG8_BAR;
            PG8_LDA(At, 1, 1); PG8_STAGE(PG8_SA(1, 0), a3, voffA);
            PG8_BAR; PG8_WAIT_L(0); PG8_MMA(1, 0, At, B0); PG8_BAR; PG8_SCHED;
            PG8_STAGE(PG8_SB(1, 1), b3 + hstep, voffB);
            PG8_WAIT_V(6); PG8_BAR; PG8_MMA(1, 1, At, B1); PG8_BAR;
        }
        if constexpr (!Epi::AFTER_DRAIN) E(acc, cur, wr, wc, fr, fq);
        if (!has_next) break;
#pragma unroll
        for (int a = 0; a < 2; ++a)
#pragma unroll
            for (int b = 0; b < 2; ++b)
#pragma unroll
                for (int m = 0; m < 4; ++m)
#pragma unroll
                    for (int n = 0; n < 2; ++n) acc[a][b][m][n] = (f32x4){0.f, 0.f, 0.f, 0.f};
        cur = nxt; cA = nA; cB = nB; ++ui;
    }
    PG8_WAIT_V(0);
    if (wr == 0) PG8_BAR;
    PG8_BAR;
    if constexpr (Epi::AFTER_DRAIN) E.fused(acc, cur, wr, wc, fr, fq, lds, wid, lane);
#undef PG8_SA
#undef PG8_SB
#undef PG8_STAGE
#undef PG8_LDA
#undef PG8_LDB
#undef PG8_MMA
#undef PG8_WAIT_V
#undef PG8_WAIT_L
#undef PG8_BAR
#undef PG8_SCHED
}
}

template <class Epi>
__device__ __forceinline__ void run_gemm(unsigned char* smem, const bf16_t* A, const bf16_t* Bt, int M, int N, int K, const Epi& E) {
    pg8::Gemm g{A, Bt, M, N, K, K}; pg8::StaticOrder S; S.init(M, N, (int)gridDim.x, (int)blockIdx.x);
    pg8::gemm_phase<Epi, pg8::StaticOrder>((LAS unsigned char*)smem, g, S, E);
}
__device__ __forceinline__ void run_gemm_f32_split(unsigned char* smem, const bf16_t* A, const bf16_t* Bt, int M, int K, const pg8::EpiFusedRow& EF, float* YP) {
    { pg8::Gemm g{A, Bt, TL, D, K, K}; pg8::StaticOrder S; S.init(TL, D, (int)gridDim.x, (int)blockIdx.x);
      pg8::gemm_phase<pg8::EpiFusedRow, pg8::StaticOrder>((LAS unsigned char*)smem, g, S, EF); }
    __syncthreads();
    if (M > TL && blockIdx.x < 64) {
        const int ks = blockIdx.x >> 4;
        int koff, klen;
        if (K == DFF) { koff = (ks < 2) ? ks * 768 : 1536 + (ks - 2) * 640; klen = (ks < 2) ? 768 : 640; }
        else { klen = K / 4; koff = ks * klen; }
        pg8::Gemm g{A + (size_t)TL * K + koff, Bt + koff, TC, D, klen, K}; pg8::StaticOrder S; S.init(TC, D, 16, (int)(blockIdx.x & 15)); pg8::EpiF32 E{YP + (size_t)ks * TC * D, D};
        pg8::gemm_phase<pg8::EpiF32, pg8::StaticOrder>((LAS unsigned char*)smem, g, S, E);
        __syncthreads();
    }
}

__device__ __forceinline__ float* xrow(const KQ p, int t) { return t < TL ? p.out + (size_t)t * D : (float*)(p.ws + WS_XC) + (size_t)(t - TL) * D; }
__device__ __forceinline__ int modrow(int t) { return t < TL ? (t >> 12) : 4; }
__device__ __forceinline__ const float* modp(const KQ p, int l, int mr, int idx) { return (const float*)(p.ws + WS_MOD) + ((size_t)(l * 5 + mr) * NMOD + idx) * D; }

__device__ __forceinline__ void p0_setup(const KQ p_in, float* sm) {
    const KQ p = lq(p_in);
    const int tid = ltid(), bid = blockIdx.x, nb = gridDim.x;
    const int gtid = bid * 512 + tid, gthreads = nb * 512;
    {
        float* rope = (float*)(p.ws + WS_ROPE);
        for (int idx = gtid; idx < SEQ * 32; idx += gthreads) {
            const int t = idx >> 5, i = idx & 31;
            const int ii = i & 15; const float pos = (i < 16) ? (float)(t >> 6) : (float)(t & 63);
            const float invA = powf(10000.0f, -(float)ii / 16.0f);
            const float angA = pos * invA;
            rope[idx] = cosf(angA); rope[SEQ * 32 + idx] = sinf(angA);
            const float ex = (float)i * (1.0f / 31.0f);
            const float invR = powf(10000.0f, -ex);
            const float angR = (float)t * invR;
            rope[2 * SEQ * 32 + idx] = cosf(angR); rope[3 * SEQ * 32 + idx] = sinf(angR);
        }
    }
    {
        float* tile = sm;
        for (int gs = bid; gs < 20864 / 4; gs += nb) {
            const int g = gs * 4;
            int j, tl;
            if (g < 16896) { j = g / 704; tl = g % 704; }
            else if (g < 18304) { j = 24 + (g - 16896) / 704; tl = (g - 16896) % 704; }
            else if (g < 18816) { j = 26 + (g - 18304) / 256; tl = (g - 18304) % 256; }
            else if (g < 20352) { j = 28 + (g - 18816) / 768; tl = (g - 18816) % 768; }
            else { j = 30 + (g - 20352) / 256; tl = (g - 20352) % 256; }
            const float* src; bf16_t* dst; int K, N, mode = 0;
            if (j < 8) { src = pin_ld(8) + (size_t)j * D * DFF; dst = (bf16_t*)(p.ws + WS_WGU + (size_t)j * SZ_WGU); K = D; N = DFF; mode = 1; }
            else if (j < 16) { src = pin_ld(9) + (size_t)(j - 8) * D * DFF; dst = (bf16_t*)(p.ws + WS_WGU + (size_t)(j - 8) * SZ_WGU); K = D; N = DFF; mode = 2; }
            else if (j < 24) { src = pin_ld(10) + (size_t)(j - 16) * DFF * D; dst = (bf16_t*)(p.ws + WS_WD + (size_t)(j - 16) * SZ_WD); K = DFF; N = D; }
            else if (j < 26) { src = pin_ld(11) + (size_t)(j - 24) * D * INW; dst = (bf16_t*)(p.ws + WS_WIN + (size_t)(j - 24) * SZ_WIN); K = D; N = INW; mode = 3; }
            else if (j < 28) { src = pin_ld(14) + (size_t)(j - 26) * D * D; dst = (bf16_t*)(p.ws + WS_WOUT + (size_t)(j - 26) * SZ_WOUT); K = D; N = D; }
            else if (j < 30) { src = pin_ld(15) + (size_t)(j - 28) * D * HYW; dst = (bf16_t*)(p.ws + WS_HWIN + (size_t)(j - 28) * SZ_HWIN); K = D; N = HYW; }
            else { src = pin_ld(28) + (size_t)(j - 30) * D * D; dst = (bf16_t*)(p.ws + WS_HWOUT + (size_t)(j - 30) * SZ_WOUT); K = D; N = D; }
            const int ntn = N / 64; const int k0 = (tl / ntn) * 64, n0 = (tl % ntn) * 64;
            f32x4 ld[8];
#pragma unroll
            for (int i = 0; i < 8; ++i) ld[i] = *(const f32x4*)(src + (size_t)(k0 + i * 8 + (tid >> 6)) * N + n0 + (tid & 63) * 4);
            __syncthreads();
#pragma unroll
            for (int i = 0; i < 8; ++i) *(f32x4*)(tile + (i * 8 + (tid >> 6)) * 260 + (tid & 63) * 4) = ld[i];
            __syncthreads();
            {
                const int n = tid >> 1, kh = (tid & 1) * 32; const int gn = n0 + n;
                float sc_ = 1.0f; int row = gn;
                if (mode == 1) row = 256 * (gn >> 7) + (gn & 127);
                else if (mode == 2) row = 256 * (gn >> 7) + 128 + (gn & 127);
                else if (mode == 3) { if (gn < 512 || (gn >= 1792 && gn < 2304)) sc_ = 0.125f; }
#pragma unroll
                for (int q = 0; q < 4; ++q) {
                    float v[8];
#pragma unroll
                    for (int jj = 0; jj < 8; ++jj) v[jj] = tile[(kh + q * 8 + jj) * 260 + n] * sc_;
                    u32x4 o4; o4.x = pg8::cvt_pk_bf16(v[0], v[1]); o4.y = pg8::cvt_pk_bf16(v[2], v[3]); o4.z = pg8::cvt_pk_bf16(v[4], v[5]); o4.w = pg8::cvt_pk_bf16(v[6], v[7]);
                    *(u32x4*)(dst + (size_t)row * K + k0 + kh + q * 8) = o4;
                }
            }
        }
        __syncthreads();
    }
    {
        float* sc = sm;
        float* red = sm + 5 * 1024;
        for (int i = tid; i < 5 * 1024; i += 512) { const int r = i >> 10, k = i & 1023; const float v = (r < 4) ? pin_ld(1)[r * D + k] : pin_ld(3)[k]; sc[i] = silu_f(v); }
        __syncthreads();
        const int w = tid >> 6, lane = tid & 63;
        for (int it = bid; it < 288; it += nb) {
            const int l = it / 72, c0 = (it % 72) * 128;
            const float* wm = pin_ld(4) + (size_t)l * D * (NMOD * D) + c0 + 2 * lane;
            float a[5][2];
#pragma unroll
            for (int r = 0; r < 5; ++r) { a[r][0] = 0.f; a[r][1] = 0.f; }
            for (int kb = w * 128; kb < w * 128 + 128; kb += 16) {
                float2 wv[16];
#pragma unroll
                for (int q = 0; q < 16; ++q) wv[q] = *(const float2*)(wm + (size_t)(kb + q) * (NMOD * D));
#pragma unroll
                for (int q = 0; q < 16; ++q)
#pragma unroll
                    for (int r = 0; r < 5; ++r) { const float s = sc[r * 1024 + kb + q]; a[r][0] += s * wv[q].x; a[r][1] += s * wv[q].y; }
            }
#pragma unroll
            for (int r = 0; r < 5; ++r) { red[(w * 5 + r) * 128 + 2 * lane] = a[r][0]; red[(w * 5 + r) * 128 + 2 * lane + 1] = a[r][1]; }
            __syncthreads();
            for (int i = tid; i < 5 * 128; i += 512) {
                const int r = i >> 7, c = i & 127; float s = 0.f;
#pragma unroll
                for (int ww = 0; ww < 8; ++ww) s += red[(ww * 5 + r) * 128 + c];
                s += pin_ld(5)[(size_t)l * (NMOD * D) + c0 + c];
                ((float*)(p.ws + WS_MOD))[(size_t)(l * 5 + r) * (NMOD * D) + c0 + c] = s;
            }
            __syncthreads();
        }
    }
    {
        float* z = sm;
        float* a1 = sm + 16 * 36;
        float* a2 = a1 + 16 * 64;
        float* a3 = a2 + 16 * 64;
        float* tl = a3 + 16 * 64;
        float* wl = tl + 16;
        const float HMAX = -4.605170185988091f / 0.3f, HMIN = -4.605170185988091f / 1.5f;
        int o_loaded = -1;
        for (int it = nb - 1 - bid; it < 544; it += nb) {
            const int o = it / 272, r = it % 272;
            const int Lf = (r < 256) ? SEQ : CL; const int p0 = (r < 256) ? r * 16 : (r - 256) * 16;
            float* kf = (float*)(p.ws + WS_KF + (size_t)o * SZ_KF) + ((r < 256) ? (size_t)0 : (size_t)2 * SEQ * D);
            const float* f3 = pin_ld(25) + (size_t)o * 64 * 2048;
            __syncthreads();
            if (o != o_loaded) {
                const float* f0 = pin_ld(19) + (size_t)o * 33 * 64; const float* f1 = pin_ld(21) + (size_t)o * 64 * 64; const float* f2 = pin_ld(23) + (size_t)o * 64 * 64;
                for (int i = tid; i < 33 * 64; i += 512) wl[i] = f0[i];
                for (int i = tid; i < 64 * 64; i += 512) { wl[2112 + i] = f1[i]; wl[2112 + 4096 + i] = f2[i]; }
                if (tid < 64) { wl[10304 + tid] = pin_ld(20)[o * 64 + tid]; wl[10304 + 64 + tid] = pin_ld(22)[o * 64 + tid]; wl[10304 + 128 + tid] = pin_ld(24)[o * 64 + tid]; wl[10304 + 192 + tid] = pin_ld(26)[o * 64 + tid]; }
                o_loaded = o;
            }
            const float* f0 = wl; const float* f1 = wl + 2112; const float* f2 = wl + 2112 + 4096;
            const float* fb0 = wl + 10304; const float* fb1 = fb0 + 64; const float* fb2 = fb0 + 128; const float* fq = fb0 + 192;
            for (int idx = tid; idx < 16 * 33; idx += 512) {
                const int ps = idx / 33, f = idx % 33; const int i = p0 + ps;
                const float tlin = (float)i * (1.0f / (float)(Lf - 1));
                const float w = (6.283185307179586f * (float)i) / (float)Lf;
                float v;
                if (f == 0) { v = tlin; tl[ps] = tlin; }
                else { const int jj = (f - 1) & 15; const float fj = 1e-4f + (float)jj * ((15.0f - 1e-4f) / 15.0f); v = (f <= 16) ? cosf(fj * w) : -sinf(fj * w); }
                z[ps * 36 + f] = v;
            }
            __syncthreads();
            for (int idx = tid; idx < 16 * 64; idx += 512) { const int ps = idx >> 6, oc = idx & 63; float s = fb0[oc];
                for (int f = 0; f < 33; ++f) s += z[ps * 36 + f] * f0[f * 64 + oc];
                a1[idx] = sinf(fq[oc] * s); }
            __syncthreads();
            for (int idx = tid; idx < 16 * 64; idx += 512) { const int ps = idx >> 6, oc = idx & 63; float s = fb1[oc];
                for (int f = 0; f < 64; ++f) s += a1[ps * 64 + f] * f1[f * 64 + oc];
                a2[idx] = sinf(fq[oc] * s); }
            __syncthreads();
            for (int idx = tid; idx < 16 * 64; idx += 512) { const int ps = idx >> 6, oc = idx & 63; float s = fb2[oc];
                for (int f = 0; f < 64; ++f) s += a2[ps * 64 + f] * f2[f * 64 + oc];
                a3[oc * 16 + ps] = sinf(fq[oc] * s); }
            __syncthreads();
            {
                float acc[4][16];
#pragma unroll
                for (int q = 0; q < 4; ++q)
#pragma unroll
                    for (int ps = 0; ps < 16; ++ps) acc[q][ps] = 0.f;
                for (int fb = 0; fb < 64; fb += 4) {
                    float wv[4][4];
#pragma unroll
                    for (int f = 0; f < 4; ++f)
#pragma unroll
                        for (int q = 0; q < 4; ++q) wv[f][q] = f3[(fb + f) * 2048 + tid + 512 * q];
#pragma unroll
                    for (int f = 0; f < 4; ++f) {
                        const f32x4 av0 = *(const f32x4*)(a3 + (fb + f) * 16), av1 = *(const f32x4*)(a3 + (fb + f) * 16 + 4), av2 = *(const f32x4*)(a3 + (fb + f) * 16 + 8), av3 = *(const f32x4*)(a3 + (fb + f) * 16 + 12);
#pragma unroll
                        for (int q = 0; q < 4; ++q)
#pragma unroll
                            for (int e = 0; e < 4; ++e) { acc[q][e] += av0[e] * wv[f][q]; acc[q][4 + e] += av1[e] * wv[f][q]; acc[q][8 + e] += av2[e] * wv[f][q]; acc[q][12 + e] += av3[e] * wv[f][q]; }
                    }
                }
#pragma unroll
                for (int q = 0; q < 4; ++q) {
                    const int c = tid + 512 * q; const int dir = c >> 10, d = c & 1023;
                    const float delta = fabsf(HMIN + (float)d * ((HMAX - HMIN) / 1023.0f));
                    float kv[16];
#pragma unroll
                    for (int ps = 0; ps < 16; ++ps) kv[ps] = acc[q][ps] * expf(-tl[ps] * delta);
                    if (r < 256) {
                        bf16_t* rk = (bf16_t*)(p.ws + WS_KF + (size_t)o * SZ_KF) + (size_t)d * 8192;
                        if (dir == 0) {
                            u32x4 w0, w1;
                            w0.x = pg8::cvt_pk_bf16(kv[15], kv[14]); w0.y = pg8::cvt_pk_bf16(kv[13], kv[12]); w0.z = pg8::cvt_pk_bf16(kv[11], kv[10]); w0.w = pg8::cvt_pk_bf16(kv[9], kv[8]);
                            w1.x = pg8::cvt_pk_bf16(kv[7], kv[6]); w1.y = pg8::cvt_pk_bf16(kv[5], kv[4]); w1.z = pg8::cvt_pk_bf16(kv[3], kv[2]); w1.w = pg8::cvt_pk_bf16(kv[1], kv[0]);
                            *(u32x4*)(rk + 4080 - p0) = w0; *(u32x4*)(rk + 4088 - p0) = w1;
                            if (p0 == 0) rk[8191] = 0;
                        } else {
                            if (p0 > 0) rk[4095 + p0] = f2bf(kv[0]);
                            u32x4 w0; w0.x = pg8::cvt_pk_bf16(kv[1], kv[2]); w0.y = pg8::cvt_pk_bf16(kv[3], kv[4]); w0.z = pg8::cvt_pk_bf16(kv[5], kv[6]); w0.w = pg8::cvt_pk_bf16(kv[7], kv[8]);
                            *(u32x4*)(rk + 4096 + p0) = w0;
                            uint2 w1; w1.x = pg8::cvt_pk_bf16(kv[9], kv[10]); w1.y = pg8::cvt_pk_bf16(kv[11], kv[12]);
                            *(uint2*)(rk + 4104 + p0) = w1;
                            *(unsigned*)(rk + 4108 + p0) = pg8::cvt_pk_bf16(kv[13], kv[14]);
                            rk[4110 + p0] = f2bf(kv[15]);
                        }
                    } else {
#pragma unroll
                        for (int ps = 0; ps < 16; ++ps) kf[((size_t)dir * Lf + p0 + ps) * D + d] = kv[ps];
                    }
                }
            }
        }
        __syncthreads();
    }
}

__device__ __forceinline__ void rowphase(const KQ p_in, int Mupd, const bf16_t* Y, int lu, int gidx, float wgt, const float* gpost,
                         int Mnext, int ln, const float* gpre, int shidx, int scidx, bf16_t* Hout, bool from_input, int tbeg) {
    const KQ p = lq(p_in);
    const int tid = ltid(), w = tid >> 6, lane = tid & 63;
    const int Mmax = Mupd > Mnext ? Mupd : Mnext;
    for (int t = tbeg + (blockIdx.x * 8 + w) * 2; t < Mmax; t += gridDim.x * 16) {
        float* xr = xrow(p, t); const int mr = modrow(t);
        const float* xs = xr;
        if (from_input) xs = (t < TL) ? pin_ld(0) + (size_t)t * D : pin_ld(2) + (size_t)(t - TL) * D;
        float4 xv[2][4];
#pragma unroll
        for (int rr = 0; rr < 2; ++rr)
#pragma unroll
            for (int q = 0; q < 4; ++q) xv[rr][q] = *(const float4*)(xs + rr * D + q * 256 + lane * 4);
        if (Y != nullptr && t < Mupd) {
            float4 yv[2][4]; float ss[2] = {0.f, 0.f};
#pragma unroll
            for (int rr = 0; rr < 2; ++rr)
#pragma unroll
                for (int q = 0; q < 4; ++q) {
                    if (t < TL) { const bf16x4 yb = *(const bf16x4*)(Y + (size_t)(t + rr) * D + q * 256 + lane * 4);
                        yv[rr][q] = make_float4(bf2f((bf16_t)yb[0]), bf2f((bf16_t)yb[1]), bf2f((bf16_t)yb[2]), bf2f((bf16_t)yb[3])); }
                    else { const float* yp = (const float*)(p.ws + WS_YP) + (size_t)(t + rr - TL) * D + q * 256 + lane * 4;
                        const float4 a0 = *(const float4*)yp, a1 = *(const float4*)(yp + (size_t)TC * D), a2 = *(const float4*)(yp + (size_t)2 * TC * D), a3 = *(const float4*)(yp + (size_t)3 * TC * D);
                        yv[rr][q] = make_float4(a0.x + a1.x + a2.x + a3.x, a0.y + a1.y + a2.y + a3.y, a0.z + a1.z + a2.z + a3.z, a0.w + a1.w + a2.w + a3.w); }
                    ss[rr] += yv[rr][q].x * yv[rr][q].x + yv[rr][q].y * yv[rr][q].y + yv[rr][q].z * yv[rr][q].z + yv[rr][q].w * yv[rr][q].w; }
            ss[0] = wave_sum(ss[0]); ss[1] = wave_sum(ss[1]);
            float wgl = wgt; asm volatile("" : "+v"(wgl));
            const float r0 = rsqrtf(ss[0] * (1.0f / D) + EPS) * wgl, r1 = rsqrtf(ss[1] * (1.0f / D) + EPS) * wgl;
            const float* gm = modp(p, lu, mr, gidx);
#pragma unroll
            for (int q = 0; q < 4; ++q) {
                const float4 g4 = *(const float4*)(gm + q * 256 + lane * 4); const float4 p4 = *(const float4*)(gpost + q * 256 + lane * 4);
                const float cx = g4.x * p4.x, cy = g4.y * p4.y, cz = g4.z * p4.z, cw = g4.w * p4.w;
                xv[0][q].x += r0 * cx * yv[0][q].x; xv[0][q].y += r0 * cy * yv[0][q].y; xv[0][q].z += r0 * cz * yv[0][q].z; xv[0][q].w += r0 * cw * yv[0][q].w;
                xv[1][q].x += r1 * cx * yv[1][q].x; xv[1][q].y += r1 * cy * yv[1][q].y; xv[1][q].z += r1 * cz * yv[1][q].z; xv[1][q].w += r1 * cw * yv[1][q].w;
                *(float4*)(xr + q * 256 + lane * 4) = xv[0][q]; *(float4*)(xr + D + q * 256 + lane * 4) = xv[1][q];
            }
        }
        if (Hout != nullptr && t < Mnext) {
            float ss[2] = {0.f, 0.f};
#pragma unroll
            for (int rr = 0; rr < 2; ++rr)
#pragma unroll
                for (int q = 0; q < 4; ++q) ss[rr] += xv[rr][q].x * xv[rr][q].x + xv[rr][q].y * xv[rr][q].y + xv[rr][q].z * xv[rr][q].z + xv[rr][q].w * xv[rr][q].w;
            ss[0] = wave_sum(ss[0]); ss[1] = wave_sum(ss[1]);
            const float rn[2] = {rsqrtf(ss[0] * (1.0f / D) + EPS), rsqrtf(ss[1] * (1.0f / D) + EPS)};
            const float* sh = modp(p, ln, mr, shidx); const float* sc = modp(p, ln, mr, scidx);
#pragma unroll
            for (int q = 0; q < 4; ++q) {
                const float4 g4 = *(const float4*)(gpre + q * 256 + lane * 4); const float4 s4 = *(const float4*)(sc + q * 256 + lane * 4); const float4 h4 = *(const float4*)(sh + q * 256 + lane * 4);
                const float mx_ = g4.x * (1.0f + s4.x), my_ = g4.y * (1.0f + s4.y), mz_ = g4.z * (1.0f + s4.z), mw_ = g4.w * (1.0f + s4.w);
#pragma unroll
                for (int rr = 0; rr < 2; ++rr) {
                    const float h0 = xv[rr][q].x * rn[rr] * mx_ + h4.x, h1 = xv[rr][q].y * rn[rr] * my_ + h4.y;
                    const float h2 = xv[rr][q].z * rn[rr] * mz_ + h4.z, h3 = xv[rr][q].w * rn[rr] * mw_ + h4.w;
                    uint2 pk; pk.x = pg8::cvt_pk_bf16(h0, h1); pk.y = pg8::cvt_pk_bf16(h2, h3);
                    *(uint2*)(Hout + (size_t)(t + rr) * D + q * 256 + lane * 4) = pk;
                }
            }
        }
    }
}

__device__ __forceinline__ float log_sigmoid(float x) { return -log1pf(expf(-x)); }
__device__ __forceinline__ int chunk_t0(int b, int cidx) { return cidx < 32 ? b * SEQ + cidx * 128 : TL + b * CL + (cidx - 32) * 128; }

__device__ __forceinline__ void m1_rope_states(const KQ p_in, int e, float* sm) {
    const KQ p = lq(p_in);
    const int tid = ltid(), bid = blockIdx.x, nb = gridDim.x;
    bf16_t* Z = (bf16_t*)(p.ws + WS_BIG);
    const float* rope = (const float*)(p.ws + WS_ROPE);
    for (int base = bid * 512 + tid; base < TL * 72; base += 2 * nb * 512) {
        bf16_t* zp[2]; bf16x8 a1[2], a2[2]; f32x4 c0[2], c1[2], s0[2], s1[2]; bool ok[2];
#pragma unroll
        for (int u = 0; u < 2; ++u) {
            const int idx = base + u * nb * 512; ok[u] = idx < TL * 72; const int ix = ok[u] ? idx : base;
            const int t = ix / 72, r = ix % 72; const int hd = r >> 2, i0 = (r & 3) * 8;
            const int cb = hd < 16 ? hd * 64 : 1536 + (hd - 16) * 64;
            const int tb = (hd >= 8 && hd < 16) ? 2 : 0; const int pos = t & (SEQ - 1);
            const float* cp = rope + (size_t)tb * SEQ * 32 + pos * 32 + i0; const float* sp = cp + (size_t)SEQ * 32;
            zp[u] = Z + (size_t)t * INW + cb + i0;
            a1[u] = *(const bf16x8*)zp[u]; a2[u] = *(const bf16x8*)(zp[u] + 32);
            c0[u] = *(const f32x4*)cp; c1[u] = *(const f32x4*)(cp + 4); s0[u] = *(const f32x4*)sp; s1[u] = *(const f32x4*)(sp + 4);
        }
#pragma unroll
        for (int u = 0; u < 2; ++u) {
            if (!ok[u]) continue;
            float o1[8], o2[8];
#pragma unroll
            for (int j = 0; j < 8; ++j) { const float x1 = bf2f((bf16_t)a1[u][j]), x2 = bf2f((bf16_t)a2[u][j]); const float cc = j < 4 ? c0[u][j & 3] : c1[u][j & 3], sn = j < 4 ? s0[u][j & 3] : s1[u][j & 3];
                o1[j] = x1 * cc - x2 * sn; o2[j] = x1 * sn + x2 * cc; }
            u32x4 w1, w2;
            w1.x = pg8::cvt_pk_bf16(o1[0], o1[1]); w1.y = pg8::cvt_pk_bf16(o1[2], o1[3]); w1.z = pg8::cvt_pk_bf16(o1[4], o1[5]); w1.w = pg8::cvt_pk_bf16(o1[6], o1[7]);
            w2.x = pg8::cvt_pk_bf16(o2[0], o2[1]); w2.y = pg8::cvt_pk_bf16(o2[2], o2[3]); w2.z = pg8::cvt_pk_bf16(o2[4], o2[5]); w2.w = pg8::cvt_pk_bf16(o2[6], o2[7]);
            *(u32x4*)zp[u] = w1; *(u32x4*)(zp[u] + 32) = w2;
        }
    }
    float* Ks = sm;
    float* Vs = sm + 128 * 64;
    float* wf = Vs + 128 * 64;
    float* wb = wf + 128;
    float* AF = (float*)(p.ws + WS_ST); float* AB = AF + SZ_ST / 4;
    const float* dec = pin_ld(13) + e * 16;
    for (int it = bid; it < NB * NCH * 8; it += nb) {
        const int h = it & 7, cidx = (it >> 3) % NCH, b = it / (8 * NCH);
        const int t0 = chunk_t0(b, cidx); const bool lat = cidx < 32;
        const float lgf = log_sigmoid(dec[h]), lgb = log_sigmoid(dec[8 + h]);
        __syncthreads();
        if (tid < 128) { wf[tid] = expf(lgf * (float)(127 - tid)); wb[tid] = expf(lgb * (float)tid); }
        const int kc = 1792 + h * 64, vc = 2304 + h * 64;
        {
            const int r = tid >> 2, pq = tid & 3;
            bf16_t* zp = Z + (size_t)(t0 + r) * INW + kc + 8 * pq;
            const bf16x8 a1 = *(const bf16x8*)zp, a2 = *(const bf16x8*)(zp + 32);
            float o1[8], o2[8];
            if (lat) {
                const int pos = (t0 + r) & (SEQ - 1);
                const float* cp = rope + (size_t)2 * SEQ * 32 + pos * 32 + 8 * pq; const float* sp = cp + (size_t)SEQ * 32;
                const f32x4 c0 = *(const f32x4*)cp, c1 = *(const f32x4*)(cp + 4), s0 = *(const f32x4*)sp, s1 = *(const f32x4*)(sp + 4);
#pragma unroll
                for (int j = 0; j < 8; ++j) { const float x1 = bf2f((bf16_t)a1[j]), x2 = bf2f((bf16_t)a2[j]); const float cc = j < 4 ? c0[j & 3] : c1[j & 3], sn = j < 4 ? s0[j & 3] : s1[j & 3];
                    o1[j] = bf2f(f2bf(x1 * cc - x2 * sn)); o2[j] = bf2f(f2bf(x1 * sn + x2 * cc)); }
                u32x4 w1, w2;
                w1.x = pg8::cvt_pk_bf16(o1[0], o1[1]); w1.y = pg8::cvt_pk_bf16(o1[2], o1[3]); w1.z = pg8::cvt_pk_bf16(o1[4], o1[5]); w1.w = pg8::cvt_pk_bf16(o1[6], o1[7]);
                w2.x = pg8::cvt_pk_bf16(o2[0], o2[1]); w2.y = pg8::cvt_pk_bf16(o2[2], o2[3]); w2.z = pg8::cvt_pk_bf16(o2[4], o2[5]); w2.w = pg8::cvt_pk_bf16(o2[6], o2[7]);
                *(u32x4*)zp = w1; *(u32x4*)(zp + 32) = w2;
            } else {
#pragma unroll
                for (int j = 0; j < 8; ++j) { o1[j] = bf2f((bf16_t)a1[j]); o2[j] = bf2f((bf16_t)a2[j]); }
            }
            *(f32x4*)(Ks + r * 64 + 8 * pq) = (f32x4){o1[0], o1[1], o1[2], o1[3]}; *(f32x4*)(Ks + r * 64 + 8 * pq + 4) = (f32x4){o1[4], o1[5], o1[6], o1[7]};
            *(f32x4*)(Ks + r * 64 + 32 + 8 * pq) = (f32x4){o2[0], o2[1], o2[2], o2[3]}; *(f32x4*)(Ks + r * 64 + 32 + 8 * pq + 4) = (f32x4){o2[4], o2[5], o2[6], o2[7]};
        }
#pragma unroll
        for (int q = 0; q < 2; ++q) { const int idx = tid + 512 * q; const int r = idx >> 3, pc = idx & 7;
            const bf16x8 vv = *(const bf16x8*)(Z + (size_t)(t0 + r) * INW + vc + 8 * pc);
            *(f32x4*)(Vs + r * 64 + 8 * pc) = (f32x4){bf2f((bf16_t)vv[0]), bf2f((bf16_t)vv[1]), bf2f((bf16_t)vv[2]), bf2f((bf16_t)vv[3])};
            *(f32x4*)(Vs + r * 64 + 8 * pc + 4) = (f32x4){bf2f((bf16_t)vv[4]), bf2f((bf16_t)vv[5]), bf2f((bf16_t)vv[6]), bf2f((bf16_t)vv[7])}; }
        __syncthreads();
        const int d = tid >> 3, e0 = (tid & 7) * 8;
        float af[8], ab[8];
#pragma unroll
        for (int j = 0; j < 8; ++j) { af[j] = 0.f; ab[j] = 0.f; }
        for (int s = 0; s < 128; ++s) {
            const float kv = Ks[s * 64 + d]; const float kfw = kv * wf[s], kbw = kv * wb[s];
            const float4 v0 = *(const float4*)(Vs + s * 64 + e0), v1 = *(const float4*)(Vs + s * 64 + e0 + 4);
            af[0] += kfw * v0.x; af[1] += kfw * v0.y; af[2] += kfw * v0.z; af[3] += kfw * v0.w; af[4] += kfw * v1.x; af[5] += kfw * v1.y; af[6] += kfw * v1.z; af[7] += kfw * v1.w;
            ab[0] += kbw * v0.x; ab[1] += kbw * v0.y; ab[2] += kbw * v0.z; ab[3] += kbw * v0.w; ab[4] += kbw * v1.x; ab[5] += kbw * v1.y; ab[6] += kbw * v1.z; ab[7] += kbw * v1.w;
        }
        const size_t so = ((size_t)(b * NCH + cidx) * 8 + h) * 4096 + d * 64 + e0;
        *(float4*)(AF + so) = make_float4(af[0], af[1], af[2], af[3]); *(float4*)(AF + so + 4) = make_float4(af[4], af[5], af[6], af[7]);
        *(float4*)(AB + so) = make_float4(ab[0], ab[1], ab[2], ab[3]); *(float4*)(AB + so + 4) = make_float4(ab[4], ab[5], ab[6], ab[7]);
    }
    __syncthreads();
}

__device__ __forceinline__ void m2_scan(const KQ p_in, int e) {
    const KQ p = lq(p_in);
    const float* __restrict__ AF = (const float*)(p.ws + WS_ST); const float* __restrict__ AB = AF + SZ_ST / 4;
    float* __restrict__ TF = (float*)(p.ws + WS_ST) + 2 * (SZ_ST / 4); float* __restrict__ TB = TF + SZ_ST / 4;
    const float* dec = pin_ld(13) + e * 16;
    for (int idx = blockIdx.x * 512 + ltid(); idx < NB * 8 * 4096; idx += gridDim.x * 512) {
        const int el = idx & 4095, h = (idx >> 12) & 7, b = idx >> 15;
        const float gf = expf(log_sigmoid(dec[h]) * 128.0f), gb = expf(log_sigmoid(dec[8 + h]) * 128.0f);
        const size_t base = ((size_t)(b * NCH) * 8 + h) * 4096 + el; constexpr size_t CS = (size_t)8 * 4096;
        float af[NCH], ab[NCH];
#pragma unroll
        for (int c = 0; c < NCH; ++c) { af[c] = AF[base + c * CS]; ab[c] = AB[base + c * CS]; }
        TF[base + 32 * CS] = 0.f; TF[base + 33 * CS] = af[32]; TB[base + 33 * CS] = 0.f; TB[base + 32 * CS] = ab[33];
        float sf = gf * af[32] + af[33], sb = ab[32] + gb * ab[33];
#pragma unroll
        for (int c = 0; c < 32; ++c) { TF[base + c * CS] = sf; sf = gf * sf + af[c]; }
#pragma unroll
        for (int c = 31; c >= 0; --c) { TB[base + c * CS] = sb; sb = ab[c] + gb * sb; }
    }
}

__device__ __forceinline__ bf16x8 pack8(const f32x4& a, const f32x4& b) {
    u32x4 w; w.x = pg8::cvt_pk_bf16(a[0], a[1]); w.y = pg8::cvt_pk_bf16(a[2], a[3]); w.z = pg8::cvt_pk_bf16(b[0], b[1]); w.w = pg8::cvt_pk_bf16(b[2], b[3]);
    return __builtin_bit_cast(bf16x8, w);
}
__device__ __forceinline__ void m3_outputs(const KQ p_in, int e, bool ctx_full, unsigned char* smem, unsigned* scan_word) {
    const KQ p = lq(p_in);
    m2_scan(p, e);
    sub_arrive(scan_word);
    bool scan_ready = false;
    const int tid = ltid(), bid = blockIdx.x, nb = gridDim.x;
    const int w = tid >> 6, lane = tid & 63, ln = lane & 15, g4 = lane >> 4;
    const bf16_t* Z = (const bf16_t*)(p.ws + WS_BIG);
    bf16_t* MIX = (bf16_t*)(p.ws + WS_MIX);
    const float* dec = pin_ld(13) + e * 16;
    const float* sink = pin_ld(12) + e * 8;
    const float* TF = (const float*)(p.ws + WS_ST) + 2 * (SZ_ST / 4); const float* TB = TF + SZ_ST / 4;
    const int nchunk = ctx_full ? NCH : 32;
    const int nitems = NB * nchunk * 8;
    bf16_t* Kt = (bf16_t*)smem;
    bf16_t* Vt = Kt + 128 * 72;
    bf16_t* TfT = Vt + 64 * 136;
    bf16_t* TbT = TfT + 64 * 72;
    const int i = 16 * w + ln;
    for (int it = bid; it < 2 * nitems; it += nb) {
        const bool is_attn = it < nitems; const int ii = is_attn ? it : it - nitems;
        const int h = (ii >> 3) & 7, cbx = (ii >> 6) * 8 + (ii & 7), cidx = cbx % nchunk, b = cbx / nchunk;
        if (!is_attn && !scan_ready) { sub_wait(scan_word, gridDim.x); scan_ready = true; }
        const int t0 = chunk_t0(b, cidx); const bool lat = cidx < 32;
        f32x4 O[4];
#pragma unroll
        for (int m = 0; m < 4; ++m) O[m] = (f32x4){0.f, 0.f, 0.f, 0.f};
        if (!is_attn) {
            const float lgf = log_sigmoid(dec[h]), lgb = log_sigmoid(dec[8 + h]);
            __syncthreads();
#pragma unroll
            for (int q = 0; q < 2; ++q) { const int idx = tid + 512 * q; const int r = idx >> 3, pc = idx & 7; const bf16_t* zr = Z + (size_t)(t0 + r) * INW + h * 64 + pc * 8;
                *(u32x4*)(Kt + r * 72 + pc * 8) = *(const u32x4*)(zr + 1792);
                const bf16x8 vv = *(const bf16x8*)(zr + 2304);
#pragma unroll
                for (int j = 0; j < 8; ++j) Vt[(pc * 8 + j) * 136 + (r ^ (pc << 2))] = (bf16_t)vv[j]; }
            const size_t so = ((size_t)(b * NCH + cidx) * 8 + h) * 4096;
            {
                const int ee = tid & 63, d0 = (tid >> 6) * 8;
                float tf[8], tb[8];
#pragma unroll
                for (int j = 0; j < 8; ++j) { tf[j] = TF[so + (d0 + j) * 64 + ee]; tb[j] = TB[so + (d0 + j) * 64 + ee]; }
                u32x4 wf4, wb4;
                wf4.x = pg8::cvt_pk_bf16(tf[0], tf[1]); wf4.y = pg8::cvt_pk_bf16(tf[2], tf[3]); wf4.z = pg8::cvt_pk_bf16(tf[4], tf[5]); wf4.w = pg8::cvt_pk_bf16(tf[6], tf[7]);
                wb4.x = pg8::cvt_pk_bf16(tb[0], tb[1]); wb4.y = pg8::cvt_pk_bf16(tb[2], tb[3]); wb4.z = pg8::cvt_pk_bf16(tb[4], tb[5]); wb4.w = pg8::cvt_pk_bf16(tb[6], tb[7]);
                *(u32x4*)(TfT + ee * 72 + d0) = wf4; *(u32x4*)(TbT + ee * 72 + d0) = wb4;
            }
            __builtin_amdgcn_sched_barrier(0);
            bf16x8 qf[2], qff[2], qfb[2];
            { const bf16_t* qr = Z + (size_t)(t0 + i) * INW + 512 + h * 64 + 8 * g4;
              const float cf = __expf(lgf * (float)(i + 1)), cb = __expf(lgb * (float)(128 - i));
#pragma unroll
              for (int k2 = 0; k2 < 2; ++k2) { qf[k2] = *(const bf16x8*)(qr + 32 * k2);
                  f32x4 a0, a1, b0, b1;
#pragma unroll
                  for (int j = 0; j < 4; ++j) { const float x0 = bf2f((bf16_t)qf[k2][j]), x1 = bf2f((bf16_t)qf[k2][4 + j]); a0[j] = x0 * cf; a1[j] = x1 * cf; b0[j] = x0 * cb; b1[j] = x1 * cb; }
                  qff[k2] = pack8(a0, a1); qfb[k2] = pack8(b0, b1); } }
            __builtin_amdgcn_sched_barrier(0);
            __syncthreads();
#pragma unroll
            for (int m = 0; m < 4; ++m)
#pragma unroll
                for (int k2 = 0; k2 < 2; ++k2) {
                    const bf16x8 af = *(const bf16x8*)(TfT + (16 * m + ln) * 72 + 32 * k2 + 8 * g4);
                    const bf16x8 ab = *(const bf16x8*)(TbT + (16 * m + ln) * 72 + 32 * k2 + 8 * g4);
                    O[m] = __builtin_amdgcn_mfma_f32_16x16x32_bf16(af, qff[k2], O[m], 0, 0, 0);
                    O[m] = __builtin_amdgcn_mfma_f32_16x16x32_bf16(ab, qfb[k2], O[m], 0, 0, 0);
                    __builtin_amdgcn_sched_barrier(0);
                }
            const float lf2 = lgf * 1.44269504f, lb2 = lgb * 1.44269504f; const int di = i - 4 * g4;
            const float bfw = lf2 * (float)di, bbw = -lb2 * (float)di;
            f32x4 st[8];
#pragma unroll
            for (int mt = 0; mt < 8; ++mt) {
                f32x4 a = (f32x4){0.f, 0.f, 0.f, 0.f};
#pragma unroll
                for (int k2 = 0; k2 < 2; ++k2) { const bf16x8 kf = *(const bf16x8*)(Kt + (16 * mt + ln) * 72 + 32 * k2 + 8 * g4); a = __builtin_amdgcn_mfma_f32_16x16x32_bf16(kf, qf[k2], a, 0, 0, 0); }
#pragma unroll
                for (int rg = 0; rg < 4; ++rg) { const int cc = 16 * mt + rg; const int df = di - cc;
                    const float arg = (df > 0) ? fmaf(-lf2, (float)cc, bfw) : fmaf(lb2, (float)cc, bbw);
                    float wgt = __builtin_amdgcn_exp2f(arg); wgt = (df == 0) ? 2.0f : wgt;
                    a[rg] *= wgt; }
                st[mt] = a;
                __builtin_amdgcn_sched_barrier(0);
            }
#pragma unroll
            for (int ks = 0; ks < 4; ++ks) {
                const bf16x8 pfr = pack8(st[2 * ks], st[2 * ks + 1]);
#pragma unroll
                for (int m = 0; m < 4; ++m) {
                    const int vrow = 16 * m + ln; const int kx = (32 * ks + 4 * g4) ^ (((vrow >> 3) & 7) << 2);
                    const bf16_t* vr = Vt + vrow * 136;
                    const bf16x4 v0 = *(const bf16x4*)(vr + kx), v1 = *(const bf16x4*)(vr + (kx ^ 16));
                    const bf16x8 vf = __builtin_shufflevector(v0, v1, 0, 1, 2, 3, 4, 5, 6, 7);
                    O[m] = __builtin_amdgcn_mfma_f32_16x16x32_bf16(vf, pfr, O[m], 0, 0, 0);
                }
                __builtin_amdgcn_sched_barrier(0);
            }
            float ss = 0.f;
#pragma unroll
            for (int m = 0; m < 4; ++m)
#pragma unroll
                for (int rg = 0; rg < 4; ++rg) ss += O[m][rg] * O[m][rg];
            ss += __shfl_xor(ss, 16, 64); ss += __shfl_xor(ss, 32, 64);
            const float rn = rsqrtf(ss * (1.0f / 64.0f) + EPS);
#pragma unroll
            for (int m = 0; m < 4; ++m) {
                const int ee = 16 * m + 4 * g4;
                const bf16x4 gv = *(const bf16x4*)(Z + (size_t)(t0 + i) * INW + 1024 + h * 64 + ee);
                uint2 o2; o2.x = pg8::cvt_pk_bf16(O[m][0] * rn * silu_f(bf2f((bf16_t)gv[0])), O[m][1] * rn * silu_f(bf2f((bf16_t)gv[1])));
                o2.y = pg8::cvt_pk_bf16(O[m][2] * rn * silu_f(bf2f((bf16_t)gv[2])), O[m][3] * rn * silu_f(bf2f((bf16_t)gv[3])));
                *(uint2*)(MIX + (size_t)(t0 + i) * D + 512 + h * 64 + ee) = o2;
            }
        } else {
            const int gk = h >> 2;
            bf16x8 qf[2];
            { const bf16_t* qr = Z + (size_t)(t0 + i) * INW + h * 64 + 8 * g4; qf[0] = *(const bf16x8*)qr; qf[1] = *(const bf16x8*)(qr + 32); }
            float mx = sink[h], l = (g4 == 0) ? 1.0f : 0.0f;
            const int qpos = lat ? (cidx * 128 + i) : 0;
#define ATT_VALID(tl_) ((tl_) >= 3 || (lat && (cidx - 1 + (tl_)) >= 0 && (cidx - 1 + (tl_)) < 32))
#define ATT_KT0(tl_) ((tl_) >= 3 ? TL + b * CL + ((tl_) - 3) * 128 : b * SEQ + (cidx - 1 + (tl_)) * 128)
            int tl = 0; while (!ATT_VALID(tl)) ++tl;
            u32x4 kreg[2]; bf16x8 vreg[2];
            { const int kt0 = ATT_KT0(tl);
#pragma unroll
              for (int q = 0; q < 2; ++q) { const int idx = tid + 512 * q; const int r = idx >> 3, pc = idx & 7; const bf16_t* zr = Z + (size_t)(kt0 + r) * INW + gk * 64 + pc * 8;
                  kreg[q] = *(const u32x4*)(zr + 1536); vreg[q] = *(const bf16x8*)(zr + 1664); } }
            while (tl < 5) {
                const bool isc = tl >= 3; const int kp0 = isc ? 0 : (cidx - 1 + tl) * 128;
                __syncthreads();
#pragma unroll
                for (int q = 0; q < 2; ++q) { const int idx = tid + 512 * q; const int r = idx >> 3, pc = idx & 7;
                    *(u32x4*)(Kt + r * 72 + pc * 8) = kreg[q];
#pragma unroll
                    for (int j = 0; j < 8; ++j) Vt[(pc * 8 + j) * 136 + (r ^ (pc << 2))] = (bf16_t)vreg[q][j]; }
                __syncthreads();
                int tn = tl + 1; while (tn < 5 && !ATT_VALID(tn)) ++tn;
                if (tn < 5) { const int kt0 = ATT_KT0(tn);
#pragma unroll
                    for (int q = 0; q < 2; ++q) { const int idx = tid + 512 * q; const int r = idx >> 3, pc = idx & 7; const bf16_t* zr = Z + (size_t)(kt0 + r) * INW + gk * 64 + pc * 8;
                        kreg[q] = *(const u32x4*)(zr + 1536); vreg[q] = *(const bf16x8*)(zr + 1664); } }
                f32x4 st[8];
                float mloc = -1e30f;
#pragma unroll
                for (int mt = 0; mt < 8; ++mt) {
                    f32x4 a = (f32x4){0.f, 0.f, 0.f, 0.f};
#pragma unroll
                    for (int k2 = 0; k2 < 2; ++k2) { const bf16x8 kf = *(const bf16x8*)(Kt + (16 * mt + ln) * 72 + 32 * k2 + 8 * g4); a = __builtin_amdgcn_mfma_f32_16x16x32_bf16(kf, qf[k2], a, 0, 0, 0); }
                    if (!isc) {
#pragma unroll
                        for (int rg = 0; rg < 4; ++rg) { const int dd = qpos - (kp0 + 16 * mt + 4 * g4 + rg); if (dd > 128 || dd < -128) a[rg] = -1e30f; }
                    }
#pragma unroll
                    for (int rg = 0; rg < 4; ++rg) mloc = fmaxf(mloc, a[rg]);
                    st[mt] = a;
                    __builtin_amdgcn_sched_barrier(0);
                }
                mloc = fmaxf(mloc, __shfl_xor(mloc, 16, 64)); mloc = fmaxf(mloc, __shfl_xor(mloc, 32, 64));
                const float mnew = fmaxf(mx, mloc);
                const float sc = __expf(mx - mnew); mx = mnew; l *= sc;
#pragma unroll
                for (int m = 0; m < 4; ++m) O[m] *= sc;
#pragma unroll
                for (int mt = 0; mt < 8; ++mt)
#pragma unroll
                    for (int rg = 0; rg < 4; ++rg) { const float pv = __expf(st[mt][rg] - mnew); st[mt][rg] = pv; l += pv; }
#pragma unroll
                for (int ks = 0; ks < 4; ++ks) {
                    const bf16x8 pfr = pack8(st[2 * ks], st[2 * ks + 1]);
#pragma unroll
                    for (int m = 0; m < 4; ++m) {
                        const int vrow = 16 * m + ln; const int kx = (32 * ks + 4 * g4) ^ (((vrow >> 3) & 7) << 2);
                        const bf16_t* vr = Vt + vrow * 136;
                        const bf16x4 v0 = *(const bf16x4*)(vr + kx), v1 = *(const bf16x4*)(vr + (kx ^ 16));
                        const bf16x8 vf = __builtin_shufflevector(v0, v1, 0, 1, 2, 3, 4, 5, 6, 7);
                        O[m] = __builtin_amdgcn_mfma_f32_16x16x32_bf16(vf, pfr, O[m], 0, 0, 0);
                    }
                    __builtin_amdgcn_sched_barrier(0);
                }
                tl = tn;
            }
#undef ATT_VALID
#undef ATT_KT0
            l += __shfl_xor(l, 16, 64); l += __shfl_xor(l, 32, 64);
            const float inv = 1.0f / l;
#pragma unroll
            for (int m = 0; m < 4; ++m) {
                uint2 o2; o2.x = pg8::cvt_pk_bf16(O[m][0] * inv, O[m][1] * inv); o2.y = pg8::cvt_pk_bf16(O[m][2] * inv, O[m][3] * inv);
                *(uint2*)(MIX + (size_t)(t0 + i) * D + h * 64 + 16 * m + 4 * g4) = o2;
            }
        }
    }
    __syncthreads();
}

__device__ __forceinline__ void h2_shortconv(const KQ p_in, int o, int M, unsigned char* smem) {
    const KQ p = lq(p_in);
    const int tid = ltid();
    const bf16_t* ZH = (const bf16_t*)(p.ws + WS_BIG);
    const float* w = pin_ld(17) + (size_t)o * 3 * HYW; const float* bs = pin_ld(18) + (size_t)o * HYW;
    bf16_t* VXT = (bf16_t*)(p.ws + WS_Y); bf16_t* X0T = VXT + (size_t)D * TL;
    bf16_t* tx = (bf16_t*)smem;
    bf16_t* tv = tx + 64 * 136;
    const int tok = tid >> 3, cg8 = (tid & 7) * 8;
    float* wl = (float*)(smem + 40960);
    { const int c0b = (blockIdx.x & 15) * 64;
      for (int i = tid; i < 768; i += 512) { const int k = i >> 8, q = (i >> 6) & 3, c = i & 63; const int col = k * 1024 + c0b + c; wl[i] = (q < 3) ? w[q * HYW + col] : bs[col]; } }
    __syncthreads();
    for (int it = blockIdx.x; it < (TL / 128) * 16; it += gridDim.x) {
        const int c0 = (it & 15) * 64, t0 = (it >> 4) * 128;
        bf16x8 zc[2][3], zp[2][3], zn[2][3];
#pragma unroll
        for (int g = 0; g < 2; ++g) {
            const int t = t0 + tok + 64 * g; const int pos = t & (SEQ - 1); const bool first = pos == 0, last = pos == SEQ - 1;
#pragma unroll
            for (int k = 0; k < 3; ++k) {
                const int c = k * 1024 + c0 + cg8;
                zc[g][k] = *(const bf16x8*)(ZH + (size_t)t * HYW + c);
                zp[g][k] = *(const bf16x8*)(ZH + (size_t)(first ? t : t - 1) * HYW + c);
                zn[g][k] = *(const bf16x8*)(ZH + (size_t)(last ? t : t + 1) * HYW + c);
            }
        }
        __syncthreads();
#pragma unroll
        for (int g = 0; g < 2; ++g) {
            const int t = t0 + tok + 64 * g; const int pos = t & (SEQ - 1); const float mf = (pos == 0) ? 0.f : 1.f, ml = (pos == SEQ - 1) ? 0.f : 1.f;
            float zz[3][8];
#pragma unroll
            for (int k = 0; k < 3; ++k) {
                const float* wk = wl + k * 256 + cg8;
#pragma unroll
                for (int j = 0; j < 8; ++j)
                    zz[k][j] = wk[192 + j] + bf2f((bf16_t)zc[g][k][j]) * wk[64 + j] + mf * bf2f((bf16_t)zp[g][k][j]) * wk[j] + ml * bf2f((bf16_t)zn[g][k][j]) * wk[128 + j];
            }
#pragma unroll
            for (int j = 0; j < 8; ++j) { const int cs = (tok + 64 * g) ^ ((tid & 7) << 3);
                tx[(cg8 + j) * 136 + cs] = f2bf(zz[0][j]); tv[(cg8 + j) * 136 + cs] = f2bf(zz[2][j] * zz[1][j]); }
        }
        __syncthreads();
        { const int ch = tid >> 3, tk = (tid & 7) * 8;
#pragma unroll
          for (int q = 0; q < 2; ++q) {
            const int cs = (tk + 64 * q) ^ (((ch >> 3) & 7) << 3);
            *(u32x4*)(X0T + (size_t)(c0 + ch) * TL + t0 + tk + 64 * q) = *(const u32x4*)(tx + ch * 136 + cs);
            *(u32x4*)(VXT + (size_t)(c0 + ch) * TL + t0 + tk + 64 * q) = *(const u32x4*)(tv + ch * 136 + cs); } }
    }
    __syncthreads();
    if (M > TL) {
        float* VX = (float*)(p.ws + WS_Y); bf16_t* X0 = (bf16_t*)(p.ws + WS_H);
        for (int idx = TL * D + blockIdx.x * 512 + tid; idx < M * D; idx += gridDim.x * 512) {
            const int t = idx >> 10, d = idx & 1023;
            const int pos = (t - TL) & (CL - 1); const bool first = pos == 0, last = pos == CL - 1;
            float zz[3];
#pragma unroll
            for (int k = 0; k < 3; ++k) {
                const int c = k * 1024 + d;
                float sacc = bs[c] + bf2f(ZH[(size_t)t * HYW + c]) * w[HYW + c];
                if (!first) sacc += bf2f(ZH[(size_t)(t - 1) * HYW + c]) * w[c];
                if (!last) sacc += bf2f(ZH[(size_t)(t + 1) * HYW + c]) * w[2 * HYW + c];
                zz[k] = sacc;
            }
            VX[idx] = zz[2] * zz[1]; X0[idx] = f2bf(zz[0]);
        }
    }
}

typedef float f32x16 __attribute__((ext_vector_type(16)));
__device__ __forceinline__ void h3_longconv(const KQ p_in, int o, bool ctx_full, unsigned char* smem) {
    const KQ p = lq(p_in);
    const int tid = ltid(), w = tid >> 6, lane = tid & 63;
    const float* bias = pin_ld(27) + (size_t)o * D;
    {
        const bf16_t* VXT = (const bf16_t*)(p.ws + WS_Y); const bf16_t* X0T = VXT + (size_t)D * TL;
        bf16_t* HMT = (bf16_t*)(p.ws + WS_H);
        const bf16_t* RKT = (const bf16_t*)(p.ws + WS_KF + (size_t)o * SZ_KF);
        constexpr int RK2_OFF = 16384 + 64, U_OFF = 2 * 16384 + 128, CH_BYTES = U_OFF + 142 * 256;
        const int cw = w >> 2, w4 = w & 3;
        const int ct = tid & 255;
        unsigned char* cb = smem + cw * CH_BYTES;
        unsigned char* ub = cb + U_OFF;
        const int r = lane & 31, hh = lane >> 5;
        for (int pr = blockIdx.x; pr < D / 2; pr += gridDim.x) {
            const int d = pr * 2 + cw;
            __syncthreads();
            { const bf16_t* src = RKT + (size_t)d * 8192;
              for (int i = ct; i < 1024; i += 256) *(u32x4*)(cb + i * 16) = *(const u32x4*)(src + i * 8);
              for (int i = ct; i < 2 * 7 * 4 * 4; i += 256) { const int side = i / 112, rem = i % 112; unsigned z0 = 0u; asm volatile("" : "+v"(z0)); *(u32x4*)(ub + (side ? (135 * 4 * 64) : 0) + rem * 16) = (u32x4){z0, z0, z0, z0}; }
#pragma unroll 8
              for (int i = ct; i < 4 * 512; i += 256) { const int b = i >> 9, pc = i & 511;
                  const u32x4 v = *(const u32x4*)(VXT + (size_t)d * TL + b * SEQ + pc * 8);
                  const int col = ((pc >> 2) + 7) * 4 + b, q = pc & 3;
                  *(u32x4*)(ub + col * 64 + ((q ^ ((col >> 2) & 3)) * 16)) = v; } }
            __syncthreads();
            { const bf16_t* rk = (const bf16_t*)cb; bf16_t* rk2 = (bf16_t*)(cb + RK2_OFF);
#pragma unroll 4
              for (int i = ct; i < 4096; i += 256) { const unsigned lo = rk[2 * i + 1]; const unsigned hi = (2 * i + 2 < 8192) ? rk[2 * i + 2] : 0u; *(unsigned*)(rk2 + 2 * i) = lo | (hi << 16); } }
            __syncthreads();
            f32x16 acc[4];
#pragma unroll
            for (int j = 0; j < 4; ++j)
#pragma unroll
                for (int q = 0; q < 16; ++q) acc[j][q] = 0.f;
            const bf16_t* rsel = (const bf16_t*)(cb + ((r & 1) ? 0 : RK2_OFF));
            const int adj = (r & 1) ? 0 : -1;
            const int bq = r & 3;
#define H3_LOAD(AF, BF, U) do { \
                _Pragma("unroll") for (int s2 = 0; s2 < 2; ++s2) { \
                    const unsigned* ap = (const unsigned*)(Ab + 64 * (3 - (U)) + 32 * s2); \
                    u32x4 t4; t4.x = ap[0]; t4.y = ap[1]; t4.z = ap[2]; t4.w = ap[3]; \
                    AF[s2] = __builtin_bit_cast(bf16x8, t4); } \
                _Pragma("unroll") for (int j = 0; j < 4; ++j) { \
                    int c_ = Lb - 256 * (U) + 2048 * j; c_ = c_ < LO ? LO : (c_ > HI ? HI : c_); \
                    BF[j][0] = *(const bf16x8*)(ub + c_ + off[U][0]); BF[j][1] = *(const bf16x8*)(ub + c_ + off[U][1]); } } while (0)
#define H3_MMA(AF, BF) do { \
                _Pragma("unroll") for (int s2 = 0; s2 < 2; ++s2) \
                _Pragma("unroll") for (int j = 0; j < 4; ++j) acc[j] = __builtin_amdgcn_mfma_f32_32x32x16_bf16(AF[s2], BF[j][s2], acc[j], 0, 0, 0); } while (0)
            {
                const int dlo = 32 * w4 - 127;
                const int LO = (24 + bq) * 64, HI = (540 + bq) * 64;
                int off[4][2];
#pragma unroll
                for (int u = 0; u < 4; ++u) { const int sw = ((r >> 2) + 2 - u) & 3; off[u][0] = (hh ^ sw) * 16; off[u][1] = ((2 + hh) ^ sw) * 16; }
                int Lb = (((r >> 2) + 134) * 4 + bq) * 64;
                const unsigned char* Ab = (const unsigned char*)(rsel + (4095 - 32 * dlo - r + 8 * hh + adj)) - 192;
                bf16x8 afA[2], bfA[4][2], afB[2], bfB[4][2];
                H3_LOAD(afA, bfA, 0);
                for (int g = 0; g < 39; ++g) {
                    H3_LOAD(afB, bfB, 1);
                    __builtin_amdgcn_sched_barrier(0);
                    H3_MMA(afA, bfA);
                    __builtin_amdgcn_sched_barrier(0);
                    H3_LOAD(afA, bfA, 2);
                    __builtin_amdgcn_sched_barrier(0);
                    H3_MMA(afB, bfB);
                    __builtin_amdgcn_sched_barrier(0);
                    H3_LOAD(afB, bfB, 3);
                    __builtin_amdgcn_sched_barrier(0);
                    H3_MMA(afA, bfA);
                    __builtin_amdgcn_sched_barrier(0);
                    Ab -= 256; Lb -= 1024;
                    H3_LOAD(afA, bfA, 0);
                    __builtin_amdgcn_sched_barrier(0);
                    H3_MMA(afB, bfB);
                    __builtin_amdgcn_sched_barrier(0);
                }
                H3_LOAD(afB, bfB, 1);
                __builtin_amdgcn_sched_barrier(0);
                H3_MMA(afA, bfA);
                __builtin_amdgcn_sched_barrier(0);
                H3_LOAD(afA, bfA, 2);
                __builtin_amdgcn_sched_barrier(0);
                H3_MMA(afB, bfB);
                H3_MMA(afA, bfA);
            }
#undef H3_LOAD
#undef H3_MMA
            __syncthreads();
            const float bd = bias[d];
#pragma unroll
            for (int j = 0; j < 4; ++j) {
                const int n1 = 8 * (4 * w4 + j) + (r >> 2);
                const int col = (n1 + 7) * 4 + bq; const int sw = (col >> 2) & 3;
                bf16_t* up = (bf16_t*)(ub + col * 64);
#pragma unroll
                for (int q4 = 0; q4 < 4; ++q4) {
                    bf16_t* pp = up + ((q4 ^ sw) * 8) + 4 * hh;
                    const bf16x4 uv = *(const bf16x4*)pp;
                    uint2 o2; o2.x = pg8::cvt_pk_bf16(acc[j][4 * q4] + bd * bf2f((bf16_t)uv[0]), acc[j][4 * q4 + 1] + bd * bf2f((bf16_t)uv[1]));
                    o2.y = pg8::cvt_pk_bf16(acc[j][4 * q4 + 2] + bd * bf2f((bf16_t)uv[2]), acc[j][4 * q4 + 3] + bd * bf2f((bf16_t)uv[3]));
                    *(uint2*)pp = o2;
                }
            }
            __syncthreads();
#pragma unroll 4
            for (int i = ct; i < 4 * 512; i += 256) { const int b = i >> 9, pc = i & 511;
                const int col = ((pc >> 2) + 7) * 4 + b, q = pc & 3;
                const bf16x8 yv = *(const bf16x8*)(ub + col * 64 + ((q ^ ((col >> 2) & 3)) * 16));
                const size_t gi = (size_t)d * TL + b * SEQ + pc * 8;
                const bf16x8 xv = *(const bf16x8*)(X0T + gi);
                u32x4 o4;
                o4.x = pg8::cvt_pk_bf16(bf2f((bf16_t)yv[0]) * bf2f((bf16_t)xv[0]), bf2f((bf16_t)yv[1]) * bf2f((bf16_t)xv[1]));
                o4.y = pg8::cvt_pk_bf16(bf2f((bf16_t)yv[2]) * bf2f((bf16_t)xv[2]), bf2f((bf16_t)yv[3]) * bf2f((bf16_t)xv[3]));
                o4.z = pg8::cvt_pk_bf16(bf2f((bf16_t)yv[4]) * bf2f((bf16_t)xv[4]), bf2f((bf16_t)yv[5]) * bf2f((bf16_t)xv[5]));
                o4.w = pg8::cvt_pk_bf16(bf2f((bf16_t)yv[6]) * bf2f((bf16_t)xv[6]), bf2f((bf16_t)yv[7]) * bf2f((bf16_t)xv[7]));
                *(u32x4*)(HMT + gi) = o4; }
        }
        __syncthreads();
    }
    if (ctx_full) {
        const float* VX = (const float*)(p.ws + WS_Y); const bf16_t* X0 = (const bf16_t*)(p.ws + WS_H);
        bf16_t* MIX = (bf16_t*)(p.ws + WS_MIX);
        const float* kf = (const float*)(p.ws + WS_KF + (size_t)o * SZ_KF) + (size_t)2 * SEQ * D;
        for (int idx = blockIdx.x * 512 + tid; idx < (TC / 8) * D; idx += gridDim.x * 512) {
            const int d = idx & 1023, og = idx >> 10;
            const int bb = og >> 5, n0 = (og & 31) * 8, tb = TL + bb * CL;
            const float* up = VX + (size_t)tb * D + d;
            float acc[8];
#pragma unroll
            for (int j = 0; j < 8; ++j) acc[j] = 0.f;
#pragma unroll 1
            for (int mb = 0; mb < CL; mb += 8) {
                float kk[15], uu[8];
#pragma unroll
                for (int q = 0; q < 15; ++q) { const int lag = n0 - mb - 7 + q;
                    kk[q] = (lag >= 0) ? ((lag < CL) ? kf[(size_t)lag * D + d] : 0.f) : ((-lag < CL) ? kf[(size_t)(CL - lag) * D + d] : 0.f); }
#pragma unroll
                for (int u = 0; u < 8; ++u) uu[u] = up[(size_t)(mb + u) * D];
#pragma unroll
                for (int u = 0; u < 8; ++u)
#pragma unroll
                    for (int j = 0; j < 8; ++j) acc[j] += uu[u] * kk[7 - u + j];
            }
            const float bd = bias[d];
#pragma unroll
            for (int j = 0; j < 8; ++j) { const size_t ti = (size_t)(tb + n0 + j) * D + d; MIX[ti] = f2bf(bf2f(X0[ti]) * (acc[j] + bd * VX[ti])); }
        }
    }
}

__device__ __forceinline__ void h3b_transpose(const KQ p_in, unsigned char* smem) {
    const KQ p = lq(p_in);
    const int tid = ltid();
    const bf16_t* HMT = (const bf16_t*)(p.ws + WS_H); bf16_t* MIX = (bf16_t*)(p.ws + WS_MIX);
    bf16_t* tile = (bf16_t*)smem;
    for (int it = blockIdx.x; it < (TL / 256) * 16; it += gridDim.x) {
        const int c0 = (it & 15) * 64, t0 = (it >> 4) * 256;
        u32x4 ld[4];
        { const int ch = tid >> 3, tk = (tid & 7) * 8;
#pragma unroll
          for (int q = 0; q < 4; ++q) ld[q] = *(const u32x4*)(HMT + (size_t)(c0 + ch) * TL + t0 + tk + 64 * q);
          __syncthreads();
#pragma unroll
          for (int q = 0; q < 4; ++q) *(u32x4*)(tile + ch * 264 + ((tk + 64 * q) ^ (((ch >> 3) & 7) << 3))) = ld[q]; }
        __syncthreads();
        { const int cg8 = (tid & 7) * 8;
#pragma unroll
          for (int q = 0; q < 4; ++q) { const int tok = (tid >> 3) + 64 * q; unsigned short v[8];
#pragma unroll
              for (int j = 0; j < 8; ++j) v[j] = tile[(cg8 + j) * 264 + (tok ^ ((tid & 7) << 3))];
              u32x4 o4; o4.x = v[0] | ((unsigned)v[1] << 16); o4.y = v[2] | ((unsigned)v[3] << 16); o4.z = v[4] | ((unsigned)v[5] << 16); o4.w = v[6] | ((unsigned)v[7] << 16);
              *(u32x4*)(MIX + (size_t)(t0 + tok) * D + c0 + cg8) = o4; } }
    }
    __syncthreads();
}

__global__ void __launch_bounds__(512, 2) mega_fwd(KP kp) {
    unsigned char* const smem = g_smem;
    if (threadIdx.x < 29) *(LAS unsigned long long*)((LAS unsigned char*)g_smem + PTAB_OFF + 8 * threadIdx.x) = ((const unsigned long long*)__builtin_amdgcn_kernarg_segment_ptr())[threadIdx.x];
    KQ p; p.out = kp.out; p.ws = kp.ws;
    cg::grid_group grid = cg::this_grid();
    if (threadIdx.x < 4) ((volatile LAS unsigned*)(LAS unsigned char*)smem)[(LDS_BYTES - 16) / 4 + threadIdx.x] = 0u;
    __syncthreads();
    if (threadIdx.x == 0) (void)xb_add(&((unsigned*)(lq(p).ws + WS_BAR))[XB_XCNT(xb_xcc_id())], 1u);
    grid.sync();
    float* smf = (float*)smem;
#define Hb ((bf16_t*)(lq(p).ws + WS_H))
#define BIG ((bf16_t*)(lq(p).ws + WS_BIG))
#define Y ((bf16_t*)(lq(p).ws + WS_Y))
#define MIX ((bf16_t*)(lq(p).ws + WS_MIX))

#ifndef NO_P0
    p0_setup(p, smf);
#endif
    GRID_BAR();
    rowphase(p, 0, nullptr, 0, 0, 0.f, nullptr, T, 0, pin_ld(6), 0, 1, Hb, true, 0);
    GRID_BAR();
    for (int l = 0; l < 4; ++l) {
        const bool ctx_live = l <= 2, ctx_full = l < 2;
        const int Mff = ctx_live ? T : TL, Mpost = ctx_full ? T : TL;
        for (int sub = 0; sub < 3; ++sub) {
            const bf16_t* Ao; const bf16_t* Bo; int Ko; int Mo;
            if (sub != 1) {
                const int fi = sub >> 1; const int M = (sub == 0) ? Mff : Mpost;
                { pg8::EpiSwiGLU E{BIG, DFF}; run_gemm(smem, Hb, (const bf16_t*)(lq(p).ws + WS_WGU + (size_t)(l * 2 + fi) * SZ_WGU), M, 2 * DFF, D, E); }
                GRID_BAR();
                Ao = BIG; Bo = (const bf16_t*)(lq(p).ws + WS_WD + (size_t)(l * 2 + fi) * SZ_WD); Ko = DFF; Mo = M;
            } else {
                if ((l & 1) == 0) {
                    const int e = l >> 1;
                    { pg8::EpiBf16 E{BIG, INW, nullptr}; run_gemm(smem, Hb, (const bf16_t*)(lq(p).ws + WS_WIN + (size_t)e * SZ_WIN), Mff, INW, D, E); }
                    GRID_BAR();
#ifndef NO_M1
                    m1_rope_states(p, e, smf);
#endif
                    GRID_BAR();
#ifndef NO_M3
                    m3_outputs(p, e, ctx_full, smem, (unsigned*)(lq(p).ws + WS_CNT) + (size_t)12 * 2 * 64 * 64 + (12 + e) * 64);
#endif
                    GRID_BAR();
                    Bo = (const bf16_t*)(lq(p).ws + WS_WOUT + (size_t)e * SZ_WOUT);
                } else {
                    const int o = l >> 1;
                    { pg8::EpiBf16 E{BIG, HYW, pin_ld(16) + (size_t)o * HYW}; run_gemm(smem, Hb, (const bf16_t*)(lq(p).ws + WS_HWIN + (size_t)o * SZ_HWIN), Mpost, HYW, D, E); }
                    GRID_BAR();
#ifndef NO_H2
                    h2_shortconv(p, o, Mpost, smem);
#endif
                    GRID_BAR();
#ifndef NO_H3
                    h3_longconv(p, o, ctx_full, smem);
#endif
                    GRID_BAR();
                    h3b_transpose(p, smem);
                    GRID_BAR();
                    Bo = (const bf16_t*)(lq(p).ws + WS_HWOUT + (size_t)o * SZ_WOUT);
                }
                Ao = MIX; Ko = D; Mo = Mpost;
            }
            const int gidx = 2 + 3 * sub;
            const int ln = (sub == 2) ? l + 1 : l; const bool has_next = ln < 4; const int lnn = has_next ? ln : l;
            const int pre_i = (sub == 2) ? 0 : sub + 1;
            const int Mn = has_next ? ((sub == 2) ? ((ln <= 2) ? T : TL) : ((sub == 0) ? Mff : Mpost)) : 0;
            const float* gpost = pin_ld(7) + (size_t)(l * 3 + sub) * D; const float* gpre = pin_ld(6) + (size_t)(lnn * 3 + pre_i) * D;
            const float wg = (sub == 1) ? 1.0f : 0.5f;
            {
                pg8::EpiFusedRow EF;
                EF.xin = (l == 0 && sub == 0) ? pin_ld(0) : (const float*)lq(p).out; EF.xout = lq(p).out; EF.H = has_next ? Hb : nullptr;
                EF.gate = modp(lq(p), l, 0, gidx); EF.gpost = gpost; EF.wgt = wg;
                EF.gpre = gpre; EF.shift = modp(lq(p), lnn, 0, 3 * pre_i); EF.scale = modp(lq(p), lnn, 0, 3 * pre_i + 1);
                EF.slots = (float*)(lq(p).ws + WS_SLOT); EF.cnt = (unsigned*)(lq(p).ws + WS_CNT) + (size_t)(l * 3 + sub) * 2 * 64 * 64;
                run_gemm_f32_split(smem, Ao, Bo, Mo, Ko, EF, (float*)(lq(p).ws + WS_YP));
            }
            if (Mo > TL && blockIdx.x < 64) {
                sub_barrier((unsigned*)(lq(p).ws + WS_CNT) + (size_t)12 * 2 * 64 * 64 + (l * 3 + sub) * 64, 64u);
                rowphase(p, Mo, Y, l, gidx, wg, gpost, Mn, lnn, gpre, 3 * pre_i, 3 * pre_i + 1, has_next ? Hb : nullptr, l == 0 && sub == 0, TL);
            }
            GRID_BAR();
        }
    }
}

extern "C" void kernel_launch(void* const* d_in, const int* in_sizes, int n_in, void* d_out, int out_size, void* d_ws, size_t ws_size, hipStream_t stream) {
    static int grid = 0;
    if (grid == 0) {
        if (n_in != 29 || out_size != TL * D || ws_size < WS_END) { fprintf(stderr, "kernel_launch: unexpected shapes: n_in %d out %d ws %zu (need %zu)\n", n_in, out_size, ws_size, (size_t)WS_END); grid = -1; return; }
        int dev = 0, cus = 0, per_cu = 0;
        (void)hipGetDevice(&dev);
        (void)hipDeviceGetAttribute(&cus, hipDeviceAttributeMultiprocessorCount, dev);
        if (hipFuncSetAttribute((const void*)mega_fwd, hipFuncAttributeMaxDynamicSharedMemorySize, LDS_BYTES) != hipSuccess) { fprintf(stderr, "kernel_launch: hipFuncSetAttribute failed\n"); grid = -1; return; }
        if (hipOccupancyMaxActiveBlocksPerMultiprocessor(&per_cu, (const void*)mega_fwd, 512, LDS_BYTES) != hipSuccess || per_cu < 1) { fprintf(stderr, "kernel_launch: occupancy query says %d\n", per_cu); per_cu = 1; }
        (void)hipGetLastError();
        grid = cus >= 256 ? 256 : cus;
    }
    if (grid < 0) return;
    (void)hipMemsetAsync((unsigned char*)d_ws + WS_BAR, 0, 16384 + SZ_CNT, stream);
    KP kp{};
    for (int i = 0; i < 29; ++i) kp.in[i] = (const float*)d_in[i];
    kp.out = (float*)d_out; kp.ws = (unsigned char*)d_ws;
    void* args[] = {&kp};
    hipError_t e = hipLaunchCooperativeKernel((const void*)mega_fwd, dim3(grid), dim3(512), args, LDS_BYTES, stream);
    if (e != hipSuccess) fprintf(stderr, "cooperative launch failed: %s (grid %d)\n", hipGetErrorString(e), grid);
}
```

```cpp
#include <hip/hip_runtime.h>
#include <hip/hip_cooperative_groups.h>
#include <cstdio>
namespace cg = cooperative_groups;

#define LAS __attribute__((address_space(3)))
typedef unsigned short bf16_t;
typedef short bf16x8 __attribute__((ext_vector_type(8)));
typedef short bf16x4 __attribute__((ext_vector_type(4)));
typedef float f32x4 __attribute__((ext_vector_type(4)));
typedef unsigned u32x4 __attribute__((ext_vector_type(4)));

constexpr int D = 1024, NB = 4, SEQ = 4096, CL = 256, TL = NB * SEQ, TC = NB * CL, T = TL + TC, DFF = 2816, INW = 2816, HYW = 3072;
constexpr int NMOD = 9;
constexpr float EPS = 1e-6f;
constexpr int NCH = 34;
constexpr int LDS_BYTES = 144 * 1024;

constexpr size_t SZ_WGU = (size_t)2 * DFF * D * 2, SZ_WD = (size_t)D * DFF * 2, SZ_WIN = (size_t)INW * D * 2, SZ_WOUT = (size_t)D * D * 2, SZ_HWIN = (size_t)HYW * D * 2;
constexpr size_t WS_WGU = 0;
constexpr size_t WS_WD = WS_WGU + 8 * SZ_WGU;
constexpr size_t WS_WIN = WS_WD + 8 * SZ_WD;
constexpr size_t WS_WOUT = WS_WIN + 2 * SZ_WIN;
constexpr size_t WS_HWIN = WS_WOUT + 2 * SZ_WOUT;
constexpr size_t WS_HWOUT = WS_HWIN + 2 * SZ_HWIN;
constexpr size_t WS_MOD = WS_HWOUT + 2 * SZ_WOUT;
constexpr size_t WS_ROPE = WS_MOD + (size_t)4 * 5 * NMOD * D * 4;
constexpr size_t WS_XC = WS_ROPE + (size_t)4 * SEQ * 32 * 4;
constexpr size_t WS_H = WS_XC + (size_t)TC * D * 4;
constexpr size_t WS_BIG = WS_H + (size_t)T * D * 2;
constexpr size_t WS_Y = WS_BIG + (size_t)T * HYW * 2;
constexpr size_t WS_MIX = WS_Y + (size_t)T * D * 4;
constexpr size_t SZ_ST = (size_t)NB * NCH * 8 * 4096 * 4;
constexpr size_t WS_ST = WS_MIX + (size_t)T * D * 2;
constexpr size_t SZ_KF = (size_t)(SEQ + CL) * 2 * D * 4;
constexpr size_t WS_KF = WS_ST + 4 * SZ_ST;
constexpr size_t WS_YP = WS_KF + 2 * SZ_KF;
constexpr size_t WS_BAR = WS_YP + (size_t)4 * TC * D * 4;
constexpr size_t WS_CNT = WS_BAR + 16384;
constexpr size_t SZ_CNT = (size_t)12 * 2 * 64 * 256 + 16 * 256;
constexpr size_t WS_SLOT = WS_CNT + SZ_CNT;
constexpr size_t WS_END = WS_SLOT + (size_t)2 * TL * 4 * 4;

struct KP { const float* in[29]; float* out; unsigned char* ws; };
extern __shared__ __attribute__((aligned(16))) unsigned char g_smem[];
constexpr int PTAB_OFF = LDS_BYTES - 512;
__device__ __forceinline__ const float* pin_ld(int k) {
    const unsigned long long v = *(volatile LAS unsigned long long*)((LAS unsigned char*)g_smem + PTAB_OFF + 8 * k);
    const unsigned lo = __builtin_amdgcn_readfirstlane((unsigned)v), hi = __builtin_amdgcn_readfirstlane((unsigned)(v >> 32));
    return (const float*)(((unsigned long long)hi << 32) | lo);
}
struct KQ { float* out; unsigned char* ws; };
__device__ __forceinline__ KQ lq(KQ q) { asm volatile("" : "+s"(q.out), "+s"(q.ws)); return q; }

__device__ __forceinline__ bf16_t f2bf(float f) { unsigned u = __float_as_uint(f); u += 0x7FFFu + ((u >> 16) & 1u); return (bf16_t)(u >> 16); }
__device__ __forceinline__ float bf2f(bf16_t b) { return __uint_as_float(((unsigned)b) << 16); }
__device__ __forceinline__ float silu_f(float x) { return x * __builtin_amdgcn_rcpf(1.0f + __expf(-x)); }
__device__ __forceinline__ int ltid() { int t = threadIdx.x; asm volatile("" : "+v"(t)); return t; }
__device__ __forceinline__ float wave_sum(float v) {
#pragma unroll
    for (int o = 32; o > 0; o >>= 1) v += __shfl_xor(v, o, 64);
    return v;
}


#define XB_TMO      128
#define XB_XCNT(j)  (256  + 64 * (j))
#define XB_XSUB(j)  (1280 + 64 * (j))
#define XB_XGEN(j)  (2304 + 64 * (j))
#define XB_TOP      3328
#define XB_TOPGEN   3392
#define XCD_BAR_WORDS 3456
#define XB_SPIN_CAP (1u << 18)
__device__ __forceinline__ unsigned xb_ld(unsigned* p)              { return __hip_atomic_load(p, __ATOMIC_RELAXED, __HIP_MEMORY_SCOPE_AGENT); }
__device__ __forceinline__ unsigned xb_add(unsigned* p, unsigned v) { return __hip_atomic_fetch_add(p, v, __ATOMIC_RELAXED, __HIP_MEMORY_SCOPE_AGENT); }
__device__ __forceinline__ unsigned xb_xcc_id() { return (unsigned)__builtin_amdgcn_s_getreg((3 << 11) | 20) & 0xFu; }
#define XB_SPIN(cond, bar) do { unsigned _sp = 0; while (cond) { __builtin_amdgcn_s_sleep(1); \
    if ((++_sp & 255u) == 0u) { if (xb_ld(&(bar)[XB_TMO])) break; if (_sp > XB_SPIN_CAP) { atomicAdd(&(bar)[XB_TMO], 1u); break; } } } } while (0)
struct XcdBarrier { unsigned* bar; unsigned x; volatile LAS unsigned* st; };
__device__ __forceinline__ XcdBarrier xcd_barrier_post(unsigned* bar, volatile LAS unsigned* st) {
    XcdBarrier b; b.bar = bar; b.x = xb_xcc_id(); b.st = st;
    if (threadIdx.x == 0) (void)xb_add(&bar[XB_XCNT(b.x)], 1u);
    return b;
}
__device__ __forceinline__ void xcd_barrier_complete(unsigned* bar, unsigned x, unsigned& nloc, unsigned& nx) {
    const unsigned G = gridDim.x * gridDim.y * gridDim.z;
    unsigned sum, cnt, mine, sp = 0u;
    for (;;) {
        sum = 0u; cnt = 0u; mine = 0u;
#pragma unroll
        for (unsigned j = 0; j < 16; ++j) { const unsigned c = xb_ld(&bar[XB_XCNT(j)]); sum += c; cnt += (c > 0u) ? 1u : 0u; mine = (j == x) ? c : mine; }
        if (sum == G) break;
        __builtin_amdgcn_s_sleep(1);
        if ((++sp & 255u) == 0u) { if (xb_ld(&bar[XB_TMO])) break; if (sp > XB_SPIN_CAP) { atomicAdd(&bar[XB_TMO], 1u); break; } }
    }
    nloc = mine > 0u ? mine : 1u; nx = cnt > 0u ? cnt : 1u;
}
__device__ __forceinline__ void xcd_barrier_impl(unsigned* bar, volatile LAS unsigned* st) {
    asm volatile("s_waitcnt vmcnt(0)" ::: "memory");
    __syncthreads();
    if (ltid() == 0) {
        const unsigned x = xb_xcc_id();
        __builtin_amdgcn_s_waitcnt(0);
        unsigned nloc = st[0], nx = st[1];
        if (nloc == 0u) { xcd_barrier_complete(bar, x, nloc, nx); st[0] = nloc; st[1] = nx; }
        const unsigned old = xb_add(&bar[XB_XSUB(x)], 1u);
        const unsigned gen = old / nloc;
        if (old + 1u == (gen + 1u) * nloc) {
            __builtin_amdgcn_fence(__ATOMIC_RELEASE, "agent");
            asm volatile("s_waitcnt vmcnt(0)" ::: "memory");
            const unsigned og = xb_add(&bar[XB_TOP], 1u);
            const unsigned tg = og / nx;
            if (og + 1u == (tg + 1u) * nx) xb_add(&bar[XB_TOPGEN], 1u);
            else XB_SPIN(xb_ld(&bar[XB_TOPGEN]) == tg, bar);
            __builtin_amdgcn_fence(__ATOMIC_ACQUIRE, "agent");
            xb_add(&bar[XB_XGEN(x)], 1u);
            asm volatile("s_waitcnt vmcnt(0)" ::: "memory");
        } else {
            XB_SPIN(xb_ld(&bar[XB_XGEN(x)]) == gen, bar);
            __builtin_amdgcn_fence(__ATOMIC_ACQUIRE, "agent");
            asm volatile("s_waitcnt vmcnt(0)" ::: "memory");
        }
    }
    __syncthreads();
}
__device__ __forceinline__ void sub_barrier(unsigned* word, unsigned n) {
    asm volatile("s_waitcnt vmcnt(0)" ::: "memory");
    __syncthreads();
    if (ltid() == 0) {
        __builtin_amdgcn_fence(__ATOMIC_RELEASE, "agent");
        asm volatile("s_waitcnt vmcnt(0)" ::: "memory");
        (void)xb_add(word, 1u);
        for (unsigned sp = 0; sp < (1u << 21); ++sp) { if (xb_ld(word) >= n) break; __builtin_amdgcn_s_sleep(2); }
        __builtin_amdgcn_fence(__ATOMIC_ACQUIRE, "agent");
        asm volatile("s_waitcnt vmcnt(0)" ::: "memory");
    }
    __syncthreads();
}
__device__ __forceinline__ void sub_arrive(unsigned* word) {
    asm volatile("s_waitcnt vmcnt(0)" ::: "memory");
    __syncthreads();
    if (ltid() == 0) { __builtin_amdgcn_fence(__ATOMIC_RELEASE, "agent"); asm volatile("s_waitcnt vmcnt(0)" ::: "memory"); (void)xb_add(word, 1u); }
}
__device__ __forceinline__ void sub_wait(unsigned* word, unsigned n) {
    if (ltid() == 0) {
        for (unsigned sp = 0; sp < (1u << 21); ++sp) { if (xb_ld(word) >= n) break; __builtin_amdgcn_s_sleep(2); }
        __builtin_amdgcn_fence(__ATOMIC_ACQUIRE, "agent");
        asm volatile("s_waitcnt vmcnt(0)" ::: "memory");
    }
    __syncthreads();
}
#define GRID_BAR() xcd_barrier_impl((unsigned*)(p.ws + WS_BAR), (volatile LAS unsigned*)((LAS unsigned char*)smem + LDS_BYTES - 16))

namespace pg8 {
constexpr int BM = 256, BK = 64, HALF = 128, HTB = HALF * BK * 2, STAGE_BYTES = 8 * HTB, NXCD = 8, WGM = 8;
__host__ __device__ __forceinline__ int lds_byte(int r, int c) { const int st = (r >> 4) * 2 + (c >> 5), rr = r & 15, cc = c & 31, ob = rr * 64 + cc * 2; return st * 1024 + (ob ^ (((ob >> 9) & 1) << 5)); }
__host__ __device__ __forceinline__ void stage_rc(int b, int& R, int& C) { const int st = b / 1024, sb = b % 1024, swz = sb ^ (((sb >> 9) & 1) << 5); R = (st >> 1) * 16 + swz / 64; C = (st & 1) * 32 + (swz % 64) / 2; }
__host__ __device__ __forceinline__ int perm32(int rho) { const int n = rho >> 4, i = rho & 15; return 8 * (i >> 2) + 4 * n + (i & 3); }
struct Unit { int pm, pn; };
struct Gemm { const bf16_t* A; const bf16_t* Bt; int M, N, K, ld; };
struct StaticOrder {
    int nM, nN, nwg, G, c;
    __device__ void init(int M, int N, int G_, int c_) { nM = M / BM; nN = N / BM; nwg = nM * nN; G = G_; c = c_; }
    __device__ bool next(int i, Unit& u) const {
        const long Lx = (long)i * G + c; if (Lx >= nwg) return false;
        int wgid = (int)Lx; { const int q = nwg / NXCD, r = nwg % NXCD, xcd = wgid % NXCD, off = wgid / NXCD; wgid = (xcd < r ? xcd * (q + 1) : r * (q + 1) + (xcd - r) * q) + off; }
        const int nig = WGM * nN, gid = wgid / nig, fm = gid * WGM, gsz = (nM - fm) < WGM ? (nM - fm) : WGM;
        u.pm = fm + ((wgid % nig) % gsz); u.pn = (wgid % nig) / gsz; return true;
    }
};
__device__ __forceinline__ unsigned cvt_pk_bf16(float lo, float hi) { unsigned r; asm volatile("v_cvt_pk_bf16_f32 %0, %1, %2" : "=v"(r) : "v"(lo), "v"(hi)); return r; }

struct EpiF32 {
    static constexpr bool PERM = false, AFTER_DRAIN = false;
    float* C; int ldc;
    __device__ __forceinline__ void operator()(const f32x4 (&acc)[2][2][4][2], const Unit& u, int wr, int wc, int fr, int fq) const {
        const int row0 = u.pm * BM + wr * 64 + fr, col0 = u.pn * BM + wc * 32 + 4 * fq;
#pragma unroll
        for (int ai = 0; ai < 2; ++ai)
#pragma unroll
            for (int m = 0; m < 4; ++m) { float* rowp = C + (size_t)(row0 + ai * HALF + m * 16) * ldc + col0;
#pragma unroll
                for (int bj = 0; bj < 2; ++bj)
#pragma unroll
                    for (int n = 0; n < 2; ++n) *(f32x4*)(rowp + bj * HALF + n * 16) = acc[ai][bj][m][n]; }
    }
};
struct EpiBf16 {
    static constexpr bool PERM = true, AFTER_DRAIN = false;
    bf16_t* O; int ldc; const float* bias;
    __device__ __forceinline__ void operator()(const f32x4 (&acc)[2][2][4][2], const Unit& u, int wr, int wc, int fr, int fq) const {
        const int row0 = u.pm * BM + wr * 64 + fr; const int col0 = u.pn * BM + wc * 32 + 8 * fq;
        f32x4 bv[2][2];
#pragma unroll
        for (int bj = 0; bj < 2; ++bj)
#pragma unroll
            for (int n = 0; n < 2; ++n) bv[bj][n] = bias ? *(const f32x4*)(bias + col0 + bj * HALF + 4 * n) : (f32x4){0.f, 0.f, 0.f, 0.f};
#pragma unroll
        for (int ai = 0; ai < 2; ++ai)
#pragma unroll
            for (int m = 0; m < 4; ++m) { bf16_t* rowp = O + (size_t)(row0 + ai * HALF + m * 16) * ldc + col0;
#pragma unroll
                for (int bj = 0; bj < 2; ++bj) { f32x4 v0 = acc[ai][bj][m][0] + bv[bj][0], v1 = acc[ai][bj][m][1] + bv[bj][1];
                    u32x4 w; w.x = cvt_pk_bf16(v0[0], v0[1]); w.y = cvt_pk_bf16(v0[2], v0[3]); w.z = cvt_pk_bf16(v1[0], v1[1]); w.w = cvt_pk_bf16(v1[2], v1[3]);
                    *(u32x4*)(rowp + bj * HALF) = w; } }
    }
};
struct EpiSwiGLU {
    static constexpr bool PERM = true, AFTER_DRAIN = false;
    bf16_t* O; int ldc;
    __device__ __forceinline__ void operator()(const f32x4 (&acc)[2][2][4][2], const Unit& u, int wr, int wc, int fr, int fq) const {
        const int row0 = u.pm * BM + wr * 64 + fr; const int col0 = u.pn * HALF + wc * 32 + 8 * fq;
#pragma unroll
        for (int ai = 0; ai < 2; ++ai)
#pragma unroll
            for (int m = 0; m < 4; ++m) { bf16_t* rowp = O + (size_t)(row0 + ai * HALF + m * 16) * ldc + col0;
                float v[8];
#pragma unroll
                for (int n = 0; n < 2; ++n)
#pragma unroll
                    for (int j = 0; j < 4; ++j) { const float g = acc[ai][0][m][n][j], up = acc[ai][1][m][n][j]; v[n * 4 + j] = silu_f(g) * up; }
                u32x4 w; w.x = cvt_pk_bf16(v[0], v[1]); w.y = cvt_pk_bf16(v[2], v[3]); w.z = cvt_pk_bf16(v[4], v[5]); w.w = cvt_pk_bf16(v[6], v[7]);
                *(u32x4*)rowp = w; }
    }
};


__device__ __forceinline__ void row_exchange(const f32x4 (&v)[2][2][4][2], const Unit& u, int wr, int wc, int fr, int fq, LAS unsigned char* lds, int wid, int lane, float* slots, unsigned* cnt) {
    LAS float* P = (LAS float*)lds;
    LAS float* S = (LAS float*)(lds + 4096);
#pragma unroll
    for (int ai = 0; ai < 2; ++ai)
#pragma unroll
        for (int m = 0; m < 4; ++m) {
            float sq = 0.f;
#pragma unroll
            for (int bj = 0; bj < 2; ++bj)
#pragma unroll
                for (int n = 0; n < 2; ++n) { const f32x4 x = v[ai][bj][m][n]; sq += (x[0] * x[0] + x[1] * x[1]) + (x[2] * x[2] + x[3] * x[3]); }
            sq += __shfl_xor(sq, 16); sq += __shfl_xor(sq, 32);
            if (fq == 0) P[(ai * HALF + wr * 64 + m * 16 + fr) * 4 + wc] = sq;
        }
    asm volatile("s_waitcnt lgkmcnt(0)" ::: "memory"); __builtin_amdgcn_s_barrier(); asm volatile("" ::: "memory");
    const int row = wid * 32 + (lane & 31);
    if (lane < 32) {
        const float tot = (P[row * 4 + 0] + P[row * 4 + 1]) + (P[row * 4 + 2] + P[row * 4 + 3]);
        __hip_atomic_store((unsigned*)slots + ((size_t)(u.pm * BM + row) * 4 + u.pn), __float_as_uint(tot), __ATOMIC_RELAXED, __HIP_MEMORY_SCOPE_AGENT);
    }
    asm volatile("s_waitcnt vmcnt(0)" ::: "memory");
    if (lane == 0) __hip_atomic_fetch_add(cnt + 64 * u.pm, 1u, __ATOMIC_RELAXED, __HIP_MEMORY_SCOPE_AGENT);
    if (wid == 0) {
        for (unsigned sp = 0; sp < (1u << 21); ++sp) {
            if ((unsigned)__builtin_amdgcn_readfirstlane(__hip_atomic_load(cnt + 64 * u.pm, __ATOMIC_RELAXED, __HIP_MEMORY_SCOPE_AGENT)) >= 32u) break;
            __builtin_amdgcn_s_sleep(2);
        }
        __builtin_amdgcn_fence(__ATOMIC_ACQUIRE, "agent");
    }
    asm volatile("s_waitcnt vmcnt(0) lgkmcnt(0)" ::: "memory"); __builtin_amdgcn_s_barrier(); asm volatile("" ::: "memory");
    if (lane < 32) {
        const unsigned* sl = (const unsigned*)slots + (size_t)(u.pm * BM + row) * 4;
        float tot = 0.f;
#pragma unroll
        for (int t = 0; t < 4; ++t) tot += __uint_as_float(__hip_atomic_load(sl + t, __ATOMIC_RELAXED, __HIP_MEMORY_SCOPE_AGENT));
        S[row] = tot;
    }
    asm volatile("s_waitcnt vmcnt(0) lgkmcnt(0)" ::: "memory"); __builtin_amdgcn_s_barrier(); asm volatile("" ::: "memory");
}
struct EpiFusedRow {
    static constexpr bool PERM = false, AFTER_DRAIN = true;
    const float* xin; float* xout; bf16_t* H;
    const float* gate; const float* gpost; float wgt;
    const float* gpre; const float* shift; const float* scale;
    float* slots; unsigned* cnt;
    __device__ __forceinline__ void operator()(const f32x4 (&)[2][2][4][2], const Unit&, int, int, int, int) const {}
    __device__ __forceinline__ void fused(f32x4 (&acc)[2][2][4][2], const Unit& u, int wr, int wc, int fr, int fq, LAS unsigned char* lds, int wid, int lane) const {
        const LAS float* S = (const LAS float*)(lds + 4096);
        const int col0 = u.pn * BM + wc * 32 + 4 * fq; const size_t mb = (size_t)(u.pm >> 4) * (NMOD * D);
        f32x4 cw[2][2];
#pragma unroll
        for (int bj = 0; bj < 2; ++bj)
#pragma unroll
            for (int n = 0; n < 2; ++n) cw[bj][n] = *(const f32x4*)(gate + mb + col0 + bj * HALF + n * 16) * *(const f32x4*)(gpost + col0 + bj * HALF + n * 16);
        row_exchange(acc, u, wr, wc, fr, fq, lds, wid, lane, slots, cnt);
        {
#pragma unroll
            for (int ai = 0; ai < 2; ++ai)
#pragma unroll
                for (int m = 0; m < 4; ++m) { const int r = ai * HALF + wr * 64 + m * 16 + fr; const float r1 = rsqrtf(S[r] * (1.0f / D) + EPS) * wgt; const size_t off = (size_t)(u.pm * BM + r) * D + col0;
#pragma unroll
                    for (int bj = 0; bj < 2; ++bj)
#pragma unroll
                        for (int n = 0; n < 2; ++n) { const f32x4 xv = *(const f32x4*)(xin + off + bj * HALF + n * 16); const f32x4 xn = xv + (cw[bj][n] * r1) * acc[ai][bj][m][n];
                            acc[ai][bj][m][n] = xn; *(f32x4*)(xout + off + bj * HALF + n * 16) = xn; }
                    asm volatile("" : "+v"(acc[ai][0][m][0]), "+v"(acc[ai][0][m][1]), "+v"(acc[ai][1][m][0]), "+v"(acc[ai][1][m][1]));
                    asm volatile("" ::: "memory"); }
        }
        if (H == nullptr) return;
        f32x4 gm[2][2], sh[2][2];
#pragma unroll
        for (int bj = 0; bj < 2; ++bj)
#pragma unroll
            for (int n = 0; n < 2; ++n) { const int c = col0 + bj * HALF + n * 16; gm[bj][n] = *(const f32x4*)(gpre + c) * (*(const f32x4*)(scale + mb + c) + 1.0f); sh[bj][n] = *(const f32x4*)(shift + mb + c); }
        row_exchange(acc, u, wr, wc, fr, fq, lds, wid, lane, slots + (size_t)TL * 4, cnt + 64 * 64);
        {
#pragma unroll
            for (int ai = 0; ai < 2; ++ai)
#pragma unroll
                for (int m = 0; m < 4; ++m) { const int r = ai * HALF + wr * 64 + m * 16 + fr; const float r2 = rsqrtf(S[r] * (1.0f / D) + EPS); const size_t off = (size_t)(u.pm * BM + r) * D + col0;
#pragma unroll
                    for (int bj = 0; bj < 2; ++bj)
#pragma unroll
                        for (int n = 0; n < 2; ++n) { const f32x4 hv = (acc[ai][bj][m][n] * r2) * gm[bj][n] + sh[bj][n];
                            uint2 w2; w2.x = cvt_pk_bf16(hv[0], hv[1]); w2.y = cvt_pk_bf16(hv[2], hv[3]); *(uint2*)(H + off + bj * HALF + n * 16) = w2; }
                    asm volatile("" ::: "memory"); }
        }
    }
};

template <class Epi, class Sched>
__device__ __forceinline__ void gemm_phase(LAS unsigned char* lds, const Gemm g, const Sched& S, const Epi& E) {
    const int tid = ltid(), wid = __builtin_amdgcn_readfirstlane(tid >> 6), lane = tid & 63, wr = wid >> 2, wc = wid & 3, fr = lane & 15, fq = lane >> 4;
    const int K = g.ld, nt = g.K / BK;
    unsigned voffA[2], voffB[2];
#pragma unroll
    for (int i = 0; i < 2; ++i) { int R, C; stage_rc(tid * 16 + i * 8192, R, C); const int Rb = Epi::PERM ? ((R & ~31) + perm32(R & 31)) : R;
        voffA[i] = (unsigned)(R * K + C) * 2u; voffB[i] = (unsigned)(Rb * K + C) * 2u; }
    const size_t kstep = (size_t)(BK * 2);
    const size_t hstep = (size_t)HALF * K * 2;
    const size_t tstep = 2 * hstep;
    const unsigned ldsw = (unsigned)wid * 1024u;
    const int aoff = lds_byte(wr * 64 + fr, fq * 8), boff = lds_byte(wc * 32 + fr, fq * 8);
#define PG8_SA(b, h) (((b) * 2 + (h)) * HTB)
#define PG8_SB(b, h) ((4 + (b) * 2 + (h)) * HTB)
#define PG8_STAGE(bufoff, gbase, voff) do { _Pragma("unroll") for (int _i = 0; _i < 2; ++_i) \
        __builtin_amdgcn_global_load_lds((const unsigned*)((const char*)(gbase) + (voff)[_i]), (LAS unsigned*)(lds + (bufoff) + ldsw + _i * 8192), 16, 0, 0); } while (0)
#define PG8_LDA(dst, b, h) do { _Pragma("unroll") for (int m = 0; m < 4; ++m) _Pragma("unroll") for (int k = 0; k < 2; ++k) dst[m][k] = *(const LAS bf16x8*)(lds + PG8_SA(b, h) + aoff + m * 2048 + k * 1024); } while (0)
#define PG8_LDB(dst, b, h) do { _Pragma("unroll") for (int n = 0; n < 2; ++n) _Pragma("unroll") for (int k = 0; k < 2; ++k) dst[n][k] = *(const LAS bf16x8*)(lds + PG8_SB(b, h) + boff + n * 2048 + k * 1024); } while (0)
#define PG8_MMA(ai, bj, At, Bt) do { __builtin_amdgcn_s_setprio(1); _Pragma("unroll") for (int m = 0; m < 4; ++m) _Pragma("unroll") for (int n = 0; n < 2; ++n) _Pragma("unroll") for (int k = 0; k < 2; ++k) \
        acc[ai][bj][m][n] = __builtin_amdgcn_mfma_f32_16x16x32_bf16(Bt[n][k], At[m][k], acc[ai][bj][m][n], 0, 0, 0); __builtin_amdgcn_s_setprio(0); } while (0)
#define PG8_WAIT_V(n) asm volatile("s_waitcnt vmcnt(" #n ")" ::: "memory")
#define PG8_WAIT_L(n) asm volatile("s_waitcnt lgkmcnt(" #n ")" ::: "memory")
#define PG8_BAR __builtin_amdgcn_s_barrier()
#define PG8_SCHED __builtin_amdgcn_sched_barrier(0)
    Unit cur, nxt; int ui = 0;
    if (!S.next(0, cur)) return;
    f32x4 acc[2][2][4][2];
#pragma unroll
    for (int a = 0; a < 2; ++a)
#pragma unroll
        for (int b = 0; b < 2; ++b)
#pragma unroll
            for (int m = 0; m < 4; ++m)
#pragma unroll
                for (int n = 0; n < 2; ++n) acc[a][b][m][n] = (f32x4){0.f, 0.f, 0.f, 0.f};
    bf16x8 At[4][2], B0[2][2], B1[2][2];
    const char* cA = (const char*)g.A + (size_t)cur.pm * tstep; const char* cB = (const char*)g.Bt + (size_t)cur.pn * tstep;
    PG8_STAGE(PG8_SB(0, 0), cB, voffB); PG8_STAGE(PG8_SA(0, 0), cA, voffA); PG8_STAGE(PG8_SB(0, 1), cB + hstep, voffB); PG8_STAGE(PG8_SA(0, 1), cA + hstep, voffA);
    if (wr == 1) PG8_BAR;
    PG8_WAIT_V(4); PG8_BAR;
    PG8_STAGE(PG8_SB(1, 0), cB + kstep, voffB); PG8_STAGE(PG8_SA(1, 0), cA + kstep, voffA); PG8_STAGE(PG8_SB(1, 1), cB + hstep + kstep, voffB);
    PG8_WAIT_V(6); PG8_BAR;
    for (;;) {
        const bool has_next = S.next(ui + 1, nxt);
        const char* nA = has_next ? (const char*)g.A + (size_t)nxt.pm * tstep : cA; const char* nB = has_next ? (const char*)g.Bt + (size_t)nxt.pn * tstep : cB;
        for (int t = 0; t < nt; t += 2) {
            const bool last = (t == nt - 2);
            const char* a1 = cA + (size_t)(t + 1) * kstep;
            const char* a2 = last ? nA : cA + (size_t)(t + 2) * kstep; const char* b2 = last ? nB : cB + (size_t)(t + 2) * kstep;
            const char* a3 = a2 + kstep; const char* b3 = b2 + kstep;
            PG8_LDB(B0, 0, 0); PG8_SCHED; PG8_LDA(At, 0, 0); PG8_STAGE(PG8_SA(1, 1), a1 + hstep, voffA);
            PG8_WAIT_L(8); PG8_BAR; PG8_WAIT_L(0); PG8_MMA(0, 0, At, B0); PG8_BAR; PG8_SCHED;
            PG8_LDB(B1, 0, 1); PG8_STAGE(PG8_SB(0, 0), b2, voffB);
            PG8_BAR; PG8_WAIT_L(0); PG8_MMA(0, 1, At, B1); PG8_BAR;
            PG8_LDA(At, 0, 1); PG8_STAGE(PG8_SA(0, 0), a2, voffA);
            PG8_BAR; PG8_WAIT_L(0); PG8_MMA(1, 0, At, B0); PG8_BAR; PG8_SCHED;
            PG8_STAGE(PG8_SB(0, 1), b2 + hstep, voffB);
            PG8_WAIT_V(6); PG8_BAR; PG8_MMA(1, 1, At, B1); PG8_BAR;
            PG8_LDB(B0, 1, 0); PG8_SCHED; PG8_LDA(At, 1, 0); PG8_STAGE(PG8_SA(0, 1), a2 + hstep, voffA);
            PG8_WAIT_L(8); PG8_BAR; PG8_WAIT_L(0); PG8_MMA(0, 0, At, B0); PG8_BAR; PG8_SCHED;
            PG8_LDB(B1, 1, 1); PG8_STAGE(PG8_SB(1, 0), b3, voffB);
            PG8_BAR; PG8_WAIT_L(0); PG8_MMA(0, 1, At, B1); PG8_BAR;
            PG8_LDA(At, 1, 1); PG8_STAGE(PG8_SA(1, 0), a3, voffA);
            PG8_BAR; PG8_WAIT_L(0); PG8_MMA(1, 0, At, B0); PG8_BAR; PG8_SCHED;
            PG8_STAGE(PG8_SB(1, 1), b3 + hstep, voffB);
            PG8_WAIT_V(6); PG8_BAR; PG8_MMA(1, 1, At, B1); PG8_BAR;
        }
        if constexpr (!Epi::AFTER_DRAIN) E(acc, cur, wr, wc, fr, fq);
        if (!has_next) break;
#pragma unroll
        for (int a = 0; a < 2; ++a)
#pragma unroll
            for (int b = 0; b < 2; ++b)
#pragma unroll
                for (int m = 0; m < 4; ++m)
#pragma unroll
                    for (int n = 0; n < 2; ++n) acc[a][b][m][n] = (f32x4){0.f, 0.f, 0.f, 0.f};
        cur = nxt; cA = nA; cB = nB; ++ui;
    }
    PG8_WAIT_V(0);
    if (wr == 0) PG8_BAR;
    PG8_BAR;
    if constexpr (Epi::AFTER_DRAIN) E.fused(acc, cur, wr, wc, fr, fq, lds, wid, lane);
#undef PG8_SA
#undef PG8_SB
#undef PG8_STAGE
#undef PG8_LDA
#undef PG8_LDB
#undef PG8_MMA
#undef PG8_WAIT_V
#undef PG8_WAIT_L
#undef PG8_BAR
#undef PG8_SCHED
}
}

template <class Epi>
__device__ __forceinline__ void run_gemm(unsigned char* smem, const bf16_t* A, const bf16_t* Bt, int M, int N, int K, const Epi& E) {
    pg8::Gemm g{A, Bt, M, N, K, K}; pg8::StaticOrder S; S.init(M, N, (int)gridDim.x, (int)blockIdx.x);
    pg8::gemm_phase<Epi, pg8::StaticOrder>((LAS unsigned char*)smem, g, S, E);
}
__device__ __forceinline__ void run_gemm_f32_split(unsigned char* smem, const bf16_t* A, const bf16_t* Bt, int M, int K, const pg8::EpiFusedRow& EF, float* YP) {
    { pg8::Gemm g{A, Bt, TL, D, K, K}; pg8::StaticOrder S; S.init(TL, D, (int)gridDim.x, (int)blockIdx.x);
      pg8::gemm_phase<pg8::EpiFusedRow, pg8::StaticOrder>((LAS unsigned char*)smem, g, S, EF); }
    __syncthreads();
    if (M > TL && blockIdx.x < 64) {
        const int ks = blockIdx.x >> 4;
        int koff, klen;
        if (K == DFF) { koff = (ks < 2) ? ks * 768 : 1536 + (ks - 2) * 640; klen = (ks < 2) ? 768 : 640; }
        else { klen = K / 4; koff = ks * klen; }
        pg8::Gemm g{A + (size_t)TL * K + koff, Bt + koff, TC, D, klen, K}; pg8::StaticOrder S; S.init(TC, D, 16, (int)(blockIdx.x & 15)); pg8::EpiF32 E{YP + (size_t)ks * TC * D, D};
        pg8::gemm_phase<pg8::EpiF32, pg8::StaticOrder>((LAS unsigned char*)smem, g, S, E);
        __syncthreads();
    }
}

__device__ __forceinline__ float* xrow(const KQ p, int t) { return t < TL ? p.out + (size_t)t * D : (float*)(p.ws + WS_XC) + (size_t)(t - TL) * D; }
__device__ __forceinline__ int modrow(int t) { return t < TL ? (t >> 12) : 4; }
__device__ __forceinline__ const float* modp(const KQ p, int l, int mr, int idx) { return (const float*)(p.ws + WS_MOD) + ((size_t)(l * 5 + mr) * NMOD + idx) * D; }

__device__ __forceinline__ void p0_setup(const KQ p_in, float* sm) {
    const KQ p = lq(p_in);
    const int tid = ltid(), bid = blockIdx.x, nb = gridDim.x;
    const int gtid = bid * 512 + tid, gthreads = nb * 512;
    {
        float* rope = (float*)(p.ws + WS_ROPE);
        for (int idx = gtid; idx < SEQ * 32; idx += gthreads) {
            const int t = idx >> 5, i = idx & 31;
            const int ii = i & 15; const float pos = (i < 16) ? (float)(t >> 6) : (float)(t & 63);
            const float invA = powf(10000.0f, -(float)ii / 16.0f);
            const float angA = pos * invA;
            rope[idx] = cosf(angA); rope[SEQ * 32 + idx] = sinf(angA);
            const float ex = (float)i * (1.0f / 31.0f);
            const float invR = powf(10000.0f, -ex);
            const float angR = (float)t * invR;
            rope[2 * SEQ * 32 + idx] = cosf(angR); rope[3 * SEQ * 32 + idx] = sinf(angR);
        }
    }
    {
        float* tile = sm;
        for (int gs = bid; gs < 20864 / 4; gs += nb) {
            const int g = gs * 4;
            int j, tl;
            if (g < 16896) { j = g / 704; tl = g % 704; }
            else if (g < 18304) { j = 24 + (g - 16896) / 704; tl = (g - 16896) % 704; }
            else if (g < 18816) { j = 26 + (g - 18304) / 256; tl = (g - 18304) % 256; }
            else if (g < 20352) { j = 28 + (g - 18816) / 768; tl = (g - 18816) % 768; }
            else { j = 30 + (g - 20352) / 256; tl = (g - 20352) % 256; }
            const float* src; bf16_t* dst; int K, N, mode = 0;
            if (j < 8) { src = pin_ld(8) + (size_t)j * D * DFF; dst = (bf16_t*)(p.ws + WS_WGU + (size_t)j * SZ_WGU); K = D; N = DFF; mode = 1; }
            else if (j < 16) { src = pin_ld(9) + (size_t)(j - 8) * D * DFF; dst = (bf16_t*)(p.ws + WS_WGU + (size_t)(j - 8) * SZ_WGU); K = D; N = DFF; mode = 2; }
            else if (j < 24) { src = pin_ld(10) + (size_t)(j - 16) * DFF * D; dst = (bf16_t*)(p.ws + WS_WD + (size_t)(j - 16) * SZ_WD); K = DFF; N = D; }
            else if (j < 26) { src = pin_ld(11) + (size_t)(j - 24) * D * INW; dst = (bf16_t*)(p.ws + WS_WIN + (size_t)(j - 24) * SZ_WIN); K = D; N = INW; mode = 3; }
            else if (j < 28) { src = pin_ld(14) + (size_t)(j - 26) * D * D; dst = (bf16_t*)(p.ws + WS_WOUT + (size_t)(j - 26) * SZ_WOUT); K = D; N = D; }
            else if (j < 30) { src = pin_ld(15) + (size_t)(j - 28) * D * HYW; dst = (bf16_t*)(p.ws + WS_HWIN + (size_t)(j - 28) * SZ_HWIN); K = D; N = HYW; }
            else { src = pin_ld(28) + (size_t)(j - 30) * D * D; dst = (bf16_t*)(p.ws + WS_HWOUT + (size_t)(j - 30) * SZ_WOUT); K = D; N = D; }
            const int ntn = N / 64; const int k0 = (tl / ntn) * 64, n0 = (tl % ntn) * 64;
            f32x4 ld[8];
#pragma unroll
            for (int i = 0; i < 8; ++i) ld[i] = *(const f32x4*)(src + (size_t)(k0 + i * 8 + (tid >> 6)) * N + n0 + (tid & 63) * 4);
            __syncthreads();
#pragma unroll
            for (int i = 0; i < 8; ++i) *(f32x4*)(tile + (i * 8 + (tid >> 6)) * 260 + (tid & 63) * 4) = ld[i];
            __syncthreads();
            {
                const int n = tid >> 1, kh = (tid & 1) * 32; const int gn = n0 + n;
                float sc_ = 1.0f; int row = gn;
                if (mode == 1) row = 256 * (gn >> 7) + (gn & 127);
                else if (mode == 2) row = 256 * (gn >> 7) + 128 + (gn & 127);
                else if (mode == 3) { if (gn < 512 || (gn >= 1792 && gn < 2304)) sc_ = 0.125f; }
#pragma unroll
                for (int q = 0; q < 4; ++q) {
                    float v[8];
#pragma unroll
                    for (int jj = 0; jj < 8; ++jj) v[jj] = tile[(kh + q * 8 + jj) * 260 + n] * sc_;
                    u32x4 o4; o4.x = pg8::cvt_pk_bf16(v[0], v[1]); o4.y = pg8::cvt_pk_bf16(v[2], v[3]); o4.z = pg8::cvt_pk_bf16(v[4], v[5]); o4.w = pg8::cvt_pk_bf16(v[6], v[7]);
                    *(u32x4*)(dst + (size_t)row * K + k0 + kh + q * 8) = o4;
                }
            }
        }
        __syncthreads();
    }
    {
        float* sc = sm;
        float* red = sm + 5 * 1024;
        for (int i = tid; i < 5 * 1024; i += 512) { const int r = i >> 10, k = i & 1023; const float v = (r < 4) ? pin_ld(1)[r * D + k] : pin_ld(3)[k]; sc[i] = silu_f(v); }
        __syncthreads();
        const int w = tid >> 6, lane = tid & 63;
        for (int it = bid; it < 288; it += nb) {
            const int l = it / 72, c0 = (it % 72) * 128;
            const float* wm = pin_ld(4) + (size_t)l * D * (NMOD * D) + c0 + 2 * lane;
            float a[5][2];
#pragma unroll
            for (int r = 0; r < 5; ++r) { a[r][0] = 0.f; a[r][1] = 0.f; }
            for (int kb = w * 128; kb < w * 128 + 128; kb += 16) {
                float2 wv[16];
#pragma unroll
                for (int q = 0; q < 16; ++q) wv[q] = *(const float2*)(wm + (size_t)(kb + q) * (NMOD * D));
#pragma unroll
                for (int q = 0; q < 16; ++q)
#pragma unroll
                    for (int r = 0; r < 5; ++r) { const float s = sc[r * 1024 + kb + q]; a[r][0] += s * wv[q].x; a[r][1] += s * wv[q].y; }
            }
#pragma unroll
            for (int r = 0; r < 5; ++r) { red[(w * 5 + r) * 128 + 2 * lane] = a[r][0]; red[(w * 5 + r) * 128 + 2 * lane + 1] = a[r][1]; }
            __syncthreads();
            for (int i = tid; i < 5 * 128; i += 512) {
                const int r = i >> 7, c = i & 127; float s = 0.f;
#pragma unroll
                for (int ww = 0; ww < 8; ++ww) s += red[(ww * 5 + r) * 128 + c];
                s += pin_ld(5)[(size_t)l * (NMOD * D) + c0 + c];
                ((float*)(p.ws + WS_MOD))[(size_t)(l * 5 + r) * (NMOD * D) + c0 + c] = s;
            }
            __syncthreads();
        }
    }
    {
        float* z = sm;
        float* a1 = sm + 16 * 36;
        float* a2 = a1 + 16 * 64;
        float* a3 = a2 + 16 * 64;
        float* tl = a3 + 16 * 64;
        float* wl = tl + 16;
        const float HMAX = -4.605170185988091f / 0.3f, HMIN = -4.605170185988091f / 1.5f;
        int o_loaded = -1;
        for (int it = nb - 1 - bid; it < 544; it += nb) {
            const int o = it / 272, r = it % 272;
            const int Lf = (r < 256) ? SEQ : CL; const int p0 = (r < 256) ? r * 16 : (r - 256) * 16;
            float* kf = (float*)(p.ws + WS_KF + (size_t)o * SZ_KF) + ((r < 256) ? (size_t)0 : (size_t)2 * SEQ * D);
            const float* f3 = pin_ld(25) + (size_t)o * 64 * 2048;
            __syncthreads();
            if (o != o_loaded) {
                const float* f0 = pin_ld(19) + (size_t)o * 33 * 64; const float* f1 = pin_ld(21) + (size_t)o * 64 * 64; const float* f2 = pin_ld(23) + (size_t)o * 64 * 64;
                for (int i = tid; i < 33 * 64; i += 512) wl[i] = f0[i];
                for (int i = tid; i < 64 * 64; i += 512) { wl[2112 + i] = f1[i]; wl[2112 + 4096 + i] = f2[i]; }
                if (tid < 64) { wl[10304 + tid] = pin_ld(20)[o * 64 + tid]; wl[10304 + 64 + tid] = pin_ld(22)[o * 64 + tid]; wl[10304 + 128 + tid] = pin_ld(24)[o * 64 + tid]; wl[10304 + 192 + tid] = pin_ld(26)[o * 64 + tid]; }
                o_loaded = o;
            }
            const float* f0 = wl; const float* f1 = wl + 2112; const float* f2 = wl + 2112 + 4096;
            const float* fb0 = wl + 10304; const float* fb1 = fb0 + 64; const float* fb2 = fb0 + 128; const float* fq = fb0 + 192;
            for (int idx = tid; idx < 16 * 33; idx += 512) {
                const int ps = idx / 33, f = idx % 33; const int i = p0 + ps;
                const float tlin = (float)i * (1.0f / (float)(Lf - 1));
                const float w = (6.283185307179586f * (float)i) / (float)Lf;
                float v;
                if (f == 0) { v = tlin; tl[ps] = tlin; }
                else { const int jj = (f - 1) & 15; const float fj = 1e-4f + (float)jj * ((15.0f - 1e-4f) / 15.0f); v = (f <= 16) ? cosf(fj * w) : -sinf(fj * w); }
                z[ps * 36 + f] = v;
            }
            __syncthreads();
            for (int idx = tid; idx < 16 * 64; idx += 512) { const int ps = idx >> 6, oc = idx & 63; float s = fb0[oc];
                for (int f = 0; f < 33; ++f) s += z[ps * 36 + f] * f0[f * 64 + oc];
                a1[idx] = sinf(fq[oc] * s); }
            __syncthreads();
            for (int idx = tid; idx < 16 * 64; idx += 512) { const int ps = idx >> 6, oc = idx & 63; float s = fb1[oc];
                for (int f = 0; f < 64; ++f) s += a1[ps * 64 + f] * f1[f * 64 + oc];
                a2[idx] = sinf(fq[oc] * s); }
            __syncthreads();
            for (int idx = tid; idx < 16 * 64; idx += 512) { const int ps = idx >> 6, oc = idx & 63; float s = fb2[oc];
                for (int f = 0; f < 64; ++f) s += a2[ps * 64 + f] * f2[f * 64 + oc];
                a3[oc * 16 + ps] = sinf(fq[oc] * s); }
            __syncthreads();
            {
                float acc[4][16];
#pragma unroll
                for (int q = 0; q < 4; ++q)
#pragma unroll
                    for (int ps = 0; ps < 16; ++ps) acc[q][ps] = 0.f;
                for (int fb = 0; fb < 64; fb += 4) {
                    float wv[4][4];
#pragma unroll
                    for (int f = 0; f < 4; ++f)
#pragma unroll
                        for (int q = 0; q < 4; ++q) wv[f][q] = f3[(fb + f) * 2048 + tid + 512 * q];
#pragma unroll
                    for (int f = 0; f < 4; ++f) {
                        const f32x4 av0 = *(const f32x4*)(a3 + (fb + f) * 16), av1 = *(const f32x4*)(a3 + (fb + f) * 16 + 4), av2 = *(const f32x4*)(a3 + (fb + f) * 16 + 8), av3 = *(const f32x4*)(a3 + (fb + f) * 16 + 12);
#pragma unroll
                        for (int q = 0; q < 4; ++q)
#pragma unroll
                            for (int e = 0; e < 4; ++e) { acc[q][e] += av0[e] * wv[f][q]; acc[q][4 + e] += av1[e] * wv[f][q]; acc[q][8 + e] += av2[e] * wv[f][q]; acc[q][12 + e] += av3[e] * wv[f][q]; }
                    }
                }
#pragma unroll
                for (int q = 0; q < 4; ++q) {
                    const int c = tid + 512 * q; const int dir = c >> 10, d = c & 1023;
                    const float delta = fabsf(HMIN + (float)d * ((HMAX - HMIN) / 1023.0f));
                    float kv[16];
#pragma unroll
                    for (int ps = 0; ps < 16; ++ps) kv[ps] = acc[q][ps] * expf(-tl[ps] * delta);
                    if (r < 256) {
                        bf16_t* rk = (bf16_t*)(p.ws + WS_KF + (size_t)o * SZ_KF) + (size_t)d * 8192;
                        if (dir == 0) {
                            u32x4 w0, w1;
                            w0.x = pg8::cvt_pk_bf16(kv[15], kv[14]); w0.y = pg8::cvt_pk_bf16(kv[13], kv[12]); w0.z = pg8::cvt_pk_bf16(kv[11], kv[10]); w0.w = pg8::cvt_pk_bf16(kv[9], kv[8]);
                            w1.x = pg8::cvt_pk_bf16(kv[7], kv[6]); w1.y = pg8::cvt_pk_bf16(kv[5], kv[4]); w1.z = pg8::cvt_pk_bf16(kv[3], kv[2]); w1.w = pg8::cvt_pk_bf16(kv[1], kv[0]);
                            *(u32x4*)(rk + 4080 - p0) = w0; *(u32x4*)(rk + 4088 - p0) = w1;
                            if (p0 == 0) rk[8191] = 0;
                        } else {
                            if (p0 > 0) rk[4095 + p0] = f2bf(kv[0]);
                            u32x4 w0; w0.x = pg8::cvt_pk_bf16(kv[1], kv[2]); w0.y = pg8::cvt_pk_bf16(kv[3], kv[4]); w0.z = pg8::cvt_pk_bf16(kv[5], kv[6]); w0.w = pg8::cvt_pk_bf16(kv[7], kv[8]);
                            *(u32x4*)(rk + 4096 + p0) = w0;
                            uint2 w1; w1.x = pg8::cvt_pk_bf16(kv[9], kv[10]); w1.y = pg8::cvt_pk_bf16(kv[11], kv[12]);
                            *(uint2*)(rk + 4104 + p0) = w1;
                            *(unsigned*)(rk + 4108 + p0) = pg8::cvt_pk_bf16(kv[13], kv[14]);
                            rk[4110 + p0] = f2bf(kv[15]);
                        }
                    } else {
#pragma unroll
                        for (int ps = 0; ps < 16; ++ps) kf[((size_t)dir * Lf + p0 + ps) * D + d] = kv[ps];
                    }
                }
            }
        }
        __syncthreads();
    }
}

__device__ __forceinline__ void rowphase(const KQ p_in, int Mupd, const bf16_t* Y, int lu, int gidx, float wgt, const float* gpost,
                         int Mnext, int ln, const float* gpre, int shidx, int scidx, bf16_t* Hout, bool from_input, int tbeg) {
    const KQ p = lq(p_in);
    const int tid = ltid(), w = tid >> 6, lane = tid & 63;
    const int Mmax = Mupd > Mnext ? Mupd : Mnext;
    for (int t = tbeg + (blockIdx.x * 8 + w) * 2; t < Mmax; t += gridDim.x * 16) {
        float* xr = xrow(p, t); const int mr = modrow(t);
        const float* xs = xr;
        if (from_input) xs = (t < TL) ? pin_ld(0) + (size_t)t * D : pin_ld(2) + (size_t)(t - TL) * D;
        float4 xv[2][4];
#pragma unroll
        for (int rr = 0; rr < 2; ++rr)
#pragma unroll
            for (int q = 0; q < 4; ++q) xv[rr][q] = *(const float4*)(xs + rr * D + q * 256 + lane * 4);
        if (Y != nullptr && t < Mupd) {
            float4 yv[2][4]; float ss[2] = {0.f, 0.f};
#pragma unroll
            for (int rr = 0; rr < 2; ++rr)
#pragma unroll
                for (int q = 0; q < 4; ++q) {
                    if (t < TL) { const bf16x4 yb = *(const bf16x4*)(Y + (size_t)(t + rr) * D + q * 256 + lane * 4);
                        yv[rr][q] = make_float4(bf2f((bf16_t)yb[0]), bf2f((bf16_t)yb[1]), bf2f((bf16_t)yb[2]), bf2f((bf16_t)yb[3])); }
                    else { const float* yp = (const float*)(p.ws + WS_YP) + (size_t)(t + rr - TL) * D + q * 256 + lane * 4;
                        const float4 a0 = *(const float4*)yp, a1 = *(const float4*)(yp + (size_t)TC * D), a2 = *(const float4*)(yp + (size_t)2 * TC * D), a3 = *(const float4*)(yp + (size_t)3 * TC * D);
                        yv[rr][q] = make_float4(a0.x + a1.x + a2.x + a3.x, a0.y + a1.y + a2.y + a3.y, a0.z + a1.z + a2.z + a3.z, a0.w + a1.w + a2.w + a3.w); }
                    ss[rr] += yv[rr][q].x * yv[rr][q].x + yv[rr][q].y * yv[rr][q].y + yv[rr][q].z * yv[rr][q].z + yv[rr][q].w * yv[rr][q].w; }
            ss[0] = wave_sum(ss[0]); ss[1] = wave_sum(ss[1]);
            float wgl = wgt; asm volatile("" : "+v"(wgl));
            const float r0 = rsqrtf(ss[0] * (1.0f / D) + EPS) * wgl, r1 = rsqrtf(ss[1] * (1.0f / D) + EPS) * wgl;
            const float* gm = modp(p, lu, mr, gidx);
#pragma unroll
            for (int q = 0; q < 4; ++q) {
                const float4 g4 = *(const float4*)(gm + q * 256 + lane * 4); const float4 p4 = *(const float4*)(gpost + q * 256 + lane * 4);
                const float cx = g4.x * p4.x, cy = g4.y * p4.y, cz = g4.z * p4.z, cw = g4.w * p4.w;
                xv[0][q].x += r0 * cx * yv[0][q].x; xv[0][q].y += r0 * cy * yv[0][q].y; xv[0][q].z += r0 * cz * yv[0][q].z; xv[0][q].w += r0 * cw * yv[0][q].w;
                xv[1][q].x += r1 * cx * yv[1][q].x; xv[1][q].y += r1 * cy * yv[1][q].y; xv[1][q].z += r1 * cz * yv[1][q].z; xv[1][q].w += r1 * cw * yv[1][q].w;
                *(float4*)(xr + q * 256 + lane * 4) = xv[0][q]; *(float4*)(xr + D + q * 256 + lane * 4) = xv[1][q];
            }
        }
        if (Hout != nullptr && t < Mnext) {
            float ss[2] = {0.f, 0.f};
#pragma unroll
            for (int rr = 0; rr < 2; ++rr)
#pragma unroll
                for (int q = 0; q < 4; ++q) ss[rr] += xv[rr][q].x * xv[rr][q].x + xv[rr][q].y * xv[rr][q].y + xv[rr][q].z * xv[rr][q].z + xv[rr][q].w * xv[rr][q].w;
            ss[0] = wave_sum(ss[0]); ss[1] = wave_sum(ss[1]);
            const float rn[2] = {rsqrtf(ss[0] * (1.0f / D) + EPS), rsqrtf(ss[1] * (1.0f / D) + EPS)};
            const float* sh = modp(p, ln, mr, shidx); const float* sc = modp(p, ln, mr, scidx);
#pragma unroll
            for (int q = 0; q < 4; ++q) {
                const float4 g4 = *(const float4*)(gpre + q * 256 + lane * 4); const float4 s4 = *(const float4*)(sc + q * 256 + lane * 4); const float4 h4 = *(const float4*)(sh + q * 256 + lane * 4);
                const float mx_ = g4.x * (1.0f + s4.x), my_ = g4.y * (1.0f + s4.y), mz_ = g4.z * (1.0f + s4.z), mw_ = g4.w * (1.0f + s4.w);
#pragma unroll
                for (int rr = 0; rr < 2; ++rr) {
                    const float h0 = xv[rr][q].x * rn[rr] * mx_ + h4.x, h1 = xv[rr][q].y * rn[rr] * my_ + h4.y;
                    const float h2 = xv[rr][q].z * rn[rr] * mz_ + h4.z, h3 = xv[rr][q].w * rn[rr] * mw_ + h4.w;
                    uint2 pk; pk.x = pg8::cvt_pk_bf16(h0, h1); pk.y = pg8::cvt_pk_bf16(h2, h3);
                    *(uint2*)(Hout + (size_t)(t + rr) * D + q * 256 + lane * 4) = pk;
                }
            }
        }
    }
}

__device__ __forceinline__ float log_sigmoid(float x) { return -log1pf(expf(-x)); }
__device__ __forceinline__ int chunk_t0(int b, int cidx) { return cidx < 32 ? b * SEQ + cidx * 128 : TL + b * CL + (cidx - 32) * 128; }

__device__ __forceinline__ void m1_rope_states(const KQ p_in, int e, float* sm) {
    const KQ p = lq(p_in);
    const int tid = ltid(), bid = blockIdx.x, nb = gridDim.x;
    bf16_t* Z = (bf16_t*)(p.ws + WS_BIG);
    const float* rope = (const float*)(p.ws + WS_ROPE);
    for (int base = bid * 512 + tid; base < TL * 72; base += 2 * nb * 512) {
        bf16_t* zp[2]; bf16x8 a1[2], a2[2]; f32x4 c0[2], c1[2], s0[2], s1[2]; bool ok[2];
#pragma unroll
        for (int u = 0; u < 2; ++u) {
            const int idx = base + u * nb * 512; ok[u] = idx < TL * 72; const int ix = ok[u] ? idx : base;
            const int t = ix / 72, r = ix % 72; const int hd = r >> 2, i0 = (r & 3) * 8;
            const int cb = hd < 16 ? hd * 64 : 1536 + (hd - 16) * 64;
            const int tb = (hd >= 8 && hd < 16) ? 2 : 0; const int pos = t & (SEQ - 1);
            const float* cp = rope + (size_t)tb * SEQ * 32 + pos * 32 + i0; const float* sp = cp + (size_t)SEQ * 32;
            zp[u] = Z + (size_t)t * INW + cb + i0;
            a1[u] = *(const bf16x8*)zp[u]; a2[u] = *(const bf16x8*)(zp[u] + 32);
            c0[u] = *(const f32x4*)cp; c1[u] = *(const f32x4*)(cp + 4); s0[u] = *(const f32x4*)sp; s1[u] = *(const f32x4*)(sp + 4);
        }
#pragma unroll
        for (int u = 0; u < 2; ++u) {
            if (!ok[u]) continue;
            float o1[8], o2[8];
#pragma unroll
            for (int j = 0; j < 8; ++j) { const float x1 = bf2f((bf16_t)a1[u][j]), x2 = bf2f((bf16_t)a2[u][j]); const float cc = j < 4 ? c0[u][j & 3] : c1[u][j & 3], sn = j < 4 ? s0[u][j & 3] : s1[u][j & 3];
                o1[j] = x1 * cc - x2 * sn; o2[j] = x1 * sn + x2 * cc; }
            u32x4 w1, w2;
            w1.x = pg8::cvt_pk_bf16(o1[0], o1[1]); w1.y = pg8::cvt_pk_bf16(o1[2], o1[3]); w1.z = pg8::cvt_pk_bf16(o1[4], o1[5]); w1.w = pg8::cvt_pk_bf16(o1[6], o1[7]);
            w2.x = pg8::cvt_pk_bf16(o2[0], o2[1]); w2.y = pg8::cvt_pk_bf16(o2[2], o2[3]); w2.z = pg8::cvt_pk_bf16(o2[4], o2[5]); w2.w = pg8::cvt_pk_bf16(o2[6], o2[7]);
            *(u32x4*)zp[u] = w1; *(u32x4*)(zp[u] + 32) = w2;
        }
    }
    float* Ks = sm;
    float* Vs = sm + 128 * 64;
    float* wf = Vs + 128 * 64;
    float* wb = wf + 128;
    float* AF = (float*)(p.ws + WS_ST); float* AB = AF + SZ_ST / 4;
    const float* dec = pin_ld(13) + e * 16;
    for (int it = bid; it < NB * NCH * 8; it += nb) {
        const int h = it & 7, cidx = (it >> 3) % NCH, b = it / (8 * NCH);
        const int t0 = chunk_t0(b, cidx); const bool lat = cidx < 32;
        const float lgf = log_sigmoid(dec[h]), lgb = log_sigmoid(dec[8 + h]);
        __syncthreads();
        if (tid < 128) { wf[tid] = expf(lgf * (float)(127 - tid)); wb[tid] = expf(lgb * (float)tid); }
        const int kc = 1792 + h * 64, vc = 2304 + h * 64;
        {
            const int r = tid >> 2, pq = tid & 3;
            bf16_t* zp = Z + (size_t)(t0 + r) * INW + kc + 8 * pq;
            const bf16x8 a1 = *(const bf16x8*)zp, a2 = *(const bf16x8*)(zp + 32);
            float o1[8], o2[8];
            if (lat) {
                const int pos = (t0 + r) & (SEQ - 1);
                const float* cp = rope + (size_t)2 * SEQ * 32 + pos * 32 + 8 * pq; const float* sp = cp + (size_t)SEQ * 32;
                const f32x4 c0 = *(const f32x4*)cp, c1 = *(const f32x4*)(cp + 4), s0 = *(const f32x4*)sp, s1 = *(const f32x4*)(sp + 4);
#pragma unroll
                for (int j = 0; j < 8; ++j) { const float x1 = bf2f((bf16_t)a1[j]), x2 = bf2f((bf16_t)a2[j]); const float cc = j < 4 ? c0[j & 3] : c1[j & 3], sn = j < 4 ? s0[j & 3] : s1[j & 3];
                    o1[j] = bf2f(f2bf(x1 * cc - x2 * sn)); o2[j] = bf2f(f2bf(x1 * sn + x2 * cc)); }
                u32x4 w1, w2;
                w1.x = pg8::cvt_pk_bf16(o1[0], o1[1]); w1.y = pg8::cvt_pk_bf16(o1[2], o1[3]); w1.z = pg8::cvt_pk_bf16(o1[4], o1[5]); w1.w = pg8::cvt_pk_bf16(o1[6], o1[7]);
                w2.x = pg8::cvt_pk_bf16(o2[0], o2[1]); w2.y = pg8::cvt_pk_bf16(o2[2], o2[3]); w2.z = pg8::cvt_pk_bf16(o2[4], o2[5]); w2.w = pg8::cvt_pk_bf16(o2[6], o2[7]);
                *(u32x4*)zp = w1; *(u32x4*)(zp + 32) = w2;
            } else {
#pragma unroll
                for (int j = 0; j < 8; ++j) { o1[j] = bf2f((bf16_t)a1[j]); o2[j] = bf2f((bf16_t)a2[j]); }
            }
            *(f32x4*)(Ks + r * 64 + 8 * pq) = (f32x4){o1[0], o1[1], o1[2], o1[3]}; *(f32x4*)(Ks + r * 64 + 8 * pq + 4) = (f32x4){o1[4], o1[5], o1[6], o1[7]};
            *(f32x4*)(Ks + r * 64 + 32 + 8 * pq) = (f32x4){o2[0], o2[1], o2[2], o2[3]}; *(f32x4*)(Ks + r * 64 + 32 + 8 * pq + 4) = (f32x4){o2[4], o2[5], o2[6], o2[7]};
        }
#pragma unroll
        for (int q = 0; q < 2; ++q) { const int idx = tid + 512 * q; const int r = idx >> 3, pc = idx & 7;
            const bf16x8 vv = *(const bf16x8*)(Z + (size_t)(t0 + r) * INW + vc + 8 * pc);
            *(f32x4*)(Vs + r * 64 + 8 * pc) = (f32x4){bf2f((bf16_t)vv[0]), bf2f((bf16_t)vv[1]), bf2f((bf16_t)vv[2]), bf2f((bf16_t)vv[3])};
            *(f32x4*)(Vs + r * 64 + 8 * pc + 4) = (f32x4){bf2f((bf16_t)vv[4]), bf2f((bf16_t)vv[5]), bf2f((bf16_t)vv[6]), bf2f((bf16_t)vv[7])}; }
        __syncthreads();
        const int d = tid >> 3, e0 = (tid & 7) * 8;
        float af[8], ab[8];
#pragma unroll
        for (int j = 0; j < 8; ++j) { af[j] = 0.f; ab[j] = 0.f; }
        for (int s = 0; s < 128; ++s) {
            const float kv = Ks[s * 64 + d]; const float kfw = kv * wf[s], kbw = kv * wb[s];
            const float4 v0 = *(const float4*)(Vs + s * 64 + e0), v1 = *(const float4*)(Vs + s * 64 + e0 + 4);
            af[0] += kfw * v0.x; af[1] += kfw * v0.y; af[2] += kfw * v0.z; af[3] += kfw * v0.w; af[4] += kfw * v1.x; af[5] += kfw * v1.y; af[6] += kfw * v1.z; af[7] += kfw * v1.w;
            ab[0] += kbw * v0.x; ab[1] += kbw * v0.y; ab[2] += kbw * v0.z; ab[3] += kbw * v0.w; ab[4] += kbw * v1.x; ab[5] += kbw * v1.y; ab[6] += kbw * v1.z; ab[7] += kbw * v1.w;
        }
        const size_t so = ((size_t)(b * NCH + cidx) * 8 + h) * 4096 + d * 64 + e0;
        *(float4*)(AF + so) = make_float4(af[0], af[1], af[2], af[3]); *(float4*)(AF + so + 4) = make_float4(af[4], af[5], af[6], af[7]);
        *(float4*)(AB + so) = make_float4(ab[0], ab[1], ab[2], ab[3]); *(float4*)(AB + so + 4) = make_float4(ab[4], ab[5], ab[6], ab[7]);
    }
    __syncthreads();
}

__device__ __forceinline__ void m2_scan(const KQ p_in, int e) {
    const KQ p = lq(p_in);
    const float* __restrict__ AF = (const float*)(p.ws + WS_ST); const float* __restrict__ AB = AF + SZ_ST / 4;
    float* __restrict__ TF = (float*)(p.ws + WS_ST) + 2 * (SZ_ST / 4); float* __restrict__ TB = TF + SZ_ST / 4;
    const float* dec = pin_ld(13) + e * 16;
    for (int idx = blockIdx.x * 512 + ltid(); idx < NB * 8 * 4096; idx += gridDim.x * 512) {
        const int el = idx & 4095, h = (idx >> 12) & 7, b = idx >> 15;
        const float gf = expf(log_sigmoid(dec[h]) * 128.0f), gb = expf(log_sigmoid(dec[8 + h]) * 128.0f);
        const size_t base = ((size_t)(b * NCH) * 8 + h) * 4096 + el; constexpr size_t CS = (size_t)8 * 4096;
        float af[NCH], ab[NCH];
#pragma unroll
        for (int c = 0; c < NCH; ++c) { af[c] = AF[base + c * CS]; ab[c] = AB[base + c * CS]; }
        TF[base + 32 * CS] = 0.f; TF[base + 33 * CS] = af[32]; TB[base + 33 * CS] = 0.f; TB[base + 32 * CS] = ab[33];
        float sf = gf * af[32] + af[33], sb = ab[32] + gb * ab[33];
#pragma unroll
        for (int c = 0; c < 32; ++c) { TF[base + c * CS] = sf; sf = gf * sf + af[c]; }
#pragma unroll
        for (int c = 31; c >= 0; --c) { TB[base + c * CS] = sb; sb = ab[c] + gb * sb; }
    }
}

__device__ __forceinline__ bf16x8 pack8(const f32x4& a, const f32x4& b) {
    u32x4 w; w.x = pg8::cvt_pk_bf16(a[0], a[1]); w.y = pg8::cvt_pk_bf16(a[2], a[3]); w.z = pg8::cvt_pk_bf16(b[0], b[1]); w.w = pg8::cvt_pk_bf16(b[2], b[3]);
    return __builtin_bit_cast(bf16x8, w);
}
__device__ __forceinline__ void m3_outputs(const KQ p_in, int e, bool ctx_full, unsigned char* smem, unsigned* scan_word) {
    const KQ p = lq(p_in);
    m2_scan(p, e);
    sub_arrive(scan_word);
    bool scan_ready = false;
    const int tid = ltid(), bid = blockIdx.x, nb = gridDim.x;
    const int w = tid >> 6, lane = tid & 63, ln = lane & 15, g4 = lane >> 4;
    const bf16_t* Z = (const bf16_t*)(p.ws + WS_BIG);
    bf16_t* MIX = (bf16_t*)(p.ws + WS_MIX);
    const float* dec = pin_ld(13) + e * 16;
    const float* sink = pin_ld(12) + e * 8;
    const float* TF = (const float*)(p.ws + WS_ST) + 2 * (SZ_ST / 4); const float* TB = TF + SZ_ST / 4;
    const int nchunk = ctx_full ? NCH : 32;
    const int nitems = NB * nchunk * 8;
    bf16_t* Kt = (bf16_t*)smem;
    bf16_t* Vt = Kt + 128 * 72;
    bf16_t* TfT = Vt + 64 * 136;
    bf16_t* TbT = TfT + 64 * 72;
    const int i = 16 * w + ln;
    for (int it = bid; it < 2 * nitems; it += nb) {
        const bool is_attn = it < nitems; const int ii = is_attn ? it : it - nitems;
        const int h = (ii >> 3) & 7, cbx = (ii >> 6) * 8 + (ii & 7), cidx = cbx % nchunk, b = cbx / nchunk;
        if (!is_attn && !scan_ready) { sub_wait(scan_word, gridDim.x); scan_ready = true; }
        const int t0 = chunk_t0(b, cidx); const bool lat = cidx < 32;
        f32x4 O[4];
#pragma unroll
        for (int m = 0; m < 4; ++m) O[m] = (f32x4){0.f, 0.f, 0.f, 0.f};
        if (!is_attn) {
            const float lgf = log_sigmoid(dec[h]), lgb = log_sigmoid(dec[8 + h]);
            __syncthreads();
#pragma unroll
            for (int q = 0; q < 2; ++q) { const int idx = tid + 512 * q; const int r = idx >> 3, pc = idx & 7; const bf16_t* zr = Z + (size_t)(t0 + r) * INW + h * 64 + pc * 8;
                *(u32x4*)(Kt + r * 72 + pc * 8) = *(const u32x4*)(zr + 1792);
                const bf16x8 vv = *(const bf16x8*)(zr + 2304);
#pragma unroll
                for (int j = 0; j < 8; ++j) Vt[(pc * 8 + j) * 136 + (r ^ (pc << 2))] = (bf16_t)vv[j]; }
            const size_t so = ((size_t)(b * NCH + cidx) * 8 + h) * 4096;
            {
                const int ee = tid & 63, d0 = (tid >> 6) * 8;
                float tf[8], tb[8];
#pragma unroll
                for (int j = 0; j < 8; ++j) { tf[j] = TF[so + (d0 + j) * 64 + ee]; tb[j] = TB[so + (d0 + j) * 64 + ee]; }
                u32x4 wf4, wb4;
                wf4.x = pg8::cvt_pk_bf16(tf[0], tf[1]); wf4.y = pg8::cvt_pk_bf16(tf[2], tf[3]); wf4.z = pg8::cvt_pk_bf16(tf[4], tf[5]); wf4.w = pg8::cvt_pk_bf16(tf[6], tf[7]);
                wb4.x = pg8::cvt_pk_bf16(tb[0], tb[1]); wb4.y = pg8::cvt_pk_bf16(tb[2], tb[3]); wb4.z = pg8::cvt_pk_bf16(tb[4], tb[5]); wb4.w = pg8::cvt_pk_bf16(tb[6], tb[7]);
                *(u32x4*)(TfT + ee * 72 + d0) = wf4; *(u32x4*)(TbT + ee * 72 + d0) = wb4;
            }
            __builtin_amdgcn_sched_barrier(0);
            bf16x8 qf[2], qff[2], qfb[2];
            { const bf16_t* qr = Z + (size_t)(t0 + i) * INW + 512 + h * 64 + 8 * g4;
              const float cf = __expf(lgf * (float)(i + 1)), cb = __expf(lgb * (float)(128 - i));
#pragma unroll
              for (int k2 = 0; k2 < 2; ++k2) { qf[k2] = *(const bf16x8*)(qr + 32 * k2);
                  f32x4 a0, a1, b0, b1;
#pragma unroll
                  for (int j = 0; j < 4; ++j) { const float x0 = bf2f((bf16_t)qf[k2][j]), x1 = bf2f((bf16_t)qf[k2][4 + j]); a0[j] = x0 * cf; a1[j] = x1 * cf; b0[j] = x0 * cb; b1[j] = x1 * cb; }
                  qff[k2] = pack8(a0, a1); qfb[k2] = pack8(b0, b1); } }
            __builtin_amdgcn_sched_barrier(0);
            __syncthreads();
#pragma unroll
            for (int m = 0; m < 4; ++m)
#pragma unroll
                for (int k2 = 0; k2 < 2; ++k2) {
                    const bf16x8 af = *(const bf16x8*)(TfT + (16 * m + ln) * 72 + 32 * k2 + 8 * g4);
                    const bf16x8 ab = *(const bf16x8*)(TbT + (16 * m + ln) * 72 + 32 * k2 + 8 * g4);
                    O[m] = __builtin_amdgcn_mfma_f32_16x16x32_bf16(af, qff[k2], O[m], 0, 0, 0);
                    O[m] = __builtin_amdgcn_mfma_f32_16x16x32_bf16(ab, qfb[k2], O[m], 0, 0, 0);
                    __builtin_amdgcn_sched_barrier(0);
                }
            const float lf2 = lgf * 1.44269504f, lb2 = lgb * 1.44269504f; const int di = i - 4 * g4;
            const float bfw = lf2 * (float)di, bbw = -lb2 * (float)di;
            f32x4 st[8];
#pragma unroll
            for (int mt = 0; mt < 8; ++mt) {
                f32x4 a = (f32x4){0.f, 0.f, 0.f, 0.f};
#pragma unroll
                for (int k2 = 0; k2 < 2; ++k2) { const bf16x8 kf = *(const bf16x8*)(Kt + (16 * mt + ln) * 72 + 32 * k2 + 8 * g4); a = __builtin_amdgcn_mfma_f32_16x16x32_bf16(kf, qf[k2], a, 0, 0, 0); }
#pragma unroll
                for (int rg = 0; rg < 4; ++rg) { const int cc = 16 * mt + rg; const int df = di - cc;
                    const float arg = (df > 0) ? fmaf(-lf2, (float)cc, bfw) : fmaf(lb2, (float)cc, bbw);
                    float wgt = __builtin_amdgcn_exp2f(arg); wgt = (df == 0) ? 2.0f : wgt;
                    a[rg] *= wgt; }
                st[mt] = a;
                __builtin_amdgcn_sched_barrier(0);
            }
#pragma unroll
            for (int ks = 0; ks < 4; ++ks) {
                const bf16x8 pfr = pack8(st[2 * ks], st[2 * ks + 1]);
#pragma unroll
                for (int m = 0; m < 4; ++m) {
                    const int vrow = 16 * m + ln; const int kx = (32 * ks + 4 * g4) ^ (((vrow >> 3) & 7) << 2);
                    const bf16_t* vr = Vt + vrow * 136;
                    const bf16x4 v0 = *(const bf16x4*)(vr + kx), v1 = *(const bf16x4*)(vr + (kx ^ 16));
                    const bf16x8 vf = __builtin_shufflevector(v0, v1, 0, 1, 2, 3, 4, 5, 6, 7);
                    O[m] = __builtin_amdgcn_mfma_f32_16x16x32_bf16(vf, pfr, O[m], 0, 0, 0);
                }
                __builtin_amdgcn_sched_barrier(0);
            }
            float ss = 0.f;
#pragma unroll
            for (int m = 0; m < 4; ++m)
#pragma unroll
                for (int rg = 0; rg < 4; ++rg) ss += O[m][rg] * O[m][rg];
            ss += __shfl_xor(ss, 16, 64); ss += __shfl_xor(ss, 32, 64);
            const float rn = rsqrtf(ss * (1.0f / 64.0f) + EPS);
#pragma unroll
            for (int m = 0; m < 4; ++m) {
                const int ee = 16 * m + 4 * g4;
                const bf16x4 gv = *(const bf16x4*)(Z + (size_t)(t0 + i) * INW + 1024 + h * 64 + ee);
                uint2 o2; o2.x = pg8::cvt_pk_bf16(O[m][0] * rn * silu_f(bf2f((bf16_t)gv[0])), O[m][1] * rn * silu_f(bf2f((bf16_t)gv[1])));
                o2.y = pg8::cvt_pk_bf16(O[m][2] * rn * silu_f(bf2f((bf16_t)gv[2])), O[m][3] * rn * silu_f(bf2f((bf16_t)gv[3])));
                *(uint2*)(MIX + (size_t)(t0 + i) * D + 512 + h * 64 + ee) = o2;
            }
        } else {
            const int gk = h >> 2;
            bf16x8 qf[2];
            { const bf16_t* qr = Z + (size_t)(t0 + i) * INW + h * 64 + 8 * g4; qf[0] = *(const bf16x8*)qr; qf[1] = *(const bf16x8*)(qr + 32); }
            float mx = sink[h], l = (g4 == 0) ? 1.0f : 0.0f;
            const int qpos = lat ? (cidx * 128 + i) : 0;
#define ATT_VALID(tl_) ((tl_) >= 3 || (lat && (cidx - 1 + (tl_)) >= 0 && (cidx - 1 + (tl_)) < 32))
#define ATT_KT0(tl_) ((tl_) >= 3 ? TL + b * CL + ((tl_) - 3) * 128 : b * SEQ + (cidx - 1 + (tl_)) * 128)
            int tl = 0; while (!ATT_VALID(tl)) ++tl;
            u32x4 kreg[2]; bf16x8 vreg[2];
            { const int kt0 = ATT_KT0(tl);
#pragma unroll
              for (int q = 0; q < 2; ++q) { const int idx = tid + 512 * q; const int r = idx >> 3, pc = idx & 7; const bf16_t* zr = Z + (size_t)(kt0 + r) * INW + gk * 64 + pc * 8;
                  kreg[q] = *(const u32x4*)(zr + 1536); vreg[q] = *(const bf16x8*)(zr + 1664); } }
            while (tl < 5) {
                const bool isc = tl >= 3; const int kp0 = isc ? 0 : (cidx - 1 + tl) * 128;
                __syncthreads();
#pragma unroll
                for (int q = 0; q < 2; ++q) { const int idx = tid + 512 * q; const int r = idx >> 3, pc = idx & 7;
                    *(u32x4*)(Kt + r * 72 + pc * 8) = kreg[q];
#pragma unroll
                    for (int j = 0; j < 8; ++j) Vt[(pc * 8 + j) * 136 + (r ^ (pc << 2))] = (bf16_t)vreg[q][j]; }
                __syncthreads();
                int tn = tl + 1; while (tn < 5 && !ATT_VALID(tn)) ++tn;
                if (tn < 5) { const int kt0 = ATT_KT0(tn);
#pragma unroll
                    for (int q = 0; q < 2; ++q) { const int idx = tid + 512 * q; const int r = idx >> 3, pc = idx & 7; const bf16_t* zr = Z + (size_t)(kt0 + r) * INW + gk * 64 + pc * 8;
                        kreg[q] = *(const u32x4*)(zr + 1536); vreg[q] = *(const bf16x8*)(zr + 1664); } }
                f32x4 st[8];
                float mloc = -1e30f;
#pragma unroll
                for (int mt = 0; mt < 8; ++mt) {
                    f32x4 a = (f32x4){0.f, 0.f, 0.f, 0.f};
#pragma unroll
                    for (int k2 = 0; k2 < 2; ++k2) { const bf16x8 kf = *(const bf16x8*)(Kt + (16 * mt + ln) * 72 + 32 * k2 + 8 * g4); a = __builtin_amdgcn_mfma_f32_16x16x32_bf16(kf, qf[k2], a, 0, 0, 0); }
                    if (!isc) {
#pragma unroll
                        for (int rg = 0; rg < 4; ++rg) { const int dd = qpos - (kp0 + 16 * mt + 4 * g4 + rg); if (dd > 128 || dd < -128) a[rg] = -1e30f; }
                    }
#pragma unroll
                    for (int rg = 0; rg < 4; ++rg) mloc = fmaxf(mloc, a[rg]);
                    st[mt] = a;
                    __builtin_amdgcn_sched_barrier(0);
                }
                mloc = fmaxf(mloc, __shfl_xor(mloc, 16, 64)); mloc = fmaxf(mloc, __shfl_xor(mloc, 32, 64));
                const float mnew = fmaxf(mx, mloc);
                const float sc = __expf(mx - mnew); mx = mnew; l *= sc;
#pragma unroll
                for (int m = 0; m < 4; ++m) O[m] *= sc;
#pragma unroll
                for (int mt = 0; mt < 8; ++mt)
#pragma unroll
                    for (int rg = 0; rg < 4; ++rg) { const float pv = __expf(st[mt][rg] - mnew); st[mt][rg] = pv; l += pv; }
#pragma unroll
                for (int ks = 0; ks < 4; ++ks) {
                    const bf16x8 pfr = pack8(st[2 * ks], st[2 * ks + 1]);
#pragma unroll
                    for (int m = 0; m < 4; ++m) {
                        const int vrow = 16 * m + ln; const int kx = (32 * ks + 4 * g4) ^ (((vrow >> 3) & 7) << 2);
                        const bf16_t* vr = Vt + vrow * 136;
                        const bf16x4 v0 = *(const bf16x4*)(vr + kx), v1 = *(const bf16x4*)(vr + (kx ^ 16));
                        const bf16x8 vf = __builtin_shufflevector(v0, v1, 0, 1, 2, 3, 4, 5, 6, 7);
                        O[m] = __builtin_amdgcn_mfma_f32_16x16x32_bf16(vf, pfr, O[m], 0, 0, 0);
                    }
                    __builtin_amdgcn_sched_barrier(0);
                }
                tl = tn;
            }
#undef ATT_VALID
#undef ATT_KT0
            l += __shfl_xor(l, 16, 64); l += __shfl_xor(l, 32, 64);
            const float inv = 1.0f / l;
#pragma unroll
            for (int m = 0; m < 4; ++m) {
                uint2 o2; o2.x = pg8::cvt_pk_bf16(O[m][0] * inv, O[m][1] * inv); o2.y = pg8::cvt_pk_bf16(O[m][2] * inv, O[m][3] * inv);
                *(uint2*)(MIX + (size_t)(t0 + i) * D + h * 64 + 16 * m + 4 * g4) = o2;
            }
        }
    }
    __syncthreads();
}

__device__ __forceinline__ void h2_shortconv(const KQ p_in, int o, int M, unsigned char* smem) {
    const KQ p = lq(p_in);
    const int tid = ltid();
    const bf16_t* ZH = (const bf16_t*)(p.ws + WS_BIG);
    const float* w = pin_ld(17) + (size_t)o * 3 * HYW; const float* bs = pin_ld(18) + (size_t)o * HYW;
    bf16_t* VXT = (bf16_t*)(p.ws + WS_Y); bf16_t* X0T = VXT + (size_t)D * TL;
    bf16_t* tx = (bf16_t*)smem;
    bf16_t* tv = tx + 64 * 136;
    const int tok = tid >> 3, cg8 = (tid & 7) * 8;
    float* wl = (float*)(smem + 40960);
    { const int c0b = (blockIdx.x & 15) * 64;
      for (int i = tid; i < 768; i += 512) { const int k = i >> 8, q = (i >> 6) & 3, c = i & 63; const int col = k * 1024 + c0b + c; wl[i] = (q < 3) ? w[q * HYW + col] : bs[col]; } }
    __syncthreads();
    for (int it = blockIdx.x; it < (TL / 128) * 16; it += gridDim.x) {
        const int c0 = (it & 15) * 64, t0 = (it >> 4) * 128;
        bf16x8 zc[2][3], zp[2][3], zn[2][3];
#pragma unroll
        for (int g = 0; g < 2; ++g) {
            const int t = t0 + tok + 64 * g; const int pos = t & (SEQ - 1); const bool first = pos == 0, last = pos == SEQ - 1;
#pragma unroll
            for (int k = 0; k < 3; ++k) {
                const int c = k * 1024 + c0 + cg8;
                zc[g][k] = *(const bf16x8*)(ZH + (size_t)t * HYW + c);
                zp[g][k] = *(const bf16x8*)(ZH + (size_t)(first ? t : t - 1) * HYW + c);
                zn[g][k] = *(const bf16x8*)(ZH + (size_t)(last ? t : t + 1) * HYW + c);
            }
        }
        __syncthreads();
#pragma unroll
        for (int g = 0; g < 2; ++g) {
            const int t = t0 + tok + 64 * g; const int pos = t & (SEQ - 1); const float mf = (pos == 0) ? 0.f : 1.f, ml = (pos == SEQ - 1) ? 0.f : 1.f;
            float zz[3][8];
#pragma unroll
            for (int k = 0; k < 3; ++k) {
                const float* wk = wl + k * 256 + cg8;
#pragma unroll
                for (int j = 0; j < 8; ++j)
                    zz[k][j] = wk[192 + j] + bf2f((bf16_t)zc[g][k][j]) * wk[64 + j] + mf * bf2f((bf16_t)zp[g][k][j]) * wk[j] + ml * bf2f((bf16_t)zn[g][k][j]) * wk[128 + j];
            }
#pragma unroll
            for (int j = 0; j < 8; ++j) { const int cs = (tok + 64 * g) ^ ((tid & 7) << 3);
                tx[(cg8 + j) * 136 + cs] = f2bf(zz[0][j]); tv[(cg8 + j) * 136 + cs] = f2bf(zz[2][j] * zz[1][j]); }
        }
        __syncthreads();
        { const int ch = tid >> 3, tk = (tid & 7) * 8;
#pragma unroll
          for (int q = 0; q < 2; ++q) {
            const int cs = (tk + 64 * q) ^ (((ch >> 3) & 7) << 3);
            *(u32x4*)(X0T + (size_t)(c0 + ch) * TL + t0 + tk + 64 * q) = *(const u32x4*)(tx + ch * 136 + cs);
            *(u32x4*)(VXT + (size_t)(c0 + ch) * TL + t0 + tk + 64 * q) = *(const u32x4*)(tv + ch * 136 + cs); } }
    }
    __syncthreads();
    if (M > TL) {
        float* VX = (float*)(p.ws + WS_Y); bf16_t* X0 = (bf16_t*)(p.ws + WS_H);
        for (int idx = TL * D + blockIdx.x * 512 + tid; idx < M * D; idx += gridDim.x * 512) {
            const int t = idx >> 10, d = idx & 1023;
            const int pos = (t - TL) & (CL - 1); const bool first = pos == 0, last = pos == CL - 1;
            float zz[3];
#pragma unroll
            for (int k = 0; k < 3; ++k) {
                const int c = k * 1024 + d;
                float sacc = bs[c] + bf2f(ZH[(size_t)t * HYW + c]) * w[HYW + c];
                if (!first) sacc += bf2f(ZH[(size_t)(t - 1) * HYW + c]) * w[c];
                if (!last) sacc += bf2f(ZH[(size_t)(t + 1) * HYW + c]) * w[2 * HYW + c];
                zz[k] = sacc;
            }
            VX[idx] = zz[2] * zz[1]; X0[idx] = f2bf(zz[0]);
        }
    }
}

typedef float f32x16 __attribute__((ext_vector_type(16)));
__device__ __forceinline__ void h3_longconv(const KQ p_in, int o, bool ctx_full, unsigned char* smem) {
    const KQ p = lq(p_in);
    const int tid = ltid(), w = tid >> 6, lane = tid & 63;
    const float* bias = pin_ld(27) + (size_t)o * D;
    {
        const bf16_t* VXT = (const bf16_t*)(p.ws + WS_Y); const bf16_t* X0T = VXT + (size_t)D * TL;
        bf16_t* HMT = (bf16_t*)(p.ws + WS_H);
        const bf16_t* RKT = (const bf16_t*)(p.ws + WS_KF + (size_t)o * SZ_KF);
        constexpr int RK2_OFF = 16384 + 64, U_OFF = 2 * 16384 + 128, CH_BYTES = U_OFF + 142 * 256;
        const int cw = w >> 2, w4 = w & 3;
        const int ct = tid & 255;
        unsigned char* cb = smem + cw * CH_BYTES;
        unsigned char* ub = cb + U_OFF;
        const int r = lane & 31, hh = lane >> 5;
        for (int pr = blockIdx.x; pr < D / 2; pr += gridDim.x) {
            const int d = pr * 2 + cw;
            __syncthreads();
            { const bf16_t* src = RKT + (size_t)d * 8192;
              for (int i = ct; i < 1024; i += 256) *(u32x4*)(cb + i * 16) = *(const u32x4*)(src + i * 8);
              for (int i = ct; i < 2 * 7 * 4 * 4; i += 256) { const int side = i / 112, rem = i % 112; unsigned z0 = 0u; asm volatile("" : "+v"(z0)); *(u32x4*)(ub + (side ? (135 * 4 * 64) : 0) + rem * 16) = (u32x4){z0, z0, z0, z0}; }
#pragma unroll 8
              for (int i = ct; i < 4 * 512; i += 256) { const int b = i >> 9, pc = i & 511;
                  const u32x4 v = *(const u32x4*)(VXT + (size_t)d * TL + b * SEQ + pc * 8);
                  const int col = ((pc >> 2) + 7) * 4 + b, q = pc & 3;
                  *(u32x4*)(ub + col * 64 + ((q ^ ((col >> 2) & 3)) * 16)) = v; } }
            __syncthreads();
            { const bf16_t* rk = (const bf16_t*)cb; bf16_t* rk2 = (bf16_t*)(cb + RK2_OFF);
#pragma unroll 4
              for (int i = ct; i < 4096; i += 256) { const unsigned lo = rk[2 * i + 1]; const unsigned hi = (2 * i + 2 < 8192) ? rk[2 * i + 2] : 0u; *(unsigned*)(rk2 + 2 * i) = lo | (hi << 16); } }
            __syncthreads();
            f32x16 acc[4];
#pragma unroll
            for (int j = 0; j < 4; ++j)
#pragma unroll
                for (int q = 0; q < 16; ++q) acc[j][q] = 0.f;
            const bf16_t* rsel = (const bf16_t*)(cb + ((r & 1) ? 0 : RK2_OFF));
            const int adj = (r & 1) ? 0 : -1;
            const int bq = r & 3;
#define H3_LOAD(AF, BF, U) do { \
                _Pragma("unroll") for (int s2 = 0; s2 < 2; ++s2) { \
                    const unsigned* ap = (const unsigned*)(Ab + 64 * (3 - (U)) + 32 * s2); \
                    u32x4 t4; t4.x = ap[0]; t4.y = ap[1]; t4.z = ap[2]; t4.w = ap[3]; \
                    AF[s2] = __builtin_bit_cast(bf16x8, t4); } \
                _Pragma("unroll") for (int j = 0; j < 4; ++j) { \
                    int c_ = Lb - 256 * (U) + 2048 * j; c_ = c_ < LO ? LO : (c_ > HI ? HI : c_); \
                    BF[j][0] = *(const bf16x8*)(ub + c_ + off[U][0]); BF[j][1] = *(const bf16x8*)(ub + c_ + off[U][1]); } } while (0)
#define H3_MMA(AF, BF) do { \
                _Pragma("unroll") for (int s2 = 0; s2 < 2; ++s2) \
                _Pragma("unroll") for (int j = 0; j < 4; ++j) acc[j] = __builtin_amdgcn_mfma_f32_32x32x16_bf16(AF[s2], BF[j][s2], acc[j], 0, 0, 0); } while (0)
            {
                const int dlo = 32 * w4 - 127;
                const int LO = (24 + bq) * 64, HI = (540 + bq) * 64;
                int off[4][2];
#pragma unroll
                for (int u = 0; u < 4; ++u) { const int sw = ((r >> 2) + 2 - u) & 3; off[u][0] = (hh ^ sw) * 16; off[u][1] = ((2 + hh) ^ sw) * 16; }
                int Lb = (((r >> 2) + 134) * 4 + bq) * 64;
                const unsigned char* Ab = (const unsigned char*)(rsel + (4095 - 32 * dlo - r + 8 * hh + adj)) - 192;
                bf16x8 afA[2], bfA[4][2], afB[2], bfB[4][2];
                H3_LOAD(afA, bfA, 0);
                for (int g = 0; g < 39; ++g) {
                    H3_LOAD(afB, bfB, 1);
                    __builtin_amdgcn_sched_barrier(0);
                    H3_MMA(afA, bfA);
                    __builtin_amdgcn_sched_barrier(0);
                    H3_LOAD(afA, bfA, 2);
                    __builtin_amdgcn_sched_barrier(0);
                    H3_MMA(afB, bfB);
                    __builtin_amdgcn_sched_barrier(0);
                    H3_LOAD(afB, bfB, 3);
                    __builtin_amdgcn_sched_barrier(0);
                    H3_MMA(afA, bfA);
                    __builtin_amdgcn_sched_barrier(0);
                    Ab -= 256; Lb -= 1024;
                    H3_LOAD(afA, bfA, 0);
                    __builtin_amdgcn_sched_barrier(0);
                    H3_MMA(afB, bfB);
                    __builtin_amdgcn_sched_barrier(0);
                }
                H3_LOAD(afB, bfB, 1);
                __builtin_amdgcn_sched_barrier(0);
                H3_MMA(afA, bfA);
                __builtin_amdgcn_sched_barrier(0);
                H3_LOAD(afA, bfA, 2);
                __builtin_amdgcn_sched_barrier(0);
                H3_MMA(afB, bfB);
                H3_MMA(afA, bfA);
            }
#undef H3_LOAD
#undef H3_MMA
            __syncthreads();
            const float bd = bias[d];
#pragma unroll
            for (int j = 0; j < 4; ++j) {
                const int n1 = 8 * (4 * w4 + j) + (r >> 2);
                const int col = (n1 + 7) * 4 + bq; const int sw = (col >> 2) & 3;
                bf16_t* up = (bf16_t*)(ub + col * 64);
#pragma unroll
                for (int q4 = 0; q4 < 4; ++q4) {
                    bf16_t* pp = up + ((q4 ^ sw) * 8) + 4 * hh;
                    const bf16x4 uv = *(const bf16x4*)pp;
                    uint2 o2; o2.x = pg8::cvt_pk_bf16(acc[j][4 * q4] + bd * bf2f((bf16_t)uv[0]), acc[j][4 * q4 + 1] + bd * bf2f((bf16_t)uv[1]));
                    o2.y = pg8::cvt_pk_bf16(acc[j][4 * q4 + 2] + bd * bf2f((bf16_t)uv[2]), acc[j][4 * q4 + 3] + bd * bf2f((bf16_t)uv[3]));
                    *(uint2*)pp = o2;
                }
            }
            __syncthreads();
#pragma unroll 4
            for (int i = ct; i < 4 * 512; i += 256) { const int b = i >> 9, pc = i & 511;
                const int col = ((pc >> 2) + 7) * 4 + b, q = pc & 3;
                const bf16x8 yv = *(const bf16x8*)(ub + col * 64 + ((q ^ ((col >> 2) & 3)) * 16));
                const size_t gi = (size_t)d * TL + b * SEQ + pc * 8;
                const bf16x8 xv = *(const bf16x8*)(X0T + gi);
                u32x4 o4;
                o4.x = pg8::cvt_pk_bf16(bf2f((bf16_t)yv[0]) * bf2f((bf16_t)xv[0]), bf2f((bf16_t)yv[1]) * bf2f((bf16_t)xv[1]));
                o4.y = pg8::cvt_pk_bf16(bf2f((bf16_t)yv[2]) * bf2f((bf16_t)xv[2]), bf2f((bf16_t)yv[3]) * bf2f((bf16_t)xv[3]));
                o4.z = pg8::cvt_pk_bf16(bf2f((bf16_t)yv[4]) * bf2f((bf16_t)xv[4]), bf2f((bf16_t)yv[5]) * bf2f((bf16_t)xv[5]));
                o4.w = pg8::cvt_pk_bf16(bf2f((bf16_t)yv[6]) * bf2f((bf16_t)xv[6]), bf2f((bf16_t)yv[7]) * bf2f((bf16_t)xv[7]));
                *(u32x4*)(HMT + gi) = o4; }
        }
        __syncthreads();
    }
    if (ctx_full) {
        const float* VX = (const float*)(p.ws + WS_Y); const bf16_t* X0 = (const bf16_t*)(p.ws + WS_H);
        bf16_t* MIX = (bf16_t*)(p.ws + WS_MIX);
        const float* kf = (const float*)(p.ws + WS_KF + (size_t)o * SZ_KF) + (size_t)2 * SEQ * D;
        for (int idx = blockIdx.x * 512 + tid; idx < (TC / 8) * D; idx += gridDim.x * 512) {
            const int d = idx & 1023, og = idx >> 10;
            const int bb = og >> 5, n0 = (og & 31) * 8, tb = TL + bb * CL;
            const float* up = VX + (size_t)tb * D + d;
            float acc[8];
#pragma unroll
            for (int j = 0; j < 8; ++j) acc[j] = 0.f;
#pragma unroll 1
            for (int mb = 0; mb < CL; mb += 8) {
                float kk[15], uu[8];
#pragma unroll
                for (int q = 0; q < 15; ++q) { const int lag = n0 - mb - 7 + q;
                    kk[q] = (lag >= 0) ? ((lag < CL) ? kf[(size_t)lag * D + d] : 0.f) : ((-lag < CL) ? kf[(size_t)(CL - lag) * D + d] : 0.f); }
#pragma unroll
                for (int u = 0; u < 8; ++u) uu[u] = up[(size_t)(mb + u) * D];
#pragma unroll
                for (int u = 0; u < 8; ++u)
#pragma unroll
                    for (int j = 0; j < 8; ++j) acc[j] += uu[u] * kk[7 - u + j];
            }
            const float bd = bias[d];
#pragma unroll
            for (int j = 0; j < 8; ++j) { const size_t ti = (size_t)(tb + n0 + j) * D + d; MIX[ti] = f2bf(bf2f(X0[ti]) * (acc[j] + bd * VX[ti])); }
        }
    }
}

__device__ __forceinline__ void h3b_transpose(const KQ p_in, unsigned char* smem) {
    const KQ p = lq(p_in);
    const int tid = ltid();
    const bf16_t* HMT = (const bf16_t*)(p.ws + WS_H); bf16_t* MIX = (bf16_t*)(p.ws + WS_MIX);
    bf16_t* tile = (bf16_t*)smem;
    for (int it = blockIdx.x; it < (TL / 256) * 16; it += gridDim.x) {
        const int c0 = (it & 15) * 64, t0 = (it >> 4) * 256;
        u32x4 ld[4];
        { const int ch = tid >> 3, tk = (tid & 7) * 8;
#pragma unroll
          for (int q = 0; q < 4; ++q) ld[q] = *(const u32x4*)(HMT + (size_t)(c0 + ch) * TL + t0 + tk + 64 * q);
          __syncthreads();
#pragma unroll
          for (int q = 0; q < 4; ++q) *(u32x4*)(tile + ch * 264 + ((tk + 64 * q) ^ (((ch >> 3) & 7) << 3))) = ld[q]; }
        __syncthreads();
        { const int cg8 = (tid & 7) * 8;
#pragma unroll
          for (int q = 0; q < 4; ++q) { const int tok = (tid >> 3) + 64 * q; unsigned short v[8];
#pragma unroll
              for (int j = 0; j < 8; ++j) v[j] = tile[(cg8 + j) * 264 + (tok ^ ((tid & 7) << 3))];
              u32x4 o4; o4.x = v[0] | ((unsigned)v[1] << 16); o4.y = v[2] | ((unsigned)v[3] << 16); o4.z = v[4] | ((unsigned)v[5] << 16); o4.w = v[6] | ((unsigned)v[7] << 16);
              *(u32x4*)(MIX + (size_t)(t0 + tok) * D + c0 + cg8) = o4; } }
    }
    __syncthreads();
}

__global__ void __launch_bounds__(512, 2) mega_fwd(KP kp) {
    unsigned char* const smem = g_smem;
    if (threadIdx.x < 29) *(LAS unsigned long long*)((LAS unsigned char*)g_smem + PTAB_OFF + 8 * threadIdx.x) = ((const unsigned long long*)__builtin_amdgcn_kernarg_segment_ptr())[threadIdx.x];
    KQ p; p.out = kp.out; p.ws = kp.ws;
    cg::grid_group grid = cg::this_grid();
    if (threadIdx.x < 4) ((volatile LAS unsigned*)(LAS unsigned char*)smem)[(LDS_BYTES - 16) / 4 + threadIdx.x] = 0u;
    __syncthreads();
    if (threadIdx.x == 0) (void)xb_add(&((unsigned*)(lq(p).ws + WS_BAR))[XB_XCNT(xb_xcc_id())], 1u);
    grid.sync();
    float* smf = (float*)smem;
#define Hb ((bf16_t*)(lq(p).ws + WS_H))
#define BIG ((bf16_t*)(lq(p).ws + WS_BIG))
#define Y ((bf16_t*)(lq(p).ws + WS_Y))
#define MIX ((bf16_t*)(lq(p).ws + WS_MIX))

#ifndef NO_P0
    p0_setup(p, smf);
#endif
    GRID_BAR();
    rowphase(p, 0, nullptr, 0, 0, 0.f, nullptr, T, 0, pin_ld(6), 0, 1, Hb, true, 0);
    GRID_BAR();
    for (int l = 0; l < 4; ++l) {
        const bool ctx_live = l <= 2, ctx_full = l < 2;
        const int Mff = ctx_live ? T : TL, Mpost = ctx_full ? T : TL;
        for (int sub = 0; sub < 3; ++sub) {
            const bf16_t* Ao; const bf16_t* Bo; int Ko; int Mo;
            if (sub != 1) {
                const int fi = sub >> 1; const int M = (sub == 0) ? Mff : Mpost;
                { pg8::EpiSwiGLU E{BIG, DFF}; run_gemm(smem, Hb, (const bf16_t*)(lq(p).ws + WS_WGU + (size_t)(l * 2 + fi) * SZ_WGU), M, 2 * DFF, D, E); }
                GRID_BAR();
                Ao = BIG; Bo = (const bf16_t*)(lq(p).ws + WS_WD + (size_t)(l * 2 + fi) * SZ_WD); Ko = DFF; Mo = M;
            } else {
                if ((l & 1) == 0) {
                    const int e = l >> 1;
                    { pg8::EpiBf16 E{BIG, INW, nullptr}; run_gemm(smem, Hb, (const bf16_t*)(lq(p).ws + WS_WIN + (size_t)e * SZ_WIN), Mff, INW, D, E); }
                    GRID_BAR();
#ifndef NO_M1
                    m1_rope_states(p, e, smf);
#endif
                    GRID_BAR();
#ifndef NO_M3
                    m3_outputs(p, e, ctx_full, smem, (unsigned*)(lq(p).ws + WS_CNT) + (size_t)12 * 2 * 64 * 64 + (12 + e) * 64);
#endif
                    GRID_BAR();
                    Bo = (const bf16_t*)(lq(p).ws + WS_WOUT + (size_t)e * SZ_WOUT);
                } else {
                    const int o = l >> 1;
                    { pg8::EpiBf16 E{BIG, HYW, pin_ld(16) + (size_t)o * HYW}; run_gemm(smem, Hb, (const bf16_t*)(lq(p).ws + WS_HWIN + (size_t)o * SZ_HWIN), Mpost, HYW, D, E); }
                    GRID_BAR();
#ifndef NO_H2
                    h2_shortconv(p, o, Mpost, smem);
#endif
                    GRID_BAR();
#ifndef NO_H3
                    h3_longconv(p, o, ctx_full, smem);
#endif
                    GRID_BAR();
                    h3b_transpose(p, smem);
                    GRID_BAR();
                    Bo = (const bf16_t*)(lq(p).ws + WS_HWOUT + (size_t)o * SZ_WOUT);
                }
                Ao = MIX; Ko = D; Mo = Mpost;
            }
            const int gidx = 2 + 3 * sub;
            const int ln = (sub == 2) ? l + 1 : l; const bool has_next = ln < 4; const int lnn = has_next ? ln : l;
            const int pre_i = (sub == 2) ? 0 : sub + 1;
            const int Mn = has_next ? ((sub == 2) ? ((ln <= 2) ? T : TL) : ((sub == 0) ? Mff : Mpost)) : 0;
            const float* gpost = pin_ld(7) + (size_t)(l * 3 + sub) * D; const float* gpre = pin_ld(6) + (size_t)(lnn * 3 + pre_i) * D;
            const float wg = (sub == 1) ? 1.0f : 0.5f;
            {
                pg8::EpiFusedRow EF;
                EF.xin = (l == 0 && sub == 0) ? pin_ld(0) : (const float*)lq(p).out; EF.xout = lq(p).out; EF.H = has_next ? Hb : nullptr;
                EF.gate = modp(lq(p), l, 0, gidx); EF.gpost = gpost; EF.wgt = wg;
                EF.gpre = gpre; EF.shift = modp(lq(p), lnn, 0, 3 * pre_i); EF.scale = modp(lq(p), lnn, 0, 3 * pre_i + 1);
                EF.slots = (float*)(lq(p).ws + WS_SLOT); EF.cnt = (unsigned*)(lq(p).ws + WS_CNT) + (size_t)(l * 3 + sub) * 2 * 64 * 64;
                run_gemm_f32_split(smem, Ao, Bo, Mo, Ko, EF, (float*)(lq(p).ws + WS_YP));
            }
            if (Mo > TL && blockIdx.x < 64) {
                sub_barrier((unsigned*)(lq(p).ws + WS_CNT) + (size_t)12 * 2 * 64 * 64 + (l * 3 + sub) * 64, 64u);
                rowphase(p, Mo, Y, l, gidx, wg, gpost, Mn, lnn, gpre, 3 * pre_i, 3 * pre_i + 1, has_next ? Hb : nullptr, l == 0 && sub == 0, TL);
            }
            GRID_BAR();
        }
    }
}

extern "C" void kernel_launch(void* const* d_in, const int* in_sizes, int n_in, void* d_out, int out_size, void* d_ws, size_t ws_size, hipStream_t stream) {
    static int grid = 0;
    if (grid == 0) {
        if (n_in != 29 || out_size != TL * D || ws_size < WS_END) { fprintf(stderr, "kernel_launch: unexpected shapes: n_in %d out %d ws %zu (need %zu)\n", n_in, out_size, ws_size, (size_t)WS_END); grid = -1; return; }
        int dev = 0, cus = 0, per_cu = 0;
        (void)hipGetDevice(&dev);
        (void)hipDeviceGetAttribute(&cus, hipDeviceAttributeMultiprocessorCount, dev);
        if (hipFuncSetAttribute((const void*)mega_fwd, hipFuncAttributeMaxDynamicSharedMemorySize, LDS_BYTES) != hipSuccess) { fprintf(stderr, "kernel_launch: hipFuncSetAttribute failed\n"); grid = -1; return; }
        if (hipOccupancyMaxActiveBlocksPerMultiprocessor(&per_cu, (const void*)mega_fwd, 512, LDS_BYTES) != hipSuccess || per_cu < 1) { fprintf(stderr, "kernel_launch: occupancy query says %d\n", per_cu); per_cu = 1; }
        (void)hipGetLastError();
        grid = cus >= 256 ? 256 : cus;
    }
    if (grid < 0) return;
    (void)hipMemsetAsync((unsigned char*)d_ws + WS_BAR, 0, 16384 + SZ_CNT, stream);
    KP kp{};
    for (int i = 0; i < 29; ++i) kp.in[i] = (const float*)d_in[i];
    kp.out = (float*)d_out; kp.ws = (unsigned char*)d_ws;
    void* args[] = {&kp};
    hipError_t e = hipLaunchCooperativeKernel((const void*)mega_fwd, dim3(grid), dim3(512), args, LDS_BYTES, stream);
    if (e != hipSuccess) fprintf(stderr, "cooperative launch failed: %s (grid %d)\n", hipGetErrorString(e), grid);
}
```

```cpp
#include <hip/hip_runtime.h>
#include <hip/hip_cooperative_groups.h>
#include <cstdio>
namespace cg = cooperative_groups;

#define LAS __attribute__((address_space(3)))
typedef unsigned short bf16_t;
typedef short bf16x8 __attribute__((ext_vector_type(8)));
typedef short bf16x4 __attribute__((ext_vector_type(4)));
typedef float f32x4 __attribute__((ext_vector_type(4)));
typedef unsigned u32x4 __attribute__((ext_vector_type(4)));

constexpr int D = 1024, NB = 4, SEQ = 4096, CL = 256, TL = NB * SEQ, TC = NB * CL, T = TL + TC, DFF = 2816, INW = 2816, HYW = 3072;
constexpr int NMOD = 9;
constexpr float EPS = 1e-6f;
constexpr int NCH = 34;
constexpr int LDS_BYTES = 144 * 1024;

constexpr size_t SZ_WGU = (size_t)2 * DFF * D * 2, SZ_WD = (size_t)D * DFF * 2, SZ_WIN = (size_t)INW * D * 2, SZ_WOUT = (size_t)D * D * 2, SZ_HWIN = (size_t)HYW * D * 2;
constexpr size_t WS_WGU = 0;
constexpr size_t WS_WD = WS_WGU + 8 * SZ_WGU;
constexpr size_t WS_WIN = WS_WD + 8 * SZ_WD;
constexpr size_t WS_WOUT = WS_WIN + 2 * SZ_WIN;
constexpr size_t WS_HWIN = WS_WOUT + 2 * SZ_WOUT;
constexpr size_t WS_HWOUT = WS_HWIN + 2 * SZ_HWIN;
constexpr size_t WS_MOD = WS_HWOUT + 2 * SZ_WOUT;
constexpr size_t WS_ROPE = WS_MOD + (size_t)4 * 5 * NMOD * D * 4;
constexpr size_t WS_XC = WS_ROPE + (size_t)4 * SEQ * 32 * 4;
constexpr size_t WS_H = WS_XC + (size_t)TC * D * 4;
constexpr size_t WS_BIG = WS_H + (size_t)T * D * 2;
constexpr size_t WS_Y = WS_BIG + (size_t)T * HYW * 2;
constexpr size_t WS_MIX = WS_Y + (size_t)T * D * 4;
constexpr size_t SZ_ST = (size_t)NB * NCH * 8 * 4096 * 4;
constexpr size_t WS_ST = WS_MIX + (size_t)T * D * 2;
constexpr size_t SZ_KF = (size_t)(SEQ + CL) * 2 * D * 4;
constexpr size_t WS_KF = WS_ST + 4 * SZ_ST;
constexpr size_t WS_YP = WS_KF + 2 * SZ_KF;
constexpr size_t WS_BAR = WS_YP + (size_t)4 * TC * D * 4;
constexpr size_t WS_CNT = WS_BAR + 16384;
constexpr size_t SZ_CNT = (size_t)12 * 2 * 64 * 256 + 16 * 256;
constexpr size_t WS_SLOT = WS_CNT + SZ_CNT;
constexpr size_t WS_END = WS_SLOT + (size_t)2 * TL * 4 * 4;

struct KP { const float* in[29]; float* out; unsigned char* ws; };
extern __shared__ __attribute__((aligned(16))) unsigned char g_smem[];
constexpr int PTAB_OFF = LDS_BYTES - 512;
__device__ __forceinline__ const float* pin_ld(int k) {
    const unsigned long long v = *(volatile LAS unsigned long long*)((LAS unsigned char*)g_smem + PTAB_OFF + 8 * k);
    const unsigned lo = __builtin_amdgcn_readfirstlane((unsigned)v), hi = __builtin_amdgcn_readfirstlane((unsigned)(v >> 32));
    return (const float*)(((unsigned long long)hi << 32) | lo);
}
struct KQ { float* out; unsigned char* ws; };
__device__ __forceinline__ KQ lq(KQ q) { asm volatile("" : "+s"(q.out), "+s"(q.ws)); return q; }

__device__ __forceinline__ bf16_t f2bf(float f) { unsigned u = __float_as_uint(f); u += 0x7FFFu + ((u >> 16) & 1u); return (bf16_t)(u >> 16); }
__device__ __forceinline__ float bf2f(bf16_t b) { return __uint_as_float(((unsigned)b) << 16); }
__device__ __forceinline__ float silu_f(float x) { return x * __builtin_amdgcn_rcpf(1.0f + __expf(-x)); }
__device__ __forceinline__ int ltid() { int t = threadIdx.x; asm volatile("" : "+v"(t)); return t; }
__device__ __forceinline__ float wave_sum(float v) {
#pragma unroll
    for (int o = 32; o > 0; o >>= 1) v += __shfl_xor(v, o, 64);
    return v;
}


#define XB_TMO      128
#define XB_XCNT(j)  (256  + 64 * (j))
#define XB_XSUB(j)  (1280 + 64 * (j))
#define XB_XGEN(j)  (2304 + 64 * (j))
#define XB_TOP      3328
#define XB_TOPGEN   3392
#define XCD_BAR_WORDS 3456
#define XB_SPIN_CAP (1u << 18)
__device__ __forceinline__ unsigned xb_ld(unsigned* p)              { return __hip_atomic_load(p, __ATOMIC_RELAXED, __HIP_MEMORY_SCOPE_AGENT); }
__device__ __forceinline__ unsigned xb_add(unsigned* p, unsigned v) { return __hip_atomic_fetch_add(p, v, __ATOMIC_RELAXED, __HIP_MEMORY_SCOPE_AGENT); }
__device__ __forceinline__ unsigned xb_xcc_id() { return (unsigned)__builtin_amdgcn_s_getreg((3 << 11) | 20) & 0xFu; }
#define XB_SPIN(cond, bar) do { unsigned _sp = 0; while (cond) { __builtin_amdgcn_s_sleep(1); \
    if ((++_sp & 255u) == 0u) { if (xb_ld(&(bar)[XB_TMO])) break; if (_sp > XB_SPIN_CAP) { atomicAdd(&(bar)[XB_TMO], 1u); break; } } } } while (0)
struct XcdBarrier { unsigned* bar; unsigned x; volatile LAS unsigned* st; };
__device__ __forceinline__ XcdBarrier xcd_barrier_post(unsigned* bar, volatile LAS unsigned* st) {
    XcdBarrier b; b.bar = bar; b.x = xb_xcc_id(); b.st = st;
    if (threadIdx.x == 0) (void)xb_add(&bar[XB_XCNT(b.x)], 1u);
    return b;
}
__device__ __forceinline__ void xcd_barrier_complete(unsigned* bar, unsigned x, unsigned& nloc, unsigned& nx) {
    const unsigned G = gridDim.x * gridDim.y * gridDim.z;
    unsigned sum, cnt, mine, sp = 0u;
    for (;;) {
        sum = 0u; cnt = 0u; mine = 0u;
#pragma unroll
        for (unsigned j = 0; j < 16; ++j) { const unsigned c = xb_ld(&bar[XB_XCNT(j)]); sum += c; cnt += (c > 0u) ? 1u : 0u; mine = (j == x) ? c : mine; }
        if (sum == G) break;
        __builtin_amdgcn_s_sleep(1);
        if ((++sp & 255u) == 0u) { if (xb_ld(&bar[XB_TMO])) break; if (sp > XB_SPIN_CAP) { atomicAdd(&bar[XB_TMO], 1u); break; } }
    }
    nloc = mine > 0u ? mine : 1u; nx = cnt > 0u ? cnt : 1u;
}
__device__ __forceinline__ void xcd_barrier_impl(unsigned* bar, volatile LAS unsigned* st) {
    asm volatile("s_waitcnt vmcnt(0)" ::: "memory");
    __syncthreads();
    if (ltid() == 0) {
        const unsigned x = xb_xcc_id();
        __builtin_amdgcn_s_waitcnt(0);
        unsigned nloc = st[0], nx = st[1];
        if (nloc == 0u) { xcd_barrier_complete(bar, x, nloc, nx); st[0] = nloc; st[1] = nx; }
        const unsigned old = xb_add(&bar[XB_XSUB(x)], 1u);
        const unsigned gen = old / nloc;
        if (old + 1u == (gen + 1u) * nloc) {
            __builtin_amdgcn_fence(__ATOMIC_RELEASE, "agent");
            asm volatile("s_waitcnt vmcnt(0)" ::: "memory");
            const unsigned og = xb_add(&bar[XB_TOP], 1u);
            const unsigned tg = og / nx;
            if (og + 1u == (tg + 1u) * nx) xb_add(&bar[XB_TOPGEN], 1u);
            else XB_SPIN(xb_ld(&bar[XB_TOPGEN]) == tg, bar);
            __builtin_amdgcn_fence(__ATOMIC_ACQUIRE, "agent");
            xb_add(&bar[XB_XGEN(x)], 1u);
            asm volatile("s_waitcnt vmcnt(0)" ::: "memory");
        } else {
            XB_SPIN(xb_ld(&bar[XB_XGEN(x)]) == gen, bar);
            __builtin_amdgcn_fence(__ATOMIC_ACQUIRE, "agent");
            asm volatile("s_waitcnt vmcnt(0)" ::: "memory");
        }
    }
    __syncthreads();
}
__device__ __forceinline__ void sub_barrier(unsigned* word, unsigned n) {
    asm volatile("s_waitcnt vmcnt(0)" ::: "memory");
    __syncthreads();
    if (ltid() == 0) {
        __builtin_amdgcn_fence(__ATOMIC_RELEASE, "agent");
        asm volatile("s_waitcnt vmcnt(0)" ::: "memory");
        (void)xb_add(word, 1u);
        for (unsigned sp = 0; sp < (1u << 21); ++sp) { if (xb_ld(word) >= n) break; __builtin_amdgcn_s_sleep(2); }
        __builtin_amdgcn_fence(__ATOMIC_ACQUIRE, "agent");
        asm volatile("s_waitcnt vmcnt(0)" ::: "memory");
    }
    __syncthreads();
}
__device__ __forceinline__ void sub_arrive(unsigned* word) {
    asm volatile("s_waitcnt vmcnt(0)" ::: "memory");
    __syncthreads();
    if (ltid() == 0) { __builtin_amdgcn_fence(__ATOMIC_RELEASE, "agent"); asm volatile("s_waitcnt vmcnt(0)" ::: "memory"); (void)xb_add(word, 1u); }
}
__device__ __forceinline__ void sub_wait(unsigned* word, unsigned n) {
    if (ltid() == 0) {
        for (unsigned sp = 0; sp < (1u << 21); ++sp) { if (xb_ld(word) >= n) break; __builtin_amdgcn_s_sleep(2); }
        __builtin_amdgcn_fence(__ATOMIC_ACQUIRE, "agent");
        asm volatile("s_waitcnt vmcnt(0)" ::: "memory");
    }
    __syncthreads();
}
#define GRID_BAR() xcd_barrier_impl((unsigned*)(p.ws + WS_BAR), (volatile LAS unsigned*)((LAS unsigned char*)smem + LDS_BYTES - 16))

namespace pg8 {
constexpr int BM = 256, BK = 64, HALF = 128, HTB = HALF * BK * 2, STAGE_BYTES = 8 * HTB, NXCD = 8, WGM = 8;
__host__ __device__ __forceinline__ int lds_byte(int r, int c) { const int st = (r >> 4) * 2 + (c >> 5), rr = r & 15, cc = c & 31, ob = rr * 64 + cc * 2; return st * 1024 + (ob ^ (((ob >> 9) & 1) << 5)); }
__host__ __device__ __forceinline__ void stage_rc(int b, int& R, int& C) { const int st = b / 1024, sb = b % 1024, swz = sb ^ (((sb >> 9) & 1) << 5); R = (st >> 1) * 16 + swz / 64; C = (st & 1) * 32 + (swz % 64) / 2; }
__host__ __device__ __forceinline__ int perm32(int rho) { const int n = rho >> 4, i = rho & 15; return 8 * (i >> 2) + 4 * n + (i & 3); }
struct Unit { int pm, pn; };
struct Gemm { const bf16_t* A; const bf16_t* Bt; int M, N, K, ld; };
struct StaticOrder {
    int nM, nN, nwg, G, c;
    __device__ void init(int M, int N, int G_, int c_) { nM = M / BM; nN = N / BM; nwg = nM * nN; G = G_; c = c_; }
    __device__ bool next(int i, Unit& u) const {
        const long Lx = (long)i * G + c; if (Lx >= nwg) return false;
        int wgid = (int)Lx; { const int q = nwg / NXCD, r = nwg % NXCD, xcd = wgid % NXCD, off = wgid / NXCD; wgid = (xcd < r ? xcd * (q + 1) : r * (q + 1) + (xcd - r) * q) + off; }
        const int nig = WGM * nN, gid = wgid / nig, fm = gid * WGM, gsz = (nM - fm) < WGM ? (nM - fm) : WGM;
        u.pm = fm + ((wgid % nig) % gsz); u.pn = (wgid % nig) / gsz; return true;
    }
};
__device__ __forceinline__ unsigned cvt_pk_bf16(float lo, float hi) { unsigned r; asm volatile("v_cvt_pk_bf16_f32 %0, %1, %2" : "=v"(r) : "v"(lo), "v"(hi)); return r; }

struct EpiF32 {
    static constexpr bool PERM = false, AFTER_DRAIN = false;
    float* C; int ldc;
    __device__ __forceinline__ void operator()(const f32x4 (&acc)[2][2][4][2], const Unit& u, int wr, int wc, int fr, int fq) const {
        const int row0 = u.pm * BM + wr * 64 + fr, col0 = u.pn * BM + wc * 32 + 4 * fq;
#pragma unroll
        for (int ai = 0; ai < 2; ++ai)
#pragma unroll
            for (int m = 0; m < 4; ++m) { float* rowp = C + (size_t)(row0 + ai * HALF + m * 16) * ldc + col0;
#pragma unroll
                for (int bj = 0; bj < 2; ++bj)
#pragma unroll
                    for (int n = 0; n < 2; ++n) *(f32x4*)(rowp + bj * HALF + n * 16) = acc[ai][bj][m][n]; }
    }
};
struct EpiBf16 {
    static constexpr bool PERM = true, AFTER_DRAIN = false;
    bf16_t* O; int ldc; const float* bias;
    __device__ __forceinline__ void operator()(const f32x4 (&acc)[2][2][4][2], const Unit& u, int wr, int wc, int fr, int fq) const {
        const int row0 = u.pm * BM + wr * 64 + fr; const int col0 = u.pn * BM + wc * 32 + 8 * fq;
        f32x4 bv[2][2];
#pragma unroll
        for (int bj = 0; bj < 2; ++bj)
#pragma unroll
            for (int n = 0; n < 2; ++n) bv[bj][n] = bias ? *(const f32x4*)(bias + col0 + bj * HALF + 4 * n) : (f32x4){0.f, 0.f, 0.f, 0.f};
#pragma unroll
        for (int ai = 0; ai < 2; ++ai)
#pragma unroll
            for (int m = 0; m < 4; ++m) { bf16_t* rowp = O + (size_t)(row0 + ai * HALF + m * 16) * ldc + col0;
#pragma unroll
                for (int bj = 0; bj < 2; ++bj) { f32x4 v0 = acc[ai][bj][m][0] + bv[bj][0], v1 = acc[ai][bj][m][1] + bv[bj][1];
                    u32x4 w; w.x = cvt_pk_bf16(v0[0], v0[1]); w.y = cvt_pk_bf16(v0[2], v0[3]); w.z = cvt_pk_bf16(v1[0], v1[1]); w.w = cvt_pk_bf16(v1[2], v1[3]);
                    *(u32x4*)(rowp + bj * HALF) = w; } }
    }
};
struct EpiSwiGLU {
    static constexpr bool PERM = true, AFTER_DRAIN = false;
    bf16_t* O; int ldc;
    __device__ __forceinline__ void operator()(const f32x4 (&acc)[2][2][4][2], const Unit& u, int wr, int wc, int fr, int fq) const {
        const int row0 = u.pm * BM + wr * 64 + fr; const int col0 = u.pn * HALF + wc * 32 + 8 * fq;
#pragma unroll
        for (int ai = 0; ai < 2; ++ai)
#pragma unroll
            for (int m = 0; m < 4; ++m) { bf16_t* rowp = O + (size_t)(row0 + ai * HALF + m * 16) * ldc + col0;
                float v[8];
#pragma unroll
                for (int n = 0; n < 2; ++n)
#pragma unroll
                    for (int j = 0; j < 4; ++j) { const float g = acc[ai][0][m][n][j], up = acc[ai][1][m][n][j]; v[n * 4 + j] = silu_f(g) * up; }
                u32x4 w; w.x = cvt_pk_bf16(v[0], v[1]); w.y = cvt_pk_bf16(v[2], v[3]); w.z = cvt_pk_bf16(v[4], v[5]); w.w = cvt_pk_bf16(v[6], v[7]);
                *(u32x4*)rowp = w; }
    }
};


__device__ __forceinline__ void row_exchange(const f32x4 (&v)[2][2][4][2], const Unit& u, int wr, int wc, int fr, int fq, LAS unsigned char* lds, int wid, int lane, float* slots, unsigned* cnt) {
    LAS float* P = (LAS float*)lds;
    LAS float* S = (LAS float*)(lds + 4096);
#pragma unroll
    for (int ai = 0; ai < 2; ++ai)
#pragma unroll
        for (int m = 0; m < 4; ++m) {
            float sq = 0.f;
#pragma unroll
            for (int bj = 0; bj < 2; ++bj)
#pragma unroll
                for (int n = 0; n < 2; ++n) { const f32x4 x = v[ai][bj][m][n]; sq += (x[0] * x[0] + x[1] * x[1]) + (x[2] * x[2] + x[3] * x[3]); }
            sq += __shfl_xor(sq, 16); sq += __shfl_xor(sq, 32);
            if (fq == 0) P[(ai * HALF + wr * 64 + m * 16 + fr) * 4 + wc] = sq;
        }
    asm volatile("s_waitcnt lgkmcnt(0)" ::: "memory"); __builtin_amdgcn_s_barrier(); asm volatile("" ::: "memory");
    const int row = wid * 32 + (lane & 31);
    if (lane < 32) {
        const float tot = (P[row * 4 + 0] + P[row * 4 + 1]) + (P[row * 4 + 2] + P[row * 4 + 3]);
        __hip_atomic_store((unsigned*)slots + ((size_t)(u.pm * BM + row) * 4 + u.pn), __float_as_uint(tot), __ATOMIC_RELAXED, __HIP_MEMORY_SCOPE_AGENT);
    }
    asm volatile("s_waitcnt vmcnt(0)" ::: "memory");
    if (lane == 0) __hip_atomic_fetch_add(cnt + 64 * u.pm, 1u, __ATOMIC_RELAXED, __HIP_MEMORY_SCOPE_AGENT);
    if (wid == 0) {
        for (unsigned sp = 0; sp < (1u << 21); ++sp) {
            if ((unsigned)__builtin_amdgcn_readfirstlane(__hip_atomic_load(cnt + 64 * u.pm, __ATOMIC_RELAXED, __HIP_MEMORY_SCOPE_AGENT)) >= 32u) break;
            __builtin_amdgcn_s_sleep(2);
        }
        __builtin_amdgcn_fence(__ATOMIC_ACQUIRE, "agent");
    }
    asm volatile("s_waitcnt vmcnt(0) lgkmcnt(0)" ::: "memory"); __builtin_amdgcn_s_barrier(); asm volatile("" ::: "memory");
    if (lane < 32) {
        const unsigned* sl = (const unsigned*)slots + (size_t)(u.pm * BM + row) * 4;
        float tot = 0.f;
#pragma unroll
        for (int t = 0; t < 4; ++t) tot += __uint_as_float(__hip_atomic_load(sl + t, __ATOMIC_RELAXED, __HIP_MEMORY_SCOPE_AGENT));
        S[row] = tot;
    }
    asm volatile("s_waitcnt vmcnt(0) lgkmcnt(0)" ::: "memory"); __builtin_amdgcn_s_barrier(); asm volatile("" ::: "memory");
}
struct EpiFusedRow {
    static constexpr bool PERM = false, AFTER_DRAIN = true;
    const float* xin; float* xout; bf16_t* H;
    const float* gate; const float* gpost; float wgt;
    const float* gpre; const float* shift; const float* scale;
    float* slots; unsigned* cnt;
    __device__ __forceinline__ void operator()(const f32x4 (&)[2][2][4][2], const Unit&, int, int, int, int) const {}
    __device__ __forceinline__ void fused(f32x4 (&acc)[2][2][4][2], const Unit& u, int wr, int wc, int fr, int fq, LAS unsigned char* lds, int wid, int lane) const {
        const LAS float* S = (const LAS float*)(lds + 4096);
        const int col0 = u.pn * BM + wc * 32 + 4 * fq; const size_t mb = (size_t)(u.pm >> 4) * (NMOD * D);
        f32x4 cw[2][2];
#pragma unroll
        for (int bj = 0; bj < 2; ++bj)
#pragma unroll
            for (int n = 0; n < 2; ++n) cw[bj][n] = *(const f32x4*)(gate + mb + col0 + bj * HALF + n * 16) * *(const f32x4*)(gpost + col0 + bj * HALF + n * 16);
        row_exchange(acc, u, wr, wc, fr, fq, lds, wid, lane, slots, cnt);
        {
#pragma unroll
            for (int ai = 0; ai < 2; ++ai)
#pragma unroll
                for (int m = 0; m < 4; ++m) { const int r = ai * HALF + wr * 64 + m * 16 + fr; const float r1 = rsqrtf(S[r] * (1.0f / D) + EPS) * wgt; const size_t off = (size_t)(u.pm * BM + r) * D + col0;
#pragma unroll
                    for (int bj = 0; bj < 2; ++bj)
#pragma unroll
                        for (int n = 0; n < 2; ++n) { const f32x4 xv = *(const f32x4*)(xin + off + bj * HALF + n * 16); const f32x4 xn = xv + (cw[bj][n] * r1) * acc[ai][bj][m][n];
                            acc[ai][bj][m][n] = xn; *(f32x4*)(xout + off + bj * HALF + n * 16) = xn; }
                    asm volatile("" : "+v"(acc[ai][0][m][0]), "+v"(acc[ai][0][m][1]), "+v"(acc[ai][1][m][0]), "+v"(acc[ai][1][m][1]));
                    asm volatile("" ::: "memory"); }
        }
        if (H == nullptr) return;
        f32x4 gm[2][2], sh[2][2];
#pragma unroll
        for (int bj = 0; bj < 2; ++bj)
#pragma unroll
            for (int n = 0; n < 2; ++n) { const int c = col0 + bj * HALF + n * 16; gm[bj][n] = *(const f32x4*)(gpre + c) * (*(const f32x4*)(scale + mb + c) + 1.0f); sh[bj][n] = *(const f32x4*)(shift + mb + c); }
        row_exchange(acc, u, wr, wc, fr, fq, lds, wid, lane, slots + (size_t)TL * 4, cnt + 64 * 64);
        {
#pragma unroll
            for (int ai = 0; ai < 2; ++ai)
#pragma unroll
                for (int m = 0; m < 4; ++m) { const int r = ai * HALF + wr * 64 + m * 16 + fr; const float r2 = rsqrtf(S[r] * (1.0f / D) + EPS); const size_t off = (size_t)(u.pm * BM + r) * D + col0;
#pragma unroll
                    for (int bj = 0; bj < 2; ++bj)
#pragma unroll
                        for (int n = 0; n < 2; ++n) { const f32x4 hv = (acc[ai][bj][m][n] * r2) * gm[bj][n] + sh[bj][n];
                            uint2 w2; w2.x = cvt_pk_bf16(hv[0], hv[1]); w2.y = cvt_pk_bf16(hv[2], hv[3]); *(uint2*)(H + off + bj * HALF + n * 16) = w2; }
                    asm volatile("" ::: "memory"); }
        }
    }
};

template <class Epi, class Sched>
__device__ __forceinline__ void gemm_phase(LAS unsigned char* lds, const Gemm g, const Sched& S, const Epi& E) {
    const int tid = ltid(), wid = __builtin_amdgcn_readfirstlane(tid >> 6), lane = tid & 63, wr = wid >> 2, wc = wid & 3, fr = lane & 15, fq = lane >> 4;
    const int K = g.ld, nt = g.K / BK;
    unsigned voffA[2], voffB[2];
#pragma unroll
    for (int i = 0; i < 2; ++i) { int R, C; stage_rc(tid * 16 + i * 8192, R, C); const int Rb = Epi::PERM ? ((R & ~31) + perm32(R & 31)) : R;
        voffA[i] = (unsigned)(R * K + C) * 2u; voffB[i] = (unsigned)(Rb * K + C) * 2u; }
    const size_t kstep = (size_t)(BK * 2);
    const size_t hstep = (size_t)HALF * K * 2;
    const size_t tstep = 2 * hstep;
    const unsigned ldsw = (unsigned)wid * 1024u;
    const int aoff = lds_byte(wr * 64 + fr, fq * 8), boff = lds_byte(wc * 32 + fr, fq * 8);
#define PG8_SA(b, h) (((b) * 2 + (h)) * HTB)
#define PG8_SB(b, h) ((4 + (b) * 2 + (h)) * HTB)
#define PG8_STAGE(bufoff, gbase, voff) do { _Pragma("unroll") for (int _i = 0; _i < 2; ++_i) \
        __builtin_amdgcn_global_load_lds((const unsigned*)((const char*)(gbase) + (voff)[_i]), (LAS unsigned*)(lds + (bufoff) + ldsw + _i * 8192), 16, 0, 0); } while (0)
#define PG8_LDA(dst, b, h) do { _Pragma("unroll") for (int m = 0; m < 4; ++m) _Pragma("unroll") for (int k = 0; k < 2; ++k) dst[m][k] = *(const LAS bf16x8*)(lds + PG8_SA(b, h) + aoff + m * 2048 + k * 1024); } while (0)
#define PG8_LDB(dst, b, h) do { _Pragma("unroll") for (int n = 0; n < 2; ++n) _Pragma("unroll") for (int k = 0; k < 2; ++k) dst[n][k] = *(const LAS bf16x8*)(lds + PG8_SB(b, h) + boff + n * 2048 + k * 1024); } while (0)
#define PG8_MMA(ai, bj, At, Bt) do { __builtin_amdgcn_s_setprio(1); _Pragma("unroll") for (int m = 0; m < 4; ++m) _Pragma("unroll") for (int n = 0; n < 2; ++n) _Pragma("unroll") for (int k = 0; k < 2; ++k) \
        acc[ai][bj][m][n] = __builtin_amdgcn_mfma_f32_16x16x32_bf16(Bt[n][k], At[m][k], acc[ai][bj][m][n], 0, 0, 0); __builtin_amdgcn_s_setprio(0); } while (0)
#define PG8_WAIT_V(n) asm volatile("s_waitcnt vmcnt(" #n ")" ::: "memory")
#define PG8_WAIT_L(n) asm volatile("s_waitcnt lgkmcnt(" #n ")" ::: "memory")
#define PG8_BAR __builtin_amdgcn_s_barrier()
#define PG8_SCHED __builtin_amdgcn_sched_barrier(0)
    Unit cur, nxt; int ui = 0;
    if (!S.next(0, cur)) return;
    f32x4 acc[2][2][4][2];
#pragma unroll
    for (int a = 0; a < 2; ++a)
#pragma unroll
        for (int b = 0; b < 2; ++b)
#pragma unroll
            for (int m = 0; m < 4; ++m)
#pragma unroll
                for (int n = 0; n < 2; ++n) acc[a][b][m][n] = (f32x4){0.f, 0.f, 0.f, 0.f};
    bf16x8 At[4][2], B0[2][2], B1[2][2];
    const char* cA = (const char*)g.A + (size_t)cur.pm * tstep; const char* cB = (const char*)g.Bt + (size_t)cur.pn * tstep;
    PG8_STAGE(PG8_SB(0, 0), cB, voffB); PG8_STAGE(PG8_SA(0, 0), cA, voffA); PG8_STAGE(PG8_SB(0, 1), cB + hstep, voffB); PG8_STAGE(PG8_SA(0, 1), cA + hstep, voffA);
    if (wr == 1) PG8_BAR;
    PG8_WAIT_V(4); PG8_BAR;
    PG8_STAGE(PG8_SB(1, 0), cB + kstep, voffB); PG8_STAGE(PG8_SA(1, 0), cA + kstep, voffA); PG8_STAGE(PG8_SB(1, 1), cB + hstep + kstep, voffB);
    PG8_WAIT_V(6); PG8_BAR;
    for (;;) {
        const bool has_next = S.next(ui + 1, nxt);
        const char* nA = has_next ? (const char*)g.A + (size_t)nxt.pm * tstep : cA; const char* nB = has_next ? (const char*)g.Bt + (size_t)nxt.pn * tstep : cB;
        for (int t = 0; t < nt; t += 2) {
            const bool last = (t == nt - 2);
            const char* a1 = cA + (size_t)(t + 1) * kstep;
            const char* a2 = last ? nA : cA + (size_t)(t + 2) * kstep; const char* b2 = last ? nB : cB + (size_t)(t + 2) * kstep;
            const char* a3 = a2 + kstep; const char* b3 = b2 + kstep;
            PG8_LDB(B0, 0, 0); PG8_SCHED; PG8_LDA(At, 0, 0); PG8_STAGE(PG8_SA(1, 1), a1 + hstep, voffA);
            PG8_WAIT_L(8); PG8_BAR; PG8_WAIT_L(0); PG8_MMA(0, 0, At, B0); PG8_BAR; PG8_SCHED;
            PG8_LDB(B1, 0, 1); PG8_STAGE(PG8_SB(0, 0), b2, voffB);
            PG8_BAR; PG8_WAIT_L(0); PG8_MMA(0, 1, At, B1); PG8_BAR;
            PG8_LDA(At, 0, 1); PG8_STAGE(PG8_SA(0, 0), a2, voffA);
            PG8_BAR; PG8_WAIT_L(0); PG8_MMA(1, 0, At, B0); PG8_BAR; PG8_SCHED;
            PG8_STAGE(PG8_SB(0, 1), b2 + hstep, voffB);
            PG8_WAIT_V(6); PG8_BAR; PG8_MMA(1, 1, At, B1); PG8_BAR;
            PG8_LDB(B0, 1, 0); PG8_SCHED; PG8_LDA(At, 1, 0); PG8_STAGE(PG8_SA(0, 1), a2 + hstep, voffA);
            PG8_WAIT_L(8); PG8_BAR; PG8_WAIT_L(0); PG8_MMA(0, 0, At, B0); PG8_BAR; PG8_SCHED;
            PG8_LDB(B1, 1, 1); PG8_STAGE(PG8_SB(1, 0), b3, voffB);
            PG8_BAR; PG8_WAIT_L(0); PG8_MMA(0, 1, At, B1); PG8_BAR;
            PG8_LDA(At, 1, 1); PG8_STAGE(PG8_SA(1, 0), a3, voffA);
            PG8_BAR; PG8_WAIT_L(0); PG8_MMA(1, 0, At, B0); PG8_BAR; PG8_SCHED;
            PG8_STAGE(PG8_SB(1, 1), b3 + hstep, voffB);
            PG8_WAIT_V(6); PG8_BAR; PG8_MMA(1, 1, At, B1); PG8_BAR;
        }
        if constexpr (!Epi::AFTER_DRAIN) E(acc, cur, wr, wc, fr, fq);
        if (!has_next) break;
#pragma unroll
        for (int a = 0; a < 2; ++a)
#pragma unroll
            for (int b = 0; b < 2; ++b)
#pragma unroll
                for (int m = 0; m < 4; ++m)
#pragma unroll
                    for (int n = 0; n < 2; ++n) acc[a][b][m][n] = (f32x4){0.f, 0.f, 0.f, 0.f};
        cur = nxt; cA = nA; cB = nB; ++ui;
    }
    PG8_WAIT_V(0);
    if (wr == 0) PG8_BAR;
    PG8_BAR;
    if constexpr (Epi::AFTER_DRAIN) E.fused(acc, cur, wr, wc, fr, fq, lds, wid, lane);
#undef PG8_SA
#undef PG8_SB
#undef PG8_STAGE
#undef PG8_LDA
#undef PG8_LDB
#undef PG8_MMA
#undef PG8_WAIT_V
#undef PG8_WAIT_L
#undef PG8_BAR
#undef PG8_SCHED
}
}

template <class Epi>
__device__ __forceinline__ void run_gemm(unsigned char* smem, const bf16_t* A, const bf16_t* Bt, int M, int N, int K, const Epi& E) {
    pg8::Gemm g{A, Bt, M, N, K, K}; pg8::StaticOrder S; S.init(M, N, (int)gridDim.x, (int)blockIdx.x);
    pg8::gemm_phase<Epi, pg8::StaticOrder>((LAS unsigned char*)smem, g, S, E);
}
__device__ __forceinline__ void run_gemm_f32_split(unsigned char* smem, const bf16_t* A, const bf16_t* Bt, int M, int K, const pg8::EpiFusedRow& EF, float* YP) {
    { pg8::Gemm g{A, Bt, TL, D, K, K}; pg8::StaticOrder S; S.init(TL, D, (int)gridDim.x, (int)blockIdx.x);
      pg8::gemm_phase<pg8::EpiFusedRow, pg8::StaticOrder>((LAS unsigned char*)smem, g, S, EF); }
    __syncthreads();
    if (M > TL && blockIdx.x < 64) {
        const int ks = blockIdx.x >> 4;
        int koff, klen;
        if (K == DFF) { koff = (ks < 2) ? ks * 768 : 1536 + (ks - 2) * 640; klen = (ks < 2) ? 768 : 640; }
        else { klen = K / 4; koff = ks * klen; }
        pg8::Gemm g{A + (size_t)TL * K + koff, Bt + koff, TC, D, klen, K}; pg8::StaticOrder S; S.init(TC, D, 16, (int)(blockIdx.x & 15)); pg8::EpiF32 E{YP + (size_t)ks * TC * D, D};
        pg8::gemm_phase<pg8::EpiF32, pg8::StaticOrder>((LAS unsigned char*)smem, g, S, E);
        __syncthreads();
    }
}

__device__ __forceinline__ float* xrow(const KQ p, int t) { return t < TL ? p.out + (size_t)t * D : (float*)(p.ws + WS_XC) + (size_t)(t - TL) * D; }
__device__ __forceinline__ int modrow(int t) { return t < TL ? (t >> 12) : 4; }
__device__ __forceinline__ const float* modp(const KQ p, int l, int mr, int idx) { return (const float*)(p.ws + WS_MOD) + ((size_t)(l * 5 + mr) * NMOD + idx) * D; }

__device__ __forceinline__ void p0_setup(const KQ p_in, float* sm) {
    const KQ p = lq(p_in);
    const int tid = ltid(), bid = blockIdx.x, nb = gridDim.x;
    const int gtid = bid * 512 + tid, gthreads = nb * 512;
    {
        float* rope = (float*)(p.ws + WS_ROPE);
        for (int idx = gtid; idx < SEQ * 32; idx += gthreads) {
            const int t = idx >> 5, i = idx & 31;
            const int ii = i & 15; const float pos = (i < 16) ? (float)(t >> 6) : (float)(t & 63);
            const float invA = powf(10000.0f, -(float)ii / 16.0f);
            const float angA = pos * invA;
            rope[idx] = cosf(angA); rope[SEQ * 32 + idx] = sinf(angA);
            const float ex = (float)i * (1.0f / 31.0f);
            const float invR = powf(10000.0f, -ex);
            const float angR = (float)t * invR;
            rope[2 * SEQ * 32 + idx] = cosf(angR); rope[3 * SEQ * 32 + idx] = sinf(angR);
        }
    }
    {
        float* tile = sm;
        for (int gs = bid; gs < 20864 / 4; gs += nb) {
            const int g = gs * 4;
            int j, tl;
            if (g < 16896) { j = g / 704; tl = g % 704; }
            else if (g < 18304) { j = 24 + (g - 16896) / 704; tl = (g - 16896) % 704; }
            else if (g < 18816) { j = 26 + (g - 18304) / 256; tl = (g - 18304) % 256; }
            else if (g < 20352) { j = 28 + (g - 18816) / 768; tl = (g - 18816) % 768; }
            else { j = 30 + (g - 20352) / 256; tl = (g - 20352) % 256; }
            const float* src; bf16_t* dst; int K, N, mode = 0;
            if (j < 8) { src = pin_ld(8) + (size_t)j * D * DFF; dst = (bf16_t*)(p.ws + WS_WGU + (size_t)j * SZ_WGU); K = D; N = DFF; mode = 1; }
            else if (j < 16) { src = pin_ld(9) + (size_t)(j - 8) * D * DFF; dst = (bf16_t*)(p.ws + WS_WGU + (size_t)(j - 8) * SZ_WGU); K = D; N = DFF; mode = 2; }
            else if (j < 24) { src = pin_ld(10) + (size_t)(j - 16) * DFF * D; dst = (bf16_t*)(p.ws + WS_WD + (size_t)(j - 16) * SZ_WD); K = DFF; N = D; }
            else if (j < 26) { src = pin_ld(11) + (size_t)(j - 24) * D * INW; dst = (bf16_t*)(p.ws + WS_WIN + (size_t)(j - 24) * SZ_WIN); K = D; N = INW; mode = 3; }
            else if (j < 28) { src = pin_ld(14) + (size_t)(j - 26) * D * D; dst = (bf16_t*)(p.ws + WS_WOUT + (size_t)(j - 26) * SZ_WOUT); K = D; N = D; }
            else if (j < 30) { src = pin_ld(15) + (size_t)(j - 28) * D * HYW; dst = (bf16_t*)(p.ws + WS_HWIN + (size_t)(j - 28) * SZ_HWIN); K = D; N = HYW; }
            else { src = pin_ld(28) + (size_t)(j - 30) * D * D; dst = (bf16_t*)(p.ws + WS_HWOUT + (size_t)(j - 30) * SZ_WOUT); K = D; N = D; }
            const int ntn = N / 64; const int k0 = (tl / ntn) * 64, n0 = (tl % ntn) * 64;
            f32x4 ld[8];
#pragma unroll
            for (int i = 0; i < 8; ++i) ld[i] = *(const f32x4*)(src + (size_t)(k0 + i * 8 + (tid >> 6)) * N + n0 + (tid & 63) * 4);
            __syncthreads();
#pragma unroll
            for (int i = 0; i < 8; ++i) *(f32x4*)(tile + (i * 8 + (tid >> 6)) * 260 + (tid & 63) * 4) = ld[i];
            __syncthreads();
            {
                const int n = tid >> 1, kh = (tid & 1) * 32; const int gn = n0 + n;
                float sc_ = 1.0f; int row = gn;
                if (mode == 1) row = 256 * (gn >> 7) + (gn & 127);
                else if (mode == 2) row = 256 * (gn >> 7) + 128 + (gn & 127);
                else if (mode == 3) { if (gn < 512) sc_ = 0.125f * 1.44269504f; else if (gn >= 1792 && gn < 2304) sc_ = 0.125f; }
#pragma unroll
                for (int q = 0; q < 4; ++q) {
                    float v[8];
#pragma unroll
                    for (int jj = 0; jj < 8; ++jj) v[jj] = tile[(kh + q * 8 + jj) * 260 + n] * sc_;
                    u32x4 o4; o4.x = pg8::cvt_pk_bf16(v[0], v[1]); o4.y = pg8::cvt_pk_bf16(v[2], v[3]); o4.z = pg8::cvt_pk_bf16(v[4], v[5]); o4.w = pg8::cvt_pk_bf16(v[6], v[7]);
                    *(u32x4*)(dst + (size_t)row * K + k0 + kh + q * 8) = o4;
                }
            }
        }
        __syncthreads();
    }
    {
        float* sc = sm;
        float* red = sm + 5 * 1024;
        for (int i = tid; i < 5 * 1024; i += 512) { const int r = i >> 10, k = i & 1023; const float v = (r < 4) ? pin_ld(1)[r * D + k] : pin_ld(3)[k]; sc[i] = silu_f(v); }
        __syncthreads();
        const int w = tid >> 6, lane = tid & 63;
        for (int it = bid; it < 288; it += nb) {
            const int l = it / 72, c0 = (it % 72) * 128;
            const float* wm = pin_ld(4) + (size_t)l * D * (NMOD * D) + c0 + 2 * lane;
            float a[5][2];
#pragma unroll
            for (int r = 0; r < 5; ++r) { a[r][0] = 0.f; a[r][1] = 0.f; }
            for (int kb = w * 128; kb < w * 128 + 128; kb += 16) {
                float2 wv[16];
#pragma unroll
                for (int q = 0; q < 16; ++q) wv[q] = *(const float2*)(wm + (size_t)(kb + q) * (NMOD * D));
#pragma unroll
                for (int q = 0; q < 16; ++q)
#pragma unroll
                    for (int r = 0; r < 5; ++r) { const float s = sc[r * 1024 + kb + q]; a[r][0] += s * wv[q].x; a[r][1] += s * wv[q].y; }
            }
#pragma unroll
            for (int r = 0; r < 5; ++r) { red[(w * 5 + r) * 128 + 2 * lane] = a[r][0]; red[(w * 5 + r) * 128 + 2 * lane + 1] = a[r][1]; }
            __syncthreads();
            for (int i = tid; i < 5 * 128; i += 512) {
                const int r = i >> 7, c = i & 127; float s = 0.f;
#pragma unroll
                for (int ww = 0; ww < 8; ++ww) s += red[(ww * 5 + r) * 128 + c];
                s += pin_ld(5)[(size_t)l * (NMOD * D) + c0 + c];
                ((float*)(p.ws + WS_MOD))[(size_t)(l * 5 + r) * (NMOD * D) + c0 + c] = s;
            }
            __syncthreads();
        }
    }
    {
        float* z = sm;
        float* a1 = sm + 16 * 36;
        float* a2 = a1 + 16 * 64;
        float* a3 = a2 + 16 * 64;
        float* tl = a3 + 16 * 64;
        float* wl = tl + 16;
        const float HMAX = -4.605170185988091f / 0.3f, HMIN = -4.605170185988091f / 1.5f;
        int o_loaded = -1;
        for (int it = nb - 1 - bid; it < 544; it += nb) {
            const int o = it / 272, r = it % 272;
            const int Lf = (r < 256) ? SEQ : CL; const int p0 = (r < 256) ? r * 16 : (r - 256) * 16;
            float* kf = (float*)(p.ws + WS_KF + (size_t)o * SZ_KF) + ((r < 256) ? (size_t)0 : (size_t)2 * SEQ * D);
            const float* f3 = pin_ld(25) + (size_t)o * 64 * 2048;
            __syncthreads();
            if (o != o_loaded) {
                const float* f0 = pin_ld(19) + (size_t)o * 33 * 64; const float* f1 = pin_ld(21) + (size_t)o * 64 * 64; const float* f2 = pin_ld(23) + (size_t)o * 64 * 64;
                for (int i = tid; i < 33 * 64; i += 512) wl[i] = f0[i];
                for (int i = tid; i < 64 * 64; i += 512) { wl[2112 + i] = f1[i]; wl[2112 + 4096 + i] = f2[i]; }
                if (tid < 64) { wl[10304 + tid] = pin_ld(20)[o * 64 + tid]; wl[10304 + 64 + tid] = pin_ld(22)[o * 64 + tid]; wl[10304 + 128 + tid] = pin_ld(24)[o * 64 + tid]; wl[10304 + 192 + tid] = pin_ld(26)[o * 64 + tid]; }
                o_loaded = o;
            }
            const float* f0 = wl; const float* f1 = wl + 2112; const float* f2 = wl + 2112 + 4096;
            const float* fb0 = wl + 10304; const float* fb1 = fb0 + 64; const float* fb2 = fb0 + 128; const float* fq = fb0 + 192;
            for (int idx = tid; idx < 16 * 33; idx += 512) {
                const int ps = idx / 33, f = idx % 33; const int i = p0 + ps;
                const float tlin = (float)i * (1.0f / (float)(Lf - 1));
                const float w = (6.283185307179586f * (float)i) / (float)Lf;
                float v;
                if (f == 0) { v = tlin; tl[ps] = tlin; }
                else { const int jj = (f - 1) & 15; const float fj = 1e-4f + (float)jj * ((15.0f - 1e-4f) / 15.0f); v = (f <= 16) ? cosf(fj * w) : -sinf(fj * w); }
                z[ps * 36 + f] = v;
            }
            __syncthreads();
            for (int idx = tid; idx < 16 * 64; idx += 512) { const int ps = idx >> 6, oc = idx & 63; float s = fb0[oc];
                for (int f = 0; f < 33; ++f) s += z[ps * 36 + f] * f0[f * 64 + oc];
                a1[idx] = sinf(fq[oc] * s); }
            __syncthreads();
            for (int idx = tid; idx < 16 * 64; idx += 512) { const int ps = idx >> 6, oc = idx & 63; float s = fb1[oc];
                for (int f = 0; f < 64; ++f) s += a1[ps * 64 + f] * f1[f * 64 + oc];
                a2[idx] = sinf(fq[oc] * s); }
            __syncthreads();
            for (int idx = tid; idx < 16 * 64; idx += 512) { const int ps = idx >> 6, oc = idx & 63; float s = fb2[oc];
                for (int f = 0; f < 64; ++f) s += a2[ps * 64 + f] * f2[f * 64 + oc];
                a3[oc * 16 + ps] = sinf(fq[oc] * s); }
            __syncthreads();
            {
                float acc[4][16];
#pragma unroll
                for (int q = 0; q < 4; ++q)
#pragma unroll
                    for (int ps = 0; ps < 16; ++ps) acc[q][ps] = 0.f;
                for (int fb = 0; fb < 64; fb += 4) {
                    float wv[4][4];
#pragma unroll
                    for (int f = 0; f < 4; ++f)
#pragma unroll
                        for (int q = 0; q < 4; ++q) wv[f][q] = f3[(fb + f) * 2048 + tid + 512 * q];
#pragma unroll
                    for (int f = 0; f < 4; ++f) {
                        const f32x4 av0 = *(const f32x4*)(a3 + (fb + f) * 16), av1 = *(const f32x4*)(a3 + (fb + f) * 16 + 4), av2 = *(const f32x4*)(a3 + (fb + f) * 16 + 8), av3 = *(const f32x4*)(a3 + (fb + f) * 16 + 12);
#pragma unroll
                        for (int q = 0; q < 4; ++q)
#pragma unroll
                            for (int e = 0; e < 4; ++e) { acc[q][e] += av0[e] * wv[f][q]; acc[q][4 + e] += av1[e] * wv[f][q]; acc[q][8 + e] += av2[e] * wv[f][q]; acc[q][12 + e] += av3[e] * wv[f][q]; }
                    }
                }
#pragma unroll
                for (int q = 0; q < 4; ++q) {
                    const int c = tid + 512 * q; const int dir = c >> 10, d = c & 1023;
                    const float delta = fabsf(HMIN + (float)d * ((HMAX - HMIN) / 1023.0f));
                    float kv[16];
#pragma unroll
                    for (int ps = 0; ps < 16; ++ps) kv[ps] = acc[q][ps] * expf(-tl[ps] * delta);
                    if (r < 256) {
                        bf16_t* rk = (bf16_t*)(p.ws + WS_KF + (size_t)o * SZ_KF) + (size_t)d * 8192;
                        if (dir == 0) {
                            u32x4 w0, w1;
                            w0.x = pg8::cvt_pk_bf16(kv[15], kv[14]); w0.y = pg8::cvt_pk_bf16(kv[13], kv[12]); w0.z = pg8::cvt_pk_bf16(kv[11], kv[10]); w0.w = pg8::cvt_pk_bf16(kv[9], kv[8]);
                            w1.x = pg8::cvt_pk_bf16(kv[7], kv[6]); w1.y = pg8::cvt_pk_bf16(kv[5], kv[4]); w1.z = pg8::cvt_pk_bf16(kv[3], kv[2]); w1.w = pg8::cvt_pk_bf16(kv[1], kv[0]);
                            *(u32x4*)(rk + 4080 - p0) = w0; *(u32x4*)(rk + 4088 - p0) = w1;
                            if (p0 == 0) rk[8191] = 0;
                        } else {
                            if (p0 > 0) rk[4095 + p0] = f2bf(kv[0]);
                            u32x4 w0; w0.x = pg8::cvt_pk_bf16(kv[1], kv[2]); w0.y = pg8::cvt_pk_bf16(kv[3], kv[4]); w0.z = pg8::cvt_pk_bf16(kv[5], kv[6]); w0.w = pg8::cvt_pk_bf16(kv[7], kv[8]);
                            *(u32x4*)(rk + 4096 + p0) = w0;
                            uint2 w1; w1.x = pg8::cvt_pk_bf16(kv[9], kv[10]); w1.y = pg8::cvt_pk_bf16(kv[11], kv[12]);
                            *(uint2*)(rk + 4104 + p0) = w1;
                            *(unsigned*)(rk + 4108 + p0) = pg8::cvt_pk_bf16(kv[13], kv[14]);
                            rk[4110 + p0] = f2bf(kv[15]);
                        }
                    } else {
#pragma unroll
                        for (int ps = 0; ps < 16; ++ps) kf[((size_t)dir * Lf + p0 + ps) * D + d] = kv[ps];
                    }
                }
            }
        }
        __syncthreads();
    }
}

__device__ __forceinline__ void rowphase(const KQ p_in, int Mupd, const bf16_t* Y, int lu, int gidx, float wgt, const float* gpost,
                         int Mnext, int ln, const float* gpre, int shidx, int scidx, bf16_t* Hout, bool from_input, int tbeg) {
    const KQ p = lq(p_in);
    const int tid = ltid(), w = tid >> 6, lane = tid & 63;
    const int Mmax = Mupd > Mnext ? Mupd : Mnext;
    for (int t = tbeg + (blockIdx.x * 8 + w) * 2; t < Mmax; t += gridDim.x * 16) {
        float* xr = xrow(p, t); const int mr = modrow(t);
        const float* xs = xr;
        if (from_input) xs = (t < TL) ? pin_ld(0) + (size_t)t * D : pin_ld(2) + (size_t)(t - TL) * D;
        float4 xv[2][4];
#pragma unroll
        for (int rr = 0; rr < 2; ++rr)
#pragma unroll
            for (int q = 0; q < 4; ++q) xv[rr][q] = *(const float4*)(xs + rr * D + q * 256 + lane * 4);
        if (Y != nullptr && t < Mupd) {
            float4 yv[2][4]; float ss[2] = {0.f, 0.f};
#pragma unroll
            for (int rr = 0; rr < 2; ++rr)
#pragma unroll
                for (int q = 0; q < 4; ++q) {
                    if (t < TL) { const bf16x4 yb = *(const bf16x4*)(Y + (size_t)(t + rr) * D + q * 256 + lane * 4);
                        yv[rr][q] = make_float4(bf2f((bf16_t)yb[0]), bf2f((bf16_t)yb[1]), bf2f((bf16_t)yb[2]), bf2f((bf16_t)yb[3])); }
                    else { const float* yp = (const float*)(p.ws + WS_YP) + (size_t)(t + rr - TL) * D + q * 256 + lane * 4;
                        const float4 a0 = *(const float4*)yp, a1 = *(const float4*)(yp + (size_t)TC * D), a2 = *(const float4*)(yp + (size_t)2 * TC * D), a3 = *(const float4*)(yp + (size_t)3 * TC * D);
                        yv[rr][q] = make_float4(a0.x + a1.x + a2.x + a3.x, a0.y + a1.y + a2.y + a3.y, a0.z + a1.z + a2.z + a3.z, a0.w + a1.w + a2.w + a3.w); }
                    ss[rr] += yv[rr][q].x * yv[rr][q].x + yv[rr][q].y * yv[rr][q].y + yv[rr][q].z * yv[rr][q].z + yv[rr][q].w * yv[rr][q].w; }
            ss[0] = wave_sum(ss[0]); ss[1] = wave_sum(ss[1]);
            float wgl = wgt; asm volatile("" : "+v"(wgl));
            const float r0 = rsqrtf(ss[0] * (1.0f / D) + EPS) * wgl, r1 = rsqrtf(ss[1] * (1.0f / D) + EPS) * wgl;
            const float* gm = modp(p, lu, mr, gidx);
#pragma unroll
            for (int q = 0; q < 4; ++q) {
                const float4 g4 = *(const float4*)(gm + q * 256 + lane * 4); const float4 p4 = *(const float4*)(gpost + q * 256 + lane * 4);
                const float cx = g4.x * p4.x, cy = g4.y * p4.y, cz = g4.z * p4.z, cw = g4.w * p4.w;
                xv[0][q].x += r0 * cx * yv[0][q].x; xv[0][q].y += r0 * cy * yv[0][q].y; xv[0][q].z += r0 * cz * yv[0][q].z; xv[0][q].w += r0 * cw * yv[0][q].w;
                xv[1][q].x += r1 * cx * yv[1][q].x; xv[1][q].y += r1 * cy * yv[1][q].y; xv[1][q].z += r1 * cz * yv[1][q].z; xv[1][q].w += r1 * cw * yv[1][q].w;
                *(float4*)(xr + q * 256 + lane * 4) = xv[0][q]; *(float4*)(xr + D + q * 256 + lane * 4) = xv[1][q];
            }
        }
        if (Hout != nullptr && t < Mnext) {
            float ss[2] = {0.f, 0.f};
#pragma unroll
            for (int rr = 0; rr < 2; ++rr)
#pragma unroll
                for (int q = 0; q < 4; ++q) ss[rr] += xv[rr][q].x * xv[rr][q].x + xv[rr][q].y * xv[rr][q].y + xv[rr][q].z * xv[rr][q].z + xv[rr][q].w * xv[rr][q].w;
            ss[0] = wave_sum(ss[0]); ss[1] = wave_sum(ss[1]);
            const float rn[2] = {rsqrtf(ss[0] * (1.0f / D) + EPS), rsqrtf(ss[1] * (1.0f / D) + EPS)};
            const float* sh = modp(p, ln, mr, shidx); const float* sc = modp(p, ln, mr, scidx);
#pragma unroll
            for (int q = 0; q < 4; ++q) {
                const float4 g4 = *(const float4*)(gpre + q * 256 + lane * 4); const float4 s4 = *(const float4*)(sc + q * 256 + lane * 4); const float4 h4 = *(const float4*)(sh + q * 256 + lane * 4);
                const float mx_ = g4.x * (1.0f + s4.x), my_ = g4.y * (1.0f + s4.y), mz_ = g4.z * (1.0f + s4.z), mw_ = g4.w * (1.0f + s4.w);
#pragma unroll
                for (int rr = 0; rr < 2; ++rr) {
                    const float h0 = xv[rr][q].x * rn[rr] * mx_ + h4.x, h1 = xv[rr][q].y * rn[rr] * my_ + h4.y;
                    const float h2 = xv[rr][q].z * rn[rr] * mz_ + h4.z, h3 = xv[rr][q].w * rn[rr] * mw_ + h4.w;
                    uint2 pk; pk.x = pg8::cvt_pk_bf16(h0, h1); pk.y = pg8::cvt_pk_bf16(h2, h3);
                    *(uint2*)(Hout + (size_t)(t + rr) * D + q * 256 + lane * 4) = pk;
                }
            }
        }
    }
}

__device__ __forceinline__ float log_sigmoid(float x) { return -log1pf(expf(-x)); }
__device__ __forceinline__ int chunk_t0(int b, int cidx) { return cidx < 32 ? b * SEQ + cidx * 128 : TL + b * CL + (cidx - 32) * 128; }

__device__ __forceinline__ void m1_rope_states(const KQ p_in, int e, float* sm) {
    const KQ p = lq(p_in);
    const int tid = ltid(), bid = blockIdx.x, nb = gridDim.x;
    bf16_t* Z = (bf16_t*)(p.ws + WS_BIG);
    const float* rope = (const float*)(p.ws + WS_ROPE);
    for (int base = bid * 512 + tid; base < TL * 72; base += 2 * nb * 512) {
        bf16_t* zp[2]; bf16x8 a1[2], a2[2]; f32x4 c0[2], c1[2], s0[2], s1[2]; bool ok[2];
#pragma unroll
        for (int u = 0; u < 2; ++u) {
            const int idx = base + u * nb * 512; ok[u] = idx < TL * 72; const int ix = ok[u] ? idx : base;
            const int t = ix / 72, r = ix % 72; const int hd = r >> 2, i0 = (r & 3) * 8;
            const int cb = hd < 16 ? hd * 64 : 1536 + (hd - 16) * 64;
            const int tb = (hd >= 8 && hd < 16) ? 2 : 0; const int pos = t & (SEQ - 1);
            const float* cp = rope + (size_t)tb * SEQ * 32 + pos * 32 + i0; const float* sp = cp + (size_t)SEQ * 32;
            zp[u] = Z + (size_t)t * INW + cb + i0;
            a1[u] = *(const bf16x8*)zp[u]; a2[u] = *(const bf16x8*)(zp[u] + 32);
            c0[u] = *(const f32x4*)cp; c1[u] = *(const f32x4*)(cp + 4); s0[u] = *(const f32x4*)sp; s1[u] = *(const f32x4*)(sp + 4);
        }
#pragma unroll
        for (int u = 0; u < 2; ++u) {
            if (!ok[u]) continue;
            float o1[8], o2[8];
#pragma unroll
            for (int j = 0; j < 8; ++j) { const float x1 = bf2f((bf16_t)a1[u][j]), x2 = bf2f((bf16_t)a2[u][j]); const float cc = j < 4 ? c0[u][j & 3] : c1[u][j & 3], sn = j < 4 ? s0[u][j & 3] : s1[u][j & 3];
                o1[j] = x1 * cc - x2 * sn; o2[j] = x1 * sn + x2 * cc; }
            u32x4 w1, w2;
            w1.x = pg8::cvt_pk_bf16(o1[0], o1[1]); w1.y = pg8::cvt_pk_bf16(o1[2], o1[3]); w1.z = pg8::cvt_pk_bf16(o1[4], o1[5]); w1.w = pg8::cvt_pk_bf16(o1[6], o1[7]);
            w2.x = pg8::cvt_pk_bf16(o2[0], o2[1]); w2.y = pg8::cvt_pk_bf16(o2[2], o2[3]); w2.z = pg8::cvt_pk_bf16(o2[4], o2[5]); w2.w = pg8::cvt_pk_bf16(o2[6], o2[7]);
            *(u32x4*)zp[u] = w1; *(u32x4*)(zp[u] + 32) = w2;
        }
    }
    float* Ks = sm;
    float* Vs = sm + 128 * 64;
    float* wf = Vs + 128 * 64;
    float* wb = wf + 128;
    float* AF = (float*)(p.ws + WS_ST); float* AB = AF + SZ_ST / 4;
    const float* dec = pin_ld(13) + e * 16;
    for (int it = bid; it < NB * NCH * 8; it += nb) {
        const int h = it & 7, cidx = (it >> 3) % NCH, b = it / (8 * NCH);
        const int t0 = chunk_t0(b, cidx); const bool lat = cidx < 32;
        const float lgf = log_sigmoid(dec[h]), lgb = log_sigmoid(dec[8 + h]);
        __syncthreads();
        if (tid < 128) { wf[tid] = expf(lgf * (float)(127 - tid)); wb[tid] = expf(lgb * (float)tid); }
        const int kc = 1792 + h * 64, vc = 2304 + h * 64;
        {
            const int r = tid >> 2, pq = tid & 3;
            bf16_t* zp = Z + (size_t)(t0 + r) * INW + kc + 8 * pq;
            const bf16x8 a1 = *(const bf16x8*)zp, a2 = *(const bf16x8*)(zp + 32);
            float o1[8], o2[8];
            if (lat) {
                const int pos = (t0 + r) & (SEQ - 1);
                const float* cp = rope + (size_t)2 * SEQ * 32 + pos * 32 + 8 * pq; const float* sp = cp + (size_t)SEQ * 32;
                const f32x4 c0 = *(const f32x4*)cp, c1 = *(const f32x4*)(cp + 4), s0 = *(const f32x4*)sp, s1 = *(const f32x4*)(sp + 4);
#pragma unroll
                for (int j = 0; j < 8; ++j) { const float x1 = bf2f((bf16_t)a1[j]), x2 = bf2f((bf16_t)a2[j]); const float cc = j < 4 ? c0[j & 3] : c1[j & 3], sn = j < 4 ? s0[j & 3] : s1[j & 3];
                    o1[j] = bf2f(f2bf(x1 * cc - x2 * sn)); o2[j] = bf2f(f2bf(x1 * sn + x2 * cc)); }
                u32x4 w1, w2;
                w1.x = pg8::cvt_pk_bf16(o1[0], o1[1]); w1.y = pg8::cvt_pk_bf16(o1[2], o1[3]); w1.z = pg8::cvt_pk_bf16(o1[4], o1[5]); w1.w = pg8::cvt_pk_bf16(o1[6], o1[7]);
                w2.x = pg8::cvt_pk_bf16(o2[0], o2[1]); w2.y = pg8::cvt_pk_bf16(o2[2], o2[3]); w2.z = pg8::cvt_pk_bf16(o2[4], o2[5]); w2.w = pg8::cvt_pk_bf16(o2[6], o2[7]);
                *(u32x4*)zp = w1; *(u32x4*)(zp + 32) = w2;
            } else {
#pragma unroll
                for (int j = 0; j < 8; ++j) { o1[j] = bf2f((bf16_t)a1[j]); o2[j] = bf2f((bf16_t)a2[j]); }
            }
            *(f32x4*)(Ks + r * 64 + 8 * pq) = (f32x4){o1[0], o1[1], o1[2], o1[3]}; *(f32x4*)(Ks + r * 64 + 8 * pq + 4) = (f32x4){o1[4], o1[5], o1[6], o1[7]};
            *(f32x4*)(Ks + r * 64 + 32 + 8 * pq) = (f32x4){o2[0], o2[1], o2[2], o2[3]}; *(f32x4*)(Ks + r * 64 + 32 + 8 * pq + 4) = (f32x4){o2[4], o2[5], o2[6], o2[7]};
        }
#pragma unroll
        for (int q = 0; q < 2; ++q) { const int idx = tid + 512 * q; const int r = idx >> 3, pc = idx & 7;
            const bf16x8 vv = *(const bf16x8*)(Z + (size_t)(t0 + r) * INW + vc + 8 * pc);
            *(f32x4*)(Vs + r * 64 + 8 * pc) = (f32x4){bf2f((bf16_t)vv[0]), bf2f((bf16_t)vv[1]), bf2f((bf16_t)vv[2]), bf2f((bf16_t)vv[3])};
            *(f32x4*)(Vs + r * 64 + 8 * pc + 4) = (f32x4){bf2f((bf16_t)vv[4]), bf2f((bf16_t)vv[5]), bf2f((bf16_t)vv[6]), bf2f((bf16_t)vv[7])}; }
        __syncthreads();
        const int d = tid >> 3, e0 = (tid & 7) * 8;
        float af[8], ab[8];
#pragma unroll
        for (int j = 0; j < 8; ++j) { af[j] = 0.f; ab[j] = 0.f; }
        for (int s = 0; s < 128; ++s) {
            const float kv = Ks[s * 64 + d]; const float kfw = kv * wf[s], kbw = kv * wb[s];
            const float4 v0 = *(const float4*)(Vs + s * 64 + e0), v1 = *(const float4*)(Vs + s * 64 + e0 + 4);
            af[0] += kfw * v0.x; af[1] += kfw * v0.y; af[2] += kfw * v0.z; af[3] += kfw * v0.w; af[4] += kfw * v1.x; af[5] += kfw * v1.y; af[6] += kfw * v1.z; af[7] += kfw * v1.w;
            ab[0] += kbw * v0.x; ab[1] += kbw * v0.y; ab[2] += kbw * v0.z; ab[3] += kbw * v0.w; ab[4] += kbw * v1.x; ab[5] += kbw * v1.y; ab[6] += kbw * v1.z; ab[7] += kbw * v1.w;
        }
        const size_t so = ((size_t)(b * NCH + cidx) * 8 + h) * 4096 + d * 64 + e0;
        *(float4*)(AF + so) = make_float4(af[0], af[1], af[2], af[3]); *(float4*)(AF + so + 4) = make_float4(af[4], af[5], af[6], af[7]);
        *(float4*)(AB + so) = make_float4(ab[0], ab[1], ab[2], ab[3]); *(float4*)(AB + so + 4) = make_float4(ab[4], ab[5], ab[6], ab[7]);
    }
    __syncthreads();
}

__device__ __forceinline__ void m2_scan(const KQ p_in, int e) {
    const KQ p = lq(p_in);
    const float* __restrict__ AF = (const float*)(p.ws + WS_ST); const float* __restrict__ AB = AF + SZ_ST / 4;
    float* __restrict__ TF = (float*)(p.ws + WS_ST) + 2 * (SZ_ST / 4); float* __restrict__ TB = TF + SZ_ST / 4;
    const float* dec = pin_ld(13) + e * 16;
    for (int idx = blockIdx.x * 512 + ltid(); idx < NB * 8 * 4096; idx += gridDim.x * 512) {
        const int el = idx & 4095, h = (idx >> 12) & 7, b = idx >> 15;
        const float gf = expf(log_sigmoid(dec[h]) * 128.0f), gb = expf(log_sigmoid(dec[8 + h]) * 128.0f);
        const size_t base = ((size_t)(b * NCH) * 8 + h) * 4096 + el; constexpr size_t CS = (size_t)8 * 4096;
        float af[NCH], ab[NCH];
#pragma unroll
        for (int c = 0; c < NCH; ++c) { af[c] = AF[base + c * CS]; ab[c] = AB[base + c * CS]; }
        TF[base + 32 * CS] = 0.f; TF[base + 33 * CS] = af[32]; TB[base + 33 * CS] = 0.f; TB[base + 32 * CS] = ab[33];
        float sf = gf * af[32] + af[33], sb = ab[32] + gb * ab[33];
#pragma unroll
        for (int c = 0; c < 32; ++c) { TF[base + c * CS] = sf; sf = gf * sf + af[c]; }
#pragma unroll
        for (int c = 31; c >= 0; --c) { TB[base + c * CS] = sb; sb = ab[c] + gb * sb; }
    }
}

__device__ __forceinline__ bf16x8 pack8(const f32x4& a, const f32x4& b) {
    u32x4 w; w.x = pg8::cvt_pk_bf16(a[0], a[1]); w.y = pg8::cvt_pk_bf16(a[2], a[3]); w.z = pg8::cvt_pk_bf16(b[0], b[1]); w.w = pg8::cvt_pk_bf16(b[2], b[3]);
    return __builtin_bit_cast(bf16x8, w);
}
__device__ __forceinline__ void m3_outputs(const KQ p_in, int e, bool ctx_full, unsigned char* smem, unsigned* scan_word) {
    const KQ p = lq(p_in);
    m2_scan(p, e);
    sub_arrive(scan_word);
    bool scan_ready = false;
    const int tid = ltid(), bid = blockIdx.x, nb = gridDim.x;
    const int w = tid >> 6, lane = tid & 63, ln = lane & 15, g4 = lane >> 4;
    const bf16_t* Z = (const bf16_t*)(p.ws + WS_BIG);
    bf16_t* MIX = (bf16_t*)(p.ws + WS_MIX);
    const float* dec = pin_ld(13) + e * 16;
    const float* sink = pin_ld(12) + e * 8;
    const float* TF = (const float*)(p.ws + WS_ST) + 2 * (SZ_ST / 4); const float* TB = TF + SZ_ST / 4;
    const int nchunk = ctx_full ? NCH : 32;
    const int nitems = NB * nchunk * 8;
    bf16_t* Kt = (bf16_t*)smem;
    bf16_t* Vt = Kt + 128 * 72;
    bf16_t* TfT = Vt + 64 * 136;
    bf16_t* TbT = TfT + 64 * 72;
    const int i = 16 * w + ln;
    for (int it = bid; it < 2 * nitems; it += nb) {
        const bool is_attn = it < nitems; const int ii = is_attn ? it : it - nitems;
        const int h = (ii >> 3) & 7, cbx = (ii >> 6) * 8 + (ii & 7), cidx = cbx % nchunk, b = cbx / nchunk;
        if (!is_attn && !scan_ready) { sub_wait(scan_word, gridDim.x); scan_ready = true; }
        const int t0 = chunk_t0(b, cidx); const bool lat = cidx < 32;
        f32x4 O[4];
#pragma unroll
        for (int m = 0; m < 4; ++m) O[m] = (f32x4){0.f, 0.f, 0.f, 0.f};
        if (!is_attn) {
            const float lgf = log_sigmoid(dec[h]), lgb = log_sigmoid(dec[8 + h]);
            __syncthreads();
#pragma unroll
            for (int q = 0; q < 2; ++q) { const int idx = tid + 512 * q; const int r = idx >> 3, pc = idx & 7; const bf16_t* zr = Z + (size_t)(t0 + r) * INW + h * 64 + pc * 8;
                *(u32x4*)(Kt + r * 72 + pc * 8) = *(const u32x4*)(zr + 1792);
                const bf16x8 vv = *(const bf16x8*)(zr + 2304);
#pragma unroll
                for (int j = 0; j < 8; ++j) Vt[(pc * 8 + j) * 136 + (r ^ (pc << 2))] = (bf16_t)vv[j]; }
            const size_t so = ((size_t)(b * NCH + cidx) * 8 + h) * 4096;
            {
                const int ee = tid & 63, d0 = (tid >> 6) * 8;
                float tf[8], tb[8];
#pragma unroll
                for (int j = 0; j < 8; ++j) { tf[j] = TF[so + (d0 + j) * 64 + ee]; tb[j] = TB[so + (d0 + j) * 64 + ee]; }
                u32x4 wf4, wb4;
                wf4.x = pg8::cvt_pk_bf16(tf[0], tf[1]); wf4.y = pg8::cvt_pk_bf16(tf[2], tf[3]); wf4.z = pg8::cvt_pk_bf16(tf[4], tf[5]); wf4.w = pg8::cvt_pk_bf16(tf[6], tf[7]);
                wb4.x = pg8::cvt_pk_bf16(tb[0], tb[1]); wb4.y = pg8::cvt_pk_bf16(tb[2], tb[3]); wb4.z = pg8::cvt_pk_bf16(tb[4], tb[5]); wb4.w = pg8::cvt_pk_bf16(tb[6], tb[7]);
                *(u32x4*)(TfT + ee * 72 + d0) = wf4; *(u32x4*)(TbT + ee * 72 + d0) = wb4;
            }
            __builtin_amdgcn_sched_barrier(0);
            bf16x8 qf[2], qff[2], qfb[2];
            { const bf16_t* qr = Z + (size_t)(t0 + i) * INW + 512 + h * 64 + 8 * g4;
              const float cf = __expf(lgf * (float)(i + 1)), cb = __expf(lgb * (float)(128 - i));
#pragma unroll
              for (int k2 = 0; k2 < 2; ++k2) { qf[k2] = *(const bf16x8*)(qr + 32 * k2);
                  f32x4 a0, a1, b0, b1;
#pragma unroll
                  for (int j = 0; j < 4; ++j) { const float x0 = bf2f((bf16_t)qf[k2][j]), x1 = bf2f((bf16_t)qf[k2][4 + j]); a0[j] = x0 * cf; a1[j] = x1 * cf; b0[j] = x0 * cb; b1[j] = x1 * cb; }
                  qff[k2] = pack8(a0, a1); qfb[k2] = pack8(b0, b1); } }
            __builtin_amdgcn_sched_barrier(0);
            __syncthreads();
#pragma unroll
            for (int m = 0; m < 4; ++m)
#pragma unroll
                for (int k2 = 0; k2 < 2; ++k2) {
                    const bf16x8 af = *(const bf16x8*)(TfT + (16 * m + ln) * 72 + 32 * k2 + 8 * g4);
                    const bf16x8 ab = *(const bf16x8*)(TbT + (16 * m + ln) * 72 + 32 * k2 + 8 * g4);
                    O[m] = __builtin_amdgcn_mfma_f32_16x16x32_bf16(af, qff[k2], O[m], 0, 0, 0);
                    O[m] = __builtin_amdgcn_mfma_f32_16x16x32_bf16(ab, qfb[k2], O[m], 0, 0, 0);
                    __builtin_amdgcn_sched_barrier(0);
                }
            const float lf2 = lgf * 1.44269504f, lb2 = lgb * 1.44269504f; const int di = i - 4 * g4;
            const float bfw = lf2 * (float)di, bbw = -lb2 * (float)di;
            f32x4 st[8];
#pragma unroll
            for (int mt = 0; mt < 8; ++mt) {
                f32x4 a = (f32x4){0.f, 0.f, 0.f, 0.f};
#pragma unroll
                for (int k2 = 0; k2 < 2; ++k2) { const bf16x8 kf = *(const bf16x8*)(Kt + (16 * mt + ln) * 72 + 32 * k2 + 8 * g4); a = __builtin_amdgcn_mfma_f32_16x16x32_bf16(kf, qf[k2], a, 0, 0, 0); }
#pragma unroll
                for (int rg = 0; rg < 4; ++rg) { const int cc = 16 * mt + rg; const int df = di - cc;
                    const float arg = (df > 0) ? fmaf(-lf2, (float)cc, bfw) : fmaf(lb2, (float)cc, bbw);
                    float wgt = __builtin_amdgcn_exp2f(arg); wgt = (df == 0) ? 2.0f : wgt;
                    a[rg] *= wgt; }
                st[mt] = a;
                __builtin_amdgcn_sched_barrier(0);
            }
#pragma unroll
            for (int ks = 0; ks < 4; ++ks) {
                const bf16x8 pfr = pack8(st[2 * ks], st[2 * ks + 1]);
#pragma unroll
                for (int m = 0; m < 4; ++m) {
                    const int vrow = 16 * m + ln; const int kx = (32 * ks + 4 * g4) ^ (((vrow >> 3) & 7) << 2);
                    const bf16_t* vr = Vt + vrow * 136;
                    const bf16x4 v0 = *(const bf16x4*)(vr + kx), v1 = *(const bf16x4*)(vr + (kx ^ 16));
                    const bf16x8 vf = __builtin_shufflevector(v0, v1, 0, 1, 2, 3, 4, 5, 6, 7);
                    O[m] = __builtin_amdgcn_mfma_f32_16x16x32_bf16(vf, pfr, O[m], 0, 0, 0);
                }
                __builtin_amdgcn_sched_barrier(0);
            }
            float ss = 0.f;
#pragma unroll
            for (int m = 0; m < 4; ++m)
#pragma unroll
                for (int rg = 0; rg < 4; ++rg) ss += O[m][rg] * O[m][rg];
            ss += __shfl_xor(ss, 16, 64); ss += __shfl_xor(ss, 32, 64);
            const float rn = rsqrtf(ss * (1.0f / 64.0f) + EPS);
#pragma unroll
            for (int m = 0; m < 4; ++m) {
                const int ee = 16 * m + 4 * g4;
                const bf16x4 gv = *(const bf16x4*)(Z + (size_t)(t0 + i) * INW + 1024 + h * 64 + ee);
                uint2 o2; o2.x = pg8::cvt_pk_bf16(O[m][0] * rn * silu_f(bf2f((bf16_t)gv[0])), O[m][1] * rn * silu_f(bf2f((bf16_t)gv[1])));
                o2.y = pg8::cvt_pk_bf16(O[m][2] * rn * silu_f(bf2f((bf16_t)gv[2])), O[m][3] * rn * silu_f(bf2f((bf16_t)gv[3])));
                *(uint2*)(MIX + (size_t)(t0 + i) * D + 512 + h * 64 + ee) = o2;
            }
        } else {
            const int gk = h >> 2;
            bf16x8 qf[2];
            { const bf16_t* qr = Z + (size_t)(t0 + i) * INW + h * 64 + 8 * g4; qf[0] = *(const bf16x8*)qr; qf[1] = *(const bf16x8*)(qr + 32); }
            float mx = sink[h] * 1.44269504f, l = (g4 == 0) ? 1.0f : 0.0f;
            const int qpos = lat ? (cidx * 128 + i) : 0;
#define ATT_VALID(tl_) ((tl_) >= 3 || (lat && (cidx - 1 + (tl_)) >= 0 && (cidx - 1 + (tl_)) < 32))
#define ATT_KT0(tl_) ((tl_) >= 3 ? TL + b * CL + ((tl_) - 3) * 128 : b * SEQ + (cidx - 1 + (tl_)) * 128)
            int tl = 0; while (!ATT_VALID(tl)) ++tl;
            u32x4 kreg[2]; bf16x8 vreg[2];
            { const int kt0 = ATT_KT0(tl);
#pragma unroll
              for (int q = 0; q < 2; ++q) { const int idx = tid + 512 * q; const int r = idx >> 3, pc = idx & 7; const bf16_t* zr = Z + (size_t)(kt0 + r) * INW + gk * 64 + pc * 8;
                  kreg[q] = *(const u32x4*)(zr + 1536); vreg[q] = *(const bf16x8*)(zr + 1664); } }
            while (tl < 5) {
                const bool isc = tl >= 3; const int kp0 = isc ? 0 : (cidx - 1 + tl) * 128;
                __syncthreads();
#pragma unroll
                for (int q = 0; q < 2; ++q) { const int idx = tid + 512 * q; const int r = idx >> 3, pc = idx & 7;
                    *(u32x4*)(Kt + r * 72 + pc * 8) = kreg[q];
#pragma unroll
                    for (int j = 0; j < 8; ++j) Vt[(pc * 8 + j) * 136 + (r ^ (pc << 2))] = (bf16_t)vreg[q][j]; }
                __syncthreads();
                int tn = tl + 1; while (tn < 5 && !ATT_VALID(tn)) ++tn;
                if (tn < 5) { const int kt0 = ATT_KT0(tn);
#pragma unroll
                    for (int q = 0; q < 2; ++q) { const int idx = tid + 512 * q; const int r = idx >> 3, pc = idx & 7; const bf16_t* zr = Z + (size_t)(kt0 + r) * INW + gk * 64 + pc * 8;
                        kreg[q] = *(const u32x4*)(zr + 1536); vreg[q] = *(const bf16x8*)(zr + 1664); } }
                f32x4 st[8];
                float mloc = -1e30f;
#pragma unroll
                for (int mt = 0; mt < 8; ++mt) {
                    f32x4 a = (f32x4){0.f, 0.f, 0.f, 0.f};
#pragma unroll
                    for (int k2 = 0; k2 < 2; ++k2) { const bf16x8 kf = *(const bf16x8*)(Kt + (16 * mt + ln) * 72 + 32 * k2 + 8 * g4); a = __builtin_amdgcn_mfma_f32_16x16x32_bf16(kf, qf[k2], a, 0, 0, 0); }
                    if (!isc && tl != 1) {
#pragma unroll
                        for (int rg = 0; rg < 4; ++rg) { const int dd = qpos - (kp0 + 16 * mt + 4 * g4 + rg); if (dd > 128 || dd < -128) a[rg] = -1e30f; }
                    }
#pragma unroll
                    for (int rg = 0; rg < 4; ++rg) mloc = fmaxf(mloc, a[rg]);
                    st[mt] = a;
                    __builtin_amdgcn_sched_barrier(0);
                }
                mloc = fmaxf(mloc, __shfl_xor(mloc, 16, 64)); mloc = fmaxf(mloc, __shfl_xor(mloc, 32, 64));
                const float mnew = fmaxf(mx, mloc);
                const float sc = __builtin_amdgcn_exp2f(mx - mnew); mx = mnew; l *= sc;
#pragma unroll
                for (int m = 0; m < 4; ++m) O[m] *= sc;
#pragma unroll
                for (int mt = 0; mt < 8; ++mt)
#pragma unroll
                    for (int rg = 0; rg < 4; ++rg) { const float pv = __builtin_amdgcn_exp2f(st[mt][rg] - mnew); st[mt][rg] = pv; l += pv; }
#pragma unroll
                for (int ks = 0; ks < 4; ++ks) {
                    const bf16x8 pfr = pack8(st[2 * ks], st[2 * ks + 1]);
#pragma unroll
                    for (int m = 0; m < 4; ++m) {
                        const int vrow = 16 * m + ln; const int kx = (32 * ks + 4 * g4) ^ (((vrow >> 3) & 7) << 2);
                        const bf16_t* vr = Vt + vrow * 136;
                        const bf16x4 v0 = *(const bf16x4*)(vr + kx), v1 = *(const bf16x4*)(vr + (kx ^ 16));
                        const bf16x8 vf = __builtin_shufflevector(v0, v1, 0, 1, 2, 3, 4, 5, 6, 7);
                        O[m] = __builtin_amdgcn_mfma_f32_16x16x32_bf16(vf, pfr, O[m], 0, 0, 0);
                    }
                    __builtin_amdgcn_sched_barrier(0);
                }
                tl = tn;
            }
#undef ATT_VALID
#undef ATT_KT0
            l += __shfl_xor(l, 16, 64); l += __shfl_xor(l, 32, 64);
            const float inv = 1.0f / l;
#pragma unroll
            for (int m = 0; m < 4; ++m) {
                uint2 o2; o2.x = pg8::cvt_pk_bf16(O[m][0] * inv, O[m][1] * inv); o2.y = pg8::cvt_pk_bf16(O[m][2] * inv, O[m][3] * inv);
                *(uint2*)(MIX + (size_t)(t0 + i) * D + h * 64 + 16 * m + 4 * g4) = o2;
            }
        }
    }
    __syncthreads();
}

__device__ __forceinline__ void h2_shortconv(const KQ p_in, int o, int M, unsigned char* smem) {
    const KQ p = lq(p_in);
    const int tid = ltid();
    const bf16_t* ZH = (const bf16_t*)(p.ws + WS_BIG);
    const float* w = pin_ld(17) + (size_t)o * 3 * HYW; const float* bs = pin_ld(18) + (size_t)o * HYW;
    bf16_t* VXT = (bf16_t*)(p.ws + WS_Y); bf16_t* X0T = VXT + (size_t)D * TL;
    bf16_t* tx = (bf16_t*)smem;
    bf16_t* tv = tx + 64 * 136;
    const int tok = tid >> 3, cg8 = (tid & 7) * 8;
    float* wl = (float*)(smem + 40960);
    { const int c0b = (blockIdx.x & 15) * 64;
      for (int i = tid; i < 768; i += 512) { const int k = i >> 8, q = (i >> 6) & 3, c = i & 63; const int col = k * 1024 + c0b + c; wl[i] = (q < 3) ? w[q * HYW + col] : bs[col]; } }
    __syncthreads();
    for (int it = blockIdx.x; it < (TL / 128) * 16; it += gridDim.x) {
        const int c0 = (it & 15) * 64, t0 = (it >> 4) * 128;
        bf16x8 zc[2][3], zp[2][3], zn[2][3];
#pragma unroll
        for (int g = 0; g < 2; ++g) {
            const int t = t0 + tok + 64 * g; const int pos = t & (SEQ - 1); const bool first = pos == 0, last = pos == SEQ - 1;
#pragma unroll
            for (int k = 0; k < 3; ++k) {
                const int c = k * 1024 + c0 + cg8;
                zc[g][k] = *(const bf16x8*)(ZH + (size_t)t * HYW + c);
                zp[g][k] = *(const bf16x8*)(ZH + (size_t)(first ? t : t - 1) * HYW + c);
                zn[g][k] = *(const bf16x8*)(ZH + (size_t)(last ? t : t + 1) * HYW + c);
            }
        }
        __syncthreads();
#pragma unroll
        for (int g = 0; g < 2; ++g) {
            const int t = t0 + tok + 64 * g; const int pos = t & (SEQ - 1); const float mf = (pos == 0) ? 0.f : 1.f, ml = (pos == SEQ - 1) ? 0.f : 1.f;
            float zz[3][8];
#pragma unroll
            for (int k = 0; k < 3; ++k) {
                const float* wk = wl + k * 256 + cg8;
#pragma unroll
                for (int j = 0; j < 8; ++j)
                    zz[k][j] = wk[192 + j] + bf2f((bf16_t)zc[g][k][j]) * wk[64 + j] + mf * bf2f((bf16_t)zp[g][k][j]) * wk[j] + ml * bf2f((bf16_t)zn[g][k][j]) * wk[128 + j];
            }
#pragma unroll
            for (int j = 0; j < 8; ++j) { const int cs = (tok + 64 * g) ^ ((tid & 7) << 3);
                tx[(cg8 + j) * 136 + cs] = f2bf(zz[0][j]); tv[(cg8 + j) * 136 + cs] = f2bf(zz[2][j] * zz[1][j]); }
        }
        __syncthreads();
        { const int ch = tid >> 3, tk = (tid & 7) * 8;
#pragma unroll
          for (int q = 0; q < 2; ++q) {
            const int cs = (tk + 64 * q) ^ (((ch >> 3) & 7) << 3);
            *(u32x4*)(X0T + (size_t)(c0 + ch) * TL + t0 + tk + 64 * q) = *(const u32x4*)(tx + ch * 136 + cs);
            *(u32x4*)(VXT + (size_t)(c0 + ch) * TL + t0 + tk + 64 * q) = *(const u32x4*)(tv + ch * 136 + cs); } }
    }
    __syncthreads();
    if (M > TL) {
        float* VX = (float*)(p.ws + WS_Y); bf16_t* X0 = (bf16_t*)(p.ws + WS_H);
        for (int idx = TL * D + blockIdx.x * 512 + tid; idx < M * D; idx += gridDim.x * 512) {
            const int t = idx >> 10, d = idx & 1023;
            const int pos = (t - TL) & (CL - 1); const bool first = pos == 0, last = pos == CL - 1;
            float zz[3];
#pragma unroll
            for (int k = 0; k < 3; ++k) {
                const int c = k * 1024 + d;
                float sacc = bs[c] + bf2f(ZH[(size_t)t * HYW + c]) * w[HYW + c];
                if (!first) sacc += bf2f(ZH[(size_t)(t - 1) * HYW + c]) * w[c];
                if (!last) sacc += bf2f(ZH[(size_t)(t + 1) * HYW + c]) * w[2 * HYW + c];
                zz[k] = sacc;
            }
            VX[idx] = zz[2] * zz[1]; X0[idx] = f2bf(zz[0]);
        }
    }
}

typedef float f32x16 __attribute__((ext_vector_type(16)));
__device__ __forceinline__ void h3_longconv(const KQ p_in, int o, bool ctx_full, unsigned char* smem) {
    const KQ p = lq(p_in);
    const int tid = ltid(), w = tid >> 6, lane = tid & 63;
    const float* bias = pin_ld(27) + (size_t)o * D;
    {
        const bf16_t* VXT = (const bf16_t*)(p.ws + WS_Y); const bf16_t* X0T = VXT + (size_t)D * TL;
        bf16_t* HMT = (bf16_t*)(p.ws + WS_H);
        const bf16_t* RKT = (const bf16_t*)(p.ws + WS_KF + (size_t)o * SZ_KF);
        constexpr int RK2_OFF = 16384 + 64, U_OFF = 2 * 16384 + 128, CH_BYTES = U_OFF + 142 * 256;
        const int cw = w >> 2, w4 = w & 3;
        const int ct = tid & 255;
        unsigned char* cb = smem + cw * CH_BYTES;
        unsigned char* ub = cb + U_OFF;
        const int r = lane & 31, hh = lane >> 5;
        for (int pr = blockIdx.x; pr < D / 2; pr += gridDim.x) {
            const int d = pr * 2 + cw;
            __syncthreads();
            { const bf16_t* src = RKT + (size_t)d * 8192;
              for (int i = ct; i < 1024; i += 256) *(u32x4*)(cb + i * 16) = *(const u32x4*)(src + i * 8);
              for (int i = ct; i < 2 * 7 * 4 * 4; i += 256) { const int side = i / 112, rem = i % 112; unsigned z0 = 0u; asm volatile("" : "+v"(z0)); *(u32x4*)(ub + (side ? (135 * 4 * 64) : 0) + rem * 16) = (u32x4){z0, z0, z0, z0}; }
#pragma unroll 8
              for (int i = ct; i < 4 * 512; i += 256) { const int b = i >> 9, pc = i & 511;
                  const u32x4 v = *(const u32x4*)(VXT + (size_t)d * TL + b * SEQ + pc * 8);
                  const int col = ((pc >> 2) + 7) * 4 + b, q = pc & 3;
                  *(u32x4*)(ub + col * 64 + ((q ^ ((col >> 2) & 3)) * 16)) = v; } }
            __syncthreads();
            { const bf16_t* rk = (const bf16_t*)cb; bf16_t* rk2 = (bf16_t*)(cb + RK2_OFF);
#pragma unroll 4
              for (int i = ct; i < 4096; i += 256) { const unsigned lo = rk[2 * i + 1]; const unsigned hi = (2 * i + 2 < 8192) ? rk[2 * i + 2] : 0u; *(unsigned*)(rk2 + 2 * i) = lo | (hi << 16); } }
            __syncthreads();
            f32x16 acc[4];
#pragma unroll
            for (int j = 0; j < 4; ++j)
#pragma unroll
                for (int q = 0; q < 16; ++q) acc[j][q] = 0.f;
            const bf16_t* rsel = (const bf16_t*)(cb + ((r & 1) ? 0 : RK2_OFF));
            const int adj = (r & 1) ? 0 : -1;
            const int bq = r & 3;
#define H3_LOAD(AF, BF, U) do { \
                _Pragma("unroll") for (int s2 = 0; s2 < 2; ++s2) { \
                    const unsigned* ap = (const unsigned*)(Ab + 64 * (3 - (U)) + 32 * s2); \
                    u32x4 t4; t4.x = ap[0]; t4.y = ap[1]; t4.z = ap[2]; t4.w = ap[3]; \
                    AF[s2] = __builtin_bit_cast(bf16x8, t4); } \
                _Pragma("unroll") for (int j = 0; j < 4; ++j) { \
                    int c_ = Lb - 256 * (U) + 2048 * j; c_ = c_ < LO ? LO : (c_ > HI ? HI : c_); \
                    BF[j][0] = *(const bf16x8*)(ub + c_ + off[U][0]); BF[j][1] = *(const bf16x8*)(ub + c_ + off[U][1]); } } while (0)
#define H3_MMA(AF, BF) do { \
                _Pragma("unroll") for (int s2 = 0; s2 < 2; ++s2) \
                _Pragma("unroll") for (int j = 0; j < 4; ++j) acc[j] = __builtin_amdgcn_mfma_f32_32x32x16_bf16(AF[s2], BF[j][s2], acc[j], 0, 0, 0); } while (0)
            {
                const int dlo = 32 * w4 - 127;
                const int LO = (24 + bq) * 64, HI = (540 + bq) * 64;
                int off[4][2];
#pragma unroll
                for (int u = 0; u < 4; ++u) { const int sw = ((r >> 2) + 2 - u) & 3; off[u][0] = (hh ^ sw) * 16; off[u][1] = ((2 + hh) ^ sw) * 16; }
                int Lb = (((r >> 2) + 134) * 4 + bq) * 64;
                const unsigned char* Ab = (const unsigned char*)(rsel + (4095 - 32 * dlo - r + 8 * hh + adj)) - 192;
                bf16x8 afA[2], bfA[4][2], afB[2], bfB[4][2];
                H3_LOAD(afA, bfA, 0);
                for (int g = 0; g < 39; ++g) {
                    H3_LOAD(afB, bfB, 1);
                    __builtin_amdgcn_sched_barrier(0);
                    H3_MMA(afA, bfA);
                    __builtin_amdgcn_sched_barrier(0);
                    H3_LOAD(afA, bfA, 2);
                    __builtin_amdgcn_sched_barrier(0);
                    H3_MMA(afB, bfB);
                    __builtin_amdgcn_sched_barrier(0);
                    H3_LOAD(afB, bfB, 3);
                    __builtin_amdgcn_sched_barrier(0);
                    H3_MMA(afA, bfA);
                    __builtin_amdgcn_sched_barrier(0);
                    Ab -= 256; Lb -= 1024;
                    H3_LOAD(afA, bfA, 0);
                    __builtin_amdgcn_sched_barrier(0);
                    H3_MMA(afB, bfB);
                    __builtin_amdgcn_sched_barrier(0);
                }
                H3_LOAD(afB, bfB, 1);
                __builtin_amdgcn_sched_barrier(0);
                H3_MMA(afA, bfA);
                __builtin_amdgcn_sched_barrier(0);
                H3_LOAD(afA, bfA, 2);
                __builtin_amdgcn_sched_barrier(0);
                H3_MMA(afB, bfB);
                H3_MMA(afA, bfA);
            }
#undef H3_LOAD
#undef H3_MMA
            __syncthreads();
            const float bd = bias[d];
#pragma unroll
            for (int j = 0; j < 4; ++j) {
                const int n1 = 8 * (4 * w4 + j) + (r >> 2);
                const int col = (n1 + 7) * 4 + bq; const int sw = (col >> 2) & 3;
                bf16_t* up = (bf16_t*)(ub + col * 64);
#pragma unroll
                for (int q4 = 0; q4 < 4; ++q4) {
                    bf16_t* pp = up + ((q4 ^ sw) * 8) + 4 * hh;
                    const bf16x4 uv = *(const bf16x4*)pp;
                    uint2 o2; o2.x = pg8::cvt_pk_bf16(acc[j][4 * q4] + bd * bf2f((bf16_t)uv[0]), acc[j][4 * q4 + 1] + bd * bf2f((bf16_t)uv[1]));
                    o2.y = pg8::cvt_pk_bf16(acc[j][4 * q4 + 2] + bd * bf2f((bf16_t)uv[2]), acc[j][4 * q4 + 3] + bd * bf2f((bf16_t)uv[3]));
                    *(uint2*)pp = o2;
                }
            }
            __syncthreads();
#pragma unroll 4
            for (int i = ct; i < 4 * 512; i += 256) { const int b = i >> 9, pc = i & 511;
                const int col = ((pc >> 2) + 7) * 4 + b, q = pc & 3;
                const bf16x8 yv = *(const bf16x8*)(ub + col * 64 + ((q ^ ((col >> 2) & 3)) * 16));
                const size_t gi = (size_t)d * TL + b * SEQ + pc * 8;
                const bf16x8 xv = *(const bf16x8*)(X0T + gi);
                u32x4 o4;
                o4.x = pg8::cvt_pk_bf16(bf2f((bf16_t)yv[0]) * bf2f((bf16_t)xv[0]), bf2f((bf16_t)yv[1]) * bf2f((bf16_t)xv[1]));
                o4.y = pg8::cvt_pk_bf16(bf2f((bf16_t)yv[2]) * bf2f((bf16_t)xv[2]), bf2f((bf16_t)yv[3]) * bf2f((bf16_t)xv[3]));
                o4.z = pg8::cvt_pk_bf16(bf2f((bf16_t)yv[4]) * bf2f((bf16_t)xv[4]), bf2f((bf16_t)yv[5]) * bf2f((bf16_t)xv[5]));
                o4.w = pg8::cvt_pk_bf16(bf2f((bf16_t)yv[6]) * bf2f((bf16_t)xv[6]), bf2f((bf16_t)yv[7]) * bf2f((bf16_t)xv[7]));
                *(u32x4*)(HMT + gi) = o4; }
        }
        __syncthreads();
    }
    if (ctx_full) {
        const float* VX = (const float*)(p.ws + WS_Y); const bf16_t* X0 = (const bf16_t*)(p.ws + WS_H);
        bf16_t* MIX = (bf16_t*)(p.ws + WS_MIX);
        const float* kf = (const float*)(p.ws + WS_KF + (size_t)o * SZ_KF) + (size_t)2 * SEQ * D;
        for (int idx = blockIdx.x * 512 + tid; idx < (TC / 8) * D; idx += gridDim.x * 512) {
            const int d = idx & 1023, og = idx >> 10;
            const int bb = og >> 5, n0 = (og & 31) * 8, tb = TL + bb * CL;
            const float* up = VX + (size_t)tb * D + d;
            float acc[8];
#pragma unroll
            for (int j = 0; j < 8; ++j) acc[j] = 0.f;
#pragma unroll 1
            for (int mb = 0; mb < CL; mb += 8) {
                float kk[15], uu[8];
#pragma unroll
                for (int q = 0; q < 15; ++q) { const int lag = n0 - mb - 7 + q;
                    kk[q] = (lag >= 0) ? ((lag < CL) ? kf[(size_t)lag * D + d] : 0.f) : ((-lag < CL) ? kf[(size_t)(CL - lag) * D + d] : 0.f); }
#pragma unroll
                for (int u = 0; u < 8; ++u) uu[u] = up[(size_t)(mb + u) * D];
#pragma unroll
                for (int u = 0; u < 8; ++u)
#pragma unroll
                    for (int j = 0; j < 8; ++j) acc[j] += uu[u] * kk[7 - u + j];
            }
            const float bd = bias[d];
#pragma unroll
            for (int j = 0; j < 8; ++j) { const size_t ti = (size_t)(tb + n0 + j) * D + d; MIX[ti] = f2bf(bf2f(X0[ti]) * (acc[j] + bd * VX[ti])); }
        }
    }
}

__device__ __forceinline__ void h3b_transpose(const KQ p_in, unsigned char* smem) {
    const KQ p = lq(p_in);
    const int tid = ltid();
    const bf16_t* HMT = (const bf16_t*)(p.ws + WS_H); bf16_t* MIX = (bf16_t*)(p.ws + WS_MIX);
    bf16_t* tile = (bf16_t*)smem;
    for (int it = blockIdx.x; it < (TL / 256) * 16; it += gridDim.x) {
        const int c0 = (it & 15) * 64, t0 = (it >> 4) * 256;
        u32x4 ld[4];
        { const int ch = tid >> 3, tk = (tid & 7) * 8;
#pragma unroll
          for (int q = 0; q < 4; ++q) ld[q] = *(const u32x4*)(HMT + (size_t)(c0 + ch) * TL + t0 + tk + 64 * q);
          __syncthreads();
#pragma unroll
          for (int q = 0; q < 4; ++q) *(u32x4*)(tile + ch * 264 + ((tk + 64 * q) ^ (((ch >> 3) & 7) << 3))) = ld[q]; }
        __syncthreads();
        { const int cg8 = (tid & 7) * 8;
#pragma unroll
          for (int q = 0; q < 4; ++q) { const int tok = (tid >> 3) + 64 * q; unsigned short v[8];
#pragma unroll
              for (int j = 0; j < 8; ++j) v[j] = tile[(cg8 + j) * 264 + (tok ^ ((tid & 7) << 3))];
              u32x4 o4; o4.x = v[0] | ((unsigned)v[1] << 16); o4.y = v[2] | ((unsigned)v[3] << 16); o4.z = v[4] | ((unsigned)v[5] << 16); o4.w = v[6] | ((unsigned)v[7] << 16);
              *(u32x4*)(MIX + (size_t)(t0 + tok) * D + c0 + cg8) = o4; } }
    }
    __syncthreads();
}

__global__ void __launch_bounds__(512, 2) mega_fwd(KP kp) {
    unsigned char* const smem = g_smem;
    if (threadIdx.x < 29) *(LAS unsigned long long*)((LAS unsigned char*)g_smem + PTAB_OFF + 8 * threadIdx.x) = ((const unsigned long long*)__builtin_amdgcn_kernarg_segment_ptr())[threadIdx.x];
    KQ p; p.out = kp.out; p.ws = kp.ws;
    cg::grid_group grid = cg::this_grid();
    if (threadIdx.x < 4) ((volatile LAS unsigned*)(LAS unsigned char*)smem)[(LDS_BYTES - 16) / 4 + threadIdx.x] = 0u;
    __syncthreads();
    if (threadIdx.x == 0) (void)xb_add(&((unsigned*)(lq(p).ws + WS_BAR))[XB_XCNT(xb_xcc_id())], 1u);
    grid.sync();
    float* smf = (float*)smem;
#define Hb ((bf16_t*)(lq(p).ws + WS_H))
#define BIG ((bf16_t*)(lq(p).ws + WS_BIG))
#define Y ((bf16_t*)(lq(p).ws + WS_Y))
#define MIX ((bf16_t*)(lq(p).ws + WS_MIX))

#ifndef NO_P0
    p0_setup(p, smf);
#endif
    GRID_BAR();
    rowphase(p, 0, nullptr, 0, 0, 0.f, nullptr, T, 0, pin_ld(6), 0, 1, Hb, true, 0);
    GRID_BAR();
    for (int l = 0; l < 4; ++l) {
        const bool ctx_live = l <= 2, ctx_full = l < 2;
        const int Mff = ctx_live ? T : TL, Mpost = ctx_full ? T : TL;
        for (int sub = 0; sub < 3; ++sub) {
            const bf16_t* Ao; const bf16_t* Bo; int Ko; int Mo;
            if (sub != 1) {
                const int fi = sub >> 1; const int M = (sub == 0) ? Mff : Mpost;
                { pg8::EpiSwiGLU E{BIG, DFF}; run_gemm(smem, Hb, (const bf16_t*)(lq(p).ws + WS_WGU + (size_t)(l * 2 + fi) * SZ_WGU), M, 2 * DFF, D, E); }
                GRID_BAR();
                Ao = BIG; Bo = (const bf16_t*)(lq(p).ws + WS_WD + (size_t)(l * 2 + fi) * SZ_WD); Ko = DFF; Mo = M;
            } else {
                if ((l & 1) == 0) {
                    const int e = l >> 1;
                    { pg8::EpiBf16 E{BIG, INW, nullptr}; run_gemm(smem, Hb, (const bf16_t*)(lq(p).ws + WS_WIN + (size_t)e * SZ_WIN), Mff, INW, D, E); }
                    GRID_BAR();
#ifndef NO_M1
                    m1_rope_states(p, e, smf);
#endif
                    GRID_BAR();
#ifndef NO_M3
                    m3_outputs(p, e, ctx_full, smem, (unsigned*)(lq(p).ws + WS_CNT) + (size_t)12 * 2 * 64 * 64 + (12 + e) * 64);
#endif
                    GRID_BAR();
                    Bo = (const bf16_t*)(lq(p).ws + WS_WOUT + (size_t)e * SZ_WOUT);
                } else {
                    const int o = l >> 1;
                    { pg8::EpiBf16 E{BIG, HYW, pin_ld(16) + (size_t)o * HYW}; run_gemm(smem, Hb, (const bf16_t*)(lq(p).ws + WS_HWIN + (size_t)o * SZ_HWIN), Mpost, HYW, D, E); }
                    GRID_BAR();
#ifndef NO_H2
                    h2_shortconv(p, o, Mpost, smem);
#endif
                    GRID_BAR();
#ifndef NO_H3
                    h3_longconv(p, o, ctx_full, smem);
#endif
                    GRID_BAR();
                    h3b_transpose(p, smem);
                    GRID_BAR();
                    Bo = (const bf16_t*)(lq(p).ws + WS_HWOUT + (size_t)o * SZ_WOUT);
                }
                Ao = MIX; Ko = D; Mo = Mpost;
            }
            const int gidx = 2 + 3 * sub;
            const int ln = (sub == 2) ? l + 1 : l; const bool has_next = ln < 4; const int lnn = has_next ? ln : l;
            const int pre_i = (sub == 2) ? 0 : sub + 1;
            const int Mn = has_next ? ((sub == 2) ? ((ln <= 2) ? T : TL) : ((sub == 0) ? Mff : Mpost)) : 0;
            const float* gpost = pin_ld(7) + (size_t)(l * 3 + sub) * D; const float* gpre = pin_ld(6) + (size_t)(lnn * 3 + pre_i) * D;
            const float wg = (sub == 1) ? 1.0f : 0.5f;
            {
                pg8::EpiFusedRow EF;
                EF.xin = (l == 0 && sub == 0) ? pin_ld(0) : (const float*)lq(p).out; EF.xout = lq(p).out; EF.H = has_next ? Hb : nullptr;
                EF.gate = modp(lq(p), l, 0, gidx); EF.gpost = gpost; EF.wgt = wg;
                EF.gpre = gpre; EF.shift = modp(lq(p), lnn, 0, 3 * pre_i); EF.scale = modp(lq(p), lnn, 0, 3 * pre_i + 1);
                EF.slots = (float*)(lq(p).ws + WS_SLOT); EF.cnt = (unsigned*)(lq(p).ws + WS_CNT) + (size_t)(l * 3 + sub) * 2 * 64 * 64;
                run_gemm_f32_split(smem, Ao, Bo, Mo, Ko, EF, (float*)(lq(p).ws + WS_YP));
            }
            if (Mo > TL && blockIdx.x < 64) {
                sub_barrier((unsigned*)(lq(p).ws + WS_CNT) + (size_t)12 * 2 * 64 * 64 + (l * 3 + sub) * 64, 64u);
                rowphase(p, Mo, Y, l, gidx, wg, gpost, Mn, lnn, gpre, 3 * pre_i, 3 * pre_i + 1, has_next ? Hb : nullptr, l == 0 && sub == 0, TL);
            }
            GRID_BAR();
        }
    }
}

extern "C" void kernel_launch(void* const* d_in, const int* in_sizes, int n_in, void* d_out, int out_size, void* d_ws, size_t ws_size, hipStream_t stream) {
    static int grid = 0;
    if (grid == 0) {
        if (n_in != 29 || out_size != TL * D || ws_size < WS_END) { fprintf(stderr, "kernel_launch: unexpected shapes: n_in %d out %d ws %zu (need %zu)\n", n_in, out_size, ws_size, (size_t)WS_END); grid = -1; return; }
        int dev = 0, cus = 0, per_cu = 0;
        (void)hipGetDevice(&dev);
        (void)hipDeviceGetAttribute(&cus, hipDeviceAttributeMultiprocessorCount, dev);
        if (hipFuncSetAttribute((const void*)mega_fwd, hipFuncAttributeMaxDynamicSharedMemorySize, LDS_BYTES) != hipSuccess) { fprintf(stderr, "kernel_launch: hipFuncSetAttribute failed\n"); grid = -1; return; }
        if (hipOccupancyMaxActiveBlocksPerMultiprocessor(&per_cu, (const void*)mega_fwd, 512, LDS_BYTES) != hipSuccess || per_cu < 1) { fprintf(stderr, "kernel_launch: occupancy query says %d\n", per_cu); per_cu = 1; }
        (void)hipGetLastError();
        grid = cus >= 256 ? 256 : cus;
    }
    if (grid < 0) return;
    (void)hipMemsetAsync((unsigned char*)d_ws + WS_BAR, 0, 16384 + SZ_CNT, stream);
    KP kp{};
    for (int i = 0; i < 29; ++i) kp.in[i] = (const float*)d_in[i];
    kp.out = (float*)d_out; kp.ws = (unsigned char*)d_ws;
    void* args[] = {&kp};
    hipError_t e = hipLaunchCooperativeKernel((const void*)mega_fwd, dim3(grid), dim3(512), args, LDS_BYTES, stream);
    if (e != hipSuccess) fprintf(stderr, "cooperative launch failed: %s (grid %d)\n", hipGetErrorString(e), grid);
}
```
